# Optimizing an MI355X kernel written in HIP

```python
import math
import jax
import jax.numpy as jnp
from jax import lax
import numpy as np

D_MODEL = 1024
BATCH = 4
SEQ = 8192
DEPTH = 4

MEM_LEN = 256
GRID_W = 64
CHUNK = 128
Q_BLOCK = 128
EPS = 1e-6
GM_GROUPS = 4
GM_GROUP_DIM = 128
GM_WIDTH = GM_GROUPS * GM_GROUP_DIM
HEAD_DIM = 64
N_Q_HEADS = 8
N_KV_HEADS = 2
Q_PER_KV = N_Q_HEADS // N_KV_HEADS
ATT_WIDTH = N_Q_HEADS * HEAD_DIM
KV_WIDTH = N_KV_HEADS * HEAD_DIM
ROPE_THETA = 10000.0
MIX_WIDTH = GM_WIDTH + ATT_WIDTH
IN_WIDTH = 2 * GM_WIDTH + ATT_WIDTH + 2 * KV_WIDTH
SPLITS = (GM_WIDTH, 2 * GM_WIDTH, 2 * GM_WIDTH + ATT_WIDTH, 2 * GM_WIDTH + ATT_WIDTH + KV_WIDTH)
X_HEADS = 4
X_HEAD_DIM = D_MODEL // X_HEADS
N_EXPERTS = 16
EC_FACTOR = 2
EXPERT_FF = 1024

kernel_name = 'hybrid_gmlp_gqa_ec_encoder'


def rms_norm(x, g):
    xf = x.astype(jnp.float32)
    y = xf * lax.rsqrt(jnp.mean(xf * xf, axis=-1, keepdims=True) + EPS)
    return (y * g.astype(jnp.float32)).astype(x.dtype)


def axial_rope_tables(seq_len):
    rows = seq_len // GRID_W
    row_id = jnp.repeat(jnp.arange(rows, dtype=jnp.float32), GRID_W)
    col_id = jnp.tile(jnp.arange(GRID_W, dtype=jnp.float32), rows)
    n_pairs = HEAD_DIM // 4
    freqs = jnp.exp(-math.log(ROPE_THETA) * jnp.arange(n_pairs, dtype=jnp.float32) / n_pairs)
    ang = jnp.concatenate([row_id[:, None] * freqs[None, :], col_id[:, None] * freqs[None, :]], axis=-1)
    return jnp.cos(ang), jnp.sin(ang)


def apply_rope(x, cos, sin):
    b, s, h, d = x.shape
    xf = x.astype(jnp.float32).reshape(b, s, h, d // 2, 2)
    x0, x1 = xf[..., 0], xf[..., 1]
    c = cos[None, :, None, :]
    sn = sin[None, :, None, :]
    out = jnp.stack([x0 * c - x1 * sn, x0 * sn + x1 * c], axis=-1)
    return out.reshape(b, s, h, d).astype(x.dtype)


def gmlp_group(u, v, v_norm_g, w_s, b_s):
    b, s, _ = u.shape
    v = rms_norm(v, v_norm_g).reshape(b, s // CHUNK, CHUNK, GM_GROUPS, GM_GROUP_DIM)
    mixed = jnp.einsum('gij,bnjgc->bnigc', w_s, v) + b_s.T[None, None, :, :, None]
    return u * mixed.reshape(b, s, GM_WIDTH)


def gqa_group(q, k, v, q_norm_g, k_norm_g, cos, sin):
    b, s, _ = q.shape
    q = q.reshape(b, s, N_Q_HEADS, HEAD_DIM)
    k = k.reshape(b, s, N_KV_HEADS, HEAD_DIM)
    v = v.reshape(b, s, N_KV_HEADS, HEAD_DIM)
    q = apply_rope(rms_norm(q, q_norm_g), cos, sin) * (HEAD_DIM ** -0.5)
    k = apply_rope(rms_norm(k, k_norm_g), cos, sin)
    n_blk = s // Q_BLOCK
    q_blocks = q.reshape(b, n_blk, Q_BLOCK, N_KV_HEADS, Q_PER_KV, HEAD_DIM).transpose(1, 0, 3, 4, 2, 5)

    def attend(qb):
        sc = jnp.einsum('bkgqd,bskd->bkgqs', qb, k, preferred_element_type=jnp.float32)
        p = jax.nn.softmax(sc, axis=-1).astype(v.dtype)
        return jnp.einsum('bkgqs,bskd->bkgqd', p, v)

    o = lax.map(attend, q_blocks)
    return o.transpose(1, 0, 4, 2, 3, 5).reshape(b, s, ATT_WIDTH)


def memory_cross_attention(h, mem_n, w_q, w_kv, w_o):
    b, s, _ = h.shape
    m = mem_n.shape[1]
    q = (h @ w_q).reshape(b, s, X_HEADS, X_HEAD_DIM) * (X_HEAD_DIM ** -0.5)
    kv = (mem_n @ w_kv).reshape(b, m, 2, X_HEADS, X_HEAD_DIM)
    k, v = kv[:, :, 0], kv[:, :, 1]
    sc = jnp.einsum('bshd,bmhd->bhsm', q, k, preferred_element_type=jnp.float32)
    p = jax.nn.softmax(sc, axis=-1).astype(v.dtype)
    o = jnp.einsum('bhsm,bmhd->bshd', p, v).reshape(b, s, D_MODEL)
    return o @ w_o


def expert_choice_moe(h, w_router, w_gate, w_up, w_down):
    b, s, _ = h.shape
    cap = EC_FACTOR * s // N_EXPERTS
    logits = jnp.einsum('bsd,de->bse', h, w_router, preferred_element_type=jnp.float32)
    aff = jax.nn.softmax(logits, axis=-1)
    gates, idx = lax.top_k(aff.transpose(0, 2, 1), cap)
    b_ix = jnp.arange(b)[:, None, None]
    xs = h[b_ix, idx]
    a = jnp.einsum('becd,edf->becf', xs, w_gate)
    u = jnp.einsum('becd,edf->becf', xs, w_up)
    y = jnp.einsum('becf,efd->becd', jax.nn.silu(a) * u, w_down)
    y = y * gates[..., None].astype(y.dtype)
    return jnp.zeros_like(h).at[b_ix, idx].add(y)


def setup_inputs(seed: int = 0) -> dict:
    key = jax.random.key(seed)
    ks = jax.random.split(key, 24)

    def nrm(k, shape, scale):
        return jax.random.normal(k, shape, jnp.float32) * scale

    def gain(k, shape):
        return 1.0 + 0.05 * jax.random.normal(k, shape, jnp.float32)

    L, D = DEPTH, D_MODEL
    return {
        'x': nrm(ks[0], (BATCH, SEQ, D), 1.0),
        'mem': nrm(ks[1], (BATCH, MEM_LEN, D), 1.0),
        'mix_norm_g': gain(ks[2], (L, D)),
        'w_in': nrm(ks[3], (L, D, IN_WIDTH), D ** -0.5),
        'gm_v_norm_g': gain(ks[4], (L, GM_WIDTH)),
        'gm_w_s': nrm(ks[5], (L, GM_GROUPS, CHUNK, CHUNK), CHUNK ** -0.5),
        'gm_b_s': gain(ks[6], (L, GM_GROUPS, CHUNK)),
        'q_norm_g': gain(ks[7], (L, HEAD_DIM)),
        'k_norm_g': gain(ks[8], (L, HEAD_DIM)),
        'branch_norm_g': gain(ks[9], (L, 2, GM_WIDTH)),
        'w_out': nrm(ks[10], (L, MIX_WIDTH, D), MIX_WIDTH ** -0.5),
        'xattn_norm_g': gain(ks[11], (L, D)),
        'mem_norm_g': gain(ks[12], (D,)),
        'xattn_w_q': nrm(ks[13], (L, D, D), D ** -0.5),
        'xattn_w_kv': nrm(ks[14], (L, D, 2 * D), D ** -0.5),
        'xattn_w_o': nrm(ks[15], (L, D, D), D ** -0.5),
        'ffn_norm_g': gain(ks[16], (L, D)),
        'w_router': nrm(ks[17], (L, D, N_EXPERTS), D ** -0.5),
        'w_gate': nrm(ks[18], (L, N_EXPERTS, D, EXPERT_FF), D ** -0.5),
        'w_up': nrm(ks[19], (L, N_EXPERTS, D, EXPERT_FF), D ** -0.5),
        'w_down': nrm(ks[20], (L, N_EXPERTS, EXPERT_FF, D), EXPERT_FF ** -0.5),
        'final_norm_g': gain(ks[21], (D,)),
    }


def reference(x, mem, mix_norm_g, w_in, gm_v_norm_g, gm_w_s, gm_b_s, q_norm_g, k_norm_g,
              branch_norm_g, w_out, xattn_norm_g, mem_norm_g, xattn_w_q, xattn_w_kv, xattn_w_o,
              ffn_norm_g, w_router, w_gate, w_up, w_down, final_norm_g):
    cos, sin = axial_rope_tables(x.shape[1])
    mem_n = rms_norm(mem, mem_norm_g)
    for l in range(DEPTH):
        h = rms_norm(x, mix_norm_g[l])
        proj = h @ w_in[l]
        u, v, q, k, vv = jnp.split(proj, SPLITS, axis=-1)
        gm = gmlp_group(jax.nn.gelu(u), jax.nn.gelu(v), gm_v_norm_g[l], gm_w_s[l], gm_b_s[l])
        at = gqa_group(q, k, vv, q_norm_g[l], k_norm_g[l], cos, sin)
        merged = jnp.concatenate([rms_norm(gm, branch_norm_g[l, 0]), rms_norm(at, branch_norm_g[l, 1])], axis=-1)
        x = x + merged @ w_out[l]
        x = x + memory_cross_attention(rms_norm(x, xattn_norm_g[l]), mem_n,
                                       xattn_w_q[l], xattn_w_kv[l], xattn_w_o[l])
        x = x + expert_choice_moe(rms_norm(x, ffn_norm_g[l]), w_router[l], w_gate[l], w_up[l], w_down[l])
    return rms_norm(x, final_norm_g)
```

```cpp
#include <hip/hip_runtime.h>
#include <cstdio>
#include <cstdint>

constexpr int NB_ = 4, SEQ = 8192, T = NB_ * SEQ, D = 1024, NL = 4;
constexpr int MEML = 256, NMEM = NB_ * MEML;
constexpr int INW = 1792, GMW = 512, NE = 16, CAP = 1024, FF = 1024;
constexpr float EPS = 1e-6f;
constexpr float LOG2E = 1.4426950408889634f;
constexpr float QSCALE = 0.125f * LOG2E;
constexpr float XQSCALE = 0.0625f * LOG2E;

constexpr size_t MiB = 1u << 20;
constexpr size_t WS_CTL = 0, CTL_ZERO_BYTES = 1 * MiB;
constexpr size_t WS_ROPE = 1 * MiB;
constexpr size_t WS_AFF = 3 * MiB;
constexpr size_t WS_INV = 5 * MiB;
constexpr size_t WS_IDX = 7 * MiB;
constexpr size_t WS_VSTAT = 8 * MiB;
constexpr size_t WS_ATSTAT = 9 * MiB;
constexpr size_t WS_GMSTAT = 10 * MiB;
constexpr size_t WS_XSTAT = 11 * MiB;
constexpr size_t WS_MEMN = 13 * MiB;
constexpr size_t WS_HB = 486 * MiB;
constexpr size_t WS_R1 = 550 * MiB;
constexpr size_t WS_UACT = WS_R1, WS_VACT = WS_R1 + 32 * MiB, WS_Q = WS_R1 + 64 * MiB, WS_K = WS_R1 + 96 * MiB, WS_V = WS_R1 + 104 * MiB;
constexpr size_t WS_H = WS_R1;
constexpr size_t WS_MERGED = 678 * MiB;
constexpr size_t WS_XB = 742 * MiB;
constexpr size_t WS_Y = 678 * MiB;
constexpr size_t WS_NSCR = 806 * MiB;
constexpr size_t WS_Q2 = WS_MERGED;
constexpr size_t WS_O2 = WS_NSCR;
constexpr size_t WS_KVN = WS_NSCR + 64 * MiB;
constexpr size_t WS_END = 1024 * MiB;

constexpr int CW_TMO = 0, CW_CODE = 1, CW_BAR = 4096;

#define GAS __attribute__((address_space(1)))
#define LAS __attribute__((address_space(3)))
typedef unsigned short bf16;
typedef unsigned v4u __attribute__((ext_vector_type(4)));
typedef unsigned v2u __attribute__((ext_vector_type(2)));
typedef float f32x4 __attribute__((ext_vector_type(4)));
typedef GAS unsigned gu32;
#define RLX_AGENT __ATOMIC_RELAXED, __HIP_MEMORY_SCOPE_AGENT
__device__ __forceinline__ unsigned f2bf(float f) { unsigned u = __builtin_bit_cast(unsigned, f); return (u + 0x7fffu + ((u >> 16) & 1u)) >> 16; }
__device__ __forceinline__ unsigned pk2(float lo, float hi) { return f2bf(lo) | (f2bf(hi) << 16); }
__device__ __forceinline__ float bf2f(unsigned v) { return __builtin_bit_cast(float, v << 16); }
__device__ __forceinline__ float bflo(unsigned w) { return __builtin_bit_cast(float, w << 16); }
__device__ __forceinline__ float bfhi(unsigned w) { return __builtin_bit_cast(float, w & 0xffff0000u); }
__device__ __forceinline__ float rbf(float f) { return bf2f(f2bf(f)); }
__device__ __forceinline__ float gelu_tanh(float x) {
    const float z = 1.5957691216057308f * (x + 0.044715f * x * x * x);
    return x / (1.0f + __builtin_amdgcn_exp2f(-z * LOG2E));
}
__device__ __forceinline__ float silu_f(float a) { return a / (1.0f + __builtin_amdgcn_exp2f(-a * LOG2E)); }
__device__ __forceinline__ float wave_sum(float v) {
#pragma unroll
    for (int o = 1; o < 64; o <<= 1) v += __shfl_xor(v, o);
    return v;
}

#define XB_TMO      128
#define XB_XCNT(j)  (256  + 64 * (j))
#define XB_XSUB(j)  (1280 + 64 * (j))
#define XB_XGEN(j)  (2304 + 64 * (j))
#define XB_TOP      3328
#define XB_TOPGEN   3392
#define XCD_BAR_WORDS 3456
#define XB_SPIN_CAP (1u << 18)
__device__ __forceinline__ unsigned xb_ld(unsigned* p)              { return __hip_atomic_load(p, __ATOMIC_RELAXED, __HIP_MEMORY_SCOPE_AGENT); }
__device__ __forceinline__ unsigned xb_add(unsigned* p, unsigned v) { return __hip_atomic_fetch_add(p, v, __ATOMIC_RELAXED, __HIP_MEMORY_SCOPE_AGENT); }
__device__ __forceinline__ unsigned xb_xcc_id() { return (unsigned)__builtin_amdgcn_s_getreg((3 << 11) | 20) & 0xFu; }
#define XB_SPIN(cond, bar) do { unsigned _sp = 0; while (cond) { __builtin_amdgcn_s_sleep(1); \
    if ((++_sp & 255u) == 0u) { if (xb_ld(&(bar)[XB_TMO])) break; if (_sp > XB_SPIN_CAP) { atomicAdd(&(bar)[XB_TMO], 1u); break; } } } } while (0)
struct XcdBarrier { unsigned* bar; unsigned x; volatile LAS unsigned* st; };
__device__ __forceinline__ XcdBarrier xcd_barrier_post(unsigned* bar, volatile LAS unsigned* st) {
    XcdBarrier b; b.bar = bar; b.x = xb_xcc_id(); b.st = st;
    if (threadIdx.x == 0) (void)xb_add(&bar[XB_XCNT(b.x)], 1u);
    return b;
}
__device__ __forceinline__ void xcd_barrier_complete(unsigned* bar, unsigned x, unsigned& nloc, unsigned& nx) {
    const unsigned G = gridDim.x * gridDim.y * gridDim.z;
    unsigned sum, cnt, mine, sp = 0u;
    for (;;) {
        sum = 0u; cnt = 0u; mine = 0u;
#pragma unroll
        for (unsigned j = 0; j < 16; ++j) { const unsigned c = xb_ld(&bar[XB_XCNT(j)]); sum += c; cnt += (c > 0u) ? 1u : 0u; mine = (j == x) ? c : mine; }
        if (sum == G) break;
        __builtin_amdgcn_s_sleep(1);
        if ((++sp & 255u) == 0u) { if (xb_ld(&bar[XB_TMO])) break; if (sp > XB_SPIN_CAP) { atomicAdd(&bar[XB_TMO], 1u); break; } }
    }
    nloc = mine > 0u ? mine : 1u; nx = cnt > 0u ? cnt : 1u;
}
__device__ __forceinline__ void xcd_barrier(const XcdBarrier& b) {
    asm volatile("s_waitcnt vmcnt(0)" ::: "memory");
    __syncthreads();
    if (threadIdx.x == 0) {
        unsigned* bar = b.bar;
        __builtin_amdgcn_s_waitcnt(0);
        unsigned nloc = b.st[0], nx = b.st[1];
        if (nloc == 0u) { xcd_barrier_complete(bar, b.x, nloc, nx); b.st[0] = nloc; b.st[1] = nx; }
        const unsigned old = xb_add(&bar[XB_XSUB(b.x)], 1u);
        const unsigned gen = old / nloc;
        if (old + 1u == (gen + 1u) * nloc) {
            __builtin_amdgcn_fence(__ATOMIC_RELEASE, "agent");
            asm volatile("s_waitcnt vmcnt(0)" ::: "memory");
            const unsigned og = xb_add(&bar[XB_TOP], 1u);
            const unsigned tg = og / nx;
            if (og + 1u == (tg + 1u) * nx) xb_add(&bar[XB_TOPGEN], 1u);
            else XB_SPIN(xb_ld(&bar[XB_TOPGEN]) == tg, bar);
            __builtin_amdgcn_fence(__ATOMIC_ACQUIRE, "agent");
            xb_add(&bar[XB_XGEN(b.x)], 1u);
            asm volatile("s_waitcnt vmcnt(0)" ::: "memory");
        } else {
            XB_SPIN(xb_ld(&bar[XB_XGEN(b.x)]) == gen, bar);
            __builtin_amdgcn_fence(__ATOMIC_ACQUIRE, "agent");
            asm volatile("s_waitcnt vmcnt(0)" ::: "memory");
        }
    }
    __syncthreads();
}

struct Args { const float* in[22]; float* out; unsigned char* ws; int ph_lo, ph_hi, bar_region, pad; };
constexpr int PH_LAYER0 = 4, PH_PER_LAYER = 10, PH_END = PH_LAYER0 + NL * PH_PER_LAYER;

constexpr int NWAVES = 8, NTHR = NWAVES * 64;
constexpr int RING_BYTES = 131072, LDSCTL_OFF = RING_BYTES, MISC_OFF = LDSCTL_OFF + 320;
constexpr int LDS_BYTES = 147456;

struct Frame {
    LAS unsigned char* lds;
    int tid, lane, wave, vcu, G;
    const float* in[22];
    unsigned char* ws;
    float* xres;
};

__device__ __forceinline__ void ph_rows0(Frame& F) {
    const int gw = F.vcu * NWAVES + F.wave, NGW = F.G * NWAVES;
    const float* x = F.in[0]; const float* mem = F.in[1]; const float* mg = F.in[12];
    bf16* HB = (bf16*)(F.ws + WS_HB); bf16* MEMN = (bf16*)(F.ws + WS_MEMN);
    for (int m = gw; m < T + NMEM; m += NGW) {
        const bool is_mem = m >= T;
        const float* src = is_mem ? mem + (size_t)(m - T) * D : x + (size_t)m * D;
        bf16* dst = is_mem ? MEMN + (size_t)(m - T) * D : HB + (size_t)m * D;
        f32x4 v[4]; float s = 0.f;
#pragma unroll
        for (int j = 0; j < 4; ++j) { v[j] = *(const f32x4*)(src + 4 * F.lane + 256 * j); s += (v[j].x * v[j].x + v[j].y * v[j].y) + (v[j].z * v[j].z + v[j].w * v[j].w); }
        const float rinv = 1.0f / sqrtf(wave_sum(s) * (1.0f / D) + EPS);
#pragma unroll
        for (int j = 0; j < 4; ++j) {
            f32x4 g = (f32x4){1.f, 1.f, 1.f, 1.f};
            if (is_mem) g = *(const f32x4*)(mg + 4 * F.lane + 256 * j);
            v2u o; o.x = pk2(v[j].x * rinv * g.x, v[j].y * rinv * g.y); o.y = pk2(v[j].z * rinv * g.z, v[j].w * rinv * g.w);
            *(v2u*)(dst + 4 * F.lane + 256 * j) = o;
        }
    }
    float* COS = (float*)(F.ws + WS_ROPE); float* SIN = COS + SEQ * 32;
    const int gt = F.vcu * NTHR + F.tid, NGT = F.G * NTHR;
    for (int i = gt; i < SEQ * 32; i += NGT) {
        const int t = i >> 5, p = i & 31;
        const float fr = expf(-9.210340371976184f * (float)(p & 15) * (1.0f / 16.0f));
        const float pos = (float)((p < 16) ? (t >> 6) : (t & 63));
        float rev = pos * fr * 0.15915494309189535f; rev -= floorf(rev);
        COS[i] = __builtin_amdgcn_cosf(rev); SIN[i] = __builtin_amdgcn_sinf(rev);
    }
}

__device__ __forceinline__ void ph_gmlp(Frame& F, int l) {
    const bf16* UACT = (const bf16*)(F.ws + WS_UACT); const bf16* VACT = (const bf16*)(F.ws + WS_VACT);
    const float* VSTAT = (const float*)(F.ws + WS_VSTAT); float* GMSTAT = (float*)(F.ws + WS_GMSTAT);
    bf16* MERGED = (bf16*)(F.ws + WS_MERGED);
    const float* gvn = F.in[4] + (size_t)l * GMW; const float* ws_ = F.in[5] + (size_t)l * 4 * 128 * 128; const float* bs = F.in[6] + (size_t)l * 4 * 128;
    LAS float* sV = (LAS float*)F.lds;
    LAS float* sW = (LAS float*)(F.lds + 65536);
    for (int u = F.vcu; u < (T / 128) * 4; u += F.G) {
        const int n = u >> 2, g = u & 3; const int row0 = n * 128;
        __syncthreads();
        for (int it = F.tid; it < 128 * 16; it += NTHR) {
            const int j = it >> 4, c8 = (it & 15) * 8; const int row = row0 + j;
            const float* vs = VSTAT + (size_t)row * 8; float ss = 0.f;
#pragma unroll
            for (int q = 0; q < 8; ++q) ss += vs[q];
            const float rinv = 1.0f / sqrtf(ss * (1.0f / GMW) + EPS);
            const v4u raw = *(const v4u*)(VACT + (size_t)row * GMW + g * 128 + c8);
            const float* gp = gvn + g * 128 + c8;
            LAS float* d = sV + j * 128 + c8;
            d[0] = bflo(raw.x) * rinv * gp[0]; d[1] = bfhi(raw.x) * rinv * gp[1]; d[2] = bflo(raw.y) * rinv * gp[2]; d[3] = bfhi(raw.y) * rinv * gp[3];
            d[4] = bflo(raw.z) * rinv * gp[4]; d[5] = bfhi(raw.z) * rinv * gp[5]; d[6] = bflo(raw.w) * rinv * gp[6]; d[7] = bfhi(raw.w) * rinv * gp[7];
        }
        for (int it = F.tid; it < 128 * 32; it += NTHR) {
            const int i = it >> 5, j4 = (it & 31) * 4;
            const f32x4 w = *(const f32x4*)(ws_ + ((size_t)g * 128 + i) * 128 + j4);
            *(LAS f32x4*)(sW + i * 128 + j4) = w;
        }
        __syncthreads();
        const int c = F.tid & 127, ib = (F.tid >> 7) * 32;
        float acc[32];
#pragma unroll
        for (int ii = 0; ii < 32; ++ii) acc[ii] = 0.f;
        for (int j4 = 0; j4 < 128; j4 += 4) {
            const float v0 = sV[(j4 + 0) * 128 + c], v1 = sV[(j4 + 1) * 128 + c], v2 = sV[(j4 + 2) * 128 + c], v3 = sV[(j4 + 3) * 128 + c];
#pragma unroll
            for (int ii = 0; ii < 32; ++ii) { const f32x4 w = *(const LAS f32x4*)(sW + (ib + ii) * 128 + j4); acc[ii] += (w.x * v0 + w.y * v1) + (w.z * v2 + w.w * v3); }
        }
        __syncthreads();
#pragma unroll
        for (int ii = 0; ii < 32; ++ii) {
            const int i = ib + ii, row = row0 + i;
            const float uu = bf2f(UACT[(size_t)row * GMW + g * 128 + c]);
            const float o = uu * (acc[ii] + bs[g * 128 + i]);
            const unsigned ob = f2bf(o); const float orr = bf2f(ob);
            MERGED[(size_t)row * 1024 + g * 128 + c] = (bf16)ob;
            sV[i * 129 + c] = orr * orr;
        }
        __syncthreads();
        if (F.tid < 128) { float s = 0.f; for (int cc = 0; cc < 128; ++cc) s += sV[F.tid * 129 + cc]; GMSTAT[(size_t)(row0 + F.tid) * 4 + g] = s; }
    }
    __syncthreads();
}

__device__ __forceinline__ void ph_router(Frame& F, int l) {
    const float* g = F.in[16] + (size_t)l * D; const float* wr = F.in[17] + (size_t)l * D * NE;
    bf16* HB = (bf16*)(F.ws + WS_HB); float* AFF = (float*)(F.ws + WS_AFF);
    LAS float* sW = (LAS float*)F.lds;
    __syncthreads();
    for (int i = F.tid; i < D * NE; i += NTHR) { const int c = i >> 4, e = i & 15; sW[e * D + c] = wr[i] * g[c]; }
    __syncthreads();
    const int gw = F.vcu * NWAVES + F.wave, NGW = F.G * NWAVES;
    for (int m = gw; m < T; m += NGW) {
        const float* xr = F.xres + (size_t)m * D;
        f32x4 v[4]; float s = 0.f;
#pragma unroll
        for (int j = 0; j < 4; ++j) { v[j] = *(const f32x4*)(xr + 4 * F.lane + 256 * j); s += (v[j].x * v[j].x + v[j].y * v[j].y) + (v[j].z * v[j].z + v[j].w * v[j].w); }
        const float rinv = 1.0f / sqrtf(wave_sum(s) * (1.0f / D) + EPS);
#pragma unroll
        for (int j = 0; j < 4; ++j) { v2u o; o.x = pk2(v[j].x * rinv, v[j].y * rinv); o.y = pk2(v[j].z * rinv, v[j].w * rinv); *(v2u*)(HB + (size_t)m * D + 4 * F.lane + 256 * j) = o; }
        float mylg = 0.f;
#pragma unroll 1
        for (int e = 0; e < NE; ++e) { float a = 0.f;
#pragma unroll
            for (int j = 0; j < 4; ++j) { const f32x4 w = *(const LAS f32x4*)(sW + e * D + 4 * F.lane + 256 * j); a += (v[j].x * w.x + v[j].y * w.y) + (v[j].z * w.z + v[j].w * w.w); }
            a = wave_sum(a) * rinv; mylg = (F.lane == e) ? a : mylg; }
        float mx = mylg;
        mx = fmaxf(mx, __shfl_xor(mx, 1)); mx = fmaxf(mx, __shfl_xor(mx, 2)); mx = fmaxf(mx, __shfl_xor(mx, 4)); mx = fmaxf(mx, __shfl_xor(mx, 8));
        const float pe = __builtin_amdgcn_exp2f((mylg - mx) * LOG2E);
        float den = pe; den += __shfl_xor(den, 1); den += __shfl_xor(den, 2); den += __shfl_xor(den, 4); den += __shfl_xor(den, 8);
        const float mine = pe / den;
        if (F.lane < NE) AFF[(size_t)m * NE + F.lane] = mine;
    }
    __syncthreads();
}

__device__ __forceinline__ void ph_topk(Frame& F) {
    const float* AFF = (const float*)(F.ws + WS_AFF); int* IDX = (int*)(F.ws + WS_IDX); int* INV = (int*)(F.ws + WS_INV);
    LAS unsigned* hist = (LAS unsigned*)F.lds;
    LAS unsigned* sh = hist + 256;
    LAS unsigned* wsum = hist + 512;
    for (int p = F.vcu; p < NB_ * NE; p += F.G) {
        const int b = p >> 4, e = p & 15;
        unsigned key[16];
#pragma unroll
        for (int i = 0; i < 16; ++i) key[i] = __builtin_bit_cast(unsigned, AFF[((size_t)b * SEQ + F.tid * 16 + i) * NE + e]);
        unsigned prefix = 0u, krem = CAP;
#pragma unroll
        for (int pass = 0; pass < 4; ++pass) {
            const int shift = 24 - 8 * pass; const unsigned himask = pass == 0 ? 0u : (0xffffffffu << (shift + 8));
            __syncthreads();
            if (F.tid < 256) hist[F.tid] = 0u;
            __syncthreads();
#pragma unroll
            for (int i = 0; i < 16; ++i) if ((key[i] & himask) == prefix) atomicAdd((unsigned*)&hist[(key[i] >> shift) & 255u], 1u);
            __syncthreads();
            if (F.tid == 0) { unsigned above = 0u; int d = 255; for (; d > 0; --d) { const unsigned c = hist[d]; if (above + c >= krem) break; above += c; } sh[0] = prefix | ((unsigned)d << shift); sh[1] = krem - above; }
            __syncthreads();
            prefix = sh[0]; krem = sh[1];
        }
        const unsigned thr = prefix;
        unsigned cg = 0u, ce = 0u;
#pragma unroll
        for (int i = 0; i < 16; ++i) { cg += key[i] > thr ? 1u : 0u; ce += key[i] == thr ? 1u : 0u; }
        unsigned sg = cg, se = ce;
#pragma unroll
        for (int o = 1; o < 64; o <<= 1) { const unsigned a = __shfl_up(sg, o), c2 = __shfl_up(se, o); if (F.lane >= o) { sg += a; se += c2; } }
        __syncthreads();
        if (F.lane == 63) { wsum[F.wave] = sg; wsum[8 + F.wave] = se; }
        __syncthreads();
        unsigned og = 0u, oe = 0u;
        for (int w = 0; w < F.wave; ++w) { og += wsum[w]; oe += wsum[8 + w]; }
        unsigned gb = og + sg - cg, eb = oe + se - ce;
#pragma unroll
        for (int i = 0; i < 16; ++i) {
            const int t = F.tid * 16 + i; int pos = -1;
            if (key[i] > thr) { pos = (int)(gb + (eb < krem ? eb : krem)); ++gb; }
            else if (key[i] == thr) { if (eb < krem) pos = (int)(gb + eb); ++eb; }
            INV[((size_t)b * SEQ + t) * NE + e] = pos;
            if (pos >= 0) IDX[(size_t)p * CAP + pos] = t;
        }
    }
    __syncthreads();
}

__device__ __forceinline__ void ph_combine(Frame& F, int l) {
    const float* AFF = (const float*)(F.ws + WS_AFF); const int* INV = (const int*)(F.ws + WS_INV);
    const bf16* Y = (const bf16*)(F.ws + WS_Y); bf16* HB = (bf16*)(F.ws + WS_HB); const float* fg = F.in[21];
    const int gw = F.vcu * NWAVES + F.wave, NGW = F.G * NWAVES;
    for (int m = gw; m < T; m += NGW) {
        float* xr = F.xres + (size_t)m * D; const int b = m / SEQ;
        f32x4 v[4];
#pragma unroll
        for (int j = 0; j < 4; ++j) v[j] = *(const f32x4*)(xr + 4 * F.lane + 256 * j);
        const int mypos = F.lane < NE ? INV[(size_t)m * NE + F.lane] : -1;
        const float myaff = F.lane < NE ? AFF[(size_t)m * NE + F.lane] : 0.f;
#pragma unroll
        for (int e = 0; e < NE; ++e) {
            const int pos = __shfl(mypos, e); const float a = __shfl(myaff, e);
            if (pos >= 0) {
                const bf16* yr = Y + ((size_t)(b * NE + e) * CAP + pos) * D;
#pragma unroll
                for (int j = 0; j < 4; ++j) { const v2u w = *(const v2u*)(yr + 4 * F.lane + 256 * j);
                    v[j].x += a * bflo(w.x); v[j].y += a * bfhi(w.x); v[j].z += a * bflo(w.y); v[j].w += a * bfhi(w.y); }
            }
        }
        float s = 0.f;
#pragma unroll
        for (int j = 0; j < 4; ++j) s += (v[j].x * v[j].x + v[j].y * v[j].y) + (v[j].z * v[j].z + v[j].w * v[j].w);
        const float rinv = 1.0f / sqrtf(wave_sum(s) * (1.0f / D) + EPS);
        if (l == NL - 1) {
#pragma unroll
            for (int j = 0; j < 4; ++j) { const f32x4 g = *(const f32x4*)(fg + 4 * F.lane + 256 * j); *(f32x4*)(xr + 4 * F.lane + 256 * j) = (f32x4){v[j].x * rinv * g.x, v[j].y * rinv * g.y, v[j].z * rinv * g.z, v[j].w * rinv * g.w}; }
        } else {
#pragma unroll
            for (int j = 0; j < 4; ++j) { *(f32x4*)(xr + 4 * F.lane + 256 * j) = v[j];
                v2u o; o.x = pk2(v[j].x * rinv, v[j].y * rinv); o.y = pk2(v[j].z * rinv, v[j].w * rinv); *(v2u*)(HB + (size_t)m * D + 4 * F.lane + 256 * j) = o; }
        }
    }
}

__global__ void __launch_bounds__(NTHR, 2) mega(Args args) {
    extern __shared__ __attribute__((aligned(16))) unsigned char lds[];
    Frame F;
    F.lds = (LAS unsigned char*)lds;
    F.tid = threadIdx.x; F.lane = F.tid & 63; F.wave = __builtin_amdgcn_readfirstlane(F.tid >> 6);
    F.G = gridDim.x; { const int bx = blockIdx.x; F.vcu = (F.G % 8 == 0) ? (bx % 8) * (F.G / 8) + bx / 8 : bx; }
#pragma unroll
    for (int i = 0; i < 22; ++i) F.in[i] = args.in[i];
    F.ws = args.ws; F.xres = args.out;
    volatile LAS unsigned* MISC = (volatile LAS unsigned*)(F.lds + MISC_OFF);
    for (int u = F.tid; u < (LDS_BYTES - LDSCTL_OFF) / 4; u += NTHR) ((LAS unsigned*)(F.lds + LDSCTL_OFF))[u] = 0u;
    __syncthreads();
    const int lo = args.ph_lo, hi = args.ph_hi;
    unsigned* barw = (unsigned*)(F.ws + WS_CTL) + CW_BAR + args.bar_region * XCD_BAR_WORDS;
    XcdBarrier bar; bar.bar = barw; bar.x = 0; bar.st = nullptr;
    if (hi - lo > 1) bar = xcd_barrier_post(barw, MISC + 8);
#define IN(k) (lo <= (k) && (k) < hi)
#define SEAM(k) do { if (IN(k) && IN((k) + 1)) xcd_barrier(bar); } while (0)
    if (IN(0)) { ph_rows0(F); } SEAM(0);
    for (int l = 0; l < NL; ++l) {
        const int pb = PH_LAYER0 + PH_PER_LAYER * l;
        if (IN(pb + 1)) { ph_gmlp(F, l); } SEAM(pb + 1);
        if (IN(pb + 5)) { ph_router(F, l); } SEAM(pb + 5);
        if (IN(pb + 6)) { ph_topk(F); } SEAM(pb + 6);
        if (IN(pb + 9)) { ph_combine(F, l); } SEAM(pb + 9);
    }
#undef IN
#undef SEAM
}

template <int NB, class AF>
__device__ __forceinline__ void ngemm_tile(const bf16* A, int lda, const int* aidx, int arow_base, int m0, const float* W0, const float* W1, int ldw, int n0, int K,
                                           float (&acc)[NB][4][4], float* sA, float* sB, const AF& af) {
    const int tid = threadIdx.x, tx = tid & 15, ty = tid >> 4;
    const int lr = tid >> 2, k4 = (tid & 3) * 4;
    const int arow = arow_base + (aidx ? aidx[m0 + lr] : (m0 + lr));
    const int bk = tid >> 4, bn = (tid & 15) * 4;
#pragma unroll
    for (int b = 0; b < NB; ++b)
#pragma unroll
        for (int i = 0; i < 4; ++i)
#pragma unroll
            for (int j = 0; j < 4; ++j) acc[b][i][j] = 0.f;
    for (int k0 = 0; k0 < K; k0 += 16) {
        const v2u raw = *(const v2u*)(A + (size_t)arow * lda + k0 + k4);
        sA[(k4 + 0) * 68 + lr] = af(lr, k0 + k4 + 0, bflo(raw.x)); sA[(k4 + 1) * 68 + lr] = af(lr, k0 + k4 + 1, bfhi(raw.x));
        sA[(k4 + 2) * 68 + lr] = af(lr, k0 + k4 + 2, bflo(raw.y)); sA[(k4 + 3) * 68 + lr] = af(lr, k0 + k4 + 3, bfhi(raw.y));
        *(f32x4*)(sB + bk * 64 + bn) = *(const f32x4*)(W0 + (size_t)(k0 + bk) * ldw + n0 + bn);
        if (NB == 2) *(f32x4*)(sB + 1024 + bk * 64 + bn) = *(const f32x4*)(W1 + (size_t)(k0 + bk) * ldw + n0 + bn);
        __syncthreads();
#pragma unroll
        for (int kk = 0; kk < 16; ++kk) {
            const f32x4 a = *(const f32x4*)(sA + kk * 68 + ty * 4);
#pragma unroll
            for (int b = 0; b < NB; ++b) { const f32x4 w = *(const f32x4*)(sB + b * 1024 + kk * 64 + tx * 4);
#pragma unroll
                for (int i = 0; i < 4; ++i) { acc[b][i][0] += a[i] * w.x; acc[b][i][1] += a[i] * w.y; acc[b][i][2] += a[i] * w.z; acc[b][i][3] += a[i] * w.w; } }
        }
        __syncthreads();
    }
}
__device__ __forceinline__ float sum16(float v) { v += __shfl_xor(v, 1); v += __shfl_xor(v, 2); v += __shfl_xor(v, 4); v += __shfl_xor(v, 8); return v; }
__device__ __forceinline__ float max16(float v) { v = fmaxf(v, __shfl_xor(v, 1)); v = fmaxf(v, __shfl_xor(v, 2)); v = fmaxf(v, __shfl_xor(v, 4)); v = fmaxf(v, __shfl_xor(v, 8)); return v; }
struct AfGain { const float* g; __device__ __forceinline__ float operator()(int, int k, float a) const { return a * g[k]; } };
struct AfNone { __device__ __forceinline__ float operator()(int, int, float a) const { return a; } };
struct AfRowGain { const float* rs; const float* g; __device__ __forceinline__ float operator()(int r, int k, float a) const { return a * rs[r] * g[k]; } };
struct AfMerged { const float* rgm; const float* rat; const float* g; __device__ __forceinline__ float operator()(int r, int k, float a) const { return a * g[k] * (k < 512 ? rgm[r] : rat[r]); } };

__global__ void __launch_bounds__(256) nk_inproj(Args args, int l) {
    __shared__ float sA[16 * 68]; __shared__ float sB[1024];
    const int nt = blockIdx.x, m0 = blockIdx.y * 64, tid = threadIdx.x, tx = tid & 15, ty = tid >> 4;
    unsigned char* ws = args.ws;
    float acc[1][4][4];
    AfGain af{args.in[2] + (size_t)l * D};
    ngemm_tile<1>((const bf16*)(ws + WS_HB), D, nullptr, 0, m0, args.in[3] + (size_t)l * D * INW, nullptr, INW, nt * 64, D, acc, sA, sB, af);
    const float* COS = (const float*)(ws + WS_ROPE); const float* SIN = COS + SEQ * 32;
#pragma unroll
    for (int i = 0; i < 4; ++i) {
        const int row = m0 + ty * 4 + i; float v[4];
#pragma unroll
        for (int j = 0; j < 4; ++j) v[j] = acc[0][i][j];
        if (nt < 16) {
#pragma unroll
            for (int j = 0; j < 4; ++j) v[j] = gelu_tanh(v[j]);
            v2u o; o.x = pk2(v[0], v[1]); o.y = pk2(v[2], v[3]);
            if (nt < 8) *(v2u*)((bf16*)(ws + WS_UACT) + (size_t)row * GMW + nt * 64 + tx * 4) = o;
            else {
                *(v2u*)((bf16*)(ws + WS_VACT) + (size_t)row * GMW + (nt - 8) * 64 + tx * 4) = o;
                const float a = bflo(o.x), b = bfhi(o.x), c = bflo(o.y), d = bfhi(o.y);
                const float s = sum16((a * a + b * b) + (c * c + d * d));
                if (tx == 0) ((float*)(ws + WS_VSTAT))[(size_t)row * 8 + (nt - 8)] = s;
            }
        } else if (nt < 26) {
            const bool isq = nt < 24; const float* g = (isq ? args.in[7] : args.in[8]) + (size_t)l * 64;
            const float s = sum16((v[0] * v[0] + v[1] * v[1]) + (v[2] * v[2] + v[3] * v[3]));
            const float rinv = 1.0f / sqrtf(s * (1.0f / 64.0f) + EPS);
#pragma unroll
            for (int j = 0; j < 4; ++j) v[j] = v[j] * rinv * g[tx * 4 + j];
            const int t = row % SEQ; float o4[4];
#pragma unroll
            for (int pp = 0; pp < 2; ++pp) { const int p = tx * 2 + pp; const float c = COS[t * 32 + p], sn = SIN[t * 32 + p];
                o4[2 * pp] = v[2 * pp] * c - v[2 * pp + 1] * sn; o4[2 * pp + 1] = v[2 * pp] * sn + v[2 * pp + 1] * c; }
            const float sc = isq ? QSCALE : 1.0f;
            v2u o; o.x = pk2(o4[0] * sc, o4[1] * sc); o.y = pk2(o4[2] * sc, o4[3] * sc);
            if (isq) *(v2u*)((bf16*)(ws + WS_Q) + (size_t)row * 512 + (nt - 16) * 64 + tx * 4) = o;
            else *(v2u*)((bf16*)(ws + WS_K) + (size_t)row * 128 + (nt - 24) * 64 + tx * 4) = o;
        } else {
            v2u o; o.x = pk2(v[0], v[1]); o.y = pk2(v[2], v[3]);
            *(v2u*)((bf16*)(ws + WS_V) + (size_t)row * 128 + (nt - 26) * 64 + tx * 4) = o;
        }
    }
}

__global__ void __launch_bounds__(256) nk_attn(Args args) {
    __shared__ float sQt[64 * 68]; __shared__ float sKt[64 * 68]; __shared__ float sV[64 * 68];
    const int qb = blockIdx.x, h = blockIdx.y, b = blockIdx.z, tid = threadIdx.x, tx = tid & 15, ty = tid >> 4;
    unsigned char* ws = args.ws;
    const bf16* Q = (const bf16*)(ws + WS_Q); const bf16* Kp = (const bf16*)(ws + WS_K); const bf16* Vp = (const bf16*)(ws + WS_V);
    const int kvh = h >> 2; const size_t rb = (size_t)b * SEQ;
    const int lr = tid >> 2, d16 = (tid & 3) * 16;
    {   const bf16* src = Q + (rb + qb * 64 + lr) * 512 + h * 64 + d16;
        const v4u r0 = *(const v4u*)src, r1 = *(const v4u*)(src + 8);
        const unsigned w[8] = {r0.x, r0.y, r0.z, r0.w, r1.x, r1.y, r1.z, r1.w};
#pragma unroll
        for (int q = 0; q < 8; ++q) { sQt[(d16 + 2 * q) * 68 + lr] = bflo(w[q]); sQt[(d16 + 2 * q + 1) * 68 + lr] = bfhi(w[q]); } }
    float o[4][4], mrow[4], lrow[4];
#pragma unroll
    for (int i = 0; i < 4; ++i) { mrow[i] = -1e30f; lrow[i] = 0.f;
#pragma unroll
        for (int j = 0; j < 4; ++j) o[i][j] = 0.f; }
    for (int kt = 0; kt < SEQ / 64; ++kt) {
        __syncthreads();
        {   const bf16* ks = Kp + (rb + kt * 64 + lr) * 128 + kvh * 64 + d16; const bf16* vs = Vp + (rb + kt * 64 + lr) * 128 + kvh * 64 + d16;
            const v4u r0 = *(const v4u*)ks, r1 = *(const v4u*)(ks + 8), s0 = *(const v4u*)vs, s1 = *(const v4u*)(vs + 8);
            const unsigned w[8] = {r0.x, r0.y, r0.z, r0.w, r1.x, r1.y, r1.z, r1.w}; const unsigned x[8] = {s0.x, s0.y, s0.z, s0.w, s1.x, s1.y, s1.z, s1.w};
#pragma unroll
            for (int q = 0; q < 8; ++q) { sKt[(d16 + 2 * q) * 68 + lr] = bflo(w[q]); sKt[(d16 + 2 * q + 1) * 68 + lr] = bfhi(w[q]);
                sV[lr * 68 + d16 + 2 * q] = bflo(x[q]); sV[lr * 68 + d16 + 2 * q + 1] = bfhi(x[q]); } }
        __syncthreads();
        float s[4][4];
#pragma unroll
        for (int i = 0; i < 4; ++i)
#pragma unroll
            for (int j = 0; j < 4; ++j) s[i][j] = 0.f;
#pragma unroll 8
        for (int d = 0; d < 64; ++d) { const f32x4 a = *(const f32x4*)(sQt + d * 68 + ty * 4), k = *(const f32x4*)(sKt + d * 68 + tx * 4);
#pragma unroll
            for (int i = 0; i < 4; ++i) { s[i][0] += a[i] * k.x; s[i][1] += a[i] * k.y; s[i][2] += a[i] * k.z; s[i][3] += a[i] * k.w; } }
        __syncthreads();
#pragma unroll
        for (int i = 0; i < 4; ++i) {
            const float mx = max16(fmaxf(fmaxf(s[i][0], s[i][1]), fmaxf(s[i][2], s[i][3])));
            const float mn = fmaxf(mrow[i], mx), f = __builtin_amdgcn_exp2f(mrow[i] - mn); mrow[i] = mn;
            float ps = 0.f;
#pragma unroll
            for (int j = 0; j < 4; ++j) { const float p = __builtin_amdgcn_exp2f(s[i][j] - mn); ps += p; sKt[(tx * 4 + j) * 68 + ty * 4 + i] = p; }
            lrow[i] = lrow[i] * f + sum16(ps);
#pragma unroll
            for (int j = 0; j < 4; ++j) o[i][j] *= f;
        }
        __syncthreads();
#pragma unroll 8
        for (int k = 0; k < 64; ++k) { const f32x4 p = *(const f32x4*)(sKt + k * 68 + ty * 4), v = *(const f32x4*)(sV + k * 68 + tx * 4);
#pragma unroll
            for (int i = 0; i < 4; ++i) { o[i][0] += p[i] * v.x; o[i][1] += p[i] * v.y; o[i][2] += p[i] * v.z; o[i][3] += p[i] * v.w; } }
    }
    bf16* MERGED = (bf16*)(ws + WS_MERGED); float* ATSTAT = (float*)(ws + WS_ATSTAT);
#pragma unroll
    for (int i = 0; i < 4; ++i) {
        const size_t row = rb + qb * 64 + ty * 4 + i; const float rl = 1.0f / lrow[i];
        v2u w; w.x = pk2(o[i][0] * rl, o[i][1] * rl); w.y = pk2(o[i][2] * rl, o[i][3] * rl);
        *(v2u*)(MERGED + row * 1024 + 512 + h * 64 + tx * 4) = w;
        const float a = bflo(w.x), b2 = bfhi(w.x), c = bflo(w.y), d = bfhi(w.y);
        const float ss = sum16((a * a + b2 * b2) + (c * c + d * d));
        if (tx == 0) ATSTAT[row * 8 + h] = ss;
    }
}

__global__ void __launch_bounds__(256) nk_outproj(Args args, int l) {
    __shared__ float sA[16 * 68]; __shared__ float sB[1024]; __shared__ float rgm[64]; __shared__ float rat[64]; __shared__ float gg[1024];
    const int nt = blockIdx.x, m0 = blockIdx.y * 64, tid = threadIdx.x, tx = tid & 15, ty = tid >> 4;
    unsigned char* ws = args.ws;
    if (tid < 64) { const float* gs = (const float*)(ws + WS_GMSTAT) + (size_t)(m0 + tid) * 4; const float* as = (const float*)(ws + WS_ATSTAT) + (size_t)(m0 + tid) * 8;
        float a = 0.f, b = 0.f; for (int q = 0; q < 4; ++q) a += gs[q]; for (int q = 0; q < 8; ++q) b += as[q];
        rgm[tid] = 1.0f / sqrtf(a * (1.0f / 512.0f) + EPS); rat[tid] = 1.0f / sqrtf(b * (1.0f / 512.0f) + EPS); }
    for (int i = tid; i < 1024; i += 256) gg[i] = args.in[9][(size_t)l * 1024 + i];
    __syncthreads();
    float acc[1][4][4];
    AfMerged af{rgm, rat, gg};
    ngemm_tile<1>((const bf16*)(ws + WS_MERGED), 1024, nullptr, 0, m0, args.in[10] + (size_t)l * D * D, nullptr, D, nt * 64, D, acc, sA, sB, af);
    const float* base = l == 0 ? args.in[0] : args.out;
#pragma unroll
    for (int i = 0; i < 4; ++i) {
        const size_t row = m0 + ty * 4 + i; const size_t off = row * D + nt * 64 + tx * 4;
        const f32x4 bs = *(const f32x4*)(base + off);
        const f32x4 xn = (f32x4){bs.x + acc[0][i][0], bs.y + acc[0][i][1], bs.z + acc[0][i][2], bs.w + acc[0][i][3]};
        *(f32x4*)(args.out + off) = xn;
        v2u o; o.x = pk2(xn.x, xn.y); o.y = pk2(xn.z, xn.w); *(v2u*)((bf16*)(ws + WS_XB) + off) = o;
        const float s = sum16((xn.x * xn.x + xn.y * xn.y) + (xn.z * xn.z + xn.w * xn.w));
        if (tx == 0) ((float*)(ws + WS_XSTAT))[row * 16 + nt] = s;
    }
}

__global__ void __launch_bounds__(256) nk_xq(Args args, int l) {
    __shared__ float sA[16 * 68]; __shared__ float sB[1024]; __shared__ float rs[64];
    const int nt = blockIdx.x, m0 = blockIdx.y * 64, tid = threadIdx.x, tx = tid & 15, ty = tid >> 4;
    unsigned char* ws = args.ws;
    if (tid < 64) { const float* xs = (const float*)(ws + WS_XSTAT) + (size_t)(m0 + tid) * 16; float a = 0.f; for (int q = 0; q < 16; ++q) a += xs[q]; rs[tid] = 1.0f / sqrtf(a * (1.0f / D) + EPS); }
    __syncthreads();
    float acc[1][4][4];
    AfRowGain af{rs, args.in[11] + (size_t)l * D};
    ngemm_tile<1>((const bf16*)(ws + WS_XB), D, nullptr, 0, m0, args.in[13] + (size_t)l * D * D, nullptr, D, nt * 64, D, acc, sA, sB, af);
#pragma unroll
    for (int i = 0; i < 4; ++i) { const size_t off = (size_t)(m0 + ty * 4 + i) * D + nt * 64 + tx * 4;
        v2u o; o.x = pk2(acc[0][i][0] * XQSCALE, acc[0][i][1] * XQSCALE); o.y = pk2(acc[0][i][2] * XQSCALE, acc[0][i][3] * XQSCALE); *(v2u*)((bf16*)(ws + WS_Q2) + off) = o; }
}
__global__ void __launch_bounds__(256) nk_xkv(Args args, int l) {
    __shared__ float sA[16 * 68]; __shared__ float sB[1024];
    const int nt = blockIdx.x, m0 = blockIdx.y * 64, tid = threadIdx.x, tx = tid & 15, ty = tid >> 4;
    unsigned char* ws = args.ws;
    float acc[1][4][4]; AfNone af;
    ngemm_tile<1>((const bf16*)(ws + WS_MEMN), D, nullptr, 0, m0, args.in[14] + (size_t)l * D * 2 * D, nullptr, 2 * D, nt * 64, D, acc, sA, sB, af);
#pragma unroll
    for (int i = 0; i < 4; ++i) { const size_t off = (size_t)(m0 + ty * 4 + i) * 2 * D + nt * 64 + tx * 4;
        v2u o; o.x = pk2(acc[0][i][0], acc[0][i][1]); o.y = pk2(acc[0][i][2], acc[0][i][3]); *(v2u*)((bf16*)(ws + WS_KVN) + off) = o; }
}
__global__ void __launch_bounds__(256) nk_xattn(Args args) {
    __shared__ float sq[8 * 256]; __shared__ float sp[8 * 256];
    const int r0 = blockIdx.x * 8, h = blockIdx.y, tid = threadIdx.x, lane = tid & 63, wv = tid >> 6;
    unsigned char* ws = args.ws; const int b = r0 / SEQ;
    const bf16* Q2 = (const bf16*)(ws + WS_Q2); const bf16* KVN = (const bf16*)(ws + WS_KVN);
    for (int i = tid; i < 8 * 256; i += 256) sq[i] = bf2f(Q2[(size_t)(r0 + (i >> 8)) * D + h * 256 + (i & 255)]);
    __syncthreads();
    {   const bf16* kr = KVN + (size_t)(b * MEML + tid) * 2 * D + h * 256;
        float sc[8];
#pragma unroll
        for (int r = 0; r < 8; ++r) sc[r] = 0.f;
        for (int d = 0; d < 256; d += 8) { const v4u w = *(const v4u*)(kr + d);
            const float kv[8] = {bflo(w.x), bfhi(w.x), bflo(w.y), bfhi(w.y), bflo(w.z), bfhi(w.z), bflo(w.w), bfhi(w.w)};
#pragma unroll
            for (int r = 0; r < 8; ++r) {
#pragma unroll
                for (int q = 0; q < 8; ++q) sc[r] += sq[r * 256 + d + q] * kv[q]; } }
#pragma unroll
        for (int r = 0; r < 8; ++r) sp[r * 256 + tid] = sc[r]; }
    __syncthreads();
#pragma unroll
    for (int rr = 0; rr < 2; ++rr) { const int r = wv * 2 + rr;
        float v[4]; float mx = -1e30f;
#pragma unroll
        for (int q = 0; q < 4; ++q) { v[q] = sp[r * 256 + lane + 64 * q]; mx = fmaxf(mx, v[q]); }
#pragma unroll
        for (int o = 1; o < 64; o <<= 1) mx = fmaxf(mx, __shfl_xor(mx, o));
        float sm = 0.f;
#pragma unroll
        for (int q = 0; q < 4; ++q) { v[q] = __builtin_amdgcn_exp2f(v[q] - mx); sm += v[q]; }
        sm = wave_sum(sm); const float rinv = 1.0f / sm;
#pragma unroll
        for (int q = 0; q < 4; ++q) sp[r * 256 + lane + 64 * q] = v[q] * rinv; }
    __syncthreads();
    {   float o[8];
#pragma unroll
        for (int r = 0; r < 8; ++r) o[r] = 0.f;
        const bf16* vr = KVN + (size_t)(b * MEML) * 2 * D + D + h * 256 + tid;
        for (int m = 0; m < MEML; ++m) { const float v = bf2f(vr[(size_t)m * 2 * D]);
#pragma unroll
            for (int r = 0; r < 8; ++r) o[r] += sp[r * 256 + m] * v; }
#pragma unroll
        for (int r = 0; r < 8; ++r) ((bf16*)(ws + WS_O2))[(size_t)(r0 + r) * D + h * 256 + tid] = (bf16)f2bf(o[r]); }
}
__global__ void __launch_bounds__(256) nk_xo(Args args, int l) {
    __shared__ float sA[16 * 68]; __shared__ float sB[1024];
    const int nt = blockIdx.x, m0 = blockIdx.y * 64, tid = threadIdx.x, tx = tid & 15, ty = tid >> 4;
    unsigned char* ws = args.ws;
    float acc[1][4][4]; AfNone af;
    ngemm_tile<1>((const bf16*)(ws + WS_O2), D, nullptr, 0, m0, args.in[15] + (size_t)l * D * D, nullptr, D, nt * 64, D, acc, sA, sB, af);
#pragma unroll
    for (int i = 0; i < 4; ++i) { const size_t off = (size_t)(m0 + ty * 4 + i) * D + nt * 64 + tx * 4;
        const f32x4 bs = *(const f32x4*)(args.out + off);
        *(f32x4*)(args.out + off) = (f32x4){bs.x + acc[0][i][0], bs.y + acc[0][i][1], bs.z + acc[0][i][2], bs.w + acc[0][i][3]}; }
}
__global__ void __launch_bounds__(256) nk_moe1(Args args, int l) {
    __shared__ float sA[16 * 68]; __shared__ float sB[2048];
    const int nt = blockIdx.x, m0 = blockIdx.y * 64, z = blockIdx.z, b = z >> 4, e = z & 15, tid = threadIdx.x, tx = tid & 15, ty = tid >> 4;
    unsigned char* ws = args.ws;
    float acc[2][4][4];
    AfGain af{args.in[16] + (size_t)l * D};
    const size_t wo = ((size_t)l * NE + e) * D * FF;
    ngemm_tile<2>((const bf16*)(ws + WS_HB), D, (const int*)(ws + WS_IDX) + (size_t)z * CAP, b * SEQ, m0, args.in[18] + wo, args.in[19] + wo, FF, nt * 64, D, acc, sA, sB, af);
#pragma unroll
    for (int i = 0; i < 4; ++i) { const size_t off = ((size_t)z * CAP + m0 + ty * 4 + i) * FF + nt * 64 + tx * 4;
        float hv[4];
#pragma unroll
        for (int j = 0; j < 4; ++j) hv[j] = silu_f(acc[0][i][j]) * acc[1][i][j];
        v2u o; o.x = pk2(hv[0], hv[1]); o.y = pk2(hv[2], hv[3]); *(v2u*)((bf16*)(ws + WS_H) + off) = o; }
}
__global__ void __launch_bounds__(256) nk_moe2(Args args, int l) {
    __shared__ float sA[16 * 68]; __shared__ float sB[1024];
    const int nt = blockIdx.x, m0 = blockIdx.y * 64, z = blockIdx.z, e = z & 15, tid = threadIdx.x, tx = tid & 15, ty = tid >> 4;
    unsigned char* ws = args.ws;
    float acc[1][4][4]; AfNone af;
    ngemm_tile<1>((const bf16*)(ws + WS_H) + (size_t)z * CAP * FF, FF, nullptr, 0, m0, args.in[20] + ((size_t)l * NE + e) * FF * D, nullptr, D, nt * 64, FF, acc, sA, sB, af);
#pragma unroll
    for (int i = 0; i < 4; ++i) { const size_t off = ((size_t)z * CAP + m0 + ty * 4 + i) * D + nt * 64 + tx * 4;
        v2u o; o.x = pk2(acc[0][i][0], acc[0][i][1]); o.y = pk2(acc[0][i][2], acc[0][i][3]); *(v2u*)((bf16*)(ws + WS_Y) + off) = o; }
}

static int g_grid = 0;
static void launch_mega(Args a, int lo, int hi, int region, hipStream_t stream) {
    a.ph_lo = lo; a.ph_hi = hi; a.bar_region = region; a.pad = 0;
    hipLaunchKernelGGL(mega, dim3(g_grid), dim3(NTHR), LDS_BYTES, stream, a);
}
extern "C" void kernel_launch(void* const* d_in, const int* in_sizes, int n_in, void* d_out, int out_size, void* d_ws, size_t ws_size, hipStream_t stream) {
    if (g_grid == 0) {
        if (n_in != 22 || out_size != T * D || ws_size < WS_END) { fprintf(stderr, "kernel_launch: unexpected sizes n_in %d out %d ws %zu\n", n_in, out_size, ws_size); g_grid = -1; return; }
        int dev = 0, cus = 0;
        if (hipGetDevice(&dev) != hipSuccess || hipDeviceGetAttribute(&cus, hipDeviceAttributeMultiprocessorCount, dev) != hipSuccess) { g_grid = -1; return; }
        if (hipFuncSetAttribute((const void*)mega, hipFuncAttributeMaxDynamicSharedMemorySize, LDS_BYTES) != hipSuccess) { g_grid = -1; return; }
        int per_cu = 0;
        if (hipOccupancyMaxActiveBlocksPerMultiprocessor(&per_cu, (const void*)mega, NTHR, LDS_BYTES) != hipSuccess || per_cu < 1) fprintf(stderr, "kernel_launch: occupancy query says %d\n", per_cu);
        (void)hipGetLastError();
        g_grid = cus;
    }
    if (g_grid < 0) return;
    hipMemsetAsync((char*)d_ws + WS_CTL, 0, CTL_ZERO_BYTES, stream);
    Args a{};
    for (int i = 0; i < 22; ++i) a.in[i] = (const float*)d_in[i];
    a.out = (float*)d_out; a.ws = (unsigned char*)d_ws;
    launch_mega(a, 0, 1, 0, stream);
    for (int l = 0; l < NL; ++l) {
        const int pb = PH_LAYER0 + PH_PER_LAYER * l;
        hipLaunchKernelGGL(nk_inproj, dim3(28, T / 64), dim3(256), 0, stream, a, l);
        hipLaunchKernelGGL(nk_attn, dim3(SEQ / 64, 8, NB_), dim3(256), 0, stream, a);
        launch_mega(a, pb + 1, pb + 2, 0, stream);
        hipLaunchKernelGGL(nk_outproj, dim3(16, T / 64), dim3(256), 0, stream, a, l);
        hipLaunchKernelGGL(nk_xq, dim3(16, T / 64), dim3(256), 0, stream, a, l);
        hipLaunchKernelGGL(nk_xkv, dim3(32, 16), dim3(256), 0, stream, a, l);
        hipLaunchKernelGGL(nk_xattn, dim3(T / 8, 4), dim3(256), 0, stream, a);
        hipLaunchKernelGGL(nk_xo, dim3(16, T / 64), dim3(256), 0, stream, a, l);
        launch_mega(a, pb + 5, pb + 7, 1 + l, stream);
        hipLaunchKernelGGL(nk_moe1, dim3(16, 16, 64), dim3(256), 0, stream, a, l);
        hipLaunchKernelGGL(nk_moe2, dim3(16, 16, 64), dim3(256), 0, stream, a, l);
        launch_mega(a, pb + 9, pb + 10, 0, stream);
    }
}
```

```cpp
#include <hip/hip_runtime.h>
#include <hip/hip_bf16.h>
#include <cstdio>
#include <cstdint>
#include <cmath>

constexpr int NB_ = 4, SEQ = 8192, T = NB_ * SEQ, D = 1024, NL = 4;
constexpr int MEML = 256, NMEM = NB_ * MEML;
constexpr int INW = 1792, GMW = 512, NE = 16, CAP = 1024, FF = 1024;
constexpr float EPS = 1e-6f;
constexpr float LOG2E = 1.4426950408889634f;
constexpr float QSCALE = 0.125f * LOG2E;
constexpr float XQSCALE = 0.0625f * LOG2E;

constexpr size_t MiB = 1u << 20;
constexpr size_t WS_CTL = 0, CTL_ZERO_BYTES = 1 * MiB;
constexpr size_t WS_ROPE = 1 * MiB;
constexpr size_t WS_AFF = 3 * MiB;
constexpr size_t WS_INV = 5 * MiB;
constexpr size_t WS_IDX = 7 * MiB;
constexpr size_t WS_VSTAT = 8 * MiB;
constexpr size_t WS_ATSTAT = 9 * MiB;
constexpr size_t WS_GMSTAT = 10 * MiB;
constexpr size_t WS_XSTAT = 11 * MiB;
constexpr size_t WS_MEMN = 13 * MiB;
constexpr size_t WS_WIN = 16 * MiB;
constexpr size_t WS_WOUT = 30 * MiB;
constexpr size_t WS_QKT = 38 * MiB;
constexpr size_t WS_VOT = 70 * MiB;
constexpr size_t WS_WGU = 102 * MiB;
constexpr size_t WS_WD = 358 * MiB;
constexpr size_t WS_HB = 486 * MiB;
constexpr size_t WS_R1 = 550 * MiB;
constexpr size_t WS_UACT = WS_R1, WS_VACT = WS_R1 + 32 * MiB, WS_Q = WS_R1 + 64 * MiB, WS_K = WS_R1 + 96 * MiB, WS_V = WS_R1 + 104 * MiB;
constexpr size_t WS_WQB = WS_R1, WS_WOT = WS_R1 + 8 * MiB, WS_WKVT = WS_R1 + 16 * MiB, WS_KVM = WS_R1 + 32 * MiB;
constexpr size_t WS_H = WS_R1;
constexpr size_t WS_MERGED = 678 * MiB;
constexpr size_t WS_XB = 742 * MiB;
constexpr size_t WS_P = WS_MERGED;
constexpr size_t WS_Y = 678 * MiB;
constexpr size_t WS_NSCR = 806 * MiB;
constexpr size_t WS_Q2 = WS_MERGED;
constexpr size_t WS_O2 = WS_NSCR;
constexpr size_t WS_KVN = WS_NSCR + 64 * MiB;
constexpr size_t WS_END = 1024 * MiB;

constexpr int CW_TMO = 0, CW_CODE = 1, CW_BAR = 4096;

#define GAS __attribute__((address_space(1)))
#define LAS __attribute__((address_space(3)))
typedef unsigned short bf16;
typedef unsigned v4u __attribute__((ext_vector_type(4)));
typedef unsigned v2u __attribute__((ext_vector_type(2)));
typedef float f32x4 __attribute__((ext_vector_type(4)));
typedef GAS unsigned gu32;
#define RLX_AGENT __ATOMIC_RELAXED, __HIP_MEMORY_SCOPE_AGENT
__device__ __forceinline__ unsigned f2bf(float f) { unsigned u = __builtin_bit_cast(unsigned, f); return (u + 0x7fffu + ((u >> 16) & 1u)) >> 16; }
__device__ __forceinline__ unsigned pk2(float lo, float hi) { return f2bf(lo) | (f2bf(hi) << 16); }
__device__ __forceinline__ float bf2f(unsigned v) { return __builtin_bit_cast(float, v << 16); }
__device__ __forceinline__ float bflo(unsigned w) { return __builtin_bit_cast(float, w << 16); }
__device__ __forceinline__ float bfhi(unsigned w) { return __builtin_bit_cast(float, w & 0xffff0000u); }
__device__ __forceinline__ float rbf(float f) { return bf2f(f2bf(f)); }
__device__ __forceinline__ float gelu_tanh(float x) {
    const float z = 1.5957691216057308f * (x + 0.044715f * x * x * x);
    return x / (1.0f + __builtin_amdgcn_exp2f(-z * LOG2E));
}
__device__ __forceinline__ float silu_f(float a) { return a / (1.0f + __builtin_amdgcn_exp2f(-a * LOG2E)); }
__device__ __forceinline__ int lane_id() { return (int)__builtin_amdgcn_mbcnt_hi(~0u, __builtin_amdgcn_mbcnt_lo(~0u, 0u)); }
__device__ __forceinline__ float wave_sum(float v) {
#pragma unroll
    for (int o = 1; o < 64; o <<= 1) v += __shfl_xor(v, o);
    return v;
}

#define XB_TMO      128
#define XB_XCNT(j)  (256  + 64 * (j))
#define XB_XSUB(j)  (1280 + 64 * (j))
#define XB_XGEN(j)  (2304 + 64 * (j))
#define XB_TOP      3328
#define XB_TOPGEN   3392
#define XCD_BAR_WORDS 3456
#define XB_SPIN_CAP (1u << 18)
__device__ __forceinline__ unsigned xb_ld(unsigned* p)              { return __hip_atomic_load(p, __ATOMIC_RELAXED, __HIP_MEMORY_SCOPE_AGENT); }
__device__ __forceinline__ unsigned xb_add(unsigned* p, unsigned v) { return __hip_atomic_fetch_add(p, v, __ATOMIC_RELAXED, __HIP_MEMORY_SCOPE_AGENT); }
__device__ __forceinline__ unsigned xb_xcc_id() { return (unsigned)__builtin_amdgcn_s_getreg((3 << 11) | 20) & 0xFu; }
#define XB_SPIN(cond, bar) do { unsigned _sp = 0; while (cond) { __builtin_amdgcn_s_sleep(1); \
    if ((++_sp & 255u) == 0u) { if (xb_ld(&(bar)[XB_TMO])) break; if (_sp > XB_SPIN_CAP) { atomicAdd(&(bar)[XB_TMO], 1u); break; } } } } while (0)
struct XcdBarrier { unsigned* bar; unsigned x; volatile LAS unsigned* st; };
__device__ __forceinline__ XcdBarrier xcd_barrier_post(unsigned* bar, volatile LAS unsigned* st) {
    XcdBarrier b; b.bar = bar; b.x = xb_xcc_id(); b.st = st;
    if (threadIdx.x == 0) (void)xb_add(&bar[XB_XCNT(b.x)], 1u);
    return b;
}
__device__ __forceinline__ void xcd_barrier_complete(unsigned* bar, unsigned x, unsigned& nloc, unsigned& nx) {
    const unsigned G = gridDim.x * gridDim.y * gridDim.z;
    unsigned sum, cnt, mine, sp = 0u;
    for (;;) {
        sum = 0u; cnt = 0u; mine = 0u;
#pragma unroll
        for (unsigned j = 0; j < 16; ++j) { const unsigned c = xb_ld(&bar[XB_XCNT(j)]); sum += c; cnt += (c > 0u) ? 1u : 0u; mine = (j == x) ? c : mine; }
        if (sum == G) break;
        __builtin_amdgcn_s_sleep(1);
        if ((++sp & 255u) == 0u) { if (xb_ld(&bar[XB_TMO])) break; if (sp > XB_SPIN_CAP) { atomicAdd(&bar[XB_TMO], 1u); break; } }
    }
    nloc = mine > 0u ? mine : 1u; nx = cnt > 0u ? cnt : 1u;
}
__device__ __forceinline__ void xcd_barrier(const XcdBarrier& b) {
    asm volatile("s_waitcnt vmcnt(0)" ::: "memory");
    __syncthreads();
    if (threadIdx.x == 0) {
        unsigned* bar = b.bar;
        __builtin_amdgcn_s_waitcnt(0);
        unsigned nloc = b.st[0], nx = b.st[1];
        if (nloc == 0u) { xcd_barrier_complete(bar, b.x, nloc, nx); b.st[0] = nloc; b.st[1] = nx; }
        const unsigned old = xb_add(&bar[XB_XSUB(b.x)], 1u);
        const unsigned gen = old / nloc;
        if (old + 1u == (gen + 1u) * nloc) {
            __builtin_amdgcn_fence(__ATOMIC_RELEASE, "agent");
            asm volatile("s_waitcnt vmcnt(0)" ::: "memory");
            const unsigned og = xb_add(&bar[XB_TOP], 1u);
            const unsigned tg = og / nx;
            if (og + 1u == (tg + 1u) * nx) xb_add(&bar[XB_TOPGEN], 1u);
            else XB_SPIN(xb_ld(&bar[XB_TOPGEN]) == tg, bar);
            __builtin_amdgcn_fence(__ATOMIC_ACQUIRE, "agent");
            xb_add(&bar[XB_XGEN(b.x)], 1u);
            asm volatile("s_waitcnt vmcnt(0)" ::: "memory");
        } else {
            XB_SPIN(xb_ld(&bar[XB_XGEN(b.x)]) == gen, bar);
            __builtin_amdgcn_fence(__ATOMIC_ACQUIRE, "agent");
            asm volatile("s_waitcnt vmcnt(0)" ::: "memory");
        }
    }
    __syncthreads();
}

struct Args { const float* in[22]; float* out; unsigned char* ws; int ph_lo, ph_hi, bar_region, pad; };
constexpr int PH_LAYER0 = 4, PH_PER_LAYER = 10, PH_END = PH_LAYER0 + NL * PH_PER_LAYER;

constexpr int NWAVES = 8, NTHR = NWAVES * 64;
constexpr int RING_BYTES = 131072, LDSCTL_OFF = RING_BYTES, MISC_OFF = LDSCTL_OFF + 320;
constexpr int LDS_BYTES = 147456;

struct Frame {
    LAS unsigned char* lds;
    int wave, vcu, G;
    const float* in[22];
    unsigned char* ws;
    float* xres;
};

__device__ __forceinline__ void ph_rows0(Frame& F) {
    int lane_ = lane_id(); asm volatile("" : "+v"(lane_)); const int tid_ = F.wave * 64 + lane_;
    const int gw = F.vcu * NWAVES + F.wave, NGW = F.G * NWAVES;
    const float* x = F.in[0]; const float* mem = F.in[1]; const float* mg = F.in[12];
    bf16* HB = (bf16*)(F.ws + WS_HB); bf16* MEMN = (bf16*)(F.ws + WS_MEMN);
    for (int m = gw; m < T + NMEM; m += NGW) {
        const bool is_mem = m >= T;
        const float* src = is_mem ? mem + (size_t)(m - T) * D : x + (size_t)m * D;
        bf16* dst = is_mem ? MEMN + (size_t)(m - T) * D : HB + (size_t)m * D;
        f32x4 v[4]; float s = 0.f;
#pragma unroll
        for (int j = 0; j < 4; ++j) { v[j] = *(const f32x4*)(src + 4 * lane_ + 256 * j); s += (v[j].x * v[j].x + v[j].y * v[j].y) + (v[j].z * v[j].z + v[j].w * v[j].w); }
        const float rinv = 1.0f / sqrtf(wave_sum(s) * (1.0f / D) + EPS);
#pragma unroll
        for (int j = 0; j < 4; ++j) {
            f32x4 g = (f32x4){1.f, 1.f, 1.f, 1.f};
            if (is_mem) g = *(const f32x4*)(mg + 4 * lane_ + 256 * j);
            v2u o; o.x = pk2(v[j].x * rinv * g.x, v[j].y * rinv * g.y); o.y = pk2(v[j].z * rinv * g.z, v[j].w * rinv * g.w);
            *(v2u*)(dst + 4 * lane_ + 256 * j) = o;
        }
    }
    float* COS = (float*)(F.ws + WS_ROPE); float* SIN = COS + SEQ * 32;
    const int gt = F.vcu * NTHR + tid_, NGT = F.G * NTHR;
    for (int i = gt; i < SEQ * 32; i += NGT) {
        const int t = i >> 5, p = i & 31;
        const float fr = expf(-9.210340371976184f * (float)(p & 15) * (1.0f / 16.0f));
        const float pos = (float)((p < 16) ? (t >> 6) : (t & 63));
        float rev = pos * fr * 0.15915494309189535f; rev -= floorf(rev);
        COS[i] = __builtin_amdgcn_cosf(rev); SIN[i] = __builtin_amdgcn_sinf(rev);
    }
}

__device__ __forceinline__ void ph_gmlp(Frame& F, int l) {
    int lane_ = lane_id(); asm volatile("" : "+v"(lane_)); const int tid_ = F.wave * 64 + lane_;
    const bf16* UACT = (const bf16*)(F.ws + WS_UACT); const bf16* VACT = (const bf16*)(F.ws + WS_VACT);
    const float* VSTAT = (const float*)(F.ws + WS_VSTAT); float* GMSTAT = (float*)(F.ws + WS_GMSTAT);
    bf16* MERGED = (bf16*)(F.ws + WS_MERGED);
    const float* gvn = F.in[4] + (size_t)l * GMW; const float* ws_ = F.in[5] + (size_t)l * 4 * 128 * 128; const float* bs = F.in[6] + (size_t)l * 4 * 128;
    LAS float* sV = (LAS float*)F.lds;
    LAS float* sW = (LAS float*)(F.lds + 65536);
    for (int u = F.vcu; u < (T / 128) * 4; u += F.G) {
        const int n = u >> 2, g = u & 3; const int row0 = n * 128;
        __syncthreads();
        for (int it = tid_; it < 128 * 16; it += NTHR) {
            const int j = it >> 4, c8 = (it & 15) * 8; const int row = row0 + j;
            const float* vs = VSTAT + (size_t)row * 8; float ss = 0.f;
#pragma unroll
            for (int q = 0; q < 8; ++q) ss += vs[q];
            const float rinv = 1.0f / sqrtf(ss * (1.0f / GMW) + EPS);
            const v4u raw = *(const v4u*)(VACT + (size_t)row * GMW + g * 128 + c8);
            const float* gp = gvn + g * 128 + c8;
            LAS float* d = sV + j * 128 + c8;
            d[0] = bflo(raw.x) * rinv * gp[0]; d[1] = bfhi(raw.x) * rinv * gp[1]; d[2] = bflo(raw.y) * rinv * gp[2]; d[3] = bfhi(raw.y) * rinv * gp[3];
            d[4] = bflo(raw.z) * rinv * gp[4]; d[5] = bfhi(raw.z) * rinv * gp[5]; d[6] = bflo(raw.w) * rinv * gp[6]; d[7] = bfhi(raw.w) * rinv * gp[7];
        }
        for (int it = tid_; it < 128 * 32; it += NTHR) {
            const int i = it >> 5, j4 = (it & 31) * 4;
            const f32x4 w = *(const f32x4*)(ws_ + ((size_t)g * 128 + i) * 128 + j4);
            *(LAS f32x4*)(sW + i * 128 + j4) = w;
        }
        __syncthreads();
        const int c = tid_ & 127, ib = (tid_ >> 7) * 32;
        float acc[32];
#pragma unroll
        for (int ii = 0; ii < 32; ++ii) acc[ii] = 0.f;
        for (int j4 = 0; j4 < 128; j4 += 4) {
            const float v0 = sV[(j4 + 0) * 128 + c], v1 = sV[(j4 + 1) * 128 + c], v2 = sV[(j4 + 2) * 128 + c], v3 = sV[(j4 + 3) * 128 + c];
#pragma unroll
            for (int ii = 0; ii < 32; ++ii) { const f32x4 w = *(const LAS f32x4*)(sW + (ib + ii) * 128 + j4); acc[ii] += (w.x * v0 + w.y * v1) + (w.z * v2 + w.w * v3); }
        }
        __syncthreads();
#pragma unroll
        for (int ii = 0; ii < 32; ++ii) {
            const int i = ib + ii, row = row0 + i;
            const float uu = bf2f(UACT[(size_t)row * GMW + g * 128 + c]);
            const float o = uu * (acc[ii] + bs[g * 128 + i]);
            const unsigned ob = f2bf(o); const float orr = bf2f(ob);
            MERGED[(size_t)row * 1024 + g * 128 + c] = (bf16)ob;
            sV[i * 129 + c] = orr * orr;
        }
        __syncthreads();
        if (tid_ < 128) { float s = 0.f; for (int cc = 0; cc < 128; ++cc) s += sV[tid_ * 129 + cc]; GMSTAT[(size_t)(row0 + tid_) * 4 + g] = s; }
    }
    __syncthreads();
}

__device__ __forceinline__ void ph_router(Frame& F, int l) {
    int lane_ = lane_id(); asm volatile("" : "+v"(lane_)); const int tid_ = F.wave * 64 + lane_;
    const float* g = F.in[16] + (size_t)l * D; const float* wr = F.in[17] + (size_t)l * D * NE;
    bf16* HB = (bf16*)(F.ws + WS_HB); float* AFF = (float*)(F.ws + WS_AFF);
    LAS float* sW = (LAS float*)F.lds;
    __syncthreads();
    for (int i = tid_; i < D * NE; i += NTHR) { const int c = i >> 4, e = i & 15; sW[e * D + c] = wr[i] * g[c]; }
    __syncthreads();
    const int gw = F.vcu * NWAVES + F.wave, NGW = F.G * NWAVES;
    for (int m = gw; m < T; m += NGW) {
        const float* xr = F.xres + (size_t)m * D;
        f32x4 v[4]; float s = 0.f;
#pragma unroll
        for (int j = 0; j < 4; ++j) { v[j] = *(const f32x4*)(xr + 4 * lane_ + 256 * j); s += (v[j].x * v[j].x + v[j].y * v[j].y) + (v[j].z * v[j].z + v[j].w * v[j].w); }
        const float rinv = 1.0f / sqrtf(wave_sum(s) * (1.0f / D) + EPS);
#pragma unroll
        for (int j = 0; j < 4; ++j) { v2u o; o.x = pk2(v[j].x * rinv, v[j].y * rinv); o.y = pk2(v[j].z * rinv, v[j].w * rinv); *(v2u*)(HB + (size_t)m * D + 4 * lane_ + 256 * j) = o; }
        float mylg = 0.f;
#pragma unroll 1
        for (int e = 0; e < NE; ++e) { float a = 0.f;
#pragma unroll
            for (int j = 0; j < 4; ++j) { const f32x4 w = *(const LAS f32x4*)(sW + e * D + 4 * lane_ + 256 * j); a += (v[j].x * w.x + v[j].y * w.y) + (v[j].z * w.z + v[j].w * w.w); }
            a = wave_sum(a) * rinv; mylg = (lane_ == e) ? a : mylg; }
        float mx = mylg;
        mx = fmaxf(mx, __shfl_xor(mx, 1)); mx = fmaxf(mx, __shfl_xor(mx, 2)); mx = fmaxf(mx, __shfl_xor(mx, 4)); mx = fmaxf(mx, __shfl_xor(mx, 8));
        const float pe = __builtin_amdgcn_exp2f((mylg - mx) * LOG2E);
        float den = pe; den += __shfl_xor(den, 1); den += __shfl_xor(den, 2); den += __shfl_xor(den, 4); den += __shfl_xor(den, 8);
        const float mine = pe / den;
        if (lane_ < NE) AFF[(size_t)m * NE + lane_] = mine;
    }
    __syncthreads();
}

__device__ __forceinline__ void ph_topk(Frame& F) {
    int lane_ = lane_id(); asm volatile("" : "+v"(lane_)); const int tid_ = F.wave * 64 + lane_;
    const float* AFF = (const float*)(F.ws + WS_AFF); int* IDX = (int*)(F.ws + WS_IDX); int* INV = (int*)(F.ws + WS_INV);
    LAS unsigned* hist = (LAS unsigned*)F.lds;
    LAS unsigned* sh = hist + 256;
    LAS unsigned* wsum = hist + 512;
    for (int p = F.vcu; p < NB_ * NE; p += F.G) {
        const int b = p >> 4, e = p & 15;
        unsigned key[16];
#pragma unroll
        for (int i = 0; i < 16; ++i) key[i] = __builtin_bit_cast(unsigned, AFF[((size_t)b * SEQ + tid_ * 16 + i) * NE + e]);
        unsigned prefix = 0u, krem = CAP;
#pragma unroll
        for (int pass = 0; pass < 4; ++pass) {
            const int shift = 24 - 8 * pass; const unsigned himask = pass == 0 ? 0u : (0xffffffffu << (shift + 8));
            __syncthreads();
            if (tid_ < 256) hist[tid_] = 0u;
            __syncthreads();
#pragma unroll
            for (int i = 0; i < 16; ++i) if ((key[i] & himask) == prefix) atomicAdd((unsigned*)&hist[(key[i] >> shift) & 255u], 1u);
            __syncthreads();
            if (tid_ == 0) { unsigned above = 0u; int d = 255; for (; d > 0; --d) { const unsigned c = hist[d]; if (above + c >= krem) break; above += c; } sh[0] = prefix | ((unsigned)d << shift); sh[1] = krem - above; }
            __syncthreads();
            prefix = sh[0]; krem = sh[1];
        }
        const unsigned thr = prefix;
        unsigned cg = 0u, ce = 0u;
#pragma unroll
        for (int i = 0; i < 16; ++i) { cg += key[i] > thr ? 1u : 0u; ce += key[i] == thr ? 1u : 0u; }
        unsigned sg = cg, se = ce;
#pragma unroll
        for (int o = 1; o < 64; o <<= 1) { const unsigned a = __shfl_up(sg, o), c2 = __shfl_up(se, o); if (lane_ >= o) { sg += a; se += c2; } }
        __syncthreads();
        if (lane_ == 63) { wsum[F.wave] = sg; wsum[8 + F.wave] = se; }
        __syncthreads();
        unsigned og = 0u, oe = 0u;
        for (int w = 0; w < F.wave; ++w) { og += wsum[w]; oe += wsum[8 + w]; }
        unsigned gb = og + sg - cg, eb = oe + se - ce;
#pragma unroll
        for (int i = 0; i < 16; ++i) {
            const int t = tid_ * 16 + i; int pos = -1;
            if (key[i] > thr) { pos = (int)(gb + (eb < krem ? eb : krem)); ++gb; }
            else if (key[i] == thr) { if (eb < krem) pos = (int)(gb + eb); ++eb; }
            INV[((size_t)b * SEQ + t) * NE + e] = pos;
            if (pos >= 0) IDX[(size_t)p * CAP + pos] = t;
        }
    }
    __syncthreads();
}

__device__ __forceinline__ void ph_combine(Frame& F, int l) {
    int lane_ = lane_id(); asm volatile("" : "+v"(lane_)); const int tid_ = F.wave * 64 + lane_;
    const float* AFF = (const float*)(F.ws + WS_AFF); const int* INV = (const int*)(F.ws + WS_INV);
    const bf16* Y = (const bf16*)(F.ws + WS_Y); bf16* HB = (bf16*)(F.ws + WS_HB); const float* fg = F.in[21];
    const int gw = F.vcu * NWAVES + F.wave, NGW = F.G * NWAVES;
    for (int m = gw; m < T; m += NGW) {
        float* xr = F.xres + (size_t)m * D; const int b = m / SEQ;
        f32x4 v[4];
#pragma unroll
        for (int j = 0; j < 4; ++j) v[j] = *(const f32x4*)(xr + 4 * lane_ + 256 * j);
        const int mypos = lane_ < NE ? INV[(size_t)m * NE + lane_] : -1;
        const float myaff = lane_ < NE ? AFF[(size_t)m * NE + lane_] : 0.f;
#pragma unroll
        for (int e = 0; e < NE; ++e) {
            const int pos = __shfl(mypos, e); const float a = __shfl(myaff, e);
            if (pos >= 0) {
                const bf16* yr = Y + ((size_t)(b * NE + e) * CAP + pos) * D;
#pragma unroll
                for (int j = 0; j < 4; ++j) { const v2u w = *(const v2u*)(yr + 4 * lane_ + 256 * j);
                    v[j].x += a * bflo(w.x); v[j].y += a * bfhi(w.x); v[j].z += a * bflo(w.y); v[j].w += a * bfhi(w.y); }
            }
        }
        float s = 0.f;
#pragma unroll
        for (int j = 0; j < 4; ++j) s += (v[j].x * v[j].x + v[j].y * v[j].y) + (v[j].z * v[j].z + v[j].w * v[j].w);
        const float rinv = 1.0f / sqrtf(wave_sum(s) * (1.0f / D) + EPS);
        if (l == NL - 1) {
#pragma unroll
            for (int j = 0; j < 4; ++j) { const f32x4 g = *(const f32x4*)(fg + 4 * lane_ + 256 * j); *(f32x4*)(xr + 4 * lane_ + 256 * j) = (f32x4){v[j].x * rinv * g.x, v[j].y * rinv * g.y, v[j].z * rinv * g.z, v[j].w * rinv * g.w}; }
        } else {
#pragma unroll
            for (int j = 0; j < 4; ++j) { *(f32x4*)(xr + 4 * lane_ + 256 * j) = v[j];
                v2u o; o.x = pk2(v[j].x * rinv, v[j].y * rinv); o.y = pk2(v[j].z * rinv, v[j].w * rinv); *(v2u*)(HB + (size_t)m * D + 4 * lane_ + 256 * j) = o; }
        }
    }
}


namespace pg8 {
typedef short bf16x8 __attribute__((ext_vector_type(8)));
typedef float f32x2 __attribute__((ext_vector_type(2)));
constexpr int BM = 256, BK = 64, HALF = 128, HTB = HALF * BK * 2, STAGE_BYTES = 8 * HTB, NXCD = 8, WGM = 8;
__host__ __device__ __forceinline__ int lds_byte(int r, int c) { const int st = (r >> 4) * 2 + (c >> 5), rr = r & 15, cc = c & 31, ob = rr * 64 + cc * 2; return st * 1024 + (ob ^ (((ob >> 9) & 1) << 5)); }
__host__ __device__ __forceinline__ void stage_rc(int b, int& R, int& C) { const int st = b / 1024, sb = b % 1024, swz = sb ^ (((sb >> 9) & 1) << 5); R = (st >> 1) * 16 + swz / 64; C = (st & 1) * 32 + (swz % 64) / 2; }
__host__ __device__ __forceinline__ int perm32(int rho) { const int n = rho >> 4, i = rho & 15; return 8 * (i >> 2) + 4 * n + (i & 3); }

struct Unit { int pm, pn, z; const char* a; const char* b; const int* gi; int grow; };

struct TileOrder {
    int nM, nN, nwg, G, c;
    __device__ __forceinline__ void init(int nM_, int nN_, int G_, int c_) { nM = nM_; nN = nN_; nwg = nM * nN; G = G_; c = c_; }
    __device__ __forceinline__ bool tile(int i, int& pm, int& pn) const {
        const long L = (long)i * G + c; if (L >= nwg) return false;
        int wgid = (int)L; { const int q = nwg / NXCD, r = nwg % NXCD, xcd = wgid % NXCD, off = wgid / NXCD; wgid = (xcd < r ? xcd * (q + 1) : r * (q + 1) + (xcd - r) * q) + off; }
        const int nig = WGM * nN, gid = wgid / nig, fm = gid * WGM, gsz = (nM - fm) < WGM ? (nM - fm) : WGM;
        pm = fm + ((wgid % nig) % gsz); pn = (wgid % nig) / gsz; return true;
    }
};

__device__ __forceinline__ unsigned cvt_pk_bf16(float lo, float hi) { unsigned r; asm volatile("v_cvt_pk_bf16_f32 %0, %1, %2" : "=v"(r) : "v"(lo), "v"(hi)); return r; }
typedef f32x4 Acc[2][2][4][2];

template <class Epi, class Sched, bool ALIGN_EPI, bool GATHER>
__device__ __forceinline__ void gemm_phase(LAS unsigned char* lds, const int wave_idx, const int lda, const int ldb, const int K, const Sched& S, Epi& E) {
    int lane = lane_id(); asm volatile("" : "+v"(lane));
    const int wid = wave_idx, tid = wid * 64 + lane, wr = wid >> 2, wc = wid & 3, fr = lane & 15, fq = lane >> 4;
    const int nt = K / BK;
    unsigned voffA[2], voffB[2]; int gR[2]; unsigned gC[2];
#pragma unroll
    for (int i = 0; i < 2; ++i) { int R, C; stage_rc(tid * 16 + i * 8192, R, C); const int Rb = (R & ~31) + perm32(R & 31);
        voffA[i] = (unsigned)(R * lda + C) * 2u; voffB[i] = (unsigned)(Rb * ldb + C) * 2u; gR[i] = R; gC[i] = (unsigned)C * 2u; }
    const size_t kstep = (size_t)(BK * 2);
    const size_t hstepA = (size_t)HALF * lda * 2, hstepB = (size_t)HALF * ldb * 2;
    const unsigned ldsw = (unsigned)wid * 1024u;
    const int aoff = lds_byte(wr * 64 + fr, fq * 8), boff = lds_byte(wc * 32 + fr, fq * 8);
    unsigned vgc[2][2], vgn[2][2];
#define PG8_SA(b, h) (((b) * 2 + (h)) * HTB)
#define PG8_SB(b, h) ((4 + (b) * 2 + (h)) * HTB)
#define PG8_GL(gp, voff, bufoff, _i) __builtin_amdgcn_global_load_lds((const unsigned*)((const char*)(gp) + (voff)), (LAS unsigned*)(lds + (bufoff) + ldsw + (_i) * 8192), 16, 0, 0)
#define PG8_STAGE_B(bufoff, gbase) do { PG8_GL(gbase, voffB[0], bufoff, 0); PG8_GL(gbase, voffB[1], bufoff, 1); } while (0)
#define PG8_STAGE_A(bufoff, gbase, h, VG) do { if constexpr (GATHER) { PG8_GL(gbase, VG[h][0], bufoff, 0); PG8_GL(gbase, VG[h][1], bufoff, 1); } \
        else { PG8_GL((gbase) + (h) * hstepA, voffA[0], bufoff, 0); PG8_GL((gbase) + (h) * hstepA, voffA[1], bufoff, 1); } } while (0)
#define PG8_LDA(dst, b, h) do { _Pragma("unroll") for (int m = 0; m < 4; ++m) _Pragma("unroll") for (int k = 0; k < 2; ++k) dst[m][k] = *(const LAS bf16x8*)(lds + PG8_SA(b, h) + aoff + m * 2048 + k * 1024); } while (0)
#define PG8_LDB(dst, b, h) do { _Pragma("unroll") for (int n = 0; n < 2; ++n) _Pragma("unroll") for (int k = 0; k < 2; ++k) dst[n][k] = *(const LAS bf16x8*)(lds + PG8_SB(b, h) + boff + n * 2048 + k * 1024); } while (0)
#define PG8_MMA(ai, bj, At, Bt) do { __builtin_amdgcn_s_setprio(1); _Pragma("unroll") for (int m = 0; m < 4; ++m) _Pragma("unroll") for (int n = 0; n < 2; ++n) _Pragma("unroll") for (int k = 0; k < 2; ++k) \
        acc[ai][bj][m][n] = __builtin_amdgcn_mfma_f32_16x16x32_bf16(Bt[n][k], At[m][k], acc[ai][bj][m][n], 0, 0, 0); __builtin_amdgcn_s_setprio(0); } while (0)
#define PG8_WAIT_V(n) asm volatile("s_waitcnt vmcnt(" #n ")" ::: "memory")
#define PG8_WAIT_L(n) asm volatile("s_waitcnt lgkmcnt(" #n ")" ::: "memory")
#define PG8_BAR __builtin_amdgcn_s_barrier()
#define PG8_SCHED __builtin_amdgcn_sched_barrier(0)
#define PG8_GIDX(VG, U) do { _Pragma("unroll") for (int _h = 0; _h < 2; ++_h) _Pragma("unroll") for (int _i = 0; _i < 2; ++_i) \
        VG[_h][_i] = (unsigned)((U).grow + (U).gi[_h * HALF + gR[_i]]) * (unsigned)(lda * 2) + gC[_i]; } while (0)
    Unit cur, nxt; int ui = 0;
    if (!S.next(0, cur)) return;
    Acc acc;
#pragma unroll
    for (int a = 0; a < 2; ++a)
#pragma unroll
        for (int b = 0; b < 2; ++b)
#pragma unroll
            for (int m = 0; m < 4; ++m)
#pragma unroll
                for (int n = 0; n < 2; ++n) acc[a][b][m][n] = (f32x4){0.f, 0.f, 0.f, 0.f};
    bf16x8 At[4][2], B0[2][2], B1[2][2];
    const char* cA = cur.a; const char* cB = cur.b;
    if constexpr (GATHER) { PG8_GIDX(vgc, cur); } else { vgc[0][0] = vgc[0][1] = vgc[1][0] = vgc[1][1] = 0u; }
    E.prep(cur, wr, wc, fr, fq);
    PG8_STAGE_B(PG8_SB(0, 0), cB); PG8_STAGE_B(PG8_SB(0, 1), cB + hstepB); PG8_STAGE_A(PG8_SA(0, 0), cA, 0, vgc); PG8_STAGE_A(PG8_SA(0, 1), cA, 1, vgc);
    if (wr == 1) PG8_BAR;
    PG8_WAIT_V(2); PG8_BAR;
    PG8_STAGE_B(PG8_SB(1, 0), cB + kstep); PG8_STAGE_A(PG8_SA(1, 0), cA + kstep, 0, vgc); PG8_STAGE_B(PG8_SB(1, 1), cB + hstepB + kstep);
    PG8_WAIT_V(6); PG8_BAR;
    for (;;) {
        const bool has_next = S.next(ui + 1, nxt);
        const char* nA = has_next ? nxt.a : cA; const char* nB = has_next ? nxt.b : cB;
        if constexpr (GATHER) { if (has_next) { PG8_GIDX(vgn, nxt); } else {
#pragma unroll
            for (int h = 0; h < 2; ++h) { vgn[h][0] = vgc[h][0]; vgn[h][1] = vgc[h][1]; } } }
        else { vgn[0][0] = vgn[0][1] = vgn[1][0] = vgn[1][1] = 0u; }
        for (int t = 0; t < nt; t += 2) {
            const bool last = (t == nt - 2);
            const char* a1 = cA + (size_t)(t + 1) * kstep;
            const char* a2 = last ? nA : cA + (size_t)(t + 2) * kstep; const char* b2 = last ? nB : cB + (size_t)(t + 2) * kstep;
            const char* a3 = a2 + kstep; const char* b3 = b2 + kstep;
            unsigned vg2[2][2];
#pragma unroll
            for (int h = 0; h < 2; ++h) { vg2[h][0] = last ? vgn[h][0] : vgc[h][0]; vg2[h][1] = last ? vgn[h][1] : vgc[h][1]; }
            if constexpr (Epi::MIDK) { if (t == (nt >> 1)) E.midk(acc); }
            PG8_LDB(B0, 0, 0); PG8_LDB(B1, 0, 1); PG8_SCHED; PG8_LDA(At, 0, 0); PG8_STAGE_A(PG8_SA(1, 1), a1, 1, vgc);
            PG8_WAIT_V(8); PG8_WAIT_L(0); PG8_BAR; PG8_MMA(0, 0, At, B0); PG8_MMA(0, 1, At, B1); PG8_BAR; PG8_SCHED;
            PG8_LDA(At, 0, 1); PG8_STAGE_B(PG8_SB(0, 0), b2); PG8_STAGE_B(PG8_SB(0, 1), b2 + hstepB); PG8_STAGE_A(PG8_SA(0, 0), a2, 0, vg2);
            PG8_WAIT_V(8); PG8_WAIT_L(0); PG8_BAR; PG8_MMA(1, 0, At, B0); PG8_MMA(1, 1, At, B1); PG8_BAR; PG8_SCHED;
            PG8_LDB(B0, 1, 0); PG8_LDB(B1, 1, 1); PG8_SCHED; PG8_LDA(At, 1, 0); PG8_STAGE_A(PG8_SA(0, 1), a2, 1, vg2);
            PG8_WAIT_V(8); PG8_WAIT_L(0); PG8_BAR; PG8_MMA(0, 0, At, B0); PG8_MMA(0, 1, At, B1); PG8_BAR; PG8_SCHED;
            PG8_LDA(At, 1, 1); PG8_STAGE_B(PG8_SB(1, 0), b3); PG8_STAGE_B(PG8_SB(1, 1), b3 + hstepB); PG8_STAGE_A(PG8_SA(1, 0), a3, 0, vg2);
            PG8_WAIT_V(8); PG8_WAIT_L(0); PG8_BAR; PG8_MMA(1, 0, At, B0); PG8_MMA(1, 1, At, B1); PG8_BAR; PG8_SCHED;
        }
        if constexpr (ALIGN_EPI) { if (wr == 0) PG8_BAR; }
        E(acc, cur, wr, wc, fr, fq);
        if (!has_next) break;
#pragma unroll
        for (int a = 0; a < 2; ++a)
#pragma unroll
            for (int b = 0; b < 2; ++b)
#pragma unroll
                for (int m = 0; m < 4; ++m)
#pragma unroll
                    for (int n = 0; n < 2; ++n) acc[a][b][m][n] = (f32x4){0.f, 0.f, 0.f, 0.f};
        cur = nxt; cA = nA; cB = nB; ++ui;
#pragma unroll
        for (int h = 0; h < 2; ++h) { vgc[h][0] = vgn[h][0]; vgc[h][1] = vgn[h][1]; }
        E.prep(cur, wr, wc, fr, fq);
        if constexpr (ALIGN_EPI) { if (wr == 1) PG8_BAR; }
    }
    PG8_WAIT_V(0);
    if constexpr (!ALIGN_EPI) { if (wr == 0) PG8_BAR; }
    PG8_BAR;
#undef PG8_SA
#undef PG8_SB
#undef PG8_GL
#undef PG8_STAGE_A
#undef PG8_STAGE_B
#undef PG8_LDA
#undef PG8_LDB
#undef PG8_MMA
#undef PG8_WAIT_V
#undef PG8_WAIT_L
#undef PG8_SCHED
#undef PG8_GIDX
}

#define EPI_ROWS for (int ai = 0; ai < 2; ++ai) _Pragma("unroll") for (int m = 0; m < 4; ++m)
__device__ __forceinline__ v4u pack8(const f32x4 a, const f32x4 b) { v4u w; w.x = cvt_pk_bf16(a[0], a[1]); w.y = cvt_pk_bf16(a[2], a[3]); w.z = cvt_pk_bf16(b[0], b[1]); w.w = cvt_pk_bf16(b[2], b[3]); return w; }

template <int mode>
struct EpiStore {
    static constexpr bool MIDK = false;
    bf16* O; int ldc; const float* cs; float scale;
    __device__ __forceinline__ void prep(const Unit&, int, int, int, int) {}
    __device__ __forceinline__ void midk(Acc&) {}
    __device__ __forceinline__ void operator()(const Acc& acc, const Unit& u, int wr, int wc, int fr, int fq) const {
        asm volatile("" : "+v"(fr), "+v"(fq));
        size_t base; const float* csp = cs;
        if constexpr (mode == 0) base = (size_t)u.pm * 256 * ldc + (size_t)u.pn * 256;
        else if constexpr (mode == 1) { const int lb = u.pm >> 2, h = u.pm & 3; base = (size_t)lb * D * D + (size_t)(h * 256) * D + u.pn * 256; csp = cs + (size_t)(lb >> 2) * D + u.pn * 256; }
        else if constexpr (mode == 2) { const int pml = u.pm & 3, lbh = u.pm >> 2, h = lbh & 3, lb = lbh >> 2; base = (size_t)lb * D * D + (size_t)(pml * 256) * D + h * 256; }
        else { const int l = u.pm >> 2, pml = u.pm & 3; base = (size_t)l * NMEM * 2 * D + (size_t)(pml * 256) * 2 * D + u.pn * 256; }
        const int cb = wc * 32 + 8 * fq;
        f32x4 c0[2], c1[2];
#pragma unroll
        for (int bj = 0; bj < 2; ++bj) { if (csp) { c0[bj] = *(const f32x4*)(csp + bj * HALF + cb) * scale; c1[bj] = *(const f32x4*)(csp + bj * HALF + cb + 4) * scale; } else { c0[bj] = (f32x4){scale, scale, scale, scale}; c1[bj] = c0[bj]; } }
#pragma unroll
        EPI_ROWS { bf16* rowp = O + base + (size_t)(ai * HALF + wr * 64 + m * 16 + fr) * ldc + cb;
#pragma unroll
            for (int bj = 0; bj < 2; ++bj) *(v4u*)(rowp + bj * HALF) = pack8(acc[ai][bj][m][0] * c0[bj], acc[ai][bj][m][1] * c1[bj]); }
    }
};
struct EpiH {
    static constexpr bool MIDK = false;
    bf16* H;
    __device__ __forceinline__ void prep(const Unit&, int, int, int, int) {}
    __device__ __forceinline__ void midk(Acc&) {}
    __device__ __forceinline__ void operator()(const Acc& acc, const Unit& u, int wr, int wc, int fr, int fq) const {
        asm volatile("" : "+v"(fr), "+v"(fq));
        const int cb = u.pn * 128 + wc * 32 + 8 * fq;
#pragma unroll
        EPI_ROWS { bf16* rowp = H + (size_t)(u.pm * 256 + ai * HALF + wr * 64 + m * 16 + fr) * FF + cb;
            f32x4 h0, h1;
#pragma unroll
            for (int i = 0; i < 4; ++i) { h0[i] = silu_f(acc[ai][0][m][0][i]) * acc[ai][1][m][0][i]; h1[i] = silu_f(acc[ai][0][m][1][i]) * acc[ai][1][m][1][i]; }
            *(v4u*)rowp = pack8(h0, h1); }
    }
};
template <bool MK, bool WRITE_XB>
struct EpiX {
    static constexpr bool MIDK = MK;
    const float* base; float* out; bf16* xb; float* xstat; const float* gmstat; const float* atstat; LAS unsigned char* lds;
    int wr_, wc_, fr_;
    __device__ __forceinline__ void prep(const Unit& u, int wr, int wc, int fr, int fq) {
        wr_ = wr; wc_ = wc; fr_ = fr;
        if constexpr (MK) {
            asm volatile("" : "+v"(fr), "+v"(fq));
            LAS f32x2* X = (LAS f32x2*)(lds + RING_BYTES + 1024) + (wr * 4 + wc) * 128;
#pragma unroll
            EPI_ROWS { const size_t row = (size_t)u.pm * 256 + ai * HALF + wr * 64 + m * 16 + fr;
                const f32x4 g = *(const f32x4*)(gmstat + row * 4), a0 = *(const f32x4*)(atstat + row * 8), a1 = *(const f32x4*)(atstat + row * 8 + 4);
                const float sg = (g[0] + g[1]) + (g[2] + g[3]), sa = ((a0[0] + a0[1]) + (a0[2] + a0[3])) + ((a1[0] + a1[1]) + (a1[2] + a1[3]));
                const float rgm = 1.0f / sqrtf(sg * (1.0f / 512.0f) + EPS), rat = 1.0f / sqrtf(sa * (1.0f / 512.0f) + EPS);
                if (fq == 0) X[(ai * 4 + m) * 16 + fr] = (f32x2){rgm / rat, rat}; }
            asm volatile("s_waitcnt lgkmcnt(0)" ::: "memory");
        }
    }
    __device__ __forceinline__ void midk(Acc& acc) {
        int fr = fr_; asm volatile("" : "+v"(fr));
        const LAS f32x2* X = (const LAS f32x2*)(lds + RING_BYTES + 1024) + (wr_ * 4 + wc_) * 128;
#pragma unroll
        EPI_ROWS { const float f = X[(ai * 4 + m) * 16 + fr].x;
#pragma unroll
            for (int bj = 0; bj < 2; ++bj) { acc[ai][bj][m][0] *= f; acc[ai][bj][m][1] *= f; } }
    }
    __device__ __forceinline__ void operator()(const Acc& acc, const Unit& u, int wr, int wc, int fr, int fq) const {
        asm volatile("" : "+v"(fr), "+v"(fq));
        const int cb = u.pn * 256 + wc * 32 + 8 * fq;
#pragma unroll
        EPI_ROWS { const size_t row = (size_t)u.pm * 256 + ai * HALF + wr * 64 + m * 16 + fr; const size_t off = row * D + cb;
            float f = 1.0f; if constexpr (MK) f = ((const LAS f32x2*)(lds + RING_BYTES + 1024) + (wr * 4 + wc) * 128)[(ai * 4 + m) * 16 + fr].y; float ss = 0.f;
#pragma unroll
            for (int bj = 0; bj < 2; ++bj) { const f32x4 b0 = *(const f32x4*)(base + off + bj * HALF), b1 = *(const f32x4*)(base + off + bj * HALF + 4);
                const f32x4 x0 = b0 + acc[ai][bj][m][0] * f, x1 = b1 + acc[ai][bj][m][1] * f;
                *(f32x4*)(out + off + bj * HALF) = x0; *(f32x4*)(out + off + bj * HALF + 4) = x1;
                if constexpr (WRITE_XB) { *(v4u*)(xb + off + bj * HALF) = pack8(x0, x1);
                    ss += ((x0[0] * x0[0] + x0[1] * x0[1]) + (x0[2] * x0[2] + x0[3] * x0[3])) + ((x1[0] * x1[0] + x1[1] * x1[1]) + (x1[2] * x1[2] + x1[3] * x1[3])); } }
            if constexpr (WRITE_XB) { ss += __shfl_xor(ss, 16); ss += __shfl_xor(ss, 32); if (fq == 0) xstat[row * 16 + u.pn * 4 + wc] = ss; }
            if (m & 1) asm volatile("" ::: "memory"); }
    }
};

constexpr int EXCH_OFF = RING_BYTES + 1024;
struct EpiS {
    static constexpr bool MIDK = false;
    const float* xstat; bf16* P; LAS unsigned char* lds;
    __device__ __forceinline__ void prep(const Unit&, int, int, int, int) {}
    __device__ __forceinline__ void midk(Acc&) {}
    __device__ __forceinline__ void operator()(Acc& acc, const Unit& u, int wr, int wc, int fr, int fq) const {
        asm volatile("" : "+v"(fr), "+v"(fq));
        LAS f32x2* X = (LAS f32x2*)(lds + EXCH_OFF);
        float mw[2][4];
#pragma unroll
        EPI_ROWS { const int rl = ai * HALF + wr * 64 + m * 16 + fr; const size_t row = (size_t)u.pm * 256 + rl;
            const f32x4 s0 = *(const f32x4*)(xstat + row * 16), s1 = *(const f32x4*)(xstat + row * 16 + 4), s2 = *(const f32x4*)(xstat + row * 16 + 8), s3 = *(const f32x4*)(xstat + row * 16 + 12);
            const float ssq = (((s0[0] + s0[1]) + (s0[2] + s0[3])) + ((s1[0] + s1[1]) + (s1[2] + s1[3]))) + (((s2[0] + s2[1]) + (s2[2] + s2[3])) + ((s3[0] + s3[1]) + (s3[2] + s3[3])));
            const float rinv = 1.0f / sqrtf(ssq * (1.0f / D) + EPS);
            float mx = -3.0e38f;
#pragma unroll
            for (int bj = 0; bj < 2; ++bj)
#pragma unroll
                for (int n = 0; n < 2; ++n) { acc[ai][bj][m][n] *= rinv; const f32x4 v = acc[ai][bj][m][n]; mx = fmaxf(mx, fmaxf(fmaxf(v[0], v[1]), fmaxf(v[2], v[3]))); }
            mx = fmaxf(mx, __shfl_xor(mx, 16)); mx = fmaxf(mx, __shfl_xor(mx, 32));
            float sm = 0.f;
#pragma unroll
            for (int bj = 0; bj < 2; ++bj)
#pragma unroll
                for (int n = 0; n < 2; ++n) { f32x4 v = acc[ai][bj][m][n];
#pragma unroll
                    for (int i = 0; i < 4; ++i) { v[i] = __builtin_amdgcn_exp2f(v[i] - mx); sm += v[i]; }
                    acc[ai][bj][m][n] = v; }
            sm += __shfl_xor(sm, 16); sm += __shfl_xor(sm, 32);
            mw[ai][m] = mx;
            if (fq == 0) X[rl * 4 + wc] = (f32x2){mx, sm};
            if (m & 1) asm volatile("" ::: "memory"); }
        asm volatile("s_waitcnt lgkmcnt(0)\n\ts_barrier" ::: "memory");
        const int cb = u.pn * 256 + wc * 32 + 8 * fq;
#pragma unroll
        EPI_ROWS { const int rl = ai * HALF + wr * 64 + m * 16 + fr; const size_t row = (size_t)u.pm * 256 + rl;
            const f32x2 e0 = X[rl * 4 + 0], e1 = X[rl * 4 + 1], e2 = X[rl * 4 + 2], e3 = X[rl * 4 + 3];
            const float M = fmaxf(fmaxf(e0.x, e1.x), fmaxf(e2.x, e3.x));
            const float den = (e0.y * __builtin_amdgcn_exp2f(e0.x - M) + e1.y * __builtin_amdgcn_exp2f(e1.x - M)) + (e2.y * __builtin_amdgcn_exp2f(e2.x - M) + e3.y * __builtin_amdgcn_exp2f(e3.x - M));
            const float f = __builtin_amdgcn_exp2f(mw[ai][m] - M) / den;
#pragma unroll
            for (int bj = 0; bj < 2; ++bj) *(v4u*)(P + row * D + cb + bj * HALF) = pack8(acc[ai][bj][m][0] * f, acc[ai][bj][m][1] * f); }
        asm volatile("s_waitcnt lgkmcnt(0)" ::: "memory");
    }
};
struct EpiIn {
    static constexpr bool MIDK = false;
    bf16 *uact, *vact, *q, *k, *v; float* vstat; const float *qg, *kg, *cosT, *sinT;
    __device__ __forceinline__ void prep(const Unit&, int, int, int, int) {}
    __device__ __forceinline__ void midk(Acc&) {}
    __device__ __forceinline__ void operator()(const Acc& acc, const Unit& u, int wr, int wc, int fr, int fq) const {
        asm volatile("" : "+v"(fr), "+v"(fq));
        const int pn = u.pn;
        if (pn < 4) {
            bf16* O = pn < 2 ? uact : vact; const int cb = (pn & 1) * 256 + wc * 32 + 8 * fq;
#pragma unroll
            EPI_ROWS { const size_t row = (size_t)u.pm * 256 + ai * HALF + wr * 64 + m * 16 + fr; float ss = 0.f;
#pragma unroll
                for (int bj = 0; bj < 2; ++bj) { f32x4 g0, g1;
#pragma unroll
                    for (int i = 0; i < 4; ++i) { g0[i] = gelu_tanh(acc[ai][bj][m][0][i]); g1[i] = gelu_tanh(acc[ai][bj][m][1][i]); }
                    const v4u w = pack8(g0, g1); *(v4u*)(O + row * GMW + cb + bj * HALF) = w;
                    if (pn >= 2) { const float a0 = bflo(w.x), a1 = bfhi(w.x), a2 = bflo(w.y), a3 = bfhi(w.y), a4 = bflo(w.z), a5 = bfhi(w.z), a6 = bflo(w.w), a7 = bfhi(w.w);
                        ss += ((a0 * a0 + a1 * a1) + (a2 * a2 + a3 * a3)) + ((a4 * a4 + a5 * a5) + (a6 * a6 + a7 * a7)); } }
                if (pn >= 2) { ss += __shfl_xor(ss, 16); ss += __shfl_xor(ss, 32); if (fq == 0) vstat[row * 8 + (pn - 2) * 4 + wc] = ss; } }
        } else if (pn == 6 && wc >= 2) {
#pragma unroll
            EPI_ROWS { const size_t row = (size_t)u.pm * 256 + ai * HALF + wr * 64 + m * 16 + fr;
#pragma unroll
                for (int bj = 0; bj < 2; ++bj) *(v4u*)(v + row * 128 + (wc - 2) * 64 + bj * 32 + 8 * fq) = pack8(acc[ai][bj][m][0], acc[ai][bj][m][1]); }
        } else {
            const bool isq = pn < 6; const float* g = isq ? qg : kg; const float sc = isq ? QSCALE : 1.0f;
            bf16* O = isq ? q + ((pn - 4) * 4 + wc) * 64 : k + wc * 64; const int ldo = isq ? 512 : 128;
            f32x4 gv[2][2];
#pragma unroll
            for (int bj = 0; bj < 2; ++bj) { gv[bj][0] = *(const f32x4*)(g + bj * 32 + 8 * fq) * sc; gv[bj][1] = *(const f32x4*)(g + bj * 32 + 8 * fq + 4) * sc; }
#pragma unroll
            EPI_ROWS { const size_t row = (size_t)u.pm * 256 + ai * HALF + wr * 64 + m * 16 + fr; const int t = (int)(row % SEQ);
                float ss = 0.f;
#pragma unroll
                for (int bj = 0; bj < 2; ++bj)
#pragma unroll
                    for (int n = 0; n < 2; ++n) { const f32x4 x = acc[ai][bj][m][n]; ss += (x[0] * x[0] + x[1] * x[1]) + (x[2] * x[2] + x[3] * x[3]); }
                ss += __shfl_xor(ss, 16); ss += __shfl_xor(ss, 32);
                const float rinv = 1.0f / sqrtf(ss * (1.0f / 64.0f) + EPS);
#pragma unroll
                for (int bj = 0; bj < 2; ++bj) { const f32x4 c = *(const f32x4*)(cosT + t * 32 + bj * 16 + 4 * fq), sn = *(const f32x4*)(sinT + t * 32 + bj * 16 + 4 * fq);
                    const f32x4 x0 = acc[ai][bj][m][0] * gv[bj][0] * rinv, x1 = acc[ai][bj][m][1] * gv[bj][1] * rinv; f32x4 o0, o1;
                    o0[0] = x0[0] * c[0] - x0[1] * sn[0]; o0[1] = x0[0] * sn[0] + x0[1] * c[0]; o0[2] = x0[2] * c[1] - x0[3] * sn[1]; o0[3] = x0[2] * sn[1] + x0[3] * c[1];
                    o1[0] = x1[0] * c[2] - x1[1] * sn[2]; o1[1] = x1[0] * sn[2] + x1[1] * c[2]; o1[2] = x1[2] * c[3] - x1[3] * sn[3]; o1[3] = x1[2] * sn[3] + x1[3] * c[3];
                    *(v4u*)(O + row * ldo + bj * 32 + 8 * fq) = pack8(o0, o1); }
                if (m & 1) asm volatile("" ::: "memory"); }
        }
    }
};
}


__device__ __forceinline__ void cvt_item(const float* W, int K, int N, const float* gain, bf16* WT, int dst_row0, int k0, int n0, LAS float* scr, int lane) {
#pragma unroll 8
    for (int i = 0; i < 32; ++i) { const int kk = 2 * i + (lane >> 5); float v = W[(size_t)(k0 + kk) * N + n0 + (lane & 31)]; if (gain) v *= gain[k0 + kk]; scr[kk * 33 + (lane & 31)] = v; }
    asm volatile("s_waitcnt lgkmcnt(0)" ::: "memory");
    const int c = lane & 7;
#pragma unroll
    for (int j = 0; j < 4; ++j) { const int n = (lane >> 3) + 8 * j; const LAS float* sp = scr + (8 * c) * 33 + n;
        v4u o; o.x = pk2(sp[0 * 33], sp[1 * 33]); o.y = pk2(sp[2 * 33], sp[3 * 33]); o.z = pk2(sp[4 * 33], sp[5 * 33]); o.w = pk2(sp[6 * 33], sp[7 * 33]);
        *(v4u*)(WT + (size_t)(dst_row0 + n) * K + k0 + 8 * c) = o; }
    asm volatile("s_waitcnt lgkmcnt(0)" ::: "memory");
}
__device__ __forceinline__ void ph_convert(Frame& F) {
    int lane_ = lane_id(); asm volatile("" : "+v"(lane_)); const int tid_ = F.wave * 64 + lane_;
    LAS float* scr = (LAS float*)(F.lds + F.wave * 16384);
    const int gw = F.vcu * NWAVES + F.wave, NGW = F.G * NWAVES;
    constexpr int I_IN = 16 * 56, I_SQ = 512, I_KV = 1024, I_HEAD = I_IN + I_SQ + I_KV + I_SQ, I_LAYER = I_HEAD + NE * 3 * I_SQ, NITEMS = NL * I_LAYER;
    for (int it = gw; it < NITEMS; it += NGW) {
        const int l = it / I_LAYER; int r = it % I_LAYER;
        if (r < I_IN) {
            const int kb = r / 56, nb = r % 56, n0 = nb * 32, pn = n0 >> 8; int dr = n0;
            if (pn >= 4) { const int sidx = n0 & 255, w = sidx >> 6, bj = (sidx >> 5) & 1; dr = pn * 256 + 128 * bj + 32 * w; }
            cvt_item(F.in[3] + (size_t)l * D * INW, D, INW, F.in[2] + (size_t)l * D, (bf16*)(F.ws + WS_WIN) + (size_t)l * INW * D, dr, kb * 64, n0, scr, lane_); continue; }
        r -= I_IN;
        if (r < I_SQ) { cvt_item(F.in[10] + (size_t)l * D * D, D, D, F.in[9] + (size_t)l * D, (bf16*)(F.ws + WS_WOUT) + (size_t)l * D * D, (r % 32) * 32, (r / 32) * 64, (r % 32) * 32, scr, lane_); continue; }
        r -= I_SQ;
        if (r < I_KV) { cvt_item(F.in[14] + (size_t)l * D * 2 * D, D, 2 * D, nullptr, (bf16*)(F.ws + WS_WKVT) + (size_t)l * 2 * D * D, (r % 64) * 32, (r / 64) * 64, (r % 64) * 32, scr, lane_); continue; }
        r -= I_KV;
        if (r < I_SQ) { cvt_item(F.in[15] + (size_t)l * D * D, D, D, nullptr, (bf16*)(F.ws + WS_WOT) + (size_t)l * D * D, (r % 32) * 32, (r / 32) * 64, (r % 32) * 32, scr, lane_); continue; }
        r -= I_SQ;
        const int e = r / (3 * I_SQ), rr = r % (3 * I_SQ), which = rr / I_SQ, sub = rr % I_SQ, kb = sub / 32, n0 = (sub % 32) * 32;
        const size_t mo = ((size_t)l * NE + e) * D * FF;
        if (which == 2) cvt_item(F.in[20] + mo, FF, D, nullptr, (bf16*)(F.ws + WS_WD) + mo, n0, kb * 64, n0, scr, lane_);
        else cvt_item((which == 0 ? F.in[18] : F.in[19]) + mo, D, FF, F.in[16] + (size_t)l * D, (bf16*)(F.ws + WS_WGU) + 2 * mo, 256 * (n0 >> 7) + 128 * which + (n0 & 127), kb * 64, n0, scr, lane_);
    }
    const int gt = F.vcu * NTHR + tid_, NGT = F.G * NTHR;
    const float* wq = F.in[13]; bf16* WQB = (bf16*)(F.ws + WS_WQB);
    for (int i = gt; i < NL * D * D / 8; i += NGT) { const f32x4 a = *(const f32x4*)(wq + (size_t)i * 8), b = *(const f32x4*)(wq + (size_t)i * 8 + 4);
        v4u o; o.x = pk2(a.x, a.y); o.y = pk2(a.z, a.w); o.z = pk2(b.x, b.y); o.w = pk2(b.z, b.w); *(v4u*)(WQB + (size_t)i * 8) = o; }
}

struct SchedDense {
    pg8::TileOrder o; const char* A; size_t a_tile; const char* B; size_t b_tile, b_batch; int bdiv, bmod;
    __device__ __forceinline__ bool next(int i, pg8::Unit& u) const { if (!o.tile(i, u.pm, u.pn)) return false;
        u.z = 0; u.gi = nullptr; u.grow = 0; u.a = A + (size_t)u.pm * a_tile; u.b = B + (size_t)((u.pm / bdiv) % bmod) * b_batch + (size_t)u.pn * b_tile; return true; }
};
struct SchedE1 {
    pg8::TileOrder o; const char* HBp; const int* IDX; const char* WGU;
    __device__ __forceinline__ bool next(int i, pg8::Unit& u) const { if (!o.tile(i, u.pm, u.pn)) return false;
        const int z = u.pm >> 2; u.z = z; u.gi = IDX + (size_t)u.pm * 256; u.grow = (z >> 4) * SEQ; u.a = HBp;
        u.b = WGU + (size_t)(z & 15) * (2 * FF * D * 2) + (size_t)u.pn * (256 * D * 2); return true; }
};
struct SchedKV { pg8::TileOrder o; const char* MEMN; const char* WKVT;
    __device__ __forceinline__ bool next(int i, pg8::Unit& u) const { if (!o.tile(i, u.pm, u.pn)) return false; u.z = 0; u.gi = nullptr; u.grow = 0;
        u.a = MEMN + (size_t)(u.pm & 3) * (256 * D * 2); u.b = WKVT + (size_t)(u.pm >> 2) * (2 * D * D * 2) + (size_t)u.pn * (256 * D * 2); return true; } };
struct SchedQK { pg8::TileOrder o; const char* KVM; const char* WQB;
    __device__ __forceinline__ bool next(int i, pg8::Unit& u) const { if (!o.tile(i, u.pm, u.pn)) return false; u.z = 0; u.gi = nullptr; u.grow = 0;
        const int h = u.pm & 3, lb = u.pm >> 2, b = lb & 3, l = lb >> 2;
        u.a = KVM + ((size_t)l * NMEM * 2 * D + (size_t)(b * 256) * 2 * D + h * 256) * 2; u.b = WQB + ((size_t)l * D * D + (size_t)u.pn * 256 * D + h * 256) * 2; return true; } };
struct SchedVO { pg8::TileOrder o; const char* KVM; const char* WOT;
    __device__ __forceinline__ bool next(int i, pg8::Unit& u) const { if (!o.tile(i, u.pm, u.pn)) return false; u.z = 0; u.gi = nullptr; u.grow = 0;
        const int pml = u.pm & 3, lbh = u.pm >> 2, h = lbh & 3, lb = lbh >> 2, b = lb & 3, l = lb >> 2;
        u.a = WOT + ((size_t)l * D * D + (size_t)pml * 256 * D + h * 256) * 2; u.b = KVM + ((size_t)l * NMEM * 2 * D + (size_t)(b * 256) * 2 * D + D + h * 256) * 2; return true; } };

namespace attn_body {
using bf16=__hip_bfloat16;
using bf16x8=__attribute__((ext_vector_type(8)))short;
using s16x4=__attribute__((ext_vector_type(4)))short;
using f32x16=__attribute__((ext_vector_type(16)))float;
using u32x4=__attribute__((ext_vector_type(4)))unsigned;
constexpr int SEQ=8192,D=64,QP=512,KP=128,OP=1024;
constexpr int NW=8,QBLK=32,QB=QBLK*NW,KVBLK=64,NQB=SEQ/QB;
constexpr int ATTN_UNIT_ROWS=QB;
__device__ __forceinline__ int crow(int r,int hi){return (r&3)+8*(r>>2)+4*hi;}
#define SBAR() __builtin_amdgcn_sched_barrier(0)
__device__ __forceinline__ void cmask(f32x16&p0,f32x16&p1,int jb,int qrel,int hi){
  const float NEG=-INFINITY; int kb=64*jb+4*hi;
  #pragma unroll
  for(int r=0;r<16;++r){int kv=kb+(r&3)+8*(r>>2); if(kv>qrel)p0[r]=NEG; if(kv+32>qrel)p1[r]=NEG;}
}

constexpr int NSLOT=3, SLOTB=8192;
constexpr int LDS_K=0, LDS_V=NSLOT*SLOTB, LDS_WS=2*NSLOT*SLOTB, LDS_OST=LDS_WS+NW*64*4, LDS_BYTES=LDS_OST+NW*4096;
constexpr float C2=0.125f*1.4426950408889634f;
__device__ __forceinline__ void glds16(const void*gsrc,unsigned lds_dst){unsigned keep;
  asm volatile("s_mov_b32 %0, m0\n\ts_mov_b32 m0, %2\n\ts_nop 0\n\tglobal_load_lds_dwordx4 %1, off\n\ts_mov_b32 m0, %0":"=&s"(keep):"v"(gsrc),"s"(lds_dst):"memory");}
__device__ __forceinline__ float max3f(float a,float b,float c){float r;asm("v_max3_f32 %0, %1, %2, %3":"=v"(r):"v"(a),"v"(b),"v"(c));return r;}
__device__ __forceinline__ float max2f(float a,float b){float r;asm("v_max_f32_e32 %0, %1, %2":"=v"(r):"v"(a),"v"(b));return r;}
__device__ __forceinline__ float fadd_s(float a,float b){float r;asm("v_add_f32_e32 %0, %1, %2":"=v"(r):"v"(a),"v"(b));return r;}
__device__ __forceinline__ float fsub_s(float a,float b){float r;asm("v_sub_f32_e32 %0, %1, %2":"=v"(r):"v"(a),"v"(b));return r;}
typedef float f32x2_t __attribute__((ext_vector_type(2))); typedef __bf16 bf16x2_t __attribute__((ext_vector_type(2)));
__device__ __forceinline__ unsigned cvtpk_s(float lo,float hi){f32x2_t v={lo,hi};bf16x2_t b=__builtin_convertvector(v,bf16x2_t);return __builtin_bit_cast(unsigned,b);}
#define WAIT_BAR(N) asm volatile("s_waitcnt vmcnt(" #N ") lgkmcnt(0)\n\ts_barrier":::"memory")

__device__ __forceinline__ void qkt(f32x16&p0,f32x16&p1,const char*Kslot,const bf16x8*qr,const f32x16&negm,int r32,int hi){
  const char*kb=Kslot+hi*1024+r32*16;
  #pragma unroll
  for(int d0=0;d0<4;++d0){
    const bf16x8 b0=*reinterpret_cast<const bf16x8*>(kb+d0*2048);
    const bf16x8 b1=*reinterpret_cast<const bf16x8*>(kb+d0*2048+512);
    if(d0==0){p0=__builtin_amdgcn_mfma_f32_32x32x16_bf16(b0,qr[0],negm,0,0,0);p1=__builtin_amdgcn_mfma_f32_32x32x16_bf16(b1,qr[0],negm,0,0,0);}
    else{p0=__builtin_amdgcn_mfma_f32_32x32x16_bf16(b0,qr[d0],p0,0,0,0);p1=__builtin_amdgcn_mfma_f32_32x32x16_bf16(b1,qr[d0],p1,0,0,0);}}
}
typedef __attribute__((address_space(3))) const char* lds_cptr;
typedef short v4i16_t __attribute__((ext_vector_type(4)));
__device__ __forceinline__ void kload8(bf16x8*kf,lds_cptr kp){
  kf[0]=*(const __attribute__((address_space(3))) bf16x8*)(kp);      kf[1]=*(const __attribute__((address_space(3))) bf16x8*)(kp+512);
  kf[2]=*(const __attribute__((address_space(3))) bf16x8*)(kp+2048); kf[3]=*(const __attribute__((address_space(3))) bf16x8*)(kp+2560);
  kf[4]=*(const __attribute__((address_space(3))) bf16x8*)(kp+4096); kf[5]=*(const __attribute__((address_space(3))) bf16x8*)(kp+4608);
  kf[6]=*(const __attribute__((address_space(3))) bf16x8*)(kp+6144); kf[7]=*(const __attribute__((address_space(3))) bf16x8*)(kp+6656);
}
__device__ __forceinline__ void kload2(bf16x8*kf,lds_cptr kp,int j){ kf[2*j]=*(const __attribute__((address_space(3))) bf16x8*)(kp+j*2048); kf[2*j+1]=*(const __attribute__((address_space(3))) bf16x8*)(kp+j*2048+512); }
__device__ __forceinline__ s16x4 vtr(lds_cptr p){ return __builtin_bit_cast(s16x4,__builtin_amdgcn_ds_read_tr16_b64_v4i16((__attribute__((address_space(3))) v4i16_t*)p)); }
__device__ __forceinline__ float rowmax(const f32x16&p0,const f32x16&p1){
  float a=max3f(p0[0],p0[1],p1[0]),b=max3f(p0[2],p0[3],p1[1]);a=max3f(a,p1[2],p1[3]);
  #pragma unroll
  for(int r=4;r<16;r+=4){a=max3f(a,p0[r],p0[r+1]);b=max3f(b,p0[r+2],p0[r+3]);a=max3f(a,p1[r],p1[r+1]);b=max3f(b,p1[r+2],p1[r+3]);}
  const float m=max2f(a,b);
  auto rr=__builtin_amdgcn_permlane32_swap(__float_as_uint(m),__float_as_uint(m),false,false);
  return max2f(__uint_as_float(rr[0]),__uint_as_float(rr[1]));
}
__device__ __forceinline__ void pv(f32x16*o,int vb,bf16x8 pa0,bf16x8 pa1,bf16x8 pa2,bf16x8 pa3){
  #pragma unroll
  for(int d0=0;d0<2;++d0){s16x4 lo[4],hi[4];
    #pragma unroll
    for(int ks=0;ks<4;++ks){
      asm volatile("ds_read_b64_tr_b16 %0,%1 offset:%c2":"=&v"(lo[ks]):"v"(vb),"i"(d0*4096+ks*1024):"memory");
      asm volatile("ds_read_b64_tr_b16 %0,%1 offset:%c2":"=&v"(hi[ks]):"v"(vb),"i"(d0*4096+ks*1024+512):"memory");}
    asm volatile("s_waitcnt lgkmcnt(0)":::"memory");SBAR();
    #define PK(k) (bf16x8){lo[k][0],lo[k][1],lo[k][2],lo[k][3],hi[k][0],hi[k][1],hi[k][2],hi[k][3]}
    o[d0]=__builtin_amdgcn_mfma_f32_32x32x16_bf16(pa0,PK(0),o[d0],0,0,0);
    o[d0]=__builtin_amdgcn_mfma_f32_32x32x16_bf16(pa1,PK(1),o[d0],0,0,0);
    o[d0]=__builtin_amdgcn_mfma_f32_32x32x16_bf16(pa2,PK(2),o[d0],0,0,0);
    o[d0]=__builtin_amdgcn_mfma_f32_32x32x16_bf16(pa3,PK(3),o[d0],0,0,0);
    #undef PK
  }
}

#ifndef ATTN_STORE16
#define ATTN_STORE16(p,v) (*(u32x4*)(p)=(v))
#endif
template<int THRL> __device__ __forceinline__ void attn_unit(int b,int h,int qb,const bf16*Q,const bf16*__restrict__ K,const bf16*__restrict__ V,bf16*O,float*ATS,char*shm,int wave_idx){
  int lane=(int)__builtin_amdgcn_mbcnt_hi(~0u,__builtin_amdgcn_mbcnt_lo(~0u,0u)); asm volatile("":"+v"(lane)); const int r32=lane&31,hi=lane>>5; const int wid=wave_idx; const int kvh=h>>2;
  const long rowbase=(long)b*SEQ; const int q0=qb*QB;
  const bf16*Qw=Q+(rowbase+q0+wid*QBLK)*QP+h*D;
  const bf16*Kh=K+rowbase*KP+kvh*D,*Vh=V+rowbase*KP+kvh*D;
  const unsigned lds0=(unsigned)(uintptr_t)shm;
  float*wsf=(float*)(shm+LDS_WS)+wid*64;
  const bf16*ksrc=Kh+(long)lane*KP+wid*8;
  const bf16*vsrc=Vh+(long)(16*(wid&3)+(lane>>2))*KP+(wid>>2)*32+(lane&3)*8;
  const unsigned kdst=lds0+LDS_K+wid*1024, vdst=lds0+LDS_V+wid*1024;
  #define DMA_K(t,slot) glds16(ksrc+(long)(t)*KVBLK*KP,(unsigned)__builtin_amdgcn_readfirstlane(kdst+(slot)))
  #define DMA_V(t,slot) glds16(vsrc+(long)(t)*KVBLK*KP,(unsigned)__builtin_amdgcn_readfirstlane(vdst+(slot)))
  const int vb0=(int)(lds0+LDS_V)+((lane>>4)&1)*32+(lane&3)*8+(4*hi+((lane&15)>>2))*64;
  const char*Kbase=shm+LDS_K; bf16x8 kf[8];
  const lds_cptr shm3=(lds_cptr)shm; const lds_cptr kp0=shm3+LDS_K+hi*1024+r32*16; const lds_cptr vp0=shm3+LDS_V+((lane>>4)&1)*32+(lane&3)*8+(4*hi+((lane&15)>>2))*64;
  const int NT=SEQ/KVBLK;
  DMA_K(0,0);DMA_V(0,0);DMA_K(1,SLOTB);
  bf16x8 qr[4];
  #pragma unroll
  for(int d0=0;d0<4;++d0)qr[d0]=*reinterpret_cast<const bf16x8*>(&Qw[(long)r32*QP+d0*16+hi*8]);
  float mhat=0.f,l_reg=0.f;f32x16 o[2];o[0]=f32x16{};o[1]=f32x16{};f32x16 negm=f32x16{};asm volatile("":"+v"(negm));
  const int qrel=wid*QBLK+r32;
  #define CMASK(P0,P1,t) do{}while(0)
  bool resc=false;
  #define START(P0,P1) do{ const float rm=rowmax(P0,P1); resc=false; \
    { const float dl=rm; mhat=fadd_s(mhat,dl); \
      _Pragma("unroll") for(int r=0;r<16;++r){P0[r]=fsub_s(P0[r],dl);P1[r]=fsub_s(P1[r],dl);} \
      _Pragma("unroll") for(int r=0;r<16;++r)negm[r]=-mhat; asm volatile("":"+v"(negm)); } \
    _Pragma("unroll") for(int r=0;r<16;++r)P0[r]=__builtin_amdgcn_exp2f(P0[r]); }while(0)
  #define RESC() do{ if(resc){ asm volatile("s_waitcnt lgkmcnt(0)":::"memory"); \
      _Pragma("unroll") for(int d_=0;d_<2;++d_) _Pragma("unroll") for(int r=0;r<16;++r)o[d_][r]*=wsf[crow(r,hi)]; } }while(0)
  f32x16 pA0,pA1,pB0,pB1;
  int sl_prev=0,sl_cur=0,sl_next=SLOTB;
  #define ROT() do{sl_prev=sl_cur;sl_cur=sl_next;sl_next=(sl_next==(NSLOT-1)*SLOTB)?0:sl_next+SLOTB;}while(0)
  DMA_K(2,2*SLOTB);
  WAIT_BAR(3);
  qkt(pA0,pA1,Kbase,qr,negm,r32,hi);asm volatile("s_nop 15\n\ts_nop 7":"+v"(pA0),"+v"(pA1));CMASK(pA0,pA1,0);
  START(pA0,pA1);
  _Pragma("unroll") for(int r=0;r<16;++r)pA1[r]=__builtin_amdgcn_exp2f(pA1[r]);
  WAIT_BAR(0);
  DMA_K(3,0);DMA_V(1,SLOTB);
  ROT();
  kload8(kf,kp0+sl_cur);
  WAIT_BAR(2);
  s16x4 vlo[8],vhi[8]; u32x4 pw0,pw1,pw2,pw3;
  #define PKW(P,B) cvtpk_s(P[B],P[B+1])
  #define PAF(k) __builtin_bit_cast(bf16x8,pw##k)
  #define VFR(i) (bf16x8){vlo[i][0],vlo[i][1],vlo[i][2],vlo[i][3],vhi[i][0],vhi[i][1],vhi[i][2],vhi[i][3]}
  #define PIN(x) asm volatile("":"+v"(x))
  #define MX3(a,b,c) __builtin_fmaxf(__builtin_fmaxf((a),(b)),(c))
  #define GAPA(MF,A0,A1,A2,A3,W0,W1,PW) do{ MF; sacc+=A0; sacc+=A1; sacc+=A2; sacc+=A3; PIN(sacc); W0; W1; PIN(PW); SBAR(); }while(0)
  #define EX(v) __builtin_amdgcn_exp2f(v)
  #define GAPB(MF,X,B) do{ MF; X[B]=EX(X[B]); X[B+1]=EX(X[B+1]); X[B+2]=EX(X[B+2]); X[B+3]=EX(X[B+3]); PIN(X); SBAR(); }while(0)
  #define VRD(i) do{ vlo[i]=vtr(vp_+(((i)>>2)*4096+((i)&3)*1024)); vhi[i]=vtr(vp_+(((i)>>2)*4096+((i)&3)*1024+512)); }while(0)
  #define KRD(G,j) do{ if(G){ kload2(kf,kp0+sl_next,j); SBAR(); } }while(0)
  #define STEP(C0,C1,P0,P1,t,GK,GV,GL) do{ SBAR(); \
    const lds_cptr vp_=vp0+sl_prev; \
    VRD(0); SBAR(); float sacc=(P0[0]+P0[1]); \
    GAPA(C0=__builtin_amdgcn_mfma_f32_32x32x16_bf16(kf[0],qr[0],negm,0,0,0), P0[2],P0[3],P0[4],P0[5],     pw0[0]=PKW(P0,0), pw0[1]=PKW(P0,2), pw0); \
    VRD(4); SBAR(); GAPA(C1=__builtin_amdgcn_mfma_f32_32x32x16_bf16(kf[1],qr[0],negm,0,0,0), P0[6],P0[7],P0[8],P0[9],     pw0[2]=PKW(P0,4), pw0[3]=PKW(P0,6), pw0); \
    VRD(1); SBAR(); GAPA(C0=__builtin_amdgcn_mfma_f32_32x32x16_bf16(kf[2],qr[1],C0,0,0,0),   P0[10],P0[11],P0[12],P0[13], pw1[0]=PKW(P0,8), pw1[1]=PKW(P0,10), pw1); \
    VRD(5); SBAR(); GAPA(C1=__builtin_amdgcn_mfma_f32_32x32x16_bf16(kf[3],qr[1],C1,0,0,0),   P0[14],P0[15],P1[0],P1[1],   pw1[2]=PKW(P0,12),pw1[3]=PKW(P0,14), pw1); \
    VRD(2); SBAR(); GAPA(C0=__builtin_amdgcn_mfma_f32_32x32x16_bf16(kf[4],qr[2],C0,0,0,0),   P1[2],P1[3],P1[4],P1[5],     pw2[0]=PKW(P1,0), pw2[1]=PKW(P1,2), pw2); \
    VRD(6); SBAR(); GAPA(C1=__builtin_amdgcn_mfma_f32_32x32x16_bf16(kf[5],qr[2],C1,0,0,0),   P1[6],P1[7],P1[8],P1[9],     pw2[2]=PKW(P1,4), pw2[3]=PKW(P1,6), pw2); \
    VRD(3); SBAR(); GAPA(C0=__builtin_amdgcn_mfma_f32_32x32x16_bf16(kf[6],qr[3],C0,0,0,0),   P1[10],P1[11],P1[12],P1[13], pw3[0]=PKW(P1,8), pw3[1]=PKW(P1,10), pw3); \
    VRD(7); SBAR(); GAPA(C1=__builtin_amdgcn_mfma_f32_32x32x16_bf16(kf[7],qr[3],C1,0,0,0),   P1[14],P1[15],0.f,0.f,       pw3[2]=PKW(P1,12),pw3[3]=PKW(P1,14), pw3); \
    l_reg+=sacc; \
    if(GK){DMA_K((t)+3,sl_cur);} if(GV){DMA_V((t)+1,sl_next);} \
    CMASK(C0,C1,t); \
    { float a=MX3(C0[0],C0[1],C1[0]),b=MX3(C0[2],C0[3],C1[1]); a=MX3(a,C1[2],C1[3]); \
      _Pragma("unroll") for(int r=4;r<16;r+=4){a=MX3(a,C0[r],C0[r+1]);b=MX3(b,C0[r+2],C0[r+3]);a=MX3(a,C1[r],C1[r+1]);b=MX3(b,C1[r+2],C1[r+3]);} \
      float rm=__builtin_fmaxf(a,b); { auto rr=__builtin_amdgcn_permlane32_swap(__float_as_uint(rm),__float_as_uint(rm),false,false); rm=__builtin_fmaxf(__uint_as_float(rr[0]),__uint_as_float(rr[1])); } \
      resc=false; \
      if(__builtin_expect(__any(rm>(float)THRL),0)){ const float dl=__builtin_fmaxf(rm,0.f); mhat+=dl; \
        _Pragma("unroll") for(int r=0;r<16;++r){C0[r]-=dl;C1[r]-=dl;} \
        _Pragma("unroll") for(int r=0;r<16;++r)negm[r]=-mhat; asm volatile("":"+v"(negm)); \
        const float f=__builtin_amdgcn_exp2f(-dl); l_reg*=f; if(hi==0)wsf[r32]=f; resc=true; } } \
    SBAR(); \
    GAPB(o[0]=__builtin_amdgcn_mfma_f32_32x32x16_bf16(PAF(0),VFR(0),o[0],0,0,0), C0,0); \
    GAPB(o[1]=__builtin_amdgcn_mfma_f32_32x32x16_bf16(PAF(0),VFR(4),o[1],0,0,0), C0,4); \
    KRD(GL,0); GAPB(o[0]=__builtin_amdgcn_mfma_f32_32x32x16_bf16(PAF(1),VFR(1),o[0],0,0,0), C0,8); \
    KRD(GL,1); GAPB(o[1]=__builtin_amdgcn_mfma_f32_32x32x16_bf16(PAF(1),VFR(5),o[1],0,0,0), C0,12); \
    KRD(GL,2); GAPB(o[0]=__builtin_amdgcn_mfma_f32_32x32x16_bf16(PAF(2),VFR(2),o[0],0,0,0), C1,0); \
    KRD(GL,3); GAPB(o[1]=__builtin_amdgcn_mfma_f32_32x32x16_bf16(PAF(2),VFR(6),o[1],0,0,0), C1,4); \
    GAPB(o[0]=__builtin_amdgcn_mfma_f32_32x32x16_bf16(PAF(3),VFR(3),o[0],0,0,0), C1,8); \
    GAPB(o[1]=__builtin_amdgcn_mfma_f32_32x32x16_bf16(PAF(3),VFR(7),o[1],0,0,0), C1,12); \
    }while(0)
  int t=1;
  for(;t+5<NT;t+=2){
    STEP(pB0,pB1,pA0,pA1,t,true,true,true);     WAIT_BAR(2); RESC(); ROT();
    STEP(pA0,pA1,pB0,pB1,t+1,true,true,true);   WAIT_BAR(2); RESC(); ROT();
  }
  #define ENDW(tt) do{ if((tt)+3<NT){WAIT_BAR(2);} else if((tt)+2<NT){WAIT_BAR(1);} else {WAIT_BAR(0);} }while(0)
  for(;t+1<NT;t+=2){
    STEP(pB0,pB1,pA0,pA1,t,(t+3<NT),(t+1<NT),(t+1<NT));       ENDW(t);   RESC(); ROT();
    STEP(pA0,pA1,pB0,pB1,t+1,(t+4<NT),(t+2<NT),(t+2<NT));     ENDW(t+1); RESC(); ROT();
  }
  STEP(pB0,pB1,pA0,pA1,NT-1,false,false,false); RESC();
  { float sacc=pB0[0]+pB0[1]; _Pragma("unroll") for(int r=2;r<16;++r)sacc+=pB0[r]; _Pragma("unroll") for(int r=0;r<16;++r)sacc+=pB1[r]; l_reg+=sacc;
    pw0=(u32x4){PKW(pB0,0),PKW(pB0,2),PKW(pB0,4),PKW(pB0,6)};pw1=(u32x4){PKW(pB0,8),PKW(pB0,10),PKW(pB0,12),PKW(pB0,14)};pw2=(u32x4){PKW(pB1,0),PKW(pB1,2),PKW(pB1,4),PKW(pB1,6)};pw3=(u32x4){PKW(pB1,8),PKW(pB1,10),PKW(pB1,12),PKW(pB1,14)};
    SBAR(); pv(o,vb0+sl_cur,PAF(0),PAF(1),PAF(2),PAF(3)); }
  #undef PKW
  #undef PAF
  #undef VFR
  #undef PIN
  #undef MX3
  #undef GAPA
  #undef GAPB
  #undef EX
  #undef VRD
  #undef KRD
  #undef STEP
  #undef ENDW
  {auto rr=__builtin_amdgcn_permlane32_swap(__float_as_uint(l_reg),__float_as_uint(l_reg),false,false);l_reg=__uint_as_float(rr[0])+__uint_as_float(rr[1]);}
  if(hi==0)wsf[32+r32]=l_reg;asm volatile("s_waitcnt lgkmcnt(0)":::"memory");
  float rli[16];
  #pragma unroll
  for(int r=0;r<16;++r)rli[r]=__builtin_amdgcn_rcpf(wsf[32+crow(r,hi)]);
  bf16*Ow=O+(rowbase+q0+wid*QBLK)*OP+512+h*D; float*ATw=ATS+(rowbase+q0+wid*QBLK)*8+h;
  { bf16*stg=(bf16*)(shm+LDS_OST)+wid*2048;
    #pragma unroll
    for(int r=0;r<16;++r){const int orow=crow(r,hi);
      #pragma unroll
      for(int d0=0;d0<2;++d0)stg[orow*64+d0*32+r32]=__float2bfloat16(o[d0][r]*rli[r]);}
    asm volatile("s_waitcnt lgkmcnt(0)":::"memory");
    #pragma unroll
    for(int i=0;i<4;++i){const int row=i*8+(lane>>3),ch=lane&7; const u32x4 v=*(const u32x4*)(stg+row*64+ch*8); ATTN_STORE16(Ow+(long)row*OP+ch*8,v);
      float ss=0.f;
      #pragma unroll
      for(int q=0;q<4;++q){const float lo=__uint_as_float(v[q]<<16),hh=__uint_as_float(v[q]&0xffff0000u);ss+=lo*lo+hh*hh;}
      ss+=__shfl_xor(ss,1);ss+=__shfl_xor(ss,2);ss+=__shfl_xor(ss,4); if(ch==0)ATw[(long)row*8]=ss;} }
  asm volatile("s_waitcnt lgkmcnt(0)\n\ts_barrier":::"memory");
  #undef DMA_K
  #undef DMA_V
  #undef CMASK
  #undef START
  #undef RESC
  #undef ROT
}
constexpr int ATTN_LDS_BYTES=LDS_BYTES;
#undef SBAR
#undef WAIT_BAR
}

__global__ void __launch_bounds__(NTHR, 2) mega(Args args) {
    extern __shared__ __attribute__((aligned(16))) unsigned char lds[];
    Frame F;
    F.lds = (LAS unsigned char*)lds;
    F.wave = __builtin_amdgcn_readfirstlane(threadIdx.x >> 6);
    F.G = gridDim.x; { const int bx = blockIdx.x; F.vcu = (F.G % 8 == 0) ? (bx % 8) * (F.G / 8) + bx / 8 : bx; }
#pragma unroll
    for (int i = 0; i < 22; ++i) F.in[i] = args.in[i];
    F.ws = args.ws; F.xres = args.out;
    volatile LAS unsigned* MISC = (volatile LAS unsigned*)(F.lds + MISC_OFF);
    for (int u = threadIdx.x; u < (LDS_BYTES - LDSCTL_OFF) / 4; u += NTHR) ((LAS unsigned*)(F.lds + LDSCTL_OFF))[u] = 0u;
    __syncthreads();
    const int lo = args.ph_lo, hi = args.ph_hi;
    unsigned* barw = (unsigned*)(F.ws + WS_CTL) + CW_BAR + args.bar_region * XCD_BAR_WORDS;
    XcdBarrier bar; bar.bar = barw; bar.x = 0; bar.st = nullptr;
    if (hi - lo > 1) bar = xcd_barrier_post(barw, MISC + 8);
#ifndef ONLY_K
#define ONLY_K -1
#endif
#define EN(kind) (ONLY_K < 0 || ONLY_K == (kind))
#define IN(k) (lo <= (k) && (k) < hi)
#define SEAM(k) do { if (IN(k) && IN((k) + 1)) xcd_barrier(bar); } while (0)
    const int cid0 = (int)blockIdx.x; const int cid = cid0;
    if (EN(100) && IN(0)) { asm volatile("; PHASE_MARK P0"); ph_rows0(F); } SEAM(0);
    if (EN(101) && IN(1)) { asm volatile("; PHASE_MARK P1"); ph_convert(F); } SEAM(1);
    if (EN(102) && IN(2)) { asm volatile("; PHASE_MARK P2");
        SchedKV S; S.o.init(NL * 4, 8, F.G, cid); S.MEMN = (const char*)(F.ws + WS_MEMN); S.WKVT = (const char*)(F.ws + WS_WKVT);
        pg8::EpiStore<3> E{(bf16*)(F.ws + WS_KVM), 2 * D, nullptr, 1.0f};
        pg8::gemm_phase<pg8::EpiStore<3>, SchedKV, true, false>(F.lds, F.wave, D, D, D, S, E);
    } SEAM(2);
    if (EN(103) && IN(3)) { asm volatile("; PHASE_MARK P3a");
        SchedQK S; S.o.init(NL * 16, 4, F.G, cid); S.KVM = (const char*)(F.ws + WS_KVM); S.WQB = (const char*)(F.ws + WS_WQB);
        pg8::EpiStore<1> E{(bf16*)(F.ws + WS_QKT), D, F.in[11], XQSCALE};
        int la = 2 * D, lb = D, kk = 256; asm volatile("" : "+s"(la), "+s"(lb), "+s"(kk));
        pg8::gemm_phase<pg8::EpiStore<1>, SchedQK, true, false>(F.lds, F.wave, la, lb, kk, S, E);
    }
    if (EN(104) && IN(3)) { asm volatile("; PHASE_MARK P3b");
        SchedVO S; S.o.init(NL * 64, 1, F.G, cid); S.KVM = (const char*)(F.ws + WS_KVM); S.WOT = (const char*)(F.ws + WS_WOT);
        pg8::EpiStore<2> E{(bf16*)(F.ws + WS_VOT), D, nullptr, 1.0f};
        int la = D, lb = 2 * D, kk = 256; asm volatile("" : "+s"(la), "+s"(lb), "+s"(kk));
        pg8::gemm_phase<pg8::EpiStore<2>, SchedVO, true, false>(F.lds, F.wave, la, lb, kk, S, E);
    } SEAM(3);
    for (int l = 0; l < NL; ++l) {
        const int pb = PH_LAYER0 + PH_PER_LAYER * l;
        int cid = cid0; asm volatile("" : "+s"(cid));
        if (EN(0) && IN(pb + 0)) { asm volatile("; PHASE_MARK L0");
            SchedDense S; S.o.init(T / 256, 7, F.G, cid); S.A = (const char*)(F.ws + WS_HB); S.a_tile = 256 * D * 2; S.B = (const char*)(F.ws + WS_WIN) + (size_t)l * INW * D * 2; S.b_tile = 256 * D * 2; S.b_batch = 0; S.bdiv = 1; S.bmod = 1;
            pg8::EpiIn E{(bf16*)(F.ws + WS_UACT), (bf16*)(F.ws + WS_VACT), (bf16*)(F.ws + WS_Q), (bf16*)(F.ws + WS_K), (bf16*)(F.ws + WS_V), (float*)(F.ws + WS_VSTAT),
                         F.in[7] + (size_t)l * 64, F.in[8] + (size_t)l * 64, (const float*)(F.ws + WS_ROPE), (const float*)(F.ws + WS_ROPE) + SEQ * 32};
            pg8::gemm_phase<pg8::EpiIn, SchedDense, true, false>(F.lds, F.wave, D, D, D, S, E);
        } SEAM(pb + 0);
        if (EN(1) && IN(pb + 1)) { asm volatile("; PHASE_MARK L1");
            for (int it = 0; ; ++it) { const int w = it * F.G + F.vcu; if (w >= NB_ * 8 * (SEQ / 256)) break;
                const int i = w >> 8, c = w & 255, x = c >> 5, j = c & 31;
                attn_body::attn_unit<8>(x >> 1, (x & 1) * 4 + i, j, (const attn_body::bf16*)(F.ws + WS_Q), (const attn_body::bf16*)(F.ws + WS_K), (const attn_body::bf16*)(F.ws + WS_V),
                                        (attn_body::bf16*)(F.ws + WS_MERGED), (float*)(F.ws + WS_ATSTAT), (char*)lds, F.wave); }
            ph_gmlp(F, l); } SEAM(pb + 1);
        if (EN(2) && IN(pb + 2)) { asm volatile("; PHASE_MARK L2");
            SchedDense S; S.o.init(T / 256, 4, F.G, cid); S.A = (const char*)(F.ws + WS_MERGED); S.a_tile = 256 * D * 2; S.B = (const char*)(F.ws + WS_WOUT) + (size_t)l * D * D * 2; S.b_tile = 256 * D * 2; S.b_batch = 0; S.bdiv = 1; S.bmod = 1;
            pg8::EpiX<true, true> E; E.base = l == 0 ? F.in[0] : F.xres; E.out = F.xres; E.xb = (bf16*)(F.ws + WS_XB); E.xstat = (float*)(F.ws + WS_XSTAT); E.gmstat = (const float*)(F.ws + WS_GMSTAT); E.atstat = (const float*)(F.ws + WS_ATSTAT); E.lds = F.lds;
            pg8::gemm_phase<pg8::EpiX<true, true>, SchedDense, true, false>(F.lds, F.wave, D, D, D, S, E);
        } SEAM(pb + 2);
        if (EN(3) && IN(pb + 3)) { asm volatile("; PHASE_MARK L3");
            SchedDense S; S.o.init(T / 256, 4, F.G, cid); S.A = (const char*)(F.ws + WS_XB); S.a_tile = 256 * D * 2; S.B = (const char*)(F.ws + WS_QKT) + (size_t)l * NB_ * D * D * 2; S.b_tile = 256 * D * 2; S.b_batch = (size_t)D * D * 2; S.bdiv = SEQ / 256; S.bmod = NB_;
            pg8::EpiS E{(const float*)(F.ws + WS_XSTAT), (bf16*)(F.ws + WS_P), F.lds};
            pg8::gemm_phase<pg8::EpiS, SchedDense, true, false>(F.lds, F.wave, D, D, D, S, E);
        } SEAM(pb + 3);
        if (EN(4) && IN(pb + 4)) { asm volatile("; PHASE_MARK L4");
            SchedDense S; S.o.init(T / 256, 4, F.G, cid); S.A = (const char*)(F.ws + WS_P); S.a_tile = 256 * D * 2; S.B = (const char*)(F.ws + WS_VOT) + (size_t)l * NB_ * D * D * 2; S.b_tile = 256 * D * 2; S.b_batch = (size_t)D * D * 2; S.bdiv = SEQ / 256; S.bmod = NB_;
            pg8::EpiX<false, false> E; E.base = F.xres; E.out = F.xres; E.xb = nullptr; E.xstat = nullptr; E.gmstat = nullptr; E.atstat = nullptr; E.lds = F.lds;
            pg8::gemm_phase<pg8::EpiX<false, false>, SchedDense, true, false>(F.lds, F.wave, D, D, D, S, E);
        } SEAM(pb + 4);
        if (EN(5) && IN(pb + 5)) { asm volatile("; PHASE_MARK L5"); ph_router(F, l); } SEAM(pb + 5);
        if (EN(6) && IN(pb + 6)) { asm volatile("; PHASE_MARK L6"); ph_topk(F); } SEAM(pb + 6);
        if (EN(7) && IN(pb + 7)) { asm volatile("; PHASE_MARK L7");
            SchedE1 S; S.o.init(NB_ * NE * 4, 8, F.G, cid); S.HBp = (const char*)(F.ws + WS_HB); S.IDX = (const int*)(F.ws + WS_IDX); S.WGU = (const char*)(F.ws + WS_WGU) + (size_t)l * NE * 2 * FF * D * 2;
            pg8::EpiH E{(bf16*)(F.ws + WS_H)};
            pg8::gemm_phase<pg8::EpiH, SchedE1, true, true>(F.lds, F.wave, D, D, D, S, E);
        } SEAM(pb + 7);
        if (EN(8) && IN(pb + 8)) { asm volatile("; PHASE_MARK L8");
            SchedDense S; S.o.init(NB_ * NE * 4, 4, F.G, cid); S.A = (const char*)(F.ws + WS_H); S.a_tile = 256 * FF * 2; S.B = (const char*)(F.ws + WS_WD) + (size_t)l * NE * D * FF * 2; S.b_tile = 256 * FF * 2; S.b_batch = (size_t)D * FF * 2; S.bdiv = 4; S.bmod = NE;
            pg8::EpiStore<0> E{(bf16*)(F.ws + WS_Y), D, nullptr, 1.0f};
            pg8::gemm_phase<pg8::EpiStore<0>, SchedDense, true, false>(F.lds, F.wave, FF, FF, FF, S, E);
        } SEAM(pb + 8);
        if (EN(9) && IN(pb + 9)) { asm volatile("; PHASE_MARK L9"); ph_combine(F, l); } SEAM(pb + 9);
    }
#undef IN
#undef SEAM
}

template <int NB, class AF>
__device__ __forceinline__ void ngemm_tile(const bf16* A, int lda, const int* aidx, int arow_base, int m0, const float* W0, const float* W1, int ldw, int n0, int K,
                                           float (&acc)[NB][4][4], float* sA, float* sB, const AF& af) {
    const int tid = threadIdx.x, tx = tid & 15, ty = tid >> 4;
    const int lr = tid >> 2, k4 = (tid & 3) * 4;
    const int arow = arow_base + (aidx ? aidx[m0 + lr] : (m0 + lr));
    const int bk = tid >> 4, bn = (tid & 15) * 4;
#pragma unroll
    for (int b = 0; b < NB; ++b)
#pragma unroll
        for (int i = 0; i < 4; ++i)
#pragma unroll
            for (int j = 0; j < 4; ++j) acc[b][i][j] = 0.f;
    for (int k0 = 0; k0 < K; k0 += 16) {
        const v2u raw = *(const v2u*)(A + (size_t)arow * lda + k0 + k4);
        sA[(k4 + 0) * 68 + lr] = af(lr, k0 + k4 + 0, bflo(raw.x)); sA[(k4 + 1) * 68 + lr] = af(lr, k0 + k4 + 1, bfhi(raw.x));
        sA[(k4 + 2) * 68 + lr] = af(lr, k0 + k4 + 2, bflo(raw.y)); sA[(k4 + 3) * 68 + lr] = af(lr, k0 + k4 + 3, bfhi(raw.y));
        *(f32x4*)(sB + bk * 64 + bn) = *(const f32x4*)(W0 + (size_t)(k0 + bk) * ldw + n0 + bn);
        if (NB == 2) *(f32x4*)(sB + 1024 + bk * 64 + bn) = *(const f32x4*)(W1 + (size_t)(k0 + bk) * ldw + n0 + bn);
        __syncthreads();
#pragma unroll
        for (int kk = 0; kk < 16; ++kk) {
            const f32x4 a = *(const f32x4*)(sA + kk * 68 + ty * 4);
#pragma unroll
            for (int b = 0; b < NB; ++b) { const f32x4 w = *(const f32x4*)(sB + b * 1024 + kk * 64 + tx * 4);
#pragma unroll
                for (int i = 0; i < 4; ++i) { acc[b][i][0] += a[i] * w.x; acc[b][i][1] += a[i] * w.y; acc[b][i][2] += a[i] * w.z; acc[b][i][3] += a[i] * w.w; } }
        }
        __syncthreads();
    }
}
__device__ __forceinline__ float sum16(float v) { v += __shfl_xor(v, 1); v += __shfl_xor(v, 2); v += __shfl_xor(v, 4); v += __shfl_xor(v, 8); return v; }
__device__ __forceinline__ float max16(float v) { v = fmaxf(v, __shfl_xor(v, 1)); v = fmaxf(v, __shfl_xor(v, 2)); v = fmaxf(v, __shfl_xor(v, 4)); v = fmaxf(v, __shfl_xor(v, 8)); return v; }
struct AfGain { const float* g; __device__ __forceinline__ float operator()(int, int k, float a) const { return a * g[k]; } };
struct AfNone { __device__ __forceinline__ float operator()(int, int, float a) const { return a; } };
struct AfRowGain { const float* rs; const float* g; __device__ __forceinline__ float operator()(int r, int k, float a) const { return a * rs[r] * g[k]; } };
struct AfMerged { const float* rgm; const float* rat; const float* g; __device__ __forceinline__ float operator()(int r, int k, float a) const { return a * g[k] * (k < 512 ? rgm[r] : rat[r]); } };

__global__ void __launch_bounds__(256) nk_inproj(Args args, int l) {
    __shared__ float sA[16 * 68]; __shared__ float sB[1024];
    const int nt = blockIdx.x, m0 = blockIdx.y * 64, tid = threadIdx.x, tx = tid & 15, ty = tid >> 4;
    unsigned char* ws = args.ws;
    float acc[1][4][4];
    AfGain af{args.in[2] + (size_t)l * D};
    ngemm_tile<1>((const bf16*)(ws + WS_HB), D, nullptr, 0, m0, args.in[3] + (size_t)l * D * INW, nullptr, INW, nt * 64, D, acc, sA, sB, af);
    const float* COS = (const float*)(ws + WS_ROPE); const float* SIN = COS + SEQ * 32;
#pragma unroll
    for (int i = 0; i < 4; ++i) {
        const int row = m0 + ty * 4 + i; float v[4];
#pragma unroll
        for (int j = 0; j < 4; ++j) v[j] = acc[0][i][j];
        if (nt < 16) {
#pragma unroll
            for (int j = 0; j < 4; ++j) v[j] = gelu_tanh(v[j]);
            v2u o; o.x = pk2(v[0], v[1]); o.y = pk2(v[2], v[3]);
            if (nt < 8) *(v2u*)((bf16*)(ws + WS_UACT) + (size_t)row * GMW + nt * 64 + tx * 4) = o;
            else {
                *(v2u*)((bf16*)(ws + WS_VACT) + (size_t)row * GMW + (nt - 8) * 64 + tx * 4) = o;
                const float a = bflo(o.x), b = bfhi(o.x), c = bflo(o.y), d = bfhi(o.y);
                const float s = sum16((a * a + b * b) + (c * c + d * d));
                if (tx == 0) ((float*)(ws + WS_VSTAT))[(size_t)row * 8 + (nt - 8)] = s;
            }
        } else if (nt < 26) {
            const bool isq = nt < 24; const float* g = (isq ? args.in[7] : args.in[8]) + (size_t)l * 64;
            const float s = sum16((v[0] * v[0] + v[1] * v[1]) + (v[2] * v[2] + v[3] * v[3]));
            const float rinv = 1.0f / sqrtf(s * (1.0f / 64.0f) + EPS);
#pragma unroll
            for (int j = 0; j < 4; ++j) v[j] = v[j] * rinv * g[tx * 4 + j];
            const int t = row % SEQ; float o4[4];
#pragma unroll
            for (int pp = 0; pp < 2; ++pp) { const int p = tx * 2 + pp; const float c = COS[t * 32 + p], sn = SIN[t * 32 + p];
                o4[2 * pp] = v[2 * pp] * c - v[2 * pp + 1] * sn; o4[2 * pp + 1] = v[2 * pp] * sn + v[2 * pp + 1] * c; }
            const float sc = isq ? QSCALE : 1.0f;
            v2u o; o.x = pk2(o4[0] * sc, o4[1] * sc); o.y = pk2(o4[2] * sc, o4[3] * sc);
            if (isq) *(v2u*)((bf16*)(ws + WS_Q) + (size_t)row * 512 + (nt - 16) * 64 + tx * 4) = o;
            else *(v2u*)((bf16*)(ws + WS_K) + (size_t)row * 128 + (nt - 24) * 64 + tx * 4) = o;
        } else {
            v2u o; o.x = pk2(v[0], v[1]); o.y = pk2(v[2], v[3]);
            *(v2u*)((bf16*)(ws + WS_V) + (size_t)row * 128 + (nt - 26) * 64 + tx * 4) = o;
        }
    }
}

__global__ void __launch_bounds__(256) nk_attn(Args args) {
    __shared__ float sQt[64 * 68]; __shared__ float sKt[64 * 68]; __shared__ float sV[64 * 68];
    const int qb = blockIdx.x, h = blockIdx.y, b = blockIdx.z, tid = threadIdx.x, tx = tid & 15, ty = tid >> 4;
    unsigned char* ws = args.ws;
    const bf16* Q = (const bf16*)(ws + WS_Q); const bf16* Kp = (const bf16*)(ws + WS_K); const bf16* Vp = (const bf16*)(ws + WS_V);
    const int kvh = h >> 2; const size_t rb = (size_t)b * SEQ;
    const int lr = tid >> 2, d16 = (tid & 3) * 16;
    {   const bf16* src = Q + (rb + qb * 64 + lr) * 512 + h * 64 + d16;
        const v4u r0 = *(const v4u*)src, r1 = *(const v4u*)(src + 8);
        const unsigned w[8] = {r0.x, r0.y, r0.z, r0.w, r1.x, r1.y, r1.z, r1.w};
#pragma unroll
        for (int q = 0; q < 8; ++q) { sQt[(d16 + 2 * q) * 68 + lr] = bflo(w[q]); sQt[(d16 + 2 * q + 1) * 68 + lr] = bfhi(w[q]); } }
    float o[4][4], mrow[4], lrow[4];
#pragma unroll
    for (int i = 0; i < 4; ++i) { mrow[i] = -1e30f; lrow[i] = 0.f;
#pragma unroll
        for (int j = 0; j < 4; ++j) o[i][j] = 0.f; }
    for (int kt = 0; kt < SEQ / 64; ++kt) {
        __syncthreads();
        {   const bf16* ks = Kp + (rb + kt * 64 + lr) * 128 + kvh * 64 + d16; const bf16* vs = Vp + (rb + kt * 64 + lr) * 128 + kvh * 64 + d16;
            const v4u r0 = *(const v4u*)ks, r1 = *(const v4u*)(ks + 8), s0 = *(const v4u*)vs, s1 = *(const v4u*)(vs + 8);
            const unsigned w[8] = {r0.x, r0.y, r0.z, r0.w, r1.x, r1.y, r1.z, r1.w}; const unsigned x[8] = {s0.x, s0.y, s0.z, s0.w, s1.x, s1.y, s1.z, s1.w};
#pragma unroll
            for (int q = 0; q < 8; ++q) { sKt[(d16 + 2 * q) * 68 + lr] = bflo(w[q]); sKt[(d16 + 2 * q + 1) * 68 + lr] = bfhi(w[q]);
                sV[lr * 68 + d16 + 2 * q] = bflo(x[q]); sV[lr * 68 + d16 + 2 * q + 1] = bfhi(x[q]); } }
        __syncthreads();
        float s[4][4];
#pragma unroll
        for (int i = 0; i < 4; ++i)
#pragma unroll
            for (int j = 0; j < 4; ++j) s[i][j] = 0.f;
#pragma unroll 8
        for (int d = 0; d < 64; ++d) { const f32x4 a = *(const f32x4*)(sQt + d * 68 + ty * 4), k = *(const f32x4*)(sKt + d * 68 + tx * 4);
#pragma unroll
            for (int i = 0; i < 4; ++i) { s[i][0] += a[i] * k.x; s[i][1] += a[i] * k.y; s[i][2] += a[i] * k.z; s[i][3] += a[i] * k.w; } }
        __syncthreads();
#pragma unroll
        for (int i = 0; i < 4; ++i) {
            const float mx = max16(fmaxf(fmaxf(s[i][0], s[i][1]), fmaxf(s[i][2], s[i][3])));
            const float mn = fmaxf(mrow[i], mx), f = __builtin_amdgcn_exp2f(mrow[i] - mn); mrow[i] = mn;
            float ps = 0.f;
#pragma unroll
            for (int j = 0; j < 4; ++j) { const float p = __builtin_amdgcn_exp2f(s[i][j] - mn); ps += p; sKt[(tx * 4 + j) * 68 + ty * 4 + i] = p; }
            lrow[i] = lrow[i] * f + sum16(ps);
#pragma unroll
            for (int j = 0; j < 4; ++j) o[i][j] *= f;
        }
        __syncthreads();
#pragma unroll 8
        for (int k = 0; k < 64; ++k) { const f32x4 p = *(const f32x4*)(sKt + k * 68 + ty * 4), v = *(const f32x4*)(sV + k * 68 + tx * 4);
#pragma unroll
            for (int i = 0; i < 4; ++i) { o[i][0] += p[i] * v.x; o[i][1] += p[i] * v.y; o[i][2] += p[i] * v.z; o[i][3] += p[i] * v.w; } }
    }
    bf16* MERGED = (bf16*)(ws + WS_MERGED); float* ATSTAT = (float*)(ws + WS_ATSTAT);
#pragma unroll
    for (int i = 0; i < 4; ++i) {
        const size_t row = rb + qb * 64 + ty * 4 + i; const float rl = 1.0f / lrow[i];
        v2u w; w.x = pk2(o[i][0] * rl, o[i][1] * rl); w.y = pk2(o[i][2] * rl, o[i][3] * rl);
        *(v2u*)(MERGED + row * 1024 + 512 + h * 64 + tx * 4) = w;
        const float a = bflo(w.x), b2 = bfhi(w.x), c = bflo(w.y), d = bfhi(w.y);
        const float ss = sum16((a * a + b2 * b2) + (c * c + d * d));
        if (tx == 0) ATSTAT[row * 8 + h] = ss;
    }
}

__global__ void __launch_bounds__(256) nk_outproj(Args args, int l) {
    __shared__ float sA[16 * 68]; __shared__ float sB[1024]; __shared__ float rgm[64]; __shared__ float rat[64]; __shared__ float gg[1024];
    const int nt = blockIdx.x, m0 = blockIdx.y * 64, tid = threadIdx.x, tx = tid & 15, ty = tid >> 4;
    unsigned char* ws = args.ws;
    if (tid < 64) { const float* gs = (const float*)(ws + WS_GMSTAT) + (size_t)(m0 + tid) * 4; const float* as = (const float*)(ws + WS_ATSTAT) + (size_t)(m0 + tid) * 8;
        float a = 0.f, b = 0.f; for (int q = 0; q < 4; ++q) a += gs[q]; for (int q = 0; q < 8; ++q) b += as[q];
        rgm[tid] = 1.0f / sqrtf(a * (1.0f / 512.0f) + EPS); rat[tid] = 1.0f / sqrtf(b * (1.0f / 512.0f) + EPS); }
    for (int i = tid; i < 1024; i += 256) gg[i] = args.in[9][(size_t)l * 1024 + i];
    __syncthreads();
    float acc[1][4][4];
    AfMerged af{rgm, rat, gg};
    ngemm_tile<1>((const bf16*)(ws + WS_MERGED), 1024, nullptr, 0, m0, args.in[10] + (size_t)l * D * D, nullptr, D, nt * 64, D, acc, sA, sB, af);
    const float* base = l == 0 ? args.in[0] : args.out;
#pragma unroll
    for (int i = 0; i < 4; ++i) {
        const size_t row = m0 + ty * 4 + i; const size_t off = row * D + nt * 64 + tx * 4;
        const f32x4 bs = *(const f32x4*)(base + off);
        const f32x4 xn = (f32x4){bs.x + acc[0][i][0], bs.y + acc[0][i][1], bs.z + acc[0][i][2], bs.w + acc[0][i][3]};
        *(f32x4*)(args.out + off) = xn;
        v2u o; o.x = pk2(xn.x, xn.y); o.y = pk2(xn.z, xn.w); *(v2u*)((bf16*)(ws + WS_XB) + off) = o;
        const float s = sum16((xn.x * xn.x + xn.y * xn.y) + (xn.z * xn.z + xn.w * xn.w));
        if (tx == 0) ((float*)(ws + WS_XSTAT))[row * 16 + nt] = s;
    }
}

__global__ void __launch_bounds__(256) nk_xq(Args args, int l) {
    __shared__ float sA[16 * 68]; __shared__ float sB[1024]; __shared__ float rs[64];
    const int nt = blockIdx.x, m0 = blockIdx.y * 64, tid = threadIdx.x, tx = tid & 15, ty = tid >> 4;
    unsigned char* ws = args.ws;
    if (tid < 64) { const float* xs = (const float*)(ws + WS_XSTAT) + (size_t)(m0 + tid) * 16; float a = 0.f; for (int q = 0; q < 16; ++q) a += xs[q]; rs[tid] = 1.0f / sqrtf(a * (1.0f / D) + EPS); }
    __syncthreads();
    float acc[1][4][4];
    AfRowGain af{rs, args.in[11] + (size_t)l * D};
    ngemm_tile<1>((const bf16*)(ws + WS_XB), D, nullptr, 0, m0, args.in[13] + (size_t)l * D * D, nullptr, D, nt * 64, D, acc, sA, sB, af);
#pragma unroll
    for (int i = 0; i < 4; ++i) { const size_t off = (size_t)(m0 + ty * 4 + i) * D + nt * 64 + tx * 4;
        v2u o; o.x = pk2(acc[0][i][0] * XQSCALE, acc[0][i][1] * XQSCALE); o.y = pk2(acc[0][i][2] * XQSCALE, acc[0][i][3] * XQSCALE); *(v2u*)((bf16*)(ws + WS_Q2) + off) = o; }
}
__global__ void __launch_bounds__(256) nk_xkv(Args args, int l) {
    __shared__ float sA[16 * 68]; __shared__ float sB[1024];
    const int nt = blockIdx.x, m0 = blockIdx.y * 64, tid = threadIdx.x, tx = tid & 15, ty = tid >> 4;
    unsigned char* ws = args.ws;
    float acc[1][4][4]; AfNone af;
    ngemm_tile<1>((const bf16*)(ws + WS_MEMN), D, nullptr, 0, m0, args.in[14] + (size_t)l * D * 2 * D, nullptr, 2 * D, nt * 64, D, acc, sA, sB, af);
#pragma unroll
    for (int i = 0; i < 4; ++i) { const size_t off = (size_t)(m0 + ty * 4 + i) * 2 * D + nt * 64 + tx * 4;
        v2u o; o.x = pk2(acc[0][i][0], acc[0][i][1]); o.y = pk2(acc[0][i][2], acc[0][i][3]); *(v2u*)((bf16*)(ws + WS_KVN) + off) = o; }
}
__global__ void __launch_bounds__(256) nk_xattn(Args args) {
    __shared__ float sq[8 * 256]; __shared__ float sp[8 * 256];
    const int r0 = blockIdx.x * 8, h = blockIdx.y, tid = threadIdx.x, lane = tid & 63, wv = tid >> 6;
    unsigned char* ws = args.ws; const int b = r0 / SEQ;
    const bf16* Q2 = (const bf16*)(ws + WS_Q2); const bf16* KVN = (const bf16*)(ws + WS_KVN);
    for (int i = tid; i < 8 * 256; i += 256) sq[i] = bf2f(Q2[(size_t)(r0 + (i >> 8)) * D + h * 256 + (i & 255)]);
    __syncthreads();
    {   const bf16* kr = KVN + (size_t)(b * MEML + tid) * 2 * D + h * 256;
        float sc[8];
#pragma unroll
        for (int r = 0; r < 8; ++r) sc[r] = 0.f;
        for (int d = 0; d < 256; d += 8) { const v4u w = *(const v4u*)(kr + d);
            const float kv[8] = {bflo(w.x), bfhi(w.x), bflo(w.y), bfhi(w.y), bflo(w.z), bfhi(w.z), bflo(w.w), bfhi(w.w)};
#pragma unroll
            for (int r = 0; r < 8; ++r) {
#pragma unroll
                for (int q = 0; q < 8; ++q) sc[r] += sq[r * 256 + d + q] * kv[q]; } }
#pragma unroll
        for (int r = 0; r < 8; ++r) sp[r * 256 + tid] = sc[r]; }
    __syncthreads();
#pragma unroll
    for (int rr = 0; rr < 2; ++rr) { const int r = wv * 2 + rr;
        float v[4]; float mx = -1e30f;
#pragma unroll
        for (int q = 0; q < 4; ++q) { v[q] = sp[r * 256 + lane + 64 * q]; mx = fmaxf(mx, v[q]); }
#pragma unroll
        for (int o = 1; o < 64; o <<= 1) mx = fmaxf(mx, __shfl_xor(mx, o));
        float sm = 0.f;
#pragma unroll
        for (int q = 0; q < 4; ++q) { v[q] = __builtin_amdgcn_exp2f(v[q] - mx); sm += v[q]; }
        sm = wave_sum(sm); const float rinv = 1.0f / sm;
#pragma unroll
        for (int q = 0; q < 4; ++q) sp[r * 256 + lane + 64 * q] = v[q] * rinv; }
    __syncthreads();
    {   float o[8];
#pragma unroll
        for (int r = 0; r < 8; ++r) o[r] = 0.f;
        const bf16* vr = KVN + (size_t)(b * MEML) * 2 * D + D + h * 256 + tid;
        for (int m = 0; m < MEML; ++m) { const float v = bf2f(vr[(size_t)m * 2 * D]);
#pragma unroll
            for (int r = 0; r < 8; ++r) o[r] += sp[r * 256 + m] * v; }
#pragma unroll
        for (int r = 0; r < 8; ++r) ((bf16*)(ws + WS_O2))[(size_t)(r0 + r) * D + h * 256 + tid] = (bf16)f2bf(o[r]); }
}
__global__ void __launch_bounds__(256) nk_xo(Args args, int l) {
    __shared__ float sA[16 * 68]; __shared__ float sB[1024];
    const int nt = blockIdx.x, m0 = blockIdx.y * 64, tid = threadIdx.x, tx = tid & 15, ty = tid >> 4;
    unsigned char* ws = args.ws;
    float acc[1][4][4]; AfNone af;
    ngemm_tile<1>((const bf16*)(ws + WS_O2), D, nullptr, 0, m0, args.in[15] + (size_t)l * D * D, nullptr, D, nt * 64, D, acc, sA, sB, af);
#pragma unroll
    for (int i = 0; i < 4; ++i) { const size_t off = (size_t)(m0 + ty * 4 + i) * D + nt * 64 + tx * 4;
        const f32x4 bs = *(const f32x4*)(args.out + off);
        *(f32x4*)(args.out + off) = (f32x4){bs.x + acc[0][i][0], bs.y + acc[0][i][1], bs.z + acc[0][i][2], bs.w + acc[0][i][3]}; }
}
__global__ void __launch_bounds__(256) nk_moe1(Args args, int l) {
    __shared__ float sA[16 * 68]; __shared__ float sB[2048];
    const int nt = blockIdx.x, m0 = blockIdx.y * 64, z = blockIdx.z, b = z >> 4, e = z & 15, tid = threadIdx.x, tx = tid & 15, ty = tid >> 4;
    unsigned char* ws = args.ws;
    float acc[2][4][4];
    AfGain af{args.in[16] + (size_t)l * D};
    const size_t wo = ((size_t)l * NE + e) * D * FF;
    ngemm_tile<2>((const bf16*)(ws + WS_HB), D, (const int*)(ws + WS_IDX) + (size_t)z * CAP, b * SEQ, m0, args.in[18] + wo, args.in[19] + wo, FF, nt * 64, D, acc, sA, sB, af);
#pragma unroll
    for (int i = 0; i < 4; ++i) { const size_t off = ((size_t)z * CAP + m0 + ty * 4 + i) * FF + nt * 64 + tx * 4;
        float hv[4];
#pragma unroll
        for (int j = 0; j < 4; ++j) hv[j] = silu_f(acc[0][i][j]) * acc[1][i][j];
        v2u o; o.x = pk2(hv[0], hv[1]); o.y = pk2(hv[2], hv[3]); *(v2u*)((bf16*)(ws + WS_H) + off) = o; }
}
__global__ void __launch_bounds__(256) nk_moe2(Args args, int l) {
    __shared__ float sA[16 * 68]; __shared__ float sB[1024];
    const int nt = blockIdx.x, m0 = blockIdx.y * 64, z = blockIdx.z, e = z & 15, tid = threadIdx.x, tx = tid & 15, ty = tid >> 4;
    unsigned char* ws = args.ws;
    float acc[1][4][4]; AfNone af;
    ngemm_tile<1>((const bf16*)(ws + WS_H) + (size_t)z * CAP * FF, FF, nullptr, 0, m0, args.in[20] + ((size_t)l * NE + e) * FF * D, nullptr, D, nt * 64, FF, acc, sA, sB, af);
#pragma unroll
    for (int i = 0; i < 4; ++i) { const size_t off = ((size_t)z * CAP + m0 + ty * 4 + i) * D + nt * 64 + tx * 4;
        v2u o; o.x = pk2(acc[0][i][0], acc[0][i][1]); o.y = pk2(acc[0][i][2], acc[0][i][3]); *(v2u*)((bf16*)(ws + WS_Y) + off) = o; }
}

static int g_grid = 0;
static void launch_mega(Args a, int lo, int hi, int region, hipStream_t stream) {
    a.ph_lo = lo; a.ph_hi = hi; a.bar_region = region; a.pad = 0;
    hipLaunchKernelGGL(mega, dim3(g_grid), dim3(NTHR), LDS_BYTES, stream, a);
}
extern "C" void kernel_launch(void* const* d_in, const int* in_sizes, int n_in, void* d_out, int out_size, void* d_ws, size_t ws_size, hipStream_t stream) {
    if (g_grid == 0) {
        if (n_in != 22 || out_size != T * D || ws_size < WS_END) { fprintf(stderr, "kernel_launch: unexpected sizes n_in %d out %d ws %zu\n", n_in, out_size, ws_size); g_grid = -1; return; }
        int dev = 0, cus = 0;
        if (hipGetDevice(&dev) != hipSuccess || hipDeviceGetAttribute(&cus, hipDeviceAttributeMultiprocessorCount, dev) != hipSuccess) { g_grid = -1; return; }
        if (hipFuncSetAttribute((const void*)mega, hipFuncAttributeMaxDynamicSharedMemorySize, LDS_BYTES) != hipSuccess) { g_grid = -1; return; }
        int per_cu = 0;
        if (hipOccupancyMaxActiveBlocksPerMultiprocessor(&per_cu, (const void*)mega, NTHR, LDS_BYTES) != hipSuccess || per_cu < 1) fprintf(stderr, "kernel_launch: occupancy query says %d\n", per_cu);
        (void)hipGetLastError();
        g_grid = cus;
    }
    if (g_grid < 0) return;
    hipMemsetAsync((char*)d_ws + WS_CTL, 0, CTL_ZERO_BYTES, stream);
    Args a{};
    for (int i = 0; i < 22; ++i) a.in[i] = (const float*)d_in[i];
    a.out = (float*)d_out; a.ws = (unsigned char*)d_ws;
    static const bool MEGA_KIND[10] = {true, true, true, true, true, true, true, true, true, true};
    const bool NAIVE_ATTN = false, NEED_WEIGHTS = true, NEED_XPRE = true;
    const bool ONE_LAUNCH = true;
    if (ONE_LAUNCH) { launch_mega(a, 0, PH_END, 0, stream); return; }
    int region = 0;
    launch_mega(a, 0, NEED_XPRE ? 4 : (NEED_WEIGHTS ? 2 : 1), region++, stream);
    for (int l = 0; l < NL; ++l) {
        const int pb = PH_LAYER0 + PH_PER_LAYER * l;
        int k = 0;
        while (k < 10) {
            if (MEGA_KIND[k] && !(k == 1 && NAIVE_ATTN)) { int k2 = k; while (k2 < 10 && MEGA_KIND[k2] && !(k2 == 1 && NAIVE_ATTN)) ++k2; launch_mega(a, pb + k, pb + k2, region++, stream); k = k2; continue; }
            if (k == 0) hipLaunchKernelGGL(nk_inproj, dim3(28, T / 64), dim3(256), 0, stream, a, l);
            else if (k == 1) { hipLaunchKernelGGL(nk_attn, dim3(SEQ / 64, 8, NB_), dim3(256), 0, stream, a); launch_mega(a, pb + 1, pb + 2, region++, stream); }
            else if (k == 2) hipLaunchKernelGGL(nk_outproj, dim3(16, T / 64), dim3(256), 0, stream, a, l);
            else if (k == 3) { hipLaunchKernelGGL(nk_xq, dim3(16, T / 64), dim3(256), 0, stream, a, l); hipLaunchKernelGGL(nk_xkv, dim3(32, 16), dim3(256), 0, stream, a, l);
                               hipLaunchKernelGGL(nk_xattn, dim3(T / 8, 4), dim3(256), 0, stream, a); hipLaunchKernelGGL(nk_xo, dim3(16, T / 64), dim3(256), 0, stream, a, l); ++k; }
            else if (k == 7) { hipLaunchKernelGGL(nk_moe1, dim3(16, 16, 64), dim3(256), 0, stream, a, l); }
            else if (k == 8) { hipLaunchKernelGGL(nk_moe2, dim3(16, 16, 64), dim3(256), 0, stream, a, l); }
            ++k;
        }
    }
}
```

```cpp
#include <hip/hip_runtime.h>
#include <hip/hip_bf16.h>
#include <cstdio>
#include <cstdint>
#include <cmath>

constexpr int NB_ = 4, SEQ = 8192, T = NB_ * SEQ, D = 1024, NL = 4;
constexpr int MEML = 256, NMEM = NB_ * MEML;
constexpr int INW = 1792, GMW = 512, NE = 16, CAP = 1024, FF = 1024;
constexpr float EPS = 1e-6f;
constexpr float LOG2E = 1.4426950408889634f;
constexpr float QSCALE = 0.125f * LOG2E;
constexpr float XQSCALE = 0.0625f * LOG2E;

constexpr size_t MiB = 1u << 20;
constexpr size_t WS_CTL = 0, CTL_ZERO_BYTES = 1 * MiB;
constexpr size_t WS_ROPE = 1 * MiB;
constexpr size_t WS_AFF = 3 * MiB;
constexpr size_t WS_INV = 5 * MiB;
constexpr size_t WS_IDX = 7 * MiB;
constexpr size_t WS_VSTAT = 8 * MiB;
constexpr size_t WS_ATSTAT = 9 * MiB;
constexpr size_t WS_GMSTAT = 10 * MiB;
constexpr size_t WS_XSTAT = 11 * MiB;
constexpr size_t WS_MEMN = 13 * MiB;
constexpr size_t WS_WSB = 15 * MiB;
constexpr size_t WS_WIN = 16 * MiB;
constexpr size_t WS_WOUT = 30 * MiB;
constexpr size_t WS_QKT = 38 * MiB;
constexpr size_t WS_VOT = 70 * MiB;
constexpr size_t WS_WGU = 102 * MiB;
constexpr size_t WS_WD = 358 * MiB;
constexpr size_t WS_HB = 486 * MiB;
constexpr size_t WS_R1 = 550 * MiB;
constexpr size_t WS_UACT = WS_R1, WS_VACT = WS_R1 + 32 * MiB, WS_Q = WS_R1 + 64 * MiB, WS_K = WS_R1 + 96 * MiB, WS_V = WS_R1 + 104 * MiB;
constexpr size_t WS_WQB = WS_R1, WS_WOT = WS_R1 + 8 * MiB, WS_WKVT = WS_R1 + 16 * MiB, WS_KVM = WS_R1 + 32 * MiB;
constexpr size_t WS_H = WS_R1;
constexpr size_t WS_MERGED = 678 * MiB;
constexpr size_t WS_XB = 742 * MiB;
constexpr size_t WS_P = WS_MERGED;
constexpr size_t WS_Y = 678 * MiB;
constexpr size_t WS_NSCR = 806 * MiB;
constexpr size_t WS_Q2 = WS_MERGED;
constexpr size_t WS_O2 = WS_NSCR;
constexpr size_t WS_KVN = WS_NSCR + 64 * MiB;
constexpr size_t WS_END = 1024 * MiB;

constexpr int CW_TMO = 0, CW_CODE = 1, CW_BAR = 4096;

#define GAS __attribute__((address_space(1)))
#define LAS __attribute__((address_space(3)))
typedef unsigned short bf16;
typedef unsigned v4u __attribute__((ext_vector_type(4)));
typedef unsigned v2u __attribute__((ext_vector_type(2)));
typedef float f32x4 __attribute__((ext_vector_type(4)));
typedef short bf16x8_t __attribute__((ext_vector_type(8)));
typedef GAS unsigned gu32;
#define RLX_AGENT __ATOMIC_RELAXED, __HIP_MEMORY_SCOPE_AGENT
__device__ __forceinline__ unsigned f2bf(float f) { unsigned u = __builtin_bit_cast(unsigned, f); return (u + 0x7fffu + ((u >> 16) & 1u)) >> 16; }
__device__ __forceinline__ unsigned pk2(float lo, float hi) { return f2bf(lo) | (f2bf(hi) << 16); }
__device__ __forceinline__ float bf2f(unsigned v) { return __builtin_bit_cast(float, v << 16); }
__device__ __forceinline__ float bflo(unsigned w) { return __builtin_bit_cast(float, w << 16); }
__device__ __forceinline__ float bfhi(unsigned w) { return __builtin_bit_cast(float, w & 0xffff0000u); }
__device__ __forceinline__ float rbf(float f) { return bf2f(f2bf(f)); }
__device__ __forceinline__ float gelu_tanh(float x) {
    const float z = 1.5957691216057308f * (x + 0.044715f * x * x * x);
    return x / (1.0f + __builtin_amdgcn_exp2f(-z * LOG2E));
}
__device__ __forceinline__ float silu_f(float a) { return a / (1.0f + __builtin_amdgcn_exp2f(-a * LOG2E)); }
__device__ __forceinline__ int lane_id() { return (int)__builtin_amdgcn_mbcnt_hi(~0u, __builtin_amdgcn_mbcnt_lo(~0u, 0u)); }
__device__ __forceinline__ float wave_sum(float v) {
#pragma unroll
    for (int o = 1; o < 64; o <<= 1) v += __shfl_xor(v, o);
    return v;
}

#define XB_TMO      128
#define XB_XCNT(j)  (256  + 64 * (j))
#define XB_XSUB(j)  (1280 + 64 * (j))
#define XB_XGEN(j)  (2304 + 64 * (j))
#define XB_TOP      3328
#define XB_TOPGEN   3392
#define XCD_BAR_WORDS 3456
#define XB_SPIN_CAP (1u << 18)
__device__ __forceinline__ unsigned xb_ld(unsigned* p)              { return __hip_atomic_load(p, __ATOMIC_RELAXED, __HIP_MEMORY_SCOPE_AGENT); }
__device__ __forceinline__ unsigned xb_add(unsigned* p, unsigned v) { return __hip_atomic_fetch_add(p, v, __ATOMIC_RELAXED, __HIP_MEMORY_SCOPE_AGENT); }
__device__ __forceinline__ unsigned xb_xcc_id() { return (unsigned)__builtin_amdgcn_s_getreg((3 << 11) | 20) & 0xFu; }
#define XB_SPIN(cond, bar) do { unsigned _sp = 0; while (cond) { __builtin_amdgcn_s_sleep(1); \
    if ((++_sp & 255u) == 0u) { if (xb_ld(&(bar)[XB_TMO])) break; if (_sp > XB_SPIN_CAP) { atomicAdd(&(bar)[XB_TMO], 1u); break; } } } } while (0)
struct XcdBarrier { unsigned* bar; unsigned x; volatile LAS unsigned* st; };
__device__ __forceinline__ XcdBarrier xcd_barrier_post(unsigned* bar, volatile LAS unsigned* st) {
    XcdBarrier b; b.bar = bar; b.x = xb_xcc_id(); b.st = st;
    if (threadIdx.x == 0) (void)xb_add(&bar[XB_XCNT(b.x)], 1u);
    return b;
}
__device__ __forceinline__ void xcd_barrier_complete(unsigned* bar, unsigned x, unsigned& nloc, unsigned& nx) {
    const unsigned G = gridDim.x * gridDim.y * gridDim.z;
    unsigned sum, cnt, mine, sp = 0u;
    for (;;) {
        sum = 0u; cnt = 0u; mine = 0u;
#pragma unroll
        for (unsigned j = 0; j < 16; ++j) { const unsigned c = xb_ld(&bar[XB_XCNT(j)]); sum += c; cnt += (c > 0u) ? 1u : 0u; mine = (j == x) ? c : mine; }
        if (sum == G) break;
        __builtin_amdgcn_s_sleep(1);
        if ((++sp & 255u) == 0u) { if (xb_ld(&bar[XB_TMO])) break; if (sp > XB_SPIN_CAP) { atomicAdd(&bar[XB_TMO], 1u); break; } }
    }
    nloc = mine > 0u ? mine : 1u; nx = cnt > 0u ? cnt : 1u;
}
__device__ __forceinline__ void xcd_barrier(const XcdBarrier& b) {
    asm volatile("s_waitcnt vmcnt(0)" ::: "memory");
    __syncthreads();
    if (threadIdx.x == 0) {
        unsigned* bar = b.bar;
        __builtin_amdgcn_s_waitcnt(0);
        unsigned nloc = b.st[0], nx = b.st[1];
        if (nloc == 0u) { xcd_barrier_complete(bar, b.x, nloc, nx); b.st[0] = nloc; b.st[1] = nx; }
        const unsigned old = xb_add(&bar[XB_XSUB(b.x)], 1u);
        const unsigned gen = old / nloc;
        if (old + 1u == (gen + 1u) * nloc) {
            __builtin_amdgcn_fence(__ATOMIC_RELEASE, "agent");
            asm volatile("s_waitcnt vmcnt(0)" ::: "memory");
            const unsigned og = xb_add(&bar[XB_TOP], 1u);
            const unsigned tg = og / nx;
            if (og + 1u == (tg + 1u) * nx) xb_add(&bar[XB_TOPGEN], 1u);
            else XB_SPIN(xb_ld(&bar[XB_TOPGEN]) == tg, bar);
            __builtin_amdgcn_fence(__ATOMIC_ACQUIRE, "agent");
            xb_add(&bar[XB_XGEN(b.x)], 1u);
            asm volatile("s_waitcnt vmcnt(0)" ::: "memory");
        } else {
            XB_SPIN(xb_ld(&bar[XB_XGEN(b.x)]) == gen, bar);
            __builtin_amdgcn_fence(__ATOMIC_ACQUIRE, "agent");
            asm volatile("s_waitcnt vmcnt(0)" ::: "memory");
        }
    }
    __syncthreads();
}

struct Args { const float* in[22]; float* out; unsigned char* ws; int ph_lo, ph_hi, bar_region, pad; };
constexpr int PH_LAYER0 = 4, PH_PER_LAYER = 10, PH_END = PH_LAYER0 + NL * PH_PER_LAYER;

constexpr int NWAVES = 8, NTHR = NWAVES * 64;
constexpr int RING_BYTES = 131072, LDSCTL_OFF = RING_BYTES, MISC_OFF = LDSCTL_OFF + 320;
constexpr int LDS_BYTES = 147456;

struct Frame {
    LAS unsigned char* lds;
    int wave, vcu, G;
    const float* in[22];
    unsigned char* ws;
    float* xres;
};

__device__ __forceinline__ void ph_rows0(Frame& F) {
    int lane_ = lane_id(); asm volatile("" : "+v"(lane_)); const int tid_ = F.wave * 64 + lane_;
    const int gw = F.vcu * NWAVES + F.wave, NGW = F.G * NWAVES;
    const float* x = F.in[0]; const float* mem = F.in[1]; const float* mg = F.in[12];
    bf16* HB = (bf16*)(F.ws + WS_HB); bf16* MEMN = (bf16*)(F.ws + WS_MEMN);
    for (int m = gw; m < T + NMEM; m += NGW) {
        const bool is_mem = m >= T;
        const float* src = is_mem ? mem + (size_t)(m - T) * D : x + (size_t)m * D;
        bf16* dst = is_mem ? MEMN + (size_t)(m - T) * D : HB + (size_t)m * D;
        f32x4 v[4]; float s = 0.f;
#pragma unroll
        for (int j = 0; j < 4; ++j) { v[j] = *(const f32x4*)(src + 4 * lane_ + 256 * j); s += (v[j].x * v[j].x + v[j].y * v[j].y) + (v[j].z * v[j].z + v[j].w * v[j].w); }
        const float rinv = 1.0f / sqrtf(wave_sum(s) * (1.0f / D) + EPS);
#pragma unroll
        for (int j = 0; j < 4; ++j) {
            f32x4 g = (f32x4){1.f, 1.f, 1.f, 1.f};
            if (is_mem) g = *(const f32x4*)(mg + 4 * lane_ + 256 * j);
            v2u o; o.x = pk2(v[j].x * rinv * g.x, v[j].y * rinv * g.y); o.y = pk2(v[j].z * rinv * g.z, v[j].w * rinv * g.w);
            *(v2u*)(dst + 4 * lane_ + 256 * j) = o;
        }
    }
    float* COS = (float*)(F.ws + WS_ROPE); float* SIN = COS + SEQ * 32;
    const int gt = F.vcu * NTHR + tid_, NGT = F.G * NTHR;
    for (int i = gt; i < SEQ * 32; i += NGT) {
        const int t = i >> 5, p = i & 31;
        const float fr = expf(-9.210340371976184f * (float)(p & 15) * (1.0f / 16.0f));
        const float pos = (float)((p < 16) ? (t >> 6) : (t & 63));
        float rev = pos * fr * 0.15915494309189535f; rev -= floorf(rev);
        COS[i] = __builtin_amdgcn_cosf(rev); SIN[i] = __builtin_amdgcn_sinf(rev);
    }
}

__device__ __forceinline__ void ph_gmlp(Frame& F, int l) {
    int lane_ = lane_id(); asm volatile("" : "+v"(lane_)); const int tid_ = F.wave * 64 + lane_;
    const bf16* UACT = (const bf16*)(F.ws + WS_UACT); const bf16* VACT = (const bf16*)(F.ws + WS_VACT);
    const float* VSTAT = (const float*)(F.ws + WS_VSTAT); float* GMSTAT = (float*)(F.ws + WS_GMSTAT);
    bf16* MERGED = (bf16*)(F.ws + WS_MERGED);
    const float* gvn = F.in[4] + (size_t)l * GMW; const float* bs = F.in[6] + (size_t)l * 4 * 128;
    const bf16* WSB = (const bf16*)(F.ws + WS_WSB) + (size_t)l * 4 * 128 * 128;
    LAS bf16* vT = (LAS bf16*)F.lds;
    const int fr = lane_ & 15, fq = lane_ >> 4, w = F.wave;
    for (int u = F.vcu; u < (T / 128) * 4; u += F.G) {
        const int n = u >> 2, g = u & 3; const int row0 = n * 128;
        __syncthreads();
        {   const int j = tid_ & 127, cs = tid_ >> 7; const size_t row = (size_t)row0 + j;
            const f32x4 s0 = *(const f32x4*)(VSTAT + row * 8), s1 = *(const f32x4*)(VSTAT + row * 8 + 4);
            const float rinv = 1.0f / sqrtf((((s0[0] + s0[1]) + (s0[2] + s0[3])) + ((s1[0] + s1[1]) + (s1[2] + s1[3]))) * (1.0f / GMW) + EPS);
#pragma unroll
            for (int q = 0; q < 4; ++q) { const int c8 = (cs * 4 + q) * 8;
                const v4u raw = *(const v4u*)(VACT + row * GMW + g * 128 + c8);
                const f32x4 g0 = *(const f32x4*)(gvn + g * 128 + c8) * rinv, g1 = *(const f32x4*)(gvn + g * 128 + c8 + 4) * rinv;
                LAS bf16* d = vT + c8 * 136 + j;
                d[0 * 136] = (bf16)f2bf(bflo(raw.x) * g0[0]); d[1 * 136] = (bf16)f2bf(bfhi(raw.x) * g0[1]); d[2 * 136] = (bf16)f2bf(bflo(raw.y) * g0[2]); d[3 * 136] = (bf16)f2bf(bfhi(raw.y) * g0[3]);
                d[4 * 136] = (bf16)f2bf(bflo(raw.z) * g1[0]); d[5 * 136] = (bf16)f2bf(bfhi(raw.z) * g1[1]); d[6 * 136] = (bf16)f2bf(bflo(raw.w) * g1[2]); d[7 * 136] = (bf16)f2bf(bfhi(raw.w) * g1[3]); } }
        bf16x8_t bw[4];
#pragma unroll
        for (int ks = 0; ks < 4; ++ks) bw[ks] = *(const bf16x8_t*)(WSB + ((size_t)(g * 128 + 16 * w + fr)) * 128 + 32 * ks + 8 * fq);
        __syncthreads();
        f32x4 acc[8];
#pragma unroll
        for (int cb = 0; cb < 8; ++cb) { acc[cb] = (f32x4){0.f, 0.f, 0.f, 0.f};
#pragma unroll
            for (int ks = 0; ks < 4; ++ks) { const bf16x8_t a = *(const LAS bf16x8_t*)(vT + (16 * cb + fr) * 136 + 32 * ks + 8 * fq);
                acc[cb] = __builtin_amdgcn_mfma_f32_16x16x32_bf16(a, bw[ks], acc[cb], 0, 0, 0); } }
        const size_t row = (size_t)row0 + 16 * w + fr; const float bias = bs[g * 128 + 16 * w + fr]; float ss = 0.f;
#pragma unroll
        for (int cb = 0; cb < 8; ++cb) { const v2u uu = *(const v2u*)(UACT + row * GMW + g * 128 + 16 * cb + 4 * fq);
            v2u o; o.x = pk2(bflo(uu.x) * (acc[cb][0] + bias), bfhi(uu.x) * (acc[cb][1] + bias)); o.y = pk2(bflo(uu.y) * (acc[cb][2] + bias), bfhi(uu.y) * (acc[cb][3] + bias));
            *(v2u*)(MERGED + row * 1024 + g * 128 + 16 * cb + 4 * fq) = o;
            const float a0 = bflo(o.x), a1 = bfhi(o.x), a2 = bflo(o.y), a3 = bfhi(o.y); ss += (a0 * a0 + a1 * a1) + (a2 * a2 + a3 * a3); }
        ss += __shfl_xor(ss, 16); ss += __shfl_xor(ss, 32);
        if (fq == 0) GMSTAT[row * 4 + g] = ss;
    }
    __syncthreads();
}

__device__ __forceinline__ void ph_router(Frame& F, int l) {
    int lane_ = lane_id(); asm volatile("" : "+v"(lane_)); const int tid_ = F.wave * 64 + lane_;
    const float* g = F.in[16] + (size_t)l * D; const float* wr = F.in[17] + (size_t)l * D * NE;
    bf16* HB = (bf16*)(F.ws + WS_HB); float* AFF = (float*)(F.ws + WS_AFF);
    LAS float* sW = (LAS float*)F.lds;
    __syncthreads();
    for (int i = tid_; i < D * NE; i += NTHR) { const int c = i >> 4, e = i & 15; sW[e * D + c] = wr[i] * g[c]; }
    __syncthreads();
    const int gw = F.vcu * NWAVES + F.wave, NGW = F.G * NWAVES;
    for (int m = gw; m < T; m += NGW) {
        const float* xr = F.xres + (size_t)m * D;
        f32x4 v[4]; float s = 0.f;
#pragma unroll
        for (int j = 0; j < 4; ++j) { v[j] = *(const f32x4*)(xr + 4 * lane_ + 256 * j); s += (v[j].x * v[j].x + v[j].y * v[j].y) + (v[j].z * v[j].z + v[j].w * v[j].w); }
        const float rinv = 1.0f / sqrtf(wave_sum(s) * (1.0f / D) + EPS);
#pragma unroll
        for (int j = 0; j < 4; ++j) { v2u o; o.x = pk2(v[j].x * rinv, v[j].y * rinv); o.y = pk2(v[j].z * rinv, v[j].w * rinv); *(v2u*)(HB + (size_t)m * D + 4 * lane_ + 256 * j) = o; }
        LAS float* tp = (LAS float*)(F.lds + 65536) + F.wave * (64 * 17);
#pragma unroll 4
        for (int e = 0; e < NE; ++e) { float a = 0.f;
#pragma unroll
            for (int j = 0; j < 4; ++j) { const f32x4 w = *(const LAS f32x4*)(sW + e * D + 4 * lane_ + 256 * j); a += (v[j].x * w.x + v[j].y * w.y) + (v[j].z * w.z + v[j].w * w.w); }
            tp[lane_ * 17 + e] = a; }
        asm volatile("s_waitcnt lgkmcnt(0)" ::: "memory");
        float mylg = 0.f;
        { const int e = lane_ & 15, q = lane_ >> 4; float a0 = 0.f, a1 = 0.f;
#pragma unroll
          for (int r = 0; r < 16; r += 2) { a0 += tp[(q * 16 + r) * 17 + e]; a1 += tp[(q * 16 + r + 1) * 17 + e]; }
          mylg = a0 + a1; mylg += __shfl_xor(mylg, 16); mylg += __shfl_xor(mylg, 32); mylg *= rinv; }
        asm volatile("s_waitcnt lgkmcnt(0)" ::: "memory");
        float mx = mylg;
        mx = fmaxf(mx, __shfl_xor(mx, 1)); mx = fmaxf(mx, __shfl_xor(mx, 2)); mx = fmaxf(mx, __shfl_xor(mx, 4)); mx = fmaxf(mx, __shfl_xor(mx, 8));
        const float pe = __builtin_amdgcn_exp2f((mylg - mx) * LOG2E);
        float den = pe; den += __shfl_xor(den, 1); den += __shfl_xor(den, 2); den += __shfl_xor(den, 4); den += __shfl_xor(den, 8);
        const float mine = pe / den;
        if (lane_ < NE) AFF[(size_t)m * NE + lane_] = mine;
    }
    __syncthreads();
}

__device__ __forceinline__ void ph_topk(Frame& F) {
    int lane_ = lane_id(); asm volatile("" : "+v"(lane_)); const int tid_ = F.wave * 64 + lane_;
    const float* AFF = (const float*)(F.ws + WS_AFF); int* IDX = (int*)(F.ws + WS_IDX); int* INV = (int*)(F.ws + WS_INV);
    LAS unsigned* hist = (LAS unsigned*)F.lds;
    LAS unsigned* sh = hist + 256;
    LAS unsigned* wsum = hist + 512;
    for (int p = F.vcu; p < NB_ * NE; p += F.G) {
        const int b = p >> 4, e = p & 15;
        unsigned key[16];
#pragma unroll
        for (int i = 0; i < 16; ++i) key[i] = __builtin_bit_cast(unsigned, AFF[((size_t)b * SEQ + tid_ * 16 + i) * NE + e]);
        unsigned prefix = 0u, krem = CAP;
#pragma unroll
        for (int pass = 0; pass < 4; ++pass) {
            const int shift = 24 - 8 * pass; const unsigned himask = pass == 0 ? 0u : (0xffffffffu << (shift + 8));
            __syncthreads();
            if (tid_ < 256) hist[tid_] = 0u;
            __syncthreads();
#pragma unroll
            for (int i = 0; i < 16; ++i) if ((key[i] & himask) == prefix) atomicAdd((unsigned*)&hist[(key[i] >> shift) & 255u], 1u);
            __syncthreads();
            if (tid_ == 0) { unsigned above = 0u; int d = 255; for (; d > 0; --d) { const unsigned c = hist[d]; if (above + c >= krem) break; above += c; } sh[0] = prefix | ((unsigned)d << shift); sh[1] = krem - above; }
            __syncthreads();
            prefix = sh[0]; krem = sh[1];
        }
        const unsigned thr = prefix;
        unsigned cg = 0u, ce = 0u;
#pragma unroll
        for (int i = 0; i < 16; ++i) { cg += key[i] > thr ? 1u : 0u; ce += key[i] == thr ? 1u : 0u; }
        unsigned sg = cg, se = ce;
#pragma unroll
        for (int o = 1; o < 64; o <<= 1) { const unsigned a = __shfl_up(sg, o), c2 = __shfl_up(se, o); if (lane_ >= o) { sg += a; se += c2; } }
        __syncthreads();
        if (lane_ == 63) { wsum[F.wave] = sg; wsum[8 + F.wave] = se; }
        __syncthreads();
        unsigned og = 0u, oe = 0u;
        for (int w = 0; w < F.wave; ++w) { og += wsum[w]; oe += wsum[8 + w]; }
        unsigned gb = og + sg - cg, eb = oe + se - ce;
#pragma unroll
        for (int i = 0; i < 16; ++i) {
            const int t = tid_ * 16 + i; int pos = -1;
            if (key[i] > thr) { pos = (int)(gb + (eb < krem ? eb : krem)); ++gb; }
            else if (key[i] == thr) { if (eb < krem) pos = (int)(gb + eb); ++eb; }
            INV[((size_t)b * SEQ + t) * NE + e] = pos;
            if (pos >= 0) IDX[(size_t)p * CAP + pos] = t;
        }
    }
    __syncthreads();
}

__device__ __forceinline__ void ph_combine(Frame& F, int l, bool dummy) {
    int lane_ = lane_id(); asm volatile("" : "+v"(lane_)); const int tid_ = F.wave * 64 + lane_;
    const float* AFF = (const float*)(F.ws + WS_AFF); const int* INV = (const int*)(F.ws + WS_INV);
    const bf16* Y = (const bf16*)(F.ws + WS_Y); bf16* HB = (bf16*)(F.ws + WS_HB); const float* fg = F.in[21];
    const int gw = F.vcu * NWAVES + F.wave, NGW = F.G * NWAVES;
    for (int m = gw; m < T; m += NGW) {
        const float* xr = F.xres + (size_t)m * D; const int b = m / SEQ;
        float* xw = (dummy ? (float*)(F.ws + WS_NSCR) : F.xres) + (size_t)m * D; bf16* hw = (dummy ? (bf16*)(F.ws + WS_NSCR + 128 * MiB) : HB) + (size_t)m * D;
        f32x4 v[4];
#pragma unroll
        for (int j = 0; j < 4; ++j) v[j] = *(const f32x4*)(xr + 4 * lane_ + 256 * j);
        const int mypos = lane_ < NE ? INV[(size_t)m * NE + lane_] : -1;
        const float myaff = lane_ < NE ? AFF[(size_t)m * NE + lane_] : 0.f;
#pragma unroll
        for (int e = 0; e < NE; ++e) {
            const int pos = __shfl(mypos, e); const float a = __shfl(myaff, e);
            if (pos >= 0) {
                const bf16* yr = Y + ((size_t)(b * NE + e) * CAP + pos) * D;
#pragma unroll
                for (int j = 0; j < 4; ++j) { const v2u w = *(const v2u*)(yr + 4 * lane_ + 256 * j);
                    v[j].x += a * bflo(w.x); v[j].y += a * bfhi(w.x); v[j].z += a * bflo(w.y); v[j].w += a * bfhi(w.y); }
            }
        }
        float s = 0.f;
#pragma unroll
        for (int j = 0; j < 4; ++j) s += (v[j].x * v[j].x + v[j].y * v[j].y) + (v[j].z * v[j].z + v[j].w * v[j].w);
        const float rinv = 1.0f / sqrtf(wave_sum(s) * (1.0f / D) + EPS);
        if (l == NL - 1) {
#pragma unroll
            for (int j = 0; j < 4; ++j) { const f32x4 g = *(const f32x4*)(fg + 4 * lane_ + 256 * j); *(f32x4*)(xw + 4 * lane_ + 256 * j) = (f32x4){v[j].x * rinv * g.x, v[j].y * rinv * g.y, v[j].z * rinv * g.z, v[j].w * rinv * g.w}; }
        } else {
#pragma unroll
            for (int j = 0; j < 4; ++j) { *(f32x4*)(xw + 4 * lane_ + 256 * j) = v[j];
                v2u o; o.x = pk2(v[j].x * rinv, v[j].y * rinv); o.y = pk2(v[j].z * rinv, v[j].w * rinv); *(v2u*)(hw + 4 * lane_ + 256 * j) = o; }
        }
    }
}


namespace pg8 {
typedef short bf16x8 __attribute__((ext_vector_type(8)));
typedef float f32x2 __attribute__((ext_vector_type(2)));
constexpr int BM = 256, BK = 64, HALF = 128, HTB = HALF * BK * 2, STAGE_BYTES = 8 * HTB, NXCD = 8, WGM = 8;
__host__ __device__ __forceinline__ int lds_byte(int r, int c) { const int st = (r >> 4) * 2 + (c >> 5), rr = r & 15, cc = c & 31, ob = rr * 64 + cc * 2; return st * 1024 + (ob ^ (((ob >> 9) & 1) << 5)); }
__host__ __device__ __forceinline__ void stage_rc(int b, int& R, int& C) { const int st = b / 1024, sb = b % 1024, swz = sb ^ (((sb >> 9) & 1) << 5); R = (st >> 1) * 16 + swz / 64; C = (st & 1) * 32 + (swz % 64) / 2; }
__host__ __device__ __forceinline__ int perm32(int rho) { const int n = rho >> 4, i = rho & 15; return 8 * (i >> 2) + 4 * n + (i & 3); }

struct Unit { int pm, pn, z; const char* a; const char* b; const int* gi; int grow; };

struct TileOrder {
    int nM, nN, nwg, G, c;
    __device__ __forceinline__ void init(int nM_, int nN_, int G_, int c_) { nM = nM_; nN = nN_; nwg = nM * nN; G = G_; c = c_; }
    __device__ __forceinline__ bool tile(int i, int& pm, int& pn) const {
        const long L = (long)i * G + c; if (L >= nwg) return false;
        int wgid = (int)L; { const int q = nwg / NXCD, r = nwg % NXCD, xcd = wgid % NXCD, off = wgid / NXCD; wgid = (xcd < r ? xcd * (q + 1) : r * (q + 1) + (xcd - r) * q) + off; }
        const int nig = WGM * nN, gid = wgid / nig, fm = gid * WGM, gsz = (nM - fm) < WGM ? (nM - fm) : WGM;
        pm = fm + ((wgid % nig) % gsz); pn = (wgid % nig) / gsz; return true;
    }
};

__device__ __forceinline__ unsigned cvt_pk_bf16(float lo, float hi) { unsigned r; asm volatile("v_cvt_pk_bf16_f32 %0, %1, %2" : "=v"(r) : "v"(lo), "v"(hi)); return r; }
typedef f32x4 Acc[2][2][4][2];

template <class Epi, class Sched, bool ALIGN_EPI, bool GATHER>
__device__ __forceinline__ void gemm_phase(LAS unsigned char* lds, const int wave_idx, const int lda, const int ldb, const int K, const Sched& S, Epi& E) {
    int lane = lane_id(); asm volatile("" : "+v"(lane));
    const int wid = wave_idx, tid = wid * 64 + lane, wr = wid >> 2, wc = wid & 3, fr = lane & 15, fq = lane >> 4;
    const int nt = K / BK;
    unsigned voffA[2], voffB[2]; int gR[2]; unsigned gC[2];
#pragma unroll
    for (int i = 0; i < 2; ++i) { int R, C; stage_rc(tid * 16 + i * 8192, R, C); const int Rb = (R & ~31) + perm32(R & 31);
        voffA[i] = (unsigned)(R * lda + C) * 2u; voffB[i] = (unsigned)(Rb * ldb + C) * 2u; gR[i] = R; gC[i] = (unsigned)C * 2u; }
    const size_t kstep = (size_t)(BK * 2);
    const size_t hstepA = (size_t)HALF * lda * 2, hstepB = (size_t)HALF * ldb * 2;
    const unsigned ldsw = (unsigned)wid * 1024u;
    const int aoff = lds_byte(wr * 64 + fr, fq * 8), boff = lds_byte(wc * 32 + fr, fq * 8);
    unsigned vgc[2][2], vgn[2][2];
#define PG8_SA(b, h) (((b) * 2 + (h)) * HTB)
#define PG8_SB(b, h) ((4 + (b) * 2 + (h)) * HTB)
#define PG8_GL(gp, voff, bufoff, _i) __builtin_amdgcn_global_load_lds((const unsigned*)((const char*)(gp) + (voff)), (LAS unsigned*)(lds + (bufoff) + ldsw + (_i) * 8192), 16, 0, 0)
#define PG8_STAGE_B(bufoff, gbase) do { PG8_GL(gbase, voffB[0], bufoff, 0); PG8_GL(gbase, voffB[1], bufoff, 1); } while (0)
#define PG8_STAGE_A(bufoff, gbase, h, VG) do { if constexpr (GATHER) { PG8_GL(gbase, VG[h][0], bufoff, 0); PG8_GL(gbase, VG[h][1], bufoff, 1); } \
        else { PG8_GL((gbase) + (h) * hstepA, voffA[0], bufoff, 0); PG8_GL((gbase) + (h) * hstepA, voffA[1], bufoff, 1); } } while (0)
#define PG8_LDA(dst, b, h) do { _Pragma("unroll") for (int m = 0; m < 4; ++m) _Pragma("unroll") for (int k = 0; k < 2; ++k) dst[m][k] = *(const LAS bf16x8*)(lds + PG8_SA(b, h) + aoff + m * 2048 + k * 1024); } while (0)
#define PG8_LDB(dst, b, h) do { _Pragma("unroll") for (int n = 0; n < 2; ++n) _Pragma("unroll") for (int k = 0; k < 2; ++k) dst[n][k] = *(const LAS bf16x8*)(lds + PG8_SB(b, h) + boff + n * 2048 + k * 1024); } while (0)
#define PG8_MMA(ai, bj, At, Bt) do { __builtin_amdgcn_s_setprio(1); _Pragma("unroll") for (int m = 0; m < 4; ++m) _Pragma("unroll") for (int n = 0; n < 2; ++n) _Pragma("unroll") for (int k = 0; k < 2; ++k) \
        acc[ai][bj][m][n] = __builtin_amdgcn_mfma_f32_16x16x32_bf16(Bt[n][k], At[m][k], acc[ai][bj][m][n], 0, 0, 0); __builtin_amdgcn_s_setprio(0); } while (0)
#define PG8_WAIT_V(n) asm volatile("s_waitcnt vmcnt(" #n ")" ::: "memory")
#define PG8_WAIT_L(n) asm volatile("s_waitcnt lgkmcnt(" #n ")" ::: "memory")
#define PG8_BAR __builtin_amdgcn_s_barrier()
#define PG8_SCHED __builtin_amdgcn_sched_barrier(0)
#define PG8_GIDX(VG, U) do { _Pragma("unroll") for (int _h = 0; _h < 2; ++_h) _Pragma("unroll") for (int _i = 0; _i < 2; ++_i) \
        VG[_h][_i] = (unsigned)((U).grow + (U).gi[_h * HALF + gR[_i]]) * (unsigned)(lda * 2) + gC[_i]; } while (0)
    Unit cur, nxt; int ui = 0;
    if (!S.next(0, cur)) return;
    Acc acc;
#pragma unroll
    for (int a = 0; a < 2; ++a)
#pragma unroll
        for (int b = 0; b < 2; ++b)
#pragma unroll
            for (int m = 0; m < 4; ++m)
#pragma unroll
                for (int n = 0; n < 2; ++n) acc[a][b][m][n] = (f32x4){0.f, 0.f, 0.f, 0.f};
    bf16x8 At[4][2], B0[2][2], B1[2][2];
    const char* cA = cur.a; const char* cB = cur.b;
    if constexpr (GATHER) { PG8_GIDX(vgc, cur); } else { vgc[0][0] = vgc[0][1] = vgc[1][0] = vgc[1][1] = 0u; }
    E.prep(cur, wr, wc, fr, fq);
    PG8_STAGE_B(PG8_SB(0, 0), cB); PG8_STAGE_B(PG8_SB(0, 1), cB + hstepB); PG8_STAGE_A(PG8_SA(0, 0), cA, 0, vgc); PG8_STAGE_A(PG8_SA(0, 1), cA, 1, vgc);
    if (wr == 1) PG8_BAR;
    PG8_WAIT_V(2); PG8_BAR;
    PG8_STAGE_B(PG8_SB(1, 0), cB + kstep); PG8_STAGE_A(PG8_SA(1, 0), cA + kstep, 0, vgc); PG8_STAGE_B(PG8_SB(1, 1), cB + hstepB + kstep);
    PG8_WAIT_V(6); PG8_BAR;
    for (;;) {
        const bool has_next = S.next(ui + 1, nxt);
        const char* nA = has_next ? nxt.a : cA; const char* nB = has_next ? nxt.b : cB;
        if constexpr (GATHER) { if (has_next) { PG8_GIDX(vgn, nxt); } else {
#pragma unroll
            for (int h = 0; h < 2; ++h) { vgn[h][0] = vgc[h][0]; vgn[h][1] = vgc[h][1]; } } }
        else { vgn[0][0] = vgn[0][1] = vgn[1][0] = vgn[1][1] = 0u; }
        for (int t = 0; t < nt; t += 2) {
            const bool last = (t == nt - 2);
            const char* a1 = cA + (size_t)(t + 1) * kstep;
            const char* a2 = last ? nA : cA + (size_t)(t + 2) * kstep; const char* b2 = last ? nB : cB + (size_t)(t + 2) * kstep;
            const char* a3 = a2 + kstep; const char* b3 = b2 + kstep;
            unsigned vg2[2][2];
#pragma unroll
            for (int h = 0; h < 2; ++h) { vg2[h][0] = last ? vgn[h][0] : vgc[h][0]; vg2[h][1] = last ? vgn[h][1] : vgc[h][1]; }
            if constexpr (Epi::MIDK) { if (t == (nt >> 1)) E.midk(acc); }
            PG8_LDB(B0, 0, 0); PG8_LDB(B1, 0, 1); PG8_SCHED; PG8_LDA(At, 0, 0); PG8_STAGE_A(PG8_SA(1, 1), a1, 1, vgc);
            PG8_WAIT_V(8); PG8_WAIT_L(0); PG8_BAR; PG8_MMA(0, 0, At, B0); PG8_MMA(0, 1, At, B1); PG8_BAR; PG8_SCHED;
            PG8_LDA(At, 0, 1); PG8_STAGE_B(PG8_SB(0, 0), b2); PG8_STAGE_B(PG8_SB(0, 1), b2 + hstepB); PG8_STAGE_A(PG8_SA(0, 0), a2, 0, vg2);
            PG8_WAIT_V(8); PG8_WAIT_L(0); PG8_BAR; PG8_MMA(1, 0, At, B0); PG8_MMA(1, 1, At, B1); PG8_BAR; PG8_SCHED;
            PG8_LDB(B0, 1, 0); PG8_LDB(B1, 1, 1); PG8_SCHED; PG8_LDA(At, 1, 0); PG8_STAGE_A(PG8_SA(0, 1), a2, 1, vg2);
            PG8_WAIT_V(8); PG8_WAIT_L(0); PG8_BAR; PG8_MMA(0, 0, At, B0); PG8_MMA(0, 1, At, B1); PG8_BAR; PG8_SCHED;
            PG8_LDA(At, 1, 1); PG8_STAGE_B(PG8_SB(1, 0), b3); PG8_STAGE_B(PG8_SB(1, 1), b3 + hstepB); PG8_STAGE_A(PG8_SA(1, 0), a3, 0, vg2);
            PG8_WAIT_V(8); PG8_WAIT_L(0); PG8_BAR; PG8_MMA(1, 0, At, B0); PG8_MMA(1, 1, At, B1); PG8_BAR; PG8_SCHED;
        }
        if constexpr (ALIGN_EPI) { if (wr == 0) PG8_BAR; }
        E(acc, cur, wr, wc, fr, fq);
        if (!has_next) break;
#pragma unroll
        for (int a = 0; a < 2; ++a)
#pragma unroll
            for (int b = 0; b < 2; ++b)
#pragma unroll
                for (int m = 0; m < 4; ++m)
#pragma unroll
                    for (int n = 0; n < 2; ++n) acc[a][b][m][n] = (f32x4){0.f, 0.f, 0.f, 0.f};
        cur = nxt; cA = nA; cB = nB; ++ui;
#pragma unroll
        for (int h = 0; h < 2; ++h) { vgc[h][0] = vgn[h][0]; vgc[h][1] = vgn[h][1]; }
        E.prep(cur, wr, wc, fr, fq);
        if constexpr (ALIGN_EPI) { if (wr == 1) PG8_BAR; }
    }
    PG8_WAIT_V(0);
    if constexpr (!ALIGN_EPI) { if (wr == 0) PG8_BAR; }
    PG8_BAR;
#undef PG8_SA
#undef PG8_SB
#undef PG8_GL
#undef PG8_STAGE_A
#undef PG8_STAGE_B
#undef PG8_LDA
#undef PG8_LDB
#undef PG8_MMA
#undef PG8_WAIT_V
#undef PG8_WAIT_L
#undef PG8_SCHED
#undef PG8_GIDX
}

#define EPI_ROWS for (int ai = 0; ai < 2; ++ai) _Pragma("unroll") for (int m = 0; m < 4; ++m)
__device__ __forceinline__ v4u pack8(const f32x4 a, const f32x4 b) { v4u w; w.x = cvt_pk_bf16(a[0], a[1]); w.y = cvt_pk_bf16(a[2], a[3]); w.z = cvt_pk_bf16(b[0], b[1]); w.w = cvt_pk_bf16(b[2], b[3]); return w; }

template <int mode>
struct EpiStore {
    static constexpr bool MIDK = false;
    bf16* O; int ldc; const float* cs; float scale;
    __device__ __forceinline__ void prep(const Unit&, int, int, int, int) {}
    __device__ __forceinline__ void midk(Acc&) {}
    __device__ __forceinline__ void operator()(const Acc& acc, const Unit& u, int wr, int wc, int fr, int fq) const {
        asm volatile("" : "+v"(fr), "+v"(fq));
        size_t base; const float* csp = cs;
        if constexpr (mode == 0) base = (size_t)u.pm * 256 * ldc + (size_t)u.pn * 256;
        else if constexpr (mode == 1) { const int lb = u.pm >> 2, h = u.pm & 3; base = (size_t)lb * D * D + (size_t)(h * 256) * D + u.pn * 256; csp = cs + (size_t)(lb >> 2) * D + u.pn * 256; }
        else if constexpr (mode == 2) { const int pml = u.pm & 3, lbh = u.pm >> 2, h = lbh & 3, lb = lbh >> 2; base = (size_t)lb * D * D + (size_t)(pml * 256) * D + h * 256; }
        else { const int l = u.pm >> 2, pml = u.pm & 3; base = (size_t)l * NMEM * 2 * D + (size_t)(pml * 256) * 2 * D + u.pn * 256; }
        const int cb = wc * 32 + 8 * fq;
        f32x4 c0[2], c1[2];
#pragma unroll
        for (int bj = 0; bj < 2; ++bj) { if (csp) { c0[bj] = *(const f32x4*)(csp + bj * HALF + cb) * scale; c1[bj] = *(const f32x4*)(csp + bj * HALF + cb + 4) * scale; } else { c0[bj] = (f32x4){scale, scale, scale, scale}; c1[bj] = c0[bj]; } }
#pragma unroll
        EPI_ROWS { bf16* rowp = O + base + (size_t)(ai * HALF + wr * 64 + m * 16 + fr) * ldc + cb;
#pragma unroll
            for (int bj = 0; bj < 2; ++bj) *(v4u*)(rowp + bj * HALF) = pack8(acc[ai][bj][m][0] * c0[bj], acc[ai][bj][m][1] * c1[bj]); }
    }
};
struct EpiH {
    static constexpr bool MIDK = false;
    bf16* H;
    __device__ __forceinline__ void prep(const Unit&, int, int, int, int) {}
    __device__ __forceinline__ void midk(Acc&) {}
    __device__ __forceinline__ void operator()(const Acc& acc, const Unit& u, int wr, int wc, int fr, int fq) const {
        asm volatile("" : "+v"(fr), "+v"(fq));
        const int cb = u.pn * 128 + wc * 32 + 8 * fq;
#pragma unroll
        EPI_ROWS { bf16* rowp = H + (size_t)(u.pm * 256 + ai * HALF + wr * 64 + m * 16 + fr) * FF + cb;
            f32x4 h0, h1;
#pragma unroll
            for (int i = 0; i < 4; ++i) { h0[i] = silu_f(acc[ai][0][m][0][i]) * acc[ai][1][m][0][i]; h1[i] = silu_f(acc[ai][0][m][1][i]) * acc[ai][1][m][1][i]; }
            *(v4u*)rowp = pack8(h0, h1); }
    }
};
template <bool MK, bool WRITE_XB>
struct EpiX {
    static constexpr bool MIDK = MK;
    const float* base; float* out; bf16* xb; float* xstat; const float* gmstat; const float* atstat; LAS unsigned char* lds;
    int wr_, wc_, fr_;
    __device__ __forceinline__ void prep(const Unit& u, int wr, int wc, int fr, int fq) {
        wr_ = wr; wc_ = wc; fr_ = fr;
        if constexpr (MK) {
            asm volatile("" : "+v"(fr), "+v"(fq));
            LAS f32x2* X = (LAS f32x2*)(lds + RING_BYTES + 1024) + (wr * 4 + wc) * 128;
#pragma unroll
            EPI_ROWS { const size_t row = (size_t)u.pm * 256 + ai * HALF + wr * 64 + m * 16 + fr;
                const f32x4 g = *(const f32x4*)(gmstat + row * 4), a0 = *(const f32x4*)(atstat + row * 8), a1 = *(const f32x4*)(atstat + row * 8 + 4);
                const float sg = (g[0] + g[1]) + (g[2] + g[3]), sa = ((a0[0] + a0[1]) + (a0[2] + a0[3])) + ((a1[0] + a1[1]) + (a1[2] + a1[3]));
                const float rgm = 1.0f / sqrtf(sg * (1.0f / 512.0f) + EPS), rat = 1.0f / sqrtf(sa * (1.0f / 512.0f) + EPS);
                if (fq == 0) X[(ai * 4 + m) * 16 + fr] = (f32x2){rgm / rat, rat}; }
            asm volatile("s_waitcnt lgkmcnt(0)" ::: "memory");
        }
    }
    __device__ __forceinline__ void midk(Acc& acc) {
        int fr = fr_; asm volatile("" : "+v"(fr));
        const LAS f32x2* X = (const LAS f32x2*)(lds + RING_BYTES + 1024) + (wr_ * 4 + wc_) * 128;
#pragma unroll
        EPI_ROWS { const float f = X[(ai * 4 + m) * 16 + fr].x;
#pragma unroll
            for (int bj = 0; bj < 2; ++bj) { acc[ai][bj][m][0] *= f; acc[ai][bj][m][1] *= f; } }
    }
    __device__ __forceinline__ void operator()(const Acc& acc, const Unit& u, int wr, int wc, int fr, int fq) const {
        asm volatile("" : "+v"(fr), "+v"(fq));
        const int cb = u.pn * 256 + wc * 32 + 8 * fq;
#pragma unroll
        EPI_ROWS { const size_t row = (size_t)u.pm * 256 + ai * HALF + wr * 64 + m * 16 + fr; const size_t off = row * D + cb;
            float f = 1.0f; if constexpr (MK) f = ((const LAS f32x2*)(lds + RING_BYTES + 1024) + (wr * 4 + wc) * 128)[(ai * 4 + m) * 16 + fr].y; float ss = 0.f;
#pragma unroll
            for (int bj = 0; bj < 2; ++bj) { const f32x4 b0 = *(const f32x4*)(base + off + bj * HALF), b1 = *(const f32x4*)(base + off + bj * HALF + 4);
                const f32x4 x0 = b0 + acc[ai][bj][m][0] * f, x1 = b1 + acc[ai][bj][m][1] * f;
                *(f32x4*)(out + off + bj * HALF) = x0; *(f32x4*)(out + off + bj * HALF + 4) = x1;
                if constexpr (WRITE_XB) { *(v4u*)(xb + off + bj * HALF) = pack8(x0, x1);
                    ss += ((x0[0] * x0[0] + x0[1] * x0[1]) + (x0[2] * x0[2] + x0[3] * x0[3])) + ((x1[0] * x1[0] + x1[1] * x1[1]) + (x1[2] * x1[2] + x1[3] * x1[3])); } }
            if constexpr (WRITE_XB) { ss += __shfl_xor(ss, 16); ss += __shfl_xor(ss, 32); if (fq == 0) xstat[row * 16 + u.pn * 4 + wc] = ss; }
            if (m & 1) asm volatile("" ::: "memory"); }
    }
};

constexpr int EXCH_OFF = RING_BYTES + 1024;
struct EpiS {
    static constexpr bool MIDK = false;
    const float* xstat; bf16* P; LAS unsigned char* lds;
    __device__ __forceinline__ void prep(const Unit&, int, int, int, int) {}
    __device__ __forceinline__ void midk(Acc&) {}
    __device__ __forceinline__ void operator()(Acc& acc, const Unit& u, int wr, int wc, int fr, int fq) const {
        asm volatile("" : "+v"(fr), "+v"(fq));
        LAS f32x2* X = (LAS f32x2*)(lds + EXCH_OFF);
        float mw[2][4];
#pragma unroll
        EPI_ROWS { const int rl = ai * HALF + wr * 64 + m * 16 + fr; const size_t row = (size_t)u.pm * 256 + rl;
            const f32x4 s0 = *(const f32x4*)(xstat + row * 16), s1 = *(const f32x4*)(xstat + row * 16 + 4), s2 = *(const f32x4*)(xstat + row * 16 + 8), s3 = *(const f32x4*)(xstat + row * 16 + 12);
            const float ssq = (((s0[0] + s0[1]) + (s0[2] + s0[3])) + ((s1[0] + s1[1]) + (s1[2] + s1[3]))) + (((s2[0] + s2[1]) + (s2[2] + s2[3])) + ((s3[0] + s3[1]) + (s3[2] + s3[3])));
            const float rinv = 1.0f / sqrtf(ssq * (1.0f / D) + EPS);
            float mx = -3.0e38f;
#pragma unroll
            for (int bj = 0; bj < 2; ++bj)
#pragma unroll
                for (int n = 0; n < 2; ++n) { acc[ai][bj][m][n] *= rinv; const f32x4 v = acc[ai][bj][m][n]; mx = fmaxf(mx, fmaxf(fmaxf(v[0], v[1]), fmaxf(v[2], v[3]))); }
            mx = fmaxf(mx, __shfl_xor(mx, 16)); mx = fmaxf(mx, __shfl_xor(mx, 32));
            float sm = 0.f;
#pragma unroll
            for (int bj = 0; bj < 2; ++bj)
#pragma unroll
                for (int n = 0; n < 2; ++n) { f32x4 v = acc[ai][bj][m][n];
#pragma unroll
                    for (int i = 0; i < 4; ++i) { v[i] = __builtin_amdgcn_exp2f(v[i] - mx); sm += v[i]; }
                    acc[ai][bj][m][n] = v; }
            sm += __shfl_xor(sm, 16); sm += __shfl_xor(sm, 32);
            mw[ai][m] = mx;
            if (fq == 0) X[rl * 4 + wc] = (f32x2){mx, sm};
            if (m & 1) asm volatile("" ::: "memory"); }
        asm volatile("s_waitcnt lgkmcnt(0)\n\ts_barrier" ::: "memory");
        const int cb = u.pn * 256 + wc * 32 + 8 * fq;
#pragma unroll
        EPI_ROWS { const int rl = ai * HALF + wr * 64 + m * 16 + fr; const size_t row = (size_t)u.pm * 256 + rl;
            const f32x2 e0 = X[rl * 4 + 0], e1 = X[rl * 4 + 1], e2 = X[rl * 4 + 2], e3 = X[rl * 4 + 3];
            const float M = fmaxf(fmaxf(e0.x, e1.x), fmaxf(e2.x, e3.x));
            const float den = (e0.y * __builtin_amdgcn_exp2f(e0.x - M) + e1.y * __builtin_amdgcn_exp2f(e1.x - M)) + (e2.y * __builtin_amdgcn_exp2f(e2.x - M) + e3.y * __builtin_amdgcn_exp2f(e3.x - M));
            const float f = __builtin_amdgcn_exp2f(mw[ai][m] - M) / den;
#pragma unroll
            for (int bj = 0; bj < 2; ++bj) *(v4u*)(P + row * D + cb + bj * HALF) = pack8(acc[ai][bj][m][0] * f, acc[ai][bj][m][1] * f); }
        asm volatile("s_waitcnt lgkmcnt(0)" ::: "memory");
    }
};
struct EpiIn {
    static constexpr bool MIDK = false;
    bf16 *uact, *vact, *q, *k, *v; float* vstat; const float *qg, *kg, *cosT, *sinT;
    __device__ __forceinline__ void prep(const Unit&, int, int, int, int) {}
    __device__ __forceinline__ void midk(Acc&) {}
    __device__ __forceinline__ void operator()(const Acc& acc, const Unit& u, int wr, int wc, int fr, int fq) const {
        asm volatile("" : "+v"(fr), "+v"(fq));
        const int pn = u.pn;
        if (pn < 4) {
            bf16* O = pn < 2 ? uact : vact; const int cb = (pn & 1) * 256 + wc * 32 + 8 * fq;
#pragma unroll
            EPI_ROWS { const size_t row = (size_t)u.pm * 256 + ai * HALF + wr * 64 + m * 16 + fr; float ss = 0.f;
#pragma unroll
                for (int bj = 0; bj < 2; ++bj) { f32x4 g0, g1;
#pragma unroll
                    for (int i = 0; i < 4; ++i) { g0[i] = gelu_tanh(acc[ai][bj][m][0][i]); g1[i] = gelu_tanh(acc[ai][bj][m][1][i]); }
                    const v4u w = pack8(g0, g1); *(v4u*)(O + row * GMW + cb + bj * HALF) = w;
                    if (pn >= 2) { const float a0 = bflo(w.x), a1 = bfhi(w.x), a2 = bflo(w.y), a3 = bfhi(w.y), a4 = bflo(w.z), a5 = bfhi(w.z), a6 = bflo(w.w), a7 = bfhi(w.w);
                        ss += ((a0 * a0 + a1 * a1) + (a2 * a2 + a3 * a3)) + ((a4 * a4 + a5 * a5) + (a6 * a6 + a7 * a7)); } }
                if (pn >= 2) { ss += __shfl_xor(ss, 16); ss += __shfl_xor(ss, 32); if (fq == 0) vstat[row * 8 + (pn - 2) * 4 + wc] = ss; } }
        } else if (pn == 6 && wc >= 2) {
#pragma unroll
            EPI_ROWS { const size_t row = (size_t)u.pm * 256 + ai * HALF + wr * 64 + m * 16 + fr;
#pragma unroll
                for (int bj = 0; bj < 2; ++bj) *(v4u*)(v + row * 128 + (wc - 2) * 64 + bj * 32 + 8 * fq) = pack8(acc[ai][bj][m][0], acc[ai][bj][m][1]); }
        } else {
            const bool isq = pn < 6; const float* g = isq ? qg : kg; const float sc = isq ? QSCALE : 1.0f;
            bf16* O = isq ? q + ((pn - 4) * 4 + wc) * 64 : k + wc * 64; const int ldo = isq ? 512 : 128;
            f32x4 gv[2][2];
#pragma unroll
            for (int bj = 0; bj < 2; ++bj) { gv[bj][0] = *(const f32x4*)(g + bj * 32 + 8 * fq) * sc; gv[bj][1] = *(const f32x4*)(g + bj * 32 + 8 * fq + 4) * sc; }
#pragma unroll
            EPI_ROWS { const size_t row = (size_t)u.pm * 256 + ai * HALF + wr * 64 + m * 16 + fr; const int t = (int)(row % SEQ);
                float ss = 0.f;
#pragma unroll
                for (int bj = 0; bj < 2; ++bj)
#pragma unroll
                    for (int n = 0; n < 2; ++n) { const f32x4 x = acc[ai][bj][m][n]; ss += (x[0] * x[0] + x[1] * x[1]) + (x[2] * x[2] + x[3] * x[3]); }
                ss += __shfl_xor(ss, 16); ss += __shfl_xor(ss, 32);
                const float rinv = 1.0f / sqrtf(ss * (1.0f / 64.0f) + EPS);
#pragma unroll
                for (int bj = 0; bj < 2; ++bj) { const f32x4 c = *(const f32x4*)(cosT + t * 32 + bj * 16 + 4 * fq), sn = *(const f32x4*)(sinT + t * 32 + bj * 16 + 4 * fq);
                    const f32x4 x0 = acc[ai][bj][m][0] * gv[bj][0] * rinv, x1 = acc[ai][bj][m][1] * gv[bj][1] * rinv; f32x4 o0, o1;
                    o0[0] = x0[0] * c[0] - x0[1] * sn[0]; o0[1] = x0[0] * sn[0] + x0[1] * c[0]; o0[2] = x0[2] * c[1] - x0[3] * sn[1]; o0[3] = x0[2] * sn[1] + x0[3] * c[1];
                    o1[0] = x1[0] * c[2] - x1[1] * sn[2]; o1[1] = x1[0] * sn[2] + x1[1] * c[2]; o1[2] = x1[2] * c[3] - x1[3] * sn[3]; o1[3] = x1[2] * sn[3] + x1[3] * c[3];
                    *(v4u*)(O + row * ldo + bj * 32 + 8 * fq) = pack8(o0, o1); }
                if (m & 1) asm volatile("" ::: "memory"); }
        }
    }
};
}


struct CvtJob { const float* W; const float* gain; bf16* WT; int K, N, dst_row0, k0, n0; };
__device__ __forceinline__ CvtJob cvt_decode(const Frame& F, int it) {
    constexpr int I_IN = 16 * 56, I_SQ = 512, I_KV = 1024, I_HEAD = I_IN + I_SQ + I_KV + I_SQ, I_LAYER = I_HEAD + NE * 3 * I_SQ;
    CvtJob j; const int l = it / I_LAYER; int r = it % I_LAYER;
    if (r < I_IN) { const int kb = r / 56, nb = r % 56, n0 = nb * 32, pn = n0 >> 8; int dr = n0;
        if (pn >= 4) { const int sidx = n0 & 255, w = sidx >> 6, bj = (sidx >> 5) & 1; dr = pn * 256 + 128 * bj + 32 * w; }
        j.W = F.in[3] + (size_t)l * D * INW; j.gain = F.in[2] + (size_t)l * D; j.WT = (bf16*)(F.ws + WS_WIN) + (size_t)l * INW * D; j.K = D; j.N = INW; j.dst_row0 = dr; j.k0 = kb * 64; j.n0 = n0; return j; }
    r -= I_IN;
    if (r < I_SQ) { j.W = F.in[10] + (size_t)l * D * D; j.gain = F.in[9] + (size_t)l * D; j.WT = (bf16*)(F.ws + WS_WOUT) + (size_t)l * D * D; j.K = D; j.N = D; j.dst_row0 = (r % 32) * 32; j.k0 = (r / 32) * 64; j.n0 = (r % 32) * 32; return j; }
    r -= I_SQ;
    if (r < I_KV) { j.W = F.in[14] + (size_t)l * D * 2 * D; j.gain = nullptr; j.WT = (bf16*)(F.ws + WS_WKVT) + (size_t)l * 2 * D * D; j.K = D; j.N = 2 * D; j.dst_row0 = (r % 64) * 32; j.k0 = (r / 64) * 64; j.n0 = (r % 64) * 32; return j; }
    r -= I_KV;
    if (r < I_SQ) { j.W = F.in[15] + (size_t)l * D * D; j.gain = nullptr; j.WT = (bf16*)(F.ws + WS_WOT) + (size_t)l * D * D; j.K = D; j.N = D; j.dst_row0 = (r % 32) * 32; j.k0 = (r / 32) * 64; j.n0 = (r % 32) * 32; return j; }
    r -= I_SQ;
    const int e = r / (3 * I_SQ), rr = r % (3 * I_SQ), which = rr / I_SQ, sub = rr % I_SQ, kb = sub / 32, n0 = (sub % 32) * 32;
    const size_t mo = ((size_t)l * NE + e) * D * FF;
    j.K = D; j.N = FF; j.k0 = kb * 64; j.n0 = n0;
    if (which == 2) { j.W = F.in[20] + mo; j.gain = nullptr; j.WT = (bf16*)(F.ws + WS_WD) + mo; j.dst_row0 = n0; }
    else { j.W = (which == 0 ? F.in[18] : F.in[19]) + mo; j.gain = F.in[16] + (size_t)l * D; j.WT = (bf16*)(F.ws + WS_WGU) + 2 * mo; j.dst_row0 = 256 * (n0 >> 7) + 128 * which + (n0 & 127); }
    return j;
}
#define CVT_LOAD(J, R) do { const float* p_ = (J).W + (size_t)((J).k0 + (lane_ >> 5)) * (J).N + (J).n0 + (lane_ & 31); _Pragma("unroll") for (int i_ = 0; i_ < 32; ++i_) R[i_] = p_[(size_t)(2 * i_) * (J).N]; } while (0)
__device__ __forceinline__ void ph_convert(Frame& F) {
    int lane_ = lane_id(); asm volatile("" : "+v"(lane_)); const int tid_ = F.wave * 64 + lane_;
    LAS float* scr = (LAS float*)(F.lds + F.wave * 16384);
    const int gw = F.vcu * NWAVES + F.wave, NGW = F.G * NWAVES;
    constexpr int I_LAYER = 16 * 56 + 512 + 1024 + 512 + NE * 3 * 512, NITEMS = NL * I_LAYER;
    if (gw < NITEMS) {
        int it = gw; CvtJob cur = cvt_decode(F, it); float r[32]; CVT_LOAD(cur, r);
        for (;;) {
            const int nit = it + NGW; const bool hn = nit < NITEMS; CvtJob nx = cur; if (hn) nx = cvt_decode(F, nit);
#pragma unroll
            for (int i = 0; i < 32; ++i) scr[(2 * i + (lane_ >> 5)) * 33 + (lane_ & 31)] = r[i];
            if (hn) CVT_LOAD(nx, r);
            asm volatile("s_waitcnt lgkmcnt(0)" ::: "memory");
            const int c = lane_ & 7;
            f32x4 g0 = (f32x4){1.f, 1.f, 1.f, 1.f}, g1 = g0;
            if (cur.gain) { g0 = *(const f32x4*)(cur.gain + cur.k0 + 8 * c); g1 = *(const f32x4*)(cur.gain + cur.k0 + 8 * c + 4); }
#pragma unroll
            for (int j = 0; j < 4; ++j) { const int n = (lane_ >> 3) + 8 * j; const LAS float* sp = scr + (8 * c) * 33 + n;
                v4u o; o.x = pk2(sp[0 * 33] * g0[0], sp[1 * 33] * g0[1]); o.y = pk2(sp[2 * 33] * g0[2], sp[3 * 33] * g0[3]); o.z = pk2(sp[4 * 33] * g1[0], sp[5 * 33] * g1[1]); o.w = pk2(sp[6 * 33] * g1[2], sp[7 * 33] * g1[3]);
                *(v4u*)(cur.WT + (size_t)(cur.dst_row0 + n) * cur.K + cur.k0 + 8 * c) = o; }
            asm volatile("s_waitcnt lgkmcnt(0)" ::: "memory");
            if (!hn) break; cur = nx; it = nit;
        }
    }
    {   const float* wsrc = F.in[5]; bf16* WSBd = (bf16*)(F.ws + WS_WSB);
        for (int i = F.vcu * NTHR + tid_; i < NL * 4 * 128 * 128 / 8; i += F.G * NTHR) { const f32x4 a = *(const f32x4*)(wsrc + (size_t)i * 8), b = *(const f32x4*)(wsrc + (size_t)i * 8 + 4);
            v4u o; o.x = pk2(a.x, a.y); o.y = pk2(a.z, a.w); o.z = pk2(b.x, b.y); o.w = pk2(b.z, b.w); *(v4u*)(WSBd + (size_t)i * 8) = o; } }
    const int gt = F.vcu * NTHR + tid_, NGT = F.G * NTHR;
    const float* wq = F.in[13]; bf16* WQB = (bf16*)(F.ws + WS_WQB);
    for (int i = gt; i < NL * D * D / 8; i += NGT) { const f32x4 a = *(const f32x4*)(wq + (size_t)i * 8), b = *(const f32x4*)(wq + (size_t)i * 8 + 4);
        v4u o; o.x = pk2(a.x, a.y); o.y = pk2(a.z, a.w); o.z = pk2(b.x, b.y); o.w = pk2(b.z, b.w); *(v4u*)(WQB + (size_t)i * 8) = o; }
}

struct SchedDense {
    pg8::TileOrder o; const char* A; size_t a_tile; const char* B; size_t b_tile, b_batch; int bdiv, bmod;
    __device__ __forceinline__ bool next(int i, pg8::Unit& u) const { if (!o.tile(i, u.pm, u.pn)) return false;
        u.z = 0; u.gi = nullptr; u.grow = 0; u.a = A + (size_t)u.pm * a_tile; u.b = B + (size_t)((u.pm / bdiv) % bmod) * b_batch + (size_t)u.pn * b_tile; return true; }
};
struct SchedE1 {
    pg8::TileOrder o; const char* HBp; const int* IDX; const char* WGU;
    __device__ __forceinline__ bool next(int i, pg8::Unit& u) const { if (!o.tile(i, u.pm, u.pn)) return false;
        const int z = u.pm >> 2; u.z = z; u.gi = IDX + (size_t)u.pm * 256; u.grow = (z >> 4) * SEQ; u.a = HBp;
        u.b = WGU + (size_t)(z & 15) * (2 * FF * D * 2) + (size_t)u.pn * (256 * D * 2); return true; }
};
struct SchedKV { pg8::TileOrder o; const char* MEMN; const char* WKVT;
    __device__ __forceinline__ bool next(int i, pg8::Unit& u) const { if (!o.tile(i, u.pm, u.pn)) return false; u.z = 0; u.gi = nullptr; u.grow = 0;
        u.a = MEMN + (size_t)(u.pm & 3) * (256 * D * 2); u.b = WKVT + (size_t)(u.pm >> 2) * (2 * D * D * 2) + (size_t)u.pn * (256 * D * 2); return true; } };
struct SchedQK { pg8::TileOrder o; const char* KVM; const char* WQB;
    __device__ __forceinline__ bool next(int i, pg8::Unit& u) const { if (!o.tile(i, u.pm, u.pn)) return false; u.z = 0; u.gi = nullptr; u.grow = 0;
        const int h = u.pm & 3, lb = u.pm >> 2, b = lb & 3, l = lb >> 2;
        u.a = KVM + ((size_t)l * NMEM * 2 * D + (size_t)(b * 256) * 2 * D + h * 256) * 2; u.b = WQB + ((size_t)l * D * D + (size_t)u.pn * 256 * D + h * 256) * 2; return true; } };
struct SchedVO { pg8::TileOrder o; const char* KVM; const char* WOT;
    __device__ __forceinline__ bool next(int i, pg8::Unit& u) const { if (!o.tile(i, u.pm, u.pn)) return false; u.z = 0; u.gi = nullptr; u.grow = 0;
        const int pml = u.pm & 3, lbh = u.pm >> 2, h = lbh & 3, lb = lbh >> 2, b = lb & 3, l = lb >> 2;
        u.a = WOT + ((size_t)l * D * D + (size_t)pml * 256 * D + h * 256) * 2; u.b = KVM + ((size_t)l * NMEM * 2 * D + (size_t)(b * 256) * 2 * D + D + h * 256) * 2; return true; } };

namespace attn_body {
using bf16=__hip_bfloat16;
using bf16x8=__attribute__((ext_vector_type(8)))short;
using s16x4=__attribute__((ext_vector_type(4)))short;
using f32x16=__attribute__((ext_vector_type(16)))float;
using u32x4=__attribute__((ext_vector_type(4)))unsigned;
constexpr int SEQ=8192,D=64,QP=512,KP=128,OP=1024;
constexpr int NW=8,QBLK=32,QB=QBLK*NW,KVBLK=64,NQB=SEQ/QB;
constexpr int ATTN_UNIT_ROWS=QB;
__device__ __forceinline__ int crow(int r,int hi){return (r&3)+8*(r>>2)+4*hi;}
#define SBAR() __builtin_amdgcn_sched_barrier(0)
__device__ __forceinline__ void cmask(f32x16&p0,f32x16&p1,int jb,int qrel,int hi){
  const float NEG=-INFINITY; int kb=64*jb+4*hi;
  #pragma unroll
  for(int r=0;r<16;++r){int kv=kb+(r&3)+8*(r>>2); if(kv>qrel)p0[r]=NEG; if(kv+32>qrel)p1[r]=NEG;}
}

constexpr int NSLOT=3, SLOTB=8192;
constexpr int LDS_K=0, LDS_V=NSLOT*SLOTB, LDS_WS=2*NSLOT*SLOTB, LDS_OST=LDS_WS+NW*64*4, LDS_BYTES=LDS_OST+NW*4096;
constexpr float C2=0.125f*1.4426950408889634f;
__device__ __forceinline__ void glds16(const void*gsrc,unsigned lds_dst){unsigned keep;
  asm volatile("s_mov_b32 %0, m0\n\ts_mov_b32 m0, %2\n\ts_nop 0\n\tglobal_load_lds_dwordx4 %1, off\n\ts_mov_b32 m0, %0":"=&s"(keep):"v"(gsrc),"s"(lds_dst):"memory");}
__device__ __forceinline__ float max3f(float a,float b,float c){float r;asm("v_max3_f32 %0, %1, %2, %3":"=v"(r):"v"(a),"v"(b),"v"(c));return r;}
__device__ __forceinline__ float max2f(float a,float b){float r;asm("v_max_f32_e32 %0, %1, %2":"=v"(r):"v"(a),"v"(b));return r;}
__device__ __forceinline__ float fadd_s(float a,float b){float r;asm("v_add_f32_e32 %0, %1, %2":"=v"(r):"v"(a),"v"(b));return r;}
__device__ __forceinline__ float fsub_s(float a,float b){float r;asm("v_sub_f32_e32 %0, %1, %2":"=v"(r):"v"(a),"v"(b));return r;}
typedef float f32x2_t __attribute__((ext_vector_type(2))); typedef __bf16 bf16x2_t __attribute__((ext_vector_type(2)));
__device__ __forceinline__ unsigned cvtpk_s(float lo,float hi){f32x2_t v={lo,hi};bf16x2_t b=__builtin_convertvector(v,bf16x2_t);return __builtin_bit_cast(unsigned,b);}
#define WAIT_BAR(N) asm volatile("s_waitcnt vmcnt(" #N ") lgkmcnt(0)\n\ts_barrier":::"memory")

__device__ __forceinline__ void qkt(f32x16&p0,f32x16&p1,const char*Kslot,const bf16x8*qr,const f32x16&negm,int r32,int hi){
  const char*kb=Kslot+hi*1024+r32*16;
  #pragma unroll
  for(int d0=0;d0<4;++d0){
    const bf16x8 b0=*reinterpret_cast<const bf16x8*>(kb+d0*2048);
    const bf16x8 b1=*reinterpret_cast<const bf16x8*>(kb+d0*2048+512);
    if(d0==0){p0=__builtin_amdgcn_mfma_f32_32x32x16_bf16(b0,qr[0],negm,0,0,0);p1=__builtin_amdgcn_mfma_f32_32x32x16_bf16(b1,qr[0],negm,0,0,0);}
    else{p0=__builtin_amdgcn_mfma_f32_32x32x16_bf16(b0,qr[d0],p0,0,0,0);p1=__builtin_amdgcn_mfma_f32_32x32x16_bf16(b1,qr[d0],p1,0,0,0);}}
}
typedef __attribute__((address_space(3))) const char* lds_cptr;
typedef short v4i16_t __attribute__((ext_vector_type(4)));
__device__ __forceinline__ void kload8(bf16x8*kf,lds_cptr kp){
  kf[0]=*(const __attribute__((address_space(3))) bf16x8*)(kp);      kf[1]=*(const __attribute__((address_space(3))) bf16x8*)(kp+512);
  kf[2]=*(const __attribute__((address_space(3))) bf16x8*)(kp+2048); kf[3]=*(const __attribute__((address_space(3))) bf16x8*)(kp+2560);
  kf[4]=*(const __attribute__((address_space(3))) bf16x8*)(kp+4096); kf[5]=*(const __attribute__((address_space(3))) bf16x8*)(kp+4608);
  kf[6]=*(const __attribute__((address_space(3))) bf16x8*)(kp+6144); kf[7]=*(const __attribute__((address_space(3))) bf16x8*)(kp+6656);
}
__device__ __forceinline__ void kload2(bf16x8*kf,lds_cptr kp,int j){ kf[2*j]=*(const __attribute__((address_space(3))) bf16x8*)(kp+j*2048); kf[2*j+1]=*(const __attribute__((address_space(3))) bf16x8*)(kp+j*2048+512); }
__device__ __forceinline__ s16x4 vtr(lds_cptr p){ return __builtin_bit_cast(s16x4,__builtin_amdgcn_ds_read_tr16_b64_v4i16((__attribute__((address_space(3))) v4i16_t*)p)); }
__device__ __forceinline__ float rowmax(const f32x16&p0,const f32x16&p1){
  float a=max3f(p0[0],p0[1],p1[0]),b=max3f(p0[2],p0[3],p1[1]);a=max3f(a,p1[2],p1[3]);
  #pragma unroll
  for(int r=4;r<16;r+=4){a=max3f(a,p0[r],p0[r+1]);b=max3f(b,p0[r+2],p0[r+3]);a=max3f(a,p1[r],p1[r+1]);b=max3f(b,p1[r+2],p1[r+3]);}
  const float m=max2f(a,b);
  auto rr=__builtin_amdgcn_permlane32_swap(__float_as_uint(m),__float_as_uint(m),false,false);
  return max2f(__uint_as_float(rr[0]),__uint_as_float(rr[1]));
}
__device__ __forceinline__ void pv(f32x16*o,int vb,bf16x8 pa0,bf16x8 pa1,bf16x8 pa2,bf16x8 pa3){
  #pragma unroll
  for(int d0=0;d0<2;++d0){s16x4 lo[4],hi[4];
    #pragma unroll
    for(int ks=0;ks<4;++ks){
      asm volatile("ds_read_b64_tr_b16 %0,%1 offset:%c2":"=&v"(lo[ks]):"v"(vb),"i"(d0*4096+ks*1024):"memory");
      asm volatile("ds_read_b64_tr_b16 %0,%1 offset:%c2":"=&v"(hi[ks]):"v"(vb),"i"(d0*4096+ks*1024+512):"memory");}
    asm volatile("s_waitcnt lgkmcnt(0)":::"memory");SBAR();
    #define PK(k) (bf16x8){lo[k][0],lo[k][1],lo[k][2],lo[k][3],hi[k][0],hi[k][1],hi[k][2],hi[k][3]}
    o[d0]=__builtin_amdgcn_mfma_f32_32x32x16_bf16(pa0,PK(0),o[d0],0,0,0);
    o[d0]=__builtin_amdgcn_mfma_f32_32x32x16_bf16(pa1,PK(1),o[d0],0,0,0);
    o[d0]=__builtin_amdgcn_mfma_f32_32x32x16_bf16(pa2,PK(2),o[d0],0,0,0);
    o[d0]=__builtin_amdgcn_mfma_f32_32x32x16_bf16(pa3,PK(3),o[d0],0,0,0);
    #undef PK
  }
}

#ifndef ATTN_STORE16
#define ATTN_STORE16(p,v) (*(u32x4*)(p)=(v))
#endif
template<int THRL> __device__ __forceinline__ void attn_unit(int b,int h,int qb,const bf16*Q,const bf16*__restrict__ K,const bf16*__restrict__ V,bf16*O,float*ATS,char*shm,int wave_idx){
  int lane=(int)__builtin_amdgcn_mbcnt_hi(~0u,__builtin_amdgcn_mbcnt_lo(~0u,0u)); asm volatile("":"+v"(lane)); const int r32=lane&31,hi=lane>>5; const int wid=wave_idx; const int kvh=h>>2;
  const long rowbase=(long)b*SEQ; const int q0=qb*QB;
  const bf16*Qw=Q+(rowbase+q0+wid*QBLK)*QP+h*D;
  const bf16*Kh=K+rowbase*KP+kvh*D,*Vh=V+rowbase*KP+kvh*D;
  const unsigned lds0=(unsigned)(uintptr_t)shm;
  float*wsf=(float*)(shm+LDS_WS)+wid*64;
  const bf16*ksrc=Kh+(long)lane*KP+wid*8;
  const bf16*vsrc=Vh+(long)(16*(wid&3)+(lane>>2))*KP+(wid>>2)*32+(lane&3)*8;
  const unsigned kdst=lds0+LDS_K+wid*1024, vdst=lds0+LDS_V+wid*1024;
  #define DMA_K(t,slot) glds16(ksrc+(long)(t)*KVBLK*KP,(unsigned)__builtin_amdgcn_readfirstlane(kdst+(slot)))
  #define DMA_V(t,slot) glds16(vsrc+(long)(t)*KVBLK*KP,(unsigned)__builtin_amdgcn_readfirstlane(vdst+(slot)))
  const int vb0=(int)(lds0+LDS_V)+((lane>>4)&1)*32+(lane&3)*8+(4*hi+((lane&15)>>2))*64;
  const char*Kbase=shm+LDS_K; bf16x8 kf[8];
  const lds_cptr shm3=(lds_cptr)shm; const lds_cptr kp0=shm3+LDS_K+hi*1024+r32*16; const lds_cptr vp0=shm3+LDS_V+((lane>>4)&1)*32+(lane&3)*8+(4*hi+((lane&15)>>2))*64;
  const int NT=SEQ/KVBLK;
  DMA_K(0,0);DMA_V(0,0);DMA_K(1,SLOTB);
  bf16x8 qr[4];
  #pragma unroll
  for(int d0=0;d0<4;++d0)qr[d0]=*reinterpret_cast<const bf16x8*>(&Qw[(long)r32*QP+d0*16+hi*8]);
  float mhat=0.f,l_reg=0.f;f32x16 o[2];o[0]=f32x16{};o[1]=f32x16{};f32x16 negm=f32x16{};asm volatile("":"+v"(negm));
  const int qrel=wid*QBLK+r32;
  #define CMASK(P0,P1,t) do{}while(0)
  bool resc=false;
  #define START(P0,P1) do{ const float rm=rowmax(P0,P1); resc=false; \
    { const float dl=rm; mhat=fadd_s(mhat,dl); \
      _Pragma("unroll") for(int r=0;r<16;++r){P0[r]=fsub_s(P0[r],dl);P1[r]=fsub_s(P1[r],dl);} \
      _Pragma("unroll") for(int r=0;r<16;++r)negm[r]=-mhat; asm volatile("":"+v"(negm)); } \
    _Pragma("unroll") for(int r=0;r<16;++r)P0[r]=__builtin_amdgcn_exp2f(P0[r]); }while(0)
  #define RESC() do{ if(resc){ asm volatile("s_waitcnt lgkmcnt(0)":::"memory"); \
      _Pragma("unroll") for(int d_=0;d_<2;++d_) _Pragma("unroll") for(int r=0;r<16;++r)o[d_][r]*=wsf[crow(r,hi)]; } }while(0)
  f32x16 pA0,pA1,pB0,pB1;
  int sl_prev=0,sl_cur=0,sl_next=SLOTB;
  #define ROT() do{sl_prev=sl_cur;sl_cur=sl_next;sl_next=(sl_next==(NSLOT-1)*SLOTB)?0:sl_next+SLOTB;}while(0)
  DMA_K(2,2*SLOTB);
  WAIT_BAR(3);
  qkt(pA0,pA1,Kbase,qr,negm,r32,hi);asm volatile("s_nop 15\n\ts_nop 7":"+v"(pA0),"+v"(pA1));CMASK(pA0,pA1,0);
  START(pA0,pA1);
  _Pragma("unroll") for(int r=0;r<16;++r)pA1[r]=__builtin_amdgcn_exp2f(pA1[r]);
  WAIT_BAR(0);
  DMA_K(3,0);DMA_V(1,SLOTB);
  ROT();
  kload8(kf,kp0+sl_cur);
  WAIT_BAR(2);
  s16x4 vlo[8],vhi[8]; u32x4 pw0,pw1,pw2,pw3;
  #define PKW(P,B) cvtpk_s(P[B],P[B+1])
  #define PAF(k) __builtin_bit_cast(bf16x8,pw##k)
  #define VFR(i) (bf16x8){vlo[i][0],vlo[i][1],vlo[i][2],vlo[i][3],vhi[i][0],vhi[i][1],vhi[i][2],vhi[i][3]}
  #define PIN(x) asm volatile("":"+v"(x))
  #define MX3(a,b,c) __builtin_fmaxf(__builtin_fmaxf((a),(b)),(c))
  #define GAPA(MF,A0,A1,A2,A3,W0,W1,PW) do{ MF; sacc+=A0; sacc+=A1; sacc+=A2; sacc+=A3; PIN(sacc); W0; W1; PIN(PW); SBAR(); }while(0)
  #define EX(v) __builtin_amdgcn_exp2f(v)
  #define GAPB(MF,X,B) do{ MF; X[B]=EX(X[B]); X[B+1]=EX(X[B+1]); X[B+2]=EX(X[B+2]); X[B+3]=EX(X[B+3]); PIN(X); SBAR(); }while(0)
  #define VRD(i) do{ vlo[i]=vtr(vp_+(((i)>>2)*4096+((i)&3)*1024)); vhi[i]=vtr(vp_+(((i)>>2)*4096+((i)&3)*1024+512)); }while(0)
  #define KRD(G,j) do{ if(G){ kload2(kf,kp0+sl_next,j); SBAR(); } }while(0)
  #define STEP(C0,C1,P0,P1,t,GK,GV,GL) do{ SBAR(); \
    const lds_cptr vp_=vp0+sl_prev; \
    VRD(0); SBAR(); float sacc=(P0[0]+P0[1]); \
    GAPA(C0=__builtin_amdgcn_mfma_f32_32x32x16_bf16(kf[0],qr[0],negm,0,0,0), P0[2],P0[3],P0[4],P0[5],     pw0[0]=PKW(P0,0), pw0[1]=PKW(P0,2), pw0); \
    VRD(4); SBAR(); GAPA(C1=__builtin_amdgcn_mfma_f32_32x32x16_bf16(kf[1],qr[0],negm,0,0,0), P0[6],P0[7],P0[8],P0[9],     pw0[2]=PKW(P0,4), pw0[3]=PKW(P0,6), pw0); \
    VRD(1); SBAR(); GAPA(C0=__builtin_amdgcn_mfma_f32_32x32x16_bf16(kf[2],qr[1],C0,0,0,0),   P0[10],P0[11],P0[12],P0[13], pw1[0]=PKW(P0,8), pw1[1]=PKW(P0,10), pw1); \
    VRD(5); SBAR(); GAPA(C1=__builtin_amdgcn_mfma_f32_32x32x16_bf16(kf[3],qr[1],C1,0,0,0),   P0[14],P0[15],P1[0],P1[1],   pw1[2]=PKW(P0,12),pw1[3]=PKW(P0,14), pw1); \
    VRD(2); SBAR(); GAPA(C0=__builtin_amdgcn_mfma_f32_32x32x16_bf16(kf[4],qr[2],C0,0,0,0),   P1[2],P1[3],P1[4],P1[5],     pw2[0]=PKW(P1,0), pw2[1]=PKW(P1,2), pw2); \
    VRD(6); SBAR(); GAPA(C1=__builtin_amdgcn_mfma_f32_32x32x16_bf16(kf[5],qr[2],C1,0,0,0),   P1[6],P1[7],P1[8],P1[9],     pw2[2]=PKW(P1,4), pw2[3]=PKW(P1,6), pw2); \
    VRD(3); SBAR(); GAPA(C0=__builtin_amdgcn_mfma_f32_32x32x16_bf16(kf[6],qr[3],C0,0,0,0),   P1[10],P1[11],P1[12],P1[13], pw3[0]=PKW(P1,8), pw3[1]=PKW(P1,10), pw3); \
    VRD(7); SBAR(); GAPA(C1=__builtin_amdgcn_mfma_f32_32x32x16_bf16(kf[7],qr[3],C1,0,0,0),   P1[14],P1[15],0.f,0.f,       pw3[2]=PKW(P1,12),pw3[3]=PKW(P1,14), pw3); \
    l_reg+=sacc; \
    if(GK){DMA_K((t)+3,sl_cur);} if(GV){DMA_V((t)+1,sl_next);} \
    CMASK(C0,C1,t); \
    { float a=MX3(C0[0],C0[1],C1[0]),b=MX3(C0[2],C0[3],C1[1]); a=MX3(a,C1[2],C1[3]); \
      _Pragma("unroll") for(int r=4;r<16;r+=4){a=MX3(a,C0[r],C0[r+1]);b=MX3(b,C0[r+2],C0[r+3]);a=MX3(a,C1[r],C1[r+1]);b=MX3(b,C1[r+2],C1[r+3]);} \
      float rm=__builtin_fmaxf(a,b); { auto rr=__builtin_amdgcn_permlane32_swap(__float_as_uint(rm),__float_as_uint(rm),false,false); rm=__builtin_fmaxf(__uint_as_float(rr[0]),__uint_as_float(rr[1])); } \
      resc=false; \
      if(__builtin_expect(__any(rm>(float)THRL),0)){ const float dl=__builtin_fmaxf(rm,0.f); mhat+=dl; \
        _Pragma("unroll") for(int r=0;r<16;++r){C0[r]-=dl;C1[r]-=dl;} \
        _Pragma("unroll") for(int r=0;r<16;++r)negm[r]=-mhat; asm volatile("":"+v"(negm)); \
        const float f=__builtin_amdgcn_exp2f(-dl); l_reg*=f; if(hi==0)wsf[r32]=f; resc=true; } } \
    SBAR(); \
    GAPB(o[0]=__builtin_amdgcn_mfma_f32_32x32x16_bf16(PAF(0),VFR(0),o[0],0,0,0), C0,0); \
    GAPB(o[1]=__builtin_amdgcn_mfma_f32_32x32x16_bf16(PAF(0),VFR(4),o[1],0,0,0), C0,4); \
    KRD(GL,0); GAPB(o[0]=__builtin_amdgcn_mfma_f32_32x32x16_bf16(PAF(1),VFR(1),o[0],0,0,0), C0,8); \
    KRD(GL,1); GAPB(o[1]=__builtin_amdgcn_mfma_f32_32x32x16_bf16(PAF(1),VFR(5),o[1],0,0,0), C0,12); \
    KRD(GL,2); GAPB(o[0]=__builtin_amdgcn_mfma_f32_32x32x16_bf16(PAF(2),VFR(2),o[0],0,0,0), C1,0); \
    KRD(GL,3); GAPB(o[1]=__builtin_amdgcn_mfma_f32_32x32x16_bf16(PAF(2),VFR(6),o[1],0,0,0), C1,4); \
    GAPB(o[0]=__builtin_amdgcn_mfma_f32_32x32x16_bf16(PAF(3),VFR(3),o[0],0,0,0), C1,8); \
    GAPB(o[1]=__builtin_amdgcn_mfma_f32_32x32x16_bf16(PAF(3),VFR(7),o[1],0,0,0), C1,12); \
    }while(0)
  int t=1;
  for(;t+5<NT;t+=2){
    STEP(pB0,pB1,pA0,pA1,t,true,true,true);     WAIT_BAR(2); RESC(); ROT();
    STEP(pA0,pA1,pB0,pB1,t+1,true,true,true);   WAIT_BAR(2); RESC(); ROT();
  }
  #define ENDW(tt) do{ if((tt)+3<NT){WAIT_BAR(2);} else if((tt)+2<NT){WAIT_BAR(1);} else {WAIT_BAR(0);} }while(0)
  for(;t+1<NT;t+=2){
    STEP(pB0,pB1,pA0,pA1,t,(t+3<NT),(t+1<NT),(t+1<NT));       ENDW(t);   RESC(); ROT();
    STEP(pA0,pA1,pB0,pB1,t+1,(t+4<NT),(t+2<NT),(t+2<NT));     ENDW(t+1); RESC(); ROT();
  }
  STEP(pB0,pB1,pA0,pA1,NT-1,false,false,false); RESC();
  { float sacc=pB0[0]+pB0[1]; _Pragma("unroll") for(int r=2;r<16;++r)sacc+=pB0[r]; _Pragma("unroll") for(int r=0;r<16;++r)sacc+=pB1[r]; l_reg+=sacc;
    pw0=(u32x4){PKW(pB0,0),PKW(pB0,2),PKW(pB0,4),PKW(pB0,6)};pw1=(u32x4){PKW(pB0,8),PKW(pB0,10),PKW(pB0,12),PKW(pB0,14)};pw2=(u32x4){PKW(pB1,0),PKW(pB1,2),PKW(pB1,4),PKW(pB1,6)};pw3=(u32x4){PKW(pB1,8),PKW(pB1,10),PKW(pB1,12),PKW(pB1,14)};
    SBAR(); pv(o,vb0+sl_cur,PAF(0),PAF(1),PAF(2),PAF(3)); }
  #undef PKW
  #undef PAF
  #undef VFR
  #undef PIN
  #undef MX3
  #undef GAPA
  #undef GAPB
  #undef EX
  #undef VRD
  #undef KRD
  #undef STEP
  #undef ENDW
  {auto rr=__builtin_amdgcn_permlane32_swap(__float_as_uint(l_reg),__float_as_uint(l_reg),false,false);l_reg=__uint_as_float(rr[0])+__uint_as_float(rr[1]);}
  if(hi==0)wsf[32+r32]=l_reg;asm volatile("s_waitcnt lgkmcnt(0)":::"memory");
  float rli[16];
  #pragma unroll
  for(int r=0;r<16;++r)rli[r]=__builtin_amdgcn_rcpf(wsf[32+crow(r,hi)]);
  bf16*Ow=O+(rowbase+q0+wid*QBLK)*OP+512+h*D; float*ATw=ATS+(rowbase+q0+wid*QBLK)*8+h;
  { bf16*stg=(bf16*)(shm+LDS_OST)+wid*2048;
    #pragma unroll
    for(int r=0;r<16;++r){const int orow=crow(r,hi);
      #pragma unroll
      for(int d0=0;d0<2;++d0)stg[orow*64+d0*32+r32]=__float2bfloat16(o[d0][r]*rli[r]);}
    asm volatile("s_waitcnt lgkmcnt(0)":::"memory");
    #pragma unroll
    for(int i=0;i<4;++i){const int row=i*8+(lane>>3),ch=lane&7; const u32x4 v=*(const u32x4*)(stg+row*64+ch*8); ATTN_STORE16(Ow+(long)row*OP+ch*8,v);
      float ss=0.f;
      #pragma unroll
      for(int q=0;q<4;++q){const float lo=__uint_as_float(v[q]<<16),hh=__uint_as_float(v[q]&0xffff0000u);ss+=lo*lo+hh*hh;}
      ss+=__shfl_xor(ss,1);ss+=__shfl_xor(ss,2);ss+=__shfl_xor(ss,4); if(ch==0)ATw[(long)row*8]=ss;} }
  asm volatile("s_waitcnt lgkmcnt(0)\n\ts_barrier":::"memory");
  #undef DMA_K
  #undef DMA_V
  #undef CMASK
  #undef START
  #undef RESC
  #undef ROT
}
constexpr int ATTN_LDS_BYTES=LDS_BYTES;
#undef SBAR
#undef WAIT_BAR
}

__global__ void __launch_bounds__(NTHR, 2) mega(Args args) {
    extern __shared__ __attribute__((aligned(16))) unsigned char lds[];
    Frame F;
    F.lds = (LAS unsigned char*)lds;
    F.wave = __builtin_amdgcn_readfirstlane(threadIdx.x >> 6);
    F.G = gridDim.x; { const int bx = blockIdx.x; F.vcu = (F.G % 8 == 0) ? (bx % 8) * (F.G / 8) + bx / 8 : bx; }
#pragma unroll
    for (int i = 0; i < 22; ++i) F.in[i] = args.in[i];
    F.ws = args.ws; F.xres = args.out;
    volatile LAS unsigned* MISC = (volatile LAS unsigned*)(F.lds + MISC_OFF);
    for (int u = threadIdx.x; u < (LDS_BYTES - LDSCTL_OFF) / 4; u += NTHR) ((LAS unsigned*)(F.lds + LDSCTL_OFF))[u] = 0u;
    __syncthreads();
    const int lo = args.ph_lo, hi = args.ph_hi;
    unsigned* barw = (unsigned*)(F.ws + WS_CTL) + CW_BAR + args.bar_region * XCD_BAR_WORDS;
    XcdBarrier bar; bar.bar = barw; bar.x = 0; bar.st = nullptr;
    if (hi - lo > 1) bar = xcd_barrier_post(barw, MISC + 8);
#ifndef ONLY_K
#define ONLY_K -1
#endif
#define EN(kind) (ONLY_K < 0 || ONLY_K == (kind))
#define IN(k) (lo <= (k) && (k) < hi)
#ifndef REPK
#define REPK -1
#endif
#define PROBE_TOP(k) for (int rep_ = 0; rep_ < (REPK == (k) ? 2 : 1); ++rep_) {
#define PROBE_END(k) if (REPK == (k) && rep_ == 0) xcd_barrier(bar); }
#define SEAM(k) do { if (IN(k) && IN((k) + 1)) xcd_barrier(bar); } while (0)
    const int cid0 = (int)blockIdx.x; const int cid = cid0;
    if (EN(100) && IN(0)) { asm volatile("; PHASE_MARK P0"); PROBE_TOP(100) ph_rows0(F); PROBE_END(100) } SEAM(0);
    if (EN(101) && IN(1)) { asm volatile("; PHASE_MARK P1"); PROBE_TOP(101) ph_convert(F); PROBE_END(101) } SEAM(1);
    if (EN(102) && IN(2)) { asm volatile("; PHASE_MARK P2"); PROBE_TOP(102)
        SchedKV S; S.o.init(NL * 4, 8, F.G, cid); S.MEMN = (const char*)(F.ws + WS_MEMN); S.WKVT = (const char*)(F.ws + WS_WKVT);
        pg8::EpiStore<3> E{(bf16*)(F.ws + WS_KVM), 2 * D, nullptr, 1.0f};
        pg8::gemm_phase<pg8::EpiStore<3>, SchedKV, true, false>(F.lds, F.wave, D, D, D, S, E);
    PROBE_END(102) } SEAM(2);
    if (EN(103) && IN(3)) { asm volatile("; PHASE_MARK P3a");
        SchedQK S; S.o.init(NL * 16, 4, F.G, cid); S.KVM = (const char*)(F.ws + WS_KVM); S.WQB = (const char*)(F.ws + WS_WQB);
        pg8::EpiStore<1> E{(bf16*)(F.ws + WS_QKT), D, F.in[11], XQSCALE};
        int la = 2 * D, lb = D, kk = 256; asm volatile("" : "+s"(la), "+s"(lb), "+s"(kk));
        pg8::gemm_phase<pg8::EpiStore<1>, SchedQK, true, false>(F.lds, F.wave, la, lb, kk, S, E);
    }
    if (EN(104) && IN(3)) { asm volatile("; PHASE_MARK P3b");
        SchedVO S; S.o.init(NL * 64, 1, F.G, cid); S.KVM = (const char*)(F.ws + WS_KVM); S.WOT = (const char*)(F.ws + WS_WOT);
        pg8::EpiStore<2> E{(bf16*)(F.ws + WS_VOT), D, nullptr, 1.0f};
        int la = D, lb = 2 * D, kk = 256; asm volatile("" : "+s"(la), "+s"(lb), "+s"(kk));
        pg8::gemm_phase<pg8::EpiStore<2>, SchedVO, true, false>(F.lds, F.wave, la, lb, kk, S, E);
    } SEAM(3);
    for (int l = 0; l < NL; ++l) {
        const int pb = PH_LAYER0 + PH_PER_LAYER * l;
        int cid = cid0; asm volatile("" : "+s"(cid));
        if (EN(0) && IN(pb + 0)) { asm volatile("; PHASE_MARK L0"); PROBE_TOP(0)
            SchedDense S; S.o.init(T / 256, 7, F.G, cid); S.A = (const char*)(F.ws + WS_HB); S.a_tile = 256 * D * 2; S.B = (const char*)(F.ws + WS_WIN) + (size_t)l * INW * D * 2; S.b_tile = 256 * D * 2; S.b_batch = 0; S.bdiv = 1; S.bmod = 1;
            pg8::EpiIn E{(bf16*)(F.ws + WS_UACT), (bf16*)(F.ws + WS_VACT), (bf16*)(F.ws + WS_Q), (bf16*)(F.ws + WS_K), (bf16*)(F.ws + WS_V), (float*)(F.ws + WS_VSTAT),
                         F.in[7] + (size_t)l * 64, F.in[8] + (size_t)l * 64, (const float*)(F.ws + WS_ROPE), (const float*)(F.ws + WS_ROPE) + SEQ * 32};
            pg8::gemm_phase<pg8::EpiIn, SchedDense, true, false>(F.lds, F.wave, D, D, D, S, E);
        PROBE_END(0) } SEAM(pb + 0);
        if (EN(1) && IN(pb + 1)) { asm volatile("; PHASE_MARK L1");
            PROBE_TOP(11)
            for (int it = 0; ; ++it) { const int w = it * F.G + F.vcu; if (w >= NB_ * 8 * (SEQ / 256)) break;
                const int i = w >> 8, c = w & 255, x = c >> 5, j = c & 31;
                attn_body::attn_unit<8>(x >> 1, (x & 1) * 4 + i, j, (const attn_body::bf16*)(F.ws + WS_Q), (const attn_body::bf16*)(F.ws + WS_K), (const attn_body::bf16*)(F.ws + WS_V),
                                        (attn_body::bf16*)(F.ws + WS_MERGED), (float*)(F.ws + WS_ATSTAT), (char*)lds, F.wave); }
            PROBE_END(11)
            PROBE_TOP(12) ph_gmlp(F, l); PROBE_END(12) } SEAM(pb + 1);
        if (EN(2) && IN(pb + 2)) { asm volatile("; PHASE_MARK L2"); PROBE_TOP(2)
            SchedDense S; S.o.init(T / 256, 4, F.G, cid); S.A = (const char*)(F.ws + WS_MERGED); S.a_tile = 256 * D * 2; S.B = (const char*)(F.ws + WS_WOUT) + (size_t)l * D * D * 2; S.b_tile = 256 * D * 2; S.b_batch = 0; S.bdiv = 1; S.bmod = 1;
            pg8::EpiX<true, true> E; E.base = l == 0 ? F.in[0] : F.xres; E.out = (REPK == 2 && rep_ == 0) ? (float*)(F.ws + WS_NSCR) : F.xres; E.xb = (REPK == 2 && rep_ == 0) ? (bf16*)(F.ws + WS_NSCR + 128 * MiB) : (bf16*)(F.ws + WS_XB); E.xstat = (float*)(F.ws + WS_XSTAT); E.gmstat = (const float*)(F.ws + WS_GMSTAT); E.atstat = (const float*)(F.ws + WS_ATSTAT); E.lds = F.lds;
            pg8::gemm_phase<pg8::EpiX<true, true>, SchedDense, true, false>(F.lds, F.wave, D, D, D, S, E);
        PROBE_END(2) } SEAM(pb + 2);
        if (EN(3) && IN(pb + 3)) { asm volatile("; PHASE_MARK L3"); PROBE_TOP(3)
            SchedDense S; S.o.init(T / 256, 4, F.G, cid); S.A = (const char*)(F.ws + WS_XB); S.a_tile = 256 * D * 2; S.B = (const char*)(F.ws + WS_QKT) + (size_t)l * NB_ * D * D * 2; S.b_tile = 256 * D * 2; S.b_batch = (size_t)D * D * 2; S.bdiv = SEQ / 256; S.bmod = NB_;
            pg8::EpiS E{(const float*)(F.ws + WS_XSTAT), (bf16*)(F.ws + WS_P), F.lds};
            pg8::gemm_phase<pg8::EpiS, SchedDense, true, false>(F.lds, F.wave, D, D, D, S, E);
        PROBE_END(3) } SEAM(pb + 3);
        if (EN(4) && IN(pb + 4)) { asm volatile("; PHASE_MARK L4"); PROBE_TOP(4)
            SchedDense S; S.o.init(T / 256, 4, F.G, cid); S.A = (const char*)(F.ws + WS_P); S.a_tile = 256 * D * 2; S.B = (const char*)(F.ws + WS_VOT) + (size_t)l * NB_ * D * D * 2; S.b_tile = 256 * D * 2; S.b_batch = (size_t)D * D * 2; S.bdiv = SEQ / 256; S.bmod = NB_;
            pg8::EpiX<false, false> E; E.base = F.xres; E.out = (REPK == 4 && rep_ == 0) ? (float*)(F.ws + WS_NSCR) : F.xres; E.xb = nullptr; E.xstat = nullptr; E.gmstat = nullptr; E.atstat = nullptr; E.lds = F.lds;
            pg8::gemm_phase<pg8::EpiX<false, false>, SchedDense, true, false>(F.lds, F.wave, D, D, D, S, E);
        PROBE_END(4) } SEAM(pb + 4);
        if (EN(5) && IN(pb + 5)) { asm volatile("; PHASE_MARK L5"); PROBE_TOP(5) ph_router(F, l); PROBE_END(5) } SEAM(pb + 5);
        if (EN(6) && IN(pb + 6)) { asm volatile("; PHASE_MARK L6"); PROBE_TOP(6) ph_topk(F); PROBE_END(6) } SEAM(pb + 6);
        if (EN(7) && IN(pb + 7)) { asm volatile("; PHASE_MARK L7"); PROBE_TOP(7)
            SchedE1 S; S.o.init(NB_ * NE * 4, 8, F.G, cid); S.HBp = (const char*)(F.ws + WS_HB); S.IDX = (const int*)(F.ws + WS_IDX); S.WGU = (const char*)(F.ws + WS_WGU) + (size_t)l * NE * 2 * FF * D * 2;
            pg8::EpiH E{(bf16*)(F.ws + WS_H)};
            pg8::gemm_phase<pg8::EpiH, SchedE1, true, true>(F.lds, F.wave, D, D, D, S, E);
        PROBE_END(7) } SEAM(pb + 7);
        if (EN(8) && IN(pb + 8)) { asm volatile("; PHASE_MARK L8"); PROBE_TOP(8)
            SchedDense S; S.o.init(NB_ * NE * 4, 4, F.G, cid); S.A = (const char*)(F.ws + WS_H); S.a_tile = 256 * FF * 2; S.B = (const char*)(F.ws + WS_WD) + (size_t)l * NE * D * FF * 2; S.b_tile = 256 * FF * 2; S.b_batch = (size_t)D * FF * 2; S.bdiv = 4; S.bmod = NE;
            pg8::EpiStore<0> E{(bf16*)(F.ws + WS_Y), D, nullptr, 1.0f};
            pg8::gemm_phase<pg8::EpiStore<0>, SchedDense, true, false>(F.lds, F.wave, FF, FF, FF, S, E);
        PROBE_END(8) } SEAM(pb + 8);
        if (EN(9) && IN(pb + 9)) { asm volatile("; PHASE_MARK L9"); PROBE_TOP(9) ph_combine(F, l, REPK == 9 && rep_ == 0); PROBE_END(9) } SEAM(pb + 9);
    }
#undef IN
#undef SEAM
}

template <int NB, class AF>
__device__ __forceinline__ void ngemm_tile(const bf16* A, int lda, const int* aidx, int arow_base, int m0, const float* W0, const float* W1, int ldw, int n0, int K,
                                           float (&acc)[NB][4][4], float* sA, float* sB, const AF& af) {
    const int tid = threadIdx.x, tx = tid & 15, ty = tid >> 4;
    const int lr = tid >> 2, k4 = (tid & 3) * 4;
    const int arow = arow_base + (aidx ? aidx[m0 + lr] : (m0 + lr));
    const int bk = tid >> 4, bn = (tid & 15) * 4;
#pragma unroll
    for (int b = 0; b < NB; ++b)
#pragma unroll
        for (int i = 0; i < 4; ++i)
#pragma unroll
            for (int j = 0; j < 4; ++j) acc[b][i][j] = 0.f;
    for (int k0 = 0; k0 < K; k0 += 16) {
        const v2u raw = *(const v2u*)(A + (size_t)arow * lda + k0 + k4);
        sA[(k4 + 0) * 68 + lr] = af(lr, k0 + k4 + 0, bflo(raw.x)); sA[(k4 + 1) * 68 + lr] = af(lr, k0 + k4 + 1, bfhi(raw.x));
        sA[(k4 + 2) * 68 + lr] = af(lr, k0 + k4 + 2, bflo(raw.y)); sA[(k4 + 3) * 68 + lr] = af(lr, k0 + k4 + 3, bfhi(raw.y));
        *(f32x4*)(sB + bk * 64 + bn) = *(const f32x4*)(W0 + (size_t)(k0 + bk) * ldw + n0 + bn);
        if (NB == 2) *(f32x4*)(sB + 1024 + bk * 64 + bn) = *(const f32x4*)(W1 + (size_t)(k0 + bk) * ldw + n0 + bn);
        __syncthreads();
#pragma unroll
        for (int kk = 0; kk < 16; ++kk) {
            const f32x4 a = *(const f32x4*)(sA + kk * 68 + ty * 4);
#pragma unroll
            for (int b = 0; b < NB; ++b) { const f32x4 w = *(const f32x4*)(sB + b * 1024 + kk * 64 + tx * 4);
#pragma unroll
                for (int i = 0; i < 4; ++i) { acc[b][i][0] += a[i] * w.x; acc[b][i][1] += a[i] * w.y; acc[b][i][2] += a[i] * w.z; acc[b][i][3] += a[i] * w.w; } }
        }
        __syncthreads();
    }
}
__device__ __forceinline__ float sum16(float v) { v += __shfl_xor(v, 1); v += __shfl_xor(v, 2); v += __shfl_xor(v, 4); v += __shfl_xor(v, 8); return v; }
__device__ __forceinline__ float max16(float v) { v = fmaxf(v, __shfl_xor(v, 1)); v = fmaxf(v, __shfl_xor(v, 2)); v = fmaxf(v, __shfl_xor(v, 4)); v = fmaxf(v, __shfl_xor(v, 8)); return v; }
struct AfGain { const float* g; __device__ __forceinline__ float operator()(int, int k, float a) const { return a * g[k]; } };
struct AfNone { __device__ __forceinline__ float operator()(int, int, float a) const { return a; } };
struct AfRowGain { const float* rs; const float* g; __device__ __forceinline__ float operator()(int r, int k, float a) const { return a * rs[r] * g[k]; } };
struct AfMerged { const float* rgm; const float* rat; const float* g; __device__ __forceinline__ float operator()(int r, int k, float a) const { return a * g[k] * (k < 512 ? rgm[r] : rat[r]); } };

__global__ void __launch_bounds__(256) nk_inproj(Args args, int l) {
    __shared__ float sA[16 * 68]; __shared__ float sB[1024];
    const int nt = blockIdx.x, m0 = blockIdx.y * 64, tid = threadIdx.x, tx = tid & 15, ty = tid >> 4;
    unsigned char* ws = args.ws;
    float acc[1][4][4];
    AfGain af{args.in[2] + (size_t)l * D};
    ngemm_tile<1>((const bf16*)(ws + WS_HB), D, nullptr, 0, m0, args.in[3] + (size_t)l * D * INW, nullptr, INW, nt * 64, D, acc, sA, sB, af);
    const float* COS = (const float*)(ws + WS_ROPE); const float* SIN = COS + SEQ * 32;
#pragma unroll
    for (int i = 0; i < 4; ++i) {
        const int row = m0 + ty * 4 + i; float v[4];
#pragma unroll
        for (int j = 0; j < 4; ++j) v[j] = acc[0][i][j];
        if (nt < 16) {
#pragma unroll
            for (int j = 0; j < 4; ++j) v[j] = gelu_tanh(v[j]);
            v2u o; o.x = pk2(v[0], v[1]); o.y = pk2(v[2], v[3]);
            if (nt < 8) *(v2u*)((bf16*)(ws + WS_UACT) + (size_t)row * GMW + nt * 64 + tx * 4) = o;
            else {
                *(v2u*)((bf16*)(ws + WS_VACT) + (size_t)row * GMW + (nt - 8) * 64 + tx * 4) = o;
                const float a = bflo(o.x), b = bfhi(o.x), c = bflo(o.y), d = bfhi(o.y);
                const float s = sum16((a * a + b * b) + (c * c + d * d));
                if (tx == 0) ((float*)(ws + WS_VSTAT))[(size_t)row * 8 + (nt - 8)] = s;
            }
        } else if (nt < 26) {
            const bool isq = nt < 24; const float* g = (isq ? args.in[7] : args.in[8]) + (size_t)l * 64;
            const float s = sum16((v[0] * v[0] + v[1] * v[1]) + (v[2] * v[2] + v[3] * v[3]));
            const float rinv = 1.0f / sqrtf(s * (1.0f / 64.0f) + EPS);
#pragma unroll
            for (int j = 0; j < 4; ++j) v[j] = v[j] * rinv * g[tx * 4 + j];
            const int t = row % SEQ; float o4[4];
#pragma unroll
            for (int pp = 0; pp < 2; ++pp) { const int p = tx * 2 + pp; const float c = COS[t * 32 + p], sn = SIN[t * 32 + p];
                o4[2 * pp] = v[2 * pp] * c - v[2 * pp + 1] * sn; o4[2 * pp + 1] = v[2 * pp] * sn + v[2 * pp + 1] * c; }
            const float sc = isq ? QSCALE : 1.0f;
            v2u o; o.x = pk2(o4[0] * sc, o4[1] * sc); o.y = pk2(o4[2] * sc, o4[3] * sc);
            if (isq) *(v2u*)((bf16*)(ws + WS_Q) + (size_t)row * 512 + (nt - 16) * 64 + tx * 4) = o;
            else *(v2u*)((bf16*)(ws + WS_K) + (size_t)row * 128 + (nt - 24) * 64 + tx * 4) = o;
        } else {
            v2u o; o.x = pk2(v[0], v[1]); o.y = pk2(v[2], v[3]);
            *(v2u*)((bf16*)(ws + WS_V) + (size_t)row * 128 + (nt - 26) * 64 + tx * 4) = o;
        }
    }
}

__global__ void __launch_bounds__(256) nk_attn(Args args) {
    __shared__ float sQt[64 * 68]; __shared__ float sKt[64 * 68]; __shared__ float sV[64 * 68];
    const int qb = blockIdx.x, h = blockIdx.y, b = blockIdx.z, tid = threadIdx.x, tx = tid & 15, ty = tid >> 4;
    unsigned char* ws = args.ws;
    const bf16* Q = (const bf16*)(ws + WS_Q); const bf16* Kp = (const bf16*)(ws + WS_K); const bf16* Vp = (const bf16*)(ws + WS_V);
    const int kvh = h >> 2; const size_t rb = (size_t)b * SEQ;
    const int lr = tid >> 2, d16 = (tid & 3) * 16;
    {   const bf16* src = Q + (rb + qb * 64 + lr) * 512 + h * 64 + d16;
        const v4u r0 = *(const v4u*)src, r1 = *(const v4u*)(src + 8);
        const unsigned w[8] = {r0.x, r0.y, r0.z, r0.w, r1.x, r1.y, r1.z, r1.w};
#pragma unroll
        for (int q = 0; q < 8; ++q) { sQt[(d16 + 2 * q) * 68 + lr] = bflo(w[q]); sQt[(d16 + 2 * q + 1) * 68 + lr] = bfhi(w[q]); } }
    float o[4][4], mrow[4], lrow[4];
#pragma unroll
    for (int i = 0; i < 4; ++i) { mrow[i] = -1e30f; lrow[i] = 0.f;
#pragma unroll
        for (int j = 0; j < 4; ++j) o[i][j] = 0.f; }
    for (int kt = 0; kt < SEQ / 64; ++kt) {
        __syncthreads();
        {   const bf16* ks = Kp + (rb + kt * 64 + lr) * 128 + kvh * 64 + d16; const bf16* vs = Vp + (rb + kt * 64 + lr) * 128 + kvh * 64 + d16;
            const v4u r0 = *(const v4u*)ks, r1 = *(const v4u*)(ks + 8), s0 = *(const v4u*)vs, s1 = *(const v4u*)(vs + 8);
            const unsigned w[8] = {r0.x, r0.y, r0.z, r0.w, r1.x, r1.y, r1.z, r1.w}; const unsigned x[8] = {s0.x, s0.y, s0.z, s0.w, s1.x, s1.y, s1.z, s1.w};
#pragma unroll
            for (int q = 0; q < 8; ++q) { sKt[(d16 + 2 * q) * 68 + lr] = bflo(w[q]); sKt[(d16 + 2 * q + 1) * 68 + lr] = bfhi(w[q]);
                sV[lr * 68 + d16 + 2 * q] = bflo(x[q]); sV[lr * 68 + d16 + 2 * q + 1] = bfhi(x[q]); } }
        __syncthreads();
        float s[4][4];
#pragma unroll
        for (int i = 0; i < 4; ++i)
#pragma unroll
            for (int j = 0; j < 4; ++j) s[i][j] = 0.f;
#pragma unroll 8
        for (int d = 0; d < 64; ++d) { const f32x4 a = *(const f32x4*)(sQt + d * 68 + ty * 4), k = *(const f32x4*)(sKt + d * 68 + tx * 4);
#pragma unroll
            for (int i = 0; i < 4; ++i) { s[i][0] += a[i] * k.x; s[i][1] += a[i] * k.y; s[i][2] += a[i] * k.z; s[i][3] += a[i] * k.w; } }
        __syncthreads();
#pragma unroll
        for (int i = 0; i < 4; ++i) {
            const float mx = max16(fmaxf(fmaxf(s[i][0], s[i][1]), fmaxf(s[i][2], s[i][3])));
            const float mn = fmaxf(mrow[i], mx), f = __builtin_amdgcn_exp2f(mrow[i] - mn); mrow[i] = mn;
            float ps = 0.f;
#pragma unroll
            for (int j = 0; j < 4; ++j) { const float p = __builtin_amdgcn_exp2f(s[i][j] - mn); ps += p; sKt[(tx * 4 + j) * 68 + ty * 4 + i] = p; }
            lrow[i] = lrow[i] * f + sum16(ps);
#pragma unroll
            for (int j = 0; j < 4; ++j) o[i][j] *= f;
        }
        __syncthreads();
#pragma unroll 8
        for (int k = 0; k < 64; ++k) { const f32x4 p = *(const f32x4*)(sKt + k * 68 + ty * 4), v = *(const f32x4*)(sV + k * 68 + tx * 4);
#pragma unroll
            for (int i = 0; i < 4; ++i) { o[i][0] += p[i] * v.x; o[i][1] += p[i] * v.y; o[i][2] += p[i] * v.z; o[i][3] += p[i] * v.w; } }
    }
    bf16* MERGED = (bf16*)(ws + WS_MERGED); float* ATSTAT = (float*)(ws + WS_ATSTAT);
#pragma unroll
    for (int i = 0; i < 4; ++i) {
        const size_t row = rb + qb * 64 + ty * 4 + i; const float rl = 1.0f / lrow[i];
        v2u w; w.x = pk2(o[i][0] * rl, o[i][1] * rl); w.y = pk2(o[i][2] * rl, o[i][3] * rl);
        *(v2u*)(MERGED + row * 1024 + 512 + h * 64 + tx * 4) = w;
        const float a = bflo(w.x), b2 = bfhi(w.x), c = bflo(w.y), d = bfhi(w.y);
        const float ss = sum16((a * a + b2 * b2) + (c * c + d * d));
        if (tx == 0) ATSTAT[row * 8 + h] = ss;
    }
}

__global__ void __launch_bounds__(256) nk_outproj(Args args, int l) {
    __shared__ float sA[16 * 68]; __shared__ float sB[1024]; __shared__ float rgm[64]; __shared__ float rat[64]; __shared__ float gg[1024];
    const int nt = blockIdx.x, m0 = blockIdx.y * 64, tid = threadIdx.x, tx = tid & 15, ty = tid >> 4;
    unsigned char* ws = args.ws;
    if (tid < 64) { const float* gs = (const float*)(ws + WS_GMSTAT) + (size_t)(m0 + tid) * 4; const float* as = (const float*)(ws + WS_ATSTAT) + (size_t)(m0 + tid) * 8;
        float a = 0.f, b = 0.f; for (int q = 0; q < 4; ++q) a += gs[q]; for (int q = 0; q < 8; ++q) b += as[q];
        rgm[tid] = 1.0f / sqrtf(a * (1.0f / 512.0f) + EPS); rat[tid] = 1.0f / sqrtf(b * (1.0f / 512.0f) + EPS); }
    for (int i = tid; i < 1024; i += 256) gg[i] = args.in[9][(size_t)l * 1024 + i];
    __syncthreads();
    float acc[1][4][4];
    AfMerged af{rgm, rat, gg};
    ngemm_tile<1>((const bf16*)(ws + WS_MERGED), 1024, nullptr, 0, m0, args.in[10] + (size_t)l * D * D, nullptr, D, nt * 64, D, acc, sA, sB, af);
    const float* base = l == 0 ? args.in[0] : args.out;
#pragma unroll
    for (int i = 0; i < 4; ++i) {
        const size_t row = m0 + ty * 4 + i; const size_t off = row * D + nt * 64 + tx * 4;
        const f32x4 bs = *(const f32x4*)(base + off);
        const f32x4 xn = (f32x4){bs.x + acc[0][i][0], bs.y + acc[0][i][1], bs.z + acc[0][i][2], bs.w + acc[0][i][3]};
        *(f32x4*)(args.out + off) = xn;
        v2u o; o.x = pk2(xn.x, xn.y); o.y = pk2(xn.z, xn.w); *(v2u*)((bf16*)(ws + WS_XB) + off) = o;
        const float s = sum16((xn.x * xn.x + xn.y * xn.y) + (xn.z * xn.z + xn.w * xn.w));
        if (tx == 0) ((float*)(ws + WS_XSTAT))[row * 16 + nt] = s;
    }
}

__global__ void __launch_bounds__(256) nk_xq(Args args, int l) {
    __shared__ float sA[16 * 68]; __shared__ float sB[1024]; __shared__ float rs[64];
    const int nt = blockIdx.x, m0 = blockIdx.y * 64, tid = threadIdx.x, tx = tid & 15, ty = tid >> 4;
    unsigned char* ws = args.ws;
    if (tid < 64) { const float* xs = (const float*)(ws + WS_XSTAT) + (size_t)(m0 + tid) * 16; float a = 0.f; for (int q = 0; q < 16; ++q) a += xs[q]; rs[tid] = 1.0f / sqrtf(a * (1.0f / D) + EPS); }
    __syncthreads();
    float acc[1][4][4];
    AfRowGain af{rs, args.in[11] + (size_t)l * D};
    ngemm_tile<1>((const bf16*)(ws + WS_XB), D, nullptr, 0, m0, args.in[13] + (size_t)l * D * D, nullptr, D, nt * 64, D, acc, sA, sB, af);
#pragma unroll
    for (int i = 0; i < 4; ++i) { const size_t off = (size_t)(m0 + ty * 4 + i) * D + nt * 64 + tx * 4;
        v2u o; o.x = pk2(acc[0][i][0] * XQSCALE, acc[0][i][1] * XQSCALE); o.y = pk2(acc[0][i][2] * XQSCALE, acc[0][i][3] * XQSCALE); *(v2u*)((bf16*)(ws + WS_Q2) + off) = o; }
}
__global__ void __launch_bounds__(256) nk_xkv(Args args, int l) {
    __shared__ float sA[16 * 68]; __shared__ float sB[1024];
    const int nt = blockIdx.x, m0 = blockIdx.y * 64, tid = threadIdx.x, tx = tid & 15, ty = tid >> 4;
    unsigned char* ws = args.ws;
    float acc[1][4][4]; AfNone af;
    ngemm_tile<1>((const bf16*)(ws + WS_MEMN), D, nullptr, 0, m0, args.in[14] + (size_t)l * D * 2 * D, nullptr, 2 * D, nt * 64, D, acc, sA, sB, af);
#pragma unroll
    for (int i = 0; i < 4; ++i) { const size_t off = (size_t)(m0 + ty * 4 + i) * 2 * D + nt * 64 + tx * 4;
        v2u o; o.x = pk2(acc[0][i][0], acc[0][i][1]); o.y = pk2(acc[0][i][2], acc[0][i][3]); *(v2u*)((bf16*)(ws + WS_KVN) + off) = o; }
}
__global__ void __launch_bounds__(256) nk_xattn(Args args) {
    __shared__ float sq[8 * 256]; __shared__ float sp[8 * 256];
    const int r0 = blockIdx.x * 8, h = blockIdx.y, tid = threadIdx.x, lane = tid & 63, wv = tid >> 6;
    unsigned char* ws = args.ws; const int b = r0 / SEQ;
    const bf16* Q2 = (const bf16*)(ws + WS_Q2); const bf16* KVN = (const bf16*)(ws + WS_KVN);
    for (int i = tid; i < 8 * 256; i += 256) sq[i] = bf2f(Q2[(size_t)(r0 + (i >> 8)) * D + h * 256 + (i & 255)]);
    __syncthreads();
    {   const bf16* kr = KVN + (size_t)(b * MEML + tid) * 2 * D + h * 256;
        float sc[8];
#pragma unroll
        for (int r = 0; r < 8; ++r) sc[r] = 0.f;
        for (int d = 0; d < 256; d += 8) { const v4u w = *(const v4u*)(kr + d);
            const float kv[8] = {bflo(w.x), bfhi(w.x), bflo(w.y), bfhi(w.y), bflo(w.z), bfhi(w.z), bflo(w.w), bfhi(w.w)};
#pragma unroll
            for (int r = 0; r < 8; ++r) {
#pragma unroll
                for (int q = 0; q < 8; ++q) sc[r] += sq[r * 256 + d + q] * kv[q]; } }
#pragma unroll
        for (int r = 0; r < 8; ++r) sp[r * 256 + tid] = sc[r]; }
    __syncthreads();
#pragma unroll
    for (int rr = 0; rr < 2; ++rr) { const int r = wv * 2 + rr;
        float v[4]; float mx = -1e30f;
#pragma unroll
        for (int q = 0; q < 4; ++q) { v[q] = sp[r * 256 + lane + 64 * q]; mx = fmaxf(mx, v[q]); }
#pragma unroll
        for (int o = 1; o < 64; o <<= 1) mx = fmaxf(mx, __shfl_xor(mx, o));
        float sm = 0.f;
#pragma unroll
        for (int q = 0; q < 4; ++q) { v[q] = __builtin_amdgcn_exp2f(v[q] - mx); sm += v[q]; }
        sm = wave_sum(sm); const float rinv = 1.0f / sm;
#pragma unroll
        for (int q = 0; q < 4; ++q) sp[r * 256 + lane + 64 * q] = v[q] * rinv; }
    __syncthreads();
    {   float o[8];
#pragma unroll
        for (int r = 0; r < 8; ++r) o[r] = 0.f;
        const bf16* vr = KVN + (size_t)(b * MEML) * 2 * D + D + h * 256 + tid;
        for (int m = 0; m < MEML; ++m) { const float v = bf2f(vr[(size_t)m * 2 * D]);
#pragma unroll
            for (int r = 0; r < 8; ++r) o[r] += sp[r * 256 + m] * v; }
#pragma unroll
        for (int r = 0; r < 8; ++r) ((bf16*)(ws + WS_O2))[(size_t)(r0 + r) * D + h * 256 + tid] = (bf16)f2bf(o[r]); }
}
__global__ void __launch_bounds__(256) nk_xo(Args args, int l) {
    __shared__ float sA[16 * 68]; __shared__ float sB[1024];
    const int nt = blockIdx.x, m0 = blockIdx.y * 64, tid = threadIdx.x, tx = tid & 15, ty = tid >> 4;
    unsigned char* ws = args.ws;
    float acc[1][4][4]; AfNone af;
    ngemm_tile<1>((const bf16*)(ws + WS_O2), D, nullptr, 0, m0, args.in[15] + (size_t)l * D * D, nullptr, D, nt * 64, D, acc, sA, sB, af);
#pragma unroll
    for (int i = 0; i < 4; ++i) { const size_t off = (size_t)(m0 + ty * 4 + i) * D + nt * 64 + tx * 4;
        const f32x4 bs = *(const f32x4*)(args.out + off);
        *(f32x4*)(args.out + off) = (f32x4){bs.x + acc[0][i][0], bs.y + acc[0][i][1], bs.z + acc[0][i][2], bs.w + acc[0][i][3]}; }
}
__global__ void __launch_bounds__(256) nk_moe1(Args args, int l) {
    __shared__ float sA[16 * 68]; __shared__ float sB[2048];
    const int nt = blockIdx.x, m0 = blockIdx.y * 64, z = blockIdx.z, b = z >> 4, e = z & 15, tid = threadIdx.x, tx = tid & 15, ty = tid >> 4;
    unsigned char* ws = args.ws;
    float acc[2][4][4];
    AfGain af{args.in[16] + (size_t)l * D};
    const size_t wo = ((size_t)l * NE + e) * D * FF;
    ngemm_tile<2>((const bf16*)(ws + WS_HB), D, (const int*)(ws + WS_IDX) + (size_t)z * CAP, b * SEQ, m0, args.in[18] + wo, args.in[19] + wo, FF, nt * 64, D, acc, sA, sB, af);
#pragma unroll
    for (int i = 0; i < 4; ++i) { const size_t off = ((size_t)z * CAP + m0 + ty * 4 + i) * FF + nt * 64 + tx * 4;
        float hv[4];
#pragma unroll
        for (int j = 0; j < 4; ++j) hv[j] = silu_f(acc[0][i][j]) * acc[1][i][j];
        v2u o; o.x = pk2(hv[0], hv[1]); o.y = pk2(hv[2], hv[3]); *(v2u*)((bf16*)(ws + WS_H) + off) = o; }
}
__global__ void __launch_bounds__(256) nk_moe2(Args args, int l) {
    __shared__ float sA[16 * 68]; __shared__ float sB[1024];
    const int nt = blockIdx.x, m0 = blockIdx.y * 64, z = blockIdx.z, e = z & 15, tid = threadIdx.x, tx = tid & 15, ty = tid >> 4;
    unsigned char* ws = args.ws;
    float acc[1][4][4]; AfNone af;
    ngemm_tile<1>((const bf16*)(ws + WS_H) + (size_t)z * CAP * FF, FF, nullptr, 0, m0, args.in[20] + ((size_t)l * NE + e) * FF * D, nullptr, D, nt * 64, FF, acc, sA, sB, af);
#pragma unroll
    for (int i = 0; i < 4; ++i) { const size_t off = ((size_t)z * CAP + m0 + ty * 4 + i) * D + nt * 64 + tx * 4;
        v2u o; o.x = pk2(acc[0][i][0], acc[0][i][1]); o.y = pk2(acc[0][i][2], acc[0][i][3]); *(v2u*)((bf16*)(ws + WS_Y) + off) = o; }
}

static int g_grid = 0;
static void launch_mega(Args a, int lo, int hi, int region, hipStream_t stream) {
    a.ph_lo = lo; a.ph_hi = hi; a.bar_region = region; a.pad = 0;
    hipLaunchKernelGGL(mega, dim3(g_grid), dim3(NTHR), LDS_BYTES, stream, a);
}
extern "C" void kernel_launch(void* const* d_in, const int* in_sizes, int n_in, void* d_out, int out_size, void* d_ws, size_t ws_size, hipStream_t stream) {
    if (g_grid == 0) {
        if (n_in != 22 || out_size != T * D || ws_size < WS_END) { fprintf(stderr, "kernel_launch: unexpected sizes n_in %d out %d ws %zu\n", n_in, out_size, ws_size); g_grid = -1; return; }
        int dev = 0, cus = 0;
        if (hipGetDevice(&dev) != hipSuccess || hipDeviceGetAttribute(&cus, hipDeviceAttributeMultiprocessorCount, dev) != hipSuccess) { g_grid = -1; return; }
        if (hipFuncSetAttribute((const void*)mega, hipFuncAttributeMaxDynamicSharedMemorySize, LDS_BYTES) != hipSuccess) { g_grid = -1; return; }
        int per_cu = 0;
        if (hipOccupancyMaxActiveBlocksPerMultiprocessor(&per_cu, (const void*)mega, NTHR, LDS_BYTES) != hipSuccess || per_cu < 1) fprintf(stderr, "kernel_launch: occupancy query says %d\n", per_cu);
        (void)hipGetLastError();
        g_grid = cus;
    }
    if (g_grid < 0) return;
    hipMemsetAsync((char*)d_ws + WS_CTL, 0, CTL_ZERO_BYTES, stream);
    Args a{};
    for (int i = 0; i < 22; ++i) a.in[i] = (const float*)d_in[i];
    a.out = (float*)d_out; a.ws = (unsigned char*)d_ws;
    static const bool MEGA_KIND[10] = {true, true, true, true, true, true, true, true, true, true};
    const bool NAIVE_ATTN = false, NEED_WEIGHTS = true, NEED_XPRE = true;
    const bool ONE_LAUNCH = true;
    if (ONE_LAUNCH) { launch_mega(a, 0, PH_END, 0, stream); return; }
    int region = 0;
    launch_mega(a, 0, NEED_XPRE ? 4 : (NEED_WEIGHTS ? 2 : 1), region++, stream);
    for (int l = 0; l < NL; ++l) {
        const int pb = PH_LAYER0 + PH_PER_LAYER * l;
        int k = 0;
        while (k < 10) {
            if (MEGA_KIND[k] && !(k == 1 && NAIVE_ATTN)) { int k2 = k; while (k2 < 10 && MEGA_KIND[k2] && !(k2 == 1 && NAIVE_ATTN)) ++k2; launch_mega(a, pb + k, pb + k2, region++, stream); k = k2; continue; }
            if (k == 0) hipLaunchKernelGGL(nk_inproj, dim3(28, T / 64), dim3(256), 0, stream, a, l);
            else if (k == 1) { hipLaunchKernelGGL(nk_attn, dim3(SEQ / 64, 8, NB_), dim3(256), 0, stream, a); launch_mega(a, pb + 1, pb + 2, region++, stream); }
            else if (k == 2) hipLaunchKernelGGL(nk_outproj, dim3(16, T / 64), dim3(256), 0, stream, a, l);
            else if (k == 3) { hipLaunchKernelGGL(nk_xq, dim3(16, T / 64), dim3(256), 0, stream, a, l); hipLaunchKernelGGL(nk_xkv, dim3(32, 16), dim3(256), 0, stream, a, l);
                               hipLaunchKernelGGL(nk_xattn, dim3(T / 8, 4), dim3(256), 0, stream, a); hipLaunchKernelGGL(nk_xo, dim3(16, T / 64), dim3(256), 0, stream, a, l); ++k; }
            else if (k == 7) { hipLaunchKernelGGL(nk_moe1, dim3(16, 16, 64), dim3(256), 0, stream, a, l); }
            else if (k == 8) { hipLaunchKernelGGL(nk_moe2, dim3(16, 16, 64), dim3(256), 0, stream, a, l); }
            ++k;
        }
    }
}
```

```cpp
#include <hip/hip_runtime.h>
#include <hip/hip_bf16.h>
#include <cstdio>
#include <cstdint>
#include <cmath>

constexpr int NB_ = 4, SEQ = 8192, T = NB_ * SEQ, D = 1024, NL = 4;
constexpr int MEML = 256, NMEM = NB_ * MEML;
constexpr int INW = 1792, GMW = 512, NE = 16, CAP = 1024, FF = 1024;
constexpr float EPS = 1e-6f;
constexpr float LOG2E = 1.4426950408889634f;
constexpr float QSCALE = 0.125f * LOG2E;
constexpr float XQSCALE = 0.0625f * LOG2E;

constexpr size_t MiB = 1u << 20;
constexpr size_t WS_CTL = 0, CTL_ZERO_BYTES = 1 * MiB;
constexpr size_t WS_ROPE = 1 * MiB;
constexpr size_t WS_AFF = 3 * MiB;
constexpr size_t WS_INV = 5 * MiB;
constexpr size_t WS_IDX = 7 * MiB;
constexpr size_t WS_VSTAT = 8 * MiB;
constexpr size_t WS_ATSTAT = 9 * MiB;
constexpr size_t WS_GMSTAT = 10 * MiB;
constexpr size_t WS_XSTAT = 11 * MiB;
constexpr size_t WS_MEMN = 13 * MiB;
constexpr size_t WS_WSB = 15 * MiB;
constexpr size_t WS_WIN = 16 * MiB;
constexpr size_t WS_WOUT = 30 * MiB;
constexpr size_t WS_QKT = 38 * MiB;
constexpr size_t WS_VOT = 70 * MiB;
constexpr size_t WS_WGU = 102 * MiB;
constexpr size_t WS_WD = 358 * MiB;
constexpr size_t WS_HB = 486 * MiB;
constexpr size_t WS_R1 = 550 * MiB;
constexpr size_t WS_UACT = WS_R1, WS_VACT = WS_R1 + 32 * MiB, WS_Q = WS_R1 + 64 * MiB, WS_K = WS_R1 + 96 * MiB, WS_V = WS_R1 + 104 * MiB;
constexpr size_t WS_WQB = WS_R1, WS_WOT = WS_R1 + 8 * MiB, WS_WKVT = WS_R1 + 16 * MiB, WS_KVM = WS_R1 + 32 * MiB;
constexpr size_t WS_H = WS_R1;
constexpr size_t WS_MERGED = 678 * MiB;
constexpr size_t WS_XB = 742 * MiB;
constexpr size_t WS_P = WS_MERGED;
constexpr size_t WS_Y = 678 * MiB;
constexpr size_t WS_NSCR = 806 * MiB;
constexpr size_t WS_Q2 = WS_MERGED;
constexpr size_t WS_O2 = WS_NSCR;
constexpr size_t WS_KVN = WS_NSCR + 64 * MiB;
constexpr size_t WS_END = 1024 * MiB;

constexpr int CW_TMO = 0, CW_CODE = 1, CW_BAR = 4096;

#define GAS __attribute__((address_space(1)))
#define LAS __attribute__((address_space(3)))
typedef unsigned short bf16;
typedef unsigned v4u __attribute__((ext_vector_type(4)));
typedef unsigned v2u __attribute__((ext_vector_type(2)));
typedef float f32x4 __attribute__((ext_vector_type(4)));
typedef short bf16x8_t __attribute__((ext_vector_type(8)));
typedef GAS unsigned gu32;
#define RLX_AGENT __ATOMIC_RELAXED, __HIP_MEMORY_SCOPE_AGENT
__device__ __forceinline__ unsigned f2bf(float f) { unsigned u = __builtin_bit_cast(unsigned, f); return (u + 0x7fffu + ((u >> 16) & 1u)) >> 16; }
__device__ __forceinline__ unsigned pk2(float lo, float hi) { return f2bf(lo) | (f2bf(hi) << 16); }
__device__ __forceinline__ float bf2f(unsigned v) { return __builtin_bit_cast(float, v << 16); }
__device__ __forceinline__ float bflo(unsigned w) { return __builtin_bit_cast(float, w << 16); }
__device__ __forceinline__ float bfhi(unsigned w) { return __builtin_bit_cast(float, w & 0xffff0000u); }
__device__ __forceinline__ float rbf(float f) { return bf2f(f2bf(f)); }
__device__ __forceinline__ float gelu_tanh(float x) {
    const float z = 1.5957691216057308f * (x + 0.044715f * x * x * x);
    return x / (1.0f + __builtin_amdgcn_exp2f(-z * LOG2E));
}
__device__ __forceinline__ float silu_f(float a) { return a / (1.0f + __builtin_amdgcn_exp2f(-a * LOG2E)); }
__device__ __forceinline__ int lane_id() { return (int)__builtin_amdgcn_mbcnt_hi(~0u, __builtin_amdgcn_mbcnt_lo(~0u, 0u)); }
__device__ __forceinline__ float wave_sum(float v) {
#pragma unroll
    for (int o = 1; o < 64; o <<= 1) v += __shfl_xor(v, o);
    return v;
}

#define XB_TMO      128
#define XB_XCNT(j)  (256  + 64 * (j))
#define XB_XSUB(j)  (1280 + 64 * (j))
#define XB_XGEN(j)  (2304 + 64 * (j))
#define XB_TOP      3328
#define XB_TOPGEN   3392
#define XCD_BAR_WORDS 3456
#define XB_SPIN_CAP (1u << 18)
__device__ __forceinline__ unsigned xb_ld(unsigned* p)              { return __hip_atomic_load(p, __ATOMIC_RELAXED, __HIP_MEMORY_SCOPE_AGENT); }
__device__ __forceinline__ unsigned xb_add(unsigned* p, unsigned v) { return __hip_atomic_fetch_add(p, v, __ATOMIC_RELAXED, __HIP_MEMORY_SCOPE_AGENT); }
__device__ __forceinline__ unsigned xb_xcc_id() { return (unsigned)__builtin_amdgcn_s_getreg((3 << 11) | 20) & 0xFu; }
#define XB_SPIN(cond, bar) do { unsigned _sp = 0; while (cond) { __builtin_amdgcn_s_sleep(1); \
    if ((++_sp & 255u) == 0u) { if (xb_ld(&(bar)[XB_TMO])) break; if (_sp > XB_SPIN_CAP) { atomicAdd(&(bar)[XB_TMO], 1u); break; } } } } while (0)
struct XcdBarrier { unsigned* bar; unsigned x; volatile LAS unsigned* st; };
__device__ __forceinline__ XcdBarrier xcd_barrier_post(unsigned* bar, volatile LAS unsigned* st) {
    XcdBarrier b; b.bar = bar; b.x = xb_xcc_id(); b.st = st;
    if (threadIdx.x == 0) (void)xb_add(&bar[XB_XCNT(b.x)], 1u);
    return b;
}
__device__ __forceinline__ void xcd_barrier_complete(unsigned* bar, unsigned x, unsigned& nloc, unsigned& nx) {
    const unsigned G = gridDim.x * gridDim.y * gridDim.z;
    unsigned sum, cnt, mine, sp = 0u;
    for (;;) {
        sum = 0u; cnt = 0u; mine = 0u;
#pragma unroll
        for (unsigned j = 0; j < 16; ++j) { const unsigned c = xb_ld(&bar[XB_XCNT(j)]); sum += c; cnt += (c > 0u) ? 1u : 0u; mine = (j == x) ? c : mine; }
        if (sum == G) break;
        __builtin_amdgcn_s_sleep(1);
        if ((++sp & 255u) == 0u) { if (xb_ld(&bar[XB_TMO])) break; if (sp > XB_SPIN_CAP) { atomicAdd(&bar[XB_TMO], 1u); break; } }
    }
    nloc = mine > 0u ? mine : 1u; nx = cnt > 0u ? cnt : 1u;
}
__device__ __forceinline__ void xcd_barrier(const XcdBarrier& b) {
    asm volatile("s_waitcnt vmcnt(0)" ::: "memory");
    __syncthreads();
    if (threadIdx.x == 0) {
        unsigned* bar = b.bar;
        __builtin_amdgcn_s_waitcnt(0);
        unsigned nloc = b.st[0], nx = b.st[1];
        if (nloc == 0u) { xcd_barrier_complete(bar, b.x, nloc, nx); b.st[0] = nloc; b.st[1] = nx; }
        const unsigned old = xb_add(&bar[XB_XSUB(b.x)], 1u);
        const unsigned gen = old / nloc;
        if (old + 1u == (gen + 1u) * nloc) {
            __builtin_amdgcn_fence(__ATOMIC_RELEASE, "agent");
            asm volatile("s_waitcnt vmcnt(0)" ::: "memory");
            const unsigned og = xb_add(&bar[XB_TOP], 1u);
            const unsigned tg = og / nx;
            if (og + 1u == (tg + 1u) * nx) xb_add(&bar[XB_TOPGEN], 1u);
            else XB_SPIN(xb_ld(&bar[XB_TOPGEN]) == tg, bar);
            __builtin_amdgcn_fence(__ATOMIC_ACQUIRE, "agent");
            xb_add(&bar[XB_XGEN(b.x)], 1u);
            asm volatile("s_waitcnt vmcnt(0)" ::: "memory");
        } else {
            XB_SPIN(xb_ld(&bar[XB_XGEN(b.x)]) == gen, bar);
            __builtin_amdgcn_fence(__ATOMIC_ACQUIRE, "agent");
            asm volatile("s_waitcnt vmcnt(0)" ::: "memory");
        }
    }
    __syncthreads();
}

struct Args { const float* in[22]; float* out; unsigned char* ws; int ph_lo, ph_hi, bar_region, pad; };
constexpr int PH_LAYER0 = 4, PH_PER_LAYER = 10, PH_END = PH_LAYER0 + NL * PH_PER_LAYER;

constexpr int NWAVES = 8, NTHR = NWAVES * 64;
constexpr int RING_BYTES = 131072, LDSCTL_OFF = RING_BYTES, MISC_OFF = LDSCTL_OFF + 320;
constexpr int LDS_BYTES = 147456;

struct Frame {
    LAS unsigned char* lds;
    int wave, vcu, G;
    const float* in[22];
    unsigned char* ws;
    float* xres;
};

__device__ __forceinline__ void ph_rows0(Frame& F) {
    int lane_ = lane_id(); asm volatile("" : "+v"(lane_)); const int tid_ = F.wave * 64 + lane_;
    const int gw = F.vcu * NWAVES + F.wave, NGW = F.G * NWAVES;
    const float* x = F.in[0]; const float* mem = F.in[1]; const float* mg = F.in[12];
    bf16* HB = (bf16*)(F.ws + WS_HB); bf16* MEMN = (bf16*)(F.ws + WS_MEMN);
    for (int m = gw; m < T + NMEM; m += NGW) {
        const bool is_mem = m >= T;
        const float* src = is_mem ? mem + (size_t)(m - T) * D : x + (size_t)m * D;
        bf16* dst = is_mem ? MEMN + (size_t)(m - T) * D : HB + (size_t)m * D;
        f32x4 v[4]; float s = 0.f;
#pragma unroll
        for (int j = 0; j < 4; ++j) { v[j] = *(const f32x4*)(src + 4 * lane_ + 256 * j); s += (v[j].x * v[j].x + v[j].y * v[j].y) + (v[j].z * v[j].z + v[j].w * v[j].w); }
        const float rinv = 1.0f / sqrtf(wave_sum(s) * (1.0f / D) + EPS);
#pragma unroll
        for (int j = 0; j < 4; ++j) {
            f32x4 g = (f32x4){1.f, 1.f, 1.f, 1.f};
            if (is_mem) g = *(const f32x4*)(mg + 4 * lane_ + 256 * j);
            v2u o; o.x = pk2(v[j].x * rinv * g.x, v[j].y * rinv * g.y); o.y = pk2(v[j].z * rinv * g.z, v[j].w * rinv * g.w);
            *(v2u*)(dst + 4 * lane_ + 256 * j) = o;
        }
    }
    float* COS = (float*)(F.ws + WS_ROPE); float* SIN = COS + SEQ * 32;
    const int gt = F.vcu * NTHR + tid_, NGT = F.G * NTHR;
    for (int i = gt; i < SEQ * 32; i += NGT) {
        const int t = i >> 5, p = i & 31;
        const float fr = expf(-9.210340371976184f * (float)(p & 15) * (1.0f / 16.0f));
        const float pos = (float)((p < 16) ? (t >> 6) : (t & 63));
        float rev = pos * fr * 0.15915494309189535f; rev -= floorf(rev);
        COS[i] = __builtin_amdgcn_cosf(rev); SIN[i] = __builtin_amdgcn_sinf(rev);
    }
}

__device__ __forceinline__ void ph_gmlp(Frame& F, int l) {
    int lane_ = lane_id(); asm volatile("" : "+v"(lane_)); const int tid_ = F.wave * 64 + lane_;
    const bf16* UACT = (const bf16*)(F.ws + WS_UACT); const bf16* VACT = (const bf16*)(F.ws + WS_VACT);
    const float* VSTAT = (const float*)(F.ws + WS_VSTAT); float* GMSTAT = (float*)(F.ws + WS_GMSTAT);
    bf16* MERGED = (bf16*)(F.ws + WS_MERGED);
    const float* gvn = F.in[4] + (size_t)l * GMW; const float* bs = F.in[6] + (size_t)l * 4 * 128;
    const bf16* WSB = (const bf16*)(F.ws + WS_WSB) + (size_t)l * 4 * 128 * 128;
    LAS bf16* vT = (LAS bf16*)F.lds;
    const int fr = lane_ & 15, fq = lane_ >> 4, w = F.wave;
    for (int u = F.vcu; u < (T / 128) * 4; u += F.G) {
        const int n = u >> 2, g = u & 3; const int row0 = n * 128;
        __syncthreads();
        {   const int j = tid_ & 127, cs = tid_ >> 7; const size_t row = (size_t)row0 + j;
            const f32x4 s0 = *(const f32x4*)(VSTAT + row * 8), s1 = *(const f32x4*)(VSTAT + row * 8 + 4);
            const float rinv = 1.0f / sqrtf((((s0[0] + s0[1]) + (s0[2] + s0[3])) + ((s1[0] + s1[1]) + (s1[2] + s1[3]))) * (1.0f / GMW) + EPS);
#pragma unroll
            for (int q = 0; q < 4; ++q) { const int c8 = (cs * 4 + q) * 8;
                const v4u raw = *(const v4u*)(VACT + row * GMW + g * 128 + c8);
                const f32x4 g0 = *(const f32x4*)(gvn + g * 128 + c8) * rinv, g1 = *(const f32x4*)(gvn + g * 128 + c8 + 4) * rinv;
                LAS bf16* d = vT + c8 * 136 + j;
                d[0 * 136] = (bf16)f2bf(bflo(raw.x) * g0[0]); d[1 * 136] = (bf16)f2bf(bfhi(raw.x) * g0[1]); d[2 * 136] = (bf16)f2bf(bflo(raw.y) * g0[2]); d[3 * 136] = (bf16)f2bf(bfhi(raw.y) * g0[3]);
                d[4 * 136] = (bf16)f2bf(bflo(raw.z) * g1[0]); d[5 * 136] = (bf16)f2bf(bfhi(raw.z) * g1[1]); d[6 * 136] = (bf16)f2bf(bflo(raw.w) * g1[2]); d[7 * 136] = (bf16)f2bf(bfhi(raw.w) * g1[3]); } }
        bf16x8_t bw[4];
#pragma unroll
        for (int ks = 0; ks < 4; ++ks) bw[ks] = *(const bf16x8_t*)(WSB + ((size_t)(g * 128 + 16 * w + fr)) * 128 + 32 * ks + 8 * fq);
        __syncthreads();
        f32x4 acc[8];
#pragma unroll
        for (int cb = 0; cb < 8; ++cb) { acc[cb] = (f32x4){0.f, 0.f, 0.f, 0.f};
#pragma unroll
            for (int ks = 0; ks < 4; ++ks) { const bf16x8_t a = *(const LAS bf16x8_t*)(vT + (16 * cb + fr) * 136 + 32 * ks + 8 * fq);
                acc[cb] = __builtin_amdgcn_mfma_f32_16x16x32_bf16(a, bw[ks], acc[cb], 0, 0, 0); } }
        const size_t row = (size_t)row0 + 16 * w + fr; const float bias = bs[g * 128 + 16 * w + fr]; float ss = 0.f;
#pragma unroll
        for (int cb = 0; cb < 8; ++cb) { const v2u uu = *(const v2u*)(UACT + row * GMW + g * 128 + 16 * cb + 4 * fq);
            v2u o; o.x = pk2(bflo(uu.x) * (acc[cb][0] + bias), bfhi(uu.x) * (acc[cb][1] + bias)); o.y = pk2(bflo(uu.y) * (acc[cb][2] + bias), bfhi(uu.y) * (acc[cb][3] + bias));
            *(v2u*)(MERGED + row * 1024 + g * 128 + 16 * cb + 4 * fq) = o;
            const float a0 = bflo(o.x), a1 = bfhi(o.x), a2 = bflo(o.y), a3 = bfhi(o.y); ss += (a0 * a0 + a1 * a1) + (a2 * a2 + a3 * a3); }
        ss += __shfl_xor(ss, 16); ss += __shfl_xor(ss, 32);
        if (fq == 0) GMSTAT[row * 4 + g] = ss;
    }
    __syncthreads();
}

__device__ __forceinline__ void ph_router(Frame& F, int l) {
    int lane_ = lane_id(); asm volatile("" : "+v"(lane_)); const int tid_ = F.wave * 64 + lane_;
    const float* g = F.in[16] + (size_t)l * D; const float* wr = F.in[17] + (size_t)l * D * NE;
    bf16* HB = (bf16*)(F.ws + WS_HB); float* AFF = (float*)(F.ws + WS_AFF);
    LAS float* sW = (LAS float*)F.lds;
    __syncthreads();
    for (int i = tid_; i < D * NE; i += NTHR) { const int c = i >> 4, e = i & 15; sW[e * D + c] = wr[i] * g[c]; }
    __syncthreads();
    const int gw = F.vcu * NWAVES + F.wave, NGW = F.G * NWAVES;
    LAS float* tp = (LAS float*)(F.lds + 65536) + F.wave * (64 * 17);
    f32x4 nv[2][4];
#pragma unroll
    for (int r = 0; r < 2; ++r) { const int m = gw + r * NGW; if (m < T) {
#pragma unroll
        for (int j = 0; j < 4; ++j) nv[r][j] = *(const f32x4*)(F.xres + (size_t)m * D + 4 * lane_ + 256 * j); } }
    for (int m0 = gw; m0 < T; m0 += 2 * NGW) {
        f32x4 v[2][4];
#pragma unroll
        for (int r = 0; r < 2; ++r)
#pragma unroll
            for (int j = 0; j < 4; ++j) v[r][j] = nv[r][j];
#pragma unroll
        for (int r = 0; r < 2; ++r) { const int m = m0 + (2 + r) * NGW; if (m < T) {
#pragma unroll
            for (int j = 0; j < 4; ++j) nv[r][j] = *(const f32x4*)(F.xres + (size_t)m * D + 4 * lane_ + 256 * j); } }
        const bool has1 = (m0 + NGW) < T;
        float rinv[2];
#pragma unroll
        for (int r = 0; r < 2; ++r) { float s = 0.f;
#pragma unroll
            for (int j = 0; j < 4; ++j) s += (v[r][j].x * v[r][j].x + v[r][j].y * v[r][j].y) + (v[r][j].z * v[r][j].z + v[r][j].w * v[r][j].w);
            rinv[r] = 1.0f / sqrtf(wave_sum(s) * (1.0f / D) + EPS); }
#pragma unroll
        for (int r = 0; r < 2; ++r) { const int m = m0 + r * NGW; if (r == 0 || has1) {
#pragma unroll
            for (int j = 0; j < 4; ++j) { v2u o; o.x = pk2(v[r][j].x * rinv[r], v[r][j].y * rinv[r]); o.y = pk2(v[r][j].z * rinv[r], v[r][j].w * rinv[r]); *(v2u*)(HB + (size_t)m * D + 4 * lane_ + 256 * j) = o; } } }
#pragma unroll 4
        for (int e = 0; e < NE; ++e) { float a0 = 0.f, a1 = 0.f;
#pragma unroll
            for (int j = 0; j < 4; ++j) { const f32x4 w = *(const LAS f32x4*)(sW + e * D + 4 * lane_ + 256 * j);
                a0 += (v[0][j].x * w.x + v[0][j].y * w.y) + (v[0][j].z * w.z + v[0][j].w * w.w); a1 += (v[1][j].x * w.x + v[1][j].y * w.y) + (v[1][j].z * w.z + v[1][j].w * w.w); }
            { const auto rr = __builtin_amdgcn_permlane32_swap(__float_as_uint(a0), __float_as_uint(a1), false, false);
              tp[lane_ * 17 + e] = __uint_as_float(rr[0]) + __uint_as_float(rr[1]); } }
        asm volatile("s_waitcnt lgkmcnt(0)" ::: "memory");
        {   const int e = lane_ & 15, r = (lane_ >> 4) & 1, hp = lane_ >> 5; float a0 = 0.f, a1 = 0.f;
#pragma unroll
            for (int rr = 0; rr < 16; rr += 2) { a0 += tp[(r * 32 + hp * 16 + rr) * 17 + e]; a1 += tp[(r * 32 + hp * 16 + rr + 1) * 17 + e]; }
            float mylg = a0 + a1; mylg += __shfl_xor(mylg, 32); mylg *= (r == 0 ? rinv[0] : rinv[1]);
            float mx = mylg;
            mx = fmaxf(mx, __shfl_xor(mx, 1)); mx = fmaxf(mx, __shfl_xor(mx, 2)); mx = fmaxf(mx, __shfl_xor(mx, 4)); mx = fmaxf(mx, __shfl_xor(mx, 8));
            const float pe = __builtin_amdgcn_exp2f((mylg - mx) * LOG2E);
            float den = pe; den += __shfl_xor(den, 1); den += __shfl_xor(den, 2); den += __shfl_xor(den, 4); den += __shfl_xor(den, 8);
            const int m = m0 + r * NGW;
            if (lane_ < 32 && (r == 0 || has1)) AFF[(size_t)m * NE + e] = pe / den;
        }
        asm volatile("s_waitcnt lgkmcnt(0)" ::: "memory");
    }
    __syncthreads();
}

__device__ __forceinline__ void ph_topk(Frame& F) {
    int lane_ = lane_id(); asm volatile("" : "+v"(lane_)); const int tid_ = F.wave * 64 + lane_;
    const float* AFF = (const float*)(F.ws + WS_AFF); int* IDX = (int*)(F.ws + WS_IDX); int* INV = (int*)(F.ws + WS_INV);
    LAS unsigned* hist = (LAS unsigned*)F.lds;
    LAS unsigned* sh = hist + 256;
    LAS unsigned* wsum = hist + 512;
    for (int p = F.vcu; p < NB_ * NE; p += F.G) {
        const int b = p >> 4, e = p & 15;
        unsigned key[16];
#pragma unroll
        for (int i = 0; i < 16; ++i) key[i] = __builtin_bit_cast(unsigned, AFF[((size_t)b * SEQ + tid_ * 16 + i) * NE + e]);
        unsigned prefix = 0u, krem = CAP;
#pragma unroll
        for (int pass = 0; pass < 4; ++pass) {
            const int shift = 24 - 8 * pass; const unsigned himask = pass == 0 ? 0u : (0xffffffffu << (shift + 8));
            __syncthreads();
            if (tid_ < 256) hist[tid_] = 0u;
            __syncthreads();
#pragma unroll
            for (int i = 0; i < 16; ++i) if ((key[i] & himask) == prefix) atomicAdd((unsigned*)&hist[(key[i] >> shift) & 255u], 1u);
            __syncthreads();
            if (tid_ == 0) { unsigned above = 0u; int d = 255; for (; d > 0; --d) { const unsigned c = hist[d]; if (above + c >= krem) break; above += c; } sh[0] = prefix | ((unsigned)d << shift); sh[1] = krem - above; }
            __syncthreads();
            prefix = sh[0]; krem = sh[1];
        }
        const unsigned thr = prefix;
        unsigned cg = 0u, ce = 0u;
#pragma unroll
        for (int i = 0; i < 16; ++i) { cg += key[i] > thr ? 1u : 0u; ce += key[i] == thr ? 1u : 0u; }
        unsigned sg = cg, se = ce;
#pragma unroll
        for (int o = 1; o < 64; o <<= 1) { const unsigned a = __shfl_up(sg, o), c2 = __shfl_up(se, o); if (lane_ >= o) { sg += a; se += c2; } }
        __syncthreads();
        if (lane_ == 63) { wsum[F.wave] = sg; wsum[8 + F.wave] = se; }
        __syncthreads();
        unsigned og = 0u, oe = 0u;
        for (int w = 0; w < F.wave; ++w) { og += wsum[w]; oe += wsum[8 + w]; }
        unsigned gb = og + sg - cg, eb = oe + se - ce;
#pragma unroll
        for (int i = 0; i < 16; ++i) {
            const int t = tid_ * 16 + i; int pos = -1;
            if (key[i] > thr) { pos = (int)(gb + (eb < krem ? eb : krem)); ++gb; }
            else if (key[i] == thr) { if (eb < krem) pos = (int)(gb + eb); ++eb; }
            INV[((size_t)b * SEQ + t) * NE + e] = pos;
            if (pos >= 0) IDX[(size_t)p * CAP + pos] = t;
        }
    }
    __syncthreads();
}

__device__ __forceinline__ void ph_combine(Frame& F, int l, bool dummy) {
    int lane_ = lane_id(); asm volatile("" : "+v"(lane_)); const int tid_ = F.wave * 64 + lane_;
    const float* AFF = (const float*)(F.ws + WS_AFF); const int* INV = (const int*)(F.ws + WS_INV);
    const bf16* Y = (const bf16*)(F.ws + WS_Y); bf16* HB = (bf16*)(F.ws + WS_HB); const float* fg = F.in[21];
    const int gw = F.vcu * NWAVES + F.wave, NGW = F.G * NWAVES;
    for (int m = gw; m < T; m += NGW) {
        const float* xr = F.xres + (size_t)m * D; const int b = m / SEQ;
        float* xw = (dummy ? (float*)(F.ws + WS_NSCR) : F.xres) + (size_t)m * D; bf16* hw = (dummy ? (bf16*)(F.ws + WS_NSCR + 128 * MiB) : HB) + (size_t)m * D;
        f32x4 v[4];
#pragma unroll
        for (int j = 0; j < 4; ++j) v[j] = *(const f32x4*)(xr + 4 * lane_ + 256 * j);
        const int mypos = lane_ < NE ? INV[(size_t)m * NE + lane_] : -1;
        const float myaff = lane_ < NE ? AFF[(size_t)m * NE + lane_] : 0.f;
#pragma unroll
        for (int e = 0; e < NE; ++e) {
            const int pos = __shfl(mypos, e); const float a = __shfl(myaff, e);
            if (pos >= 0) {
                const bf16* yr = Y + ((size_t)(b * NE + e) * CAP + pos) * D;
#pragma unroll
                for (int j = 0; j < 4; ++j) { const v2u w = *(const v2u*)(yr + 4 * lane_ + 256 * j);
                    v[j].x += a * bflo(w.x); v[j].y += a * bfhi(w.x); v[j].z += a * bflo(w.y); v[j].w += a * bfhi(w.y); }
            }
        }
        float s = 0.f;
#pragma unroll
        for (int j = 0; j < 4; ++j) s += (v[j].x * v[j].x + v[j].y * v[j].y) + (v[j].z * v[j].z + v[j].w * v[j].w);
        const float rinv = 1.0f / sqrtf(wave_sum(s) * (1.0f / D) + EPS);
        if (l == NL - 1) {
#pragma unroll
            for (int j = 0; j < 4; ++j) { const f32x4 g = *(const f32x4*)(fg + 4 * lane_ + 256 * j); *(f32x4*)(xw + 4 * lane_ + 256 * j) = (f32x4){v[j].x * rinv * g.x, v[j].y * rinv * g.y, v[j].z * rinv * g.z, v[j].w * rinv * g.w}; }
        } else {
#pragma unroll
            for (int j = 0; j < 4; ++j) { *(f32x4*)(xw + 4 * lane_ + 256 * j) = v[j];
                v2u o; o.x = pk2(v[j].x * rinv, v[j].y * rinv); o.y = pk2(v[j].z * rinv, v[j].w * rinv); *(v2u*)(hw + 4 * lane_ + 256 * j) = o; }
        }
    }
}


namespace pg8 {
typedef short bf16x8 __attribute__((ext_vector_type(8)));
typedef float f32x2 __attribute__((ext_vector_type(2)));
constexpr int BM = 256, BK = 64, HALF = 128, HTB = HALF * BK * 2, STAGE_BYTES = 8 * HTB, NXCD = 8, WGM = 8;
__host__ __device__ __forceinline__ int lds_byte(int r, int c) { const int st = (r >> 4) * 2 + (c >> 5), rr = r & 15, cc = c & 31, ob = rr * 64 + cc * 2; return st * 1024 + (ob ^ (((ob >> 9) & 1) << 5)); }
__host__ __device__ __forceinline__ void stage_rc(int b, int& R, int& C) { const int st = b / 1024, sb = b % 1024, swz = sb ^ (((sb >> 9) & 1) << 5); R = (st >> 1) * 16 + swz / 64; C = (st & 1) * 32 + (swz % 64) / 2; }
__host__ __device__ __forceinline__ int perm32(int rho) { const int n = rho >> 4, i = rho & 15; return 8 * (i >> 2) + 4 * n + (i & 3); }

struct Unit { int pm, pn, z; const char* a; const char* b; const int* gi; int grow; };

struct TileOrder {
    int nM, nN, nwg, G, c;
    __device__ __forceinline__ void init(int nM_, int nN_, int G_, int c_) { nM = nM_; nN = nN_; nwg = nM * nN; G = G_; c = c_; }
    __device__ __forceinline__ bool tile(int i, int& pm, int& pn) const {
        const long L = (long)i * G + c; if (L >= nwg) return false;
        int wgid = (int)L; { const int q = nwg / NXCD, r = nwg % NXCD, xcd = wgid % NXCD, off = wgid / NXCD; wgid = (xcd < r ? xcd * (q + 1) : r * (q + 1) + (xcd - r) * q) + off; }
        const int nig = WGM * nN, gid = wgid / nig, fm = gid * WGM, gsz = (nM - fm) < WGM ? (nM - fm) : WGM;
        pm = fm + ((wgid % nig) % gsz); pn = (wgid % nig) / gsz; return true;
    }
};

__device__ __forceinline__ unsigned cvt_pk_bf16(float lo, float hi) { unsigned r; asm volatile("v_cvt_pk_bf16_f32 %0, %1, %2" : "=v"(r) : "v"(lo), "v"(hi)); return r; }
typedef f32x4 Acc[2][2][4][2];

template <class Epi, class Sched, bool ALIGN_EPI, bool GATHER>
__device__ __forceinline__ void gemm_phase(LAS unsigned char* lds, const int wave_idx, const int lda, const int ldb, const int K, const Sched& S, Epi& E) {
    int lane = lane_id(); asm volatile("" : "+v"(lane));
    const int wid = wave_idx, tid = wid * 64 + lane, wr = wid >> 2, wc = wid & 3, fr = lane & 15, fq = lane >> 4;
    const int nt = K / BK;
    unsigned voffA[2], voffB[2]; int gR[2]; unsigned gC[2];
#pragma unroll
    for (int i = 0; i < 2; ++i) { int R, C; stage_rc(tid * 16 + i * 8192, R, C); const int Rb = (R & ~31) + perm32(R & 31);
        voffA[i] = (unsigned)(R * lda + C) * 2u; voffB[i] = (unsigned)(Rb * ldb + C) * 2u; gR[i] = R; gC[i] = (unsigned)C * 2u; }
    const size_t kstep = (size_t)(BK * 2);
    const size_t hstepA = (size_t)HALF * lda * 2, hstepB = (size_t)HALF * ldb * 2;
    const unsigned ldsw = (unsigned)wid * 1024u;
    const int aoff = lds_byte(wr * 64 + fr, fq * 8), boff = lds_byte(wc * 32 + fr, fq * 8);
    unsigned vgc[2][2], vgn[2][2];
#define PG8_SA(b, h) (((b) * 2 + (h)) * HTB)
#define PG8_SB(b, h) ((4 + (b) * 2 + (h)) * HTB)
#define PG8_GL(gp, voff, bufoff, _i) __builtin_amdgcn_global_load_lds((const unsigned*)((const char*)(gp) + (voff)), (LAS unsigned*)(lds + (bufoff) + ldsw + (_i) * 8192), 16, 0, 0)
#define PG8_STAGE_B(bufoff, gbase) do { PG8_GL(gbase, voffB[0], bufoff, 0); PG8_GL(gbase, voffB[1], bufoff, 1); } while (0)
#define PG8_STAGE_A(bufoff, gbase, h, VG) do { if constexpr (GATHER) { PG8_GL(gbase, VG[h][0], bufoff, 0); PG8_GL(gbase, VG[h][1], bufoff, 1); } \
        else { PG8_GL((gbase) + (h) * hstepA, voffA[0], bufoff, 0); PG8_GL((gbase) + (h) * hstepA, voffA[1], bufoff, 1); } } while (0)
#define PG8_LDA(dst, b, h) do { _Pragma("unroll") for (int m = 0; m < 4; ++m) _Pragma("unroll") for (int k = 0; k < 2; ++k) dst[m][k] = *(const LAS bf16x8*)(lds + PG8_SA(b, h) + aoff + m * 2048 + k * 1024); } while (0)
#define PG8_LDB(dst, b, h) do { _Pragma("unroll") for (int n = 0; n < 2; ++n) _Pragma("unroll") for (int k = 0; k < 2; ++k) dst[n][k] = *(const LAS bf16x8*)(lds + PG8_SB(b, h) + boff + n * 2048 + k * 1024); } while (0)
#define PG8_MMA(ai, bj, At, Bt) do { __builtin_amdgcn_s_setprio(1); _Pragma("unroll") for (int m = 0; m < 4; ++m) _Pragma("unroll") for (int n = 0; n < 2; ++n) _Pragma("unroll") for (int k = 0; k < 2; ++k) \
        acc[ai][bj][m][n] = __builtin_amdgcn_mfma_f32_16x16x32_bf16(Bt[n][k], At[m][k], acc[ai][bj][m][n], 0, 0, 0); __builtin_amdgcn_s_setprio(0); } while (0)
#define PG8_WAIT_V(n) asm volatile("s_waitcnt vmcnt(" #n ")" ::: "memory")
#define PG8_WAIT_L(n) asm volatile("s_waitcnt lgkmcnt(" #n ")" ::: "memory")
#define PG8_BAR __builtin_amdgcn_s_barrier()
#define PG8_SCHED __builtin_amdgcn_sched_barrier(0)
#define PG8_GIDX(VG, U) do { _Pragma("unroll") for (int _h = 0; _h < 2; ++_h) _Pragma("unroll") for (int _i = 0; _i < 2; ++_i) \
        VG[_h][_i] = (unsigned)((U).grow + (U).gi[_h * HALF + gR[_i]]) * (unsigned)(lda * 2) + gC[_i]; } while (0)
    Unit cur, nxt; int ui = 0;
    if (!S.next(0, cur)) return;
    Acc acc;
#pragma unroll
    for (int a = 0; a < 2; ++a)
#pragma unroll
        for (int b = 0; b < 2; ++b)
#pragma unroll
            for (int m = 0; m < 4; ++m)
#pragma unroll
                for (int n = 0; n < 2; ++n) acc[a][b][m][n] = (f32x4){0.f, 0.f, 0.f, 0.f};
    bf16x8 At[4][2], B0[2][2], B1[2][2];
    const char* cA = cur.a; const char* cB = cur.b;
    if constexpr (GATHER) { PG8_GIDX(vgc, cur); } else { vgc[0][0] = vgc[0][1] = vgc[1][0] = vgc[1][1] = 0u; }
    E.prep(cur, wr, wc, fr, fq);
    PG8_STAGE_B(PG8_SB(0, 0), cB); PG8_STAGE_B(PG8_SB(0, 1), cB + hstepB); PG8_STAGE_A(PG8_SA(0, 0), cA, 0, vgc); PG8_STAGE_A(PG8_SA(0, 1), cA, 1, vgc);
    if (wr == 1) PG8_BAR;
    PG8_WAIT_V(2); PG8_BAR;
    PG8_STAGE_B(PG8_SB(1, 0), cB + kstep); PG8_STAGE_A(PG8_SA(1, 0), cA + kstep, 0, vgc); PG8_STAGE_B(PG8_SB(1, 1), cB + hstepB + kstep);
    PG8_WAIT_V(6); PG8_BAR;
    for (;;) {
        const bool has_next = S.next(ui + 1, nxt);
        const char* nA = has_next ? nxt.a : cA; const char* nB = has_next ? nxt.b : cB;
        if constexpr (GATHER) { if (has_next) { PG8_GIDX(vgn, nxt); } else {
#pragma unroll
            for (int h = 0; h < 2; ++h) { vgn[h][0] = vgc[h][0]; vgn[h][1] = vgc[h][1]; } } }
        else { vgn[0][0] = vgn[0][1] = vgn[1][0] = vgn[1][1] = 0u; }
        for (int t = 0; t < nt; t += 2) {
            const bool last = (t == nt - 2);
            const char* a1 = cA + (size_t)(t + 1) * kstep;
            const char* a2 = last ? nA : cA + (size_t)(t + 2) * kstep; const char* b2 = last ? nB : cB + (size_t)(t + 2) * kstep;
            const char* a3 = a2 + kstep; const char* b3 = b2 + kstep;
            unsigned vg2[2][2];
#pragma unroll
            for (int h = 0; h < 2; ++h) { vg2[h][0] = last ? vgn[h][0] : vgc[h][0]; vg2[h][1] = last ? vgn[h][1] : vgc[h][1]; }
            if constexpr (Epi::MIDK) { if (t == (nt >> 1)) E.midk(acc); }
            PG8_LDB(B0, 0, 0); PG8_LDB(B1, 0, 1); PG8_SCHED; PG8_LDA(At, 0, 0); PG8_STAGE_A(PG8_SA(1, 1), a1, 1, vgc);
            PG8_WAIT_V(8); PG8_WAIT_L(0); PG8_BAR; PG8_MMA(0, 0, At, B0); PG8_MMA(0, 1, At, B1); PG8_BAR; PG8_SCHED;
            PG8_LDA(At, 0, 1); PG8_STAGE_B(PG8_SB(0, 0), b2); PG8_STAGE_B(PG8_SB(0, 1), b2 + hstepB); PG8_STAGE_A(PG8_SA(0, 0), a2, 0, vg2);
            PG8_WAIT_V(8); PG8_WAIT_L(0); PG8_BAR; PG8_MMA(1, 0, At, B0); PG8_MMA(1, 1, At, B1); PG8_BAR; PG8_SCHED;
            PG8_LDB(B0, 1, 0); PG8_LDB(B1, 1, 1); PG8_SCHED; PG8_LDA(At, 1, 0); PG8_STAGE_A(PG8_SA(0, 1), a2, 1, vg2);
            PG8_WAIT_V(8); PG8_WAIT_L(0); PG8_BAR; PG8_MMA(0, 0, At, B0); PG8_MMA(0, 1, At, B1); PG8_BAR; PG8_SCHED;
            PG8_LDA(At, 1, 1); PG8_STAGE_B(PG8_SB(1, 0), b3); PG8_STAGE_B(PG8_SB(1, 1), b3 + hstepB); PG8_STAGE_A(PG8_SA(1, 0), a3, 0, vg2);
            PG8_WAIT_V(8); PG8_WAIT_L(0); PG8_BAR; PG8_MMA(1, 0, At, B0); PG8_MMA(1, 1, At, B1); PG8_BAR; PG8_SCHED;
        }
        if constexpr (ALIGN_EPI) { if (wr == 0) PG8_BAR; }
        E(acc, cur, wr, wc, fr, fq);
        if (!has_next) break;
#pragma unroll
        for (int a = 0; a < 2; ++a)
#pragma unroll
            for (int b = 0; b < 2; ++b)
#pragma unroll
                for (int m = 0; m < 4; ++m)
#pragma unroll
                    for (int n = 0; n < 2; ++n) acc[a][b][m][n] = (f32x4){0.f, 0.f, 0.f, 0.f};
        cur = nxt; cA = nA; cB = nB; ++ui;
#pragma unroll
        for (int h = 0; h < 2; ++h) { vgc[h][0] = vgn[h][0]; vgc[h][1] = vgn[h][1]; }
        E.prep(cur, wr, wc, fr, fq);
        if constexpr (ALIGN_EPI) { if (wr == 1) PG8_BAR; }
    }
    PG8_WAIT_V(0);
    if constexpr (!ALIGN_EPI) { if (wr == 0) PG8_BAR; }
    PG8_BAR;
#undef PG8_SA
#undef PG8_SB
#undef PG8_GL
#undef PG8_STAGE_A
#undef PG8_STAGE_B
#undef PG8_LDA
#undef PG8_LDB
#undef PG8_MMA
#undef PG8_WAIT_V
#undef PG8_WAIT_L
#undef PG8_SCHED
#undef PG8_GIDX
}

#define EPI_ROWS for (int ai = 0; ai < 2; ++ai) _Pragma("unroll") for (int m = 0; m < 4; ++m)
__device__ __forceinline__ v4u pack8(const f32x4 a, const f32x4 b) { v4u w; w.x = cvt_pk_bf16(a[0], a[1]); w.y = cvt_pk_bf16(a[2], a[3]); w.z = cvt_pk_bf16(b[0], b[1]); w.w = cvt_pk_bf16(b[2], b[3]); return w; }

template <int mode>
struct EpiStore {
    static constexpr bool MIDK = false;
    bf16* O; int ldc; const float* cs; float scale;
    __device__ __forceinline__ void prep(const Unit&, int, int, int, int) {}
    __device__ __forceinline__ void midk(Acc&) {}
    __device__ __forceinline__ void operator()(const Acc& acc, const Unit& u, int wr, int wc, int fr, int fq) const {
        asm volatile("" : "+v"(fr), "+v"(fq));
        size_t base; const float* csp = cs;
        if constexpr (mode == 0) base = (size_t)u.pm * 256 * ldc + (size_t)u.pn * 256;
        else if constexpr (mode == 1) { const int lb = u.pm >> 2, h = u.pm & 3; base = (size_t)lb * D * D + (size_t)(h * 256) * D + u.pn * 256; csp = cs + (size_t)(lb >> 2) * D + u.pn * 256; }
        else if constexpr (mode == 2) { const int pml = u.pm & 3, lbh = u.pm >> 2, h = lbh & 3, lb = lbh >> 2; base = (size_t)lb * D * D + (size_t)(pml * 256) * D + h * 256; }
        else { const int l = u.pm >> 2, pml = u.pm & 3; base = (size_t)l * NMEM * 2 * D + (size_t)(pml * 256) * 2 * D + u.pn * 256; }
        const int cb = wc * 32 + 8 * fq;
        f32x4 c0[2], c1[2];
#pragma unroll
        for (int bj = 0; bj < 2; ++bj) { if (csp) { c0[bj] = *(const f32x4*)(csp + bj * HALF + cb) * scale; c1[bj] = *(const f32x4*)(csp + bj * HALF + cb + 4) * scale; } else { c0[bj] = (f32x4){scale, scale, scale, scale}; c1[bj] = c0[bj]; } }
#pragma unroll
        EPI_ROWS { bf16* rowp = O + base + (size_t)(ai * HALF + wr * 64 + m * 16 + fr) * ldc + cb;
#pragma unroll
            for (int bj = 0; bj < 2; ++bj) *(v4u*)(rowp + bj * HALF) = pack8(acc[ai][bj][m][0] * c0[bj], acc[ai][bj][m][1] * c1[bj]); }
    }
};
struct EpiH {
    static constexpr bool MIDK = false;
    bf16* H;
    __device__ __forceinline__ void prep(const Unit&, int, int, int, int) {}
    __device__ __forceinline__ void midk(Acc&) {}
    __device__ __forceinline__ void operator()(const Acc& acc, const Unit& u, int wr, int wc, int fr, int fq) const {
        asm volatile("" : "+v"(fr), "+v"(fq));
        const int cb = u.pn * 128 + wc * 32 + 8 * fq;
#pragma unroll
        EPI_ROWS { bf16* rowp = H + (size_t)(u.pm * 256 + ai * HALF + wr * 64 + m * 16 + fr) * FF + cb;
            f32x4 h0, h1;
#pragma unroll
            for (int i = 0; i < 4; ++i) { h0[i] = silu_f(acc[ai][0][m][0][i]) * acc[ai][1][m][0][i]; h1[i] = silu_f(acc[ai][0][m][1][i]) * acc[ai][1][m][1][i]; }
            *(v4u*)rowp = pack8(h0, h1); }
    }
};
template <bool MK, bool WRITE_XB>
struct EpiX {
    static constexpr bool MIDK = MK;
    const float* base; float* out; bf16* xb; float* xstat; const float* gmstat; const float* atstat; LAS unsigned char* lds;
    int wr_, wc_, fr_;
    __device__ __forceinline__ void prep(const Unit& u, int wr, int wc, int fr, int fq) {
        wr_ = wr; wc_ = wc; fr_ = fr;
        if constexpr (MK) {
            asm volatile("" : "+v"(fr), "+v"(fq));
            LAS f32x2* X = (LAS f32x2*)(lds + RING_BYTES + 1024) + (wr * 4 + wc) * 128;
#pragma unroll
            EPI_ROWS { const size_t row = (size_t)u.pm * 256 + ai * HALF + wr * 64 + m * 16 + fr;
                const f32x4 g = *(const f32x4*)(gmstat + row * 4), a0 = *(const f32x4*)(atstat + row * 8), a1 = *(const f32x4*)(atstat + row * 8 + 4);
                const float sg = (g[0] + g[1]) + (g[2] + g[3]), sa = ((a0[0] + a0[1]) + (a0[2] + a0[3])) + ((a1[0] + a1[1]) + (a1[2] + a1[3]));
                const float rgm = 1.0f / sqrtf(sg * (1.0f / 512.0f) + EPS), rat = 1.0f / sqrtf(sa * (1.0f / 512.0f) + EPS);
                if (fq == 0) X[(ai * 4 + m) * 16 + fr] = (f32x2){rgm / rat, rat}; }
            asm volatile("s_waitcnt lgkmcnt(0)" ::: "memory");
        }
    }
    __device__ __forceinline__ void midk(Acc& acc) {
        int fr = fr_; asm volatile("" : "+v"(fr));
        const LAS f32x2* X = (const LAS f32x2*)(lds + RING_BYTES + 1024) + (wr_ * 4 + wc_) * 128;
#pragma unroll
        EPI_ROWS { const float f = X[(ai * 4 + m) * 16 + fr].x;
#pragma unroll
            for (int bj = 0; bj < 2; ++bj) { acc[ai][bj][m][0] *= f; acc[ai][bj][m][1] *= f; } }
    }
    __device__ __forceinline__ void operator()(const Acc& acc, const Unit& u, int wr, int wc, int fr, int fq) const {
        asm volatile("" : "+v"(fr), "+v"(fq));
        const int cb = u.pn * 256 + wc * 32 + 8 * fq;
#pragma unroll
        EPI_ROWS { const size_t row = (size_t)u.pm * 256 + ai * HALF + wr * 64 + m * 16 + fr; const size_t off = row * D + cb;
            float f = 1.0f; if constexpr (MK) f = ((const LAS f32x2*)(lds + RING_BYTES + 1024) + (wr * 4 + wc) * 128)[(ai * 4 + m) * 16 + fr].y; float ss = 0.f;
#pragma unroll
            for (int bj = 0; bj < 2; ++bj) { const f32x4 b0 = *(const f32x4*)(base + off + bj * HALF), b1 = *(const f32x4*)(base + off + bj * HALF + 4);
                const f32x4 x0 = b0 + acc[ai][bj][m][0] * f, x1 = b1 + acc[ai][bj][m][1] * f;
                *(f32x4*)(out + off + bj * HALF) = x0; *(f32x4*)(out + off + bj * HALF + 4) = x1;
                if constexpr (WRITE_XB) { *(v4u*)(xb + off + bj * HALF) = pack8(x0, x1);
                    ss += ((x0[0] * x0[0] + x0[1] * x0[1]) + (x0[2] * x0[2] + x0[3] * x0[3])) + ((x1[0] * x1[0] + x1[1] * x1[1]) + (x1[2] * x1[2] + x1[3] * x1[3])); } }
            if constexpr (WRITE_XB) { ss += __shfl_xor(ss, 16); ss += __shfl_xor(ss, 32); if (fq == 0) xstat[row * 16 + u.pn * 4 + wc] = ss; }
            if (m & 1) asm volatile("" ::: "memory"); }
    }
};

constexpr int EXCH_OFF = RING_BYTES + 1024;
struct EpiS {
    static constexpr bool MIDK = false;
    const float* xstat; bf16* P; LAS unsigned char* lds;
    __device__ __forceinline__ void prep(const Unit&, int, int, int, int) {}
    __device__ __forceinline__ void midk(Acc&) {}
    __device__ __forceinline__ void operator()(Acc& acc, const Unit& u, int wr, int wc, int fr, int fq) const {
        asm volatile("" : "+v"(fr), "+v"(fq));
        LAS f32x2* X = (LAS f32x2*)(lds + EXCH_OFF);
        float mw[2][4];
#pragma unroll
        EPI_ROWS { const int rl = ai * HALF + wr * 64 + m * 16 + fr; const size_t row = (size_t)u.pm * 256 + rl;
            const f32x4 s0 = *(const f32x4*)(xstat + row * 16), s1 = *(const f32x4*)(xstat + row * 16 + 4), s2 = *(const f32x4*)(xstat + row * 16 + 8), s3 = *(const f32x4*)(xstat + row * 16 + 12);
            const float ssq = (((s0[0] + s0[1]) + (s0[2] + s0[3])) + ((s1[0] + s1[1]) + (s1[2] + s1[3]))) + (((s2[0] + s2[1]) + (s2[2] + s2[3])) + ((s3[0] + s3[1]) + (s3[2] + s3[3])));
            const float rinv = 1.0f / sqrtf(ssq * (1.0f / D) + EPS);
            float mx = -3.0e38f;
#pragma unroll
            for (int bj = 0; bj < 2; ++bj)
#pragma unroll
                for (int n = 0; n < 2; ++n) { acc[ai][bj][m][n] *= rinv; const f32x4 v = acc[ai][bj][m][n]; mx = fmaxf(mx, fmaxf(fmaxf(v[0], v[1]), fmaxf(v[2], v[3]))); }
            mx = fmaxf(mx, __shfl_xor(mx, 16)); mx = fmaxf(mx, __shfl_xor(mx, 32));
            float sm = 0.f;
#pragma unroll
            for (int bj = 0; bj < 2; ++bj)
#pragma unroll
                for (int n = 0; n < 2; ++n) { f32x4 v = acc[ai][bj][m][n];
#pragma unroll
                    for (int i = 0; i < 4; ++i) { v[i] = __builtin_amdgcn_exp2f(v[i] - mx); sm += v[i]; }
                    acc[ai][bj][m][n] = v; }
            sm += __shfl_xor(sm, 16); sm += __shfl_xor(sm, 32);
            mw[ai][m] = mx;
            if (fq == 0) X[rl * 4 + wc] = (f32x2){mx, sm};
            if (m & 1) asm volatile("" ::: "memory"); }
        asm volatile("s_waitcnt lgkmcnt(0)\n\ts_barrier" ::: "memory");
        const int cb = u.pn * 256 + wc * 32 + 8 * fq;
#pragma unroll
        EPI_ROWS { const int rl = ai * HALF + wr * 64 + m * 16 + fr; const size_t row = (size_t)u.pm * 256 + rl;
            const f32x2 e0 = X[rl * 4 + 0], e1 = X[rl * 4 + 1], e2 = X[rl * 4 + 2], e3 = X[rl * 4 + 3];
            const float M = fmaxf(fmaxf(e0.x, e1.x), fmaxf(e2.x, e3.x));
            const float den = (e0.y * __builtin_amdgcn_exp2f(e0.x - M) + e1.y * __builtin_amdgcn_exp2f(e1.x - M)) + (e2.y * __builtin_amdgcn_exp2f(e2.x - M) + e3.y * __builtin_amdgcn_exp2f(e3.x - M));
            const float f = __builtin_amdgcn_exp2f(mw[ai][m] - M) / den;
#pragma unroll
            for (int bj = 0; bj < 2; ++bj) *(v4u*)(P + row * D + cb + bj * HALF) = pack8(acc[ai][bj][m][0] * f, acc[ai][bj][m][1] * f); }
        asm volatile("s_waitcnt lgkmcnt(0)" ::: "memory");
    }
};
struct EpiIn {
    static constexpr bool MIDK = false;
    bf16 *uact, *vact, *q, *k, *v; float* vstat; const float *qg, *kg, *cosT, *sinT;
    __device__ __forceinline__ void prep(const Unit&, int, int, int, int) {}
    __device__ __forceinline__ void midk(Acc&) {}
    __device__ __forceinline__ void operator()(const Acc& acc, const Unit& u, int wr, int wc, int fr, int fq) const {
        asm volatile("" : "+v"(fr), "+v"(fq));
        const int pn = u.pn;
        if (pn < 4) {
            bf16* O = pn < 2 ? uact : vact; const int cb = (pn & 1) * 256 + wc * 32 + 8 * fq;
#pragma unroll
            EPI_ROWS { const size_t row = (size_t)u.pm * 256 + ai * HALF + wr * 64 + m * 16 + fr; float ss = 0.f;
#pragma unroll
                for (int bj = 0; bj < 2; ++bj) { f32x4 g0, g1;
#pragma unroll
                    for (int i = 0; i < 4; ++i) { g0[i] = gelu_tanh(acc[ai][bj][m][0][i]); g1[i] = gelu_tanh(acc[ai][bj][m][1][i]); }
                    const v4u w = pack8(g0, g1); *(v4u*)(O + row * GMW + cb + bj * HALF) = w;
                    if (pn >= 2) { const float a0 = bflo(w.x), a1 = bfhi(w.x), a2 = bflo(w.y), a3 = bfhi(w.y), a4 = bflo(w.z), a5 = bfhi(w.z), a6 = bflo(w.w), a7 = bfhi(w.w);
                        ss += ((a0 * a0 + a1 * a1) + (a2 * a2 + a3 * a3)) + ((a4 * a4 + a5 * a5) + (a6 * a6 + a7 * a7)); } }
                if (pn >= 2) { ss += __shfl_xor(ss, 16); ss += __shfl_xor(ss, 32); if (fq == 0) vstat[row * 8 + (pn - 2) * 4 + wc] = ss; } }
        } else if (pn == 6 && wc >= 2) {
#pragma unroll
            EPI_ROWS { const size_t row = (size_t)u.pm * 256 + ai * HALF + wr * 64 + m * 16 + fr;
#pragma unroll
                for (int bj = 0; bj < 2; ++bj) *(v4u*)(v + row * 128 + (wc - 2) * 64 + bj * 32 + 8 * fq) = pack8(acc[ai][bj][m][0], acc[ai][bj][m][1]); }
        } else {
            const bool isq = pn < 6; const float* g = isq ? qg : kg; const float sc = isq ? QSCALE : 1.0f;
            bf16* O = isq ? q + ((pn - 4) * 4 + wc) * 64 : k + wc * 64; const int ldo = isq ? 512 : 128;
            f32x4 gv[2][2];
#pragma unroll
            for (int bj = 0; bj < 2; ++bj) { gv[bj][0] = *(const f32x4*)(g + bj * 32 + 8 * fq) * sc; gv[bj][1] = *(const f32x4*)(g + bj * 32 + 8 * fq + 4) * sc; }
#pragma unroll
            EPI_ROWS { const size_t row = (size_t)u.pm * 256 + ai * HALF + wr * 64 + m * 16 + fr; const int t = (int)(row % SEQ);
                float ss = 0.f;
#pragma unroll
                for (int bj = 0; bj < 2; ++bj)
#pragma unroll
                    for (int n = 0; n < 2; ++n) { const f32x4 x = acc[ai][bj][m][n]; ss += (x[0] * x[0] + x[1] * x[1]) + (x[2] * x[2] + x[3] * x[3]); }
                ss += __shfl_xor(ss, 16); ss += __shfl_xor(ss, 32);
                const float rinv = 1.0f / sqrtf(ss * (1.0f / 64.0f) + EPS);
#pragma unroll
                for (int bj = 0; bj < 2; ++bj) { const f32x4 c = *(const f32x4*)(cosT + t * 32 + bj * 16 + 4 * fq), sn = *(const f32x4*)(sinT + t * 32 + bj * 16 + 4 * fq);
                    const f32x4 x0 = acc[ai][bj][m][0] * gv[bj][0] * rinv, x1 = acc[ai][bj][m][1] * gv[bj][1] * rinv; f32x4 o0, o1;
                    o0[0] = x0[0] * c[0] - x0[1] * sn[0]; o0[1] = x0[0] * sn[0] + x0[1] * c[0]; o0[2] = x0[2] * c[1] - x0[3] * sn[1]; o0[3] = x0[2] * sn[1] + x0[3] * c[1];
                    o1[0] = x1[0] * c[2] - x1[1] * sn[2]; o1[1] = x1[0] * sn[2] + x1[1] * c[2]; o1[2] = x1[2] * c[3] - x1[3] * sn[3]; o1[3] = x1[2] * sn[3] + x1[3] * c[3];
                    *(v4u*)(O + row * ldo + bj * 32 + 8 * fq) = pack8(o0, o1); }
                if (m & 1) asm volatile("" ::: "memory"); }
        }
    }
};
}


struct CvtJob { const float* W; const float* gain; bf16* WT; int K, N, dst_row0, k0, n0; };
__device__ __forceinline__ CvtJob cvt_decode(const Frame& F, int it) {
    constexpr int I_IN = 16 * 56, I_SQ = 512, I_KV = 1024, I_HEAD = I_IN + I_SQ + I_KV + I_SQ, I_LAYER = I_HEAD + NE * 3 * I_SQ;
    CvtJob j; const int l = it / I_LAYER; int r = it % I_LAYER;
    if (r < I_IN) { const int kb = r / 56, nb = r % 56, n0 = nb * 32, pn = n0 >> 8; int dr = n0;
        if (pn >= 4) { const int sidx = n0 & 255, w = sidx >> 6, bj = (sidx >> 5) & 1; dr = pn * 256 + 128 * bj + 32 * w; }
        j.W = F.in[3] + (size_t)l * D * INW; j.gain = F.in[2] + (size_t)l * D; j.WT = (bf16*)(F.ws + WS_WIN) + (size_t)l * INW * D; j.K = D; j.N = INW; j.dst_row0 = dr; j.k0 = kb * 64; j.n0 = n0; return j; }
    r -= I_IN;
    if (r < I_SQ) { j.W = F.in[10] + (size_t)l * D * D; j.gain = F.in[9] + (size_t)l * D; j.WT = (bf16*)(F.ws + WS_WOUT) + (size_t)l * D * D; j.K = D; j.N = D; j.dst_row0 = (r % 32) * 32; j.k0 = (r / 32) * 64; j.n0 = (r % 32) * 32; return j; }
    r -= I_SQ;
    if (r < I_KV) { j.W = F.in[14] + (size_t)l * D * 2 * D; j.gain = nullptr; j.WT = (bf16*)(F.ws + WS_WKVT) + (size_t)l * 2 * D * D; j.K = D; j.N = 2 * D; j.dst_row0 = (r % 64) * 32; j.k0 = (r / 64) * 64; j.n0 = (r % 64) * 32; return j; }
    r -= I_KV;
    if (r < I_SQ) { j.W = F.in[15] + (size_t)l * D * D; j.gain = nullptr; j.WT = (bf16*)(F.ws + WS_WOT) + (size_t)l * D * D; j.K = D; j.N = D; j.dst_row0 = (r % 32) * 32; j.k0 = (r / 32) * 64; j.n0 = (r % 32) * 32; return j; }
    r -= I_SQ;
    const int e = r / (3 * I_SQ), rr = r % (3 * I_SQ), which = rr / I_SQ, sub = rr % I_SQ, kb = sub / 32, n0 = (sub % 32) * 32;
    const size_t mo = ((size_t)l * NE + e) * D * FF;
    j.K = D; j.N = FF; j.k0 = kb * 64; j.n0 = n0;
    if (which == 2) { j.W = F.in[20] + mo; j.gain = nullptr; j.WT = (bf16*)(F.ws + WS_WD) + mo; j.dst_row0 = n0; }
    else { j.W = (which == 0 ? F.in[18] : F.in[19]) + mo; j.gain = F.in[16] + (size_t)l * D; j.WT = (bf16*)(F.ws + WS_WGU) + 2 * mo; j.dst_row0 = 256 * (n0 >> 7) + 128 * which + (n0 & 127); }
    return j;
}
#define CVT_LOAD(J, R) do { const float* p_ = (J).W + (size_t)((J).k0 + (lane_ >> 5)) * (J).N + (J).n0 + (lane_ & 31); _Pragma("unroll") for (int i_ = 0; i_ < 32; ++i_) R[i_] = p_[(size_t)(2 * i_) * (J).N]; } while (0)
__device__ __forceinline__ void ph_convert(Frame& F) {
    int lane_ = lane_id(); asm volatile("" : "+v"(lane_)); const int tid_ = F.wave * 64 + lane_;
    LAS float* scr = (LAS float*)(F.lds + F.wave * 16384);
    const int gw = F.vcu * NWAVES + F.wave, NGW = F.G * NWAVES;
    constexpr int I_LAYER = 16 * 56 + 512 + 1024 + 512 + NE * 3 * 512, NITEMS = NL * I_LAYER;
    if (gw < NITEMS) {
        int it = gw; CvtJob cur = cvt_decode(F, it); float r[32]; CVT_LOAD(cur, r);
        for (;;) {
            const int nit = it + NGW; const bool hn = nit < NITEMS; CvtJob nx = cur; if (hn) nx = cvt_decode(F, nit);
#pragma unroll
            for (int i = 0; i < 32; ++i) scr[(2 * i + (lane_ >> 5)) * 33 + (lane_ & 31)] = r[i];
            if (hn) CVT_LOAD(nx, r);
            asm volatile("s_waitcnt lgkmcnt(0)" ::: "memory");
            const int c = lane_ & 7;
            f32x4 g0 = (f32x4){1.f, 1.f, 1.f, 1.f}, g1 = g0;
            if (cur.gain) { g0 = *(const f32x4*)(cur.gain + cur.k0 + 8 * c); g1 = *(const f32x4*)(cur.gain + cur.k0 + 8 * c + 4); }
#pragma unroll
            for (int j = 0; j < 4; ++j) { const int n = (lane_ >> 3) + 8 * j; const LAS float* sp = scr + (8 * c) * 33 + n;
                v4u o; o.x = pk2(sp[0 * 33] * g0[0], sp[1 * 33] * g0[1]); o.y = pk2(sp[2 * 33] * g0[2], sp[3 * 33] * g0[3]); o.z = pk2(sp[4 * 33] * g1[0], sp[5 * 33] * g1[1]); o.w = pk2(sp[6 * 33] * g1[2], sp[7 * 33] * g1[3]);
                *(v4u*)(cur.WT + (size_t)(cur.dst_row0 + n) * cur.K + cur.k0 + 8 * c) = o; }
            asm volatile("s_waitcnt lgkmcnt(0)" ::: "memory");
            if (!hn) break; cur = nx; it = nit;
        }
    }
    {   const float* wsrc = F.in[5]; bf16* WSBd = (bf16*)(F.ws + WS_WSB);
        for (int i = F.vcu * NTHR + tid_; i < NL * 4 * 128 * 128 / 8; i += F.G * NTHR) { const f32x4 a = *(const f32x4*)(wsrc + (size_t)i * 8), b = *(const f32x4*)(wsrc + (size_t)i * 8 + 4);
            v4u o; o.x = pk2(a.x, a.y); o.y = pk2(a.z, a.w); o.z = pk2(b.x, b.y); o.w = pk2(b.z, b.w); *(v4u*)(WSBd + (size_t)i * 8) = o; } }
    const int gt = F.vcu * NTHR + tid_, NGT = F.G * NTHR;
    const float* wq = F.in[13]; bf16* WQB = (bf16*)(F.ws + WS_WQB);
    for (int i = gt; i < NL * D * D / 8; i += NGT) { const f32x4 a = *(const f32x4*)(wq + (size_t)i * 8), b = *(const f32x4*)(wq + (size_t)i * 8 + 4);
        v4u o; o.x = pk2(a.x, a.y); o.y = pk2(a.z, a.w); o.z = pk2(b.x, b.y); o.w = pk2(b.z, b.w); *(v4u*)(WQB + (size_t)i * 8) = o; }
}

struct SchedDense {
    pg8::TileOrder o; const char* A; size_t a_tile; const char* B; size_t b_tile, b_batch; int bdiv, bmod;
    __device__ __forceinline__ bool next(int i, pg8::Unit& u) const { if (!o.tile(i, u.pm, u.pn)) return false;
        u.z = 0; u.gi = nullptr; u.grow = 0; u.a = A + (size_t)u.pm * a_tile; u.b = B + (size_t)((u.pm / bdiv) % bmod) * b_batch + (size_t)u.pn * b_tile; return true; }
};
struct SchedE1 {
    pg8::TileOrder o; const char* HBp; const int* IDX; const char* WGU;
    __device__ __forceinline__ bool next(int i, pg8::Unit& u) const { if (!o.tile(i, u.pm, u.pn)) return false;
        const int z = u.pm >> 2; u.z = z; u.gi = IDX + (size_t)u.pm * 256; u.grow = (z >> 4) * SEQ; u.a = HBp;
        u.b = WGU + (size_t)(z & 15) * (2 * FF * D * 2) + (size_t)u.pn * (256 * D * 2); return true; }
};
struct SchedKV { pg8::TileOrder o; const char* MEMN; const char* WKVT;
    __device__ __forceinline__ bool next(int i, pg8::Unit& u) const { if (!o.tile(i, u.pm, u.pn)) return false; u.z = 0; u.gi = nullptr; u.grow = 0;
        u.a = MEMN + (size_t)(u.pm & 3) * (256 * D * 2); u.b = WKVT + (size_t)(u.pm >> 2) * (2 * D * D * 2) + (size_t)u.pn * (256 * D * 2); return true; } };
struct SchedQK { pg8::TileOrder o; const char* KVM; const char* WQB;
    __device__ __forceinline__ bool next(int i, pg8::Unit& u) const { if (!o.tile(i, u.pm, u.pn)) return false; u.z = 0; u.gi = nullptr; u.grow = 0;
        const int h = u.pm & 3, lb = u.pm >> 2, b = lb & 3, l = lb >> 2;
        u.a = KVM + ((size_t)l * NMEM * 2 * D + (size_t)(b * 256) * 2 * D + h * 256) * 2; u.b = WQB + ((size_t)l * D * D + (size_t)u.pn * 256 * D + h * 256) * 2; return true; } };
struct SchedVO { pg8::TileOrder o; const char* KVM; const char* WOT;
    __device__ __forceinline__ bool next(int i, pg8::Unit& u) const { if (!o.tile(i, u.pm, u.pn)) return false; u.z = 0; u.gi = nullptr; u.grow = 0;
        const int pml = u.pm & 3, lbh = u.pm >> 2, h = lbh & 3, lb = lbh >> 2, b = lb & 3, l = lb >> 2;
        u.a = WOT + ((size_t)l * D * D + (size_t)pml * 256 * D + h * 256) * 2; u.b = KVM + ((size_t)l * NMEM * 2 * D + (size_t)(b * 256) * 2 * D + D + h * 256) * 2; return true; } };

namespace attn_body {
using bf16=__hip_bfloat16;
using bf16x8=__attribute__((ext_vector_type(8)))short;
using s16x4=__attribute__((ext_vector_type(4)))short;
using f32x16=__attribute__((ext_vector_type(16)))float;
using u32x4=__attribute__((ext_vector_type(4)))unsigned;
constexpr int SEQ=8192,D=64,QP=512,KP=128,OP=1024;
constexpr int NW=8,QBLK=32,QB=QBLK*NW,KVBLK=64,NQB=SEQ/QB;
constexpr int ATTN_UNIT_ROWS=QB;
__device__ __forceinline__ int crow(int r,int hi){return (r&3)+8*(r>>2)+4*hi;}
#define SBAR() __builtin_amdgcn_sched_barrier(0)
__device__ __forceinline__ void cmask(f32x16&p0,f32x16&p1,int jb,int qrel,int hi){
  const float NEG=-INFINITY; int kb=64*jb+4*hi;
  #pragma unroll
  for(int r=0;r<16;++r){int kv=kb+(r&3)+8*(r>>2); if(kv>qrel)p0[r]=NEG; if(kv+32>qrel)p1[r]=NEG;}
}

constexpr int NSLOT=3, SLOTB=8192;
constexpr int LDS_K=0, LDS_V=NSLOT*SLOTB, LDS_WS=2*NSLOT*SLOTB, LDS_OST=LDS_WS+NW*64*4, LDS_BYTES=LDS_OST+NW*4096;
constexpr float C2=0.125f*1.4426950408889634f;
__device__ __forceinline__ void glds16(const void*gsrc,unsigned lds_dst){unsigned keep;
  asm volatile("s_mov_b32 %0, m0\n\ts_mov_b32 m0, %2\n\ts_nop 0\n\tglobal_load_lds_dwordx4 %1, off\n\ts_mov_b32 m0, %0":"=&s"(keep):"v"(gsrc),"s"(lds_dst):"memory");}
__device__ __forceinline__ float max3f(float a,float b,float c){float r;asm("v_max3_f32 %0, %1, %2, %3":"=v"(r):"v"(a),"v"(b),"v"(c));return r;}
__device__ __forceinline__ float max2f(float a,float b){float r;asm("v_max_f32_e32 %0, %1, %2":"=v"(r):"v"(a),"v"(b));return r;}
__device__ __forceinline__ float fadd_s(float a,float b){float r;asm("v_add_f32_e32 %0, %1, %2":"=v"(r):"v"(a),"v"(b));return r;}
__device__ __forceinline__ float fsub_s(float a,float b){float r;asm("v_sub_f32_e32 %0, %1, %2":"=v"(r):"v"(a),"v"(b));return r;}
typedef float f32x2_t __attribute__((ext_vector_type(2))); typedef __bf16 bf16x2_t __attribute__((ext_vector_type(2)));
__device__ __forceinline__ unsigned cvtpk_s(float lo,float hi){f32x2_t v={lo,hi};bf16x2_t b=__builtin_convertvector(v,bf16x2_t);return __builtin_bit_cast(unsigned,b);}
#define WAIT_BAR(N) asm volatile("s_waitcnt vmcnt(" #N ") lgkmcnt(0)\n\ts_barrier":::"memory")

__device__ __forceinline__ void qkt(f32x16&p0,f32x16&p1,const char*Kslot,const bf16x8*qr,const f32x16&negm,int r32,int hi){
  const char*kb=Kslot+hi*1024+r32*16;
  #pragma unroll
  for(int d0=0;d0<4;++d0){
    const bf16x8 b0=*reinterpret_cast<const bf16x8*>(kb+d0*2048);
    const bf16x8 b1=*reinterpret_cast<const bf16x8*>(kb+d0*2048+512);
    if(d0==0){p0=__builtin_amdgcn_mfma_f32_32x32x16_bf16(b0,qr[0],negm,0,0,0);p1=__builtin_amdgcn_mfma_f32_32x32x16_bf16(b1,qr[0],negm,0,0,0);}
    else{p0=__builtin_amdgcn_mfma_f32_32x32x16_bf16(b0,qr[d0],p0,0,0,0);p1=__builtin_amdgcn_mfma_f32_32x32x16_bf16(b1,qr[d0],p1,0,0,0);}}
}
typedef __attribute__((address_space(3))) const char* lds_cptr;
typedef short v4i16_t __attribute__((ext_vector_type(4)));
__device__ __forceinline__ void kload8(bf16x8*kf,lds_cptr kp){
  kf[0]=*(const __attribute__((address_space(3))) bf16x8*)(kp);      kf[1]=*(const __attribute__((address_space(3))) bf16x8*)(kp+512);
  kf[2]=*(const __attribute__((address_space(3))) bf16x8*)(kp+2048); kf[3]=*(const __attribute__((address_space(3))) bf16x8*)(kp+2560);
  kf[4]=*(const __attribute__((address_space(3))) bf16x8*)(kp+4096); kf[5]=*(const __attribute__((address_space(3))) bf16x8*)(kp+4608);
  kf[6]=*(const __attribute__((address_space(3))) bf16x8*)(kp+6144); kf[7]=*(const __attribute__((address_space(3))) bf16x8*)(kp+6656);
}
__device__ __forceinline__ void kload2(bf16x8*kf,lds_cptr kp,int j){ kf[2*j]=*(const __attribute__((address_space(3))) bf16x8*)(kp+j*2048); kf[2*j+1]=*(const __attribute__((address_space(3))) bf16x8*)(kp+j*2048+512); }
__device__ __forceinline__ s16x4 vtr(lds_cptr p){ return __builtin_bit_cast(s16x4,__builtin_amdgcn_ds_read_tr16_b64_v4i16((__attribute__((address_space(3))) v4i16_t*)p)); }
__device__ __forceinline__ float rowmax(const f32x16&p0,const f32x16&p1){
  float a=max3f(p0[0],p0[1],p1[0]),b=max3f(p0[2],p0[3],p1[1]);a=max3f(a,p1[2],p1[3]);
  #pragma unroll
  for(int r=4;r<16;r+=4){a=max3f(a,p0[r],p0[r+1]);b=max3f(b,p0[r+2],p0[r+3]);a=max3f(a,p1[r],p1[r+1]);b=max3f(b,p1[r+2],p1[r+3]);}
  const float m=max2f(a,b);
  auto rr=__builtin_amdgcn_permlane32_swap(__float_as_uint(m),__float_as_uint(m),false,false);
  return max2f(__uint_as_float(rr[0]),__uint_as_float(rr[1]));
}
__device__ __forceinline__ void pv(f32x16*o,int vb,bf16x8 pa0,bf16x8 pa1,bf16x8 pa2,bf16x8 pa3){
  #pragma unroll
  for(int d0=0;d0<2;++d0){s16x4 lo[4],hi[4];
    #pragma unroll
    for(int ks=0;ks<4;++ks){
      asm volatile("ds_read_b64_tr_b16 %0,%1 offset:%c2":"=&v"(lo[ks]):"v"(vb),"i"(d0*4096+ks*1024):"memory");
      asm volatile("ds_read_b64_tr_b16 %0,%1 offset:%c2":"=&v"(hi[ks]):"v"(vb),"i"(d0*4096+ks*1024+512):"memory");}
    asm volatile("s_waitcnt lgkmcnt(0)":::"memory");SBAR();
    #define PK(k) (bf16x8){lo[k][0],lo[k][1],lo[k][2],lo[k][3],hi[k][0],hi[k][1],hi[k][2],hi[k][3]}
    o[d0]=__builtin_amdgcn_mfma_f32_32x32x16_bf16(pa0,PK(0),o[d0],0,0,0);
    o[d0]=__builtin_amdgcn_mfma_f32_32x32x16_bf16(pa1,PK(1),o[d0],0,0,0);
    o[d0]=__builtin_amdgcn_mfma_f32_32x32x16_bf16(pa2,PK(2),o[d0],0,0,0);
    o[d0]=__builtin_amdgcn_mfma_f32_32x32x16_bf16(pa3,PK(3),o[d0],0,0,0);
    #undef PK
  }
}

#ifndef ATTN_STORE16
#define ATTN_STORE16(p,v) (*(u32x4*)(p)=(v))
#endif
template<int THRL> __device__ __forceinline__ void attn_unit(int b,int h,int qb,const bf16*Q,const bf16*__restrict__ K,const bf16*__restrict__ V,bf16*O,float*ATS,char*shm,int wave_idx){
  int lane=(int)__builtin_amdgcn_mbcnt_hi(~0u,__builtin_amdgcn_mbcnt_lo(~0u,0u)); asm volatile("":"+v"(lane)); const int r32=lane&31,hi=lane>>5; const int wid=wave_idx; const int kvh=h>>2;
  const long rowbase=(long)b*SEQ; const int q0=qb*QB;
  const bf16*Qw=Q+(rowbase+q0+wid*QBLK)*QP+h*D;
  const bf16*Kh=K+rowbase*KP+kvh*D,*Vh=V+rowbase*KP+kvh*D;
  const unsigned lds0=(unsigned)(uintptr_t)shm;
  float*wsf=(float*)(shm+LDS_WS)+wid*64;
  const bf16*ksrc=Kh+(long)lane*KP+wid*8;
  const bf16*vsrc=Vh+(long)(16*(wid&3)+(lane>>2))*KP+(wid>>2)*32+(lane&3)*8;
  const unsigned kdst=lds0+LDS_K+wid*1024, vdst=lds0+LDS_V+wid*1024;
  #define DMA_K(t,slot) glds16(ksrc+(long)(t)*KVBLK*KP,(unsigned)__builtin_amdgcn_readfirstlane(kdst+(slot)))
  #define DMA_V(t,slot) glds16(vsrc+(long)(t)*KVBLK*KP,(unsigned)__builtin_amdgcn_readfirstlane(vdst+(slot)))
  const int vb0=(int)(lds0+LDS_V)+((lane>>4)&1)*32+(lane&3)*8+(4*hi+((lane&15)>>2))*64;
  const char*Kbase=shm+LDS_K; bf16x8 kf[8];
  const lds_cptr shm3=(lds_cptr)shm; const lds_cptr kp0=shm3+LDS_K+hi*1024+r32*16; const lds_cptr vp0=shm3+LDS_V+((lane>>4)&1)*32+(lane&3)*8+(4*hi+((lane&15)>>2))*64;
  const int NT=SEQ/KVBLK;
  DMA_K(0,0);DMA_V(0,0);DMA_K(1,SLOTB);
  bf16x8 qr[4];
  #pragma unroll
  for(int d0=0;d0<4;++d0)qr[d0]=*reinterpret_cast<const bf16x8*>(&Qw[(long)r32*QP+d0*16+hi*8]);
  float mhat=0.f,l_reg=0.f;f32x16 o[2];o[0]=f32x16{};o[1]=f32x16{};f32x16 negm=f32x16{};asm volatile("":"+v"(negm));
  const int qrel=wid*QBLK+r32;
  #define CMASK(P0,P1,t) do{}while(0)
  bool resc=false;
  #define START(P0,P1) do{ const float rm=rowmax(P0,P1); resc=false; \
    { const float dl=rm; mhat=fadd_s(mhat,dl); \
      _Pragma("unroll") for(int r=0;r<16;++r){P0[r]=fsub_s(P0[r],dl);P1[r]=fsub_s(P1[r],dl);} \
      _Pragma("unroll") for(int r=0;r<16;++r)negm[r]=-mhat; asm volatile("":"+v"(negm)); } \
    _Pragma("unroll") for(int r=0;r<16;++r)P0[r]=__builtin_amdgcn_exp2f(P0[r]); }while(0)
  #define RESC() do{ if(resc){ asm volatile("s_waitcnt lgkmcnt(0)":::"memory"); \
      _Pragma("unroll") for(int d_=0;d_<2;++d_) _Pragma("unroll") for(int r=0;r<16;++r)o[d_][r]*=wsf[crow(r,hi)]; } }while(0)
  f32x16 pA0,pA1,pB0,pB1;
  int sl_prev=0,sl_cur=0,sl_next=SLOTB;
  #define ROT() do{sl_prev=sl_cur;sl_cur=sl_next;sl_next=(sl_next==(NSLOT-1)*SLOTB)?0:sl_next+SLOTB;}while(0)
  DMA_K(2,2*SLOTB);
  WAIT_BAR(3);
  qkt(pA0,pA1,Kbase,qr,negm,r32,hi);asm volatile("s_nop 15\n\ts_nop 7":"+v"(pA0),"+v"(pA1));CMASK(pA0,pA1,0);
  START(pA0,pA1);
  _Pragma("unroll") for(int r=0;r<16;++r)pA1[r]=__builtin_amdgcn_exp2f(pA1[r]);
  WAIT_BAR(0);
  DMA_K(3,0);DMA_V(1,SLOTB);
  ROT();
  kload8(kf,kp0+sl_cur);
  WAIT_BAR(2);
  s16x4 vlo[8],vhi[8]; u32x4 pw0,pw1,pw2,pw3;
  #define PKW(P,B) cvtpk_s(P[B],P[B+1])
  #define PAF(k) __builtin_bit_cast(bf16x8,pw##k)
  #define VFR(i) (bf16x8){vlo[i][0],vlo[i][1],vlo[i][2],vlo[i][3],vhi[i][0],vhi[i][1],vhi[i][2],vhi[i][3]}
  #define PIN(x) asm volatile("":"+v"(x))
  #define MX3(a,b,c) __builtin_fmaxf(__builtin_fmaxf((a),(b)),(c))
  #define GAPA(MF,A0,A1,A2,A3,W0,W1,PW) do{ MF; sacc+=A0; sacc+=A1; sacc+=A2; sacc+=A3; PIN(sacc); W0; W1; PIN(PW); SBAR(); }while(0)
  #define EX(v) __builtin_amdgcn_exp2f(v)
  #define GAPB(MF,X,B) do{ MF; X[B]=EX(X[B]); X[B+1]=EX(X[B+1]); X[B+2]=EX(X[B+2]); X[B+3]=EX(X[B+3]); PIN(X); SBAR(); }while(0)
  #define VRD(i) do{ vlo[i]=vtr(vp_+(((i)>>2)*4096+((i)&3)*1024)); vhi[i]=vtr(vp_+(((i)>>2)*4096+((i)&3)*1024+512)); }while(0)
  #define KRD(G,j) do{ if(G){ kload2(kf,kp0+sl_next,j); SBAR(); } }while(0)
  #define STEP(C0,C1,P0,P1,t,GK,GV,GL) do{ SBAR(); \
    const lds_cptr vp_=vp0+sl_prev; \
    VRD(0); SBAR(); float sacc=(P0[0]+P0[1]); \
    GAPA(C0=__builtin_amdgcn_mfma_f32_32x32x16_bf16(kf[0],qr[0],negm,0,0,0), P0[2],P0[3],P0[4],P0[5],     pw0[0]=PKW(P0,0), pw0[1]=PKW(P0,2), pw0); \
    VRD(4); SBAR(); GAPA(C1=__builtin_amdgcn_mfma_f32_32x32x16_bf16(kf[1],qr[0],negm,0,0,0), P0[6],P0[7],P0[8],P0[9],     pw0[2]=PKW(P0,4), pw0[3]=PKW(P0,6), pw0); \
    VRD(1); SBAR(); GAPA(C0=__builtin_amdgcn_mfma_f32_32x32x16_bf16(kf[2],qr[1],C0,0,0,0),   P0[10],P0[11],P0[12],P0[13], pw1[0]=PKW(P0,8), pw1[1]=PKW(P0,10), pw1); \
    VRD(5); SBAR(); GAPA(C1=__builtin_amdgcn_mfma_f32_32x32x16_bf16(kf[3],qr[1],C1,0,0,0),   P0[14],P0[15],P1[0],P1[1],   pw1[2]=PKW(P0,12),pw1[3]=PKW(P0,14), pw1); \
    VRD(2); SBAR(); GAPA(C0=__builtin_amdgcn_mfma_f32_32x32x16_bf16(kf[4],qr[2],C0,0,0,0),   P1[2],P1[3],P1[4],P1[5],     pw2[0]=PKW(P1,0), pw2[1]=PKW(P1,2), pw2); \
    VRD(6); SBAR(); GAPA(C1=__builtin_amdgcn_mfma_f32_32x32x16_bf16(kf[5],qr[2],C1,0,0,0),   P1[6],P1[7],P1[8],P1[9],     pw2[2]=PKW(P1,4), pw2[3]=PKW(P1,6), pw2); \
    VRD(3); SBAR(); GAPA(C0=__builtin_amdgcn_mfma_f32_32x32x16_bf16(kf[6],qr[3],C0,0,0,0),   P1[10],P1[11],P1[12],P1[13], pw3[0]=PKW(P1,8), pw3[1]=PKW(P1,10), pw3); \
    VRD(7); SBAR(); GAPA(C1=__builtin_amdgcn_mfma_f32_32x32x16_bf16(kf[7],qr[3],C1,0,0,0),   P1[14],P1[15],0.f,0.f,       pw3[2]=PKW(P1,12),pw3[3]=PKW(P1,14), pw3); \
    l_reg+=sacc; \
    if(GK){DMA_K((t)+3,sl_cur);} if(GV){DMA_V((t)+1,sl_next);} \
    CMASK(C0,C1,t); \
    { float a=MX3(C0[0],C0[1],C1[0]),b=MX3(C0[2],C0[3],C1[1]); a=MX3(a,C1[2],C1[3]); \
      _Pragma("unroll") for(int r=4;r<16;r+=4){a=MX3(a,C0[r],C0[r+1]);b=MX3(b,C0[r+2],C0[r+3]);a=MX3(a,C1[r],C1[r+1]);b=MX3(b,C1[r+2],C1[r+3]);} \
      float rm=__builtin_fmaxf(a,b); { auto rr=__builtin_amdgcn_permlane32_swap(__float_as_uint(rm),__float_as_uint(rm),false,false); rm=__builtin_fmaxf(__uint_as_float(rr[0]),__uint_as_float(rr[1])); } \
      resc=false; \
      if(__builtin_expect(__any(rm>(float)THRL),0)){ const float dl=__builtin_fmaxf(rm,0.f); mhat+=dl; \
        _Pragma("unroll") for(int r=0;r<16;++r){C0[r]-=dl;C1[r]-=dl;} \
        _Pragma("unroll") for(int r=0;r<16;++r)negm[r]=-mhat; asm volatile("":"+v"(negm)); \
        const float f=__builtin_amdgcn_exp2f(-dl); l_reg*=f; if(hi==0)wsf[r32]=f; resc=true; } } \
    SBAR(); \
    GAPB(o[0]=__builtin_amdgcn_mfma_f32_32x32x16_bf16(PAF(0),VFR(0),o[0],0,0,0), C0,0); \
    GAPB(o[1]=__builtin_amdgcn_mfma_f32_32x32x16_bf16(PAF(0),VFR(4),o[1],0,0,0), C0,4); \
    KRD(GL,0); GAPB(o[0]=__builtin_amdgcn_mfma_f32_32x32x16_bf16(PAF(1),VFR(1),o[0],0,0,0), C0,8); \
    KRD(GL,1); GAPB(o[1]=__builtin_amdgcn_mfma_f32_32x32x16_bf16(PAF(1),VFR(5),o[1],0,0,0), C0,12); \
    KRD(GL,2); GAPB(o[0]=__builtin_amdgcn_mfma_f32_32x32x16_bf16(PAF(2),VFR(2),o[0],0,0,0), C1,0); \
    KRD(GL,3); GAPB(o[1]=__builtin_amdgcn_mfma_f32_32x32x16_bf16(PAF(2),VFR(6),o[1],0,0,0), C1,4); \
    GAPB(o[0]=__builtin_amdgcn_mfma_f32_32x32x16_bf16(PAF(3),VFR(3),o[0],0,0,0), C1,8); \
    GAPB(o[1]=__builtin_amdgcn_mfma_f32_32x32x16_bf16(PAF(3),VFR(7),o[1],0,0,0), C1,12); \
    }while(0)
  int t=1;
  for(;t+5<NT;t+=2){
    STEP(pB0,pB1,pA0,pA1,t,true,true,true);     WAIT_BAR(2); RESC(); ROT();
    STEP(pA0,pA1,pB0,pB1,t+1,true,true,true);   WAIT_BAR(2); RESC(); ROT();
  }
  #define ENDW(tt) do{ if((tt)+3<NT){WAIT_BAR(2);} else if((tt)+2<NT){WAIT_BAR(1);} else {WAIT_BAR(0);} }while(0)
  for(;t+1<NT;t+=2){
    STEP(pB0,pB1,pA0,pA1,t,(t+3<NT),(t+1<NT),(t+1<NT));       ENDW(t);   RESC(); ROT();
    STEP(pA0,pA1,pB0,pB1,t+1,(t+4<NT),(t+2<NT),(t+2<NT));     ENDW(t+1); RESC(); ROT();
  }
  STEP(pB0,pB1,pA0,pA1,NT-1,false,false,false); RESC();
  { float sacc=pB0[0]+pB0[1]; _Pragma("unroll") for(int r=2;r<16;++r)sacc+=pB0[r]; _Pragma("unroll") for(int r=0;r<16;++r)sacc+=pB1[r]; l_reg+=sacc;
    pw0=(u32x4){PKW(pB0,0),PKW(pB0,2),PKW(pB0,4),PKW(pB0,6)};pw1=(u32x4){PKW(pB0,8),PKW(pB0,10),PKW(pB0,12),PKW(pB0,14)};pw2=(u32x4){PKW(pB1,0),PKW(pB1,2),PKW(pB1,4),PKW(pB1,6)};pw3=(u32x4){PKW(pB1,8),PKW(pB1,10),PKW(pB1,12),PKW(pB1,14)};
    SBAR(); pv(o,vb0+sl_cur,PAF(0),PAF(1),PAF(2),PAF(3)); }
  #undef PKW
  #undef PAF
  #undef VFR
  #undef PIN
  #undef MX3
  #undef GAPA
  #undef GAPB
  #undef EX
  #undef VRD
  #undef KRD
  #undef STEP
  #undef ENDW
  {auto rr=__builtin_amdgcn_permlane32_swap(__float_as_uint(l_reg),__float_as_uint(l_reg),false,false);l_reg=__uint_as_float(rr[0])+__uint_as_float(rr[1]);}
  if(hi==0)wsf[32+r32]=l_reg;asm volatile("s_waitcnt lgkmcnt(0)":::"memory");
  float rli[16];
  #pragma unroll
  for(int r=0;r<16;++r)rli[r]=__builtin_amdgcn_rcpf(wsf[32+crow(r,hi)]);
  bf16*Ow=O+(rowbase+q0+wid*QBLK)*OP+512+h*D; float*ATw=ATS+(rowbase+q0+wid*QBLK)*8+h;
  { bf16*stg=(bf16*)(shm+LDS_OST)+wid*2048;
    #pragma unroll
    for(int r=0;r<16;++r){const int orow=crow(r,hi);
      #pragma unroll
      for(int d0=0;d0<2;++d0)stg[orow*64+d0*32+r32]=__float2bfloat16(o[d0][r]*rli[r]);}
    asm volatile("s_waitcnt lgkmcnt(0)":::"memory");
    #pragma unroll
    for(int i=0;i<4;++i){const int row=i*8+(lane>>3),ch=lane&7; const u32x4 v=*(const u32x4*)(stg+row*64+ch*8); ATTN_STORE16(Ow+(long)row*OP+ch*8,v);
      float ss=0.f;
      #pragma unroll
      for(int q=0;q<4;++q){const float lo=__uint_as_float(v[q]<<16),hh=__uint_as_float(v[q]&0xffff0000u);ss+=lo*lo+hh*hh;}
      ss+=__shfl_xor(ss,1);ss+=__shfl_xor(ss,2);ss+=__shfl_xor(ss,4); if(ch==0)ATw[(long)row*8]=ss;} }
  asm volatile("s_waitcnt lgkmcnt(0)\n\ts_barrier":::"memory");
  #undef DMA_K
  #undef DMA_V
  #undef CMASK
  #undef START
  #undef RESC
  #undef ROT
}
constexpr int ATTN_LDS_BYTES=LDS_BYTES;
#undef SBAR
#undef WAIT_BAR
}

__global__ void __launch_bounds__(NTHR, 2) mega(Args args) {
    extern __shared__ __attribute__((aligned(16))) unsigned char lds[];
    Frame F;
    F.lds = (LAS unsigned char*)lds;
    F.wave = __builtin_amdgcn_readfirstlane(threadIdx.x >> 6);
    F.G = gridDim.x; { const int bx = blockIdx.x; F.vcu = (F.G % 8 == 0) ? (bx % 8) * (F.G / 8) + bx / 8 : bx; }
#pragma unroll
    for (int i = 0; i < 22; ++i) F.in[i] = args.in[i];
    F.ws = args.ws; F.xres = args.out;
    volatile LAS unsigned* MISC = (volatile LAS unsigned*)(F.lds + MISC_OFF);
    for (int u = threadIdx.x; u < (LDS_BYTES - LDSCTL_OFF) / 4; u += NTHR) ((LAS unsigned*)(F.lds + LDSCTL_OFF))[u] = 0u;
    __syncthreads();
    const int lo = args.ph_lo, hi = args.ph_hi;
    unsigned* barw = (unsigned*)(F.ws + WS_CTL) + CW_BAR + args.bar_region * XCD_BAR_WORDS;
    XcdBarrier bar; bar.bar = barw; bar.x = 0; bar.st = nullptr;
    if (hi - lo > 1) bar = xcd_barrier_post(barw, MISC + 8);
#ifndef ONLY_K
#define ONLY_K -1
#endif
#define EN(kind) (ONLY_K < 0 || ONLY_K == (kind))
#define IN(k) (lo <= (k) && (k) < hi)
#ifndef REPK
#define REPK -1
#endif
#define PROBE_TOP(k) for (int rep_ = 0; rep_ < (REPK == (k) ? 2 : 1); ++rep_) {
#define PROBE_END(k) if (REPK == (k) && rep_ == 0) xcd_barrier(bar); }
#define SEAM(k) do { if (IN(k) && IN((k) + 1)) xcd_barrier(bar); } while (0)
    const int cid0 = (int)blockIdx.x; const int cid = cid0;
    if (EN(100) && IN(0)) { asm volatile("; PHASE_MARK P0"); PROBE_TOP(100) ph_rows0(F); PROBE_END(100) } SEAM(0);
    if (EN(101) && IN(1)) { asm volatile("; PHASE_MARK P1"); PROBE_TOP(101) ph_convert(F); PROBE_END(101) } SEAM(1);
    if (EN(102) && IN(2)) { asm volatile("; PHASE_MARK P2"); PROBE_TOP(102)
        SchedKV S; S.o.init(NL * 4, 8, F.G, cid); S.MEMN = (const char*)(F.ws + WS_MEMN); S.WKVT = (const char*)(F.ws + WS_WKVT);
        pg8::EpiStore<3> E{(bf16*)(F.ws + WS_KVM), 2 * D, nullptr, 1.0f};
        pg8::gemm_phase<pg8::EpiStore<3>, SchedKV, true, false>(F.lds, F.wave, D, D, D, S, E);
    PROBE_END(102) } SEAM(2);
    if (EN(103) && IN(3)) { asm volatile("; PHASE_MARK P3a");
        SchedQK S; S.o.init(NL * 16, 4, F.G, cid); S.KVM = (const char*)(F.ws + WS_KVM); S.WQB = (const char*)(F.ws + WS_WQB);
        pg8::EpiStore<1> E{(bf16*)(F.ws + WS_QKT), D, F.in[11], XQSCALE};
        int la = 2 * D, lb = D, kk = 256; asm volatile("" : "+s"(la), "+s"(lb), "+s"(kk));
        pg8::gemm_phase<pg8::EpiStore<1>, SchedQK, true, false>(F.lds, F.wave, la, lb, kk, S, E);
    }
    if (EN(104) && IN(3)) { asm volatile("; PHASE_MARK P3b");
        SchedVO S; S.o.init(NL * 64, 1, F.G, cid); S.KVM = (const char*)(F.ws + WS_KVM); S.WOT = (const char*)(F.ws + WS_WOT);
        pg8::EpiStore<2> E{(bf16*)(F.ws + WS_VOT), D, nullptr, 1.0f};
        int la = D, lb = 2 * D, kk = 256; asm volatile("" : "+s"(la), "+s"(lb), "+s"(kk));
        pg8::gemm_phase<pg8::EpiStore<2>, SchedVO, true, false>(F.lds, F.wave, la, lb, kk, S, E);
    } SEAM(3);
    for (int l = 0; l < NL; ++l) {
        const int pb = PH_LAYER0 + PH_PER_LAYER * l;
        int cid = cid0; asm volatile("" : "+s"(cid));
        if (EN(0) && IN(pb + 0)) { asm volatile("; PHASE_MARK L0"); PROBE_TOP(0)
            SchedDense S; S.o.init(T / 256, 7, F.G, cid); S.A = (const char*)(F.ws + WS_HB); S.a_tile = 256 * D * 2; S.B = (const char*)(F.ws + WS_WIN) + (size_t)l * INW * D * 2; S.b_tile = 256 * D * 2; S.b_batch = 0; S.bdiv = 1; S.bmod = 1;
            pg8::EpiIn E{(bf16*)(F.ws + WS_UACT), (bf16*)(F.ws + WS_VACT), (bf16*)(F.ws + WS_Q), (bf16*)(F.ws + WS_K), (bf16*)(F.ws + WS_V), (float*)(F.ws + WS_VSTAT),
                         F.in[7] + (size_t)l * 64, F.in[8] + (size_t)l * 64, (const float*)(F.ws + WS_ROPE), (const float*)(F.ws + WS_ROPE) + SEQ * 32};
            pg8::gemm_phase<pg8::EpiIn, SchedDense, true, false>(F.lds, F.wave, D, D, D, S, E);
        PROBE_END(0) } SEAM(pb + 0);
        if (EN(1) && IN(pb + 1)) { asm volatile("; PHASE_MARK L1");
            PROBE_TOP(11)
            for (int it = 0; ; ++it) { const int w = it * F.G + F.vcu; if (w >= NB_ * 8 * (SEQ / 256)) break;
                const int i = w >> 8, c = w & 255, x = c >> 5, j = c & 31;
                attn_body::attn_unit<8>(x >> 1, (x & 1) * 4 + i, j, (const attn_body::bf16*)(F.ws + WS_Q), (const attn_body::bf16*)(F.ws + WS_K), (const attn_body::bf16*)(F.ws + WS_V),
                                        (attn_body::bf16*)(F.ws + WS_MERGED), (float*)(F.ws + WS_ATSTAT), (char*)lds, F.wave); }
            PROBE_END(11)
            PROBE_TOP(12) ph_gmlp(F, l); PROBE_END(12) } SEAM(pb + 1);
        if (EN(2) && IN(pb + 2)) { asm volatile("; PHASE_MARK L2"); PROBE_TOP(2)
            SchedDense S; S.o.init(T / 256, 4, F.G, cid); S.A = (const char*)(F.ws + WS_MERGED); S.a_tile = 256 * D * 2; S.B = (const char*)(F.ws + WS_WOUT) + (size_t)l * D * D * 2; S.b_tile = 256 * D * 2; S.b_batch = 0; S.bdiv = 1; S.bmod = 1;
            pg8::EpiX<true, true> E; E.base = l == 0 ? F.in[0] : F.xres; E.out = (REPK == 2 && rep_ == 0) ? (float*)(F.ws + WS_NSCR) : F.xres; E.xb = (REPK == 2 && rep_ == 0) ? (bf16*)(F.ws + WS_NSCR + 128 * MiB) : (bf16*)(F.ws + WS_XB); E.xstat = (float*)(F.ws + WS_XSTAT); E.gmstat = (const float*)(F.ws + WS_GMSTAT); E.atstat = (const float*)(F.ws + WS_ATSTAT); E.lds = F.lds;
            pg8::gemm_phase<pg8::EpiX<true, true>, SchedDense, true, false>(F.lds, F.wave, D, D, D, S, E);
        PROBE_END(2) } SEAM(pb + 2);
        if (EN(3) && IN(pb + 3)) { asm volatile("; PHASE_MARK L3"); PROBE_TOP(3)
            SchedDense S; S.o.init(T / 256, 4, F.G, cid); S.A = (const char*)(F.ws + WS_XB); S.a_tile = 256 * D * 2; S.B = (const char*)(F.ws + WS_QKT) + (size_t)l * NB_ * D * D * 2; S.b_tile = 256 * D * 2; S.b_batch = (size_t)D * D * 2; S.bdiv = SEQ / 256; S.bmod = NB_;
            pg8::EpiS E{(const float*)(F.ws + WS_XSTAT), (bf16*)(F.ws + WS_P), F.lds};
            pg8::gemm_phase<pg8::EpiS, SchedDense, true, false>(F.lds, F.wave, D, D, D, S, E);
        PROBE_END(3) } SEAM(pb + 3);
        if (EN(4) && IN(pb + 4)) { asm volatile("; PHASE_MARK L4"); PROBE_TOP(4)
            SchedDense S; S.o.init(T / 256, 4, F.G, cid); S.A = (const char*)(F.ws + WS_P); S.a_tile = 256 * D * 2; S.B = (const char*)(F.ws + WS_VOT) + (size_t)l * NB_ * D * D * 2; S.b_tile = 256 * D * 2; S.b_batch = (size_t)D * D * 2; S.bdiv = SEQ / 256; S.bmod = NB_;
            pg8::EpiX<false, false> E; E.base = F.xres; E.out = (REPK == 4 && rep_ == 0) ? (float*)(F.ws + WS_NSCR) : F.xres; E.xb = nullptr; E.xstat = nullptr; E.gmstat = nullptr; E.atstat = nullptr; E.lds = F.lds;
            pg8::gemm_phase<pg8::EpiX<false, false>, SchedDense, true, false>(F.lds, F.wave, D, D, D, S, E);
        PROBE_END(4) } SEAM(pb + 4);
        if (EN(5) && IN(pb + 5)) { asm volatile("; PHASE_MARK L5"); PROBE_TOP(5) ph_router(F, l); PROBE_END(5) } SEAM(pb + 5);
        if (EN(6) && IN(pb + 6)) { asm volatile("; PHASE_MARK L6"); PROBE_TOP(6) ph_topk(F); PROBE_END(6) } SEAM(pb + 6);
        if (EN(7) && IN(pb + 7)) { asm volatile("; PHASE_MARK L7"); PROBE_TOP(7)
            SchedE1 S; S.o.init(NB_ * NE * 4, 8, F.G, cid); S.HBp = (const char*)(F.ws + WS_HB); S.IDX = (const int*)(F.ws + WS_IDX); S.WGU = (const char*)(F.ws + WS_WGU) + (size_t)l * NE * 2 * FF * D * 2;
            pg8::EpiH E{(bf16*)(F.ws + WS_H)};
            pg8::gemm_phase<pg8::EpiH, SchedE1, true, true>(F.lds, F.wave, D, D, D, S, E);
        PROBE_END(7) } SEAM(pb + 7);
        if (EN(8) && IN(pb + 8)) { asm volatile("; PHASE_MARK L8"); PROBE_TOP(8)
            SchedDense S; S.o.init(NB_ * NE * 4, 4, F.G, cid); S.A = (const char*)(F.ws + WS_H); S.a_tile = 256 * FF * 2; S.B = (const char*)(F.ws + WS_WD) + (size_t)l * NE * D * FF * 2; S.b_tile = 256 * FF * 2; S.b_batch = (size_t)D * FF * 2; S.bdiv = 4; S.bmod = NE;
            pg8::EpiStore<0> E{(bf16*)(F.ws + WS_Y), D, nullptr, 1.0f};
            pg8::gemm_phase<pg8::EpiStore<0>, SchedDense, true, false>(F.lds, F.wave, FF, FF, FF, S, E);
        PROBE_END(8) } SEAM(pb + 8);
        if (EN(9) && IN(pb + 9)) { asm volatile("; PHASE_MARK L9"); PROBE_TOP(9) ph_combine(F, l, REPK == 9 && rep_ == 0); PROBE_END(9) } SEAM(pb + 9);
    }
#undef IN
#undef SEAM
}

template <int NB, class AF>
__device__ __forceinline__ void ngemm_tile(const bf16* A, int lda, const int* aidx, int arow_base, int m0, const float* W0, const float* W1, int ldw, int n0, int K,
                                           float (&acc)[NB][4][4], float* sA, float* sB, const AF& af) {
    const int tid = threadIdx.x, tx = tid & 15, ty = tid >> 4;
    const int lr = tid >> 2, k4 = (tid & 3) * 4;
    const int arow = arow_base + (aidx ? aidx[m0 + lr] : (m0 + lr));
    const int bk = tid >> 4, bn = (tid & 15) * 4;
#pragma unroll
    for (int b = 0; b < NB; ++b)
#pragma unroll
        for (int i = 0; i < 4; ++i)
#pragma unroll
            for (int j = 0; j < 4; ++j) acc[b][i][j] = 0.f;
    for (int k0 = 0; k0 < K; k0 += 16) {
        const v2u raw = *(const v2u*)(A + (size_t)arow * lda + k0 + k4);
        sA[(k4 + 0) * 68 + lr] = af(lr, k0 + k4 + 0, bflo(raw.x)); sA[(k4 + 1) * 68 + lr] = af(lr, k0 + k4 + 1, bfhi(raw.x));
        sA[(k4 + 2) * 68 + lr] = af(lr, k0 + k4 + 2, bflo(raw.y)); sA[(k4 + 3) * 68 + lr] = af(lr, k0 + k4 + 3, bfhi(raw.y));
        *(f32x4*)(sB + bk * 64 + bn) = *(const f32x4*)(W0 + (size_t)(k0 + bk) * ldw + n0 + bn);
        if (NB == 2) *(f32x4*)(sB + 1024 + bk * 64 + bn) = *(const f32x4*)(W1 + (size_t)(k0 + bk) * ldw + n0 + bn);
        __syncthreads();
#pragma unroll
        for (int kk = 0; kk < 16; ++kk) {
            const f32x4 a = *(const f32x4*)(sA + kk * 68 + ty * 4);
#pragma unroll
            for (int b = 0; b < NB; ++b) { const f32x4 w = *(const f32x4*)(sB + b * 1024 + kk * 64 + tx * 4);
#pragma unroll
                for (int i = 0; i < 4; ++i) { acc[b][i][0] += a[i] * w.x; acc[b][i][1] += a[i] * w.y; acc[b][i][2] += a[i] * w.z; acc[b][i][3] += a[i] * w.w; } }
        }
        __syncthreads();
    }
}
__device__ __forceinline__ float sum16(float v) { v += __shfl_xor(v, 1); v += __shfl_xor(v, 2); v += __shfl_xor(v, 4); v += __shfl_xor(v, 8); return v; }
__device__ __forceinline__ float max16(float v) { v = fmaxf(v, __shfl_xor(v, 1)); v = fmaxf(v, __shfl_xor(v, 2)); v = fmaxf(v, __shfl_xor(v, 4)); v = fmaxf(v, __shfl_xor(v, 8)); return v; }
struct AfGain { const float* g; __device__ __forceinline__ float operator()(int, int k, float a) const { return a * g[k]; } };
struct AfNone { __device__ __forceinline__ float operator()(int, int, float a) const { return a; } };
struct AfRowGain { const float* rs; const float* g; __device__ __forceinline__ float operator()(int r, int k, float a) const { return a * rs[r] * g[k]; } };
struct AfMerged { const float* rgm; const float* rat; const float* g; __device__ __forceinline__ float operator()(int r, int k, float a) const { return a * g[k] * (k < 512 ? rgm[r] : rat[r]); } };

__global__ void __launch_bounds__(256) nk_inproj(Args args, int l) {
    __shared__ float sA[16 * 68]; __shared__ float sB[1024];
    const int nt = blockIdx.x, m0 = blockIdx.y * 64, tid = threadIdx.x, tx = tid & 15, ty = tid >> 4;
    unsigned char* ws = args.ws;
    float acc[1][4][4];
    AfGain af{args.in[2] + (size_t)l * D};
    ngemm_tile<1>((const bf16*)(ws + WS_HB), D, nullptr, 0, m0, args.in[3] + (size_t)l * D * INW, nullptr, INW, nt * 64, D, acc, sA, sB, af);
    const float* COS = (const float*)(ws + WS_ROPE); const float* SIN = COS + SEQ * 32;
#pragma unroll
    for (int i = 0; i < 4; ++i) {
        const int row = m0 + ty * 4 + i; float v[4];
#pragma unroll
        for (int j = 0; j < 4; ++j) v[j] = acc[0][i][j];
        if (nt < 16) {
#pragma unroll
            for (int j = 0; j < 4; ++j) v[j] = gelu_tanh(v[j]);
            v2u o; o.x = pk2(v[0], v[1]); o.y = pk2(v[2], v[3]);
            if (nt < 8) *(v2u*)((bf16*)(ws + WS_UACT) + (size_t)row * GMW + nt * 64 + tx * 4) = o;
            else {
                *(v2u*)((bf16*)(ws + WS_VACT) + (size_t)row * GMW + (nt - 8) * 64 + tx * 4) = o;
                const float a = bflo(o.x), b = bfhi(o.x), c = bflo(o.y), d = bfhi(o.y);
                const float s = sum16((a * a + b * b) + (c * c + d * d));
                if (tx == 0) ((float*)(ws + WS_VSTAT))[(size_t)row * 8 + (nt - 8)] = s;
            }
        } else if (nt < 26) {
            const bool isq = nt < 24; const float* g = (isq ? args.in[7] : args.in[8]) + (size_t)l * 64;
            const float s = sum16((v[0] * v[0] + v[1] * v[1]) + (v[2] * v[2] + v[3] * v[3]));
            const float rinv = 1.0f / sqrtf(s * (1.0f / 64.0f) + EPS);
#pragma unroll
            for (int j = 0; j < 4; ++j) v[j] = v[j] * rinv * g[tx * 4 + j];
            const int t = row % SEQ; float o4[4];
#pragma unroll
            for (int pp = 0; pp < 2; ++pp) { const int p = tx * 2 + pp; const float c = COS[t * 32 + p], sn = SIN[t * 32 + p];
                o4[2 * pp] = v[2 * pp] * c - v[2 * pp + 1] * sn; o4[2 * pp + 1] = v[2 * pp] * sn + v[2 * pp + 1] * c; }
            const float sc = isq ? QSCALE : 1.0f;
            v2u o; o.x = pk2(o4[0] * sc, o4[1] * sc); o.y = pk2(o4[2] * sc, o4[3] * sc);
            if (isq) *(v2u*)((bf16*)(ws + WS_Q) + (size_t)row * 512 + (nt - 16) * 64 + tx * 4) = o;
            else *(v2u*)((bf16*)(ws + WS_K) + (size_t)row * 128 + (nt - 24) * 64 + tx * 4) = o;
        } else {
            v2u o; o.x = pk2(v[0], v[1]); o.y = pk2(v[2], v[3]);
            *(v2u*)((bf16*)(ws + WS_V) + (size_t)row * 128 + (nt - 26) * 64 + tx * 4) = o;
        }
    }
}

__global__ void __launch_bounds__(256) nk_attn(Args args) {
    __shared__ float sQt[64 * 68]; __shared__ float sKt[64 * 68]; __shared__ float sV[64 * 68];
    const int qb = blockIdx.x, h = blockIdx.y, b = blockIdx.z, tid = threadIdx.x, tx = tid & 15, ty = tid >> 4;
    unsigned char* ws = args.ws;
    const bf16* Q = (const bf16*)(ws + WS_Q); const bf16* Kp = (const bf16*)(ws + WS_K); const bf16* Vp = (const bf16*)(ws + WS_V);
    const int kvh = h >> 2; const size_t rb = (size_t)b * SEQ;
    const int lr = tid >> 2, d16 = (tid & 3) * 16;
    {   const bf16* src = Q + (rb + qb * 64 + lr) * 512 + h * 64 + d16;
        const v4u r0 = *(const v4u*)src, r1 = *(const v4u*)(src + 8);
        const unsigned w[8] = {r0.x, r0.y, r0.z, r0.w, r1.x, r1.y, r1.z, r1.w};
#pragma unroll
        for (int q = 0; q < 8; ++q) { sQt[(d16 + 2 * q) * 68 + lr] = bflo(w[q]); sQt[(d16 + 2 * q + 1) * 68 + lr] = bfhi(w[q]); } }
    float o[4][4], mrow[4], lrow[4];
#pragma unroll
    for (int i = 0; i < 4; ++i) { mrow[i] = -1e30f; lrow[i] = 0.f;
#pragma unroll
        for (int j = 0; j < 4; ++j) o[i][j] = 0.f; }
    for (int kt = 0; kt < SEQ / 64; ++kt) {
        __syncthreads();
        {   const bf16* ks = Kp + (rb + kt * 64 + lr) * 128 + kvh * 64 + d16; const bf16* vs = Vp + (rb + kt * 64 + lr) * 128 + kvh * 64 + d16;
            const v4u r0 = *(const v4u*)ks, r1 = *(const v4u*)(ks + 8), s0 = *(const v4u*)vs, s1 = *(const v4u*)(vs + 8);
            const unsigned w[8] = {r0.x, r0.y, r0.z, r0.w, r1.x, r1.y, r1.z, r1.w}; const unsigned x[8] = {s0.x, s0.y, s0.z, s0.w, s1.x, s1.y, s1.z, s1.w};
#pragma unroll
            for (int q = 0; q < 8; ++q) { sKt[(d16 + 2 * q) * 68 + lr] = bflo(w[q]); sKt[(d16 + 2 * q + 1) * 68 + lr] = bfhi(w[q]);
                sV[lr * 68 + d16 + 2 * q] = bflo(x[q]); sV[lr * 68 + d16 + 2 * q + 1] = bfhi(x[q]); } }
        __syncthreads();
        float s[4][4];
#pragma unroll
        for (int i = 0; i < 4; ++i)
#pragma unroll
            for (int j = 0; j < 4; ++j) s[i][j] = 0.f;
#pragma unroll 8
        for (int d = 0; d < 64; ++d) { const f32x4 a = *(const f32x4*)(sQt + d * 68 + ty * 4), k = *(const f32x4*)(sKt + d * 68 + tx * 4);
#pragma unroll
            for (int i = 0; i < 4; ++i) { s[i][0] += a[i] * k.x; s[i][1] += a[i] * k.y; s[i][2] += a[i] * k.z; s[i][3] += a[i] * k.w; } }
        __syncthreads();
#pragma unroll
        for (int i = 0; i < 4; ++i) {
            const float mx = max16(fmaxf(fmaxf(s[i][0], s[i][1]), fmaxf(s[i][2], s[i][3])));
            const float mn = fmaxf(mrow[i], mx), f = __builtin_amdgcn_exp2f(mrow[i] - mn); mrow[i] = mn;
            float ps = 0.f;
#pragma unroll
            for (int j = 0; j < 4; ++j) { const float p = __builtin_amdgcn_exp2f(s[i][j] - mn); ps += p; sKt[(tx * 4 + j) * 68 + ty * 4 + i] = p; }
            lrow[i] = lrow[i] * f + sum16(ps);
#pragma unroll
            for (int j = 0; j < 4; ++j) o[i][j] *= f;
        }
        __syncthreads();
#pragma unroll 8
        for (int k = 0; k < 64; ++k) { const f32x4 p = *(const f32x4*)(sKt + k * 68 + ty * 4), v = *(const f32x4*)(sV + k * 68 + tx * 4);
#pragma unroll
            for (int i = 0; i < 4; ++i) { o[i][0] += p[i] * v.x; o[i][1] += p[i] * v.y; o[i][2] += p[i] * v.z; o[i][3] += p[i] * v.w; } }
    }
    bf16* MERGED = (bf16*)(ws + WS_MERGED); float* ATSTAT = (float*)(ws + WS_ATSTAT);
#pragma unroll
    for (int i = 0; i < 4; ++i) {
        const size_t row = rb + qb * 64 + ty * 4 + i; const float rl = 1.0f / lrow[i];
        v2u w; w.x = pk2(o[i][0] * rl, o[i][1] * rl); w.y = pk2(o[i][2] * rl, o[i][3] * rl);
        *(v2u*)(MERGED + row * 1024 + 512 + h * 64 + tx * 4) = w;
        const float a = bflo(w.x), b2 = bfhi(w.x), c = bflo(w.y), d = bfhi(w.y);
        const float ss = sum16((a * a + b2 * b2) + (c * c + d * d));
        if (tx == 0) ATSTAT[row * 8 + h] = ss;
    }
}

__global__ void __launch_bounds__(256) nk_outproj(Args args, int l) {
    __shared__ float sA[16 * 68]; __shared__ float sB[1024]; __shared__ float rgm[64]; __shared__ float rat[64]; __shared__ float gg[1024];
    const int nt = blockIdx.x, m0 = blockIdx.y * 64, tid = threadIdx.x, tx = tid & 15, ty = tid >> 4;
    unsigned char* ws = args.ws;
    if (tid < 64) { const float* gs = (const float*)(ws + WS_GMSTAT) + (size_t)(m0 + tid) * 4; const float* as = (const float*)(ws + WS_ATSTAT) + (size_t)(m0 + tid) * 8;
        float a = 0.f, b = 0.f; for (int q = 0; q < 4; ++q) a += gs[q]; for (int q = 0; q < 8; ++q) b += as[q];
        rgm[tid] = 1.0f / sqrtf(a * (1.0f / 512.0f) + EPS); rat[tid] = 1.0f / sqrtf(b * (1.0f / 512.0f) + EPS); }
    for (int i = tid; i < 1024; i += 256) gg[i] = args.in[9][(size_t)l * 1024 + i];
    __syncthreads();
    float acc[1][4][4];
    AfMerged af{rgm, rat, gg};
    ngemm_tile<1>((const bf16*)(ws + WS_MERGED), 1024, nullptr, 0, m0, args.in[10] + (size_t)l * D * D, nullptr, D, nt * 64, D, acc, sA, sB, af);
    const float* base = l == 0 ? args.in[0] : args.out;
#pragma unroll
    for (int i = 0; i < 4; ++i) {
        const size_t row = m0 + ty * 4 + i; const size_t off = row * D + nt * 64 + tx * 4;
        const f32x4 bs = *(const f32x4*)(base + off);
        const f32x4 xn = (f32x4){bs.x + acc[0][i][0], bs.y + acc[0][i][1], bs.z + acc[0][i][2], bs.w + acc[0][i][3]};
        *(f32x4*)(args.out + off) = xn;
        v2u o; o.x = pk2(xn.x, xn.y); o.y = pk2(xn.z, xn.w); *(v2u*)((bf16*)(ws + WS_XB) + off) = o;
        const float s = sum16((xn.x * xn.x + xn.y * xn.y) + (xn.z * xn.z + xn.w * xn.w));
        if (tx == 0) ((float*)(ws + WS_XSTAT))[row * 16 + nt] = s;
    }
}

__global__ void __launch_bounds__(256) nk_xq(Args args, int l) {
    __shared__ float sA[16 * 68]; __shared__ float sB[1024]; __shared__ float rs[64];
    const int nt = blockIdx.x, m0 = blockIdx.y * 64, tid = threadIdx.x, tx = tid & 15, ty = tid >> 4;
    unsigned char* ws = args.ws;
    if (tid < 64) { const float* xs = (const float*)(ws + WS_XSTAT) + (size_t)(m0 + tid) * 16; float a = 0.f; for (int q = 0; q < 16; ++q) a += xs[q]; rs[tid] = 1.0f / sqrtf(a * (1.0f / D) + EPS); }
    __syncthreads();
    float acc[1][4][4];
    AfRowGain af{rs, args.in[11] + (size_t)l * D};
    ngemm_tile<1>((const bf16*)(ws + WS_XB), D, nullptr, 0, m0, args.in[13] + (size_t)l * D * D, nullptr, D, nt * 64, D, acc, sA, sB, af);
#pragma unroll
    for (int i = 0; i < 4; ++i) { const size_t off = (size_t)(m0 + ty * 4 + i) * D + nt * 64 + tx * 4;
        v2u o; o.x = pk2(acc[0][i][0] * XQSCALE, acc[0][i][1] * XQSCALE); o.y = pk2(acc[0][i][2] * XQSCALE, acc[0][i][3] * XQSCALE); *(v2u*)((bf16*)(ws + WS_Q2) + off) = o; }
}
__global__ void __launch_bounds__(256) nk_xkv(Args args, int l) {
    __shared__ float sA[16 * 68]; __shared__ float sB[1024];
    const int nt = blockIdx.x, m0 = blockIdx.y * 64, tid = threadIdx.x, tx = tid & 15, ty = tid >> 4;
    unsigned char* ws = args.ws;
    float acc[1][4][4]; AfNone af;
    ngemm_tile<1>((const bf16*)(ws + WS_MEMN), D, nullptr, 0, m0, args.in[14] + (size_t)l * D * 2 * D, nullptr, 2 * D, nt * 64, D, acc, sA, sB, af);
#pragma unroll
    for (int i = 0; i < 4; ++i) { const size_t off = (size_t)(m0 + ty * 4 + i) * 2 * D + nt * 64 + tx * 4;
        v2u o; o.x = pk2(acc[0][i][0], acc[0][i][1]); o.y = pk2(acc[0][i][2], acc[0][i][3]); *(v2u*)((bf16*)(ws + WS_KVN) + off) = o; }
}
__global__ void __launch_bounds__(256) nk_xattn(Args args) {
    __shared__ float sq[8 * 256]; __shared__ float sp[8 * 256];
    const int r0 = blockIdx.x * 8, h = blockIdx.y, tid = threadIdx.x, lane = tid & 63, wv = tid >> 6;
    unsigned char* ws = args.ws; const int b = r0 / SEQ;
    const bf16* Q2 = (const bf16*)(ws + WS_Q2); const bf16* KVN = (const bf16*)(ws + WS_KVN);
    for (int i = tid; i < 8 * 256; i += 256) sq[i] = bf2f(Q2[(size_t)(r0 + (i >> 8)) * D + h * 256 + (i & 255)]);
    __syncthreads();
    {   const bf16* kr = KVN + (size_t)(b * MEML + tid) * 2 * D + h * 256;
        float sc[8];
#pragma unroll
        for (int r = 0; r < 8; ++r) sc[r] = 0.f;
        for (int d = 0; d < 256; d += 8) { const v4u w = *(const v4u*)(kr + d);
            const float kv[8] = {bflo(w.x), bfhi(w.x), bflo(w.y), bfhi(w.y), bflo(w.z), bfhi(w.z), bflo(w.w), bfhi(w.w)};
#pragma unroll
            for (int r = 0; r < 8; ++r) {
#pragma unroll
                for (int q = 0; q < 8; ++q) sc[r] += sq[r * 256 + d + q] * kv[q]; } }
#pragma unroll
        for (int r = 0; r < 8; ++r) sp[r * 256 + tid] = sc[r]; }
    __syncthreads();
#pragma unroll
    for (int rr = 0; rr < 2; ++rr) { const int r = wv * 2 + rr;
        float v[4]; float mx = -1e30f;
#pragma unroll
        for (int q = 0; q < 4; ++q) { v[q] = sp[r * 256 + lane + 64 * q]; mx = fmaxf(mx, v[q]); }
#pragma unroll
        for (int o = 1; o < 64; o <<= 1) mx = fmaxf(mx, __shfl_xor(mx, o));
        float sm = 0.f;
#pragma unroll
        for (int q = 0; q < 4; ++q) { v[q] = __builtin_amdgcn_exp2f(v[q] - mx); sm += v[q]; }
        sm = wave_sum(sm); const float rinv = 1.0f / sm;
#pragma unroll
        for (int q = 0; q < 4; ++q) sp[r * 256 + lane + 64 * q] = v[q] * rinv; }
    __syncthreads();
    {   float o[8];
#pragma unroll
        for (int r = 0; r < 8; ++r) o[r] = 0.f;
        const bf16* vr = KVN + (size_t)(b * MEML) * 2 * D + D + h * 256 + tid;
        for (int m = 0; m < MEML; ++m) { const float v = bf2f(vr[(size_t)m * 2 * D]);
#pragma unroll
            for (int r = 0; r < 8; ++r) o[r] += sp[r * 256 + m] * v; }
#pragma unroll
        for (int r = 0; r < 8; ++r) ((bf16*)(ws + WS_O2))[(size_t)(r0 + r) * D + h * 256 + tid] = (bf16)f2bf(o[r]); }
}
__global__ void __launch_bounds__(256) nk_xo(Args args, int l) {
    __shared__ float sA[16 * 68]; __shared__ float sB[1024];
    const int nt = blockIdx.x, m0 = blockIdx.y * 64, tid = threadIdx.x, tx = tid & 15, ty = tid >> 4;
    unsigned char* ws = args.ws;
    float acc[1][4][4]; AfNone af;
    ngemm_tile<1>((const bf16*)(ws + WS_O2), D, nullptr, 0, m0, args.in[15] + (size_t)l * D * D, nullptr, D, nt * 64, D, acc, sA, sB, af);
#pragma unroll
    for (int i = 0; i < 4; ++i) { const size_t off = (size_t)(m0 + ty * 4 + i) * D + nt * 64 + tx * 4;
        const f32x4 bs = *(const f32x4*)(args.out + off);
        *(f32x4*)(args.out + off) = (f32x4){bs.x + acc[0][i][0], bs.y + acc[0][i][1], bs.z + acc[0][i][2], bs.w + acc[0][i][3]}; }
}
__global__ void __launch_bounds__(256) nk_moe1(Args args, int l) {
    __shared__ float sA[16 * 68]; __shared__ float sB[2048];
    const int nt = blockIdx.x, m0 = blockIdx.y * 64, z = blockIdx.z, b = z >> 4, e = z & 15, tid = threadIdx.x, tx = tid & 15, ty = tid >> 4;
    unsigned char* ws = args.ws;
    float acc[2][4][4];
    AfGain af{args.in[16] + (size_t)l * D};
    const size_t wo = ((size_t)l * NE + e) * D * FF;
    ngemm_tile<2>((const bf16*)(ws + WS_HB), D, (const int*)(ws + WS_IDX) + (size_t)z * CAP, b * SEQ, m0, args.in[18] + wo, args.in[19] + wo, FF, nt * 64, D, acc, sA, sB, af);
#pragma unroll
    for (int i = 0; i < 4; ++i) { const size_t off = ((size_t)z * CAP + m0 + ty * 4 + i) * FF + nt * 64 + tx * 4;
        float hv[4];
#pragma unroll
        for (int j = 0; j < 4; ++j) hv[j] = silu_f(acc[0][i][j]) * acc[1][i][j];
        v2u o; o.x = pk2(hv[0], hv[1]); o.y = pk2(hv[2], hv[3]); *(v2u*)((bf16*)(ws + WS_H) + off) = o; }
}
__global__ void __launch_bounds__(256) nk_moe2(Args args, int l) {
    __shared__ float sA[16 * 68]; __shared__ float sB[1024];
    const int nt = blockIdx.x, m0 = blockIdx.y * 64, z = blockIdx.z, e = z & 15, tid = threadIdx.x, tx = tid & 15, ty = tid >> 4;
    unsigned char* ws = args.ws;
    float acc[1][4][4]; AfNone af;
    ngemm_tile<1>((const bf16*)(ws + WS_H) + (size_t)z * CAP * FF, FF, nullptr, 0, m0, args.in[20] + ((size_t)l * NE + e) * FF * D, nullptr, D, nt * 64, FF, acc, sA, sB, af);
#pragma unroll
    for (int i = 0; i < 4; ++i) { const size_t off = ((size_t)z * CAP + m0 + ty * 4 + i) * D + nt * 64 + tx * 4;
        v2u o; o.x = pk2(acc[0][i][0], acc[0][i][1]); o.y = pk2(acc[0][i][2], acc[0][i][3]); *(v2u*)((bf16*)(ws + WS_Y) + off) = o; }
}

static int g_grid = 0;
static void launch_mega(Args a, int lo, int hi, int region, hipStream_t stream) {
    a.ph_lo = lo; a.ph_hi = hi; a.bar_region = region; a.pad = 0;
    hipLaunchKernelGGL(mega, dim3(g_grid), dim3(NTHR), LDS_BYTES, stream, a);
}
extern "C" void kernel_launch(void* const* d_in, const int* in_sizes, int n_in, void* d_out, int out_size, void* d_ws, size_t ws_size, hipStream_t stream) {
    if (g_grid == 0) {
        if (n_in != 22 || out_size != T * D || ws_size < WS_END) { fprintf(stderr, "kernel_launch: unexpected sizes n_in %d out %d ws %zu\n", n_in, out_size, ws_size); g_grid = -1; return; }
        int dev = 0, cus = 0;
        if (hipGetDevice(&dev) != hipSuccess || hipDeviceGetAttribute(&cus, hipDeviceAttributeMultiprocessorCount, dev) != hipSuccess) { g_grid = -1; return; }
        if (hipFuncSetAttribute((const void*)mega, hipFuncAttributeMaxDynamicSharedMemorySize, LDS_BYTES) != hipSuccess) { g_grid = -1; return; }
        int per_cu = 0;
        if (hipOccupancyMaxActiveBlocksPerMultiprocessor(&per_cu, (const void*)mega, NTHR, LDS_BYTES) != hipSuccess || per_cu < 1) fprintf(stderr, "kernel_launch: occupancy query says %d\n", per_cu);
        (void)hipGetLastError();
        g_grid = cus;
    }
    if (g_grid < 0) return;
    hipMemsetAsync((char*)d_ws + WS_CTL, 0, CTL_ZERO_BYTES, stream);
    Args a{};
    for (int i = 0; i < 22; ++i) a.in[i] = (const float*)d_in[i];
    a.out = (float*)d_out; a.ws = (unsigned char*)d_ws;
    static const bool MEGA_KIND[10] = {true, true, true, true, true, true, true, true, true, true};
    const bool NAIVE_ATTN = false, NEED_WEIGHTS = true, NEED_XPRE = true;
    const bool ONE_LAUNCH = true;
    if (ONE_LAUNCH) { launch_mega(a, 0, PH_END, 0, stream); return; }
    int region = 0;
    launch_mega(a, 0, NEED_XPRE ? 4 : (NEED_WEIGHTS ? 2 : 1), region++, stream);
    for (int l = 0; l < NL; ++l) {
        const int pb = PH_LAYER0 + PH_PER_LAYER * l;
        int k = 0;
        while (k < 10) {
            if (MEGA_KIND[k] && !(k == 1 && NAIVE_ATTN)) { int k2 = k; while (k2 < 10 && MEGA_KIND[k2] && !(k2 == 1 && NAIVE_ATTN)) ++k2; launch_mega(a, pb + k, pb + k2, region++, stream); k = k2; continue; }
            if (k == 0) hipLaunchKernelGGL(nk_inproj, dim3(28, T / 64), dim3(256), 0, stream, a, l);
            else if (k == 1) { hipLaunchKernelGGL(nk_attn, dim3(SEQ / 64, 8, NB_), dim3(256), 0, stream, a); launch_mega(a, pb + 1, pb + 2, region++, stream); }
            else if (k == 2) hipLaunchKernelGGL(nk_outproj, dim3(16, T / 64), dim3(256), 0, stream, a, l);
            else if (k == 3) { hipLaunchKernelGGL(nk_xq, dim3(16, T / 64), dim3(256), 0, stream, a, l); hipLaunchKernelGGL(nk_xkv, dim3(32, 16), dim3(256), 0, stream, a, l);
                               hipLaunchKernelGGL(nk_xattn, dim3(T / 8, 4), dim3(256), 0, stream, a); hipLaunchKernelGGL(nk_xo, dim3(16, T / 64), dim3(256), 0, stream, a, l); ++k; }
            else if (k == 7) { hipLaunchKernelGGL(nk_moe1, dim3(16, 16, 64), dim3(256), 0, stream, a, l); }
            else if (k == 8) { hipLaunchKernelGGL(nk_moe2, dim3(16, 16, 64), dim3(256), 0, stream, a, l); }
            ++k;
        }
    }
}
```

```cpp
#include <hip/hip_runtime.h>
#include <hip/hip_bf16.h>
#include <cstdio>
#include <cstdint>
#include <cmath>

constexpr int NB_ = 4, SEQ = 8192, T = NB_ * SEQ, D = 1024, NL = 4;
constexpr int MEML = 256, NMEM = NB_ * MEML;
constexpr int INW = 1792, GMW = 512, NE = 16, CAP = 1024, FF = 1024;
constexpr float EPS = 1e-6f;
constexpr float LOG2E = 1.4426950408889634f;
constexpr float QSCALE = 0.125f * LOG2E;
constexpr float XQSCALE = 0.0625f * LOG2E;

constexpr size_t MiB = 1u << 20;
constexpr size_t WS_CTL = 0, CTL_ZERO_BYTES = 1 * MiB;
constexpr size_t WS_ROPE = 1 * MiB;
constexpr size_t WS_AFF = 3 * MiB;
constexpr size_t WS_INV = 5 * MiB;
constexpr size_t WS_IDX = 7 * MiB;
constexpr size_t WS_VSTAT = 8 * MiB;
constexpr size_t WS_ATSTAT = 9 * MiB;
constexpr size_t WS_GMSTAT = 10 * MiB;
constexpr size_t WS_RINV = 10 * MiB + 512 * 1024;
constexpr size_t WS_RINV2 = 10 * MiB + 768 * 1024;
constexpr size_t WS_XSTAT = 11 * MiB;
constexpr size_t WS_MEMN = 13 * MiB;
constexpr size_t WS_WSB = 15 * MiB;
constexpr size_t WS_WIN = 16 * MiB;
constexpr size_t WS_WOUT = 30 * MiB;
constexpr size_t WS_QKT = 38 * MiB;
constexpr size_t WS_VOT = 70 * MiB;
constexpr size_t WS_WGU = 102 * MiB;
constexpr size_t WS_WD = 358 * MiB;
constexpr size_t WS_XR = 486 * MiB;
constexpr size_t WS_R1 = 550 * MiB;
constexpr size_t WS_UACT = WS_R1, WS_VACT = WS_R1 + 32 * MiB, WS_Q = WS_R1 + 64 * MiB, WS_K = WS_R1 + 96 * MiB, WS_V = WS_R1 + 104 * MiB;
constexpr size_t WS_WQB = WS_R1, WS_WOT = WS_R1 + 8 * MiB, WS_WKVT = WS_R1 + 16 * MiB, WS_KVM = WS_R1 + 32 * MiB;
constexpr size_t WS_H = WS_R1;
constexpr size_t WS_MERGED = 678 * MiB;
constexpr size_t WS_XB = 742 * MiB;
constexpr size_t WS_P = WS_MERGED;
constexpr size_t WS_Y = 678 * MiB;
constexpr size_t WS_NSCR = 806 * MiB;
constexpr size_t WS_Q2 = WS_MERGED;
constexpr size_t WS_O2 = WS_NSCR;
constexpr size_t WS_KVN = WS_NSCR + 64 * MiB;
constexpr size_t WS_END = 1024 * MiB;

constexpr int CW_TMO = 0, CW_CODE = 1, CW_BAR = 4096;

#define GAS __attribute__((address_space(1)))
#define LAS __attribute__((address_space(3)))
typedef unsigned short bf16;
typedef unsigned v4u __attribute__((ext_vector_type(4)));
typedef unsigned v2u __attribute__((ext_vector_type(2)));
typedef float f32x4 __attribute__((ext_vector_type(4)));
typedef short bf16x8_t __attribute__((ext_vector_type(8)));
typedef GAS unsigned gu32;
#define RLX_AGENT __ATOMIC_RELAXED, __HIP_MEMORY_SCOPE_AGENT
__device__ __forceinline__ unsigned f2bf(float f) { unsigned u = __builtin_bit_cast(unsigned, f); return (u + 0x7fffu + ((u >> 16) & 1u)) >> 16; }
__device__ __forceinline__ unsigned pk2(float lo, float hi) { return f2bf(lo) | (f2bf(hi) << 16); }
__device__ __forceinline__ float bf2f(unsigned v) { return __builtin_bit_cast(float, v << 16); }
__device__ __forceinline__ float bflo(unsigned w) { return __builtin_bit_cast(float, w << 16); }
__device__ __forceinline__ float bfhi(unsigned w) { return __builtin_bit_cast(float, w & 0xffff0000u); }
__device__ __forceinline__ float rbf(float f) { return bf2f(f2bf(f)); }
__device__ __forceinline__ float gelu_tanh(float x) {
    const float z = 1.5957691216057308f * (x + 0.044715f * x * x * x);
    return x / (1.0f + __builtin_amdgcn_exp2f(-z * LOG2E));
}
__device__ __forceinline__ float silu_f(float a) { return a / (1.0f + __builtin_amdgcn_exp2f(-a * LOG2E)); }
__device__ __forceinline__ int lane_id() { return (int)__builtin_amdgcn_mbcnt_hi(~0u, __builtin_amdgcn_mbcnt_lo(~0u, 0u)); }
__device__ __forceinline__ float wave_sum(float v) {
#pragma unroll
    for (int o = 1; o < 64; o <<= 1) v += __shfl_xor(v, o);
    return v;
}

#define XB_TMO      128
#define XB_XCNT(j)  (256  + 64 * (j))
#define XB_XSUB(j)  (1280 + 64 * (j))
#define XB_XGEN(j)  (2304 + 64 * (j))
#define XB_TOP      3328
#define XB_TOPGEN   3392
#define XCD_BAR_WORDS 3456
#define XB_SPIN_CAP (1u << 18)
__device__ __forceinline__ unsigned xb_ld(unsigned* p)              { return __hip_atomic_load(p, __ATOMIC_RELAXED, __HIP_MEMORY_SCOPE_AGENT); }
__device__ __forceinline__ unsigned xb_add(unsigned* p, unsigned v) { return __hip_atomic_fetch_add(p, v, __ATOMIC_RELAXED, __HIP_MEMORY_SCOPE_AGENT); }
__device__ __forceinline__ unsigned xb_xcc_id() { return (unsigned)__builtin_amdgcn_s_getreg((3 << 11) | 20) & 0xFu; }
#define XB_SPIN(cond, bar) do { unsigned _sp = 0; while (cond) { __builtin_amdgcn_s_sleep(1); \
    if ((++_sp & 255u) == 0u) { if (xb_ld(&(bar)[XB_TMO])) break; if (_sp > XB_SPIN_CAP) { atomicAdd(&(bar)[XB_TMO], 1u); break; } } } } while (0)
struct XcdBarrier { unsigned* bar; unsigned x; volatile LAS unsigned* st; };
__device__ __forceinline__ XcdBarrier xcd_barrier_post(unsigned* bar, volatile LAS unsigned* st) {
    XcdBarrier b; b.bar = bar; b.x = xb_xcc_id(); b.st = st;
    if (threadIdx.x == 0) (void)xb_add(&bar[XB_XCNT(b.x)], 1u);
    return b;
}
__device__ __forceinline__ void xcd_barrier_complete(unsigned* bar, unsigned x, unsigned& nloc, unsigned& nx) {
    const unsigned G = gridDim.x * gridDim.y * gridDim.z;
    unsigned sum, cnt, mine, sp = 0u;
    for (;;) {
        sum = 0u; cnt = 0u; mine = 0u;
#pragma unroll
        for (unsigned j = 0; j < 16; ++j) { const unsigned c = xb_ld(&bar[XB_XCNT(j)]); sum += c; cnt += (c > 0u) ? 1u : 0u; mine = (j == x) ? c : mine; }
        if (sum == G) break;
        __builtin_amdgcn_s_sleep(1);
        if ((++sp & 255u) == 0u) { if (xb_ld(&bar[XB_TMO])) break; if (sp > XB_SPIN_CAP) { atomicAdd(&bar[XB_TMO], 1u); break; } }
    }
    nloc = mine > 0u ? mine : 1u; nx = cnt > 0u ? cnt : 1u;
}
__device__ __forceinline__ void xcd_barrier(const XcdBarrier& b) {
    asm volatile("s_waitcnt vmcnt(0)" ::: "memory");
    __syncthreads();
    if (threadIdx.x == 0) {
        unsigned* bar = b.bar;
        __builtin_amdgcn_s_waitcnt(0);
        unsigned nloc = b.st[0], nx = b.st[1];
        if (nloc == 0u) { xcd_barrier_complete(bar, b.x, nloc, nx); b.st[0] = nloc; b.st[1] = nx; }
        const unsigned old = xb_add(&bar[XB_XSUB(b.x)], 1u);
        const unsigned gen = old / nloc;
        if (old + 1u == (gen + 1u) * nloc) {
            __builtin_amdgcn_fence(__ATOMIC_RELEASE, "agent");
            asm volatile("s_waitcnt vmcnt(0)" ::: "memory");
            const unsigned og = xb_add(&bar[XB_TOP], 1u);
            const unsigned tg = og / nx;
            if (og + 1u == (tg + 1u) * nx) xb_add(&bar[XB_TOPGEN], 1u);
            else XB_SPIN(xb_ld(&bar[XB_TOPGEN]) == tg, bar);
            __builtin_amdgcn_fence(__ATOMIC_ACQUIRE, "agent");
            xb_add(&bar[XB_XGEN(b.x)], 1u);
            asm volatile("s_waitcnt vmcnt(0)" ::: "memory");
        } else {
            XB_SPIN(xb_ld(&bar[XB_XGEN(b.x)]) == gen, bar);
            __builtin_amdgcn_fence(__ATOMIC_ACQUIRE, "agent");
            asm volatile("s_waitcnt vmcnt(0)" ::: "memory");
        }
    }
    __syncthreads();
}

struct Args { const float* in[22]; float* out; unsigned char* ws; int ph_lo, ph_hi, bar_region, pad; };
constexpr int PH_LAYER0 = 4, PH_PER_LAYER = 10, PH_END = PH_LAYER0 + NL * PH_PER_LAYER;

constexpr int NWAVES = 8, NTHR = NWAVES * 64;
constexpr int RING_BYTES = 131072, LDSCTL_OFF = RING_BYTES, MISC_OFF = LDSCTL_OFF + 320;
constexpr int LDS_BYTES = 147456;

struct Frame {
    LAS unsigned char* lds;
    int wave, vcu, G;
    const float* in[22];
    unsigned char* ws;
    float* xres;
};

__device__ __forceinline__ void ph_rows0(Frame& F) {
    int lane_ = lane_id(); asm volatile("" : "+v"(lane_)); const int tid_ = F.wave * 64 + lane_;
    const int gw = F.vcu * NWAVES + F.wave, NGW = F.G * NWAVES;
    const float* x = F.in[0]; const float* mem = F.in[1]; const float* mg = F.in[12];
    bf16* XR = (bf16*)(F.ws + WS_XR); bf16* MEMN = (bf16*)(F.ws + WS_MEMN); float* RINV = (float*)(F.ws + WS_RINV);
    for (int m = gw; m < T + NMEM; m += NGW) {
        const bool is_mem = m >= T;
        const float* src = is_mem ? mem + (size_t)(m - T) * D : x + (size_t)m * D;
        bf16* dst = is_mem ? MEMN + (size_t)(m - T) * D : XR + (size_t)m * D;
        f32x4 v[4]; float s = 0.f;
#pragma unroll
        for (int j = 0; j < 4; ++j) { v[j] = *(const f32x4*)(src + 4 * lane_ + 256 * j); s += (v[j].x * v[j].x + v[j].y * v[j].y) + (v[j].z * v[j].z + v[j].w * v[j].w); }
        const float rinv = 1.0f / sqrtf(wave_sum(s) * (1.0f / D) + EPS);
        if (!is_mem && lane_ == 0) RINV[m] = rinv;
        const float sc = is_mem ? rinv : 1.0f;
#pragma unroll
        for (int j = 0; j < 4; ++j) {
            f32x4 g = (f32x4){1.f, 1.f, 1.f, 1.f};
            if (is_mem) g = *(const f32x4*)(mg + 4 * lane_ + 256 * j);
            v2u o; o.x = pk2(v[j].x * sc * g.x, v[j].y * sc * g.y); o.y = pk2(v[j].z * sc * g.z, v[j].w * sc * g.w);
            *(v2u*)(dst + 4 * lane_ + 256 * j) = o;
        }
    }
    float* COS = (float*)(F.ws + WS_ROPE); float* SIN = COS + SEQ * 32;
    const int gt = F.vcu * NTHR + tid_, NGT = F.G * NTHR;
    for (int i = gt; i < SEQ * 32; i += NGT) {
        const int t = i >> 5, p = i & 31;
        const float fr = expf(-9.210340371976184f * (float)(p & 15) * (1.0f / 16.0f));
        const float pos = (float)((p < 16) ? (t >> 6) : (t & 63));
        float rev = pos * fr * 0.15915494309189535f; rev -= floorf(rev);
        COS[i] = __builtin_amdgcn_cosf(rev); SIN[i] = __builtin_amdgcn_sinf(rev);
    }
}

__device__ __forceinline__ void ph_gmlp(Frame& F, int l) {
    int lane_ = lane_id(); asm volatile("" : "+v"(lane_)); const int tid_ = F.wave * 64 + lane_;
    const bf16* UACT = (const bf16*)(F.ws + WS_UACT); const bf16* VACT = (const bf16*)(F.ws + WS_VACT);
    const float* VSTAT = (const float*)(F.ws + WS_VSTAT); float* GMSTAT = (float*)(F.ws + WS_GMSTAT);
    bf16* MERGED = (bf16*)(F.ws + WS_MERGED);
    const float* gvn = F.in[4] + (size_t)l * GMW; const float* bs = F.in[6] + (size_t)l * 4 * 128;
    const bf16* WSB = (const bf16*)(F.ws + WS_WSB) + (size_t)l * 4 * 128 * 128;
    LAS bf16* vT = (LAS bf16*)F.lds;
    const int fr = lane_ & 15, fq = lane_ >> 4, w = F.wave;
    for (int u = F.vcu; u < (T / 128) * 4; u += F.G) {
        const int n = u >> 2, g = u & 3; const int row0 = n * 128;
        __syncthreads();
        {   const int j = tid_ & 127, cs = tid_ >> 7; const size_t row = (size_t)row0 + j;
            const f32x4 s0 = *(const f32x4*)(VSTAT + row * 8), s1 = *(const f32x4*)(VSTAT + row * 8 + 4);
            const float rinv = 1.0f / sqrtf((((s0[0] + s0[1]) + (s0[2] + s0[3])) + ((s1[0] + s1[1]) + (s1[2] + s1[3]))) * (1.0f / GMW) + EPS);
#pragma unroll
            for (int q = 0; q < 4; ++q) { const int c8 = (cs * 4 + q) * 8;
                const v4u raw = *(const v4u*)(VACT + row * GMW + g * 128 + c8);
                const f32x4 g0 = *(const f32x4*)(gvn + g * 128 + c8) * rinv, g1 = *(const f32x4*)(gvn + g * 128 + c8 + 4) * rinv;
                LAS bf16* d = vT + c8 * 136 + j;
                d[0 * 136] = (bf16)f2bf(bflo(raw.x) * g0[0]); d[1 * 136] = (bf16)f2bf(bfhi(raw.x) * g0[1]); d[2 * 136] = (bf16)f2bf(bflo(raw.y) * g0[2]); d[3 * 136] = (bf16)f2bf(bfhi(raw.y) * g0[3]);
                d[4 * 136] = (bf16)f2bf(bflo(raw.z) * g1[0]); d[5 * 136] = (bf16)f2bf(bfhi(raw.z) * g1[1]); d[6 * 136] = (bf16)f2bf(bflo(raw.w) * g1[2]); d[7 * 136] = (bf16)f2bf(bfhi(raw.w) * g1[3]); } }
        bf16x8_t bw[4];
#pragma unroll
        for (int ks = 0; ks < 4; ++ks) bw[ks] = *(const bf16x8_t*)(WSB + ((size_t)(g * 128 + 16 * w + fr)) * 128 + 32 * ks + 8 * fq);
        __syncthreads();
        f32x4 acc[8];
#pragma unroll
        for (int cb = 0; cb < 8; ++cb) { acc[cb] = (f32x4){0.f, 0.f, 0.f, 0.f};
#pragma unroll
            for (int ks = 0; ks < 4; ++ks) { const bf16x8_t a = *(const LAS bf16x8_t*)(vT + (16 * cb + fr) * 136 + 32 * ks + 8 * fq);
                acc[cb] = __builtin_amdgcn_mfma_f32_16x16x32_bf16(a, bw[ks], acc[cb], 0, 0, 0); } }
        const size_t row = (size_t)row0 + 16 * w + fr; const float bias = bs[g * 128 + 16 * w + fr]; float ss = 0.f;
#pragma unroll
        for (int cb = 0; cb < 8; ++cb) { const v2u uu = *(const v2u*)(UACT + row * GMW + g * 128 + 16 * cb + 4 * fq);
            v2u o; o.x = pk2(bflo(uu.x) * (acc[cb][0] + bias), bfhi(uu.x) * (acc[cb][1] + bias)); o.y = pk2(bflo(uu.y) * (acc[cb][2] + bias), bfhi(uu.y) * (acc[cb][3] + bias));
            *(v2u*)(MERGED + row * 1024 + g * 128 + 16 * cb + 4 * fq) = o;
            const float a0 = bflo(o.x), a1 = bfhi(o.x), a2 = bflo(o.y), a3 = bfhi(o.y); ss += (a0 * a0 + a1 * a1) + (a2 * a2 + a3 * a3); }
        ss += __shfl_xor(ss, 16); ss += __shfl_xor(ss, 32);
        if (fq == 0) GMSTAT[row * 4 + g] = ss;
    }
    __syncthreads();
}

__device__ __forceinline__ void ph_router(Frame& F, int l) {
    int lane_ = lane_id(); asm volatile("" : "+v"(lane_)); const int tid_ = F.wave * 64 + lane_;
    const float* g = F.in[16] + (size_t)l * D; const float* wr = F.in[17] + (size_t)l * D * NE;
    const bf16* XR = (const bf16*)(F.ws + WS_XR); float* AFF = (float*)(F.ws + WS_AFF); float* RINV2 = (float*)(F.ws + WS_RINV2);
    LAS float* sW = (LAS float*)F.lds;
    __syncthreads();
    for (int i = tid_; i < D * NE; i += NTHR) { const int c = i >> 4, e = i & 15; sW[e * D + c] = wr[i] * g[c]; }
    __syncthreads();
    const int gw = F.vcu * NWAVES + F.wave, NGW = F.G * NWAVES;
    LAS float* tp = (LAS float*)(F.lds + 65536) + F.wave * (64 * 17);
    v2u nv[2][4];
#pragma unroll
    for (int r = 0; r < 2; ++r) { const int m = gw + r * NGW; if (m < T) {
#pragma unroll
        for (int j = 0; j < 4; ++j) nv[r][j] = *(const v2u*)(XR + (size_t)m * D + 4 * lane_ + 256 * j); } }
    for (int m0 = gw; m0 < T; m0 += 2 * NGW) {
        f32x4 v[2][4];
#pragma unroll
        for (int r = 0; r < 2; ++r)
#pragma unroll
            for (int j = 0; j < 4; ++j) v[r][j] = (f32x4){bflo(nv[r][j].x), bfhi(nv[r][j].x), bflo(nv[r][j].y), bfhi(nv[r][j].y)};
#pragma unroll
        for (int r = 0; r < 2; ++r) { const int m = m0 + (2 + r) * NGW; if (m < T) {
#pragma unroll
            for (int j = 0; j < 4; ++j) nv[r][j] = *(const v2u*)(XR + (size_t)m * D + 4 * lane_ + 256 * j); } }
        const bool has1 = (m0 + NGW) < T;
        float rinv[2];
#pragma unroll
        for (int r = 0; r < 2; ++r) { float s = 0.f;
#pragma unroll
            for (int j = 0; j < 4; ++j) s += (v[r][j].x * v[r][j].x + v[r][j].y * v[r][j].y) + (v[r][j].z * v[r][j].z + v[r][j].w * v[r][j].w);
            rinv[r] = 1.0f / sqrtf(wave_sum(s) * (1.0f / D) + EPS); }
        if (lane_ == 0) { RINV2[m0] = rinv[0]; if (has1) RINV2[m0 + NGW] = rinv[1]; }
#pragma unroll 4
        for (int e = 0; e < NE; ++e) { float a0 = 0.f, a1 = 0.f;
#pragma unroll
            for (int j = 0; j < 4; ++j) { const f32x4 w = *(const LAS f32x4*)(sW + e * D + 4 * lane_ + 256 * j);
                a0 += (v[0][j].x * w.x + v[0][j].y * w.y) + (v[0][j].z * w.z + v[0][j].w * w.w); a1 += (v[1][j].x * w.x + v[1][j].y * w.y) + (v[1][j].z * w.z + v[1][j].w * w.w); }
            { const auto rr = __builtin_amdgcn_permlane32_swap(__float_as_uint(a0), __float_as_uint(a1), false, false);
              tp[lane_ * 17 + e] = __uint_as_float(rr[0]) + __uint_as_float(rr[1]); } }
        asm volatile("s_waitcnt lgkmcnt(0)" ::: "memory");
        {   const int e = lane_ & 15, r = (lane_ >> 4) & 1, hp = lane_ >> 5; float a0 = 0.f, a1 = 0.f;
#pragma unroll
            for (int rr = 0; rr < 16; rr += 2) { a0 += tp[(r * 32 + hp * 16 + rr) * 17 + e]; a1 += tp[(r * 32 + hp * 16 + rr + 1) * 17 + e]; }
            float mylg = a0 + a1; mylg += __shfl_xor(mylg, 32); mylg *= (r == 0 ? rinv[0] : rinv[1]);
            float mx = mylg;
            mx = fmaxf(mx, __shfl_xor(mx, 1)); mx = fmaxf(mx, __shfl_xor(mx, 2)); mx = fmaxf(mx, __shfl_xor(mx, 4)); mx = fmaxf(mx, __shfl_xor(mx, 8));
            const float pe = __builtin_amdgcn_exp2f((mylg - mx) * LOG2E);
            float den = pe; den += __shfl_xor(den, 1); den += __shfl_xor(den, 2); den += __shfl_xor(den, 4); den += __shfl_xor(den, 8);
            const int m = m0 + r * NGW;
            if (lane_ < 32 && (r == 0 || has1)) AFF[(size_t)m * NE + e] = pe / den;
        }
        asm volatile("s_waitcnt lgkmcnt(0)" ::: "memory");
    }
    __syncthreads();
}

__device__ __forceinline__ void ph_topk(Frame& F) {
    int lane_ = lane_id(); asm volatile("" : "+v"(lane_)); const int tid_ = F.wave * 64 + lane_;
    const float* AFF = (const float*)(F.ws + WS_AFF); int* IDX = (int*)(F.ws + WS_IDX); int* INV = (int*)(F.ws + WS_INV);
    LAS unsigned* hist = (LAS unsigned*)F.lds;
    LAS unsigned* sh = hist + 256;
    LAS unsigned* wsum = hist + 512;
    for (int p = F.vcu; p < NB_ * NE; p += F.G) {
        const int b = p >> 4, e = p & 15;
        unsigned key[16];
#pragma unroll
        for (int i = 0; i < 16; ++i) key[i] = __builtin_bit_cast(unsigned, AFF[((size_t)b * SEQ + tid_ * 16 + i) * NE + e]);
        unsigned prefix = 0u, krem = CAP;
#pragma unroll
        for (int pass = 0; pass < 4; ++pass) {
            const int shift = pass == 3 ? 0 : 23 - 8 * pass; const unsigned dmask = pass == 3 ? 127u : 255u;
            const unsigned himask = pass == 0 ? 0u : (pass == 1 ? 0xff800000u : (pass == 2 ? 0xffff8000u : 0xffffff80u));
            __syncthreads();
            if (tid_ < 256) hist[tid_] = 0u;
            __syncthreads();
#pragma unroll
            for (int i = 0; i < 16; ++i) if ((key[i] & himask) == prefix) atomicAdd((unsigned*)&hist[(key[i] >> shift) & dmask], 1u);
            __syncthreads();
            if (F.wave == 0) {
                unsigned c[4]; unsigned t = 0u;
#pragma unroll
                for (int j = 0; j < 4; ++j) { c[j] = hist[255 - 4 * lane_ - j]; t += c[j]; }
                unsigned inc = t;
#pragma unroll
                for (int o = 1; o < 64; o <<= 1) { const unsigned a = __shfl_up(inc, o); if (lane_ >= o) inc += a; }
                unsigned above = inc - t;
                if (above < krem && krem <= inc) {
                    int d = 255 - 4 * lane_;
#pragma unroll
                    for (int j = 0; j < 3; ++j) { if (above + c[j] < krem) { above += c[j]; d = 254 - 4 * lane_ - j; } else break; }
                    sh[0] = prefix | ((unsigned)d << shift); sh[1] = krem - above; }
            }
            __syncthreads();
            prefix = sh[0]; krem = sh[1];
        }
        const unsigned thr = prefix;
        unsigned cg = 0u, ce = 0u;
#pragma unroll
        for (int i = 0; i < 16; ++i) { cg += key[i] > thr ? 1u : 0u; ce += key[i] == thr ? 1u : 0u; }
        unsigned sg = cg, se = ce;
#pragma unroll
        for (int o = 1; o < 64; o <<= 1) { const unsigned a = __shfl_up(sg, o), c2 = __shfl_up(se, o); if (lane_ >= o) { sg += a; se += c2; } }
        __syncthreads();
        if (lane_ == 63) { wsum[F.wave] = sg; wsum[8 + F.wave] = se; }
        __syncthreads();
        unsigned og = 0u, oe = 0u;
        for (int w = 0; w < F.wave; ++w) { og += wsum[w]; oe += wsum[8 + w]; }
        unsigned gb = og + sg - cg, eb = oe + se - ce;
#pragma unroll
        for (int i = 0; i < 16; ++i) {
            const int t = tid_ * 16 + i; int pos = -1;
            if (key[i] > thr) { pos = (int)(gb + (eb < krem ? eb : krem)); ++gb; }
            else if (key[i] == thr) { if (eb < krem) pos = (int)(gb + eb); ++eb; }
            INV[((size_t)b * SEQ + t) * NE + e] = pos;
            if (pos >= 0) IDX[(size_t)p * CAP + pos] = t;
        }
    }
    __syncthreads();
}

__device__ __forceinline__ void ph_combine(Frame& F, int l, bool dummy) {
    int lane_ = lane_id(); asm volatile("" : "+v"(lane_));
    const float* AFF = (const float*)(F.ws + WS_AFF); const int* INV = (const int*)(F.ws + WS_INV);
    const bf16* Y = (const bf16*)(F.ws + WS_Y); bf16* XR = (bf16*)(F.ws + WS_XR); const float* fg = F.in[21]; float* RINV = (float*)(F.ws + WS_RINV);
    const int gw = F.vcu * NWAVES + F.wave, NGW = F.G * NWAVES;
    for (int m = gw; m < T; m += NGW) {
        const int b = m / SEQ;
        bf16* xw = (dummy ? (bf16*)(F.ws + WS_NSCR) : XR) + (size_t)m * D; float* ow = (dummy ? (float*)(F.ws + WS_NSCR) : F.xres) + (size_t)m * D;
        f32x4 v[4];
#pragma unroll
        for (int j = 0; j < 4; ++j) { const v2u w = *(const v2u*)(XR + (size_t)m * D + 4 * lane_ + 256 * j); v[j] = (f32x4){bflo(w.x), bfhi(w.x), bflo(w.y), bfhi(w.y)}; }
        const int mypos = lane_ < NE ? INV[(size_t)m * NE + lane_] : -1;
        const float myaff = lane_ < NE ? AFF[(size_t)m * NE + lane_] : 0.f;
#pragma unroll
        for (int e = 0; e < NE; ++e) {
            const int pos = __shfl(mypos, e); const float a = __shfl(myaff, e);
            if (pos >= 0) {
                const bf16* yr = Y + ((size_t)(b * NE + e) * CAP + pos) * D;
#pragma unroll
                for (int j = 0; j < 4; ++j) { const v2u w = *(const v2u*)(yr + 4 * lane_ + 256 * j);
                    v[j].x += a * bflo(w.x); v[j].y += a * bfhi(w.x); v[j].z += a * bflo(w.y); v[j].w += a * bfhi(w.y); }
            }
        }
        float s = 0.f;
#pragma unroll
        for (int j = 0; j < 4; ++j) s += (v[j].x * v[j].x + v[j].y * v[j].y) + (v[j].z * v[j].z + v[j].w * v[j].w);
        const float rinv = 1.0f / sqrtf(wave_sum(s) * (1.0f / D) + EPS);
        if (l == NL - 1) {
#pragma unroll
            for (int j = 0; j < 4; ++j) { const f32x4 g = *(const f32x4*)(fg + 4 * lane_ + 256 * j); *(f32x4*)(ow + 4 * lane_ + 256 * j) = (f32x4){v[j].x * rinv * g.x, v[j].y * rinv * g.y, v[j].z * rinv * g.z, v[j].w * rinv * g.w}; }
        } else {
            if (lane_ == 0 && !dummy) RINV[m] = rinv;
#pragma unroll
            for (int j = 0; j < 4; ++j) { v2u o; o.x = pk2(v[j].x, v[j].y); o.y = pk2(v[j].z, v[j].w); *(v2u*)(xw + 4 * lane_ + 256 * j) = o; }
        }
    }
}

namespace pg8 {
typedef short bf16x8 __attribute__((ext_vector_type(8)));
typedef float f32x2 __attribute__((ext_vector_type(2)));
constexpr int BM = 256, BK = 64, HALF = 128, HTB = HALF * BK * 2, STAGE_BYTES = 8 * HTB, NXCD = 8, WGM = 8;
__host__ __device__ __forceinline__ int lds_byte(int r, int c) { const int st = (r >> 4) * 2 + (c >> 5), rr = r & 15, cc = c & 31, ob = rr * 64 + cc * 2; return st * 1024 + (ob ^ (((ob >> 9) & 1) << 5)); }
__host__ __device__ __forceinline__ void stage_rc(int b, int& R, int& C) { const int st = b / 1024, sb = b % 1024, swz = sb ^ (((sb >> 9) & 1) << 5); R = (st >> 1) * 16 + swz / 64; C = (st & 1) * 32 + (swz % 64) / 2; }
__host__ __device__ __forceinline__ int perm32(int rho) { const int n = rho >> 4, i = rho & 15; return 8 * (i >> 2) + 4 * n + (i & 3); }

struct Unit { int pm, pn, z; const char* a; const char* b; const int* gi; int grow; };

struct TileOrder {
    int nM, nN, nwg, G, c;
    __device__ __forceinline__ void init(int nM_, int nN_, int G_, int c_) { nM = nM_; nN = nN_; nwg = nM * nN; G = G_; c = c_; }
    __device__ __forceinline__ bool tile(int i, int& pm, int& pn) const {
        const long L = (long)i * G + c; if (L >= nwg) return false;
        int wgid = (int)L; { const int q = nwg / NXCD, r = nwg % NXCD, xcd = wgid % NXCD, off = wgid / NXCD; wgid = (xcd < r ? xcd * (q + 1) : r * (q + 1) + (xcd - r) * q) + off; }
        const int nig = WGM * nN, gid = wgid / nig, fm = gid * WGM, gsz = (nM - fm) < WGM ? (nM - fm) : WGM;
        pm = fm + ((wgid % nig) % gsz); pn = (wgid % nig) / gsz; return true;
    }
};

__device__ __forceinline__ unsigned cvt_pk_bf16(float lo, float hi) { unsigned r; asm volatile("v_cvt_pk_bf16_f32 %0, %1, %2" : "=v"(r) : "v"(lo), "v"(hi)); return r; }
typedef f32x4 Acc[2][2][4][2];

template <class Epi, class Sched, bool ALIGN_EPI, bool GATHER>
__device__ __forceinline__ void gemm_phase(LAS unsigned char* lds, const int wave_idx, const int lda, const int ldb, const int K, const Sched& S, Epi& E) {
    int lane = lane_id(); asm volatile("" : "+v"(lane));
    const int wid = wave_idx, tid = wid * 64 + lane, wr = wid >> 2, wc = wid & 3, fr = lane & 15, fq = lane >> 4;
    const int nt = K / BK;
    unsigned voffA[2], voffB[2]; int gR[2]; unsigned gC[2];
#pragma unroll
    for (int i = 0; i < 2; ++i) { int R, C; stage_rc(tid * 16 + i * 8192, R, C); const int Rb = (R & ~31) + perm32(R & 31);
        voffA[i] = (unsigned)(R * lda + C) * 2u; voffB[i] = (unsigned)(Rb * ldb + C) * 2u; gR[i] = R; gC[i] = (unsigned)C * 2u; }
    const size_t kstep = (size_t)(BK * 2);
    const size_t hstepA = (size_t)HALF * lda * 2, hstepB = (size_t)HALF * ldb * 2;
    const unsigned ldsw = (unsigned)wid * 1024u;
    const int aoff = lds_byte(wr * 64 + fr, fq * 8), boff = lds_byte(wc * 32 + fr, fq * 8);
    unsigned vgc[2][2], vgn[2][2];
#define PG8_SA(b, h) (((b) * 2 + (h)) * HTB)
#define PG8_SB(b, h) ((4 + (b) * 2 + (h)) * HTB)
#define PG8_GL(gp, voff, bufoff, _i) __builtin_amdgcn_global_load_lds((const unsigned*)((const char*)(gp) + (voff)), (LAS unsigned*)(lds + (bufoff) + ldsw + (_i) * 8192), 16, 0, 0)
#define PG8_STAGE_B(bufoff, gbase) do { PG8_GL(gbase, voffB[0], bufoff, 0); PG8_GL(gbase, voffB[1], bufoff, 1); } while (0)
#define PG8_STAGE_A(bufoff, gbase, h, VG) do { if constexpr (GATHER) { PG8_GL(gbase, VG[h][0], bufoff, 0); PG8_GL(gbase, VG[h][1], bufoff, 1); } \
        else { PG8_GL((gbase) + (h) * hstepA, voffA[0], bufoff, 0); PG8_GL((gbase) + (h) * hstepA, voffA[1], bufoff, 1); } } while (0)
#define PG8_LDA(dst, b, h) do { _Pragma("unroll") for (int m = 0; m < 4; ++m) _Pragma("unroll") for (int k = 0; k < 2; ++k) dst[m][k] = *(const LAS bf16x8*)(lds + PG8_SA(b, h) + aoff + m * 2048 + k * 1024); } while (0)
#define PG8_LDB(dst, b, h) do { _Pragma("unroll") for (int n = 0; n < 2; ++n) _Pragma("unroll") for (int k = 0; k < 2; ++k) dst[n][k] = *(const LAS bf16x8*)(lds + PG8_SB(b, h) + boff + n * 2048 + k * 1024); } while (0)
#define PG8_MMA(ai, bj, At, Bt) do { __builtin_amdgcn_s_setprio(1); _Pragma("unroll") for (int m = 0; m < 4; ++m) _Pragma("unroll") for (int n = 0; n < 2; ++n) _Pragma("unroll") for (int k = 0; k < 2; ++k) \
        acc[ai][bj][m][n] = __builtin_amdgcn_mfma_f32_16x16x32_bf16(Bt[n][k], At[m][k], acc[ai][bj][m][n], 0, 0, 0); __builtin_amdgcn_s_setprio(0); } while (0)
#define PG8_WAIT_V(n) asm volatile("s_waitcnt vmcnt(" #n ")" ::: "memory")
#define PG8_WAIT_L(n) asm volatile("s_waitcnt lgkmcnt(" #n ")" ::: "memory")
#define PG8_BAR __builtin_amdgcn_s_barrier()
#define PG8_SCHED __builtin_amdgcn_sched_barrier(0)
#define PG8_GIDX(VG, U) do { _Pragma("unroll") for (int _h = 0; _h < 2; ++_h) _Pragma("unroll") for (int _i = 0; _i < 2; ++_i) \
        VG[_h][_i] = (unsigned)((U).grow + (U).gi[_h * HALF + gR[_i]]) * (unsigned)(lda * 2) + gC[_i]; } while (0)
    Unit cur, nxt; int ui = 0;
    if (!S.next(0, cur)) return;
    Acc acc;
#pragma unroll
    for (int a = 0; a < 2; ++a)
#pragma unroll
        for (int b = 0; b < 2; ++b)
#pragma unroll
            for (int m = 0; m < 4; ++m)
#pragma unroll
                for (int n = 0; n < 2; ++n) acc[a][b][m][n] = (f32x4){0.f, 0.f, 0.f, 0.f};
    bf16x8 At[4][2], B0[2][2], B1[2][2];
    const char* cA = cur.a; const char* cB = cur.b;
    if constexpr (GATHER) { PG8_GIDX(vgc, cur); } else { vgc[0][0] = vgc[0][1] = vgc[1][0] = vgc[1][1] = 0u; }
    E.prep(cur, wr, wc, fr, fq);
    PG8_STAGE_B(PG8_SB(0, 0), cB); PG8_STAGE_B(PG8_SB(0, 1), cB + hstepB); PG8_STAGE_A(PG8_SA(0, 0), cA, 0, vgc); PG8_STAGE_A(PG8_SA(0, 1), cA, 1, vgc);
    if (wr == 1) PG8_BAR;
    PG8_WAIT_V(2); PG8_BAR;
    PG8_STAGE_B(PG8_SB(1, 0), cB + kstep); PG8_STAGE_A(PG8_SA(1, 0), cA + kstep, 0, vgc); PG8_STAGE_B(PG8_SB(1, 1), cB + hstepB + kstep);
    PG8_WAIT_V(6); PG8_BAR;
    for (;;) {
        const bool has_next = S.next(ui + 1, nxt);
        const char* nA = has_next ? nxt.a : cA; const char* nB = has_next ? nxt.b : cB;
        if constexpr (GATHER) { if (has_next) { PG8_GIDX(vgn, nxt); } else {
#pragma unroll
            for (int h = 0; h < 2; ++h) { vgn[h][0] = vgc[h][0]; vgn[h][1] = vgc[h][1]; } } }
        else { vgn[0][0] = vgn[0][1] = vgn[1][0] = vgn[1][1] = 0u; }
        for (int t = 0; t < nt; t += 2) {
            const bool last = (t == nt - 2);
            const char* a1 = cA + (size_t)(t + 1) * kstep;
            const char* a2 = last ? nA : cA + (size_t)(t + 2) * kstep; const char* b2 = last ? nB : cB + (size_t)(t + 2) * kstep;
            const char* a3 = a2 + kstep; const char* b3 = b2 + kstep;
            unsigned vg2[2][2];
#pragma unroll
            for (int h = 0; h < 2; ++h) { vg2[h][0] = last ? vgn[h][0] : vgc[h][0]; vg2[h][1] = last ? vgn[h][1] : vgc[h][1]; }
            if constexpr (Epi::MIDK) { if (t == (nt >> 1)) E.midk(acc); }
            PG8_LDB(B0, 0, 0); PG8_LDB(B1, 0, 1); PG8_SCHED; PG8_LDA(At, 0, 0); PG8_STAGE_A(PG8_SA(1, 1), a1, 1, vgc);
            PG8_WAIT_V(8); PG8_WAIT_L(0); PG8_BAR; PG8_MMA(0, 0, At, B0); PG8_MMA(0, 1, At, B1); PG8_BAR; PG8_SCHED;
            PG8_LDA(At, 0, 1); PG8_STAGE_B(PG8_SB(0, 0), b2); PG8_STAGE_B(PG8_SB(0, 1), b2 + hstepB); PG8_STAGE_A(PG8_SA(0, 0), a2, 0, vg2);
            PG8_WAIT_V(8); PG8_WAIT_L(0); PG8_BAR; PG8_MMA(1, 0, At, B0); PG8_MMA(1, 1, At, B1); PG8_BAR; PG8_SCHED;
            PG8_LDB(B0, 1, 0); PG8_LDB(B1, 1, 1); PG8_SCHED; PG8_LDA(At, 1, 0); PG8_STAGE_A(PG8_SA(0, 1), a2, 1, vg2);
            PG8_WAIT_V(8); PG8_WAIT_L(0); PG8_BAR; PG8_MMA(0, 0, At, B0); PG8_MMA(0, 1, At, B1); PG8_BAR; PG8_SCHED;
            PG8_LDA(At, 1, 1); PG8_STAGE_B(PG8_SB(1, 0), b3); PG8_STAGE_B(PG8_SB(1, 1), b3 + hstepB); PG8_STAGE_A(PG8_SA(1, 0), a3, 0, vg2);
            PG8_WAIT_V(8); PG8_WAIT_L(0); PG8_BAR; PG8_MMA(1, 0, At, B0); PG8_MMA(1, 1, At, B1); PG8_BAR; PG8_SCHED;
        }
        if constexpr (ALIGN_EPI) { if (wr == 0) PG8_BAR; }
        E(acc, cur, wr, wc, fr, fq);
        if (!has_next) break;
#pragma unroll
        for (int a = 0; a < 2; ++a)
#pragma unroll
            for (int b = 0; b < 2; ++b)
#pragma unroll
                for (int m = 0; m < 4; ++m)
#pragma unroll
                    for (int n = 0; n < 2; ++n) acc[a][b][m][n] = (f32x4){0.f, 0.f, 0.f, 0.f};
        cur = nxt; cA = nA; cB = nB; ++ui;
#pragma unroll
        for (int h = 0; h < 2; ++h) { vgc[h][0] = vgn[h][0]; vgc[h][1] = vgn[h][1]; }
        E.prep(cur, wr, wc, fr, fq);
        if constexpr (ALIGN_EPI) { if (wr == 1) PG8_BAR; }
    }
    PG8_WAIT_V(0);
    if constexpr (!ALIGN_EPI) { if (wr == 0) PG8_BAR; }
    PG8_BAR;
#undef PG8_SA
#undef PG8_SB
#undef PG8_GL
#undef PG8_STAGE_A
#undef PG8_STAGE_B
#undef PG8_LDA
#undef PG8_LDB
#undef PG8_MMA
#undef PG8_WAIT_V
#undef PG8_WAIT_L
#undef PG8_SCHED
#undef PG8_GIDX
}

#define EPI_ROWS for (int ai = 0; ai < 2; ++ai) _Pragma("unroll") for (int m = 0; m < 4; ++m)
__device__ __forceinline__ v4u pack8(const f32x4 a, const f32x4 b) { v4u w; w.x = cvt_pk_bf16(a[0], a[1]); w.y = cvt_pk_bf16(a[2], a[3]); w.z = cvt_pk_bf16(b[0], b[1]); w.w = cvt_pk_bf16(b[2], b[3]); return w; }

template <int mode>
struct EpiStore {
    static constexpr bool MIDK = false;
    bf16* O; int ldc; const float* cs; float scale;
    __device__ __forceinline__ void prep(const Unit&, int, int, int, int) {}
    __device__ __forceinline__ void midk(Acc&) {}
    __device__ __forceinline__ void operator()(const Acc& acc, const Unit& u, int wr, int wc, int fr, int fq) const {
        asm volatile("" : "+v"(fr), "+v"(fq));
        size_t base; const float* csp = cs;
        if constexpr (mode == 0) base = (size_t)u.pm * 256 * ldc + (size_t)u.pn * 256;
        else if constexpr (mode == 1) { const int lb = u.pm >> 2, h = u.pm & 3; base = (size_t)lb * D * D + (size_t)(h * 256) * D + u.pn * 256; csp = cs + (size_t)(lb >> 2) * D + u.pn * 256; }
        else if constexpr (mode == 2) { const int pml = u.pm & 3, lbh = u.pm >> 2, h = lbh & 3, lb = lbh >> 2; base = (size_t)lb * D * D + (size_t)(pml * 256) * D + h * 256; }
        else { const int l = u.pm >> 2, pml = u.pm & 3; base = (size_t)l * NMEM * 2 * D + (size_t)(pml * 256) * 2 * D + u.pn * 256; }
        const int cb = wc * 32 + 8 * fq;
        f32x4 c0[2], c1[2];
#pragma unroll
        for (int bj = 0; bj < 2; ++bj) { if (csp) { c0[bj] = *(const f32x4*)(csp + bj * HALF + cb) * scale; c1[bj] = *(const f32x4*)(csp + bj * HALF + cb + 4) * scale; } else { c0[bj] = (f32x4){scale, scale, scale, scale}; c1[bj] = c0[bj]; } }
#pragma unroll
        EPI_ROWS { bf16* rowp = O + base + (size_t)(ai * HALF + wr * 64 + m * 16 + fr) * ldc + cb;
#pragma unroll
            for (int bj = 0; bj < 2; ++bj) *(v4u*)(rowp + bj * HALF) = pack8(acc[ai][bj][m][0] * c0[bj], acc[ai][bj][m][1] * c1[bj]); }
    }
};
struct EpiH {
    static constexpr bool MIDK = false;
    bf16* H; const float* rinv2;
    __device__ __forceinline__ void prep(const Unit&, int, int, int, int) {}
    __device__ __forceinline__ void midk(Acc&) {}
    __device__ __forceinline__ void operator()(const Acc& acc, const Unit& u, int wr, int wc, int fr, int fq) const {
        asm volatile("" : "+v"(fr), "+v"(fq));
        const int cb = u.pn * 128 + wc * 32 + 8 * fq;
#pragma unroll
        EPI_ROWS { const int rl = ai * HALF + wr * 64 + m * 16 + fr; bf16* rowp = H + (size_t)(u.pm * 256 + rl) * FF + cb;
            const float ri = rinv2[u.grow + u.gi[rl]];
            f32x4 h0, h1;
#pragma unroll
            for (int i = 0; i < 4; ++i) { h0[i] = silu_f(acc[ai][0][m][0][i] * ri) * (acc[ai][1][m][0][i] * ri); h1[i] = silu_f(acc[ai][0][m][1][i] * ri) * (acc[ai][1][m][1][i] * ri); }
            *(v4u*)rowp = pack8(h0, h1); }
    }
};
template <bool MK, bool WRITE_XB>
struct EpiX {
    static constexpr bool MIDK = MK;
    bf16* xr; float* xstat; const float* gmstat; const float* atstat; LAS unsigned char* lds;
    int wr_, wc_, fr_;
    __device__ __forceinline__ void prep(const Unit& u, int wr, int wc, int fr, int fq) {
        wr_ = wr; wc_ = wc; fr_ = fr;
        if constexpr (MK) {
            asm volatile("" : "+v"(fr), "+v"(fq));
            LAS f32x2* X = (LAS f32x2*)(lds + RING_BYTES + 1024) + (wr * 4 + wc) * 128;
#pragma unroll
            EPI_ROWS { const size_t row = (size_t)u.pm * 256 + ai * HALF + wr * 64 + m * 16 + fr;
                const f32x4 g = *(const f32x4*)(gmstat + row * 4), a0 = *(const f32x4*)(atstat + row * 8), a1 = *(const f32x4*)(atstat + row * 8 + 4);
                const float sg = (g[0] + g[1]) + (g[2] + g[3]), sa = ((a0[0] + a0[1]) + (a0[2] + a0[3])) + ((a1[0] + a1[1]) + (a1[2] + a1[3]));
                const float rgm = 1.0f / sqrtf(sg * (1.0f / 512.0f) + EPS), rat = 1.0f / sqrtf(sa * (1.0f / 512.0f) + EPS);
                if (fq == 0) X[(ai * 4 + m) * 16 + fr] = (f32x2){rgm / rat, rat}; }
            asm volatile("s_waitcnt lgkmcnt(0)" ::: "memory");
        }
    }
    __device__ __forceinline__ void midk(Acc& acc) {
        int fr = fr_; asm volatile("" : "+v"(fr));
        const LAS f32x2* X = (const LAS f32x2*)(lds + RING_BYTES + 1024) + (wr_ * 4 + wc_) * 128;
#pragma unroll
        EPI_ROWS { const float f = X[(ai * 4 + m) * 16 + fr].x;
#pragma unroll
            for (int bj = 0; bj < 2; ++bj) { acc[ai][bj][m][0] *= f; acc[ai][bj][m][1] *= f; } }
    }
    __device__ __forceinline__ void operator()(const Acc& acc, const Unit& u, int wr, int wc, int fr, int fq) const {
        asm volatile("" : "+v"(fr), "+v"(fq));
        const int cb = u.pn * 256 + wc * 32 + 8 * fq;
#pragma unroll
        EPI_ROWS { const size_t row = (size_t)u.pm * 256 + ai * HALF + wr * 64 + m * 16 + fr; const size_t off = row * D + cb;
            float f = 1.0f; if constexpr (MK) f = ((const LAS f32x2*)(lds + RING_BYTES + 1024) + (wr * 4 + wc) * 128)[(ai * 4 + m) * 16 + fr].y; float ss = 0.f;
#pragma unroll
            for (int bj = 0; bj < 2; ++bj) { const v4u b = *(const v4u*)(xr + off + bj * HALF);
                const f32x4 x0 = (f32x4){bflo(b.x), bfhi(b.x), bflo(b.y), bfhi(b.y)} + acc[ai][bj][m][0] * f, x1 = (f32x4){bflo(b.z), bfhi(b.z), bflo(b.w), bfhi(b.w)} + acc[ai][bj][m][1] * f;
                *(v4u*)(xr + off + bj * HALF) = pack8(x0, x1);
                if constexpr (WRITE_XB) ss += ((x0[0] * x0[0] + x0[1] * x0[1]) + (x0[2] * x0[2] + x0[3] * x0[3])) + ((x1[0] * x1[0] + x1[1] * x1[1]) + (x1[2] * x1[2] + x1[3] * x1[3])); }
            if constexpr (WRITE_XB) { ss += __shfl_xor(ss, 16); ss += __shfl_xor(ss, 32); if (fq == 0) xstat[row * 16 + u.pn * 4 + wc] = ss; }
            if (m & 1) asm volatile("" ::: "memory"); }
    }
};
constexpr int EXCH_OFF = RING_BYTES + 1024;
struct EpiS {
    static constexpr bool MIDK = false;
    const float* xstat; bf16* P; LAS unsigned char* lds;
    __device__ __forceinline__ void prep(const Unit&, int, int, int, int) {}
    __device__ __forceinline__ void midk(Acc&) {}
    __device__ __forceinline__ void operator()(Acc& acc, const Unit& u, int wr, int wc, int fr, int fq) const {
        asm volatile("" : "+v"(fr), "+v"(fq));
        LAS f32x2* X = (LAS f32x2*)(lds + EXCH_OFF);
        float mw[2][4];
#pragma unroll
        EPI_ROWS { const int rl = ai * HALF + wr * 64 + m * 16 + fr; const size_t row = (size_t)u.pm * 256 + rl;
            const f32x4 s0 = *(const f32x4*)(xstat + row * 16), s1 = *(const f32x4*)(xstat + row * 16 + 4), s2 = *(const f32x4*)(xstat + row * 16 + 8), s3 = *(const f32x4*)(xstat + row * 16 + 12);
            const float ssq = (((s0[0] + s0[1]) + (s0[2] + s0[3])) + ((s1[0] + s1[1]) + (s1[2] + s1[3]))) + (((s2[0] + s2[1]) + (s2[2] + s2[3])) + ((s3[0] + s3[1]) + (s3[2] + s3[3])));
            const float rinv = 1.0f / sqrtf(ssq * (1.0f / D) + EPS);
            float mx = -3.0e38f;
#pragma unroll
            for (int bj = 0; bj < 2; ++bj)
#pragma unroll
                for (int n = 0; n < 2; ++n) { acc[ai][bj][m][n] *= rinv; const f32x4 v = acc[ai][bj][m][n]; mx = fmaxf(mx, fmaxf(fmaxf(v[0], v[1]), fmaxf(v[2], v[3]))); }
            mx = fmaxf(mx, __shfl_xor(mx, 16)); mx = fmaxf(mx, __shfl_xor(mx, 32));
            float sm = 0.f;
#pragma unroll
            for (int bj = 0; bj < 2; ++bj)
#pragma unroll
                for (int n = 0; n < 2; ++n) { f32x4 v = acc[ai][bj][m][n];
#pragma unroll
                    for (int i = 0; i < 4; ++i) { v[i] = __builtin_amdgcn_exp2f(v[i] - mx); sm += v[i]; }
                    acc[ai][bj][m][n] = v; }
            sm += __shfl_xor(sm, 16); sm += __shfl_xor(sm, 32);
            mw[ai][m] = mx;
            if (fq == 0) X[rl * 4 + wc] = (f32x2){mx, sm};
            if (m & 1) asm volatile("" ::: "memory"); }
        asm volatile("s_waitcnt lgkmcnt(0)\n\ts_barrier" ::: "memory");
        const int cb = u.pn * 256 + wc * 32 + 8 * fq;
#pragma unroll
        EPI_ROWS { const int rl = ai * HALF + wr * 64 + m * 16 + fr; const size_t row = (size_t)u.pm * 256 + rl;
            const f32x2 e0 = X[rl * 4 + 0], e1 = X[rl * 4 + 1], e2 = X[rl * 4 + 2], e3 = X[rl * 4 + 3];
            const float M = fmaxf(fmaxf(e0.x, e1.x), fmaxf(e2.x, e3.x));
            const float den = (e0.y * __builtin_amdgcn_exp2f(e0.x - M) + e1.y * __builtin_amdgcn_exp2f(e1.x - M)) + (e2.y * __builtin_amdgcn_exp2f(e2.x - M) + e3.y * __builtin_amdgcn_exp2f(e3.x - M));
            const float f = __builtin_amdgcn_exp2f(mw[ai][m] - M) / den;
#pragma unroll
            for (int bj = 0; bj < 2; ++bj) *(v4u*)(P + row * D + cb + bj * HALF) = pack8(acc[ai][bj][m][0] * f, acc[ai][bj][m][1] * f); }
        asm volatile("s_waitcnt lgkmcnt(0)" ::: "memory");
    }
};
struct EpiIn {
    static constexpr bool MIDK = false;
    bf16 *uact, *vact, *q, *k, *v; float* vstat; const float *qg, *kg, *cosT, *sinT, *rinv;
    __device__ __forceinline__ void prep(const Unit&, int, int, int, int) {}
    __device__ __forceinline__ void midk(Acc&) {}
    __device__ __forceinline__ void operator()(const Acc& acc, const Unit& u, int wr, int wc, int fr, int fq) const {
        asm volatile("" : "+v"(fr), "+v"(fq));
        const int pn = u.pn;
        if (pn < 4) {
            bf16* O = pn < 2 ? uact : vact; const int cb = (pn & 1) * 256 + wc * 32 + 8 * fq;
#pragma unroll
            EPI_ROWS { const size_t row = (size_t)u.pm * 256 + ai * HALF + wr * 64 + m * 16 + fr; float ss = 0.f; const float ri = rinv[row];
#pragma unroll
                for (int bj = 0; bj < 2; ++bj) { f32x4 g0, g1;
#pragma unroll
                    for (int i = 0; i < 4; ++i) { g0[i] = gelu_tanh(acc[ai][bj][m][0][i] * ri); g1[i] = gelu_tanh(acc[ai][bj][m][1][i] * ri); }
                    const v4u w = pack8(g0, g1); *(v4u*)(O + row * GMW + cb + bj * HALF) = w;
                    if (pn >= 2) { const float a0 = bflo(w.x), a1 = bfhi(w.x), a2 = bflo(w.y), a3 = bfhi(w.y), a4 = bflo(w.z), a5 = bfhi(w.z), a6 = bflo(w.w), a7 = bfhi(w.w);
                        ss += ((a0 * a0 + a1 * a1) + (a2 * a2 + a3 * a3)) + ((a4 * a4 + a5 * a5) + (a6 * a6 + a7 * a7)); } }
                if (pn >= 2) { ss += __shfl_xor(ss, 16); ss += __shfl_xor(ss, 32); if (fq == 0) vstat[row * 8 + (pn - 2) * 4 + wc] = ss; } }
        } else if (pn == 6 && wc >= 2) {
#pragma unroll
            EPI_ROWS { const size_t row = (size_t)u.pm * 256 + ai * HALF + wr * 64 + m * 16 + fr; const float ri = rinv[row];
#pragma unroll
                for (int bj = 0; bj < 2; ++bj) *(v4u*)(v + row * 128 + (wc - 2) * 64 + bj * 32 + 8 * fq) = pack8(acc[ai][bj][m][0] * ri, acc[ai][bj][m][1] * ri); }
        } else {
            const bool isq = pn < 6; const float* g = isq ? qg : kg; const float sc = isq ? QSCALE : 1.0f;
            bf16* O = isq ? q + ((pn - 4) * 4 + wc) * 64 : k + wc * 64; const int ldo = isq ? 512 : 128;
            f32x4 gv[2][2];
#pragma unroll
            for (int bj = 0; bj < 2; ++bj) { gv[bj][0] = *(const f32x4*)(g + bj * 32 + 8 * fq) * sc; gv[bj][1] = *(const f32x4*)(g + bj * 32 + 8 * fq + 4) * sc; }
#pragma unroll
            EPI_ROWS { const size_t row = (size_t)u.pm * 256 + ai * HALF + wr * 64 + m * 16 + fr; const int t = (int)(row % SEQ); const float ri = this->rinv[row];
                float ss = 0.f;
#pragma unroll
                for (int bj = 0; bj < 2; ++bj)
#pragma unroll
                    for (int n = 0; n < 2; ++n) { const f32x4 x = acc[ai][bj][m][n]; ss += (x[0] * x[0] + x[1] * x[1]) + (x[2] * x[2] + x[3] * x[3]); }
                ss += __shfl_xor(ss, 16); ss += __shfl_xor(ss, 32);
                const float rinv = ri / sqrtf(ss * (ri * ri) * (1.0f / 64.0f) + EPS);
#pragma unroll
                for (int bj = 0; bj < 2; ++bj) { const f32x4 c = *(const f32x4*)(cosT + t * 32 + bj * 16 + 4 * fq), sn = *(const f32x4*)(sinT + t * 32 + bj * 16 + 4 * fq);
                    const f32x4 x0 = acc[ai][bj][m][0] * gv[bj][0] * rinv, x1 = acc[ai][bj][m][1] * gv[bj][1] * rinv; f32x4 o0, o1;
                    o0[0] = x0[0] * c[0] - x0[1] * sn[0]; o0[1] = x0[0] * sn[0] + x0[1] * c[0]; o0[2] = x0[2] * c[1] - x0[3] * sn[1]; o0[3] = x0[2] * sn[1] + x0[3] * c[1];
                    o1[0] = x1[0] * c[2] - x1[1] * sn[2]; o1[1] = x1[0] * sn[2] + x1[1] * c[2]; o1[2] = x1[2] * c[3] - x1[3] * sn[3]; o1[3] = x1[2] * sn[3] + x1[3] * c[3];
                    *(v4u*)(O + row * ldo + bj * 32 + 8 * fq) = pack8(o0, o1); }
                if (m & 1) asm volatile("" ::: "memory"); }
        }
    }
};
}


struct CvtJob { const float* W; const float* gain; bf16* WT; int K, N, dst_row0, k0, n0; };
__device__ __forceinline__ CvtJob cvt_decode(const Frame& F, int it) {
    constexpr int I_IN = 16 * 56, I_SQ = 512, I_KV = 1024, I_HEAD = I_IN + I_SQ + I_KV + I_SQ, I_LAYER = I_HEAD + NE * 3 * I_SQ;
    CvtJob j; const int l = it / I_LAYER; int r = it % I_LAYER;
    if (r < I_IN) { const int kb = r / 56, nb = r % 56, n0 = nb * 32, pn = n0 >> 8; int dr = n0;
        if (pn >= 4) { const int sidx = n0 & 255, w = sidx >> 6, bj = (sidx >> 5) & 1; dr = pn * 256 + 128 * bj + 32 * w; }
        j.W = F.in[3] + (size_t)l * D * INW; j.gain = F.in[2] + (size_t)l * D; j.WT = (bf16*)(F.ws + WS_WIN) + (size_t)l * INW * D; j.K = D; j.N = INW; j.dst_row0 = dr; j.k0 = kb * 64; j.n0 = n0; return j; }
    r -= I_IN;
    if (r < I_SQ) { j.W = F.in[10] + (size_t)l * D * D; j.gain = F.in[9] + (size_t)l * D; j.WT = (bf16*)(F.ws + WS_WOUT) + (size_t)l * D * D; j.K = D; j.N = D; j.dst_row0 = (r % 32) * 32; j.k0 = (r / 32) * 64; j.n0 = (r % 32) * 32; return j; }
    r -= I_SQ;
    if (r < I_KV) { j.W = F.in[14] + (size_t)l * D * 2 * D; j.gain = nullptr; j.WT = (bf16*)(F.ws + WS_WKVT) + (size_t)l * 2 * D * D; j.K = D; j.N = 2 * D; j.dst_row0 = (r % 64) * 32; j.k0 = (r / 64) * 64; j.n0 = (r % 64) * 32; return j; }
    r -= I_KV;
    if (r < I_SQ) { j.W = F.in[15] + (size_t)l * D * D; j.gain = nullptr; j.WT = (bf16*)(F.ws + WS_WOT) + (size_t)l * D * D; j.K = D; j.N = D; j.dst_row0 = (r % 32) * 32; j.k0 = (r / 32) * 64; j.n0 = (r % 32) * 32; return j; }
    r -= I_SQ;
    const int e = r / (3 * I_SQ), rr = r % (3 * I_SQ), which = rr / I_SQ, sub = rr % I_SQ, kb = sub / 32, n0 = (sub % 32) * 32;
    const size_t mo = ((size_t)l * NE + e) * D * FF;
    j.K = D; j.N = FF; j.k0 = kb * 64; j.n0 = n0;
    if (which == 2) { j.W = F.in[20] + mo; j.gain = nullptr; j.WT = (bf16*)(F.ws + WS_WD) + mo; j.dst_row0 = n0; }
    else { j.W = (which == 0 ? F.in[18] : F.in[19]) + mo; j.gain = F.in[16] + (size_t)l * D; j.WT = (bf16*)(F.ws + WS_WGU) + 2 * mo; j.dst_row0 = 256 * (n0 >> 7) + 128 * which + (n0 & 127); }
    return j;
}
#define CVT_LOAD(J, R) do { const float* p_ = (J).W + (size_t)((J).k0 + (lane_ >> 5)) * (J).N + (J).n0 + (lane_ & 31); _Pragma("unroll") for (int i_ = 0; i_ < 32; ++i_) R[i_] = p_[(size_t)(2 * i_) * (J).N]; } while (0)
__device__ __forceinline__ void ph_convert(Frame& F) {
    int lane_ = lane_id(); asm volatile("" : "+v"(lane_)); const int tid_ = F.wave * 64 + lane_;
    LAS float* scr = (LAS float*)(F.lds + F.wave * 16384);
    const int gw = F.vcu * NWAVES + F.wave, NGW = F.G * NWAVES;
    constexpr int I_LAYER = 16 * 56 + 512 + 1024 + 512 + NE * 3 * 512, NITEMS = NL * I_LAYER;
    if (gw < NITEMS) {
        int it = gw; CvtJob cur = cvt_decode(F, it); float r[32]; CVT_LOAD(cur, r);
        for (;;) {
            const int nit = it + NGW; const bool hn = nit < NITEMS; CvtJob nx = cur; if (hn) nx = cvt_decode(F, nit);
#pragma unroll
            for (int i = 0; i < 32; ++i) scr[(2 * i + (lane_ >> 5)) * 33 + (lane_ & 31)] = r[i];
            if (hn) CVT_LOAD(nx, r);
            asm volatile("s_waitcnt lgkmcnt(0)" ::: "memory");
            const int c = lane_ & 7;
            f32x4 g0 = (f32x4){1.f, 1.f, 1.f, 1.f}, g1 = g0;
            if (cur.gain) { g0 = *(const f32x4*)(cur.gain + cur.k0 + 8 * c); g1 = *(const f32x4*)(cur.gain + cur.k0 + 8 * c + 4); }
#pragma unroll
            for (int j = 0; j < 4; ++j) { const int n = (lane_ >> 3) + 8 * j; const LAS float* sp = scr + (8 * c) * 33 + n;
                v4u o; o.x = pk2(sp[0 * 33] * g0[0], sp[1 * 33] * g0[1]); o.y = pk2(sp[2 * 33] * g0[2], sp[3 * 33] * g0[3]); o.z = pk2(sp[4 * 33] * g1[0], sp[5 * 33] * g1[1]); o.w = pk2(sp[6 * 33] * g1[2], sp[7 * 33] * g1[3]);
                *(v4u*)(cur.WT + (size_t)(cur.dst_row0 + n) * cur.K + cur.k0 + 8 * c) = o; }
            asm volatile("s_waitcnt lgkmcnt(0)" ::: "memory");
            if (!hn) break; cur = nx; it = nit;
        }
    }
    {   const float* wsrc = F.in[5]; bf16* WSBd = (bf16*)(F.ws + WS_WSB);
        for (int i = F.vcu * NTHR + tid_; i < NL * 4 * 128 * 128 / 8; i += F.G * NTHR) { const f32x4 a = *(const f32x4*)(wsrc + (size_t)i * 8), b = *(const f32x4*)(wsrc + (size_t)i * 8 + 4);
            v4u o; o.x = pk2(a.x, a.y); o.y = pk2(a.z, a.w); o.z = pk2(b.x, b.y); o.w = pk2(b.z, b.w); *(v4u*)(WSBd + (size_t)i * 8) = o; } }
    const int gt = F.vcu * NTHR + tid_, NGT = F.G * NTHR;
    const float* wq = F.in[13]; bf16* WQB = (bf16*)(F.ws + WS_WQB);
    for (int i = gt; i < NL * D * D / 8; i += NGT) { const f32x4 a = *(const f32x4*)(wq + (size_t)i * 8), b = *(const f32x4*)(wq + (size_t)i * 8 + 4);
        v4u o; o.x = pk2(a.x, a.y); o.y = pk2(a.z, a.w); o.z = pk2(b.x, b.y); o.w = pk2(b.z, b.w); *(v4u*)(WQB + (size_t)i * 8) = o; }
}

struct SchedDense {
    pg8::TileOrder o; const char* A; size_t a_tile; const char* B; size_t b_tile, b_batch; int bdiv, bmod;
    __device__ __forceinline__ bool next(int i, pg8::Unit& u) const { if (!o.tile(i, u.pm, u.pn)) return false;
        u.z = 0; u.gi = nullptr; u.grow = 0; u.a = A + (size_t)u.pm * a_tile; u.b = B + (size_t)((u.pm / bdiv) % bmod) * b_batch + (size_t)u.pn * b_tile; return true; }
};
struct SchedE1 {
    pg8::TileOrder o; const char* HBp; const int* IDX; const char* WGU;
    __device__ __forceinline__ bool next(int i, pg8::Unit& u) const { if (!o.tile(i, u.pm, u.pn)) return false;
        const int z = u.pm >> 2; u.z = z; u.gi = IDX + (size_t)u.pm * 256; u.grow = (z >> 4) * SEQ; u.a = HBp;
        u.b = WGU + (size_t)(z & 15) * (2 * FF * D * 2) + (size_t)u.pn * (256 * D * 2); return true; }
};
struct SchedKV { pg8::TileOrder o; const char* MEMN; const char* WKVT;
    __device__ __forceinline__ bool next(int i, pg8::Unit& u) const { if (!o.tile(i, u.pm, u.pn)) return false; u.z = 0; u.gi = nullptr; u.grow = 0;
        u.a = MEMN + (size_t)(u.pm & 3) * (256 * D * 2); u.b = WKVT + (size_t)(u.pm >> 2) * (2 * D * D * 2) + (size_t)u.pn * (256 * D * 2); return true; } };
struct SchedQK { pg8::TileOrder o; const char* KVM; const char* WQB;
    __device__ __forceinline__ bool next(int i, pg8::Unit& u) const { if (!o.tile(i, u.pm, u.pn)) return false; u.z = 0; u.gi = nullptr; u.grow = 0;
        const int h = u.pm & 3, lb = u.pm >> 2, b = lb & 3, l = lb >> 2;
        u.a = KVM + ((size_t)l * NMEM * 2 * D + (size_t)(b * 256) * 2 * D + h * 256) * 2; u.b = WQB + ((size_t)l * D * D + (size_t)u.pn * 256 * D + h * 256) * 2; return true; } };
struct SchedVO { pg8::TileOrder o; const char* KVM; const char* WOT;
    __device__ __forceinline__ bool next(int i, pg8::Unit& u) const { if (!o.tile(i, u.pm, u.pn)) return false; u.z = 0; u.gi = nullptr; u.grow = 0;
        const int pml = u.pm & 3, lbh = u.pm >> 2, h = lbh & 3, lb = lbh >> 2, b = lb & 3, l = lb >> 2;
        u.a = WOT + ((size_t)l * D * D + (size_t)pml * 256 * D + h * 256) * 2; u.b = KVM + ((size_t)l * NMEM * 2 * D + (size_t)(b * 256) * 2 * D + D + h * 256) * 2; return true; } };

namespace attn_body {
using bf16=__hip_bfloat16;
using bf16x8=__attribute__((ext_vector_type(8)))short;
using s16x4=__attribute__((ext_vector_type(4)))short;
using f32x16=__attribute__((ext_vector_type(16)))float;
using u32x4=__attribute__((ext_vector_type(4)))unsigned;
constexpr int SEQ=8192,D=64,QP=512,KP=128,OP=1024;
constexpr int NW=8,QBLK=32,QB=QBLK*NW,KVBLK=64,NQB=SEQ/QB;
constexpr int ATTN_UNIT_ROWS=QB;
__device__ __forceinline__ int crow(int r,int hi){return (r&3)+8*(r>>2)+4*hi;}
#define SBAR() __builtin_amdgcn_sched_barrier(0)
__device__ __forceinline__ void cmask(f32x16&p0,f32x16&p1,int jb,int qrel,int hi){
  const float NEG=-INFINITY; int kb=64*jb+4*hi;
  #pragma unroll
  for(int r=0;r<16;++r){int kv=kb+(r&3)+8*(r>>2); if(kv>qrel)p0[r]=NEG; if(kv+32>qrel)p1[r]=NEG;}
}

constexpr int NSLOT=3, SLOTB=8192;
constexpr int LDS_K=0, LDS_V=NSLOT*SLOTB, LDS_WS=2*NSLOT*SLOTB, LDS_OST=LDS_WS+NW*64*4, LDS_BYTES=LDS_OST+NW*4096;
constexpr float C2=0.125f*1.4426950408889634f;
__device__ __forceinline__ void glds16(const void*gsrc,unsigned lds_dst){unsigned keep;
  asm volatile("s_mov_b32 %0, m0\n\ts_mov_b32 m0, %2\n\ts_nop 0\n\tglobal_load_lds_dwordx4 %1, off\n\ts_mov_b32 m0, %0":"=&s"(keep):"v"(gsrc),"s"(lds_dst):"memory");}
__device__ __forceinline__ float max3f(float a,float b,float c){float r;asm("v_max3_f32 %0, %1, %2, %3":"=v"(r):"v"(a),"v"(b),"v"(c));return r;}
__device__ __forceinline__ float max2f(float a,float b){float r;asm("v_max_f32_e32 %0, %1, %2":"=v"(r):"v"(a),"v"(b));return r;}
__device__ __forceinline__ float fadd_s(float a,float b){float r;asm("v_add_f32_e32 %0, %1, %2":"=v"(r):"v"(a),"v"(b));return r;}
__device__ __forceinline__ float fsub_s(float a,float b){float r;asm("v_sub_f32_e32 %0, %1, %2":"=v"(r):"v"(a),"v"(b));return r;}
typedef float f32x2_t __attribute__((ext_vector_type(2))); typedef __bf16 bf16x2_t __attribute__((ext_vector_type(2)));
__device__ __forceinline__ unsigned cvtpk_s(float lo,float hi){f32x2_t v={lo,hi};bf16x2_t b=__builtin_convertvector(v,bf16x2_t);return __builtin_bit_cast(unsigned,b);}
#define WAIT_BAR(N) asm volatile("s_waitcnt vmcnt(" #N ") lgkmcnt(0)\n\ts_barrier":::"memory")

__device__ __forceinline__ void qkt(f32x16&p0,f32x16&p1,const char*Kslot,const bf16x8*qr,const f32x16&negm,int r32,int hi){
  const char*kb=Kslot+hi*1024+r32*16;
  #pragma unroll
  for(int d0=0;d0<4;++d0){
    const bf16x8 b0=*reinterpret_cast<const bf16x8*>(kb+d0*2048);
    const bf16x8 b1=*reinterpret_cast<const bf16x8*>(kb+d0*2048+512);
    if(d0==0){p0=__builtin_amdgcn_mfma_f32_32x32x16_bf16(b0,qr[0],negm,0,0,0);p1=__builtin_amdgcn_mfma_f32_32x32x16_bf16(b1,qr[0],negm,0,0,0);}
    else{p0=__builtin_amdgcn_mfma_f32_32x32x16_bf16(b0,qr[d0],p0,0,0,0);p1=__builtin_amdgcn_mfma_f32_32x32x16_bf16(b1,qr[d0],p1,0,0,0);}}
}
typedef __attribute__((address_space(3))) const char* lds_cptr;
typedef short v4i16_t __attribute__((ext_vector_type(4)));
__device__ __forceinline__ void kload8(bf16x8*kf,lds_cptr kp){
  kf[0]=*(const __attribute__((address_space(3))) bf16x8*)(kp);      kf[1]=*(const __attribute__((address_space(3))) bf16x8*)(kp+512);
  kf[2]=*(const __attribute__((address_space(3))) bf16x8*)(kp+2048); kf[3]=*(const __attribute__((address_space(3))) bf16x8*)(kp+2560);
  kf[4]=*(const __attribute__((address_space(3))) bf16x8*)(kp+4096); kf[5]=*(const __attribute__((address_space(3))) bf16x8*)(kp+4608);
  kf[6]=*(const __attribute__((address_space(3))) bf16x8*)(kp+6144); kf[7]=*(const __attribute__((address_space(3))) bf16x8*)(kp+6656);
}
__device__ __forceinline__ void kload2(bf16x8*kf,lds_cptr kp,int j){ kf[2*j]=*(const __attribute__((address_space(3))) bf16x8*)(kp+j*2048); kf[2*j+1]=*(const __attribute__((address_space(3))) bf16x8*)(kp+j*2048+512); }
__device__ __forceinline__ s16x4 vtr(lds_cptr p){ return __builtin_bit_cast(s16x4,__builtin_amdgcn_ds_read_tr16_b64_v4i16((__attribute__((address_space(3))) v4i16_t*)p)); }
__device__ __forceinline__ float rowmax(const f32x16&p0,const f32x16&p1){
  float a=max3f(p0[0],p0[1],p1[0]),b=max3f(p0[2],p0[3],p1[1]);a=max3f(a,p1[2],p1[3]);
  #pragma unroll
  for(int r=4;r<16;r+=4){a=max3f(a,p0[r],p0[r+1]);b=max3f(b,p0[r+2],p0[r+3]);a=max3f(a,p1[r],p1[r+1]);b=max3f(b,p1[r+2],p1[r+3]);}
  const float m=max2f(a,b);
  auto rr=__builtin_amdgcn_permlane32_swap(__float_as_uint(m),__float_as_uint(m),false,false);
  return max2f(__uint_as_float(rr[0]),__uint_as_float(rr[1]));
}
__device__ __forceinline__ void pv(f32x16*o,int vb,bf16x8 pa0,bf16x8 pa1,bf16x8 pa2,bf16x8 pa3){
  #pragma unroll
  for(int d0=0;d0<2;++d0){s16x4 lo[4],hi[4];
    #pragma unroll
    for(int ks=0;ks<4;++ks){
      asm volatile("ds_read_b64_tr_b16 %0,%1 offset:%c2":"=&v"(lo[ks]):"v"(vb),"i"(d0*4096+ks*1024):"memory");
      asm volatile("ds_read_b64_tr_b16 %0,%1 offset:%c2":"=&v"(hi[ks]):"v"(vb),"i"(d0*4096+ks*1024+512):"memory");}
    asm volatile("s_waitcnt lgkmcnt(0)":::"memory");SBAR();
    #define PK(k) (bf16x8){lo[k][0],lo[k][1],lo[k][2],lo[k][3],hi[k][0],hi[k][1],hi[k][2],hi[k][3]}
    o[d0]=__builtin_amdgcn_mfma_f32_32x32x16_bf16(pa0,PK(0),o[d0],0,0,0);
    o[d0]=__builtin_amdgcn_mfma_f32_32x32x16_bf16(pa1,PK(1),o[d0],0,0,0);
    o[d0]=__builtin_amdgcn_mfma_f32_32x32x16_bf16(pa2,PK(2),o[d0],0,0,0);
    o[d0]=__builtin_amdgcn_mfma_f32_32x32x16_bf16(pa3,PK(3),o[d0],0,0,0);
    #undef PK
  }
}

#ifndef ATTN_STORE16
#define ATTN_STORE16(p,v) (*(u32x4*)(p)=(v))
#endif
template<int THRL> __device__ __forceinline__ void attn_unit(int b,int h,int qb,const bf16*Q,const bf16*__restrict__ K,const bf16*__restrict__ V,bf16*O,float*ATS,char*shm,int wave_idx){
  int lane=(int)__builtin_amdgcn_mbcnt_hi(~0u,__builtin_amdgcn_mbcnt_lo(~0u,0u)); asm volatile("":"+v"(lane)); const int r32=lane&31,hi=lane>>5; const int wid=wave_idx; const int kvh=h>>2;
  const long rowbase=(long)b*SEQ; const int q0=qb*QB;
  const bf16*Qw=Q+(rowbase+q0+wid*QBLK)*QP+h*D;
  const bf16*Kh=K+rowbase*KP+kvh*D,*Vh=V+rowbase*KP+kvh*D;
  const unsigned lds0=(unsigned)(uintptr_t)shm;
  float*wsf=(float*)(shm+LDS_WS)+wid*64;
  const bf16*ksrc=Kh+(long)lane*KP+wid*8;
  const bf16*vsrc=Vh+(long)(16*(wid&3)+(lane>>2))*KP+(wid>>2)*32+(lane&3)*8;
  const unsigned kdst=lds0+LDS_K+wid*1024, vdst=lds0+LDS_V+wid*1024;
  #define DMA_K(t,slot) glds16(ksrc+(long)(t)*KVBLK*KP,(unsigned)__builtin_amdgcn_readfirstlane(kdst+(slot)))
  #define DMA_V(t,slot) glds16(vsrc+(long)(t)*KVBLK*KP,(unsigned)__builtin_amdgcn_readfirstlane(vdst+(slot)))
  const int vb0=(int)(lds0+LDS_V)+((lane>>4)&1)*32+(lane&3)*8+(4*hi+((lane&15)>>2))*64;
  const char*Kbase=shm+LDS_K; bf16x8 kf[8];
  const lds_cptr shm3=(lds_cptr)shm; const lds_cptr kp0=shm3+LDS_K+hi*1024+r32*16; const lds_cptr vp0=shm3+LDS_V+((lane>>4)&1)*32+(lane&3)*8+(4*hi+((lane&15)>>2))*64;
  const int NT=SEQ/KVBLK;
  DMA_K(0,0);DMA_V(0,0);DMA_K(1,SLOTB);
  bf16x8 qr[4];
  #pragma unroll
  for(int d0=0;d0<4;++d0)qr[d0]=*reinterpret_cast<const bf16x8*>(&Qw[(long)r32*QP+d0*16+hi*8]);
  float mhat=0.f,l_reg=0.f;f32x16 o[2];o[0]=f32x16{};o[1]=f32x16{};f32x16 negm=f32x16{};asm volatile("":"+v"(negm));
  const int qrel=wid*QBLK+r32;
  #define CMASK(P0,P1,t) do{}while(0)
  bool resc=false;
  #define START(P0,P1) do{ const float rm=rowmax(P0,P1); resc=false; \
    { const float dl=rm; mhat=fadd_s(mhat,dl); \
      _Pragma("unroll") for(int r=0;r<16;++r){P0[r]=fsub_s(P0[r],dl);P1[r]=fsub_s(P1[r],dl);} \
      _Pragma("unroll") for(int r=0;r<16;++r)negm[r]=-mhat; asm volatile("":"+v"(negm)); } \
    _Pragma("unroll") for(int r=0;r<16;++r)P0[r]=__builtin_amdgcn_exp2f(P0[r]); }while(0)
  #define RESC() do{ if(resc){ asm volatile("s_waitcnt lgkmcnt(0)":::"memory"); \
      _Pragma("unroll") for(int d_=0;d_<2;++d_) _Pragma("unroll") for(int r=0;r<16;++r)o[d_][r]*=wsf[crow(r,hi)]; } }while(0)
  f32x16 pA0,pA1,pB0,pB1;
  int sl_prev=0,sl_cur=0,sl_next=SLOTB;
  #define ROT() do{sl_prev=sl_cur;sl_cur=sl_next;sl_next=(sl_next==(NSLOT-1)*SLOTB)?0:sl_next+SLOTB;}while(0)
  DMA_K(2,2*SLOTB);
  WAIT_BAR(3);
  qkt(pA0,pA1,Kbase,qr,negm,r32,hi);asm volatile("s_nop 15\n\ts_nop 7":"+v"(pA0),"+v"(pA1));CMASK(pA0,pA1,0);
  START(pA0,pA1);
  _Pragma("unroll") for(int r=0;r<16;++r)pA1[r]=__builtin_amdgcn_exp2f(pA1[r]);
  WAIT_BAR(0);
  DMA_K(3,0);DMA_V(1,SLOTB);
  ROT();
  kload8(kf,kp0+sl_cur);
  WAIT_BAR(2);
  s16x4 vlo[8],vhi[8]; u32x4 pw0,pw1,pw2,pw3;
  #define PKW(P,B) cvtpk_s(P[B],P[B+1])
  #define PAF(k) __builtin_bit_cast(bf16x8,pw##k)
  #define VFR(i) (bf16x8){vlo[i][0],vlo[i][1],vlo[i][2],vlo[i][3],vhi[i][0],vhi[i][1],vhi[i][2],vhi[i][3]}
  #define PIN(x) asm volatile("":"+v"(x))
  #define MX3(a,b,c) __builtin_fmaxf(__builtin_fmaxf((a),(b)),(c))
  #define GAPA(MF,A0,A1,A2,A3,W0,W1,PW) do{ MF; sacc+=A0; sacc+=A1; sacc+=A2; sacc+=A3; PIN(sacc); W0; W1; PIN(PW); SBAR(); }while(0)
  #define EX(v) __builtin_amdgcn_exp2f(v)
  #define GAPB(MF,X,B) do{ MF; X[B]=EX(X[B]); X[B+1]=EX(X[B+1]); X[B+2]=EX(X[B+2]); X[B+3]=EX(X[B+3]); PIN(X); SBAR(); }while(0)
  #define VRD(i) do{ vlo[i]=vtr(vp_+(((i)>>2)*4096+((i)&3)*1024)); vhi[i]=vtr(vp_+(((i)>>2)*4096+((i)&3)*1024+512)); }while(0)
  #define KRD(G,j) do{ if(G){ kload2(kf,kp0+sl_next,j); SBAR(); } }while(0)
  #define STEP(C0,C1,P0,P1,t,GK,GV,GL) do{ SBAR(); \
    const lds_cptr vp_=vp0+sl_prev; \
    VRD(0); SBAR(); float sacc=(P0[0]+P0[1]); \
    GAPA(C0=__builtin_amdgcn_mfma_f32_32x32x16_bf16(kf[0],qr[0],negm,0,0,0), P0[2],P0[3],P0[4],P0[5],     pw0[0]=PKW(P0,0), pw0[1]=PKW(P0,2), pw0); \
    VRD(4); SBAR(); GAPA(C1=__builtin_amdgcn_mfma_f32_32x32x16_bf16(kf[1],qr[0],negm,0,0,0), P0[6],P0[7],P0[8],P0[9],     pw0[2]=PKW(P0,4), pw0[3]=PKW(P0,6), pw0); \
    VRD(1); SBAR(); GAPA(C0=__builtin_amdgcn_mfma_f32_32x32x16_bf16(kf[2],qr[1],C0,0,0,0),   P0[10],P0[11],P0[12],P0[13], pw1[0]=PKW(P0,8), pw1[1]=PKW(P0,10), pw1); \
    VRD(5); SBAR(); GAPA(C1=__builtin_amdgcn_mfma_f32_32x32x16_bf16(kf[3],qr[1],C1,0,0,0),   P0[14],P0[15],P1[0],P1[1],   pw1[2]=PKW(P0,12),pw1[3]=PKW(P0,14), pw1); \
    VRD(2); SBAR(); GAPA(C0=__builtin_amdgcn_mfma_f32_32x32x16_bf16(kf[4],qr[2],C0,0,0,0),   P1[2],P1[3],P1[4],P1[5],     pw2[0]=PKW(P1,0), pw2[1]=PKW(P1,2), pw2); \
    VRD(6); SBAR(); GAPA(C1=__builtin_amdgcn_mfma_f32_32x32x16_bf16(kf[5],qr[2],C1,0,0,0),   P1[6],P1[7],P1[8],P1[9],     pw2[2]=PKW(P1,4), pw2[3]=PKW(P1,6), pw2); \
    VRD(3); SBAR(); GAPA(C0=__builtin_amdgcn_mfma_f32_32x32x16_bf16(kf[6],qr[3],C0,0,0,0),   P1[10],P1[11],P1[12],P1[13], pw3[0]=PKW(P1,8), pw3[1]=PKW(P1,10), pw3); \
    VRD(7); SBAR(); GAPA(C1=__builtin_amdgcn_mfma_f32_32x32x16_bf16(kf[7],qr[3],C1,0,0,0),   P1[14],P1[15],0.f,0.f,       pw3[2]=PKW(P1,12),pw3[3]=PKW(P1,14), pw3); \
    l_reg+=sacc; \
    if(GK){DMA_K((t)+3,sl_cur);} if(GV){DMA_V((t)+1,sl_next);} \
    CMASK(C0,C1,t); \
    { float a=MX3(C0[0],C0[1],C1[0]),b=MX3(C0[2],C0[3],C1[1]); a=MX3(a,C1[2],C1[3]); \
      _Pragma("unroll") for(int r=4;r<16;r+=4){a=MX3(a,C0[r],C0[r+1]);b=MX3(b,C0[r+2],C0[r+3]);a=MX3(a,C1[r],C1[r+1]);b=MX3(b,C1[r+2],C1[r+3]);} \
      float rm=__builtin_fmaxf(a,b); { auto rr=__builtin_amdgcn_permlane32_swap(__float_as_uint(rm),__float_as_uint(rm),false,false); rm=__builtin_fmaxf(__uint_as_float(rr[0]),__uint_as_float(rr[1])); } \
      resc=false; \
      if(__builtin_expect(__any(rm>(float)THRL),0)){ const float dl=__builtin_fmaxf(rm,0.f); mhat+=dl; \
        _Pragma("unroll") for(int r=0;r<16;++r){C0[r]-=dl;C1[r]-=dl;} \
        _Pragma("unroll") for(int r=0;r<16;++r)negm[r]=-mhat; asm volatile("":"+v"(negm)); \
        const float f=__builtin_amdgcn_exp2f(-dl); l_reg*=f; if(hi==0)wsf[r32]=f; resc=true; } } \
    SBAR(); \
    GAPB(o[0]=__builtin_amdgcn_mfma_f32_32x32x16_bf16(PAF(0),VFR(0),o[0],0,0,0), C0,0); \
    GAPB(o[1]=__builtin_amdgcn_mfma_f32_32x32x16_bf16(PAF(0),VFR(4),o[1],0,0,0), C0,4); \
    KRD(GL,0); GAPB(o[0]=__builtin_amdgcn_mfma_f32_32x32x16_bf16(PAF(1),VFR(1),o[0],0,0,0), C0,8); \
    KRD(GL,1); GAPB(o[1]=__builtin_amdgcn_mfma_f32_32x32x16_bf16(PAF(1),VFR(5),o[1],0,0,0), C0,12); \
    KRD(GL,2); GAPB(o[0]=__builtin_amdgcn_mfma_f32_32x32x16_bf16(PAF(2),VFR(2),o[0],0,0,0), C1,0); \
    KRD(GL,3); GAPB(o[1]=__builtin_amdgcn_mfma_f32_32x32x16_bf16(PAF(2),VFR(6),o[1],0,0,0), C1,4); \
    GAPB(o[0]=__builtin_amdgcn_mfma_f32_32x32x16_bf16(PAF(3),VFR(3),o[0],0,0,0), C1,8); \
    GAPB(o[1]=__builtin_amdgcn_mfma_f32_32x32x16_bf16(PAF(3),VFR(7),o[1],0,0,0), C1,12); \
    }while(0)
  int t=1;
  for(;t+5<NT;t+=2){
    STEP(pB0,pB1,pA0,pA1,t,true,true,true);     WAIT_BAR(2); RESC(); ROT();
    STEP(pA0,pA1,pB0,pB1,t+1,true,true,true);   WAIT_BAR(2); RESC(); ROT();
  }
  #define ENDW(tt) do{ if((tt)+3<NT){WAIT_BAR(2);} else if((tt)+2<NT){WAIT_BAR(1);} else {WAIT_BAR(0);} }while(0)
  for(;t+1<NT;t+=2){
    STEP(pB0,pB1,pA0,pA1,t,(t+3<NT),(t+1<NT),(t+1<NT));       ENDW(t);   RESC(); ROT();
    STEP(pA0,pA1,pB0,pB1,t+1,(t+4<NT),(t+2<NT),(t+2<NT));     ENDW(t+1); RESC(); ROT();
  }
  STEP(pB0,pB1,pA0,pA1,NT-1,false,false,false); RESC();
  { float sacc=pB0[0]+pB0[1]; _Pragma("unroll") for(int r=2;r<16;++r)sacc+=pB0[r]; _Pragma("unroll") for(int r=0;r<16;++r)sacc+=pB1[r]; l_reg+=sacc;
    pw0=(u32x4){PKW(pB0,0),PKW(pB0,2),PKW(pB0,4),PKW(pB0,6)};pw1=(u32x4){PKW(pB0,8),PKW(pB0,10),PKW(pB0,12),PKW(pB0,14)};pw2=(u32x4){PKW(pB1,0),PKW(pB1,2),PKW(pB1,4),PKW(pB1,6)};pw3=(u32x4){PKW(pB1,8),PKW(pB1,10),PKW(pB1,12),PKW(pB1,14)};
    SBAR(); pv(o,vb0+sl_cur,PAF(0),PAF(1),PAF(2),PAF(3)); }
  #undef PKW
  #undef PAF
  #undef VFR
  #undef PIN
  #undef MX3
  #undef GAPA
  #undef GAPB
  #undef EX
  #undef VRD
  #undef KRD
  #undef STEP
  #undef ENDW
  {auto rr=__builtin_amdgcn_permlane32_swap(__float_as_uint(l_reg),__float_as_uint(l_reg),false,false);l_reg=__uint_as_float(rr[0])+__uint_as_float(rr[1]);}
  if(hi==0)wsf[32+r32]=l_reg;asm volatile("s_waitcnt lgkmcnt(0)":::"memory");
  float rli[16];
  #pragma unroll
  for(int r=0;r<16;++r)rli[r]=__builtin_amdgcn_rcpf(wsf[32+crow(r,hi)]);
  bf16*Ow=O+(rowbase+q0+wid*QBLK)*OP+512+h*D; float*ATw=ATS+(rowbase+q0+wid*QBLK)*8+h;
  { bf16*stg=(bf16*)(shm+LDS_OST)+wid*2048;
    #pragma unroll
    for(int r=0;r<16;++r){const int orow=crow(r,hi);
      #pragma unroll
      for(int d0=0;d0<2;++d0)stg[orow*64+d0*32+r32]=__float2bfloat16(o[d0][r]*rli[r]);}
    asm volatile("s_waitcnt lgkmcnt(0)":::"memory");
    #pragma unroll
    for(int i=0;i<4;++i){const int row=i*8+(lane>>3),ch=lane&7; const u32x4 v=*(const u32x4*)(stg+row*64+ch*8); ATTN_STORE16(Ow+(long)row*OP+ch*8,v);
      float ss=0.f;
      #pragma unroll
      for(int q=0;q<4;++q){const float lo=__uint_as_float(v[q]<<16),hh=__uint_as_float(v[q]&0xffff0000u);ss+=lo*lo+hh*hh;}
      ss+=__shfl_xor(ss,1);ss+=__shfl_xor(ss,2);ss+=__shfl_xor(ss,4); if(ch==0)ATw[(long)row*8]=ss;} }
  asm volatile("s_waitcnt lgkmcnt(0)\n\ts_barrier":::"memory");
  #undef DMA_K
  #undef DMA_V
  #undef CMASK
  #undef START
  #undef RESC
  #undef ROT
}
constexpr int ATTN_LDS_BYTES=LDS_BYTES;
#undef SBAR
#undef WAIT_BAR
}

__global__ void __launch_bounds__(NTHR, 2) mega(Args args) {
    extern __shared__ __attribute__((aligned(16))) unsigned char lds[];
    Frame F;
    F.lds = (LAS unsigned char*)lds;
    F.wave = __builtin_amdgcn_readfirstlane(threadIdx.x >> 6);
    F.G = gridDim.x; { const int bx = blockIdx.x; F.vcu = (F.G % 8 == 0) ? (bx % 8) * (F.G / 8) + bx / 8 : bx; }
#pragma unroll
    for (int i = 0; i < 22; ++i) F.in[i] = args.in[i];
    F.ws = args.ws; F.xres = args.out;
    volatile LAS unsigned* MISC = (volatile LAS unsigned*)(F.lds + MISC_OFF);
    for (int u = threadIdx.x; u < (LDS_BYTES - LDSCTL_OFF) / 4; u += NTHR) ((LAS unsigned*)(F.lds + LDSCTL_OFF))[u] = 0u;
    __syncthreads();
    const int lo = args.ph_lo, hi = args.ph_hi;
    unsigned* barw = (unsigned*)(F.ws + WS_CTL) + CW_BAR + args.bar_region * XCD_BAR_WORDS;
    XcdBarrier bar; bar.bar = barw; bar.x = 0; bar.st = nullptr;
    if (hi - lo > 1) bar = xcd_barrier_post(barw, MISC + 8);
#ifndef ONLY_K
#define ONLY_K -1
#endif
#define EN(kind) (ONLY_K < 0 || ONLY_K == (kind))
#define IN(k) (lo <= (k) && (k) < hi)
#ifndef REPK
#define REPK -1
#endif
#define PROBE_TOP(k) for (int rep_ = 0; rep_ < (REPK == (k) ? 2 : 1); ++rep_) {
#define PROBE_END(k) if (REPK == (k) && rep_ == 0) xcd_barrier(bar); }
#define SEAM(k) do { if (IN(k) && IN((k) + 1)) xcd_barrier(bar); } while (0)
    const int cid0 = (int)blockIdx.x; const int cid = cid0;
    if (EN(100) && IN(0)) { asm volatile("; PHASE_MARK P0"); PROBE_TOP(100) ph_rows0(F); PROBE_END(100) } SEAM(0);
    if (EN(101) && IN(1)) { asm volatile("; PHASE_MARK P1"); PROBE_TOP(101) ph_convert(F); PROBE_END(101) } SEAM(1);
    if (EN(102) && IN(2)) { asm volatile("; PHASE_MARK P2"); PROBE_TOP(102)
        SchedKV S; S.o.init(NL * 4, 8, F.G, cid); S.MEMN = (const char*)(F.ws + WS_MEMN); S.WKVT = (const char*)(F.ws + WS_WKVT);
        pg8::EpiStore<3> E{(bf16*)(F.ws + WS_KVM), 2 * D, nullptr, 1.0f};
        pg8::gemm_phase<pg8::EpiStore<3>, SchedKV, true, false>(F.lds, F.wave, D, D, D, S, E);
    PROBE_END(102) } SEAM(2);
    if (EN(103) && IN(3)) { asm volatile("; PHASE_MARK P3a");
        SchedQK S; S.o.init(NL * 16, 4, F.G, cid); S.KVM = (const char*)(F.ws + WS_KVM); S.WQB = (const char*)(F.ws + WS_WQB);
        pg8::EpiStore<1> E{(bf16*)(F.ws + WS_QKT), D, F.in[11], XQSCALE};
        int la = 2 * D, lb = D, kk = 256; asm volatile("" : "+s"(la), "+s"(lb), "+s"(kk));
        pg8::gemm_phase<pg8::EpiStore<1>, SchedQK, true, false>(F.lds, F.wave, la, lb, kk, S, E);
    }
    if (EN(104) && IN(3)) { asm volatile("; PHASE_MARK P3b");
        SchedVO S; S.o.init(NL * 64, 1, F.G, cid); S.KVM = (const char*)(F.ws + WS_KVM); S.WOT = (const char*)(F.ws + WS_WOT);
        pg8::EpiStore<2> E{(bf16*)(F.ws + WS_VOT), D, nullptr, 1.0f};
        int la = D, lb = 2 * D, kk = 256; asm volatile("" : "+s"(la), "+s"(lb), "+s"(kk));
        pg8::gemm_phase<pg8::EpiStore<2>, SchedVO, true, false>(F.lds, F.wave, la, lb, kk, S, E);
    } SEAM(3);
    for (int l = 0; l < NL; ++l) {
        const int pb = PH_LAYER0 + PH_PER_LAYER * l;
        int cid = cid0; asm volatile("" : "+s"(cid));
        if (EN(0) && IN(pb + 0)) { asm volatile("; PHASE_MARK L0"); PROBE_TOP(0)
            SchedDense S; S.o.init(T / 256, 7, F.G, cid); S.A = (const char*)(F.ws + WS_XR); S.a_tile = 256 * D * 2; S.B = (const char*)(F.ws + WS_WIN) + (size_t)l * INW * D * 2; S.b_tile = 256 * D * 2; S.b_batch = 0; S.bdiv = 1; S.bmod = 1;
            pg8::EpiIn E{(bf16*)(F.ws + WS_UACT), (bf16*)(F.ws + WS_VACT), (bf16*)(F.ws + WS_Q), (bf16*)(F.ws + WS_K), (bf16*)(F.ws + WS_V), (float*)(F.ws + WS_VSTAT),
                         F.in[7] + (size_t)l * 64, F.in[8] + (size_t)l * 64, (const float*)(F.ws + WS_ROPE), (const float*)(F.ws + WS_ROPE) + SEQ * 32, (const float*)(F.ws + WS_RINV)};
            pg8::gemm_phase<pg8::EpiIn, SchedDense, true, false>(F.lds, F.wave, D, D, D, S, E);
        PROBE_END(0) } SEAM(pb + 0);
        if (EN(1) && IN(pb + 1)) { asm volatile("; PHASE_MARK L1");
            PROBE_TOP(11)
            for (int it = 0; ; ++it) { const int w = it * F.G + F.vcu; if (w >= NB_ * 8 * (SEQ / 256)) break;
                const int i = w >> 8, c = w & 255, x = c >> 5, j = c & 31;
                attn_body::attn_unit<8>(x >> 1, (x & 1) * 4 + i, j, (const attn_body::bf16*)(F.ws + WS_Q), (const attn_body::bf16*)(F.ws + WS_K), (const attn_body::bf16*)(F.ws + WS_V),
                                        (attn_body::bf16*)(F.ws + WS_MERGED), (float*)(F.ws + WS_ATSTAT), (char*)lds, F.wave); }
            PROBE_END(11)
            PROBE_TOP(12) ph_gmlp(F, l); PROBE_END(12) } SEAM(pb + 1);
        if (EN(2) && IN(pb + 2)) { asm volatile("; PHASE_MARK L2"); PROBE_TOP(2)
            SchedDense S; S.o.init(T / 256, 4, F.G, cid); S.A = (const char*)(F.ws + WS_MERGED); S.a_tile = 256 * D * 2; S.B = (const char*)(F.ws + WS_WOUT) + (size_t)l * D * D * 2; S.b_tile = 256 * D * 2; S.b_batch = 0; S.bdiv = 1; S.bmod = 1;
            pg8::EpiX<true, true> E; E.xr = (bf16*)(F.ws + WS_XR); E.xstat = (float*)(F.ws + WS_XSTAT); E.gmstat = (const float*)(F.ws + WS_GMSTAT); E.atstat = (const float*)(F.ws + WS_ATSTAT); E.lds = F.lds;
            pg8::gemm_phase<pg8::EpiX<true, true>, SchedDense, true, false>(F.lds, F.wave, D, D, D, S, E);
        PROBE_END(2) } SEAM(pb + 2);
        if (EN(3) && IN(pb + 3)) { asm volatile("; PHASE_MARK L3"); PROBE_TOP(3)
            SchedDense S; S.o.init(T / 256, 4, F.G, cid); S.A = (const char*)(F.ws + WS_XR); S.a_tile = 256 * D * 2; S.B = (const char*)(F.ws + WS_QKT) + (size_t)l * NB_ * D * D * 2; S.b_tile = 256 * D * 2; S.b_batch = (size_t)D * D * 2; S.bdiv = SEQ / 256; S.bmod = NB_;
            pg8::EpiS E{(const float*)(F.ws + WS_XSTAT), (bf16*)(F.ws + WS_P), F.lds};
            pg8::gemm_phase<pg8::EpiS, SchedDense, true, false>(F.lds, F.wave, D, D, D, S, E);
        PROBE_END(3) } SEAM(pb + 3);
        if (EN(4) && IN(pb + 4)) { asm volatile("; PHASE_MARK L4"); PROBE_TOP(4)
            SchedDense S; S.o.init(T / 256, 4, F.G, cid); S.A = (const char*)(F.ws + WS_P); S.a_tile = 256 * D * 2; S.B = (const char*)(F.ws + WS_VOT) + (size_t)l * NB_ * D * D * 2; S.b_tile = 256 * D * 2; S.b_batch = (size_t)D * D * 2; S.bdiv = SEQ / 256; S.bmod = NB_;
            pg8::EpiX<false, false> E; E.xr = (bf16*)(F.ws + WS_XR); E.xstat = nullptr; E.gmstat = nullptr; E.atstat = nullptr; E.lds = F.lds;
            pg8::gemm_phase<pg8::EpiX<false, false>, SchedDense, true, false>(F.lds, F.wave, D, D, D, S, E);
        PROBE_END(4) } SEAM(pb + 4);
        if (EN(5) && IN(pb + 5)) { asm volatile("; PHASE_MARK L5"); PROBE_TOP(5) ph_router(F, l); PROBE_END(5) } SEAM(pb + 5);
        if (EN(6) && IN(pb + 6)) { asm volatile("; PHASE_MARK L6"); PROBE_TOP(6) ph_topk(F); PROBE_END(6) } SEAM(pb + 6);
        if (EN(7) && IN(pb + 7)) { asm volatile("; PHASE_MARK L7"); PROBE_TOP(7)
            SchedE1 S; S.o.init(NB_ * NE * 4, 8, F.G, cid); S.HBp = (const char*)(F.ws + WS_XR); S.IDX = (const int*)(F.ws + WS_IDX); S.WGU = (const char*)(F.ws + WS_WGU) + (size_t)l * NE * 2 * FF * D * 2;
            pg8::EpiH E{(bf16*)(F.ws + WS_H), (const float*)(F.ws + WS_RINV2)};
            pg8::gemm_phase<pg8::EpiH, SchedE1, true, true>(F.lds, F.wave, D, D, D, S, E);
        PROBE_END(7) } SEAM(pb + 7);
        if (EN(8) && IN(pb + 8)) { asm volatile("; PHASE_MARK L8"); PROBE_TOP(8)
            SchedDense S; S.o.init(NB_ * NE * 4, 4, F.G, cid); S.A = (const char*)(F.ws + WS_H); S.a_tile = 256 * FF * 2; S.B = (const char*)(F.ws + WS_WD) + (size_t)l * NE * D * FF * 2; S.b_tile = 256 * FF * 2; S.b_batch = (size_t)D * FF * 2; S.bdiv = 4; S.bmod = NE;
            pg8::EpiStore<0> E{(bf16*)(F.ws + WS_Y), D, nullptr, 1.0f};
            pg8::gemm_phase<pg8::EpiStore<0>, SchedDense, true, false>(F.lds, F.wave, FF, FF, FF, S, E);
        PROBE_END(8) } SEAM(pb + 8);
        if (EN(9) && IN(pb + 9)) { asm volatile("; PHASE_MARK L9"); PROBE_TOP(9) ph_combine(F, l, REPK == 9 && rep_ == 0); PROBE_END(9) } SEAM(pb + 9);
    }
#undef IN
#undef SEAM
}

static int g_grid = 0;
static void launch_mega(Args a, int lo, int hi, int region, hipStream_t stream) {
    a.ph_lo = lo; a.ph_hi = hi; a.bar_region = region; a.pad = 0;
    hipLaunchKernelGGL(mega, dim3(g_grid), dim3(NTHR), LDS_BYTES, stream, a);
}
extern "C" void kernel_launch(void* const* d_in, const int* in_sizes, int n_in, void* d_out, int out_size, void* d_ws, size_t ws_size, hipStream_t stream) {
    if (g_grid == 0) {
        if (n_in != 22 || out_size != T * D || ws_size < WS_END) { fprintf(stderr, "kernel_launch: unexpected sizes n_in %d out %d ws %zu\n", n_in, out_size, ws_size); g_grid = -1; return; }
        int dev = 0, cus = 0;
        if (hipGetDevice(&dev) != hipSuccess || hipDeviceGetAttribute(&cus, hipDeviceAttributeMultiprocessorCount, dev) != hipSuccess) { g_grid = -1; return; }
        if (hipFuncSetAttribute((const void*)mega, hipFuncAttributeMaxDynamicSharedMemorySize, LDS_BYTES) != hipSuccess) { g_grid = -1; return; }
        int per_cu = 0;
        if (hipOccupancyMaxActiveBlocksPerMultiprocessor(&per_cu, (const void*)mega, NTHR, LDS_BYTES) != hipSuccess || per_cu < 1) fprintf(stderr, "kernel_launch: occupancy query says %d\n", per_cu);
        (void)hipGetLastError();
        g_grid = cus;
    }
    if (g_grid < 0) return;
    hipMemsetAsync((char*)d_ws + WS_CTL, 0, CTL_ZERO_BYTES, stream);
    Args a{};
    for (int i = 0; i < 22; ++i) a.in[i] = (const float*)d_in[i];
    a.out = (float*)d_out; a.ws = (unsigned char*)d_ws;
    launch_mega(a, 0, PH_END, 0, stream);
}
```

```cpp
#include <hip/hip_runtime.h>
#include <hip/hip_bf16.h>
#include <cstdio>
#include <cstdint>
#include <cmath>

constexpr int NB_ = 4, SEQ = 8192, T = NB_ * SEQ, D = 1024, NL = 4;
constexpr int MEML = 256, NMEM = NB_ * MEML;
constexpr int INW = 1792, GMW = 512, NE = 16, CAP = 1024, FF = 1024;
constexpr float EPS = 1e-6f;
constexpr float LOG2E = 1.4426950408889634f;
constexpr float QSCALE = 0.125f * LOG2E;
constexpr float XQSCALE = 0.0625f * LOG2E;
constexpr float W8S = 256.0f, A8S = 16.0f, H8S = 8.0f;

constexpr size_t MiB = 1u << 20;
constexpr size_t WS_CTL = 0, CTL_ZERO_BYTES = 1 * MiB;
constexpr size_t WS_ROPE = 1 * MiB;
constexpr size_t WS_AFF = 3 * MiB;
constexpr size_t WS_INV = 5 * MiB;
constexpr size_t WS_IDX = 7 * MiB;
constexpr size_t WS_VSTAT = 8 * MiB;
constexpr size_t WS_ATSTAT = 9 * MiB;
constexpr size_t WS_GMSTAT = 10 * MiB;
constexpr size_t WS_RINV = 10 * MiB + 512 * 1024;
constexpr size_t WS_RINV2 = 10 * MiB + 768 * 1024;
constexpr size_t WS_XSTAT = 11 * MiB;
constexpr size_t WS_MEMN = 13 * MiB;
constexpr size_t WS_WSB = 15 * MiB;
constexpr size_t WS_WIN = 16 * MiB;
constexpr size_t WS_WOUT = 30 * MiB;
constexpr size_t WS_QKT = 38 * MiB;
constexpr size_t WS_VOT = 70 * MiB;
constexpr size_t WS_WGU = 102 * MiB;
constexpr size_t WS_WD = 358 * MiB;
constexpr size_t WS_XR = 486 * MiB;
constexpr size_t WS_R1 = 550 * MiB;
constexpr size_t WS_UACT = WS_R1, WS_VACT = WS_R1 + 32 * MiB, WS_Q = WS_R1 + 64 * MiB, WS_K = WS_R1 + 96 * MiB, WS_V = WS_R1 + 104 * MiB;
constexpr size_t WS_WQB = WS_R1, WS_WOT = WS_R1 + 8 * MiB, WS_WKVT = WS_R1 + 16 * MiB, WS_KVM = WS_R1 + 32 * MiB;
constexpr size_t WS_H = WS_R1;
constexpr size_t WS_MERGED = 678 * MiB;
constexpr size_t WS_XR8 = 742 * MiB;
constexpr size_t WS_P = WS_MERGED;
constexpr size_t WS_Y = 678 * MiB;
constexpr size_t WS_NSCR = 806 * MiB;
constexpr size_t WS_Q2 = WS_MERGED;
constexpr size_t WS_O2 = WS_NSCR;
constexpr size_t WS_KVN = WS_NSCR + 64 * MiB;
constexpr size_t WS_END = 1024 * MiB;

constexpr int CW_TMO = 0, CW_CODE = 1, CW_BAR = 4096;

#define GAS __attribute__((address_space(1)))
#define LAS __attribute__((address_space(3)))
typedef unsigned short bf16;
typedef unsigned v4u __attribute__((ext_vector_type(4)));
typedef unsigned v2u __attribute__((ext_vector_type(2)));
typedef float f32x4 __attribute__((ext_vector_type(4)));
typedef short bf16x8_t __attribute__((ext_vector_type(8)));
typedef GAS unsigned gu32;
#define RLX_AGENT __ATOMIC_RELAXED, __HIP_MEMORY_SCOPE_AGENT
__device__ __forceinline__ unsigned f2bf(float f) { unsigned u = __builtin_bit_cast(unsigned, f); return (u + 0x7fffu + ((u >> 16) & 1u)) >> 16; }
__device__ __forceinline__ unsigned pk2(float lo, float hi) { return f2bf(lo) | (f2bf(hi) << 16); }
__device__ __forceinline__ float bf2f(unsigned v) { return __builtin_bit_cast(float, v << 16); }
__device__ __forceinline__ float bflo(unsigned w) { return __builtin_bit_cast(float, w << 16); }
__device__ __forceinline__ float bfhi(unsigned w) { return __builtin_bit_cast(float, w & 0xffff0000u); }
__device__ __forceinline__ float rbf(float f) { return bf2f(f2bf(f)); }
__device__ __forceinline__ float clamp8(float v) { return __builtin_amdgcn_fmed3f(v, -448.0f, 448.0f); }
__device__ __forceinline__ unsigned pk4_fp8(float a, float b, float c, float d) { unsigned w = 0u; w = __builtin_amdgcn_cvt_pk_fp8_f32(clamp8(a), clamp8(b), w, false); w = __builtin_amdgcn_cvt_pk_fp8_f32(clamp8(c), clamp8(d), w, true); return w; }
__device__ __forceinline__ float gelu_tanh(float x) {
    const float z = 1.5957691216057308f * (x + 0.044715f * x * x * x);
    return x / (1.0f + __builtin_amdgcn_exp2f(-z * LOG2E));
}
__device__ __forceinline__ float silu_f(float a) { return a / (1.0f + __builtin_amdgcn_exp2f(-a * LOG2E)); }
__device__ __forceinline__ int lane_id() { int l; asm volatile("v_mbcnt_lo_u32_b32 %0, -1, 0\n\tv_mbcnt_hi_u32_b32 %0, -1, %0" : "=v"(l)); return l; }
template <int CTRL> __device__ __forceinline__ float dpp_f(float v) { return __builtin_bit_cast(float, __builtin_amdgcn_update_dpp(0, __builtin_bit_cast(int, v), CTRL, 0xf, 0xf, true)); }
__device__ __forceinline__ float sum_row16(float v) { v += dpp_f<0xB1>(v); v += dpp_f<0x4E>(v); v += dpp_f<0x141>(v); v += dpp_f<0x140>(v); return v; }
__device__ __forceinline__ float max_row16(float v) { v = fmaxf(v, dpp_f<0xB1>(v)); v = fmaxf(v, dpp_f<0x4E>(v)); v = fmaxf(v, dpp_f<0x141>(v)); v = fmaxf(v, dpp_f<0x140>(v)); return v; }
__device__ __forceinline__ float sum_row8(float v) { v += dpp_f<0xB1>(v); v += dpp_f<0x4E>(v); v += dpp_f<0x141>(v); return v; }
__device__ __forceinline__ float swz16(float v) { return __builtin_bit_cast(float, __builtin_amdgcn_ds_swizzle(__builtin_bit_cast(int, v), 0x401f)); }
__device__ __forceinline__ float add_x16(float v) { return v + swz16(v); }
__device__ __forceinline__ float add_x32(float v) { const unsigned a = __builtin_bit_cast(unsigned, v); const auto r = __builtin_amdgcn_permlane32_swap(a, a, false, false); const unsigned r0 = r[0], r1 = r[1]; return __builtin_bit_cast(float, r0) + __builtin_bit_cast(float, r1); }
__device__ __forceinline__ float max_x16(float v) { return fmaxf(v, swz16(v)); }
__device__ __forceinline__ float max_x32(float v) { const unsigned a = __builtin_bit_cast(unsigned, v); const auto r = __builtin_amdgcn_permlane32_swap(a, a, false, false); const unsigned r0 = r[0], r1 = r[1]; return fmaxf(__builtin_bit_cast(float, r0), __builtin_bit_cast(float, r1)); }
__device__ __forceinline__ float wave_sum(float v) { return add_x32(add_x16(sum_row16(v))); }

#define XB_TMO      128
#define XB_XCNT(j)  (256  + 64 * (j))
#define XB_XSUB(j)  (1280 + 64 * (j))
#define XB_XGEN(j)  (2304 + 64 * (j))
#define XB_TOP      3328
#define XB_TOPGEN   3392
#define XCD_BAR_WORDS 3456
#define XB_SPIN_CAP (1u << 18)
__device__ __forceinline__ unsigned xb_ld(unsigned* p)              { return __hip_atomic_load(p, __ATOMIC_RELAXED, __HIP_MEMORY_SCOPE_AGENT); }
__device__ __forceinline__ unsigned xb_add(unsigned* p, unsigned v) { return __hip_atomic_fetch_add(p, v, __ATOMIC_RELAXED, __HIP_MEMORY_SCOPE_AGENT); }
__device__ __forceinline__ unsigned xb_xcc_id() { return (unsigned)__builtin_amdgcn_s_getreg((3 << 11) | 20) & 0xFu; }
#define XB_SPIN(cond, bar) do { unsigned _sp = 0; while (cond) { __builtin_amdgcn_s_sleep(1); \
    if ((++_sp & 255u) == 0u) { if (xb_ld(&(bar)[XB_TMO])) break; if (_sp > XB_SPIN_CAP) { atomicAdd(&(bar)[XB_TMO], 1u); break; } } } } while (0)
struct XcdBarrier { unsigned* bar; unsigned x; volatile LAS unsigned* st; };
__device__ __forceinline__ XcdBarrier xcd_barrier_post(unsigned* bar, volatile LAS unsigned* st) {
    XcdBarrier b; b.bar = bar; b.x = xb_xcc_id(); b.st = st;
    if (threadIdx.x == 0) (void)xb_add(&bar[XB_XCNT(b.x)], 1u);
    return b;
}
__device__ __forceinline__ void xcd_barrier_complete(unsigned* bar, unsigned x, unsigned& nloc, unsigned& nx) {
    const unsigned G = gridDim.x * gridDim.y * gridDim.z;
    unsigned sum, cnt, mine, sp = 0u;
    for (;;) {
        sum = 0u; cnt = 0u; mine = 0u;
#pragma unroll
        for (unsigned j = 0; j < 16; ++j) { const unsigned c = xb_ld(&bar[XB_XCNT(j)]); sum += c; cnt += (c > 0u) ? 1u : 0u; mine = (j == x) ? c : mine; }
        if (sum == G) break;
        __builtin_amdgcn_s_sleep(1);
        if ((++sp & 255u) == 0u) { if (xb_ld(&bar[XB_TMO])) break; if (sp > XB_SPIN_CAP) { atomicAdd(&bar[XB_TMO], 1u); break; } }
    }
    nloc = mine > 0u ? mine : 1u; nx = cnt > 0u ? cnt : 1u;
}
__device__ __forceinline__ void xcd_barrier(const XcdBarrier& b) {
    asm volatile("s_waitcnt vmcnt(0)" ::: "memory");
    __syncthreads();
    if (threadIdx.x == 0) {
        unsigned* bar = b.bar;
        __builtin_amdgcn_s_waitcnt(0);
        unsigned nloc = b.st[0], nx = b.st[1];
        if (nloc == 0u) { xcd_barrier_complete(bar, b.x, nloc, nx); b.st[0] = nloc; b.st[1] = nx; }
        const unsigned old = xb_add(&bar[XB_XSUB(b.x)], 1u);
        const unsigned gen = old / nloc;
        if (old + 1u == (gen + 1u) * nloc) {
            __builtin_amdgcn_fence(__ATOMIC_RELEASE, "agent");
            asm volatile("s_waitcnt vmcnt(0)" ::: "memory");
            const unsigned og = xb_add(&bar[XB_TOP], 1u);
            const unsigned tg = og / nx;
            if (og + 1u == (tg + 1u) * nx) xb_add(&bar[XB_TOPGEN], 1u);
            else XB_SPIN(xb_ld(&bar[XB_TOPGEN]) == tg, bar);
            __builtin_amdgcn_fence(__ATOMIC_ACQUIRE, "agent");
            xb_add(&bar[XB_XGEN(b.x)], 1u);
            asm volatile("s_waitcnt vmcnt(0)" ::: "memory");
        } else {
            XB_SPIN(xb_ld(&bar[XB_XGEN(b.x)]) == gen, bar);
            __builtin_amdgcn_fence(__ATOMIC_ACQUIRE, "agent");
            asm volatile("s_waitcnt vmcnt(0)" ::: "memory");
        }
    }
    __syncthreads();
}

struct Args { const float* in[22]; float* out; unsigned char* ws; int ph_lo, ph_hi, bar_region, pad; };
constexpr int PH_LAYER0 = 4, PH_PER_LAYER = 10, PH_END = PH_LAYER0 + NL * PH_PER_LAYER;

constexpr int NWAVES = 8, NTHR = NWAVES * 64;
constexpr int RING_BYTES = 131072, LDSCTL_OFF = RING_BYTES, MISC_OFF = LDSCTL_OFF + 320;
constexpr int LDS_BYTES = 147456;

struct Frame {
    LAS unsigned char* lds;
    int wave, vcu, G;
    const float* in[22];
    unsigned char* ws;
    float* xres;
};

__device__ __forceinline__ void ph_rows0(Frame& F) {
    int lane_ = lane_id(); asm volatile("" : "+v"(lane_)); const int tid_ = F.wave * 64 + lane_;
    const int gw = F.vcu * NWAVES + F.wave, NGW = F.G * NWAVES;
    const float* x = F.in[0]; const float* mem = F.in[1]; const float* mg = F.in[12];
    bf16* XR = (bf16*)(F.ws + WS_XR); bf16* MEMN = (bf16*)(F.ws + WS_MEMN); float* RINV = (float*)(F.ws + WS_RINV);
    for (int m = gw; m < T + NMEM; m += NGW) {
        const bool is_mem = m >= T;
        const float* src = is_mem ? mem + (size_t)(m - T) * D : x + (size_t)m * D;
        bf16* dst = is_mem ? MEMN + (size_t)(m - T) * D : XR + (size_t)m * D;
        f32x4 v[4]; float s = 0.f;
#pragma unroll
        for (int j = 0; j < 4; ++j) { v[j] = *(const f32x4*)(src + 4 * lane_ + 256 * j); s += (v[j].x * v[j].x + v[j].y * v[j].y) + (v[j].z * v[j].z + v[j].w * v[j].w); }
        const float rinv = __builtin_amdgcn_rsqf(wave_sum(s) * (1.0f / D) + EPS);
        if (!is_mem && lane_ == 0) RINV[m] = rinv;
        const float sc = is_mem ? rinv : 1.0f;
#pragma unroll
        for (int j = 0; j < 4; ++j) {
            f32x4 g = (f32x4){1.f, 1.f, 1.f, 1.f};
            if (is_mem) g = *(const f32x4*)(mg + 4 * lane_ + 256 * j);
            v2u o; o.x = pk2(v[j].x * sc * g.x, v[j].y * sc * g.y); o.y = pk2(v[j].z * sc * g.z, v[j].w * sc * g.w);
            *(v2u*)(dst + 4 * lane_ + 256 * j) = o;
        }
    }
#if defined(SELFTEST_F8)
    if (F.vcu == 0 && F.wave == 0) {
        typedef int v8i_t __attribute__((ext_vector_type(8)));
        const int fr = lane_ & 15; const unsigned codes[4] = {0x38383838u, 0x3A3A3A3Au, 0x3C3C3C3Cu, 0x40404040u}; const float vals[4] = {1.0f, 1.25f, 1.5f, 2.0f};
        unsigned bc = codes[0]; float bv = vals[0];
#pragma unroll
        for (int q = 1; q < 4; ++q) if ((fr & 3) == q) { bc = codes[q]; bv = vals[q]; }
        v8i_t A, B;
#pragma unroll
        for (int q = 0; q < 8; ++q) { A[q] = 0x38383838; B[q] = (int)bc; }
        f32x4 acc = (f32x4){0.f, 0.f, 0.f, 0.f}; unsigned sc = 0x7f7f7f7fu; asm volatile("" : "+v"(sc), "+v"(A), "+v"(B), "+v"(acc));
        asm volatile("s_nop 7\n\tv_mfma_scale_f32_16x16x128_f8f6f4 %0, %1, %2, %0, %3, %3 op_sel_hi:[0,0,0]\n\ts_nop 15\n\ts_nop 15\n\ts_nop 15\n\ts_nop 15\n\ts_nop 15\n\ts_nop 15" : "+v"(acc) : "v"(A), "v"(B), "v"(sc));
        bool bad = false;
#pragma unroll
        for (int e = 0; e < 4; ++e) bad |= (acc[e] != 128.0f * bv);
        const unsigned w = pk4_fp8(1.25f, 448.0f, 1000.0f, -2.0f); bad |= (w != 0xC07E7E3Au);
        {   const float v = (float)((lane_ * 37 + 11) % 101);
            float r16 = v; r16 += __shfl_xor(r16, 1); r16 += __shfl_xor(r16, 2); r16 += __shfl_xor(r16, 4); r16 += __shfl_xor(r16, 8);
            float m16 = v; m16 = fmaxf(m16, __shfl_xor(m16, 1)); m16 = fmaxf(m16, __shfl_xor(m16, 2)); m16 = fmaxf(m16, __shfl_xor(m16, 4)); m16 = fmaxf(m16, __shfl_xor(m16, 8));
            float r8 = v; r8 += __shfl_xor(r8, 1); r8 += __shfl_xor(r8, 2); r8 += __shfl_xor(r8, 4);
            float r64 = r16; r64 += __shfl_xor(r64, 16); r64 += __shfl_xor(r64, 32);
            if (SELFTEST_F8 & 1) bad |= (sum_row16(v) != r16) | (max_row16(v) != m16) | (sum_row8(v) != r8);
            if (SELFTEST_F8 & 2) bad |= (wave_sum(v) != r64);
            if (SELFTEST_F8 & 4) bad |= (add_x16(v) != v + __shfl_xor(v, 16)) | (max_x16(v) != fmaxf(v, __shfl_xor(v, 16)));
            if (SELFTEST_F8 & 8) bad |= (add_x32(v) != v + __shfl_xor(v, 32)) | (max_x32(v) != fmaxf(v, __shfl_xor(v, 32)));
            if (SELFTEST_F8 & 16) bad |= (lane_ != (int)(threadIdx.x & 63));
            const int iv = lane_ * 3 + 1; if (SELFTEST_F8 & 32) bad |= (__builtin_amdgcn_readlane(iv, 5) != 16) | false; { const int bp = __builtin_amdgcn_ds_bpermute((lane_ - 1) << 2, iv); if (SELFTEST_F8 & 32) bad |= (lane_ > 0 && bp != iv - 3); }
            const float xq = 0.37f + (float)lane_; const float rq = __builtin_amdgcn_rsqf(xq), rr = 1.0f / sqrtf(xq); if (SELFTEST_F8 & 64) bad |= (fabsf(rq - rr) > 1e-5f * rr); }
        if (bad) __hip_atomic_store((unsigned*)(F.ws + WS_CTL) + CW_TMO, 1u, __ATOMIC_RELAXED, __HIP_MEMORY_SCOPE_AGENT);
    }
#endif
    float* COS = (float*)(F.ws + WS_ROPE); float* SIN = COS + SEQ * 32;
    const int gt = F.vcu * NTHR + tid_, NGT = F.G * NTHR;
    for (int i = gt; i < SEQ * 32; i += NGT) {
        const int t = i >> 5, p = i & 31;
        const float fr = expf(-9.210340371976184f * (float)(p & 15) * (1.0f / 16.0f));
        const float pos = (float)((p < 16) ? (t >> 6) : (t & 63));
        float rev = pos * fr * 0.15915494309189535f; rev -= floorf(rev);
        COS[i] = __builtin_amdgcn_cosf(rev); SIN[i] = __builtin_amdgcn_sinf(rev);
    }
}

__device__ __forceinline__ void ph_gmlp(Frame& F, int l) {
    int lane_ = lane_id(); asm volatile("" : "+v"(lane_)); const int tid_ = F.wave * 64 + lane_;
    const bf16* UACT = (const bf16*)(F.ws + WS_UACT); const bf16* VACT = (const bf16*)(F.ws + WS_VACT);
    const float* VSTAT = (const float*)(F.ws + WS_VSTAT); float* GMSTAT = (float*)(F.ws + WS_GMSTAT);
    bf16* MERGED = (bf16*)(F.ws + WS_MERGED);
    const float* gvn = F.in[4] + (size_t)l * GMW; const float* bs = F.in[6] + (size_t)l * 4 * 128;
    const bf16* WSB = (const bf16*)(F.ws + WS_WSB) + (size_t)l * 4 * 128 * 128;
    LAS bf16* vT = (LAS bf16*)F.lds;
    const int fr = lane_ & 15, fq = lane_ >> 4, w = F.wave;
    for (int u = F.vcu; u < (T / 128) * 4; u += F.G) {
        const int n = u >> 2, g = u & 3; const int row0 = n * 128;
        __syncthreads();
        {   const int j = tid_ & 127, cs = tid_ >> 7; const size_t row = (size_t)row0 + j;
            const f32x4 s0 = *(const f32x4*)(VSTAT + row * 8), s1 = *(const f32x4*)(VSTAT + row * 8 + 4);
            const float rinv = __builtin_amdgcn_rsqf((((s0[0] + s0[1]) + (s0[2] + s0[3])) + ((s1[0] + s1[1]) + (s1[2] + s1[3]))) * (1.0f / GMW) + EPS);
#pragma unroll
            for (int q = 0; q < 4; ++q) { const int c8 = (cs * 4 + q) * 8;
                const v4u raw = *(const v4u*)(VACT + row * GMW + g * 128 + c8);
                const f32x4 g0 = *(const f32x4*)(gvn + g * 128 + c8) * rinv, g1 = *(const f32x4*)(gvn + g * 128 + c8 + 4) * rinv;
                LAS bf16* d = vT + c8 * 136 + j;
                d[0 * 136] = (bf16)f2bf(bflo(raw.x) * g0[0]); d[1 * 136] = (bf16)f2bf(bfhi(raw.x) * g0[1]); d[2 * 136] = (bf16)f2bf(bflo(raw.y) * g0[2]); d[3 * 136] = (bf16)f2bf(bfhi(raw.y) * g0[3]);
                d[4 * 136] = (bf16)f2bf(bflo(raw.z) * g1[0]); d[5 * 136] = (bf16)f2bf(bfhi(raw.z) * g1[1]); d[6 * 136] = (bf16)f2bf(bflo(raw.w) * g1[2]); d[7 * 136] = (bf16)f2bf(bfhi(raw.w) * g1[3]); } }
        bf16x8_t bw[4];
#pragma unroll
        for (int ks = 0; ks < 4; ++ks) bw[ks] = *(const bf16x8_t*)(WSB + ((size_t)(g * 128 + 16 * w + fr)) * 128 + 32 * ks + 8 * fq);
        __syncthreads();
        f32x4 acc[8];
#pragma unroll
        for (int cb = 0; cb < 8; ++cb) { acc[cb] = (f32x4){0.f, 0.f, 0.f, 0.f};
#pragma unroll
            for (int ks = 0; ks < 4; ++ks) { const bf16x8_t a = *(const LAS bf16x8_t*)(vT + (16 * cb + fr) * 136 + 32 * ks + 8 * fq);
                acc[cb] = __builtin_amdgcn_mfma_f32_16x16x32_bf16(a, bw[ks], acc[cb], 0, 0, 0); } }
        const size_t row = (size_t)row0 + 16 * w + fr; const float bias = bs[g * 128 + 16 * w + fr]; float ss = 0.f;
#pragma unroll
        for (int cb = 0; cb < 8; ++cb) { const v2u uu = *(const v2u*)(UACT + row * GMW + g * 128 + 16 * cb + 4 * fq);
            v2u o; o.x = pk2(bflo(uu.x) * (acc[cb][0] + bias), bfhi(uu.x) * (acc[cb][1] + bias)); o.y = pk2(bflo(uu.y) * (acc[cb][2] + bias), bfhi(uu.y) * (acc[cb][3] + bias));
            *(v2u*)(MERGED + row * 1024 + g * 128 + 16 * cb + 4 * fq) = o;
            const float a0 = bflo(o.x), a1 = bfhi(o.x), a2 = bflo(o.y), a3 = bfhi(o.y); ss += (a0 * a0 + a1 * a1) + (a2 * a2 + a3 * a3); }
        ss = add_x32(add_x16(ss));
        if (fq == 0) GMSTAT[row * 4 + g] = ss;
    }
    __syncthreads();
}

__device__ __forceinline__ void ph_router(Frame& F, int l) {
    int lane_ = lane_id(); asm volatile("" : "+v"(lane_)); const int tid_ = F.wave * 64 + lane_;
    const float* g = F.in[16] + (size_t)l * D; const float* wr = F.in[17] + (size_t)l * D * NE;
    const bf16* XR = (const bf16*)(F.ws + WS_XR); float* AFF = (float*)(F.ws + WS_AFF);
    LAS float* sW = (LAS float*)F.lds;
    __syncthreads();
    for (int i = tid_; i < D * NE; i += NTHR) { const int c = i >> 4, e = i & 15; sW[e * D + c] = wr[i] * g[c]; }
    __syncthreads();
    const int gw = F.vcu * NWAVES + F.wave, NGW = F.G * NWAVES;
    LAS float* tp = (LAS float*)(F.lds + 65536) + F.wave * (64 * 17);
    v2u nv[2][4];
#pragma unroll
    for (int r = 0; r < 2; ++r) { const int m = gw + r * NGW; if (m < T) {
#pragma unroll
        for (int j = 0; j < 4; ++j) nv[r][j] = *(const v2u*)(XR + (size_t)m * D + 4 * lane_ + 256 * j); } }
    for (int m0 = gw; m0 < T; m0 += 2 * NGW) {
        f32x4 v[2][4];
#pragma unroll
        for (int r = 0; r < 2; ++r)
#pragma unroll
            for (int j = 0; j < 4; ++j) v[r][j] = (f32x4){bflo(nv[r][j].x), bfhi(nv[r][j].x), bflo(nv[r][j].y), bfhi(nv[r][j].y)};
#pragma unroll
        for (int r = 0; r < 2; ++r) { const int m = m0 + (2 + r) * NGW; if (m < T) {
#pragma unroll
            for (int j = 0; j < 4; ++j) nv[r][j] = *(const v2u*)(XR + (size_t)m * D + 4 * lane_ + 256 * j); } }
        const bool has1 = (m0 + NGW) < T;
        float rinv[2];
#pragma unroll
        for (int r = 0; r < 2; ++r) { float s = 0.f;
#pragma unroll
            for (int j = 0; j < 4; ++j) s += (v[r][j].x * v[r][j].x + v[r][j].y * v[r][j].y) + (v[r][j].z * v[r][j].z + v[r][j].w * v[r][j].w);
            rinv[r] = __builtin_amdgcn_rsqf(wave_sum(s) * (1.0f / D) + EPS); }
        {   unsigned char* X8 = F.ws + WS_XR8;
#pragma unroll
            for (int r = 0; r < 2; ++r) { if (r == 0 || has1) { const float sc = rinv[r] * A8S;
#pragma unroll
                for (int j = 0; j < 4; ++j) *(unsigned*)(X8 + (size_t)(m0 + r * NGW) * D + 4 * lane_ + 256 * j) = pk4_fp8(v[r][j].x * sc, v[r][j].y * sc, v[r][j].z * sc, v[r][j].w * sc); } } }
#pragma unroll 4
        for (int e = 0; e < NE; ++e) { float a0 = 0.f, a1 = 0.f;
#pragma unroll
            for (int j = 0; j < 4; ++j) { const f32x4 w = *(const LAS f32x4*)(sW + e * D + 4 * lane_ + 256 * j);
                a0 += (v[0][j].x * w.x + v[0][j].y * w.y) + (v[0][j].z * w.z + v[0][j].w * w.w); a1 += (v[1][j].x * w.x + v[1][j].y * w.y) + (v[1][j].z * w.z + v[1][j].w * w.w); }
            { const auto rr = __builtin_amdgcn_permlane32_swap(__float_as_uint(a0), __float_as_uint(a1), false, false);
              tp[lane_ * 17 + e] = __uint_as_float(rr[0]) + __uint_as_float(rr[1]); } }
        asm volatile("s_waitcnt lgkmcnt(0)" ::: "memory");
        {   const int e = lane_ & 15, r = (lane_ >> 4) & 1, hp = lane_ >> 5; float a0 = 0.f, a1 = 0.f;
#pragma unroll
            for (int rr = 0; rr < 16; rr += 2) { a0 += tp[(r * 32 + hp * 16 + rr) * 17 + e]; a1 += tp[(r * 32 + hp * 16 + rr + 1) * 17 + e]; }
            float mylg = add_x32(a0 + a1); mylg *= (r == 0 ? rinv[0] : rinv[1]);
            const float mx = max_row16(mylg);
            const float pe = __builtin_amdgcn_exp2f((mylg - mx) * LOG2E);
            const float den = sum_row16(pe);
            const int m = m0 + r * NGW;
            if (lane_ < 32 && (r == 0 || has1)) AFF[(size_t)m * NE + e] = pe / den;
        }
        asm volatile("s_waitcnt lgkmcnt(0)" ::: "memory");
    }
    __syncthreads();
}

__device__ __forceinline__ void ph_topk(Frame& F) {
    int lane_ = lane_id(); asm volatile("" : "+v"(lane_)); const int tid_ = F.wave * 64 + lane_;
    const float* AFF = (const float*)(F.ws + WS_AFF); int* IDX = (int*)(F.ws + WS_IDX); int* INV = (int*)(F.ws + WS_INV);
    LAS unsigned* hist = (LAS unsigned*)F.lds;
    LAS unsigned* sh = hist + 256;
    LAS unsigned* wsum = hist + 512;
    for (int p = F.vcu; p < NB_ * NE; p += F.G) {
        const int b = p >> 4, e = p & 15;
        unsigned key[16];
#pragma unroll
        for (int i = 0; i < 16; ++i) key[i] = __builtin_bit_cast(unsigned, AFF[((size_t)b * SEQ + tid_ * 16 + i) * NE + e]);
        unsigned prefix = 0u, krem = CAP;
#pragma unroll
        for (int pass = 0; pass < 4; ++pass) {
            const int shift = pass == 3 ? 0 : 23 - 8 * pass; const unsigned dmask = pass == 3 ? 127u : 255u;
            const unsigned himask = pass == 0 ? 0u : (pass == 1 ? 0xff800000u : (pass == 2 ? 0xffff8000u : 0xffffff80u));
            __syncthreads();
            if (tid_ < 256) hist[tid_] = 0u;
            __syncthreads();
#pragma unroll
            for (int i = 0; i < 16; ++i) if ((key[i] & himask) == prefix) atomicAdd((unsigned*)&hist[(key[i] >> shift) & dmask], 1u);
            __syncthreads();
            if (F.wave == 0) {
                unsigned c[4]; unsigned t = 0u;
#pragma unroll
                for (int j = 0; j < 4; ++j) { c[j] = hist[255 - 4 * lane_ - j]; t += c[j]; }
                unsigned inc = t;
#pragma unroll
                for (int o = 1; o < 64; o <<= 1) { const unsigned a = (unsigned)__builtin_amdgcn_ds_bpermute((lane_ - o) << 2, (int)inc); if (lane_ >= o) inc += a; }
                unsigned above = inc - t;
                if (above < krem && krem <= inc) {
                    int d = 255 - 4 * lane_;
#pragma unroll
                    for (int j = 0; j < 3; ++j) { if (above + c[j] < krem) { above += c[j]; d = 254 - 4 * lane_ - j; } else break; }
                    sh[0] = prefix | ((unsigned)d << shift); sh[1] = krem - above; }
            }
            __syncthreads();
            prefix = sh[0]; krem = sh[1];
        }
        const unsigned thr = prefix;
        unsigned cg = 0u, ce = 0u;
#pragma unroll
        for (int i = 0; i < 16; ++i) { cg += key[i] > thr ? 1u : 0u; ce += key[i] == thr ? 1u : 0u; }
        unsigned sg = cg, se = ce;
#pragma unroll
        for (int o = 1; o < 64; o <<= 1) { const unsigned a = (unsigned)__builtin_amdgcn_ds_bpermute((lane_ - o) << 2, (int)sg), c2 = (unsigned)__builtin_amdgcn_ds_bpermute((lane_ - o) << 2, (int)se); if (lane_ >= o) { sg += a; se += c2; } }
        __syncthreads();
        if (lane_ == 63) { wsum[F.wave] = sg; wsum[8 + F.wave] = se; }
        __syncthreads();
        unsigned og = 0u, oe = 0u;
        for (int w = 0; w < F.wave; ++w) { og += wsum[w]; oe += wsum[8 + w]; }
        unsigned gb = og + sg - cg, eb = oe + se - ce;
#pragma unroll
        for (int i = 0; i < 16; ++i) {
            const int t = tid_ * 16 + i; int pos = -1;
            if (key[i] > thr) { pos = (int)(gb + (eb < krem ? eb : krem)); ++gb; }
            else if (key[i] == thr) { if (eb < krem) pos = (int)(gb + eb); ++eb; }
            INV[((size_t)b * SEQ + t) * NE + e] = pos;
            if (pos >= 0) IDX[(size_t)p * CAP + pos] = t;
        }
    }
    __syncthreads();
}

__device__ __forceinline__ void ph_combine(Frame& F, int l, bool dummy) {
    int lane_ = lane_id(); asm volatile("" : "+v"(lane_));
    const float* AFF = (const float*)(F.ws + WS_AFF); const int* INV = (const int*)(F.ws + WS_INV);
    const bf16* Y = (const bf16*)(F.ws + WS_Y); bf16* XR = (bf16*)(F.ws + WS_XR); const float* fg = F.in[21]; float* RINV = (float*)(F.ws + WS_RINV);
    const int gw = F.vcu * NWAVES + F.wave, NGW = F.G * NWAVES;
    for (int m = gw; m < T; m += NGW) {
        const int b = m / SEQ;
        bf16* xw = (dummy ? (bf16*)(F.ws + WS_NSCR) : XR) + (size_t)m * D; float* ow = (dummy ? (float*)(F.ws + WS_NSCR) : F.xres) + (size_t)m * D;
        f32x4 v[4];
#pragma unroll
        for (int j = 0; j < 4; ++j) { const v2u w = *(const v2u*)(XR + (size_t)m * D + 4 * lane_ + 256 * j); v[j] = (f32x4){bflo(w.x), bfhi(w.x), bflo(w.y), bfhi(w.y)}; }
        const int mypos = lane_ < NE ? INV[(size_t)m * NE + lane_] : -1;
        const float myaff = lane_ < NE ? AFF[(size_t)m * NE + lane_] : 0.f;
#pragma unroll
        for (int e = 0; e < NE; ++e) {
            const int pos = __builtin_amdgcn_readlane(mypos, e); const float a = __builtin_bit_cast(float, __builtin_amdgcn_readlane(__builtin_bit_cast(int, myaff), e));
            if (pos >= 0) {
                const bf16* yr = Y + ((size_t)(b * NE + e) * CAP + pos) * D;
#pragma unroll
                for (int j = 0; j < 4; ++j) { const v2u w = *(const v2u*)(yr + 4 * lane_ + 256 * j);
                    v[j].x += a * bflo(w.x); v[j].y += a * bfhi(w.x); v[j].z += a * bflo(w.y); v[j].w += a * bfhi(w.y); }
            }
        }
        float s = 0.f;
#pragma unroll
        for (int j = 0; j < 4; ++j) s += (v[j].x * v[j].x + v[j].y * v[j].y) + (v[j].z * v[j].z + v[j].w * v[j].w);
        const float rinv = __builtin_amdgcn_rsqf(wave_sum(s) * (1.0f / D) + EPS);
        if (l == NL - 1) {
#if defined(SELFTEST_F8)
            if (__hip_atomic_load((unsigned*)(F.ws + WS_CTL) + CW_TMO, __ATOMIC_RELAXED, __HIP_MEMORY_SCOPE_AGENT) != 0u) v[0].x = __builtin_nanf("");
#endif
#pragma unroll
            for (int j = 0; j < 4; ++j) { const f32x4 g = *(const f32x4*)(fg + 4 * lane_ + 256 * j); *(f32x4*)(ow + 4 * lane_ + 256 * j) = (f32x4){v[j].x * rinv * g.x, v[j].y * rinv * g.y, v[j].z * rinv * g.z, v[j].w * rinv * g.w}; }
        } else {
            if (lane_ == 0 && !dummy) RINV[m] = rinv;
#pragma unroll
            for (int j = 0; j < 4; ++j) { v2u o; o.x = pk2(v[j].x, v[j].y); o.y = pk2(v[j].z, v[j].w); *(v2u*)(xw + 4 * lane_ + 256 * j) = o; }
        }
    }
}

namespace pg8 {
typedef short bf16x8 __attribute__((ext_vector_type(8)));
typedef float f32x2 __attribute__((ext_vector_type(2)));
typedef int v4i_t __attribute__((ext_vector_type(4)));
typedef int v8i_t __attribute__((ext_vector_type(8)));
constexpr int BM = 256, BK = 64, HALF = 128, HTB = HALF * BK * 2, STAGE_BYTES = 8 * HTB, NXCD = 8, WGM = 8;
__host__ __device__ __forceinline__ int lds_byte(int r, int c) { const int st = (r >> 4) * 2 + (c >> 5), rr = r & 15, cc = c & 31, ob = rr * 64 + cc * 2; return st * 1024 + (ob ^ (((ob >> 9) & 1) << 5)); }
__host__ __device__ __forceinline__ void stage_rc(int b, int& R, int& C) { const int st = b / 1024, sb = b % 1024, swz = sb ^ (((sb >> 9) & 1) << 5); R = (st >> 1) * 16 + swz / 64; C = (st & 1) * 32 + (swz % 64) / 2; }
__host__ __device__ __forceinline__ int perm32(int rho) { const int n = rho >> 4, i = rho & 15; return 8 * (i >> 2) + 4 * n + (i & 3); }

struct Unit { int pm, pn, z; const char* a; const char* b; const int* gi; int grow; };

struct TileOrder {
    int nM, nN, nwg, G, c;
    __device__ __forceinline__ void init(int nM_, int nN_, int G_, int c_) { nM = nM_; nN = nN_; nwg = nM * nN; G = G_; c = c_; }
    __device__ __forceinline__ bool tile(int i, int& pm, int& pn) const {
        const long L = (long)i * G + c; if (L >= nwg) return false;
        int wgid = (int)L; { const int q = nwg / NXCD, r = nwg % NXCD, xcd = wgid % NXCD, off = wgid / NXCD; wgid = (xcd < r ? xcd * (q + 1) : r * (q + 1) + (xcd - r) * q) + off; }
        const int nig = WGM * nN, gid = wgid / nig, fm = gid * WGM, gsz = (nM - fm) < WGM ? (nM - fm) : WGM;
        pm = fm + ((wgid % nig) % gsz); pn = (wgid % nig) / gsz; return true;
    }
};

__device__ __forceinline__ unsigned cvt_pk_bf16(float lo, float hi) { unsigned r; asm volatile("v_cvt_pk_bf16_f32 %0, %1, %2" : "=v"(r) : "v"(lo), "v"(hi)); return r; }
typedef f32x4 Acc[2][2][4][2];
#ifndef NT_STORE
#define NT_STORE 0
#endif
__device__ __forceinline__ void st16(void* p, const v4u w) { if (NT_STORE) __builtin_nontemporal_store(w, (v4u*)p); else *(v4u*)p = w; }
#ifndef NT_Y
#define NT_Y 1
#endif

template <class Epi, class Sched, bool ALIGN_EPI, bool GATHER, bool FP8 = false>
__device__ __forceinline__ void gemm_phase(LAS unsigned char* lds, const int wave_idx, const int lda, const int ldb, const int K, const Sched& S, Epi& E) {
    const int lane = lane_id();
    int wid = wave_idx; asm volatile("" : "+s"(wid));
    const int tid = wid * 64 + lane, wr = wid >> 2, wc = wid & 3, fr = lane & 15, fq = lane >> 4;
    const int nt = K / BK;
    unsigned voffA[2], voffB[2];
#pragma unroll
    for (int i = 0; i < 2; ++i) { int R, C; stage_rc(tid * 16 + i * 8192, R, C); const int Rb = (R & ~31) + perm32(R & 31);
        voffA[i] = (unsigned)(R * lda + C) * 2u; voffB[i] = (unsigned)(Rb * ldb + C) * 2u; }
    const size_t kstep = (size_t)(BK * 2);
    const size_t hstepA = (size_t)HALF * lda * 2, hstepB = (size_t)HALF * ldb * 2;
    const unsigned ldsw = (unsigned)wid * 1024u;
    const int aoff = lds_byte(wr * 64 + fr, fq * 8), boff = lds_byte(wc * 32 + fr, fq * 8);
    unsigned vgc[2][2], vgn[2][2];
#define PG8_SA(b, h) (((b) * 2 + (h)) * HTB)
#define PG8_SB(b, h) ((4 + (b) * 2 + (h)) * HTB)
#define PG8_GL(gp, voff, bufoff, _i) __builtin_amdgcn_global_load_lds((const unsigned*)((const char*)(gp) + (voff)), (LAS unsigned*)(lds + (bufoff) + ldsw + (_i) * 8192), 16, 0, 0)
#define PG8_STAGE_B(bufoff, gbase) do { PG8_GL(gbase, voffB[0], bufoff, 0); PG8_GL(gbase, voffB[1], bufoff, 1); } while (0)
#define PG8_STAGE_A(bufoff, gbase, h, VG) do { if constexpr (GATHER) { PG8_GL(gbase, VG[h][0], bufoff, 0); PG8_GL(gbase, VG[h][1], bufoff, 1); } \
        else { PG8_GL((gbase) + (h) * hstepA, voffA[0], bufoff, 0); PG8_GL((gbase) + (h) * hstepA, voffA[1], bufoff, 1); } } while (0)
#define PG8_CAT(x0, x1) __builtin_shufflevector(__builtin_bit_cast(v4i_t, x0), __builtin_bit_cast(v4i_t, x1), 0, 1, 2, 3, 4, 5, 6, 7)
#define PG8_RD(off) (*(const LAS bf16x8*)(lds + (off)))
#define PG8_LDA(dst, b, h) do { if constexpr (FP8) { _Pragma("unroll") for (int m = 0; m < 4; ++m) dst##8[m] = PG8_CAT(PG8_RD(PG8_SA(b, h) + aoff + m * 2048), PG8_RD(PG8_SA(b, h) + aoff + m * 2048 + 1024)); } \
        else { _Pragma("unroll") for (int m = 0; m < 4; ++m) _Pragma("unroll") for (int k = 0; k < 2; ++k) dst[m][k] = PG8_RD(PG8_SA(b, h) + aoff + m * 2048 + k * 1024); } } while (0)
#define PG8_LDB(dst, b, h) do { if constexpr (FP8) { _Pragma("unroll") for (int n = 0; n < 2; ++n) dst##8[n] = PG8_CAT(PG8_RD(PG8_SB(b, h) + boff + n * 2048), PG8_RD(PG8_SB(b, h) + boff + n * 2048 + 1024)); } \
        else { _Pragma("unroll") for (int n = 0; n < 2; ++n) _Pragma("unroll") for (int k = 0; k < 2; ++k) dst[n][k] = PG8_RD(PG8_SB(b, h) + boff + n * 2048 + k * 1024); } } while (0)
#define PG8_MMA(ai, bj, At, Bt) do { __builtin_amdgcn_s_setprio(1); _Pragma("unroll") for (int m = 0; m < 4; ++m) _Pragma("unroll") for (int n = 0; n < 2; ++n) { \
        if constexpr (FP8) asm volatile("v_mfma_scale_f32_16x16x128_f8f6f4 %0, %1, %2, %0, %3, %3 op_sel_hi:[0,0,0]" : "+v"(acc[ai][bj][m][n]) : "v"(Bt##8[n]), "v"(At##8[m]), "v"(sc8)); \
        else { _Pragma("unroll") for (int k = 0; k < 2; ++k) acc[ai][bj][m][n] = __builtin_amdgcn_mfma_f32_16x16x32_bf16(Bt[n][k], At[m][k], acc[ai][bj][m][n], 0, 0, 0); } } __builtin_amdgcn_s_setprio(0); } while (0)
#define PG8_WAIT_V(n) asm volatile("s_waitcnt vmcnt(" #n ")" ::: "memory")
#define PG8_WAIT_L(n) asm volatile("s_waitcnt lgkmcnt(" #n ")" ::: "memory")
#define PG8_BAR __builtin_amdgcn_s_barrier()
#define PG8_SCHED __builtin_amdgcn_sched_barrier(0)
#define PG8_GIDX(VG, U) do { const int _t = wid * 64 + lane_id();   \
        _Pragma("unroll") for (int _i = 0; _i < 2; ++_i) { int _R, _C; stage_rc(_t * 16 + _i * 8192, _R, _C); _Pragma("unroll") for (int _h = 0; _h < 2; ++_h) \
        VG[_h][_i] = (unsigned)((U).grow + (U).gi[_h * HALF + _R]) * (unsigned)(lda * 2) + (unsigned)_C * 2u; } } while (0)
    Unit cur, nxt; int ui = 0;
    if (!S.next(0, cur)) return;
    Acc acc;
#pragma unroll
    for (int a = 0; a < 2; ++a)
#pragma unroll
        for (int b = 0; b < 2; ++b)
#pragma unroll
            for (int m = 0; m < 4; ++m)
#pragma unroll
                for (int n = 0; n < 2; ++n) acc[a][b][m][n] = (f32x4){0.f, 0.f, 0.f, 0.f};
    bf16x8 At[4][2], B0[2][2], B1[2][2];
    v8i_t At8[4], B08[2], B18[2];
    unsigned sc8 = 0x7f7f7f7fu; asm volatile("" : "+v"(sc8));
    const char* cA = cur.a; const char* cB = cur.b;
    if constexpr (GATHER) { PG8_GIDX(vgc, cur); } else { vgc[0][0] = vgc[0][1] = vgc[1][0] = vgc[1][1] = 0u; }
    E.prep(cur, wr, wc, fr, fq);
    PG8_STAGE_B(PG8_SB(0, 0), cB); PG8_STAGE_B(PG8_SB(0, 1), cB + hstepB); PG8_STAGE_A(PG8_SA(0, 0), cA, 0, vgc); PG8_STAGE_A(PG8_SA(0, 1), cA, 1, vgc);
    if (wr == 1) PG8_BAR;
    PG8_WAIT_V(2); PG8_BAR;
    PG8_STAGE_B(PG8_SB(1, 0), cB + kstep); PG8_STAGE_A(PG8_SA(1, 0), cA + kstep, 0, vgc); PG8_STAGE_B(PG8_SB(1, 1), cB + hstepB + kstep);
    PG8_WAIT_V(6); PG8_BAR;
    for (;;) {
        const bool has_next = S.next(ui + 1, nxt);
        const char* nA = has_next ? nxt.a : cA; const char* nB = has_next ? nxt.b : cB;
        if constexpr (GATHER) { if (has_next) { PG8_GIDX(vgn, nxt); } else {
#pragma unroll
            for (int h = 0; h < 2; ++h) { vgn[h][0] = vgc[h][0]; vgn[h][1] = vgc[h][1]; } } }
        else { vgn[0][0] = vgn[0][1] = vgn[1][0] = vgn[1][1] = 0u; }
        for (int t = 0; t < nt; t += 2) {
            const bool last = (t == nt - 2);
            const char* a1 = cA + (size_t)(t + 1) * kstep;
            const char* a2 = last ? nA : cA + (size_t)(t + 2) * kstep; const char* b2 = last ? nB : cB + (size_t)(t + 2) * kstep;
            const char* a3 = a2 + kstep; const char* b3 = b2 + kstep;
            if constexpr (Epi::MIDK) { if (t == (nt >> 1)) E.midk(acc); }
            PG8_LDB(B0, 0, 0); PG8_LDB(B1, 0, 1); PG8_SCHED; PG8_LDA(At, 0, 0); PG8_STAGE_A(PG8_SA(1, 1), a1, 1, vgc);
            if constexpr (GATHER) { if (last) {
#pragma unroll
                for (int h = 0; h < 2; ++h) { vgc[h][0] = vgn[h][0]; vgc[h][1] = vgn[h][1]; } } }
            PG8_WAIT_V(8); PG8_WAIT_L(0); PG8_BAR; PG8_MMA(0, 0, At, B0); PG8_MMA(0, 1, At, B1); PG8_BAR; PG8_SCHED;
            PG8_LDA(At, 0, 1); PG8_STAGE_B(PG8_SB(0, 0), b2); PG8_STAGE_B(PG8_SB(0, 1), b2 + hstepB); PG8_STAGE_A(PG8_SA(0, 0), a2, 0, vgc);
            PG8_WAIT_V(8); PG8_WAIT_L(0); PG8_BAR; PG8_MMA(1, 0, At, B0); PG8_MMA(1, 1, At, B1); PG8_BAR; PG8_SCHED;
            PG8_LDB(B0, 1, 0); PG8_LDB(B1, 1, 1); PG8_SCHED; PG8_LDA(At, 1, 0); PG8_STAGE_A(PG8_SA(0, 1), a2, 1, vgc);
            PG8_WAIT_V(8); PG8_WAIT_L(0); PG8_BAR; PG8_MMA(0, 0, At, B0); PG8_MMA(0, 1, At, B1); PG8_BAR; PG8_SCHED;
            PG8_LDA(At, 1, 1); PG8_STAGE_B(PG8_SB(1, 0), b3); PG8_STAGE_B(PG8_SB(1, 1), b3 + hstepB); PG8_STAGE_A(PG8_SA(1, 0), a3, 0, vgc);
            PG8_WAIT_V(8); PG8_WAIT_L(0); PG8_BAR; PG8_MMA(1, 0, At, B0); PG8_MMA(1, 1, At, B1); PG8_BAR; PG8_SCHED;
        }
        if constexpr (ALIGN_EPI) { if (wr == 0) PG8_BAR; }
        E(acc, cur, wr, wc, fr, fq);
        if (!has_next) break;
#pragma unroll
        for (int a = 0; a < 2; ++a)
#pragma unroll
            for (int b = 0; b < 2; ++b)
#pragma unroll
                for (int m = 0; m < 4; ++m)
#pragma unroll
                    for (int n = 0; n < 2; ++n) acc[a][b][m][n] = (f32x4){0.f, 0.f, 0.f, 0.f};
        cur = nxt; cA = nA; cB = nB; ++ui;
#pragma unroll
        for (int h = 0; h < 2; ++h) { vgc[h][0] = vgn[h][0]; vgc[h][1] = vgn[h][1]; }
        E.prep(cur, wr, wc, fr, fq);
        if constexpr (ALIGN_EPI) { if (wr == 1) PG8_BAR; }
    }
    PG8_WAIT_V(0);
    if constexpr (!ALIGN_EPI) { if (wr == 0) PG8_BAR; }
    PG8_BAR;
#undef PG8_SA
#undef PG8_SB
#undef PG8_GL
#undef PG8_STAGE_A
#undef PG8_STAGE_B
#undef PG8_LDA
#undef PG8_RD
#undef PG8_LDB
#undef PG8_MMA
#undef PG8_CAT
#undef PG8_WAIT_V
#undef PG8_WAIT_L
#undef PG8_SCHED
#undef PG8_GIDX
}

#define EPI_ROWS for (int ai = 0; ai < 2; ++ai) _Pragma("unroll") for (int m = 0; m < 4; ++m)
__device__ __forceinline__ v4u pack8(const f32x4 a, const f32x4 b) { v4u w; w.x = cvt_pk_bf16(a[0], a[1]); w.y = cvt_pk_bf16(a[2], a[3]); w.z = cvt_pk_bf16(b[0], b[1]); w.w = cvt_pk_bf16(b[2], b[3]); return w; }

template <int mode>
struct EpiStore {
    static constexpr bool MIDK = false;
    bf16* O; int ldc; const float* cs; float scale; bool skip = false;
    __device__ __forceinline__ void prep(const Unit&, int, int, int, int) {}
    __device__ __forceinline__ void midk(Acc&) {}
    __device__ __forceinline__ void operator()(const Acc& acc, const Unit& u, int wr, int wc, int fr, int fq) const {
        asm volatile("" : "+v"(fr), "+v"(fq));
        if (skip) return;
        size_t base; const float* csp = cs;
        if constexpr (mode == 0) base = (size_t)u.pm * 256 * ldc + (size_t)u.pn * 256;
        else if constexpr (mode == 1) { const int lb = u.pm >> 2, h = u.pm & 3; base = (size_t)lb * D * D + (size_t)(h * 256) * D + u.pn * 256; csp = cs + (size_t)(lb >> 2) * D + u.pn * 256; }
        else if constexpr (mode == 2) { const int pml = u.pm & 3, lbh = u.pm >> 2, h = lbh & 3, lb = lbh >> 2; base = (size_t)lb * D * D + (size_t)(pml * 256) * D + h * 256; }
        else { const int l = u.pm >> 2, pml = u.pm & 3; base = (size_t)l * NMEM * 2 * D + (size_t)(pml * 256) * 2 * D + u.pn * 256; }
        const int cb = wc * 32 + 8 * fq;
        f32x4 c0[2], c1[2];
#pragma unroll
        for (int bj = 0; bj < 2; ++bj) { if (csp) { c0[bj] = *(const f32x4*)(csp + bj * HALF + cb) * scale; c1[bj] = *(const f32x4*)(csp + bj * HALF + cb + 4) * scale; } else { c0[bj] = (f32x4){scale, scale, scale, scale}; c1[bj] = c0[bj]; } }
#pragma unroll
        EPI_ROWS { bf16* rowp = O + base + (size_t)(ai * HALF + wr * 64 + m * 16 + fr) * ldc + cb;
#pragma unroll
            for (int bj = 0; bj < 2; ++bj) { const v4u w_ = pack8(acc[ai][bj][m][0] * c0[bj], acc[ai][bj][m][1] * c1[bj]); if constexpr (mode == 0 && NT_Y) __builtin_nontemporal_store(w_, (v4u*)(rowp + bj * HALF)); else *(v4u*)(rowp + bj * HALF) = w_; } }
    }
};
struct EpiH {
    static constexpr bool MIDK = false;
    unsigned char* H;
    __device__ __forceinline__ void prep(const Unit&, int, int, int, int) {}
    __device__ __forceinline__ void midk(Acc&) {}
    __device__ __forceinline__ void operator()(const Acc& acc, const Unit& u, int wr, int wc, int fr, int fq) const {
        asm volatile("" : "+v"(fr), "+v"(fq));
        const int cb = u.pn * 128 + wc * 32 + 8 * fq; constexpr float us = 1.0f / (W8S * A8S);
#pragma unroll
        EPI_ROWS { const int rl = ai * HALF + wr * 64 + m * 16 + fr; unsigned char* rowp = H + (size_t)(u.pm * 256 + rl) * FF + cb;
            f32x4 h0, h1;
#pragma unroll
            for (int i = 0; i < 4; ++i) { h0[i] = silu_f(acc[ai][0][m][0][i] * us) * (acc[ai][1][m][0][i] * (us * H8S)); h1[i] = silu_f(acc[ai][0][m][1][i] * us) * (acc[ai][1][m][1][i] * (us * H8S)); }
            v2u o; o.x = pk4_fp8(h0[0], h0[1], h0[2], h0[3]); o.y = pk4_fp8(h1[0], h1[1], h1[2], h1[3]); *(v2u*)rowp = o; }
    }
};
template <bool MK, bool WRITE_XB>
struct EpiX {
    static constexpr bool MIDK = MK;
    bf16* xr; float* xstat; const float* gmstat; const float* atstat; LAS unsigned char* lds;
    int wr_, wc_, fr_;
    __device__ __forceinline__ void prep(const Unit& u, int wr, int wc, int fr, int fq) {
        wr_ = wr; wc_ = wc; fr_ = fr;
        if constexpr (MK) {
            asm volatile("" : "+v"(fr), "+v"(fq));
            LAS f32x2* X = (LAS f32x2*)(lds + RING_BYTES + 1024) + (wr * 4 + wc) * 128;
#pragma unroll
            EPI_ROWS { const size_t row = (size_t)u.pm * 256 + ai * HALF + wr * 64 + m * 16 + fr;
                const f32x4 g = *(const f32x4*)(gmstat + row * 4), a0 = *(const f32x4*)(atstat + row * 8), a1 = *(const f32x4*)(atstat + row * 8 + 4);
                const float sg = (g[0] + g[1]) + (g[2] + g[3]), sa = ((a0[0] + a0[1]) + (a0[2] + a0[3])) + ((a1[0] + a1[1]) + (a1[2] + a1[3]));
                const float rgm = __builtin_amdgcn_rsqf(sg * (1.0f / 512.0f) + EPS), rat = __builtin_amdgcn_rsqf(sa * (1.0f / 512.0f) + EPS);
                if (fq == 0) X[(ai * 4 + m) * 16 + fr] = (f32x2){rgm / rat, rat}; }
            asm volatile("s_waitcnt lgkmcnt(0)" ::: "memory");
        }
    }
    __device__ __forceinline__ void midk(Acc& acc) {
        int fr = fr_; asm volatile("" : "+v"(fr));
        const LAS f32x2* X = (const LAS f32x2*)(lds + RING_BYTES + 1024) + (wr_ * 4 + wc_) * 128;
#pragma unroll
        EPI_ROWS { const float f = X[(ai * 4 + m) * 16 + fr].x;
#pragma unroll
            for (int bj = 0; bj < 2; ++bj) { acc[ai][bj][m][0] *= f; acc[ai][bj][m][1] *= f; } }
    }
    __device__ __forceinline__ void operator()(const Acc& acc, const Unit& u, int wr, int wc, int fr, int fq) const {
        asm volatile("" : "+v"(fr), "+v"(fq));
        const int cb = u.pn * 256 + wc * 32 + 8 * fq;
#pragma unroll
        EPI_ROWS { const size_t row = (size_t)u.pm * 256 + ai * HALF + wr * 64 + m * 16 + fr; const size_t off = row * D + cb;
            float f = 1.0f; if constexpr (MK) f = ((const LAS f32x2*)(lds + RING_BYTES + 1024) + (wr * 4 + wc) * 128)[(ai * 4 + m) * 16 + fr].y; float ss = 0.f;
#pragma unroll
            for (int bj = 0; bj < 2; ++bj) { const v4u b = *(const v4u*)(xr + off + bj * HALF);
                const f32x4 x0 = (f32x4){bflo(b.x), bfhi(b.x), bflo(b.y), bfhi(b.y)} + acc[ai][bj][m][0] * f, x1 = (f32x4){bflo(b.z), bfhi(b.z), bflo(b.w), bfhi(b.w)} + acc[ai][bj][m][1] * f;
                *(v4u*)(xr + off + bj * HALF) = pack8(x0, x1);
                if constexpr (WRITE_XB) ss += ((x0[0] * x0[0] + x0[1] * x0[1]) + (x0[2] * x0[2] + x0[3] * x0[3])) + ((x1[0] * x1[0] + x1[1] * x1[1]) + (x1[2] * x1[2] + x1[3] * x1[3])); }
            if constexpr (WRITE_XB) { ss = add_x32(add_x16(ss)); if (fq == 0) xstat[row * 16 + u.pn * 4 + wc] = ss; }
            if (m & 1) asm volatile("" ::: "memory"); }
    }
};
constexpr int EXCH_OFF = RING_BYTES + 1024;
struct EpiS {
    static constexpr bool MIDK = false;
    const float* xstat; bf16* P; LAS unsigned char* lds;
    __device__ __forceinline__ void prep(const Unit&, int, int, int, int) {}
    __device__ __forceinline__ void midk(Acc&) {}
    __device__ __forceinline__ void operator()(Acc& acc, const Unit& u, int wr, int wc, int fr, int fq) const {
        asm volatile("" : "+v"(fr), "+v"(fq));
        LAS f32x2* X = (LAS f32x2*)(lds + EXCH_OFF);
        float mw[2][4];
#pragma unroll
        EPI_ROWS { const int rl = ai * HALF + wr * 64 + m * 16 + fr; const size_t row = (size_t)u.pm * 256 + rl;
            const f32x4 s0 = *(const f32x4*)(xstat + row * 16), s1 = *(const f32x4*)(xstat + row * 16 + 4), s2 = *(const f32x4*)(xstat + row * 16 + 8), s3 = *(const f32x4*)(xstat + row * 16 + 12);
            const float ssq = (((s0[0] + s0[1]) + (s0[2] + s0[3])) + ((s1[0] + s1[1]) + (s1[2] + s1[3]))) + (((s2[0] + s2[1]) + (s2[2] + s2[3])) + ((s3[0] + s3[1]) + (s3[2] + s3[3])));
            const float rinv = __builtin_amdgcn_rsqf(ssq * (1.0f / D) + EPS);
            float mx = -3.0e38f;
#pragma unroll
            for (int bj = 0; bj < 2; ++bj)
#pragma unroll
                for (int n = 0; n < 2; ++n) { acc[ai][bj][m][n] *= rinv; const f32x4 v = acc[ai][bj][m][n]; mx = fmaxf(mx, fmaxf(fmaxf(v[0], v[1]), fmaxf(v[2], v[3]))); }
            mx = max_x32(max_x16(mx));
            float sm = 0.f;
#pragma unroll
            for (int bj = 0; bj < 2; ++bj)
#pragma unroll
                for (int n = 0; n < 2; ++n) { f32x4 v = acc[ai][bj][m][n];
#pragma unroll
                    for (int i = 0; i < 4; ++i) { v[i] = __builtin_amdgcn_exp2f(v[i] - mx); sm += v[i]; }
                    acc[ai][bj][m][n] = v; }
            sm = add_x32(add_x16(sm));
            mw[ai][m] = mx;
            if (fq == 0) X[rl * 4 + wc] = (f32x2){mx, sm};
            if (m & 1) asm volatile("" ::: "memory"); }
        asm volatile("s_waitcnt lgkmcnt(0)\n\ts_barrier" ::: "memory");
        const int cb = u.pn * 256 + wc * 32 + 8 * fq;
#pragma unroll
        EPI_ROWS { const int rl = ai * HALF + wr * 64 + m * 16 + fr; const size_t row = (size_t)u.pm * 256 + rl;
            const f32x2 e0 = X[rl * 4 + 0], e1 = X[rl * 4 + 1], e2 = X[rl * 4 + 2], e3 = X[rl * 4 + 3];
            const float M = fmaxf(fmaxf(e0.x, e1.x), fmaxf(e2.x, e3.x));
            const float den = (e0.y * __builtin_amdgcn_exp2f(e0.x - M) + e1.y * __builtin_amdgcn_exp2f(e1.x - M)) + (e2.y * __builtin_amdgcn_exp2f(e2.x - M) + e3.y * __builtin_amdgcn_exp2f(e3.x - M));
            const float f = __builtin_amdgcn_exp2f(mw[ai][m] - M) / den;
#pragma unroll
            for (int bj = 0; bj < 2; ++bj) st16(P + row * D + cb + bj * HALF, pack8(acc[ai][bj][m][0] * f, acc[ai][bj][m][1] * f)); }
        asm volatile("s_waitcnt lgkmcnt(0)" ::: "memory");
    }
};
struct EpiIn {
    static constexpr bool MIDK = false;
    bf16 *uact, *vact, *q, *k, *v; float* vstat; const float *qg, *kg, *cosT, *sinT, *rinv;
    __device__ __forceinline__ void prep(const Unit&, int, int, int, int) {}
    __device__ __forceinline__ void midk(Acc&) {}
    __device__ __forceinline__ void operator()(const Acc& acc, const Unit& u, int wr, int wc, int fr, int fq) const {
        asm volatile("" : "+v"(fr), "+v"(fq));
        const int pn = u.pn;
        if (pn < 4) {
            bf16* O = pn < 2 ? uact : vact; const int cb = (pn & 1) * 256 + wc * 32 + 8 * fq;
#pragma unroll
            EPI_ROWS { const size_t row = (size_t)u.pm * 256 + ai * HALF + wr * 64 + m * 16 + fr; float ss = 0.f; const float ri = rinv[row];
#pragma unroll
                for (int bj = 0; bj < 2; ++bj) { f32x4 g0, g1;
#pragma unroll
                    for (int i = 0; i < 4; ++i) { g0[i] = gelu_tanh(acc[ai][bj][m][0][i] * ri); g1[i] = gelu_tanh(acc[ai][bj][m][1][i] * ri); }
                    const v4u w = pack8(g0, g1); st16(O + row * GMW + cb + bj * HALF, w);
                    if (pn >= 2) { const float a0 = bflo(w.x), a1 = bfhi(w.x), a2 = bflo(w.y), a3 = bfhi(w.y), a4 = bflo(w.z), a5 = bfhi(w.z), a6 = bflo(w.w), a7 = bfhi(w.w);
                        ss += ((a0 * a0 + a1 * a1) + (a2 * a2 + a3 * a3)) + ((a4 * a4 + a5 * a5) + (a6 * a6 + a7 * a7)); } }
                if (pn >= 2) { ss = add_x32(add_x16(ss)); if (fq == 0) vstat[row * 8 + (pn - 2) * 4 + wc] = ss; } }
        } else if (pn == 6 && wc >= 2) {
#pragma unroll
            EPI_ROWS { const size_t row = (size_t)u.pm * 256 + ai * HALF + wr * 64 + m * 16 + fr; const float ri = rinv[row];
#pragma unroll
                for (int bj = 0; bj < 2; ++bj) st16(v + row * 128 + (wc - 2) * 64 + bj * 32 + 8 * fq, pack8(acc[ai][bj][m][0] * ri, acc[ai][bj][m][1] * ri)); }
        } else {
            const bool isq = pn < 6; const float* g = isq ? qg : kg; const float sc = isq ? QSCALE : 1.0f;
            bf16* O = isq ? q + ((pn - 4) * 4 + wc) * 64 : k + wc * 64; const int ldo = isq ? 512 : 128;
            f32x4 gv[2][2];
#pragma unroll
            for (int bj = 0; bj < 2; ++bj) { gv[bj][0] = *(const f32x4*)(g + bj * 32 + 8 * fq) * sc; gv[bj][1] = *(const f32x4*)(g + bj * 32 + 8 * fq + 4) * sc; }
#pragma unroll
            EPI_ROWS { const size_t row = (size_t)u.pm * 256 + ai * HALF + wr * 64 + m * 16 + fr; const int t = (int)(row % SEQ); const float ri = this->rinv[row];
                float ss = 0.f;
#pragma unroll
                for (int bj = 0; bj < 2; ++bj)
#pragma unroll
                    for (int n = 0; n < 2; ++n) { const f32x4 x = acc[ai][bj][m][n]; ss += (x[0] * x[0] + x[1] * x[1]) + (x[2] * x[2] + x[3] * x[3]); }
                ss = add_x32(add_x16(ss));
                const float rinv = ri * __builtin_amdgcn_rsqf(ss * (ri * ri) * (1.0f / 64.0f) + EPS);
#pragma unroll
                for (int bj = 0; bj < 2; ++bj) { const f32x4 c = *(const f32x4*)(cosT + t * 32 + bj * 16 + 4 * fq), sn = *(const f32x4*)(sinT + t * 32 + bj * 16 + 4 * fq);
                    const f32x4 x0 = acc[ai][bj][m][0] * gv[bj][0] * rinv, x1 = acc[ai][bj][m][1] * gv[bj][1] * rinv; f32x4 o0, o1;
                    o0[0] = x0[0] * c[0] - x0[1] * sn[0]; o0[1] = x0[0] * sn[0] + x0[1] * c[0]; o0[2] = x0[2] * c[1] - x0[3] * sn[1]; o0[3] = x0[2] * sn[1] + x0[3] * c[1];
                    o1[0] = x1[0] * c[2] - x1[1] * sn[2]; o1[1] = x1[0] * sn[2] + x1[1] * c[2]; o1[2] = x1[2] * c[3] - x1[3] * sn[3]; o1[3] = x1[2] * sn[3] + x1[3] * c[3];
                    st16(O + row * ldo + bj * 32 + 8 * fq, pack8(o0, o1)); }
                if (m & 1) asm volatile("" ::: "memory"); }
        }
    }
};
}


struct CvtJob { const float* W; const float* gain; bf16* WT; int K, N, dst_row0, k0, n0; bool f8; };
__device__ __forceinline__ CvtJob cvt_decode(const Frame& F, int it) {
    constexpr int I_IN = 16 * 56, I_SQ = 512, I_KV = 1024, I_HEAD = I_IN + I_SQ + I_KV + I_SQ, I_LAYER = I_HEAD + NE * 3 * I_SQ;
    CvtJob j; j.f8 = false; const int l = it / I_LAYER; int r = it % I_LAYER;
    if (r < I_IN) { const int kb = r / 56, nb = r % 56, n0 = nb * 32, pn = n0 >> 8; int dr = n0;
        if (pn >= 4) { const int sidx = n0 & 255, w = sidx >> 6, bj = (sidx >> 5) & 1; dr = pn * 256 + 128 * bj + 32 * w; }
        j.W = F.in[3] + (size_t)l * D * INW; j.gain = F.in[2] + (size_t)l * D; j.WT = (bf16*)(F.ws + WS_WIN) + (size_t)l * INW * D; j.K = D; j.N = INW; j.dst_row0 = dr; j.k0 = kb * 64; j.n0 = n0; return j; }
    r -= I_IN;
    if (r < I_SQ) { j.W = F.in[10] + (size_t)l * D * D; j.gain = F.in[9] + (size_t)l * D; j.WT = (bf16*)(F.ws + WS_WOUT) + (size_t)l * D * D; j.K = D; j.N = D; j.dst_row0 = (r % 32) * 32; j.k0 = (r / 32) * 64; j.n0 = (r % 32) * 32; return j; }
    r -= I_SQ;
    if (r < I_KV) { j.W = F.in[14] + (size_t)l * D * 2 * D; j.gain = nullptr; j.WT = (bf16*)(F.ws + WS_WKVT) + (size_t)l * 2 * D * D; j.K = D; j.N = 2 * D; j.dst_row0 = (r % 64) * 32; j.k0 = (r / 64) * 64; j.n0 = (r % 64) * 32; return j; }
    r -= I_KV;
    if (r < I_SQ) { j.W = F.in[15] + (size_t)l * D * D; j.gain = nullptr; j.WT = (bf16*)(F.ws + WS_WOT) + (size_t)l * D * D; j.K = D; j.N = D; j.dst_row0 = (r % 32) * 32; j.k0 = (r / 32) * 64; j.n0 = (r % 32) * 32; return j; }
    r -= I_SQ;
    const int e = r / (3 * I_SQ), rr = r % (3 * I_SQ), which = rr / I_SQ, sub = rr % I_SQ, kb = sub / 32, n0 = (sub % 32) * 32;
    const size_t mo = ((size_t)l * NE + e) * D * FF;
    j.K = D; j.N = FF; j.k0 = kb * 64; j.n0 = n0;
    j.f8 = true;
    if (which == 2) { j.W = F.in[20] + mo; j.gain = nullptr; j.WT = (bf16*)(F.ws + WS_WD + mo); j.dst_row0 = n0; }
    else { j.W = (which == 0 ? F.in[18] : F.in[19]) + mo; j.gain = F.in[16] + (size_t)l * D; j.WT = (bf16*)(F.ws + WS_WGU + 2 * mo); j.dst_row0 = 256 * (n0 >> 7) + 128 * which + (n0 & 127); }
    return j;
}
#define CVT_LOAD(J, R) do { const float* p_ = (J).W + (size_t)((J).k0 + (lane_ >> 5)) * (J).N + (J).n0 + (lane_ & 31); _Pragma("unroll") for (int i_ = 0; i_ < 32; ++i_) R[i_] = p_[(size_t)(2 * i_) * (J).N]; } while (0)
__device__ __forceinline__ void ph_convert(Frame& F) {
    int lane_ = lane_id(); asm volatile("" : "+v"(lane_)); const int tid_ = F.wave * 64 + lane_;
    LAS float* scr = (LAS float*)(F.lds + F.wave * 16384);
    const int gw = F.vcu * NWAVES + F.wave, NGW = F.G * NWAVES;
    constexpr int I_LAYER = 16 * 56 + 512 + 1024 + 512 + NE * 3 * 512, NITEMS = NL * I_LAYER;
    if (gw < NITEMS) {
        int it = gw; CvtJob cur = cvt_decode(F, it); float r[32]; CVT_LOAD(cur, r);
        for (;;) {
            const int nit = it + NGW; const bool hn = nit < NITEMS; CvtJob nx = cur; if (hn) nx = cvt_decode(F, nit);
#pragma unroll
            for (int i = 0; i < 32; ++i) scr[(2 * i + (lane_ >> 5)) * 33 + (lane_ & 31)] = r[i];
            if (hn) CVT_LOAD(nx, r);
            asm volatile("s_waitcnt lgkmcnt(0)" ::: "memory");
            const int c = lane_ & 7;
            f32x4 g0 = (f32x4){1.f, 1.f, 1.f, 1.f}, g1 = g0;
            if (cur.gain) { g0 = *(const f32x4*)(cur.gain + cur.k0 + 8 * c); g1 = *(const f32x4*)(cur.gain + cur.k0 + 8 * c + 4); }
#pragma unroll
            for (int j = 0; j < 4; ++j) { const int n = (lane_ >> 3) + 8 * j; const LAS float* sp = scr + (8 * c) * 33 + n;
                if (cur.f8) { v2u o; o.x = pk4_fp8(sp[0 * 33] * g0[0] * W8S, sp[1 * 33] * g0[1] * W8S, sp[2 * 33] * g0[2] * W8S, sp[3 * 33] * g0[3] * W8S); o.y = pk4_fp8(sp[4 * 33] * g1[0] * W8S, sp[5 * 33] * g1[1] * W8S, sp[6 * 33] * g1[2] * W8S, sp[7 * 33] * g1[3] * W8S);
                    *(v2u*)((unsigned char*)cur.WT + (size_t)(cur.dst_row0 + n) * cur.K + cur.k0 + 8 * c) = o; }
                else { v4u o; o.x = pk2(sp[0 * 33] * g0[0], sp[1 * 33] * g0[1]); o.y = pk2(sp[2 * 33] * g0[2], sp[3 * 33] * g0[3]); o.z = pk2(sp[4 * 33] * g1[0], sp[5 * 33] * g1[1]); o.w = pk2(sp[6 * 33] * g1[2], sp[7 * 33] * g1[3]);
                    *(v4u*)(cur.WT + (size_t)(cur.dst_row0 + n) * cur.K + cur.k0 + 8 * c) = o; } }
            asm volatile("s_waitcnt lgkmcnt(0)" ::: "memory");
            if (!hn) break; cur = nx; it = nit;
        }
    }
    {   const float* wsrc = F.in[5]; bf16* WSBd = (bf16*)(F.ws + WS_WSB);
        for (int i = F.vcu * NTHR + tid_; i < NL * 4 * 128 * 128 / 8; i += F.G * NTHR) { const f32x4 a = *(const f32x4*)(wsrc + (size_t)i * 8), b = *(const f32x4*)(wsrc + (size_t)i * 8 + 4);
            v4u o; o.x = pk2(a.x, a.y); o.y = pk2(a.z, a.w); o.z = pk2(b.x, b.y); o.w = pk2(b.z, b.w); *(v4u*)(WSBd + (size_t)i * 8) = o; } }
    const int gt = F.vcu * NTHR + tid_, NGT = F.G * NTHR;
    const float* wq = F.in[13]; bf16* WQB = (bf16*)(F.ws + WS_WQB);
    for (int i = gt; i < NL * D * D / 8; i += NGT) { const f32x4 a = *(const f32x4*)(wq + (size_t)i * 8), b = *(const f32x4*)(wq + (size_t)i * 8 + 4);
        v4u o; o.x = pk2(a.x, a.y); o.y = pk2(a.z, a.w); o.z = pk2(b.x, b.y); o.w = pk2(b.z, b.w); *(v4u*)(WQB + (size_t)i * 8) = o; }
}

struct SchedDense {
    pg8::TileOrder o; const char* A; size_t a_tile; const char* B; size_t b_tile, b_batch; int bdiv, bmod;
    __device__ __forceinline__ bool next(int i, pg8::Unit& u) const { if (!o.tile(i, u.pm, u.pn)) return false;
        u.z = 0; u.gi = nullptr; u.grow = 0; u.a = A + (size_t)u.pm * a_tile; u.b = B + (size_t)((u.pm / bdiv) % bmod) * b_batch + (size_t)u.pn * b_tile; return true; }
};
struct SchedE1 {
    pg8::TileOrder o; const char* HBp; const int* IDX; const char* WGU;
    __device__ __forceinline__ bool next(int i, pg8::Unit& u) const { if (!o.tile(i, u.pm, u.pn)) return false;
        const int z = u.pm >> 2; u.z = z; u.gi = IDX + (size_t)u.pm * 256; u.grow = (z >> 4) * SEQ; u.a = HBp;
        u.b = WGU + (size_t)(z & 15) * (2 * FF * D) + (size_t)u.pn * (256 * D); return true; }
};
struct SchedKV { pg8::TileOrder o; const char* MEMN; const char* WKVT;
    __device__ __forceinline__ bool next(int i, pg8::Unit& u) const { if (!o.tile(i, u.pm, u.pn)) return false; u.z = 0; u.gi = nullptr; u.grow = 0;
        u.a = MEMN + (size_t)(u.pm & 3) * (256 * D * 2); u.b = WKVT + (size_t)(u.pm >> 2) * (2 * D * D * 2) + (size_t)u.pn * (256 * D * 2); return true; } };
struct SchedQK { pg8::TileOrder o; const char* KVM; const char* WQB;
    __device__ __forceinline__ bool next(int i, pg8::Unit& u) const { if (!o.tile(i, u.pm, u.pn)) return false; u.z = 0; u.gi = nullptr; u.grow = 0;
        const int h = u.pm & 3, lb = u.pm >> 2, b = lb & 3, l = lb >> 2;
        u.a = KVM + ((size_t)l * NMEM * 2 * D + (size_t)(b * 256) * 2 * D + h * 256) * 2; u.b = WQB + ((size_t)l * D * D + (size_t)u.pn * 256 * D + h * 256) * 2; return true; } };
struct SchedVO { pg8::TileOrder o; const char* KVM; const char* WOT;
    __device__ __forceinline__ bool next(int i, pg8::Unit& u) const { if (!o.tile(i, u.pm, u.pn)) return false; u.z = 0; u.gi = nullptr; u.grow = 0;
        const int pml = u.pm & 3, lbh = u.pm >> 2, h = lbh & 3, lb = lbh >> 2, b = lb & 3, l = lb >> 2;
        u.a = WOT + ((size_t)l * D * D + (size_t)pml * 256 * D + h * 256) * 2; u.b = KVM + ((size_t)l * NMEM * 2 * D + (size_t)(b * 256) * 2 * D + D + h * 256) * 2; return true; } };

namespace attn_body {
using bf16=__hip_bfloat16;
using bf16x8=__attribute__((ext_vector_type(8)))short;
using s16x4=__attribute__((ext_vector_type(4)))short;
using f32x16=__attribute__((ext_vector_type(16)))float;
using u32x4=__attribute__((ext_vector_type(4)))unsigned;
constexpr int SEQ=8192,D=64,QP=512,KP=128,OP=1024;
constexpr int NW=8,QBLK=32,QB=QBLK*NW,KVBLK=64,NQB=SEQ/QB;
constexpr int ATTN_UNIT_ROWS=QB;
__device__ __forceinline__ int crow(int r,int hi){return (r&3)+8*(r>>2)+4*hi;}
#define SBAR() __builtin_amdgcn_sched_barrier(0)
__device__ __forceinline__ void cmask(f32x16&p0,f32x16&p1,int jb,int qrel,int hi){
  const float NEG=-INFINITY; int kb=64*jb+4*hi;
  #pragma unroll
  for(int r=0;r<16;++r){int kv=kb+(r&3)+8*(r>>2); if(kv>qrel)p0[r]=NEG; if(kv+32>qrel)p1[r]=NEG;}
}

constexpr int NSLOT=3, SLOTB=8192;
constexpr int LDS_K=0, LDS_V=NSLOT*SLOTB, LDS_WS=2*NSLOT*SLOTB, LDS_OST=LDS_WS+NW*64*4, LDS_BYTES=LDS_OST+NW*4096;
constexpr float C2=0.125f*1.4426950408889634f;
__device__ __forceinline__ void glds16(const void*gsrc,unsigned lds_dst){unsigned keep;
  asm volatile("s_mov_b32 %0, m0\n\ts_mov_b32 m0, %2\n\ts_nop 0\n\tglobal_load_lds_dwordx4 %1, off\n\ts_mov_b32 m0, %0":"=&s"(keep):"v"(gsrc),"s"(lds_dst):"memory");}
__device__ __forceinline__ float max3f(float a,float b,float c){float r;asm("v_max3_f32 %0, %1, %2, %3":"=v"(r):"v"(a),"v"(b),"v"(c));return r;}
__device__ __forceinline__ float max2f(float a,float b){float r;asm("v_max_f32_e32 %0, %1, %2":"=v"(r):"v"(a),"v"(b));return r;}
__device__ __forceinline__ float fadd_s(float a,float b){float r;asm("v_add_f32_e32 %0, %1, %2":"=v"(r):"v"(a),"v"(b));return r;}
__device__ __forceinline__ float fsub_s(float a,float b){float r;asm("v_sub_f32_e32 %0, %1, %2":"=v"(r):"v"(a),"v"(b));return r;}
typedef float f32x2_t __attribute__((ext_vector_type(2))); typedef __bf16 bf16x2_t __attribute__((ext_vector_type(2)));
__device__ __forceinline__ unsigned cvtpk_s(float lo,float hi){f32x2_t v={lo,hi};bf16x2_t b=__builtin_convertvector(v,bf16x2_t);return __builtin_bit_cast(unsigned,b);}
#define WAIT_BAR(N) asm volatile("s_waitcnt vmcnt(" #N ") lgkmcnt(0)\n\ts_barrier":::"memory")

__device__ __forceinline__ void qkt(f32x16&p0,f32x16&p1,const char*Kslot,const bf16x8*qr,const f32x16&negm,int r32,int hi){
  const char*kb=Kslot+hi*1024+r32*16;
  #pragma unroll
  for(int d0=0;d0<4;++d0){
    const bf16x8 b0=*reinterpret_cast<const bf16x8*>(kb+d0*2048);
    const bf16x8 b1=*reinterpret_cast<const bf16x8*>(kb+d0*2048+512);
    if(d0==0){p0=__builtin_amdgcn_mfma_f32_32x32x16_bf16(b0,qr[0],negm,0,0,0);p1=__builtin_amdgcn_mfma_f32_32x32x16_bf16(b1,qr[0],negm,0,0,0);}
    else{p0=__builtin_amdgcn_mfma_f32_32x32x16_bf16(b0,qr[d0],p0,0,0,0);p1=__builtin_amdgcn_mfma_f32_32x32x16_bf16(b1,qr[d0],p1,0,0,0);}}
}
typedef __attribute__((address_space(3))) const char* lds_cptr;
typedef short v4i16_t __attribute__((ext_vector_type(4)));
__device__ __forceinline__ void kload8(bf16x8*kf,lds_cptr kp){
  kf[0]=*(const __attribute__((address_space(3))) bf16x8*)(kp);      kf[1]=*(const __attribute__((address_space(3))) bf16x8*)(kp+512);
  kf[2]=*(const __attribute__((address_space(3))) bf16x8*)(kp+2048); kf[3]=*(const __attribute__((address_space(3))) bf16x8*)(kp+2560);
  kf[4]=*(const __attribute__((address_space(3))) bf16x8*)(kp+4096); kf[5]=*(const __attribute__((address_space(3))) bf16x8*)(kp+4608);
  kf[6]=*(const __attribute__((address_space(3))) bf16x8*)(kp+6144); kf[7]=*(const __attribute__((address_space(3))) bf16x8*)(kp+6656);
}
__device__ __forceinline__ void kload2(bf16x8*kf,lds_cptr kp,int j){ kf[2*j]=*(const __attribute__((address_space(3))) bf16x8*)(kp+j*2048); kf[2*j+1]=*(const __attribute__((address_space(3))) bf16x8*)(kp+j*2048+512); }
__device__ __forceinline__ s16x4 vtr(lds_cptr p){ return __builtin_bit_cast(s16x4,__builtin_amdgcn_ds_read_tr16_b64_v4i16((__attribute__((address_space(3))) v4i16_t*)p)); }
__device__ __forceinline__ float rowmax(const f32x16&p0,const f32x16&p1){
  float a=max3f(p0[0],p0[1],p1[0]),b=max3f(p0[2],p0[3],p1[1]);a=max3f(a,p1[2],p1[3]);
  #pragma unroll
  for(int r=4;r<16;r+=4){a=max3f(a,p0[r],p0[r+1]);b=max3f(b,p0[r+2],p0[r+3]);a=max3f(a,p1[r],p1[r+1]);b=max3f(b,p1[r+2],p1[r+3]);}
  const float m=max2f(a,b);
  auto rr=__builtin_amdgcn_permlane32_swap(__float_as_uint(m),__float_as_uint(m),false,false);
  return max2f(__uint_as_float(rr[0]),__uint_as_float(rr[1]));
}
__device__ __forceinline__ void pv(f32x16*o,int vb,bf16x8 pa0,bf16x8 pa1,bf16x8 pa2,bf16x8 pa3){
  #pragma unroll
  for(int d0=0;d0<2;++d0){s16x4 lo[4],hi[4];
    #pragma unroll
    for(int ks=0;ks<4;++ks){
      asm volatile("ds_read_b64_tr_b16 %0,%1 offset:%c2":"=&v"(lo[ks]):"v"(vb),"i"(d0*4096+ks*1024):"memory");
      asm volatile("ds_read_b64_tr_b16 %0,%1 offset:%c2":"=&v"(hi[ks]):"v"(vb),"i"(d0*4096+ks*1024+512):"memory");}
    asm volatile("s_waitcnt lgkmcnt(0)":::"memory");SBAR();
    #define PK(k) (bf16x8){lo[k][0],lo[k][1],lo[k][2],lo[k][3],hi[k][0],hi[k][1],hi[k][2],hi[k][3]}
    o[d0]=__builtin_amdgcn_mfma_f32_32x32x16_bf16(pa0,PK(0),o[d0],0,0,0);
    o[d0]=__builtin_amdgcn_mfma_f32_32x32x16_bf16(pa1,PK(1),o[d0],0,0,0);
    o[d0]=__builtin_amdgcn_mfma_f32_32x32x16_bf16(pa2,PK(2),o[d0],0,0,0);
    o[d0]=__builtin_amdgcn_mfma_f32_32x32x16_bf16(pa3,PK(3),o[d0],0,0,0);
    #undef PK
  }
}

#ifndef ATTN_STORE16
#define ATTN_STORE16(p,v) (*(u32x4*)(p)=(v))
#endif
template<int THRL> __device__ __forceinline__ void attn_unit(int b,int h,int qb,const bf16*Q,const bf16*__restrict__ K,const bf16*__restrict__ V,bf16*O,float*ATS,char*shm,int wave_idx){
  int lane; asm volatile("v_mbcnt_lo_u32_b32 %0, -1, 0\n\tv_mbcnt_hi_u32_b32 %0, -1, %0":"=v"(lane)); const int r32=lane&31,hi=lane>>5; const int wid=wave_idx; const int kvh=h>>2;
  const long rowbase=(long)b*SEQ; const int q0=qb*QB;
  const bf16*Qw=Q+(rowbase+q0+wid*QBLK)*QP+h*D;
  const bf16*Kh=K+rowbase*KP+kvh*D,*Vh=V+rowbase*KP+kvh*D;
  const unsigned lds0=(unsigned)(uintptr_t)shm;
  float*wsf=(float*)(shm+LDS_WS)+wid*64;
  const bf16*ksrc=Kh+(long)lane*KP+wid*8;
  const bf16*vsrc=Vh+(long)(16*(wid&3)+(lane>>2))*KP+(wid>>2)*32+(lane&3)*8;
  const unsigned kdst=lds0+LDS_K+wid*1024, vdst=lds0+LDS_V+wid*1024;
  #define DMA_K(t,slot) glds16(ksrc+(long)(t)*KVBLK*KP,(unsigned)__builtin_amdgcn_readfirstlane(kdst+(slot)))
  #define DMA_V(t,slot) glds16(vsrc+(long)(t)*KVBLK*KP,(unsigned)__builtin_amdgcn_readfirstlane(vdst+(slot)))
  const int vb0=(int)(lds0+LDS_V)+((lane>>4)&1)*32+(lane&3)*8+(4*hi+((lane&15)>>2))*64;
  const char*Kbase=shm+LDS_K; bf16x8 kf[8];
  const lds_cptr shm3=(lds_cptr)shm; const lds_cptr kp0=shm3+LDS_K+hi*1024+r32*16; const lds_cptr vp0=shm3+LDS_V+((lane>>4)&1)*32+(lane&3)*8+(4*hi+((lane&15)>>2))*64;
  const int NT=SEQ/KVBLK;
  DMA_K(0,0);DMA_V(0,0);DMA_K(1,SLOTB);
  bf16x8 qr[4];
  #pragma unroll
  for(int d0=0;d0<4;++d0)qr[d0]=*reinterpret_cast<const bf16x8*>(&Qw[(long)r32*QP+d0*16+hi*8]);
  float mhat=0.f,l_reg=0.f;f32x16 o[2];o[0]=f32x16{};o[1]=f32x16{};f32x16 negm=f32x16{};asm volatile("":"+v"(negm));
  const int qrel=wid*QBLK+r32;
  #define CMASK(P0,P1,t) do{}while(0)
  bool resc=false;
  #define START(P0,P1) do{ const float rm=rowmax(P0,P1); resc=false; \
    { const float dl=rm; mhat=fadd_s(mhat,dl); \
      _Pragma("unroll") for(int r=0;r<16;++r){P0[r]=fsub_s(P0[r],dl);P1[r]=fsub_s(P1[r],dl);} \
      _Pragma("unroll") for(int r=0;r<16;++r)negm[r]=-mhat; asm volatile("":"+v"(negm)); } \
    _Pragma("unroll") for(int r=0;r<16;++r)P0[r]=__builtin_amdgcn_exp2f(P0[r]); }while(0)
  #define RESC() do{ if(resc){ asm volatile("s_waitcnt lgkmcnt(0)":::"memory"); \
      _Pragma("unroll") for(int d_=0;d_<2;++d_) _Pragma("unroll") for(int r=0;r<16;++r)o[d_][r]*=wsf[crow(r,hi)]; } }while(0)
  f32x16 pA0,pA1,pB0,pB1;
  int sl_prev=0,sl_cur=0,sl_next=SLOTB;
  #define ROT() do{sl_prev=sl_cur;sl_cur=sl_next;sl_next=(sl_next==(NSLOT-1)*SLOTB)?0:sl_next+SLOTB;}while(0)
  DMA_K(2,2*SLOTB);
  WAIT_BAR(3);
  qkt(pA0,pA1,Kbase,qr,negm,r32,hi);asm volatile("s_nop 15\n\ts_nop 7":"+v"(pA0),"+v"(pA1));CMASK(pA0,pA1,0);
  START(pA0,pA1);
  _Pragma("unroll") for(int r=0;r<16;++r)pA1[r]=__builtin_amdgcn_exp2f(pA1[r]);
  WAIT_BAR(0);
  DMA_K(3,0);DMA_V(1,SLOTB);
  ROT();
  kload8(kf,kp0+sl_cur);
  WAIT_BAR(2);
  s16x4 vlo[8],vhi[8]; u32x4 pw0,pw1,pw2,pw3;
  #define PKW(P,B) cvtpk_s(P[B],P[B+1])
  #define PAF(k) __builtin_bit_cast(bf16x8,pw##k)
  #define VFR(i) (bf16x8){vlo[i][0],vlo[i][1],vlo[i][2],vlo[i][3],vhi[i][0],vhi[i][1],vhi[i][2],vhi[i][3]}
  #define PIN(x) asm volatile("":"+v"(x))
  #define MX3(a,b,c) __builtin_fmaxf(__builtin_fmaxf((a),(b)),(c))
  #define GAPA(MF,A0,A1,A2,A3,W0,W1,PW) do{ MF; sacc+=A0; sacc+=A1; sacc+=A2; sacc+=A3; PIN(sacc); W0; W1; PIN(PW); SBAR(); }while(0)
  #define EX(v) __builtin_amdgcn_exp2f(v)
  #define GAPB(MF,X,B) do{ MF; X[B]=EX(X[B]); X[B+1]=EX(X[B+1]); X[B+2]=EX(X[B+2]); X[B+3]=EX(X[B+3]); PIN(X); SBAR(); }while(0)
  #define VRD(i) do{ vlo[i]=vtr(vp_+(((i)>>2)*4096+((i)&3)*1024)); vhi[i]=vtr(vp_+(((i)>>2)*4096+((i)&3)*1024+512)); }while(0)
  #define KRD(G,j) do{ if(G){ kload2(kf,kp0+sl_next,j); SBAR(); } }while(0)
  #define STEP(C0,C1,P0,P1,t,GK,GV,GL) do{ SBAR(); \
    const lds_cptr vp_=vp0+sl_prev; \
    VRD(0); SBAR(); float sacc=(P0[0]+P0[1]); \
    GAPA(C0=__builtin_amdgcn_mfma_f32_32x32x16_bf16(kf[0],qr[0],negm,0,0,0), P0[2],P0[3],P0[4],P0[5],     pw0[0]=PKW(P0,0), pw0[1]=PKW(P0,2), pw0); \
    VRD(4); SBAR(); GAPA(C1=__builtin_amdgcn_mfma_f32_32x32x16_bf16(kf[1],qr[0],negm,0,0,0), P0[6],P0[7],P0[8],P0[9],     pw0[2]=PKW(P0,4), pw0[3]=PKW(P0,6), pw0); \
    VRD(1); SBAR(); GAPA(C0=__builtin_amdgcn_mfma_f32_32x32x16_bf16(kf[2],qr[1],C0,0,0,0),   P0[10],P0[11],P0[12],P0[13], pw1[0]=PKW(P0,8), pw1[1]=PKW(P0,10), pw1); \
    VRD(5); SBAR(); GAPA(C1=__builtin_amdgcn_mfma_f32_32x32x16_bf16(kf[3],qr[1],C1,0,0,0),   P0[14],P0[15],P1[0],P1[1],   pw1[2]=PKW(P0,12),pw1[3]=PKW(P0,14), pw1); \
    VRD(2); SBAR(); GAPA(C0=__builtin_amdgcn_mfma_f32_32x32x16_bf16(kf[4],qr[2],C0,0,0,0),   P1[2],P1[3],P1[4],P1[5],     pw2[0]=PKW(P1,0), pw2[1]=PKW(P1,2), pw2); \
    VRD(6); SBAR(); GAPA(C1=__builtin_amdgcn_mfma_f32_32x32x16_bf16(kf[5],qr[2],C1,0,0,0),   P1[6],P1[7],P1[8],P1[9],     pw2[2]=PKW(P1,4), pw2[3]=PKW(P1,6), pw2); \
    VRD(3); SBAR(); GAPA(C0=__builtin_amdgcn_mfma_f32_32x32x16_bf16(kf[6],qr[3],C0,0,0,0),   P1[10],P1[11],P1[12],P1[13], pw3[0]=PKW(P1,8), pw3[1]=PKW(P1,10), pw3); \
    VRD(7); SBAR(); GAPA(C1=__builtin_amdgcn_mfma_f32_32x32x16_bf16(kf[7],qr[3],C1,0,0,0),   P1[14],P1[15],0.f,0.f,       pw3[2]=PKW(P1,12),pw3[3]=PKW(P1,14), pw3); \
    l_reg+=sacc; \
    if(GK){DMA_K((t)+3,sl_cur);} if(GV){DMA_V((t)+1,sl_next);} \
    CMASK(C0,C1,t); \
    { float a=MX3(C0[0],C0[1],C1[0]),b=MX3(C0[2],C0[3],C1[1]); a=MX3(a,C1[2],C1[3]); \
      _Pragma("unroll") for(int r=4;r<16;r+=4){a=MX3(a,C0[r],C0[r+1]);b=MX3(b,C0[r+2],C0[r+3]);a=MX3(a,C1[r],C1[r+1]);b=MX3(b,C1[r+2],C1[r+3]);} \
      float rm=__builtin_fmaxf(a,b); { auto rr=__builtin_amdgcn_permlane32_swap(__float_as_uint(rm),__float_as_uint(rm),false,false); rm=__builtin_fmaxf(__uint_as_float(rr[0]),__uint_as_float(rr[1])); } \
      resc=false; \
      if(__builtin_expect(__any(rm>(float)THRL),0)){ const float dl=__builtin_fmaxf(rm,0.f); mhat+=dl; \
        _Pragma("unroll") for(int r=0;r<16;++r){C0[r]-=dl;C1[r]-=dl;} \
        _Pragma("unroll") for(int r=0;r<16;++r)negm[r]=-mhat; asm volatile("":"+v"(negm)); \
        const float f=__builtin_amdgcn_exp2f(-dl); l_reg*=f; if(hi==0)wsf[r32]=f; resc=true; } } \
    SBAR(); \
    GAPB(o[0]=__builtin_amdgcn_mfma_f32_32x32x16_bf16(PAF(0),VFR(0),o[0],0,0,0), C0,0); \
    GAPB(o[1]=__builtin_amdgcn_mfma_f32_32x32x16_bf16(PAF(0),VFR(4),o[1],0,0,0), C0,4); \
    KRD(GL,0); GAPB(o[0]=__builtin_amdgcn_mfma_f32_32x32x16_bf16(PAF(1),VFR(1),o[0],0,0,0), C0,8); \
    KRD(GL,1); GAPB(o[1]=__builtin_amdgcn_mfma_f32_32x32x16_bf16(PAF(1),VFR(5),o[1],0,0,0), C0,12); \
    KRD(GL,2); GAPB(o[0]=__builtin_amdgcn_mfma_f32_32x32x16_bf16(PAF(2),VFR(2),o[0],0,0,0), C1,0); \
    KRD(GL,3); GAPB(o[1]=__builtin_amdgcn_mfma_f32_32x32x16_bf16(PAF(2),VFR(6),o[1],0,0,0), C1,4); \
    GAPB(o[0]=__builtin_amdgcn_mfma_f32_32x32x16_bf16(PAF(3),VFR(3),o[0],0,0,0), C1,8); \
    GAPB(o[1]=__builtin_amdgcn_mfma_f32_32x32x16_bf16(PAF(3),VFR(7),o[1],0,0,0), C1,12); \
    }while(0)
  int t=1;
  for(;t+5<NT;t+=2){
    STEP(pB0,pB1,pA0,pA1,t,true,true,true);     WAIT_BAR(2); RESC(); ROT();
    STEP(pA0,pA1,pB0,pB1,t+1,true,true,true);   WAIT_BAR(2); RESC(); ROT();
  }
  #define ENDW(tt) do{ if((tt)+3<NT){WAIT_BAR(2);} else if((tt)+2<NT){WAIT_BAR(1);} else {WAIT_BAR(0);} }while(0)
  for(;t+1<NT;t+=2){
    STEP(pB0,pB1,pA0,pA1,t,(t+3<NT),(t+1<NT),(t+1<NT));       ENDW(t);   RESC(); ROT();
    STEP(pA0,pA1,pB0,pB1,t+1,(t+4<NT),(t+2<NT),(t+2<NT));     ENDW(t+1); RESC(); ROT();
  }
  STEP(pB0,pB1,pA0,pA1,NT-1,false,false,false); RESC();
  { float sacc=pB0[0]+pB0[1]; _Pragma("unroll") for(int r=2;r<16;++r)sacc+=pB0[r]; _Pragma("unroll") for(int r=0;r<16;++r)sacc+=pB1[r]; l_reg+=sacc;
    pw0=(u32x4){PKW(pB0,0),PKW(pB0,2),PKW(pB0,4),PKW(pB0,6)};pw1=(u32x4){PKW(pB0,8),PKW(pB0,10),PKW(pB0,12),PKW(pB0,14)};pw2=(u32x4){PKW(pB1,0),PKW(pB1,2),PKW(pB1,4),PKW(pB1,6)};pw3=(u32x4){PKW(pB1,8),PKW(pB1,10),PKW(pB1,12),PKW(pB1,14)};
    SBAR(); pv(o,vb0+sl_cur,PAF(0),PAF(1),PAF(2),PAF(3)); }
  #undef PKW
  #undef PAF
  #undef VFR
  #undef PIN
  #undef MX3
  #undef GAPA
  #undef GAPB
  #undef EX
  #undef VRD
  #undef KRD
  #undef STEP
  #undef ENDW
  {auto rr=__builtin_amdgcn_permlane32_swap(__float_as_uint(l_reg),__float_as_uint(l_reg),false,false);l_reg=__uint_as_float(rr[0])+__uint_as_float(rr[1]);}
  if(hi==0)wsf[32+r32]=l_reg;asm volatile("s_waitcnt lgkmcnt(0)":::"memory");
  float rli[16];
  #pragma unroll
  for(int r=0;r<16;++r)rli[r]=__builtin_amdgcn_rcpf(wsf[32+crow(r,hi)]);
  bf16*Ow=O+(rowbase+q0+wid*QBLK)*OP+512+h*D; float*ATw=ATS+(rowbase+q0+wid*QBLK)*8+h;
  { bf16*stg=(bf16*)(shm+LDS_OST)+wid*2048;
    #pragma unroll
    for(int r=0;r<16;++r){const int orow=crow(r,hi);
      #pragma unroll
      for(int d0=0;d0<2;++d0)stg[orow*64+d0*32+r32]=__float2bfloat16(o[d0][r]*rli[r]);}
    asm volatile("s_waitcnt lgkmcnt(0)":::"memory");
    #pragma unroll
    for(int i=0;i<4;++i){const int row=i*8+(lane>>3),ch=lane&7; const u32x4 v=*(const u32x4*)(stg+row*64+ch*8); ATTN_STORE16(Ow+(long)row*OP+ch*8,v);
      float ss=0.f;
      #pragma unroll
      for(int q=0;q<4;++q){const float lo=__uint_as_float(v[q]<<16),hh=__uint_as_float(v[q]&0xffff0000u);ss+=lo*lo+hh*hh;}
      ss=sum_row8(ss); if(ch==0)ATw[(long)row*8]=ss;} }
  asm volatile("s_waitcnt lgkmcnt(0)\n\ts_barrier":::"memory");
  #undef DMA_K
  #undef DMA_V
  #undef CMASK
  #undef START
  #undef RESC
  #undef ROT
}
constexpr int ATTN_LDS_BYTES=LDS_BYTES;
#undef SBAR
#undef WAIT_BAR
}

__global__ void __launch_bounds__(NTHR, 2) mega(Args args) {
    extern __shared__ __attribute__((aligned(16))) unsigned char lds[];
    Frame F;
    F.lds = (LAS unsigned char*)lds;
    F.wave = __builtin_amdgcn_readfirstlane(threadIdx.x >> 6);
    F.G = gridDim.x; { const int bx = blockIdx.x; F.vcu = (F.G % 8 == 0) ? (bx % 8) * (F.G / 8) + bx / 8 : bx; }
#pragma unroll
    for (int i = 0; i < 22; ++i) F.in[i] = args.in[i];
    F.ws = args.ws; F.xres = args.out;
    volatile LAS unsigned* MISC = (volatile LAS unsigned*)(F.lds + MISC_OFF);
    for (int u = threadIdx.x; u < (LDS_BYTES - LDSCTL_OFF) / 4; u += NTHR) ((LAS unsigned*)(F.lds + LDSCTL_OFF))[u] = 0u;
    __syncthreads();
    const int lo = args.ph_lo, hi = args.ph_hi;
    unsigned* barw = (unsigned*)(F.ws + WS_CTL) + CW_BAR + args.bar_region * XCD_BAR_WORDS;
    XcdBarrier bar; bar.bar = barw; bar.x = 0; bar.st = nullptr;
    if (hi - lo > 1) bar = xcd_barrier_post(barw, MISC + 8);
#ifndef ONLY_K
#define ONLY_K -1
#endif
#define EN(kind) (ONLY_K < 0 || ONLY_K == (kind))
#ifndef ALIGN_A
#define ALIGN_A true
#endif
#ifndef ALIGN_IN
#define ALIGN_IN true
#endif
#ifndef ALIGN_E1
#define ALIGN_E1 true
#endif
#define IN(k) (lo <= (k) && (k) < hi)
#ifndef REPK
#define REPK -1
#endif
#define PROBE_TOP(k) for (int rep_ = 0; rep_ < (REPK == (k) ? 2 : 1); ++rep_) {
#define PROBE_END(k) if (REPK == (k) && rep_ == 0) xcd_barrier(bar); }
#define SEAM(k) do { if (IN(k) && IN((k) + 1)) { xcd_barrier(bar); if (REPK == 200) xcd_barrier(bar); } } while (0)
    const int cid0 = (int)blockIdx.x; const int cid = cid0;
    if (EN(100) && IN(0)) { asm volatile("; PHASE_MARK P0"); PROBE_TOP(100) ph_rows0(F); PROBE_END(100) } SEAM(0);
    if (EN(101) && IN(1)) { asm volatile("; PHASE_MARK P1"); PROBE_TOP(101) ph_convert(F); PROBE_END(101) } SEAM(1);
    if (EN(102) && IN(2)) { asm volatile("; PHASE_MARK P2"); PROBE_TOP(102)
        SchedKV S; S.o.init(NL * 4, 8, F.G, cid); S.MEMN = (const char*)(F.ws + WS_MEMN); S.WKVT = (const char*)(F.ws + WS_WKVT);
        pg8::EpiStore<3> E{(bf16*)(F.ws + WS_KVM), 2 * D, nullptr, 1.0f};
        pg8::gemm_phase<pg8::EpiStore<3>, SchedKV, true, false>(F.lds, F.wave, D, D, D, S, E);
    PROBE_END(102) } SEAM(2);
    if (EN(103) && IN(3)) { asm volatile("; PHASE_MARK P3a");
        SchedQK S; S.o.init(NL * 16, 4, F.G, cid); S.KVM = (const char*)(F.ws + WS_KVM); S.WQB = (const char*)(F.ws + WS_WQB);
        pg8::EpiStore<1> E{(bf16*)(F.ws + WS_QKT), D, F.in[11], XQSCALE};
        int la = 2 * D, lb = D, kk = 256; asm volatile("" : "+s"(la), "+s"(lb), "+s"(kk));
        pg8::gemm_phase<pg8::EpiStore<1>, SchedQK, true, false>(F.lds, F.wave, la, lb, kk, S, E);
    }
    if (EN(104) && IN(3)) { asm volatile("; PHASE_MARK P3b");
        SchedVO S; S.o.init(NL * 64, 1, F.G, cid); S.KVM = (const char*)(F.ws + WS_KVM); S.WOT = (const char*)(F.ws + WS_WOT);
        pg8::EpiStore<2> E{(bf16*)(F.ws + WS_VOT), D, nullptr, 1.0f};
        int la = D, lb = 2 * D, kk = 256; asm volatile("" : "+s"(la), "+s"(lb), "+s"(kk));
        pg8::gemm_phase<pg8::EpiStore<2>, SchedVO, true, false>(F.lds, F.wave, la, lb, kk, S, E);
    } SEAM(3);
    for (int l = 0; l < NL; ++l) {
        const int pb = PH_LAYER0 + PH_PER_LAYER * l;
        int cid = cid0; asm volatile("" : "+s"(cid));
        if (EN(0) && IN(pb + 0)) { asm volatile("; PHASE_MARK L0"); PROBE_TOP(0)
            SchedDense S; S.o.init(T / 256, 7, F.G, cid); S.A = (const char*)(F.ws + WS_XR); S.a_tile = 256 * D * 2; S.B = (const char*)(F.ws + WS_WIN) + (size_t)l * INW * D * 2; S.b_tile = 256 * D * 2; S.b_batch = 0; S.bdiv = 1; S.bmod = 1;
            pg8::EpiIn E{(bf16*)(F.ws + WS_UACT), (bf16*)(F.ws + WS_VACT), (bf16*)(F.ws + WS_Q), (bf16*)(F.ws + WS_K), (bf16*)(F.ws + WS_V), (float*)(F.ws + WS_VSTAT),
                         F.in[7] + (size_t)l * 64, F.in[8] + (size_t)l * 64, (const float*)(F.ws + WS_ROPE), (const float*)(F.ws + WS_ROPE) + SEQ * 32, (const float*)(F.ws + WS_RINV)};
            pg8::gemm_phase<pg8::EpiIn, SchedDense, ALIGN_IN, false>(F.lds, F.wave, D, D, D, S, E);
        PROBE_END(0) } SEAM(pb + 0);
        if (EN(1) && IN(pb + 1)) { asm volatile("; PHASE_MARK L1");
            PROBE_TOP(11)
            for (int it = 0; ; ++it) { const int w = it * F.G + F.vcu; if (w >= NB_ * 8 * (SEQ / 256)) break;
                const int i = w >> 8, c = w & 255, x = c >> 5, j = c & 31;
                attn_body::attn_unit<8>(x >> 1, (x & 1) * 4 + i, j, (const attn_body::bf16*)(F.ws + WS_Q), (const attn_body::bf16*)(F.ws + WS_K), (const attn_body::bf16*)(F.ws + WS_V),
                                        (attn_body::bf16*)(F.ws + WS_MERGED), (float*)(F.ws + WS_ATSTAT), (char*)lds, F.wave); }
            PROBE_END(11)
            PROBE_TOP(12) ph_gmlp(F, l); PROBE_END(12) } SEAM(pb + 1);
        if (EN(2) && IN(pb + 2)) { asm volatile("; PHASE_MARK L2"); PROBE_TOP(2)
            SchedDense S; S.o.init(T / 256, 4, F.G, cid); S.A = (const char*)(F.ws + WS_MERGED); S.a_tile = 256 * D * 2; S.B = (const char*)(F.ws + WS_WOUT) + (size_t)l * D * D * 2; S.b_tile = 256 * D * 2; S.b_batch = 0; S.bdiv = 1; S.bmod = 1;
            pg8::EpiX<true, true> E; E.xr = (bf16*)(F.ws + WS_XR); E.xstat = (float*)(F.ws + WS_XSTAT); E.gmstat = (const float*)(F.ws + WS_GMSTAT); E.atstat = (const float*)(F.ws + WS_ATSTAT); E.lds = F.lds;
            pg8::gemm_phase<pg8::EpiX<true, true>, SchedDense, ALIGN_A, false>(F.lds, F.wave, D, D, D, S, E);
        PROBE_END(2) } SEAM(pb + 2);
        if (EN(3) && IN(pb + 3)) { asm volatile("; PHASE_MARK L3"); PROBE_TOP(3)
            SchedDense S; S.o.init(T / 256, 4, F.G, cid); S.A = (const char*)(F.ws + WS_XR); S.a_tile = 256 * D * 2; S.B = (const char*)(F.ws + WS_QKT) + (size_t)l * NB_ * D * D * 2; S.b_tile = 256 * D * 2; S.b_batch = (size_t)D * D * 2; S.bdiv = SEQ / 256; S.bmod = NB_;
            pg8::EpiS E{(const float*)(F.ws + WS_XSTAT), (bf16*)(F.ws + WS_P), F.lds};
            pg8::gemm_phase<pg8::EpiS, SchedDense, true, false>(F.lds, F.wave, D, D, D, S, E);
        PROBE_END(3) } SEAM(pb + 3);
        if (EN(4) && IN(pb + 4)) { asm volatile("; PHASE_MARK L4"); PROBE_TOP(4)
            SchedDense S; S.o.init(T / 256, 4, F.G, cid); S.A = (const char*)(F.ws + WS_P); S.a_tile = 256 * D * 2; S.B = (const char*)(F.ws + WS_VOT) + (size_t)l * NB_ * D * D * 2; S.b_tile = 256 * D * 2; S.b_batch = (size_t)D * D * 2; S.bdiv = SEQ / 256; S.bmod = NB_;
            pg8::EpiX<false, false> E; E.xr = (bf16*)(F.ws + WS_XR); E.xstat = nullptr; E.gmstat = nullptr; E.atstat = nullptr; E.lds = F.lds;
            pg8::gemm_phase<pg8::EpiX<false, false>, SchedDense, ALIGN_A, false>(F.lds, F.wave, D, D, D, S, E);
        PROBE_END(4) } SEAM(pb + 4);
        if (EN(5) && IN(pb + 5)) { asm volatile("; PHASE_MARK L5"); PROBE_TOP(5) ph_router(F, l); PROBE_END(5) } SEAM(pb + 5);
        if (EN(6) && IN(pb + 6)) { asm volatile("; PHASE_MARK L6"); PROBE_TOP(6) ph_topk(F); PROBE_END(6) } SEAM(pb + 6);
        if (EN(7) && IN(pb + 7)) { asm volatile("; PHASE_MARK L7"); PROBE_TOP(7)
            SchedE1 S; S.o.init(NB_ * NE * 4, 8, F.G, cid); S.HBp = (const char*)(F.ws + WS_XR8); S.IDX = (const int*)(F.ws + WS_IDX); S.WGU = (const char*)(F.ws + WS_WGU) + (size_t)l * NE * 2 * FF * D;
            pg8::EpiH E{F.ws + WS_H};
            int kq = D / 2; asm volatile("" : "+s"(kq));
            pg8::gemm_phase<pg8::EpiH, SchedE1, ALIGN_E1, true, true>(F.lds, F.wave, kq, kq, kq, S, E);
        PROBE_END(7) } SEAM(pb + 7);
        if (EN(8) && IN(pb + 8)) { asm volatile("; PHASE_MARK L8"); for (int rep_ = 0; rep_ < ((REPK == 8 || REPK == 81) ? 2 : 1); ++rep_) {
            SchedDense S; S.o.init(NB_ * NE * 4, 4, F.G, cid); S.A = (const char*)(F.ws + WS_H); S.a_tile = 256 * FF; S.B = (const char*)(F.ws + WS_WD) + (size_t)l * NE * D * FF; S.b_tile = 256 * FF; S.b_batch = (size_t)D * FF; S.bdiv = 4; S.bmod = NE;
            pg8::EpiStore<0> E{(bf16*)(F.ws + WS_Y), D, nullptr, 1.0f / (H8S * W8S)}; E.skip = (REPK == 81 && rep_ == 0);
            int kq = FF / 2; asm volatile("" : "+s"(kq));
            pg8::gemm_phase<pg8::EpiStore<0>, SchedDense, ALIGN_A, false, true>(F.lds, F.wave, kq, kq, kq, S, E);
        if ((REPK == 8 || REPK == 81) && rep_ == 0) xcd_barrier(bar); } } SEAM(pb + 8);
        if (EN(9) && IN(pb + 9)) { asm volatile("; PHASE_MARK L9"); PROBE_TOP(9) ph_combine(F, l, REPK == 9 && rep_ == 0); PROBE_END(9) } SEAM(pb + 9);
    }
#undef IN
#undef SEAM
}

static int g_grid = 0;
static void launch_mega(Args a, int lo, int hi, int region, hipStream_t stream) {
    a.ph_lo = lo; a.ph_hi = hi; a.bar_region = region; a.pad = 0;
    hipLaunchKernelGGL(mega, dim3(g_grid), dim3(NTHR), LDS_BYTES, stream, a);
}
extern "C" void kernel_launch(void* const* d_in, const int* in_sizes, int n_in, void* d_out, int out_size, void* d_ws, size_t ws_size, hipStream_t stream) {
    if (g_grid == 0) {
        if (n_in != 22 || out_size != T * D || ws_size < WS_END) { fprintf(stderr, "kernel_launch: unexpected sizes n_in %d out %d ws %zu\n", n_in, out_size, ws_size); g_grid = -1; return; }
        int dev = 0, cus = 0;
        if (hipGetDevice(&dev) != hipSuccess || hipDeviceGetAttribute(&cus, hipDeviceAttributeMultiprocessorCount, dev) != hipSuccess) { g_grid = -1; return; }
        if (hipFuncSetAttribute((const void*)mega, hipFuncAttributeMaxDynamicSharedMemorySize, LDS_BYTES) != hipSuccess) { g_grid = -1; return; }
        int per_cu = 0;
        if (hipOccupancyMaxActiveBlocksPerMultiprocessor(&per_cu, (const void*)mega, NTHR, LDS_BYTES) != hipSuccess || per_cu < 1) fprintf(stderr, "kernel_launch: occupancy query says %d\n", per_cu);
        (void)hipGetLastError();
        g_grid = cus;
    }
    if (g_grid < 0) return;
    hipMemsetAsync((char*)d_ws + WS_CTL, 0, CTL_ZERO_BYTES, stream);
    Args a{};
    for (int i = 0; i < 22; ++i) a.in[i] = (const float*)d_in[i];
    a.out = (float*)d_out; a.ws = (unsigned char*)d_ws;
    launch_mega(a, 0, PH_END, 0, stream);
}
```

```cpp
#include <hip/hip_runtime.h>
#include <hip/hip_bf16.h>
#include <cstdio>
#include <cstdint>
#include <cmath>

constexpr int NB_ = 4, SEQ = 8192, T = NB_ * SEQ, D = 1024, NL = 4;
constexpr int MEML = 256, NMEM = NB_ * MEML;
constexpr int INW = 1792, GMW = 512, NE = 16, CAP = 1024, FF = 1024;
constexpr float EPS = 1e-6f;
constexpr float LOG2E = 1.4426950408889634f;
constexpr float QSCALE = 0.125f * LOG2E;
constexpr float XQSCALE = 0.0625f * LOG2E;
constexpr float W8S = 256.0f, A8S = 16.0f, H8S = 8.0f, Y8S = 32.0f;

constexpr size_t MiB = 1u << 20;
constexpr size_t WS_CTL = 0, CTL_ZERO_BYTES = 1 * MiB;
constexpr size_t WS_ROPE = 1 * MiB;
constexpr size_t WS_AFF = 3 * MiB;
constexpr size_t WS_INV = 5 * MiB;
constexpr size_t WS_IDX = 7 * MiB;
constexpr size_t WS_VSTAT = 8 * MiB;
constexpr size_t WS_ATSTAT = 9 * MiB;
constexpr size_t WS_GMSTAT = 10 * MiB;
constexpr size_t WS_RINV = 10 * MiB + 512 * 1024;
constexpr size_t WS_RINV2 = 10 * MiB + 768 * 1024;
constexpr size_t WS_XSTAT = 11 * MiB;
constexpr size_t WS_MEMN = 13 * MiB;
constexpr size_t WS_WSB = 15 * MiB;
constexpr size_t WS_WIN = 16 * MiB;
constexpr size_t WS_WOUT = 30 * MiB;
constexpr size_t WS_QKT = 38 * MiB;
constexpr size_t WS_VOT = 70 * MiB;
constexpr size_t WS_WGU = 102 * MiB;
constexpr size_t WS_WD = 358 * MiB;
constexpr size_t WS_XR = 486 * MiB;
constexpr size_t WS_R1 = 550 * MiB;
constexpr size_t WS_UACT = WS_R1, WS_VACT = WS_R1 + 32 * MiB, WS_Q = WS_R1 + 64 * MiB, WS_K = WS_R1 + 96 * MiB, WS_V = WS_R1 + 104 * MiB;
constexpr size_t WS_WQB = WS_R1, WS_WOT = WS_R1 + 8 * MiB, WS_WKVT = WS_R1 + 16 * MiB, WS_KVM = WS_R1 + 32 * MiB;
constexpr size_t WS_H = WS_R1;
constexpr size_t WS_MERGED = 678 * MiB;
constexpr size_t WS_XR8 = 742 * MiB;
constexpr size_t WS_P = WS_MERGED;
constexpr size_t WS_Y = 678 * MiB;
constexpr size_t WS_NSCR = 806 * MiB;
constexpr size_t WS_Q2 = WS_MERGED;
constexpr size_t WS_O2 = WS_NSCR;
constexpr size_t WS_KVN = WS_NSCR + 64 * MiB;
constexpr size_t WS_END = 1024 * MiB;

constexpr int CW_TMO = 0, CW_CODE = 1, CW_BAR = 4096;

#define GAS __attribute__((address_space(1)))
#define LAS __attribute__((address_space(3)))
typedef unsigned short bf16;
typedef unsigned v4u __attribute__((ext_vector_type(4)));
typedef unsigned v2u __attribute__((ext_vector_type(2)));
typedef float f32x4 __attribute__((ext_vector_type(4)));
typedef short bf16x8_t __attribute__((ext_vector_type(8)));
typedef GAS unsigned gu32;
#define RLX_AGENT __ATOMIC_RELAXED, __HIP_MEMORY_SCOPE_AGENT
__device__ __forceinline__ unsigned f2bf(float f) { unsigned u = __builtin_bit_cast(unsigned, f); return (u + 0x7fffu + ((u >> 16) & 1u)) >> 16; }
__device__ __forceinline__ unsigned pk2(float lo, float hi) { return f2bf(lo) | (f2bf(hi) << 16); }
__device__ __forceinline__ float bf2f(unsigned v) { return __builtin_bit_cast(float, v << 16); }
__device__ __forceinline__ float bflo(unsigned w) { return __builtin_bit_cast(float, w << 16); }
__device__ __forceinline__ float bfhi(unsigned w) { return __builtin_bit_cast(float, w & 0xffff0000u); }
__device__ __forceinline__ float rbf(float f) { return bf2f(f2bf(f)); }
__device__ __forceinline__ float clamp8(float v) { return __builtin_amdgcn_fmed3f(v, -448.0f, 448.0f); }
__device__ __forceinline__ unsigned pk4_fp8(float a, float b, float c, float d) { unsigned w = 0u; w = __builtin_amdgcn_cvt_pk_fp8_f32(clamp8(a), clamp8(b), w, false); w = __builtin_amdgcn_cvt_pk_fp8_f32(clamp8(c), clamp8(d), w, true); return w; }
__device__ __forceinline__ float gelu_tanh(float x) {
    const float z = 1.5957691216057308f * (x + 0.044715f * x * x * x);
    return x * __builtin_amdgcn_rcpf(1.0f + __builtin_amdgcn_exp2f(-z * LOG2E));
}
__device__ __forceinline__ float silu_f(float a) { return a * __builtin_amdgcn_rcpf(1.0f + __builtin_amdgcn_exp2f(-a * LOG2E)); }
__device__ __forceinline__ int lane_id() { int l; asm volatile("v_mbcnt_lo_u32_b32 %0, -1, 0\n\tv_mbcnt_hi_u32_b32 %0, -1, %0" : "=v"(l)); return l; }
template <int CTRL> __device__ __forceinline__ float dpp_f(float v) { return __builtin_bit_cast(float, __builtin_amdgcn_update_dpp(0, __builtin_bit_cast(int, v), CTRL, 0xf, 0xf, true)); }
__device__ __forceinline__ float sum_row16(float v) { v += dpp_f<0xB1>(v); v += dpp_f<0x4E>(v); v += dpp_f<0x141>(v); v += dpp_f<0x140>(v); return v; }
__device__ __forceinline__ float max_row16(float v) { v = fmaxf(v, dpp_f<0xB1>(v)); v = fmaxf(v, dpp_f<0x4E>(v)); v = fmaxf(v, dpp_f<0x141>(v)); v = fmaxf(v, dpp_f<0x140>(v)); return v; }
__device__ __forceinline__ float sum_row8(float v) { v += dpp_f<0xB1>(v); v += dpp_f<0x4E>(v); v += dpp_f<0x141>(v); return v; }
__device__ __forceinline__ float swz16(float v) { return __builtin_bit_cast(float, __builtin_amdgcn_ds_swizzle(__builtin_bit_cast(int, v), 0x401f)); }
__device__ __forceinline__ float add_x16(float v) { return v + swz16(v); }
__device__ __forceinline__ float add_x32(float v) { const unsigned a = __builtin_bit_cast(unsigned, v); const auto r = __builtin_amdgcn_permlane32_swap(a, a, false, false); const unsigned r0 = r[0], r1 = r[1]; return __builtin_bit_cast(float, r0) + __builtin_bit_cast(float, r1); }
__device__ __forceinline__ float max_x16(float v) { return fmaxf(v, swz16(v)); }
__device__ __forceinline__ float max_x32(float v) { const unsigned a = __builtin_bit_cast(unsigned, v); const auto r = __builtin_amdgcn_permlane32_swap(a, a, false, false); const unsigned r0 = r[0], r1 = r[1]; return fmaxf(__builtin_bit_cast(float, r0), __builtin_bit_cast(float, r1)); }
__device__ __forceinline__ float wave_sum(float v) { return add_x32(add_x16(sum_row16(v))); }

#define XB_TMO      128
#define XB_XCNT(j)  (256  + 64 * (j))
#define XB_XSUB(j)  (1280 + 64 * (j))
#define XB_XGEN(j)  (2304 + 64 * (j))
#define XB_TOP      3328
#define XB_TOPGEN   3392
#define XCD_BAR_WORDS 3456
#define XB_SPIN_CAP (1u << 18)
__device__ __forceinline__ unsigned xb_ld(unsigned* p)              { return __hip_atomic_load(p, __ATOMIC_RELAXED, __HIP_MEMORY_SCOPE_AGENT); }
__device__ __forceinline__ unsigned xb_add(unsigned* p, unsigned v) { return __hip_atomic_fetch_add(p, v, __ATOMIC_RELAXED, __HIP_MEMORY_SCOPE_AGENT); }
__device__ __forceinline__ unsigned xb_xcc_id() { return (unsigned)__builtin_amdgcn_s_getreg((3 << 11) | 20) & 0xFu; }
#define XB_SPIN(cond, bar) do { unsigned _sp = 0; while (cond) { __builtin_amdgcn_s_sleep(1); \
    if ((++_sp & 255u) == 0u) { if (xb_ld(&(bar)[XB_TMO])) break; if (_sp > XB_SPIN_CAP) { atomicAdd(&(bar)[XB_TMO], 1u); break; } } } } while (0)
struct XcdBarrier { unsigned* bar; unsigned x; volatile LAS unsigned* st; };
__device__ __forceinline__ XcdBarrier xcd_barrier_post(unsigned* bar, volatile LAS unsigned* st) {
    XcdBarrier b; b.bar = bar; b.x = xb_xcc_id(); b.st = st;
    if (threadIdx.x == 0) (void)xb_add(&bar[XB_XCNT(b.x)], 1u);
    return b;
}
__device__ __forceinline__ void xcd_barrier_complete(unsigned* bar, unsigned x, unsigned& nloc, unsigned& nx) {
    const unsigned G = gridDim.x * gridDim.y * gridDim.z;
    unsigned sum, cnt, mine, sp = 0u;
    for (;;) {
        sum = 0u; cnt = 0u; mine = 0u;
#pragma unroll
        for (unsigned j = 0; j < 16; ++j) { const unsigned c = xb_ld(&bar[XB_XCNT(j)]); sum += c; cnt += (c > 0u) ? 1u : 0u; mine = (j == x) ? c : mine; }
        if (sum == G) break;
        __builtin_amdgcn_s_sleep(1);
        if ((++sp & 255u) == 0u) { if (xb_ld(&bar[XB_TMO])) break; if (sp > XB_SPIN_CAP) { atomicAdd(&bar[XB_TMO], 1u); break; } }
    }
    nloc = mine > 0u ? mine : 1u; nx = cnt > 0u ? cnt : 1u;
}
__device__ __forceinline__ void xcd_barrier(const XcdBarrier& b) {
    asm volatile("s_waitcnt vmcnt(0)" ::: "memory");
    __syncthreads();
    if (threadIdx.x == 0) {
        unsigned* bar = b.bar;
        __builtin_amdgcn_s_waitcnt(0);
        unsigned nloc = b.st[0], nx = b.st[1];
        if (nloc == 0u) { xcd_barrier_complete(bar, b.x, nloc, nx); b.st[0] = nloc; b.st[1] = nx; }
        const unsigned old = xb_add(&bar[XB_XSUB(b.x)], 1u);
        const unsigned gen = old / nloc;
        if (old + 1u == (gen + 1u) * nloc) {
            __builtin_amdgcn_fence(__ATOMIC_RELEASE, "agent");
            asm volatile("s_waitcnt vmcnt(0)" ::: "memory");
            const unsigned og = xb_add(&bar[XB_TOP], 1u);
            const unsigned tg = og / nx;
            if (og + 1u == (tg + 1u) * nx) xb_add(&bar[XB_TOPGEN], 1u);
            else XB_SPIN(xb_ld(&bar[XB_TOPGEN]) == tg, bar);
            __builtin_amdgcn_fence(__ATOMIC_ACQUIRE, "agent");
            xb_add(&bar[XB_XGEN(b.x)], 1u);
            asm volatile("s_waitcnt vmcnt(0)" ::: "memory");
        } else {
            XB_SPIN(xb_ld(&bar[XB_XGEN(b.x)]) == gen, bar);
            __builtin_amdgcn_fence(__ATOMIC_ACQUIRE, "agent");
            asm volatile("s_waitcnt vmcnt(0)" ::: "memory");
        }
    }
    __syncthreads();
}

struct Args { const float* in[22]; float* out; unsigned char* ws; int ph_lo, ph_hi, bar_region, pad; };
constexpr int PH_LAYER0 = 4, PH_PER_LAYER = 10, PH_END = PH_LAYER0 + NL * PH_PER_LAYER;

constexpr int NWAVES = 8, NTHR = NWAVES * 64;
constexpr int RING_BYTES = 131072, LDSCTL_OFF = RING_BYTES, MISC_OFF = LDSCTL_OFF + 320;
constexpr int LDS_BYTES = 147456;

struct Frame {
    LAS unsigned char* lds;
    int wave, vcu, G;
    const float* in[22];
    unsigned char* ws;
    float* xres;
};

__device__ __forceinline__ void ph_rows0(Frame& F) {
    int lane_ = lane_id(); asm volatile("" : "+v"(lane_)); const int tid_ = F.wave * 64 + lane_;
    const int gw = F.vcu * NWAVES + F.wave, NGW = F.G * NWAVES;
    const float* x = F.in[0]; const float* mem = F.in[1]; const float* mg = F.in[12];
    bf16* XR = (bf16*)(F.ws + WS_XR); bf16* MEMN = (bf16*)(F.ws + WS_MEMN); float* RINV = (float*)(F.ws + WS_RINV);
    for (int m = gw; m < T + NMEM; m += NGW) {
        const bool is_mem = m >= T;
        const float* src = is_mem ? mem + (size_t)(m - T) * D : x + (size_t)m * D;
        bf16* dst = is_mem ? MEMN + (size_t)(m - T) * D : XR + (size_t)m * D;
        f32x4 v[4]; float s = 0.f;
#pragma unroll
        for (int j = 0; j < 4; ++j) { v[j] = *(const f32x4*)(src + 4 * lane_ + 256 * j); s += (v[j].x * v[j].x + v[j].y * v[j].y) + (v[j].z * v[j].z + v[j].w * v[j].w); }
        const float rinv = __builtin_amdgcn_rsqf(wave_sum(s) * (1.0f / D) + EPS);
        if (!is_mem && lane_ == 0) RINV[m] = rinv;
        const float sc = is_mem ? rinv : 1.0f;
#pragma unroll
        for (int j = 0; j < 4; ++j) {
            f32x4 g = (f32x4){1.f, 1.f, 1.f, 1.f};
            if (is_mem) g = *(const f32x4*)(mg + 4 * lane_ + 256 * j);
            v2u o; o.x = pk2(v[j].x * sc * g.x, v[j].y * sc * g.y); o.y = pk2(v[j].z * sc * g.z, v[j].w * sc * g.w);
            *(v2u*)(dst + 4 * lane_ + 256 * j) = o;
        }
    }
#if defined(SELFTEST_F8)
    if (F.vcu == 0 && F.wave == 0) {
        typedef int v8i_t __attribute__((ext_vector_type(8)));
        const int fr = lane_ & 15; const unsigned codes[4] = {0x38383838u, 0x3A3A3A3Au, 0x3C3C3C3Cu, 0x40404040u}; const float vals[4] = {1.0f, 1.25f, 1.5f, 2.0f};
        unsigned bc = codes[0]; float bv = vals[0];
#pragma unroll
        for (int q = 1; q < 4; ++q) if ((fr & 3) == q) { bc = codes[q]; bv = vals[q]; }
        v8i_t A, B;
#pragma unroll
        for (int q = 0; q < 8; ++q) { A[q] = 0x38383838; B[q] = (int)bc; }
        f32x4 acc = (f32x4){0.f, 0.f, 0.f, 0.f}; unsigned sc = 0x7f7f7f7fu; asm volatile("" : "+v"(sc), "+v"(A), "+v"(B), "+v"(acc));
        asm volatile("s_nop 7\n\tv_mfma_scale_f32_16x16x128_f8f6f4 %0, %1, %2, %0, %3, %3 op_sel_hi:[0,0,0]\n\ts_nop 15\n\ts_nop 15\n\ts_nop 15\n\ts_nop 15\n\ts_nop 15\n\ts_nop 15" : "+v"(acc) : "v"(A), "v"(B), "v"(sc));
        bool bad = false;
#pragma unroll
        for (int e = 0; e < 4; ++e) bad |= (acc[e] != 128.0f * bv);
        const unsigned w = pk4_fp8(1.25f, 448.0f, 1000.0f, -2.0f); bad |= (w != 0xC07E7E3Au);
        {   const float v = (float)((lane_ * 37 + 11) % 101);
            float r16 = v; r16 += __shfl_xor(r16, 1); r16 += __shfl_xor(r16, 2); r16 += __shfl_xor(r16, 4); r16 += __shfl_xor(r16, 8);
            float m16 = v; m16 = fmaxf(m16, __shfl_xor(m16, 1)); m16 = fmaxf(m16, __shfl_xor(m16, 2)); m16 = fmaxf(m16, __shfl_xor(m16, 4)); m16 = fmaxf(m16, __shfl_xor(m16, 8));
            float r8 = v; r8 += __shfl_xor(r8, 1); r8 += __shfl_xor(r8, 2); r8 += __shfl_xor(r8, 4);
            float r64 = r16; r64 += __shfl_xor(r64, 16); r64 += __shfl_xor(r64, 32);
            if (SELFTEST_F8 & 1) bad |= (sum_row16(v) != r16) | (max_row16(v) != m16) | (sum_row8(v) != r8);
            if (SELFTEST_F8 & 2) bad |= (wave_sum(v) != r64);
            if (SELFTEST_F8 & 4) bad |= (add_x16(v) != v + __shfl_xor(v, 16)) | (max_x16(v) != fmaxf(v, __shfl_xor(v, 16)));
            if (SELFTEST_F8 & 8) bad |= (add_x32(v) != v + __shfl_xor(v, 32)) | (max_x32(v) != fmaxf(v, __shfl_xor(v, 32)));
            if (SELFTEST_F8 & 16) bad |= (lane_ != (int)(threadIdx.x & 63));
            const int iv = lane_ * 3 + 1; if (SELFTEST_F8 & 32) bad |= (__builtin_amdgcn_readlane(iv, 5) != 16) | false; { const int bp = __builtin_amdgcn_ds_bpermute((lane_ - 1) << 2, iv); if (SELFTEST_F8 & 32) bad |= (lane_ > 0 && bp != iv - 3); }
            const float xq = 0.37f + (float)lane_; const float rq = __builtin_amdgcn_rsqf(xq), rr = 1.0f / sqrtf(xq); if (SELFTEST_F8 & 64) bad |= (fabsf(rq - rr) > 1e-5f * rr); }
        if (bad) __hip_atomic_store((unsigned*)(F.ws + WS_CTL) + CW_TMO, 1u, __ATOMIC_RELAXED, __HIP_MEMORY_SCOPE_AGENT);
    }
#endif
    float* COS = (float*)(F.ws + WS_ROPE); float* SIN = COS + SEQ * 32;
    const int gt = F.vcu * NTHR + tid_, NGT = F.G * NTHR;
    for (int i = gt; i < SEQ * 32; i += NGT) {
        const int t = i >> 5, p = i & 31;
        const float fr = expf(-9.210340371976184f * (float)(p & 15) * (1.0f / 16.0f));
        const float pos = (float)((p < 16) ? (t >> 6) : (t & 63));
        float rev = pos * fr * 0.15915494309189535f; rev -= floorf(rev);
        COS[i] = __builtin_amdgcn_cosf(rev); SIN[i] = __builtin_amdgcn_sinf(rev);
    }
}

__device__ __forceinline__ void ph_gmlp(Frame& F, int l) {
    int lane_ = lane_id(); asm volatile("" : "+v"(lane_)); const int tid_ = F.wave * 64 + lane_;
    const bf16* UACT = (const bf16*)(F.ws + WS_UACT); const bf16* VACT = (const bf16*)(F.ws + WS_VACT);
    const float* VSTAT = (const float*)(F.ws + WS_VSTAT); float* GMSTAT = (float*)(F.ws + WS_GMSTAT);
    bf16* MERGED = (bf16*)(F.ws + WS_MERGED);
    const float* gvn = F.in[4] + (size_t)l * GMW; const float* bs = F.in[6] + (size_t)l * 4 * 128;
    const bf16* WSB = (const bf16*)(F.ws + WS_WSB) + (size_t)l * 4 * 128 * 128;
    LAS bf16* vT = (LAS bf16*)F.lds;
    const int fr = lane_ & 15, fq = lane_ >> 4, w = F.wave;
    for (int u = F.vcu; u < (T / 128) * 4; u += F.G) {
        const int n = u >> 2, g = u & 3; const int row0 = n * 128;
        __syncthreads();
        {   const int j = tid_ & 127, cs = tid_ >> 7; const size_t row = (size_t)row0 + j;
            const f32x4 s0 = *(const f32x4*)(VSTAT + row * 8), s1 = *(const f32x4*)(VSTAT + row * 8 + 4);
            const float rinv = __builtin_amdgcn_rsqf((((s0[0] + s0[1]) + (s0[2] + s0[3])) + ((s1[0] + s1[1]) + (s1[2] + s1[3]))) * (1.0f / GMW) + EPS);
#pragma unroll
            for (int q = 0; q < 4; ++q) { const int c8 = (cs * 4 + q) * 8;
                const v4u raw = *(const v4u*)(VACT + row * GMW + g * 128 + c8);
                const f32x4 g0 = *(const f32x4*)(gvn + g * 128 + c8) * rinv, g1 = *(const f32x4*)(gvn + g * 128 + c8 + 4) * rinv;
                LAS bf16* d = vT + c8 * 136 + j;
                d[0 * 136] = (bf16)f2bf(bflo(raw.x) * g0[0]); d[1 * 136] = (bf16)f2bf(bfhi(raw.x) * g0[1]); d[2 * 136] = (bf16)f2bf(bflo(raw.y) * g0[2]); d[3 * 136] = (bf16)f2bf(bfhi(raw.y) * g0[3]);
                d[4 * 136] = (bf16)f2bf(bflo(raw.z) * g1[0]); d[5 * 136] = (bf16)f2bf(bfhi(raw.z) * g1[1]); d[6 * 136] = (bf16)f2bf(bflo(raw.w) * g1[2]); d[7 * 136] = (bf16)f2bf(bfhi(raw.w) * g1[3]); } }
        bf16x8_t bw[4];
#pragma unroll
        for (int ks = 0; ks < 4; ++ks) bw[ks] = *(const bf16x8_t*)(WSB + ((size_t)(g * 128 + 16 * w + fr)) * 128 + 32 * ks + 8 * fq);
        __syncthreads();
        f32x4 acc[8];
#pragma unroll
        for (int cb = 0; cb < 8; ++cb) { acc[cb] = (f32x4){0.f, 0.f, 0.f, 0.f};
#pragma unroll
            for (int ks = 0; ks < 4; ++ks) { const bf16x8_t a = *(const LAS bf16x8_t*)(vT + (16 * cb + fr) * 136 + 32 * ks + 8 * fq);
                acc[cb] = __builtin_amdgcn_mfma_f32_16x16x32_bf16(a, bw[ks], acc[cb], 0, 0, 0); } }
        const size_t row = (size_t)row0 + 16 * w + fr; const float bias = bs[g * 128 + 16 * w + fr]; float ss = 0.f;
#pragma unroll
        for (int cb = 0; cb < 8; ++cb) { const v2u uu = *(const v2u*)(UACT + row * GMW + g * 128 + 16 * cb + 4 * fq);
            v2u o; o.x = pk2(bflo(uu.x) * (acc[cb][0] + bias), bfhi(uu.x) * (acc[cb][1] + bias)); o.y = pk2(bflo(uu.y) * (acc[cb][2] + bias), bfhi(uu.y) * (acc[cb][3] + bias));
            *(v2u*)(MERGED + row * 1024 + g * 128 + 16 * cb + 4 * fq) = o;
            const float a0 = bflo(o.x), a1 = bfhi(o.x), a2 = bflo(o.y), a3 = bfhi(o.y); ss += (a0 * a0 + a1 * a1) + (a2 * a2 + a3 * a3); }
        ss = add_x32(add_x16(ss));
        if (fq == 0) GMSTAT[row * 4 + g] = ss;
    }
    __syncthreads();
}

__device__ __forceinline__ void ph_router(Frame& F, int l) {
    int lane_ = lane_id(); asm volatile("" : "+v"(lane_)); const int tid_ = F.wave * 64 + lane_;
    const float* g = F.in[16] + (size_t)l * D; const float* wr = F.in[17] + (size_t)l * D * NE;
    const bf16* XR = (const bf16*)(F.ws + WS_XR); float* AFF = (float*)(F.ws + WS_AFF);
    LAS float* sW = (LAS float*)F.lds;
    __syncthreads();
    for (int i = tid_; i < D * NE; i += NTHR) { const int c = i >> 4, e = i & 15; sW[e * D + c] = wr[i] * g[c]; }
    __syncthreads();
    const int gw = F.vcu * NWAVES + F.wave, NGW = F.G * NWAVES;
    LAS float* tp = (LAS float*)(F.lds + 65536) + F.wave * (64 * 17);
    v2u nv[2][4];
#pragma unroll
    for (int r = 0; r < 2; ++r) { const int m = gw + r * NGW; if (m < T) {
#pragma unroll
        for (int j = 0; j < 4; ++j) nv[r][j] = *(const v2u*)(XR + (size_t)m * D + 4 * lane_ + 256 * j); } }
    for (int m0 = gw; m0 < T; m0 += 2 * NGW) {
        f32x4 v[2][4];
#pragma unroll
        for (int r = 0; r < 2; ++r)
#pragma unroll
            for (int j = 0; j < 4; ++j) v[r][j] = (f32x4){bflo(nv[r][j].x), bfhi(nv[r][j].x), bflo(nv[r][j].y), bfhi(nv[r][j].y)};
#pragma unroll
        for (int r = 0; r < 2; ++r) { const int m = m0 + (2 + r) * NGW; if (m < T) {
#pragma unroll
            for (int j = 0; j < 4; ++j) nv[r][j] = *(const v2u*)(XR + (size_t)m * D + 4 * lane_ + 256 * j); } }
        const bool has1 = (m0 + NGW) < T;
        float rinv[2];
#pragma unroll
        for (int r = 0; r < 2; ++r) { float s = 0.f;
#pragma unroll
            for (int j = 0; j < 4; ++j) s += (v[r][j].x * v[r][j].x + v[r][j].y * v[r][j].y) + (v[r][j].z * v[r][j].z + v[r][j].w * v[r][j].w);
            rinv[r] = __builtin_amdgcn_rsqf(wave_sum(s) * (1.0f / D) + EPS); }
        {   unsigned char* X8 = F.ws + WS_XR8;
#pragma unroll
            for (int r = 0; r < 2; ++r) { if (r == 0 || has1) { const float sc = rinv[r] * A8S;
#pragma unroll
                for (int j = 0; j < 4; ++j) *(unsigned*)(X8 + (size_t)(m0 + r * NGW) * D + 4 * lane_ + 256 * j) = pk4_fp8(v[r][j].x * sc, v[r][j].y * sc, v[r][j].z * sc, v[r][j].w * sc); } } }
#pragma unroll 4
        for (int e = 0; e < NE; ++e) { float a0 = 0.f, a1 = 0.f;
#pragma unroll
            for (int j = 0; j < 4; ++j) { const f32x4 w = *(const LAS f32x4*)(sW + e * D + 4 * lane_ + 256 * j);
                a0 += (v[0][j].x * w.x + v[0][j].y * w.y) + (v[0][j].z * w.z + v[0][j].w * w.w); a1 += (v[1][j].x * w.x + v[1][j].y * w.y) + (v[1][j].z * w.z + v[1][j].w * w.w); }
            { const auto rr = __builtin_amdgcn_permlane32_swap(__float_as_uint(a0), __float_as_uint(a1), false, false);
              tp[lane_ * 17 + e] = __uint_as_float(rr[0]) + __uint_as_float(rr[1]); } }
        asm volatile("s_waitcnt lgkmcnt(0)" ::: "memory");
        {   const int e = lane_ & 15, r = (lane_ >> 4) & 1, hp = lane_ >> 5; float a0 = 0.f, a1 = 0.f;
#pragma unroll
            for (int rr = 0; rr < 16; rr += 2) { a0 += tp[(r * 32 + hp * 16 + rr) * 17 + e]; a1 += tp[(r * 32 + hp * 16 + rr + 1) * 17 + e]; }
            float mylg = add_x32(a0 + a1); mylg *= (r == 0 ? rinv[0] : rinv[1]);
            const float mx = max_row16(mylg);
            const float pe = __builtin_amdgcn_exp2f((mylg - mx) * LOG2E);
            const float den = sum_row16(pe);
            const int m = m0 + r * NGW;
            if (lane_ < 32 && (r == 0 || has1)) AFF[(size_t)m * NE + e] = pe / den;
        }
        asm volatile("s_waitcnt lgkmcnt(0)" ::: "memory");
    }
    __syncthreads();
}

__device__ __forceinline__ void ph_topk(Frame& F) {
    int lane_ = lane_id(); asm volatile("" : "+v"(lane_)); const int tid_ = F.wave * 64 + lane_;
    const float* AFF = (const float*)(F.ws + WS_AFF); int* IDX = (int*)(F.ws + WS_IDX); int* INV = (int*)(F.ws + WS_INV);
    LAS unsigned* hist = (LAS unsigned*)F.lds;
    LAS unsigned* sh = hist + 256;
    LAS unsigned* wsum = hist + 512;
    for (int p = F.vcu; p < NB_ * NE; p += F.G) {
        const int b = p >> 4, e = p & 15;
        unsigned key[16];
#pragma unroll
        for (int i = 0; i < 16; ++i) key[i] = __builtin_bit_cast(unsigned, AFF[((size_t)b * SEQ + tid_ * 16 + i) * NE + e]);
        unsigned prefix = 0u, krem = CAP;
#pragma unroll
        for (int pass = 0; pass < 4; ++pass) {
            const int shift = pass == 3 ? 0 : 23 - 8 * pass; const unsigned dmask = pass == 3 ? 127u : 255u;
            const unsigned himask = pass == 0 ? 0u : (pass == 1 ? 0xff800000u : (pass == 2 ? 0xffff8000u : 0xffffff80u));
            __syncthreads();
            if (tid_ < 256) hist[tid_] = 0u;
            __syncthreads();
#pragma unroll
            for (int i = 0; i < 16; ++i) if ((key[i] & himask) == prefix) atomicAdd((unsigned*)&hist[(key[i] >> shift) & dmask], 1u);
            __syncthreads();
            if (F.wave == 0) {
                unsigned c[4]; unsigned t = 0u;
#pragma unroll
                for (int j = 0; j < 4; ++j) { c[j] = hist[255 - 4 * lane_ - j]; t += c[j]; }
                unsigned inc = t;
#pragma unroll
                for (int o = 1; o < 64; o <<= 1) { const unsigned a = (unsigned)__builtin_amdgcn_ds_bpermute((lane_ - o) << 2, (int)inc); if (lane_ >= o) inc += a; }
                unsigned above = inc - t;
                if (above < krem && krem <= inc) {
                    int d = 255 - 4 * lane_;
#pragma unroll
                    for (int j = 0; j < 3; ++j) { if (above + c[j] < krem) { above += c[j]; d = 254 - 4 * lane_ - j; } else break; }
                    sh[0] = prefix | ((unsigned)d << shift); sh[1] = krem - above; }
            }
            __syncthreads();
            prefix = sh[0]; krem = sh[1];
        }
        const unsigned thr = prefix;
        unsigned cg = 0u, ce = 0u;
#pragma unroll
        for (int i = 0; i < 16; ++i) { cg += key[i] > thr ? 1u : 0u; ce += key[i] == thr ? 1u : 0u; }
        unsigned sg = cg, se = ce;
#pragma unroll
        for (int o = 1; o < 64; o <<= 1) { const unsigned a = (unsigned)__builtin_amdgcn_ds_bpermute((lane_ - o) << 2, (int)sg), c2 = (unsigned)__builtin_amdgcn_ds_bpermute((lane_ - o) << 2, (int)se); if (lane_ >= o) { sg += a; se += c2; } }
        __syncthreads();
        if (lane_ == 63) { wsum[F.wave] = sg; wsum[8 + F.wave] = se; }
        __syncthreads();
        unsigned og = 0u, oe = 0u;
        for (int w = 0; w < F.wave; ++w) { og += wsum[w]; oe += wsum[8 + w]; }
        unsigned gb = og + sg - cg, eb = oe + se - ce;
#pragma unroll
        for (int i = 0; i < 16; ++i) {
            const int t = tid_ * 16 + i; int pos = -1;
            if (key[i] > thr) { pos = (int)(gb + (eb < krem ? eb : krem)); ++gb; }
            else if (key[i] == thr) { if (eb < krem) pos = (int)(gb + eb); ++eb; }
            INV[((size_t)b * SEQ + t) * NE + e] = pos;
            if (pos >= 0) IDX[(size_t)p * CAP + pos] = t;
        }
    }
    __syncthreads();
}

__device__ __forceinline__ void ph_combine(Frame& F, int l, bool dummy) {
    int lane_ = lane_id(); asm volatile("" : "+v"(lane_));
    const float* AFF = (const float*)(F.ws + WS_AFF); const int* INV = (const int*)(F.ws + WS_INV);
    const unsigned char* Y = F.ws + WS_Y; bf16* XR = (bf16*)(F.ws + WS_XR); const float* fg = F.in[21]; float* RINV = (float*)(F.ws + WS_RINV);
    const int gw = F.vcu * NWAVES + F.wave, NGW = F.G * NWAVES;
    v2u nx[4]; int npos = -1; float naff = 0.f;
    if (gw < T) {
#pragma unroll
        for (int j = 0; j < 4; ++j) nx[j] = *(const v2u*)(XR + (size_t)gw * D + 4 * lane_ + 256 * j);
        if (lane_ < NE) { npos = INV[(size_t)gw * NE + lane_]; naff = AFF[(size_t)gw * NE + lane_]; } }
    for (int m = gw; m < T; m += NGW) {
        const int b = m / SEQ;
        bf16* xw = (dummy ? (bf16*)(F.ws + WS_NSCR) : XR) + (size_t)m * D; float* ow = (dummy ? (float*)(F.ws + WS_NSCR) : F.xres) + (size_t)m * D;
        f32x4 v[4];
#pragma unroll
        for (int j = 0; j < 4; ++j) v[j] = (f32x4){bflo(nx[j].x), bfhi(nx[j].x), bflo(nx[j].y), bfhi(nx[j].y)};
        const int mypos = npos; const float myaff = naff;
        {   const int mn = m + NGW; npos = -1; naff = 0.f;
            if (mn < T) {
#pragma unroll
                for (int j = 0; j < 4; ++j) nx[j] = *(const v2u*)(XR + (size_t)mn * D + 4 * lane_ + 256 * j);
                if (lane_ < NE) { npos = INV[(size_t)mn * NE + lane_]; naff = AFF[(size_t)mn * NE + lane_]; } } }
        unsigned mask = (unsigned)__builtin_amdgcn_ballot_w64(mypos >= 0) & 0xffffu;
        while (mask) {
            int ee[4]; int nsel = 0;
#pragma unroll
            for (int q = 0; q < 4; ++q) { ee[q] = 0; if (mask) { ee[q] = __builtin_ctz(mask); mask &= mask - 1u; nsel = q + 1; } }
            int w[4][4]; float as[4];
#pragma unroll
            for (int q = 0; q < 4; ++q) { as[q] = 0.f;
                if (q < nsel) { const int pos = __builtin_amdgcn_readlane(mypos, ee[q]); as[q] = __builtin_bit_cast(float, __builtin_amdgcn_readlane(__builtin_bit_cast(int, myaff), ee[q])) * (1.0f / Y8S);
                    const unsigned char* yr = Y + ((size_t)(b * NE + ee[q]) * CAP + pos) * D;
#pragma unroll
                    for (int j = 0; j < 4; ++j) w[q][j] = *(const int*)(yr + 4 * lane_ + 256 * j); }
                else {
#pragma unroll
                    for (int j = 0; j < 4; ++j) w[q][j] = 0; } }
#pragma unroll
            for (int q = 0; q < 4; ++q)
#pragma unroll
                for (int j = 0; j < 4; ++j) { const auto lo = __builtin_amdgcn_cvt_pk_f32_fp8(w[q][j], false), hi = __builtin_amdgcn_cvt_pk_f32_fp8(w[q][j], true);
                    const float l0 = lo[0], l1 = lo[1], h0 = hi[0], h1 = hi[1];
                    v[j].x += as[q] * l0; v[j].y += as[q] * l1; v[j].z += as[q] * h0; v[j].w += as[q] * h1; }
        }
        float s = 0.f;
#pragma unroll
        for (int j = 0; j < 4; ++j) s += (v[j].x * v[j].x + v[j].y * v[j].y) + (v[j].z * v[j].z + v[j].w * v[j].w);
        const float rinv = __builtin_amdgcn_rsqf(wave_sum(s) * (1.0f / D) + EPS);
        if (l == NL - 1) {
#if defined(SELFTEST_F8)
            if (__hip_atomic_load((unsigned*)(F.ws + WS_CTL) + CW_TMO, __ATOMIC_RELAXED, __HIP_MEMORY_SCOPE_AGENT) != 0u) v[0].x = __builtin_nanf("");
#endif
#pragma unroll
            for (int j = 0; j < 4; ++j) { const f32x4 g = *(const f32x4*)(fg + 4 * lane_ + 256 * j); *(f32x4*)(ow + 4 * lane_ + 256 * j) = (f32x4){v[j].x * rinv * g.x, v[j].y * rinv * g.y, v[j].z * rinv * g.z, v[j].w * rinv * g.w}; }
        } else {
            if (lane_ == 0 && !dummy) RINV[m] = rinv;
#pragma unroll
            for (int j = 0; j < 4; ++j) { v2u o; o.x = pk2(v[j].x, v[j].y); o.y = pk2(v[j].z, v[j].w); *(v2u*)(xw + 4 * lane_ + 256 * j) = o; }
        }
    }
}

namespace pg8 {
typedef short bf16x8 __attribute__((ext_vector_type(8)));
typedef float f32x2 __attribute__((ext_vector_type(2)));
typedef int v4i_t __attribute__((ext_vector_type(4)));
typedef int v8i_t __attribute__((ext_vector_type(8)));
constexpr int BM = 256, BK = 64, HALF = 128, HTB = HALF * BK * 2, STAGE_BYTES = 8 * HTB, NXCD = 8, WGM = 8;
__host__ __device__ __forceinline__ int lds_byte(int r, int c) { const int st = (r >> 4) * 2 + (c >> 5), rr = r & 15, cc = c & 31, ob = rr * 64 + cc * 2; return st * 1024 + (ob ^ (((ob >> 9) & 1) << 5)); }
__host__ __device__ __forceinline__ void stage_rc(int b, int& R, int& C) { const int st = b / 1024, sb = b % 1024, swz = sb ^ (((sb >> 9) & 1) << 5); R = (st >> 1) * 16 + swz / 64; C = (st & 1) * 32 + (swz % 64) / 2; }
__host__ __device__ __forceinline__ int perm32(int rho) { const int n = rho >> 4, i = rho & 15; return 8 * (i >> 2) + 4 * n + (i & 3); }

struct Unit { int pm, pn, z; const char* a; const char* b; const int* gi; int grow; };

struct TileOrder {
    int nM, nN, nwg, G, c;
    __device__ __forceinline__ void init(int nM_, int nN_, int G_, int c_) { nM = nM_; nN = nN_; nwg = nM * nN; G = G_; c = c_; }
    __device__ __forceinline__ bool tile(int i, int& pm, int& pn) const {
        const long L = (long)i * G + c; if (L >= nwg) return false;
        int wgid = (int)L; { const int q = nwg / NXCD, r = nwg % NXCD, xcd = wgid % NXCD, off = wgid / NXCD; wgid = (xcd < r ? xcd * (q + 1) : r * (q + 1) + (xcd - r) * q) + off; }
        const int nig = WGM * nN, gid = wgid / nig, fm = gid * WGM, gsz = (nM - fm) < WGM ? (nM - fm) : WGM;
        pm = fm + ((wgid % nig) % gsz); pn = (wgid % nig) / gsz; return true;
    }
};

__device__ __forceinline__ unsigned cvt_pk_bf16(float lo, float hi) { unsigned r; asm volatile("v_cvt_pk_bf16_f32 %0, %1, %2" : "=v"(r) : "v"(lo), "v"(hi)); return r; }
typedef f32x4 Acc[2][2][4][2];
#ifndef NT_STORE
#define NT_STORE 0
#endif
__device__ __forceinline__ void st16(void* p, const v4u w) { if (NT_STORE) __builtin_nontemporal_store(w, (v4u*)p); else *(v4u*)p = w; }
#ifndef NT_Y
#define NT_Y 1
#endif

template <class Epi, class Sched, bool ALIGN_EPI, bool GATHER, bool FP8 = false>
__device__ __forceinline__ void gemm_phase(LAS unsigned char* lds, const int wave_idx, const int lda, const int ldb, const int K, const Sched& S, Epi& E) {
    const int lane = lane_id();
    int wid = wave_idx; asm volatile("" : "+s"(wid));
    const int tid = wid * 64 + lane, wr = wid >> 2, wc = wid & 3, fr = lane & 15, fq = lane >> 4;
    const int nt = K / BK;
    unsigned voffA[2], voffB[2];
#pragma unroll
    for (int i = 0; i < 2; ++i) { int R, C; stage_rc(tid * 16 + i * 8192, R, C); const int Rb = (R & ~31) + perm32(R & 31);
        voffA[i] = (unsigned)(R * lda + C) * 2u; voffB[i] = (unsigned)(Rb * ldb + C) * 2u; }
    const size_t kstep = (size_t)(BK * 2);
    const size_t hstepA = (size_t)HALF * lda * 2, hstepB = (size_t)HALF * ldb * 2;
    const unsigned ldsw = (unsigned)wid * 1024u;
    const int aoff = lds_byte(wr * 64 + fr, fq * 8), boff = lds_byte(wc * 32 + fr, fq * 8);
    unsigned vgc[2][2], vgn[2][2];
#define PG8_SA(b, h) (((b) * 2 + (h)) * HTB)
#define PG8_SB(b, h) ((4 + (b) * 2 + (h)) * HTB)
#define PG8_GL(gp, voff, bufoff, _i) __builtin_amdgcn_global_load_lds((const unsigned*)((const char*)(gp) + (voff)), (LAS unsigned*)(lds + (bufoff) + ldsw + (_i) * 8192), 16, 0, 0)
#define PG8_STAGE_B(bufoff, gbase) do { PG8_GL(gbase, voffB[0], bufoff, 0); PG8_GL(gbase, voffB[1], bufoff, 1); } while (0)
#define PG8_STAGE_A(bufoff, gbase, h, VG) do { if constexpr (GATHER) { PG8_GL(gbase, VG[h][0], bufoff, 0); PG8_GL(gbase, VG[h][1], bufoff, 1); } \
        else { PG8_GL((gbase) + (h) * hstepA, voffA[0], bufoff, 0); PG8_GL((gbase) + (h) * hstepA, voffA[1], bufoff, 1); } } while (0)
#define PG8_CAT(x0, x1) __builtin_shufflevector(__builtin_bit_cast(v4i_t, x0), __builtin_bit_cast(v4i_t, x1), 0, 1, 2, 3, 4, 5, 6, 7)
#define PG8_RD(off) (*(const LAS bf16x8*)(lds + (off)))
#define PG8_LDA(dst, b, h) do { if constexpr (FP8) { _Pragma("unroll") for (int m = 0; m < 4; ++m) dst##8[m] = PG8_CAT(PG8_RD(PG8_SA(b, h) + aoff + m * 2048), PG8_RD(PG8_SA(b, h) + aoff + m * 2048 + 1024)); } \
        else { _Pragma("unroll") for (int m = 0; m < 4; ++m) _Pragma("unroll") for (int k = 0; k < 2; ++k) dst[m][k] = PG8_RD(PG8_SA(b, h) + aoff + m * 2048 + k * 1024); } } while (0)
#define PG8_LDB(dst, b, h) do { if constexpr (FP8) { _Pragma("unroll") for (int n = 0; n < 2; ++n) dst##8[n] = PG8_CAT(PG8_RD(PG8_SB(b, h) + boff + n * 2048), PG8_RD(PG8_SB(b, h) + boff + n * 2048 + 1024)); } \
        else { _Pragma("unroll") for (int n = 0; n < 2; ++n) _Pragma("unroll") for (int k = 0; k < 2; ++k) dst[n][k] = PG8_RD(PG8_SB(b, h) + boff + n * 2048 + k * 1024); } } while (0)
#define PG8_MMA(ai, bj, At, Bt) do { __builtin_amdgcn_s_setprio(1); _Pragma("unroll") for (int m = 0; m < 4; ++m) _Pragma("unroll") for (int n = 0; n < 2; ++n) { \
        if constexpr (FP8) asm volatile("v_mfma_scale_f32_16x16x128_f8f6f4 %0, %1, %2, %0, %3, %3 op_sel_hi:[0,0,0]" : "+v"(acc[ai][bj][m][n]) : "v"(Bt##8[n]), "v"(At##8[m]), "v"(sc8)); \
        else { _Pragma("unroll") for (int k = 0; k < 2; ++k) acc[ai][bj][m][n] = __builtin_amdgcn_mfma_f32_16x16x32_bf16(Bt[n][k], At[m][k], acc[ai][bj][m][n], 0, 0, 0); } } __builtin_amdgcn_s_setprio(0); } while (0)
#define PG8_WAIT_V(n) asm volatile("s_waitcnt vmcnt(" #n ")" ::: "memory")
#define PG8_WAIT_L(n) asm volatile("s_waitcnt lgkmcnt(" #n ")" ::: "memory")
#define PG8_BAR __builtin_amdgcn_s_barrier()
#define PG8_SCHED __builtin_amdgcn_sched_barrier(0)
#define PG8_GIDX(VG, U) do { const int _t = wid * 64 + lane_id();   \
        _Pragma("unroll") for (int _i = 0; _i < 2; ++_i) { int _R, _C; stage_rc(_t * 16 + _i * 8192, _R, _C); _Pragma("unroll") for (int _h = 0; _h < 2; ++_h) \
        VG[_h][_i] = (unsigned)((U).grow + (U).gi[_h * HALF + _R]) * (unsigned)(lda * 2) + (unsigned)_C * 2u; } } while (0)
    Unit cur, nxt; int ui = 0;
    if (!S.next(0, cur)) return;
    Acc acc;
#pragma unroll
    for (int a = 0; a < 2; ++a)
#pragma unroll
        for (int b = 0; b < 2; ++b)
#pragma unroll
            for (int m = 0; m < 4; ++m)
#pragma unroll
                for (int n = 0; n < 2; ++n) acc[a][b][m][n] = (f32x4){0.f, 0.f, 0.f, 0.f};
    bf16x8 At[4][2], B0[2][2], B1[2][2];
    v8i_t At8[4], B08[2], B18[2];
    unsigned sc8 = 0x7f7f7f7fu; asm volatile("" : "+v"(sc8));
    const char* cA = cur.a; const char* cB = cur.b;
    if constexpr (GATHER) { PG8_GIDX(vgc, cur); } else { vgc[0][0] = vgc[0][1] = vgc[1][0] = vgc[1][1] = 0u; }
    E.prep(cur, wr, wc, fr, fq);
    PG8_STAGE_B(PG8_SB(0, 0), cB); PG8_STAGE_B(PG8_SB(0, 1), cB + hstepB); PG8_STAGE_A(PG8_SA(0, 0), cA, 0, vgc); PG8_STAGE_A(PG8_SA(0, 1), cA, 1, vgc);
    if (wr == 1) PG8_BAR;
    PG8_WAIT_V(2); PG8_BAR;
    PG8_STAGE_B(PG8_SB(1, 0), cB + kstep); PG8_STAGE_A(PG8_SA(1, 0), cA + kstep, 0, vgc); PG8_STAGE_B(PG8_SB(1, 1), cB + hstepB + kstep);
    PG8_WAIT_V(6); PG8_BAR;
    for (;;) {
        const bool has_next = S.next(ui + 1, nxt);
        const char* nA = has_next ? nxt.a : cA; const char* nB = has_next ? nxt.b : cB;
        if constexpr (GATHER) { if (has_next) { PG8_GIDX(vgn, nxt); } else {
#pragma unroll
            for (int h = 0; h < 2; ++h) { vgn[h][0] = vgc[h][0]; vgn[h][1] = vgc[h][1]; } } }
        else { vgn[0][0] = vgn[0][1] = vgn[1][0] = vgn[1][1] = 0u; }
        for (int t = 0; t < nt; t += 2) {
            const bool last = (t == nt - 2);
            const char* a1 = cA + (size_t)(t + 1) * kstep;
            const char* a2 = last ? nA : cA + (size_t)(t + 2) * kstep; const char* b2 = last ? nB : cB + (size_t)(t + 2) * kstep;
            const char* a3 = a2 + kstep; const char* b3 = b2 + kstep;
            if constexpr (Epi::MIDK) { if (t == (nt >> 1)) E.midk(acc); }
            PG8_LDB(B0, 0, 0); PG8_LDB(B1, 0, 1); PG8_SCHED; PG8_LDA(At, 0, 0); PG8_STAGE_A(PG8_SA(1, 1), a1, 1, vgc);
            if constexpr (GATHER) { if (last) {
#pragma unroll
                for (int h = 0; h < 2; ++h) { vgc[h][0] = vgn[h][0]; vgc[h][1] = vgn[h][1]; } } }
            PG8_WAIT_V(8); PG8_WAIT_L(0); PG8_BAR; PG8_MMA(0, 0, At, B0); PG8_MMA(0, 1, At, B1); PG8_BAR; PG8_SCHED;
            PG8_LDA(At, 0, 1); PG8_STAGE_B(PG8_SB(0, 0), b2); PG8_STAGE_B(PG8_SB(0, 1), b2 + hstepB); PG8_STAGE_A(PG8_SA(0, 0), a2, 0, vgc);
            PG8_WAIT_V(8); PG8_WAIT_L(0); PG8_BAR; PG8_MMA(1, 0, At, B0); PG8_MMA(1, 1, At, B1); PG8_BAR; PG8_SCHED;
            PG8_LDB(B0, 1, 0); PG8_LDB(B1, 1, 1); PG8_SCHED; PG8_LDA(At, 1, 0); PG8_STAGE_A(PG8_SA(0, 1), a2, 1, vgc);
            PG8_WAIT_V(8); PG8_WAIT_L(0); PG8_BAR; PG8_MMA(0, 0, At, B0); PG8_MMA(0, 1, At, B1); PG8_BAR; PG8_SCHED;
            PG8_LDA(At, 1, 1); PG8_STAGE_B(PG8_SB(1, 0), b3); PG8_STAGE_B(PG8_SB(1, 1), b3 + hstepB); PG8_STAGE_A(PG8_SA(1, 0), a3, 0, vgc);
            PG8_WAIT_V(8); PG8_WAIT_L(0); PG8_BAR; PG8_MMA(1, 0, At, B0); PG8_MMA(1, 1, At, B1); PG8_BAR; PG8_SCHED;
        }
        if constexpr (ALIGN_EPI) { if (wr == 0) PG8_BAR; }
        E(acc, cur, wr, wc, fr, fq);
        if (!has_next) break;
#pragma unroll
        for (int a = 0; a < 2; ++a)
#pragma unroll
            for (int b = 0; b < 2; ++b)
#pragma unroll
                for (int m = 0; m < 4; ++m)
#pragma unroll
                    for (int n = 0; n < 2; ++n) acc[a][b][m][n] = (f32x4){0.f, 0.f, 0.f, 0.f};
        cur = nxt; cA = nA; cB = nB; ++ui;
#pragma unroll
        for (int h = 0; h < 2; ++h) { vgc[h][0] = vgn[h][0]; vgc[h][1] = vgn[h][1]; }
        E.prep(cur, wr, wc, fr, fq);
        if constexpr (ALIGN_EPI) { if (wr == 1) PG8_BAR; }
    }
    PG8_WAIT_V(0);
    if constexpr (!ALIGN_EPI) { if (wr == 0) PG8_BAR; }
    PG8_BAR;
#undef PG8_SA
#undef PG8_SB
#undef PG8_GL
#undef PG8_STAGE_A
#undef PG8_STAGE_B
#undef PG8_LDA
#undef PG8_RD
#undef PG8_LDB
#undef PG8_MMA
#undef PG8_CAT
#undef PG8_WAIT_V
#undef PG8_WAIT_L
#undef PG8_SCHED
#undef PG8_GIDX
}

#define EPI_ROWS for (int ai = 0; ai < 2; ++ai) _Pragma("unroll") for (int m = 0; m < 4; ++m)
__device__ __forceinline__ v4u pack8(const f32x4 a, const f32x4 b) { v4u w; w.x = cvt_pk_bf16(a[0], a[1]); w.y = cvt_pk_bf16(a[2], a[3]); w.z = cvt_pk_bf16(b[0], b[1]); w.w = cvt_pk_bf16(b[2], b[3]); return w; }

template <int mode>
struct EpiStore {
    static constexpr bool MIDK = false;
    bf16* O; int ldc; const float* cs; float scale; bool skip = false;
    __device__ __forceinline__ void prep(const Unit&, int, int, int, int) {}
    __device__ __forceinline__ void midk(Acc&) {}
    __device__ __forceinline__ void operator()(const Acc& acc, const Unit& u, int wr, int wc, int fr, int fq) const {
        asm volatile("" : "+v"(fr), "+v"(fq));
        if (skip) return;
        size_t base; const float* csp = cs;
        if constexpr (mode == 0) base = (size_t)u.pm * 256 * ldc + (size_t)u.pn * 256;
        else if constexpr (mode == 1) { const int lb = u.pm >> 2, h = u.pm & 3; base = (size_t)lb * D * D + (size_t)(h * 256) * D + u.pn * 256; csp = cs + (size_t)(lb >> 2) * D + u.pn * 256; }
        else if constexpr (mode == 2) { const int pml = u.pm & 3, lbh = u.pm >> 2, h = lbh & 3, lb = lbh >> 2; base = (size_t)lb * D * D + (size_t)(pml * 256) * D + h * 256; }
        else { const int l = u.pm >> 2, pml = u.pm & 3; base = (size_t)l * NMEM * 2 * D + (size_t)(pml * 256) * 2 * D + u.pn * 256; }
        const int cb = wc * 32 + 8 * fq;
        f32x4 c0[2], c1[2];
#pragma unroll
        for (int bj = 0; bj < 2; ++bj) { if (csp) { c0[bj] = *(const f32x4*)(csp + bj * HALF + cb) * scale; c1[bj] = *(const f32x4*)(csp + bj * HALF + cb + 4) * scale; } else { c0[bj] = (f32x4){scale, scale, scale, scale}; c1[bj] = c0[bj]; } }
#pragma unroll
        EPI_ROWS { bf16* rowp = O + base + (size_t)(ai * HALF + wr * 64 + m * 16 + fr) * ldc + cb;
#pragma unroll
            for (int bj = 0; bj < 2; ++bj) { const v4u w_ = pack8(acc[ai][bj][m][0] * c0[bj], acc[ai][bj][m][1] * c1[bj]); if constexpr (mode == 0 && NT_Y) __builtin_nontemporal_store(w_, (v4u*)(rowp + bj * HALF)); else *(v4u*)(rowp + bj * HALF) = w_; } }
    }
};
struct EpiH {
    static constexpr bool MIDK = false;
    unsigned char* H;
    __device__ __forceinline__ void prep(const Unit&, int, int, int, int) {}
    __device__ __forceinline__ void midk(Acc&) {}
    __device__ __forceinline__ void operator()(const Acc& acc, const Unit& u, int wr, int wc, int fr, int fq) const {
        asm volatile("" : "+v"(fr), "+v"(fq));
        const int cb = u.pn * 128 + wc * 32 + 8 * fq; constexpr float us = 1.0f / (W8S * A8S);
#pragma unroll
        EPI_ROWS { const int rl = ai * HALF + wr * 64 + m * 16 + fr; unsigned char* rowp = H + (size_t)(u.pm * 256 + rl) * FF + cb;
            f32x4 h0, h1;
#pragma unroll
            for (int i = 0; i < 4; ++i) { h0[i] = silu_f(acc[ai][0][m][0][i] * us) * (acc[ai][1][m][0][i] * (us * H8S)); h1[i] = silu_f(acc[ai][0][m][1][i] * us) * (acc[ai][1][m][1][i] * (us * H8S)); }
            v2u o; o.x = pk4_fp8(h0[0], h0[1], h0[2], h0[3]); o.y = pk4_fp8(h1[0], h1[1], h1[2], h1[3]); *(v2u*)rowp = o; }
    }
};
struct EpiY8 {
    static constexpr bool MIDK = false;
    unsigned char* Y; float scale; bool skip = false;
    __device__ __forceinline__ void prep(const Unit&, int, int, int, int) {}
    __device__ __forceinline__ void midk(Acc&) {}
    __device__ __forceinline__ void operator()(const Acc& acc, const Unit& u, int wr, int wc, int fr, int fq) const {
        if (skip) return;
        asm volatile("" : "+v"(fr), "+v"(fq));
        const int cb = u.pn * 256 + wc * 32 + 8 * fq;
#pragma unroll
        EPI_ROWS { unsigned char* rowp = Y + (size_t)(u.pm * 256 + ai * HALF + wr * 64 + m * 16 + fr) * D + cb;
#pragma unroll
            for (int bj = 0; bj < 2; ++bj) { const f32x4 a = acc[ai][bj][m][0] * scale, b = acc[ai][bj][m][1] * scale;
                v2u o; o.x = pk4_fp8(a[0], a[1], a[2], a[3]); o.y = pk4_fp8(b[0], b[1], b[2], b[3]); __builtin_nontemporal_store(o, (v2u*)(rowp + bj * HALF)); } }
    }
};
template <bool MK, bool WRITE_XB>
struct EpiX {
    static constexpr bool MIDK = MK;
    bf16* xr; float* xstat; const float* gmstat; const float* atstat; LAS unsigned char* lds;
    int wr_, wc_, fr_;
    __device__ __forceinline__ void prep(const Unit& u, int wr, int wc, int fr, int fq) {
        wr_ = wr; wc_ = wc; fr_ = fr;
        if constexpr (MK) {
            asm volatile("" : "+v"(fr), "+v"(fq));
            LAS f32x2* X = (LAS f32x2*)(lds + RING_BYTES + 1024) + (wr * 4 + wc) * 128;
#pragma unroll
            EPI_ROWS { const size_t row = (size_t)u.pm * 256 + ai * HALF + wr * 64 + m * 16 + fr;
                const f32x4 g = *(const f32x4*)(gmstat + row * 4), a0 = *(const f32x4*)(atstat + row * 8), a1 = *(const f32x4*)(atstat + row * 8 + 4);
                const float sg = (g[0] + g[1]) + (g[2] + g[3]), sa = ((a0[0] + a0[1]) + (a0[2] + a0[3])) + ((a1[0] + a1[1]) + (a1[2] + a1[3]));
                const float rgm = __builtin_amdgcn_rsqf(sg * (1.0f / 512.0f) + EPS), rat = __builtin_amdgcn_rsqf(sa * (1.0f / 512.0f) + EPS);
                if (fq == 0) X[(ai * 4 + m) * 16 + fr] = (f32x2){rgm / rat, rat}; }
            asm volatile("s_waitcnt lgkmcnt(0)" ::: "memory");
        }
    }
    __device__ __forceinline__ void midk(Acc& acc) {
        int fr = fr_; asm volatile("" : "+v"(fr));
        const LAS f32x2* X = (const LAS f32x2*)(lds + RING_BYTES + 1024) + (wr_ * 4 + wc_) * 128;
#pragma unroll
        EPI_ROWS { const float f = X[(ai * 4 + m) * 16 + fr].x;
#pragma unroll
            for (int bj = 0; bj < 2; ++bj) { acc[ai][bj][m][0] *= f; acc[ai][bj][m][1] *= f; } }
    }
    __device__ __forceinline__ void operator()(const Acc& acc, const Unit& u, int wr, int wc, int fr, int fq) const {
        asm volatile("" : "+v"(fr), "+v"(fq));
        const int cb = u.pn * 256 + wc * 32 + 8 * fq;
#pragma unroll
        EPI_ROWS { const size_t row = (size_t)u.pm * 256 + ai * HALF + wr * 64 + m * 16 + fr; const size_t off = row * D + cb;
            float f = 1.0f; if constexpr (MK) f = ((const LAS f32x2*)(lds + RING_BYTES + 1024) + (wr * 4 + wc) * 128)[(ai * 4 + m) * 16 + fr].y; float ss = 0.f;
#pragma unroll
            for (int bj = 0; bj < 2; ++bj) { const v4u b = *(const v4u*)(xr + off + bj * HALF);
                const f32x4 x0 = (f32x4){bflo(b.x), bfhi(b.x), bflo(b.y), bfhi(b.y)} + acc[ai][bj][m][0] * f, x1 = (f32x4){bflo(b.z), bfhi(b.z), bflo(b.w), bfhi(b.w)} + acc[ai][bj][m][1] * f;
                *(v4u*)(xr + off + bj * HALF) = pack8(x0, x1);
                if constexpr (WRITE_XB) ss += ((x0[0] * x0[0] + x0[1] * x0[1]) + (x0[2] * x0[2] + x0[3] * x0[3])) + ((x1[0] * x1[0] + x1[1] * x1[1]) + (x1[2] * x1[2] + x1[3] * x1[3])); }
            if constexpr (WRITE_XB) { ss = add_x32(add_x16(ss)); if (fq == 0) xstat[row * 16 + u.pn * 4 + wc] = ss; }
            if (m & 1) asm volatile("" ::: "memory"); }
    }
};
constexpr int EXCH_OFF = RING_BYTES + 1024;
struct EpiS {
    static constexpr bool MIDK = false;
    const float* xstat; bf16* P; LAS unsigned char* lds;
    __device__ __forceinline__ void prep(const Unit&, int, int, int, int) {}
    __device__ __forceinline__ void midk(Acc&) {}
    __device__ __forceinline__ void operator()(Acc& acc, const Unit& u, int wr, int wc, int fr, int fq) const {
        asm volatile("" : "+v"(fr), "+v"(fq));
        LAS f32x2* X = (LAS f32x2*)(lds + EXCH_OFF);
        float mw[2][4];
#pragma unroll
        EPI_ROWS { const int rl = ai * HALF + wr * 64 + m * 16 + fr; const size_t row = (size_t)u.pm * 256 + rl;
            const f32x4 s0 = *(const f32x4*)(xstat + row * 16), s1 = *(const f32x4*)(xstat + row * 16 + 4), s2 = *(const f32x4*)(xstat + row * 16 + 8), s3 = *(const f32x4*)(xstat + row * 16 + 12);
            const float ssq = (((s0[0] + s0[1]) + (s0[2] + s0[3])) + ((s1[0] + s1[1]) + (s1[2] + s1[3]))) + (((s2[0] + s2[1]) + (s2[2] + s2[3])) + ((s3[0] + s3[1]) + (s3[2] + s3[3])));
            const float rinv = __builtin_amdgcn_rsqf(ssq * (1.0f / D) + EPS);
            float mx = -3.0e38f;
#pragma unroll
            for (int bj = 0; bj < 2; ++bj)
#pragma unroll
                for (int n = 0; n < 2; ++n) { acc[ai][bj][m][n] *= rinv; const f32x4 v = acc[ai][bj][m][n]; mx = fmaxf(mx, fmaxf(fmaxf(v[0], v[1]), fmaxf(v[2], v[3]))); }
            mx = max_x32(max_x16(mx));
            float sm = 0.f;
#pragma unroll
            for (int bj = 0; bj < 2; ++bj)
#pragma unroll
                for (int n = 0; n < 2; ++n) { f32x4 v = acc[ai][bj][m][n];
#pragma unroll
                    for (int i = 0; i < 4; ++i) { v[i] = __builtin_amdgcn_exp2f(v[i] - mx); sm += v[i]; }
                    acc[ai][bj][m][n] = v; }
            sm = add_x32(add_x16(sm));
            mw[ai][m] = mx;
            if (fq == 0) X[rl * 4 + wc] = (f32x2){mx, sm};
            if (m & 1) asm volatile("" ::: "memory"); }
        asm volatile("s_waitcnt lgkmcnt(0)\n\ts_barrier" ::: "memory");
        const int cb = u.pn * 256 + wc * 32 + 8 * fq;
#pragma unroll
        EPI_ROWS { const int rl = ai * HALF + wr * 64 + m * 16 + fr; const size_t row = (size_t)u.pm * 256 + rl;
            const f32x2 e0 = X[rl * 4 + 0], e1 = X[rl * 4 + 1], e2 = X[rl * 4 + 2], e3 = X[rl * 4 + 3];
            const float M = fmaxf(fmaxf(e0.x, e1.x), fmaxf(e2.x, e3.x));
            const float den = (e0.y * __builtin_amdgcn_exp2f(e0.x - M) + e1.y * __builtin_amdgcn_exp2f(e1.x - M)) + (e2.y * __builtin_amdgcn_exp2f(e2.x - M) + e3.y * __builtin_amdgcn_exp2f(e3.x - M));
            const float f = __builtin_amdgcn_exp2f(mw[ai][m] - M) * __builtin_amdgcn_rcpf(den);
#pragma unroll
            for (int bj = 0; bj < 2; ++bj) st16(P + row * D + cb + bj * HALF, pack8(acc[ai][bj][m][0] * f, acc[ai][bj][m][1] * f)); }
        asm volatile("s_waitcnt lgkmcnt(0)" ::: "memory");
    }
};
struct EpiIn {
    static constexpr bool MIDK = false;
    bf16 *uact, *vact, *q, *k, *v; float* vstat; const float *qg, *kg, *cosT, *sinT, *rinv;
    __device__ __forceinline__ void prep(const Unit&, int, int, int, int) {}
    __device__ __forceinline__ void midk(Acc&) {}
    __device__ __forceinline__ void operator()(const Acc& acc, const Unit& u, int wr, int wc, int fr, int fq) const {
        asm volatile("" : "+v"(fr), "+v"(fq));
        const int pn = u.pn;
        if (pn < 4) {
            bf16* O = pn < 2 ? uact : vact; const int cb = (pn & 1) * 256 + wc * 32 + 8 * fq;
#pragma unroll
            EPI_ROWS { const size_t row = (size_t)u.pm * 256 + ai * HALF + wr * 64 + m * 16 + fr; float ss = 0.f; const float ri = rinv[row];
#pragma unroll
                for (int bj = 0; bj < 2; ++bj) { f32x4 g0, g1;
#pragma unroll
                    for (int i = 0; i < 4; ++i) { g0[i] = gelu_tanh(acc[ai][bj][m][0][i] * ri); g1[i] = gelu_tanh(acc[ai][bj][m][1][i] * ri); }
                    const v4u w = pack8(g0, g1); st16(O + row * GMW + cb + bj * HALF, w);
                    if (pn >= 2) { const float a0 = bflo(w.x), a1 = bfhi(w.x), a2 = bflo(w.y), a3 = bfhi(w.y), a4 = bflo(w.z), a5 = bfhi(w.z), a6 = bflo(w.w), a7 = bfhi(w.w);
                        ss += ((a0 * a0 + a1 * a1) + (a2 * a2 + a3 * a3)) + ((a4 * a4 + a5 * a5) + (a6 * a6 + a7 * a7)); } }
                if (pn >= 2) { ss = add_x32(add_x16(ss)); if (fq == 0) vstat[row * 8 + (pn - 2) * 4 + wc] = ss; } }
        } else if (pn == 6 && wc >= 2) {
#pragma unroll
            EPI_ROWS { const size_t row = (size_t)u.pm * 256 + ai * HALF + wr * 64 + m * 16 + fr; const float ri = rinv[row];
#pragma unroll
                for (int bj = 0; bj < 2; ++bj) st16(v + row * 128 + (wc - 2) * 64 + bj * 32 + 8 * fq, pack8(acc[ai][bj][m][0] * ri, acc[ai][bj][m][1] * ri)); }
        } else {
            const bool isq = pn < 6; const float* g = isq ? qg : kg; const float sc = isq ? QSCALE : 1.0f;
            bf16* O = isq ? q + ((pn - 4) * 4 + wc) * 64 : k + wc * 64; const int ldo = isq ? 512 : 128;
            f32x4 gv[2][2];
#pragma unroll
            for (int bj = 0; bj < 2; ++bj) { gv[bj][0] = *(const f32x4*)(g + bj * 32 + 8 * fq) * sc; gv[bj][1] = *(const f32x4*)(g + bj * 32 + 8 * fq + 4) * sc; }
#pragma unroll
            EPI_ROWS { const size_t row = (size_t)u.pm * 256 + ai * HALF + wr * 64 + m * 16 + fr; const int t = (int)(row % SEQ); const float ri = this->rinv[row];
                float ss = 0.f;
#pragma unroll
                for (int bj = 0; bj < 2; ++bj)
#pragma unroll
                    for (int n = 0; n < 2; ++n) { const f32x4 x = acc[ai][bj][m][n]; ss += (x[0] * x[0] + x[1] * x[1]) + (x[2] * x[2] + x[3] * x[3]); }
                ss = add_x32(add_x16(ss));
                const float rinv = ri * __builtin_amdgcn_rsqf(ss * (ri * ri) * (1.0f / 64.0f) + EPS);
#pragma unroll
                for (int bj = 0; bj < 2; ++bj) { const f32x4 c = *(const f32x4*)(cosT + t * 32 + bj * 16 + 4 * fq), sn = *(const f32x4*)(sinT + t * 32 + bj * 16 + 4 * fq);
                    const f32x4 x0 = acc[ai][bj][m][0] * gv[bj][0] * rinv, x1 = acc[ai][bj][m][1] * gv[bj][1] * rinv; f32x4 o0, o1;
                    o0[0] = x0[0] * c[0] - x0[1] * sn[0]; o0[1] = x0[0] * sn[0] + x0[1] * c[0]; o0[2] = x0[2] * c[1] - x0[3] * sn[1]; o0[3] = x0[2] * sn[1] + x0[3] * c[1];
                    o1[0] = x1[0] * c[2] - x1[1] * sn[2]; o1[1] = x1[0] * sn[2] + x1[1] * c[2]; o1[2] = x1[2] * c[3] - x1[3] * sn[3]; o1[3] = x1[2] * sn[3] + x1[3] * c[3];
                    st16(O + row * ldo + bj * 32 + 8 * fq, pack8(o0, o1)); }
                if (m & 1) asm volatile("" ::: "memory"); }
        }
    }
};
}


struct CvtJob { const float* W; const float* gain; bf16* WT; int K, N, dst_row0, k0, n0; bool f8; };
__device__ __forceinline__ CvtJob cvt_decode(const Frame& F, int it) {
    constexpr int I_IN = 16 * 56, I_SQ = 512, I_KV = 1024, I_HEAD = I_IN + I_SQ + I_KV + I_SQ, I_LAYER = I_HEAD + NE * 3 * I_SQ;
    CvtJob j; j.f8 = false; const int l = it / I_LAYER; int r = it % I_LAYER;
    if (r < I_IN) { const int kb = r / 56, nb = r % 56, n0 = nb * 32, pn = n0 >> 8; int dr = n0;
        if (pn >= 4) { const int sidx = n0 & 255, w = sidx >> 6, bj = (sidx >> 5) & 1; dr = pn * 256 + 128 * bj + 32 * w; }
        j.W = F.in[3] + (size_t)l * D * INW; j.gain = F.in[2] + (size_t)l * D; j.WT = (bf16*)(F.ws + WS_WIN) + (size_t)l * INW * D; j.K = D; j.N = INW; j.dst_row0 = dr; j.k0 = kb * 64; j.n0 = n0; return j; }
    r -= I_IN;
    if (r < I_SQ) { j.W = F.in[10] + (size_t)l * D * D; j.gain = F.in[9] + (size_t)l * D; j.WT = (bf16*)(F.ws + WS_WOUT) + (size_t)l * D * D; j.K = D; j.N = D; j.dst_row0 = (r % 32) * 32; j.k0 = (r / 32) * 64; j.n0 = (r % 32) * 32; return j; }
    r -= I_SQ;
    if (r < I_KV) { j.W = F.in[14] + (size_t)l * D * 2 * D; j.gain = nullptr; j.WT = (bf16*)(F.ws + WS_WKVT) + (size_t)l * 2 * D * D; j.K = D; j.N = 2 * D; j.dst_row0 = (r % 64) * 32; j.k0 = (r / 64) * 64; j.n0 = (r % 64) * 32; return j; }
    r -= I_KV;
    if (r < I_SQ) { j.W = F.in[15] + (size_t)l * D * D; j.gain = nullptr; j.WT = (bf16*)(F.ws + WS_WOT) + (size_t)l * D * D; j.K = D; j.N = D; j.dst_row0 = (r % 32) * 32; j.k0 = (r / 32) * 64; j.n0 = (r % 32) * 32; return j; }
    r -= I_SQ;
    const int e = r / (3 * I_SQ), rr = r % (3 * I_SQ), which = rr / I_SQ, sub = rr % I_SQ, kb = sub / 32, n0 = (sub % 32) * 32;
    const size_t mo = ((size_t)l * NE + e) * D * FF;
    j.K = D; j.N = FF; j.k0 = kb * 64; j.n0 = n0;
    j.f8 = true;
    if (which == 2) { j.W = F.in[20] + mo; j.gain = nullptr; j.WT = (bf16*)(F.ws + WS_WD + mo); j.dst_row0 = n0; }
    else { j.W = (which == 0 ? F.in[18] : F.in[19]) + mo; j.gain = F.in[16] + (size_t)l * D; j.WT = (bf16*)(F.ws + WS_WGU + 2 * mo); j.dst_row0 = 256 * (n0 >> 7) + 128 * which + (n0 & 127); }
    return j;
}
#define CVT_LOAD(J, R) do { const float* p_ = (J).W + (size_t)((J).k0 + (lane_ >> 5)) * (J).N + (J).n0 + (lane_ & 31); _Pragma("unroll") for (int i_ = 0; i_ < 32; ++i_) R[i_] = p_[(size_t)(2 * i_) * (J).N]; } while (0)
__device__ __forceinline__ void ph_convert(Frame& F) {
    int lane_ = lane_id(); asm volatile("" : "+v"(lane_)); const int tid_ = F.wave * 64 + lane_;
    LAS float* scr = (LAS float*)(F.lds + F.wave * 16384);
    const int gw = F.vcu * NWAVES + F.wave, NGW = F.G * NWAVES;
    constexpr int I_LAYER = 16 * 56 + 512 + 1024 + 512 + NE * 3 * 512, NITEMS = NL * I_LAYER;
    if (gw < NITEMS) {
        int it = gw; CvtJob cur = cvt_decode(F, it); float r[32]; CVT_LOAD(cur, r);
        for (;;) {
            const int nit = it + NGW; const bool hn = nit < NITEMS; CvtJob nx = cur; if (hn) nx = cvt_decode(F, nit);
#pragma unroll
            for (int i = 0; i < 32; ++i) scr[(2 * i + (lane_ >> 5)) * 33 + (lane_ & 31)] = r[i];
            if (hn) CVT_LOAD(nx, r);
            asm volatile("s_waitcnt lgkmcnt(0)" ::: "memory");
            const int c = lane_ & 7;
            f32x4 g0 = (f32x4){1.f, 1.f, 1.f, 1.f}, g1 = g0;
            if (cur.gain) { g0 = *(const f32x4*)(cur.gain + cur.k0 + 8 * c); g1 = *(const f32x4*)(cur.gain + cur.k0 + 8 * c + 4); }
#pragma unroll
            for (int j = 0; j < 4; ++j) { const int n = (lane_ >> 3) + 8 * j; const LAS float* sp = scr + (8 * c) * 33 + n;
                if (cur.f8) { v2u o; o.x = pk4_fp8(sp[0 * 33] * g0[0] * W8S, sp[1 * 33] * g0[1] * W8S, sp[2 * 33] * g0[2] * W8S, sp[3 * 33] * g0[3] * W8S); o.y = pk4_fp8(sp[4 * 33] * g1[0] * W8S, sp[5 * 33] * g1[1] * W8S, sp[6 * 33] * g1[2] * W8S, sp[7 * 33] * g1[3] * W8S);
                    *(v2u*)((unsigned char*)cur.WT + (size_t)(cur.dst_row0 + n) * cur.K + cur.k0 + 8 * c) = o; }
                else { v4u o; o.x = pk2(sp[0 * 33] * g0[0], sp[1 * 33] * g0[1]); o.y = pk2(sp[2 * 33] * g0[2], sp[3 * 33] * g0[3]); o.z = pk2(sp[4 * 33] * g1[0], sp[5 * 33] * g1[1]); o.w = pk2(sp[6 * 33] * g1[2], sp[7 * 33] * g1[3]);
                    *(v4u*)(cur.WT + (size_t)(cur.dst_row0 + n) * cur.K + cur.k0 + 8 * c) = o; } }
            asm volatile("s_waitcnt lgkmcnt(0)" ::: "memory");
            if (!hn) break; cur = nx; it = nit;
        }
    }
    {   const float* wsrc = F.in[5]; bf16* WSBd = (bf16*)(F.ws + WS_WSB);
        for (int i = F.vcu * NTHR + tid_; i < NL * 4 * 128 * 128 / 8; i += F.G * NTHR) { const f32x4 a = *(const f32x4*)(wsrc + (size_t)i * 8), b = *(const f32x4*)(wsrc + (size_t)i * 8 + 4);
            v4u o; o.x = pk2(a.x, a.y); o.y = pk2(a.z, a.w); o.z = pk2(b.x, b.y); o.w = pk2(b.z, b.w); *(v4u*)(WSBd + (size_t)i * 8) = o; } }
    const int gt = F.vcu * NTHR + tid_, NGT = F.G * NTHR;
    const float* wq = F.in[13]; bf16* WQB = (bf16*)(F.ws + WS_WQB);
    for (int i = gt; i < NL * D * D / 8; i += NGT) { const f32x4 a = *(const f32x4*)(wq + (size_t)i * 8), b = *(const f32x4*)(wq + (size_t)i * 8 + 4);
        v4u o; o.x = pk2(a.x, a.y); o.y = pk2(a.z, a.w); o.z = pk2(b.x, b.y); o.w = pk2(b.z, b.w); *(v4u*)(WQB + (size_t)i * 8) = o; }
}

struct SchedDense {
    pg8::TileOrder o; const char* A; size_t a_tile; const char* B; size_t b_tile, b_batch; int bdiv, bmod;
    __device__ __forceinline__ bool next(int i, pg8::Unit& u) const { if (!o.tile(i, u.pm, u.pn)) return false;
        u.z = 0; u.gi = nullptr; u.grow = 0; u.a = A + (size_t)u.pm * a_tile; u.b = B + (size_t)((u.pm / bdiv) % bmod) * b_batch + (size_t)u.pn * b_tile; return true; }
};
struct SchedE1 {
    pg8::TileOrder o; const char* HBp; const int* IDX; const char* WGU;
    __device__ __forceinline__ bool next(int i, pg8::Unit& u) const { if (!o.tile(i, u.pm, u.pn)) return false;
        const int z = u.pm >> 2; u.z = z; u.gi = IDX + (size_t)u.pm * 256; u.grow = (z >> 4) * SEQ; u.a = HBp;
        u.b = WGU + (size_t)(z & 15) * (2 * FF * D) + (size_t)u.pn * (256 * D); return true; }
};
struct SchedKV { pg8::TileOrder o; const char* MEMN; const char* WKVT;
    __device__ __forceinline__ bool next(int i, pg8::Unit& u) const { if (!o.tile(i, u.pm, u.pn)) return false; u.z = 0; u.gi = nullptr; u.grow = 0;
        u.a = MEMN + (size_t)(u.pm & 3) * (256 * D * 2); u.b = WKVT + (size_t)(u.pm >> 2) * (2 * D * D * 2) + (size_t)u.pn * (256 * D * 2); return true; } };
struct SchedQK { pg8::TileOrder o; const char* KVM; const char* WQB;
    __device__ __forceinline__ bool next(int i, pg8::Unit& u) const { if (!o.tile(i, u.pm, u.pn)) return false; u.z = 0; u.gi = nullptr; u.grow = 0;
        const int h = u.pm & 3, lb = u.pm >> 2, b = lb & 3, l = lb >> 2;
        u.a = KVM + ((size_t)l * NMEM * 2 * D + (size_t)(b * 256) * 2 * D + h * 256) * 2; u.b = WQB + ((size_t)l * D * D + (size_t)u.pn * 256 * D + h * 256) * 2; return true; } };
struct SchedVO { pg8::TileOrder o; const char* KVM; const char* WOT;
    __device__ __forceinline__ bool next(int i, pg8::Unit& u) const { if (!o.tile(i, u.pm, u.pn)) return false; u.z = 0; u.gi = nullptr; u.grow = 0;
        const int pml = u.pm & 3, lbh = u.pm >> 2, h = lbh & 3, lb = lbh >> 2, b = lb & 3, l = lb >> 2;
        u.a = WOT + ((size_t)l * D * D + (size_t)pml * 256 * D + h * 256) * 2; u.b = KVM + ((size_t)l * NMEM * 2 * D + (size_t)(b * 256) * 2 * D + D + h * 256) * 2; return true; } };

namespace attn_body {
using bf16=__hip_bfloat16;
using bf16x8=__attribute__((ext_vector_type(8)))short;
using s16x4=__attribute__((ext_vector_type(4)))short;
using f32x16=__attribute__((ext_vector_type(16)))float;
using u32x4=__attribute__((ext_vector_type(4)))unsigned;
constexpr int SEQ=8192,D=64,QP=512,KP=128,OP=1024;
constexpr int NW=8,QBLK=32,QB=QBLK*NW,KVBLK=64,NQB=SEQ/QB;
constexpr int ATTN_UNIT_ROWS=QB;
__device__ __forceinline__ int crow(int r,int hi){return (r&3)+8*(r>>2)+4*hi;}
#define SBAR() __builtin_amdgcn_sched_barrier(0)
__device__ __forceinline__ void cmask(f32x16&p0,f32x16&p1,int jb,int qrel,int hi){
  const float NEG=-INFINITY; int kb=64*jb+4*hi;
  #pragma unroll
  for(int r=0;r<16;++r){int kv=kb+(r&3)+8*(r>>2); if(kv>qrel)p0[r]=NEG; if(kv+32>qrel)p1[r]=NEG;}
}

constexpr int NSLOT=3, SLOTB=8192;
constexpr int LDS_K=0, LDS_V=NSLOT*SLOTB, LDS_WS=2*NSLOT*SLOTB, LDS_OST=LDS_WS+NW*64*4, LDS_BYTES=LDS_OST+NW*4096;
constexpr float C2=0.125f*1.4426950408889634f;
__device__ __forceinline__ void glds16(const void*gsrc,unsigned lds_dst){unsigned keep;
  asm volatile("s_mov_b32 %0, m0\n\ts_mov_b32 m0, %2\n\ts_nop 0\n\tglobal_load_lds_dwordx4 %1, off\n\ts_mov_b32 m0, %0":"=&s"(keep):"v"(gsrc),"s"(lds_dst):"memory");}
__device__ __forceinline__ float max3f(float a,float b,float c){float r;asm("v_max3_f32 %0, %1, %2, %3":"=v"(r):"v"(a),"v"(b),"v"(c));return r;}
__device__ __forceinline__ float max2f(float a,float b){float r;asm("v_max_f32_e32 %0, %1, %2":"=v"(r):"v"(a),"v"(b));return r;}
__device__ __forceinline__ float fadd_s(float a,float b){float r;asm("v_add_f32_e32 %0, %1, %2":"=v"(r):"v"(a),"v"(b));return r;}
__device__ __forceinline__ float fsub_s(float a,float b){float r;asm("v_sub_f32_e32 %0, %1, %2":"=v"(r):"v"(a),"v"(b));return r;}
typedef float f32x2_t __attribute__((ext_vector_type(2))); typedef __bf16 bf16x2_t __attribute__((ext_vector_type(2)));
__device__ __forceinline__ unsigned cvtpk_s(float lo,float hi){f32x2_t v={lo,hi};bf16x2_t b=__builtin_convertvector(v,bf16x2_t);return __builtin_bit_cast(unsigned,b);}
#define WAIT_BAR(N) asm volatile("s_waitcnt vmcnt(" #N ") lgkmcnt(0)\n\ts_barrier":::"memory")

__device__ __forceinline__ void qkt(f32x16&p0,f32x16&p1,const char*Kslot,const bf16x8*qr,const f32x16&negm,int r32,int hi){
  const char*kb=Kslot+hi*1024+r32*16;
  #pragma unroll
  for(int d0=0;d0<4;++d0){
    const bf16x8 b0=*reinterpret_cast<const bf16x8*>(kb+d0*2048);
    const bf16x8 b1=*reinterpret_cast<const bf16x8*>(kb+d0*2048+512);
    if(d0==0){p0=__builtin_amdgcn_mfma_f32_32x32x16_bf16(b0,qr[0],negm,0,0,0);p1=__builtin_amdgcn_mfma_f32_32x32x16_bf16(b1,qr[0],negm,0,0,0);}
    else{p0=__builtin_amdgcn_mfma_f32_32x32x16_bf16(b0,qr[d0],p0,0,0,0);p1=__builtin_amdgcn_mfma_f32_32x32x16_bf16(b1,qr[d0],p1,0,0,0);}}
}
typedef __attribute__((address_space(3))) const char* lds_cptr;
typedef short v4i16_t __attribute__((ext_vector_type(4)));
__device__ __forceinline__ void kload8(bf16x8*kf,lds_cptr kp){
  kf[0]=*(const __attribute__((address_space(3))) bf16x8*)(kp);      kf[1]=*(const __attribute__((address_space(3))) bf16x8*)(kp+512);
  kf[2]=*(const __attribute__((address_space(3))) bf16x8*)(kp+2048); kf[3]=*(const __attribute__((address_space(3))) bf16x8*)(kp+2560);
  kf[4]=*(const __attribute__((address_space(3))) bf16x8*)(kp+4096); kf[5]=*(const __attribute__((address_space(3))) bf16x8*)(kp+4608);
  kf[6]=*(const __attribute__((address_space(3))) bf16x8*)(kp+6144); kf[7]=*(const __attribute__((address_space(3))) bf16x8*)(kp+6656);
}
__device__ __forceinline__ void kload2(bf16x8*kf,lds_cptr kp,int j){ kf[2*j]=*(const __attribute__((address_space(3))) bf16x8*)(kp+j*2048); kf[2*j+1]=*(const __attribute__((address_space(3))) bf16x8*)(kp+j*2048+512); }
__device__ __forceinline__ s16x4 vtr(lds_cptr p){ return __builtin_bit_cast(s16x4,__builtin_amdgcn_ds_read_tr16_b64_v4i16((__attribute__((address_space(3))) v4i16_t*)p)); }
__device__ __forceinline__ float rowmax(const f32x16&p0,const f32x16&p1){
  float a=max3f(p0[0],p0[1],p1[0]),b=max3f(p0[2],p0[3],p1[1]);a=max3f(a,p1[2],p1[3]);
  #pragma unroll
  for(int r=4;r<16;r+=4){a=max3f(a,p0[r],p0[r+1]);b=max3f(b,p0[r+2],p0[r+3]);a=max3f(a,p1[r],p1[r+1]);b=max3f(b,p1[r+2],p1[r+3]);}
  const float m=max2f(a,b);
  auto rr=__builtin_amdgcn_permlane32_swap(__float_as_uint(m),__float_as_uint(m),false,false);
  return max2f(__uint_as_float(rr[0]),__uint_as_float(rr[1]));
}
__device__ __forceinline__ void pv(f32x16*o,int vb,bf16x8 pa0,bf16x8 pa1,bf16x8 pa2,bf16x8 pa3){
  #pragma unroll
  for(int d0=0;d0<2;++d0){s16x4 lo[4],hi[4];
    #pragma unroll
    for(int ks=0;ks<4;++ks){
      asm volatile("ds_read_b64_tr_b16 %0,%1 offset:%c2":"=&v"(lo[ks]):"v"(vb),"i"(d0*4096+ks*1024):"memory");
      asm volatile("ds_read_b64_tr_b16 %0,%1 offset:%c2":"=&v"(hi[ks]):"v"(vb),"i"(d0*4096+ks*1024+512):"memory");}
    asm volatile("s_waitcnt lgkmcnt(0)":::"memory");SBAR();
    #define PK(k) (bf16x8){lo[k][0],lo[k][1],lo[k][2],lo[k][3],hi[k][0],hi[k][1],hi[k][2],hi[k][3]}
    o[d0]=__builtin_amdgcn_mfma_f32_32x32x16_bf16(pa0,PK(0),o[d0],0,0,0);
    o[d0]=__builtin_amdgcn_mfma_f32_32x32x16_bf16(pa1,PK(1),o[d0],0,0,0);
    o[d0]=__builtin_amdgcn_mfma_f32_32x32x16_bf16(pa2,PK(2),o[d0],0,0,0);
    o[d0]=__builtin_amdgcn_mfma_f32_32x32x16_bf16(pa3,PK(3),o[d0],0,0,0);
    #undef PK
  }
}

#ifndef ATTN_STORE16
#define ATTN_STORE16(p,v) (*(u32x4*)(p)=(v))
#endif
template<int THRL> __device__ __forceinline__ void attn_unit(int b,int h,int qb,const bf16*Q,const bf16*__restrict__ K,const bf16*__restrict__ V,bf16*O,float*ATS,char*shm,int wave_idx){
  int lane; asm volatile("v_mbcnt_lo_u32_b32 %0, -1, 0\n\tv_mbcnt_hi_u32_b32 %0, -1, %0":"=v"(lane)); const int r32=lane&31,hi=lane>>5; const int wid=wave_idx; const int kvh=h>>2;
  const long rowbase=(long)b*SEQ; const int q0=qb*QB;
  const bf16*Qw=Q+(rowbase+q0+wid*QBLK)*QP+h*D;
  const bf16*Kh=K+rowbase*KP+kvh*D,*Vh=V+rowbase*KP+kvh*D;
  const unsigned lds0=(unsigned)(uintptr_t)shm;
  float*wsf=(float*)(shm+LDS_WS)+wid*64;
  const bf16*ksrc=Kh+(long)lane*KP+wid*8;
  const bf16*vsrc=Vh+(long)(16*(wid&3)+(lane>>2))*KP+(wid>>2)*32+(lane&3)*8;
  const unsigned kdst=lds0+LDS_K+wid*1024, vdst=lds0+LDS_V+wid*1024;
  #define DMA_K(t,slot) glds16(ksrc+(long)(t)*KVBLK*KP,(unsigned)__builtin_amdgcn_readfirstlane(kdst+(slot)))
  #define DMA_V(t,slot) glds16(vsrc+(long)(t)*KVBLK*KP,(unsigned)__builtin_amdgcn_readfirstlane(vdst+(slot)))
  const int vb0=(int)(lds0+LDS_V)+((lane>>4)&1)*32+(lane&3)*8+(4*hi+((lane&15)>>2))*64;
  const char*Kbase=shm+LDS_K; bf16x8 kf[8];
  const lds_cptr shm3=(lds_cptr)shm; const lds_cptr kp0=shm3+LDS_K+hi*1024+r32*16; const lds_cptr vp0=shm3+LDS_V+((lane>>4)&1)*32+(lane&3)*8+(4*hi+((lane&15)>>2))*64;
  const int NT=SEQ/KVBLK;
  DMA_K(0,0);DMA_V(0,0);DMA_K(1,SLOTB);
  bf16x8 qr[4];
  #pragma unroll
  for(int d0=0;d0<4;++d0)qr[d0]=*reinterpret_cast<const bf16x8*>(&Qw[(long)r32*QP+d0*16+hi*8]);
  float mhat=0.f,l_reg=0.f;f32x16 o[2];o[0]=f32x16{};o[1]=f32x16{};f32x16 negm=f32x16{};asm volatile("":"+v"(negm));
  const int qrel=wid*QBLK+r32;
  #define CMASK(P0,P1,t) do{}while(0)
  bool resc=false;
  #define START(P0,P1) do{ const float rm=rowmax(P0,P1); resc=false; \
    { const float dl=rm; mhat=fadd_s(mhat,dl); \
      _Pragma("unroll") for(int r=0;r<16;++r){P0[r]=fsub_s(P0[r],dl);P1[r]=fsub_s(P1[r],dl);} \
      _Pragma("unroll") for(int r=0;r<16;++r)negm[r]=-mhat; asm volatile("":"+v"(negm)); } \
    _Pragma("unroll") for(int r=0;r<16;++r)P0[r]=__builtin_amdgcn_exp2f(P0[r]); }while(0)
  #define RESC() do{ if(resc){ asm volatile("s_waitcnt lgkmcnt(0)":::"memory"); \
      _Pragma("unroll") for(int d_=0;d_<2;++d_) _Pragma("unroll") for(int r=0;r<16;++r)o[d_][r]*=wsf[crow(r,hi)]; } }while(0)
  f32x16 pA0,pA1,pB0,pB1;
  int sl_prev=0,sl_cur=0,sl_next=SLOTB;
  #define ROT() do{sl_prev=sl_cur;sl_cur=sl_next;sl_next=(sl_next==(NSLOT-1)*SLOTB)?0:sl_next+SLOTB;}while(0)
  DMA_K(2,2*SLOTB);
  WAIT_BAR(3);
  qkt(pA0,pA1,Kbase,qr,negm,r32,hi);asm volatile("s_nop 15\n\ts_nop 7":"+v"(pA0),"+v"(pA1));CMASK(pA0,pA1,0);
  START(pA0,pA1);
  _Pragma("unroll") for(int r=0;r<16;++r)pA1[r]=__builtin_amdgcn_exp2f(pA1[r]);
  WAIT_BAR(0);
  DMA_K(3,0);DMA_V(1,SLOTB);
  ROT();
  kload8(kf,kp0+sl_cur);
  WAIT_BAR(2);
  s16x4 vlo[8],vhi[8]; u32x4 pw0,pw1,pw2,pw3;
  #define PKW(P,B) cvtpk_s(P[B],P[B+1])
  #define PAF(k) __builtin_bit_cast(bf16x8,pw##k)
  #define VFR(i) (bf16x8){vlo[i][0],vlo[i][1],vlo[i][2],vlo[i][3],vhi[i][0],vhi[i][1],vhi[i][2],vhi[i][3]}
  #define PIN(x) asm volatile("":"+v"(x))
  #define MX3(a,b,c) __builtin_fmaxf(__builtin_fmaxf((a),(b)),(c))
  #define GAPA(MF,A0,A1,A2,A3,W0,W1,PW) do{ MF; sacc+=A0; sacc+=A1; sacc+=A2; sacc+=A3; PIN(sacc); W0; W1; PIN(PW); SBAR(); }while(0)
  #define EX(v) __builtin_amdgcn_exp2f(v)
  #define GAPB(MF,X,B) do{ MF; X[B]=EX(X[B]); X[B+1]=EX(X[B+1]); X[B+2]=EX(X[B+2]); X[B+3]=EX(X[B+3]); PIN(X); SBAR(); }while(0)
  #define VRD(i) do{ vlo[i]=vtr(vp_+(((i)>>2)*4096+((i)&3)*1024)); vhi[i]=vtr(vp_+(((i)>>2)*4096+((i)&3)*1024+512)); }while(0)
  #define KRD(G,j) do{ if(G){ kload2(kf,kp0+sl_next,j); SBAR(); } }while(0)
  #define STEP(C0,C1,P0,P1,t,GK,GV,GL) do{ SBAR(); \
    const lds_cptr vp_=vp0+sl_prev; \
    VRD(0); SBAR(); float sacc=(P0[0]+P0[1]); \
    GAPA(C0=__builtin_amdgcn_mfma_f32_32x32x16_bf16(kf[0],qr[0],negm,0,0,0), P0[2],P0[3],P0[4],P0[5],     pw0[0]=PKW(P0,0), pw0[1]=PKW(P0,2), pw0); \
    VRD(4); SBAR(); GAPA(C1=__builtin_amdgcn_mfma_f32_32x32x16_bf16(kf[1],qr[0],negm,0,0,0), P0[6],P0[7],P0[8],P0[9],     pw0[2]=PKW(P0,4), pw0[3]=PKW(P0,6), pw0); \
    VRD(1); SBAR(); GAPA(C0=__builtin_amdgcn_mfma_f32_32x32x16_bf16(kf[2],qr[1],C0,0,0,0),   P0[10],P0[11],P0[12],P0[13], pw1[0]=PKW(P0,8), pw1[1]=PKW(P0,10), pw1); \
    VRD(5); SBAR(); GAPA(C1=__builtin_amdgcn_mfma_f32_32x32x16_bf16(kf[3],qr[1],C1,0,0,0),   P0[14],P0[15],P1[0],P1[1],   pw1[2]=PKW(P0,12),pw1[3]=PKW(P0,14), pw1); \
    VRD(2); SBAR(); GAPA(C0=__builtin_amdgcn_mfma_f32_32x32x16_bf16(kf[4],qr[2],C0,0,0,0),   P1[2],P1[3],P1[4],P1[5],     pw2[0]=PKW(P1,0), pw2[1]=PKW(P1,2), pw2); \
    VRD(6); SBAR(); GAPA(C1=__builtin_amdgcn_mfma_f32_32x32x16_bf16(kf[5],qr[2],C1,0,0,0),   P1[6],P1[7],P1[8],P1[9],     pw2[2]=PKW(P1,4), pw2[3]=PKW(P1,6), pw2); \
    VRD(3); SBAR(); GAPA(C0=__builtin_amdgcn_mfma_f32_32x32x16_bf16(kf[6],qr[3],C0,0,0,0),   P1[10],P1[11],P1[12],P1[13], pw3[0]=PKW(P1,8), pw3[1]=PKW(P1,10), pw3); \
    VRD(7); SBAR(); GAPA(C1=__builtin_amdgcn_mfma_f32_32x32x16_bf16(kf[7],qr[3],C1,0,0,0),   P1[14],P1[15],0.f,0.f,       pw3[2]=PKW(P1,12),pw3[3]=PKW(P1,14), pw3); \
    l_reg+=sacc; \
    if(GK){DMA_K((t)+3,sl_cur);} if(GV){DMA_V((t)+1,sl_next);} \
    CMASK(C0,C1,t); \
    { float a=MX3(C0[0],C0[1],C1[0]),b=MX3(C0[2],C0[3],C1[1]); a=MX3(a,C1[2],C1[3]); \
      _Pragma("unroll") for(int r=4;r<16;r+=4){a=MX3(a,C0[r],C0[r+1]);b=MX3(b,C0[r+2],C0[r+3]);a=MX3(a,C1[r],C1[r+1]);b=MX3(b,C1[r+2],C1[r+3]);} \
      float rm=__builtin_fmaxf(a,b); { auto rr=__builtin_amdgcn_permlane32_swap(__float_as_uint(rm),__float_as_uint(rm),false,false); rm=__builtin_fmaxf(__uint_as_float(rr[0]),__uint_as_float(rr[1])); } \
      resc=false; \
      if(__builtin_expect(__any(rm>(float)THRL),0)){ const float dl=__builtin_fmaxf(rm,0.f); mhat+=dl; \
        _Pragma("unroll") for(int r=0;r<16;++r){C0[r]-=dl;C1[r]-=dl;} \
        _Pragma("unroll") for(int r=0;r<16;++r)negm[r]=-mhat; asm volatile("":"+v"(negm)); \
        const float f=__builtin_amdgcn_exp2f(-dl); l_reg*=f; if(hi==0)wsf[r32]=f; resc=true; } } \
    SBAR(); \
    GAPB(o[0]=__builtin_amdgcn_mfma_f32_32x32x16_bf16(PAF(0),VFR(0),o[0],0,0,0), C0,0); \
    GAPB(o[1]=__builtin_amdgcn_mfma_f32_32x32x16_bf16(PAF(0),VFR(4),o[1],0,0,0), C0,4); \
    KRD(GL,0); GAPB(o[0]=__builtin_amdgcn_mfma_f32_32x32x16_bf16(PAF(1),VFR(1),o[0],0,0,0), C0,8); \
    KRD(GL,1); GAPB(o[1]=__builtin_amdgcn_mfma_f32_32x32x16_bf16(PAF(1),VFR(5),o[1],0,0,0), C0,12); \
    KRD(GL,2); GAPB(o[0]=__builtin_amdgcn_mfma_f32_32x32x16_bf16(PAF(2),VFR(2),o[0],0,0,0), C1,0); \
    KRD(GL,3); GAPB(o[1]=__builtin_amdgcn_mfma_f32_32x32x16_bf16(PAF(2),VFR(6),o[1],0,0,0), C1,4); \
    GAPB(o[0]=__builtin_amdgcn_mfma_f32_32x32x16_bf16(PAF(3),VFR(3),o[0],0,0,0), C1,8); \
    GAPB(o[1]=__builtin_amdgcn_mfma_f32_32x32x16_bf16(PAF(3),VFR(7),o[1],0,0,0), C1,12); \
    }while(0)
  int t=1;
  for(;t+5<NT;t+=2){
    STEP(pB0,pB1,pA0,pA1,t,true,true,true);     WAIT_BAR(2); RESC(); ROT();
    STEP(pA0,pA1,pB0,pB1,t+1,true,true,true);   WAIT_BAR(2); RESC(); ROT();
  }
  #define ENDW(tt) do{ if((tt)+3<NT){WAIT_BAR(2);} else if((tt)+2<NT){WAIT_BAR(1);} else {WAIT_BAR(0);} }while(0)
  for(;t+1<NT;t+=2){
    STEP(pB0,pB1,pA0,pA1,t,(t+3<NT),(t+1<NT),(t+1<NT));       ENDW(t);   RESC(); ROT();
    STEP(pA0,pA1,pB0,pB1,t+1,(t+4<NT),(t+2<NT),(t+2<NT));     ENDW(t+1); RESC(); ROT();
  }
  STEP(pB0,pB1,pA0,pA1,NT-1,false,false,false); RESC();
  { float sacc=pB0[0]+pB0[1]; _Pragma("unroll") for(int r=2;r<16;++r)sacc+=pB0[r]; _Pragma("unroll") for(int r=0;r<16;++r)sacc+=pB1[r]; l_reg+=sacc;
    pw0=(u32x4){PKW(pB0,0),PKW(pB0,2),PKW(pB0,4),PKW(pB0,6)};pw1=(u32x4){PKW(pB0,8),PKW(pB0,10),PKW(pB0,12),PKW(pB0,14)};pw2=(u32x4){PKW(pB1,0),PKW(pB1,2),PKW(pB1,4),PKW(pB1,6)};pw3=(u32x4){PKW(pB1,8),PKW(pB1,10),PKW(pB1,12),PKW(pB1,14)};
    SBAR(); pv(o,vb0+sl_cur,PAF(0),PAF(1),PAF(2),PAF(3)); }
  #undef PKW
  #undef PAF
  #undef VFR
  #undef PIN
  #undef MX3
  #undef GAPA
  #undef GAPB
  #undef EX
  #undef VRD
  #undef KRD
  #undef STEP
  #undef ENDW
  {auto rr=__builtin_amdgcn_permlane32_swap(__float_as_uint(l_reg),__float_as_uint(l_reg),false,false);l_reg=__uint_as_float(rr[0])+__uint_as_float(rr[1]);}
  if(hi==0)wsf[32+r32]=l_reg;asm volatile("s_waitcnt lgkmcnt(0)":::"memory");
  float rli[16];
  #pragma unroll
  for(int r=0;r<16;++r)rli[r]=__builtin_amdgcn_rcpf(wsf[32+crow(r,hi)]);
  bf16*Ow=O+(rowbase+q0+wid*QBLK)*OP+512+h*D; float*ATw=ATS+(rowbase+q0+wid*QBLK)*8+h;
  { bf16*stg=(bf16*)(shm+LDS_OST)+wid*2048;
    #pragma unroll
    for(int r=0;r<16;++r){const int orow=crow(r,hi);
      #pragma unroll
      for(int d0=0;d0<2;++d0)stg[orow*64+d0*32+r32]=__float2bfloat16(o[d0][r]*rli[r]);}
    asm volatile("s_waitcnt lgkmcnt(0)":::"memory");
    #pragma unroll
    for(int i=0;i<4;++i){const int row=i*8+(lane>>3),ch=lane&7; const u32x4 v=*(const u32x4*)(stg+row*64+ch*8); ATTN_STORE16(Ow+(long)row*OP+ch*8,v);
      float ss=0.f;
      #pragma unroll
      for(int q=0;q<4;++q){const float lo=__uint_as_float(v[q]<<16),hh=__uint_as_float(v[q]&0xffff0000u);ss+=lo*lo+hh*hh;}
      ss=sum_row8(ss); if(ch==0)ATw[(long)row*8]=ss;} }
  asm volatile("s_waitcnt lgkmcnt(0)\n\ts_barrier":::"memory");
  #undef DMA_K
  #undef DMA_V
  #undef CMASK
  #undef START
  #undef RESC
  #undef ROT
}
constexpr int ATTN_LDS_BYTES=LDS_BYTES;
#undef SBAR
#undef WAIT_BAR
}

__global__ void __launch_bounds__(NTHR, 2) mega(Args args) {
    extern __shared__ __attribute__((aligned(16))) unsigned char lds[];
    Frame F;
    F.lds = (LAS unsigned char*)lds;
    F.wave = __builtin_amdgcn_readfirstlane(threadIdx.x >> 6);
    F.G = gridDim.x; { const int bx = blockIdx.x; F.vcu = (F.G % 8 == 0) ? (bx % 8) * (F.G / 8) + bx / 8 : bx; }
#pragma unroll
    for (int i = 0; i < 22; ++i) F.in[i] = args.in[i];
    F.ws = args.ws; F.xres = args.out;
    volatile LAS unsigned* MISC = (volatile LAS unsigned*)(F.lds + MISC_OFF);
    for (int u = threadIdx.x; u < (LDS_BYTES - LDSCTL_OFF) / 4; u += NTHR) ((LAS unsigned*)(F.lds + LDSCTL_OFF))[u] = 0u;
    __syncthreads();
    const int lo = args.ph_lo, hi = args.ph_hi;
    unsigned* barw = (unsigned*)(F.ws + WS_CTL) + CW_BAR + args.bar_region * XCD_BAR_WORDS;
    XcdBarrier bar; bar.bar = barw; bar.x = 0; bar.st = nullptr;
    if (hi - lo > 1) bar = xcd_barrier_post(barw, MISC + 8);
#ifndef ONLY_K
#define ONLY_K -1
#endif
#define EN(kind) (ONLY_K < 0 || ONLY_K == (kind))
#ifndef ALIGN_A
#define ALIGN_A true
#endif
#ifndef ALIGN_IN
#define ALIGN_IN true
#endif
#ifndef ALIGN_E1
#define ALIGN_E1 true
#endif
#define IN(k) (lo <= (k) && (k) < hi)
#ifndef REPK
#define REPK -1
#endif
#define PROBE_TOP(k) for (int rep_ = 0; rep_ < (REPK == (k) ? 2 : 1); ++rep_) {
#define PROBE_END(k) if (REPK == (k) && rep_ == 0) xcd_barrier(bar); }
#define SEAM(k) do { if (IN(k) && IN((k) + 1)) { xcd_barrier(bar); if (REPK == 200) xcd_barrier(bar); } } while (0)
    const int cid0 = (int)blockIdx.x; const int cid = cid0;
    if (EN(100) && IN(0)) { asm volatile("; PHASE_MARK P0"); PROBE_TOP(100) ph_rows0(F); PROBE_END(100) } SEAM(0);
    if (EN(101) && IN(1)) { asm volatile("; PHASE_MARK P1"); PROBE_TOP(101) ph_convert(F); PROBE_END(101) } SEAM(1);
    if (EN(102) && IN(2)) { asm volatile("; PHASE_MARK P2"); PROBE_TOP(102)
        SchedKV S; S.o.init(NL * 4, 8, F.G, cid); S.MEMN = (const char*)(F.ws + WS_MEMN); S.WKVT = (const char*)(F.ws + WS_WKVT);
        pg8::EpiStore<3> E{(bf16*)(F.ws + WS_KVM), 2 * D, nullptr, 1.0f};
        pg8::gemm_phase<pg8::EpiStore<3>, SchedKV, true, false>(F.lds, F.wave, D, D, D, S, E);
    PROBE_END(102) } SEAM(2);
    if (EN(103) && IN(3)) { asm volatile("; PHASE_MARK P3a");
        SchedQK S; S.o.init(NL * 16, 4, F.G, cid); S.KVM = (const char*)(F.ws + WS_KVM); S.WQB = (const char*)(F.ws + WS_WQB);
        pg8::EpiStore<1> E{(bf16*)(F.ws + WS_QKT), D, F.in[11], XQSCALE};
        int la = 2 * D, lb = D, kk = 256; asm volatile("" : "+s"(la), "+s"(lb), "+s"(kk));
        pg8::gemm_phase<pg8::EpiStore<1>, SchedQK, true, false>(F.lds, F.wave, la, lb, kk, S, E);
    }
    if (EN(104) && IN(3)) { asm volatile("; PHASE_MARK P3b");
        SchedVO S; S.o.init(NL * 64, 1, F.G, cid); S.KVM = (const char*)(F.ws + WS_KVM); S.WOT = (const char*)(F.ws + WS_WOT);
        pg8::EpiStore<2> E{(bf16*)(F.ws + WS_VOT), D, nullptr, 1.0f};
        int la = D, lb = 2 * D, kk = 256; asm volatile("" : "+s"(la), "+s"(lb), "+s"(kk));
        pg8::gemm_phase<pg8::EpiStore<2>, SchedVO, true, false>(F.lds, F.wave, la, lb, kk, S, E);
    } SEAM(3);
    for (int l = 0; l < NL; ++l) {
        const int pb = PH_LAYER0 + PH_PER_LAYER * l;
        int cid = cid0; asm volatile("" : "+s"(cid));
        if (EN(0) && IN(pb + 0)) { asm volatile("; PHASE_MARK L0"); PROBE_TOP(0)
            SchedDense S; S.o.init(T / 256, 7, F.G, cid); S.A = (const char*)(F.ws + WS_XR); S.a_tile = 256 * D * 2; S.B = (const char*)(F.ws + WS_WIN) + (size_t)l * INW * D * 2; S.b_tile = 256 * D * 2; S.b_batch = 0; S.bdiv = 1; S.bmod = 1;
            pg8::EpiIn E{(bf16*)(F.ws + WS_UACT), (bf16*)(F.ws + WS_VACT), (bf16*)(F.ws + WS_Q), (bf16*)(F.ws + WS_K), (bf16*)(F.ws + WS_V), (float*)(F.ws + WS_VSTAT),
                         F.in[7] + (size_t)l * 64, F.in[8] + (size_t)l * 64, (const float*)(F.ws + WS_ROPE), (const float*)(F.ws + WS_ROPE) + SEQ * 32, (const float*)(F.ws + WS_RINV)};
            pg8::gemm_phase<pg8::EpiIn, SchedDense, ALIGN_IN, false>(F.lds, F.wave, D, D, D, S, E);
        PROBE_END(0) } SEAM(pb + 0);
        if (EN(1) && IN(pb + 1)) { asm volatile("; PHASE_MARK L1");
            PROBE_TOP(11)
            for (int it = 0; ; ++it) { const int w = it * F.G + F.vcu; if (w >= NB_ * 8 * (SEQ / 256)) break;
                const int i = w >> 8, c = w & 255, x = c >> 5, j = c & 31;
                attn_body::attn_unit<8>(x >> 1, (x & 1) * 4 + i, j, (const attn_body::bf16*)(F.ws + WS_Q), (const attn_body::bf16*)(F.ws + WS_K), (const attn_body::bf16*)(F.ws + WS_V),
                                        (attn_body::bf16*)(F.ws + WS_MERGED), (float*)(F.ws + WS_ATSTAT), (char*)lds, F.wave); }
            PROBE_END(11)
            PROBE_TOP(12) ph_gmlp(F, l); PROBE_END(12) } SEAM(pb + 1);
        if (EN(2) && IN(pb + 2)) { asm volatile("; PHASE_MARK L2"); PROBE_TOP(2)
            SchedDense S; S.o.init(T / 256, 4, F.G, cid); S.A = (const char*)(F.ws + WS_MERGED); S.a_tile = 256 * D * 2; S.B = (const char*)(F.ws + WS_WOUT) + (size_t)l * D * D * 2; S.b_tile = 256 * D * 2; S.b_batch = 0; S.bdiv = 1; S.bmod = 1;
            pg8::EpiX<true, true> E; E.xr = (bf16*)(F.ws + WS_XR); E.xstat = (float*)(F.ws + WS_XSTAT); E.gmstat = (const float*)(F.ws + WS_GMSTAT); E.atstat = (const float*)(F.ws + WS_ATSTAT); E.lds = F.lds;
            pg8::gemm_phase<pg8::EpiX<true, true>, SchedDense, ALIGN_A, false>(F.lds, F.wave, D, D, D, S, E);
        PROBE_END(2) } SEAM(pb + 2);
        if (EN(3) && IN(pb + 3)) { asm volatile("; PHASE_MARK L3"); PROBE_TOP(3)
            SchedDense S; S.o.init(T / 256, 4, F.G, cid); S.A = (const char*)(F.ws + WS_XR); S.a_tile = 256 * D * 2; S.B = (const char*)(F.ws + WS_QKT) + (size_t)l * NB_ * D * D * 2; S.b_tile = 256 * D * 2; S.b_batch = (size_t)D * D * 2; S.bdiv = SEQ / 256; S.bmod = NB_;
            pg8::EpiS E{(const float*)(F.ws + WS_XSTAT), (bf16*)(F.ws + WS_P), F.lds};
            pg8::gemm_phase<pg8::EpiS, SchedDense, true, false>(F.lds, F.wave, D, D, D, S, E);
        PROBE_END(3) } SEAM(pb + 3);
        if (EN(4) && IN(pb + 4)) { asm volatile("; PHASE_MARK L4"); PROBE_TOP(4)
            SchedDense S; S.o.init(T / 256, 4, F.G, cid); S.A = (const char*)(F.ws + WS_P); S.a_tile = 256 * D * 2; S.B = (const char*)(F.ws + WS_VOT) + (size_t)l * NB_ * D * D * 2; S.b_tile = 256 * D * 2; S.b_batch = (size_t)D * D * 2; S.bdiv = SEQ / 256; S.bmod = NB_;
            pg8::EpiX<false, false> E; E.xr = (bf16*)(F.ws + WS_XR); E.xstat = nullptr; E.gmstat = nullptr; E.atstat = nullptr; E.lds = F.lds;
            pg8::gemm_phase<pg8::EpiX<false, false>, SchedDense, ALIGN_A, false>(F.lds, F.wave, D, D, D, S, E);
        PROBE_END(4) } SEAM(pb + 4);
        if (EN(5) && IN(pb + 5)) { asm volatile("; PHASE_MARK L5"); PROBE_TOP(5) ph_router(F, l); PROBE_END(5) } SEAM(pb + 5);
        if (EN(6) && IN(pb + 6)) { asm volatile("; PHASE_MARK L6"); PROBE_TOP(6) ph_topk(F); PROBE_END(6) } SEAM(pb + 6);
        if (EN(7) && IN(pb + 7)) { asm volatile("; PHASE_MARK L7"); PROBE_TOP(7)
            SchedE1 S; S.o.init(NB_ * NE * 4, 8, F.G, cid); S.HBp = (const char*)(F.ws + WS_XR8); S.IDX = (const int*)(F.ws + WS_IDX); S.WGU = (const char*)(F.ws + WS_WGU) + (size_t)l * NE * 2 * FF * D;
            pg8::EpiH E{F.ws + WS_H};
            int kq = D / 2; asm volatile("" : "+s"(kq));
            pg8::gemm_phase<pg8::EpiH, SchedE1, ALIGN_E1, true, true>(F.lds, F.wave, kq, kq, kq, S, E);
        PROBE_END(7) } SEAM(pb + 7);
        if (EN(8) && IN(pb + 8)) { asm volatile("; PHASE_MARK L8"); for (int rep_ = 0; rep_ < ((REPK == 8 || REPK == 81) ? 2 : 1); ++rep_) {
            SchedDense S; S.o.init(NB_ * NE * 4, 4, F.G, cid); S.A = (const char*)(F.ws + WS_H); S.a_tile = 256 * FF; S.B = (const char*)(F.ws + WS_WD) + (size_t)l * NE * D * FF; S.b_tile = 256 * FF; S.b_batch = (size_t)D * FF; S.bdiv = 4; S.bmod = NE;
            pg8::EpiY8 E{F.ws + WS_Y, Y8S / (H8S * W8S)}; E.skip = (REPK == 81 && rep_ == 0);
            int kq = FF / 2; asm volatile("" : "+s"(kq));
            pg8::gemm_phase<pg8::EpiY8, SchedDense, ALIGN_A, false, true>(F.lds, F.wave, kq, kq, kq, S, E);
        if ((REPK == 8 || REPK == 81) && rep_ == 0) xcd_barrier(bar); } } SEAM(pb + 8);
        if (EN(9) && IN(pb + 9)) { asm volatile("; PHASE_MARK L9"); PROBE_TOP(9) ph_combine(F, l, REPK == 9 && rep_ == 0); PROBE_END(9) } SEAM(pb + 9);
    }
#undef IN
#undef SEAM
}

static int g_grid = 0;
static void launch_mega(Args a, int lo, int hi, int region, hipStream_t stream) {
    a.ph_lo = lo; a.ph_hi = hi; a.bar_region = region; a.pad = 0;
    hipLaunchKernelGGL(mega, dim3(g_grid), dim3(NTHR), LDS_BYTES, stream, a);
}
extern "C" void kernel_launch(void* const* d_in, const int* in_sizes, int n_in, void* d_out, int out_size, void* d_ws, size_t ws_size, hipStream_t stream) {
    if (g_grid == 0) {
        if (n_in != 22 || out_size != T * D || ws_size < WS_END) { fprintf(stderr, "kernel_launch: unexpected sizes n_in %d out %d ws %zu\n", n_in, out_size, ws_size); g_grid = -1; return; }
        int dev = 0, cus = 0;
        if (hipGetDevice(&dev) != hipSuccess || hipDeviceGetAttribute(&cus, hipDeviceAttributeMultiprocessorCount, dev) != hipSuccess) { g_grid = -1; return; }
        if (hipFuncSetAttribute((const void*)mega, hipFuncAttributeMaxDynamicSharedMemorySize, LDS_BYTES) != hipSuccess) { g_grid = -1; return; }
        int per_cu = 0;
        if (hipOccupancyMaxActiveBlocksPerMultiprocessor(&per_cu, (const void*)mega, NTHR, LDS_BYTES) != hipSuccess || per_cu < 1) fprintf(stderr, "kernel_launch: occupancy query says %d\n", per_cu);
        (void)hipGetLastError();
        g_grid = cus;
    }
    if (g_grid < 0) return;
    hipMemsetAsync((char*)d_ws + WS_CTL, 0, CTL_ZERO_BYTES, stream);
    Args a{};
    for (int i = 0; i < 22; ++i) a.in[i] = (const float*)d_in[i];
    a.out = (float*)d_out; a.ws = (unsigned char*)d_ws;
    launch_mega(a, 0, PH_END, 0, stream);
}
```

```cpp
#include <hip/hip_runtime.h>
#include <hip/hip_bf16.h>
#include <cstdio>
#include <cstdint>
#include <cmath>

constexpr int NB_ = 4, SEQ = 8192, T = NB_ * SEQ, D = 1024, NL = 4;
constexpr int MEML = 256, NMEM = NB_ * MEML;
constexpr int INW = 1792, GMW = 512, NE = 16, CAP = 1024, FF = 1024;
constexpr float EPS = 1e-6f;
constexpr float LOG2E = 1.4426950408889634f;
constexpr float QSCALE = 0.125f * LOG2E;
constexpr float XQSCALE = 0.0625f * LOG2E;
constexpr float W8S = 256.0f, A8S = 16.0f, H8S = 8.0f, Y8S = 32.0f;
constexpr float Q8S = 512.0f, P8S = 256.0f, V8S = 64.0f;

constexpr size_t MiB = 1u << 20;
constexpr size_t WS_CTL = 0, CTL_ZERO_BYTES = 1 * MiB;
constexpr size_t WS_ROPE = 1 * MiB;
constexpr size_t WS_AFF = 3 * MiB;
constexpr size_t WS_INV = 5 * MiB;
constexpr size_t WS_IDX = 7 * MiB;
constexpr size_t WS_VSTAT = 8 * MiB;
constexpr size_t WS_ATSTAT = 9 * MiB;
constexpr size_t WS_GMSTAT = 10 * MiB;
constexpr size_t WS_RINV = 10 * MiB + 512 * 1024;
constexpr size_t WS_RINV2 = 10 * MiB + 768 * 1024;
constexpr size_t WS_XSTAT = 11 * MiB;
constexpr size_t WS_MEMN = 13 * MiB;
constexpr size_t WS_WSB = 15 * MiB;
constexpr size_t WS_WRH = 15 * MiB + 512 * 1024, WS_WRL = WS_WRH + 128 * 1024;
constexpr size_t WS_WIN = 16 * MiB;
constexpr size_t WS_WOUT = 30 * MiB;
constexpr size_t WS_QKT = 38 * MiB;
constexpr size_t WS_VOT = 70 * MiB;
constexpr size_t WS_WGU = 102 * MiB;
constexpr size_t WS_WD = 358 * MiB;
constexpr size_t WS_XR = 486 * MiB;
constexpr size_t WS_R1 = 550 * MiB;
constexpr size_t WS_UACT = WS_R1, WS_VACT = WS_R1 + 32 * MiB, WS_Q = WS_R1 + 64 * MiB, WS_K = WS_R1 + 96 * MiB, WS_V = WS_R1 + 104 * MiB;
constexpr size_t WS_WQB = WS_R1, WS_WOT = WS_R1 + 8 * MiB, WS_WKVT = WS_R1 + 16 * MiB, WS_KVM = WS_R1 + 32 * MiB;
constexpr size_t WS_H = WS_R1;
constexpr size_t WS_MERGED = 678 * MiB;
constexpr size_t WS_XR8 = 742 * MiB;
constexpr size_t WS_P = WS_MERGED;
constexpr size_t WS_Y = 678 * MiB;
constexpr size_t WS_NSCR = 806 * MiB;
constexpr size_t WS_Q2 = WS_MERGED;
constexpr size_t WS_O2 = WS_NSCR;
constexpr size_t WS_KVN = WS_NSCR + 64 * MiB;
constexpr size_t WS_END = 1024 * MiB;

constexpr int CW_TMO = 0, CW_CODE = 1, CW_BAR = 4096;

#define GAS __attribute__((address_space(1)))
#define LAS __attribute__((address_space(3)))
typedef unsigned short bf16;
typedef unsigned v4u __attribute__((ext_vector_type(4)));
typedef unsigned v2u __attribute__((ext_vector_type(2)));
typedef float f32x4 __attribute__((ext_vector_type(4)));
typedef short bf16x8_t __attribute__((ext_vector_type(8)));
typedef GAS unsigned gu32;
#define RLX_AGENT __ATOMIC_RELAXED, __HIP_MEMORY_SCOPE_AGENT
__device__ __forceinline__ unsigned f2bf(float f) { unsigned u = __builtin_bit_cast(unsigned, f); return (u + 0x7fffu + ((u >> 16) & 1u)) >> 16; }
__device__ __forceinline__ unsigned pk2(float lo, float hi) { return f2bf(lo) | (f2bf(hi) << 16); }
__device__ __forceinline__ float bf2f(unsigned v) { return __builtin_bit_cast(float, v << 16); }
__device__ __forceinline__ float bflo(unsigned w) { return __builtin_bit_cast(float, w << 16); }
__device__ __forceinline__ float bfhi(unsigned w) { return __builtin_bit_cast(float, w & 0xffff0000u); }
__device__ __forceinline__ float rbf(float f) { return bf2f(f2bf(f)); }
__device__ __forceinline__ float clamp8(float v) { return __builtin_amdgcn_fmed3f(v, -448.0f, 448.0f); }
__device__ __forceinline__ unsigned pk4_fp8(float a, float b, float c, float d) { unsigned w = 0u; w = __builtin_amdgcn_cvt_pk_fp8_f32(clamp8(a), clamp8(b), w, false); w = __builtin_amdgcn_cvt_pk_fp8_f32(clamp8(c), clamp8(d), w, true); return w; }
__device__ __forceinline__ float gelu_tanh(float x) {
    const float z = 1.5957691216057308f * (x + 0.044715f * x * x * x);
    return x * __builtin_amdgcn_rcpf(1.0f + __builtin_amdgcn_exp2f(-z * LOG2E));
}
__device__ __forceinline__ float silu_f(float a) { return a * __builtin_amdgcn_rcpf(1.0f + __builtin_amdgcn_exp2f(-a * LOG2E)); }
__device__ __forceinline__ int lane_id() { int l; asm volatile("v_mbcnt_lo_u32_b32 %0, -1, 0\n\tv_mbcnt_hi_u32_b32 %0, -1, %0" : "=v"(l)); return l; }
template <int CTRL> __device__ __forceinline__ float dpp_f(float v) { return __builtin_bit_cast(float, __builtin_amdgcn_update_dpp(0, __builtin_bit_cast(int, v), CTRL, 0xf, 0xf, true)); }
__device__ __forceinline__ float sum_row16(float v) { v += dpp_f<0xB1>(v); v += dpp_f<0x4E>(v); v += dpp_f<0x141>(v); v += dpp_f<0x140>(v); return v; }
__device__ __forceinline__ float max_row16(float v) { v = fmaxf(v, dpp_f<0xB1>(v)); v = fmaxf(v, dpp_f<0x4E>(v)); v = fmaxf(v, dpp_f<0x141>(v)); v = fmaxf(v, dpp_f<0x140>(v)); return v; }
__device__ __forceinline__ float sum_row8(float v) { v += dpp_f<0xB1>(v); v += dpp_f<0x4E>(v); v += dpp_f<0x141>(v); return v; }
__device__ __forceinline__ float swz16(float v) { return __builtin_bit_cast(float, __builtin_amdgcn_ds_swizzle(__builtin_bit_cast(int, v), 0x401f)); }
__device__ __forceinline__ float add_x16(float v) { return v + swz16(v); }
__device__ __forceinline__ float add_x32(float v) { const unsigned a = __builtin_bit_cast(unsigned, v); const auto r = __builtin_amdgcn_permlane32_swap(a, a, false, false); const unsigned r0 = r[0], r1 = r[1]; return __builtin_bit_cast(float, r0) + __builtin_bit_cast(float, r1); }
__device__ __forceinline__ float max_x16(float v) { return fmaxf(v, swz16(v)); }
__device__ __forceinline__ float max_x32(float v) { const unsigned a = __builtin_bit_cast(unsigned, v); const auto r = __builtin_amdgcn_permlane32_swap(a, a, false, false); const unsigned r0 = r[0], r1 = r[1]; return fmaxf(__builtin_bit_cast(float, r0), __builtin_bit_cast(float, r1)); }
__device__ __forceinline__ float wave_sum(float v) { return add_x32(add_x16(sum_row16(v))); }

#define XB_TMO      128
#define XB_XCNT(j)  (256  + 64 * (j))
#define XB_XSUB(j)  (1280 + 64 * (j))
#define XB_XGEN(j)  (2304 + 64 * (j))
#define XB_TOP      3328
#define XB_TOPGEN   3392
#define XCD_BAR_WORDS 3456
#define XB_SPIN_CAP (1u << 18)
__device__ __forceinline__ unsigned xb_ld(unsigned* p)              { return __hip_atomic_load(p, __ATOMIC_RELAXED, __HIP_MEMORY_SCOPE_AGENT); }
__device__ __forceinline__ unsigned xb_add(unsigned* p, unsigned v) { return __hip_atomic_fetch_add(p, v, __ATOMIC_RELAXED, __HIP_MEMORY_SCOPE_AGENT); }
__device__ __forceinline__ unsigned xb_xcc_id() { return (unsigned)__builtin_amdgcn_s_getreg((3 << 11) | 20) & 0xFu; }
#define XB_SPIN(cond, bar) do { unsigned _sp = 0; while (cond) { __builtin_amdgcn_s_sleep(1); \
    if ((++_sp & 255u) == 0u) { if (xb_ld(&(bar)[XB_TMO])) break; if (_sp > XB_SPIN_CAP) { atomicAdd(&(bar)[XB_TMO], 1u); break; } } } } while (0)
struct XcdBarrier { unsigned* bar; unsigned x; volatile LAS unsigned* st; };
__device__ __forceinline__ XcdBarrier xcd_barrier_post(unsigned* bar, volatile LAS unsigned* st) {
    XcdBarrier b; b.bar = bar; b.x = xb_xcc_id(); b.st = st;
    if (threadIdx.x == 0) (void)xb_add(&bar[XB_XCNT(b.x)], 1u);
    return b;
}
__device__ __forceinline__ void xcd_barrier_complete(unsigned* bar, unsigned x, unsigned& nloc, unsigned& nx) {
    const unsigned G = gridDim.x * gridDim.y * gridDim.z;
    unsigned sum, cnt, mine, sp = 0u;
    for (;;) {
        sum = 0u; cnt = 0u; mine = 0u;
#pragma unroll
        for (unsigned j = 0; j < 16; ++j) { const unsigned c = xb_ld(&bar[XB_XCNT(j)]); sum += c; cnt += (c > 0u) ? 1u : 0u; mine = (j == x) ? c : mine; }
        if (sum == G) break;
        __builtin_amdgcn_s_sleep(1);
        if ((++sp & 255u) == 0u) { if (xb_ld(&bar[XB_TMO])) break; if (sp > XB_SPIN_CAP) { atomicAdd(&bar[XB_TMO], 1u); break; } }
    }
    nloc = mine > 0u ? mine : 1u; nx = cnt > 0u ? cnt : 1u;
}
__device__ __forceinline__ void xcd_barrier(const XcdBarrier& b) {
    asm volatile("s_waitcnt vmcnt(0)" ::: "memory");
    __syncthreads();
    if (threadIdx.x == 0) {
        unsigned* bar = b.bar;
        __builtin_amdgcn_s_waitcnt(0);
        unsigned nloc = b.st[0], nx = b.st[1];
        if (nloc == 0u) { xcd_barrier_complete(bar, b.x, nloc, nx); b.st[0] = nloc; b.st[1] = nx; }
        const unsigned old = xb_add(&bar[XB_XSUB(b.x)], 1u);
        const unsigned gen = old / nloc;
        if (old + 1u == (gen + 1u) * nloc) {
            __builtin_amdgcn_fence(__ATOMIC_RELEASE, "agent");
            asm volatile("s_waitcnt vmcnt(0)" ::: "memory");
            const unsigned og = xb_add(&bar[XB_TOP], 1u);
            const unsigned tg = og / nx;
            if (og + 1u == (tg + 1u) * nx) xb_add(&bar[XB_TOPGEN], 1u);
            else XB_SPIN(xb_ld(&bar[XB_TOPGEN]) == tg, bar);
            __builtin_amdgcn_fence(__ATOMIC_ACQUIRE, "agent");
            xb_add(&bar[XB_XGEN(b.x)], 1u);
            asm volatile("s_waitcnt vmcnt(0)" ::: "memory");
        } else {
            XB_SPIN(xb_ld(&bar[XB_XGEN(b.x)]) == gen, bar);
            __builtin_amdgcn_fence(__ATOMIC_ACQUIRE, "agent");
            asm volatile("s_waitcnt vmcnt(0)" ::: "memory");
        }
    }
    __syncthreads();
}

struct Args { const float* in[22]; float* out; unsigned char* ws; int ph_lo, ph_hi, bar_region, pad; };
constexpr int PH_LAYER0 = 4, PH_PER_LAYER = 10, PH_END = PH_LAYER0 + NL * PH_PER_LAYER;

constexpr int NWAVES = 8, NTHR = NWAVES * 64;
constexpr int RING_BYTES = 131072, LDSCTL_OFF = RING_BYTES, MISC_OFF = LDSCTL_OFF + 320;
constexpr int LDS_BYTES = 147456;

struct Frame {
    LAS unsigned char* lds;
    int wave, vcu, G;
    const float* in[22];
    unsigned char* ws;
    float* xres;
};

__device__ __forceinline__ void ph_rows0(Frame& F) {
    int lane_ = lane_id(); asm volatile("" : "+v"(lane_)); const int tid_ = F.wave * 64 + lane_;
    const int gw = F.vcu * NWAVES + F.wave, NGW = F.G * NWAVES;
    const float* x = F.in[0]; const float* mem = F.in[1]; const float* mg = F.in[12];
    bf16* XR = (bf16*)(F.ws + WS_XR); bf16* MEMN = (bf16*)(F.ws + WS_MEMN); float* RINV = (float*)(F.ws + WS_RINV);
    for (int m = gw; m < T + NMEM; m += NGW) {
        const bool is_mem = m >= T;
        const float* src = is_mem ? mem + (size_t)(m - T) * D : x + (size_t)m * D;
        bf16* dst = is_mem ? MEMN + (size_t)(m - T) * D : XR + (size_t)m * D;
        f32x4 v[4]; float s = 0.f;
#pragma unroll
        for (int j = 0; j < 4; ++j) { v[j] = *(const f32x4*)(src + 4 * lane_ + 256 * j); s += (v[j].x * v[j].x + v[j].y * v[j].y) + (v[j].z * v[j].z + v[j].w * v[j].w); }
        const float rinv = __builtin_amdgcn_rsqf(wave_sum(s) * (1.0f / D) + EPS);
        if (!is_mem && lane_ == 0) RINV[m] = rinv;
        const float sc = is_mem ? rinv : 1.0f;
#pragma unroll
        for (int j = 0; j < 4; ++j) {
            f32x4 g = (f32x4){1.f, 1.f, 1.f, 1.f};
            if (is_mem) g = *(const f32x4*)(mg + 4 * lane_ + 256 * j);
            v2u o; o.x = pk2(v[j].x * sc * g.x, v[j].y * sc * g.y); o.y = pk2(v[j].z * sc * g.z, v[j].w * sc * g.w);
            *(v2u*)(dst + 4 * lane_ + 256 * j) = o;
        }
    }
#if defined(SELFTEST_F8)
    if (F.vcu == 0 && F.wave == 0) {
        typedef int v8i_t __attribute__((ext_vector_type(8)));
        const int fr = lane_ & 15; const unsigned codes[4] = {0x38383838u, 0x3A3A3A3Au, 0x3C3C3C3Cu, 0x40404040u}; const float vals[4] = {1.0f, 1.25f, 1.5f, 2.0f};
        unsigned bc = codes[0]; float bv = vals[0];
#pragma unroll
        for (int q = 1; q < 4; ++q) if ((fr & 3) == q) { bc = codes[q]; bv = vals[q]; }
        v8i_t A, B;
#pragma unroll
        for (int q = 0; q < 8; ++q) { A[q] = 0x38383838; B[q] = (int)bc; }
        f32x4 acc = (f32x4){0.f, 0.f, 0.f, 0.f}; unsigned sc = 0x7f7f7f7fu; asm volatile("" : "+v"(sc), "+v"(A), "+v"(B), "+v"(acc));
        asm volatile("s_nop 7\n\tv_mfma_scale_f32_16x16x128_f8f6f4 %0, %1, %2, %0, %3, %3 op_sel_hi:[0,0,0]\n\ts_nop 15\n\ts_nop 15\n\ts_nop 15\n\ts_nop 15\n\ts_nop 15\n\ts_nop 15" : "+v"(acc) : "v"(A), "v"(B), "v"(sc));
        bool bad = false;
#pragma unroll
        for (int e = 0; e < 4; ++e) bad |= (acc[e] != 128.0f * bv);
        const unsigned w = pk4_fp8(1.25f, 448.0f, 1000.0f, -2.0f); bad |= (w != 0xC07E7E3Au);
        {   const float v = (float)((lane_ * 37 + 11) % 101);
            float r16 = v; r16 += __shfl_xor(r16, 1); r16 += __shfl_xor(r16, 2); r16 += __shfl_xor(r16, 4); r16 += __shfl_xor(r16, 8);
            float m16 = v; m16 = fmaxf(m16, __shfl_xor(m16, 1)); m16 = fmaxf(m16, __shfl_xor(m16, 2)); m16 = fmaxf(m16, __shfl_xor(m16, 4)); m16 = fmaxf(m16, __shfl_xor(m16, 8));
            float r8 = v; r8 += __shfl_xor(r8, 1); r8 += __shfl_xor(r8, 2); r8 += __shfl_xor(r8, 4);
            float r64 = r16; r64 += __shfl_xor(r64, 16); r64 += __shfl_xor(r64, 32);
            if (SELFTEST_F8 & 1) bad |= (sum_row16(v) != r16) | (max_row16(v) != m16) | (sum_row8(v) != r8);
            if (SELFTEST_F8 & 2) bad |= (wave_sum(v) != r64);
            if (SELFTEST_F8 & 4) bad |= (add_x16(v) != v + __shfl_xor(v, 16)) | (max_x16(v) != fmaxf(v, __shfl_xor(v, 16)));
            if (SELFTEST_F8 & 8) bad |= (add_x32(v) != v + __shfl_xor(v, 32)) | (max_x32(v) != fmaxf(v, __shfl_xor(v, 32)));
            if (SELFTEST_F8 & 16) bad |= (lane_ != (int)(threadIdx.x & 63));
            const int iv = lane_ * 3 + 1; if (SELFTEST_F8 & 32) bad |= (__builtin_amdgcn_readlane(iv, 5) != 16) | false; { const int bp = __builtin_amdgcn_ds_bpermute((lane_ - 1) << 2, iv); if (SELFTEST_F8 & 32) bad |= (lane_ > 0 && bp != iv - 3); }
            const float xq = 0.37f + (float)lane_; const float rq = __builtin_amdgcn_rsqf(xq), rr = 1.0f / sqrtf(xq); if (SELFTEST_F8 & 64) bad |= (fabsf(rq - rr) > 1e-5f * rr); }
        if (bad) __hip_atomic_store((unsigned*)(F.ws + WS_CTL) + CW_TMO, 1u, __ATOMIC_RELAXED, __HIP_MEMORY_SCOPE_AGENT);
    }
#endif
    float* COS = (float*)(F.ws + WS_ROPE); float* SIN = COS + SEQ * 32;
    const int gt = F.vcu * NTHR + tid_, NGT = F.G * NTHR;
    for (int i = gt; i < SEQ * 32; i += NGT) {
        const int t = i >> 5, p = i & 31;
        const float fr = expf(-9.210340371976184f * (float)(p & 15) * (1.0f / 16.0f));
        const float pos = (float)((p < 16) ? (t >> 6) : (t & 63));
        float rev = pos * fr * 0.15915494309189535f; rev -= floorf(rev);
        COS[i] = __builtin_amdgcn_cosf(rev); SIN[i] = __builtin_amdgcn_sinf(rev);
    }
}

__device__ __forceinline__ void ph_gmlp(Frame& F, int l) {
    int lane_ = lane_id(); asm volatile("" : "+v"(lane_)); const int tid_ = F.wave * 64 + lane_;
    const bf16* UACT = (const bf16*)(F.ws + WS_UACT); const bf16* VACT = (const bf16*)(F.ws + WS_VACT);
    const float* VSTAT = (const float*)(F.ws + WS_VSTAT); float* GMSTAT = (float*)(F.ws + WS_GMSTAT);
    bf16* MERGED = (bf16*)(F.ws + WS_MERGED);
    const float* gvn = F.in[4] + (size_t)l * GMW; const float* bs = F.in[6] + (size_t)l * 4 * 128;
    const bf16* WSB = (const bf16*)(F.ws + WS_WSB) + (size_t)l * 4 * 128 * 128;
    LAS bf16* vT = (LAS bf16*)F.lds;
    const int fr = lane_ & 15, fq = lane_ >> 4, w = F.wave;
    for (int u = F.vcu; u < (T / 128) * 4; u += F.G) {
        const int n = u >> 2, g = u & 3; const int row0 = n * 128;
        __syncthreads();
        {   const int j = tid_ & 127, cs = tid_ >> 7; const size_t row = (size_t)row0 + j;
            const f32x4 s0 = *(const f32x4*)(VSTAT + row * 8), s1 = *(const f32x4*)(VSTAT + row * 8 + 4);
            const float rinv = __builtin_amdgcn_rsqf((((s0[0] + s0[1]) + (s0[2] + s0[3])) + ((s1[0] + s1[1]) + (s1[2] + s1[3]))) * (1.0f / GMW) + EPS);
#pragma unroll
            for (int q = 0; q < 4; ++q) { const int c8 = (cs * 4 + q) * 8;
                const v4u raw = *(const v4u*)(VACT + row * GMW + g * 128 + c8);
                const f32x4 g0 = *(const f32x4*)(gvn + g * 128 + c8) * rinv, g1 = *(const f32x4*)(gvn + g * 128 + c8 + 4) * rinv;
                LAS bf16* d = vT + c8 * 136 + j;
                d[0 * 136] = (bf16)f2bf(bflo(raw.x) * g0[0]); d[1 * 136] = (bf16)f2bf(bfhi(raw.x) * g0[1]); d[2 * 136] = (bf16)f2bf(bflo(raw.y) * g0[2]); d[3 * 136] = (bf16)f2bf(bfhi(raw.y) * g0[3]);
                d[4 * 136] = (bf16)f2bf(bflo(raw.z) * g1[0]); d[5 * 136] = (bf16)f2bf(bfhi(raw.z) * g1[1]); d[6 * 136] = (bf16)f2bf(bflo(raw.w) * g1[2]); d[7 * 136] = (bf16)f2bf(bfhi(raw.w) * g1[3]); } }
        bf16x8_t bw[4];
#pragma unroll
        for (int ks = 0; ks < 4; ++ks) bw[ks] = *(const bf16x8_t*)(WSB + ((size_t)(g * 128 + 16 * w + fr)) * 128 + 32 * ks + 8 * fq);
        __syncthreads();
        f32x4 acc[8];
#pragma unroll
        for (int cb = 0; cb < 8; ++cb) { acc[cb] = (f32x4){0.f, 0.f, 0.f, 0.f};
#pragma unroll
            for (int ks = 0; ks < 4; ++ks) { const bf16x8_t a = *(const LAS bf16x8_t*)(vT + (16 * cb + fr) * 136 + 32 * ks + 8 * fq);
                acc[cb] = __builtin_amdgcn_mfma_f32_16x16x32_bf16(a, bw[ks], acc[cb], 0, 0, 0); } }
        const size_t row = (size_t)row0 + 16 * w + fr; const float bias = bs[g * 128 + 16 * w + fr]; float ss = 0.f;
#pragma unroll
        for (int cb = 0; cb < 8; ++cb) { const v2u uu = *(const v2u*)(UACT + row * GMW + g * 128 + 16 * cb + 4 * fq);
            v2u o; o.x = pk2(bflo(uu.x) * (acc[cb][0] + bias), bfhi(uu.x) * (acc[cb][1] + bias)); o.y = pk2(bflo(uu.y) * (acc[cb][2] + bias), bfhi(uu.y) * (acc[cb][3] + bias));
            *(v2u*)(MERGED + row * 1024 + g * 128 + 16 * cb + 4 * fq) = o;
            const float a0 = bflo(o.x), a1 = bfhi(o.x), a2 = bflo(o.y), a3 = bfhi(o.y); ss += (a0 * a0 + a1 * a1) + (a2 * a2 + a3 * a3); }
        ss = add_x32(add_x16(ss));
        if (fq == 0) GMSTAT[row * 4 + g] = ss;
    }
    __syncthreads();
}

__device__ __forceinline__ void ph_router(Frame& F, int l) {
    const int lane_ = lane_id(); const int fr = lane_ & 15, fq = lane_ >> 4;
    const bf16* XR = (const bf16*)(F.ws + WS_XR); float* AFF = (float*)(F.ws + WS_AFF); unsigned char* X8 = F.ws + WS_XR8;
    const bf16* WRH = (const bf16*)(F.ws + WS_WRH) + ((size_t)l * NE + fr) * D + 8 * fq; const bf16* WRL = (const bf16*)(F.ws + WS_WRL) + ((size_t)l * NE + fr) * D + 8 * fq;
    const int gw = F.vcu * NWAVES + F.wave, NGW = F.G * NWAVES;
    for (int blk = gw; blk < T / 16; blk += NGW) {
        const size_t row = (size_t)blk * 16 + fr; const bf16* xp = XR + row * D + 8 * fq;
        f32x4 acc = (f32x4){0.f, 0.f, 0.f, 0.f}; float ss = 0.f;
#pragma unroll 8
        for (int ks = 0; ks < 32; ++ks) { const bf16x8_t xk = *(const bf16x8_t*)(xp + 32 * ks); const bf16x8_t wh = *(const bf16x8_t*)(WRH + 32 * ks), wl = *(const bf16x8_t*)(WRL + 32 * ks);
            acc = __builtin_amdgcn_mfma_f32_16x16x32_bf16(wh, xk, acc, 0, 0, 0); acc = __builtin_amdgcn_mfma_f32_16x16x32_bf16(wl, xk, acc, 0, 0, 0);
            const v4u xb = __builtin_bit_cast(v4u, xk);
            const float a0 = bflo(xb.x), a1 = bfhi(xb.x), a2 = bflo(xb.y), a3 = bfhi(xb.y), a4 = bflo(xb.z), a5 = bfhi(xb.z), a6 = bflo(xb.w), a7 = bfhi(xb.w);
            ss += ((a0 * a0 + a1 * a1) + (a2 * a2 + a3 * a3)) + ((a4 * a4 + a5 * a5) + (a6 * a6 + a7 * a7)); }
        ss = add_x32(add_x16(ss));
        const float rinv = __builtin_amdgcn_rsqf(ss * (1.0f / D) + EPS);
        const f32x4 lg = acc * (rinv * LOG2E);
        float mx = fmaxf(fmaxf(lg[0], lg[1]), fmaxf(lg[2], lg[3])); mx = max_x32(max_x16(mx));
        f32x4 pe; float den = 0.f;
#pragma unroll
        for (int i = 0; i < 4; ++i) { pe[i] = __builtin_amdgcn_exp2f(lg[i] - mx); den += pe[i]; }
        den = add_x32(add_x16(den));
        *(f32x4*)(AFF + row * NE + 4 * fq) = pe * __builtin_amdgcn_rcpf(den);
        const float sc = rinv * A8S;
#pragma unroll 8
        for (int ks = 0; ks < 32; ++ks) { const v4u xb = *(const v4u*)(xp + 32 * ks);
            v2u o; o.x = pk4_fp8(bflo(xb.x) * sc, bfhi(xb.x) * sc, bflo(xb.y) * sc, bfhi(xb.y) * sc); o.y = pk4_fp8(bflo(xb.z) * sc, bfhi(xb.z) * sc, bflo(xb.w) * sc, bfhi(xb.w) * sc);
            *(v2u*)(X8 + row * D + 32 * ks + 8 * fq) = o; }
    }
}

__device__ __forceinline__ void ph_topk(Frame& F) {
    int lane_ = lane_id(); asm volatile("" : "+v"(lane_)); const int tid_ = F.wave * 64 + lane_;
    const float* AFF = (const float*)(F.ws + WS_AFF); int* IDX = (int*)(F.ws + WS_IDX); int* INV = (int*)(F.ws + WS_INV);
    LAS unsigned* hist = (LAS unsigned*)F.lds;
    LAS unsigned* sh = hist + 256;
    LAS unsigned* wsum = hist + 512;
    for (int p = F.vcu; p < NB_ * NE; p += F.G) {
        const int b = p >> 4, e = p & 15;
        unsigned key[16];
#pragma unroll
        for (int i = 0; i < 16; ++i) key[i] = __builtin_bit_cast(unsigned, AFF[((size_t)b * SEQ + tid_ * 16 + i) * NE + e]);
        unsigned prefix = 0u, krem = CAP;
#pragma unroll
        for (int pass = 0; pass < 4; ++pass) {
            const int shift = pass == 3 ? 0 : 23 - 8 * pass; const unsigned dmask = pass == 3 ? 127u : 255u;
            const unsigned himask = pass == 0 ? 0u : (pass == 1 ? 0xff800000u : (pass == 2 ? 0xffff8000u : 0xffffff80u));
            __syncthreads();
            if (tid_ < 256) hist[tid_] = 0u;
            __syncthreads();
#pragma unroll
            for (int i = 0; i < 16; ++i) if ((key[i] & himask) == prefix) atomicAdd((unsigned*)&hist[(key[i] >> shift) & dmask], 1u);
            __syncthreads();
            if (F.wave == 0) {
                unsigned c[4]; unsigned t = 0u;
#pragma unroll
                for (int j = 0; j < 4; ++j) { c[j] = hist[255 - 4 * lane_ - j]; t += c[j]; }
                unsigned inc = t;
#pragma unroll
                for (int o = 1; o < 64; o <<= 1) { const unsigned a = (unsigned)__builtin_amdgcn_ds_bpermute((lane_ - o) << 2, (int)inc); if (lane_ >= o) inc += a; }
                unsigned above = inc - t;
                if (above < krem && krem <= inc) {
                    int d = 255 - 4 * lane_;
#pragma unroll
                    for (int j = 0; j < 3; ++j) { if (above + c[j] < krem) { above += c[j]; d = 254 - 4 * lane_ - j; } else break; }
                    sh[0] = prefix | ((unsigned)d << shift); sh[1] = krem - above; }
            }
            __syncthreads();
            prefix = sh[0]; krem = sh[1];
        }
        const unsigned thr = prefix;
        unsigned cg = 0u, ce = 0u;
#pragma unroll
        for (int i = 0; i < 16; ++i) { cg += key[i] > thr ? 1u : 0u; ce += key[i] == thr ? 1u : 0u; }
        unsigned sg = cg, se = ce;
#pragma unroll
        for (int o = 1; o < 64; o <<= 1) { const unsigned a = (unsigned)__builtin_amdgcn_ds_bpermute((lane_ - o) << 2, (int)sg), c2 = (unsigned)__builtin_amdgcn_ds_bpermute((lane_ - o) << 2, (int)se); if (lane_ >= o) { sg += a; se += c2; } }
        __syncthreads();
        if (lane_ == 63) { wsum[F.wave] = sg; wsum[8 + F.wave] = se; }
        __syncthreads();
        unsigned og = 0u, oe = 0u;
        for (int w = 0; w < F.wave; ++w) { og += wsum[w]; oe += wsum[8 + w]; }
        unsigned gb = og + sg - cg, eb = oe + se - ce;
#pragma unroll
        for (int i = 0; i < 16; ++i) {
            const int t = tid_ * 16 + i; int pos = -1;
            if (key[i] > thr) { pos = (int)(gb + (eb < krem ? eb : krem)); ++gb; }
            else if (key[i] == thr) { if (eb < krem) pos = (int)(gb + eb); ++eb; }
            INV[((size_t)b * SEQ + t) * NE + e] = pos;
            if (pos >= 0) IDX[(size_t)p * CAP + pos] = t;
        }
    }
    __syncthreads();
}

__device__ __forceinline__ void ph_combine(Frame& F, int l, bool dummy) {
    int lane_ = lane_id(); asm volatile("" : "+v"(lane_));
    const float* AFF = (const float*)(F.ws + WS_AFF); const int* INV = (const int*)(F.ws + WS_INV);
    const unsigned char* Y = F.ws + WS_Y; bf16* XR = (bf16*)(F.ws + WS_XR); const float* fg = F.in[21]; float* RINV = (float*)(F.ws + WS_RINV);
    const int gw = F.vcu * NWAVES + F.wave, NGW = F.G * NWAVES;
    v2u nx[4]; int npos = -1; float naff = 0.f;
    if (gw < T) {
#pragma unroll
        for (int j = 0; j < 4; ++j) nx[j] = *(const v2u*)(XR + (size_t)gw * D + 4 * lane_ + 256 * j);
        if (lane_ < NE) { npos = INV[(size_t)gw * NE + lane_]; naff = AFF[(size_t)gw * NE + lane_]; } }
    for (int m = gw; m < T; m += NGW) {
        const int b = m / SEQ;
        bf16* xw = (dummy ? (bf16*)(F.ws + WS_NSCR) : XR) + (size_t)m * D; float* ow = (dummy ? (float*)(F.ws + WS_NSCR) : F.xres) + (size_t)m * D;
        f32x4 v[4];
#pragma unroll
        for (int j = 0; j < 4; ++j) v[j] = (f32x4){bflo(nx[j].x), bfhi(nx[j].x), bflo(nx[j].y), bfhi(nx[j].y)};
        const int mypos = npos; const float myaff = naff;
        {   const int mn = m + NGW; npos = -1; naff = 0.f;
            if (mn < T) {
#pragma unroll
                for (int j = 0; j < 4; ++j) nx[j] = *(const v2u*)(XR + (size_t)mn * D + 4 * lane_ + 256 * j);
                if (lane_ < NE) { npos = INV[(size_t)mn * NE + lane_]; naff = AFF[(size_t)mn * NE + lane_]; } } }
        unsigned mask = (unsigned)__builtin_amdgcn_ballot_w64(mypos >= 0) & 0xffffu;
        while (mask) {
            int ee[4]; int nsel = 0;
#pragma unroll
            for (int q = 0; q < 4; ++q) { ee[q] = 0; if (mask) { ee[q] = __builtin_ctz(mask); mask &= mask - 1u; nsel = q + 1; } }
            int w[4][4]; float as[4];
#pragma unroll
            for (int q = 0; q < 4; ++q) { as[q] = 0.f;
                if (q < nsel) { const int pos = __builtin_amdgcn_readlane(mypos, ee[q]); as[q] = __builtin_bit_cast(float, __builtin_amdgcn_readlane(__builtin_bit_cast(int, myaff), ee[q])) * (1.0f / Y8S);
                    const unsigned char* yr = Y + ((size_t)(b * NE + ee[q]) * CAP + pos) * D;
#pragma unroll
                    for (int j = 0; j < 4; ++j) w[q][j] = *(const int*)(yr + 4 * lane_ + 256 * j); }
                else {
#pragma unroll
                    for (int j = 0; j < 4; ++j) w[q][j] = 0; } }
#pragma unroll
            for (int q = 0; q < 4; ++q)
#pragma unroll
                for (int j = 0; j < 4; ++j) { const auto lo = __builtin_amdgcn_cvt_pk_f32_fp8(w[q][j], false), hi = __builtin_amdgcn_cvt_pk_f32_fp8(w[q][j], true);
                    const float l0 = lo[0], l1 = lo[1], h0 = hi[0], h1 = hi[1];
                    v[j].x += as[q] * l0; v[j].y += as[q] * l1; v[j].z += as[q] * h0; v[j].w += as[q] * h1; }
        }
        float s = 0.f;
#pragma unroll
        for (int j = 0; j < 4; ++j) s += (v[j].x * v[j].x + v[j].y * v[j].y) + (v[j].z * v[j].z + v[j].w * v[j].w);
        const float rinv = __builtin_amdgcn_rsqf(wave_sum(s) * (1.0f / D) + EPS);
        if (l == NL - 1) {
#if defined(SELFTEST_F8)
            if (__hip_atomic_load((unsigned*)(F.ws + WS_CTL) + CW_TMO, __ATOMIC_RELAXED, __HIP_MEMORY_SCOPE_AGENT) != 0u) v[0].x = __builtin_nanf("");
#endif
#pragma unroll
            for (int j = 0; j < 4; ++j) { const f32x4 g = *(const f32x4*)(fg + 4 * lane_ + 256 * j); *(f32x4*)(ow + 4 * lane_ + 256 * j) = (f32x4){v[j].x * rinv * g.x, v[j].y * rinv * g.y, v[j].z * rinv * g.z, v[j].w * rinv * g.w}; }
        } else {
            if (lane_ == 0 && !dummy) RINV[m] = rinv;
#pragma unroll
            for (int j = 0; j < 4; ++j) { v2u o; o.x = pk2(v[j].x, v[j].y); o.y = pk2(v[j].z, v[j].w); *(v2u*)(xw + 4 * lane_ + 256 * j) = o; }
        }
    }
}

namespace pg8 {
typedef short bf16x8 __attribute__((ext_vector_type(8)));
typedef float f32x2 __attribute__((ext_vector_type(2)));
typedef int v4i_t __attribute__((ext_vector_type(4)));
typedef int v8i_t __attribute__((ext_vector_type(8)));
constexpr int BM = 256, BK = 64, HALF = 128, HTB = HALF * BK * 2, STAGE_BYTES = 8 * HTB, NXCD = 8, WGM = 8;
__host__ __device__ __forceinline__ int lds_byte(int r, int c) { const int st = (r >> 4) * 2 + (c >> 5), rr = r & 15, cc = c & 31, ob = rr * 64 + cc * 2; return st * 1024 + (ob ^ (((ob >> 9) & 1) << 5)); }
__host__ __device__ __forceinline__ void stage_rc(int b, int& R, int& C) { const int st = b / 1024, sb = b % 1024, swz = sb ^ (((sb >> 9) & 1) << 5); R = (st >> 1) * 16 + swz / 64; C = (st & 1) * 32 + (swz % 64) / 2; }
__host__ __device__ __forceinline__ int perm32(int rho) { const int n = rho >> 4, i = rho & 15; return 8 * (i >> 2) + 4 * n + (i & 3); }

struct Unit { int pm, pn, z; const char* a; const char* b; const int* gi; int grow; };

struct TileOrder {
    int nM, nN, nwg, G, c;
    __device__ __forceinline__ void init(int nM_, int nN_, int G_, int c_) { nM = nM_; nN = nN_; nwg = nM * nN; G = G_; c = c_; }
    __device__ __forceinline__ bool tile(int i, int& pm, int& pn) const {
        const long L = (long)i * G + c; if (L >= nwg) return false;
        int wgid = (int)L; { const int q = nwg / NXCD, r = nwg % NXCD, xcd = wgid % NXCD, off = wgid / NXCD; wgid = (xcd < r ? xcd * (q + 1) : r * (q + 1) + (xcd - r) * q) + off; }
        const int nig = WGM * nN, gid = wgid / nig, fm = gid * WGM, gsz = (nM - fm) < WGM ? (nM - fm) : WGM;
        pm = fm + ((wgid % nig) % gsz); pn = (wgid % nig) / gsz; return true;
    }
};

__device__ __forceinline__ unsigned cvt_pk_bf16(float lo, float hi) { unsigned r; asm volatile("v_cvt_pk_bf16_f32 %0, %1, %2" : "=v"(r) : "v"(lo), "v"(hi)); return r; }
typedef f32x4 Acc[2][2][4][2];
#ifndef NT_STORE
#define NT_STORE 0
#endif
__device__ __forceinline__ void st16(void* p, const v4u w) { if (NT_STORE) __builtin_nontemporal_store(w, (v4u*)p); else *(v4u*)p = w; }
#ifndef NT_Y
#define NT_Y 1
#endif

template <class Epi, class Sched, bool ALIGN_EPI, bool GATHER, bool FP8 = false>
__device__ __forceinline__ void gemm_phase(LAS unsigned char* lds, const int wave_idx, const int lda, const int ldb, const int K, const Sched& S, Epi& E) {
    const int lane = lane_id();
    int wid = wave_idx; asm volatile("" : "+s"(wid));
    const int tid = wid * 64 + lane, wr = wid >> 2, wc = wid & 3, fr = lane & 15, fq = lane >> 4;
    const int nt = K / BK;
    unsigned voffA[2], voffB[2];
#pragma unroll
    for (int i = 0; i < 2; ++i) { int R, C; stage_rc(tid * 16 + i * 8192, R, C); const int Rb = (R & ~31) + perm32(R & 31);
        voffA[i] = (unsigned)(R * lda + C) * 2u; voffB[i] = (unsigned)(Rb * ldb + C) * 2u; }
    const size_t kstep = (size_t)(BK * 2);
    const size_t hstepA = (size_t)HALF * lda * 2, hstepB = (size_t)HALF * ldb * 2;
    const unsigned ldsw = (unsigned)wid * 1024u;
    const int aoff = lds_byte(wr * 64 + fr, fq * 8), boff = lds_byte(wc * 32 + fr, fq * 8);
    unsigned vgc[2][2], vgn[2][2];
#define PG8_SA(b, h) (((b) * 2 + (h)) * HTB)
#define PG8_SB(b, h) ((4 + (b) * 2 + (h)) * HTB)
#define PG8_GL(gp, voff, bufoff, _i) __builtin_amdgcn_global_load_lds((const unsigned*)((const char*)(gp) + (voff)), (LAS unsigned*)(lds + (bufoff) + ldsw + (_i) * 8192), 16, 0, 0)
#define PG8_STAGE_B(bufoff, gbase) do { PG8_GL(gbase, voffB[0], bufoff, 0); PG8_GL(gbase, voffB[1], bufoff, 1); } while (0)
#define PG8_STAGE_A(bufoff, gbase, h, VG) do { if constexpr (GATHER) { PG8_GL(gbase, VG[h][0], bufoff, 0); PG8_GL(gbase, VG[h][1], bufoff, 1); } \
        else { PG8_GL((gbase) + (h) * hstepA, voffA[0], bufoff, 0); PG8_GL((gbase) + (h) * hstepA, voffA[1], bufoff, 1); } } while (0)
#define PG8_CAT(x0, x1) __builtin_shufflevector(__builtin_bit_cast(v4i_t, x0), __builtin_bit_cast(v4i_t, x1), 0, 1, 2, 3, 4, 5, 6, 7)
#define PG8_RD(off) (*(const LAS bf16x8*)(lds + (off)))
#define PG8_LDA(dst, b, h) do { if constexpr (FP8) { _Pragma("unroll") for (int m = 0; m < 4; ++m) dst##8[m] = PG8_CAT(PG8_RD(PG8_SA(b, h) + aoff + m * 2048), PG8_RD(PG8_SA(b, h) + aoff + m * 2048 + 1024)); } \
        else { _Pragma("unroll") for (int m = 0; m < 4; ++m) _Pragma("unroll") for (int k = 0; k < 2; ++k) dst[m][k] = PG8_RD(PG8_SA(b, h) + aoff + m * 2048 + k * 1024); } } while (0)
#define PG8_LDB(dst, b, h) do { if constexpr (FP8) { _Pragma("unroll") for (int n = 0; n < 2; ++n) dst##8[n] = PG8_CAT(PG8_RD(PG8_SB(b, h) + boff + n * 2048), PG8_RD(PG8_SB(b, h) + boff + n * 2048 + 1024)); } \
        else { _Pragma("unroll") for (int n = 0; n < 2; ++n) _Pragma("unroll") for (int k = 0; k < 2; ++k) dst[n][k] = PG8_RD(PG8_SB(b, h) + boff + n * 2048 + k * 1024); } } while (0)
#define PG8_MMA(ai, bj, At, Bt) do { __builtin_amdgcn_s_setprio(1); _Pragma("unroll") for (int m = 0; m < 4; ++m) _Pragma("unroll") for (int n = 0; n < 2; ++n) { \
        if constexpr (FP8) asm volatile("v_mfma_scale_f32_16x16x128_f8f6f4 %0, %1, %2, %0, %3, %3 op_sel_hi:[0,0,0]" : "+v"(acc[ai][bj][m][n]) : "v"(Bt##8[n]), "v"(At##8[m]), "v"(sc8)); \
        else { _Pragma("unroll") for (int k = 0; k < 2; ++k) acc[ai][bj][m][n] = __builtin_amdgcn_mfma_f32_16x16x32_bf16(Bt[n][k], At[m][k], acc[ai][bj][m][n], 0, 0, 0); } } __builtin_amdgcn_s_setprio(0); } while (0)
#define PG8_WAIT_V(n) asm volatile("s_waitcnt vmcnt(" #n ")" ::: "memory")
#define PG8_WAIT_L(n) asm volatile("s_waitcnt lgkmcnt(" #n ")" ::: "memory")
#define PG8_BAR __builtin_amdgcn_s_barrier()
#define PG8_SCHED __builtin_amdgcn_sched_barrier(0)
#define PG8_GIDX(VG, U) do { const int _t = wid * 64 + lane_id();   \
        _Pragma("unroll") for (int _i = 0; _i < 2; ++_i) { int _R, _C; stage_rc(_t * 16 + _i * 8192, _R, _C); _Pragma("unroll") for (int _h = 0; _h < 2; ++_h) \
        VG[_h][_i] = (unsigned)((U).grow + (U).gi[_h * HALF + _R]) * (unsigned)(lda * 2) + (unsigned)_C * 2u; } } while (0)
    Unit cur, nxt; int ui = 0;
    if (!S.next(0, cur)) return;
    Acc acc;
#pragma unroll
    for (int a = 0; a < 2; ++a)
#pragma unroll
        for (int b = 0; b < 2; ++b)
#pragma unroll
            for (int m = 0; m < 4; ++m)
#pragma unroll
                for (int n = 0; n < 2; ++n) acc[a][b][m][n] = (f32x4){0.f, 0.f, 0.f, 0.f};
    bf16x8 At[4][2], B0[2][2], B1[2][2];
    v8i_t At8[4], B08[2], B18[2];
    unsigned sc8 = 0x7f7f7f7fu; asm volatile("" : "+v"(sc8));
    const char* cA = cur.a; const char* cB = cur.b;
    if constexpr (GATHER) { PG8_GIDX(vgc, cur); } else { vgc[0][0] = vgc[0][1] = vgc[1][0] = vgc[1][1] = 0u; }
    E.prep(cur, wr, wc, fr, fq);
    PG8_STAGE_B(PG8_SB(0, 0), cB); PG8_STAGE_B(PG8_SB(0, 1), cB + hstepB); PG8_STAGE_A(PG8_SA(0, 0), cA, 0, vgc); PG8_STAGE_A(PG8_SA(0, 1), cA, 1, vgc);
    if (wr == 1) PG8_BAR;
    PG8_WAIT_V(2); PG8_BAR;
    PG8_STAGE_B(PG8_SB(1, 0), cB + kstep); PG8_STAGE_A(PG8_SA(1, 0), cA + kstep, 0, vgc); PG8_STAGE_B(PG8_SB(1, 1), cB + hstepB + kstep);
    PG8_WAIT_V(6); PG8_BAR;
    for (;;) {
        const bool has_next = S.next(ui + 1, nxt);
        const char* nA = has_next ? nxt.a : cA; const char* nB = has_next ? nxt.b : cB;
        if constexpr (GATHER) { if (has_next) { PG8_GIDX(vgn, nxt); } else {
#pragma unroll
            for (int h = 0; h < 2; ++h) { vgn[h][0] = vgc[h][0]; vgn[h][1] = vgc[h][1]; } } }
        else { vgn[0][0] = vgn[0][1] = vgn[1][0] = vgn[1][1] = 0u; }
        for (int t = 0; t < nt; t += 2) {
            const bool last = (t == nt - 2);
            const char* a1 = cA + (size_t)(t + 1) * kstep;
            const char* a2 = last ? nA : cA + (size_t)(t + 2) * kstep; const char* b2 = last ? nB : cB + (size_t)(t + 2) * kstep;
            const char* a3 = a2 + kstep; const char* b3 = b2 + kstep;
            if constexpr (Epi::MIDK) { if (t == (nt >> 1)) E.midk(acc); }
            PG8_LDB(B0, 0, 0); PG8_LDB(B1, 0, 1); PG8_SCHED; PG8_LDA(At, 0, 0); PG8_STAGE_A(PG8_SA(1, 1), a1, 1, vgc);
            if constexpr (GATHER) { if (last) {
#pragma unroll
                for (int h = 0; h < 2; ++h) { vgc[h][0] = vgn[h][0]; vgc[h][1] = vgn[h][1]; } } }
            PG8_WAIT_V(8); PG8_WAIT_L(0); PG8_BAR; PG8_MMA(0, 0, At, B0); PG8_MMA(0, 1, At, B1); PG8_BAR; PG8_SCHED;
            PG8_LDA(At, 0, 1); PG8_STAGE_B(PG8_SB(0, 0), b2); PG8_STAGE_B(PG8_SB(0, 1), b2 + hstepB); PG8_STAGE_A(PG8_SA(0, 0), a2, 0, vgc);
            PG8_WAIT_V(8); PG8_WAIT_L(0); PG8_BAR; PG8_MMA(1, 0, At, B0); PG8_MMA(1, 1, At, B1); PG8_BAR; PG8_SCHED;
            PG8_LDB(B0, 1, 0); PG8_LDB(B1, 1, 1); PG8_SCHED; PG8_LDA(At, 1, 0); PG8_STAGE_A(PG8_SA(0, 1), a2, 1, vgc);
            PG8_WAIT_V(8); PG8_WAIT_L(0); PG8_BAR; PG8_MMA(0, 0, At, B0); PG8_MMA(0, 1, At, B1); PG8_BAR; PG8_SCHED;
            PG8_LDA(At, 1, 1); PG8_STAGE_B(PG8_SB(1, 0), b3); PG8_STAGE_B(PG8_SB(1, 1), b3 + hstepB); PG8_STAGE_A(PG8_SA(1, 0), a3, 0, vgc);
            PG8_WAIT_V(8); PG8_WAIT_L(0); PG8_BAR; PG8_MMA(1, 0, At, B0); PG8_MMA(1, 1, At, B1); PG8_BAR; PG8_SCHED;
        }
        if constexpr (ALIGN_EPI) { if (wr == 0) PG8_BAR; }
        E(acc, cur, wr, wc, fr, fq);
        if (!has_next) break;
#pragma unroll
        for (int a = 0; a < 2; ++a)
#pragma unroll
            for (int b = 0; b < 2; ++b)
#pragma unroll
                for (int m = 0; m < 4; ++m)
#pragma unroll
                    for (int n = 0; n < 2; ++n) acc[a][b][m][n] = (f32x4){0.f, 0.f, 0.f, 0.f};
        cur = nxt; cA = nA; cB = nB; ++ui;
#pragma unroll
        for (int h = 0; h < 2; ++h) { vgc[h][0] = vgn[h][0]; vgc[h][1] = vgn[h][1]; }
        E.prep(cur, wr, wc, fr, fq);
        if constexpr (ALIGN_EPI) { if (wr == 1) PG8_BAR; }
    }
    PG8_WAIT_V(0);
    if constexpr (!ALIGN_EPI) { if (wr == 0) PG8_BAR; }
    PG8_BAR;
#undef PG8_SA
#undef PG8_SB
#undef PG8_GL
#undef PG8_STAGE_A
#undef PG8_STAGE_B
#undef PG8_LDA
#undef PG8_RD
#undef PG8_LDB
#undef PG8_MMA
#undef PG8_CAT
#undef PG8_WAIT_V
#undef PG8_WAIT_L
#undef PG8_SCHED
#undef PG8_GIDX
}

#define EPI_ROWS for (int ai = 0; ai < 2; ++ai) _Pragma("unroll") for (int m = 0; m < 4; ++m)
__device__ __forceinline__ v4u pack8(const f32x4 a, const f32x4 b) { v4u w; w.x = cvt_pk_bf16(a[0], a[1]); w.y = cvt_pk_bf16(a[2], a[3]); w.z = cvt_pk_bf16(b[0], b[1]); w.w = cvt_pk_bf16(b[2], b[3]); return w; }

template <int mode, bool OUT8 = false>
struct EpiStore {
    static constexpr bool MIDK = false;
    bf16* O; int ldc; const float* cs; float scale; bool skip = false;
    __device__ __forceinline__ void prep(const Unit&, int, int, int, int) {}
    __device__ __forceinline__ void midk(Acc&) {}
    __device__ __forceinline__ void operator()(const Acc& acc, const Unit& u, int wr, int wc, int fr, int fq) const {
        asm volatile("" : "+v"(fr), "+v"(fq));
        if (skip) return;
        size_t base; const float* csp = cs;
        if constexpr (mode == 0) base = (size_t)u.pm * 256 * ldc + (size_t)u.pn * 256;
        else if constexpr (mode == 1) { const int lb = u.pm >> 2, h = u.pm & 3; base = (size_t)lb * D * D + (size_t)(h * 256) * D + u.pn * 256; csp = cs + (size_t)(lb >> 2) * D + u.pn * 256; }
        else if constexpr (mode == 2) { const int pml = u.pm & 3, lbh = u.pm >> 2, h = lbh & 3, lb = lbh >> 2; base = (size_t)lb * D * D + (size_t)(pml * 256) * D + h * 256; }
        else { const int l = u.pm >> 2, pml = u.pm & 3; base = (size_t)l * NMEM * 2 * D + (size_t)(pml * 256) * 2 * D + u.pn * 256; }
        const int cb = wc * 32 + 8 * fq;
        f32x4 c0[2], c1[2];
#pragma unroll
        for (int bj = 0; bj < 2; ++bj) { if (csp) { c0[bj] = *(const f32x4*)(csp + bj * HALF + cb) * scale; c1[bj] = *(const f32x4*)(csp + bj * HALF + cb + 4) * scale; } else { c0[bj] = (f32x4){scale, scale, scale, scale}; c1[bj] = c0[bj]; } }
#pragma unroll
        EPI_ROWS { bf16* rowp = O + base + (size_t)(ai * HALF + wr * 64 + m * 16 + fr) * ldc + cb;
            if constexpr (OUT8) { unsigned char* rp8 = (unsigned char*)O + base + (size_t)(ai * HALF + wr * 64 + m * 16 + fr) * ldc + cb;
#pragma unroll
                for (int bj = 0; bj < 2; ++bj) { const f32x4 a = acc[ai][bj][m][0] * c0[bj], b = acc[ai][bj][m][1] * c1[bj]; v2u o; o.x = pk4_fp8(a[0], a[1], a[2], a[3]); o.y = pk4_fp8(b[0], b[1], b[2], b[3]); *(v2u*)(rp8 + bj * HALF) = o; } }
            else
#pragma unroll
            for (int bj = 0; bj < 2; ++bj) { const v4u w_ = pack8(acc[ai][bj][m][0] * c0[bj], acc[ai][bj][m][1] * c1[bj]); if constexpr (mode == 0 && NT_Y) __builtin_nontemporal_store(w_, (v4u*)(rowp + bj * HALF)); else *(v4u*)(rowp + bj * HALF) = w_; } }
    }
};
struct EpiH {
    static constexpr bool MIDK = false;
    unsigned char* H;
    __device__ __forceinline__ void prep(const Unit&, int, int, int, int) {}
    __device__ __forceinline__ void midk(Acc&) {}
    __device__ __forceinline__ void operator()(const Acc& acc, const Unit& u, int wr, int wc, int fr, int fq) const {
        asm volatile("" : "+v"(fr), "+v"(fq));
        const int cb = u.pn * 128 + wc * 32 + 8 * fq; constexpr float us = 1.0f / (W8S * A8S);
#pragma unroll
        EPI_ROWS { const int rl = ai * HALF + wr * 64 + m * 16 + fr; unsigned char* rowp = H + (size_t)(u.pm * 256 + rl) * FF + cb;
            f32x4 h0, h1;
#pragma unroll
            for (int i = 0; i < 4; ++i) { h0[i] = silu_f(acc[ai][0][m][0][i] * us) * (acc[ai][1][m][0][i] * (us * H8S)); h1[i] = silu_f(acc[ai][0][m][1][i] * us) * (acc[ai][1][m][1][i] * (us * H8S)); }
            v2u o; o.x = pk4_fp8(h0[0], h0[1], h0[2], h0[3]); o.y = pk4_fp8(h1[0], h1[1], h1[2], h1[3]); *(v2u*)rowp = o; }
    }
};
struct EpiY8 {
    static constexpr bool MIDK = false;
    unsigned char* Y; float scale; bool skip = false;
    __device__ __forceinline__ void prep(const Unit&, int, int, int, int) {}
    __device__ __forceinline__ void midk(Acc&) {}
    __device__ __forceinline__ void operator()(const Acc& acc, const Unit& u, int wr, int wc, int fr, int fq) const {
        if (skip) return;
        asm volatile("" : "+v"(fr), "+v"(fq));
        const int cb = u.pn * 256 + wc * 32 + 8 * fq;
#pragma unroll
        EPI_ROWS { unsigned char* rowp = Y + (size_t)(u.pm * 256 + ai * HALF + wr * 64 + m * 16 + fr) * D + cb;
#pragma unroll
            for (int bj = 0; bj < 2; ++bj) { const f32x4 a = acc[ai][bj][m][0] * scale, b = acc[ai][bj][m][1] * scale;
                v2u o; o.x = pk4_fp8(a[0], a[1], a[2], a[3]); o.y = pk4_fp8(b[0], b[1], b[2], b[3]); __builtin_nontemporal_store(o, (v2u*)(rowp + bj * HALF)); } }
    }
};
template <bool MK, bool WRITE_XB>
struct EpiX {
    static constexpr bool MIDK = MK;
    bf16* xr; float* xstat; const float* gmstat; const float* atstat; LAS unsigned char* lds; unsigned char* xa8; float scale;
    int wr_, wc_, fr_;
    __device__ __forceinline__ void prep(const Unit& u, int wr, int wc, int fr, int fq) {
        wr_ = wr; wc_ = wc; fr_ = fr;
        if constexpr (MK) {
            asm volatile("" : "+v"(fr), "+v"(fq));
            LAS f32x2* X = (LAS f32x2*)(lds + RING_BYTES + 1024) + (wr * 4 + wc) * 128;
#pragma unroll
            EPI_ROWS { const size_t row = (size_t)u.pm * 256 + ai * HALF + wr * 64 + m * 16 + fr;
                const f32x4 g = *(const f32x4*)(gmstat + row * 4), a0 = *(const f32x4*)(atstat + row * 8), a1 = *(const f32x4*)(atstat + row * 8 + 4);
                const float sg = (g[0] + g[1]) + (g[2] + g[3]), sa = ((a0[0] + a0[1]) + (a0[2] + a0[3])) + ((a1[0] + a1[1]) + (a1[2] + a1[3]));
                const float rgm = __builtin_amdgcn_rsqf(sg * (1.0f / 512.0f) + EPS), rat = __builtin_amdgcn_rsqf(sa * (1.0f / 512.0f) + EPS);
                if (fq == 0) X[(ai * 4 + m) * 16 + fr] = (f32x2){rgm / rat, rat}; }
            asm volatile("s_waitcnt lgkmcnt(0)" ::: "memory");
        }
    }
    __device__ __forceinline__ void midk(Acc& acc) {
        int fr = fr_; asm volatile("" : "+v"(fr));
        const LAS f32x2* X = (const LAS f32x2*)(lds + RING_BYTES + 1024) + (wr_ * 4 + wc_) * 128;
#pragma unroll
        EPI_ROWS { const float f = X[(ai * 4 + m) * 16 + fr].x;
#pragma unroll
            for (int bj = 0; bj < 2; ++bj) { acc[ai][bj][m][0] *= f; acc[ai][bj][m][1] *= f; } }
    }
    __device__ __forceinline__ void operator()(const Acc& acc, const Unit& u, int wr, int wc, int fr, int fq) const {
        asm volatile("" : "+v"(fr), "+v"(fq));
        const int cb = u.pn * 256 + wc * 32 + 8 * fq;
#pragma unroll
        EPI_ROWS { const size_t row = (size_t)u.pm * 256 + ai * HALF + wr * 64 + m * 16 + fr; const size_t off = row * D + cb;
            float f = scale; if constexpr (MK) f = ((const LAS f32x2*)(lds + RING_BYTES + 1024) + (wr * 4 + wc) * 128)[(ai * 4 + m) * 16 + fr].y; float ss = 0.f;
#pragma unroll
            for (int bj = 0; bj < 2; ++bj) { const v4u b = *(const v4u*)(xr + off + bj * HALF);
                const f32x4 x0 = (f32x4){bflo(b.x), bfhi(b.x), bflo(b.y), bfhi(b.y)} + acc[ai][bj][m][0] * f, x1 = (f32x4){bflo(b.z), bfhi(b.z), bflo(b.w), bfhi(b.w)} + acc[ai][bj][m][1] * f;
                *(v4u*)(xr + off + bj * HALF) = pack8(x0, x1);
                if constexpr (WRITE_XB) { v2u o8; o8.x = pk4_fp8(x0[0] * A8S, x0[1] * A8S, x0[2] * A8S, x0[3] * A8S); o8.y = pk4_fp8(x1[0] * A8S, x1[1] * A8S, x1[2] * A8S, x1[3] * A8S); *(v2u*)(xa8 + off + bj * HALF) = o8; }
                if constexpr (WRITE_XB) ss += ((x0[0] * x0[0] + x0[1] * x0[1]) + (x0[2] * x0[2] + x0[3] * x0[3])) + ((x1[0] * x1[0] + x1[1] * x1[1]) + (x1[2] * x1[2] + x1[3] * x1[3])); }
            if constexpr (WRITE_XB) { ss = add_x32(add_x16(ss)); if (fq == 0) xstat[row * 16 + u.pn * 4 + wc] = ss; }
            if (m & 1) asm volatile("" ::: "memory"); }
    }
};
constexpr int EXCH_OFF = RING_BYTES + 1024;
struct EpiS {
    static constexpr bool MIDK = false;
    const float* xstat; unsigned char* P; LAS unsigned char* lds;
    __device__ __forceinline__ void prep(const Unit&, int, int, int, int) {}
    __device__ __forceinline__ void midk(Acc&) {}
    __device__ __forceinline__ void operator()(Acc& acc, const Unit& u, int wr, int wc, int fr, int fq) const {
        asm volatile("" : "+v"(fr), "+v"(fq));
        LAS f32x2* X = (LAS f32x2*)(lds + EXCH_OFF);
        float mw[2][4];
#pragma unroll
        EPI_ROWS { const int rl = ai * HALF + wr * 64 + m * 16 + fr; const size_t row = (size_t)u.pm * 256 + rl;
            const f32x4 s0 = *(const f32x4*)(xstat + row * 16), s1 = *(const f32x4*)(xstat + row * 16 + 4), s2 = *(const f32x4*)(xstat + row * 16 + 8), s3 = *(const f32x4*)(xstat + row * 16 + 12);
            const float ssq = (((s0[0] + s0[1]) + (s0[2] + s0[3])) + ((s1[0] + s1[1]) + (s1[2] + s1[3]))) + (((s2[0] + s2[1]) + (s2[2] + s2[3])) + ((s3[0] + s3[1]) + (s3[2] + s3[3])));
            const float rinv = __builtin_amdgcn_rsqf(ssq * (1.0f / D) + EPS) * (1.0f / (A8S * Q8S));
            float mx = -3.0e38f;
#pragma unroll
            for (int bj = 0; bj < 2; ++bj)
#pragma unroll
                for (int n = 0; n < 2; ++n) { acc[ai][bj][m][n] *= rinv; const f32x4 v = acc[ai][bj][m][n]; mx = fmaxf(mx, fmaxf(fmaxf(v[0], v[1]), fmaxf(v[2], v[3]))); }
            mx = max_x32(max_x16(mx));
            float sm = 0.f;
#pragma unroll
            for (int bj = 0; bj < 2; ++bj)
#pragma unroll
                for (int n = 0; n < 2; ++n) { f32x4 v = acc[ai][bj][m][n];
#pragma unroll
                    for (int i = 0; i < 4; ++i) { v[i] = __builtin_amdgcn_exp2f(v[i] - mx); sm += v[i]; }
                    acc[ai][bj][m][n] = v; }
            sm = add_x32(add_x16(sm));
            mw[ai][m] = mx;
            if (fq == 0) X[rl * 4 + wc] = (f32x2){mx, sm};
            if (m & 1) asm volatile("" ::: "memory"); }
        asm volatile("s_waitcnt lgkmcnt(0)\n\ts_barrier" ::: "memory");
        const int cb = u.pn * 256 + wc * 32 + 8 * fq;
#pragma unroll
        EPI_ROWS { const int rl = ai * HALF + wr * 64 + m * 16 + fr; const size_t row = (size_t)u.pm * 256 + rl;
            const f32x2 e0 = X[rl * 4 + 0], e1 = X[rl * 4 + 1], e2 = X[rl * 4 + 2], e3 = X[rl * 4 + 3];
            const float M = fmaxf(fmaxf(e0.x, e1.x), fmaxf(e2.x, e3.x));
            const float den = (e0.y * __builtin_amdgcn_exp2f(e0.x - M) + e1.y * __builtin_amdgcn_exp2f(e1.x - M)) + (e2.y * __builtin_amdgcn_exp2f(e2.x - M) + e3.y * __builtin_amdgcn_exp2f(e3.x - M));
            const float f = __builtin_amdgcn_exp2f(mw[ai][m] - M) * __builtin_amdgcn_rcpf(den) * P8S;
#pragma unroll
            for (int bj = 0; bj < 2; ++bj) { const f32x4 a = acc[ai][bj][m][0] * f, b = acc[ai][bj][m][1] * f; v2u o; o.x = pk4_fp8(a[0], a[1], a[2], a[3]); o.y = pk4_fp8(b[0], b[1], b[2], b[3]); *(v2u*)(P + row * D + cb + bj * HALF) = o; } }
        asm volatile("s_waitcnt lgkmcnt(0)" ::: "memory");
    }
};
struct EpiIn {
    static constexpr bool MIDK = false;
    bf16 *uact, *vact, *q, *k, *v; float* vstat; const float *qg, *kg, *cosT, *sinT, *rinv;
    __device__ __forceinline__ void prep(const Unit&, int, int, int, int) {}
    __device__ __forceinline__ void midk(Acc&) {}
    __device__ __forceinline__ void operator()(const Acc& acc, const Unit& u, int wr, int wc, int fr, int fq) const {
        asm volatile("" : "+v"(fr), "+v"(fq));
        const int pn = u.pn;
        if (pn < 4) {
            bf16* O = pn < 2 ? uact : vact; const int cb = (pn & 1) * 256 + wc * 32 + 8 * fq;
#pragma unroll
            EPI_ROWS { const size_t row = (size_t)u.pm * 256 + ai * HALF + wr * 64 + m * 16 + fr; float ss = 0.f; const float ri = rinv[row];
#pragma unroll
                for (int bj = 0; bj < 2; ++bj) { f32x4 g0, g1;
#pragma unroll
                    for (int i = 0; i < 4; ++i) { g0[i] = gelu_tanh(acc[ai][bj][m][0][i] * ri); g1[i] = gelu_tanh(acc[ai][bj][m][1][i] * ri); }
                    const v4u w = pack8(g0, g1); st16(O + row * GMW + cb + bj * HALF, w);
                    if (pn >= 2) { const float a0 = bflo(w.x), a1 = bfhi(w.x), a2 = bflo(w.y), a3 = bfhi(w.y), a4 = bflo(w.z), a5 = bfhi(w.z), a6 = bflo(w.w), a7 = bfhi(w.w);
                        ss += ((a0 * a0 + a1 * a1) + (a2 * a2 + a3 * a3)) + ((a4 * a4 + a5 * a5) + (a6 * a6 + a7 * a7)); } }
                if (pn >= 2) { ss = add_x32(add_x16(ss)); if (fq == 0) vstat[row * 8 + (pn - 2) * 4 + wc] = ss; } }
        } else if (pn == 6 && wc >= 2) {
#pragma unroll
            EPI_ROWS { const size_t row = (size_t)u.pm * 256 + ai * HALF + wr * 64 + m * 16 + fr; const float ri = rinv[row];
#pragma unroll
                for (int bj = 0; bj < 2; ++bj) st16(v + row * 128 + (wc - 2) * 64 + bj * 32 + 8 * fq, pack8(acc[ai][bj][m][0] * ri, acc[ai][bj][m][1] * ri)); }
        } else {
            const bool isq = pn < 6; const float* g = isq ? qg : kg; const float sc = isq ? QSCALE : 1.0f;
            bf16* O = isq ? q + ((pn - 4) * 4 + wc) * 64 : k + wc * 64; const int ldo = isq ? 512 : 128;
            f32x4 gv[2][2];
#pragma unroll
            for (int bj = 0; bj < 2; ++bj) { gv[bj][0] = *(const f32x4*)(g + bj * 32 + 8 * fq) * sc; gv[bj][1] = *(const f32x4*)(g + bj * 32 + 8 * fq + 4) * sc; }
#pragma unroll
            EPI_ROWS { const size_t row = (size_t)u.pm * 256 + ai * HALF + wr * 64 + m * 16 + fr; const int t = (int)(row % SEQ); const float ri = this->rinv[row];
                float ss = 0.f;
#pragma unroll
                for (int bj = 0; bj < 2; ++bj)
#pragma unroll
                    for (int n = 0; n < 2; ++n) { const f32x4 x = acc[ai][bj][m][n]; ss += (x[0] * x[0] + x[1] * x[1]) + (x[2] * x[2] + x[3] * x[3]); }
                ss = add_x32(add_x16(ss));
                const float rinv = ri * __builtin_amdgcn_rsqf(ss * (ri * ri) * (1.0f / 64.0f) + EPS);
#pragma unroll
                for (int bj = 0; bj < 2; ++bj) { const f32x4 c = *(const f32x4*)(cosT + t * 32 + bj * 16 + 4 * fq), sn = *(const f32x4*)(sinT + t * 32 + bj * 16 + 4 * fq);
                    const f32x4 x0 = acc[ai][bj][m][0] * gv[bj][0] * rinv, x1 = acc[ai][bj][m][1] * gv[bj][1] * rinv; f32x4 o0, o1;
                    o0[0] = x0[0] * c[0] - x0[1] * sn[0]; o0[1] = x0[0] * sn[0] + x0[1] * c[0]; o0[2] = x0[2] * c[1] - x0[3] * sn[1]; o0[3] = x0[2] * sn[1] + x0[3] * c[1];
                    o1[0] = x1[0] * c[2] - x1[1] * sn[2]; o1[1] = x1[0] * sn[2] + x1[1] * c[2]; o1[2] = x1[2] * c[3] - x1[3] * sn[3]; o1[3] = x1[2] * sn[3] + x1[3] * c[3];
                    st16(O + row * ldo + bj * 32 + 8 * fq, pack8(o0, o1)); }
                if (m & 1) asm volatile("" ::: "memory"); }
        }
    }
};
}


struct CvtJob { const float* W; const float* gain; bf16* WT; int K, N, dst_row0, k0, n0; bool f8; };
__device__ __forceinline__ CvtJob cvt_decode(const Frame& F, int it) {
    constexpr int I_IN = 16 * 56, I_SQ = 512, I_KV = 1024, I_HEAD = I_IN + I_SQ + I_KV + I_SQ, I_LAYER = I_HEAD + NE * 3 * I_SQ;
    CvtJob j; j.f8 = false; const int l = it / I_LAYER; int r = it % I_LAYER;
    if (r < I_IN) { const int kb = r / 56, nb = r % 56, n0 = nb * 32, pn = n0 >> 8; int dr = n0;
        if (pn >= 4) { const int sidx = n0 & 255, w = sidx >> 6, bj = (sidx >> 5) & 1; dr = pn * 256 + 128 * bj + 32 * w; }
        j.W = F.in[3] + (size_t)l * D * INW; j.gain = F.in[2] + (size_t)l * D; j.WT = (bf16*)(F.ws + WS_WIN) + (size_t)l * INW * D; j.K = D; j.N = INW; j.dst_row0 = dr; j.k0 = kb * 64; j.n0 = n0; return j; }
    r -= I_IN;
    if (r < I_SQ) { j.W = F.in[10] + (size_t)l * D * D; j.gain = F.in[9] + (size_t)l * D; j.WT = (bf16*)(F.ws + WS_WOUT) + (size_t)l * D * D; j.K = D; j.N = D; j.dst_row0 = (r % 32) * 32; j.k0 = (r / 32) * 64; j.n0 = (r % 32) * 32; return j; }
    r -= I_SQ;
    if (r < I_KV) { j.W = F.in[14] + (size_t)l * D * 2 * D; j.gain = nullptr; j.WT = (bf16*)(F.ws + WS_WKVT) + (size_t)l * 2 * D * D; j.K = D; j.N = 2 * D; j.dst_row0 = (r % 64) * 32; j.k0 = (r / 64) * 64; j.n0 = (r % 64) * 32; return j; }
    r -= I_KV;
    if (r < I_SQ) { j.W = F.in[15] + (size_t)l * D * D; j.gain = nullptr; j.WT = (bf16*)(F.ws + WS_WOT) + (size_t)l * D * D; j.K = D; j.N = D; j.dst_row0 = (r % 32) * 32; j.k0 = (r / 32) * 64; j.n0 = (r % 32) * 32; return j; }
    r -= I_SQ;
    const int e = r / (3 * I_SQ), rr = r % (3 * I_SQ), which = rr / I_SQ, sub = rr % I_SQ, kb = sub / 32, n0 = (sub % 32) * 32;
    const size_t mo = ((size_t)l * NE + e) * D * FF;
    j.K = D; j.N = FF; j.k0 = kb * 64; j.n0 = n0;
    j.f8 = true;
    if (which == 2) { j.W = F.in[20] + mo; j.gain = nullptr; j.WT = (bf16*)(F.ws + WS_WD + mo); j.dst_row0 = n0; }
    else { j.W = (which == 0 ? F.in[18] : F.in[19]) + mo; j.gain = F.in[16] + (size_t)l * D; j.WT = (bf16*)(F.ws + WS_WGU + 2 * mo); j.dst_row0 = 256 * (n0 >> 7) + 128 * which + (n0 & 127); }
    return j;
}
#define CVT_LOAD(J, R) do { const float* p_ = (J).W + (size_t)((J).k0 + (lane_ >> 5)) * (J).N + (J).n0 + (lane_ & 31); _Pragma("unroll") for (int i_ = 0; i_ < 32; ++i_) R[i_] = p_[(size_t)(2 * i_) * (J).N]; } while (0)
__device__ __forceinline__ void ph_convert(Frame& F) {
    int lane_ = lane_id(); asm volatile("" : "+v"(lane_)); const int tid_ = F.wave * 64 + lane_;
    LAS float* scr = (LAS float*)(F.lds + F.wave * 16384);
    const int gw = F.vcu * NWAVES + F.wave, NGW = F.G * NWAVES;
    constexpr int I_LAYER = 16 * 56 + 512 + 1024 + 512 + NE * 3 * 512, NITEMS = NL * I_LAYER;
    if (gw < NITEMS) {
        int it = gw; CvtJob cur = cvt_decode(F, it); float r[32]; CVT_LOAD(cur, r);
        for (;;) {
            const int nit = it + NGW; const bool hn = nit < NITEMS; CvtJob nx = cur; if (hn) nx = cvt_decode(F, nit);
#pragma unroll
            for (int i = 0; i < 32; ++i) scr[(2 * i + (lane_ >> 5)) * 33 + (lane_ & 31)] = r[i];
            if (hn) CVT_LOAD(nx, r);
            asm volatile("s_waitcnt lgkmcnt(0)" ::: "memory");
            const int c = lane_ & 7;
            f32x4 g0 = (f32x4){1.f, 1.f, 1.f, 1.f}, g1 = g0;
            if (cur.gain) { g0 = *(const f32x4*)(cur.gain + cur.k0 + 8 * c); g1 = *(const f32x4*)(cur.gain + cur.k0 + 8 * c + 4); }
#pragma unroll
            for (int j = 0; j < 4; ++j) { const int n = (lane_ >> 3) + 8 * j; const LAS float* sp = scr + (8 * c) * 33 + n;
                if (cur.f8) { v2u o; o.x = pk4_fp8(sp[0 * 33] * g0[0] * W8S, sp[1 * 33] * g0[1] * W8S, sp[2 * 33] * g0[2] * W8S, sp[3 * 33] * g0[3] * W8S); o.y = pk4_fp8(sp[4 * 33] * g1[0] * W8S, sp[5 * 33] * g1[1] * W8S, sp[6 * 33] * g1[2] * W8S, sp[7 * 33] * g1[3] * W8S);
                    *(v2u*)((unsigned char*)cur.WT + (size_t)(cur.dst_row0 + n) * cur.K + cur.k0 + 8 * c) = o; }
                else { v4u o; o.x = pk2(sp[0 * 33] * g0[0], sp[1 * 33] * g0[1]); o.y = pk2(sp[2 * 33] * g0[2], sp[3 * 33] * g0[3]); o.z = pk2(sp[4 * 33] * g1[0], sp[5 * 33] * g1[1]); o.w = pk2(sp[6 * 33] * g1[2], sp[7 * 33] * g1[3]);
                    *(v4u*)(cur.WT + (size_t)(cur.dst_row0 + n) * cur.K + cur.k0 + 8 * c) = o; } }
            asm volatile("s_waitcnt lgkmcnt(0)" ::: "memory");
            if (!hn) break; cur = nx; it = nit;
        }
    }
    {   const float* wsrc = F.in[5]; bf16* WSBd = (bf16*)(F.ws + WS_WSB);
        for (int i = F.vcu * NTHR + tid_; i < NL * 4 * 128 * 128 / 8; i += F.G * NTHR) { const f32x4 a = *(const f32x4*)(wsrc + (size_t)i * 8), b = *(const f32x4*)(wsrc + (size_t)i * 8 + 4);
            v4u o; o.x = pk2(a.x, a.y); o.y = pk2(a.z, a.w); o.z = pk2(b.x, b.y); o.w = pk2(b.z, b.w); *(v4u*)(WSBd + (size_t)i * 8) = o; } }
    {   bf16* WRH = (bf16*)(F.ws + WS_WRH); bf16* WRL = (bf16*)(F.ws + WS_WRL);
        for (int i = F.vcu * NTHR + tid_; i < NL * NE * D; i += F.G * NTHR) { const int l = i / (NE * D), e = (i / D) % NE, c = i % D;
            const float w = F.in[17][((size_t)l * D + c) * NE + e] * F.in[16][(size_t)l * D + c]; const unsigned h = f2bf(w); WRH[i] = (bf16)h; WRL[i] = (bf16)f2bf(w - bf2f(h)); } }
    const int gt = F.vcu * NTHR + tid_, NGT = F.G * NTHR;
    const float* wq = F.in[13]; bf16* WQB = (bf16*)(F.ws + WS_WQB);
    for (int i = gt; i < NL * D * D / 8; i += NGT) { const f32x4 a = *(const f32x4*)(wq + (size_t)i * 8), b = *(const f32x4*)(wq + (size_t)i * 8 + 4);
        v4u o; o.x = pk2(a.x, a.y); o.y = pk2(a.z, a.w); o.z = pk2(b.x, b.y); o.w = pk2(b.z, b.w); *(v4u*)(WQB + (size_t)i * 8) = o; }
}

struct SchedDense {
    pg8::TileOrder o; const char* A; size_t a_tile; const char* B; size_t b_tile, b_batch; int bdiv, bmod;
    __device__ __forceinline__ bool next(int i, pg8::Unit& u) const { if (!o.tile(i, u.pm, u.pn)) return false;
        u.z = 0; u.gi = nullptr; u.grow = 0; u.a = A + (size_t)u.pm * a_tile; u.b = B + (size_t)((u.pm / bdiv) % bmod) * b_batch + (size_t)u.pn * b_tile; return true; }
};
struct SchedE1 {
    pg8::TileOrder o; const char* HBp; const int* IDX; const char* WGU;
    __device__ __forceinline__ bool next(int i, pg8::Unit& u) const { if (!o.tile(i, u.pm, u.pn)) return false;
        const int z = u.pm >> 2; u.z = z; u.gi = IDX + (size_t)u.pm * 256; u.grow = (z >> 4) * SEQ; u.a = HBp;
        u.b = WGU + (size_t)(z & 15) * (2 * FF * D) + (size_t)u.pn * (256 * D); return true; }
};
struct SchedKV { pg8::TileOrder o; const char* MEMN; const char* WKVT;
    __device__ __forceinline__ bool next(int i, pg8::Unit& u) const { if (!o.tile(i, u.pm, u.pn)) return false; u.z = 0; u.gi = nullptr; u.grow = 0;
        u.a = MEMN + (size_t)(u.pm & 3) * (256 * D * 2); u.b = WKVT + (size_t)(u.pm >> 2) * (2 * D * D * 2) + (size_t)u.pn * (256 * D * 2); return true; } };
struct SchedQK { pg8::TileOrder o; const char* KVM; const char* WQB;
    __device__ __forceinline__ bool next(int i, pg8::Unit& u) const { if (!o.tile(i, u.pm, u.pn)) return false; u.z = 0; u.gi = nullptr; u.grow = 0;
        const int h = u.pm & 3, lb = u.pm >> 2, b = lb & 3, l = lb >> 2;
        u.a = KVM + ((size_t)l * NMEM * 2 * D + (size_t)(b * 256) * 2 * D + h * 256) * 2; u.b = WQB + ((size_t)l * D * D + (size_t)u.pn * 256 * D + h * 256) * 2; return true; } };
struct SchedVO { pg8::TileOrder o; const char* KVM; const char* WOT;
    __device__ __forceinline__ bool next(int i, pg8::Unit& u) const { if (!o.tile(i, u.pm, u.pn)) return false; u.z = 0; u.gi = nullptr; u.grow = 0;
        const int pml = u.pm & 3, lbh = u.pm >> 2, h = lbh & 3, lb = lbh >> 2, b = lb & 3, l = lb >> 2;
        u.a = WOT + ((size_t)l * D * D + (size_t)pml * 256 * D + h * 256) * 2; u.b = KVM + ((size_t)l * NMEM * 2 * D + (size_t)(b * 256) * 2 * D + D + h * 256) * 2; return true; } };

namespace attn_body {
using bf16=__hip_bfloat16;
using bf16x8=__attribute__((ext_vector_type(8)))short;
using s16x4=__attribute__((ext_vector_type(4)))short;
using f32x16=__attribute__((ext_vector_type(16)))float;
using u32x4=__attribute__((ext_vector_type(4)))unsigned;
constexpr int SEQ=8192,D=64,QP=512,KP=128,OP=1024;
constexpr int NW=8,QBLK=32,QB=QBLK*NW,KVBLK=64,NQB=SEQ/QB;
constexpr int ATTN_UNIT_ROWS=QB;
__device__ __forceinline__ int crow(int r,int hi){return (r&3)+8*(r>>2)+4*hi;}
#define SBAR() __builtin_amdgcn_sched_barrier(0)
__device__ __forceinline__ void cmask(f32x16&p0,f32x16&p1,int jb,int qrel,int hi){
  const float NEG=-INFINITY; int kb=64*jb+4*hi;
  #pragma unroll
  for(int r=0;r<16;++r){int kv=kb+(r&3)+8*(r>>2); if(kv>qrel)p0[r]=NEG; if(kv+32>qrel)p1[r]=NEG;}
}

constexpr int NSLOT=3, SLOTB=8192;
constexpr int LDS_K=0, LDS_V=NSLOT*SLOTB, LDS_WS=2*NSLOT*SLOTB, LDS_OST=LDS_WS+NW*64*4, LDS_BYTES=LDS_OST+NW*4096;
constexpr float C2=0.125f*1.4426950408889634f;
__device__ __forceinline__ void glds16(const void*gsrc,unsigned lds_dst){unsigned keep;
  asm volatile("s_mov_b32 %0, m0\n\ts_mov_b32 m0, %2\n\ts_nop 0\n\tglobal_load_lds_dwordx4 %1, off\n\ts_mov_b32 m0, %0":"=&s"(keep):"v"(gsrc),"s"(lds_dst):"memory");}
__device__ __forceinline__ float max3f(float a,float b,float c){float r;asm("v_max3_f32 %0, %1, %2, %3":"=v"(r):"v"(a),"v"(b),"v"(c));return r;}
__device__ __forceinline__ float max2f(float a,float b){float r;asm("v_max_f32_e32 %0, %1, %2":"=v"(r):"v"(a),"v"(b));return r;}
__device__ __forceinline__ float fadd_s(float a,float b){float r;asm("v_add_f32_e32 %0, %1, %2":"=v"(r):"v"(a),"v"(b));return r;}
__device__ __forceinline__ float fsub_s(float a,float b){float r;asm("v_sub_f32_e32 %0, %1, %2":"=v"(r):"v"(a),"v"(b));return r;}
typedef float f32x2_t __attribute__((ext_vector_type(2))); typedef __bf16 bf16x2_t __attribute__((ext_vector_type(2)));
__device__ __forceinline__ unsigned cvtpk_s(float lo,float hi){f32x2_t v={lo,hi};bf16x2_t b=__builtin_convertvector(v,bf16x2_t);return __builtin_bit_cast(unsigned,b);}
#define WAIT_BAR(N) asm volatile("s_waitcnt vmcnt(" #N ") lgkmcnt(0)\n\ts_barrier":::"memory")

__device__ __forceinline__ void qkt(f32x16&p0,f32x16&p1,const char*Kslot,const bf16x8*qr,const f32x16&negm,int r32,int hi){
  const char*kb=Kslot+hi*1024+r32*16;
  #pragma unroll
  for(int d0=0;d0<4;++d0){
    const bf16x8 b0=*reinterpret_cast<const bf16x8*>(kb+d0*2048);
    const bf16x8 b1=*reinterpret_cast<const bf16x8*>(kb+d0*2048+512);
    if(d0==0){p0=__builtin_amdgcn_mfma_f32_32x32x16_bf16(b0,qr[0],negm,0,0,0);p1=__builtin_amdgcn_mfma_f32_32x32x16_bf16(b1,qr[0],negm,0,0,0);}
    else{p0=__builtin_amdgcn_mfma_f32_32x32x16_bf16(b0,qr[d0],p0,0,0,0);p1=__builtin_amdgcn_mfma_f32_32x32x16_bf16(b1,qr[d0],p1,0,0,0);}}
}
typedef __attribute__((address_space(3))) const char* lds_cptr;
typedef short v4i16_t __attribute__((ext_vector_type(4)));
__device__ __forceinline__ void kload8(bf16x8*kf,lds_cptr kp){
  kf[0]=*(const __attribute__((address_space(3))) bf16x8*)(kp);      kf[1]=*(const __attribute__((address_space(3))) bf16x8*)(kp+512);
  kf[2]=*(const __attribute__((address_space(3))) bf16x8*)(kp+2048); kf[3]=*(const __attribute__((address_space(3))) bf16x8*)(kp+2560);
  kf[4]=*(const __attribute__((address_space(3))) bf16x8*)(kp+4096); kf[5]=*(const __attribute__((address_space(3))) bf16x8*)(kp+4608);
  kf[6]=*(const __attribute__((address_space(3))) bf16x8*)(kp+6144); kf[7]=*(const __attribute__((address_space(3))) bf16x8*)(kp+6656);
}
__device__ __forceinline__ void kload2(bf16x8*kf,lds_cptr kp,int j){ kf[2*j]=*(const __attribute__((address_space(3))) bf16x8*)(kp+j*2048); kf[2*j+1]=*(const __attribute__((address_space(3))) bf16x8*)(kp+j*2048+512); }
__device__ __forceinline__ s16x4 vtr(lds_cptr p){ return __builtin_bit_cast(s16x4,__builtin_amdgcn_ds_read_tr16_b64_v4i16((__attribute__((address_space(3))) v4i16_t*)p)); }
__device__ __forceinline__ float rowmax(const f32x16&p0,const f32x16&p1){
  float a=max3f(p0[0],p0[1],p1[0]),b=max3f(p0[2],p0[3],p1[1]);a=max3f(a,p1[2],p1[3]);
  #pragma unroll
  for(int r=4;r<16;r+=4){a=max3f(a,p0[r],p0[r+1]);b=max3f(b,p0[r+2],p0[r+3]);a=max3f(a,p1[r],p1[r+1]);b=max3f(b,p1[r+2],p1[r+3]);}
  const float m=max2f(a,b);
  auto rr=__builtin_amdgcn_permlane32_swap(__float_as_uint(m),__float_as_uint(m),false,false);
  return max2f(__uint_as_float(rr[0]),__uint_as_float(rr[1]));
}
__device__ __forceinline__ void pv(f32x16*o,int vb,bf16x8 pa0,bf16x8 pa1,bf16x8 pa2,bf16x8 pa3){
  #pragma unroll
  for(int d0=0;d0<2;++d0){s16x4 lo[4],hi[4];
    #pragma unroll
    for(int ks=0;ks<4;++ks){
      asm volatile("ds_read_b64_tr_b16 %0,%1 offset:%c2":"=&v"(lo[ks]):"v"(vb),"i"(d0*4096+ks*1024):"memory");
      asm volatile("ds_read_b64_tr_b16 %0,%1 offset:%c2":"=&v"(hi[ks]):"v"(vb),"i"(d0*4096+ks*1024+512):"memory");}
    asm volatile("s_waitcnt lgkmcnt(0)":::"memory");SBAR();
    #define PK(k) (bf16x8){lo[k][0],lo[k][1],lo[k][2],lo[k][3],hi[k][0],hi[k][1],hi[k][2],hi[k][3]}
    o[d0]=__builtin_amdgcn_mfma_f32_32x32x16_bf16(pa0,PK(0),o[d0],0,0,0);
    o[d0]=__builtin_amdgcn_mfma_f32_32x32x16_bf16(pa1,PK(1),o[d0],0,0,0);
    o[d0]=__builtin_amdgcn_mfma_f32_32x32x16_bf16(pa2,PK(2),o[d0],0,0,0);
    o[d0]=__builtin_amdgcn_mfma_f32_32x32x16_bf16(pa3,PK(3),o[d0],0,0,0);
    #undef PK
  }
}

#ifndef ATTN_STORE16
#define ATTN_STORE16(p,v) (*(u32x4*)(p)=(v))
#endif
template<int THRL> __device__ __forceinline__ void attn_unit(int b,int h,int qb,const bf16*Q,const bf16*__restrict__ K,const bf16*__restrict__ V,bf16*O,float*ATS,char*shm,int wave_idx){
  int lane; asm volatile("v_mbcnt_lo_u32_b32 %0, -1, 0\n\tv_mbcnt_hi_u32_b32 %0, -1, %0":"=v"(lane)); const int r32=lane&31,hi=lane>>5; const int wid=wave_idx; const int kvh=h>>2;
  const long rowbase=(long)b*SEQ; const int q0=qb*QB;
  const bf16*Qw=Q+(rowbase+q0+wid*QBLK)*QP+h*D;
  const bf16*Kh=K+rowbase*KP+kvh*D,*Vh=V+rowbase*KP+kvh*D;
  const unsigned lds0=(unsigned)(uintptr_t)shm;
  float*wsf=(float*)(shm+LDS_WS)+wid*64;
  const bf16*ksrc=Kh+(long)lane*KP+wid*8;
  const bf16*vsrc=Vh+(long)(16*(wid&3)+(lane>>2))*KP+(wid>>2)*32+(lane&3)*8;
  const unsigned kdst=lds0+LDS_K+wid*1024, vdst=lds0+LDS_V+wid*1024;
  #define DMA_K(t,slot) glds16(ksrc+(long)(t)*KVBLK*KP,(unsigned)__builtin_amdgcn_readfirstlane(kdst+(slot)))
  #define DMA_V(t,slot) glds16(vsrc+(long)(t)*KVBLK*KP,(unsigned)__builtin_amdgcn_readfirstlane(vdst+(slot)))
  const int vb0=(int)(lds0+LDS_V)+((lane>>4)&1)*32+(lane&3)*8+(4*hi+((lane&15)>>2))*64;
  const char*Kbase=shm+LDS_K; bf16x8 kf[8];
  const lds_cptr shm3=(lds_cptr)shm; const lds_cptr kp0=shm3+LDS_K+hi*1024+r32*16; const lds_cptr vp0=shm3+LDS_V+((lane>>4)&1)*32+(lane&3)*8+(4*hi+((lane&15)>>2))*64;
  const int NT=SEQ/KVBLK;
  DMA_K(0,0);DMA_V(0,0);DMA_K(1,SLOTB);
  bf16x8 qr[4];
  #pragma unroll
  for(int d0=0;d0<4;++d0)qr[d0]=*reinterpret_cast<const bf16x8*>(&Qw[(long)r32*QP+d0*16+hi*8]);
  float mhat=0.f,l_reg=0.f;f32x16 o[2];o[0]=f32x16{};o[1]=f32x16{};f32x16 negm=f32x16{};asm volatile("":"+v"(negm));
  const int qrel=wid*QBLK+r32;
  #define CMASK(P0,P1,t) do{}while(0)
  bool resc=false;
  #define START(P0,P1) do{ const float rm=rowmax(P0,P1); resc=false; \
    { const float dl=rm; mhat=fadd_s(mhat,dl); \
      _Pragma("unroll") for(int r=0;r<16;++r){P0[r]=fsub_s(P0[r],dl);P1[r]=fsub_s(P1[r],dl);} \
      _Pragma("unroll") for(int r=0;r<16;++r)negm[r]=-mhat; asm volatile("":"+v"(negm)); } \
    _Pragma("unroll") for(int r=0;r<16;++r)P0[r]=__builtin_amdgcn_exp2f(P0[r]); }while(0)
  #define RESC() do{ if(resc){ asm volatile("s_waitcnt lgkmcnt(0)":::"memory"); \
      _Pragma("unroll") for(int d_=0;d_<2;++d_) _Pragma("unroll") for(int r=0;r<16;++r)o[d_][r]*=wsf[crow(r,hi)]; } }while(0)
  f32x16 pA0,pA1,pB0,pB1;
  int sl_prev=0,sl_cur=0,sl_next=SLOTB;
  #define ROT() do{sl_prev=sl_cur;sl_cur=sl_next;sl_next=(sl_next==(NSLOT-1)*SLOTB)?0:sl_next+SLOTB;}while(0)
  DMA_K(2,2*SLOTB);
  WAIT_BAR(3);
  qkt(pA0,pA1,Kbase,qr,negm,r32,hi);asm volatile("s_nop 15\n\ts_nop 7":"+v"(pA0),"+v"(pA1));CMASK(pA0,pA1,0);
  START(pA0,pA1);
  _Pragma("unroll") for(int r=0;r<16;++r)pA1[r]=__builtin_amdgcn_exp2f(pA1[r]);
  WAIT_BAR(0);
  DMA_K(3,0);DMA_V(1,SLOTB);
  ROT();
  kload8(kf,kp0+sl_cur);
  WAIT_BAR(2);
  s16x4 vlo[8],vhi[8]; u32x4 pw0,pw1,pw2,pw3;
  #define PKW(P,B) cvtpk_s(P[B],P[B+1])
  #define PAF(k) __builtin_bit_cast(bf16x8,pw##k)
  #define VFR(i) (bf16x8){vlo[i][0],vlo[i][1],vlo[i][2],vlo[i][3],vhi[i][0],vhi[i][1],vhi[i][2],vhi[i][3]}
  #define PIN(x) asm volatile("":"+v"(x))
  #define MX3(a,b,c) __builtin_fmaxf(__builtin_fmaxf((a),(b)),(c))
  #define GAPA(MF,A0,A1,A2,A3,W0,W1,PW) do{ MF; sacc+=A0; sacc+=A1; sacc+=A2; sacc+=A3; PIN(sacc); W0; W1; PIN(PW); SBAR(); }while(0)
  #define EX(v) __builtin_amdgcn_exp2f(v)
  #define GAPB(MF,X,B) do{ MF; X[B]=EX(X[B]); X[B+1]=EX(X[B+1]); X[B+2]=EX(X[B+2]); X[B+3]=EX(X[B+3]); PIN(X); SBAR(); }while(0)
  #define VRD(i) do{ vlo[i]=vtr(vp_+(((i)>>2)*4096+((i)&3)*1024)); vhi[i]=vtr(vp_+(((i)>>2)*4096+((i)&3)*1024+512)); }while(0)
  #define KRD(G,j) do{ if(G){ kload2(kf,kp0+sl_next,j); SBAR(); } }while(0)
  #define STEP(C0,C1,P0,P1,t,GK,GV,GL) do{ SBAR(); \
    const lds_cptr vp_=vp0+sl_prev; \
    VRD(0); SBAR(); float sacc=(P0[0]+P0[1]); \
    GAPA(C0=__builtin_amdgcn_mfma_f32_32x32x16_bf16(kf[0],qr[0],negm,0,0,0), P0[2],P0[3],P0[4],P0[5],     pw0[0]=PKW(P0,0), pw0[1]=PKW(P0,2), pw0); \
    VRD(4); SBAR(); GAPA(C1=__builtin_amdgcn_mfma_f32_32x32x16_bf16(kf[1],qr[0],negm,0,0,0), P0[6],P0[7],P0[8],P0[9],     pw0[2]=PKW(P0,4), pw0[3]=PKW(P0,6), pw0); \
    VRD(1); SBAR(); GAPA(C0=__builtin_amdgcn_mfma_f32_32x32x16_bf16(kf[2],qr[1],C0,0,0,0),   P0[10],P0[11],P0[12],P0[13], pw1[0]=PKW(P0,8), pw1[1]=PKW(P0,10), pw1); \
    VRD(5); SBAR(); GAPA(C1=__builtin_amdgcn_mfma_f32_32x32x16_bf16(kf[3],qr[1],C1,0,0,0),   P0[14],P0[15],P1[0],P1[1],   pw1[2]=PKW(P0,12),pw1[3]=PKW(P0,14), pw1); \
    VRD(2); SBAR(); GAPA(C0=__builtin_amdgcn_mfma_f32_32x32x16_bf16(kf[4],qr[2],C0,0,0,0),   P1[2],P1[3],P1[4],P1[5],     pw2[0]=PKW(P1,0), pw2[1]=PKW(P1,2), pw2); \
    VRD(6); SBAR(); GAPA(C1=__builtin_amdgcn_mfma_f32_32x32x16_bf16(kf[5],qr[2],C1,0,0,0),   P1[6],P1[7],P1[8],P1[9],     pw2[2]=PKW(P1,4), pw2[3]=PKW(P1,6), pw2); \
    VRD(3); SBAR(); GAPA(C0=__builtin_amdgcn_mfma_f32_32x32x16_bf16(kf[6],qr[3],C0,0,0,0),   P1[10],P1[11],P1[12],P1[13], pw3[0]=PKW(P1,8), pw3[1]=PKW(P1,10), pw3); \
    VRD(7); SBAR(); GAPA(C1=__builtin_amdgcn_mfma_f32_32x32x16_bf16(kf[7],qr[3],C1,0,0,0),   P1[14],P1[15],0.f,0.f,       pw3[2]=PKW(P1,12),pw3[3]=PKW(P1,14), pw3); \
    l_reg+=sacc; \
    if(GK){DMA_K((t)+3,sl_cur);} if(GV){DMA_V((t)+1,sl_next);} \
    CMASK(C0,C1,t); \
    { float a=MX3(C0[0],C0[1],C1[0]),b=MX3(C0[2],C0[3],C1[1]); a=MX3(a,C1[2],C1[3]); \
      _Pragma("unroll") for(int r=4;r<16;r+=4){a=MX3(a,C0[r],C0[r+1]);b=MX3(b,C0[r+2],C0[r+3]);a=MX3(a,C1[r],C1[r+1]);b=MX3(b,C1[r+2],C1[r+3]);} \
      float rm=__builtin_fmaxf(a,b); { auto rr=__builtin_amdgcn_permlane32_swap(__float_as_uint(rm),__float_as_uint(rm),false,false); rm=__builtin_fmaxf(__uint_as_float(rr[0]),__uint_as_float(rr[1])); } \
      resc=false; \
      if(__builtin_expect(__any(rm>(float)THRL),0)){ const float dl=__builtin_fmaxf(rm,0.f); mhat+=dl; \
        _Pragma("unroll") for(int r=0;r<16;++r){C0[r]-=dl;C1[r]-=dl;} \
        _Pragma("unroll") for(int r=0;r<16;++r)negm[r]=-mhat; asm volatile("":"+v"(negm)); \
        const float f=__builtin_amdgcn_exp2f(-dl); l_reg*=f; if(hi==0)wsf[r32]=f; resc=true; } } \
    SBAR(); \
    GAPB(o[0]=__builtin_amdgcn_mfma_f32_32x32x16_bf16(PAF(0),VFR(0),o[0],0,0,0), C0,0); \
    GAPB(o[1]=__builtin_amdgcn_mfma_f32_32x32x16_bf16(PAF(0),VFR(4),o[1],0,0,0), C0,4); \
    KRD(GL,0); GAPB(o[0]=__builtin_amdgcn_mfma_f32_32x32x16_bf16(PAF(1),VFR(1),o[0],0,0,0), C0,8); \
    KRD(GL,1); GAPB(o[1]=__builtin_amdgcn_mfma_f32_32x32x16_bf16(PAF(1),VFR(5),o[1],0,0,0), C0,12); \
    KRD(GL,2); GAPB(o[0]=__builtin_amdgcn_mfma_f32_32x32x16_bf16(PAF(2),VFR(2),o[0],0,0,0), C1,0); \
    KRD(GL,3); GAPB(o[1]=__builtin_amdgcn_mfma_f32_32x32x16_bf16(PAF(2),VFR(6),o[1],0,0,0), C1,4); \
    GAPB(o[0]=__builtin_amdgcn_mfma_f32_32x32x16_bf16(PAF(3),VFR(3),o[0],0,0,0), C1,8); \
    GAPB(o[1]=__builtin_amdgcn_mfma_f32_32x32x16_bf16(PAF(3),VFR(7),o[1],0,0,0), C1,12); \
    }while(0)
  int t=1;
  for(;t+5<NT;t+=2){
    STEP(pB0,pB1,pA0,pA1,t,true,true,true);     WAIT_BAR(2); RESC(); ROT();
    STEP(pA0,pA1,pB0,pB1,t+1,true,true,true);   WAIT_BAR(2); RESC(); ROT();
  }
  #define ENDW(tt) do{ if((tt)+3<NT){WAIT_BAR(2);} else if((tt)+2<NT){WAIT_BAR(1);} else {WAIT_BAR(0);} }while(0)
  for(;t+1<NT;t+=2){
    STEP(pB0,pB1,pA0,pA1,t,(t+3<NT),(t+1<NT),(t+1<NT));       ENDW(t);   RESC(); ROT();
    STEP(pA0,pA1,pB0,pB1,t+1,(t+4<NT),(t+2<NT),(t+2<NT));     ENDW(t+1); RESC(); ROT();
  }
  STEP(pB0,pB1,pA0,pA1,NT-1,false,false,false); RESC();
  { float sacc=pB0[0]+pB0[1]; _Pragma("unroll") for(int r=2;r<16;++r)sacc+=pB0[r]; _Pragma("unroll") for(int r=0;r<16;++r)sacc+=pB1[r]; l_reg+=sacc;
    pw0=(u32x4){PKW(pB0,0),PKW(pB0,2),PKW(pB0,4),PKW(pB0,6)};pw1=(u32x4){PKW(pB0,8),PKW(pB0,10),PKW(pB0,12),PKW(pB0,14)};pw2=(u32x4){PKW(pB1,0),PKW(pB1,2),PKW(pB1,4),PKW(pB1,6)};pw3=(u32x4){PKW(pB1,8),PKW(pB1,10),PKW(pB1,12),PKW(pB1,14)};
    SBAR(); pv(o,vb0+sl_cur,PAF(0),PAF(1),PAF(2),PAF(3)); }
  #undef PKW
  #undef PAF
  #undef VFR
  #undef PIN
  #undef MX3
  #undef GAPA
  #undef GAPB
  #undef EX
  #undef VRD
  #undef KRD
  #undef STEP
  #undef ENDW
  {auto rr=__builtin_amdgcn_permlane32_swap(__float_as_uint(l_reg),__float_as_uint(l_reg),false,false);l_reg=__uint_as_float(rr[0])+__uint_as_float(rr[1]);}
  if(hi==0)wsf[32+r32]=l_reg;asm volatile("s_waitcnt lgkmcnt(0)":::"memory");
  float rli[16];
  #pragma unroll
  for(int r=0;r<16;++r)rli[r]=__builtin_amdgcn_rcpf(wsf[32+crow(r,hi)]);
  bf16*Ow=O+(rowbase+q0+wid*QBLK)*OP+512+h*D; float*ATw=ATS+(rowbase+q0+wid*QBLK)*8+h;
  { bf16*stg=(bf16*)(shm+LDS_OST)+wid*2048;
    #pragma unroll
    for(int r=0;r<16;++r){const int orow=crow(r,hi);
      #pragma unroll
      for(int d0=0;d0<2;++d0)stg[orow*64+d0*32+r32]=__float2bfloat16(o[d0][r]*rli[r]);}
    asm volatile("s_waitcnt lgkmcnt(0)":::"memory");
    #pragma unroll
    for(int i=0;i<4;++i){const int row=i*8+(lane>>3),ch=lane&7; const u32x4 v=*(const u32x4*)(stg+row*64+ch*8); ATTN_STORE16(Ow+(long)row*OP+ch*8,v);
      float ss=0.f;
      #pragma unroll
      for(int q=0;q<4;++q){const float lo=__uint_as_float(v[q]<<16),hh=__uint_as_float(v[q]&0xffff0000u);ss+=lo*lo+hh*hh;}
      ss=sum_row8(ss); if(ch==0)ATw[(long)row*8]=ss;} }
  asm volatile("s_waitcnt lgkmcnt(0)\n\ts_barrier":::"memory");
  #undef DMA_K
  #undef DMA_V
  #undef CMASK
  #undef START
  #undef RESC
  #undef ROT
}
constexpr int ATTN_LDS_BYTES=LDS_BYTES;
#undef SBAR
#undef WAIT_BAR
}

__global__ void __launch_bounds__(NTHR, 2) mega(Args args) {
    extern __shared__ __attribute__((aligned(16))) unsigned char lds[];
    Frame F;
    F.lds = (LAS unsigned char*)lds;
    F.wave = __builtin_amdgcn_readfirstlane(threadIdx.x >> 6);
    F.G = gridDim.x; { const int bx = blockIdx.x; F.vcu = (F.G % 8 == 0) ? (bx % 8) * (F.G / 8) + bx / 8 : bx; }
#pragma unroll
    for (int i = 0; i < 22; ++i) F.in[i] = args.in[i];
    F.ws = args.ws; F.xres = args.out;
    volatile LAS unsigned* MISC = (volatile LAS unsigned*)(F.lds + MISC_OFF);
    for (int u = threadIdx.x; u < (LDS_BYTES - LDSCTL_OFF) / 4; u += NTHR) ((LAS unsigned*)(F.lds + LDSCTL_OFF))[u] = 0u;
    __syncthreads();
    const int lo = args.ph_lo, hi = args.ph_hi;
    unsigned* barw = (unsigned*)(F.ws + WS_CTL) + CW_BAR + args.bar_region * XCD_BAR_WORDS;
    XcdBarrier bar; bar.bar = barw; bar.x = 0; bar.st = nullptr;
    if (hi - lo > 1) bar = xcd_barrier_post(barw, MISC + 8);
#ifndef ONLY_K
#define ONLY_K -1
#endif
#define EN(kind) (ONLY_K < 0 || ONLY_K == (kind))
#ifndef ALIGN_A
#define ALIGN_A true
#endif
#ifndef ALIGN_IN
#define ALIGN_IN true
#endif
#ifndef ALIGN_E1
#define ALIGN_E1 true
#endif
#define IN(k) (lo <= (k) && (k) < hi)
#ifndef REPK
#define REPK -1
#endif
#define PROBE_TOP(k) for (int rep_ = 0; rep_ < (REPK == (k) ? 2 : 1); ++rep_) {
#define PROBE_END(k) if (REPK == (k) && rep_ == 0) xcd_barrier(bar); }
#define SEAM(k) do { if (IN(k) && IN((k) + 1)) { xcd_barrier(bar); if (REPK == 200) xcd_barrier(bar); } } while (0)
    const int cid0 = (int)blockIdx.x; const int cid = cid0;
    if (EN(100) && IN(0)) { asm volatile("; PHASE_MARK P0"); PROBE_TOP(100) ph_rows0(F); PROBE_END(100) } SEAM(0);
    if (EN(101) && IN(1)) { asm volatile("; PHASE_MARK P1"); PROBE_TOP(101) ph_convert(F); PROBE_END(101) } SEAM(1);
    if (EN(102) && IN(2)) { asm volatile("; PHASE_MARK P2"); PROBE_TOP(102)
        SchedKV S; S.o.init(NL * 4, 8, F.G, cid); S.MEMN = (const char*)(F.ws + WS_MEMN); S.WKVT = (const char*)(F.ws + WS_WKVT);
        pg8::EpiStore<3> E{(bf16*)(F.ws + WS_KVM), 2 * D, nullptr, 1.0f};
        pg8::gemm_phase<pg8::EpiStore<3>, SchedKV, true, false>(F.lds, F.wave, D, D, D, S, E);
    PROBE_END(102) } SEAM(2);
    if (EN(103) && IN(3)) { asm volatile("; PHASE_MARK P3a");
        SchedQK S; S.o.init(NL * 16, 4, F.G, cid); S.KVM = (const char*)(F.ws + WS_KVM); S.WQB = (const char*)(F.ws + WS_WQB);
        pg8::EpiStore<1, true> E{(bf16*)(F.ws + WS_QKT), D, F.in[11], XQSCALE * Q8S};
        int la = 2 * D, lb = D, kk = 256; asm volatile("" : "+s"(la), "+s"(lb), "+s"(kk));
        pg8::gemm_phase<pg8::EpiStore<1, true>, SchedQK, true, false>(F.lds, F.wave, la, lb, kk, S, E);
    }
    if (EN(104) && IN(3)) { asm volatile("; PHASE_MARK P3b");
        SchedVO S; S.o.init(NL * 64, 1, F.G, cid); S.KVM = (const char*)(F.ws + WS_KVM); S.WOT = (const char*)(F.ws + WS_WOT);
        pg8::EpiStore<2, true> E{(bf16*)(F.ws + WS_VOT), D, nullptr, V8S};
        int la = D, lb = 2 * D, kk = 256; asm volatile("" : "+s"(la), "+s"(lb), "+s"(kk));
        pg8::gemm_phase<pg8::EpiStore<2, true>, SchedVO, true, false>(F.lds, F.wave, la, lb, kk, S, E);
    } SEAM(3);
    for (int l = 0; l < NL; ++l) {
        const int pb = PH_LAYER0 + PH_PER_LAYER * l;
        int cid = cid0; asm volatile("" : "+s"(cid));
        if (EN(0) && IN(pb + 0)) { asm volatile("; PHASE_MARK L0"); PROBE_TOP(0)
            SchedDense S; S.o.init(T / 256, 7, F.G, cid); S.A = (const char*)(F.ws + WS_XR); S.a_tile = 256 * D * 2; S.B = (const char*)(F.ws + WS_WIN) + (size_t)l * INW * D * 2; S.b_tile = 256 * D * 2; S.b_batch = 0; S.bdiv = 1; S.bmod = 1;
            pg8::EpiIn E{(bf16*)(F.ws + WS_UACT), (bf16*)(F.ws + WS_VACT), (bf16*)(F.ws + WS_Q), (bf16*)(F.ws + WS_K), (bf16*)(F.ws + WS_V), (float*)(F.ws + WS_VSTAT),
                         F.in[7] + (size_t)l * 64, F.in[8] + (size_t)l * 64, (const float*)(F.ws + WS_ROPE), (const float*)(F.ws + WS_ROPE) + SEQ * 32, (const float*)(F.ws + WS_RINV)};
            pg8::gemm_phase<pg8::EpiIn, SchedDense, ALIGN_IN, false>(F.lds, F.wave, D, D, D, S, E);
        PROBE_END(0) } SEAM(pb + 0);
        if (EN(1) && IN(pb + 1)) { asm volatile("; PHASE_MARK L1");
            PROBE_TOP(11)
            for (int it = 0; ; ++it) { const int w = it * F.G + F.vcu; if (w >= NB_ * 8 * (SEQ / 256)) break;
                const int i = w >> 8, c = w & 255, x = c >> 5, j = c & 31;
                attn_body::attn_unit<8>(x >> 1, (x & 1) * 4 + i, j, (const attn_body::bf16*)(F.ws + WS_Q), (const attn_body::bf16*)(F.ws + WS_K), (const attn_body::bf16*)(F.ws + WS_V),
                                        (attn_body::bf16*)(F.ws + WS_MERGED), (float*)(F.ws + WS_ATSTAT), (char*)lds, F.wave); }
            PROBE_END(11)
            PROBE_TOP(12) ph_gmlp(F, l); PROBE_END(12) } SEAM(pb + 1);
        if (EN(2) && IN(pb + 2)) { asm volatile("; PHASE_MARK L2"); PROBE_TOP(2)
            SchedDense S; S.o.init(T / 256, 4, F.G, cid); S.A = (const char*)(F.ws + WS_MERGED); S.a_tile = 256 * D * 2; S.B = (const char*)(F.ws + WS_WOUT) + (size_t)l * D * D * 2; S.b_tile = 256 * D * 2; S.b_batch = 0; S.bdiv = 1; S.bmod = 1;
            pg8::EpiX<true, true> E; E.xr = (bf16*)(F.ws + WS_XR); E.xstat = (float*)(F.ws + WS_XSTAT); E.gmstat = (const float*)(F.ws + WS_GMSTAT); E.atstat = (const float*)(F.ws + WS_ATSTAT); E.lds = F.lds; E.xa8 = F.ws + WS_XR8; E.scale = 1.0f;
            pg8::gemm_phase<pg8::EpiX<true, true>, SchedDense, ALIGN_A, false>(F.lds, F.wave, D, D, D, S, E);
        PROBE_END(2) } SEAM(pb + 2);
        if (EN(3) && IN(pb + 3)) { asm volatile("; PHASE_MARK L3"); PROBE_TOP(3)
            SchedDense S; S.o.init(T / 256, 4, F.G, cid); S.A = (const char*)(F.ws + WS_XR8); S.a_tile = 256 * D; S.B = (const char*)(F.ws + WS_QKT) + (size_t)l * NB_ * D * D; S.b_tile = 256 * D; S.b_batch = (size_t)D * D; S.bdiv = SEQ / 256; S.bmod = NB_;
            pg8::EpiS E{(const float*)(F.ws + WS_XSTAT), F.ws + WS_P, F.lds};
            int kq = D / 2; asm volatile("" : "+s"(kq));
            pg8::gemm_phase<pg8::EpiS, SchedDense, true, false, true>(F.lds, F.wave, kq, kq, kq, S, E);
        PROBE_END(3) } SEAM(pb + 3);
        if (EN(4) && IN(pb + 4)) { asm volatile("; PHASE_MARK L4"); PROBE_TOP(4)
            SchedDense S; S.o.init(T / 256, 4, F.G, cid); S.A = (const char*)(F.ws + WS_P); S.a_tile = 256 * D; S.B = (const char*)(F.ws + WS_VOT) + (size_t)l * NB_ * D * D; S.b_tile = 256 * D; S.b_batch = (size_t)D * D; S.bdiv = SEQ / 256; S.bmod = NB_;
            pg8::EpiX<false, false> E; E.xr = (bf16*)(F.ws + WS_XR); E.xstat = nullptr; E.gmstat = nullptr; E.atstat = nullptr; E.lds = F.lds; E.xa8 = nullptr; E.scale = 1.0f / (P8S * V8S);
            int kq = D / 2; asm volatile("" : "+s"(kq));
            pg8::gemm_phase<pg8::EpiX<false, false>, SchedDense, ALIGN_A, false, true>(F.lds, F.wave, kq, kq, kq, S, E);
        PROBE_END(4) } SEAM(pb + 4);
        if (EN(5) && IN(pb + 5)) { asm volatile("; PHASE_MARK L5"); PROBE_TOP(5) ph_router(F, l); PROBE_END(5) } SEAM(pb + 5);
        if (EN(6) && IN(pb + 6)) { asm volatile("; PHASE_MARK L6"); PROBE_TOP(6) ph_topk(F); PROBE_END(6) } SEAM(pb + 6);
        if (EN(7) && IN(pb + 7)) { asm volatile("; PHASE_MARK L7"); PROBE_TOP(7)
            SchedE1 S; S.o.init(NB_ * NE * 4, 8, F.G, cid); S.HBp = (const char*)(F.ws + WS_XR8); S.IDX = (const int*)(F.ws + WS_IDX); S.WGU = (const char*)(F.ws + WS_WGU) + (size_t)l * NE * 2 * FF * D;
            pg8::EpiH E{F.ws + WS_H};
            int kq = D / 2; asm volatile("" : "+s"(kq));
            pg8::gemm_phase<pg8::EpiH, SchedE1, ALIGN_E1, true, true>(F.lds, F.wave, kq, kq, kq, S, E);
        PROBE_END(7) } SEAM(pb + 7);
        if (EN(8) && IN(pb + 8)) { asm volatile("; PHASE_MARK L8"); for (int rep_ = 0; rep_ < ((REPK == 8 || REPK == 81) ? 2 : 1); ++rep_) {
            SchedDense S; S.o.init(NB_ * NE * 4, 4, F.G, cid); S.A = (const char*)(F.ws + WS_H); S.a_tile = 256 * FF; S.B = (const char*)(F.ws + WS_WD) + (size_t)l * NE * D * FF; S.b_tile = 256 * FF; S.b_batch = (size_t)D * FF; S.bdiv = 4; S.bmod = NE;
            pg8::EpiY8 E{F.ws + WS_Y, Y8S / (H8S * W8S)}; E.skip = (REPK == 81 && rep_ == 0);
            int kq = FF / 2; asm volatile("" : "+s"(kq));
            pg8::gemm_phase<pg8::EpiY8, SchedDense, ALIGN_A, false, true>(F.lds, F.wave, kq, kq, kq, S, E);
        if ((REPK == 8 || REPK == 81) && rep_ == 0) xcd_barrier(bar); } } SEAM(pb + 8);
        if (EN(9) && IN(pb + 9)) { asm volatile("; PHASE_MARK L9"); PROBE_TOP(9) ph_combine(F, l, REPK == 9 && rep_ == 0); PROBE_END(9) } SEAM(pb + 9);
    }
#undef IN
#undef SEAM
}

static int g_grid = 0;
static void launch_mega(Args a, int lo, int hi, int region, hipStream_t stream) {
    a.ph_lo = lo; a.ph_hi = hi; a.bar_region = region; a.pad = 0;
    hipLaunchKernelGGL(mega, dim3(g_grid), dim3(NTHR), LDS_BYTES, stream, a);
}
extern "C" void kernel_launch(void* const* d_in, const int* in_sizes, int n_in, void* d_out, int out_size, void* d_ws, size_t ws_size, hipStream_t stream) {
    if (g_grid == 0) {
        if (n_in != 22 || out_size != T * D || ws_size < WS_END) { fprintf(stderr, "kernel_launch: unexpected sizes n_in %d out %d ws %zu\n", n_in, out_size, ws_size); g_grid = -1; return; }
        int dev = 0, cus = 0;
        if (hipGetDevice(&dev) != hipSuccess || hipDeviceGetAttribute(&cus, hipDeviceAttributeMultiprocessorCount, dev) != hipSuccess) { g_grid = -1; return; }
        if (hipFuncSetAttribute((const void*)mega, hipFuncAttributeMaxDynamicSharedMemorySize, LDS_BYTES) != hipSuccess) { g_grid = -1; return; }
        int per_cu = 0;
        if (hipOccupancyMaxActiveBlocksPerMultiprocessor(&per_cu, (const void*)mega, NTHR, LDS_BYTES) != hipSuccess || per_cu < 1) fprintf(stderr, "kernel_launch: occupancy query says %d\n", per_cu);
        (void)hipGetLastError();
        g_grid = cus;
    }
    if (g_grid < 0) return;
    hipMemsetAsync((char*)d_ws + WS_CTL, 0, CTL_ZERO_BYTES, stream);
    Args a{};
    for (int i = 0; i < 22; ++i) a.in[i] = (const float*)d_in[i];
    a.out = (float*)d_out; a.ws = (unsigned char*)d_ws;
    launch_mega(a, 0, PH_END, 0, stream);
}
```

```cpp
#include <hip/hip_runtime.h>
#include <hip/hip_bf16.h>
#include <cstdio>
#include <cstdint>
#include <cmath>

constexpr int NB_ = 4, SEQ = 8192, T = NB_ * SEQ, D = 1024, NL = 4;
constexpr int MEML = 256, NMEM = NB_ * MEML;
constexpr int INW = 1792, GMW = 512, NE = 16, CAP = 1024, FF = 1024;
constexpr float EPS = 1e-6f;
constexpr float LOG2E = 1.4426950408889634f;
constexpr float QSCALE = 0.125f * LOG2E;
constexpr float XQSCALE = 0.0625f * LOG2E;
constexpr float W8S = 256.0f, A8S = 16.0f, H8S = 8.0f, Y8S = 32.0f;
constexpr float Q8S = 512.0f, P8S = 256.0f, V8S = 64.0f;

constexpr size_t MiB = 1u << 20;
constexpr size_t WS_CTL = 0, CTL_ZERO_BYTES = 1 * MiB;
constexpr size_t WS_ROPE = 1 * MiB;
constexpr size_t WS_AFF = 3 * MiB;
constexpr size_t WS_INV = 5 * MiB;
constexpr size_t WS_IDX = 7 * MiB;
constexpr size_t WS_VSTAT = 8 * MiB;
constexpr size_t WS_ATSTAT = 9 * MiB;
constexpr size_t WS_GMSTAT = 10 * MiB;
constexpr size_t WS_RINV = 10 * MiB + 512 * 1024;
constexpr size_t WS_RINV2 = 10 * MiB + 768 * 1024;
constexpr size_t WS_XSTAT = 11 * MiB;
constexpr size_t WS_MEMN = 13 * MiB;
constexpr size_t WS_WSB = 15 * MiB;
constexpr size_t WS_WRH = 15 * MiB + 512 * 1024, WS_WRL = WS_WRH + 128 * 1024;
constexpr size_t WS_WIN = 16 * MiB;
constexpr size_t WS_WOUT = 30 * MiB;
constexpr size_t WS_QKT = 38 * MiB;
constexpr size_t WS_VOT = 70 * MiB;
constexpr size_t WS_WGU = 102 * MiB;
constexpr size_t WS_WD = 358 * MiB;
constexpr size_t WS_XR = 486 * MiB;
constexpr size_t WS_R1 = 550 * MiB;
constexpr size_t WS_UACT = WS_R1, WS_VACT = WS_R1 + 32 * MiB, WS_Q = WS_R1 + 64 * MiB, WS_K = WS_R1 + 96 * MiB, WS_V = WS_R1 + 104 * MiB;
constexpr size_t WS_WQB = WS_R1, WS_WOT = WS_R1 + 8 * MiB, WS_WKVT = WS_R1 + 16 * MiB, WS_KVM = WS_R1 + 32 * MiB;
constexpr size_t WS_H = WS_R1;
constexpr size_t WS_MERGED = 678 * MiB;
constexpr size_t WS_XR8 = 742 * MiB;
constexpr size_t WS_P = WS_MERGED;
constexpr size_t WS_Y = 678 * MiB;
constexpr size_t WS_NSCR = 806 * MiB;
constexpr size_t WS_Q2 = WS_MERGED;
constexpr size_t WS_O2 = WS_NSCR;
constexpr size_t WS_KVN = WS_NSCR + 64 * MiB;
constexpr size_t WS_END = 1024 * MiB;

constexpr int CW_TMO = 0, CW_CODE = 1, CW_BAR = 4096;

#define GAS __attribute__((address_space(1)))
#define LAS __attribute__((address_space(3)))
typedef unsigned short bf16;
typedef unsigned v4u __attribute__((ext_vector_type(4)));
typedef unsigned v2u __attribute__((ext_vector_type(2)));
typedef float f32x4 __attribute__((ext_vector_type(4)));
typedef short bf16x8_t __attribute__((ext_vector_type(8)));
typedef GAS unsigned gu32;
#define RLX_AGENT __ATOMIC_RELAXED, __HIP_MEMORY_SCOPE_AGENT
__device__ __forceinline__ unsigned f2bf(float f) { unsigned u = __builtin_bit_cast(unsigned, f); return (u + 0x7fffu + ((u >> 16) & 1u)) >> 16; }
__device__ __forceinline__ unsigned pk2(float lo, float hi) { return f2bf(lo) | (f2bf(hi) << 16); }
__device__ __forceinline__ float bf2f(unsigned v) { return __builtin_bit_cast(float, v << 16); }
__device__ __forceinline__ float bflo(unsigned w) { return __builtin_bit_cast(float, w << 16); }
__device__ __forceinline__ float bfhi(unsigned w) { return __builtin_bit_cast(float, w & 0xffff0000u); }
__device__ __forceinline__ float rbf(float f) { return bf2f(f2bf(f)); }
__device__ __forceinline__ float clamp8(float v) { return __builtin_amdgcn_fmed3f(v, -448.0f, 448.0f); }
__device__ __forceinline__ unsigned pk4_fp8(float a, float b, float c, float d) { unsigned w = 0u; w = __builtin_amdgcn_cvt_pk_fp8_f32(clamp8(a), clamp8(b), w, false); w = __builtin_amdgcn_cvt_pk_fp8_f32(clamp8(c), clamp8(d), w, true); return w; }
__device__ __forceinline__ float gelu_tanh(float x) {
    const float z = 1.5957691216057308f * (x + 0.044715f * x * x * x);
    return x * __builtin_amdgcn_rcpf(1.0f + __builtin_amdgcn_exp2f(-z * LOG2E));
}
typedef float f32x2_t __attribute__((ext_vector_type(2)));
__device__ __forceinline__ f32x4 gelu4(const f32x4 x) {
    const f32x4 w = (x * x) * (-1.5957691216057308f * 0.044715f * LOG2E) + (-1.5957691216057308f * LOG2E); const f32x4 a = w * x;
    f32x4 d; d[0] = __builtin_amdgcn_exp2f(a[0]); d[1] = __builtin_amdgcn_exp2f(a[1]); d[2] = __builtin_amdgcn_exp2f(a[2]); d[3] = __builtin_amdgcn_exp2f(a[3]);
    d = d + 1.0f;
    f32x4 r; r[0] = __builtin_amdgcn_rcpf(d[0]); r[1] = __builtin_amdgcn_rcpf(d[1]); r[2] = __builtin_amdgcn_rcpf(d[2]); r[3] = __builtin_amdgcn_rcpf(d[3]);
    return x * r;
}
__device__ __forceinline__ f32x4 silu_mul4(const f32x4 g, const f32x4 u, const float sg, const float su) {
    const f32x4 a = g * (-sg * LOG2E);
    f32x4 d; d[0] = __builtin_amdgcn_exp2f(a[0]); d[1] = __builtin_amdgcn_exp2f(a[1]); d[2] = __builtin_amdgcn_exp2f(a[2]); d[3] = __builtin_amdgcn_exp2f(a[3]);
    d = d + 1.0f;
    f32x4 r; r[0] = __builtin_amdgcn_rcpf(d[0]); r[1] = __builtin_amdgcn_rcpf(d[1]); r[2] = __builtin_amdgcn_rcpf(d[2]); r[3] = __builtin_amdgcn_rcpf(d[3]);
    return (g * r) * (u * (sg * sg * su));
}
__device__ __forceinline__ float silu_f(float a) { return a * __builtin_amdgcn_rcpf(1.0f + __builtin_amdgcn_exp2f(-a * LOG2E)); }
__device__ __forceinline__ int lane_id() { int l; asm volatile("v_mbcnt_lo_u32_b32 %0, -1, 0\n\tv_mbcnt_hi_u32_b32 %0, -1, %0" : "=v"(l)); return l; }
template <int CTRL> __device__ __forceinline__ float dpp_f(float v) { return __builtin_bit_cast(float, __builtin_amdgcn_update_dpp(0, __builtin_bit_cast(int, v), CTRL, 0xf, 0xf, true)); }
__device__ __forceinline__ float sum_row16(float v) { v += dpp_f<0xB1>(v); v += dpp_f<0x4E>(v); v += dpp_f<0x141>(v); v += dpp_f<0x140>(v); return v; }
__device__ __forceinline__ float max_row16(float v) { v = fmaxf(v, dpp_f<0xB1>(v)); v = fmaxf(v, dpp_f<0x4E>(v)); v = fmaxf(v, dpp_f<0x141>(v)); v = fmaxf(v, dpp_f<0x140>(v)); return v; }
__device__ __forceinline__ float sum_row8(float v) { v += dpp_f<0xB1>(v); v += dpp_f<0x4E>(v); v += dpp_f<0x141>(v); return v; }
__device__ __forceinline__ float swz16(float v) { return __builtin_bit_cast(float, __builtin_amdgcn_ds_swizzle(__builtin_bit_cast(int, v), 0x401f)); }
__device__ __forceinline__ float add_x16(float v) { return v + swz16(v); }
__device__ __forceinline__ float add_x32(float v) { const unsigned a = __builtin_bit_cast(unsigned, v); const auto r = __builtin_amdgcn_permlane32_swap(a, a, false, false); const unsigned r0 = r[0], r1 = r[1]; return __builtin_bit_cast(float, r0) + __builtin_bit_cast(float, r1); }
__device__ __forceinline__ float max_x16(float v) { return fmaxf(v, swz16(v)); }
__device__ __forceinline__ float max_x32(float v) { const unsigned a = __builtin_bit_cast(unsigned, v); const auto r = __builtin_amdgcn_permlane32_swap(a, a, false, false); const unsigned r0 = r[0], r1 = r[1]; return fmaxf(__builtin_bit_cast(float, r0), __builtin_bit_cast(float, r1)); }
__device__ __forceinline__ float wave_sum(float v) { return add_x32(add_x16(sum_row16(v))); }

#define XB_TMO      128
#define XB_XCNT(j)  (256  + 64 * (j))
#define XB_XSUB(j)  (1280 + 64 * (j))
#define XB_XGEN(j)  (2304 + 64 * (j))
#define XB_TOP      3328
#define XB_TOPGEN   3392
#define XCD_BAR_WORDS 3456
#define XB_SPIN_CAP (1u << 18)
__device__ __forceinline__ unsigned xb_ld(unsigned* p)              { return __hip_atomic_load(p, __ATOMIC_RELAXED, __HIP_MEMORY_SCOPE_AGENT); }
__device__ __forceinline__ unsigned xb_add(unsigned* p, unsigned v) { return __hip_atomic_fetch_add(p, v, __ATOMIC_RELAXED, __HIP_MEMORY_SCOPE_AGENT); }
__device__ __forceinline__ unsigned xb_xcc_id() { return (unsigned)__builtin_amdgcn_s_getreg((3 << 11) | 20) & 0xFu; }
#define XB_SPIN(cond, bar) do { unsigned _sp = 0; while (cond) { __builtin_amdgcn_s_sleep(1); \
    if ((++_sp & 255u) == 0u) { if (xb_ld(&(bar)[XB_TMO])) break; if (_sp > XB_SPIN_CAP) { atomicAdd(&(bar)[XB_TMO], 1u); break; } } } } while (0)
struct XcdBarrier { unsigned* bar; unsigned x; volatile LAS unsigned* st; };
__device__ __forceinline__ XcdBarrier xcd_barrier_post(unsigned* bar, volatile LAS unsigned* st) {
    XcdBarrier b; b.bar = bar; b.x = xb_xcc_id(); b.st = st;
    if (threadIdx.x == 0) (void)xb_add(&bar[XB_XCNT(b.x)], 1u);
    return b;
}
__device__ __forceinline__ void xcd_barrier_complete(unsigned* bar, unsigned x, unsigned& nloc, unsigned& nx) {
    const unsigned G = gridDim.x * gridDim.y * gridDim.z;
    unsigned sum, cnt, mine, sp = 0u;
    for (;;) {
        sum = 0u; cnt = 0u; mine = 0u;
#pragma unroll
        for (unsigned j = 0; j < 16; ++j) { const unsigned c = xb_ld(&bar[XB_XCNT(j)]); sum += c; cnt += (c > 0u) ? 1u : 0u; mine = (j == x) ? c : mine; }
        if (sum == G) break;
        __builtin_amdgcn_s_sleep(1);
        if ((++sp & 255u) == 0u) { if (xb_ld(&bar[XB_TMO])) break; if (sp > XB_SPIN_CAP) { atomicAdd(&bar[XB_TMO], 1u); break; } }
    }
    nloc = mine > 0u ? mine : 1u; nx = cnt > 0u ? cnt : 1u;
}
__device__ __forceinline__ void xcd_barrier(const XcdBarrier& b) {
    asm volatile("s_waitcnt vmcnt(0)" ::: "memory");
    __syncthreads();
    if (threadIdx.x == 0) {
        unsigned* bar = b.bar;
        __builtin_amdgcn_s_waitcnt(0);
        unsigned nloc = b.st[0], nx = b.st[1];
        if (nloc == 0u) { xcd_barrier_complete(bar, b.x, nloc, nx); b.st[0] = nloc; b.st[1] = nx; }
        const unsigned old = xb_add(&bar[XB_XSUB(b.x)], 1u);
        const unsigned gen = old / nloc;
        if (old + 1u == (gen + 1u) * nloc) {
            __builtin_amdgcn_fence(__ATOMIC_RELEASE, "agent");
            asm volatile("s_waitcnt vmcnt(0)" ::: "memory");
            const unsigned og = xb_add(&bar[XB_TOP], 1u);
            const unsigned tg = og / nx;
            if (og + 1u == (tg + 1u) * nx) xb_add(&bar[XB_TOPGEN], 1u);
            else XB_SPIN(xb_ld(&bar[XB_TOPGEN]) == tg, bar);
            __builtin_amdgcn_fence(__ATOMIC_ACQUIRE, "agent");
            xb_add(&bar[XB_XGEN(b.x)], 1u);
            asm volatile("s_waitcnt vmcnt(0)" ::: "memory");
        } else {
            XB_SPIN(xb_ld(&bar[XB_XGEN(b.x)]) == gen, bar);
            __builtin_amdgcn_fence(__ATOMIC_ACQUIRE, "agent");
            asm volatile("s_waitcnt vmcnt(0)" ::: "memory");
        }
    }
    __syncthreads();
}

struct Args { const float* in[22]; float* out; unsigned char* ws; int ph_lo, ph_hi, bar_region, pad; };
constexpr int PH_LAYER0 = 4, PH_PER_LAYER = 10, PH_END = PH_LAYER0 + NL * PH_PER_LAYER;

constexpr int NWAVES = 8, NTHR = NWAVES * 64;
constexpr int RING_BYTES = 131072, LDSCTL_OFF = RING_BYTES, MISC_OFF = LDSCTL_OFF + 320;
constexpr int LDS_BYTES = 147456;

struct Frame {
    LAS unsigned char* lds;
    int wave, vcu, G;
    const float* in[22];
    unsigned char* ws;
    float* xres;
};

__device__ __forceinline__ void ph_rows0(Frame& F) {
    int lane_ = lane_id(); asm volatile("" : "+v"(lane_)); const int tid_ = F.wave * 64 + lane_;
    const int gw = F.vcu * NWAVES + F.wave, NGW = F.G * NWAVES;
    const float* x = F.in[0]; const float* mem = F.in[1]; const float* mg = F.in[12];
    bf16* XR = (bf16*)(F.ws + WS_XR); bf16* MEMN = (bf16*)(F.ws + WS_MEMN); float* RINV = (float*)(F.ws + WS_RINV);
    for (int m = gw; m < T + NMEM; m += NGW) {
        const bool is_mem = m >= T;
        const float* src = is_mem ? mem + (size_t)(m - T) * D : x + (size_t)m * D;
        bf16* dst = is_mem ? MEMN + (size_t)(m - T) * D : XR + (size_t)m * D;
        f32x4 v[4]; float s = 0.f;
#pragma unroll
        for (int j = 0; j < 4; ++j) { v[j] = *(const f32x4*)(src + 4 * lane_ + 256 * j); s += (v[j].x * v[j].x + v[j].y * v[j].y) + (v[j].z * v[j].z + v[j].w * v[j].w); }
        const float rinv = __builtin_amdgcn_rsqf(wave_sum(s) * (1.0f / D) + EPS);
        if (!is_mem && lane_ == 0) RINV[m] = rinv;
        const float sc = is_mem ? rinv : 1.0f;
#pragma unroll
        for (int j = 0; j < 4; ++j) {
            f32x4 g = (f32x4){1.f, 1.f, 1.f, 1.f};
            if (is_mem) g = *(const f32x4*)(mg + 4 * lane_ + 256 * j);
            v2u o; o.x = pk2(v[j].x * sc * g.x, v[j].y * sc * g.y); o.y = pk2(v[j].z * sc * g.z, v[j].w * sc * g.w);
            *(v2u*)(dst + 4 * lane_ + 256 * j) = o;
        }
    }
#if defined(SELFTEST_F8)
    if (F.vcu == 0 && F.wave == 0) {
        typedef int v8i_t __attribute__((ext_vector_type(8)));
        const int fr = lane_ & 15; const unsigned codes[4] = {0x38383838u, 0x3A3A3A3Au, 0x3C3C3C3Cu, 0x40404040u}; const float vals[4] = {1.0f, 1.25f, 1.5f, 2.0f};
        unsigned bc = codes[0]; float bv = vals[0];
#pragma unroll
        for (int q = 1; q < 4; ++q) if ((fr & 3) == q) { bc = codes[q]; bv = vals[q]; }
        v8i_t A, B;
#pragma unroll
        for (int q = 0; q < 8; ++q) { A[q] = 0x38383838; B[q] = (int)bc; }
        f32x4 acc = (f32x4){0.f, 0.f, 0.f, 0.f}; unsigned sc = 0x7f7f7f7fu; asm volatile("" : "+v"(sc), "+v"(A), "+v"(B), "+v"(acc));
        asm volatile("s_nop 7\n\tv_mfma_scale_f32_16x16x128_f8f6f4 %0, %1, %2, %0, %3, %3 op_sel_hi:[0,0,0]\n\ts_nop 15\n\ts_nop 15\n\ts_nop 15\n\ts_nop 15\n\ts_nop 15\n\ts_nop 15" : "+v"(acc) : "v"(A), "v"(B), "v"(sc));
        bool bad = false;
#pragma unroll
        for (int e = 0; e < 4; ++e) bad |= (acc[e] != 128.0f * bv);
        const unsigned w = pk4_fp8(1.25f, 448.0f, 1000.0f, -2.0f); bad |= (w != 0xC07E7E3Au);
        {   const float v = (float)((lane_ * 37 + 11) % 101);
            float r16 = v; r16 += __shfl_xor(r16, 1); r16 += __shfl_xor(r16, 2); r16 += __shfl_xor(r16, 4); r16 += __shfl_xor(r16, 8);
            float m16 = v; m16 = fmaxf(m16, __shfl_xor(m16, 1)); m16 = fmaxf(m16, __shfl_xor(m16, 2)); m16 = fmaxf(m16, __shfl_xor(m16, 4)); m16 = fmaxf(m16, __shfl_xor(m16, 8));
            float r8 = v; r8 += __shfl_xor(r8, 1); r8 += __shfl_xor(r8, 2); r8 += __shfl_xor(r8, 4);
            float r64 = r16; r64 += __shfl_xor(r64, 16); r64 += __shfl_xor(r64, 32);
            if (SELFTEST_F8 & 1) bad |= (sum_row16(v) != r16) | (max_row16(v) != m16) | (sum_row8(v) != r8);
            if (SELFTEST_F8 & 2) bad |= (wave_sum(v) != r64);
            if (SELFTEST_F8 & 4) bad |= (add_x16(v) != v + __shfl_xor(v, 16)) | (max_x16(v) != fmaxf(v, __shfl_xor(v, 16)));
            if (SELFTEST_F8 & 8) bad |= (add_x32(v) != v + __shfl_xor(v, 32)) | (max_x32(v) != fmaxf(v, __shfl_xor(v, 32)));
            if (SELFTEST_F8 & 16) bad |= (lane_ != (int)(threadIdx.x & 63));
            const int iv = lane_ * 3 + 1; if (SELFTEST_F8 & 32) bad |= (__builtin_amdgcn_readlane(iv, 5) != 16) | false; { const int bp = __builtin_amdgcn_ds_bpermute((lane_ - 1) << 2, iv); if (SELFTEST_F8 & 32) bad |= (lane_ > 0 && bp != iv - 3); }
            const float xq = 0.37f + (float)lane_; const float rq = __builtin_amdgcn_rsqf(xq), rr = 1.0f / sqrtf(xq); if (SELFTEST_F8 & 64) bad |= (fabsf(rq - rr) > 1e-5f * rr); }
        if (bad) __hip_atomic_store((unsigned*)(F.ws + WS_CTL) + CW_TMO, 1u, __ATOMIC_RELAXED, __HIP_MEMORY_SCOPE_AGENT);
    }
#endif
    float* COS = (float*)(F.ws + WS_ROPE); float* SIN = COS + SEQ * 32;
    const int gt = F.vcu * NTHR + tid_, NGT = F.G * NTHR;
    for (int i = gt; i < SEQ * 32; i += NGT) {
        const int t = i >> 5, p = i & 31;
        const float fr = expf(-9.210340371976184f * (float)(p & 15) * (1.0f / 16.0f));
        const float pos = (float)((p < 16) ? (t >> 6) : (t & 63));
        float rev = pos * fr * 0.15915494309189535f; rev -= floorf(rev);
        COS[i] = __builtin_amdgcn_cosf(rev); SIN[i] = __builtin_amdgcn_sinf(rev);
    }
}

__device__ __forceinline__ void ph_gmlp(Frame& F, int l) {
    int lane_ = lane_id(); asm volatile("" : "+v"(lane_)); const int tid_ = F.wave * 64 + lane_;
    const bf16* UACT = (const bf16*)(F.ws + WS_UACT); const bf16* VACT = (const bf16*)(F.ws + WS_VACT);
    const float* VSTAT = (const float*)(F.ws + WS_VSTAT); float* GMSTAT = (float*)(F.ws + WS_GMSTAT);
    bf16* MERGED = (bf16*)(F.ws + WS_MERGED);
    const float* gvn = F.in[4] + (size_t)l * GMW; const float* bs = F.in[6] + (size_t)l * 4 * 128;
    const bf16* WSB = (const bf16*)(F.ws + WS_WSB) + (size_t)l * 4 * 128 * 128;
    LAS bf16* vT = (LAS bf16*)F.lds;
    const int fr = lane_ & 15, fq = lane_ >> 4, w = F.wave;
    for (int u = F.vcu; u < (T / 128) * 4; u += F.G) {
        const int n = u >> 2, g = u & 3; const int row0 = n * 128;
        __syncthreads();
        {   const int j = tid_ & 127, cs = tid_ >> 7; const size_t row = (size_t)row0 + j;
            const f32x4 s0 = *(const f32x4*)(VSTAT + row * 8), s1 = *(const f32x4*)(VSTAT + row * 8 + 4);
            const float rinv = __builtin_amdgcn_rsqf((((s0[0] + s0[1]) + (s0[2] + s0[3])) + ((s1[0] + s1[1]) + (s1[2] + s1[3]))) * (1.0f / GMW) + EPS);
#pragma unroll
            for (int q = 0; q < 4; ++q) { const int c8 = (cs * 4 + q) * 8;
                const v4u raw = *(const v4u*)(VACT + row * GMW + g * 128 + c8);
                const f32x4 g0 = *(const f32x4*)(gvn + g * 128 + c8) * rinv, g1 = *(const f32x4*)(gvn + g * 128 + c8 + 4) * rinv;
                LAS bf16* d = vT + c8 * 136 + j;
                d[0 * 136] = (bf16)f2bf(bflo(raw.x) * g0[0]); d[1 * 136] = (bf16)f2bf(bfhi(raw.x) * g0[1]); d[2 * 136] = (bf16)f2bf(bflo(raw.y) * g0[2]); d[3 * 136] = (bf16)f2bf(bfhi(raw.y) * g0[3]);
                d[4 * 136] = (bf16)f2bf(bflo(raw.z) * g1[0]); d[5 * 136] = (bf16)f2bf(bfhi(raw.z) * g1[1]); d[6 * 136] = (bf16)f2bf(bflo(raw.w) * g1[2]); d[7 * 136] = (bf16)f2bf(bfhi(raw.w) * g1[3]); } }
        bf16x8_t bw[4];
#pragma unroll
        for (int ks = 0; ks < 4; ++ks) bw[ks] = *(const bf16x8_t*)(WSB + ((size_t)(g * 128 + 16 * w + fr)) * 128 + 32 * ks + 8 * fq);
        __syncthreads();
        f32x4 acc[8];
#pragma unroll
        for (int cb = 0; cb < 8; ++cb) { acc[cb] = (f32x4){0.f, 0.f, 0.f, 0.f};
#pragma unroll
            for (int ks = 0; ks < 4; ++ks) { const bf16x8_t a = *(const LAS bf16x8_t*)(vT + (16 * cb + fr) * 136 + 32 * ks + 8 * fq);
                acc[cb] = __builtin_amdgcn_mfma_f32_16x16x32_bf16(a, bw[ks], acc[cb], 0, 0, 0); } }
        const size_t row = (size_t)row0 + 16 * w + fr; const float bias = bs[g * 128 + 16 * w + fr]; float ss = 0.f;
#pragma unroll
        for (int cb = 0; cb < 8; ++cb) { const v2u uu = *(const v2u*)(UACT + row * GMW + g * 128 + 16 * cb + 4 * fq);
            v2u o; o.x = pk2(bflo(uu.x) * (acc[cb][0] + bias), bfhi(uu.x) * (acc[cb][1] + bias)); o.y = pk2(bflo(uu.y) * (acc[cb][2] + bias), bfhi(uu.y) * (acc[cb][3] + bias));
            *(v2u*)(MERGED + row * 1024 + g * 128 + 16 * cb + 4 * fq) = o;
            const float a0 = bflo(o.x), a1 = bfhi(o.x), a2 = bflo(o.y), a3 = bfhi(o.y); ss += (a0 * a0 + a1 * a1) + (a2 * a2 + a3 * a3); }
        ss = add_x32(add_x16(ss));
        if (fq == 0) GMSTAT[row * 4 + g] = ss;
    }
    __syncthreads();
}

__device__ __forceinline__ void ph_router(Frame& F, int l) {
    const int lane_ = lane_id(); const int fr = lane_ & 15, fq = lane_ >> 4;
    const bf16* XR = (const bf16*)(F.ws + WS_XR); float* AFF = (float*)(F.ws + WS_AFF); unsigned char* X8 = F.ws + WS_XR8;
    const bf16* WRH = (const bf16*)(F.ws + WS_WRH) + ((size_t)l * NE + fr) * D + 8 * fq; const bf16* WRL = (const bf16*)(F.ws + WS_WRL) + ((size_t)l * NE + fr) * D + 8 * fq;
    const int gw = F.vcu * NWAVES + F.wave, NGW = F.G * NWAVES;
    for (int blk = gw; blk < T / 16; blk += NGW) {
        const size_t row = (size_t)blk * 16 + fr; const bf16* xp = XR + row * D + 8 * fq;
        f32x4 acc = (f32x4){0.f, 0.f, 0.f, 0.f}; float ss = 0.f;
#pragma unroll 8
        for (int ks = 0; ks < 32; ++ks) { const bf16x8_t xk = *(const bf16x8_t*)(xp + 32 * ks); const bf16x8_t wh = *(const bf16x8_t*)(WRH + 32 * ks), wl = *(const bf16x8_t*)(WRL + 32 * ks);
            acc = __builtin_amdgcn_mfma_f32_16x16x32_bf16(wh, xk, acc, 0, 0, 0); acc = __builtin_amdgcn_mfma_f32_16x16x32_bf16(wl, xk, acc, 0, 0, 0);
            const v4u xb = __builtin_bit_cast(v4u, xk);
            const float a0 = bflo(xb.x), a1 = bfhi(xb.x), a2 = bflo(xb.y), a3 = bfhi(xb.y), a4 = bflo(xb.z), a5 = bfhi(xb.z), a6 = bflo(xb.w), a7 = bfhi(xb.w);
            ss += ((a0 * a0 + a1 * a1) + (a2 * a2 + a3 * a3)) + ((a4 * a4 + a5 * a5) + (a6 * a6 + a7 * a7)); }
        ss = add_x32(add_x16(ss));
        const float rinv = __builtin_amdgcn_rsqf(ss * (1.0f / D) + EPS);
        const f32x4 lg = acc * (rinv * LOG2E);
        float mx = fmaxf(fmaxf(lg[0], lg[1]), fmaxf(lg[2], lg[3])); mx = max_x32(max_x16(mx));
        f32x4 pe; float den = 0.f;
#pragma unroll
        for (int i = 0; i < 4; ++i) { pe[i] = __builtin_amdgcn_exp2f(lg[i] - mx); den += pe[i]; }
        den = add_x32(add_x16(den));
        *(f32x4*)(AFF + row * NE + 4 * fq) = pe * __builtin_amdgcn_rcpf(den);
        const float sc = rinv * A8S;
#pragma unroll 8
        for (int ks = 0; ks < 32; ++ks) { const v4u xb = *(const v4u*)(xp + 32 * ks);
            v2u o; o.x = pk4_fp8(bflo(xb.x) * sc, bfhi(xb.x) * sc, bflo(xb.y) * sc, bfhi(xb.y) * sc); o.y = pk4_fp8(bflo(xb.z) * sc, bfhi(xb.z) * sc, bflo(xb.w) * sc, bfhi(xb.w) * sc);
            *(v2u*)(X8 + row * D + 32 * ks + 8 * fq) = o; }
    }
}

__device__ __forceinline__ void ph_topk(Frame& F) {
    int lane_ = lane_id(); asm volatile("" : "+v"(lane_)); const int tid_ = F.wave * 64 + lane_;
    const float* AFF = (const float*)(F.ws + WS_AFF); int* IDX = (int*)(F.ws + WS_IDX); int* INV = (int*)(F.ws + WS_INV);
    LAS unsigned* hist = (LAS unsigned*)F.lds;
    LAS unsigned* sh = hist + 256;
    LAS unsigned* wsum = hist + 512;
    for (int p = F.vcu; p < NB_ * NE; p += F.G) {
        const int b = p >> 4, e = p & 15;
        unsigned key[16];
#pragma unroll
        for (int i = 0; i < 16; ++i) key[i] = __builtin_bit_cast(unsigned, AFF[((size_t)b * SEQ + tid_ * 16 + i) * NE + e]);
        unsigned prefix = 0u, krem = CAP;
#pragma unroll
        for (int pass = 0; pass < 4; ++pass) {
            const int shift = pass == 3 ? 0 : 23 - 8 * pass; const unsigned dmask = pass == 3 ? 127u : 255u;
            const unsigned himask = pass == 0 ? 0u : (pass == 1 ? 0xff800000u : (pass == 2 ? 0xffff8000u : 0xffffff80u));
            __syncthreads();
            if (tid_ < 256) hist[tid_] = 0u;
            __syncthreads();
#pragma unroll
            for (int i = 0; i < 16; ++i) if ((key[i] & himask) == prefix) atomicAdd((unsigned*)&hist[(key[i] >> shift) & dmask], 1u);
            __syncthreads();
            if (F.wave == 0) {
                unsigned c[4]; unsigned t = 0u;
#pragma unroll
                for (int j = 0; j < 4; ++j) { c[j] = hist[255 - 4 * lane_ - j]; t += c[j]; }
                unsigned inc = t;
#pragma unroll
                for (int o = 1; o < 64; o <<= 1) { const unsigned a = (unsigned)__builtin_amdgcn_ds_bpermute((lane_ - o) << 2, (int)inc); if (lane_ >= o) inc += a; }
                unsigned above = inc - t;
                if (above < krem && krem <= inc) {
                    int d = 255 - 4 * lane_;
#pragma unroll
                    for (int j = 0; j < 3; ++j) { if (above + c[j] < krem) { above += c[j]; d = 254 - 4 * lane_ - j; } else break; }
                    sh[0] = prefix | ((unsigned)d << shift); sh[1] = krem - above; }
            }
            __syncthreads();
            prefix = sh[0]; krem = sh[1];
        }
        const unsigned thr = prefix;
        unsigned cg = 0u, ce = 0u;
#pragma unroll
        for (int i = 0; i < 16; ++i) { cg += key[i] > thr ? 1u : 0u; ce += key[i] == thr ? 1u : 0u; }
        unsigned sg = cg, se = ce;
#pragma unroll
        for (int o = 1; o < 64; o <<= 1) { const unsigned a = (unsigned)__builtin_amdgcn_ds_bpermute((lane_ - o) << 2, (int)sg), c2 = (unsigned)__builtin_amdgcn_ds_bpermute((lane_ - o) << 2, (int)se); if (lane_ >= o) { sg += a; se += c2; } }
        __syncthreads();
        if (lane_ == 63) { wsum[F.wave] = sg; wsum[8 + F.wave] = se; }
        __syncthreads();
        unsigned og = 0u, oe = 0u;
        for (int w = 0; w < F.wave; ++w) { og += wsum[w]; oe += wsum[8 + w]; }
        unsigned gb = og + sg - cg, eb = oe + se - ce;
#pragma unroll
        for (int i = 0; i < 16; ++i) {
            const int t = tid_ * 16 + i; int pos = -1;
            if (key[i] > thr) { pos = (int)(gb + (eb < krem ? eb : krem)); ++gb; }
            else if (key[i] == thr) { if (eb < krem) pos = (int)(gb + eb); ++eb; }
            INV[((size_t)b * SEQ + t) * NE + e] = pos;
            if (pos >= 0) IDX[(size_t)p * CAP + pos] = t;
        }
    }
    __syncthreads();
}

__device__ __forceinline__ void ph_combine(Frame& F, int l, bool dummy) {
    int lane_ = lane_id(); asm volatile("" : "+v"(lane_));
    const float* AFF = (const float*)(F.ws + WS_AFF); const int* INV = (const int*)(F.ws + WS_INV);
    const unsigned char* Y = F.ws + WS_Y; bf16* XR = (bf16*)(F.ws + WS_XR); const float* fg = F.in[21]; float* RINV = (float*)(F.ws + WS_RINV);
    const int gw = F.vcu * NWAVES + F.wave, NGW = F.G * NWAVES;
    v2u nx[4]; int npos = -1; float naff = 0.f;
    if (gw < T) {
#pragma unroll
        for (int j = 0; j < 4; ++j) nx[j] = *(const v2u*)(XR + (size_t)gw * D + 4 * lane_ + 256 * j);
        if (lane_ < NE) { npos = INV[(size_t)gw * NE + lane_]; naff = AFF[(size_t)gw * NE + lane_]; } }
    for (int m = gw; m < T; m += NGW) {
        const int b = m / SEQ;
        bf16* xw = (dummy ? (bf16*)(F.ws + WS_NSCR) : XR) + (size_t)m * D; float* ow = (dummy ? (float*)(F.ws + WS_NSCR) : F.xres) + (size_t)m * D;
        f32x4 v[4];
#pragma unroll
        for (int j = 0; j < 4; ++j) v[j] = (f32x4){bflo(nx[j].x), bfhi(nx[j].x), bflo(nx[j].y), bfhi(nx[j].y)};
        const int mypos = npos; const float myaff = naff;
        {   const int mn = m + NGW; npos = -1; naff = 0.f;
            if (mn < T) {
#pragma unroll
                for (int j = 0; j < 4; ++j) nx[j] = *(const v2u*)(XR + (size_t)mn * D + 4 * lane_ + 256 * j);
                if (lane_ < NE) { npos = INV[(size_t)mn * NE + lane_]; naff = AFF[(size_t)mn * NE + lane_]; } } }
        unsigned mask = (unsigned)__builtin_amdgcn_ballot_w64(mypos >= 0) & 0xffffu;
        while (mask) {
            int ee[4]; int nsel = 0;
#pragma unroll
            for (int q = 0; q < 4; ++q) { ee[q] = 0; if (mask) { ee[q] = __builtin_ctz(mask); mask &= mask - 1u; nsel = q + 1; } }
            int w[4][4]; float as[4];
#pragma unroll
            for (int q = 0; q < 4; ++q) { as[q] = 0.f;
                if (q < nsel) { const int pos = __builtin_amdgcn_readlane(mypos, ee[q]); as[q] = __builtin_bit_cast(float, __builtin_amdgcn_readlane(__builtin_bit_cast(int, myaff), ee[q])) * (1.0f / Y8S);
                    const unsigned char* yr = Y + ((size_t)(b * NE + ee[q]) * CAP + pos) * D;
#pragma unroll
                    for (int j = 0; j < 4; ++j) w[q][j] = *(const int*)(yr + 4 * lane_ + 256 * j); }
                else {
#pragma unroll
                    for (int j = 0; j < 4; ++j) w[q][j] = 0; } }
#pragma unroll
            for (int q = 0; q < 4; ++q)
#pragma unroll
                for (int j = 0; j < 4; ++j) { const auto lo = __builtin_amdgcn_cvt_pk_f32_fp8(w[q][j], false), hi = __builtin_amdgcn_cvt_pk_f32_fp8(w[q][j], true);
                    const float l0 = lo[0], l1 = lo[1], h0 = hi[0], h1 = hi[1];
                    v[j].x += as[q] * l0; v[j].y += as[q] * l1; v[j].z += as[q] * h0; v[j].w += as[q] * h1; }
        }
        float s = 0.f;
#pragma unroll
        for (int j = 0; j < 4; ++j) s += (v[j].x * v[j].x + v[j].y * v[j].y) + (v[j].z * v[j].z + v[j].w * v[j].w);
        const float rinv = __builtin_amdgcn_rsqf(wave_sum(s) * (1.0f / D) + EPS);
        if (l == NL - 1) {
#if defined(SELFTEST_F8)
            if (__hip_atomic_load((unsigned*)(F.ws + WS_CTL) + CW_TMO, __ATOMIC_RELAXED, __HIP_MEMORY_SCOPE_AGENT) != 0u) v[0].x = __builtin_nanf("");
#endif
#pragma unroll
            for (int j = 0; j < 4; ++j) { const f32x4 g = *(const f32x4*)(fg + 4 * lane_ + 256 * j); *(f32x4*)(ow + 4 * lane_ + 256 * j) = (f32x4){v[j].x * rinv * g.x, v[j].y * rinv * g.y, v[j].z * rinv * g.z, v[j].w * rinv * g.w}; }
        } else {
            if (lane_ == 0 && !dummy) RINV[m] = rinv;
#pragma unroll
            for (int j = 0; j < 4; ++j) { v2u o; o.x = pk2(v[j].x, v[j].y); o.y = pk2(v[j].z, v[j].w); *(v2u*)(xw + 4 * lane_ + 256 * j) = o; }
        }
    }
}

namespace pg8 {
typedef short bf16x8 __attribute__((ext_vector_type(8)));
typedef float f32x2 __attribute__((ext_vector_type(2)));
typedef int v4i_t __attribute__((ext_vector_type(4)));
typedef int v8i_t __attribute__((ext_vector_type(8)));
constexpr int BM = 256, BK = 64, HALF = 128, HTB = HALF * BK * 2, STAGE_BYTES = 8 * HTB, NXCD = 8, WGM = 8;
__host__ __device__ __forceinline__ int lds_byte(int r, int c) { const int st = (r >> 4) * 2 + (c >> 5), rr = r & 15, cc = c & 31, ob = rr * 64 + cc * 2; return st * 1024 + (ob ^ (((ob >> 9) & 1) << 5)); }
__host__ __device__ __forceinline__ void stage_rc(int b, int& R, int& C) { const int st = b / 1024, sb = b % 1024, swz = sb ^ (((sb >> 9) & 1) << 5); R = (st >> 1) * 16 + swz / 64; C = (st & 1) * 32 + (swz % 64) / 2; }
__host__ __device__ __forceinline__ int perm32(int rho) { const int n = rho >> 4, i = rho & 15; return 8 * (i >> 2) + 4 * n + (i & 3); }

struct Unit { int pm, pn, z; const char* a; const char* b; const int* gi; int grow; };

struct TileOrder {
    int nM, nN, nwg, G, c;
    __device__ __forceinline__ void init(int nM_, int nN_, int G_, int c_) { nM = nM_; nN = nN_; nwg = nM * nN; G = G_; c = c_; }
    __device__ __forceinline__ bool tile(int i, int& pm, int& pn) const {
        const long L = (long)i * G + c; if (L >= nwg) return false;
        int wgid = (int)L; { const int q = nwg / NXCD, r = nwg % NXCD, xcd = wgid % NXCD, off = wgid / NXCD; wgid = (xcd < r ? xcd * (q + 1) : r * (q + 1) + (xcd - r) * q) + off; }
        const int nig = WGM * nN, gid = wgid / nig, fm = gid * WGM, gsz = (nM - fm) < WGM ? (nM - fm) : WGM;
        pm = fm + ((wgid % nig) % gsz); pn = (wgid % nig) / gsz; return true;
    }
};

__device__ __forceinline__ unsigned cvt_pk_bf16(float lo, float hi) { unsigned r; asm volatile("v_cvt_pk_bf16_f32 %0, %1, %2" : "=v"(r) : "v"(lo), "v"(hi)); return r; }
typedef f32x4 Acc[2][2][4][2];
#ifndef NT_STORE
#define NT_STORE 0
#endif
__device__ __forceinline__ void st16(void* p, const v4u w, bool nostore = false) { if (nostore) return; if (NT_STORE) __builtin_nontemporal_store(w, (v4u*)p); else *(v4u*)p = w; }
#ifndef NT_Y
#define NT_Y 1
#endif

template <class Epi, class Sched, bool ALIGN_EPI, bool GATHER, bool FP8 = false>
__device__ __forceinline__ void gemm_phase(LAS unsigned char* lds, const int wave_idx, const int lda, const int ldb, const int K, const Sched& S, Epi& E) {
    const int lane = lane_id();
    int wid = wave_idx; asm volatile("" : "+s"(wid));
    const int tid = wid * 64 + lane, wr = wid >> 2, wc = wid & 3, fr = lane & 15, fq = lane >> 4;
    const int nt = K / BK;
    unsigned voffA[2], voffB[2];
#pragma unroll
    for (int i = 0; i < 2; ++i) { int R, C; stage_rc(tid * 16 + i * 8192, R, C); const int Rb = (R & ~31) + perm32(R & 31);
        voffA[i] = (unsigned)(R * lda + C) * 2u; voffB[i] = (unsigned)(Rb * ldb + C) * 2u; }
    const size_t kstep = (size_t)(BK * 2);
    const size_t hstepA = (size_t)HALF * lda * 2, hstepB = (size_t)HALF * ldb * 2;
    const unsigned ldsw = (unsigned)wid * 1024u;
    const int aoff = lds_byte(wr * 64 + fr, fq * 8), boff = lds_byte(wc * 32 + fr, fq * 8);
    unsigned vgc[2][2], vgn[2][2];
#define PG8_SA(b, h) (((b) * 2 + (h)) * HTB)
#define PG8_SB(b, h) ((4 + (b) * 2 + (h)) * HTB)
#define PG8_GL(gp, voff, bufoff, _i) __builtin_amdgcn_global_load_lds((const unsigned*)((const char*)(gp) + (voff)), (LAS unsigned*)(lds + (bufoff) + ldsw + (_i) * 8192), 16, 0, 0)
#define PG8_STAGE_B(bufoff, gbase) do { PG8_GL(gbase, voffB[0], bufoff, 0); PG8_GL(gbase, voffB[1], bufoff, 1); } while (0)
#define PG8_STAGE_A(bufoff, gbase, h, VG) do { if constexpr (GATHER) { PG8_GL(gbase, VG[h][0], bufoff, 0); PG8_GL(gbase, VG[h][1], bufoff, 1); } \
        else { PG8_GL((gbase) + (h) * hstepA, voffA[0], bufoff, 0); PG8_GL((gbase) + (h) * hstepA, voffA[1], bufoff, 1); } } while (0)
#define PG8_CAT(x0, x1) __builtin_shufflevector(__builtin_bit_cast(v4i_t, x0), __builtin_bit_cast(v4i_t, x1), 0, 1, 2, 3, 4, 5, 6, 7)
#define PG8_RD(off) (*(const LAS bf16x8*)(lds + (off)))
#define PG8_LDA(dst, b, h) do { if constexpr (FP8) { _Pragma("unroll") for (int m = 0; m < 4; ++m) dst##8[m] = PG8_CAT(PG8_RD(PG8_SA(b, h) + aoff + m * 2048), PG8_RD(PG8_SA(b, h) + aoff + m * 2048 + 1024)); } \
        else { _Pragma("unroll") for (int m = 0; m < 4; ++m) _Pragma("unroll") for (int k = 0; k < 2; ++k) dst[m][k] = PG8_RD(PG8_SA(b, h) + aoff + m * 2048 + k * 1024); } } while (0)
#define PG8_LDB(dst, b, h) do { if constexpr (FP8) { _Pragma("unroll") for (int n = 0; n < 2; ++n) dst##8[n] = PG8_CAT(PG8_RD(PG8_SB(b, h) + boff + n * 2048), PG8_RD(PG8_SB(b, h) + boff + n * 2048 + 1024)); } \
        else { _Pragma("unroll") for (int n = 0; n < 2; ++n) _Pragma("unroll") for (int k = 0; k < 2; ++k) dst[n][k] = PG8_RD(PG8_SB(b, h) + boff + n * 2048 + k * 1024); } } while (0)
#define PG8_MMA(ai, bj, At, Bt) do { __builtin_amdgcn_s_setprio(1); _Pragma("unroll") for (int m = 0; m < 4; ++m) _Pragma("unroll") for (int n = 0; n < 2; ++n) { \
        if constexpr (FP8) asm volatile("v_mfma_scale_f32_16x16x128_f8f6f4 %0, %1, %2, %0, %3, %3 op_sel_hi:[0,0,0]" : "+v"(acc[ai][bj][m][n]) : "v"(Bt##8[n]), "v"(At##8[m]), "v"(sc8)); \
        else { _Pragma("unroll") for (int k = 0; k < 2; ++k) acc[ai][bj][m][n] = __builtin_amdgcn_mfma_f32_16x16x32_bf16(Bt[n][k], At[m][k], acc[ai][bj][m][n], 0, 0, 0); } } __builtin_amdgcn_s_setprio(0); } while (0)
#define PG8_WAIT_V(n) asm volatile("s_waitcnt vmcnt(" #n ")" ::: "memory")
#define PG8_WAIT_L(n) asm volatile("s_waitcnt lgkmcnt(" #n ")" ::: "memory")
#define PG8_BAR __builtin_amdgcn_s_barrier()
#define PG8_SCHED __builtin_amdgcn_sched_barrier(0)
#define PG8_GIDX(VG, U) do { const int _t = wid * 64 + lane_id();   \
        _Pragma("unroll") for (int _i = 0; _i < 2; ++_i) { int _R, _C; stage_rc(_t * 16 + _i * 8192, _R, _C); _Pragma("unroll") for (int _h = 0; _h < 2; ++_h) \
        VG[_h][_i] = (unsigned)((U).grow + (U).gi[_h * HALF + _R]) * (unsigned)(lda * 2) + (unsigned)_C * 2u; } } while (0)
    Unit cur, nxt; int ui = 0;
    if (!S.next(0, cur)) return;
    Acc acc;
#pragma unroll
    for (int a = 0; a < 2; ++a)
#pragma unroll
        for (int b = 0; b < 2; ++b)
#pragma unroll
            for (int m = 0; m < 4; ++m)
#pragma unroll
                for (int n = 0; n < 2; ++n) acc[a][b][m][n] = (f32x4){0.f, 0.f, 0.f, 0.f};
    bf16x8 At[4][2], B0[2][2], B1[2][2];
    v8i_t At8[4], B08[2], B18[2];
    unsigned sc8 = 0x7f7f7f7fu; asm volatile("" : "+v"(sc8));
    const char* cA = cur.a; const char* cB = cur.b;
    if constexpr (GATHER) { PG8_GIDX(vgc, cur); } else { vgc[0][0] = vgc[0][1] = vgc[1][0] = vgc[1][1] = 0u; }
    E.prep(cur, wr, wc, fr, fq);
    PG8_STAGE_B(PG8_SB(0, 0), cB); PG8_STAGE_B(PG8_SB(0, 1), cB + hstepB); PG8_STAGE_A(PG8_SA(0, 0), cA, 0, vgc); PG8_STAGE_A(PG8_SA(0, 1), cA, 1, vgc);
    if (wr == 1) PG8_BAR;
    PG8_WAIT_V(2); PG8_BAR;
    PG8_STAGE_B(PG8_SB(1, 0), cB + kstep); PG8_STAGE_A(PG8_SA(1, 0), cA + kstep, 0, vgc); PG8_STAGE_B(PG8_SB(1, 1), cB + hstepB + kstep);
    PG8_WAIT_V(6); PG8_BAR;
    for (;;) {
        const bool has_next = S.next(ui + 1, nxt);
        const char* nA = has_next ? nxt.a : cA; const char* nB = has_next ? nxt.b : cB;
        if constexpr (GATHER) { if (has_next) { PG8_GIDX(vgn, nxt); } else {
#pragma unroll
            for (int h = 0; h < 2; ++h) { vgn[h][0] = vgc[h][0]; vgn[h][1] = vgc[h][1]; } } }
        else { vgn[0][0] = vgn[0][1] = vgn[1][0] = vgn[1][1] = 0u; }
        for (int t = 0; t < nt; t += 2) {
            const bool last = (t == nt - 2);
            const char* a1 = cA + (size_t)(t + 1) * kstep;
            const char* a2 = last ? nA : cA + (size_t)(t + 2) * kstep; const char* b2 = last ? nB : cB + (size_t)(t + 2) * kstep;
            const char* a3 = a2 + kstep; const char* b3 = b2 + kstep;
            if constexpr (Epi::MIDK) { if (t == (nt >> 1)) E.midk(acc); }
            PG8_LDB(B0, 0, 0); PG8_LDB(B1, 0, 1); PG8_SCHED; PG8_LDA(At, 0, 0); PG8_STAGE_A(PG8_SA(1, 1), a1, 1, vgc);
            if constexpr (GATHER) { if (last) {
#pragma unroll
                for (int h = 0; h < 2; ++h) { vgc[h][0] = vgn[h][0]; vgc[h][1] = vgn[h][1]; } } }
            PG8_WAIT_V(8); PG8_WAIT_L(0); PG8_BAR; PG8_MMA(0, 0, At, B0); PG8_MMA(0, 1, At, B1); PG8_BAR; PG8_SCHED;
            PG8_LDA(At, 0, 1); PG8_STAGE_B(PG8_SB(0, 0), b2); PG8_STAGE_B(PG8_SB(0, 1), b2 + hstepB); PG8_STAGE_A(PG8_SA(0, 0), a2, 0, vgc);
            PG8_WAIT_V(8); PG8_WAIT_L(0); PG8_BAR; PG8_MMA(1, 0, At, B0); PG8_MMA(1, 1, At, B1); PG8_BAR; PG8_SCHED;
            PG8_LDB(B0, 1, 0); PG8_LDB(B1, 1, 1); PG8_SCHED; PG8_LDA(At, 1, 0); PG8_STAGE_A(PG8_SA(0, 1), a2, 1, vgc);
            PG8_WAIT_V(8); PG8_WAIT_L(0); PG8_BAR; PG8_MMA(0, 0, At, B0); PG8_MMA(0, 1, At, B1); PG8_BAR; PG8_SCHED;
            PG8_LDA(At, 1, 1); PG8_STAGE_B(PG8_SB(1, 0), b3); PG8_STAGE_B(PG8_SB(1, 1), b3 + hstepB); PG8_STAGE_A(PG8_SA(1, 0), a3, 0, vgc);
            PG8_WAIT_V(8); PG8_WAIT_L(0); PG8_BAR; PG8_MMA(1, 0, At, B0); PG8_MMA(1, 1, At, B1); PG8_BAR; PG8_SCHED;
        }
        if constexpr (ALIGN_EPI) { if (wr == 0) PG8_BAR; }
        if constexpr (FP8) asm volatile("s_nop 15\n\ts_nop 15\n\ts_nop 15\n\ts_nop 15" ::: "memory");
        E(acc, cur, wr, wc, fr, fq);
        if (!has_next) break;
#pragma unroll
        for (int a = 0; a < 2; ++a)
#pragma unroll
            for (int b = 0; b < 2; ++b)
#pragma unroll
                for (int m = 0; m < 4; ++m)
#pragma unroll
                    for (int n = 0; n < 2; ++n) acc[a][b][m][n] = (f32x4){0.f, 0.f, 0.f, 0.f};
        cur = nxt; cA = nA; cB = nB; ++ui;
#pragma unroll
        for (int h = 0; h < 2; ++h) { vgc[h][0] = vgn[h][0]; vgc[h][1] = vgn[h][1]; }
        E.prep(cur, wr, wc, fr, fq);
        if constexpr (ALIGN_EPI) { if (wr == 1) PG8_BAR; }
    }
    PG8_WAIT_V(0);
    if constexpr (!ALIGN_EPI) { if (wr == 0) PG8_BAR; }
    PG8_BAR;
#undef PG8_SA
#undef PG8_SB
#undef PG8_GL
#undef PG8_STAGE_A
#undef PG8_STAGE_B
#undef PG8_LDA
#undef PG8_RD
#undef PG8_LDB
#undef PG8_MMA
#undef PG8_CAT
#undef PG8_WAIT_V
#undef PG8_WAIT_L
#undef PG8_SCHED
#undef PG8_GIDX
}

#define EPI_ROWS for (int ai = 0; ai < 2; ++ai) _Pragma("unroll") for (int m = 0; m < 4; ++m)
__device__ __forceinline__ v4u pack8(const f32x4 a, const f32x4 b) { v4u w; w.x = cvt_pk_bf16(a[0], a[1]); w.y = cvt_pk_bf16(a[2], a[3]); w.z = cvt_pk_bf16(b[0], b[1]); w.w = cvt_pk_bf16(b[2], b[3]); return w; }

template <int mode, bool OUT8 = false>
struct EpiStore {
    static constexpr bool MIDK = false;
    bf16* O; int ldc; const float* cs; float scale; bool skip = false;
    __device__ __forceinline__ void prep(const Unit&, int, int, int, int) {}
    __device__ __forceinline__ void midk(Acc&) {}
    __device__ __forceinline__ void operator()(const Acc& acc, const Unit& u, int wr, int wc, int fr, int fq) const {
        asm volatile("" : "+v"(fr), "+v"(fq));
        if (skip) return;
        size_t base; const float* csp = cs;
        if constexpr (mode == 0) base = (size_t)u.pm * 256 * ldc + (size_t)u.pn * 256;
        else if constexpr (mode == 1) { const int lb = u.pm >> 2, h = u.pm & 3; base = (size_t)lb * D * D + (size_t)(h * 256) * D + u.pn * 256; csp = cs + (size_t)(lb >> 2) * D + u.pn * 256; }
        else if constexpr (mode == 2) { const int pml = u.pm & 3, lbh = u.pm >> 2, h = lbh & 3, lb = lbh >> 2; base = (size_t)lb * D * D + (size_t)(pml * 256) * D + h * 256; }
        else { const int l = u.pm >> 2, pml = u.pm & 3; base = (size_t)l * NMEM * 2 * D + (size_t)(pml * 256) * 2 * D + u.pn * 256; }
        const int cb = wc * 32 + 8 * fq;
        f32x4 c0[2], c1[2];
#pragma unroll
        for (int bj = 0; bj < 2; ++bj) { if (csp) { c0[bj] = *(const f32x4*)(csp + bj * HALF + cb) * scale; c1[bj] = *(const f32x4*)(csp + bj * HALF + cb + 4) * scale; } else { c0[bj] = (f32x4){scale, scale, scale, scale}; c1[bj] = c0[bj]; } }
#pragma unroll
        EPI_ROWS { bf16* rowp = O + base + (size_t)(ai * HALF + wr * 64 + m * 16 + fr) * ldc + cb;
            if constexpr (OUT8) { unsigned char* rp8 = (unsigned char*)O + base + (size_t)(ai * HALF + wr * 64 + m * 16 + fr) * ldc + cb;
#pragma unroll
                for (int bj = 0; bj < 2; ++bj) { const f32x4 a = acc[ai][bj][m][0] * c0[bj], b = acc[ai][bj][m][1] * c1[bj]; v2u o; o.x = pk4_fp8(a[0], a[1], a[2], a[3]); o.y = pk4_fp8(b[0], b[1], b[2], b[3]); *(v2u*)(rp8 + bj * HALF) = o; } }
            else
#pragma unroll
            for (int bj = 0; bj < 2; ++bj) { const v4u w_ = pack8(acc[ai][bj][m][0] * c0[bj], acc[ai][bj][m][1] * c1[bj]); if constexpr (mode == 0 && NT_Y) __builtin_nontemporal_store(w_, (v4u*)(rowp + bj * HALF)); else *(v4u*)(rowp + bj * HALF) = w_; } }
    }
};
struct EpiH {
    static constexpr bool MIDK = false;
    unsigned char* H;
    __device__ __forceinline__ void prep(const Unit&, int, int, int, int) {}
    __device__ __forceinline__ void midk(Acc&) {}
    __device__ __forceinline__ void operator()(const Acc& acc, const Unit& u, int wr, int wc, int fr, int fq) const {
        asm volatile("" : "+v"(fr), "+v"(fq));
        const int cb = u.pn * 128 + wc * 32 + 8 * fq; constexpr float us = 1.0f / (W8S * A8S);
#pragma unroll
        EPI_ROWS { const int rl = ai * HALF + wr * 64 + m * 16 + fr; unsigned char* rowp = H + (size_t)(u.pm * 256 + rl) * FF + cb;
            const f32x4 h0 = silu_mul4(acc[ai][0][m][0], acc[ai][1][m][0], us, H8S), h1 = silu_mul4(acc[ai][0][m][1], acc[ai][1][m][1], us, H8S);
            v2u o; o.x = pk4_fp8(h0[0], h0[1], h0[2], h0[3]); o.y = pk4_fp8(h1[0], h1[1], h1[2], h1[3]); *(v2u*)rowp = o; }
    }
};
struct EpiY8 {
    static constexpr bool MIDK = false;
    unsigned char* Y; float scale; bool skip = false;
    __device__ __forceinline__ void prep(const Unit&, int, int, int, int) {}
    __device__ __forceinline__ void midk(Acc&) {}
    __device__ __forceinline__ void operator()(const Acc& acc, const Unit& u, int wr, int wc, int fr, int fq) const {
        if (skip) return;
        asm volatile("" : "+v"(fr), "+v"(fq));
        const int cb = u.pn * 256 + wc * 32 + 8 * fq;
#pragma unroll
        EPI_ROWS { unsigned char* rowp = Y + (size_t)(u.pm * 256 + ai * HALF + wr * 64 + m * 16 + fr) * D + cb;
#pragma unroll
            for (int bj = 0; bj < 2; ++bj) { const f32x4 a = acc[ai][bj][m][0] * scale, b = acc[ai][bj][m][1] * scale;
                v2u o; o.x = pk4_fp8(a[0], a[1], a[2], a[3]); o.y = pk4_fp8(b[0], b[1], b[2], b[3]); __builtin_nontemporal_store(o, (v2u*)(rowp + bj * HALF)); } }
    }
};
template <bool MK, bool WRITE_XB>
struct EpiX {
    static constexpr bool MIDK = MK;
    bf16* xr; float* xstat; const float* gmstat; const float* atstat; LAS unsigned char* lds; unsigned char* xa8; float scale;
    int wr_, wc_, fr_;
    __device__ __forceinline__ void prep(const Unit& u, int wr, int wc, int fr, int fq) {
        wr_ = wr; wc_ = wc; fr_ = fr;
        if constexpr (MK) {
            asm volatile("" : "+v"(fr), "+v"(fq));
            LAS f32x2* X = (LAS f32x2*)(lds + RING_BYTES + 1024) + (wr * 4 + wc) * 128;
#pragma unroll
            EPI_ROWS { const size_t row = (size_t)u.pm * 256 + ai * HALF + wr * 64 + m * 16 + fr;
                const f32x4 g = *(const f32x4*)(gmstat + row * 4), a0 = *(const f32x4*)(atstat + row * 8), a1 = *(const f32x4*)(atstat + row * 8 + 4);
                const float sg = (g[0] + g[1]) + (g[2] + g[3]), sa = ((a0[0] + a0[1]) + (a0[2] + a0[3])) + ((a1[0] + a1[1]) + (a1[2] + a1[3]));
                const float rgm = __builtin_amdgcn_rsqf(sg * (1.0f / 512.0f) + EPS), rat = __builtin_amdgcn_rsqf(sa * (1.0f / 512.0f) + EPS);
                if (fq == 0) X[(ai * 4 + m) * 16 + fr] = (f32x2){rgm / rat, rat}; }
            asm volatile("s_waitcnt lgkmcnt(0)" ::: "memory");
        }
    }
    __device__ __forceinline__ void midk(Acc& acc) {
        int fr = fr_; asm volatile("" : "+v"(fr));
        const LAS f32x2* X = (const LAS f32x2*)(lds + RING_BYTES + 1024) + (wr_ * 4 + wc_) * 128;
#pragma unroll
        EPI_ROWS { const float f = X[(ai * 4 + m) * 16 + fr].x;
#pragma unroll
            for (int bj = 0; bj < 2; ++bj) { acc[ai][bj][m][0] *= f; acc[ai][bj][m][1] *= f; } }
    }
    __device__ __forceinline__ void operator()(const Acc& acc, const Unit& u, int wr, int wc, int fr, int fq) const {
        asm volatile("" : "+v"(fr), "+v"(fq));
        const int cb = u.pn * 256 + wc * 32 + 8 * fq;
#pragma unroll
        EPI_ROWS { const size_t row = (size_t)u.pm * 256 + ai * HALF + wr * 64 + m * 16 + fr; const size_t off = row * D + cb;
            float f = scale; if constexpr (MK) f = ((const LAS f32x2*)(lds + RING_BYTES + 1024) + (wr * 4 + wc) * 128)[(ai * 4 + m) * 16 + fr].y; float ss = 0.f;
#pragma unroll
            for (int bj = 0; bj < 2; ++bj) { const v4u b = *(const v4u*)(xr + off + bj * HALF);
                const f32x4 x0 = (f32x4){bflo(b.x), bfhi(b.x), bflo(b.y), bfhi(b.y)} + acc[ai][bj][m][0] * f, x1 = (f32x4){bflo(b.z), bfhi(b.z), bflo(b.w), bfhi(b.w)} + acc[ai][bj][m][1] * f;
                *(v4u*)(xr + off + bj * HALF) = pack8(x0, x1);
                if constexpr (WRITE_XB) { v2u o8; o8.x = pk4_fp8(x0[0] * A8S, x0[1] * A8S, x0[2] * A8S, x0[3] * A8S); o8.y = pk4_fp8(x1[0] * A8S, x1[1] * A8S, x1[2] * A8S, x1[3] * A8S); *(v2u*)(xa8 + off + bj * HALF) = o8; }
                if constexpr (WRITE_XB) ss += ((x0[0] * x0[0] + x0[1] * x0[1]) + (x0[2] * x0[2] + x0[3] * x0[3])) + ((x1[0] * x1[0] + x1[1] * x1[1]) + (x1[2] * x1[2] + x1[3] * x1[3])); }
            if constexpr (WRITE_XB) { ss = add_x32(add_x16(ss)); if (fq == 0) xstat[row * 16 + u.pn * 4 + wc] = ss; }
            if (m & 1) asm volatile("" ::: "memory"); }
    }
};
constexpr int EXCH_OFF = RING_BYTES + 1024;
struct EpiS {
    static constexpr bool MIDK = false;
    const float* xstat; unsigned char* P; LAS unsigned char* lds;
    __device__ __forceinline__ void prep(const Unit&, int, int, int, int) {}
    __device__ __forceinline__ void midk(Acc&) {}
    __device__ __forceinline__ void operator()(Acc& acc, const Unit& u, int wr, int wc, int fr, int fq) const {
        asm volatile("" : "+v"(fr), "+v"(fq));
        LAS f32x2* X = (LAS f32x2*)(lds + EXCH_OFF);
        float mw[2][4];
#pragma unroll
        EPI_ROWS { const int rl = ai * HALF + wr * 64 + m * 16 + fr; const size_t row = (size_t)u.pm * 256 + rl;
            const f32x4 s0 = *(const f32x4*)(xstat + row * 16), s1 = *(const f32x4*)(xstat + row * 16 + 4), s2 = *(const f32x4*)(xstat + row * 16 + 8), s3 = *(const f32x4*)(xstat + row * 16 + 12);
            const float ssq = (((s0[0] + s0[1]) + (s0[2] + s0[3])) + ((s1[0] + s1[1]) + (s1[2] + s1[3]))) + (((s2[0] + s2[1]) + (s2[2] + s2[3])) + ((s3[0] + s3[1]) + (s3[2] + s3[3])));
            const float rinv = __builtin_amdgcn_rsqf(ssq * (1.0f / D) + EPS) * (1.0f / (A8S * Q8S));
            float mx = -3.0e38f;
#pragma unroll
            for (int bj = 0; bj < 2; ++bj)
#pragma unroll
                for (int n = 0; n < 2; ++n) { acc[ai][bj][m][n] *= rinv; const f32x4 v = acc[ai][bj][m][n]; mx = fmaxf(mx, fmaxf(fmaxf(v[0], v[1]), fmaxf(v[2], v[3]))); }
            mx = max_x32(max_x16(mx));
            float sm = 0.f;
#pragma unroll
            for (int bj = 0; bj < 2; ++bj)
#pragma unroll
                for (int n = 0; n < 2; ++n) { f32x4 v = acc[ai][bj][m][n];
#pragma unroll
                    for (int i = 0; i < 4; ++i) { v[i] = __builtin_amdgcn_exp2f(v[i] - mx); sm += v[i]; }
                    acc[ai][bj][m][n] = v; }
            sm = add_x32(add_x16(sm));
            mw[ai][m] = mx;
            if (fq == 0) X[rl * 4 + wc] = (f32x2){mx, sm};
            if (m & 1) asm volatile("" ::: "memory"); }
        asm volatile("s_waitcnt lgkmcnt(0)\n\ts_barrier" ::: "memory");
        const int cb = u.pn * 256 + wc * 32 + 8 * fq;
#pragma unroll
        EPI_ROWS { const int rl = ai * HALF + wr * 64 + m * 16 + fr; const size_t row = (size_t)u.pm * 256 + rl;
            const f32x2 e0 = X[rl * 4 + 0], e1 = X[rl * 4 + 1], e2 = X[rl * 4 + 2], e3 = X[rl * 4 + 3];
            const float M = fmaxf(fmaxf(e0.x, e1.x), fmaxf(e2.x, e3.x));
            const float den = (e0.y * __builtin_amdgcn_exp2f(e0.x - M) + e1.y * __builtin_amdgcn_exp2f(e1.x - M)) + (e2.y * __builtin_amdgcn_exp2f(e2.x - M) + e3.y * __builtin_amdgcn_exp2f(e3.x - M));
            const float f = __builtin_amdgcn_exp2f(mw[ai][m] - M) * __builtin_amdgcn_rcpf(den) * P8S;
#pragma unroll
            for (int bj = 0; bj < 2; ++bj) { const f32x4 a = acc[ai][bj][m][0] * f, b = acc[ai][bj][m][1] * f; v2u o; o.x = pk4_fp8(a[0], a[1], a[2], a[3]); o.y = pk4_fp8(b[0], b[1], b[2], b[3]); *(v2u*)(P + row * D + cb + bj * HALF) = o; } }
        asm volatile("s_waitcnt lgkmcnt(0)" ::: "memory");
    }
};
struct EpiIn {
    static constexpr bool MIDK = false;
    bf16 *uact, *vact, *q, *k, *v; float* vstat; const float *qg, *kg, *cosT, *sinT, *rinv; bool nostore = false, skip = false;
    __device__ __forceinline__ void prep(const Unit&, int, int, int, int) {}
    __device__ __forceinline__ void midk(Acc&) {}
    __device__ __forceinline__ void operator()(const Acc& acc, const Unit& u, int wr, int wc, int fr, int fq) const {
        asm volatile("" : "+v"(fr), "+v"(fq));
        if (skip) return;
        const int pn = u.pn;
        if (pn < 4) {
            bf16* O = pn < 2 ? uact : vact; const int cb = (pn & 1) * 256 + wc * 32 + 8 * fq;
#pragma unroll
            EPI_ROWS { const size_t row = (size_t)u.pm * 256 + ai * HALF + wr * 64 + m * 16 + fr; float ss = 0.f; const float ri = rinv[row];
#pragma unroll
                for (int bj = 0; bj < 2; ++bj) { const f32x4 g0 = gelu4(acc[ai][bj][m][0] * ri), g1 = gelu4(acc[ai][bj][m][1] * ri);
                    const v4u w = pack8(g0, g1); st16(O + row * GMW + cb + bj * HALF, w, nostore);
                    if (pn >= 2) { const float a0 = bflo(w.x), a1 = bfhi(w.x), a2 = bflo(w.y), a3 = bfhi(w.y), a4 = bflo(w.z), a5 = bfhi(w.z), a6 = bflo(w.w), a7 = bfhi(w.w);
                        ss += ((a0 * a0 + a1 * a1) + (a2 * a2 + a3 * a3)) + ((a4 * a4 + a5 * a5) + (a6 * a6 + a7 * a7)); } }
                if (pn >= 2) { ss = add_x32(add_x16(ss)); if (fq == 0) vstat[row * 8 + (pn - 2) * 4 + wc] = ss; } }
        } else if (pn == 6 && wc >= 2) {
#pragma unroll
            EPI_ROWS { const size_t row = (size_t)u.pm * 256 + ai * HALF + wr * 64 + m * 16 + fr; const float ri = rinv[row];
#pragma unroll
                for (int bj = 0; bj < 2; ++bj) st16(v + row * 128 + (wc - 2) * 64 + bj * 32 + 8 * fq, pack8(acc[ai][bj][m][0] * ri, acc[ai][bj][m][1] * ri), nostore); }
        } else {
            const bool isq = pn < 6; const float* g = isq ? qg : kg; const float sc = isq ? QSCALE : 1.0f;
            bf16* O = isq ? q + ((pn - 4) * 4 + wc) * 64 : k + wc * 64; const int ldo = isq ? 512 : 128;
            f32x4 gv[2][2];
#pragma unroll
            for (int bj = 0; bj < 2; ++bj) { gv[bj][0] = *(const f32x4*)(g + bj * 32 + 8 * fq) * sc; gv[bj][1] = *(const f32x4*)(g + bj * 32 + 8 * fq + 4) * sc; }
#pragma unroll
            EPI_ROWS { const size_t row = (size_t)u.pm * 256 + ai * HALF + wr * 64 + m * 16 + fr; const int t = (int)(row % SEQ); const float ri = this->rinv[row];
                float ss = 0.f;
#pragma unroll
                for (int bj = 0; bj < 2; ++bj)
#pragma unroll
                    for (int n = 0; n < 2; ++n) { const f32x4 x = acc[ai][bj][m][n]; ss += (x[0] * x[0] + x[1] * x[1]) + (x[2] * x[2] + x[3] * x[3]); }
                ss = add_x32(add_x16(ss));
                const float rinv = ri * __builtin_amdgcn_rsqf(ss * (ri * ri) * (1.0f / 64.0f) + EPS);
#pragma unroll
                for (int bj = 0; bj < 2; ++bj) { const f32x4 c = *(const f32x4*)(cosT + t * 32 + bj * 16 + 4 * fq), sn = *(const f32x4*)(sinT + t * 32 + bj * 16 + 4 * fq);
                    const f32x4 x0 = acc[ai][bj][m][0] * gv[bj][0] * rinv, x1 = acc[ai][bj][m][1] * gv[bj][1] * rinv; f32x4 o0, o1;
                    o0[0] = x0[0] * c[0] - x0[1] * sn[0]; o0[1] = x0[0] * sn[0] + x0[1] * c[0]; o0[2] = x0[2] * c[1] - x0[3] * sn[1]; o0[3] = x0[2] * sn[1] + x0[3] * c[1];
                    o1[0] = x1[0] * c[2] - x1[1] * sn[2]; o1[1] = x1[0] * sn[2] + x1[1] * c[2]; o1[2] = x1[2] * c[3] - x1[3] * sn[3]; o1[3] = x1[2] * sn[3] + x1[3] * c[3];
                    st16(O + row * ldo + bj * 32 + 8 * fq, pack8(o0, o1), nostore); }
                if (m & 1) asm volatile("" ::: "memory"); }
        }
    }
};
}


struct CvtJob { const float* W; const float* gain; bf16* WT; int K, N, dst_row0, k0, n0; bool f8; };
__device__ __forceinline__ CvtJob cvt_decode(const Frame& F, int it) {
    constexpr int I_IN = 16 * 56, I_SQ = 512, I_KV = 1024, I_HEAD = I_IN + I_SQ + I_KV + I_SQ, I_LAYER = I_HEAD + NE * 3 * I_SQ;
    CvtJob j; j.f8 = false; const int l = it / I_LAYER; int r = it % I_LAYER;
    if (r < I_IN) { const int kb = r / 56, nb = r % 56, n0 = nb * 32, pn = n0 >> 8; int dr = n0;
        if (pn >= 4) { const int sidx = n0 & 255, w = sidx >> 6, bj = (sidx >> 5) & 1; dr = pn * 256 + 128 * bj + 32 * w; }
        j.W = F.in[3] + (size_t)l * D * INW; j.gain = F.in[2] + (size_t)l * D; j.WT = (bf16*)(F.ws + WS_WIN) + (size_t)l * INW * D; j.K = D; j.N = INW; j.dst_row0 = dr; j.k0 = kb * 64; j.n0 = n0; return j; }
    r -= I_IN;
    if (r < I_SQ) { j.W = F.in[10] + (size_t)l * D * D; j.gain = F.in[9] + (size_t)l * D; j.WT = (bf16*)(F.ws + WS_WOUT) + (size_t)l * D * D; j.K = D; j.N = D; j.dst_row0 = (r % 32) * 32; j.k0 = (r / 32) * 64; j.n0 = (r % 32) * 32; return j; }
    r -= I_SQ;
    if (r < I_KV) { j.W = F.in[14] + (size_t)l * D * 2 * D; j.gain = nullptr; j.WT = (bf16*)(F.ws + WS_WKVT) + (size_t)l * 2 * D * D; j.K = D; j.N = 2 * D; j.dst_row0 = (r % 64) * 32; j.k0 = (r / 64) * 64; j.n0 = (r % 64) * 32; return j; }
    r -= I_KV;
    if (r < I_SQ) { j.W = F.in[15] + (size_t)l * D * D; j.gain = nullptr; j.WT = (bf16*)(F.ws + WS_WOT) + (size_t)l * D * D; j.K = D; j.N = D; j.dst_row0 = (r % 32) * 32; j.k0 = (r / 32) * 64; j.n0 = (r % 32) * 32; return j; }
    r -= I_SQ;
    const int e = r / (3 * I_SQ), rr = r % (3 * I_SQ), which = rr / I_SQ, sub = rr % I_SQ, kb = sub / 32, n0 = (sub % 32) * 32;
    const size_t mo = ((size_t)l * NE + e) * D * FF;
    j.K = D; j.N = FF; j.k0 = kb * 64; j.n0 = n0;
    j.f8 = true;
    if (which == 2) { j.W = F.in[20] + mo; j.gain = nullptr; j.WT = (bf16*)(F.ws + WS_WD + mo); j.dst_row0 = n0; }
    else { j.W = (which == 0 ? F.in[18] : F.in[19]) + mo; j.gain = F.in[16] + (size_t)l * D; j.WT = (bf16*)(F.ws + WS_WGU + 2 * mo); j.dst_row0 = 256 * (n0 >> 7) + 128 * which + (n0 & 127); }
    return j;
}
#define CVT_LOAD(J, R) do { const float* p_ = (J).W + (size_t)((J).k0 + (lane_ >> 5)) * (J).N + (J).n0 + (lane_ & 31); _Pragma("unroll") for (int i_ = 0; i_ < 32; ++i_) R[i_] = p_[(size_t)(2 * i_) * (J).N]; } while (0)
__device__ __forceinline__ void ph_convert(Frame& F) {
    int lane_ = lane_id(); asm volatile("" : "+v"(lane_)); const int tid_ = F.wave * 64 + lane_;
    LAS float* scr = (LAS float*)(F.lds + F.wave * 16384);
    const int gw = F.vcu * NWAVES + F.wave, NGW = F.G * NWAVES;
    constexpr int I_LAYER = 16 * 56 + 512 + 1024 + 512 + NE * 3 * 512, NITEMS = NL * I_LAYER;
    if (gw < NITEMS) {
        int it = gw; CvtJob cur = cvt_decode(F, it); float r[32]; CVT_LOAD(cur, r);
        for (;;) {
            const int nit = it + NGW; const bool hn = nit < NITEMS; CvtJob nx = cur; if (hn) nx = cvt_decode(F, nit);
#pragma unroll
            for (int i = 0; i < 32; ++i) scr[(2 * i + (lane_ >> 5)) * 33 + (lane_ & 31)] = r[i];
            if (hn) CVT_LOAD(nx, r);
            asm volatile("s_waitcnt lgkmcnt(0)" ::: "memory");
            const int c = lane_ & 7;
            f32x4 g0 = (f32x4){1.f, 1.f, 1.f, 1.f}, g1 = g0;
            if (cur.gain) { g0 = *(const f32x4*)(cur.gain + cur.k0 + 8 * c); g1 = *(const f32x4*)(cur.gain + cur.k0 + 8 * c + 4); }
#pragma unroll
            for (int j = 0; j < 4; ++j) { const int n = (lane_ >> 3) + 8 * j; const LAS float* sp = scr + (8 * c) * 33 + n;
                if (cur.f8) { v2u o; o.x = pk4_fp8(sp[0 * 33] * g0[0] * W8S, sp[1 * 33] * g0[1] * W8S, sp[2 * 33] * g0[2] * W8S, sp[3 * 33] * g0[3] * W8S); o.y = pk4_fp8(sp[4 * 33] * g1[0] * W8S, sp[5 * 33] * g1[1] * W8S, sp[6 * 33] * g1[2] * W8S, sp[7 * 33] * g1[3] * W8S);
                    *(v2u*)((unsigned char*)cur.WT + (size_t)(cur.dst_row0 + n) * cur.K + cur.k0 + 8 * c) = o; }
                else { v4u o; o.x = pk2(sp[0 * 33] * g0[0], sp[1 * 33] * g0[1]); o.y = pk2(sp[2 * 33] * g0[2], sp[3 * 33] * g0[3]); o.z = pk2(sp[4 * 33] * g1[0], sp[5 * 33] * g1[1]); o.w = pk2(sp[6 * 33] * g1[2], sp[7 * 33] * g1[3]);
                    *(v4u*)(cur.WT + (size_t)(cur.dst_row0 + n) * cur.K + cur.k0 + 8 * c) = o; } }
            asm volatile("s_waitcnt lgkmcnt(0)" ::: "memory");
            if (!hn) break; cur = nx; it = nit;
        }
    }
    {   const float* wsrc = F.in[5]; bf16* WSBd = (bf16*)(F.ws + WS_WSB);
        for (int i = F.vcu * NTHR + tid_; i < NL * 4 * 128 * 128 / 8; i += F.G * NTHR) { const f32x4 a = *(const f32x4*)(wsrc + (size_t)i * 8), b = *(const f32x4*)(wsrc + (size_t)i * 8 + 4);
            v4u o; o.x = pk2(a.x, a.y); o.y = pk2(a.z, a.w); o.z = pk2(b.x, b.y); o.w = pk2(b.z, b.w); *(v4u*)(WSBd + (size_t)i * 8) = o; } }
    {   bf16* WRH = (bf16*)(F.ws + WS_WRH); bf16* WRL = (bf16*)(F.ws + WS_WRL);
        for (int i = F.vcu * NTHR + tid_; i < NL * NE * D; i += F.G * NTHR) { const int l = i / (NE * D), e = (i / D) % NE, c = i % D;
            const float w = F.in[17][((size_t)l * D + c) * NE + e] * F.in[16][(size_t)l * D + c]; const unsigned h = f2bf(w); WRH[i] = (bf16)h; WRL[i] = (bf16)f2bf(w - bf2f(h)); } }
    const int gt = F.vcu * NTHR + tid_, NGT = F.G * NTHR;
    const float* wq = F.in[13]; bf16* WQB = (bf16*)(F.ws + WS_WQB);
    for (int i = gt; i < NL * D * D / 8; i += NGT) { const f32x4 a = *(const f32x4*)(wq + (size_t)i * 8), b = *(const f32x4*)(wq + (size_t)i * 8 + 4);
        v4u o; o.x = pk2(a.x, a.y); o.y = pk2(a.z, a.w); o.z = pk2(b.x, b.y); o.w = pk2(b.z, b.w); *(v4u*)(WQB + (size_t)i * 8) = o; }
}

struct SchedDense {
    pg8::TileOrder o; const char* A; size_t a_tile; const char* B; size_t b_tile, b_batch; int bdiv, bmod;
    __device__ __forceinline__ bool next(int i, pg8::Unit& u) const { if (!o.tile(i, u.pm, u.pn)) return false;
        u.z = 0; u.gi = nullptr; u.grow = 0; u.a = A + (size_t)u.pm * a_tile; u.b = B + (size_t)((u.pm / bdiv) % bmod) * b_batch + (size_t)u.pn * b_tile; return true; }
};
struct SchedE1 {
    pg8::TileOrder o; const char* HBp; const int* IDX; const char* WGU;
    __device__ __forceinline__ bool next(int i, pg8::Unit& u) const { if (!o.tile(i, u.pm, u.pn)) return false;
        const int z = u.pm >> 2; u.z = z; u.gi = IDX + (size_t)u.pm * 256; u.grow = (z >> 4) * SEQ; u.a = HBp;
        u.b = WGU + (size_t)(z & 15) * (2 * FF * D) + (size_t)u.pn * (256 * D); return true; }
};
struct SchedKV { pg8::TileOrder o; const char* MEMN; const char* WKVT;
    __device__ __forceinline__ bool next(int i, pg8::Unit& u) const { if (!o.tile(i, u.pm, u.pn)) return false; u.z = 0; u.gi = nullptr; u.grow = 0;
        u.a = MEMN + (size_t)(u.pm & 3) * (256 * D * 2); u.b = WKVT + (size_t)(u.pm >> 2) * (2 * D * D * 2) + (size_t)u.pn * (256 * D * 2); return true; } };
struct SchedQK { pg8::TileOrder o; const char* KVM; const char* WQB;
    __device__ __forceinline__ bool next(int i, pg8::Unit& u) const { if (!o.tile(i, u.pm, u.pn)) return false; u.z = 0; u.gi = nullptr; u.grow = 0;
        const int h = u.pm & 3, lb = u.pm >> 2, b = lb & 3, l = lb >> 2;
        u.a = KVM + ((size_t)l * NMEM * 2 * D + (size_t)(b * 256) * 2 * D + h * 256) * 2; u.b = WQB + ((size_t)l * D * D + (size_t)u.pn * 256 * D + h * 256) * 2; return true; } };
struct SchedVO { pg8::TileOrder o; const char* KVM; const char* WOT;
    __device__ __forceinline__ bool next(int i, pg8::Unit& u) const { if (!o.tile(i, u.pm, u.pn)) return false; u.z = 0; u.gi = nullptr; u.grow = 0;
        const int pml = u.pm & 3, lbh = u.pm >> 2, h = lbh & 3, lb = lbh >> 2, b = lb & 3, l = lb >> 2;
        u.a = WOT + ((size_t)l * D * D + (size_t)pml * 256 * D + h * 256) * 2; u.b = KVM + ((size_t)l * NMEM * 2 * D + (size_t)(b * 256) * 2 * D + D + h * 256) * 2; return true; } };

namespace attn_body {
using bf16=__hip_bfloat16;
using bf16x8=__attribute__((ext_vector_type(8)))short;
using s16x4=__attribute__((ext_vector_type(4)))short;
using f32x16=__attribute__((ext_vector_type(16)))float;
using u32x4=__attribute__((ext_vector_type(4)))unsigned;
constexpr int SEQ=8192,D=64,QP=512,KP=128,OP=1024;
constexpr int NW=8,QBLK=32,QB=QBLK*NW,KVBLK=64,NQB=SEQ/QB;
constexpr int ATTN_UNIT_ROWS=QB;
__device__ __forceinline__ int crow(int r,int hi){return (r&3)+8*(r>>2)+4*hi;}
#define SBAR() __builtin_amdgcn_sched_barrier(0)
__device__ __forceinline__ void cmask(f32x16&p0,f32x16&p1,int jb,int qrel,int hi){
  const float NEG=-INFINITY; int kb=64*jb+4*hi;
  #pragma unroll
  for(int r=0;r<16;++r){int kv=kb+(r&3)+8*(r>>2); if(kv>qrel)p0[r]=NEG; if(kv+32>qrel)p1[r]=NEG;}
}

constexpr int NSLOT=3, SLOTB=8192;
constexpr int LDS_K=0, LDS_V=NSLOT*SLOTB, LDS_WS=2*NSLOT*SLOTB, LDS_OST=LDS_WS+NW*64*4, LDS_BYTES=LDS_OST+NW*4096;
constexpr float C2=0.125f*1.4426950408889634f;
__device__ __forceinline__ void glds16(const void*gsrc,unsigned lds_dst){unsigned keep;
  asm volatile("s_mov_b32 %0, m0\n\ts_mov_b32 m0, %2\n\ts_nop 0\n\tglobal_load_lds_dwordx4 %1, off\n\ts_mov_b32 m0, %0":"=&s"(keep):"v"(gsrc),"s"(lds_dst):"memory");}
__device__ __forceinline__ float max3f(float a,float b,float c){float r;asm("v_max3_f32 %0, %1, %2, %3":"=v"(r):"v"(a),"v"(b),"v"(c));return r;}
__device__ __forceinline__ float max2f(float a,float b){float r;asm("v_max_f32_e32 %0, %1, %2":"=v"(r):"v"(a),"v"(b));return r;}
__device__ __forceinline__ float fadd_s(float a,float b){float r;asm("v_add_f32_e32 %0, %1, %2":"=v"(r):"v"(a),"v"(b));return r;}
__device__ __forceinline__ float fsub_s(float a,float b){float r;asm("v_sub_f32_e32 %0, %1, %2":"=v"(r):"v"(a),"v"(b));return r;}
typedef float f32x2_t __attribute__((ext_vector_type(2))); typedef __bf16 bf16x2_t __attribute__((ext_vector_type(2)));
__device__ __forceinline__ unsigned cvtpk_s(float lo,float hi){f32x2_t v={lo,hi};bf16x2_t b=__builtin_convertvector(v,bf16x2_t);return __builtin_bit_cast(unsigned,b);}
#define WAIT_BAR(N) asm volatile("s_waitcnt vmcnt(" #N ") lgkmcnt(0)\n\ts_barrier":::"memory")

__device__ __forceinline__ void qkt(f32x16&p0,f32x16&p1,const char*Kslot,const bf16x8*qr,const f32x16&negm,int r32,int hi){
  const char*kb=Kslot+hi*1024+r32*16;
  #pragma unroll
  for(int d0=0;d0<4;++d0){
    const bf16x8 b0=*reinterpret_cast<const bf16x8*>(kb+d0*2048);
    const bf16x8 b1=*reinterpret_cast<const bf16x8*>(kb+d0*2048+512);
    if(d0==0){p0=__builtin_amdgcn_mfma_f32_32x32x16_bf16(b0,qr[0],negm,0,0,0);p1=__builtin_amdgcn_mfma_f32_32x32x16_bf16(b1,qr[0],negm,0,0,0);}
    else{p0=__builtin_amdgcn_mfma_f32_32x32x16_bf16(b0,qr[d0],p0,0,0,0);p1=__builtin_amdgcn_mfma_f32_32x32x16_bf16(b1,qr[d0],p1,0,0,0);}}
}
typedef __attribute__((address_space(3))) const char* lds_cptr;
typedef short v4i16_t __attribute__((ext_vector_type(4)));
__device__ __forceinline__ void kload8(bf16x8*kf,lds_cptr kp){
  kf[0]=*(const __attribute__((address_space(3))) bf16x8*)(kp);      kf[1]=*(const __attribute__((address_space(3))) bf16x8*)(kp+512);
  kf[2]=*(const __attribute__((address_space(3))) bf16x8*)(kp+2048); kf[3]=*(const __attribute__((address_space(3))) bf16x8*)(kp+2560);
  kf[4]=*(const __attribute__((address_space(3))) bf16x8*)(kp+4096); kf[5]=*(const __attribute__((address_space(3))) bf16x8*)(kp+4608);
  kf[6]=*(const __attribute__((address_space(3))) bf16x8*)(kp+6144); kf[7]=*(const __attribute__((address_space(3))) bf16x8*)(kp+6656);
}
__device__ __forceinline__ void kload2(bf16x8*kf,lds_cptr kp,int j){ kf[2*j]=*(const __attribute__((address_space(3))) bf16x8*)(kp+j*2048); kf[2*j+1]=*(const __attribute__((address_space(3))) bf16x8*)(kp+j*2048+512); }
__device__ __forceinline__ s16x4 vtr(lds_cptr p){ return __builtin_bit_cast(s16x4,__builtin_amdgcn_ds_read_tr16_b64_v4i16((__attribute__((address_space(3))) v4i16_t*)p)); }
__device__ __forceinline__ float rowmax(const f32x16&p0,const f32x16&p1){
  float a=max3f(p0[0],p0[1],p1[0]),b=max3f(p0[2],p0[3],p1[1]);a=max3f(a,p1[2],p1[3]);
  #pragma unroll
  for(int r=4;r<16;r+=4){a=max3f(a,p0[r],p0[r+1]);b=max3f(b,p0[r+2],p0[r+3]);a=max3f(a,p1[r],p1[r+1]);b=max3f(b,p1[r+2],p1[r+3]);}
  const float m=max2f(a,b);
  auto rr=__builtin_amdgcn_permlane32_swap(__float_as_uint(m),__float_as_uint(m),false,false);
  return max2f(__uint_as_float(rr[0]),__uint_as_float(rr[1]));
}
__device__ __forceinline__ void pv(f32x16*o,int vb,bf16x8 pa0,bf16x8 pa1,bf16x8 pa2,bf16x8 pa3){
  #pragma unroll
  for(int d0=0;d0<2;++d0){s16x4 lo[4],hi[4];
    #pragma unroll
    for(int ks=0;ks<4;++ks){
      asm volatile("ds_read_b64_tr_b16 %0,%1 offset:%c2":"=&v"(lo[ks]):"v"(vb),"i"(d0*4096+ks*1024):"memory");
      asm volatile("ds_read_b64_tr_b16 %0,%1 offset:%c2":"=&v"(hi[ks]):"v"(vb),"i"(d0*4096+ks*1024+512):"memory");}
    asm volatile("s_waitcnt lgkmcnt(0)":::"memory");SBAR();
    #define PK(k) (bf16x8){lo[k][0],lo[k][1],lo[k][2],lo[k][3],hi[k][0],hi[k][1],hi[k][2],hi[k][3]}
    o[d0]=__builtin_amdgcn_mfma_f32_32x32x16_bf16(pa0,PK(0),o[d0],0,0,0);
    o[d0]=__builtin_amdgcn_mfma_f32_32x32x16_bf16(pa1,PK(1),o[d0],0,0,0);
    o[d0]=__builtin_amdgcn_mfma_f32_32x32x16_bf16(pa2,PK(2),o[d0],0,0,0);
    o[d0]=__builtin_amdgcn_mfma_f32_32x32x16_bf16(pa3,PK(3),o[d0],0,0,0);
    #undef PK
  }
}

#ifndef ATTN_STORE16
#define ATTN_STORE16(p,v) (*(u32x4*)(p)=(v))
#endif
template<int THRL> __device__ __forceinline__ void attn_unit(int b,int h,int qb,const bf16*Q,const bf16*__restrict__ K,const bf16*__restrict__ V,bf16*O,float*ATS,char*shm,int wave_idx){
  int lane; asm volatile("v_mbcnt_lo_u32_b32 %0, -1, 0\n\tv_mbcnt_hi_u32_b32 %0, -1, %0":"=v"(lane)); const int r32=lane&31,hi=lane>>5; const int wid=wave_idx; const int kvh=h>>2;
  const long rowbase=(long)b*SEQ; const int q0=qb*QB;
  const bf16*Qw=Q+(rowbase+q0+wid*QBLK)*QP+h*D;
  const bf16*Kh=K+rowbase*KP+kvh*D,*Vh=V+rowbase*KP+kvh*D;
  const unsigned lds0=(unsigned)(uintptr_t)shm;
  float*wsf=(float*)(shm+LDS_WS)+wid*64;
  const bf16*ksrc=Kh+(long)lane*KP+wid*8;
  const bf16*vsrc=Vh+(long)(16*(wid&3)+(lane>>2))*KP+(wid>>2)*32+(lane&3)*8;
  const unsigned kdst=lds0+LDS_K+wid*1024, vdst=lds0+LDS_V+wid*1024;
  #define DMA_K(t,slot) glds16(ksrc+(long)(t)*KVBLK*KP,(unsigned)__builtin_amdgcn_readfirstlane(kdst+(slot)))
  #define DMA_V(t,slot) glds16(vsrc+(long)(t)*KVBLK*KP,(unsigned)__builtin_amdgcn_readfirstlane(vdst+(slot)))
  const int vb0=(int)(lds0+LDS_V)+((lane>>4)&1)*32+(lane&3)*8+(4*hi+((lane&15)>>2))*64;
  const char*Kbase=shm+LDS_K; bf16x8 kf[8];
  const lds_cptr shm3=(lds_cptr)shm; const lds_cptr kp0=shm3+LDS_K+hi*1024+r32*16; const lds_cptr vp0=shm3+LDS_V+((lane>>4)&1)*32+(lane&3)*8+(4*hi+((lane&15)>>2))*64;
  const int NT=SEQ/KVBLK;
  DMA_K(0,0);DMA_V(0,0);DMA_K(1,SLOTB);
  bf16x8 qr[4];
  #pragma unroll
  for(int d0=0;d0<4;++d0)qr[d0]=*reinterpret_cast<const bf16x8*>(&Qw[(long)r32*QP+d0*16+hi*8]);
  float mhat=0.f,l_reg=0.f;f32x16 o[2];o[0]=f32x16{};o[1]=f32x16{};f32x16 negm=f32x16{};asm volatile("":"+v"(negm));
  const int qrel=wid*QBLK+r32;
  #define CMASK(P0,P1,t) do{}while(0)
  bool resc=false;
  #define START(P0,P1) do{ const float rm=rowmax(P0,P1); resc=false; \
    { const float dl=rm; mhat=fadd_s(mhat,dl); \
      _Pragma("unroll") for(int r=0;r<16;++r){P0[r]=fsub_s(P0[r],dl);P1[r]=fsub_s(P1[r],dl);} \
      _Pragma("unroll") for(int r=0;r<16;++r)negm[r]=-mhat; asm volatile("":"+v"(negm)); } \
    _Pragma("unroll") for(int r=0;r<16;++r)P0[r]=__builtin_amdgcn_exp2f(P0[r]); }while(0)
  #define RESC() do{ if(resc){ asm volatile("s_waitcnt lgkmcnt(0)":::"memory"); \
      _Pragma("unroll") for(int d_=0;d_<2;++d_) _Pragma("unroll") for(int r=0;r<16;++r)o[d_][r]*=wsf[crow(r,hi)]; } }while(0)
  f32x16 pA0,pA1,pB0,pB1;
  int sl_prev=0,sl_cur=0,sl_next=SLOTB;
  #define ROT() do{sl_prev=sl_cur;sl_cur=sl_next;sl_next=(sl_next==(NSLOT-1)*SLOTB)?0:sl_next+SLOTB;}while(0)
  DMA_K(2,2*SLOTB);
  WAIT_BAR(3);
  qkt(pA0,pA1,Kbase,qr,negm,r32,hi);asm volatile("s_nop 15\n\ts_nop 7":"+v"(pA0),"+v"(pA1));CMASK(pA0,pA1,0);
  START(pA0,pA1);
  _Pragma("unroll") for(int r=0;r<16;++r)pA1[r]=__builtin_amdgcn_exp2f(pA1[r]);
  WAIT_BAR(0);
  DMA_K(3,0);DMA_V(1,SLOTB);
  ROT();
  kload8(kf,kp0+sl_cur);
  WAIT_BAR(2);
  s16x4 vlo[8],vhi[8]; u32x4 pw0,pw1,pw2,pw3;
  #define PKW(P,B) cvtpk_s(P[B],P[B+1])
  #define PAF(k) __builtin_bit_cast(bf16x8,pw##k)
  #define VFR(i) (bf16x8){vlo[i][0],vlo[i][1],vlo[i][2],vlo[i][3],vhi[i][0],vhi[i][1],vhi[i][2],vhi[i][3]}
  #define PIN(x) asm volatile("":"+v"(x))
  #define MX3(a,b,c) __builtin_fmaxf(__builtin_fmaxf((a),(b)),(c))
  #define GAPA(MF,A0,A1,A2,A3,W0,W1,PW) do{ MF; sacc+=A0; sacc+=A1; sacc+=A2; sacc+=A3; PIN(sacc); W0; W1; PIN(PW); SBAR(); }while(0)
  #define EX(v) __builtin_amdgcn_exp2f(v)
  #define GAPB(MF,X,B) do{ MF; X[B]=EX(X[B]); X[B+1]=EX(X[B+1]); X[B+2]=EX(X[B+2]); X[B+3]=EX(X[B+3]); PIN(X); SBAR(); }while(0)
  #define VRD(i) do{ vlo[i]=vtr(vp_+(((i)>>2)*4096+((i)&3)*1024)); vhi[i]=vtr(vp_+(((i)>>2)*4096+((i)&3)*1024+512)); }while(0)
  #define KRD(G,j) do{ if(G){ kload2(kf,kp0+sl_next,j); SBAR(); } }while(0)
  #define STEP(C0,C1,P0,P1,t,GK,GV,GL) do{ SBAR(); \
    const lds_cptr vp_=vp0+sl_prev; \
    VRD(0); SBAR(); float sacc=(P0[0]+P0[1]); \
    GAPA(C0=__builtin_amdgcn_mfma_f32_32x32x16_bf16(kf[0],qr[0],negm,0,0,0), P0[2],P0[3],P0[4],P0[5],     pw0[0]=PKW(P0,0), pw0[1]=PKW(P0,2), pw0); \
    VRD(4); SBAR(); GAPA(C1=__builtin_amdgcn_mfma_f32_32x32x16_bf16(kf[1],qr[0],negm,0,0,0), P0[6],P0[7],P0[8],P0[9],     pw0[2]=PKW(P0,4), pw0[3]=PKW(P0,6), pw0); \
    VRD(1); SBAR(); GAPA(C0=__builtin_amdgcn_mfma_f32_32x32x16_bf16(kf[2],qr[1],C0,0,0,0),   P0[10],P0[11],P0[12],P0[13], pw1[0]=PKW(P0,8), pw1[1]=PKW(P0,10), pw1); \
    VRD(5); SBAR(); GAPA(C1=__builtin_amdgcn_mfma_f32_32x32x16_bf16(kf[3],qr[1],C1,0,0,0),   P0[14],P0[15],P1[0],P1[1],   pw1[2]=PKW(P0,12),pw1[3]=PKW(P0,14), pw1); \
    VRD(2); SBAR(); GAPA(C0=__builtin_amdgcn_mfma_f32_32x32x16_bf16(kf[4],qr[2],C0,0,0,0),   P1[2],P1[3],P1[4],P1[5],     pw2[0]=PKW(P1,0), pw2[1]=PKW(P1,2), pw2); \
    VRD(6); SBAR(); GAPA(C1=__builtin_amdgcn_mfma_f32_32x32x16_bf16(kf[5],qr[2],C1,0,0,0),   P1[6],P1[7],P1[8],P1[9],     pw2[2]=PKW(P1,4), pw2[3]=PKW(P1,6), pw2); \
    VRD(3); SBAR(); GAPA(C0=__builtin_amdgcn_mfma_f32_32x32x16_bf16(kf[6],qr[3],C0,0,0,0),   P1[10],P1[11],P1[12],P1[13], pw3[0]=PKW(P1,8), pw3[1]=PKW(P1,10), pw3); \
    VRD(7); SBAR(); GAPA(C1=__builtin_amdgcn_mfma_f32_32x32x16_bf16(kf[7],qr[3],C1,0,0,0),   P1[14],P1[15],0.f,0.f,       pw3[2]=PKW(P1,12),pw3[3]=PKW(P1,14), pw3); \
    l_reg+=sacc; \
    if(GK){DMA_K((t)+3,sl_cur);} if(GV){DMA_V((t)+1,sl_next);} \
    CMASK(C0,C1,t); \
    { float a=MX3(C0[0],C0[1],C1[0]),b=MX3(C0[2],C0[3],C1[1]); a=MX3(a,C1[2],C1[3]); \
      _Pragma("unroll") for(int r=4;r<16;r+=4){a=MX3(a,C0[r],C0[r+1]);b=MX3(b,C0[r+2],C0[r+3]);a=MX3(a,C1[r],C1[r+1]);b=MX3(b,C1[r+2],C1[r+3]);} \
      float rm=__builtin_fmaxf(a,b); { auto rr=__builtin_amdgcn_permlane32_swap(__float_as_uint(rm),__float_as_uint(rm),false,false); rm=__builtin_fmaxf(__uint_as_float(rr[0]),__uint_as_float(rr[1])); } \
      resc=false; \
      if(__builtin_expect(__any(rm>(float)THRL),0)){ const float dl=__builtin_fmaxf(rm,0.f); mhat+=dl; \
        _Pragma("unroll") for(int r=0;r<16;++r){C0[r]-=dl;C1[r]-=dl;} \
        _Pragma("unroll") for(int r=0;r<16;++r)negm[r]=-mhat; asm volatile("":"+v"(negm)); \
        const float f=__builtin_amdgcn_exp2f(-dl); l_reg*=f; if(hi==0)wsf[r32]=f; resc=true; } } \
    SBAR(); \
    GAPB(o[0]=__builtin_amdgcn_mfma_f32_32x32x16_bf16(PAF(0),VFR(0),o[0],0,0,0), C0,0); \
    GAPB(o[1]=__builtin_amdgcn_mfma_f32_32x32x16_bf16(PAF(0),VFR(4),o[1],0,0,0), C0,4); \
    KRD(GL,0); GAPB(o[0]=__builtin_amdgcn_mfma_f32_32x32x16_bf16(PAF(1),VFR(1),o[0],0,0,0), C0,8); \
    KRD(GL,1); GAPB(o[1]=__builtin_amdgcn_mfma_f32_32x32x16_bf16(PAF(1),VFR(5),o[1],0,0,0), C0,12); \
    KRD(GL,2); GAPB(o[0]=__builtin_amdgcn_mfma_f32_32x32x16_bf16(PAF(2),VFR(2),o[0],0,0,0), C1,0); \
    KRD(GL,3); GAPB(o[1]=__builtin_amdgcn_mfma_f32_32x32x16_bf16(PAF(2),VFR(6),o[1],0,0,0), C1,4); \
    GAPB(o[0]=__builtin_amdgcn_mfma_f32_32x32x16_bf16(PAF(3),VFR(3),o[0],0,0,0), C1,8); \
    GAPB(o[1]=__builtin_amdgcn_mfma_f32_32x32x16_bf16(PAF(3),VFR(7),o[1],0,0,0), C1,12); \
    }while(0)
  int t=1;
  for(;t+5<NT;t+=2){
    STEP(pB0,pB1,pA0,pA1,t,true,true,true);     WAIT_BAR(2); RESC(); ROT();
    STEP(pA0,pA1,pB0,pB1,t+1,true,true,true);   WAIT_BAR(2); RESC(); ROT();
  }
  #define ENDW(tt) do{ if((tt)+3<NT){WAIT_BAR(2);} else if((tt)+2<NT){WAIT_BAR(1);} else {WAIT_BAR(0);} }while(0)
  for(;t+1<NT;t+=2){
    STEP(pB0,pB1,pA0,pA1,t,(t+3<NT),(t+1<NT),(t+1<NT));       ENDW(t);   RESC(); ROT();
    STEP(pA0,pA1,pB0,pB1,t+1,(t+4<NT),(t+2<NT),(t+2<NT));     ENDW(t+1); RESC(); ROT();
  }
  STEP(pB0,pB1,pA0,pA1,NT-1,false,false,false); RESC();
  { float sacc=pB0[0]+pB0[1]; _Pragma("unroll") for(int r=2;r<16;++r)sacc+=pB0[r]; _Pragma("unroll") for(int r=0;r<16;++r)sacc+=pB1[r]; l_reg+=sacc;
    pw0=(u32x4){PKW(pB0,0),PKW(pB0,2),PKW(pB0,4),PKW(pB0,6)};pw1=(u32x4){PKW(pB0,8),PKW(pB0,10),PKW(pB0,12),PKW(pB0,14)};pw2=(u32x4){PKW(pB1,0),PKW(pB1,2),PKW(pB1,4),PKW(pB1,6)};pw3=(u32x4){PKW(pB1,8),PKW(pB1,10),PKW(pB1,12),PKW(pB1,14)};
    SBAR(); pv(o,vb0+sl_cur,PAF(0),PAF(1),PAF(2),PAF(3)); }
  #undef PKW
  #undef PAF
  #undef VFR
  #undef PIN
  #undef MX3
  #undef GAPA
  #undef GAPB
  #undef EX
  #undef VRD
  #undef KRD
  #undef STEP
  #undef ENDW
  {auto rr=__builtin_amdgcn_permlane32_swap(__float_as_uint(l_reg),__float_as_uint(l_reg),false,false);l_reg=__uint_as_float(rr[0])+__uint_as_float(rr[1]);}
  if(hi==0)wsf[32+r32]=l_reg;asm volatile("s_waitcnt lgkmcnt(0)":::"memory");
  float rli[16];
  #pragma unroll
  for(int r=0;r<16;++r)rli[r]=__builtin_amdgcn_rcpf(wsf[32+crow(r,hi)]);
  bf16*Ow=O+(rowbase+q0+wid*QBLK)*OP+512+h*D; float*ATw=ATS+(rowbase+q0+wid*QBLK)*8+h;
  { bf16*stg=(bf16*)(shm+LDS_OST)+wid*2048;
    #pragma unroll
    for(int r=0;r<16;++r){const int orow=crow(r,hi);
      #pragma unroll
      for(int d0=0;d0<2;++d0)stg[orow*64+d0*32+r32]=__float2bfloat16(o[d0][r]*rli[r]);}
    asm volatile("s_waitcnt lgkmcnt(0)":::"memory");
    #pragma unroll
    for(int i=0;i<4;++i){const int row=i*8+(lane>>3),ch=lane&7; const u32x4 v=*(const u32x4*)(stg+row*64+ch*8); ATTN_STORE16(Ow+(long)row*OP+ch*8,v);
      float ss=0.f;
      #pragma unroll
      for(int q=0;q<4;++q){const float lo=__uint_as_float(v[q]<<16),hh=__uint_as_float(v[q]&0xffff0000u);ss+=lo*lo+hh*hh;}
      ss=sum_row8(ss); if(ch==0)ATw[(long)row*8]=ss;} }
  asm volatile("s_waitcnt lgkmcnt(0)\n\ts_barrier":::"memory");
  #undef DMA_K
  #undef DMA_V
  #undef CMASK
  #undef START
  #undef RESC
  #undef ROT
}
constexpr int ATTN_LDS_BYTES=LDS_BYTES;
#undef SBAR
#undef WAIT_BAR
}

__global__ void __launch_bounds__(NTHR, 2) mega(Args args) {
    extern __shared__ __attribute__((aligned(16))) unsigned char lds[];
    Frame F;
    F.lds = (LAS unsigned char*)lds;
    F.wave = __builtin_amdgcn_readfirstlane(threadIdx.x >> 6);
    F.G = gridDim.x; { const int bx = blockIdx.x; F.vcu = (F.G % 8 == 0) ? (bx % 8) * (F.G / 8) + bx / 8 : bx; }
#pragma unroll
    for (int i = 0; i < 22; ++i) F.in[i] = args.in[i];
    F.ws = args.ws; F.xres = args.out;
    volatile LAS unsigned* MISC = (volatile LAS unsigned*)(F.lds + MISC_OFF);
    for (int u = threadIdx.x; u < (LDS_BYTES - LDSCTL_OFF) / 4; u += NTHR) ((LAS unsigned*)(F.lds + LDSCTL_OFF))[u] = 0u;
    __syncthreads();
    const int lo = args.ph_lo, hi = args.ph_hi;
    unsigned* barw = (unsigned*)(F.ws + WS_CTL) + CW_BAR + args.bar_region * XCD_BAR_WORDS;
    XcdBarrier bar; bar.bar = barw; bar.x = 0; bar.st = nullptr;
    if (hi - lo > 1) bar = xcd_barrier_post(barw, MISC + 8);
#ifndef ONLY_K
#define ONLY_K -1
#endif
#define EN(kind) (ONLY_K < 0 || ONLY_K == (kind))
#ifndef ALIGN_A
#define ALIGN_A true
#endif
#ifndef ALIGN_IN
#define ALIGN_IN true
#endif
#ifndef ALIGN_E1
#define ALIGN_E1 true
#endif
#define IN(k) (lo <= (k) && (k) < hi)
#ifndef REPK
#define REPK -1
#endif
#define PROBE_TOP(k) for (int rep_ = 0; rep_ < (REPK == (k) ? 2 : 1); ++rep_) {
#define PROBE_END(k) if (REPK == (k) && rep_ == 0) xcd_barrier(bar); }
#define SEAM(k) do { if (IN(k) && IN((k) + 1)) { xcd_barrier(bar); if (REPK == 200) xcd_barrier(bar); } } while (0)
    const int cid0 = (int)blockIdx.x; const int cid = cid0;
    if (EN(100) && IN(0)) { asm volatile("; PHASE_MARK P0"); PROBE_TOP(100) ph_rows0(F); PROBE_END(100) }
    if (EN(101) && IN(1)) { asm volatile("; PHASE_MARK P1"); PROBE_TOP(101) ph_convert(F); PROBE_END(101) } SEAM(1);
    if (EN(102) && IN(2)) { asm volatile("; PHASE_MARK P2"); PROBE_TOP(102)
        SchedKV S; S.o.init(NL * 4, 8, F.G, cid); S.MEMN = (const char*)(F.ws + WS_MEMN); S.WKVT = (const char*)(F.ws + WS_WKVT);
        pg8::EpiStore<3> E{(bf16*)(F.ws + WS_KVM), 2 * D, nullptr, 1.0f};
        pg8::gemm_phase<pg8::EpiStore<3>, SchedKV, true, false>(F.lds, F.wave, D, D, D, S, E);
    PROBE_END(102) } SEAM(2);
    if (EN(103) && IN(3)) { asm volatile("; PHASE_MARK P3a");
        SchedQK S; S.o.init(NL * 16, 4, F.G, cid); S.KVM = (const char*)(F.ws + WS_KVM); S.WQB = (const char*)(F.ws + WS_WQB);
        pg8::EpiStore<1, true> E{(bf16*)(F.ws + WS_QKT), D, F.in[11], XQSCALE * Q8S};
        int la = 2 * D, lb = D, kk = 256; asm volatile("" : "+s"(la), "+s"(lb), "+s"(kk));
        pg8::gemm_phase<pg8::EpiStore<1, true>, SchedQK, true, false>(F.lds, F.wave, la, lb, kk, S, E);
    }
    if (EN(104) && IN(3)) { asm volatile("; PHASE_MARK P3b");
        SchedVO S; S.o.init(NL * 64, 1, F.G, cid); S.KVM = (const char*)(F.ws + WS_KVM); S.WOT = (const char*)(F.ws + WS_WOT);
        pg8::EpiStore<2, true> E{(bf16*)(F.ws + WS_VOT), D, nullptr, V8S};
        int la = D, lb = 2 * D, kk = 256; asm volatile("" : "+s"(la), "+s"(lb), "+s"(kk));
        pg8::gemm_phase<pg8::EpiStore<2, true>, SchedVO, true, false>(F.lds, F.wave, la, lb, kk, S, E);
    } SEAM(3);
    for (int l = 0; l < NL; ++l) {
        const int pb = PH_LAYER0 + PH_PER_LAYER * l;
        int cid = cid0; asm volatile("" : "+s"(cid));
        if (EN(0) && IN(pb + 0)) { asm volatile("; PHASE_MARK L0"); for (int rep_ = 0; rep_ < ((REPK == 0 || REPK == 91 || REPK == 92) ? 2 : 1); ++rep_) {
            SchedDense S; S.o.init(T / 256, 7, F.G, cid); S.A = (const char*)(F.ws + WS_XR); S.a_tile = 256 * D * 2; S.B = (const char*)(F.ws + WS_WIN) + (size_t)l * INW * D * 2; S.b_tile = 256 * D * 2; S.b_batch = 0; S.bdiv = 1; S.bmod = 1;
            pg8::EpiIn E{(bf16*)(F.ws + WS_UACT), (bf16*)(F.ws + WS_VACT), (bf16*)(F.ws + WS_Q), (bf16*)(F.ws + WS_K), (bf16*)(F.ws + WS_V), (float*)(F.ws + WS_VSTAT),
                         F.in[7] + (size_t)l * 64, F.in[8] + (size_t)l * 64, (const float*)(F.ws + WS_ROPE), (const float*)(F.ws + WS_ROPE) + SEQ * 32, (const float*)(F.ws + WS_RINV)}; E.nostore = (REPK == 91 && rep_ == 0); E.skip = (REPK == 92 && rep_ == 0);
            pg8::gemm_phase<pg8::EpiIn, SchedDense, ALIGN_IN, false>(F.lds, F.wave, D, D, D, S, E);
        if ((REPK == 0 || REPK == 91 || REPK == 92) && rep_ == 0) xcd_barrier(bar); } } SEAM(pb + 0);
        if (EN(1) && IN(pb + 1)) { asm volatile("; PHASE_MARK L1");
            PROBE_TOP(11)
            for (int it = 0; ; ++it) { const int w = it * F.G + F.vcu; if (w >= NB_ * 8 * (SEQ / 256)) break;
                const int i = w >> 8, c = w & 255, x = c >> 5, j = c & 31;
                attn_body::attn_unit<8>(x >> 1, (x & 1) * 4 + i, j, (const attn_body::bf16*)(F.ws + WS_Q), (const attn_body::bf16*)(F.ws + WS_K), (const attn_body::bf16*)(F.ws + WS_V),
                                        (attn_body::bf16*)(F.ws + WS_MERGED), (float*)(F.ws + WS_ATSTAT), (char*)lds, F.wave); }
            PROBE_END(11)
            PROBE_TOP(12) ph_gmlp(F, l); PROBE_END(12) } SEAM(pb + 1);
        if (EN(2) && IN(pb + 2)) { asm volatile("; PHASE_MARK L2"); PROBE_TOP(2)
            SchedDense S; S.o.init(T / 256, 4, F.G, cid); S.A = (const char*)(F.ws + WS_MERGED); S.a_tile = 256 * D * 2; S.B = (const char*)(F.ws + WS_WOUT) + (size_t)l * D * D * 2; S.b_tile = 256 * D * 2; S.b_batch = 0; S.bdiv = 1; S.bmod = 1;
            pg8::EpiX<true, true> E; E.xr = (bf16*)(F.ws + WS_XR); E.xstat = (float*)(F.ws + WS_XSTAT); E.gmstat = (const float*)(F.ws + WS_GMSTAT); E.atstat = (const float*)(F.ws + WS_ATSTAT); E.lds = F.lds; E.xa8 = F.ws + WS_XR8; E.scale = 1.0f;
            pg8::gemm_phase<pg8::EpiX<true, true>, SchedDense, ALIGN_A, false>(F.lds, F.wave, D, D, D, S, E);
        PROBE_END(2) } SEAM(pb + 2);
        if (EN(3) && IN(pb + 3)) { asm volatile("; PHASE_MARK L3"); PROBE_TOP(3)
            SchedDense S; S.o.init(T / 256, 4, F.G, cid); S.A = (const char*)(F.ws + WS_XR8); S.a_tile = 256 * D; S.B = (const char*)(F.ws + WS_QKT) + (size_t)l * NB_ * D * D; S.b_tile = 256 * D; S.b_batch = (size_t)D * D; S.bdiv = SEQ / 256; S.bmod = NB_;
            pg8::EpiS E{(const float*)(F.ws + WS_XSTAT), F.ws + WS_P, F.lds};
            int kq = D / 2; asm volatile("" : "+s"(kq));
            pg8::gemm_phase<pg8::EpiS, SchedDense, true, false, true>(F.lds, F.wave, kq, kq, kq, S, E);
        PROBE_END(3) } SEAM(pb + 3);
        if (EN(4) && IN(pb + 4)) { asm volatile("; PHASE_MARK L4"); PROBE_TOP(4)
            SchedDense S; S.o.init(T / 256, 4, F.G, cid); S.A = (const char*)(F.ws + WS_P); S.a_tile = 256 * D; S.B = (const char*)(F.ws + WS_VOT) + (size_t)l * NB_ * D * D; S.b_tile = 256 * D; S.b_batch = (size_t)D * D; S.bdiv = SEQ / 256; S.bmod = NB_;
            pg8::EpiX<false, false> E; E.xr = (bf16*)(F.ws + WS_XR); E.xstat = nullptr; E.gmstat = nullptr; E.atstat = nullptr; E.lds = F.lds; E.xa8 = nullptr; E.scale = 1.0f / (P8S * V8S);
            int kq = D / 2; asm volatile("" : "+s"(kq));
            pg8::gemm_phase<pg8::EpiX<false, false>, SchedDense, ALIGN_A, false, true>(F.lds, F.wave, kq, kq, kq, S, E);
        PROBE_END(4) } SEAM(pb + 4);
        if (EN(5) && IN(pb + 5)) { asm volatile("; PHASE_MARK L5"); PROBE_TOP(5) ph_router(F, l); PROBE_END(5) } SEAM(pb + 5);
        if (EN(6) && IN(pb + 6)) { asm volatile("; PHASE_MARK L6"); PROBE_TOP(6) ph_topk(F); PROBE_END(6) } SEAM(pb + 6);
        if (EN(7) && IN(pb + 7)) { asm volatile("; PHASE_MARK L7"); PROBE_TOP(7)
            SchedE1 S; S.o.init(NB_ * NE * 4, 8, F.G, cid); S.HBp = (const char*)(F.ws + WS_XR8); S.IDX = (const int*)(F.ws + WS_IDX); S.WGU = (const char*)(F.ws + WS_WGU) + (size_t)l * NE * 2 * FF * D;
            pg8::EpiH E{F.ws + WS_H};
            int kq = D / 2; asm volatile("" : "+s"(kq));
            pg8::gemm_phase<pg8::EpiH, SchedE1, ALIGN_E1, true, true>(F.lds, F.wave, kq, kq, kq, S, E);
        PROBE_END(7) } SEAM(pb + 7);
        if (EN(8) && IN(pb + 8)) { asm volatile("; PHASE_MARK L8"); for (int rep_ = 0; rep_ < ((REPK == 8 || REPK == 81) ? 2 : 1); ++rep_) {
            SchedDense S; S.o.init(NB_ * NE * 4, 4, F.G, cid); S.A = (const char*)(F.ws + WS_H); S.a_tile = 256 * FF; S.B = (const char*)(F.ws + WS_WD) + (size_t)l * NE * D * FF; S.b_tile = 256 * FF; S.b_batch = (size_t)D * FF; S.bdiv = 4; S.bmod = NE;
            pg8::EpiY8 E{F.ws + WS_Y, Y8S / (H8S * W8S)}; E.skip = (REPK == 81 && rep_ == 0);
            int kq = FF / 2; asm volatile("" : "+s"(kq));
            pg8::gemm_phase<pg8::EpiY8, SchedDense, ALIGN_A, false, true>(F.lds, F.wave, kq, kq, kq, S, E);
        if ((REPK == 8 || REPK == 81) && rep_ == 0) xcd_barrier(bar); } } SEAM(pb + 8);
        if (EN(9) && IN(pb + 9)) { asm volatile("; PHASE_MARK L9"); PROBE_TOP(9) ph_combine(F, l, REPK == 9 && rep_ == 0); PROBE_END(9) } SEAM(pb + 9);
    }
#undef IN
#undef SEAM
}

static int g_grid = 0;
static void launch_mega(Args a, int lo, int hi, int region, hipStream_t stream) {
    a.ph_lo = lo; a.ph_hi = hi; a.bar_region = region; a.pad = 0;
    hipLaunchKernelGGL(mega, dim3(g_grid), dim3(NTHR), LDS_BYTES, stream, a);
}
extern "C" void kernel_launch(void* const* d_in, const int* in_sizes, int n_in, void* d_out, int out_size, void* d_ws, size_t ws_size, hipStream_t stream) {
    if (g_grid == 0) {
        if (n_in != 22 || out_size != T * D || ws_size < WS_END) { fprintf(stderr, "kernel_launch: unexpected sizes n_in %d out %d ws %zu\n", n_in, out_size, ws_size); g_grid = -1; return; }
        int dev = 0, cus = 0;
        if (hipGetDevice(&dev) != hipSuccess || hipDeviceGetAttribute(&cus, hipDeviceAttributeMultiprocessorCount, dev) != hipSuccess) { g_grid = -1; return; }
        if (hipFuncSetAttribute((const void*)mega, hipFuncAttributeMaxDynamicSharedMemorySize, LDS_BYTES) != hipSuccess) { g_grid = -1; return; }
        int per_cu = 0;
        if (hipOccupancyMaxActiveBlocksPerMultiprocessor(&per_cu, (const void*)mega, NTHR, LDS_BYTES) != hipSuccess || per_cu < 1) fprintf(stderr, "kernel_launch: occupancy query says %d\n", per_cu);
        (void)hipGetLastError();
        g_grid = cus;
    }
    if (g_grid < 0) return;
    hipMemsetAsync((char*)d_ws + WS_CTL, 0, CTL_ZERO_BYTES, stream);
    Args a{};
    for (int i = 0; i < 22; ++i) a.in[i] = (const float*)d_in[i];
    a.out = (float*)d_out; a.ws = (unsigned char*)d_ws;
    launch_mega(a, 0, PH_END, 0, stream);
}
```

```cpp
#include <hip/hip_runtime.h>
#include <hip/hip_bf16.h>
#include <cstdio>
#include <cstdint>
#include <cmath>

constexpr int NB_ = 4, SEQ = 8192, T = NB_ * SEQ, D = 1024, NL = 4;
constexpr int MEML = 256, NMEM = NB_ * MEML;
constexpr int INW = 1792, GMW = 512, NE = 16, CAP = 1024, FF = 1024;
constexpr float EPS = 1e-6f;
constexpr float LOG2E = 1.4426950408889634f;
constexpr float QSCALE = 0.125f * LOG2E;
constexpr float XQSCALE = 0.0625f * LOG2E;
constexpr float W8S = 256.0f, A8S = 16.0f, H8S = 8.0f, Y8S = 32.0f;
constexpr float Q8S = 512.0f, P8S = 256.0f, V8S = 64.0f;

constexpr size_t MiB = 1u << 20;
constexpr size_t WS_CTL = 0, CTL_ZERO_BYTES = 1 * MiB;
constexpr size_t WS_ROPE = 1 * MiB;
constexpr size_t WS_AFF = 3 * MiB;
constexpr size_t WS_INV = 5 * MiB;
constexpr size_t WS_IDX = 7 * MiB;
constexpr size_t WS_VSTAT = 8 * MiB;
constexpr size_t WS_ATSTAT = 9 * MiB;
constexpr size_t WS_GMSTAT = 10 * MiB;
constexpr size_t WS_RINV = 10 * MiB + 512 * 1024;
constexpr size_t WS_RINV2 = 10 * MiB + 768 * 1024;
constexpr size_t WS_XSTAT = 11 * MiB;
constexpr size_t WS_MEMN = 13 * MiB;
constexpr size_t WS_WSB = 15 * MiB;
constexpr size_t WS_WRH = 15 * MiB + 512 * 1024, WS_WRL = WS_WRH + 128 * 1024;
constexpr size_t WS_WIN = 16 * MiB;
constexpr size_t WS_WOUT = 30 * MiB;
constexpr size_t WS_QKT = 38 * MiB;
constexpr size_t WS_VOT = 70 * MiB;
constexpr size_t WS_WGU = 102 * MiB;
constexpr size_t WS_WD = 358 * MiB;
constexpr size_t WS_XR = 486 * MiB;
constexpr size_t WS_R1 = 550 * MiB;
constexpr size_t WS_UACT = WS_R1, WS_VACT = WS_R1 + 32 * MiB, WS_Q = WS_R1 + 64 * MiB, WS_K = WS_R1 + 96 * MiB, WS_V = WS_R1 + 104 * MiB;
constexpr size_t WS_WQB = WS_R1, WS_WOT = WS_R1 + 8 * MiB, WS_WKVT = WS_R1 + 16 * MiB, WS_KVM = WS_R1 + 32 * MiB;
constexpr size_t WS_H = WS_R1;
constexpr size_t WS_MERGED = 678 * MiB;
constexpr size_t WS_XR8 = 742 * MiB;
constexpr size_t WS_P = WS_MERGED;
constexpr size_t WS_Y = 678 * MiB;
constexpr size_t WS_NSCR = 806 * MiB;
constexpr size_t WS_Q2 = WS_MERGED;
constexpr size_t WS_O2 = WS_NSCR;
constexpr size_t WS_KVN = WS_NSCR + 64 * MiB;
constexpr size_t WS_END = 1024 * MiB;

constexpr int CW_TMO = 0, CW_CODE = 1, CW_BAR = 4096;

#define GAS __attribute__((address_space(1)))
#define LAS __attribute__((address_space(3)))
typedef unsigned short bf16;
typedef unsigned v4u __attribute__((ext_vector_type(4)));
typedef unsigned v2u __attribute__((ext_vector_type(2)));
typedef float f32x4 __attribute__((ext_vector_type(4)));
typedef short bf16x8_t __attribute__((ext_vector_type(8)));
typedef GAS unsigned gu32;
#define RLX_AGENT __ATOMIC_RELAXED, __HIP_MEMORY_SCOPE_AGENT
__device__ __forceinline__ unsigned f2bf(float f) { unsigned u = __builtin_bit_cast(unsigned, f); return (u + 0x7fffu + ((u >> 16) & 1u)) >> 16; }
__device__ __forceinline__ unsigned pk2(float lo, float hi) { return f2bf(lo) | (f2bf(hi) << 16); }
__device__ __forceinline__ float bf2f(unsigned v) { return __builtin_bit_cast(float, v << 16); }
__device__ __forceinline__ float bflo(unsigned w) { return __builtin_bit_cast(float, w << 16); }
__device__ __forceinline__ float bfhi(unsigned w) { return __builtin_bit_cast(float, w & 0xffff0000u); }
__device__ __forceinline__ float rbf(float f) { return bf2f(f2bf(f)); }
__device__ __forceinline__ float clamp8(float v) { return __builtin_amdgcn_fmed3f(v, -448.0f, 448.0f); }
__device__ __forceinline__ unsigned pk4_fp8(float a, float b, float c, float d) { unsigned w = 0u; w = __builtin_amdgcn_cvt_pk_fp8_f32(clamp8(a), clamp8(b), w, false); w = __builtin_amdgcn_cvt_pk_fp8_f32(clamp8(c), clamp8(d), w, true); return w; }
__device__ __forceinline__ float gelu_tanh(float x) {
    const float z = 1.5957691216057308f * (x + 0.044715f * x * x * x);
    return x * __builtin_amdgcn_rcpf(1.0f + __builtin_amdgcn_exp2f(-z * LOG2E));
}
typedef float f32x2_t __attribute__((ext_vector_type(2)));
__device__ __forceinline__ f32x4 gelu4(const f32x4 x) {
    const f32x4 w = (x * x) * (-1.5957691216057308f * 0.044715f * LOG2E) + (-1.5957691216057308f * LOG2E); const f32x4 a = w * x;
    f32x4 d; d[0] = __builtin_amdgcn_exp2f(a[0]); d[1] = __builtin_amdgcn_exp2f(a[1]); d[2] = __builtin_amdgcn_exp2f(a[2]); d[3] = __builtin_amdgcn_exp2f(a[3]);
    d = d + 1.0f;
    f32x4 r; r[0] = __builtin_amdgcn_rcpf(d[0]); r[1] = __builtin_amdgcn_rcpf(d[1]); r[2] = __builtin_amdgcn_rcpf(d[2]); r[3] = __builtin_amdgcn_rcpf(d[3]);
    return x * r;
}
__device__ __forceinline__ f32x4 silu_mul4(const f32x4 g, const f32x4 u, const float sg, const float su) {
    const f32x4 a = g * (-sg * LOG2E);
    f32x4 d; d[0] = __builtin_amdgcn_exp2f(a[0]); d[1] = __builtin_amdgcn_exp2f(a[1]); d[2] = __builtin_amdgcn_exp2f(a[2]); d[3] = __builtin_amdgcn_exp2f(a[3]);
    d = d + 1.0f;
    f32x4 r; r[0] = __builtin_amdgcn_rcpf(d[0]); r[1] = __builtin_amdgcn_rcpf(d[1]); r[2] = __builtin_amdgcn_rcpf(d[2]); r[3] = __builtin_amdgcn_rcpf(d[3]);
    return (g * r) * (u * (sg * sg * su));
}
__device__ __forceinline__ float silu_f(float a) { return a * __builtin_amdgcn_rcpf(1.0f + __builtin_amdgcn_exp2f(-a * LOG2E)); }
__device__ __forceinline__ int lane_id() { int l; asm volatile("v_mbcnt_lo_u32_b32 %0, -1, 0\n\tv_mbcnt_hi_u32_b32 %0, -1, %0" : "=v"(l)); return l; }
template <int CTRL> __device__ __forceinline__ float dpp_f(float v) { return __builtin_bit_cast(float, __builtin_amdgcn_update_dpp(0, __builtin_bit_cast(int, v), CTRL, 0xf, 0xf, true)); }
__device__ __forceinline__ float sum_row16(float v) { v += dpp_f<0xB1>(v); v += dpp_f<0x4E>(v); v += dpp_f<0x141>(v); v += dpp_f<0x140>(v); return v; }
__device__ __forceinline__ float max_row16(float v) { v = fmaxf(v, dpp_f<0xB1>(v)); v = fmaxf(v, dpp_f<0x4E>(v)); v = fmaxf(v, dpp_f<0x141>(v)); v = fmaxf(v, dpp_f<0x140>(v)); return v; }
__device__ __forceinline__ float sum_row8(float v) { v += dpp_f<0xB1>(v); v += dpp_f<0x4E>(v); v += dpp_f<0x141>(v); return v; }
__device__ __forceinline__ float swz16(float v) { return __builtin_bit_cast(float, __builtin_amdgcn_ds_swizzle(__builtin_bit_cast(int, v), 0x401f)); }
__device__ __forceinline__ float add_x16(float v) { return v + swz16(v); }
__device__ __forceinline__ float add_x32(float v) { const unsigned a = __builtin_bit_cast(unsigned, v); const auto r = __builtin_amdgcn_permlane32_swap(a, a, false, false); const unsigned r0 = r[0], r1 = r[1]; return __builtin_bit_cast(float, r0) + __builtin_bit_cast(float, r1); }
__device__ __forceinline__ float max_x16(float v) { return fmaxf(v, swz16(v)); }
__device__ __forceinline__ float max_x32(float v) { const unsigned a = __builtin_bit_cast(unsigned, v); const auto r = __builtin_amdgcn_permlane32_swap(a, a, false, false); const unsigned r0 = r[0], r1 = r[1]; return fmaxf(__builtin_bit_cast(float, r0), __builtin_bit_cast(float, r1)); }
__device__ __forceinline__ float wave_sum(float v) { return add_x32(add_x16(sum_row16(v))); }

#define XB_TMO      128
#define XB_XCNT(j)  (256  + 64 * (j))
#define XB_XSUB(j)  (1280 + 64 * (j))
#define XB_XGEN(j)  (2304 + 64 * (j))
#define XB_TOP      3328
#define XB_TOPGEN   3392
#define XCD_BAR_WORDS 3456
#define XB_SPIN_CAP (1u << 18)
__device__ __forceinline__ unsigned xb_ld(unsigned* p)              { return __hip_atomic_load(p, __ATOMIC_RELAXED, __HIP_MEMORY_SCOPE_AGENT); }
__device__ __forceinline__ unsigned xb_add(unsigned* p, unsigned v) { return __hip_atomic_fetch_add(p, v, __ATOMIC_RELAXED, __HIP_MEMORY_SCOPE_AGENT); }
__device__ __forceinline__ unsigned xb_xcc_id() { return (unsigned)__builtin_amdgcn_s_getreg((3 << 11) | 20) & 0xFu; }
#define XB_SPIN(cond, bar) do { unsigned _sp = 0; while (cond) { __builtin_amdgcn_s_sleep(1); \
    if ((++_sp & 255u) == 0u) { if (xb_ld(&(bar)[XB_TMO])) break; if (_sp > XB_SPIN_CAP) { atomicAdd(&(bar)[XB_TMO], 1u); break; } } } } while (0)
struct XcdBarrier { unsigned* bar; unsigned x; volatile LAS unsigned* st; };
__device__ __forceinline__ XcdBarrier xcd_barrier_post(unsigned* bar, volatile LAS unsigned* st) {
    XcdBarrier b; b.bar = bar; b.x = xb_xcc_id(); b.st = st;
    if (threadIdx.x == 0) (void)xb_add(&bar[XB_XCNT(b.x)], 1u);
    return b;
}
__device__ __forceinline__ void xcd_barrier_complete(unsigned* bar, unsigned x, unsigned& nloc, unsigned& nx) {
    const unsigned G = gridDim.x * gridDim.y * gridDim.z;
    unsigned sum, cnt, mine, sp = 0u;
    for (;;) {
        sum = 0u; cnt = 0u; mine = 0u;
#pragma unroll
        for (unsigned j = 0; j < 16; ++j) { const unsigned c = xb_ld(&bar[XB_XCNT(j)]); sum += c; cnt += (c > 0u) ? 1u : 0u; mine = (j == x) ? c : mine; }
        if (sum == G) break;
        __builtin_amdgcn_s_sleep(1);
        if ((++sp & 255u) == 0u) { if (xb_ld(&bar[XB_TMO])) break; if (sp > XB_SPIN_CAP) { atomicAdd(&bar[XB_TMO], 1u); break; } }
    }
    nloc = mine > 0u ? mine : 1u; nx = cnt > 0u ? cnt : 1u;
}
__device__ __forceinline__ void xcd_barrier(const XcdBarrier& b) {
    asm volatile("s_waitcnt vmcnt(0)" ::: "memory");
    __syncthreads();
    if (threadIdx.x == 0) {
        unsigned* bar = b.bar;
        __builtin_amdgcn_s_waitcnt(0);
        unsigned nloc = b.st[0], nx = b.st[1];
        if (nloc == 0u) { xcd_barrier_complete(bar, b.x, nloc, nx); b.st[0] = nloc; b.st[1] = nx; }
        const unsigned old = xb_add(&bar[XB_XSUB(b.x)], 1u);
        const unsigned gen = old / nloc;
        if (old + 1u == (gen + 1u) * nloc) {
            __builtin_amdgcn_fence(__ATOMIC_RELEASE, "agent");
            asm volatile("s_waitcnt vmcnt(0)" ::: "memory");
            const unsigned og = xb_add(&bar[XB_TOP], 1u);
            const unsigned tg = og / nx;
            if (og + 1u == (tg + 1u) * nx) xb_add(&bar[XB_TOPGEN], 1u);
            else XB_SPIN(xb_ld(&bar[XB_TOPGEN]) == tg, bar);
            __builtin_amdgcn_fence(__ATOMIC_ACQUIRE, "agent");
            xb_add(&bar[XB_XGEN(b.x)], 1u);
            asm volatile("s_waitcnt vmcnt(0)" ::: "memory");
        } else {
            XB_SPIN(xb_ld(&bar[XB_XGEN(b.x)]) == gen, bar);
            __builtin_amdgcn_fence(__ATOMIC_ACQUIRE, "agent");
            asm volatile("s_waitcnt vmcnt(0)" ::: "memory");
        }
    }
    __syncthreads();
}

struct Args { const float* in[22]; float* out; unsigned char* ws; int ph_lo, ph_hi, bar_region, pad; };
constexpr int PH_LAYER0 = 4, PH_PER_LAYER = 10, PH_END = PH_LAYER0 + NL * PH_PER_LAYER;

constexpr int NWAVES = 8, NTHR = NWAVES * 64;
constexpr int RING_BYTES = 131072, LDSCTL_OFF = RING_BYTES, MISC_OFF = LDSCTL_OFF + 320;
constexpr int LDS_BYTES = 147456;

struct Frame {
    LAS unsigned char* lds;
    int wave, vcu, G;
    const float* in[22];
    unsigned char* ws;
    float* xres;
};

__device__ __forceinline__ void ph_rows0(Frame& F) {
    int lane_ = lane_id(); asm volatile("" : "+v"(lane_)); const int tid_ = F.wave * 64 + lane_;
    const int gw = F.vcu * NWAVES + F.wave, NGW = F.G * NWAVES;
    const float* x = F.in[0]; const float* mem = F.in[1]; const float* mg = F.in[12];
    bf16* XR = (bf16*)(F.ws + WS_XR); bf16* MEMN = (bf16*)(F.ws + WS_MEMN); float* RINV = (float*)(F.ws + WS_RINV);
    for (int m = gw; m < T + NMEM; m += NGW) {
        const bool is_mem = m >= T;
        const float* src = is_mem ? mem + (size_t)(m - T) * D : x + (size_t)m * D;
        bf16* dst = is_mem ? MEMN + (size_t)(m - T) * D : XR + (size_t)m * D;
        f32x4 v[4]; float s = 0.f;
#pragma unroll
        for (int j = 0; j < 4; ++j) { v[j] = *(const f32x4*)(src + 4 * lane_ + 256 * j); s += (v[j].x * v[j].x + v[j].y * v[j].y) + (v[j].z * v[j].z + v[j].w * v[j].w); }
        const float rinv = __builtin_amdgcn_rsqf(wave_sum(s) * (1.0f / D) + EPS);
        if (!is_mem && lane_ == 0) RINV[m] = rinv;
        const float sc = is_mem ? rinv : 1.0f;
#pragma unroll
        for (int j = 0; j < 4; ++j) {
            f32x4 g = (f32x4){1.f, 1.f, 1.f, 1.f};
            if (is_mem) g = *(const f32x4*)(mg + 4 * lane_ + 256 * j);
            v2u o; o.x = pk2(v[j].x * sc * g.x, v[j].y * sc * g.y); o.y = pk2(v[j].z * sc * g.z, v[j].w * sc * g.w);
            *(v2u*)(dst + 4 * lane_ + 256 * j) = o;
        }
    }
#if defined(SELFTEST_F8)
    if (F.vcu == 0 && F.wave == 0) {
        typedef int v8i_t __attribute__((ext_vector_type(8)));
        const int fr = lane_ & 15; const unsigned codes[4] = {0x38383838u, 0x3A3A3A3Au, 0x3C3C3C3Cu, 0x40404040u}; const float vals[4] = {1.0f, 1.25f, 1.5f, 2.0f};
        unsigned bc = codes[0]; float bv = vals[0];
#pragma unroll
        for (int q = 1; q < 4; ++q) if ((fr & 3) == q) { bc = codes[q]; bv = vals[q]; }
        v8i_t A, B;
#pragma unroll
        for (int q = 0; q < 8; ++q) { A[q] = 0x38383838; B[q] = (int)bc; }
        f32x4 acc = (f32x4){0.f, 0.f, 0.f, 0.f}; unsigned sc = 0x7f7f7f7fu; asm volatile("" : "+v"(sc), "+v"(A), "+v"(B), "+v"(acc));
        asm volatile("s_nop 7\n\tv_mfma_scale_f32_16x16x128_f8f6f4 %0, %1, %2, %0, %3, %3 op_sel_hi:[0,0,0]\n\ts_nop 15\n\ts_nop 15\n\ts_nop 15\n\ts_nop 15\n\ts_nop 15\n\ts_nop 15" : "+v"(acc) : "v"(A), "v"(B), "v"(sc));
        bool bad = false;
#pragma unroll
        for (int e = 0; e < 4; ++e) bad |= (acc[e] != 128.0f * bv);
        const unsigned w = pk4_fp8(1.25f, 448.0f, 1000.0f, -2.0f); bad |= (w != 0xC07E7E3Au);
        {   const float v = (float)((lane_ * 37 + 11) % 101);
            float r16 = v; r16 += __shfl_xor(r16, 1); r16 += __shfl_xor(r16, 2); r16 += __shfl_xor(r16, 4); r16 += __shfl_xor(r16, 8);
            float m16 = v; m16 = fmaxf(m16, __shfl_xor(m16, 1)); m16 = fmaxf(m16, __shfl_xor(m16, 2)); m16 = fmaxf(m16, __shfl_xor(m16, 4)); m16 = fmaxf(m16, __shfl_xor(m16, 8));
            float r8 = v; r8 += __shfl_xor(r8, 1); r8 += __shfl_xor(r8, 2); r8 += __shfl_xor(r8, 4);
            float r64 = r16; r64 += __shfl_xor(r64, 16); r64 += __shfl_xor(r64, 32);
            if (SELFTEST_F8 & 1) bad |= (sum_row16(v) != r16) | (max_row16(v) != m16) | (sum_row8(v) != r8);
            if (SELFTEST_F8 & 2) bad |= (wave_sum(v) != r64);
            if (SELFTEST_F8 & 4) bad |= (add_x16(v) != v + __shfl_xor(v, 16)) | (max_x16(v) != fmaxf(v, __shfl_xor(v, 16)));
            if (SELFTEST_F8 & 8) bad |= (add_x32(v) != v + __shfl_xor(v, 32)) | (max_x32(v) != fmaxf(v, __shfl_xor(v, 32)));
            if (SELFTEST_F8 & 16) bad |= (lane_ != (int)(threadIdx.x & 63));
            const int iv = lane_ * 3 + 1; if (SELFTEST_F8 & 32) bad |= (__builtin_amdgcn_readlane(iv, 5) != 16) | false; { const int bp = __builtin_amdgcn_ds_bpermute((lane_ - 1) << 2, iv); if (SELFTEST_F8 & 32) bad |= (lane_ > 0 && bp != iv - 3); }
            const float xq = 0.37f + (float)lane_; const float rq = __builtin_amdgcn_rsqf(xq), rr = 1.0f / sqrtf(xq); if (SELFTEST_F8 & 64) bad |= (fabsf(rq - rr) > 1e-5f * rr); }
        if (bad) __hip_atomic_store((unsigned*)(F.ws + WS_CTL) + CW_TMO, 1u, __ATOMIC_RELAXED, __HIP_MEMORY_SCOPE_AGENT);
    }
#endif
    float* COS = (float*)(F.ws + WS_ROPE); float* SIN = COS + SEQ * 32;
    const int gt = F.vcu * NTHR + tid_, NGT = F.G * NTHR;
    for (int i = gt; i < SEQ * 32; i += NGT) {
        const int t = i >> 5, p = i & 31;
        const float fr = expf(-9.210340371976184f * (float)(p & 15) * (1.0f / 16.0f));
        const float pos = (float)((p < 16) ? (t >> 6) : (t & 63));
        float rev = pos * fr * 0.15915494309189535f; rev -= floorf(rev);
        COS[i] = __builtin_amdgcn_cosf(rev); SIN[i] = __builtin_amdgcn_sinf(rev);
    }
}

__device__ __forceinline__ void ph_gmlp(Frame& F, int l) {
    int lane_ = lane_id(); asm volatile("" : "+v"(lane_)); const int tid_ = F.wave * 64 + lane_;
    const bf16* UACT = (const bf16*)(F.ws + WS_UACT); const bf16* VACT = (const bf16*)(F.ws + WS_VACT);
    const float* VSTAT = (const float*)(F.ws + WS_VSTAT); float* GMSTAT = (float*)(F.ws + WS_GMSTAT);
    bf16* MERGED = (bf16*)(F.ws + WS_MERGED);
    const float* gvn = F.in[4] + (size_t)l * GMW; const float* bs = F.in[6] + (size_t)l * 4 * 128;
    const bf16* WSB = (const bf16*)(F.ws + WS_WSB) + (size_t)l * 4 * 128 * 128;
    LAS bf16* vT = (LAS bf16*)F.lds;
    const int fr = lane_ & 15, fq = lane_ >> 4, w = F.wave;
    for (int u = F.vcu; u < (T / 128) * 4; u += F.G) {
        const int n = u >> 2, g = u & 3; const int row0 = n * 128;
        __syncthreads();
        {   const int j = tid_ & 127, cs = tid_ >> 7; const size_t row = (size_t)row0 + j;
            const f32x4 s0 = *(const f32x4*)(VSTAT + row * 8), s1 = *(const f32x4*)(VSTAT + row * 8 + 4);
            const float rinv = __builtin_amdgcn_rsqf((((s0[0] + s0[1]) + (s0[2] + s0[3])) + ((s1[0] + s1[1]) + (s1[2] + s1[3]))) * (1.0f / GMW) + EPS);
#pragma unroll
            for (int q = 0; q < 4; ++q) { const int c8 = (cs * 4 + q) * 8;
                const v4u raw = *(const v4u*)(VACT + row * GMW + g * 128 + c8);
                const f32x4 g0 = *(const f32x4*)(gvn + g * 128 + c8) * rinv, g1 = *(const f32x4*)(gvn + g * 128 + c8 + 4) * rinv;
                LAS bf16* d = vT + c8 * 136 + j;
                d[0 * 136] = (bf16)f2bf(bflo(raw.x) * g0[0]); d[1 * 136] = (bf16)f2bf(bfhi(raw.x) * g0[1]); d[2 * 136] = (bf16)f2bf(bflo(raw.y) * g0[2]); d[3 * 136] = (bf16)f2bf(bfhi(raw.y) * g0[3]);
                d[4 * 136] = (bf16)f2bf(bflo(raw.z) * g1[0]); d[5 * 136] = (bf16)f2bf(bfhi(raw.z) * g1[1]); d[6 * 136] = (bf16)f2bf(bflo(raw.w) * g1[2]); d[7 * 136] = (bf16)f2bf(bfhi(raw.w) * g1[3]); } }
        bf16x8_t bw[4];
#pragma unroll
        for (int ks = 0; ks < 4; ++ks) bw[ks] = *(const bf16x8_t*)(WSB + ((size_t)(g * 128 + 16 * w + fr)) * 128 + 32 * ks + 8 * fq);
        __syncthreads();
        f32x4 acc[8];
#pragma unroll
        for (int cb = 0; cb < 8; ++cb) { acc[cb] = (f32x4){0.f, 0.f, 0.f, 0.f};
#pragma unroll
            for (int ks = 0; ks < 4; ++ks) { const bf16x8_t a = *(const LAS bf16x8_t*)(vT + (16 * cb + fr) * 136 + 32 * ks + 8 * fq);
                acc[cb] = __builtin_amdgcn_mfma_f32_16x16x32_bf16(a, bw[ks], acc[cb], 0, 0, 0); } }
        const size_t row = (size_t)row0 + 16 * w + fr; const float bias = bs[g * 128 + 16 * w + fr]; float ss = 0.f;
#pragma unroll
        for (int cb = 0; cb < 8; ++cb) { const v2u uu = *(const v2u*)(UACT + row * GMW + g * 128 + 16 * cb + 4 * fq);
            v2u o; o.x = pk2(bflo(uu.x) * (acc[cb][0] + bias), bfhi(uu.x) * (acc[cb][1] + bias)); o.y = pk2(bflo(uu.y) * (acc[cb][2] + bias), bfhi(uu.y) * (acc[cb][3] + bias));
            *(v2u*)(MERGED + row * 1024 + g * 128 + 16 * cb + 4 * fq) = o;
            const float a0 = bflo(o.x), a1 = bfhi(o.x), a2 = bflo(o.y), a3 = bfhi(o.y); ss += (a0 * a0 + a1 * a1) + (a2 * a2 + a3 * a3); }
        ss = add_x32(add_x16(ss));
        if (fq == 0) GMSTAT[row * 4 + g] = ss;
    }
    __syncthreads();
}

__device__ __forceinline__ void ph_router(Frame& F, int l) {
    const int lane_ = lane_id(); const int fr = lane_ & 15, fq = lane_ >> 4;
    const bf16* XR = (const bf16*)(F.ws + WS_XR); float* AFF = (float*)(F.ws + WS_AFF); unsigned char* X8 = F.ws + WS_XR8;
    const bf16* WRH = (const bf16*)(F.ws + WS_WRH) + ((size_t)l * NE + fr) * D + 8 * fq; const bf16* WRL = (const bf16*)(F.ws + WS_WRL) + ((size_t)l * NE + fr) * D + 8 * fq;
    const int gw = F.vcu * NWAVES + F.wave, NGW = F.G * NWAVES;
    for (int blk = gw; blk < T / 16; blk += NGW) {
        const size_t row = (size_t)blk * 16 + fr; const bf16* xp = XR + row * D + 8 * fq;
        f32x4 acc = (f32x4){0.f, 0.f, 0.f, 0.f}; float ss = 0.f;
#pragma unroll 8
        for (int ks = 0; ks < 32; ++ks) { const bf16x8_t xk = *(const bf16x8_t*)(xp + 32 * ks); const bf16x8_t wh = *(const bf16x8_t*)(WRH + 32 * ks), wl = *(const bf16x8_t*)(WRL + 32 * ks);
            acc = __builtin_amdgcn_mfma_f32_16x16x32_bf16(wh, xk, acc, 0, 0, 0); acc = __builtin_amdgcn_mfma_f32_16x16x32_bf16(wl, xk, acc, 0, 0, 0);
            const v4u xb = __builtin_bit_cast(v4u, xk);
            const float a0 = bflo(xb.x), a1 = bfhi(xb.x), a2 = bflo(xb.y), a3 = bfhi(xb.y), a4 = bflo(xb.z), a5 = bfhi(xb.z), a6 = bflo(xb.w), a7 = bfhi(xb.w);
            ss += ((a0 * a0 + a1 * a1) + (a2 * a2 + a3 * a3)) + ((a4 * a4 + a5 * a5) + (a6 * a6 + a7 * a7)); }
        ss = add_x32(add_x16(ss));
        const float rinv = __builtin_amdgcn_rsqf(ss * (1.0f / D) + EPS);
        const f32x4 lg = acc * (rinv * LOG2E);
        float mx = fmaxf(fmaxf(lg[0], lg[1]), fmaxf(lg[2], lg[3])); mx = max_x32(max_x16(mx));
        f32x4 pe; float den = 0.f;
#pragma unroll
        for (int i = 0; i < 4; ++i) { pe[i] = __builtin_amdgcn_exp2f(lg[i] - mx); den += pe[i]; }
        den = add_x32(add_x16(den));
        *(f32x4*)(AFF + row * NE + 4 * fq) = pe * __builtin_amdgcn_rcpf(den);
        const float sc = rinv * A8S;
#pragma unroll 8
        for (int ks = 0; ks < 32; ++ks) { const v4u xb = *(const v4u*)(xp + 32 * ks);
            v2u o; o.x = pk4_fp8(bflo(xb.x) * sc, bfhi(xb.x) * sc, bflo(xb.y) * sc, bfhi(xb.y) * sc); o.y = pk4_fp8(bflo(xb.z) * sc, bfhi(xb.z) * sc, bflo(xb.w) * sc, bfhi(xb.w) * sc);
            *(v2u*)(X8 + row * D + 32 * ks + 8 * fq) = o; }
    }
}

__device__ __forceinline__ void ph_topk(Frame& F) {
    int lane_ = lane_id(); asm volatile("" : "+v"(lane_)); const int tid_ = F.wave * 64 + lane_;
    const float* AFF = (const float*)(F.ws + WS_AFF); int* IDX = (int*)(F.ws + WS_IDX); int* INV = (int*)(F.ws + WS_INV);
    LAS unsigned* hist = (LAS unsigned*)F.lds;
    LAS unsigned* sh = hist + 256;
    LAS unsigned* wsum = hist + 512;
    for (int p = F.vcu; p < NB_ * NE; p += F.G) {
        const int b = p >> 4, e = p & 15;
        unsigned key[16];
#pragma unroll
        for (int i = 0; i < 16; ++i) key[i] = __builtin_bit_cast(unsigned, AFF[((size_t)b * SEQ + tid_ * 16 + i) * NE + e]);
        unsigned prefix = 0u, krem = CAP;
#pragma unroll
        for (int pass = 0; pass < 4; ++pass) {
            const int shift = pass == 3 ? 0 : 23 - 8 * pass; const unsigned dmask = pass == 3 ? 127u : 255u;
            const unsigned himask = pass == 0 ? 0u : (pass == 1 ? 0xff800000u : (pass == 2 ? 0xffff8000u : 0xffffff80u));
            __syncthreads();
            if (tid_ < 256) hist[tid_] = 0u;
            __syncthreads();
#pragma unroll
            for (int i = 0; i < 16; ++i) if ((key[i] & himask) == prefix) atomicAdd((unsigned*)&hist[(key[i] >> shift) & dmask], 1u);
            __syncthreads();
            if (F.wave == 0) {
                unsigned c[4]; unsigned t = 0u;
#pragma unroll
                for (int j = 0; j < 4; ++j) { c[j] = hist[255 - 4 * lane_ - j]; t += c[j]; }
                unsigned inc = t;
#pragma unroll
                for (int o = 1; o < 64; o <<= 1) { const unsigned a = (unsigned)__builtin_amdgcn_ds_bpermute((lane_ - o) << 2, (int)inc); if (lane_ >= o) inc += a; }
                unsigned above = inc - t;
                if (above < krem && krem <= inc) {
                    int d = 255 - 4 * lane_;
#pragma unroll
                    for (int j = 0; j < 3; ++j) { if (above + c[j] < krem) { above += c[j]; d = 254 - 4 * lane_ - j; } else break; }
                    sh[0] = prefix | ((unsigned)d << shift); sh[1] = krem - above; }
            }
            __syncthreads();
            prefix = sh[0]; krem = sh[1];
        }
        const unsigned thr = prefix;
        unsigned cg = 0u, ce = 0u;
#pragma unroll
        for (int i = 0; i < 16; ++i) { cg += key[i] > thr ? 1u : 0u; ce += key[i] == thr ? 1u : 0u; }
        unsigned sg = cg, se = ce;
#pragma unroll
        for (int o = 1; o < 64; o <<= 1) { const unsigned a = (unsigned)__builtin_amdgcn_ds_bpermute((lane_ - o) << 2, (int)sg), c2 = (unsigned)__builtin_amdgcn_ds_bpermute((lane_ - o) << 2, (int)se); if (lane_ >= o) { sg += a; se += c2; } }
        __syncthreads();
        if (lane_ == 63) { wsum[F.wave] = sg; wsum[8 + F.wave] = se; }
        __syncthreads();
        unsigned og = 0u, oe = 0u;
        for (int w = 0; w < F.wave; ++w) { og += wsum[w]; oe += wsum[8 + w]; }
        unsigned gb = og + sg - cg, eb = oe + se - ce;
#pragma unroll
        for (int i = 0; i < 16; ++i) {
            const int t = tid_ * 16 + i; int pos = -1;
            if (key[i] > thr) { pos = (int)(gb + (eb < krem ? eb : krem)); ++gb; }
            else if (key[i] == thr) { if (eb < krem) pos = (int)(gb + eb); ++eb; }
            INV[((size_t)b * SEQ + t) * NE + e] = pos;
            if (pos >= 0) IDX[(size_t)p * CAP + pos] = t;
        }
    }
    __syncthreads();
}

__device__ __forceinline__ void ph_combine(Frame& F, int l, bool dummy) {
    int lane_ = lane_id(); asm volatile("" : "+v"(lane_));
    const float* AFF = (const float*)(F.ws + WS_AFF); const int* INV = (const int*)(F.ws + WS_INV);
    const unsigned char* Y = F.ws + WS_Y; bf16* XR = (bf16*)(F.ws + WS_XR); const float* fg = F.in[21]; float* RINV = (float*)(F.ws + WS_RINV);
    const int gw = F.vcu * NWAVES + F.wave, NGW = F.G * NWAVES;
    v2u nx[4]; int npos = -1; float naff = 0.f;
    if (gw < T) {
#pragma unroll
        for (int j = 0; j < 4; ++j) nx[j] = *(const v2u*)(XR + (size_t)gw * D + 4 * lane_ + 256 * j);
        if (lane_ < NE) { npos = INV[(size_t)gw * NE + lane_]; naff = AFF[(size_t)gw * NE + lane_]; } }
    for (int m = gw; m < T; m += NGW) {
        const int b = m / SEQ;
        bf16* xw = (dummy ? (bf16*)(F.ws + WS_NSCR) : XR) + (size_t)m * D; float* ow = (dummy ? (float*)(F.ws + WS_NSCR) : F.xres) + (size_t)m * D;
        f32x4 v[4];
#pragma unroll
        for (int j = 0; j < 4; ++j) v[j] = (f32x4){bflo(nx[j].x), bfhi(nx[j].x), bflo(nx[j].y), bfhi(nx[j].y)};
        const int mypos = npos; const float myaff = naff;
        {   const int mn = m + NGW; npos = -1; naff = 0.f;
            if (mn < T) {
#pragma unroll
                for (int j = 0; j < 4; ++j) nx[j] = *(const v2u*)(XR + (size_t)mn * D + 4 * lane_ + 256 * j);
                if (lane_ < NE) { npos = INV[(size_t)mn * NE + lane_]; naff = AFF[(size_t)mn * NE + lane_]; } } }
        unsigned mask = (unsigned)__builtin_amdgcn_ballot_w64(mypos >= 0) & 0xffffu;
        while (mask) {
            int ee[4]; int nsel = 0;
#pragma unroll
            for (int q = 0; q < 4; ++q) { ee[q] = 0; if (mask) { ee[q] = __builtin_ctz(mask); mask &= mask - 1u; nsel = q + 1; } }
            int w[4][4]; float as[4];
#pragma unroll
            for (int q = 0; q < 4; ++q) { as[q] = 0.f;
                if (q < nsel) { const int pos = __builtin_amdgcn_readlane(mypos, ee[q]); as[q] = __builtin_bit_cast(float, __builtin_amdgcn_readlane(__builtin_bit_cast(int, myaff), ee[q])) * (1.0f / Y8S);
                    const unsigned char* yr = Y + ((size_t)(b * NE + ee[q]) * CAP + pos) * D;
#pragma unroll
                    for (int j = 0; j < 4; ++j) w[q][j] = *(const int*)(yr + 4 * lane_ + 256 * j); }
                else {
#pragma unroll
                    for (int j = 0; j < 4; ++j) w[q][j] = 0; } }
#pragma unroll
            for (int q = 0; q < 4; ++q)
#pragma unroll
                for (int j = 0; j < 4; ++j) { const auto lo = __builtin_amdgcn_cvt_pk_f32_fp8(w[q][j], false), hi = __builtin_amdgcn_cvt_pk_f32_fp8(w[q][j], true);
                    const float l0 = lo[0], l1 = lo[1], h0 = hi[0], h1 = hi[1];
                    v[j].x += as[q] * l0; v[j].y += as[q] * l1; v[j].z += as[q] * h0; v[j].w += as[q] * h1; }
        }
        float s = 0.f;
#pragma unroll
        for (int j = 0; j < 4; ++j) s += (v[j].x * v[j].x + v[j].y * v[j].y) + (v[j].z * v[j].z + v[j].w * v[j].w);
        const float rinv = __builtin_amdgcn_rsqf(wave_sum(s) * (1.0f / D) + EPS);
        if (l == NL - 1) {
#if defined(SELFTEST_F8)
            if (__hip_atomic_load((unsigned*)(F.ws + WS_CTL) + CW_TMO, __ATOMIC_RELAXED, __HIP_MEMORY_SCOPE_AGENT) != 0u) v[0].x = __builtin_nanf("");
#endif
#pragma unroll
            for (int j = 0; j < 4; ++j) { const f32x4 g = *(const f32x4*)(fg + 4 * lane_ + 256 * j); *(f32x4*)(ow + 4 * lane_ + 256 * j) = (f32x4){v[j].x * rinv * g.x, v[j].y * rinv * g.y, v[j].z * rinv * g.z, v[j].w * rinv * g.w}; }
        } else {
            if (lane_ == 0 && !dummy) RINV[m] = rinv;
#pragma unroll
            for (int j = 0; j < 4; ++j) { v2u o; o.x = pk2(v[j].x, v[j].y); o.y = pk2(v[j].z, v[j].w); *(v2u*)(xw + 4 * lane_ + 256 * j) = o; }
        }
    }
}

namespace pg8 {
typedef short bf16x8 __attribute__((ext_vector_type(8)));
typedef float f32x2 __attribute__((ext_vector_type(2)));
typedef int v4i_t __attribute__((ext_vector_type(4)));
typedef int v8i_t __attribute__((ext_vector_type(8)));
constexpr int BM = 256, BK = 64, HALF = 128, HTB = HALF * BK * 2, STAGE_BYTES = 8 * HTB, NXCD = 8, WGM = 8;
__host__ __device__ __forceinline__ int lds_byte(int r, int c) { const int st = (r >> 4) * 2 + (c >> 5), rr = r & 15, cc = c & 31, ob = rr * 64 + cc * 2; return st * 1024 + (ob ^ (((ob >> 9) & 1) << 5)); }
__host__ __device__ __forceinline__ void stage_rc(int b, int& R, int& C) { const int st = b / 1024, sb = b % 1024, swz = sb ^ (((sb >> 9) & 1) << 5); R = (st >> 1) * 16 + swz / 64; C = (st & 1) * 32 + (swz % 64) / 2; }
__host__ __device__ __forceinline__ int perm32(int rho) { const int n = rho >> 4, i = rho & 15; return 8 * (i >> 2) + 4 * n + (i & 3); }

struct Unit { int pm, pn, z; const char* a; const char* b; const int* gi; int grow; };

struct TileOrder {
    int nM, nN, nwg, G, c;
    __device__ __forceinline__ void init(int nM_, int nN_, int G_, int c_) { nM = nM_; nN = nN_; nwg = nM * nN; G = G_; c = c_; }
    __device__ __forceinline__ bool tile(int i, int& pm, int& pn) const {
        const long L = (long)i * G + c; if (L >= nwg) return false;
        int wgid = (int)L; { const int q = nwg / NXCD, r = nwg % NXCD, xcd = wgid % NXCD, off = wgid / NXCD; wgid = (xcd < r ? xcd * (q + 1) : r * (q + 1) + (xcd - r) * q) + off; }
        const int nig = WGM * nN, gid = wgid / nig, fm = gid * WGM, gsz = (nM - fm) < WGM ? (nM - fm) : WGM;
        pm = fm + ((wgid % nig) % gsz); pn = (wgid % nig) / gsz; return true;
    }
};

__device__ __forceinline__ unsigned cvt_pk_bf16(float lo, float hi) { unsigned r; asm volatile("v_cvt_pk_bf16_f32 %0, %1, %2" : "=v"(r) : "v"(lo), "v"(hi)); return r; }
typedef f32x4 Acc[2][2][4][2];
#ifndef NT_STORE
#define NT_STORE 0
#endif
__device__ __forceinline__ void st16(void* p, const v4u w, bool nostore = false) { if (nostore) return; if (NT_STORE) __builtin_nontemporal_store(w, (v4u*)p); else *(v4u*)p = w; }
#ifndef NT_Y
#define NT_Y 1
#endif

template <class Epi, class Sched, bool ALIGN_EPI, bool GATHER, bool FP8 = false>
__device__ __forceinline__ void gemm_phase(LAS unsigned char* lds, const int wave_idx, const int lda, const int ldb, const int K, const Sched& S, Epi& E) {
    const int lane = lane_id();
    int wid = wave_idx; asm volatile("" : "+s"(wid));
    const int tid = wid * 64 + lane, wr = wid >> 2, wc = wid & 3, fr = lane & 15, fq = lane >> 4;
    const int nt = K / BK;
    unsigned voffA[2], voffB[2];
#pragma unroll
    for (int i = 0; i < 2; ++i) { int R, C; stage_rc(tid * 16 + i * 8192, R, C); const int Rb = (R & ~31) + perm32(R & 31);
        voffA[i] = (unsigned)(R * lda + C) * 2u; voffB[i] = (unsigned)(Rb * ldb + C) * 2u; }
    const size_t kstep = (size_t)(BK * 2);
    const size_t hstepA = (size_t)HALF * lda * 2, hstepB = (size_t)HALF * ldb * 2;
    const unsigned ldsw = (unsigned)wid * 1024u;
    const int aoff = lds_byte(wr * 64 + fr, fq * 8), boff = lds_byte(wc * 32 + fr, fq * 8);
    unsigned vgc[2][2], vgn[2][2];
#define PG8_SA(b, h) (((b) * 2 + (h)) * HTB)
#define PG8_SB(b, h) ((4 + (b) * 2 + (h)) * HTB)
#define PG8_GL(gp, voff, bufoff, _i) __builtin_amdgcn_global_load_lds((const unsigned*)((const char*)(gp) + (voff)), (LAS unsigned*)(lds + (bufoff) + ldsw + (_i) * 8192), 16, 0, 0)
#define PG8_STAGE_B(bufoff, gbase) do { PG8_GL(gbase, voffB[0], bufoff, 0); PG8_GL(gbase, voffB[1], bufoff, 1); } while (0)
#define PG8_STAGE_A(bufoff, gbase, h, VG) do { if constexpr (GATHER) { PG8_GL(gbase, VG[h][0], bufoff, 0); PG8_GL(gbase, VG[h][1], bufoff, 1); } \
        else { PG8_GL((gbase) + (h) * hstepA, voffA[0], bufoff, 0); PG8_GL((gbase) + (h) * hstepA, voffA[1], bufoff, 1); } } while (0)
#define PG8_CAT(x0, x1) __builtin_shufflevector(__builtin_bit_cast(v4i_t, x0), __builtin_bit_cast(v4i_t, x1), 0, 1, 2, 3, 4, 5, 6, 7)
#define PG8_RD(off) (*(const LAS bf16x8*)(lds + (off)))
#define PG8_LDA(dst, b, h) do { if constexpr (FP8) { _Pragma("unroll") for (int m = 0; m < 4; ++m) dst##8[m] = PG8_CAT(PG8_RD(PG8_SA(b, h) + aoff + m * 2048), PG8_RD(PG8_SA(b, h) + aoff + m * 2048 + 1024)); } \
        else { _Pragma("unroll") for (int m = 0; m < 4; ++m) _Pragma("unroll") for (int k = 0; k < 2; ++k) dst[m][k] = PG8_RD(PG8_SA(b, h) + aoff + m * 2048 + k * 1024); } } while (0)
#define PG8_LDB(dst, b, h) do { if constexpr (FP8) { _Pragma("unroll") for (int n = 0; n < 2; ++n) dst##8[n] = PG8_CAT(PG8_RD(PG8_SB(b, h) + boff + n * 2048), PG8_RD(PG8_SB(b, h) + boff + n * 2048 + 1024)); } \
        else { _Pragma("unroll") for (int n = 0; n < 2; ++n) _Pragma("unroll") for (int k = 0; k < 2; ++k) dst[n][k] = PG8_RD(PG8_SB(b, h) + boff + n * 2048 + k * 1024); } } while (0)
#define PG8_MMA(ai, bj, At, Bt) do { __builtin_amdgcn_s_setprio(1); _Pragma("unroll") for (int m = 0; m < 4; ++m) _Pragma("unroll") for (int n = 0; n < 2; ++n) { \
        if constexpr (FP8) asm volatile("v_mfma_scale_f32_16x16x128_f8f6f4 %0, %1, %2, %0, %3, %3 op_sel_hi:[0,0,0]" : "+v"(acc[ai][bj][m][n]) : "v"(Bt##8[n]), "v"(At##8[m]), "v"(sc8)); \
        else { _Pragma("unroll") for (int k = 0; k < 2; ++k) acc[ai][bj][m][n] = __builtin_amdgcn_mfma_f32_16x16x32_bf16(Bt[n][k], At[m][k], acc[ai][bj][m][n], 0, 0, 0); } } __builtin_amdgcn_s_setprio(0); } while (0)
#define PG8_WAIT_V(n) asm volatile("s_waitcnt vmcnt(" #n ")" ::: "memory")
#define PG8_WAIT_L(n) asm volatile("s_waitcnt lgkmcnt(" #n ")" ::: "memory")
#define PG8_BAR __builtin_amdgcn_s_barrier()
#define PG8_SCHED __builtin_amdgcn_sched_barrier(0)
#define PG8_GIDX(VG, U) do { const int _t = wid * 64 + lane_id();   \
        _Pragma("unroll") for (int _i = 0; _i < 2; ++_i) { int _R, _C; stage_rc(_t * 16 + _i * 8192, _R, _C); _Pragma("unroll") for (int _h = 0; _h < 2; ++_h) \
        VG[_h][_i] = (unsigned)((U).grow + (U).gi[_h * HALF + _R]) * (unsigned)(lda * 2) + (unsigned)_C * 2u; } } while (0)
    Unit cur, nxt; int ui = 0;
    if (!S.next(0, cur)) return;
    Acc acc;
#pragma unroll
    for (int a = 0; a < 2; ++a)
#pragma unroll
        for (int b = 0; b < 2; ++b)
#pragma unroll
            for (int m = 0; m < 4; ++m)
#pragma unroll
                for (int n = 0; n < 2; ++n) acc[a][b][m][n] = (f32x4){0.f, 0.f, 0.f, 0.f};
    bf16x8 At[4][2], B0[2][2], B1[2][2];
    v8i_t At8[4], B08[2], B18[2];
    unsigned sc8 = 0x7f7f7f7fu; asm volatile("" : "+v"(sc8));
    const char* cA = cur.a; const char* cB = cur.b;
    if constexpr (GATHER) { PG8_GIDX(vgc, cur); } else { vgc[0][0] = vgc[0][1] = vgc[1][0] = vgc[1][1] = 0u; }
    E.prep(cur, wr, wc, fr, fq);
    PG8_STAGE_B(PG8_SB(0, 0), cB); PG8_STAGE_B(PG8_SB(0, 1), cB + hstepB); PG8_STAGE_A(PG8_SA(0, 0), cA, 0, vgc); PG8_STAGE_A(PG8_SA(0, 1), cA, 1, vgc);
    if (wr == 1) PG8_BAR;
    PG8_WAIT_V(2); PG8_BAR;
    PG8_STAGE_B(PG8_SB(1, 0), cB + kstep); PG8_STAGE_A(PG8_SA(1, 0), cA + kstep, 0, vgc); PG8_STAGE_B(PG8_SB(1, 1), cB + hstepB + kstep);
    PG8_WAIT_V(6); PG8_BAR;
    for (;;) {
        const bool has_next = S.next(ui + 1, nxt);
        const char* nA = has_next ? nxt.a : cA; const char* nB = has_next ? nxt.b : cB;
        if constexpr (GATHER) { if (has_next) { PG8_GIDX(vgn, nxt); } else {
#pragma unroll
            for (int h = 0; h < 2; ++h) { vgn[h][0] = vgc[h][0]; vgn[h][1] = vgc[h][1]; } } }
        else { vgn[0][0] = vgn[0][1] = vgn[1][0] = vgn[1][1] = 0u; }
        for (int t = 0; t < nt; t += 2) {
            const bool last = (t == nt - 2);
            const char* a1 = cA + (size_t)(t + 1) * kstep;
            const char* a2 = last ? nA : cA + (size_t)(t + 2) * kstep; const char* b2 = last ? nB : cB + (size_t)(t + 2) * kstep;
            const char* a3 = a2 + kstep; const char* b3 = b2 + kstep;
            if constexpr (Epi::MIDK) { if (t == (nt >> 1)) E.midk(acc); }
            PG8_LDB(B0, 0, 0); PG8_LDB(B1, 0, 1); PG8_SCHED; PG8_LDA(At, 0, 0); PG8_STAGE_A(PG8_SA(1, 1), a1, 1, vgc);
            if constexpr (GATHER) { if (last) {
#pragma unroll
                for (int h = 0; h < 2; ++h) { vgc[h][0] = vgn[h][0]; vgc[h][1] = vgn[h][1]; } } }
            PG8_WAIT_V(8); PG8_WAIT_L(0); PG8_BAR; PG8_MMA(0, 0, At, B0); PG8_MMA(0, 1, At, B1); PG8_BAR; PG8_SCHED;
            PG8_LDA(At, 0, 1); PG8_STAGE_B(PG8_SB(0, 0), b2); PG8_STAGE_B(PG8_SB(0, 1), b2 + hstepB); PG8_STAGE_A(PG8_SA(0, 0), a2, 0, vgc);
            PG8_WAIT_V(8); PG8_WAIT_L(0); PG8_BAR; PG8_MMA(1, 0, At, B0); PG8_MMA(1, 1, At, B1); PG8_BAR; PG8_SCHED;
            PG8_LDB(B0, 1, 0); PG8_LDB(B1, 1, 1); PG8_SCHED; PG8_LDA(At, 1, 0); PG8_STAGE_A(PG8_SA(0, 1), a2, 1, vgc);
            PG8_WAIT_V(8); PG8_WAIT_L(0); PG8_BAR; PG8_MMA(0, 0, At, B0); PG8_MMA(0, 1, At, B1); PG8_BAR; PG8_SCHED;
            PG8_LDA(At, 1, 1); PG8_STAGE_B(PG8_SB(1, 0), b3); PG8_STAGE_B(PG8_SB(1, 1), b3 + hstepB); PG8_STAGE_A(PG8_SA(1, 0), a3, 0, vgc);
            PG8_WAIT_V(8); PG8_WAIT_L(0); PG8_BAR; PG8_MMA(1, 0, At, B0); PG8_MMA(1, 1, At, B1); PG8_BAR; PG8_SCHED;
        }
        if constexpr (ALIGN_EPI) { if (wr == 0) PG8_BAR; }
        if constexpr (FP8) asm volatile("s_nop 15\n\ts_nop 15\n\ts_nop 15\n\ts_nop 15" ::: "memory");
        E(acc, cur, wr, wc, fr, fq);
        if (!has_next) break;
#pragma unroll
        for (int a = 0; a < 2; ++a)
#pragma unroll
            for (int b = 0; b < 2; ++b)
#pragma unroll
                for (int m = 0; m < 4; ++m)
#pragma unroll
                    for (int n = 0; n < 2; ++n) acc[a][b][m][n] = (f32x4){0.f, 0.f, 0.f, 0.f};
        cur = nxt; cA = nA; cB = nB; ++ui;
#pragma unroll
        for (int h = 0; h < 2; ++h) { vgc[h][0] = vgn[h][0]; vgc[h][1] = vgn[h][1]; }
        E.prep(cur, wr, wc, fr, fq);
        if constexpr (ALIGN_EPI) { if (wr == 1) PG8_BAR; }
    }
    PG8_WAIT_V(0);
    if constexpr (!ALIGN_EPI) { if (wr == 0) PG8_BAR; }
    PG8_BAR;
#undef PG8_SA
#undef PG8_SB
#undef PG8_GL
#undef PG8_STAGE_A
#undef PG8_STAGE_B
#undef PG8_LDA
#undef PG8_RD
#undef PG8_LDB
#undef PG8_MMA
#undef PG8_CAT
#undef PG8_WAIT_V
#undef PG8_WAIT_L
#undef PG8_SCHED
#undef PG8_GIDX
}

#define EPI_ROWS for (int ai = 0; ai < 2; ++ai) _Pragma("unroll") for (int m = 0; m < 4; ++m)
__device__ __forceinline__ v4u pack8(const f32x4 a, const f32x4 b) { v4u w; w.x = cvt_pk_bf16(a[0], a[1]); w.y = cvt_pk_bf16(a[2], a[3]); w.z = cvt_pk_bf16(b[0], b[1]); w.w = cvt_pk_bf16(b[2], b[3]); return w; }

template <int mode, bool OUT8 = false>
struct EpiStore {
    static constexpr bool MIDK = false;
    bf16* O; int ldc; const float* cs; float scale; bool skip = false;
    __device__ __forceinline__ void prep(const Unit&, int, int, int, int) {}
    __device__ __forceinline__ void midk(Acc&) {}
    __device__ __forceinline__ void operator()(const Acc& acc, const Unit& u, int wr, int wc, int fr, int fq) const {
        asm volatile("" : "+v"(fr), "+v"(fq));
        if (skip) return;
        size_t base; const float* csp = cs;
        if constexpr (mode == 0) base = (size_t)u.pm * 256 * ldc + (size_t)u.pn * 256;
        else if constexpr (mode == 1) { const int lb = u.pm >> 2, h = u.pm & 3; base = (size_t)lb * D * D + (size_t)(h * 256) * D + u.pn * 256; csp = cs + (size_t)(lb >> 2) * D + u.pn * 256; }
        else if constexpr (mode == 2) { const int pml = u.pm & 3, lbh = u.pm >> 2, h = lbh & 3, lb = lbh >> 2; base = (size_t)lb * D * D + (size_t)(pml * 256) * D + h * 256; }
        else { const int l = u.pm >> 2, pml = u.pm & 3; base = (size_t)l * NMEM * 2 * D + (size_t)(pml * 256) * 2 * D + u.pn * 256; }
        const int cb = wc * 32 + 8 * fq;
        f32x4 c0[2], c1[2];
#pragma unroll
        for (int bj = 0; bj < 2; ++bj) { if (csp) { c0[bj] = *(const f32x4*)(csp + bj * HALF + cb) * scale; c1[bj] = *(const f32x4*)(csp + bj * HALF + cb + 4) * scale; } else { c0[bj] = (f32x4){scale, scale, scale, scale}; c1[bj] = c0[bj]; } }
#pragma unroll
        EPI_ROWS { bf16* rowp = O + base + (size_t)(ai * HALF + wr * 64 + m * 16 + fr) * ldc + cb;
            if constexpr (OUT8) { unsigned char* rp8 = (unsigned char*)O + base + (size_t)(ai * HALF + wr * 64 + m * 16 + fr) * ldc + cb;
#pragma unroll
                for (int bj = 0; bj < 2; ++bj) { const f32x4 a = acc[ai][bj][m][0] * c0[bj], b = acc[ai][bj][m][1] * c1[bj]; v2u o; o.x = pk4_fp8(a[0], a[1], a[2], a[3]); o.y = pk4_fp8(b[0], b[1], b[2], b[3]); *(v2u*)(rp8 + bj * HALF) = o; } }
            else
#pragma unroll
            for (int bj = 0; bj < 2; ++bj) { const v4u w_ = pack8(acc[ai][bj][m][0] * c0[bj], acc[ai][bj][m][1] * c1[bj]); if constexpr (mode == 0 && NT_Y) __builtin_nontemporal_store(w_, (v4u*)(rowp + bj * HALF)); else *(v4u*)(rowp + bj * HALF) = w_; } }
    }
};
struct EpiH {
    static constexpr bool MIDK = false;
    unsigned char* H;
    __device__ __forceinline__ void prep(const Unit&, int, int, int, int) {}
    __device__ __forceinline__ void midk(Acc&) {}
    __device__ __forceinline__ void operator()(const Acc& acc, const Unit& u, int wr, int wc, int fr, int fq) const {
        asm volatile("" : "+v"(fr), "+v"(fq));
        const int cb = u.pn * 128 + wc * 32 + 8 * fq; constexpr float us = 1.0f / (W8S * A8S);
#pragma unroll
        EPI_ROWS { const int rl = ai * HALF + wr * 64 + m * 16 + fr; unsigned char* rowp = H + (size_t)(u.pm * 256 + rl) * FF + cb;
            const f32x4 h0 = silu_mul4(acc[ai][0][m][0], acc[ai][1][m][0], us, H8S), h1 = silu_mul4(acc[ai][0][m][1], acc[ai][1][m][1], us, H8S);
            v2u o; o.x = pk4_fp8(h0[0], h0[1], h0[2], h0[3]); o.y = pk4_fp8(h1[0], h1[1], h1[2], h1[3]); *(v2u*)rowp = o; }
    }
};
struct EpiY8 {
    static constexpr bool MIDK = false;
    unsigned char* Y; float scale; bool skip = false;
    __device__ __forceinline__ void prep(const Unit&, int, int, int, int) {}
    __device__ __forceinline__ void midk(Acc&) {}
    __device__ __forceinline__ void operator()(const Acc& acc, const Unit& u, int wr, int wc, int fr, int fq) const {
        if (skip) return;
        asm volatile("" : "+v"(fr), "+v"(fq));
        const int cb = u.pn * 256 + wc * 32 + 8 * fq;
#pragma unroll
        EPI_ROWS { unsigned char* rowp = Y + (size_t)(u.pm * 256 + ai * HALF + wr * 64 + m * 16 + fr) * D + cb;
#pragma unroll
            for (int bj = 0; bj < 2; ++bj) { const f32x4 a = acc[ai][bj][m][0] * scale, b = acc[ai][bj][m][1] * scale;
                v2u o; o.x = pk4_fp8(a[0], a[1], a[2], a[3]); o.y = pk4_fp8(b[0], b[1], b[2], b[3]); __builtin_nontemporal_store(o, (v2u*)(rowp + bj * HALF)); } }
    }
};
template <bool MK, bool WRITE_XB>
struct EpiX {
    static constexpr bool MIDK = MK;
    bf16* xr; float* xstat; const float* gmstat; const float* atstat; LAS unsigned char* lds; unsigned char* xa8; float scale;
    int wr_, wc_, fr_;
    __device__ __forceinline__ void prep(const Unit& u, int wr, int wc, int fr, int fq) {
        wr_ = wr; wc_ = wc; fr_ = fr;
        if constexpr (MK) {
            asm volatile("" : "+v"(fr), "+v"(fq));
            LAS f32x2* X = (LAS f32x2*)(lds + RING_BYTES + 1024) + (wr * 4 + wc) * 128;
#pragma unroll
            EPI_ROWS { const size_t row = (size_t)u.pm * 256 + ai * HALF + wr * 64 + m * 16 + fr;
                const f32x4 g = *(const f32x4*)(gmstat + row * 4), a0 = *(const f32x4*)(atstat + row * 8), a1 = *(const f32x4*)(atstat + row * 8 + 4);
                const float sg = (g[0] + g[1]) + (g[2] + g[3]), sa = ((a0[0] + a0[1]) + (a0[2] + a0[3])) + ((a1[0] + a1[1]) + (a1[2] + a1[3]));
                const float rgm = __builtin_amdgcn_rsqf(sg * (1.0f / 512.0f) + EPS), rat = __builtin_amdgcn_rsqf(sa * (1.0f / 512.0f) + EPS);
                if (fq == 0) X[(ai * 4 + m) * 16 + fr] = (f32x2){rgm / rat, rat}; }
            asm volatile("s_waitcnt lgkmcnt(0)" ::: "memory");
        }
    }
    __device__ __forceinline__ void midk(Acc& acc) {
        int fr = fr_; asm volatile("" : "+v"(fr));
        const LAS f32x2* X = (const LAS f32x2*)(lds + RING_BYTES + 1024) + (wr_ * 4 + wc_) * 128;
#pragma unroll
        EPI_ROWS { const float f = X[(ai * 4 + m) * 16 + fr].x;
#pragma unroll
            for (int bj = 0; bj < 2; ++bj) { acc[ai][bj][m][0] *= f; acc[ai][bj][m][1] *= f; } }
    }
    __device__ __forceinline__ void operator()(const Acc& acc, const Unit& u, int wr, int wc, int fr, int fq) const {
        asm volatile("" : "+v"(fr), "+v"(fq));
        const int cb = u.pn * 256 + wc * 32 + 8 * fq;
#pragma unroll
        EPI_ROWS { const size_t row = (size_t)u.pm * 256 + ai * HALF + wr * 64 + m * 16 + fr; const size_t off = row * D + cb;
            float f = scale; if constexpr (MK) f = ((const LAS f32x2*)(lds + RING_BYTES + 1024) + (wr * 4 + wc) * 128)[(ai * 4 + m) * 16 + fr].y; float ss = 0.f;
#pragma unroll
            for (int bj = 0; bj < 2; ++bj) { const v4u b = *(const v4u*)(xr + off + bj * HALF);
                const f32x4 x0 = (f32x4){bflo(b.x), bfhi(b.x), bflo(b.y), bfhi(b.y)} + acc[ai][bj][m][0] * f, x1 = (f32x4){bflo(b.z), bfhi(b.z), bflo(b.w), bfhi(b.w)} + acc[ai][bj][m][1] * f;
                *(v4u*)(xr + off + bj * HALF) = pack8(x0, x1);
                if constexpr (WRITE_XB) { v2u o8; o8.x = pk4_fp8(x0[0] * A8S, x0[1] * A8S, x0[2] * A8S, x0[3] * A8S); o8.y = pk4_fp8(x1[0] * A8S, x1[1] * A8S, x1[2] * A8S, x1[3] * A8S); *(v2u*)(xa8 + off + bj * HALF) = o8; }
                if constexpr (WRITE_XB) ss += ((x0[0] * x0[0] + x0[1] * x0[1]) + (x0[2] * x0[2] + x0[3] * x0[3])) + ((x1[0] * x1[0] + x1[1] * x1[1]) + (x1[2] * x1[2] + x1[3] * x1[3])); }
            if constexpr (WRITE_XB) { ss = add_x32(add_x16(ss)); if (fq == 0) xstat[row * 16 + u.pn * 4 + wc] = ss; }
            if (m & 1) asm volatile("" ::: "memory"); }
    }
};
constexpr int EXCH_OFF = RING_BYTES + 1024;
struct EpiS {
    static constexpr bool MIDK = false;
    const float* xstat; unsigned char* P; LAS unsigned char* lds;
    __device__ __forceinline__ void prep(const Unit&, int, int, int, int) {}
    __device__ __forceinline__ void midk(Acc&) {}
    __device__ __forceinline__ void operator()(Acc& acc, const Unit& u, int wr, int wc, int fr, int fq) const {
        asm volatile("" : "+v"(fr), "+v"(fq));
        LAS f32x2* X = (LAS f32x2*)(lds + EXCH_OFF);
        float mw[2][4];
#pragma unroll
        EPI_ROWS { const int rl = ai * HALF + wr * 64 + m * 16 + fr; const size_t row = (size_t)u.pm * 256 + rl;
            const f32x4 s0 = *(const f32x4*)(xstat + row * 16), s1 = *(const f32x4*)(xstat + row * 16 + 4), s2 = *(const f32x4*)(xstat + row * 16 + 8), s3 = *(const f32x4*)(xstat + row * 16 + 12);
            const float ssq = (((s0[0] + s0[1]) + (s0[2] + s0[3])) + ((s1[0] + s1[1]) + (s1[2] + s1[3]))) + (((s2[0] + s2[1]) + (s2[2] + s2[3])) + ((s3[0] + s3[1]) + (s3[2] + s3[3])));
            const float rinv = __builtin_amdgcn_rsqf(ssq * (1.0f / D) + EPS) * (1.0f / (A8S * Q8S));
            float mx = -3.0e38f;
#pragma unroll
            for (int bj = 0; bj < 2; ++bj)
#pragma unroll
                for (int n = 0; n < 2; ++n) { acc[ai][bj][m][n] *= rinv; const f32x4 v = acc[ai][bj][m][n]; mx = fmaxf(mx, fmaxf(fmaxf(v[0], v[1]), fmaxf(v[2], v[3]))); }
            mx = max_x32(max_x16(mx));
            float sm = 0.f;
#pragma unroll
            for (int bj = 0; bj < 2; ++bj)
#pragma unroll
                for (int n = 0; n < 2; ++n) { f32x4 v = acc[ai][bj][m][n];
#pragma unroll
                    for (int i = 0; i < 4; ++i) { v[i] = __builtin_amdgcn_exp2f(v[i] - mx); sm += v[i]; }
                    acc[ai][bj][m][n] = v; }
            sm = add_x32(add_x16(sm));
            mw[ai][m] = mx;
            if (fq == 0) X[rl * 4 + wc] = (f32x2){mx, sm};
            if (m & 1) asm volatile("" ::: "memory"); }
        asm volatile("s_waitcnt lgkmcnt(0)\n\ts_barrier" ::: "memory");
        const int cb = u.pn * 256 + wc * 32 + 8 * fq;
#pragma unroll
        EPI_ROWS { const int rl = ai * HALF + wr * 64 + m * 16 + fr; const size_t row = (size_t)u.pm * 256 + rl;
            const f32x2 e0 = X[rl * 4 + 0], e1 = X[rl * 4 + 1], e2 = X[rl * 4 + 2], e3 = X[rl * 4 + 3];
            const float M = fmaxf(fmaxf(e0.x, e1.x), fmaxf(e2.x, e3.x));
            const float den = (e0.y * __builtin_amdgcn_exp2f(e0.x - M) + e1.y * __builtin_amdgcn_exp2f(e1.x - M)) + (e2.y * __builtin_amdgcn_exp2f(e2.x - M) + e3.y * __builtin_amdgcn_exp2f(e3.x - M));
            const float f = __builtin_amdgcn_exp2f(mw[ai][m] - M) * __builtin_amdgcn_rcpf(den) * P8S;
#pragma unroll
            for (int bj = 0; bj < 2; ++bj) { const f32x4 a = acc[ai][bj][m][0] * f, b = acc[ai][bj][m][1] * f; v2u o; o.x = pk4_fp8(a[0], a[1], a[2], a[3]); o.y = pk4_fp8(b[0], b[1], b[2], b[3]); *(v2u*)(P + row * D + cb + bj * HALF) = o; } }
        asm volatile("s_waitcnt lgkmcnt(0)" ::: "memory");
    }
};
struct EpiIn {
    static constexpr bool MIDK = false;
    bf16 *uact, *vact, *q, *k, *v; float* vstat; const float *qg, *kg, *cosT, *sinT, *rinv; bool nostore = false, skip = false;
    __device__ __forceinline__ void prep(const Unit&, int, int, int, int) {}
    __device__ __forceinline__ void midk(Acc&) {}
    __device__ __forceinline__ void operator()(const Acc& acc, const Unit& u, int wr, int wc, int fr, int fq) const {
        asm volatile("" : "+v"(fr), "+v"(fq));
        if (skip) return;
        const int pn = u.pn;
        if (pn < 4) {
            bf16* O = pn < 2 ? uact : vact; const int cb = (pn & 1) * 256 + wc * 32 + 8 * fq;
#pragma unroll
            EPI_ROWS { const size_t row = (size_t)u.pm * 256 + ai * HALF + wr * 64 + m * 16 + fr; float ss = 0.f; const float ri = rinv[row];
#pragma unroll
                for (int bj = 0; bj < 2; ++bj) { const f32x4 g0 = gelu4(acc[ai][bj][m][0] * ri), g1 = gelu4(acc[ai][bj][m][1] * ri);
                    const v4u w = pack8(g0, g1); st16(O + row * GMW + cb + bj * HALF, w, nostore);
                    if (pn >= 2) { const float a0 = bflo(w.x), a1 = bfhi(w.x), a2 = bflo(w.y), a3 = bfhi(w.y), a4 = bflo(w.z), a5 = bfhi(w.z), a6 = bflo(w.w), a7 = bfhi(w.w);
                        ss += ((a0 * a0 + a1 * a1) + (a2 * a2 + a3 * a3)) + ((a4 * a4 + a5 * a5) + (a6 * a6 + a7 * a7)); } }
                if (pn >= 2) { ss = add_x32(add_x16(ss)); if (fq == 0) vstat[row * 8 + (pn - 2) * 4 + wc] = ss; } }
        } else if (pn == 6 && wc >= 2) {
#pragma unroll
            EPI_ROWS { const size_t row = (size_t)u.pm * 256 + ai * HALF + wr * 64 + m * 16 + fr; const float ri = rinv[row];
#pragma unroll
                for (int bj = 0; bj < 2; ++bj) st16(v + row * 128 + (wc - 2) * 64 + bj * 32 + 8 * fq, pack8(acc[ai][bj][m][0] * ri, acc[ai][bj][m][1] * ri), nostore); }
        } else {
            const bool isq = pn < 6; const float* g = isq ? qg : kg; const float sc = isq ? QSCALE : 1.0f;
            bf16* O = isq ? q + ((pn - 4) * 4 + wc) * 64 : k + wc * 64; const int ldo = isq ? 512 : 128;
            f32x4 gv[2][2];
#pragma unroll
            for (int bj = 0; bj < 2; ++bj) { gv[bj][0] = *(const f32x4*)(g + bj * 32 + 8 * fq) * sc; gv[bj][1] = *(const f32x4*)(g + bj * 32 + 8 * fq + 4) * sc; }
#pragma unroll
            EPI_ROWS { const size_t row = (size_t)u.pm * 256 + ai * HALF + wr * 64 + m * 16 + fr; const int t = (int)(row % SEQ); const float ri = this->rinv[row];
                float ss = 0.f;
#pragma unroll
                for (int bj = 0; bj < 2; ++bj)
#pragma unroll
                    for (int n = 0; n < 2; ++n) { const f32x4 x = acc[ai][bj][m][n]; ss += (x[0] * x[0] + x[1] * x[1]) + (x[2] * x[2] + x[3] * x[3]); }
                ss = add_x32(add_x16(ss));
                const float rinv = ri * __builtin_amdgcn_rsqf(ss * (ri * ri) * (1.0f / 64.0f) + EPS);
#pragma unroll
                for (int bj = 0; bj < 2; ++bj) { const f32x4 c = *(const f32x4*)(cosT + t * 32 + bj * 16 + 4 * fq), sn = *(const f32x4*)(sinT + t * 32 + bj * 16 + 4 * fq);
                    const f32x4 x0 = acc[ai][bj][m][0] * gv[bj][0] * rinv, x1 = acc[ai][bj][m][1] * gv[bj][1] * rinv; f32x4 o0, o1;
                    o0[0] = x0[0] * c[0] - x0[1] * sn[0]; o0[1] = x0[0] * sn[0] + x0[1] * c[0]; o0[2] = x0[2] * c[1] - x0[3] * sn[1]; o0[3] = x0[2] * sn[1] + x0[3] * c[1];
                    o1[0] = x1[0] * c[2] - x1[1] * sn[2]; o1[1] = x1[0] * sn[2] + x1[1] * c[2]; o1[2] = x1[2] * c[3] - x1[3] * sn[3]; o1[3] = x1[2] * sn[3] + x1[3] * c[3];
                    st16(O + row * ldo + bj * 32 + 8 * fq, pack8(o0, o1), nostore); }
                if (m & 1) asm volatile("" ::: "memory"); }
        }
    }
};
}


struct CvtJob { const float* W; const float* gain; bf16* WT; int K, N, dst_row0, k0, n0; bool f8; };
__device__ __forceinline__ CvtJob cvt_decode(const Frame& F, int it) {
    constexpr int I_IN = 16 * 56, I_SQ = 512, I_KV = 1024, I_HEAD = I_IN + I_SQ + I_KV + I_SQ, I_LAYER = I_HEAD + NE * 3 * I_SQ;
    CvtJob j; j.f8 = false; const int l = it / I_LAYER; int r = it % I_LAYER;
    if (r < I_IN) { const int kb = r / 56, nb = r % 56, n0 = nb * 32, pn = n0 >> 8; int dr = n0;
        if (pn >= 4) { const int sidx = n0 & 255, w = sidx >> 6, bj = (sidx >> 5) & 1; dr = pn * 256 + 128 * bj + 32 * w; }
        j.W = F.in[3] + (size_t)l * D * INW; j.gain = F.in[2] + (size_t)l * D; j.WT = (bf16*)(F.ws + WS_WIN) + (size_t)l * INW * D; j.K = D; j.N = INW; j.dst_row0 = dr; j.k0 = kb * 64; j.n0 = n0; return j; }
    r -= I_IN;
    if (r < I_SQ) { j.W = F.in[10] + (size_t)l * D * D; j.gain = F.in[9] + (size_t)l * D; j.WT = (bf16*)(F.ws + WS_WOUT) + (size_t)l * D * D; j.K = D; j.N = D; j.dst_row0 = (r % 32) * 32; j.k0 = (r / 32) * 64; j.n0 = (r % 32) * 32; return j; }
    r -= I_SQ;
    if (r < I_KV) { j.W = F.in[14] + (size_t)l * D * 2 * D; j.gain = nullptr; j.WT = (bf16*)(F.ws + WS_WKVT) + (size_t)l * 2 * D * D; j.K = D; j.N = 2 * D; j.dst_row0 = (r % 64) * 32; j.k0 = (r / 64) * 64; j.n0 = (r % 64) * 32; return j; }
    r -= I_KV;
    if (r < I_SQ) { j.W = F.in[15] + (size_t)l * D * D; j.gain = nullptr; j.WT = (bf16*)(F.ws + WS_WOT) + (size_t)l * D * D; j.K = D; j.N = D; j.dst_row0 = (r % 32) * 32; j.k0 = (r / 32) * 64; j.n0 = (r % 32) * 32; return j; }
    r -= I_SQ;
    const int e = r / (3 * I_SQ), rr = r % (3 * I_SQ), which = rr / I_SQ, sub = rr % I_SQ, kb = sub / 32, n0 = (sub % 32) * 32;
    const size_t mo = ((size_t)l * NE + e) * D * FF;
    j.K = D; j.N = FF; j.k0 = kb * 64; j.n0 = n0;
    j.f8 = true;
    if (which == 2) { j.W = F.in[20] + mo; j.gain = nullptr; j.WT = (bf16*)(F.ws + WS_WD + mo); j.dst_row0 = n0; }
    else { j.W = (which == 0 ? F.in[18] : F.in[19]) + mo; j.gain = F.in[16] + (size_t)l * D; j.WT = (bf16*)(F.ws + WS_WGU + 2 * mo); j.dst_row0 = 256 * (n0 >> 7) + 128 * which + (n0 & 127); }
    return j;
}
#define CVT_LOAD(J, R) do { const float* p_ = (J).W + (size_t)((J).k0 + (lane_ >> 5)) * (J).N + (J).n0 + (lane_ & 31); _Pragma("unroll") for (int i_ = 0; i_ < 32; ++i_) R[i_] = p_[(size_t)(2 * i_) * (J).N]; } while (0)
__device__ __forceinline__ void ph_convert(Frame& F) {
    int lane_ = lane_id(); asm volatile("" : "+v"(lane_)); const int tid_ = F.wave * 64 + lane_;
    LAS float* scr = (LAS float*)(F.lds + F.wave * 16384);
    const int gw = F.vcu * NWAVES + F.wave, NGW = F.G * NWAVES;
    constexpr int I_LAYER = 16 * 56 + 512 + 1024 + 512 + NE * 3 * 512, NITEMS = NL * I_LAYER;
    if (gw < NITEMS) {
        int it = gw; CvtJob cur = cvt_decode(F, it); float r[32]; CVT_LOAD(cur, r);
        for (;;) {
            const int nit = it + NGW; const bool hn = nit < NITEMS; CvtJob nx = cur; if (hn) nx = cvt_decode(F, nit);
#pragma unroll
            for (int i = 0; i < 32; ++i) scr[(2 * i + (lane_ >> 5)) * 33 + (lane_ & 31)] = r[i];
            if (hn) CVT_LOAD(nx, r);
            asm volatile("s_waitcnt lgkmcnt(0)" ::: "memory");
            const int c = lane_ & 7;
            f32x4 g0 = (f32x4){1.f, 1.f, 1.f, 1.f}, g1 = g0;
            if (cur.gain) { g0 = *(const f32x4*)(cur.gain + cur.k0 + 8 * c); g1 = *(const f32x4*)(cur.gain + cur.k0 + 8 * c + 4); }
#pragma unroll
            for (int j = 0; j < 4; ++j) { const int n = (lane_ >> 3) + 8 * j; const LAS float* sp = scr + (8 * c) * 33 + n;
                if (cur.f8) { v2u o; o.x = pk4_fp8(sp[0 * 33] * g0[0] * W8S, sp[1 * 33] * g0[1] * W8S, sp[2 * 33] * g0[2] * W8S, sp[3 * 33] * g0[3] * W8S); o.y = pk4_fp8(sp[4 * 33] * g1[0] * W8S, sp[5 * 33] * g1[1] * W8S, sp[6 * 33] * g1[2] * W8S, sp[7 * 33] * g1[3] * W8S);
                    *(v2u*)((unsigned char*)cur.WT + (size_t)(cur.dst_row0 + n) * cur.K + cur.k0 + 8 * c) = o; }
                else { v4u o; o.x = pk2(sp[0 * 33] * g0[0], sp[1 * 33] * g0[1]); o.y = pk2(sp[2 * 33] * g0[2], sp[3 * 33] * g0[3]); o.z = pk2(sp[4 * 33] * g1[0], sp[5 * 33] * g1[1]); o.w = pk2(sp[6 * 33] * g1[2], sp[7 * 33] * g1[3]);
                    *(v4u*)(cur.WT + (size_t)(cur.dst_row0 + n) * cur.K + cur.k0 + 8 * c) = o; } }
            asm volatile("s_waitcnt lgkmcnt(0)" ::: "memory");
            if (!hn) break; cur = nx; it = nit;
        }
    }
    {   const float* wsrc = F.in[5]; bf16* WSBd = (bf16*)(F.ws + WS_WSB);
        for (int i = F.vcu * NTHR + tid_; i < NL * 4 * 128 * 128 / 8; i += F.G * NTHR) { const f32x4 a = *(const f32x4*)(wsrc + (size_t)i * 8), b = *(const f32x4*)(wsrc + (size_t)i * 8 + 4);
            v4u o; o.x = pk2(a.x, a.y); o.y = pk2(a.z, a.w); o.z = pk2(b.x, b.y); o.w = pk2(b.z, b.w); *(v4u*)(WSBd + (size_t)i * 8) = o; } }
    {   bf16* WRH = (bf16*)(F.ws + WS_WRH); bf16* WRL = (bf16*)(F.ws + WS_WRL);
        for (int i = F.vcu * NTHR + tid_; i < NL * NE * D; i += F.G * NTHR) { const int l = i / (NE * D), e = (i / D) % NE, c = i % D;
            const float w = F.in[17][((size_t)l * D + c) * NE + e] * F.in[16][(size_t)l * D + c]; const unsigned h = f2bf(w); WRH[i] = (bf16)h; WRL[i] = (bf16)f2bf(w - bf2f(h)); } }
    const int gt = F.vcu * NTHR + tid_, NGT = F.G * NTHR;
    const float* wq = F.in[13]; bf16* WQB = (bf16*)(F.ws + WS_WQB);
    for (int i = gt; i < NL * D * D / 8; i += NGT) { const f32x4 a = *(const f32x4*)(wq + (size_t)i * 8), b = *(const f32x4*)(wq + (size_t)i * 8 + 4);
        v4u o; o.x = pk2(a.x, a.y); o.y = pk2(a.z, a.w); o.z = pk2(b.x, b.y); o.w = pk2(b.z, b.w); *(v4u*)(WQB + (size_t)i * 8) = o; }
}

struct SchedDense {
    pg8::TileOrder o; const char* A; size_t a_tile; const char* B; size_t b_tile, b_batch; int bdiv, bmod;
    __device__ __forceinline__ bool next(int i, pg8::Unit& u) const { if (!o.tile(i, u.pm, u.pn)) return false;
        u.z = 0; u.gi = nullptr; u.grow = 0; u.a = A + (size_t)u.pm * a_tile; u.b = B + (size_t)((u.pm / bdiv) % bmod) * b_batch + (size_t)u.pn * b_tile; return true; }
};
struct SchedE1 {
    pg8::TileOrder o; const char* HBp; const int* IDX; const char* WGU;
    __device__ __forceinline__ bool next(int i, pg8::Unit& u) const { if (!o.tile(i, u.pm, u.pn)) return false;
        const int z = u.pm >> 2; u.z = z; u.gi = IDX + (size_t)u.pm * 256; u.grow = (z >> 4) * SEQ; u.a = HBp;
        u.b = WGU + (size_t)(z & 15) * (2 * FF * D) + (size_t)u.pn * (256 * D); return true; }
};
struct SchedKV { pg8::TileOrder o; const char* MEMN; const char* WKVT;
    __device__ __forceinline__ bool next(int i, pg8::Unit& u) const { if (!o.tile(i, u.pm, u.pn)) return false; u.z = 0; u.gi = nullptr; u.grow = 0;
        u.a = MEMN + (size_t)(u.pm & 3) * (256 * D * 2); u.b = WKVT + (size_t)(u.pm >> 2) * (2 * D * D * 2) + (size_t)u.pn * (256 * D * 2); return true; } };
struct SchedQK { pg8::TileOrder o; const char* KVM; const char* WQB;
    __device__ __forceinline__ bool next(int i, pg8::Unit& u) const { if (!o.tile(i, u.pm, u.pn)) return false; u.z = 0; u.gi = nullptr; u.grow = 0;
        const int h = u.pm & 3, lb = u.pm >> 2, b = lb & 3, l = lb >> 2;
        u.a = KVM + ((size_t)l * NMEM * 2 * D + (size_t)(b * 256) * 2 * D + h * 256) * 2; u.b = WQB + ((size_t)l * D * D + (size_t)u.pn * 256 * D + h * 256) * 2; return true; } };
struct SchedVO { pg8::TileOrder o; const char* KVM; const char* WOT;
    __device__ __forceinline__ bool next(int i, pg8::Unit& u) const { if (!o.tile(i, u.pm, u.pn)) return false; u.z = 0; u.gi = nullptr; u.grow = 0;
        const int pml = u.pm & 3, lbh = u.pm >> 2, h = lbh & 3, lb = lbh >> 2, b = lb & 3, l = lb >> 2;
        u.a = WOT + ((size_t)l * D * D + (size_t)pml * 256 * D + h * 256) * 2; u.b = KVM + ((size_t)l * NMEM * 2 * D + (size_t)(b * 256) * 2 * D + D + h * 256) * 2; return true; } };

namespace attn_body {
using bf16=__hip_bfloat16;
using bf16x8=__attribute__((ext_vector_type(8)))short;
using s16x4=__attribute__((ext_vector_type(4)))short;
using f32x16=__attribute__((ext_vector_type(16)))float;
using u32x4=__attribute__((ext_vector_type(4)))unsigned;
constexpr int SEQ=8192,D=64,QP=512,KP=128,OP=1024;
constexpr int NW=8,QBLK=32,QB=QBLK*NW,KVBLK=64,NQB=SEQ/QB;
constexpr int ATTN_UNIT_ROWS=QB;
__device__ __forceinline__ int crow(int r,int hi){return (r&3)+8*(r>>2)+4*hi;}
#define SBAR() __builtin_amdgcn_sched_barrier(0)
__device__ __forceinline__ void cmask(f32x16&p0,f32x16&p1,int jb,int qrel,int hi){
  const float NEG=-INFINITY; int kb=64*jb+4*hi;
  #pragma unroll
  for(int r=0;r<16;++r){int kv=kb+(r&3)+8*(r>>2); if(kv>qrel)p0[r]=NEG; if(kv+32>qrel)p1[r]=NEG;}
}

constexpr int NSLOT=3, SLOTB=8192;
constexpr int LDS_K=0, LDS_V=NSLOT*SLOTB, LDS_WS=2*NSLOT*SLOTB, LDS_OST=LDS_WS+NW*64*4, LDS_BYTES=LDS_OST+NW*4096;
constexpr float C2=0.125f*1.4426950408889634f;
__device__ __forceinline__ void glds16(const void*gsrc,unsigned lds_dst){unsigned keep;
  asm volatile("s_mov_b32 %0, m0\n\ts_mov_b32 m0, %2\n\ts_nop 0\n\tglobal_load_lds_dwordx4 %1, off\n\ts_mov_b32 m0, %0":"=&s"(keep):"v"(gsrc),"s"(lds_dst):"memory");}
__device__ __forceinline__ float max3f(float a,float b,float c){float r;asm("v_max3_f32 %0, %1, %2, %3":"=v"(r):"v"(a),"v"(b),"v"(c));return r;}
__device__ __forceinline__ float max2f(float a,float b){float r;asm("v_max_f32_e32 %0, %1, %2":"=v"(r):"v"(a),"v"(b));return r;}
__device__ __forceinline__ float fadd_s(float a,float b){float r;asm("v_add_f32_e32 %0, %1, %2":"=v"(r):"v"(a),"v"(b));return r;}
__device__ __forceinline__ float fsub_s(float a,float b){float r;asm("v_sub_f32_e32 %0, %1, %2":"=v"(r):"v"(a),"v"(b));return r;}
typedef float f32x2_t __attribute__((ext_vector_type(2))); typedef __bf16 bf16x2_t __attribute__((ext_vector_type(2)));
__device__ __forceinline__ unsigned cvtpk_s(float lo,float hi){f32x2_t v={lo,hi};bf16x2_t b=__builtin_convertvector(v,bf16x2_t);return __builtin_bit_cast(unsigned,b);}
#define WAIT_BAR(N) asm volatile("s_waitcnt vmcnt(" #N ") lgkmcnt(0)\n\ts_barrier":::"memory")

__device__ __forceinline__ void qkt(f32x16&p0,f32x16&p1,const char*Kslot,const bf16x8*qr,const f32x16&negm,int r32,int hi){
  const char*kb=Kslot+hi*1024+r32*16;
  #pragma unroll
  for(int d0=0;d0<4;++d0){
    const bf16x8 b0=*reinterpret_cast<const bf16x8*>(kb+d0*2048);
    const bf16x8 b1=*reinterpret_cast<const bf16x8*>(kb+d0*2048+512);
    if(d0==0){p0=__builtin_amdgcn_mfma_f32_32x32x16_bf16(b0,qr[0],negm,0,0,0);p1=__builtin_amdgcn_mfma_f32_32x32x16_bf16(b1,qr[0],negm,0,0,0);}
    else{p0=__builtin_amdgcn_mfma_f32_32x32x16_bf16(b0,qr[d0],p0,0,0,0);p1=__builtin_amdgcn_mfma_f32_32x32x16_bf16(b1,qr[d0],p1,0,0,0);}}
}
typedef __attribute__((address_space(3))) const char* lds_cptr;
typedef short v4i16_t __attribute__((ext_vector_type(4)));
__device__ __forceinline__ void kload8(bf16x8*kf,lds_cptr kp){
  kf[0]=*(const __attribute__((address_space(3))) bf16x8*)(kp);      kf[1]=*(const __attribute__((address_space(3))) bf16x8*)(kp+512);
  kf[2]=*(const __attribute__((address_space(3))) bf16x8*)(kp+2048); kf[3]=*(const __attribute__((address_space(3))) bf16x8*)(kp+2560);
  kf[4]=*(const __attribute__((address_space(3))) bf16x8*)(kp+4096); kf[5]=*(const __attribute__((address_space(3))) bf16x8*)(kp+4608);
  kf[6]=*(const __attribute__((address_space(3))) bf16x8*)(kp+6144); kf[7]=*(const __attribute__((address_space(3))) bf16x8*)(kp+6656);
}
__device__ __forceinline__ void kload2(bf16x8*kf,lds_cptr kp,int j){ kf[2*j]=*(const __attribute__((address_space(3))) bf16x8*)(kp+j*2048); kf[2*j+1]=*(const __attribute__((address_space(3))) bf16x8*)(kp+j*2048+512); }
__device__ __forceinline__ s16x4 vtr(lds_cptr p){ return __builtin_bit_cast(s16x4,__builtin_amdgcn_ds_read_tr16_b64_v4i16((__attribute__((address_space(3))) v4i16_t*)p)); }
__device__ __forceinline__ float rowmax(const f32x16&p0,const f32x16&p1){
  float a=max3f(p0[0],p0[1],p1[0]),b=max3f(p0[2],p0[3],p1[1]);a=max3f(a,p1[2],p1[3]);
  #pragma unroll
  for(int r=4;r<16;r+=4){a=max3f(a,p0[r],p0[r+1]);b=max3f(b,p0[r+2],p0[r+3]);a=max3f(a,p1[r],p1[r+1]);b=max3f(b,p1[r+2],p1[r+3]);}
  const float m=max2f(a,b);
  auto rr=__builtin_amdgcn_permlane32_swap(__float_as_uint(m),__float_as_uint(m),false,false);
  return max2f(__uint_as_float(rr[0]),__uint_as_float(rr[1]));
}
__device__ __forceinline__ void pv(f32x16*o,int vb,bf16x8 pa0,bf16x8 pa1,bf16x8 pa2,bf16x8 pa3){
  #pragma unroll
  for(int d0=0;d0<2;++d0){s16x4 lo[4],hi[4];
    #pragma unroll
    for(int ks=0;ks<4;++ks){
      asm volatile("ds_read_b64_tr_b16 %0,%1 offset:%c2":"=&v"(lo[ks]):"v"(vb),"i"(d0*4096+ks*1024):"memory");
      asm volatile("ds_read_b64_tr_b16 %0,%1 offset:%c2":"=&v"(hi[ks]):"v"(vb),"i"(d0*4096+ks*1024+512):"memory");}
    asm volatile("s_waitcnt lgkmcnt(0)":::"memory");SBAR();
    #define PK(k) (bf16x8){lo[k][0],lo[k][1],lo[k][2],lo[k][3],hi[k][0],hi[k][1],hi[k][2],hi[k][3]}
    o[d0]=__builtin_amdgcn_mfma_f32_32x32x16_bf16(pa0,PK(0),o[d0],0,0,0);
    o[d0]=__builtin_amdgcn_mfma_f32_32x32x16_bf16(pa1,PK(1),o[d0],0,0,0);
    o[d0]=__builtin_amdgcn_mfma_f32_32x32x16_bf16(pa2,PK(2),o[d0],0,0,0);
    o[d0]=__builtin_amdgcn_mfma_f32_32x32x16_bf16(pa3,PK(3),o[d0],0,0,0);
    #undef PK
  }
}

#ifndef ATTN_STORE16
#define ATTN_STORE16(p,v) (*(u32x4*)(p)=(v))
#endif
template<int THRL,bool STATIC_REF> __device__ __forceinline__ void attn_unit(int b,int h,int qb,const bf16*Q,const bf16*__restrict__ K,const bf16*__restrict__ V,bf16*O,float*ATS,char*shm,int wave_idx,float refB){
  int lane; asm volatile("v_mbcnt_lo_u32_b32 %0, -1, 0\n\tv_mbcnt_hi_u32_b32 %0, -1, %0":"=v"(lane)); const int r32=lane&31,hi=lane>>5; const int wid=wave_idx; const int kvh=h>>2;
  const long rowbase=(long)b*SEQ; const int q0=qb*QB;
  const bf16*Qw=Q+(rowbase+q0+wid*QBLK)*QP+h*D;
  const bf16*Kh=K+rowbase*KP+kvh*D,*Vh=V+rowbase*KP+kvh*D;
  const unsigned lds0=(unsigned)(uintptr_t)shm;
  float*wsf=(float*)(shm+LDS_WS)+wid*64;
  const bf16*ksrc=Kh+(long)lane*KP+wid*8;
  const bf16*vsrc=Vh+(long)(16*(wid&3)+(lane>>2))*KP+(wid>>2)*32+(lane&3)*8;
  const unsigned kdst=lds0+LDS_K+wid*1024, vdst=lds0+LDS_V+wid*1024;
  #define DMA_K(t,slot) glds16(ksrc+(long)(t)*KVBLK*KP,(unsigned)__builtin_amdgcn_readfirstlane(kdst+(slot)))
  #define DMA_V(t,slot) glds16(vsrc+(long)(t)*KVBLK*KP,(unsigned)__builtin_amdgcn_readfirstlane(vdst+(slot)))
  const int vb0=(int)(lds0+LDS_V)+((lane>>4)&1)*32+(lane&3)*8+(4*hi+((lane&15)>>2))*64;
  const char*Kbase=shm+LDS_K; bf16x8 kf[8];
  const lds_cptr shm3=(lds_cptr)shm; const lds_cptr kp0=shm3+LDS_K+hi*1024+r32*16; const lds_cptr vp0=shm3+LDS_V+((lane>>4)&1)*32+(lane&3)*8+(4*hi+((lane&15)>>2))*64;
  const int NT=SEQ/KVBLK;
  DMA_K(0,0);DMA_V(0,0);DMA_K(1,SLOTB);
  bf16x8 qr[4];
  #pragma unroll
  for(int d0=0;d0<4;++d0)qr[d0]=*reinterpret_cast<const bf16x8*>(&Qw[(long)r32*QP+d0*16+hi*8]);
  float mhat=0.f,l_reg=0.f;f32x16 o[2];o[0]=f32x16{};o[1]=f32x16{};f32x16 negm=f32x16{};
  if constexpr(STATIC_REF){ _Pragma("unroll") for(int r=0;r<16;++r)negm[r]=-refB; }
  asm volatile("":"+v"(negm));
  const int qrel=wid*QBLK+r32;
  #define CMASK(P0,P1,t) do{}while(0)
  bool resc=false;
  #define START(P0,P1) do{ if constexpr(!STATIC_REF){ const float rm=rowmax(P0,P1); resc=false; \
    { const float dl=rm; mhat=fadd_s(mhat,dl); \
      _Pragma("unroll") for(int r=0;r<16;++r){P0[r]=fsub_s(P0[r],dl);P1[r]=fsub_s(P1[r],dl);} \
      _Pragma("unroll") for(int r=0;r<16;++r)negm[r]=-mhat; asm volatile("":"+v"(negm)); } } \
    _Pragma("unroll") for(int r=0;r<16;++r)P0[r]=__builtin_amdgcn_exp2f(P0[r]); }while(0)
  #define RESC() do{ if constexpr(!STATIC_REF) if(resc){ asm volatile("s_waitcnt lgkmcnt(0)":::"memory"); \
      _Pragma("unroll") for(int d_=0;d_<2;++d_) _Pragma("unroll") for(int r=0;r<16;++r)o[d_][r]*=wsf[crow(r,hi)]; } }while(0)
  f32x16 pA0,pA1,pB0,pB1;
  int sl_prev=0,sl_cur=0,sl_next=SLOTB;
  #define ROT() do{sl_prev=sl_cur;sl_cur=sl_next;sl_next=(sl_next==(NSLOT-1)*SLOTB)?0:sl_next+SLOTB;}while(0)
  DMA_K(2,2*SLOTB);
  WAIT_BAR(3);
  qkt(pA0,pA1,Kbase,qr,negm,r32,hi);asm volatile("s_nop 15\n\ts_nop 7":"+v"(pA0),"+v"(pA1));CMASK(pA0,pA1,0);
  START(pA0,pA1);
  _Pragma("unroll") for(int r=0;r<16;++r)pA1[r]=__builtin_amdgcn_exp2f(pA1[r]);
  WAIT_BAR(0);
  DMA_K(3,0);DMA_V(1,SLOTB);
  ROT();
  kload8(kf,kp0+sl_cur);
  WAIT_BAR(2);
  s16x4 vlo[8],vhi[8]; u32x4 pw0,pw1,pw2,pw3;
  #define PKW(P,B) cvtpk_s(P[B],P[B+1])
  #define PAF(k) __builtin_bit_cast(bf16x8,pw##k)
  #define VFR(i) (bf16x8){vlo[i][0],vlo[i][1],vlo[i][2],vlo[i][3],vhi[i][0],vhi[i][1],vhi[i][2],vhi[i][3]}
  #define PIN(x) asm volatile("":"+v"(x))
  #define MX3(a,b,c) __builtin_fmaxf(__builtin_fmaxf((a),(b)),(c))
  #define GAPA(MF,A0,A1,A2,A3,W0,W1,PW) do{ MF; sacc+=A0; sacc+=A1; sacc+=A2; sacc+=A3; PIN(sacc); W0; W1; PIN(PW); SBAR(); }while(0)
  #define EX(v) __builtin_amdgcn_exp2f(v)
  #define GAPB(MF,X,B) do{ MF; X[B]=EX(X[B]); X[B+1]=EX(X[B+1]); X[B+2]=EX(X[B+2]); X[B+3]=EX(X[B+3]); PIN(X); SBAR(); }while(0)
  #define VRD(i) do{ vlo[i]=vtr(vp_+(((i)>>2)*4096+((i)&3)*1024)); vhi[i]=vtr(vp_+(((i)>>2)*4096+((i)&3)*1024+512)); }while(0)
  #define KRD(G,j) do{ if(G){ kload2(kf,kp0+sl_next,j); SBAR(); } }while(0)
  #define STEP(C0,C1,P0,P1,t,GK,GV,GL) do{ SBAR(); \
    const lds_cptr vp_=vp0+sl_prev; \
    VRD(0); SBAR(); float sacc=(P0[0]+P0[1]); \
    GAPA(C0=__builtin_amdgcn_mfma_f32_32x32x16_bf16(kf[0],qr[0],negm,0,0,0), P0[2],P0[3],P0[4],P0[5],     pw0[0]=PKW(P0,0), pw0[1]=PKW(P0,2), pw0); \
    VRD(4); SBAR(); GAPA(C1=__builtin_amdgcn_mfma_f32_32x32x16_bf16(kf[1],qr[0],negm,0,0,0), P0[6],P0[7],P0[8],P0[9],     pw0[2]=PKW(P0,4), pw0[3]=PKW(P0,6), pw0); \
    VRD(1); SBAR(); GAPA(C0=__builtin_amdgcn_mfma_f32_32x32x16_bf16(kf[2],qr[1],C0,0,0,0),   P0[10],P0[11],P0[12],P0[13], pw1[0]=PKW(P0,8), pw1[1]=PKW(P0,10), pw1); \
    VRD(5); SBAR(); GAPA(C1=__builtin_amdgcn_mfma_f32_32x32x16_bf16(kf[3],qr[1],C1,0,0,0),   P0[14],P0[15],P1[0],P1[1],   pw1[2]=PKW(P0,12),pw1[3]=PKW(P0,14), pw1); \
    VRD(2); SBAR(); GAPA(C0=__builtin_amdgcn_mfma_f32_32x32x16_bf16(kf[4],qr[2],C0,0,0,0),   P1[2],P1[3],P1[4],P1[5],     pw2[0]=PKW(P1,0), pw2[1]=PKW(P1,2), pw2); \
    VRD(6); SBAR(); GAPA(C1=__builtin_amdgcn_mfma_f32_32x32x16_bf16(kf[5],qr[2],C1,0,0,0),   P1[6],P1[7],P1[8],P1[9],     pw2[2]=PKW(P1,4), pw2[3]=PKW(P1,6), pw2); \
    VRD(3); SBAR(); GAPA(C0=__builtin_amdgcn_mfma_f32_32x32x16_bf16(kf[6],qr[3],C0,0,0,0),   P1[10],P1[11],P1[12],P1[13], pw3[0]=PKW(P1,8), pw3[1]=PKW(P1,10), pw3); \
    VRD(7); SBAR(); GAPA(C1=__builtin_amdgcn_mfma_f32_32x32x16_bf16(kf[7],qr[3],C1,0,0,0),   P1[14],P1[15],0.f,0.f,       pw3[2]=PKW(P1,12),pw3[3]=PKW(P1,14), pw3); \
    l_reg+=sacc; \
    if(GK){DMA_K((t)+3,sl_cur);} if(GV){DMA_V((t)+1,sl_next);} \
    CMASK(C0,C1,t); \
    if constexpr(!STATIC_REF){ float a=MX3(C0[0],C0[1],C1[0]),b=MX3(C0[2],C0[3],C1[1]); a=MX3(a,C1[2],C1[3]); \
      _Pragma("unroll") for(int r=4;r<16;r+=4){a=MX3(a,C0[r],C0[r+1]);b=MX3(b,C0[r+2],C0[r+3]);a=MX3(a,C1[r],C1[r+1]);b=MX3(b,C1[r+2],C1[r+3]);} \
      float rm=__builtin_fmaxf(a,b); { auto rr=__builtin_amdgcn_permlane32_swap(__float_as_uint(rm),__float_as_uint(rm),false,false); rm=__builtin_fmaxf(__uint_as_float(rr[0]),__uint_as_float(rr[1])); } \
      resc=false; \
      if(__builtin_expect(__any(rm>(float)THRL),0)){ const float dl=__builtin_fmaxf(rm,0.f); mhat+=dl; \
        _Pragma("unroll") for(int r=0;r<16;++r){C0[r]-=dl;C1[r]-=dl;} \
        _Pragma("unroll") for(int r=0;r<16;++r)negm[r]=-mhat; asm volatile("":"+v"(negm)); \
        const float f=__builtin_amdgcn_exp2f(-dl); l_reg*=f; if(hi==0)wsf[r32]=f; resc=true; } } \
    SBAR(); \
    GAPB(o[0]=__builtin_amdgcn_mfma_f32_32x32x16_bf16(PAF(0),VFR(0),o[0],0,0,0), C0,0); \
    GAPB(o[1]=__builtin_amdgcn_mfma_f32_32x32x16_bf16(PAF(0),VFR(4),o[1],0,0,0), C0,4); \
    KRD(GL,0); GAPB(o[0]=__builtin_amdgcn_mfma_f32_32x32x16_bf16(PAF(1),VFR(1),o[0],0,0,0), C0,8); \
    KRD(GL,1); GAPB(o[1]=__builtin_amdgcn_mfma_f32_32x32x16_bf16(PAF(1),VFR(5),o[1],0,0,0), C0,12); \
    KRD(GL,2); GAPB(o[0]=__builtin_amdgcn_mfma_f32_32x32x16_bf16(PAF(2),VFR(2),o[0],0,0,0), C1,0); \
    KRD(GL,3); GAPB(o[1]=__builtin_amdgcn_mfma_f32_32x32x16_bf16(PAF(2),VFR(6),o[1],0,0,0), C1,4); \
    GAPB(o[0]=__builtin_amdgcn_mfma_f32_32x32x16_bf16(PAF(3),VFR(3),o[0],0,0,0), C1,8); \
    GAPB(o[1]=__builtin_amdgcn_mfma_f32_32x32x16_bf16(PAF(3),VFR(7),o[1],0,0,0), C1,12); \
    }while(0)
  int t=1;
  for(;t+5<NT;t+=2){
    STEP(pB0,pB1,pA0,pA1,t,true,true,true);     WAIT_BAR(2); RESC(); ROT();
    STEP(pA0,pA1,pB0,pB1,t+1,true,true,true);   WAIT_BAR(2); RESC(); ROT();
  }
  #define ENDW(tt) do{ if((tt)+3<NT){WAIT_BAR(2);} else if((tt)+2<NT){WAIT_BAR(1);} else {WAIT_BAR(0);} }while(0)
  for(;t+1<NT;t+=2){
    STEP(pB0,pB1,pA0,pA1,t,(t+3<NT),(t+1<NT),(t+1<NT));       ENDW(t);   RESC(); ROT();
    STEP(pA0,pA1,pB0,pB1,t+1,(t+4<NT),(t+2<NT),(t+2<NT));     ENDW(t+1); RESC(); ROT();
  }
  STEP(pB0,pB1,pA0,pA1,NT-1,false,false,false); RESC();
  { float sacc=pB0[0]+pB0[1]; _Pragma("unroll") for(int r=2;r<16;++r)sacc+=pB0[r]; _Pragma("unroll") for(int r=0;r<16;++r)sacc+=pB1[r]; l_reg+=sacc;
    pw0=(u32x4){PKW(pB0,0),PKW(pB0,2),PKW(pB0,4),PKW(pB0,6)};pw1=(u32x4){PKW(pB0,8),PKW(pB0,10),PKW(pB0,12),PKW(pB0,14)};pw2=(u32x4){PKW(pB1,0),PKW(pB1,2),PKW(pB1,4),PKW(pB1,6)};pw3=(u32x4){PKW(pB1,8),PKW(pB1,10),PKW(pB1,12),PKW(pB1,14)};
    SBAR(); pv(o,vb0+sl_cur,PAF(0),PAF(1),PAF(2),PAF(3)); }
  #undef PKW
  #undef PAF
  #undef VFR
  #undef PIN
  #undef MX3
  #undef GAPA
  #undef GAPB
  #undef EX
  #undef VRD
  #undef KRD
  #undef STEP
  #undef ENDW
  {auto rr=__builtin_amdgcn_permlane32_swap(__float_as_uint(l_reg),__float_as_uint(l_reg),false,false);l_reg=__uint_as_float(rr[0])+__uint_as_float(rr[1]);}
  if(hi==0)wsf[32+r32]=l_reg;asm volatile("s_waitcnt lgkmcnt(0)":::"memory");
  float rli[16];
  #pragma unroll
  for(int r=0;r<16;++r)rli[r]=__builtin_amdgcn_rcpf(wsf[32+crow(r,hi)]);
  bf16*Ow=O+(rowbase+q0+wid*QBLK)*OP+512+h*D; float*ATw=ATS+(rowbase+q0+wid*QBLK)*8+h;
  { bf16*stg=(bf16*)(shm+LDS_OST)+wid*2048;
    #pragma unroll
    for(int r=0;r<16;++r){const int orow=crow(r,hi);
      #pragma unroll
      for(int d0=0;d0<2;++d0)stg[orow*64+d0*32+r32]=__float2bfloat16(o[d0][r]*rli[r]);}
    asm volatile("s_waitcnt lgkmcnt(0)":::"memory");
    #pragma unroll
    for(int i=0;i<4;++i){const int row=i*8+(lane>>3),ch=lane&7; const u32x4 v=*(const u32x4*)(stg+row*64+ch*8); ATTN_STORE16(Ow+(long)row*OP+ch*8,v);
      float ss=0.f;
      #pragma unroll
      for(int q=0;q<4;++q){const float lo=__uint_as_float(v[q]<<16),hh=__uint_as_float(v[q]&0xffff0000u);ss+=lo*lo+hh*hh;}
      ss=sum_row8(ss); if(ch==0)ATw[(long)row*8]=ss;} }
  asm volatile("s_waitcnt lgkmcnt(0)\n\ts_barrier":::"memory");
  #undef DMA_K
  #undef DMA_V
  #undef CMASK
  #undef START
  #undef RESC
  #undef ROT
}
constexpr int ATTN_LDS_BYTES=LDS_BYTES;
#undef SBAR
#undef WAIT_BAR
}

__global__ void __launch_bounds__(NTHR, 2) mega(Args args) {
    extern __shared__ __attribute__((aligned(16))) unsigned char lds[];
    Frame F;
    F.lds = (LAS unsigned char*)lds;
    F.wave = __builtin_amdgcn_readfirstlane(threadIdx.x >> 6);
    F.G = gridDim.x; { const int bx = blockIdx.x; F.vcu = (F.G % 8 == 0) ? (bx % 8) * (F.G / 8) + bx / 8 : bx; }
#pragma unroll
    for (int i = 0; i < 22; ++i) F.in[i] = args.in[i];
    F.ws = args.ws; F.xres = args.out;
    volatile LAS unsigned* MISC = (volatile LAS unsigned*)(F.lds + MISC_OFF);
    for (int u = threadIdx.x; u < (LDS_BYTES - LDSCTL_OFF) / 4; u += NTHR) ((LAS unsigned*)(F.lds + LDSCTL_OFF))[u] = 0u;
    __syncthreads();
    const int lo = args.ph_lo, hi = args.ph_hi;
    unsigned* barw = (unsigned*)(F.ws + WS_CTL) + CW_BAR + args.bar_region * XCD_BAR_WORDS;
    XcdBarrier bar; bar.bar = barw; bar.x = 0; bar.st = nullptr;
    if (hi - lo > 1) bar = xcd_barrier_post(barw, MISC + 8);
#ifndef ONLY_K
#define ONLY_K -1
#endif
#define EN(kind) (ONLY_K < 0 || ONLY_K == (kind))
#ifndef ALIGN_A
#define ALIGN_A true
#endif
#ifndef ALIGN_IN
#define ALIGN_IN true
#endif
#ifndef ALIGN_E1
#define ALIGN_E1 true
#endif
#define IN(k) (lo <= (k) && (k) < hi)
#ifndef REPK
#define REPK -1
#endif
#define PROBE_TOP(k) for (int rep_ = 0; rep_ < (REPK == (k) ? 2 : 1); ++rep_) {
#define PROBE_END(k) if (REPK == (k) && rep_ == 0) xcd_barrier(bar); }
#define SEAM(k) do { if (IN(k) && IN((k) + 1)) { xcd_barrier(bar); if (REPK == 200) xcd_barrier(bar); } } while (0)
    const int cid0 = (int)blockIdx.x; const int cid = cid0;
    if (EN(100) && IN(0)) { asm volatile("; PHASE_MARK P0"); PROBE_TOP(100) ph_rows0(F); PROBE_END(100) }
    if (EN(101) && IN(1)) { asm volatile("; PHASE_MARK P1"); PROBE_TOP(101) ph_convert(F); PROBE_END(101) } SEAM(1);
    if (EN(102) && IN(2)) { asm volatile("; PHASE_MARK P2"); PROBE_TOP(102)
        SchedKV S; S.o.init(NL * 4, 8, F.G, cid); S.MEMN = (const char*)(F.ws + WS_MEMN); S.WKVT = (const char*)(F.ws + WS_WKVT);
        pg8::EpiStore<3> E{(bf16*)(F.ws + WS_KVM), 2 * D, nullptr, 1.0f};
        pg8::gemm_phase<pg8::EpiStore<3>, SchedKV, true, false>(F.lds, F.wave, D, D, D, S, E);
    PROBE_END(102) } SEAM(2);
    if (EN(103) && IN(3)) { asm volatile("; PHASE_MARK P3a");
        SchedQK S; S.o.init(NL * 16, 4, F.G, cid); S.KVM = (const char*)(F.ws + WS_KVM); S.WQB = (const char*)(F.ws + WS_WQB);
        pg8::EpiStore<1, true> E{(bf16*)(F.ws + WS_QKT), D, F.in[11], XQSCALE * Q8S};
        int la = 2 * D, lb = D, kk = 256; asm volatile("" : "+s"(la), "+s"(lb), "+s"(kk));
        pg8::gemm_phase<pg8::EpiStore<1, true>, SchedQK, true, false>(F.lds, F.wave, la, lb, kk, S, E);
    }
    if (EN(104) && IN(3)) { asm volatile("; PHASE_MARK P3b");
        SchedVO S; S.o.init(NL * 64, 1, F.G, cid); S.KVM = (const char*)(F.ws + WS_KVM); S.WOT = (const char*)(F.ws + WS_WOT);
        pg8::EpiStore<2, true> E{(bf16*)(F.ws + WS_VOT), D, nullptr, V8S};
        int la = D, lb = 2 * D, kk = 256; asm volatile("" : "+s"(la), "+s"(lb), "+s"(kk));
        pg8::gemm_phase<pg8::EpiStore<2, true>, SchedVO, true, false>(F.lds, F.wave, la, lb, kk, S, E);
    } SEAM(3);
    for (int l = 0; l < NL; ++l) {
        const int pb = PH_LAYER0 + PH_PER_LAYER * l;
        int cid = cid0; asm volatile("" : "+s"(cid));
        if (EN(0) && IN(pb + 0)) { asm volatile("; PHASE_MARK L0"); for (int rep_ = 0; rep_ < ((REPK == 0 || REPK == 91 || REPK == 92) ? 2 : 1); ++rep_) {
            SchedDense S; S.o.init(T / 256, 7, F.G, cid); S.A = (const char*)(F.ws + WS_XR); S.a_tile = 256 * D * 2; S.B = (const char*)(F.ws + WS_WIN) + (size_t)l * INW * D * 2; S.b_tile = 256 * D * 2; S.b_batch = 0; S.bdiv = 1; S.bmod = 1;
            pg8::EpiIn E{(bf16*)(F.ws + WS_UACT), (bf16*)(F.ws + WS_VACT), (bf16*)(F.ws + WS_Q), (bf16*)(F.ws + WS_K), (bf16*)(F.ws + WS_V), (float*)(F.ws + WS_VSTAT),
                         F.in[7] + (size_t)l * 64, F.in[8] + (size_t)l * 64, (const float*)(F.ws + WS_ROPE), (const float*)(F.ws + WS_ROPE) + SEQ * 32, (const float*)(F.ws + WS_RINV)}; E.nostore = (REPK == 91 && rep_ == 0); E.skip = (REPK == 92 && rep_ == 0);
            pg8::gemm_phase<pg8::EpiIn, SchedDense, ALIGN_IN, false>(F.lds, F.wave, D, D, D, S, E);
        if ((REPK == 0 || REPK == 91 || REPK == 92) && rep_ == 0) xcd_barrier(bar); } } SEAM(pb + 0);
        if (EN(1) && IN(pb + 1)) { asm volatile("; PHASE_MARK L1");
            float refB; { const int ln = lane_id(); float mq = fabsf(F.in[7][(size_t)l * 64 + ln]), mk = fabsf(F.in[8][(size_t)l * 64 + ln]); mq = max_x32(max_x16(max_row16(mq))); mk = max_x32(max_x16(max_row16(mk)));
                          refB = 8.0f * LOG2E * 1.02f * mq * mk; refB = __builtin_bit_cast(float, __builtin_amdgcn_readfirstlane(__builtin_bit_cast(int, refB))); }
            PROBE_TOP(11)
            for (int it = 0; ; ++it) { const int w = it * F.G + F.vcu; if (w >= NB_ * 8 * (SEQ / 256)) break;
                const int i = w >> 8, c = w & 255, x = c >> 5, j = c & 31;
                if (refB < 60.0f) attn_body::attn_unit<8, true>(x >> 1, (x & 1) * 4 + i, j, (const attn_body::bf16*)(F.ws + WS_Q), (const attn_body::bf16*)(F.ws + WS_K), (const attn_body::bf16*)(F.ws + WS_V),
                                        (attn_body::bf16*)(F.ws + WS_MERGED), (float*)(F.ws + WS_ATSTAT), (char*)lds, F.wave, refB);
                else attn_body::attn_unit<8, false>(x >> 1, (x & 1) * 4 + i, j, (const attn_body::bf16*)(F.ws + WS_Q), (const attn_body::bf16*)(F.ws + WS_K), (const attn_body::bf16*)(F.ws + WS_V),
                                        (attn_body::bf16*)(F.ws + WS_MERGED), (float*)(F.ws + WS_ATSTAT), (char*)lds, F.wave, refB); }
            PROBE_END(11)
            PROBE_TOP(12) ph_gmlp(F, l); PROBE_END(12) } SEAM(pb + 1);
        if (EN(2) && IN(pb + 2)) { asm volatile("; PHASE_MARK L2"); PROBE_TOP(2)
            SchedDense S; S.o.init(T / 256, 4, F.G, cid); S.A = (const char*)(F.ws + WS_MERGED); S.a_tile = 256 * D * 2; S.B = (const char*)(F.ws + WS_WOUT) + (size_t)l * D * D * 2; S.b_tile = 256 * D * 2; S.b_batch = 0; S.bdiv = 1; S.bmod = 1;
            pg8::EpiX<true, true> E; E.xr = (bf16*)(F.ws + WS_XR); E.xstat = (float*)(F.ws + WS_XSTAT); E.gmstat = (const float*)(F.ws + WS_GMSTAT); E.atstat = (const float*)(F.ws + WS_ATSTAT); E.lds = F.lds; E.xa8 = F.ws + WS_XR8; E.scale = 1.0f;
            pg8::gemm_phase<pg8::EpiX<true, true>, SchedDense, ALIGN_A, false>(F.lds, F.wave, D, D, D, S, E);
        PROBE_END(2) } SEAM(pb + 2);
        if (EN(3) && IN(pb + 3)) { asm volatile("; PHASE_MARK L3"); PROBE_TOP(3)
            SchedDense S; S.o.init(T / 256, 4, F.G, cid); S.A = (const char*)(F.ws + WS_XR8); S.a_tile = 256 * D; S.B = (const char*)(F.ws + WS_QKT) + (size_t)l * NB_ * D * D; S.b_tile = 256 * D; S.b_batch = (size_t)D * D; S.bdiv = SEQ / 256; S.bmod = NB_;
            pg8::EpiS E{(const float*)(F.ws + WS_XSTAT), F.ws + WS_P, F.lds};
            int kq = D / 2; asm volatile("" : "+s"(kq));
            pg8::gemm_phase<pg8::EpiS, SchedDense, true, false, true>(F.lds, F.wave, kq, kq, kq, S, E);
        PROBE_END(3) } SEAM(pb + 3);
        if (EN(4) && IN(pb + 4)) { asm volatile("; PHASE_MARK L4"); PROBE_TOP(4)
            SchedDense S; S.o.init(T / 256, 4, F.G, cid); S.A = (const char*)(F.ws + WS_P); S.a_tile = 256 * D; S.B = (const char*)(F.ws + WS_VOT) + (size_t)l * NB_ * D * D; S.b_tile = 256 * D; S.b_batch = (size_t)D * D; S.bdiv = SEQ / 256; S.bmod = NB_;
            pg8::EpiX<false, false> E; E.xr = (bf16*)(F.ws + WS_XR); E.xstat = nullptr; E.gmstat = nullptr; E.atstat = nullptr; E.lds = F.lds; E.xa8 = nullptr; E.scale = 1.0f / (P8S * V8S);
            int kq = D / 2; asm volatile("" : "+s"(kq));
            pg8::gemm_phase<pg8::EpiX<false, false>, SchedDense, ALIGN_A, false, true>(F.lds, F.wave, kq, kq, kq, S, E);
        PROBE_END(4) } SEAM(pb + 4);
        if (EN(5) && IN(pb + 5)) { asm volatile("; PHASE_MARK L5"); PROBE_TOP(5) ph_router(F, l); PROBE_END(5) } SEAM(pb + 5);
        if (EN(6) && IN(pb + 6)) { asm volatile("; PHASE_MARK L6"); PROBE_TOP(6) ph_topk(F); PROBE_END(6) } SEAM(pb + 6);
        if (EN(7) && IN(pb + 7)) { asm volatile("; PHASE_MARK L7"); PROBE_TOP(7)
            SchedE1 S; S.o.init(NB_ * NE * 4, 8, F.G, cid); S.HBp = (const char*)(F.ws + WS_XR8); S.IDX = (const int*)(F.ws + WS_IDX); S.WGU = (const char*)(F.ws + WS_WGU) + (size_t)l * NE * 2 * FF * D;
            pg8::EpiH E{F.ws + WS_H};
            int kq = D / 2; asm volatile("" : "+s"(kq));
            pg8::gemm_phase<pg8::EpiH, SchedE1, ALIGN_E1, true, true>(F.lds, F.wave, kq, kq, kq, S, E);
        PROBE_END(7) } SEAM(pb + 7);
        if (EN(8) && IN(pb + 8)) { asm volatile("; PHASE_MARK L8"); for (int rep_ = 0; rep_ < ((REPK == 8 || REPK == 81) ? 2 : 1); ++rep_) {
            SchedDense S; S.o.init(NB_ * NE * 4, 4, F.G, cid); S.A = (const char*)(F.ws + WS_H); S.a_tile = 256 * FF; S.B = (const char*)(F.ws + WS_WD) + (size_t)l * NE * D * FF; S.b_tile = 256 * FF; S.b_batch = (size_t)D * FF; S.bdiv = 4; S.bmod = NE;
            pg8::EpiY8 E{F.ws + WS_Y, Y8S / (H8S * W8S)}; E.skip = (REPK == 81 && rep_ == 0);
            int kq = FF / 2; asm volatile("" : "+s"(kq));
            pg8::gemm_phase<pg8::EpiY8, SchedDense, ALIGN_A, false, true>(F.lds, F.wave, kq, kq, kq, S, E);
        if ((REPK == 8 || REPK == 81) && rep_ == 0) xcd_barrier(bar); } } SEAM(pb + 8);
        if (EN(9) && IN(pb + 9)) { asm volatile("; PHASE_MARK L9"); PROBE_TOP(9) ph_combine(F, l, REPK == 9 && rep_ == 0); PROBE_END(9) } SEAM(pb + 9);
    }
#undef IN
#undef SEAM
}

static int g_grid = 0;
static void launch_mega(Args a, int lo, int hi, int region, hipStream_t stream) {
    a.ph_lo = lo; a.ph_hi = hi; a.bar_region = region; a.pad = 0;
    hipLaunchKernelGGL(mega, dim3(g_grid), dim3(NTHR), LDS_BYTES, stream, a);
}
extern "C" void kernel_launch(void* const* d_in, const int* in_sizes, int n_in, void* d_out, int out_size, void* d_ws, size_t ws_size, hipStream_t stream) {
    if (g_grid == 0) {
        if (n_in != 22 || out_size != T * D || ws_size < WS_END) { fprintf(stderr, "kernel_launch: unexpected sizes n_in %d out %d ws %zu\n", n_in, out_size, ws_size); g_grid = -1; return; }
        int dev = 0, cus = 0;
        if (hipGetDevice(&dev) != hipSuccess || hipDeviceGetAttribute(&cus, hipDeviceAttributeMultiprocessorCount, dev) != hipSuccess) { g_grid = -1; return; }
        if (hipFuncSetAttribute((const void*)mega, hipFuncAttributeMaxDynamicSharedMemorySize, LDS_BYTES) != hipSuccess) { g_grid = -1; return; }
        int per_cu = 0;
        if (hipOccupancyMaxActiveBlocksPerMultiprocessor(&per_cu, (const void*)mega, NTHR, LDS_BYTES) != hipSuccess || per_cu < 1) fprintf(stderr, "kernel_launch: occupancy query says %d\n", per_cu);
        (void)hipGetLastError();
        g_grid = cus;
    }
    if (g_grid < 0) return;
    hipMemsetAsync((char*)d_ws + WS_CTL, 0, CTL_ZERO_BYTES, stream);
    Args a{};
    for (int i = 0; i < 22; ++i) a.in[i] = (const float*)d_in[i];
    a.out = (float*)d_out; a.ws = (unsigned char*)d_ws;
    launch_mega(a, 0, PH_END, 0, stream);
}
```

```cpp
#ifndef REPK
#define REPK -1
#endif
#include <hip/hip_runtime.h>
#include <hip/hip_bf16.h>
#include <cstdio>
#include <cstdint>
#include <cmath>

constexpr int NB_ = 4, SEQ = 8192, T = NB_ * SEQ, D = 1024, NL = 4;
constexpr int MEML = 256, NMEM = NB_ * MEML;
constexpr int INW = 1792, GMW = 512, NE = 16, CAP = 1024, FF = 1024;
constexpr float EPS = 1e-6f;
constexpr float LOG2E = 1.4426950408889634f;
constexpr float QSCALE = 0.125f * LOG2E;
constexpr float XQSCALE = 0.0625f * LOG2E;
constexpr float W8S = 256.0f, A8S = 16.0f, H8S = 8.0f, Y8S = 32.0f;
constexpr float Q8S = 512.0f, P8S = 256.0f, V8S = 64.0f;

constexpr size_t MiB = 1u << 20;
constexpr size_t WS_CTL = 0, CTL_ZERO_BYTES = 1 * MiB;
constexpr size_t WS_ROPE = 1 * MiB;
constexpr size_t WS_AFF = 3 * MiB;
constexpr size_t WS_INV = 5 * MiB;
constexpr size_t WS_IDX = 7 * MiB;
constexpr size_t WS_VSTAT = 8 * MiB;
constexpr size_t WS_ATSTAT = 9 * MiB;
constexpr size_t WS_GMSTAT = 10 * MiB;
constexpr size_t WS_RINV = 10 * MiB + 512 * 1024;
constexpr size_t WS_RINV2 = 10 * MiB + 768 * 1024;
constexpr size_t WS_XSTAT = 11 * MiB;
constexpr size_t WS_MEMN = 13 * MiB;
constexpr size_t WS_WSB = 15 * MiB;
constexpr size_t WS_WRH = 15 * MiB + 512 * 1024, WS_WRL = WS_WRH + 128 * 1024;
constexpr size_t WS_WIN = 16 * MiB;
constexpr size_t WS_WOUT = 30 * MiB;
constexpr size_t WS_QKT = 38 * MiB;
constexpr size_t WS_VOT = 70 * MiB;
constexpr size_t WS_WGU = 102 * MiB;
constexpr size_t WS_WD = 358 * MiB;
constexpr size_t WS_XR = 486 * MiB;
constexpr size_t WS_R1 = 550 * MiB;
constexpr size_t WS_UACT = WS_R1, WS_VACT = WS_R1 + 32 * MiB, WS_Q = WS_R1 + 64 * MiB, WS_K = WS_R1 + 96 * MiB, WS_V = WS_R1 + 104 * MiB;
constexpr size_t WS_WQB = 230 * MiB, WS_WOT = 238 * MiB, WS_WKVT = 246 * MiB, WS_KVM = 262 * MiB;
constexpr size_t WS_H = WS_R1;
constexpr size_t WS_MERGED = 678 * MiB;
constexpr size_t WS_XR8 = 742 * MiB;
constexpr size_t WS_P = WS_MERGED;
constexpr size_t WS_Y = 678 * MiB;
constexpr size_t WS_NSCR = 806 * MiB;
constexpr size_t WS_END = 808 * MiB;

constexpr int CW_TMO = 0, CW_CODE = 1, CW_BAR = 4096;

#define GAS __attribute__((address_space(1)))
#define LAS __attribute__((address_space(3)))
typedef unsigned short bf16;
typedef unsigned v4u __attribute__((ext_vector_type(4)));
typedef unsigned v2u __attribute__((ext_vector_type(2)));
typedef float f32x4 __attribute__((ext_vector_type(4)));
typedef short bf16x8_t __attribute__((ext_vector_type(8)));
typedef GAS unsigned gu32;
#define RLX_AGENT __ATOMIC_RELAXED, __HIP_MEMORY_SCOPE_AGENT
__device__ __forceinline__ unsigned f2bf(float f) { unsigned u = __builtin_bit_cast(unsigned, f); return (u + 0x7fffu + ((u >> 16) & 1u)) >> 16; }
__device__ __forceinline__ unsigned pk2(float lo, float hi) { return f2bf(lo) | (f2bf(hi) << 16); }
__device__ __forceinline__ float bf2f(unsigned v) { return __builtin_bit_cast(float, v << 16); }
__device__ __forceinline__ float bflo(unsigned w) { return __builtin_bit_cast(float, w << 16); }
__device__ __forceinline__ float bfhi(unsigned w) { return __builtin_bit_cast(float, w & 0xffff0000u); }
__device__ __forceinline__ float rbf(float f) { return bf2f(f2bf(f)); }
__device__ __forceinline__ float clamp8(float v) { return __builtin_amdgcn_fmed3f(v, -448.0f, 448.0f); }
__device__ __forceinline__ unsigned pk4_fp8(float a, float b, float c, float d) { unsigned w = 0u; w = __builtin_amdgcn_cvt_pk_fp8_f32(clamp8(a), clamp8(b), w, false); w = __builtin_amdgcn_cvt_pk_fp8_f32(clamp8(c), clamp8(d), w, true); return w; }
__device__ __forceinline__ float gelu_tanh(float x) {
    const float z = 1.5957691216057308f * (x + 0.044715f * x * x * x);
    return x * __builtin_amdgcn_rcpf(1.0f + __builtin_amdgcn_exp2f(-z * LOG2E));
}
typedef float f32x2_t __attribute__((ext_vector_type(2)));
__device__ __forceinline__ f32x4 gelu4(const f32x4 x) {
    const f32x4 w = (x * x) * (-1.5957691216057308f * 0.044715f * LOG2E) + (-1.5957691216057308f * LOG2E); const f32x4 a = w * x;
    f32x4 d; d[0] = __builtin_amdgcn_exp2f(a[0]); d[1] = __builtin_amdgcn_exp2f(a[1]); d[2] = __builtin_amdgcn_exp2f(a[2]); d[3] = __builtin_amdgcn_exp2f(a[3]);
    d = d + 1.0f;
    f32x4 r; r[0] = __builtin_amdgcn_rcpf(d[0]); r[1] = __builtin_amdgcn_rcpf(d[1]); r[2] = __builtin_amdgcn_rcpf(d[2]); r[3] = __builtin_amdgcn_rcpf(d[3]);
    return x * r;
}
__device__ __forceinline__ f32x4 silu_mul4(const f32x4 g, const f32x4 u, const float sg, const float su) {
    const f32x4 a = g * (-sg * LOG2E);
    f32x4 d; d[0] = __builtin_amdgcn_exp2f(a[0]); d[1] = __builtin_amdgcn_exp2f(a[1]); d[2] = __builtin_amdgcn_exp2f(a[2]); d[3] = __builtin_amdgcn_exp2f(a[3]);
    d = d + 1.0f;
    f32x4 r; r[0] = __builtin_amdgcn_rcpf(d[0]); r[1] = __builtin_amdgcn_rcpf(d[1]); r[2] = __builtin_amdgcn_rcpf(d[2]); r[3] = __builtin_amdgcn_rcpf(d[3]);
    return (g * r) * (u * (sg * sg * su));
}
__device__ __forceinline__ float silu_f(float a) { return a * __builtin_amdgcn_rcpf(1.0f + __builtin_amdgcn_exp2f(-a * LOG2E)); }
__device__ __forceinline__ int lane_id() { int l; asm volatile("v_mbcnt_lo_u32_b32 %0, -1, 0\n\tv_mbcnt_hi_u32_b32 %0, -1, %0" : "=v"(l)); return l; }
template <int CTRL> __device__ __forceinline__ float dpp_f(float v) { return __builtin_bit_cast(float, __builtin_amdgcn_update_dpp(0, __builtin_bit_cast(int, v), CTRL, 0xf, 0xf, true)); }
__device__ __forceinline__ float sum_row16(float v) { v += dpp_f<0xB1>(v); v += dpp_f<0x4E>(v); v += dpp_f<0x141>(v); v += dpp_f<0x140>(v); return v; }
__device__ __forceinline__ float max_row16(float v) { v = fmaxf(v, dpp_f<0xB1>(v)); v = fmaxf(v, dpp_f<0x4E>(v)); v = fmaxf(v, dpp_f<0x141>(v)); v = fmaxf(v, dpp_f<0x140>(v)); return v; }
__device__ __forceinline__ float sum_row8(float v) { v += dpp_f<0xB1>(v); v += dpp_f<0x4E>(v); v += dpp_f<0x141>(v); return v; }
__device__ __forceinline__ float swz16(float v) { return __builtin_bit_cast(float, __builtin_amdgcn_ds_swizzle(__builtin_bit_cast(int, v), 0x401f)); }
__device__ __forceinline__ float add_x16(float v) { return v + swz16(v); }
__device__ __forceinline__ float add_x32(float v) { const unsigned a = __builtin_bit_cast(unsigned, v); const auto r = __builtin_amdgcn_permlane32_swap(a, a, false, false); const unsigned r0 = r[0], r1 = r[1]; return __builtin_bit_cast(float, r0) + __builtin_bit_cast(float, r1); }
__device__ __forceinline__ float max_x16(float v) { return fmaxf(v, swz16(v)); }
__device__ __forceinline__ float max_x32(float v) { const unsigned a = __builtin_bit_cast(unsigned, v); const auto r = __builtin_amdgcn_permlane32_swap(a, a, false, false); const unsigned r0 = r[0], r1 = r[1]; return fmaxf(__builtin_bit_cast(float, r0), __builtin_bit_cast(float, r1)); }
__device__ __forceinline__ float wave_sum(float v) { return add_x32(add_x16(sum_row16(v))); }

#define XB_TMO      128
#define XB_XCNT(j)  (256  + 64 * (j))
#define XB_XSUB(j)  (1280 + 64 * (j))
#define XB_XGEN(j)  (2304 + 64 * (j))
#define XB_TOP      3328
#define XB_TOPGEN   3392
#define XCD_BAR_WORDS 3456
#define XB_SPIN_CAP (1u << 18)
__device__ __forceinline__ unsigned xb_ld(unsigned* p)              { return __hip_atomic_load(p, __ATOMIC_RELAXED, __HIP_MEMORY_SCOPE_AGENT); }
__device__ __forceinline__ unsigned xb_add(unsigned* p, unsigned v) { return __hip_atomic_fetch_add(p, v, __ATOMIC_RELAXED, __HIP_MEMORY_SCOPE_AGENT); }
__device__ __forceinline__ unsigned xb_xcc_id() { return (unsigned)__builtin_amdgcn_s_getreg((3 << 11) | 20) & 0xFu; }
#define XB_SPIN(cond, bar) do { unsigned _sp = 0; while (cond) { __builtin_amdgcn_s_sleep(1); \
    if ((++_sp & 255u) == 0u) { if (xb_ld(&(bar)[XB_TMO])) break; if (_sp > XB_SPIN_CAP) { atomicAdd(&(bar)[XB_TMO], 1u); break; } } } } while (0)
struct XcdBarrier { unsigned* bar; unsigned x; volatile LAS unsigned* st; };
__device__ __forceinline__ XcdBarrier xcd_barrier_post(unsigned* bar, volatile LAS unsigned* st) {
    XcdBarrier b; b.bar = bar; b.x = xb_xcc_id(); b.st = st;
    if (threadIdx.x == 0) (void)xb_add(&bar[XB_XCNT(b.x)], 1u);
    return b;
}
__device__ __forceinline__ void xcd_barrier_complete(unsigned* bar, unsigned x, unsigned& nloc, unsigned& nx) {
    const unsigned G = gridDim.x * gridDim.y * gridDim.z;
    unsigned sum, cnt, mine, sp = 0u;
    for (;;) {
        sum = 0u; cnt = 0u; mine = 0u;
#pragma unroll
        for (unsigned j = 0; j < 16; ++j) { const unsigned c = xb_ld(&bar[XB_XCNT(j)]); sum += c; cnt += (c > 0u) ? 1u : 0u; mine = (j == x) ? c : mine; }
        if (sum == G) break;
        __builtin_amdgcn_s_sleep(1);
        if ((++sp & 255u) == 0u) { if (xb_ld(&bar[XB_TMO])) break; if (sp > XB_SPIN_CAP) { atomicAdd(&bar[XB_TMO], 1u); break; } }
    }
    nloc = mine > 0u ? mine : 1u; nx = cnt > 0u ? cnt : 1u;
}
__device__ __forceinline__ void xcd_barrier(const XcdBarrier& b) {
    asm volatile("s_waitcnt vmcnt(0)" ::: "memory");
    __syncthreads();
    if (threadIdx.x == 0) {
        unsigned* bar = b.bar;
        __builtin_amdgcn_s_waitcnt(0);
        unsigned nloc = b.st[0], nx = b.st[1];
        if (nloc == 0u) { xcd_barrier_complete(bar, b.x, nloc, nx); b.st[0] = nloc; b.st[1] = nx; }
        const unsigned old = xb_add(&bar[XB_XSUB(b.x)], 1u);
        const unsigned gen = old / nloc;
        if (old + 1u == (gen + 1u) * nloc) {
            __builtin_amdgcn_fence(__ATOMIC_RELEASE, "agent");
            asm volatile("s_waitcnt vmcnt(0)" ::: "memory");
            const unsigned og = xb_add(&bar[XB_TOP], 1u);
            const unsigned tg = og / nx;
            if (og + 1u == (tg + 1u) * nx) xb_add(&bar[XB_TOPGEN], 1u);
            else XB_SPIN(xb_ld(&bar[XB_TOPGEN]) == tg, bar);
            __builtin_amdgcn_fence(__ATOMIC_ACQUIRE, "agent");
            xb_add(&bar[XB_XGEN(b.x)], 1u);
            asm volatile("s_waitcnt vmcnt(0)" ::: "memory");
        } else {
            XB_SPIN(xb_ld(&bar[XB_XGEN(b.x)]) == gen, bar);
            __builtin_amdgcn_fence(__ATOMIC_ACQUIRE, "agent");
            asm volatile("s_waitcnt vmcnt(0)" ::: "memory");
        }
    }
    __syncthreads();
}

struct Args { const float* in[22]; float* out; unsigned char* ws; int ph_lo, ph_hi, bar_region, pad; };
constexpr int PH_LAYER0 = 4, PH_PER_LAYER = 10, PH_END = PH_LAYER0 + NL * PH_PER_LAYER;

constexpr int NWAVES = 8, NTHR = NWAVES * 64;
constexpr int RING_BYTES = 131072, LDSCTL_OFF = RING_BYTES, MISC_OFF = LDSCTL_OFF + 320;
constexpr int LDS_BYTES = 147456;

struct Frame {
    LAS unsigned char* lds;
    int wave, vcu, G;
    const float* in[22];
    unsigned char* ws;
    float* xres;
};

__device__ __forceinline__ void ph_rows0(Frame& F) {
    int lane_ = lane_id(); asm volatile("" : "+v"(lane_)); const int tid_ = F.wave * 64 + lane_;
    const int gw = F.vcu * NWAVES + F.wave, NGW = F.G * NWAVES;
    const float* x = F.in[0]; const float* mem = F.in[1]; const float* mg = F.in[12];
    bf16* XR = (bf16*)(F.ws + WS_XR); bf16* MEMN = (bf16*)(F.ws + WS_MEMN); float* RINV = (float*)(F.ws + WS_RINV);
    for (int m = gw; m < T + NMEM; m += NGW) {
        const bool is_mem = m >= T;
        const float* src = is_mem ? mem + (size_t)(m - T) * D : x + (size_t)m * D;
        bf16* dst = is_mem ? MEMN + (size_t)(m - T) * D : XR + (size_t)m * D;
        f32x4 v[4]; float s = 0.f;
#pragma unroll
        for (int j = 0; j < 4; ++j) { v[j] = __builtin_nontemporal_load((const f32x4*)(src + 4 * lane_ + 256 * j)); s += (v[j].x * v[j].x + v[j].y * v[j].y) + (v[j].z * v[j].z + v[j].w * v[j].w); }
        const float rinv = __builtin_amdgcn_rsqf(wave_sum(s) * (1.0f / D) + EPS);
        if (!is_mem && lane_ == 0) RINV[m] = rinv;
        const float sc = is_mem ? rinv : 1.0f;
#pragma unroll
        for (int j = 0; j < 4; ++j) {
            f32x4 g = (f32x4){1.f, 1.f, 1.f, 1.f};
            if (is_mem) g = *(const f32x4*)(mg + 4 * lane_ + 256 * j);
            v2u o; o.x = pk2(v[j].x * sc * g.x, v[j].y * sc * g.y); o.y = pk2(v[j].z * sc * g.z, v[j].w * sc * g.w);
            *(v2u*)(dst + 4 * lane_ + 256 * j) = o;
        }
    }
#if defined(SELFTEST_F8)
    if (F.vcu == 0 && F.wave == 0) {
        typedef int v8i_t __attribute__((ext_vector_type(8)));
        const int fr = lane_ & 15; const unsigned codes[4] = {0x38383838u, 0x3A3A3A3Au, 0x3C3C3C3Cu, 0x40404040u}; const float vals[4] = {1.0f, 1.25f, 1.5f, 2.0f};
        unsigned bc = codes[0]; float bv = vals[0];
#pragma unroll
        for (int q = 1; q < 4; ++q) if ((fr & 3) == q) { bc = codes[q]; bv = vals[q]; }
        v8i_t A, B;
#pragma unroll
        for (int q = 0; q < 8; ++q) { A[q] = 0x38383838; B[q] = (int)bc; }
        f32x4 acc = (f32x4){0.f, 0.f, 0.f, 0.f}; unsigned sc = 0x7f7f7f7fu; asm volatile("" : "+v"(sc), "+v"(A), "+v"(B), "+v"(acc));
        asm volatile("s_nop 7\n\tv_mfma_scale_f32_16x16x128_f8f6f4 %0, %1, %2, %0, %3, %3 op_sel_hi:[0,0,0]\n\ts_nop 15\n\ts_nop 15\n\ts_nop 15\n\ts_nop 15\n\ts_nop 15\n\ts_nop 15" : "+v"(acc) : "v"(A), "v"(B), "v"(sc));
        bool bad = false;
#pragma unroll
        for (int e = 0; e < 4; ++e) bad |= (acc[e] != 128.0f * bv);
        const unsigned w = pk4_fp8(1.25f, 448.0f, 1000.0f, -2.0f); bad |= (w != 0xC07E7E3Au);
        {   const float v = (float)((lane_ * 37 + 11) % 101);
            float r16 = v; r16 += __shfl_xor(r16, 1); r16 += __shfl_xor(r16, 2); r16 += __shfl_xor(r16, 4); r16 += __shfl_xor(r16, 8);
            float m16 = v; m16 = fmaxf(m16, __shfl_xor(m16, 1)); m16 = fmaxf(m16, __shfl_xor(m16, 2)); m16 = fmaxf(m16, __shfl_xor(m16, 4)); m16 = fmaxf(m16, __shfl_xor(m16, 8));
            float r8 = v; r8 += __shfl_xor(r8, 1); r8 += __shfl_xor(r8, 2); r8 += __shfl_xor(r8, 4);
            float r64 = r16; r64 += __shfl_xor(r64, 16); r64 += __shfl_xor(r64, 32);
            if (SELFTEST_F8 & 1) bad |= (sum_row16(v) != r16) | (max_row16(v) != m16) | (sum_row8(v) != r8);
            if (SELFTEST_F8 & 2) bad |= (wave_sum(v) != r64);
            if (SELFTEST_F8 & 4) bad |= (add_x16(v) != v + __shfl_xor(v, 16)) | (max_x16(v) != fmaxf(v, __shfl_xor(v, 16)));
            if (SELFTEST_F8 & 8) bad |= (add_x32(v) != v + __shfl_xor(v, 32)) | (max_x32(v) != fmaxf(v, __shfl_xor(v, 32)));
            if (SELFTEST_F8 & 16) bad |= (lane_ != (int)(threadIdx.x & 63));
            const int iv = lane_ * 3 + 1; if (SELFTEST_F8 & 32) bad |= (__builtin_amdgcn_readlane(iv, 5) != 16) | false; { const int bp = __builtin_amdgcn_ds_bpermute((lane_ - 1) << 2, iv); if (SELFTEST_F8 & 32) bad |= (lane_ > 0 && bp != iv - 3); }
            const float xq = 0.37f + (float)lane_; const float rq = __builtin_amdgcn_rsqf(xq), rr = 1.0f / sqrtf(xq); if (SELFTEST_F8 & 64) bad |= (fabsf(rq - rr) > 1e-5f * rr); }
        if (bad) __hip_atomic_store((unsigned*)(F.ws + WS_CTL) + CW_TMO, 1u, __ATOMIC_RELAXED, __HIP_MEMORY_SCOPE_AGENT);
    }
#endif
    float* COS = (float*)(F.ws + WS_ROPE); float* SIN = COS + SEQ * 32;
    const int gt = F.vcu * NTHR + tid_, NGT = F.G * NTHR;
    for (int i = gt; i < SEQ * 32; i += NGT) {
        const int t = i >> 5, p = i & 31;
        const float fr = expf(-9.210340371976184f * (float)(p & 15) * (1.0f / 16.0f));
        const float pos = (float)((p < 16) ? (t >> 6) : (t & 63));
        float rev = pos * fr * 0.15915494309189535f; rev -= floorf(rev);
        COS[i] = __builtin_amdgcn_cosf(rev); SIN[i] = __builtin_amdgcn_sinf(rev);
    }
}

__device__ __forceinline__ void ph_gmlp(Frame& F, int l) {
    int lane_ = lane_id(); asm volatile("" : "+v"(lane_)); const int tid_ = F.wave * 64 + lane_;
    const bf16* UACT = (const bf16*)(F.ws + WS_UACT); const bf16* VACT = (const bf16*)(F.ws + WS_VACT);
    const float* VSTAT = (const float*)(F.ws + WS_VSTAT); float* GMSTAT = (float*)(F.ws + WS_GMSTAT);
    bf16* MERGED = (bf16*)(F.ws + WS_MERGED);
    const float* gvn = F.in[4] + (size_t)l * GMW; const float* bs = F.in[6] + (size_t)l * 4 * 128;
    const bf16* WSB = (const bf16*)(F.ws + WS_WSB) + (size_t)l * 4 * 128 * 128;
    LAS bf16* vT = (LAS bf16*)F.lds;
    const int fr = lane_ & 15, fq = lane_ >> 4, w = F.wave;
    const int jv = tid_ & 127, csv = tid_ >> 7;
    v4u nraw[4]; f32x4 ns0, ns1;
#define GM_LOADV(U_) do { const int n_ = (U_) >> 2, g_ = (U_) & 3; const size_t row_ = (size_t)n_ * 128 + jv; ns0 = *(const f32x4*)(VSTAT + row_ * 8); ns1 = *(const f32x4*)(VSTAT + row_ * 8 + 4); \
        _Pragma("unroll") for (int q_ = 0; q_ < 4; ++q_) nraw[q_] = *(const v4u*)(VACT + row_ * GMW + g_ * 128 + (csv * 4 + q_) * 8); } while (0)
    if (F.vcu < (T / 128) * 4) GM_LOADV(F.vcu);
    for (int u = F.vcu; u < (T / 128) * 4; u += F.G) {
        const int n = u >> 2, g = u & 3; const int row0 = n * 128;
        v4u raw[4]; const f32x4 s0 = ns0, s1 = ns1;
#pragma unroll
        for (int q = 0; q < 4; ++q) raw[q] = nraw[q];
        __syncthreads();
        {   const float rinv = __builtin_amdgcn_rsqf((((s0[0] + s0[1]) + (s0[2] + s0[3])) + ((s1[0] + s1[1]) + (s1[2] + s1[3]))) * (1.0f / GMW) + EPS);
#pragma unroll
            for (int q = 0; q < 4; ++q) { const int c8 = (csv * 4 + q) * 8;
                const f32x4 g0 = *(const f32x4*)(gvn + g * 128 + c8) * rinv, g1 = *(const f32x4*)(gvn + g * 128 + c8 + 4) * rinv;
                LAS bf16* d = vT + c8 * 136 + jv;
                d[0 * 136] = (bf16)f2bf(bflo(raw[q].x) * g0[0]); d[1 * 136] = (bf16)f2bf(bfhi(raw[q].x) * g0[1]); d[2 * 136] = (bf16)f2bf(bflo(raw[q].y) * g0[2]); d[3 * 136] = (bf16)f2bf(bfhi(raw[q].y) * g0[3]);
                d[4 * 136] = (bf16)f2bf(bflo(raw[q].z) * g1[0]); d[5 * 136] = (bf16)f2bf(bfhi(raw[q].z) * g1[1]); d[6 * 136] = (bf16)f2bf(bflo(raw[q].w) * g1[2]); d[7 * 136] = (bf16)f2bf(bfhi(raw[q].w) * g1[3]); } }
        bf16x8_t bw[4];
#pragma unroll
        for (int ks = 0; ks < 4; ++ks) bw[ks] = *(const bf16x8_t*)(WSB + ((size_t)(g * 128 + 16 * w + fr)) * 128 + 32 * ks + 8 * fq);
        const size_t row = (size_t)row0 + 16 * w + fr; const float bias = bs[g * 128 + 16 * w + fr];
        v2u uu[8];
#pragma unroll
        for (int cb = 0; cb < 8; ++cb) uu[cb] = *(const v2u*)(UACT + row * GMW + g * 128 + 16 * cb + 4 * fq);
        __syncthreads();
        if (u + F.G < (T / 128) * 4) GM_LOADV(u + F.G);
        f32x4 acc[8];
#pragma unroll
        for (int cb = 0; cb < 8; ++cb) { acc[cb] = (f32x4){0.f, 0.f, 0.f, 0.f};
#pragma unroll
            for (int ks = 0; ks < 4; ++ks) { const bf16x8_t a = *(const LAS bf16x8_t*)(vT + (16 * cb + fr) * 136 + 32 * ks + 8 * fq);
                acc[cb] = __builtin_amdgcn_mfma_f32_16x16x32_bf16(a, bw[ks], acc[cb], 0, 0, 0); } }
        float ss = 0.f;
#pragma unroll
        for (int cb = 0; cb < 8; ++cb) {
            v2u o; o.x = pk2(bflo(uu[cb].x) * (acc[cb][0] + bias), bfhi(uu[cb].x) * (acc[cb][1] + bias)); o.y = pk2(bflo(uu[cb].y) * (acc[cb][2] + bias), bfhi(uu[cb].y) * (acc[cb][3] + bias));
            *(v2u*)(MERGED + row * 1024 + g * 128 + 16 * cb + 4 * fq) = o;
            const float a0 = bflo(o.x), a1 = bfhi(o.x), a2 = bflo(o.y), a3 = bfhi(o.y); ss += (a0 * a0 + a1 * a1) + (a2 * a2 + a3 * a3); }
        ss = add_x32(add_x16(ss));
        if (fq == 0) GMSTAT[row * 4 + g] = ss;
    }
#undef GM_LOADV
    __syncthreads();
}

__device__ __forceinline__ void ph_router(Frame& F, int l) {
    const bf16* XR = (const bf16*)(F.ws + WS_XR); float* AFF = (float*)(F.ws + WS_AFF); unsigned char* X8 = F.ws + WS_XR8;
    constexpr int RP = 2064;
    const int gw = F.vcu * NWAVES + F.wave, NGW = F.G * NWAVES;
    for (int blk = gw; blk < T / 16; blk += NGW) {
        int lane_ = lane_id(); asm volatile("" : "+v"(lane_)); const int fr = lane_ & 15, fq = lane_ >> 4;
        v4u x[32];
#pragma unroll
        for (int ks = 0; ks < 32; ++ks) x[ks] = *(const v4u*)(XR + ((size_t)blk * 16 + fr) * D + 128 * (ks >> 2) + 32 * fq + 8 * (ks & 3));
        if (blk == gw) {
        {
            int tid_ = F.wave * 64 + lane_id(); asm volatile("" : "+v"(tid_));
            const bf16* gh = (const bf16*)(F.ws + WS_WRH) + (size_t)l * NE * D; const bf16* gl = (const bf16*)(F.ws + WS_WRL) + (size_t)l * NE * D;
            v4u th[4], tl[4];
#pragma unroll
            for (int i = 0; i < 4; ++i) { const int c = tid_ + 512 * i; th[i] = *(const v4u*)(gh + (size_t)(c >> 7) * D + 8 * (c & 127)); tl[i] = *(const v4u*)(gl + (size_t)(c >> 7) * D + 8 * (c & 127)); }
#pragma unroll
            for (int i = 0; i < 4; ++i) { const int c = tid_ + 512 * i; *(LAS v4u*)(F.lds + (c >> 7) * RP + 16 * (c & 127)) = th[i]; *(LAS v4u*)(F.lds + 16 * RP + (c >> 7) * RP + 16 * (c & 127)) = tl[i]; }
        }
        __syncthreads();
        }
        int wo_ = fr * RP + 64 * fq; asm volatile("" : "+v"(wo_));
        const LAS unsigned char* wp = F.lds + wo_;
        const size_t row = (size_t)blk * 16 + fr;
        f32x4 acc = (f32x4){0.f, 0.f, 0.f, 0.f}; float ss = 0.f;
#pragma unroll
        for (int ks = 0; ks < 32; ++ks) { const bf16x8_t xk = __builtin_bit_cast(bf16x8_t, x[ks]);
            const bf16x8_t wh = *(const LAS bf16x8_t*)(wp + 256 * (ks >> 2) + 16 * (ks & 3)), wl = *(const LAS bf16x8_t*)(wp + 16 * RP + 256 * (ks >> 2) + 16 * (ks & 3));
            acc = __builtin_amdgcn_mfma_f32_16x16x32_bf16(wh, xk, acc, 0, 0, 0); acc = __builtin_amdgcn_mfma_f32_16x16x32_bf16(wl, xk, acc, 0, 0, 0);
            const v4u xb = x[ks];
            const float a0 = bflo(xb.x), a1 = bfhi(xb.x), a2 = bflo(xb.y), a3 = bfhi(xb.y), a4 = bflo(xb.z), a5 = bfhi(xb.z), a6 = bflo(xb.w), a7 = bfhi(xb.w);
            ss += ((a0 * a0 + a1 * a1) + (a2 * a2 + a3 * a3)) + ((a4 * a4 + a5 * a5) + (a6 * a6 + a7 * a7)); }
        ss = add_x32(add_x16(ss));
        const float rinv = __builtin_amdgcn_rsqf(ss * (1.0f / D) + EPS);
        const f32x4 lg = acc * (rinv * LOG2E);
        float mx = fmaxf(fmaxf(lg[0], lg[1]), fmaxf(lg[2], lg[3])); mx = max_x32(max_x16(mx));
        f32x4 pe; float den = 0.f;
#pragma unroll
        for (int i = 0; i < 4; ++i) { pe[i] = __builtin_amdgcn_exp2f(lg[i] - mx); den += pe[i]; }
        den = add_x32(add_x16(den));
        *(f32x4*)(AFF + row * NE + 4 * fq) = pe * __builtin_amdgcn_rcpf(den);
        const float sc = rinv * A8S;
#pragma unroll
        for (int g = 0; g < 8; ++g) {
            v4u o0, o1;
#pragma unroll
            for (int i = 0; i < 4; ++i) asm volatile("" : "+v"(x[4 * g + i]));
#define RT8(xb, lo_, hi_) lo_ = pk4_fp8(bflo(xb.x) * sc, bfhi(xb.x) * sc, bflo(xb.y) * sc, bfhi(xb.y) * sc); hi_ = pk4_fp8(bflo(xb.z) * sc, bfhi(xb.z) * sc, bflo(xb.w) * sc, bfhi(xb.w) * sc);
            RT8(x[4 * g], o0.x, o0.y) RT8(x[4 * g + 1], o0.z, o0.w) RT8(x[4 * g + 2], o1.x, o1.y) RT8(x[4 * g + 3], o1.z, o1.w)
#undef RT8
            *(v4u*)(X8 + row * D + 128 * g + 32 * fq) = o0; *(v4u*)(X8 + row * D + 128 * g + 32 * fq + 16) = o1; }
    }
}

__device__ __forceinline__ void ph_topk(Frame& F) {
    int lane_ = lane_id(); asm volatile("" : "+v"(lane_)); const int tid_ = F.wave * 64 + lane_;
    const float* AFF = (const float*)(F.ws + WS_AFF); int* IDX = (int*)(F.ws + WS_IDX); int* INV = (int*)(F.ws + WS_INV);
    LAS unsigned* hist = (LAS unsigned*)F.lds;
    LAS unsigned* sh = hist + 256;
    LAS unsigned* wsum = hist + 512;
    for (int p = F.vcu; p < NB_ * NE; p += F.G) {
        const int b = p >> 4, e = p & 15;
        unsigned key[16];
#pragma unroll
        for (int i = 0; i < 16; ++i) key[i] = __builtin_bit_cast(unsigned, AFF[((size_t)b * SEQ + tid_ * 16 + i) * NE + e]);
        unsigned prefix = 0u, krem = CAP;
#pragma unroll
        for (int pass = 0; pass < 4; ++pass) {
            const int shift = pass == 3 ? 0 : 23 - 8 * pass; const unsigned dmask = pass == 3 ? 127u : 255u;
            const unsigned himask = pass == 0 ? 0u : (pass == 1 ? 0xff800000u : (pass == 2 ? 0xffff8000u : 0xffffff80u));
            __syncthreads();
            if (tid_ < 256) hist[tid_] = 0u;
            __syncthreads();
#pragma unroll
            for (int i = 0; i < 16; ++i) if ((key[i] & himask) == prefix) atomicAdd((unsigned*)&hist[(key[i] >> shift) & dmask], 1u);
            __syncthreads();
            if (F.wave == 0) {
                unsigned c[4]; unsigned t = 0u;
#pragma unroll
                for (int j = 0; j < 4; ++j) { c[j] = hist[255 - 4 * lane_ - j]; t += c[j]; }
                unsigned inc = t;
#pragma unroll
                for (int o = 1; o < 64; o <<= 1) { const unsigned a = (unsigned)__builtin_amdgcn_ds_bpermute((lane_ - o) << 2, (int)inc); if (lane_ >= o) inc += a; }
                unsigned above = inc - t;
                if (above < krem && krem <= inc) {
                    int d = 255 - 4 * lane_;
#pragma unroll
                    for (int j = 0; j < 3; ++j) { if (above + c[j] < krem) { above += c[j]; d = 254 - 4 * lane_ - j; } else break; }
                    sh[0] = prefix | ((unsigned)d << shift); sh[1] = krem - above; }
            }
            __syncthreads();
            prefix = sh[0]; krem = sh[1];
        }
        const unsigned thr = prefix;
        unsigned cg = 0u, ce = 0u;
#pragma unroll
        for (int i = 0; i < 16; ++i) { cg += key[i] > thr ? 1u : 0u; ce += key[i] == thr ? 1u : 0u; }
        unsigned sg = cg, se = ce;
#pragma unroll
        for (int o = 1; o < 64; o <<= 1) { const unsigned a = (unsigned)__builtin_amdgcn_ds_bpermute((lane_ - o) << 2, (int)sg), c2 = (unsigned)__builtin_amdgcn_ds_bpermute((lane_ - o) << 2, (int)se); if (lane_ >= o) { sg += a; se += c2; } }
        __syncthreads();
        if (lane_ == 63) { wsum[F.wave] = sg; wsum[8 + F.wave] = se; }
        __syncthreads();
        unsigned og = 0u, oe = 0u;
        for (int w = 0; w < F.wave; ++w) { og += wsum[w]; oe += wsum[8 + w]; }
        unsigned gb = og + sg - cg, eb = oe + se - ce;
#pragma unroll
        for (int i = 0; i < 16; ++i) {
            const int t = tid_ * 16 + i; int pos = -1;
            if (key[i] > thr) { pos = (int)(gb + (eb < krem ? eb : krem)); ++gb; }
            else if (key[i] == thr) { if (eb < krem) pos = (int)(gb + eb); ++eb; }
            INV[((size_t)b * SEQ + t) * NE + e] = pos;
            if (pos >= 0) IDX[(size_t)p * CAP + pos] = t;
        }
    }
    __syncthreads();
}

__device__ __forceinline__ void ph_combine(Frame& F, int l, bool dummy) {
    int lane_ = lane_id(); asm volatile("" : "+v"(lane_));
    const float* AFF = (const float*)(F.ws + WS_AFF); const int* INV = (const int*)(F.ws + WS_INV);
    const unsigned char* Y = F.ws + WS_Y; bf16* XR = (bf16*)(F.ws + WS_XR); const float* fg = F.in[21]; float* RINV = (float*)(F.ws + WS_RINV);
    const int gw = F.vcu * NWAVES + F.wave, NGW = F.G * NWAVES;
#define CMB_LOAD_A(X_, POS_, AFF_, M_) do { POS_ = -1; AFF_ = 0.f; if ((M_) < T) { _Pragma("unroll") for (int j_ = 0; j_ < 4; ++j_) X_[j_] = *(const v2u*)(XR + (size_t)(M_) * D + 4 * lane_ + 256 * j_); \
        if (lane_ < NE) { POS_ = INV[(size_t)(M_) * NE + lane_]; AFF_ = AFF[(size_t)(M_) * NE + lane_]; } } } while (0)
#define CMB_ISSUE_Y(W_, AS_, MASK_, POS_, AFF_, M_) do { MASK_ = (unsigned)__builtin_amdgcn_ballot_w64(POS_ >= 0) & 0xffffu; const int b_ = ((M_) < T ? (M_) : 0) / SEQ; \
        _Pragma("unroll") for (int q_ = 0; q_ < 4; ++q_) { AS_[q_] = 0.f; _Pragma("unroll") for (int j_ = 0; j_ < 4; ++j_) W_[q_][j_] = 0; \
            if (MASK_) { const int e_ = __builtin_ctz(MASK_); MASK_ &= MASK_ - 1u; const int pos_ = __builtin_amdgcn_readlane(POS_, e_); \
                AS_[q_] = __builtin_bit_cast(float, __builtin_amdgcn_readlane(__builtin_bit_cast(int, AFF_), e_)) * (1.0f / Y8S); const unsigned char* yr_ = Y + ((size_t)(b_ * NE + e_) * CAP + pos_) * D; \
                _Pragma("unroll") for (int j_ = 0; j_ < 4; ++j_) W_[q_][j_] = *(const int*)(yr_ + 4 * lane_ + 256 * j_); } } } while (0)
#define CMB_ACC(W_, AS_) do { _Pragma("unroll") for (int q_ = 0; q_ < 4; ++q_) _Pragma("unroll") for (int j_ = 0; j_ < 4; ++j_) { \
        const auto lo_ = __builtin_amdgcn_cvt_pk_f32_fp8(W_[q_][j_], false), hi_ = __builtin_amdgcn_cvt_pk_f32_fp8(W_[q_][j_], true); const float l0_ = lo_[0], l1_ = lo_[1], h0_ = hi_[0], h1_ = hi_[1]; \
        v[j_].x += AS_[q_] * l0_; v[j_].y += AS_[q_] * l1_; v[j_].z += AS_[q_] * h0_; v[j_].w += AS_[q_] * h1_; } } while (0)
    v2u cx[4], nx[4]; int cpos, npos; float caff, naff; int cw[4][4]; float cas[4]; unsigned cmask;
    CMB_LOAD_A(cx, cpos, caff, gw); CMB_LOAD_A(nx, npos, naff, gw + NGW);
    CMB_ISSUE_Y(cw, cas, cmask, cpos, caff, gw);
    for (int m = gw; m < T; m += NGW) {
        const int b = m / SEQ;
        bf16* xw = (dummy ? (bf16*)(F.ws + WS_NSCR) : XR) + (size_t)m * D; float* ow = (dummy ? (float*)(F.ws + WS_NSCR) : F.xres) + (size_t)m * D;
        v2u tx[4]; int tw[4][4]; float tas[4]; unsigned tmask; const int tpos = npos; const float taff = naff;
#pragma unroll
        for (int j = 0; j < 4; ++j) tx[j] = nx[j];
        CMB_ISSUE_Y(tw, tas, tmask, tpos, taff, m + NGW);
        CMB_LOAD_A(nx, npos, naff, m + 2 * NGW);
        f32x4 v[4];
#pragma unroll
        for (int j = 0; j < 4; ++j) v[j] = (f32x4){bflo(cx[j].x), bfhi(cx[j].x), bflo(cx[j].y), bfhi(cx[j].y)};
        CMB_ACC(cw, cas);
        while (cmask) {
            int rw[4][4]; float ras[4]; unsigned rm = cmask; const int rpos = cpos; const float raff = caff;
            (void)b;
            {   unsigned mk = rm;
#pragma unroll
                for (int q = 0; q < 4; ++q) { ras[q] = 0.f;
#pragma unroll
                    for (int j = 0; j < 4; ++j) rw[q][j] = 0;
                    if (mk) { const int e = __builtin_ctz(mk); mk &= mk - 1u; const int pos = __builtin_amdgcn_readlane(rpos, e);
                        ras[q] = __builtin_bit_cast(float, __builtin_amdgcn_readlane(__builtin_bit_cast(int, raff), e)) * (1.0f / Y8S); const unsigned char* yr = Y + ((size_t)(b * NE + e) * CAP + pos) * D;
#pragma unroll
                        for (int j = 0; j < 4; ++j) rw[q][j] = *(const int*)(yr + 4 * lane_ + 256 * j); } }
                cmask = mk; }
            CMB_ACC(rw, ras);
        }
#pragma unroll
        for (int j = 0; j < 4; ++j) cx[j] = tx[j];
        cpos = tpos; caff = taff; cmask = tmask;
#pragma unroll
        for (int q = 0; q < 4; ++q) { cas[q] = tas[q];
#pragma unroll
            for (int j = 0; j < 4; ++j) cw[q][j] = tw[q][j]; }
        float s = 0.f;
#pragma unroll
        for (int j = 0; j < 4; ++j) s += (v[j].x * v[j].x + v[j].y * v[j].y) + (v[j].z * v[j].z + v[j].w * v[j].w);
        const float rinv = __builtin_amdgcn_rsqf(wave_sum(s) * (1.0f / D) + EPS);
        if (l == NL - 1) {
#if defined(SELFTEST_F8)
            if (__hip_atomic_load((unsigned*)(F.ws + WS_CTL) + CW_TMO, __ATOMIC_RELAXED, __HIP_MEMORY_SCOPE_AGENT) != 0u) v[0].x = __builtin_nanf("");
#endif
#pragma unroll
            for (int j = 0; j < 4; ++j) { const f32x4 g = *(const f32x4*)(fg + 4 * lane_ + 256 * j); *(f32x4*)(ow + 4 * lane_ + 256 * j) = (f32x4){v[j].x * rinv * g.x, v[j].y * rinv * g.y, v[j].z * rinv * g.z, v[j].w * rinv * g.w}; }
        } else {
            if (lane_ == 0 && !dummy) RINV[m] = rinv;
#pragma unroll
            for (int j = 0; j < 4; ++j) { v2u o; o.x = pk2(v[j].x, v[j].y); o.y = pk2(v[j].z, v[j].w); *(v2u*)(xw + 4 * lane_ + 256 * j) = o; }
        }
    }
}

#undef CMB_LOAD_A
#undef CMB_ISSUE_Y
#undef CMB_ACC
namespace pg8 {
typedef short bf16x8 __attribute__((ext_vector_type(8)));
typedef float f32x2 __attribute__((ext_vector_type(2)));
typedef int v4i_t __attribute__((ext_vector_type(4)));
typedef int v8i_t __attribute__((ext_vector_type(8)));
constexpr int BM = 256, BK = 64, HALF = 128, HTB = HALF * BK * 2, STAGE_BYTES = 8 * HTB, NXCD = 8, WGM = 2;
__host__ __device__ __forceinline__ int lds_byte(int r, int c) { const int st = (r >> 4) * 2 + (c >> 5), rr = r & 15, cc = c & 31, ob = rr * 64 + cc * 2; return st * 1024 + (ob ^ (((ob >> 9) & 1) << 5)); }
__host__ __device__ __forceinline__ void stage_rc(int b, int& R, int& C) { const int st = b / 1024, sb = b % 1024, swz = sb ^ (((sb >> 9) & 1) << 5); R = (st >> 1) * 16 + swz / 64; C = (st & 1) * 32 + (swz % 64) / 2; }
__host__ __device__ __forceinline__ int perm32(int rho) { const int n = rho >> 4, i = rho & 15; return 8 * (i >> 2) + 4 * n + (i & 3); }

struct Unit { int pm, pn, z; const char* a; const char* b; const int* gi; int grow; };

struct TileOrder {
    int nM, nN, nwg, G, c;
    __device__ __forceinline__ void init(int nM_, int nN_, int G_, int c_) { nM = nM_; nN = nN_; nwg = nM * nN; G = G_; c = c_; }
    __device__ __forceinline__ bool tile(int i, int& pm, int& pn) const {
        const long L = (long)i * G + c; if (L >= nwg) return false;
        int wgid = (int)L; { const int q = nwg / NXCD, r = nwg % NXCD, xcd = wgid % NXCD, off = wgid / NXCD; wgid = (xcd < r ? xcd * (q + 1) : r * (q + 1) + (xcd - r) * q) + off; }
        const int nig = WGM * nN, gid = wgid / nig, fm = gid * WGM, gsz = (nM - fm) < WGM ? (nM - fm) : WGM;
        pm = fm + ((wgid % nig) % gsz); pn = (wgid % nig) / gsz; return true;
    }
};

__device__ __forceinline__ unsigned cvt_pk_bf16(float lo, float hi) { unsigned r; asm volatile("v_cvt_pk_bf16_f32 %0, %1, %2" : "=v"(r) : "v"(lo), "v"(hi)); return r; }
typedef f32x4 Acc[2][2][4][2];
#ifndef NT_STORE
#define NT_STORE 0
#endif
__device__ __forceinline__ void st16(void* p, const v4u w, bool nostore = false) { if (nostore) return; if (NT_STORE) __builtin_nontemporal_store(w, (v4u*)p); else *(v4u*)p = w; }
#ifndef NT_Y
#define NT_Y 1
#endif

template <class Epi, class Sched, bool ALIGN_EPI, bool GATHER, bool FP8 = false>
__device__ __forceinline__ void gemm_phase(LAS unsigned char* lds, const int wave_idx, const int lda, const int ldb, const int K, const Sched& S, Epi& E) {
    const int lane = lane_id();
    int wid = wave_idx; asm volatile("" : "+s"(wid));
    const int tid = wid * 64 + lane, wr = wid >> 2, wc = wid & 3, fr = lane & 15, fq = lane >> 4;
    const int nt = K / BK;
    unsigned voffA[2], voffB[2];
#pragma unroll
    for (int i = 0; i < 2; ++i) { int R, C; stage_rc(tid * 16 + i * 8192, R, C); const int Rb = (R & ~31) + perm32(R & 31);
        voffA[i] = (unsigned)(R * lda + C) * 2u; voffB[i] = (unsigned)(Rb * ldb + C) * 2u; }
    const size_t kstep = (size_t)(BK * 2);
    const size_t hstepA = (size_t)HALF * lda * 2, hstepB = (size_t)HALF * ldb * 2;
    const unsigned ldsw = (unsigned)wid * 1024u;
    const int aoff = lds_byte(wr * 64 + fr, fq * 8), boff = lds_byte(wc * 32 + fr, fq * 8);
    unsigned vgc[2][2], vgn[2][2];
#define PG8_SA(b, h) (((b) * 2 + (h)) * HTB)
#define PG8_SB(b, h) ((4 + (b) * 2 + (h)) * HTB)
#define PG8_GL(gp, voff, bufoff, _i) __builtin_amdgcn_global_load_lds((const unsigned*)((const char*)(gp) + (voff)), (LAS unsigned*)(lds + (bufoff) + ldsw + (_i) * 8192), 16, 0, 0)
#define PG8_STAGE_B(bufoff, gbase) do { PG8_GL(gbase, voffB[0], bufoff, 0); PG8_GL(gbase, voffB[1], bufoff, 1); } while (0)
#define PG8_STAGE_A(bufoff, gbase, h, VG) do { if constexpr (GATHER) { PG8_GL(gbase, VG[h][0], bufoff, 0); PG8_GL(gbase, VG[h][1], bufoff, 1); } \
        else { PG8_GL((gbase) + (h) * hstepA, voffA[0], bufoff, 0); PG8_GL((gbase) + (h) * hstepA, voffA[1], bufoff, 1); } } while (0)
#define PG8_CAT(x0, x1) __builtin_shufflevector(__builtin_bit_cast(v4i_t, x0), __builtin_bit_cast(v4i_t, x1), 0, 1, 2, 3, 4, 5, 6, 7)
#define PG8_RD(off) (*(const LAS bf16x8*)(lds + (off)))
#define PG8_LDA(dst, b, h) do { if constexpr (FP8) { _Pragma("unroll") for (int m = 0; m < 4; ++m) dst##8[m] = PG8_CAT(PG8_RD(PG8_SA(b, h) + aoff + m * 2048), PG8_RD(PG8_SA(b, h) + aoff + m * 2048 + 1024)); } \
        else { _Pragma("unroll") for (int m = 0; m < 4; ++m) _Pragma("unroll") for (int k = 0; k < 2; ++k) dst[m][k] = PG8_RD(PG8_SA(b, h) + aoff + m * 2048 + k * 1024); } } while (0)
#define PG8_LDB(dst, b, h) do { if constexpr (FP8) { _Pragma("unroll") for (int n = 0; n < 2; ++n) dst##8[n] = PG8_CAT(PG8_RD(PG8_SB(b, h) + boff + n * 2048), PG8_RD(PG8_SB(b, h) + boff + n * 2048 + 1024)); } \
        else { _Pragma("unroll") for (int n = 0; n < 2; ++n) _Pragma("unroll") for (int k = 0; k < 2; ++k) dst[n][k] = PG8_RD(PG8_SB(b, h) + boff + n * 2048 + k * 1024); } } while (0)
#define PG8_MMA(ai, bj, At, Bt) do { __builtin_amdgcn_s_setprio(1); _Pragma("unroll") for (int m = 0; m < 4; ++m) _Pragma("unroll") for (int n = 0; n < 2; ++n) { \
        if constexpr (FP8) asm volatile("v_mfma_scale_f32_16x16x128_f8f6f4 %0, %1, %2, %0, %3, %3 op_sel_hi:[0,0,0]" : "+v"(acc[ai][bj][m][n]) : "v"(Bt##8[n]), "v"(At##8[m]), "v"(sc8)); \
        else { _Pragma("unroll") for (int k = 0; k < 2; ++k) acc[ai][bj][m][n] = __builtin_amdgcn_mfma_f32_16x16x32_bf16(Bt[n][k], At[m][k], acc[ai][bj][m][n], 0, 0, 0); } } __builtin_amdgcn_s_setprio(0); } while (0)
#define PG8_WAIT_V(n) asm volatile("s_waitcnt vmcnt(" #n ")" ::: "memory")
#define PG8_WAIT_L(n) asm volatile("s_waitcnt lgkmcnt(" #n ")" ::: "memory")
#define PG8_BAR __builtin_amdgcn_s_barrier()
#define PG8_SCHED __builtin_amdgcn_sched_barrier(0)
#define PG8_GIDX(VG, U) do { const int _t = wid * 64 + lane_id();   \
        _Pragma("unroll") for (int _i = 0; _i < 2; ++_i) { int _R, _C; stage_rc(_t * 16 + _i * 8192, _R, _C); _Pragma("unroll") for (int _h = 0; _h < 2; ++_h) \
        VG[_h][_i] = (unsigned)((U).grow + (U).gi[_h * HALF + _R]) * (unsigned)(lda * 2) + (unsigned)_C * 2u; } } while (0)
    Unit cur, nxt; int ui = 0;
    if (!S.next(0, cur)) return;
    Acc acc;
#pragma unroll
    for (int a = 0; a < 2; ++a)
#pragma unroll
        for (int b = 0; b < 2; ++b)
#pragma unroll
            for (int m = 0; m < 4; ++m)
#pragma unroll
                for (int n = 0; n < 2; ++n) acc[a][b][m][n] = (f32x4){0.f, 0.f, 0.f, 0.f};
    bf16x8 At[4][2], B0[2][2], B1[2][2];
    v8i_t At8[4], B08[2], B18[2];
    unsigned sc8 = 0x7f7f7f7fu; asm volatile("" : "+v"(sc8));
    const char* cA = cur.a; const char* cB = cur.b;
    if constexpr (GATHER) { PG8_GIDX(vgc, cur); } else { vgc[0][0] = vgc[0][1] = vgc[1][0] = vgc[1][1] = 0u; }
    E.prep(cur, wr, wc, fr, fq);
    PG8_STAGE_B(PG8_SB(0, 0), cB); PG8_STAGE_B(PG8_SB(0, 1), cB + hstepB); PG8_STAGE_A(PG8_SA(0, 0), cA, 0, vgc); PG8_STAGE_A(PG8_SA(0, 1), cA, 1, vgc);
    if (wr == 1) PG8_BAR;
    PG8_WAIT_V(2); PG8_BAR;
    PG8_STAGE_B(PG8_SB(1, 0), cB + kstep); PG8_STAGE_A(PG8_SA(1, 0), cA + kstep, 0, vgc); PG8_STAGE_B(PG8_SB(1, 1), cB + hstepB + kstep);
    PG8_WAIT_V(6); PG8_BAR;
    for (;;) {
        const bool has_next = S.next(ui + 1, nxt);
        const char* nA = has_next ? nxt.a : cA; const char* nB = has_next ? nxt.b : cB;
        if constexpr (GATHER) { if (has_next) { PG8_GIDX(vgn, nxt); } else {
#pragma unroll
            for (int h = 0; h < 2; ++h) { vgn[h][0] = vgc[h][0]; vgn[h][1] = vgc[h][1]; } } }
        else { vgn[0][0] = vgn[0][1] = vgn[1][0] = vgn[1][1] = 0u; }
        for (int t = 0; t < nt; t += 2) {
            const bool last = (t == nt - 2);
            const char* a1 = cA + (size_t)(t + 1) * kstep;
            const char* a2 = last ? nA : cA + (size_t)(t + 2) * kstep; const char* b2 = last ? nB : cB + (size_t)(t + 2) * kstep;
            const char* a3 = a2 + kstep; const char* b3 = b2 + kstep;
            if constexpr (Epi::MIDK) { if (t == (nt >> 1)) E.midk(acc); }
            PG8_LDB(B0, 0, 0); PG8_LDB(B1, 0, 1); PG8_SCHED; PG8_LDA(At, 0, 0); PG8_STAGE_A(PG8_SA(1, 1), a1, 1, vgc);
            if constexpr (GATHER) { if (last) {
#pragma unroll
                for (int h = 0; h < 2; ++h) { vgc[h][0] = vgn[h][0]; vgc[h][1] = vgn[h][1]; } } }
            PG8_WAIT_V(8); PG8_WAIT_L(0); PG8_BAR; PG8_MMA(0, 0, At, B0); PG8_MMA(0, 1, At, B1); PG8_BAR; PG8_SCHED;
            PG8_LDA(At, 0, 1); PG8_STAGE_B(PG8_SB(0, 0), b2); PG8_STAGE_B(PG8_SB(0, 1), b2 + hstepB); PG8_STAGE_A(PG8_SA(0, 0), a2, 0, vgc);
            PG8_WAIT_V(8); PG8_WAIT_L(0); PG8_BAR; PG8_MMA(1, 0, At, B0); PG8_MMA(1, 1, At, B1); PG8_BAR; PG8_SCHED;
            PG8_LDB(B0, 1, 0); PG8_LDB(B1, 1, 1); PG8_SCHED; PG8_LDA(At, 1, 0); PG8_STAGE_A(PG8_SA(0, 1), a2, 1, vgc);
            PG8_WAIT_V(8); PG8_WAIT_L(0); PG8_BAR; PG8_MMA(0, 0, At, B0); PG8_MMA(0, 1, At, B1); PG8_BAR; PG8_SCHED;
            PG8_LDA(At, 1, 1); PG8_STAGE_B(PG8_SB(1, 0), b3); PG8_STAGE_B(PG8_SB(1, 1), b3 + hstepB); PG8_STAGE_A(PG8_SA(1, 0), a3, 0, vgc);
            PG8_WAIT_V(8); PG8_WAIT_L(0); PG8_BAR; PG8_MMA(1, 0, At, B0); PG8_MMA(1, 1, At, B1); PG8_BAR; PG8_SCHED;
        }
        if constexpr (ALIGN_EPI) { if (wr == 0) PG8_BAR; }
        if constexpr (FP8) asm volatile("s_nop 15\n\ts_nop 15\n\ts_nop 15\n\ts_nop 15" ::: "memory");
        E(acc, cur, wr, wc, fr, fq);
        if (!has_next) break;
#pragma unroll
        for (int a = 0; a < 2; ++a)
#pragma unroll
            for (int b = 0; b < 2; ++b)
#pragma unroll
                for (int m = 0; m < 4; ++m)
#pragma unroll
                    for (int n = 0; n < 2; ++n) acc[a][b][m][n] = (f32x4){0.f, 0.f, 0.f, 0.f};
        cur = nxt; cA = nA; cB = nB; ++ui;
#pragma unroll
        for (int h = 0; h < 2; ++h) { vgc[h][0] = vgn[h][0]; vgc[h][1] = vgn[h][1]; }
        E.prep(cur, wr, wc, fr, fq);
        if constexpr (ALIGN_EPI) { if (wr == 1) PG8_BAR; }
    }
    PG8_WAIT_V(0);
    if constexpr (!ALIGN_EPI) { if (wr == 0) PG8_BAR; }
    PG8_BAR;
#undef PG8_SA
#undef PG8_SB
#undef PG8_GL
#undef PG8_STAGE_A
#undef PG8_STAGE_B
#undef PG8_LDA
#undef PG8_RD
#undef PG8_LDB
#undef PG8_MMA
#undef PG8_CAT
#undef PG8_WAIT_V
#undef PG8_WAIT_L
#undef PG8_SCHED
#undef PG8_GIDX
}

#define EPI_ROWS for (int ai = 0; ai < 2; ++ai) _Pragma("unroll") for (int m = 0; m < 4; ++m)
__device__ __forceinline__ v4u pack8(const f32x4 a, const f32x4 b) { v4u w; w.x = cvt_pk_bf16(a[0], a[1]); w.y = cvt_pk_bf16(a[2], a[3]); w.z = cvt_pk_bf16(b[0], b[1]); w.w = cvt_pk_bf16(b[2], b[3]); return w; }

__device__ __forceinline__ void st8x2(unsigned char* pa, unsigned char* pb, const v2u a, const v2u b, const int fq, const bool nt) {
    const auto r0 = __builtin_amdgcn_permlane16_swap(a.x, b.x, false, false); const auto r1 = __builtin_amdgcn_permlane16_swap(a.y, b.y, false, false);
    const unsigned x0 = r0[0], x1 = r0[1], y0 = r1[0], y1 = r1[1];
    const v4u w = (v4u){x0, y0, x1, y1};
    unsigned char* p = (fq & 1) ? pb - 8 : pa;
    if (nt) __builtin_nontemporal_store(w, (v4u*)p); else *(v4u*)p = w;
}
template <int mode, bool OUT8 = false>
struct EpiStore {
    static constexpr bool MIDK = false;
    bf16* O; int ldc; const float* cs; float scale; bool skip = false;
    __device__ __forceinline__ void prep(const Unit&, int, int, int, int) {}
    __device__ __forceinline__ void midk(Acc&) {}
    __device__ __forceinline__ void operator()(const Acc& acc, const Unit& u, int wr, int wc, int fr, int fq) const {
        asm volatile("" : "+v"(fr), "+v"(fq));
        if (skip) return;
        size_t base; const float* csp = cs;
        if constexpr (mode == 0) base = (size_t)u.pm * 256 * ldc + (size_t)u.pn * 256;
        else if constexpr (mode == 1) { const int lb = u.pm >> 2, h = u.pm & 3; base = (size_t)lb * D * D + (size_t)(h * 256) * D + u.pn * 256; csp = cs + (size_t)(lb >> 2) * D + u.pn * 256; }
        else if constexpr (mode == 2) { const int pml = u.pm & 3, lbh = u.pm >> 2, h = lbh & 3, lb = lbh >> 2; base = (size_t)lb * D * D + (size_t)(pml * 256) * D + h * 256; }
        else { const int l = u.pm >> 2, pml = u.pm & 3; base = (size_t)l * NMEM * 2 * D + (size_t)(pml * 256) * 2 * D + u.pn * 256; }
        const int cb = wc * 32 + 8 * fq;
        f32x4 c0[2], c1[2];
#pragma unroll
        for (int bj = 0; bj < 2; ++bj) { if (csp) { c0[bj] = *(const f32x4*)(csp + bj * HALF + cb) * scale; c1[bj] = *(const f32x4*)(csp + bj * HALF + cb + 4) * scale; } else { c0[bj] = (f32x4){scale, scale, scale, scale}; c1[bj] = c0[bj]; } }
#pragma unroll
        EPI_ROWS { bf16* rowp = O + base + (size_t)(ai * HALF + wr * 64 + m * 16 + fr) * ldc + cb;
            if constexpr (OUT8) { unsigned char* rp8 = (unsigned char*)O + base + (size_t)(ai * HALF + wr * 64 + m * 16 + fr) * ldc + cb;
#pragma unroll
                for (int bj = 0; bj < 2; ++bj) { const f32x4 a = acc[ai][bj][m][0] * c0[bj], b = acc[ai][bj][m][1] * c1[bj]; v2u o; o.x = pk4_fp8(a[0], a[1], a[2], a[3]); o.y = pk4_fp8(b[0], b[1], b[2], b[3]); *(v2u*)(rp8 + bj * HALF) = o; } }
            else
#pragma unroll
            for (int bj = 0; bj < 2; ++bj) { const v4u w_ = pack8(acc[ai][bj][m][0] * c0[bj], acc[ai][bj][m][1] * c1[bj]); if constexpr (mode == 0 && NT_Y) __builtin_nontemporal_store(w_, (v4u*)(rowp + bj * HALF)); else *(v4u*)(rowp + bj * HALF) = w_; } }
    }
};
struct EpiH {
    static constexpr bool MIDK = false;
    unsigned char* H;
    __device__ __forceinline__ void prep(const Unit&, int, int, int, int) {}
    __device__ __forceinline__ void midk(Acc&) {}
    __device__ __forceinline__ void operator()(const Acc& acc, const Unit& u, int wr, int wc, int fr, int fq) const {
        asm volatile("" : "+v"(fr), "+v"(fq));
        const int cb = u.pn * 128 + wc * 32 + 8 * fq; constexpr float us = 1.0f / (W8S * A8S);
#pragma unroll
        for (int ai = 0; ai < 2; ++ai)
#pragma unroll
            for (int m = 0; m < 4; m += 2) { const int rl = ai * HALF + wr * 64 + m * 16 + fr; unsigned char* rowp = H + (size_t)(u.pm * 256 + rl) * FF + cb;
                v2u o[2];
#pragma unroll
                for (int q = 0; q < 2; ++q) { const f32x4 h0 = silu_mul4(acc[ai][0][m + q][0], acc[ai][1][m + q][0], us, H8S), h1 = silu_mul4(acc[ai][0][m + q][1], acc[ai][1][m + q][1], us, H8S);
                    o[q].x = pk4_fp8(h0[0], h0[1], h0[2], h0[3]); o[q].y = pk4_fp8(h1[0], h1[1], h1[2], h1[3]); }
                st8x2(rowp, rowp + (size_t)16 * FF, o[0], o[1], fq, false); }
    }
};
struct EpiY8 {
    static constexpr bool MIDK = false;
    unsigned char* Y; float scale; bool skip = false, halfst = false;
    __device__ __forceinline__ void prep(const Unit&, int, int, int, int) {}
    __device__ __forceinline__ void midk(Acc&) {}
    __device__ __forceinline__ void operator()(const Acc& acc, const Unit& u, int wr, int wc, int fr, int fq) const {
        if (skip) return;
        asm volatile("" : "+v"(fr), "+v"(fq));
        const int cb = u.pn * 256 + wc * 32 + 8 * fq;
#pragma unroll
        for (int ai = 0; ai < 2; ++ai)
#pragma unroll
            for (int m = 0; m < 4; m += 2) { unsigned char* rp0 = Y + (size_t)(u.pm * 256 + ai * HALF + wr * 64 + m * 16 + fr) * D + cb; unsigned char* rp1 = rp0 + (size_t)16 * D;
#pragma unroll
                for (int bj = 0; bj < 2; ++bj) { v2u o0, o1;
                    { const f32x4 a = acc[ai][bj][m][0] * scale, b = acc[ai][bj][m][1] * scale; o0.x = pk4_fp8(a[0], a[1], a[2], a[3]); o0.y = pk4_fp8(b[0], b[1], b[2], b[3]); }
                    { const f32x4 a = acc[ai][bj][m + 1][0] * scale, b = acc[ai][bj][m + 1][1] * scale; o1.x = pk4_fp8(a[0], a[1], a[2], a[3]); o1.y = pk4_fp8(b[0], b[1], b[2], b[3]); }
                    st8x2(rp0 + bj * HALF, rp1 + bj * HALF, o0, o1, fq, false); } }
    }
};
template <bool MK, bool WRITE_XB>
struct EpiX {
    static constexpr bool MIDK = MK;
    bf16* xr; float* xstat; const float* gmstat; const float* atstat; LAS unsigned char* lds; unsigned char* xa8; float scale;
#if REPK == 2 || REPK == 4
    long wofs = 0;
#else
    static constexpr long wofs = 0;
#endif
    int wr_, wc_, fr_;
    __device__ __forceinline__ void prep(const Unit& u, int wr, int wc, int fr, int fq) {
        wr_ = wr; wc_ = wc; fr_ = fr;
        if constexpr (MK) {
            asm volatile("" : "+v"(fr), "+v"(fq));
            LAS f32x2* X = (LAS f32x2*)(lds + RING_BYTES + 1024) + (wr * 4 + wc) * 128;
#pragma unroll
            EPI_ROWS { const size_t row = (size_t)u.pm * 256 + ai * HALF + wr * 64 + m * 16 + fr;
                const f32x4 g = *(const f32x4*)(gmstat + row * 4), a0 = *(const f32x4*)(atstat + row * 8), a1 = *(const f32x4*)(atstat + row * 8 + 4);
                const float sg = (g[0] + g[1]) + (g[2] + g[3]), sa = ((a0[0] + a0[1]) + (a0[2] + a0[3])) + ((a1[0] + a1[1]) + (a1[2] + a1[3]));
                const float rgm = __builtin_amdgcn_rsqf(sg * (1.0f / 512.0f) + EPS), rat = __builtin_amdgcn_rsqf(sa * (1.0f / 512.0f) + EPS);
                if (fq == 0) X[(ai * 4 + m) * 16 + fr] = (f32x2){rgm / rat, rat}; }
            asm volatile("s_waitcnt lgkmcnt(0)" ::: "memory");
        }
    }
    __device__ __forceinline__ void midk(Acc& acc) {
        int fr = fr_; asm volatile("" : "+v"(fr));
        const LAS f32x2* X = (const LAS f32x2*)(lds + RING_BYTES + 1024) + (wr_ * 4 + wc_) * 128;
#pragma unroll
        EPI_ROWS { const float f = X[(ai * 4 + m) * 16 + fr].x;
#pragma unroll
            for (int bj = 0; bj < 2; ++bj) { acc[ai][bj][m][0] *= f; acc[ai][bj][m][1] *= f; } }
    }
    __device__ __forceinline__ void operator()(const Acc& acc, const Unit& u, int wr, int wc, int fr, int fq) const {
        asm volatile("" : "+v"(fr), "+v"(fq));
        const int cb = u.pn * 256 + wc * 32 + 8 * fq;
        v4u rb[2][4][2];
#define EPX_LOAD(AI) _Pragma("unroll") for (int mm = 0; mm < 4; ++mm) _Pragma("unroll") for (int bj = 0; bj < 2; ++bj) rb[AI][mm][bj] = *(const v4u*)(xr + ((size_t)u.pm * 256 + (AI) * HALF + wr * 64 + mm * 16 + fr) * D + cb + bj * HALF);
        if constexpr (!WRITE_XB) { EPX_LOAD(0) EPX_LOAD(1) }
#pragma unroll
        for (int ai = 0; ai < 2; ++ai) {
            if constexpr (WRITE_XB) { if (ai == 0) { EPX_LOAD(0) } else { EPX_LOAD(1) } }
#pragma unroll
            for (int m = 0; m < 4; m += 2) {
                v2u o8[2][2];
#pragma unroll
                for (int q = 0; q < 2; ++q) { const size_t row = (size_t)u.pm * 256 + ai * HALF + wr * 64 + (m + q) * 16 + fr; const size_t off = row * D + cb;
                    float f = scale; if constexpr (MK) f = ((const LAS f32x2*)(lds + RING_BYTES + 1024) + (wr * 4 + wc) * 128)[(ai * 4 + m + q) * 16 + fr].y; float ss = 0.f;
#pragma unroll
                    for (int bj = 0; bj < 2; ++bj) { const v4u b = rb[ai][m + q][bj];
                        const f32x4 x0 = (f32x4){bflo(b.x), bfhi(b.x), bflo(b.y), bfhi(b.y)} + acc[ai][bj][m + q][0] * f, x1 = (f32x4){bflo(b.z), bfhi(b.z), bflo(b.w), bfhi(b.w)} + acc[ai][bj][m + q][1] * f;
                        *(v4u*)(xr + wofs + off + bj * HALF) = pack8(x0, x1);
                        if constexpr (WRITE_XB) { o8[q][bj].x = pk4_fp8(x0[0] * A8S, x0[1] * A8S, x0[2] * A8S, x0[3] * A8S); o8[q][bj].y = pk4_fp8(x1[0] * A8S, x1[1] * A8S, x1[2] * A8S, x1[3] * A8S);
                            ss += ((x0[0] * x0[0] + x0[1] * x0[1]) + (x0[2] * x0[2] + x0[3] * x0[3])) + ((x1[0] * x1[0] + x1[1] * x1[1]) + (x1[2] * x1[2] + x1[3] * x1[3])); } }
                    if constexpr (WRITE_XB) { ss = add_x32(add_x16(ss)); if (fq == 0) xstat[row * 16 + u.pn * 4 + wc] = ss; } }
                if constexpr (WRITE_XB) { unsigned char* rp = xa8 + ((size_t)u.pm * 256 + ai * HALF + wr * 64 + m * 16 + fr) * D + cb;
#pragma unroll
                    for (int bj = 0; bj < 2; ++bj) st8x2(rp + bj * HALF, rp + (size_t)16 * D + bj * HALF, o8[0][bj], o8[1][bj], fq, false); }
                asm volatile("" ::: "memory"); } }
#undef EPX_LOAD
    }
};
constexpr int EXCH_OFF = RING_BYTES + 1024;
struct EpiS {
    static constexpr bool MIDK = false;
    const float* xstat; unsigned char* P; LAS unsigned char* lds;
    __device__ __forceinline__ void prep(const Unit&, int, int, int, int) {}
    __device__ __forceinline__ void midk(Acc&) {}
    __device__ __forceinline__ void operator()(Acc& acc, const Unit& u, int wr, int wc, int fr, int fq) const {
        asm volatile("" : "+v"(fr), "+v"(fq));
        LAS f32x2* X = (LAS f32x2*)(lds + EXCH_OFF);
        float mw[2][4];
#pragma unroll
        EPI_ROWS { const int rl = ai * HALF + wr * 64 + m * 16 + fr; const size_t row = (size_t)u.pm * 256 + rl;
            const f32x4 s0 = *(const f32x4*)(xstat + row * 16), s1 = *(const f32x4*)(xstat + row * 16 + 4), s2 = *(const f32x4*)(xstat + row * 16 + 8), s3 = *(const f32x4*)(xstat + row * 16 + 12);
            const float ssq = (((s0[0] + s0[1]) + (s0[2] + s0[3])) + ((s1[0] + s1[1]) + (s1[2] + s1[3]))) + (((s2[0] + s2[1]) + (s2[2] + s2[3])) + ((s3[0] + s3[1]) + (s3[2] + s3[3])));
            const float rinv = __builtin_amdgcn_rsqf(ssq * (1.0f / D) + EPS) * (1.0f / (A8S * Q8S));
            float mx = -3.0e38f;
#pragma unroll
            for (int bj = 0; bj < 2; ++bj)
#pragma unroll
                for (int n = 0; n < 2; ++n) { acc[ai][bj][m][n] *= rinv; const f32x4 v = acc[ai][bj][m][n]; mx = fmaxf(mx, fmaxf(fmaxf(v[0], v[1]), fmaxf(v[2], v[3]))); }
            mx = max_x32(max_x16(mx));
            float sm = 0.f;
#pragma unroll
            for (int bj = 0; bj < 2; ++bj)
#pragma unroll
                for (int n = 0; n < 2; ++n) { f32x4 v = acc[ai][bj][m][n];
#pragma unroll
                    for (int i = 0; i < 4; ++i) { v[i] = __builtin_amdgcn_exp2f(v[i] - mx); sm += v[i]; }
                    acc[ai][bj][m][n] = v; }
            sm = add_x32(add_x16(sm));
            mw[ai][m] = mx;
            if (fq == 0) X[rl * 4 + wc] = (f32x2){mx, sm};
            if (m & 1) asm volatile("" ::: "memory"); }
        asm volatile("s_waitcnt lgkmcnt(0)\n\ts_barrier" ::: "memory");
        const int cb = u.pn * 256 + wc * 32 + 8 * fq;
#pragma unroll
        for (int ai = 0; ai < 2; ++ai)
#pragma unroll
            for (int m = 0; m < 4; m += 2) { float f[2];
#pragma unroll
                for (int q = 0; q < 2; ++q) { const int rl = ai * HALF + wr * 64 + (m + q) * 16 + fr;
                    const f32x2 e0 = X[rl * 4 + 0], e1 = X[rl * 4 + 1], e2 = X[rl * 4 + 2], e3 = X[rl * 4 + 3];
                    const float M = fmaxf(fmaxf(e0.x, e1.x), fmaxf(e2.x, e3.x));
                    const float den = (e0.y * __builtin_amdgcn_exp2f(e0.x - M) + e1.y * __builtin_amdgcn_exp2f(e1.x - M)) + (e2.y * __builtin_amdgcn_exp2f(e2.x - M) + e3.y * __builtin_amdgcn_exp2f(e3.x - M));
                    f[q] = __builtin_amdgcn_exp2f(mw[ai][m + q] - M) * __builtin_amdgcn_rcpf(den) * P8S; }
                unsigned char* rp = P + ((size_t)u.pm * 256 + ai * HALF + wr * 64 + m * 16 + fr) * D + cb;
#pragma unroll
                for (int bj = 0; bj < 2; ++bj) { v2u o[2];
#pragma unroll
                    for (int q = 0; q < 2; ++q) { const f32x4 a = acc[ai][bj][m + q][0] * f[q], b = acc[ai][bj][m + q][1] * f[q]; o[q].x = pk4_fp8(a[0], a[1], a[2], a[3]); o[q].y = pk4_fp8(b[0], b[1], b[2], b[3]); }
                    st8x2(rp + bj * HALF, rp + (size_t)16 * D + bj * HALF, o[0], o[1], fq, false); } }
        asm volatile("s_waitcnt lgkmcnt(0)" ::: "memory");
    }
};
struct EpiIn {
    static constexpr bool MIDK = false;
    bf16 *uact, *vact, *q, *k, *v; float* vstat; const float *qg, *kg, *cosT, *sinT, *rinv; bool nostore = false, skip = false;
    __device__ __forceinline__ void prep(const Unit&, int, int, int, int) {}
    __device__ __forceinline__ void midk(Acc&) {}
    __device__ __forceinline__ void operator()(const Acc& acc, const Unit& u, int wr, int wc, int fr, int fq) const {
        asm volatile("" : "+v"(fr), "+v"(fq));
        if (skip) return;
        const int pn = u.pn;
        if (pn < 4) {
            bf16* O = pn < 2 ? uact : vact; const int cb = (pn & 1) * 256 + wc * 32 + 8 * fq;
#pragma unroll
            EPI_ROWS { const size_t row = (size_t)u.pm * 256 + ai * HALF + wr * 64 + m * 16 + fr; float ss = 0.f; const float ri = rinv[row];
#pragma unroll
                for (int bj = 0; bj < 2; ++bj) { const f32x4 g0 = gelu4(acc[ai][bj][m][0] * ri), g1 = gelu4(acc[ai][bj][m][1] * ri);
                    const v4u w = pack8(g0, g1); st16(O + row * GMW + cb + bj * HALF, w, nostore);
                    if (pn >= 2) { const float a0 = bflo(w.x), a1 = bfhi(w.x), a2 = bflo(w.y), a3 = bfhi(w.y), a4 = bflo(w.z), a5 = bfhi(w.z), a6 = bflo(w.w), a7 = bfhi(w.w);
                        ss += ((a0 * a0 + a1 * a1) + (a2 * a2 + a3 * a3)) + ((a4 * a4 + a5 * a5) + (a6 * a6 + a7 * a7)); } }
                if (pn >= 2) { ss = add_x32(add_x16(ss)); if (fq == 0) vstat[row * 8 + (pn - 2) * 4 + wc] = ss; } }
        } else if (pn == 6 && wc >= 2) {
#pragma unroll
            EPI_ROWS { const size_t row = (size_t)u.pm * 256 + ai * HALF + wr * 64 + m * 16 + fr; const float ri = rinv[row];
#pragma unroll
                for (int bj = 0; bj < 2; ++bj) st16(v + row * 128 + (wc - 2) * 64 + bj * 32 + 8 * fq, pack8(acc[ai][bj][m][0] * ri, acc[ai][bj][m][1] * ri), nostore); }
        } else {
            const bool isq = pn < 6; const float* g = isq ? qg : kg; const float sc = isq ? QSCALE : 1.0f;
            bf16* O = isq ? q + ((pn - 4) * 4 + wc) * 64 : k + wc * 64; const int ldo = isq ? 512 : 128;
            f32x4 gv[2][2];
#pragma unroll
            for (int bj = 0; bj < 2; ++bj) { gv[bj][0] = *(const f32x4*)(g + bj * 32 + 8 * fq) * sc; gv[bj][1] = *(const f32x4*)(g + bj * 32 + 8 * fq + 4) * sc; }
#pragma unroll
            EPI_ROWS { const size_t row = (size_t)u.pm * 256 + ai * HALF + wr * 64 + m * 16 + fr; const int t = (int)(row % SEQ); const float ri = this->rinv[row];
                float ss = 0.f;
#pragma unroll
                for (int bj = 0; bj < 2; ++bj)
#pragma unroll
                    for (int n = 0; n < 2; ++n) { const f32x4 x = acc[ai][bj][m][n]; ss += (x[0] * x[0] + x[1] * x[1]) + (x[2] * x[2] + x[3] * x[3]); }
                ss = add_x32(add_x16(ss));
                const float rinv = ri * __builtin_amdgcn_rsqf(ss * (ri * ri) * (1.0f / 64.0f) + EPS);
#pragma unroll
                for (int bj = 0; bj < 2; ++bj) { const f32x4 c = *(const f32x4*)(cosT + t * 32 + bj * 16 + 4 * fq), sn = *(const f32x4*)(sinT + t * 32 + bj * 16 + 4 * fq);
                    const f32x4 x0 = acc[ai][bj][m][0] * gv[bj][0] * rinv, x1 = acc[ai][bj][m][1] * gv[bj][1] * rinv; f32x4 o0, o1;
                    o0[0] = x0[0] * c[0] - x0[1] * sn[0]; o0[1] = x0[0] * sn[0] + x0[1] * c[0]; o0[2] = x0[2] * c[1] - x0[3] * sn[1]; o0[3] = x0[2] * sn[1] + x0[3] * c[1];
                    o1[0] = x1[0] * c[2] - x1[1] * sn[2]; o1[1] = x1[0] * sn[2] + x1[1] * c[2]; o1[2] = x1[2] * c[3] - x1[3] * sn[3]; o1[3] = x1[2] * sn[3] + x1[3] * c[3];
                    st16(O + row * ldo + bj * 32 + 8 * fq, pack8(o0, o1), nostore); }
                if (m & 1) asm volatile("" ::: "memory"); }
        }
    }
};
}


struct CvtJob { const float* W; const float* gain; bf16* WT; int K, N, dst_row0, k0, n0; bool f8; };
__device__ __forceinline__ CvtJob cvt_decode(const Frame& F, int it) {
    constexpr int I_IN = 16 * 56, I_SQ = 512, I_KV = 1024, I_HEAD = I_IN + I_SQ + I_KV + I_SQ, I_LAYER = I_HEAD + NE * 3 * I_SQ;
    CvtJob j; j.f8 = false; const int l = it / I_LAYER; int r = it % I_LAYER;
    if (r < I_IN) { const int kb = r / 56, nb = r % 56, n0 = nb * 32, pn = n0 >> 8; int dr = n0;
        if (pn >= 4) { const int sidx = n0 & 255, w = sidx >> 6, bj = (sidx >> 5) & 1; dr = pn * 256 + 128 * bj + 32 * w; }
        j.W = F.in[3] + (size_t)l * D * INW; j.gain = F.in[2] + (size_t)l * D; j.WT = (bf16*)(F.ws + WS_WIN) + (size_t)l * INW * D; j.K = D; j.N = INW; j.dst_row0 = dr; j.k0 = kb * 64; j.n0 = n0; return j; }
    r -= I_IN;
    if (r < I_SQ) { j.W = F.in[10] + (size_t)l * D * D; j.gain = F.in[9] + (size_t)l * D; j.WT = (bf16*)(F.ws + WS_WOUT) + (size_t)l * D * D; j.K = D; j.N = D; j.dst_row0 = (r % 32) * 32; j.k0 = (r / 32) * 64; j.n0 = (r % 32) * 32; return j; }
    r -= I_SQ;
    if (r < I_KV) { j.W = F.in[14] + (size_t)l * D * 2 * D; j.gain = nullptr; j.WT = (bf16*)(F.ws + WS_WKVT) + (size_t)l * 2 * D * D; j.K = D; j.N = 2 * D; j.dst_row0 = (r % 64) * 32; j.k0 = (r / 64) * 64; j.n0 = (r % 64) * 32; return j; }
    r -= I_KV;
    if (r < I_SQ) { j.W = F.in[15] + (size_t)l * D * D; j.gain = nullptr; j.WT = (bf16*)(F.ws + WS_WOT) + (size_t)l * D * D; j.K = D; j.N = D; j.dst_row0 = (r % 32) * 32; j.k0 = (r / 32) * 64; j.n0 = (r % 32) * 32; return j; }
    r -= I_SQ;
    const int e = r / (3 * I_SQ), rr = r % (3 * I_SQ), which = rr / I_SQ, sub = rr % I_SQ, kb = sub / 32, n0 = (sub % 32) * 32;
    const size_t mo = ((size_t)l * NE + e) * D * FF;
    j.K = D; j.N = FF; j.k0 = kb * 64; j.n0 = n0;
    j.f8 = true;
    if (which == 2) { j.W = F.in[20] + mo; j.gain = nullptr; j.WT = (bf16*)(F.ws + WS_WD + mo); j.dst_row0 = n0; }
    else { j.W = (which == 0 ? F.in[18] : F.in[19]) + mo; j.gain = F.in[16] + (size_t)l * D; j.WT = (bf16*)(F.ws + WS_WGU + 2 * mo); j.dst_row0 = 256 * (n0 >> 7) + 128 * which + (n0 & 127); }
    return j;
}
#define CVT_LOAD(J, R) do { const float* p_ = (J).W + (size_t)((J).k0 + (lane_ >> 5)) * (J).N + (J).n0 + (lane_ & 31); _Pragma("unroll") for (int i_ = 0; i_ < 32; ++i_) R[i_] = __builtin_nontemporal_load(p_ + (size_t)(2 * i_) * (J).N); } while (0)
__device__ __forceinline__ void ph_convert(Frame& F) {
    int lane_ = lane_id(); asm volatile("" : "+v"(lane_)); const int tid_ = F.wave * 64 + lane_;
    LAS float* scr = (LAS float*)(F.lds + F.wave * 16384);
    const int gw = F.vcu * NWAVES + F.wave, NGW = F.G * NWAVES;
    constexpr int I_LAYER = 16 * 56 + 512 + 1024 + 512 + NE * 3 * 512, NITEMS = NL * I_LAYER;
    if (gw < NITEMS) {
        int it = gw; CvtJob cur = cvt_decode(F, it); float r[32]; CVT_LOAD(cur, r);
        for (;;) {
            const int nit = it + NGW; const bool hn = nit < NITEMS; CvtJob nx = cur; if (hn) nx = cvt_decode(F, nit);
#pragma unroll
            for (int i = 0; i < 32; ++i) scr[(2 * i + (lane_ >> 5)) * 33 + (lane_ & 31)] = r[i];
            if (hn) CVT_LOAD(nx, r);
            asm volatile("s_waitcnt lgkmcnt(0)" ::: "memory");
            const int c = lane_ & 7;
            f32x4 g0 = (f32x4){1.f, 1.f, 1.f, 1.f}, g1 = g0;
            if (cur.gain) { g0 = *(const f32x4*)(cur.gain + cur.k0 + 8 * c); g1 = *(const f32x4*)(cur.gain + cur.k0 + 8 * c + 4); }
#pragma unroll
            for (int j = 0; j < 4; ++j) { const int n = (lane_ >> 3) + 8 * j; const LAS float* sp = scr + (8 * c) * 33 + n;
                if (cur.f8) { v2u o; o.x = pk4_fp8(sp[0 * 33] * g0[0] * W8S, sp[1 * 33] * g0[1] * W8S, sp[2 * 33] * g0[2] * W8S, sp[3 * 33] * g0[3] * W8S); o.y = pk4_fp8(sp[4 * 33] * g1[0] * W8S, sp[5 * 33] * g1[1] * W8S, sp[6 * 33] * g1[2] * W8S, sp[7 * 33] * g1[3] * W8S);
                    *(v2u*)((unsigned char*)cur.WT + (size_t)(cur.dst_row0 + n) * cur.K + cur.k0 + 8 * c) = o; }
                else { v4u o; o.x = pk2(sp[0 * 33] * g0[0], sp[1 * 33] * g0[1]); o.y = pk2(sp[2 * 33] * g0[2], sp[3 * 33] * g0[3]); o.z = pk2(sp[4 * 33] * g1[0], sp[5 * 33] * g1[1]); o.w = pk2(sp[6 * 33] * g1[2], sp[7 * 33] * g1[3]);
                    *(v4u*)(cur.WT + (size_t)(cur.dst_row0 + n) * cur.K + cur.k0 + 8 * c) = o; } }
            asm volatile("s_waitcnt lgkmcnt(0)" ::: "memory");
            if (!hn) break; cur = nx; it = nit;
        }
    }
    {   const float* wsrc = F.in[5]; bf16* WSBd = (bf16*)(F.ws + WS_WSB);
        for (int i = F.vcu * NTHR + tid_; i < NL * 4 * 128 * 128 / 8; i += F.G * NTHR) { const f32x4 a = *(const f32x4*)(wsrc + (size_t)i * 8), b = *(const f32x4*)(wsrc + (size_t)i * 8 + 4);
            v4u o; o.x = pk2(a.x, a.y); o.y = pk2(a.z, a.w); o.z = pk2(b.x, b.y); o.w = pk2(b.z, b.w); *(v4u*)(WSBd + (size_t)i * 8) = o; } }
    {   bf16* WRH = (bf16*)(F.ws + WS_WRH); bf16* WRL = (bf16*)(F.ws + WS_WRL);
        for (int i = F.vcu * NTHR + tid_; i < NL * NE * D; i += F.G * NTHR) { const int l = i / (NE * D), e = (i / D) % NE, c = i % D;
            const float w = F.in[17][((size_t)l * D + c) * NE + e] * F.in[16][(size_t)l * D + c]; const unsigned h = f2bf(w); WRH[i] = (bf16)h; WRL[i] = (bf16)f2bf(w - bf2f(h)); } }
    const int gt = F.vcu * NTHR + tid_, NGT = F.G * NTHR;
    const float* wq = F.in[13]; bf16* WQB = (bf16*)(F.ws + WS_WQB);
    for (int i = gt; i < NL * D * D / 8; i += NGT) { const f32x4 a = *(const f32x4*)(wq + (size_t)i * 8), b = *(const f32x4*)(wq + (size_t)i * 8 + 4);
        v4u o; o.x = pk2(a.x, a.y); o.y = pk2(a.z, a.w); o.z = pk2(b.x, b.y); o.w = pk2(b.z, b.w); *(v4u*)(WQB + (size_t)i * 8) = o; }
}

struct SchedDense {
    pg8::TileOrder o; const char* A; size_t a_tile; const char* B; size_t b_tile, b_batch; int bdiv, bmod;
    __device__ __forceinline__ bool next(int i, pg8::Unit& u) const { if (!o.tile(i, u.pm, u.pn)) return false;
        u.z = 0; u.gi = nullptr; u.grow = 0; u.a = A + (size_t)u.pm * a_tile; u.b = B + (size_t)((u.pm / bdiv) % bmod) * b_batch + (size_t)u.pn * b_tile; return true; }
};
struct SchedE1 {
    pg8::TileOrder o; const char* HBp; const int* IDX; const char* WGU;
    __device__ __forceinline__ bool next(int i, pg8::Unit& u) const { if (!o.tile(i, u.pm, u.pn)) return false;
        const int z = u.pm >> 2; u.z = z; u.gi = IDX + (size_t)u.pm * 256; u.grow = (z >> 4) * SEQ; u.a = HBp;
        u.b = WGU + (size_t)(z & 15) * (2 * FF * D) + (size_t)u.pn * (256 * D); return true; }
};
struct SchedKV { pg8::TileOrder o; const char* MEMN; const char* WKVT; int pm0 = 0;
    __device__ __forceinline__ bool next(int i, pg8::Unit& u) const { if (!o.tile(i, u.pm, u.pn)) return false; u.pm += pm0; u.z = 0; u.gi = nullptr; u.grow = 0;
        u.a = MEMN + (size_t)(u.pm & 3) * (256 * D * 2); u.b = WKVT + (size_t)(u.pm >> 2) * (2 * D * D * 2) + (size_t)u.pn * (256 * D * 2); return true; } };
struct SchedQK { pg8::TileOrder o; const char* KVM; const char* WQB; int pm0 = 0;
    __device__ __forceinline__ bool next(int i, pg8::Unit& u) const { if (!o.tile(i, u.pm, u.pn)) return false; u.pm += pm0; u.z = 0; u.gi = nullptr; u.grow = 0;
        const int h = u.pm & 3, lb = u.pm >> 2, b = lb & 3, l = lb >> 2;
        u.a = KVM + ((size_t)l * NMEM * 2 * D + (size_t)(b * 256) * 2 * D + h * 256) * 2; u.b = WQB + ((size_t)l * D * D + (size_t)u.pn * 256 * D + h * 256) * 2; return true; } };
struct SchedVO { pg8::TileOrder o; const char* KVM; const char* WOT; int pm0 = 0;
    __device__ __forceinline__ bool next(int i, pg8::Unit& u) const { if (!o.tile(i, u.pm, u.pn)) return false; u.pm += pm0; u.z = 0; u.gi = nullptr; u.grow = 0;
        const int pml = u.pm & 3, lbh = u.pm >> 2, h = lbh & 3, lb = lbh >> 2, b = lb & 3, l = lb >> 2;
        u.a = WOT + ((size_t)l * D * D + (size_t)pml * 256 * D + h * 256) * 2; u.b = KVM + ((size_t)l * NMEM * 2 * D + (size_t)(b * 256) * 2 * D + D + h * 256) * 2; return true; } };

namespace attn_body {
using bf16=__hip_bfloat16;
using bf16x8=__attribute__((ext_vector_type(8)))short;
using s16x4=__attribute__((ext_vector_type(4)))short;
using f32x16=__attribute__((ext_vector_type(16)))float;
using u32x4=__attribute__((ext_vector_type(4)))unsigned;
constexpr int SEQ=8192,D=64,QP=512,KP=128,OP=1024;
constexpr int NW=8,QBLK=32,QB=QBLK*NW,KVBLK=64,NQB=SEQ/QB;
constexpr int ATTN_UNIT_ROWS=QB;
__device__ __forceinline__ int crow(int r,int hi){return (r&3)+8*(r>>2)+4*hi;}
#define SBAR() __builtin_amdgcn_sched_barrier(0)
__device__ __forceinline__ void cmask(f32x16&p0,f32x16&p1,int jb,int qrel,int hi){
  const float NEG=-INFINITY; int kb=64*jb+4*hi;
  #pragma unroll
  for(int r=0;r<16;++r){int kv=kb+(r&3)+8*(r>>2); if(kv>qrel)p0[r]=NEG; if(kv+32>qrel)p1[r]=NEG;}
}

constexpr int NSLOT=3, SLOTB=8192;
constexpr int LDS_K=0, LDS_V=NSLOT*SLOTB, LDS_WS=2*NSLOT*SLOTB, LDS_OST=LDS_WS+NW*64*4, LDS_BYTES=LDS_OST+NW*4096;
constexpr float C2=0.125f*1.4426950408889634f;
__device__ __forceinline__ void glds16(const void*gsrc,unsigned lds_dst){unsigned keep;
  asm volatile("s_mov_b32 %0, m0\n\ts_mov_b32 m0, %2\n\ts_nop 0\n\tglobal_load_lds_dwordx4 %1, off\n\ts_mov_b32 m0, %0":"=&s"(keep):"v"(gsrc),"s"(lds_dst):"memory");}
__device__ __forceinline__ float max3f(float a,float b,float c){float r;asm("v_max3_f32 %0, %1, %2, %3":"=v"(r):"v"(a),"v"(b),"v"(c));return r;}
__device__ __forceinline__ float max2f(float a,float b){float r;asm("v_max_f32_e32 %0, %1, %2":"=v"(r):"v"(a),"v"(b));return r;}
__device__ __forceinline__ float fadd_s(float a,float b){float r;asm("v_add_f32_e32 %0, %1, %2":"=v"(r):"v"(a),"v"(b));return r;}
__device__ __forceinline__ float fsub_s(float a,float b){float r;asm("v_sub_f32_e32 %0, %1, %2":"=v"(r):"v"(a),"v"(b));return r;}
typedef float f32x2_t __attribute__((ext_vector_type(2))); typedef __bf16 bf16x2_t __attribute__((ext_vector_type(2)));
__device__ __forceinline__ unsigned cvtpk_s(float lo,float hi){f32x2_t v={lo,hi};bf16x2_t b=__builtin_convertvector(v,bf16x2_t);return __builtin_bit_cast(unsigned,b);}
#define WAIT_BAR(N) asm volatile("s_waitcnt vmcnt(" #N ") lgkmcnt(0)\n\ts_barrier":::"memory")

__device__ __forceinline__ void qkt(f32x16&p0,f32x16&p1,const char*Kslot,const bf16x8*qr,const f32x16&negm,int r32,int hi){
  const char*kb=Kslot+hi*1024+r32*16;
  #pragma unroll
  for(int d0=0;d0<4;++d0){
    const bf16x8 b0=*reinterpret_cast<const bf16x8*>(kb+d0*2048);
    const bf16x8 b1=*reinterpret_cast<const bf16x8*>(kb+d0*2048+512);
    if(d0==0){p0=__builtin_amdgcn_mfma_f32_32x32x16_bf16(b0,qr[0],negm,0,0,0);p1=__builtin_amdgcn_mfma_f32_32x32x16_bf16(b1,qr[0],negm,0,0,0);}
    else{p0=__builtin_amdgcn_mfma_f32_32x32x16_bf16(b0,qr[d0],p0,0,0,0);p1=__builtin_amdgcn_mfma_f32_32x32x16_bf16(b1,qr[d0],p1,0,0,0);}}
}
typedef __attribute__((address_space(3))) const char* lds_cptr;
typedef short v4i16_t __attribute__((ext_vector_type(4)));
__device__ __forceinline__ void kload8(bf16x8*kf,lds_cptr kp){
  kf[0]=*(const __attribute__((address_space(3))) bf16x8*)(kp);      kf[1]=*(const __attribute__((address_space(3))) bf16x8*)(kp+512);
  kf[2]=*(const __attribute__((address_space(3))) bf16x8*)(kp+2048); kf[3]=*(const __attribute__((address_space(3))) bf16x8*)(kp+2560);
  kf[4]=*(const __attribute__((address_space(3))) bf16x8*)(kp+4096); kf[5]=*(const __attribute__((address_space(3))) bf16x8*)(kp+4608);
  kf[6]=*(const __attribute__((address_space(3))) bf16x8*)(kp+6144); kf[7]=*(const __attribute__((address_space(3))) bf16x8*)(kp+6656);
}
__device__ __forceinline__ void kload2(bf16x8*kf,lds_cptr kp,int j){ kf[2*j]=*(const __attribute__((address_space(3))) bf16x8*)(kp+j*2048); kf[2*j+1]=*(const __attribute__((address_space(3))) bf16x8*)(kp+j*2048+512); }
__device__ __forceinline__ s16x4 vtr(lds_cptr p){ return __builtin_bit_cast(s16x4,__builtin_amdgcn_ds_read_tr16_b64_v4i16((__attribute__((address_space(3))) v4i16_t*)p)); }
__device__ __forceinline__ float rowmax(const f32x16&p0,const f32x16&p1){
  float a=max3f(p0[0],p0[1],p1[0]),b=max3f(p0[2],p0[3],p1[1]);a=max3f(a,p1[2],p1[3]);
  #pragma unroll
  for(int r=4;r<16;r+=4){a=max3f(a,p0[r],p0[r+1]);b=max3f(b,p0[r+2],p0[r+3]);a=max3f(a,p1[r],p1[r+1]);b=max3f(b,p1[r+2],p1[r+3]);}
  const float m=max2f(a,b);
  auto rr=__builtin_amdgcn_permlane32_swap(__float_as_uint(m),__float_as_uint(m),false,false);
  return max2f(__uint_as_float(rr[0]),__uint_as_float(rr[1]));
}
__device__ __forceinline__ void pv(f32x16*o,int vb,bf16x8 pa0,bf16x8 pa1,bf16x8 pa2,bf16x8 pa3){
  #pragma unroll
  for(int d0=0;d0<2;++d0){s16x4 lo[4],hi[4];
    #pragma unroll
    for(int ks=0;ks<4;++ks){
      asm volatile("ds_read_b64_tr_b16 %0,%1 offset:%c2":"=&v"(lo[ks]):"v"(vb),"i"(d0*4096+ks*1024):"memory");
      asm volatile("ds_read_b64_tr_b16 %0,%1 offset:%c2":"=&v"(hi[ks]):"v"(vb),"i"(d0*4096+ks*1024+512):"memory");}
    asm volatile("s_waitcnt lgkmcnt(0)":::"memory");SBAR();
    #define PK(k) (bf16x8){lo[k][0],lo[k][1],lo[k][2],lo[k][3],hi[k][0],hi[k][1],hi[k][2],hi[k][3]}
    o[d0]=__builtin_amdgcn_mfma_f32_32x32x16_bf16(pa0,PK(0),o[d0],0,0,0);
    o[d0]=__builtin_amdgcn_mfma_f32_32x32x16_bf16(pa1,PK(1),o[d0],0,0,0);
    o[d0]=__builtin_amdgcn_mfma_f32_32x32x16_bf16(pa2,PK(2),o[d0],0,0,0);
    o[d0]=__builtin_amdgcn_mfma_f32_32x32x16_bf16(pa3,PK(3),o[d0],0,0,0);
    #undef PK
  }
}

#ifndef ATTN_STORE16
#define ATTN_STORE16(p,v) (*(u32x4*)(p)=(v))
#endif
template<int THRL,bool STATIC_REF,bool LSUM> __device__ __forceinline__ void attn_unit(int b,int h,int qb,const bf16*Q,const bf16*__restrict__ K,const bf16*__restrict__ V,bf16*O,float*ATS,char*shm,int wave_idx,float refB){
  int lane; asm volatile("v_mbcnt_lo_u32_b32 %0, -1, 0\n\tv_mbcnt_hi_u32_b32 %0, -1, %0":"=v"(lane)); const int r32=lane&31,hi=lane>>5; const int wid=wave_idx; const int kvh=h>>2;
  const long rowbase=(long)b*SEQ; const int q0=qb*QB;
  const bf16*Qw=Q+(rowbase+q0+wid*QBLK)*QP+h*D;
  const bf16*Kh=K+rowbase*KP+kvh*D,*Vh=V+rowbase*KP+kvh*D;
  const unsigned lds0=(unsigned)(uintptr_t)shm;
  float*wsf=(float*)(shm+LDS_WS)+wid*64;
  const bf16*ksrc=Kh+(long)lane*KP+wid*8;
  const bf16*vsrc=Vh+(long)(16*(wid&3)+(lane>>2))*KP+(wid>>2)*32+(lane&3)*8;
  const unsigned kdst=lds0+LDS_K+wid*1024, vdst=lds0+LDS_V+wid*1024;
  #define DMA_K(t,slot) glds16(ksrc+(long)(t)*KVBLK*KP,(unsigned)__builtin_amdgcn_readfirstlane(kdst+(slot)))
  #define DMA_V(t,slot) glds16(vsrc+(long)(t)*KVBLK*KP,(unsigned)__builtin_amdgcn_readfirstlane(vdst+(slot)))
  const int vb0=(int)(lds0+LDS_V)+((lane>>4)&1)*32+(lane&3)*8+(4*hi+((lane&15)>>2))*64;
  const char*Kbase=shm+LDS_K; bf16x8 kf[8];
  const lds_cptr shm3=(lds_cptr)shm; const lds_cptr kp0=shm3+LDS_K+hi*1024+r32*16; const lds_cptr vp0=shm3+LDS_V+((lane>>4)&1)*32+(lane&3)*8+(4*hi+((lane&15)>>2))*64;
  const int NT=SEQ/KVBLK;
  DMA_K(0,0);DMA_V(0,0);DMA_K(1,SLOTB);
  bf16x8 qr[4];
  #pragma unroll
  for(int d0=0;d0<4;++d0)qr[d0]=*reinterpret_cast<const bf16x8*>(&Qw[(long)r32*QP+d0*16+hi*8]);
  float mhat=0.f,l_reg=0.f;f32x16 o[2];o[0]=f32x16{};o[1]=f32x16{};f32x16 negm=f32x16{};
  if constexpr(STATIC_REF){ _Pragma("unroll") for(int r=0;r<16;++r)negm[r]=-refB; }
  asm volatile("":"+v"(negm));
  f32x16 lblk=f32x16{}; unsigned one2_; asm volatile("v_mov_b32 %0, 0x3f803f80":"=v"(one2_)); const bf16x8 ones8=__builtin_bit_cast(bf16x8,(u32x4){one2_,one2_,one2_,one2_});
  const int qrel=wid*QBLK+r32;
  #define CMASK(P0,P1,t) do{}while(0)
  bool resc=false;
  #define START(P0,P1) do{ if constexpr(!STATIC_REF){ const float rm=rowmax(P0,P1); resc=false; \
    { const float dl=rm; mhat=fadd_s(mhat,dl); \
      _Pragma("unroll") for(int r=0;r<16;++r){P0[r]=fsub_s(P0[r],dl);P1[r]=fsub_s(P1[r],dl);} \
      _Pragma("unroll") for(int r=0;r<16;++r)negm[r]=-mhat; asm volatile("":"+v"(negm)); } } \
    _Pragma("unroll") for(int r=0;r<16;++r)P0[r]=__builtin_amdgcn_exp2f(P0[r]); }while(0)
  #define RESC() do{ if constexpr(!STATIC_REF) if(resc){ asm volatile("s_waitcnt lgkmcnt(0)":::"memory"); \
      _Pragma("unroll") for(int d_=0;d_<2;++d_) _Pragma("unroll") for(int r=0;r<16;++r)o[d_][r]*=wsf[crow(r,hi)]; } }while(0)
  f32x16 pA0,pA1,pB0,pB1;
  int sl_prev=0,sl_cur=0,sl_next=SLOTB;
  #define ROT() do{sl_prev=sl_cur;sl_cur=sl_next;sl_next=(sl_next==(NSLOT-1)*SLOTB)?0:sl_next+SLOTB;}while(0)
  DMA_K(2,2*SLOTB);
  WAIT_BAR(3);
  qkt(pA0,pA1,Kbase,qr,negm,r32,hi);asm volatile("s_nop 15\n\ts_nop 7":"+v"(pA0),"+v"(pA1));CMASK(pA0,pA1,0);
  START(pA0,pA1);
  _Pragma("unroll") for(int r=0;r<16;++r)pA1[r]=__builtin_amdgcn_exp2f(pA1[r]);
  WAIT_BAR(0);
  DMA_K(3,0);DMA_V(1,SLOTB);
  ROT();
  kload8(kf,kp0+sl_cur);
  WAIT_BAR(2);
  asm volatile("":"+v"(kf[0]),"+v"(kf[1]),"+v"(kf[2]),"+v"(kf[3]),"+v"(kf[4]),"+v"(kf[5]),"+v"(kf[6]),"+v"(kf[7]));
  s16x4 vlo[8],vhi[8]; u32x4 pw0,pw1,pw2,pw3;
  #define PKW(P,B) cvtpk_s(P[B],P[B+1])
  #define PAF(k) __builtin_bit_cast(bf16x8,pw##k)
  #define VFR(i) (bf16x8){vlo[i][0],vlo[i][1],vlo[i][2],vlo[i][3],vhi[i][0],vhi[i][1],vhi[i][2],vhi[i][3]}
  #define PIN(x) asm volatile("":"+v"(x))
  #define MX3(a,b,c) __builtin_fmaxf(__builtin_fmaxf((a),(b)),(c))
  #define GAPA(MF,A0,A1,A2,A3,W0,W1,PW) do{ MF; if constexpr(!LSUM){ sacc+=A0; sacc+=A1; sacc+=A2; sacc+=A3; PIN(sacc); } W0; W1; PIN(PW); SBAR(); }while(0)
  #define GAPA2(MF,A0,A1,W0,W1,PW) do{ MF; if constexpr(!LSUM){ sacc+=A0; sacc+=A1; PIN(sacc); } W0; W1; PIN(PW); SBAR(); }while(0)
  #define LSM(k) do{ if constexpr(LSUM){ lblk=__builtin_amdgcn_mfma_f32_32x32x16_bf16(PAF(k),ones8,lblk,0,0,0); SBAR(); } }while(0)
  #define EX(v) __builtin_amdgcn_exp2f(v)
  #define GAPB(MF,X,B) do{ MF; X[B]=EX(X[B]); X[B+1]=EX(X[B+1]); X[B+2]=EX(X[B+2]); X[B+3]=EX(X[B+3]); PIN(X); SBAR(); }while(0)
  #define VRD(i) do{ vlo[i]=vtr(vp_+(((i)>>2)*4096+((i)&3)*1024)); vhi[i]=vtr(vp_+(((i)>>2)*4096+((i)&3)*1024+512)); }while(0)
  #define KRD(G,j) do{ if(G){ kload2(kf,kp0+sl_next,j); SBAR(); } }while(0)
  #define PINKF() asm volatile("":"+v"(kf[0]),"+v"(kf[1]),"+v"(kf[2]),"+v"(kf[3]),"+v"(kf[4]),"+v"(kf[5]),"+v"(kf[6]),"+v"(kf[7]))
  #define STEP(C0,C1,P0,P1,t,GK,GV,GL) do{ SBAR(); \
    const lds_cptr vp_=vp0+sl_prev; \
    VRD(0); SBAR(); float sacc=0.f; if constexpr(!LSUM) sacc=(P0[0]+P0[1]); \
    GAPA(C0=__builtin_amdgcn_mfma_f32_32x32x16_bf16(kf[0],qr[0],negm,0,0,0), P0[2],P0[3],P0[4],P0[5],     pw0[0]=PKW(P0,0), pw0[1]=PKW(P0,2), pw0); \
    VRD(4); SBAR(); GAPA(C1=__builtin_amdgcn_mfma_f32_32x32x16_bf16(kf[1],qr[0],negm,0,0,0), P0[6],P0[7],P0[8],P0[9],     pw0[2]=PKW(P0,4), pw0[3]=PKW(P0,6), pw0); \
    VRD(1); SBAR(); GAPA(C0=__builtin_amdgcn_mfma_f32_32x32x16_bf16(kf[2],qr[1],C0,0,0,0),   P0[10],P0[11],P0[12],P0[13], pw1[0]=PKW(P0,8), pw1[1]=PKW(P0,10), pw1); \
    VRD(5); SBAR(); GAPA(C1=__builtin_amdgcn_mfma_f32_32x32x16_bf16(kf[3],qr[1],C1,0,0,0),   P0[14],P0[15],P1[0],P1[1],   pw1[2]=PKW(P0,12),pw1[3]=PKW(P0,14), pw1); \
    VRD(2); SBAR(); GAPA(C0=__builtin_amdgcn_mfma_f32_32x32x16_bf16(kf[4],qr[2],C0,0,0,0),   P1[2],P1[3],P1[4],P1[5],     pw2[0]=PKW(P1,0), pw2[1]=PKW(P1,2), pw2); \
    VRD(6); SBAR(); GAPA(C1=__builtin_amdgcn_mfma_f32_32x32x16_bf16(kf[5],qr[2],C1,0,0,0),   P1[6],P1[7],P1[8],P1[9],     pw2[2]=PKW(P1,4), pw2[3]=PKW(P1,6), pw2); \
    VRD(3); SBAR(); GAPA(C0=__builtin_amdgcn_mfma_f32_32x32x16_bf16(kf[6],qr[3],C0,0,0,0),   P1[10],P1[11],P1[12],P1[13], pw3[0]=PKW(P1,8), pw3[1]=PKW(P1,10), pw3); \
    VRD(7); SBAR(); GAPA2(C1=__builtin_amdgcn_mfma_f32_32x32x16_bf16(kf[7],qr[3],C1,0,0,0),  P1[14],P1[15],               pw3[2]=PKW(P1,12),pw3[3]=PKW(P1,14), pw3); \
    l_reg+=sacc; \
    if(GK){DMA_K((t)+3,sl_cur);} if(GV){DMA_V((t)+1,sl_next);} \
    CMASK(C0,C1,t); \
    if constexpr(!STATIC_REF){ float a=MX3(C0[0],C0[1],C1[0]),b=MX3(C0[2],C0[3],C1[1]); a=MX3(a,C1[2],C1[3]); \
      _Pragma("unroll") for(int r=4;r<16;r+=4){a=MX3(a,C0[r],C0[r+1]);b=MX3(b,C0[r+2],C0[r+3]);a=MX3(a,C1[r],C1[r+1]);b=MX3(b,C1[r+2],C1[r+3]);} \
      float rm=__builtin_fmaxf(a,b); { auto rr=__builtin_amdgcn_permlane32_swap(__float_as_uint(rm),__float_as_uint(rm),false,false); rm=__builtin_fmaxf(__uint_as_float(rr[0]),__uint_as_float(rr[1])); } \
      resc=false; \
      if(__builtin_expect(__any(rm>(float)THRL),0)){ const float dl=__builtin_fmaxf(rm,0.f); mhat+=dl; \
        _Pragma("unroll") for(int r=0;r<16;++r){C0[r]-=dl;C1[r]-=dl;} \
        _Pragma("unroll") for(int r=0;r<16;++r)negm[r]=-mhat; asm volatile("":"+v"(negm)); \
        const float f=__builtin_amdgcn_exp2f(-dl); l_reg*=f; if(hi==0)wsf[r32]=f; resc=true; } } \
    SBAR(); \
    GAPB(o[0]=__builtin_amdgcn_mfma_f32_32x32x16_bf16(PAF(0),VFR(0),o[0],0,0,0), C0,0); \
    GAPB(o[1]=__builtin_amdgcn_mfma_f32_32x32x16_bf16(PAF(0),VFR(4),o[1],0,0,0), C0,4); \
    LSM(0); KRD(GL,0); GAPB(o[0]=__builtin_amdgcn_mfma_f32_32x32x16_bf16(PAF(1),VFR(1),o[0],0,0,0), C0,8); \
    KRD(GL,1); GAPB(o[1]=__builtin_amdgcn_mfma_f32_32x32x16_bf16(PAF(1),VFR(5),o[1],0,0,0), C0,12); \
    LSM(1); KRD(GL,2); GAPB(o[0]=__builtin_amdgcn_mfma_f32_32x32x16_bf16(PAF(2),VFR(2),o[0],0,0,0), C1,0); \
    KRD(GL,3); GAPB(o[1]=__builtin_amdgcn_mfma_f32_32x32x16_bf16(PAF(2),VFR(6),o[1],0,0,0), C1,4); \
    LSM(2); GAPB(o[0]=__builtin_amdgcn_mfma_f32_32x32x16_bf16(PAF(3),VFR(3),o[0],0,0,0), C1,8); \
    GAPB(o[1]=__builtin_amdgcn_mfma_f32_32x32x16_bf16(PAF(3),VFR(7),o[1],0,0,0), C1,12); LSM(3); \
    }while(0)
  int t=1;
  for(;t+5<NT;t+=2){
    STEP(pB0,pB1,pA0,pA1,t,true,true,true);     WAIT_BAR(2); PINKF(); RESC(); ROT();
    STEP(pA0,pA1,pB0,pB1,t+1,true,true,true);   WAIT_BAR(2); PINKF(); RESC(); ROT();
  }
  #define ENDW(tt) do{ if((tt)+3<NT){WAIT_BAR(2);} else if((tt)+2<NT){WAIT_BAR(1);} else {WAIT_BAR(0);} }while(0)
  for(;t+1<NT;t+=2){
    STEP(pB0,pB1,pA0,pA1,t,(t+3<NT),(t+1<NT),(t+1<NT));       ENDW(t);   RESC(); ROT();
    STEP(pA0,pA1,pB0,pB1,t+1,(t+4<NT),(t+2<NT),(t+2<NT));     ENDW(t+1); RESC(); ROT();
  }
  STEP(pB0,pB1,pA0,pA1,NT-1,false,false,false); RESC();
  { if constexpr(!LSUM){ float sacc=pB0[0]+pB0[1]; _Pragma("unroll") for(int r=2;r<16;++r)sacc+=pB0[r]; _Pragma("unroll") for(int r=0;r<16;++r)sacc+=pB1[r]; l_reg+=sacc; }
    pw0=(u32x4){PKW(pB0,0),PKW(pB0,2),PKW(pB0,4),PKW(pB0,6)};pw1=(u32x4){PKW(pB0,8),PKW(pB0,10),PKW(pB0,12),PKW(pB0,14)};pw2=(u32x4){PKW(pB1,0),PKW(pB1,2),PKW(pB1,4),PKW(pB1,6)};pw3=(u32x4){PKW(pB1,8),PKW(pB1,10),PKW(pB1,12),PKW(pB1,14)};
    SBAR(); pv(o,vb0+sl_cur,PAF(0),PAF(1),PAF(2),PAF(3)); LSM(0); LSM(1); LSM(2); LSM(3); }
  #undef PKW
  #undef PAF
  #undef VFR
  #undef PIN
  #undef MX3
  #undef GAPA
  #undef GAPA2
  #undef LSM
  #undef GAPB
  #undef EX
  #undef VRD
  #undef KRD
  #undef PINKF
  #undef STEP
  #undef ENDW
  float rli[16];
  if constexpr(LSUM){ asm volatile("s_nop 15\n\ts_nop 7":"+v"(lblk));
    #pragma unroll
    for(int r=0;r<16;++r)rli[r]=__builtin_amdgcn_rcpf(lblk[r]); }
  else{
  {auto rr=__builtin_amdgcn_permlane32_swap(__float_as_uint(l_reg),__float_as_uint(l_reg),false,false);l_reg=__uint_as_float(rr[0])+__uint_as_float(rr[1]);}
  if(hi==0)wsf[32+r32]=l_reg;asm volatile("s_waitcnt lgkmcnt(0)":::"memory");
  #pragma unroll
  for(int r=0;r<16;++r)rli[r]=__builtin_amdgcn_rcpf(wsf[32+crow(r,hi)]); }
  bf16*Ow=O+(rowbase+q0+wid*QBLK)*OP+512+h*D; float*ATw=ATS+(rowbase+q0+wid*QBLK)*8+h;
  { bf16*stg=(bf16*)(shm+LDS_OST)+wid*2048;
    #pragma unroll
    for(int r=0;r<16;++r){const int orow=crow(r,hi);
      #pragma unroll
      for(int d0=0;d0<2;++d0)stg[orow*64+d0*32+r32]=__float2bfloat16(o[d0][r]*rli[r]);}
    asm volatile("s_waitcnt lgkmcnt(0)":::"memory");
    #pragma unroll
    for(int i=0;i<4;++i){const int row=i*8+(lane>>3),ch=lane&7; const u32x4 v=*(const u32x4*)(stg+row*64+ch*8); ATTN_STORE16(Ow+(long)row*OP+ch*8,v);
      float ss=0.f;
      #pragma unroll
      for(int q=0;q<4;++q){const float lo=__uint_as_float(v[q]<<16),hh=__uint_as_float(v[q]&0xffff0000u);ss+=lo*lo+hh*hh;}
      ss=sum_row8(ss); if(ch==0)ATw[(long)row*8]=ss;} }
  asm volatile("s_waitcnt lgkmcnt(0)\n\ts_barrier":::"memory");
  #undef DMA_K
  #undef DMA_V
  #undef CMASK
  #undef START
  #undef RESC
  #undef ROT
}
constexpr int ATTN_LDS_BYTES=LDS_BYTES;
#undef SBAR
#undef WAIT_BAR
}

__global__ void __launch_bounds__(NTHR, 2) mega(Args args) {
    extern __shared__ __attribute__((aligned(16))) unsigned char lds[];
    Frame F;
    F.lds = (LAS unsigned char*)lds;
    F.wave = __builtin_amdgcn_readfirstlane(threadIdx.x >> 6);
    F.G = gridDim.x; { const int bx = blockIdx.x; F.vcu = (F.G % 8 == 0) ? (bx % 8) * (F.G / 8) + bx / 8 : bx; }
#pragma unroll
    for (int i = 0; i < 22; ++i) F.in[i] = args.in[i];
    F.ws = args.ws; F.xres = args.out;
    volatile LAS unsigned* MISC = (volatile LAS unsigned*)(F.lds + MISC_OFF);
    for (int u = threadIdx.x; u < (LDS_BYTES - LDSCTL_OFF) / 4; u += NTHR) ((LAS unsigned*)(F.lds + LDSCTL_OFF))[u] = 0u;
    __syncthreads();
    const int lo = args.ph_lo, hi = args.ph_hi;
    unsigned* barw = (unsigned*)(F.ws + WS_CTL) + CW_BAR + args.bar_region * XCD_BAR_WORDS;
    XcdBarrier bar; bar.bar = barw; bar.x = 0; bar.st = nullptr;
    if (hi - lo > 1) bar = xcd_barrier_post(barw, MISC + 8);
#ifndef ONLY_K
#define ONLY_K -1
#endif
#define EN(kind) (ONLY_K < 0 || ONLY_K == (kind))
#ifndef ALIGN_A
#define ALIGN_A true
#endif
#ifndef ATTN_LSUM
#define ATTN_LSUM false
#endif
#ifndef ALIGN_IN
#define ALIGN_IN true
#endif
#ifndef ALIGN_E1
#define ALIGN_E1 true
#endif
#define IN(k) (lo <= (k) && (k) < hi)

#define PROBE_TOP(k) for (int rep_ = 0; rep_ < (REPK == (k) ? 2 : 1); ++rep_) {
#define PROBE_END(k) if (REPK == (k) && rep_ == 0) xcd_barrier(bar); }
#define SEAM(k) do { if (IN(k) && IN((k) + 1)) { xcd_barrier(bar); if (REPK == 200) xcd_barrier(bar); } } while (0)
    const int cid0 = (int)blockIdx.x; const int cid = cid0;
    if (EN(100) && IN(0)) { asm volatile("; PHASE_MARK P0"); PROBE_TOP(100) ph_rows0(F); PROBE_END(100) }
    if (EN(101) && IN(1)) { asm volatile("; PHASE_MARK P1"); PROBE_TOP(101) ph_convert(F); PROBE_END(101) } SEAM(1);

#define RUN_KV(GG, CC) do { SchedKV S_; S_.o.init(NL * 4, 8, (GG), (CC)); S_.MEMN = (const char*)(F.ws + WS_MEMN); S_.WKVT = (const char*)(F.ws + WS_WKVT); \
        pg8::EpiStore<3> E_{(bf16*)(F.ws + WS_KVM), 2 * D, nullptr, 1.0f}; pg8::gemm_phase<pg8::EpiStore<3>, SchedKV, true, false>(F.lds, F.wave, D, D, D, S_, E_); } while (0)
#define RUN_QK(LL, GG, CC) do { SchedQK S_; S_.o.init(16, 4, (GG), (CC)); S_.pm0 = (LL) * 16; S_.KVM = (const char*)(F.ws + WS_KVM); S_.WQB = (const char*)(F.ws + WS_WQB); \
        pg8::EpiStore<1, true> E_{(bf16*)(F.ws + WS_QKT), D, F.in[11], XQSCALE * Q8S}; int la_ = 2 * D, lb_ = D, kk_ = 256; asm volatile("" : "+s"(la_), "+s"(lb_), "+s"(kk_)); \
        pg8::gemm_phase<pg8::EpiStore<1, true>, SchedQK, true, false>(F.lds, F.wave, la_, lb_, kk_, S_, E_); } while (0)
#define RUN_VO(LL, GG, CC) do { SchedVO S_; S_.o.init(64, 1, (GG), (CC)); S_.pm0 = (LL) * 64; S_.KVM = (const char*)(F.ws + WS_KVM); S_.WOT = (const char*)(F.ws + WS_WOT); \
        pg8::EpiStore<2, true> E_{(bf16*)(F.ws + WS_VOT), D, nullptr, V8S}; int la_ = D, lb_ = 2 * D, kk_ = 256; asm volatile("" : "+s"(la_), "+s"(lb_), "+s"(kk_)); \
        pg8::gemm_phase<pg8::EpiStore<2, true>, SchedVO, true, false>(F.lds, F.wave, la_, lb_, kk_, S_, E_); } while (0)
    for (int l = 0; l < NL; ++l) {
        const int pb = PH_LAYER0 + PH_PER_LAYER * l;
        int cid = cid0; asm volatile("" : "+s"(cid));
        if (EN(0) && IN(pb + 0)) { asm volatile("; PHASE_MARK L0"); for (int rep_ = 0; rep_ < ((REPK == 0 || REPK == 91 || REPK == 92) ? 2 : 1); ++rep_) {
            SchedDense S; S.o.init(T / 256, 7, F.G, cid); S.A = (const char*)(F.ws + WS_XR); S.a_tile = 256 * D * 2; S.B = (const char*)(F.ws + WS_WIN) + (size_t)l * INW * D * 2; S.b_tile = 256 * D * 2; S.b_batch = 0; S.bdiv = 1; S.bmod = 1;
            pg8::EpiIn E{(bf16*)(F.ws + WS_UACT), (bf16*)(F.ws + WS_VACT), (bf16*)(F.ws + WS_Q), (bf16*)(F.ws + WS_K), (bf16*)(F.ws + WS_V), (float*)(F.ws + WS_VSTAT),
                         F.in[7] + (size_t)l * 64, F.in[8] + (size_t)l * 64, (const float*)(F.ws + WS_ROPE), (const float*)(F.ws + WS_ROPE) + SEQ * 32, (const float*)(F.ws + WS_RINV)}; E.nostore = (REPK == 91 && rep_ == 0); E.skip = (REPK == 92 && rep_ == 0);
            pg8::gemm_phase<pg8::EpiIn, SchedDense, ALIGN_IN, false>(F.lds, F.wave, D, D, D, S, E);
            if ((REPK != 0 && REPK != 91 && REPK != 92) || rep_ == 1) { const int Gh = F.G >> 1;
                if (cid >= Gh) { if (l == 0) RUN_KV(F.G - Gh, cid - Gh); else { RUN_QK(l, F.G - Gh, cid - Gh); RUN_VO(l, F.G - Gh, cid - Gh); } } }
        if ((REPK == 0 || REPK == 91 || REPK == 92) && rep_ == 0) xcd_barrier(bar); } } SEAM(pb + 0);
        if (EN(1) && IN(pb + 1)) { asm volatile("; PHASE_MARK L1");
            float refB; { const int ln = lane_id(); float mq = fabsf(F.in[7][(size_t)l * 64 + ln]), mk = fabsf(F.in[8][(size_t)l * 64 + ln]); mq = max_x32(max_x16(max_row16(mq))); mk = max_x32(max_x16(max_row16(mk)));
                          refB = 8.0f * LOG2E * 1.02f * mq * mk; refB = __builtin_bit_cast(float, __builtin_amdgcn_readfirstlane(__builtin_bit_cast(int, refB))); }
            if (l == 0) { RUN_QK(0, F.G, cid); RUN_VO(0, F.G, (cid + (F.G >> 1)) % F.G); }
            PROBE_TOP(11)
            for (int it = 0; ; ++it) { const int w = it * F.G + F.vcu; if (w >= NB_ * 8 * (SEQ / 256)) break;
                const int i = w >> 8, c = w & 255, x = c >> 5, j = c & 31;
                if (refB < 60.0f) attn_body::attn_unit<8, true, ATTN_LSUM>(x >> 1, (x & 1) * 4 + i, j, (const attn_body::bf16*)(F.ws + WS_Q), (const attn_body::bf16*)(F.ws + WS_K), (const attn_body::bf16*)(F.ws + WS_V),
                                        (attn_body::bf16*)(F.ws + WS_MERGED), (float*)(F.ws + WS_ATSTAT), (char*)lds, F.wave, refB);
                else attn_body::attn_unit<8, false, false>(x >> 1, (x & 1) * 4 + i, j, (const attn_body::bf16*)(F.ws + WS_Q), (const attn_body::bf16*)(F.ws + WS_K), (const attn_body::bf16*)(F.ws + WS_V),
                                        (attn_body::bf16*)(F.ws + WS_MERGED), (float*)(F.ws + WS_ATSTAT), (char*)lds, F.wave, refB); }
            PROBE_END(11)
            PROBE_TOP(12) ph_gmlp(F, l); PROBE_END(12) } SEAM(pb + 1);
        if (EN(2) && IN(pb + 2)) { asm volatile("; PHASE_MARK L2"); PROBE_TOP(2)
            SchedDense S; S.o.init(T / 256, 4, F.G, cid); S.A = (const char*)(F.ws + WS_MERGED); S.a_tile = 256 * D * 2; S.B = (const char*)(F.ws + WS_WOUT) + (size_t)l * D * D * 2; S.b_tile = 256 * D * 2; S.b_batch = 0; S.bdiv = 1; S.bmod = 1;
            pg8::EpiX<true, true> E; E.xr = (bf16*)(F.ws + WS_XR); E.xstat = (float*)(F.ws + WS_XSTAT); E.gmstat = (const float*)(F.ws + WS_GMSTAT); E.atstat = (const float*)(F.ws + WS_ATSTAT); E.lds = F.lds; E.xa8 = F.ws + WS_XR8; E.scale = 1.0f;
#if REPK == 2
            if (rep_ == 0) E.wofs = (long)(WS_NSCR - WS_XR) / 2;
#endif
            pg8::gemm_phase<pg8::EpiX<true, true>, SchedDense, ALIGN_A, false>(F.lds, F.wave, D, D, D, S, E);
        PROBE_END(2) } SEAM(pb + 2);
        if (EN(3) && IN(pb + 3)) { asm volatile("; PHASE_MARK L3"); PROBE_TOP(3)
            SchedDense S; S.o.init(T / 256, 4, F.G, cid); S.A = (const char*)(F.ws + WS_XR8); S.a_tile = 256 * D; S.B = (const char*)(F.ws + WS_QKT) + (size_t)l * NB_ * D * D; S.b_tile = 256 * D; S.b_batch = (size_t)D * D; S.bdiv = SEQ / 256; S.bmod = NB_;
            pg8::EpiS E{(const float*)(F.ws + WS_XSTAT), F.ws + WS_P, F.lds};
            int kq = D / 2; asm volatile("" : "+s"(kq));
            pg8::gemm_phase<pg8::EpiS, SchedDense, true, false, true>(F.lds, F.wave, kq, kq, kq, S, E);
        PROBE_END(3) } SEAM(pb + 3);
        if (EN(4) && IN(pb + 4)) { asm volatile("; PHASE_MARK L4"); PROBE_TOP(4)
            SchedDense S; S.o.init(T / 256, 4, F.G, cid); S.A = (const char*)(F.ws + WS_P); S.a_tile = 256 * D; S.B = (const char*)(F.ws + WS_VOT) + (size_t)l * NB_ * D * D; S.b_tile = 256 * D; S.b_batch = (size_t)D * D; S.bdiv = SEQ / 256; S.bmod = NB_;
            pg8::EpiX<false, false> E; E.xr = (bf16*)(F.ws + WS_XR); E.xstat = nullptr; E.gmstat = nullptr; E.atstat = nullptr; E.lds = F.lds; E.xa8 = nullptr; E.scale = 1.0f / (P8S * V8S);
#if REPK == 4
            if (rep_ == 0) E.wofs = (long)(WS_NSCR - WS_XR) / 2;
#endif
            int kq = D / 2; asm volatile("" : "+s"(kq));
            pg8::gemm_phase<pg8::EpiX<false, false>, SchedDense, ALIGN_A, false, true>(F.lds, F.wave, kq, kq, kq, S, E);
        PROBE_END(4) } SEAM(pb + 4);
        if (EN(5) && IN(pb + 5)) { asm volatile("; PHASE_MARK L5"); PROBE_TOP(5) ph_router(F, l); PROBE_END(5) } SEAM(pb + 5);
        if (EN(6) && IN(pb + 6)) { asm volatile("; PHASE_MARK L6"); PROBE_TOP(6) ph_topk(F); PROBE_END(6) } SEAM(pb + 6);
        if (EN(7) && IN(pb + 7)) { asm volatile("; PHASE_MARK L7"); PROBE_TOP(7)
            SchedE1 S; S.o.init(NB_ * NE * 4, 8, F.G, cid); S.HBp = (const char*)(F.ws + WS_XR8); S.IDX = (const int*)(F.ws + WS_IDX); S.WGU = (const char*)(F.ws + WS_WGU) + (size_t)l * NE * 2 * FF * D;
            pg8::EpiH E{F.ws + WS_H};
            int kq = D / 2; asm volatile("" : "+s"(kq));
            pg8::gemm_phase<pg8::EpiH, SchedE1, ALIGN_E1, true, true>(F.lds, F.wave, kq, kq, kq, S, E);
        PROBE_END(7) } SEAM(pb + 7);
        if (EN(8) && IN(pb + 8)) { asm volatile("; PHASE_MARK L8"); for (int rep_ = 0; rep_ < ((REPK == 8 || REPK == 81 || REPK == 82) ? 2 : 1); ++rep_) {
            SchedDense S; S.o.init(NB_ * NE * 4, 4, F.G, cid); S.A = (const char*)(F.ws + WS_H); S.a_tile = 256 * FF; S.B = (const char*)(F.ws + WS_WD) + (size_t)l * NE * D * FF; S.b_tile = 256 * FF; S.b_batch = (size_t)D * FF; S.bdiv = 4; S.bmod = NE;
            pg8::EpiY8 E{F.ws + WS_Y, Y8S / (H8S * W8S)}; E.skip = (REPK == 81 && rep_ == 0); E.halfst = (REPK == 82 && rep_ == 0);
            int kq = FF / 2; asm volatile("" : "+s"(kq));
            pg8::gemm_phase<pg8::EpiY8, SchedDense, ALIGN_A, false, true>(F.lds, F.wave, kq, kq, kq, S, E);
        if ((REPK == 8 || REPK == 81 || REPK == 82) && rep_ == 0) xcd_barrier(bar); } } SEAM(pb + 8);
        if (EN(9) && IN(pb + 9)) { asm volatile("; PHASE_MARK L9"); PROBE_TOP(9) ph_combine(F, l, REPK == 9 && rep_ == 0); PROBE_END(9) } SEAM(pb + 9);
    }
#undef IN
#undef SEAM
}

static int g_grid = 0;
static void launch_mega(Args a, int lo, int hi, int region, hipStream_t stream) {
    a.ph_lo = lo; a.ph_hi = hi; a.bar_region = region; a.pad = 0;
    hipLaunchKernelGGL(mega, dim3(g_grid), dim3(NTHR), LDS_BYTES, stream, a);
}
extern "C" void kernel_launch(void* const* d_in, const int* in_sizes, int n_in, void* d_out, int out_size, void* d_ws, size_t ws_size, hipStream_t stream) {
    if (g_grid == 0) {
        if (n_in != 22 || out_size != T * D || ws_size < WS_END) { fprintf(stderr, "kernel_launch: unexpected sizes n_in %d out %d ws %zu\n", n_in, out_size, ws_size); g_grid = -1; return; }
        int dev = 0, cus = 0;
        if (hipGetDevice(&dev) != hipSuccess || hipDeviceGetAttribute(&cus, hipDeviceAttributeMultiprocessorCount, dev) != hipSuccess) { g_grid = -1; return; }
        if (hipFuncSetAttribute((const void*)mega, hipFuncAttributeMaxDynamicSharedMemorySize, LDS_BYTES) != hipSuccess) { g_grid = -1; return; }
        int per_cu = 0;
        if (hipOccupancyMaxActiveBlocksPerMultiprocessor(&per_cu, (const void*)mega, NTHR, LDS_BYTES) != hipSuccess || per_cu < 1) fprintf(stderr, "kernel_launch: occupancy query says %d\n", per_cu);
        (void)hipGetLastError();
        g_grid = cus;
    }
    if (g_grid < 0) return;
    hipMemsetAsync((char*)d_ws + WS_CTL, 0, CTL_ZERO_BYTES, stream);
    Args a{};
    for (int i = 0; i < 22; ++i) a.in[i] = (const float*)d_in[i];
    a.out = (float*)d_out; a.ws = (unsigned char*)d_ws;
    launch_mega(a, 0, PH_END, 0, stream);
}
```

```cpp
#ifndef PROBE_SCALE
#define PROBE_SCALE 0.5f
#endif
#ifndef PROBE_Q
#define PROBE_Q 25.0f
#endif
#ifndef PROBE_QOFF
#define PROBE_QOFF 0.0f
#endif
#ifndef REPK
#define REPK -1
#endif
#include <hip/hip_runtime.h>
#include <hip/hip_bf16.h>
#include <cstdio>
#include <cstdint>
#include <cmath>

constexpr int NB_ = 4, SEQ = 8192, T = NB_ * SEQ, D = 1024, NL = 4;
constexpr int MEML = 256, NMEM = NB_ * MEML;
constexpr int INW = 1792, GMW = 512, NE = 16, CAP = 1024, FF = 1024;
constexpr float EPS = 1e-6f;
constexpr float LOG2E = 1.4426950408889634f;
constexpr float QSCALE = 0.125f * LOG2E;
constexpr float XQSCALE = 0.0625f * LOG2E;
constexpr float W8S = 256.0f, A8S = 16.0f, H8S = 8.0f, Y8S = 32.0f;
constexpr float Q8S = 512.0f, P8S = 256.0f, V8S = 64.0f;

constexpr size_t MiB = 1u << 20;
constexpr size_t WS_CTL = 0, CTL_ZERO_BYTES = 1 * MiB;
constexpr size_t WS_ROPE = 1 * MiB;
constexpr size_t WS_AFF = 3 * MiB;
constexpr size_t WS_INV = 5 * MiB;
constexpr size_t WS_IDX = 7 * MiB;
constexpr size_t WS_VSTAT = 8 * MiB;
constexpr size_t WS_ATSTAT = 9 * MiB;
constexpr size_t WS_GMSTAT = 10 * MiB;
constexpr size_t WS_RINV = 10 * MiB + 512 * 1024;
constexpr size_t WS_RINV2 = 10 * MiB + 768 * 1024;
constexpr size_t WS_XSTAT = 11 * MiB;
constexpr size_t WS_MEMN = 13 * MiB;
constexpr size_t WS_WSB = 15 * MiB;
constexpr size_t WS_WRH = 15 * MiB + 512 * 1024, WS_WRL = WS_WRH + 128 * 1024;
constexpr size_t WS_WIN = 16 * MiB;
constexpr size_t WS_WOUT = 30 * MiB;
constexpr size_t WS_QKT = 38 * MiB;
constexpr size_t WS_VOT = 70 * MiB;
constexpr size_t WS_WGU = 102 * MiB;
constexpr size_t WS_WD = 358 * MiB;
constexpr size_t WS_XR = 486 * MiB;
constexpr size_t WS_R1 = 550 * MiB;
constexpr size_t WS_UACT = WS_R1, WS_VACT = WS_R1 + 32 * MiB, WS_Q = WS_R1 + 64 * MiB, WS_K = WS_R1 + 96 * MiB, WS_V = WS_R1 + 104 * MiB;
constexpr size_t WS_WQB = 230 * MiB, WS_WOT = 238 * MiB, WS_WKVT = 246 * MiB, WS_KVM = 262 * MiB;
constexpr size_t WS_H = WS_R1;
constexpr size_t WS_MERGED = 678 * MiB;
constexpr size_t WS_XR8 = 742 * MiB;
constexpr size_t WS_P = WS_R1;
constexpr size_t WS_Y = 678 * MiB;
constexpr size_t WS_NSCR = 806 * MiB;
constexpr size_t WS_END = 808 * MiB;

constexpr int CW_TMO = 0, CW_CODE = 1, CW_GMQ = 1024  , CW_BAR = 4096;

#define GAS __attribute__((address_space(1)))
#define LAS __attribute__((address_space(3)))
typedef unsigned short bf16;
typedef unsigned v4u __attribute__((ext_vector_type(4)));
typedef unsigned v2u __attribute__((ext_vector_type(2)));
typedef float f32x4 __attribute__((ext_vector_type(4)));
typedef short bf16x8_t __attribute__((ext_vector_type(8)));
typedef GAS unsigned gu32;
#define RLX_AGENT __ATOMIC_RELAXED, __HIP_MEMORY_SCOPE_AGENT
__device__ __forceinline__ unsigned f2bf(float f) { unsigned u = __builtin_bit_cast(unsigned, f); return (u + 0x7fffu + ((u >> 16) & 1u)) >> 16; }
__device__ __forceinline__ unsigned pk2(float lo, float hi) { return f2bf(lo) | (f2bf(hi) << 16); }
__device__ __forceinline__ float bf2f(unsigned v) { return __builtin_bit_cast(float, v << 16); }
__device__ __forceinline__ float bflo(unsigned w) { return __builtin_bit_cast(float, w << 16); }
__device__ __forceinline__ float bfhi(unsigned w) { return __builtin_bit_cast(float, w & 0xffff0000u); }
__device__ __forceinline__ float rbf(float f) { return bf2f(f2bf(f)); }
__device__ __forceinline__ float clamp8(float v) { return __builtin_amdgcn_fmed3f(v, -448.0f, 448.0f); }
__device__ __forceinline__ unsigned pk4_fp8(float a, float b, float c, float d) { unsigned w = 0u; w = __builtin_amdgcn_cvt_pk_fp8_f32(clamp8(a), clamp8(b), w, false); w = __builtin_amdgcn_cvt_pk_fp8_f32(clamp8(c), clamp8(d), w, true); return w; }
__device__ __forceinline__ float gelu_tanh(float x) {
    const float z = 1.5957691216057308f * (x + 0.044715f * x * x * x);
    return x * __builtin_amdgcn_rcpf(1.0f + __builtin_amdgcn_exp2f(-z * LOG2E));
}
typedef float f32x2_t __attribute__((ext_vector_type(2)));
__device__ __forceinline__ f32x4 gelu4(const f32x4 x) {
    const f32x4 w = (x * x) * (-1.5957691216057308f * 0.044715f * LOG2E) + (-1.5957691216057308f * LOG2E); const f32x4 a = w * x;
    f32x4 d; d[0] = __builtin_amdgcn_exp2f(a[0]); d[1] = __builtin_amdgcn_exp2f(a[1]); d[2] = __builtin_amdgcn_exp2f(a[2]); d[3] = __builtin_amdgcn_exp2f(a[3]);
    d = d + 1.0f;
    f32x4 r; r[0] = __builtin_amdgcn_rcpf(d[0]); r[1] = __builtin_amdgcn_rcpf(d[1]); r[2] = __builtin_amdgcn_rcpf(d[2]); r[3] = __builtin_amdgcn_rcpf(d[3]);
    return x * r;
}
__device__ __forceinline__ f32x4 silu_mul4(const f32x4 g, const f32x4 u, const float sg, const float su) {
    const f32x4 a = g * (-sg * LOG2E);
    f32x4 d; d[0] = __builtin_amdgcn_exp2f(a[0]); d[1] = __builtin_amdgcn_exp2f(a[1]); d[2] = __builtin_amdgcn_exp2f(a[2]); d[3] = __builtin_amdgcn_exp2f(a[3]);
    d = d + 1.0f;
    f32x4 r; r[0] = __builtin_amdgcn_rcpf(d[0]); r[1] = __builtin_amdgcn_rcpf(d[1]); r[2] = __builtin_amdgcn_rcpf(d[2]); r[3] = __builtin_amdgcn_rcpf(d[3]);
    return (g * r) * (u * (sg * sg * su));
}
__device__ __forceinline__ float silu_f(float a) { return a * __builtin_amdgcn_rcpf(1.0f + __builtin_amdgcn_exp2f(-a * LOG2E)); }
__device__ __forceinline__ int lane_id() { int l; asm volatile("v_mbcnt_lo_u32_b32 %0, -1, 0\n\tv_mbcnt_hi_u32_b32 %0, -1, %0" : "=v"(l)); return l; }
template <int CTRL> __device__ __forceinline__ float dpp_f(float v) { return __builtin_bit_cast(float, __builtin_amdgcn_update_dpp(0, __builtin_bit_cast(int, v), CTRL, 0xf, 0xf, true)); }
__device__ __forceinline__ float sum_row16(float v) { v += dpp_f<0xB1>(v); v += dpp_f<0x4E>(v); v += dpp_f<0x141>(v); v += dpp_f<0x140>(v); return v; }
__device__ __forceinline__ float max_row16(float v) { v = fmaxf(v, dpp_f<0xB1>(v)); v = fmaxf(v, dpp_f<0x4E>(v)); v = fmaxf(v, dpp_f<0x141>(v)); v = fmaxf(v, dpp_f<0x140>(v)); return v; }
__device__ __forceinline__ float sum_row8(float v) { v += dpp_f<0xB1>(v); v += dpp_f<0x4E>(v); v += dpp_f<0x141>(v); return v; }
__device__ __forceinline__ float swz16(float v) { return __builtin_bit_cast(float, __builtin_amdgcn_ds_swizzle(__builtin_bit_cast(int, v), 0x401f)); }
__device__ __forceinline__ float add_x16(float v) { return v + swz16(v); }
__device__ __forceinline__ float add_x32(float v) { const unsigned a = __builtin_bit_cast(unsigned, v); const auto r = __builtin_amdgcn_permlane32_swap(a, a, false, false); const unsigned r0 = r[0], r1 = r[1]; return __builtin_bit_cast(float, r0) + __builtin_bit_cast(float, r1); }
__device__ __forceinline__ float max_x16(float v) { return fmaxf(v, swz16(v)); }
__device__ __forceinline__ float max_x32(float v) { const unsigned a = __builtin_bit_cast(unsigned, v); const auto r = __builtin_amdgcn_permlane32_swap(a, a, false, false); const unsigned r0 = r[0], r1 = r[1]; return fmaxf(__builtin_bit_cast(float, r0), __builtin_bit_cast(float, r1)); }
__device__ __forceinline__ float wave_sum(float v) { return add_x32(add_x16(sum_row16(v))); }

#define XB_TMO      128
#define XB_XCNT(j)  (256  + 64 * (j))
#define XB_XSUB(j)  (1280 + 64 * (j))
#define XB_XGEN(j)  (2304 + 64 * (j))
#define XB_TOP      3328
#define XB_TOPGEN   3392
#define XCD_BAR_WORDS 3456
#define XB_SPIN_CAP (1u << 18)
__device__ __forceinline__ unsigned xb_ld(unsigned* p)              { return __hip_atomic_load(p, __ATOMIC_RELAXED, __HIP_MEMORY_SCOPE_AGENT); }
__device__ __forceinline__ unsigned xb_add(unsigned* p, unsigned v) { return __hip_atomic_fetch_add(p, v, __ATOMIC_RELAXED, __HIP_MEMORY_SCOPE_AGENT); }
__device__ __forceinline__ unsigned xb_xcc_id() { return (unsigned)__builtin_amdgcn_s_getreg((3 << 11) | 20) & 0xFu; }
#define XB_SPIN(cond, bar) do { unsigned _sp = 0; while (cond) { __builtin_amdgcn_s_sleep(1); \
    if ((++_sp & 255u) == 0u) { if (xb_ld(&(bar)[XB_TMO])) break; if (_sp > XB_SPIN_CAP) { atomicAdd(&(bar)[XB_TMO], 1u); break; } } } } while (0)
struct XcdBarrier { unsigned* bar; unsigned x; volatile LAS unsigned* st; };
__device__ __forceinline__ XcdBarrier xcd_barrier_post(unsigned* bar, volatile LAS unsigned* st) {
    XcdBarrier b; b.bar = bar; b.x = xb_xcc_id(); b.st = st;
    if (threadIdx.x == 0) (void)xb_add(&bar[XB_XCNT(b.x)], 1u);
    return b;
}
__device__ __forceinline__ void xcd_barrier_complete(unsigned* bar, unsigned x, unsigned& nloc, unsigned& nx) {
    const unsigned G = gridDim.x * gridDim.y * gridDim.z;
    unsigned sum, cnt, mine, sp = 0u;
    for (;;) {
        sum = 0u; cnt = 0u; mine = 0u;
#pragma unroll
        for (unsigned j = 0; j < 16; ++j) { const unsigned c = xb_ld(&bar[XB_XCNT(j)]); sum += c; cnt += (c > 0u) ? 1u : 0u; mine = (j == x) ? c : mine; }
        if (sum == G) break;
        __builtin_amdgcn_s_sleep(1);
        if ((++sp & 255u) == 0u) { if (xb_ld(&bar[XB_TMO])) break; if (sp > XB_SPIN_CAP) { atomicAdd(&bar[XB_TMO], 1u); break; } }
    }
    nloc = mine > 0u ? mine : 1u; nx = cnt > 0u ? cnt : 1u;
}
__device__ __forceinline__ void xcd_barrier(const XcdBarrier& b) {
    asm volatile("s_waitcnt vmcnt(0)" ::: "memory");
    __syncthreads();
    if (threadIdx.x == 0) {
        unsigned* bar = b.bar;
        __builtin_amdgcn_s_waitcnt(0);
        unsigned nloc = b.st[0], nx = b.st[1];
        if (nloc == 0u) { xcd_barrier_complete(bar, b.x, nloc, nx); b.st[0] = nloc; b.st[1] = nx; }
        const unsigned old = xb_add(&bar[XB_XSUB(b.x)], 1u);
        const unsigned gen = old / nloc;
        if (old + 1u == (gen + 1u) * nloc) {
            __builtin_amdgcn_fence(__ATOMIC_RELEASE, "agent");
            asm volatile("s_waitcnt vmcnt(0)" ::: "memory");
            const unsigned og = xb_add(&bar[XB_TOP], 1u);
            const unsigned tg = og / nx;
            if (og + 1u == (tg + 1u) * nx) xb_add(&bar[XB_TOPGEN], 1u);
            else XB_SPIN(xb_ld(&bar[XB_TOPGEN]) == tg, bar);
            __builtin_amdgcn_fence(__ATOMIC_ACQUIRE, "agent");
            xb_add(&bar[XB_XGEN(b.x)], 1u);
            asm volatile("s_waitcnt vmcnt(0)" ::: "memory");
        } else {
            XB_SPIN(xb_ld(&bar[XB_XGEN(b.x)]) == gen, bar);
            __builtin_amdgcn_fence(__ATOMIC_ACQUIRE, "agent");
            asm volatile("s_waitcnt vmcnt(0)" ::: "memory");
        }
    }
    __syncthreads();
}

constexpr int CW_GRP = 3072;
__device__ __forceinline__ void group_barrier(unsigned* ctl, unsigned* bar, volatile LAS unsigned* gen) {
    asm volatile("s_waitcnt vmcnt(0)" ::: "memory");
    __syncthreads();
    if (threadIdx.x == 0) {
        const unsigned g = blockIdx.x & 7u, gs = gridDim.x >> 3;
        const unsigned n = gen[0] + 1u; gen[0] = n;
        unsigned* c = ctl + CW_GRP + 64 * g;
        __builtin_amdgcn_fence(__ATOMIC_RELEASE, "agent");
        asm volatile("s_waitcnt vmcnt(0)" ::: "memory");
        (void)xb_add(c, 1u);
        XB_SPIN(xb_ld(c) < n * gs, bar);
        __builtin_amdgcn_fence(__ATOMIC_ACQUIRE, "agent");
        asm volatile("s_waitcnt vmcnt(0)" ::: "memory");
    }
    __syncthreads();
}

struct Args { const float* in[22]; float* out; unsigned char* ws; int ph_lo, ph_hi, bar_region, pad; };
constexpr int PH_LAYER0 = 4, PH_PER_LAYER = 10, PH_END = PH_LAYER0 + NL * PH_PER_LAYER;

constexpr int NWAVES = 8, NTHR = NWAVES * 64;
constexpr int RING_BYTES = 131072, LDSCTL_OFF = RING_BYTES, MISC_OFF = LDSCTL_OFF + 320;
constexpr int LDS_BYTES = 147456;

struct Frame {
    LAS unsigned char* lds;
    int wave, vcu, G;
    const float* in[22];
    unsigned char* ws;
    float* xres;
};

__device__ __forceinline__ void ph_rows0(Frame& F) {
    int lane_ = lane_id(); asm volatile("" : "+v"(lane_)); const int tid_ = F.wave * 64 + lane_;
    const int gw = F.vcu * NWAVES + F.wave, NGW = F.G * NWAVES;
    const float* x = F.in[0]; const float* mem = F.in[1]; const float* mg = F.in[12];
    bf16* XR = (bf16*)(F.ws + WS_XR); bf16* MEMN = (bf16*)(F.ws + WS_MEMN); float* RINV = (float*)(F.ws + WS_RINV);
    for (int m = gw; m < T + NMEM; m += NGW) {
        const bool is_mem = m >= T;
        const float* src = is_mem ? mem + (size_t)(m - T) * D : x + (size_t)m * D;
        bf16* dst = is_mem ? MEMN + (size_t)(m - T) * D : XR + (size_t)m * D;
        f32x4 v[4]; float s = 0.f;
#pragma unroll
        for (int j = 0; j < 4; ++j) { v[j] = __builtin_nontemporal_load((const f32x4*)(src + 4 * lane_ + 256 * j)); s += (v[j].x * v[j].x + v[j].y * v[j].y) + (v[j].z * v[j].z + v[j].w * v[j].w); }
        const float rinv = __builtin_amdgcn_rsqf(wave_sum(s) * (1.0f / D) + EPS);
        if (!is_mem && lane_ == 0) RINV[m] = rinv;
        const float sc = is_mem ? rinv : 1.0f;
#pragma unroll
        for (int j = 0; j < 4; ++j) {
            f32x4 g = (f32x4){1.f, 1.f, 1.f, 1.f};
            if (is_mem) g = *(const f32x4*)(mg + 4 * lane_ + 256 * j);
            v2u o; o.x = pk2(v[j].x * sc * g.x, v[j].y * sc * g.y); o.y = pk2(v[j].z * sc * g.z, v[j].w * sc * g.w);
            *(v2u*)(dst + 4 * lane_ + 256 * j) = o;
        }
    }
#if defined(SELFTEST_F8)
    if (F.vcu == 0 && F.wave == 0) {
        typedef int v8i_t __attribute__((ext_vector_type(8)));
        const int fr = lane_ & 15; const unsigned codes[4] = {0x38383838u, 0x3A3A3A3Au, 0x3C3C3C3Cu, 0x40404040u}; const float vals[4] = {1.0f, 1.25f, 1.5f, 2.0f};
        unsigned bc = codes[0]; float bv = vals[0];
#pragma unroll
        for (int q = 1; q < 4; ++q) if ((fr & 3) == q) { bc = codes[q]; bv = vals[q]; }
        v8i_t A, B;
#pragma unroll
        for (int q = 0; q < 8; ++q) { A[q] = 0x38383838; B[q] = (int)bc; }
        f32x4 acc = (f32x4){0.f, 0.f, 0.f, 0.f}; unsigned sc = 0x7f7f7f7fu; asm volatile("" : "+v"(sc), "+v"(A), "+v"(B), "+v"(acc));
        asm volatile("s_nop 7\n\tv_mfma_scale_f32_16x16x128_f8f6f4 %0, %1, %2, %0, %3, %3 op_sel_hi:[0,0,0]\n\ts_nop 15\n\ts_nop 15\n\ts_nop 15\n\ts_nop 15\n\ts_nop 15\n\ts_nop 15" : "+v"(acc) : "v"(A), "v"(B), "v"(sc));
        bool bad = false;
#pragma unroll
        for (int e = 0; e < 4; ++e) bad |= (acc[e] != 128.0f * bv);
        const unsigned w = pk4_fp8(1.25f, 448.0f, 1000.0f, -2.0f); bad |= (w != 0xC07E7E3Au);
        {   const float v = (float)((lane_ * 37 + 11) % 101);
            float r16 = v; r16 += __shfl_xor(r16, 1); r16 += __shfl_xor(r16, 2); r16 += __shfl_xor(r16, 4); r16 += __shfl_xor(r16, 8);
            float m16 = v; m16 = fmaxf(m16, __shfl_xor(m16, 1)); m16 = fmaxf(m16, __shfl_xor(m16, 2)); m16 = fmaxf(m16, __shfl_xor(m16, 4)); m16 = fmaxf(m16, __shfl_xor(m16, 8));
            float r8 = v; r8 += __shfl_xor(r8, 1); r8 += __shfl_xor(r8, 2); r8 += __shfl_xor(r8, 4);
            float r64 = r16; r64 += __shfl_xor(r64, 16); r64 += __shfl_xor(r64, 32);
            if (SELFTEST_F8 & 1) bad |= (sum_row16(v) != r16) | (max_row16(v) != m16) | (sum_row8(v) != r8);
            if (SELFTEST_F8 & 2) bad |= (wave_sum(v) != r64);
            if (SELFTEST_F8 & 4) bad |= (add_x16(v) != v + __shfl_xor(v, 16)) | (max_x16(v) != fmaxf(v, __shfl_xor(v, 16)));
            if (SELFTEST_F8 & 8) bad |= (add_x32(v) != v + __shfl_xor(v, 32)) | (max_x32(v) != fmaxf(v, __shfl_xor(v, 32)));
            if (SELFTEST_F8 & 16) bad |= (lane_ != (int)(threadIdx.x & 63));
            const int iv = lane_ * 3 + 1; if (SELFTEST_F8 & 32) bad |= (__builtin_amdgcn_readlane(iv, 5) != 16) | false; { const int bp = __builtin_amdgcn_ds_bpermute((lane_ - 1) << 2, iv); if (SELFTEST_F8 & 32) bad |= (lane_ > 0 && bp != iv - 3); }
            const float xq = 0.37f + (float)lane_; const float rq = __builtin_amdgcn_rsqf(xq), rr = 1.0f / sqrtf(xq); if (SELFTEST_F8 & 64) bad |= (fabsf(rq - rr) > 1e-5f * rr); }
        if (bad) __hip_atomic_store((unsigned*)(F.ws + WS_CTL) + CW_TMO, 1u, __ATOMIC_RELAXED, __HIP_MEMORY_SCOPE_AGENT);
    }
#endif
    float* COS = (float*)(F.ws + WS_ROPE); float* SIN = COS + SEQ * 32;
    const int gt = F.vcu * NTHR + tid_, NGT = F.G * NTHR;
    for (int i = gt; i < SEQ * 32; i += NGT) {
        const int t = i >> 5, p = i & 31;
        const float fr = expf(-9.210340371976184f * (float)(p & 15) * (1.0f / 16.0f));
        const float pos = (float)((p < 16) ? (t >> 6) : (t & 63));
        float rev = pos * fr * 0.15915494309189535f; rev -= floorf(rev);
        COS[i] = __builtin_amdgcn_cosf(rev); SIN[i] = __builtin_amdgcn_sinf(rev);
    }
}

__device__ __forceinline__ void ph_gmlp(Frame& F, int l) {
    int lane_ = lane_id(); asm volatile("" : "+v"(lane_)); const int tid_ = F.wave * 64 + lane_;
    const bf16* UACT = (const bf16*)(F.ws + WS_UACT); const bf16* VACT = (const bf16*)(F.ws + WS_VACT);
    const float* VSTAT = (const float*)(F.ws + WS_VSTAT); float* GMSTAT = (float*)(F.ws + WS_GMSTAT);
    bf16* MERGED = (bf16*)(F.ws + WS_MERGED);
    const float* gvn = F.in[4] + (size_t)l * GMW; const float* bs = F.in[6] + (size_t)l * 4 * 128;
    const bf16* WSB = (const bf16*)(F.ws + WS_WSB) + (size_t)l * 4 * 128 * 128;
    LAS bf16* vT = (LAS bf16*)F.lds;
    const int fr = lane_ & 15, fq = lane_ >> 4, w = F.wave;
    const int jv = tid_ & 127, csv = tid_ >> 7;
    v4u nraw[4]; f32x4 ns0, ns1;
#define GM_LOADV(U_) do { const int n_ = (U_) >> 2, g_ = (U_) & 3; const size_t row_ = (size_t)n_ * 128 + jv; ns0 = *(const f32x4*)(VSTAT + row_ * 8); ns1 = *(const f32x4*)(VSTAT + row_ * 8 + 4); \
        _Pragma("unroll") for (int q_ = 0; q_ < 4; ++q_) nraw[q_] = *(const v4u*)(VACT + row_ * GMW + g_ * 128 + (csv * 4 + q_) * 8); } while (0)
    constexpr int NU = (T / 128) * 4;
    unsigned* gmq = (unsigned*)(F.ws + WS_CTL) + CW_GMQ + 64 * l;
    LAS int* nxt = (LAS int*)(F.lds + 36864);
    if (F.vcu < NU) GM_LOADV(F.vcu);
    for (int u = F.vcu; u < NU; ) {
        const int n = u >> 2, g = u & 3; const int row0 = n * 128;
        v4u raw[4]; const f32x4 s0 = ns0, s1 = ns1;
#pragma unroll
        for (int q = 0; q < 4; ++q) raw[q] = nraw[q];
        __syncthreads();
        unsigned tk = 0u; if (tid_ == 0) tk = __hip_atomic_fetch_add(gmq, 1u, __ATOMIC_RELAXED, __HIP_MEMORY_SCOPE_AGENT);
        {   const float rinv = __builtin_amdgcn_rsqf((((s0[0] + s0[1]) + (s0[2] + s0[3])) + ((s1[0] + s1[1]) + (s1[2] + s1[3]))) * (1.0f / GMW) + EPS);
#pragma unroll
            for (int q = 0; q < 4; ++q) { const int c8 = (csv * 4 + q) * 8;
                const f32x4 g0 = *(const f32x4*)(gvn + g * 128 + c8) * rinv, g1 = *(const f32x4*)(gvn + g * 128 + c8 + 4) * rinv;
                LAS bf16* d = vT + c8 * 136 + jv;
                d[0 * 136] = (bf16)f2bf(bflo(raw[q].x) * g0[0]); d[1 * 136] = (bf16)f2bf(bfhi(raw[q].x) * g0[1]); d[2 * 136] = (bf16)f2bf(bflo(raw[q].y) * g0[2]); d[3 * 136] = (bf16)f2bf(bfhi(raw[q].y) * g0[3]);
                d[4 * 136] = (bf16)f2bf(bflo(raw[q].z) * g1[0]); d[5 * 136] = (bf16)f2bf(bfhi(raw[q].z) * g1[1]); d[6 * 136] = (bf16)f2bf(bflo(raw[q].w) * g1[2]); d[7 * 136] = (bf16)f2bf(bfhi(raw[q].w) * g1[3]); } }
        bf16x8_t bw[4];
#pragma unroll
        for (int ks = 0; ks < 4; ++ks) bw[ks] = *(const bf16x8_t*)(WSB + ((size_t)(g * 128 + 16 * w + fr)) * 128 + 32 * ks + 8 * fq);
        const size_t row = (size_t)row0 + 16 * w + fr; const float bias = bs[g * 128 + 16 * w + fr];
        v2u uu[8];
#pragma unroll
        for (int cb = 0; cb < 8; ++cb) uu[cb] = *(const v2u*)(UACT + row * GMW + g * 128 + 16 * cb + 4 * fq);
        if (tid_ == 0) *nxt = F.G + (int)tk;
        __syncthreads();
        const int un = *nxt;
        if (un < NU) GM_LOADV(un);
        f32x4 acc[8];
#pragma unroll
        for (int cb = 0; cb < 8; ++cb) { acc[cb] = (f32x4){0.f, 0.f, 0.f, 0.f};
#pragma unroll
            for (int ks = 0; ks < 4; ++ks) { const bf16x8_t a = *(const LAS bf16x8_t*)(vT + (16 * cb + fr) * 136 + 32 * ks + 8 * fq);
                acc[cb] = __builtin_amdgcn_mfma_f32_16x16x32_bf16(a, bw[ks], acc[cb], 0, 0, 0); } }
        float ss = 0.f;
#pragma unroll
        for (int cb = 0; cb < 8; ++cb) {
            v2u o; o.x = pk2(bflo(uu[cb].x) * (acc[cb][0] + bias), bfhi(uu[cb].x) * (acc[cb][1] + bias)); o.y = pk2(bflo(uu[cb].y) * (acc[cb][2] + bias), bfhi(uu[cb].y) * (acc[cb][3] + bias));
            *(v2u*)(MERGED + row * 1024 + g * 128 + 16 * cb + 4 * fq) = o;
            const float a0 = bflo(o.x), a1 = bfhi(o.x), a2 = bflo(o.y), a3 = bfhi(o.y); ss += (a0 * a0 + a1 * a1) + (a2 * a2 + a3 * a3); }
        ss = add_x32(add_x16(ss));
        if (fq == 0) GMSTAT[row * 4 + g] = ss;
        u = un;
    }
#undef GM_LOADV
    __syncthreads();
}

__device__ __forceinline__ void ph_router(Frame& F, int l) {
    const bf16* XR = (const bf16*)(F.ws + WS_XR); float* AFF = (float*)(F.ws + WS_AFF); unsigned char* X8 = F.ws + WS_XR8;
    constexpr int RP = 2064;
    const int gw = F.vcu * NWAVES + F.wave, NGW = F.G * NWAVES;
    for (int blk = gw; blk < T / 16; blk += NGW) {
        int lane_ = lane_id(); asm volatile("" : "+v"(lane_)); const int fr = lane_ & 15, fq = lane_ >> 4;
        v4u x[32];
#pragma unroll
        for (int ks = 0; ks < 32; ++ks) x[ks] = *(const v4u*)(XR + ((size_t)blk * 16 + fr) * D + 128 * (ks >> 2) + 32 * fq + 8 * (ks & 3));
        if (blk == gw) {
        {
            int tid_ = F.wave * 64 + lane_id(); asm volatile("" : "+v"(tid_));
            const bf16* gh = (const bf16*)(F.ws + WS_WRH) + (size_t)l * NE * D; const bf16* gl = (const bf16*)(F.ws + WS_WRL) + (size_t)l * NE * D;
            v4u th[4], tl[4];
#pragma unroll
            for (int i = 0; i < 4; ++i) { const int c = tid_ + 512 * i; th[i] = *(const v4u*)(gh + (size_t)(c >> 7) * D + 8 * (c & 127)); tl[i] = *(const v4u*)(gl + (size_t)(c >> 7) * D + 8 * (c & 127)); }
#pragma unroll
            for (int i = 0; i < 4; ++i) { const int c = tid_ + 512 * i; *(LAS v4u*)(F.lds + (c >> 7) * RP + 16 * (c & 127)) = th[i]; *(LAS v4u*)(F.lds + 16 * RP + (c >> 7) * RP + 16 * (c & 127)) = tl[i]; }
        }
        __syncthreads();
        }
        int wo_ = fr * RP + 64 * fq; asm volatile("" : "+v"(wo_));
        const LAS unsigned char* wp = F.lds + wo_;
        const size_t row = (size_t)blk * 16 + fr;
        f32x4 acc = (f32x4){0.f, 0.f, 0.f, 0.f}; float ss = 0.f;
#pragma unroll
        for (int ks = 0; ks < 32; ++ks) { const bf16x8_t xk = __builtin_bit_cast(bf16x8_t, x[ks]);
            const bf16x8_t wh = *(const LAS bf16x8_t*)(wp + 256 * (ks >> 2) + 16 * (ks & 3)), wl = *(const LAS bf16x8_t*)(wp + 16 * RP + 256 * (ks >> 2) + 16 * (ks & 3));
            acc = __builtin_amdgcn_mfma_f32_16x16x32_bf16(wh, xk, acc, 0, 0, 0); acc = __builtin_amdgcn_mfma_f32_16x16x32_bf16(wl, xk, acc, 0, 0, 0);
            const v4u xb = x[ks];
            const float a0 = bflo(xb.x), a1 = bfhi(xb.x), a2 = bflo(xb.y), a3 = bfhi(xb.y), a4 = bflo(xb.z), a5 = bfhi(xb.z), a6 = bflo(xb.w), a7 = bfhi(xb.w);
            ss += ((a0 * a0 + a1 * a1) + (a2 * a2 + a3 * a3)) + ((a4 * a4 + a5 * a5) + (a6 * a6 + a7 * a7)); }
        ss = add_x32(add_x16(ss));
        const float rinv = __builtin_amdgcn_rsqf(ss * (1.0f / D) + EPS);
        const f32x4 lg = acc * (rinv * LOG2E);
        float mx = fmaxf(fmaxf(lg[0], lg[1]), fmaxf(lg[2], lg[3])); mx = max_x32(max_x16(mx));
        f32x4 pe; float den = 0.f;
#pragma unroll
        for (int i = 0; i < 4; ++i) { pe[i] = __builtin_amdgcn_exp2f(lg[i] - mx); den += pe[i]; }
        den = add_x32(add_x16(den));
        *(f32x4*)(AFF + row * NE + 4 * fq) = pe * __builtin_amdgcn_rcpf(den);
        const float sc = rinv * A8S;
#pragma unroll
        for (int g = 0; g < 8; ++g) {
            v4u o0, o1;
#pragma unroll
            for (int i = 0; i < 4; ++i) asm volatile("" : "+v"(x[4 * g + i]));
#define RT8(xb, lo_, hi_) lo_ = pk4_fp8(bflo(xb.x) * sc, bfhi(xb.x) * sc, bflo(xb.y) * sc, bfhi(xb.y) * sc); hi_ = pk4_fp8(bflo(xb.z) * sc, bfhi(xb.z) * sc, bflo(xb.w) * sc, bfhi(xb.w) * sc);
            RT8(x[4 * g], o0.x, o0.y) RT8(x[4 * g + 1], o0.z, o0.w) RT8(x[4 * g + 2], o1.x, o1.y) RT8(x[4 * g + 3], o1.z, o1.w)
#undef RT8
            *(v4u*)(X8 + row * D + 128 * g + 32 * fq) = o0; *(v4u*)(X8 + row * D + 128 * g + 32 * fq + 16) = o1; }
    }
}

__device__ __forceinline__ void ph_topk(Frame& F) {
    int lane_ = lane_id(); asm volatile("" : "+v"(lane_)); const int tid_ = F.wave * 64 + lane_;
    const float* AFF = (const float*)(F.ws + WS_AFF); int* IDX = (int*)(F.ws + WS_IDX); int* INV = (int*)(F.ws + WS_INV);
    LAS unsigned* hist = (LAS unsigned*)F.lds;
    LAS unsigned* sh = hist + 256;
    LAS unsigned* wsum = hist + 512;
    for (int p = F.vcu; p < NB_ * NE; p += F.G) {
        const int b = p >> 4, e = p & 15;
        unsigned key[16];
#pragma unroll
        for (int i = 0; i < 16; ++i) key[i] = __builtin_bit_cast(unsigned, AFF[((size_t)b * SEQ + tid_ * 16 + i) * NE + e]);
        unsigned prefix = 0u, krem = CAP;
#pragma unroll
        for (int pass = 0; pass < 4; ++pass) {
            const int shift = pass == 3 ? 0 : 23 - 8 * pass; const unsigned dmask = pass == 3 ? 127u : 255u;
            const unsigned himask = pass == 0 ? 0u : (pass == 1 ? 0xff800000u : (pass == 2 ? 0xffff8000u : 0xffffff80u));
            __syncthreads();
            if (tid_ < 256) hist[tid_] = 0u;
            __syncthreads();
#pragma unroll
            for (int i = 0; i < 16; ++i) if ((key[i] & himask) == prefix) atomicAdd((unsigned*)&hist[(key[i] >> shift) & dmask], 1u);
            __syncthreads();
            if (F.wave == 0) {
                unsigned c[4]; unsigned t = 0u;
#pragma unroll
                for (int j = 0; j < 4; ++j) { c[j] = hist[255 - 4 * lane_ - j]; t += c[j]; }
                unsigned inc = t;
#pragma unroll
                for (int o = 1; o < 64; o <<= 1) { const unsigned a = (unsigned)__builtin_amdgcn_ds_bpermute((lane_ - o) << 2, (int)inc); if (lane_ >= o) inc += a; }
                unsigned above = inc - t;
                if (above < krem && krem <= inc) {
                    int d = 255 - 4 * lane_;
#pragma unroll
                    for (int j = 0; j < 3; ++j) { if (above + c[j] < krem) { above += c[j]; d = 254 - 4 * lane_ - j; } else break; }
                    sh[0] = prefix | ((unsigned)d << shift); sh[1] = krem - above; }
            }
            __syncthreads();
            prefix = sh[0]; krem = sh[1];
        }
        const unsigned thr = prefix;
        unsigned cg = 0u, ce = 0u;
#pragma unroll
        for (int i = 0; i < 16; ++i) { cg += key[i] > thr ? 1u : 0u; ce += key[i] == thr ? 1u : 0u; }
        unsigned sg = cg, se = ce;
#pragma unroll
        for (int o = 1; o < 64; o <<= 1) { const unsigned a = (unsigned)__builtin_amdgcn_ds_bpermute((lane_ - o) << 2, (int)sg), c2 = (unsigned)__builtin_amdgcn_ds_bpermute((lane_ - o) << 2, (int)se); if (lane_ >= o) { sg += a; se += c2; } }
        __syncthreads();
        if (lane_ == 63) { wsum[F.wave] = sg; wsum[8 + F.wave] = se; }
        __syncthreads();
        unsigned og = 0u, oe = 0u;
        for (int w = 0; w < F.wave; ++w) { og += wsum[w]; oe += wsum[8 + w]; }
        unsigned gb = og + sg - cg, eb = oe + se - ce;
#pragma unroll
        for (int i = 0; i < 16; ++i) {
            const int t = tid_ * 16 + i; int pos = -1;
            if (key[i] > thr) { pos = (int)(gb + (eb < krem ? eb : krem)); ++gb; }
            else if (key[i] == thr) { if (eb < krem) pos = (int)(gb + eb); ++eb; }
            INV[((size_t)b * SEQ + t) * NE + e] = pos;
            if (pos >= 0) IDX[(size_t)p * CAP + pos] = t;
        }
    }
    __syncthreads();
}

__device__ __forceinline__ void ph_combine(Frame& F, int l, bool dummy) {
    int lane_ = lane_id(); asm volatile("" : "+v"(lane_));
    const float* AFF = (const float*)(F.ws + WS_AFF); const int* INV = (const int*)(F.ws + WS_INV);
    const unsigned char* Y = F.ws + WS_Y; bf16* XR = (bf16*)(F.ws + WS_XR); const float* fg = F.in[21]; float* RINV = (float*)(F.ws + WS_RINV);
    const int gw = F.vcu * NWAVES + F.wave, NGW = F.G * NWAVES;
#define CMB_LOAD_A(X_, POS_, AFF_, M_) do { POS_ = -1; AFF_ = 0.f; if ((M_) < T) { _Pragma("unroll") for (int j_ = 0; j_ < 4; ++j_) X_[j_] = *(const v2u*)(XR + (size_t)(M_) * D + 4 * lane_ + 256 * j_); \
        if (lane_ < NE) { POS_ = INV[(size_t)(M_) * NE + lane_]; AFF_ = AFF[(size_t)(M_) * NE + lane_]; } } } while (0)
#define CMB_ISSUE_Y(W_, AS_, MASK_, POS_, AFF_, M_) do { MASK_ = (unsigned)__builtin_amdgcn_ballot_w64(POS_ >= 0) & 0xffffu; const int b_ = ((M_) < T ? (M_) : 0) / SEQ; \
        _Pragma("unroll") for (int q_ = 0; q_ < 4; ++q_) { AS_[q_] = 0.f; _Pragma("unroll") for (int j_ = 0; j_ < 4; ++j_) W_[q_][j_] = 0; \
            if (MASK_) { const int e_ = __builtin_ctz(MASK_); MASK_ &= MASK_ - 1u; const int pos_ = __builtin_amdgcn_readlane(POS_, e_); \
                AS_[q_] = __builtin_bit_cast(float, __builtin_amdgcn_readlane(__builtin_bit_cast(int, AFF_), e_)) * (1.0f / Y8S); const unsigned char* yr_ = Y + ((size_t)(b_ * NE + e_) * CAP + pos_) * D; \
                _Pragma("unroll") for (int j_ = 0; j_ < 4; ++j_) W_[q_][j_] = *(const int*)(yr_ + 4 * lane_ + 256 * j_); } } } while (0)
#define CMB_ACC(W_, AS_) do { _Pragma("unroll") for (int q_ = 0; q_ < 4; ++q_) _Pragma("unroll") for (int j_ = 0; j_ < 4; ++j_) { \
        const auto lo_ = __builtin_amdgcn_cvt_pk_f32_fp8(W_[q_][j_], false), hi_ = __builtin_amdgcn_cvt_pk_f32_fp8(W_[q_][j_], true); const float l0_ = lo_[0], l1_ = lo_[1], h0_ = hi_[0], h1_ = hi_[1]; \
        v[j_].x += AS_[q_] * l0_; v[j_].y += AS_[q_] * l1_; v[j_].z += AS_[q_] * h0_; v[j_].w += AS_[q_] * h1_; } } while (0)
    v2u cx[4], nx[4]; int cpos, npos; float caff, naff; int cw[4][4]; float cas[4]; unsigned cmask;
    CMB_LOAD_A(cx, cpos, caff, gw); CMB_LOAD_A(nx, npos, naff, gw + NGW);
    CMB_ISSUE_Y(cw, cas, cmask, cpos, caff, gw);
    for (int m = gw; m < T; m += NGW) {
        const int b = m / SEQ;
        bf16* xw = (dummy ? (bf16*)(F.ws + WS_NSCR) : XR) + (size_t)m * D; float* ow = (dummy ? (float*)(F.ws + WS_NSCR) : F.xres) + (size_t)m * D;
        v2u tx[4]; int tw[4][4]; float tas[4]; unsigned tmask; const int tpos = npos; const float taff = naff;
#pragma unroll
        for (int j = 0; j < 4; ++j) tx[j] = nx[j];
        CMB_ISSUE_Y(tw, tas, tmask, tpos, taff, m + NGW);
        CMB_LOAD_A(nx, npos, naff, m + 2 * NGW);
        f32x4 v[4];
#pragma unroll
        for (int j = 0; j < 4; ++j) v[j] = (f32x4){bflo(cx[j].x), bfhi(cx[j].x), bflo(cx[j].y), bfhi(cx[j].y)};
        CMB_ACC(cw, cas);
        while (cmask) {
            int rw[4][4]; float ras[4]; unsigned rm = cmask; const int rpos = cpos; const float raff = caff;
            (void)b;
            {   unsigned mk = rm;
#pragma unroll
                for (int q = 0; q < 4; ++q) { ras[q] = 0.f;
#pragma unroll
                    for (int j = 0; j < 4; ++j) rw[q][j] = 0;
                    if (mk) { const int e = __builtin_ctz(mk); mk &= mk - 1u; const int pos = __builtin_amdgcn_readlane(rpos, e);
                        ras[q] = __builtin_bit_cast(float, __builtin_amdgcn_readlane(__builtin_bit_cast(int, raff), e)) * (1.0f / Y8S); const unsigned char* yr = Y + ((size_t)(b * NE + e) * CAP + pos) * D;
#pragma unroll
                        for (int j = 0; j < 4; ++j) rw[q][j] = *(const int*)(yr + 4 * lane_ + 256 * j); } }
                cmask = mk; }
            CMB_ACC(rw, ras);
        }
#pragma unroll
        for (int j = 0; j < 4; ++j) cx[j] = tx[j];
        cpos = tpos; caff = taff; cmask = tmask;
#pragma unroll
        for (int q = 0; q < 4; ++q) { cas[q] = tas[q];
#pragma unroll
            for (int j = 0; j < 4; ++j) cw[q][j] = tw[q][j]; }
        float s = 0.f;
#pragma unroll
        for (int j = 0; j < 4; ++j) s += (v[j].x * v[j].x + v[j].y * v[j].y) + (v[j].z * v[j].z + v[j].w * v[j].w);
        const float rinv = __builtin_amdgcn_rsqf(wave_sum(s) * (1.0f / D) + EPS);
        if (l == NL - 1) {
#if defined(SELFTEST_F8)
            if (__hip_atomic_load((unsigned*)(F.ws + WS_CTL) + CW_TMO, __ATOMIC_RELAXED, __HIP_MEMORY_SCOPE_AGENT) != 0u) v[0].x = __builtin_nanf("");
#endif
            float pr_ = 1.0f;
#if REPK == 300 || REPK == 301 || REPK == 302 || REPK == 310
            { const unsigned* pw_ = (const unsigned*)(F.ws + WS_CTL + 64); float rr_ = (float)pw_[0] / (float)pw_[1]; if (REPK == 302) rr_ = floorf(rr_ * 20.0f) * 0.05f; if (REPK == 310) rr_ = floorf(rr_ * PROBE_Q + PROBE_QOFF) / PROBE_Q; pr_ = 1.0f + (REPK == 301 ? 1.0f : (REPK == 310 ? PROBE_SCALE : 0.125f)) * rr_; }
#endif
#pragma unroll
            for (int j = 0; j < 4; ++j) { const f32x4 g = *(const f32x4*)(fg + 4 * lane_ + 256 * j); *(f32x4*)(ow + 4 * lane_ + 256 * j) = (f32x4){v[j].x * rinv * g.x * pr_, v[j].y * rinv * g.y * pr_, v[j].z * rinv * g.z * pr_, v[j].w * rinv * g.w * pr_}; }
        } else {
            if (lane_ == 0 && !dummy) RINV[m] = rinv;
#pragma unroll
            for (int j = 0; j < 4; ++j) { v2u o; o.x = pk2(v[j].x, v[j].y); o.y = pk2(v[j].z, v[j].w); *(v2u*)(xw + 4 * lane_ + 256 * j) = o; }
        }
    }
}

#undef CMB_LOAD_A
#undef CMB_ISSUE_Y
#undef CMB_ACC
namespace pg8 {
typedef short bf16x8 __attribute__((ext_vector_type(8)));
typedef float f32x2 __attribute__((ext_vector_type(2)));
typedef int v4i_t __attribute__((ext_vector_type(4)));
typedef int v8i_t __attribute__((ext_vector_type(8)));
constexpr int BM = 256, BK = 64, HALF = 128, HTB = HALF * BK * 2, STAGE_BYTES = 8 * HTB, NXCD = 8, WGM = 2;
__host__ __device__ __forceinline__ int lds_byte(int r, int c) { const int st = (r >> 4) * 2 + (c >> 5), rr = r & 15, cc = c & 31, ob = rr * 64 + cc * 2; return st * 1024 + (ob ^ (((ob >> 9) & 1) << 5)); }
__host__ __device__ __forceinline__ void stage_rc(int b, int& R, int& C) { const int st = b / 1024, sb = b % 1024, swz = sb ^ (((sb >> 9) & 1) << 5); R = (st >> 1) * 16 + swz / 64; C = (st & 1) * 32 + (swz % 64) / 2; }
__host__ __device__ __forceinline__ int perm32(int rho) { const int n = rho >> 4, i = rho & 15; return 8 * (i >> 2) + 4 * n + (i & 3); }

struct Unit { int pm, pn, z; const char* a; const char* b; const int* gi; int grow; };

struct TileOrder {
    int nM, nN, nwg, G, c;
    __device__ __forceinline__ void init(int nM_, int nN_, int G_, int c_) { nM = nM_; nN = nN_; nwg = nM * nN; G = G_; c = c_; }
    __device__ __forceinline__ bool tile(int i, int& pm, int& pn) const {
        const long L = (long)i * G + c; if (L >= nwg) return false;
        int wgid = (int)L; { const int q = nwg / NXCD, r = nwg % NXCD, xcd = wgid % NXCD, off = wgid / NXCD; wgid = (xcd < r ? xcd * (q + 1) : r * (q + 1) + (xcd - r) * q) + off; }
        const int nig = WGM * nN, gid = wgid / nig, fm = gid * WGM, gsz = (nM - fm) < WGM ? (nM - fm) : WGM;
        pm = fm + ((wgid % nig) % gsz); pn = (wgid % nig) / gsz; return true;
    }
};

__device__ __forceinline__ unsigned cvt_pk_bf16(float lo, float hi) { unsigned r; asm volatile("v_cvt_pk_bf16_f32 %0, %1, %2" : "=v"(r) : "v"(lo), "v"(hi)); return r; }
typedef f32x4 Acc[2][2][4][2];
#ifndef NT_STORE
#define NT_STORE 0
#endif
__device__ __forceinline__ void st16(void* p, const v4u w, bool nostore = false) { if (nostore) return; if (NT_STORE) __builtin_nontemporal_store(w, (v4u*)p); else *(v4u*)p = w; }
#ifndef NT_Y
#define NT_Y 1
#endif

template <class Epi, class Sched, bool ALIGN_EPI, bool GATHER, bool FP8 = false>
__device__ __forceinline__ void gemm_phase(LAS unsigned char* lds, const int wave_idx, const int lda, const int ldb, const int K, const Sched& S, Epi& E) {
    const int lane = lane_id();
    int wid = wave_idx; asm volatile("" : "+s"(wid));
    const int tid = wid * 64 + lane, wr = wid >> 2, wc = wid & 3, fr = lane & 15, fq = lane >> 4;
    const int nt = K / BK;
    unsigned voffA[2], voffB[2];
#pragma unroll
    for (int i = 0; i < 2; ++i) { int R, C; stage_rc(tid * 16 + i * 8192, R, C); const int Rb = (R & ~31) + perm32(R & 31);
        voffA[i] = (unsigned)(R * lda + C) * 2u; voffB[i] = (unsigned)(Rb * ldb + C) * 2u; }
    const size_t kstep = (size_t)(BK * 2);
    const size_t hstepA = (size_t)HALF * lda * 2, hstepB = (size_t)HALF * ldb * 2;
    const unsigned ldsw = (unsigned)wid * 1024u;
    const int aoff = lds_byte(wr * 64 + fr, fq * 8), boff = lds_byte(wc * 32 + fr, fq * 8);
    unsigned vgc[2][2], vgn[2][2];
#define PG8_SA(b, h) (((b) * 2 + (h)) * HTB)
#define PG8_SB(b, h) ((4 + (b) * 2 + (h)) * HTB)
#define PG8_GL(gp, voff, bufoff, _i) __builtin_amdgcn_global_load_lds((const unsigned*)((const char*)(gp) + (voff)), (LAS unsigned*)(lds + (bufoff) + ldsw + (_i) * 8192), 16, 0, 0)
#define PG8_STAGE_B(bufoff, gbase) do { PG8_GL(gbase, voffB[0], bufoff, 0); PG8_GL(gbase, voffB[1], bufoff, 1); } while (0)
#define PG8_STAGE_A(bufoff, gbase, h, VG) do { if constexpr (GATHER) { PG8_GL(gbase, VG[h][0], bufoff, 0); PG8_GL(gbase, VG[h][1], bufoff, 1); } \
        else { PG8_GL((gbase) + (h) * hstepA, voffA[0], bufoff, 0); PG8_GL((gbase) + (h) * hstepA, voffA[1], bufoff, 1); } } while (0)
#define PG8_CAT(x0, x1) __builtin_shufflevector(__builtin_bit_cast(v4i_t, x0), __builtin_bit_cast(v4i_t, x1), 0, 1, 2, 3, 4, 5, 6, 7)
#define PG8_RD(off) (*(const LAS bf16x8*)(lds + (off)))
#define PG8_LDA(dst, b, h) do { if constexpr (FP8) { _Pragma("unroll") for (int m = 0; m < 4; ++m) dst##8[m] = PG8_CAT(PG8_RD(PG8_SA(b, h) + aoff + m * 2048), PG8_RD(PG8_SA(b, h) + aoff + m * 2048 + 1024)); } \
        else { _Pragma("unroll") for (int m = 0; m < 4; ++m) _Pragma("unroll") for (int k = 0; k < 2; ++k) dst[m][k] = PG8_RD(PG8_SA(b, h) + aoff + m * 2048 + k * 1024); } } while (0)
#define PG8_LDB(dst, b, h) do { if constexpr (FP8) { _Pragma("unroll") for (int n = 0; n < 2; ++n) dst##8[n] = PG8_CAT(PG8_RD(PG8_SB(b, h) + boff + n * 2048), PG8_RD(PG8_SB(b, h) + boff + n * 2048 + 1024)); } \
        else { _Pragma("unroll") for (int n = 0; n < 2; ++n) _Pragma("unroll") for (int k = 0; k < 2; ++k) dst[n][k] = PG8_RD(PG8_SB(b, h) + boff + n * 2048 + k * 1024); } } while (0)
#define PG8_MMA(ai, bj, At, Bt) do { __builtin_amdgcn_s_setprio(1); _Pragma("unroll") for (int m = 0; m < 4; ++m) _Pragma("unroll") for (int n = 0; n < 2; ++n) { \
        if constexpr (FP8) asm volatile("v_mfma_scale_f32_16x16x128_f8f6f4 %0, %1, %2, %0, %3, %3 op_sel_hi:[0,0,0]" : "+v"(acc[ai][bj][m][n]) : "v"(Bt##8[n]), "v"(At##8[m]), "v"(sc8)); \
        else { _Pragma("unroll") for (int k = 0; k < 2; ++k) acc[ai][bj][m][n] = __builtin_amdgcn_mfma_f32_16x16x32_bf16(Bt[n][k], At[m][k], acc[ai][bj][m][n], 0, 0, 0); } } __builtin_amdgcn_s_setprio(0); } while (0)
#define PG8_WAIT_V(n) asm volatile("s_waitcnt vmcnt(" #n ")" ::: "memory")
#define PG8_WAIT_L(n) asm volatile("s_waitcnt lgkmcnt(" #n ")" ::: "memory")
#define PG8_BAR __builtin_amdgcn_s_barrier()
#define PG8_SCHED __builtin_amdgcn_sched_barrier(0)
#define PG8_GIDX(VG, U) do { const int _t = wid * 64 + lane_id();   \
        _Pragma("unroll") for (int _i = 0; _i < 2; ++_i) { int _R, _C; stage_rc(_t * 16 + _i * 8192, _R, _C); _Pragma("unroll") for (int _h = 0; _h < 2; ++_h) \
        VG[_h][_i] = (unsigned)((U).grow + (U).gi[_h * HALF + _R]) * (unsigned)(lda * 2) + (unsigned)_C * 2u; } } while (0)
    Unit cur, nxt; int ui = 0;
    if (!S.next(0, cur)) return;
    Acc acc;
#pragma unroll
    for (int a = 0; a < 2; ++a)
#pragma unroll
        for (int b = 0; b < 2; ++b)
#pragma unroll
            for (int m = 0; m < 4; ++m)
#pragma unroll
                for (int n = 0; n < 2; ++n) acc[a][b][m][n] = (f32x4){0.f, 0.f, 0.f, 0.f};
    bf16x8 At[4][2], B0[2][2], B1[2][2];
    v8i_t At8[4], B08[2], B18[2];
    unsigned sc8 = 0x7f7f7f7fu; asm volatile("" : "+v"(sc8));
    const char* cA = cur.a; const char* cB = cur.b;
    if constexpr (GATHER) { PG8_GIDX(vgc, cur); } else { vgc[0][0] = vgc[0][1] = vgc[1][0] = vgc[1][1] = 0u; }
    E.prep(cur, wr, wc, fr, fq);
    PG8_STAGE_B(PG8_SB(0, 0), cB); PG8_STAGE_B(PG8_SB(0, 1), cB + hstepB); PG8_STAGE_A(PG8_SA(0, 0), cA, 0, vgc); PG8_STAGE_A(PG8_SA(0, 1), cA, 1, vgc);
    if (wr == 1) PG8_BAR;
    PG8_WAIT_V(2); PG8_BAR;
    PG8_STAGE_B(PG8_SB(1, 0), cB + kstep); PG8_STAGE_A(PG8_SA(1, 0), cA + kstep, 0, vgc); PG8_STAGE_B(PG8_SB(1, 1), cB + hstepB + kstep);
    PG8_WAIT_V(6); PG8_BAR;
    for (;;) {
        const bool has_next = S.next(ui + 1, nxt);
        const char* nA = has_next ? nxt.a : cA; const char* nB = has_next ? nxt.b : cB;
        if constexpr (GATHER) { if (has_next) { PG8_GIDX(vgn, nxt); } else {
#pragma unroll
            for (int h = 0; h < 2; ++h) { vgn[h][0] = vgc[h][0]; vgn[h][1] = vgc[h][1]; } } }
        else { vgn[0][0] = vgn[0][1] = vgn[1][0] = vgn[1][1] = 0u; }
        for (int t = 0; t < nt; t += 2) {
            const bool last = (t == nt - 2);
            const char* a1 = cA + (size_t)(t + 1) * kstep;
            const char* a2 = last ? nA : cA + (size_t)(t + 2) * kstep; const char* b2 = last ? nB : cB + (size_t)(t + 2) * kstep;
            const char* a3 = a2 + kstep; const char* b3 = b2 + kstep;
            if constexpr (Epi::MIDK) { if (t == (nt >> 1)) E.midk(acc); }
            PG8_LDB(B0, 0, 0); PG8_LDB(B1, 0, 1); PG8_SCHED; PG8_LDA(At, 0, 0); PG8_STAGE_A(PG8_SA(1, 1), a1, 1, vgc);
            if constexpr (GATHER) { if (last) {
#pragma unroll
                for (int h = 0; h < 2; ++h) { vgc[h][0] = vgn[h][0]; vgc[h][1] = vgn[h][1]; } } }
            PG8_WAIT_V(8); PG8_WAIT_L(0); PG8_BAR; PG8_MMA(0, 0, At, B0); PG8_MMA(0, 1, At, B1); PG8_BAR; PG8_SCHED;
            PG8_LDA(At, 0, 1); PG8_STAGE_B(PG8_SB(0, 0), b2); PG8_STAGE_B(PG8_SB(0, 1), b2 + hstepB); PG8_STAGE_A(PG8_SA(0, 0), a2, 0, vgc);
            PG8_WAIT_V(8); PG8_WAIT_L(0); PG8_BAR; PG8_MMA(1, 0, At, B0); PG8_MMA(1, 1, At, B1); PG8_BAR; PG8_SCHED;
            PG8_LDB(B0, 1, 0); PG8_LDB(B1, 1, 1); PG8_SCHED; PG8_LDA(At, 1, 0); PG8_STAGE_A(PG8_SA(0, 1), a2, 1, vgc);
            PG8_WAIT_V(8); PG8_WAIT_L(0); PG8_BAR; PG8_MMA(0, 0, At, B0); PG8_MMA(0, 1, At, B1); PG8_BAR; PG8_SCHED;
            PG8_LDA(At, 1, 1); PG8_STAGE_B(PG8_SB(1, 0), b3); PG8_STAGE_B(PG8_SB(1, 1), b3 + hstepB); PG8_STAGE_A(PG8_SA(1, 0), a3, 0, vgc);
            PG8_WAIT_V(8); PG8_WAIT_L(0); PG8_BAR; PG8_MMA(1, 0, At, B0); PG8_MMA(1, 1, At, B1); PG8_BAR; PG8_SCHED;
        }
        if constexpr (ALIGN_EPI) { if (wr == 0) PG8_BAR; }
        if constexpr (FP8) asm volatile("s_nop 15\n\ts_nop 15\n\ts_nop 15\n\ts_nop 15" ::: "memory");
        E(acc, cur, wr, wc, fr, fq);
        if (!has_next) break;
#pragma unroll
        for (int a = 0; a < 2; ++a)
#pragma unroll
            for (int b = 0; b < 2; ++b)
#pragma unroll
                for (int m = 0; m < 4; ++m)
#pragma unroll
                    for (int n = 0; n < 2; ++n) acc[a][b][m][n] = (f32x4){0.f, 0.f, 0.f, 0.f};
        cur = nxt; cA = nA; cB = nB; ++ui;
#pragma unroll
        for (int h = 0; h < 2; ++h) { vgc[h][0] = vgn[h][0]; vgc[h][1] = vgn[h][1]; }
        E.prep(cur, wr, wc, fr, fq);
        if constexpr (ALIGN_EPI) { if (wr == 1) PG8_BAR; }
    }
    PG8_WAIT_V(0);
    if constexpr (!ALIGN_EPI) { if (wr == 0) PG8_BAR; }
    PG8_BAR;
#undef PG8_SA
#undef PG8_SB
#undef PG8_GL
#undef PG8_STAGE_A
#undef PG8_STAGE_B
#undef PG8_LDA
#undef PG8_RD
#undef PG8_LDB
#undef PG8_MMA
#undef PG8_CAT
#undef PG8_WAIT_V
#undef PG8_WAIT_L
#undef PG8_SCHED
#undef PG8_GIDX
}

#define EPI_ROWS for (int ai = 0; ai < 2; ++ai) _Pragma("unroll") for (int m = 0; m < 4; ++m)
__device__ __forceinline__ v4u pack8(const f32x4 a, const f32x4 b) { v4u w; w.x = cvt_pk_bf16(a[0], a[1]); w.y = cvt_pk_bf16(a[2], a[3]); w.z = cvt_pk_bf16(b[0], b[1]); w.w = cvt_pk_bf16(b[2], b[3]); return w; }

__device__ __forceinline__ void st8x2(unsigned char* pa, unsigned char* pb, const v2u a, const v2u b, const int fq, const bool nt) {
    const auto r0 = __builtin_amdgcn_permlane16_swap(a.x, b.x, false, false); const auto r1 = __builtin_amdgcn_permlane16_swap(a.y, b.y, false, false);
    const unsigned x0 = r0[0], x1 = r0[1], y0 = r1[0], y1 = r1[1];
    const v4u w = (v4u){x0, y0, x1, y1};
    unsigned char* p = (fq & 1) ? pb - 8 : pa;
    if (nt) __builtin_nontemporal_store(w, (v4u*)p); else *(v4u*)p = w;
}
template <int mode, bool OUT8 = false>
struct EpiStore {
    static constexpr bool MIDK = false;
    bf16* O; int ldc; const float* cs; float scale; bool skip = false;
    __device__ __forceinline__ void prep(const Unit&, int, int, int, int) {}
    __device__ __forceinline__ void midk(Acc&) {}
    __device__ __forceinline__ void operator()(const Acc& acc, const Unit& u, int wr, int wc, int fr, int fq) const {
        asm volatile("" : "+v"(fr), "+v"(fq));
        if (skip) return;
        size_t base; const float* csp = cs;
        if constexpr (mode == 0) base = (size_t)u.pm * 256 * ldc + (size_t)u.pn * 256;
        else if constexpr (mode == 1) { const int lb = u.pm >> 2, h = u.pm & 3; base = (size_t)lb * D * D + (size_t)(h * 256) * D + u.pn * 256; csp = cs + (size_t)(lb >> 2) * D + u.pn * 256; }
        else if constexpr (mode == 2) { const int pml = u.pm & 3, lbh = u.pm >> 2, h = lbh & 3, lb = lbh >> 2; base = (size_t)lb * D * D + (size_t)(pml * 256) * D + h * 256; }
        else { const int l = u.pm >> 2, pml = u.pm & 3; base = (size_t)l * NMEM * 2 * D + (size_t)(pml * 256) * 2 * D + u.pn * 256; }
        const int cb = wc * 32 + 8 * fq;
        f32x4 c0[2], c1[2];
#pragma unroll
        for (int bj = 0; bj < 2; ++bj) { if (csp) { c0[bj] = *(const f32x4*)(csp + bj * HALF + cb) * scale; c1[bj] = *(const f32x4*)(csp + bj * HALF + cb + 4) * scale; } else { c0[bj] = (f32x4){scale, scale, scale, scale}; c1[bj] = c0[bj]; } }
#pragma unroll
        EPI_ROWS { bf16* rowp = O + base + (size_t)(ai * HALF + wr * 64 + m * 16 + fr) * ldc + cb;
            if constexpr (OUT8) { unsigned char* rp8 = (unsigned char*)O + base + (size_t)(ai * HALF + wr * 64 + m * 16 + fr) * ldc + cb;
#pragma unroll
                for (int bj = 0; bj < 2; ++bj) { const f32x4 a = acc[ai][bj][m][0] * c0[bj], b = acc[ai][bj][m][1] * c1[bj]; v2u o; o.x = pk4_fp8(a[0], a[1], a[2], a[3]); o.y = pk4_fp8(b[0], b[1], b[2], b[3]); *(v2u*)(rp8 + bj * HALF) = o; } }
            else
#pragma unroll
            for (int bj = 0; bj < 2; ++bj) { const v4u w_ = pack8(acc[ai][bj][m][0] * c0[bj], acc[ai][bj][m][1] * c1[bj]); if constexpr (mode == 0 && NT_Y) __builtin_nontemporal_store(w_, (v4u*)(rowp + bj * HALF)); else *(v4u*)(rowp + bj * HALF) = w_; } }
    }
};
struct EpiH {
    static constexpr bool MIDK = false;
    unsigned char* H;
    __device__ __forceinline__ void prep(const Unit&, int, int, int, int) {}
    __device__ __forceinline__ void midk(Acc&) {}
    __device__ __forceinline__ void operator()(const Acc& acc, const Unit& u, int wr, int wc, int fr, int fq) const {
        asm volatile("" : "+v"(fr), "+v"(fq));
        const int cb = u.pn * 128 + wc * 32 + 8 * fq; constexpr float us = 1.0f / (W8S * A8S);
#pragma unroll
        for (int ai = 0; ai < 2; ++ai)
#pragma unroll
            for (int m = 0; m < 4; m += 2) { const int rl = ai * HALF + wr * 64 + m * 16 + fr; unsigned char* rowp = H + (size_t)(u.pm * 256 + rl) * FF + cb;
                v2u o[2];
#pragma unroll
                for (int q = 0; q < 2; ++q) { const f32x4 h0 = silu_mul4(acc[ai][0][m + q][0], acc[ai][1][m + q][0], us, H8S), h1 = silu_mul4(acc[ai][0][m + q][1], acc[ai][1][m + q][1], us, H8S);
                    o[q].x = pk4_fp8(h0[0], h0[1], h0[2], h0[3]); o[q].y = pk4_fp8(h1[0], h1[1], h1[2], h1[3]); }
                st8x2(rowp, rowp + (size_t)16 * FF, o[0], o[1], fq, false); }
    }
};
struct EpiY8 {
    static constexpr bool MIDK = false;
    unsigned char* Y; float scale; bool skip = false, halfst = false;
    __device__ __forceinline__ void prep(const Unit&, int, int, int, int) {}
    __device__ __forceinline__ void midk(Acc&) {}
    __device__ __forceinline__ void operator()(const Acc& acc, const Unit& u, int wr, int wc, int fr, int fq) const {
        if (skip) return;
        asm volatile("" : "+v"(fr), "+v"(fq));
        const int cb = u.pn * 256 + wc * 32 + 8 * fq;
#pragma unroll
        for (int ai = 0; ai < 2; ++ai)
#pragma unroll
            for (int m = 0; m < 4; m += 2) { unsigned char* rp0 = Y + (size_t)(u.pm * 256 + ai * HALF + wr * 64 + m * 16 + fr) * D + cb; unsigned char* rp1 = rp0 + (size_t)16 * D;
#pragma unroll
                for (int bj = 0; bj < 2; ++bj) { v2u o0, o1;
                    { const f32x4 a = acc[ai][bj][m][0] * scale, b = acc[ai][bj][m][1] * scale; o0.x = pk4_fp8(a[0], a[1], a[2], a[3]); o0.y = pk4_fp8(b[0], b[1], b[2], b[3]); }
                    { const f32x4 a = acc[ai][bj][m + 1][0] * scale, b = acc[ai][bj][m + 1][1] * scale; o1.x = pk4_fp8(a[0], a[1], a[2], a[3]); o1.y = pk4_fp8(b[0], b[1], b[2], b[3]); }
                    st8x2(rp0 + bj * HALF, rp1 + bj * HALF, o0, o1, fq, false); } }
    }
};
template <bool MK, bool WRITE_XB>
struct EpiX {
    static constexpr bool MIDK = MK;
    bf16* xr; float* xstat; const float* gmstat; const float* atstat; LAS unsigned char* lds; unsigned char* xa8; float scale;
#if REPK == 2 || REPK == 4
    long wofs = 0;
#else
    static constexpr long wofs = 0;
#endif
    int wr_, wc_, fr_;
    __device__ __forceinline__ void prep(const Unit& u, int wr, int wc, int fr, int fq) {
        wr_ = wr; wc_ = wc; fr_ = fr;
        if constexpr (MK) {
            asm volatile("" : "+v"(fr), "+v"(fq));
            LAS f32x2* X = (LAS f32x2*)(lds + RING_BYTES + 1024) + (wr * 4 + wc) * 128;
#pragma unroll
            EPI_ROWS { const size_t row = (size_t)u.pm * 256 + ai * HALF + wr * 64 + m * 16 + fr;
                const f32x4 g = *(const f32x4*)(gmstat + row * 4), a0 = *(const f32x4*)(atstat + row * 8), a1 = *(const f32x4*)(atstat + row * 8 + 4);
                const float sg = (g[0] + g[1]) + (g[2] + g[3]), sa = ((a0[0] + a0[1]) + (a0[2] + a0[3])) + ((a1[0] + a1[1]) + (a1[2] + a1[3]));
                const float rgm = __builtin_amdgcn_rsqf(sg * (1.0f / 512.0f) + EPS), rat = __builtin_amdgcn_rsqf(sa * (1.0f / 512.0f) + EPS);
                if (fq == 0) X[(ai * 4 + m) * 16 + fr] = (f32x2){rgm / rat, rat}; }
            asm volatile("s_waitcnt lgkmcnt(0)" ::: "memory");
        }
    }
    __device__ __forceinline__ void midk(Acc& acc) {
        int fr = fr_; asm volatile("" : "+v"(fr));
        const LAS f32x2* X = (const LAS f32x2*)(lds + RING_BYTES + 1024) + (wr_ * 4 + wc_) * 128;
#pragma unroll
        EPI_ROWS { const float f = X[(ai * 4 + m) * 16 + fr].x;
#pragma unroll
            for (int bj = 0; bj < 2; ++bj) { acc[ai][bj][m][0] *= f; acc[ai][bj][m][1] *= f; } }
    }
    __device__ __forceinline__ void operator()(const Acc& acc, const Unit& u, int wr, int wc, int fr, int fq) const {
        asm volatile("" : "+v"(fr), "+v"(fq));
        const int cb = u.pn * 256 + wc * 32 + 8 * fq;
        v4u rb[2][4][2];
#define EPX_LOAD(AI) _Pragma("unroll") for (int mm = 0; mm < 4; ++mm) _Pragma("unroll") for (int bj = 0; bj < 2; ++bj) rb[AI][mm][bj] = *(const v4u*)(xr + ((size_t)u.pm * 256 + (AI) * HALF + wr * 64 + mm * 16 + fr) * D + cb + bj * HALF);
        if constexpr (!WRITE_XB) { EPX_LOAD(0) EPX_LOAD(1) }
#pragma unroll
        for (int ai = 0; ai < 2; ++ai) {
            if constexpr (WRITE_XB) { if (ai == 0) { EPX_LOAD(0) } else { EPX_LOAD(1) } }
#pragma unroll
            for (int m = 0; m < 4; m += 2) {
                v2u o8[2][2];
#pragma unroll
                for (int q = 0; q < 2; ++q) { const size_t row = (size_t)u.pm * 256 + ai * HALF + wr * 64 + (m + q) * 16 + fr; const size_t off = row * D + cb;
                    float f = scale; if constexpr (MK) f = ((const LAS f32x2*)(lds + RING_BYTES + 1024) + (wr * 4 + wc) * 128)[(ai * 4 + m + q) * 16 + fr].y; float ss = 0.f;
#pragma unroll
                    for (int bj = 0; bj < 2; ++bj) { const v4u b = rb[ai][m + q][bj];
                        const f32x4 x0 = (f32x4){bflo(b.x), bfhi(b.x), bflo(b.y), bfhi(b.y)} + acc[ai][bj][m + q][0] * f, x1 = (f32x4){bflo(b.z), bfhi(b.z), bflo(b.w), bfhi(b.w)} + acc[ai][bj][m + q][1] * f;
                        *(v4u*)(xr + wofs + off + bj * HALF) = pack8(x0, x1);
                        if constexpr (WRITE_XB) { o8[q][bj].x = pk4_fp8(x0[0] * A8S, x0[1] * A8S, x0[2] * A8S, x0[3] * A8S); o8[q][bj].y = pk4_fp8(x1[0] * A8S, x1[1] * A8S, x1[2] * A8S, x1[3] * A8S);
                            ss += ((x0[0] * x0[0] + x0[1] * x0[1]) + (x0[2] * x0[2] + x0[3] * x0[3])) + ((x1[0] * x1[0] + x1[1] * x1[1]) + (x1[2] * x1[2] + x1[3] * x1[3])); } }
                    if constexpr (WRITE_XB) { ss = add_x32(add_x16(ss)); if (fq == 0) xstat[row * 16 + u.pn * 4 + wc] = ss; } }
                if constexpr (WRITE_XB) { unsigned char* rp = xa8 + ((size_t)u.pm * 256 + ai * HALF + wr * 64 + m * 16 + fr) * D + cb;
#pragma unroll
                    for (int bj = 0; bj < 2; ++bj) st8x2(rp + bj * HALF, rp + (size_t)16 * D + bj * HALF, o8[0][bj], o8[1][bj], fq, false); }
                asm volatile("" ::: "memory"); } }
#undef EPX_LOAD
    }
};
constexpr int EXCH_OFF = RING_BYTES + 1024;
struct EpiS {
    static constexpr bool MIDK = false;
    const float* xstat; unsigned char* P; LAS unsigned char* lds;
    __device__ __forceinline__ void prep(const Unit& u, int wr, int wc, int fr, int fq) {
        asm volatile("" : "+v"(fr), "+v"(fq));
        LAS float* RV = (LAS float*)(lds + EXCH_OFF + 8192) + (wr * 4 + wc) * 128;
#pragma unroll
        EPI_ROWS { const size_t row = (size_t)u.pm * 256 + ai * HALF + wr * 64 + m * 16 + fr;
            const f32x4 s0 = *(const f32x4*)(xstat + row * 16), s1 = *(const f32x4*)(xstat + row * 16 + 4), s2 = *(const f32x4*)(xstat + row * 16 + 8), s3 = *(const f32x4*)(xstat + row * 16 + 12);
            const float ssq = (((s0[0] + s0[1]) + (s0[2] + s0[3])) + ((s1[0] + s1[1]) + (s1[2] + s1[3]))) + (((s2[0] + s2[1]) + (s2[2] + s2[3])) + ((s3[0] + s3[1]) + (s3[2] + s3[3])));
            if (fq == 0) RV[(ai * 4 + m) * 16 + fr] = __builtin_amdgcn_rsqf(ssq * (1.0f / D) + EPS) * (1.0f / (A8S * Q8S)); }
        asm volatile("s_waitcnt lgkmcnt(0)" ::: "memory");
    }
    __device__ __forceinline__ void midk(Acc&) {}
    __device__ __forceinline__ void operator()(Acc& acc, const Unit& u, int wr, int wc, int fr, int fq) const {
        asm volatile("" : "+v"(fr), "+v"(fq));
        LAS f32x2* X = (LAS f32x2*)(lds + EXCH_OFF);
        float mw[2][4];
#pragma unroll
        EPI_ROWS { const int rl = ai * HALF + wr * 64 + m * 16 + fr;
            const float rinv = ((const LAS float*)(lds + EXCH_OFF + 8192) + (wr * 4 + wc) * 128)[(ai * 4 + m) * 16 + fr];
            float mx = -3.0e38f;
#pragma unroll
            for (int bj = 0; bj < 2; ++bj)
#pragma unroll
                for (int n = 0; n < 2; ++n) { acc[ai][bj][m][n] *= rinv; const f32x4 v = acc[ai][bj][m][n]; mx = fmaxf(mx, fmaxf(fmaxf(v[0], v[1]), fmaxf(v[2], v[3]))); }
            mx = max_x32(max_x16(mx));
            float sm = 0.f;
#pragma unroll
            for (int bj = 0; bj < 2; ++bj)
#pragma unroll
                for (int n = 0; n < 2; ++n) { f32x4 v = acc[ai][bj][m][n];
#pragma unroll
                    for (int i = 0; i < 4; ++i) { v[i] = __builtin_amdgcn_exp2f(v[i] - mx); sm += v[i]; }
                    acc[ai][bj][m][n] = v; }
            sm = add_x32(add_x16(sm));
            mw[ai][m] = mx;
            if (fq == 0) X[rl * 4 + wc] = (f32x2){mx, sm};
            if (m & 1) asm volatile("" ::: "memory"); }
        asm volatile("s_waitcnt lgkmcnt(0)\n\ts_barrier" ::: "memory");
        const int cb = u.pn * 256 + wc * 32 + 8 * fq;
#pragma unroll
        for (int ai = 0; ai < 2; ++ai)
#pragma unroll
            for (int m = 0; m < 4; m += 2) { float f[2];
#pragma unroll
                for (int q = 0; q < 2; ++q) { const int rl = ai * HALF + wr * 64 + (m + q) * 16 + fr;
                    const f32x2 e0 = X[rl * 4 + 0], e1 = X[rl * 4 + 1], e2 = X[rl * 4 + 2], e3 = X[rl * 4 + 3];
                    const float M = fmaxf(fmaxf(e0.x, e1.x), fmaxf(e2.x, e3.x));
                    const float den = (e0.y * __builtin_amdgcn_exp2f(e0.x - M) + e1.y * __builtin_amdgcn_exp2f(e1.x - M)) + (e2.y * __builtin_amdgcn_exp2f(e2.x - M) + e3.y * __builtin_amdgcn_exp2f(e3.x - M));
                    f[q] = __builtin_amdgcn_exp2f(mw[ai][m + q] - M) * __builtin_amdgcn_rcpf(den) * P8S; }
                unsigned char* rp = P + ((size_t)u.pm * 256 + ai * HALF + wr * 64 + m * 16 + fr) * D + cb;
#pragma unroll
                for (int bj = 0; bj < 2; ++bj) { v2u o[2];
#pragma unroll
                    for (int q = 0; q < 2; ++q) { const f32x4 a = acc[ai][bj][m + q][0] * f[q], b = acc[ai][bj][m + q][1] * f[q]; o[q].x = pk4_fp8(a[0], a[1], a[2], a[3]); o[q].y = pk4_fp8(b[0], b[1], b[2], b[3]); }
                    st8x2(rp + bj * HALF, rp + (size_t)16 * D + bj * HALF, o[0], o[1], fq, false); } }
        asm volatile("s_waitcnt lgkmcnt(0)" ::: "memory");
    }
};
struct EpiIn {
    static constexpr bool MIDK = false;
    bf16 *uact, *vact, *q, *k, *v; float* vstat; const float *qg, *kg, *cosT, *sinT, *rinv; bool nostore = false, skip = false;
    __device__ __forceinline__ void prep(const Unit&, int, int, int, int) {}
    __device__ __forceinline__ void midk(Acc&) {}
    __device__ __forceinline__ void operator()(const Acc& acc, const Unit& u, int wr, int wc, int fr, int fq) const {
        asm volatile("" : "+v"(fr), "+v"(fq));
        if (skip) return;
        const int pn = u.pn;
        if (pn < 4) {
            bf16* O = pn < 2 ? uact : vact; const int cb = (pn & 1) * 256 + wc * 32 + 8 * fq;
#pragma unroll
            EPI_ROWS { const size_t row = (size_t)u.pm * 256 + ai * HALF + wr * 64 + m * 16 + fr; float ss = 0.f; const float ri = rinv[row];
#pragma unroll
                for (int bj = 0; bj < 2; ++bj) { const f32x4 g0 = gelu4(acc[ai][bj][m][0] * ri), g1 = gelu4(acc[ai][bj][m][1] * ri);
                    const v4u w = pack8(g0, g1); st16(O + row * GMW + cb + bj * HALF, w, nostore);
                    if (pn >= 2) { const float a0 = bflo(w.x), a1 = bfhi(w.x), a2 = bflo(w.y), a3 = bfhi(w.y), a4 = bflo(w.z), a5 = bfhi(w.z), a6 = bflo(w.w), a7 = bfhi(w.w);
                        ss += ((a0 * a0 + a1 * a1) + (a2 * a2 + a3 * a3)) + ((a4 * a4 + a5 * a5) + (a6 * a6 + a7 * a7)); } }
                if (pn >= 2) { ss = add_x32(add_x16(ss)); if (fq == 0) vstat[row * 8 + (pn - 2) * 4 + wc] = ss; } }
        } else if (pn == 6 && wc >= 2) {
#pragma unroll
            EPI_ROWS { const size_t row = (size_t)u.pm * 256 + ai * HALF + wr * 64 + m * 16 + fr; const float ri = rinv[row];
#pragma unroll
                for (int bj = 0; bj < 2; ++bj) st16(v + row * 128 + (wc - 2) * 64 + bj * 32 + 8 * fq, pack8(acc[ai][bj][m][0] * ri, acc[ai][bj][m][1] * ri), nostore); }
        } else {
            const bool isq = pn < 6; const float* g = isq ? qg : kg; const float sc = isq ? QSCALE : 1.0f;
            bf16* O = isq ? q + ((pn - 4) * 4 + wc) * 64 : k + wc * 64; const int ldo = isq ? 512 : 128;
            f32x4 gv[2][2];
#pragma unroll
            for (int bj = 0; bj < 2; ++bj) { gv[bj][0] = *(const f32x4*)(g + bj * 32 + 8 * fq) * sc; gv[bj][1] = *(const f32x4*)(g + bj * 32 + 8 * fq + 4) * sc; }
#pragma unroll
            EPI_ROWS { const size_t row = (size_t)u.pm * 256 + ai * HALF + wr * 64 + m * 16 + fr; const int t = (int)(row % SEQ); const float ri = this->rinv[row];
                float ss = 0.f;
#pragma unroll
                for (int bj = 0; bj < 2; ++bj)
#pragma unroll
                    for (int n = 0; n < 2; ++n) { const f32x4 x = acc[ai][bj][m][n]; ss += (x[0] * x[0] + x[1] * x[1]) + (x[2] * x[2] + x[3] * x[3]); }
                ss = add_x32(add_x16(ss));
                const float rinv = ri * __builtin_amdgcn_rsqf(ss * (ri * ri) * (1.0f / 64.0f) + EPS);
#pragma unroll
                for (int bj = 0; bj < 2; ++bj) { const f32x4 c = *(const f32x4*)(cosT + t * 32 + bj * 16 + 4 * fq), sn = *(const f32x4*)(sinT + t * 32 + bj * 16 + 4 * fq);
                    const f32x4 x0 = acc[ai][bj][m][0] * gv[bj][0] * rinv, x1 = acc[ai][bj][m][1] * gv[bj][1] * rinv; f32x4 o0, o1;
                    o0[0] = x0[0] * c[0] - x0[1] * sn[0]; o0[1] = x0[0] * sn[0] + x0[1] * c[0]; o0[2] = x0[2] * c[1] - x0[3] * sn[1]; o0[3] = x0[2] * sn[1] + x0[3] * c[1];
                    o1[0] = x1[0] * c[2] - x1[1] * sn[2]; o1[1] = x1[0] * sn[2] + x1[1] * c[2]; o1[2] = x1[2] * c[3] - x1[3] * sn[3]; o1[3] = x1[2] * sn[3] + x1[3] * c[3];
                    st16(O + row * ldo + bj * 32 + 8 * fq, pack8(o0, o1), nostore); }
                if (m & 1) asm volatile("" ::: "memory"); }
        }
    }
};
}


struct CvtJob { const float* W; const float* gain; bf16* WT; int K, N, dst_row0, k0, n0; bool f8; };
__device__ __forceinline__ CvtJob cvt_decode(const Frame& F, int it) {
    constexpr int I_IN = 16 * 56, I_SQ = 512, I_KV = 1024, I_HEAD = I_IN + I_SQ + I_KV + I_SQ, I_LAYER = I_HEAD + NE * 3 * I_SQ;
    CvtJob j; j.f8 = false; const int l = it / I_LAYER; int r = it % I_LAYER;
    if (r < I_IN) { const int kb = r / 56, nb = r % 56, n0 = nb * 32, pn = n0 >> 8; int dr = n0;
        if (pn >= 4) { const int sidx = n0 & 255, w = sidx >> 6, bj = (sidx >> 5) & 1; dr = pn * 256 + 128 * bj + 32 * w; }
        j.W = F.in[3] + (size_t)l * D * INW; j.gain = F.in[2] + (size_t)l * D; j.WT = (bf16*)(F.ws + WS_WIN) + (size_t)l * INW * D; j.K = D; j.N = INW; j.dst_row0 = dr; j.k0 = kb * 64; j.n0 = n0; return j; }
    r -= I_IN;
    if (r < I_SQ) { j.W = F.in[10] + (size_t)l * D * D; j.gain = F.in[9] + (size_t)l * D; j.WT = (bf16*)(F.ws + WS_WOUT) + (size_t)l * D * D; j.K = D; j.N = D; j.dst_row0 = (r % 32) * 32; j.k0 = (r / 32) * 64; j.n0 = (r % 32) * 32; return j; }
    r -= I_SQ;
    if (r < I_KV) { j.W = F.in[14] + (size_t)l * D * 2 * D; j.gain = nullptr; j.WT = (bf16*)(F.ws + WS_WKVT) + (size_t)l * 2 * D * D; j.K = D; j.N = 2 * D; j.dst_row0 = (r % 64) * 32; j.k0 = (r / 64) * 64; j.n0 = (r % 64) * 32; return j; }
    r -= I_KV;
    if (r < I_SQ) { j.W = F.in[15] + (size_t)l * D * D; j.gain = nullptr; j.WT = (bf16*)(F.ws + WS_WOT) + (size_t)l * D * D; j.K = D; j.N = D; j.dst_row0 = (r % 32) * 32; j.k0 = (r / 32) * 64; j.n0 = (r % 32) * 32; return j; }
    r -= I_SQ;
    const int e = r / (3 * I_SQ), rr = r % (3 * I_SQ), which = rr / I_SQ, sub = rr % I_SQ, kb = sub / 32, n0 = (sub % 32) * 32;
    const size_t mo = ((size_t)l * NE + e) * D * FF;
    j.K = D; j.N = FF; j.k0 = kb * 64; j.n0 = n0;
    j.f8 = true;
    if (which == 2) { j.W = F.in[20] + mo; j.gain = nullptr; j.WT = (bf16*)(F.ws + WS_WD + mo); j.dst_row0 = n0; }
    else { j.W = (which == 0 ? F.in[18] : F.in[19]) + mo; j.gain = F.in[16] + (size_t)l * D; j.WT = (bf16*)(F.ws + WS_WGU + 2 * mo); j.dst_row0 = 256 * (n0 >> 7) + 128 * which + (n0 & 127); }
    return j;
}
#define CVT_LOAD(J, R) do { const float* p_ = (J).W + (size_t)((J).k0 + (lane_ >> 5)) * (J).N + (J).n0 + (lane_ & 31); _Pragma("unroll") for (int i_ = 0; i_ < 32; ++i_) R[i_] = __builtin_nontemporal_load(p_ + (size_t)(2 * i_) * (J).N); } while (0)
#ifndef CVT_DEFER_E
#define CVT_DEFER_E 8
#endif
#ifndef CVT_DEFER_A
#define CVT_DEFER_A 3
#endif
constexpr int CVT_I_LAYER = 16 * 56 + 512 + 1024 + 512 + NE * 3 * 512, CVT_ND = CVT_DEFER_E * 3 * 512, CVT_NDA = CVT_DEFER_A * 3 * 512;
constexpr int CVT_N1 = CVT_I_LAYER - CVT_ND, CVT_N2 = CVT_I_LAYER - CVT_ND - CVT_NDA;
constexpr int CVT_NPRO = CVT_I_LAYER + (NL > 1 ? CVT_N1 : 0) + (NL > 2 ? (NL - 2) * CVT_N2 : 0);
__device__ __forceinline__ int cvt_map(int L, int part, int i) {
    if (L >= 1) return L * CVT_I_LAYER + (part ? CVT_N1 : CVT_N2) + i;
    if (i < CVT_I_LAYER) return i;
    int j = i - CVT_I_LAYER; if (j < CVT_N1) return CVT_I_LAYER + j;
    j -= CVT_N1; const int l = 2 + j / CVT_N2, r = j % CVT_N2; return l * CVT_I_LAYER + r;
}
__device__ __forceinline__ void cvt_items(Frame& F, const int L, const int part, const int gw, const int NGW) {
    int lane_ = lane_id(); asm volatile("" : "+v"(lane_));
    LAS float* scr = (LAS float*)(F.lds + F.wave * 16384);
    const int NITEMS = L >= 1 ? (part ? CVT_ND : CVT_NDA) : CVT_NPRO;
    if (gw < NITEMS) {
        int it = gw; CvtJob cur = cvt_decode(F, cvt_map(L, part, it)); float r[32]; CVT_LOAD(cur, r);
        for (;;) {
            const int nit = it + NGW; const bool hn = nit < NITEMS; CvtJob nx = cur; if (hn) nx = cvt_decode(F, cvt_map(L, part, nit));
#pragma unroll
            for (int i = 0; i < 32; ++i) scr[(2 * i + (lane_ >> 5)) * 33 + (lane_ & 31)] = r[i];
            if (hn) CVT_LOAD(nx, r);
            asm volatile("s_waitcnt lgkmcnt(0)" ::: "memory");
            const int c = lane_ & 7;
            f32x4 g0 = (f32x4){1.f, 1.f, 1.f, 1.f}, g1 = g0;
            if (cur.gain) { g0 = *(const f32x4*)(cur.gain + cur.k0 + 8 * c); g1 = *(const f32x4*)(cur.gain + cur.k0 + 8 * c + 4); }
#pragma unroll
            for (int j = 0; j < 4; ++j) { const int n = (lane_ >> 3) + 8 * j; const LAS float* sp = scr + (8 * c) * 33 + n;
                if (cur.f8) { v2u o; o.x = pk4_fp8(sp[0 * 33] * g0[0] * W8S, sp[1 * 33] * g0[1] * W8S, sp[2 * 33] * g0[2] * W8S, sp[3 * 33] * g0[3] * W8S); o.y = pk4_fp8(sp[4 * 33] * g1[0] * W8S, sp[5 * 33] * g1[1] * W8S, sp[6 * 33] * g1[2] * W8S, sp[7 * 33] * g1[3] * W8S);
                    *(v2u*)((unsigned char*)cur.WT + (size_t)(cur.dst_row0 + n) * cur.K + cur.k0 + 8 * c) = o; }
                else { v4u o; o.x = pk2(sp[0 * 33] * g0[0], sp[1 * 33] * g0[1]); o.y = pk2(sp[2 * 33] * g0[2], sp[3 * 33] * g0[3]); o.z = pk2(sp[4 * 33] * g1[0], sp[5 * 33] * g1[1]); o.w = pk2(sp[6 * 33] * g1[2], sp[7 * 33] * g1[3]);
                    *(v4u*)(cur.WT + (size_t)(cur.dst_row0 + n) * cur.K + cur.k0 + 8 * c) = o; } }
            asm volatile("s_waitcnt lgkmcnt(0)" ::: "memory");
            if (!hn) break; cur = nx; it = nit;
        }
    }
}
__device__ __forceinline__ void ph_convert(Frame& F) {
    int lane_ = lane_id(); asm volatile("" : "+v"(lane_)); const int tid_ = F.wave * 64 + lane_;
    cvt_items(F, -1, 0, F.vcu * NWAVES + F.wave, F.G * NWAVES);
    {   const float* wsrc = F.in[5]; bf16* WSBd = (bf16*)(F.ws + WS_WSB);
        for (int i = F.vcu * NTHR + tid_; i < NL * 4 * 128 * 128 / 8; i += F.G * NTHR) { const f32x4 a = *(const f32x4*)(wsrc + (size_t)i * 8), b = *(const f32x4*)(wsrc + (size_t)i * 8 + 4);
            v4u o; o.x = pk2(a.x, a.y); o.y = pk2(a.z, a.w); o.z = pk2(b.x, b.y); o.w = pk2(b.z, b.w); *(v4u*)(WSBd + (size_t)i * 8) = o; } }
    {   bf16* WRH = (bf16*)(F.ws + WS_WRH); bf16* WRL = (bf16*)(F.ws + WS_WRL);
        for (int i = F.vcu * NTHR + tid_; i < NL * NE * D; i += F.G * NTHR) { const int l = i / (NE * D), e = (i / D) % NE, c = i % D;
            const float w = F.in[17][((size_t)l * D + c) * NE + e] * F.in[16][(size_t)l * D + c]; const unsigned h = f2bf(w); WRH[i] = (bf16)h; WRL[i] = (bf16)f2bf(w - bf2f(h)); } }
    const int gt = F.vcu * NTHR + tid_, NGT = F.G * NTHR;
    const float* wq = F.in[13]; bf16* WQB = (bf16*)(F.ws + WS_WQB);
    for (int i = gt; i < NL * D * D / 8; i += NGT) { const f32x4 a = *(const f32x4*)(wq + (size_t)i * 8), b = *(const f32x4*)(wq + (size_t)i * 8 + 4);
        v4u o; o.x = pk2(a.x, a.y); o.y = pk2(a.z, a.w); o.z = pk2(b.x, b.y); o.w = pk2(b.z, b.w); *(v4u*)(WQB + (size_t)i * 8) = o; }
}

struct SchedDense {
    pg8::TileOrder o; const char* A; size_t a_tile; const char* B; size_t b_tile, b_batch; int bdiv, bmod;
    __device__ __forceinline__ bool next(int i, pg8::Unit& u) const { if (!o.tile(i, u.pm, u.pn)) return false;
        u.z = 0; u.gi = nullptr; u.grow = 0; u.a = A + (size_t)u.pm * a_tile; u.b = B + (size_t)((u.pm / bdiv) % bmod) * b_batch + (size_t)u.pn * b_tile; return true; }
};
struct SchedE1 {
    pg8::TileOrder o; const char* HBp; const int* IDX; const char* WGU;
    __device__ __forceinline__ bool next(int i, pg8::Unit& u) const { if (!o.tile(i, u.pm, u.pn)) return false;
        const int z = u.pm >> 2; u.z = z; u.gi = IDX + (size_t)u.pm * 256; u.grow = (z >> 4) * SEQ; u.a = HBp;
        u.b = WGU + (size_t)(z & 15) * (2 * FF * D) + (size_t)u.pn * (256 * D); return true; }
};
struct SchedKV { pg8::TileOrder o; const char* MEMN; const char* WKVT; int pm0 = 0;
    __device__ __forceinline__ bool next(int i, pg8::Unit& u) const { if (!o.tile(i, u.pm, u.pn)) return false; u.pm += pm0; u.z = 0; u.gi = nullptr; u.grow = 0;
        u.a = MEMN + (size_t)(u.pm & 3) * (256 * D * 2); u.b = WKVT + (size_t)(u.pm >> 2) * (2 * D * D * 2) + (size_t)u.pn * (256 * D * 2); return true; } };
struct SchedQK { pg8::TileOrder o; const char* KVM; const char* WQB; int pm0 = 0;
    __device__ __forceinline__ bool next(int i, pg8::Unit& u) const { if (!o.tile(i, u.pm, u.pn)) return false; u.pm += pm0; u.z = 0; u.gi = nullptr; u.grow = 0;
        const int h = u.pm & 3, lb = u.pm >> 2, b = lb & 3, l = lb >> 2;
        u.a = KVM + ((size_t)l * NMEM * 2 * D + (size_t)(b * 256) * 2 * D + h * 256) * 2; u.b = WQB + ((size_t)l * D * D + (size_t)u.pn * 256 * D + h * 256) * 2; return true; } };
struct SchedVO { pg8::TileOrder o; const char* KVM; const char* WOT; int pm0 = 0;
    __device__ __forceinline__ bool next(int i, pg8::Unit& u) const { if (!o.tile(i, u.pm, u.pn)) return false; u.pm += pm0; u.z = 0; u.gi = nullptr; u.grow = 0;
        const int pml = u.pm & 3, lbh = u.pm >> 2, h = lbh & 3, lb = lbh >> 2, b = lb & 3, l = lb >> 2;
        u.a = WOT + ((size_t)l * D * D + (size_t)pml * 256 * D + h * 256) * 2; u.b = KVM + ((size_t)l * NMEM * 2 * D + (size_t)(b * 256) * 2 * D + D + h * 256) * 2; return true; } };

namespace attn_body {
#if REPK == 300 || REPK == 301 || REPK == 302
#ifndef PROBE_WAVE
#define PROBE_WAVE 0
#endif
#define ATS_PROBE ((blockIdx.x == 0) ? (unsigned*)((char*)ATS - WS_ATSTAT + WS_CTL + 64) : (unsigned*)nullptr)
#endif
using bf16=__hip_bfloat16;
using bf16x8=__attribute__((ext_vector_type(8)))short;
using s16x4=__attribute__((ext_vector_type(4)))short;
using f32x16=__attribute__((ext_vector_type(16)))float;
using u32x4=__attribute__((ext_vector_type(4)))unsigned;
constexpr int SEQ=8192,D=64,QP=512,KP=128,OP=1024;
constexpr int NW=8,QBLK=32,QB=QBLK*NW,KVBLK=64,NQB=SEQ/QB;
constexpr int ATTN_UNIT_ROWS=QB;
__device__ __forceinline__ int crow(int r,int hi){return (r&3)+8*(r>>2)+4*hi;}
#define SBAR() __builtin_amdgcn_sched_barrier(0)
__device__ __forceinline__ void cmask(f32x16&p0,f32x16&p1,int jb,int qrel,int hi){
  const float NEG=-INFINITY; int kb=64*jb+4*hi;
  #pragma unroll
  for(int r=0;r<16;++r){int kv=kb+(r&3)+8*(r>>2); if(kv>qrel)p0[r]=NEG; if(kv+32>qrel)p1[r]=NEG;}
}

constexpr int NSLOT=3, SLOTB=8192;
constexpr int LDS_K=0, LDS_V=NSLOT*SLOTB, LDS_WS=2*NSLOT*SLOTB, LDS_OST=LDS_WS+NW*64*4, LDS_BYTES=LDS_OST+NW*4096;
constexpr float C2=0.125f*1.4426950408889634f;
__device__ __forceinline__ void glds16(const void*gsrc,unsigned lds_dst){unsigned keep;
  asm volatile("s_mov_b32 %0, m0\n\ts_mov_b32 m0, %2\n\ts_nop 0\n\tglobal_load_lds_dwordx4 %1, off\n\ts_mov_b32 m0, %0":"=&s"(keep):"v"(gsrc),"s"(lds_dst):"memory");}
__device__ __forceinline__ float max3f(float a,float b,float c){float r;asm("v_max3_f32 %0, %1, %2, %3":"=v"(r):"v"(a),"v"(b),"v"(c));return r;}
__device__ __forceinline__ float max2f(float a,float b){float r;asm("v_max_f32_e32 %0, %1, %2":"=v"(r):"v"(a),"v"(b));return r;}
__device__ __forceinline__ float fadd_s(float a,float b){float r;asm("v_add_f32_e32 %0, %1, %2":"=v"(r):"v"(a),"v"(b));return r;}
__device__ __forceinline__ float fsub_s(float a,float b){float r;asm("v_sub_f32_e32 %0, %1, %2":"=v"(r):"v"(a),"v"(b));return r;}
typedef float f32x2_t __attribute__((ext_vector_type(2))); typedef __bf16 bf16x2_t __attribute__((ext_vector_type(2)));
__device__ __forceinline__ unsigned cvtpk_s(float lo,float hi){f32x2_t v={lo,hi};bf16x2_t b=__builtin_convertvector(v,bf16x2_t);return __builtin_bit_cast(unsigned,b);}
#define WAIT_BAR(N) asm volatile("s_waitcnt vmcnt(" #N ") lgkmcnt(0)\n\ts_barrier":::"memory")

__device__ __forceinline__ void qkt(f32x16&p0,f32x16&p1,const char*Kslot,const bf16x8*qr,const f32x16&negm,int r32,int hi){
  const char*kb=Kslot+hi*1024+r32*16;
  #pragma unroll
  for(int d0=0;d0<4;++d0){
    const bf16x8 b0=*reinterpret_cast<const bf16x8*>(kb+d0*2048);
    const bf16x8 b1=*reinterpret_cast<const bf16x8*>(kb+d0*2048+512);
    if(d0==0){p0=__builtin_amdgcn_mfma_f32_32x32x16_bf16(b0,qr[0],negm,0,0,0);p1=__builtin_amdgcn_mfma_f32_32x32x16_bf16(b1,qr[0],negm,0,0,0);}
    else{p0=__builtin_amdgcn_mfma_f32_32x32x16_bf16(b0,qr[d0],p0,0,0,0);p1=__builtin_amdgcn_mfma_f32_32x32x16_bf16(b1,qr[d0],p1,0,0,0);}}
}
typedef __attribute__((address_space(3))) const char* lds_cptr;
typedef short v4i16_t __attribute__((ext_vector_type(4)));
__device__ __forceinline__ void kload8(bf16x8*kf,lds_cptr kp){
  kf[0]=*(const __attribute__((address_space(3))) bf16x8*)(kp);      kf[1]=*(const __attribute__((address_space(3))) bf16x8*)(kp+512);
  kf[2]=*(const __attribute__((address_space(3))) bf16x8*)(kp+2048); kf[3]=*(const __attribute__((address_space(3))) bf16x8*)(kp+2560);
  kf[4]=*(const __attribute__((address_space(3))) bf16x8*)(kp+4096); kf[5]=*(const __attribute__((address_space(3))) bf16x8*)(kp+4608);
  kf[6]=*(const __attribute__((address_space(3))) bf16x8*)(kp+6144); kf[7]=*(const __attribute__((address_space(3))) bf16x8*)(kp+6656);
}
__device__ __forceinline__ void kload2(bf16x8*kf,lds_cptr kp,int j){ kf[2*j]=*(const __attribute__((address_space(3))) bf16x8*)(kp+j*2048); kf[2*j+1]=*(const __attribute__((address_space(3))) bf16x8*)(kp+j*2048+512); }
__device__ __forceinline__ s16x4 vtr(lds_cptr p){ return __builtin_bit_cast(s16x4,__builtin_amdgcn_ds_read_tr16_b64_v4i16((__attribute__((address_space(3))) v4i16_t*)p)); }
__device__ __forceinline__ float rowmax(const f32x16&p0,const f32x16&p1){
  float a=max3f(p0[0],p0[1],p1[0]),b=max3f(p0[2],p0[3],p1[1]);a=max3f(a,p1[2],p1[3]);
  #pragma unroll
  for(int r=4;r<16;r+=4){a=max3f(a,p0[r],p0[r+1]);b=max3f(b,p0[r+2],p0[r+3]);a=max3f(a,p1[r],p1[r+1]);b=max3f(b,p1[r+2],p1[r+3]);}
  const float m=max2f(a,b);
  auto rr=__builtin_amdgcn_permlane32_swap(__float_as_uint(m),__float_as_uint(m),false,false);
  return max2f(__uint_as_float(rr[0]),__uint_as_float(rr[1]));
}
__device__ __forceinline__ void pv(f32x16*o,int vb,bf16x8 pa0,bf16x8 pa1,bf16x8 pa2,bf16x8 pa3){
  #pragma unroll
  for(int d0=0;d0<2;++d0){s16x4 lo[4],hi[4];
    #pragma unroll
    for(int ks=0;ks<4;++ks){
      asm volatile("ds_read_b64_tr_b16 %0,%1 offset:%c2":"=&v"(lo[ks]):"v"(vb),"i"(d0*4096+ks*1024):"memory");
      asm volatile("ds_read_b64_tr_b16 %0,%1 offset:%c2":"=&v"(hi[ks]):"v"(vb),"i"(d0*4096+ks*1024+512):"memory");}
    asm volatile("s_waitcnt lgkmcnt(0)":::"memory");SBAR();
    #define PK(k) (bf16x8){lo[k][0],lo[k][1],lo[k][2],lo[k][3],hi[k][0],hi[k][1],hi[k][2],hi[k][3]}
    o[d0]=__builtin_amdgcn_mfma_f32_32x32x16_bf16(pa0,PK(0),o[d0],0,0,0);
    o[d0]=__builtin_amdgcn_mfma_f32_32x32x16_bf16(pa1,PK(1),o[d0],0,0,0);
    o[d0]=__builtin_amdgcn_mfma_f32_32x32x16_bf16(pa2,PK(2),o[d0],0,0,0);
    o[d0]=__builtin_amdgcn_mfma_f32_32x32x16_bf16(pa3,PK(3),o[d0],0,0,0);
    #undef PK
  }
}

#ifndef ATTN_STORE16
#define ATTN_STORE16(p,v) (*(u32x4*)(p)=(v))
#endif
template<int THRL,bool STATIC_REF,bool LSUM> __device__ __forceinline__ void attn_unit(int b,int h,int qb,const bf16*Q,const bf16*__restrict__ K,const bf16*__restrict__ V,bf16*O,float*ATS,char*shm,int wave_idx,float refB){
  int lane; asm volatile("v_mbcnt_lo_u32_b32 %0, -1, 0\n\tv_mbcnt_hi_u32_b32 %0, -1, %0":"=v"(lane)); const int r32=lane&31,hi=lane>>5; const int wid=wave_idx; const int kvh=h>>2;
  const long rowbase=(long)b*SEQ; const int q0=qb*QB;
  const bf16*Qw=Q+(rowbase+q0+wid*QBLK)*QP+h*D;
  const bf16*Kh=K+rowbase*KP+kvh*D,*Vh=V+rowbase*KP+kvh*D;
  const unsigned lds0=(unsigned)(uintptr_t)shm;
  float*wsf=(float*)(shm+LDS_WS)+wid*64;
  const bf16*ksrc=Kh+(long)lane*KP+wid*8;
  const bf16*vsrc=Vh+(long)(16*(wid&3)+(lane>>2))*KP+(wid>>2)*32+(lane&3)*8;
  const unsigned kdst=lds0+LDS_K+wid*1024, vdst=lds0+LDS_V+wid*1024;
  #define DMA_K(t,slot) glds16(ksrc+(long)(t)*KVBLK*KP,(unsigned)__builtin_amdgcn_readfirstlane(kdst+(slot)))
  #define DMA_V(t,slot) glds16(vsrc+(long)(t)*KVBLK*KP,(unsigned)__builtin_amdgcn_readfirstlane(vdst+(slot)))
  const int vb0=(int)(lds0+LDS_V)+((lane>>4)&1)*32+(lane&3)*8+(4*hi+((lane&15)>>2))*64;
  const char*Kbase=shm+LDS_K; bf16x8 kf[8];
  const lds_cptr shm3=(lds_cptr)shm; const lds_cptr kp0=shm3+LDS_K+hi*1024+r32*16; const lds_cptr vp0=shm3+LDS_V+((lane>>4)&1)*32+(lane&3)*8+(4*hi+((lane&15)>>2))*64;
  const int NT=SEQ/KVBLK;
  DMA_K(0,0);DMA_V(0,0);DMA_K(1,SLOTB);
  bf16x8 qr[4];
  #pragma unroll
  for(int d0=0;d0<4;++d0)qr[d0]=*reinterpret_cast<const bf16x8*>(&Qw[(long)r32*QP+d0*16+hi*8]);
  float mhat=0.f,l_reg=0.f;f32x16 o[2];o[0]=f32x16{};o[1]=f32x16{};f32x16 negm=f32x16{};
  if constexpr(STATIC_REF){ _Pragma("unroll") for(int r=0;r<16;++r)negm[r]=-refB; }
  asm volatile("":"+v"(negm));
  f32x16 lblk=f32x16{}; unsigned one2_; asm volatile("v_mov_b32 %0, 0x3f803f80":"=v"(one2_)); const bf16x8 ones8=__builtin_bit_cast(bf16x8,(u32x4){one2_,one2_,one2_,one2_});
  const int qrel=wid*QBLK+r32;
  #define CMASK(P0,P1,t) do{}while(0)
  bool resc=false;
  #define START(P0,P1) do{ if constexpr(!STATIC_REF){ const float rm=rowmax(P0,P1); resc=false; \
    { const float dl=rm; mhat=fadd_s(mhat,dl); \
      _Pragma("unroll") for(int r=0;r<16;++r){P0[r]=fsub_s(P0[r],dl);P1[r]=fsub_s(P1[r],dl);} \
      _Pragma("unroll") for(int r=0;r<16;++r)negm[r]=-mhat; asm volatile("":"+v"(negm)); } } \
    _Pragma("unroll") for(int r=0;r<16;++r)P0[r]=__builtin_amdgcn_exp2f(P0[r]); }while(0)
  #define RESC() do{ if constexpr(!STATIC_REF) if(resc){ asm volatile("s_waitcnt lgkmcnt(0)":::"memory"); \
      _Pragma("unroll") for(int d_=0;d_<2;++d_) _Pragma("unroll") for(int r=0;r<16;++r)o[d_][r]*=wsf[crow(r,hi)]; } }while(0)
  f32x16 pA0,pA1,pB0,pB1;
  int sl_prev=0,sl_cur=0,sl_next=SLOTB;
  #define ROT() do{sl_prev=sl_cur;sl_cur=sl_next;sl_next=(sl_next==(NSLOT-1)*SLOTB)?0:sl_next+SLOTB;}while(0)
  DMA_K(2,2*SLOTB);
  WAIT_BAR(3);
  qkt(pA0,pA1,Kbase,qr,negm,r32,hi);asm volatile("s_nop 15\n\ts_nop 7":"+v"(pA0),"+v"(pA1));CMASK(pA0,pA1,0);
  START(pA0,pA1);
  _Pragma("unroll") for(int r=0;r<16;++r)pA1[r]=__builtin_amdgcn_exp2f(pA1[r]);
  WAIT_BAR(0);
  DMA_K(3,0);DMA_V(1,SLOTB);
  ROT();
  kload8(kf,kp0+sl_cur);
  WAIT_BAR(2);
  asm volatile("":"+v"(kf[0]),"+v"(kf[1]),"+v"(kf[2]),"+v"(kf[3]),"+v"(kf[4]),"+v"(kf[5]),"+v"(kf[6]),"+v"(kf[7]));
  s16x4 vlo[8],vhi[8]; u32x4 pw0,pw1,pw2,pw3;
  #define PKW(P,B) cvtpk_s(P[B],P[B+1])
  #define PAF(k) __builtin_bit_cast(bf16x8,pw##k)
  #define VFR(i) (bf16x8){vlo[i][0],vlo[i][1],vlo[i][2],vlo[i][3],vhi[i][0],vhi[i][1],vhi[i][2],vhi[i][3]}
  #define PIN(x) asm volatile("":"+v"(x))
  #define MX3(a,b,c) __builtin_fmaxf(__builtin_fmaxf((a),(b)),(c))
  #define GAPA(MF,A0,A1,A2,A3,W0,W1,PW) do{ MF; if constexpr(!LSUM){ sacc+=A0; sacc+=A1; sacc+=A2; sacc+=A3; PIN(sacc); } W0; W1; PIN(PW); SBAR(); }while(0)
  #define GAPA2(MF,A0,A1,W0,W1,PW) do{ MF; if constexpr(!LSUM){ sacc+=A0; sacc+=A1; PIN(sacc); } W0; W1; PIN(PW); SBAR(); }while(0)
  #define LSM(k) do{ if constexpr(LSUM){ lblk=__builtin_amdgcn_mfma_f32_32x32x16_bf16(PAF(k),ones8,lblk,0,0,0); SBAR(); } }while(0)
  #define EX(v) __builtin_amdgcn_exp2f(v)
  #define GAPB(MF,X,B) do{ MF; X[B]=EX(X[B]); X[B+1]=EX(X[B+1]); X[B+2]=EX(X[B+2]); X[B+3]=EX(X[B+3]); PIN(X); SBAR(); }while(0)
  #define VRD(i) do{ vlo[i]=vtr(vp_+(((i)>>2)*4096+((i)&3)*1024)); vhi[i]=vtr(vp_+(((i)>>2)*4096+((i)&3)*1024+512)); }while(0)
  #define KRD(G,j) do{ if(G){ kload2(kf,kp0+sl_next,j); SBAR(); } }while(0)
  #define PINKF() asm volatile("":"+v"(kf[0]),"+v"(kf[1]),"+v"(kf[2]),"+v"(kf[3]),"+v"(kf[4]),"+v"(kf[5]),"+v"(kf[6]),"+v"(kf[7]))
  #define STEP(C0,C1,P0,P1,t,GK,GV,GL) do{ SBAR(); \
    const lds_cptr vp_=vp0+sl_prev; \
    VRD(0); SBAR(); float sacc=0.f; if constexpr(!LSUM) sacc=(P0[0]+P0[1]); \
    GAPA(C0=__builtin_amdgcn_mfma_f32_32x32x16_bf16(kf[0],qr[0],negm,0,0,0), P0[2],P0[3],P0[4],P0[5],     pw0[0]=PKW(P0,0), pw0[1]=PKW(P0,2), pw0); \
    VRD(4); SBAR(); GAPA(C1=__builtin_amdgcn_mfma_f32_32x32x16_bf16(kf[1],qr[0],negm,0,0,0), P0[6],P0[7],P0[8],P0[9],     pw0[2]=PKW(P0,4), pw0[3]=PKW(P0,6), pw0); \
    VRD(1); SBAR(); GAPA(C0=__builtin_amdgcn_mfma_f32_32x32x16_bf16(kf[2],qr[1],C0,0,0,0),   P0[10],P0[11],P0[12],P0[13], pw1[0]=PKW(P0,8), pw1[1]=PKW(P0,10), pw1); \
    VRD(5); SBAR(); GAPA(C1=__builtin_amdgcn_mfma_f32_32x32x16_bf16(kf[3],qr[1],C1,0,0,0),   P0[14],P0[15],P1[0],P1[1],   pw1[2]=PKW(P0,12),pw1[3]=PKW(P0,14), pw1); \
    VRD(2); SBAR(); GAPA(C0=__builtin_amdgcn_mfma_f32_32x32x16_bf16(kf[4],qr[2],C0,0,0,0),   P1[2],P1[3],P1[4],P1[5],     pw2[0]=PKW(P1,0), pw2[1]=PKW(P1,2), pw2); \
    VRD(6); SBAR(); GAPA(C1=__builtin_amdgcn_mfma_f32_32x32x16_bf16(kf[5],qr[2],C1,0,0,0),   P1[6],P1[7],P1[8],P1[9],     pw2[2]=PKW(P1,4), pw2[3]=PKW(P1,6), pw2); \
    VRD(3); SBAR(); GAPA(C0=__builtin_amdgcn_mfma_f32_32x32x16_bf16(kf[6],qr[3],C0,0,0,0),   P1[10],P1[11],P1[12],P1[13], pw3[0]=PKW(P1,8), pw3[1]=PKW(P1,10), pw3); \
    VRD(7); SBAR(); GAPA2(C1=__builtin_amdgcn_mfma_f32_32x32x16_bf16(kf[7],qr[3],C1,0,0,0),  P1[14],P1[15],               pw3[2]=PKW(P1,12),pw3[3]=PKW(P1,14), pw3); \
    l_reg+=sacc; \
    if(GK){DMA_K((t)+3,sl_cur);} if(GV){DMA_V((t)+1,sl_next);} \
    CMASK(C0,C1,t); \
    if constexpr(!STATIC_REF){ float a=MX3(C0[0],C0[1],C1[0]),b=MX3(C0[2],C0[3],C1[1]); a=MX3(a,C1[2],C1[3]); \
      _Pragma("unroll") for(int r=4;r<16;r+=4){a=MX3(a,C0[r],C0[r+1]);b=MX3(b,C0[r+2],C0[r+3]);a=MX3(a,C1[r],C1[r+1]);b=MX3(b,C1[r+2],C1[r+3]);} \
      float rm=__builtin_fmaxf(a,b); { auto rr=__builtin_amdgcn_permlane32_swap(__float_as_uint(rm),__float_as_uint(rm),false,false); rm=__builtin_fmaxf(__uint_as_float(rr[0]),__uint_as_float(rr[1])); } \
      resc=false; \
      if(__builtin_expect(__any(rm>(float)THRL),0)){ const float dl=__builtin_fmaxf(rm,0.f); mhat+=dl; \
        _Pragma("unroll") for(int r=0;r<16;++r){C0[r]-=dl;C1[r]-=dl;} \
        _Pragma("unroll") for(int r=0;r<16;++r)negm[r]=-mhat; asm volatile("":"+v"(negm)); \
        const float f=__builtin_amdgcn_exp2f(-dl); l_reg*=f; if(hi==0)wsf[r32]=f; resc=true; } } \
    SBAR(); \
    GAPB(o[0]=__builtin_amdgcn_mfma_f32_32x32x16_bf16(PAF(0),VFR(0),o[0],0,0,0), C0,0); \
    GAPB(o[1]=__builtin_amdgcn_mfma_f32_32x32x16_bf16(PAF(0),VFR(4),o[1],0,0,0), C0,4); \
    LSM(0); KRD(GL,0); GAPB(o[0]=__builtin_amdgcn_mfma_f32_32x32x16_bf16(PAF(1),VFR(1),o[0],0,0,0), C0,8); \
    KRD(GL,1); GAPB(o[1]=__builtin_amdgcn_mfma_f32_32x32x16_bf16(PAF(1),VFR(5),o[1],0,0,0), C0,12); \
    LSM(1); KRD(GL,2); GAPB(o[0]=__builtin_amdgcn_mfma_f32_32x32x16_bf16(PAF(2),VFR(2),o[0],0,0,0), C1,0); \
    KRD(GL,3); GAPB(o[1]=__builtin_amdgcn_mfma_f32_32x32x16_bf16(PAF(2),VFR(6),o[1],0,0,0), C1,4); \
    LSM(2); GAPB(o[0]=__builtin_amdgcn_mfma_f32_32x32x16_bf16(PAF(3),VFR(3),o[0],0,0,0), C1,8); \
    GAPB(o[1]=__builtin_amdgcn_mfma_f32_32x32x16_bf16(PAF(3),VFR(7),o[1],0,0,0), C1,12); LSM(3); \
    }while(0)
  int t=1;
#if REPK == 302
  unsigned long long tc0_, tr0_; asm volatile("s_memtime %0\n\ts_memrealtime %1\n\ts_waitcnt lgkmcnt(0)":"=s"(tc0_),"=s"(tr0_)::"memory");
#endif
#if REPK == 300 || REPK == 301
  unsigned tw_acc=0u; unsigned long long tu0; asm volatile("s_memtime %0\n\ts_waitcnt lgkmcnt(0)":"=s"(tu0)::"memory");
  #if REPK == 300
  #define WAIT_BAR_T() do{ unsigned long long a_,b_; asm volatile("s_waitcnt vmcnt(2) lgkmcnt(0)\n\ts_memtime %0\n\ts_barrier\n\ts_memtime %1\n\ts_waitcnt lgkmcnt(0)":"=s"(a_),"=s"(b_)::"memory"); tw_acc+=(unsigned)(b_-a_); }while(0)
  #else
  #define WAIT_BAR_T() do{ unsigned long long a_,b_; asm volatile("s_memtime %0\n\ts_waitcnt vmcnt(2) lgkmcnt(0)\n\ts_memtime %1\n\ts_barrier\n\ts_waitcnt lgkmcnt(0)":"=s"(a_),"=s"(b_)::"memory"); tw_acc+=(unsigned)(b_-a_); }while(0)
  #endif
#else
  #define WAIT_BAR_T() WAIT_BAR(2)
#endif
  for(;t+5<NT;t+=2){
    STEP(pB0,pB1,pA0,pA1,t,true,true,true);     WAIT_BAR_T(); PINKF(); RESC(); ROT();
    STEP(pA0,pA1,pB0,pB1,t+1,true,true,true);   WAIT_BAR_T(); PINKF(); RESC(); ROT();
  }
#if REPK == 302
  { unsigned long long tc1_, tr1_; asm volatile("s_memtime %0\n\ts_memrealtime %1\n\ts_waitcnt lgkmcnt(0)":"=s"(tc1_),"=s"(tr1_)::"memory");
    if(ATS_PROBE&&wave_idx==0&&lane==0){ atomicAdd(ATS_PROBE,(unsigned)(tc1_-tc0_)); atomicAdd(ATS_PROBE+1,(unsigned)(tr1_-tr0_)*30u); } }
#endif
#if REPK == 300 || REPK == 301
  { unsigned long long tu1; asm volatile("s_memtime %0\n\ts_waitcnt lgkmcnt(0)":"=s"(tu1)::"memory");
    if(ATS_PROBE&&wave_idx==PROBE_WAVE&&lane==0){ atomicAdd(ATS_PROBE,tw_acc); atomicAdd(ATS_PROBE+1,(unsigned)(tu1-tu0)); } }
#endif
  #undef WAIT_BAR_T
  #define ENDW(tt) do{ if((tt)+3<NT){WAIT_BAR(2);} else if((tt)+2<NT){WAIT_BAR(1);} else {WAIT_BAR(0);} }while(0)
  for(;t+1<NT;t+=2){
    STEP(pB0,pB1,pA0,pA1,t,(t+3<NT),(t+1<NT),(t+1<NT));       ENDW(t);   RESC(); ROT();
    STEP(pA0,pA1,pB0,pB1,t+1,(t+4<NT),(t+2<NT),(t+2<NT));     ENDW(t+1); RESC(); ROT();
  }
  STEP(pB0,pB1,pA0,pA1,NT-1,false,false,false); RESC();
  { if constexpr(!LSUM){ float sacc=pB0[0]+pB0[1]; _Pragma("unroll") for(int r=2;r<16;++r)sacc+=pB0[r]; _Pragma("unroll") for(int r=0;r<16;++r)sacc+=pB1[r]; l_reg+=sacc; }
    pw0=(u32x4){PKW(pB0,0),PKW(pB0,2),PKW(pB0,4),PKW(pB0,6)};pw1=(u32x4){PKW(pB0,8),PKW(pB0,10),PKW(pB0,12),PKW(pB0,14)};pw2=(u32x4){PKW(pB1,0),PKW(pB1,2),PKW(pB1,4),PKW(pB1,6)};pw3=(u32x4){PKW(pB1,8),PKW(pB1,10),PKW(pB1,12),PKW(pB1,14)};
    SBAR(); pv(o,vb0+sl_cur,PAF(0),PAF(1),PAF(2),PAF(3)); LSM(0); LSM(1); LSM(2); LSM(3); }
  #undef PKW
  #undef PAF
  #undef VFR
  #undef PIN
  #undef MX3
  #undef GAPA
  #undef GAPA2
  #undef LSM
  #undef GAPB
  #undef EX
  #undef VRD
  #undef KRD
  #undef PINKF
  #undef STEP
  #undef ENDW
  float rli[16];
  if constexpr(LSUM){ asm volatile("s_nop 15\n\ts_nop 7":"+v"(lblk));
    #pragma unroll
    for(int r=0;r<16;++r)rli[r]=__builtin_amdgcn_rcpf(lblk[r]); }
  else{
  {auto rr=__builtin_amdgcn_permlane32_swap(__float_as_uint(l_reg),__float_as_uint(l_reg),false,false);l_reg=__uint_as_float(rr[0])+__uint_as_float(rr[1]);}
  if(hi==0)wsf[32+r32]=l_reg;asm volatile("s_waitcnt lgkmcnt(0)":::"memory");
  #pragma unroll
  for(int r=0;r<16;++r)rli[r]=__builtin_amdgcn_rcpf(wsf[32+crow(r,hi)]); }
  bf16*Ow=O+(rowbase+q0+wid*QBLK)*OP+512+h*D; float*ATw=ATS+(rowbase+q0+wid*QBLK)*8+h;
  { bf16*stg=(bf16*)(shm+LDS_OST)+wid*2048;
    #pragma unroll
    for(int r=0;r<16;++r){const int orow=crow(r,hi);
      #pragma unroll
      for(int d0=0;d0<2;++d0)stg[orow*64+d0*32+r32]=__float2bfloat16(o[d0][r]*rli[r]);}
    asm volatile("s_waitcnt lgkmcnt(0)":::"memory");
    #pragma unroll
    for(int i=0;i<4;++i){const int row=i*8+(lane>>3),ch=lane&7; const u32x4 v=*(const u32x4*)(stg+row*64+ch*8); ATTN_STORE16(Ow+(long)row*OP+ch*8,v);
      float ss=0.f;
      #pragma unroll
      for(int q=0;q<4;++q){const float lo=__uint_as_float(v[q]<<16),hh=__uint_as_float(v[q]&0xffff0000u);ss+=lo*lo+hh*hh;}
      ss=sum_row8(ss); if(ch==0)ATw[(long)row*8]=ss;} }
  asm volatile("s_waitcnt lgkmcnt(0)\n\ts_barrier":::"memory");
  #undef DMA_K
  #undef DMA_V
  #undef CMASK
  #undef START
  #undef RESC
  #undef ROT
}
constexpr int ATTN_LDS_BYTES=LDS_BYTES;
#undef SBAR
#undef WAIT_BAR
}

__global__ void __launch_bounds__(NTHR, 2) mega(Args args) {
    extern __shared__ __attribute__((aligned(16))) unsigned char lds[];
    Frame F;
    F.lds = (LAS unsigned char*)lds;
    F.wave = __builtin_amdgcn_readfirstlane(threadIdx.x >> 6);
    F.G = gridDim.x; { const int bx = blockIdx.x; F.vcu = (F.G % 8 == 0) ? (bx % 8) * (F.G / 8) + bx / 8 : bx; }
#pragma unroll
    for (int i = 0; i < 22; ++i) F.in[i] = args.in[i];
    F.ws = args.ws; F.xres = args.out;
    volatile LAS unsigned* MISC = (volatile LAS unsigned*)(F.lds + MISC_OFF);
    for (int u = threadIdx.x; u < (LDS_BYTES - LDSCTL_OFF) / 4; u += NTHR) ((LAS unsigned*)(F.lds + LDSCTL_OFF))[u] = 0u;
    __syncthreads();
    const int lo = args.ph_lo, hi = args.ph_hi;
    unsigned* barw = (unsigned*)(F.ws + WS_CTL) + CW_BAR + args.bar_region * XCD_BAR_WORDS;
    XcdBarrier bar; bar.bar = barw; bar.x = 0; bar.st = nullptr;
    if (hi - lo > 1) bar = xcd_barrier_post(barw, MISC + 8);
#ifndef ONLY_K
#define ONLY_K -1
#endif
#define EN(kind) (ONLY_K < 0 || ONLY_K == (kind))
#ifndef ALIGN_A
#define ALIGN_A true
#endif
#ifndef ATTN_LSUM
#define ATTN_LSUM false
#endif
#ifndef ALIGN_IN
#define ALIGN_IN true
#endif
#ifndef ALIGN_E1
#define ALIGN_E1 true
#endif
#define IN(k) (lo <= (k) && (k) < hi)

#define PROBE_TOP(k) for (int rep_ = 0; rep_ < (REPK == (k) ? 2 : 1); ++rep_) {
#define PROBE_END(k) if (REPK == (k) && rep_ == 0) xcd_barrier(bar); }
#if REPK == 310
#ifndef PROBE_SEAM
#define PROBE_SEAM -1
#endif
#define SEAM_SEL(k) (PROBE_SEAM < 0 || (PROBE_SEAM == 10 ? (k) < PH_LAYER0 : ((k) >= PH_LAYER0 && ((k) - PH_LAYER0) % PH_PER_LAYER == PROBE_SEAM)))
    if (threadIdx.x == 0) { MISC[12] = 0u; MISC[13] = (unsigned)__builtin_amdgcn_s_memrealtime(); }
#define SEAM(k) do { if (IN(k) && IN((k) + 1)) { unsigned t0_ = 0u; \
        if (threadIdx.x == 0) { t0_ = (unsigned)__builtin_amdgcn_s_memrealtime(); \
            if ((k) == PH_END - 2) { unsigned* pc_ = (unsigned*)(F.ws + WS_CTL + 64); atomicAdd(pc_, MISC[12]); if (blockIdx.x == 0) atomicAdd(pc_ + 1, (t0_ - MISC[13]) * gridDim.x); } } \
        xcd_barrier(bar); \
        if (threadIdx.x == 0 && SEAM_SEL(k)) MISC[12] += (unsigned)__builtin_amdgcn_s_memrealtime() - t0_; } } while (0)
#define SEAMG(k) SEAM(k)
#else
#define SEAM(k) do { if (IN(k) && IN((k) + 1)) { xcd_barrier(bar); if (REPK == 200) xcd_barrier(bar); } } while (0)
#ifndef GROUP_SEAMS
#define GROUP_SEAMS 1
#endif
    const bool grp_ok = GROUP_SEAMS && F.G == 256 && (hi - lo > 1);
#define SEAMG(k) do { if (IN(k) && IN((k) + 1)) { if (grp_ok) group_barrier((unsigned*)(F.ws + WS_CTL), barw, MISC + 14); else xcd_barrier(bar); } } while (0)
#endif
    const int cid0 = (int)blockIdx.x; const int cid = cid0;
    if (EN(100) && IN(0)) { asm volatile("; PHASE_MARK P0"); PROBE_TOP(100) ph_rows0(F); PROBE_END(100) }
    if (EN(101) && IN(1)) { asm volatile("; PHASE_MARK P1"); PROBE_TOP(101) ph_convert(F); PROBE_END(101) } SEAM(1);

#define RUN_KV(GG, CC) do { SchedKV S_; S_.o.init(NL * 4, 8, (GG), (CC)); S_.MEMN = (const char*)(F.ws + WS_MEMN); S_.WKVT = (const char*)(F.ws + WS_WKVT); \
        pg8::EpiStore<3> E_{(bf16*)(F.ws + WS_KVM), 2 * D, nullptr, 1.0f}; pg8::gemm_phase<pg8::EpiStore<3>, SchedKV, true, false>(F.lds, F.wave, D, D, D, S_, E_); } while (0)
#define RUN_QK(LL, GG, CC) do { SchedQK S_; S_.o.init(16, 4, (GG), (CC)); S_.pm0 = (LL) * 16; S_.KVM = (const char*)(F.ws + WS_KVM); S_.WQB = (const char*)(F.ws + WS_WQB); \
        pg8::EpiStore<1, true> E_{(bf16*)(F.ws + WS_QKT), D, F.in[11], XQSCALE * Q8S}; int la_ = 2 * D, lb_ = D, kk_ = 256; asm volatile("" : "+s"(la_), "+s"(lb_), "+s"(kk_)); \
        pg8::gemm_phase<pg8::EpiStore<1, true>, SchedQK, true, false>(F.lds, F.wave, la_, lb_, kk_, S_, E_); } while (0)
#define RUN_VO(LL, GG, CC) do { SchedVO S_; S_.o.init(64, 1, (GG), (CC)); S_.pm0 = (LL) * 64; S_.KVM = (const char*)(F.ws + WS_KVM); S_.WOT = (const char*)(F.ws + WS_WOT); \
        pg8::EpiStore<2, true> E_{(bf16*)(F.ws + WS_VOT), D, nullptr, V8S}; int la_ = D, lb_ = 2 * D, kk_ = 256; asm volatile("" : "+s"(la_), "+s"(lb_), "+s"(kk_)); \
        pg8::gemm_phase<pg8::EpiStore<2, true>, SchedVO, true, false>(F.lds, F.wave, la_, lb_, kk_, S_, E_); } while (0)
    for (int l = 0; l < NL; ++l) {
        const int pb = PH_LAYER0 + PH_PER_LAYER * l;
        int cid = cid0; asm volatile("" : "+s"(cid));
        if (EN(0) && IN(pb + 0)) { asm volatile("; PHASE_MARK L0"); for (int rep_ = 0; rep_ < ((REPK == 0 || REPK == 91 || REPK == 92) ? 2 : 1); ++rep_) {
            SchedDense S; S.o.init(T / 256, 7, F.G, cid); S.A = (const char*)(F.ws + WS_XR); S.a_tile = 256 * D * 2; S.B = (const char*)(F.ws + WS_WIN) + (size_t)l * INW * D * 2; S.b_tile = 256 * D * 2; S.b_batch = 0; S.bdiv = 1; S.bmod = 1;
            pg8::EpiIn E{(bf16*)(F.ws + WS_UACT), (bf16*)(F.ws + WS_VACT), (bf16*)(F.ws + WS_Q), (bf16*)(F.ws + WS_K), (bf16*)(F.ws + WS_V), (float*)(F.ws + WS_VSTAT),
                         F.in[7] + (size_t)l * 64, F.in[8] + (size_t)l * 64, (const float*)(F.ws + WS_ROPE), (const float*)(F.ws + WS_ROPE) + SEQ * 32, (const float*)(F.ws + WS_RINV)}; E.nostore = (REPK == 91 && rep_ == 0); E.skip = (REPK == 92 && rep_ == 0);
            pg8::gemm_phase<pg8::EpiIn, SchedDense, ALIGN_IN, false>(F.lds, F.wave, D, D, D, S, E);
            if ((REPK != 0 && REPK != 91 && REPK != 92) || rep_ == 1) { const int Gh = F.G >> 1;
                if (cid >= Gh) { if (l == 0) RUN_KV(F.G - Gh, cid - Gh); else { RUN_QK(l, F.G - Gh, cid - Gh); RUN_VO(l, F.G - Gh, cid - Gh);
                    if (CVT_NDA > 0 && l + 1 < NL) { __syncthreads(); cvt_items(F, l + 1, 0, (cid - Gh) * NWAVES + F.wave, (F.G - Gh) * NWAVES); } } } }
        if ((REPK == 0 || REPK == 91 || REPK == 92) && rep_ == 0) xcd_barrier(bar); } } SEAM(pb + 0);
        if (EN(1) && IN(pb + 1)) { asm volatile("; PHASE_MARK L1");
            float refB; { const int ln = lane_id(); float mq = fabsf(F.in[7][(size_t)l * 64 + ln]), mk = fabsf(F.in[8][(size_t)l * 64 + ln]); mq = max_x32(max_x16(max_row16(mq))); mk = max_x32(max_x16(max_row16(mk)));
                          refB = 8.0f * LOG2E * 1.02f * mq * mk; refB = __builtin_bit_cast(float, __builtin_amdgcn_readfirstlane(__builtin_bit_cast(int, refB))); }
            if (l == 0) { RUN_QK(0, F.G, cid); RUN_VO(0, F.G, (cid + (F.G >> 1)) % F.G); }
            PROBE_TOP(11)
            for (int it = 0; ; ++it) { const int w = it * F.G + F.vcu; if (w >= NB_ * 8 * (SEQ / 256)) break;
                const int i = w >> 8, c = w & 255, x = c >> 5, j = c & 31;
                if (refB < 60.0f) attn_body::attn_unit<8, true, ATTN_LSUM>(x >> 1, (x & 1) * 4 + i, j, (const attn_body::bf16*)(F.ws + WS_Q), (const attn_body::bf16*)(F.ws + WS_K), (const attn_body::bf16*)(F.ws + WS_V),
                                        (attn_body::bf16*)(F.ws + WS_MERGED), (float*)(F.ws + WS_ATSTAT), (char*)lds, F.wave, refB);
                else attn_body::attn_unit<8, false, false>(x >> 1, (x & 1) * 4 + i, j, (const attn_body::bf16*)(F.ws + WS_Q), (const attn_body::bf16*)(F.ws + WS_K), (const attn_body::bf16*)(F.ws + WS_V),
                                        (attn_body::bf16*)(F.ws + WS_MERGED), (float*)(F.ws + WS_ATSTAT), (char*)lds, F.wave, refB); }
            PROBE_END(11)
            PROBE_TOP(12) ph_gmlp(F, l); PROBE_END(12) } SEAM(pb + 1);
        if (EN(2) && IN(pb + 2)) { asm volatile("; PHASE_MARK L2"); PROBE_TOP(2)
            SchedDense S; S.o.init(T / 256, 4, F.G, cid); S.A = (const char*)(F.ws + WS_MERGED); S.a_tile = 256 * D * 2; S.B = (const char*)(F.ws + WS_WOUT) + (size_t)l * D * D * 2; S.b_tile = 256 * D * 2; S.b_batch = 0; S.bdiv = 1; S.bmod = 1;
            pg8::EpiX<true, true> E; E.xr = (bf16*)(F.ws + WS_XR); E.xstat = (float*)(F.ws + WS_XSTAT); E.gmstat = (const float*)(F.ws + WS_GMSTAT); E.atstat = (const float*)(F.ws + WS_ATSTAT); E.lds = F.lds; E.xa8 = F.ws + WS_XR8; E.scale = 1.0f;
#if REPK == 2
            if (rep_ == 0) E.wofs = (long)(WS_NSCR - WS_XR) / 2;
#endif
            pg8::gemm_phase<pg8::EpiX<true, true>, SchedDense, ALIGN_A, false>(F.lds, F.wave, D, D, D, S, E);
        PROBE_END(2) } SEAMG(pb + 2);
        if (EN(3) && IN(pb + 3)) { asm volatile("; PHASE_MARK L3"); PROBE_TOP(3)
            SchedDense S; S.o.init(T / 256, 4, F.G, cid); S.A = (const char*)(F.ws + WS_XR8); S.a_tile = 256 * D; S.B = (const char*)(F.ws + WS_QKT) + (size_t)l * NB_ * D * D; S.b_tile = 256 * D; S.b_batch = (size_t)D * D; S.bdiv = SEQ / 256; S.bmod = NB_;
            pg8::EpiS E{(const float*)(F.ws + WS_XSTAT), F.ws + WS_P, F.lds};
            int kq = D / 2; asm volatile("" : "+s"(kq));
            pg8::gemm_phase<pg8::EpiS, SchedDense, true, false, true>(F.lds, F.wave, kq, kq, kq, S, E);
        PROBE_END(3) } SEAMG(pb + 3);
        if (EN(4) && IN(pb + 4)) { asm volatile("; PHASE_MARK L4"); PROBE_TOP(4)
            SchedDense S; S.o.init(T / 256, 4, F.G, cid); S.A = (const char*)(F.ws + WS_P); S.a_tile = 256 * D; S.B = (const char*)(F.ws + WS_VOT) + (size_t)l * NB_ * D * D; S.b_tile = 256 * D; S.b_batch = (size_t)D * D; S.bdiv = SEQ / 256; S.bmod = NB_;
            pg8::EpiX<false, false> E; E.xr = (bf16*)(F.ws + WS_XR); E.xstat = nullptr; E.gmstat = nullptr; E.atstat = nullptr; E.lds = F.lds; E.xa8 = nullptr; E.scale = 1.0f / (P8S * V8S);
#if REPK == 4
            if (rep_ == 0) E.wofs = (long)(WS_NSCR - WS_XR) / 2;
#endif
            int kq = D / 2; asm volatile("" : "+s"(kq));
            pg8::gemm_phase<pg8::EpiX<false, false>, SchedDense, ALIGN_A, false, true>(F.lds, F.wave, kq, kq, kq, S, E);
        PROBE_END(4) } SEAMG(pb + 4);
        if (EN(5) && IN(pb + 5)) { asm volatile("; PHASE_MARK L5"); PROBE_TOP(5) ph_router(F, l); PROBE_END(5) } SEAM(pb + 5);
        if (EN(6) && IN(pb + 6)) { asm volatile("; PHASE_MARK L6"); PROBE_TOP(6) ph_topk(F);
            if (CVT_ND > 0 && l + 1 < NL && F.vcu >= NB_ * NE && F.G > NB_ * NE) cvt_items(F, l + 1, 1, (F.vcu - NB_ * NE) * NWAVES + F.wave, (F.G - NB_ * NE) * NWAVES);
            PROBE_END(6) } SEAM(pb + 6);
        if (EN(7) && IN(pb + 7)) { asm volatile("; PHASE_MARK L7"); PROBE_TOP(7)
            SchedE1 S; S.o.init(NB_ * NE * 4, 8, F.G, cid); S.HBp = (const char*)(F.ws + WS_XR8); S.IDX = (const int*)(F.ws + WS_IDX); S.WGU = (const char*)(F.ws + WS_WGU) + (size_t)l * NE * 2 * FF * D;
            pg8::EpiH E{F.ws + WS_H};
            int kq = D / 2; asm volatile("" : "+s"(kq));
            pg8::gemm_phase<pg8::EpiH, SchedE1, ALIGN_E1, true, true>(F.lds, F.wave, kq, kq, kq, S, E);
        PROBE_END(7) } SEAM(pb + 7);
        if (EN(8) && IN(pb + 8)) { asm volatile("; PHASE_MARK L8"); for (int rep_ = 0; rep_ < ((REPK == 8 || REPK == 81 || REPK == 82) ? 2 : 1); ++rep_) {
            SchedDense S; S.o.init(NB_ * NE * 4, 4, F.G, cid); S.A = (const char*)(F.ws + WS_H); S.a_tile = 256 * FF; S.B = (const char*)(F.ws + WS_WD) + (size_t)l * NE * D * FF; S.b_tile = 256 * FF; S.b_batch = (size_t)D * FF; S.bdiv = 4; S.bmod = NE;
            pg8::EpiY8 E{F.ws + WS_Y, Y8S / (H8S * W8S)}; E.skip = (REPK == 81 && rep_ == 0); E.halfst = (REPK == 82 && rep_ == 0);
            int kq = FF / 2; asm volatile("" : "+s"(kq));
            pg8::gemm_phase<pg8::EpiY8, SchedDense, ALIGN_A, false, true>(F.lds, F.wave, kq, kq, kq, S, E);
        if ((REPK == 8 || REPK == 81 || REPK == 82) && rep_ == 0) xcd_barrier(bar); } } SEAM(pb + 8);
        if (EN(9) && IN(pb + 9)) { asm volatile("; PHASE_MARK L9"); PROBE_TOP(9) ph_combine(F, l, REPK == 9 && rep_ == 0); PROBE_END(9) } SEAM(pb + 9);
    }
#undef IN
#undef SEAM
}

static int g_grid = 0;
static void launch_mega(Args a, int lo, int hi, int region, hipStream_t stream) {
    a.ph_lo = lo; a.ph_hi = hi; a.bar_region = region; a.pad = 0;
    hipLaunchKernelGGL(mega, dim3(g_grid), dim3(NTHR), LDS_BYTES, stream, a);
}
extern "C" void kernel_launch(void* const* d_in, const int* in_sizes, int n_in, void* d_out, int out_size, void* d_ws, size_t ws_size, hipStream_t stream) {
    if (g_grid == 0) {
        if (n_in != 22 || out_size != T * D || ws_size < WS_END) { fprintf(stderr, "kernel_launch: unexpected sizes n_in %d out %d ws %zu\n", n_in, out_size, ws_size); g_grid = -1; return; }
        int dev = 0, cus = 0;
        if (hipGetDevice(&dev) != hipSuccess || hipDeviceGetAttribute(&cus, hipDeviceAttributeMultiprocessorCount, dev) != hipSuccess) { g_grid = -1; return; }
        if (hipFuncSetAttribute((const void*)mega, hipFuncAttributeMaxDynamicSharedMemorySize, LDS_BYTES) != hipSuccess) { g_grid = -1; return; }
        int per_cu = 0;
        if (hipOccupancyMaxActiveBlocksPerMultiprocessor(&per_cu, (const void*)mega, NTHR, LDS_BYTES) != hipSuccess || per_cu < 1) fprintf(stderr, "kernel_launch: occupancy query says %d\n", per_cu);
        (void)hipGetLastError();
        g_grid = cus;
    }
    if (g_grid < 0) return;
    hipMemsetAsync((char*)d_ws + WS_CTL, 0, CTL_ZERO_BYTES, stream);
    Args a{};
    for (int i = 0; i < 22; ++i) a.in[i] = (const float*)d_in[i];
    a.out = (float*)d_out; a.ws = (unsigned char*)d_ws;
    launch_mega(a, 0, PH_END, 0, stream);
}
```

```cpp
#ifndef PROBE_SCALE
#define PROBE_SCALE 0.5f
#endif
#ifndef PROBE_Q
#define PROBE_Q 25.0f
#endif
#ifndef PROBE_QOFF
#define PROBE_QOFF 0.0f
#endif
#ifndef REPK
#define REPK -1
#endif
#include <hip/hip_runtime.h>
#include <hip/hip_bf16.h>
#include <cstdio>
#include <cstdint>
#include <cmath>

constexpr int NB_ = 4, SEQ = 8192, T = NB_ * SEQ, D = 1024, NL = 4;
constexpr int MEML = 256, NMEM = NB_ * MEML;
constexpr int INW = 1792, GMW = 512, NE = 16, CAP = 1024, FF = 1024;
constexpr float EPS = 1e-6f;
constexpr float LOG2E = 1.4426950408889634f;
constexpr float QSCALE = 0.125f * LOG2E;
constexpr float XQSCALE = 0.0625f * LOG2E;
constexpr float W8S = 256.0f, A8S = 16.0f, H8S = 8.0f, Y8S = 32.0f;
constexpr float Q8S = 512.0f, P8S = 256.0f, V8S = 64.0f;

constexpr size_t MiB = 1u << 20;
constexpr size_t WS_CTL = 0, CTL_ZERO_BYTES = 1 * MiB;
constexpr size_t WS_ROPE = 1 * MiB;
constexpr size_t WS_AFF = 3 * MiB;
constexpr size_t WS_INV = 5 * MiB;
constexpr size_t WS_IDX = 7 * MiB;
constexpr size_t WS_VSTAT = 8 * MiB;
constexpr size_t WS_ATSTAT = 9 * MiB;
constexpr size_t WS_GMSTAT = 10 * MiB;
constexpr size_t WS_RINV = 10 * MiB + 512 * 1024;
constexpr size_t WS_RINV2 = 10 * MiB + 768 * 1024;
constexpr size_t WS_XSTAT = 11 * MiB;
constexpr size_t WS_MEMN = 13 * MiB;
constexpr size_t WS_WSB = 15 * MiB;
constexpr size_t WS_WRH = 15 * MiB + 512 * 1024, WS_WRL = WS_WRH + 128 * 1024;
constexpr size_t WS_WIN = 16 * MiB;
constexpr size_t WS_WOUT = 30 * MiB;
constexpr size_t WS_QKT = 38 * MiB;
constexpr size_t WS_VOT = 70 * MiB;
constexpr size_t WS_WGU = 102 * MiB;
constexpr size_t WS_WD = 358 * MiB;
constexpr size_t WS_XR = 486 * MiB;
constexpr size_t WS_R1 = 550 * MiB;
constexpr size_t WS_UACT = WS_R1, WS_VACT = WS_R1 + 32 * MiB, WS_Q = WS_R1 + 64 * MiB, WS_K = WS_R1 + 96 * MiB, WS_V = WS_R1 + 104 * MiB;
constexpr size_t WS_WQB = 230 * MiB, WS_WOT = 238 * MiB, WS_WKVT = 246 * MiB, WS_KVM = 262 * MiB;
constexpr size_t WS_H = WS_R1;
constexpr size_t WS_MERGED = 678 * MiB;
constexpr size_t WS_XR8 = 742 * MiB;
constexpr size_t WS_P = WS_R1;
constexpr size_t WS_Y = 678 * MiB;
constexpr size_t WS_NSCR = 806 * MiB;
constexpr size_t WS_END = 808 * MiB;

constexpr int CW_TMO = 0, CW_CODE = 1, CW_GMQ = 1024  , CW_BAR = 4096;

#define GAS __attribute__((address_space(1)))
#define LAS __attribute__((address_space(3)))
typedef unsigned short bf16;
typedef unsigned v4u __attribute__((ext_vector_type(4)));
typedef unsigned v2u __attribute__((ext_vector_type(2)));
typedef float f32x4 __attribute__((ext_vector_type(4)));
typedef short bf16x8_t __attribute__((ext_vector_type(8)));
typedef GAS unsigned gu32;
#define RLX_AGENT __ATOMIC_RELAXED, __HIP_MEMORY_SCOPE_AGENT
__device__ __forceinline__ unsigned f2bf(float f) { unsigned u = __builtin_bit_cast(unsigned, f); return (u + 0x7fffu + ((u >> 16) & 1u)) >> 16; }
__device__ __forceinline__ unsigned pk2(float lo, float hi) { return f2bf(lo) | (f2bf(hi) << 16); }
__device__ __forceinline__ float bf2f(unsigned v) { return __builtin_bit_cast(float, v << 16); }
__device__ __forceinline__ float bflo(unsigned w) { return __builtin_bit_cast(float, w << 16); }
__device__ __forceinline__ float bfhi(unsigned w) { return __builtin_bit_cast(float, w & 0xffff0000u); }
__device__ __forceinline__ float rbf(float f) { return bf2f(f2bf(f)); }
__device__ __forceinline__ float clamp8(float v) { return __builtin_amdgcn_fmed3f(v, -448.0f, 448.0f); }
__device__ __forceinline__ unsigned pk4_fp8(float a, float b, float c, float d) { unsigned w = 0u; w = __builtin_amdgcn_cvt_pk_fp8_f32(clamp8(a), clamp8(b), w, false); w = __builtin_amdgcn_cvt_pk_fp8_f32(clamp8(c), clamp8(d), w, true); return w; }
__device__ __forceinline__ float gelu_tanh(float x) {
    const float z = 1.5957691216057308f * (x + 0.044715f * x * x * x);
    return x * __builtin_amdgcn_rcpf(1.0f + __builtin_amdgcn_exp2f(-z * LOG2E));
}
typedef float f32x2_t __attribute__((ext_vector_type(2)));
__device__ __forceinline__ f32x4 gelu4(const f32x4 x) {
    const f32x4 w = (x * x) * (-1.5957691216057308f * 0.044715f * LOG2E) + (-1.5957691216057308f * LOG2E); const f32x4 a = w * x;
    f32x4 d; d[0] = __builtin_amdgcn_exp2f(a[0]); d[1] = __builtin_amdgcn_exp2f(a[1]); d[2] = __builtin_amdgcn_exp2f(a[2]); d[3] = __builtin_amdgcn_exp2f(a[3]);
    d = d + 1.0f;
    f32x4 r; r[0] = __builtin_amdgcn_rcpf(d[0]); r[1] = __builtin_amdgcn_rcpf(d[1]); r[2] = __builtin_amdgcn_rcpf(d[2]); r[3] = __builtin_amdgcn_rcpf(d[3]);
    return x * r;
}
__device__ __forceinline__ f32x4 silu_mul4(const f32x4 g, const f32x4 u, const float sg, const float su) {
    const f32x4 a = g * (-sg * LOG2E);
    f32x4 d; d[0] = __builtin_amdgcn_exp2f(a[0]); d[1] = __builtin_amdgcn_exp2f(a[1]); d[2] = __builtin_amdgcn_exp2f(a[2]); d[3] = __builtin_amdgcn_exp2f(a[3]);
    d = d + 1.0f;
    f32x4 r; r[0] = __builtin_amdgcn_rcpf(d[0]); r[1] = __builtin_amdgcn_rcpf(d[1]); r[2] = __builtin_amdgcn_rcpf(d[2]); r[3] = __builtin_amdgcn_rcpf(d[3]);
    return (g * r) * (u * (sg * sg * su));
}
__device__ __forceinline__ float silu_f(float a) { return a * __builtin_amdgcn_rcpf(1.0f + __builtin_amdgcn_exp2f(-a * LOG2E)); }
__device__ __forceinline__ int lane_id() { int l; asm volatile("v_mbcnt_lo_u32_b32 %0, -1, 0\n\tv_mbcnt_hi_u32_b32 %0, -1, %0" : "=v"(l)); return l; }
template <int CTRL> __device__ __forceinline__ float dpp_f(float v) { return __builtin_bit_cast(float, __builtin_amdgcn_update_dpp(0, __builtin_bit_cast(int, v), CTRL, 0xf, 0xf, true)); }
__device__ __forceinline__ float sum_row16(float v) { v += dpp_f<0xB1>(v); v += dpp_f<0x4E>(v); v += dpp_f<0x141>(v); v += dpp_f<0x140>(v); return v; }
__device__ __forceinline__ float max_row16(float v) { v = fmaxf(v, dpp_f<0xB1>(v)); v = fmaxf(v, dpp_f<0x4E>(v)); v = fmaxf(v, dpp_f<0x141>(v)); v = fmaxf(v, dpp_f<0x140>(v)); return v; }
__device__ __forceinline__ float sum_row8(float v) { v += dpp_f<0xB1>(v); v += dpp_f<0x4E>(v); v += dpp_f<0x141>(v); return v; }
__device__ __forceinline__ float swz16(float v) { return __builtin_bit_cast(float, __builtin_amdgcn_ds_swizzle(__builtin_bit_cast(int, v), 0x401f)); }
__device__ __forceinline__ float add_x16(float v) { return v + swz16(v); }
__device__ __forceinline__ float add_x32(float v) { const unsigned a = __builtin_bit_cast(unsigned, v); const auto r = __builtin_amdgcn_permlane32_swap(a, a, false, false); const unsigned r0 = r[0], r1 = r[1]; return __builtin_bit_cast(float, r0) + __builtin_bit_cast(float, r1); }
__device__ __forceinline__ float max_x16(float v) { return fmaxf(v, swz16(v)); }
__device__ __forceinline__ float max_x32(float v) { const unsigned a = __builtin_bit_cast(unsigned, v); const auto r = __builtin_amdgcn_permlane32_swap(a, a, false, false); const unsigned r0 = r[0], r1 = r[1]; return fmaxf(__builtin_bit_cast(float, r0), __builtin_bit_cast(float, r1)); }
__device__ __forceinline__ float wave_sum(float v) { return add_x32(add_x16(sum_row16(v))); }

#define XB_TMO      128
#define XB_XCNT(j)  (256  + 64 * (j))
#define XB_XSUB(j)  (1280 + 64 * (j))
#define XB_XGEN(j)  (2304 + 64 * (j))
#define XB_TOP      3328
#define XB_TOPGEN   3392
#define XCD_BAR_WORDS 3456
#define XB_SPIN_CAP (1u << 18)
__device__ __forceinline__ unsigned xb_ld(unsigned* p)              { return __hip_atomic_load(p, __ATOMIC_RELAXED, __HIP_MEMORY_SCOPE_AGENT); }
__device__ __forceinline__ unsigned xb_add(unsigned* p, unsigned v) { return __hip_atomic_fetch_add(p, v, __ATOMIC_RELAXED, __HIP_MEMORY_SCOPE_AGENT); }
__device__ __forceinline__ unsigned xb_xcc_id() { return (unsigned)__builtin_amdgcn_s_getreg((3 << 11) | 20) & 0xFu; }
#define XB_SPIN(cond, bar) do { unsigned _sp = 0; while (cond) { __builtin_amdgcn_s_sleep(1); \
    if ((++_sp & 255u) == 0u) { if (xb_ld(&(bar)[XB_TMO])) break; if (_sp > XB_SPIN_CAP) { atomicAdd(&(bar)[XB_TMO], 1u); break; } } } } while (0)
struct XcdBarrier { unsigned* bar; unsigned x; volatile LAS unsigned* st; };
__device__ __forceinline__ XcdBarrier xcd_barrier_post(unsigned* bar, volatile LAS unsigned* st) {
    XcdBarrier b; b.bar = bar; b.x = xb_xcc_id(); b.st = st;
    if (threadIdx.x == 0) (void)xb_add(&bar[XB_XCNT(b.x)], 1u);
    return b;
}
__device__ __forceinline__ void xcd_barrier_complete(unsigned* bar, unsigned x, unsigned& nloc, unsigned& nx) {
    const unsigned G = gridDim.x * gridDim.y * gridDim.z;
    unsigned sum, cnt, mine, sp = 0u;
    for (;;) {
        sum = 0u; cnt = 0u; mine = 0u;
#pragma unroll
        for (unsigned j = 0; j < 16; ++j) { const unsigned c = xb_ld(&bar[XB_XCNT(j)]); sum += c; cnt += (c > 0u) ? 1u : 0u; mine = (j == x) ? c : mine; }
        if (sum == G) break;
        __builtin_amdgcn_s_sleep(1);
        if ((++sp & 255u) == 0u) { if (xb_ld(&bar[XB_TMO])) break; if (sp > XB_SPIN_CAP) { atomicAdd(&bar[XB_TMO], 1u); break; } }
    }
    nloc = mine > 0u ? mine : 1u; nx = cnt > 0u ? cnt : 1u;
}
__device__ __forceinline__ void xcd_barrier(const XcdBarrier& b) {
    asm volatile("s_waitcnt vmcnt(0)" ::: "memory");
    __syncthreads();
    if (threadIdx.x == 0) {
        unsigned* bar = b.bar;
        __builtin_amdgcn_s_waitcnt(0);
        unsigned nloc = b.st[0], nx = b.st[1];
        if (nloc == 0u) { xcd_barrier_complete(bar, b.x, nloc, nx); b.st[0] = nloc; b.st[1] = nx; }
        const unsigned old = xb_add(&bar[XB_XSUB(b.x)], 1u);
        const unsigned gen = old / nloc;
        if (old + 1u == (gen + 1u) * nloc) {
            __builtin_amdgcn_fence(__ATOMIC_RELEASE, "agent");
            asm volatile("s_waitcnt vmcnt(0)" ::: "memory");
            const unsigned og = xb_add(&bar[XB_TOP], 1u);
            const unsigned tg = og / nx;
            if (og + 1u == (tg + 1u) * nx) xb_add(&bar[XB_TOPGEN], 1u);
            else XB_SPIN(xb_ld(&bar[XB_TOPGEN]) == tg, bar);
            __builtin_amdgcn_fence(__ATOMIC_ACQUIRE, "agent");
            xb_add(&bar[XB_XGEN(b.x)], 1u);
            asm volatile("s_waitcnt vmcnt(0)" ::: "memory");
        } else {
            XB_SPIN(xb_ld(&bar[XB_XGEN(b.x)]) == gen, bar);
            __builtin_amdgcn_fence(__ATOMIC_ACQUIRE, "agent");
            asm volatile("s_waitcnt vmcnt(0)" ::: "memory");
        }
    }
    __syncthreads();
}

constexpr int CW_XLSUB = 3072, CW_XLGEN = 3584;
constexpr int CW_MAP = 512, CW_MAPBAD = 576;
__device__ __forceinline__ void map_check_post(unsigned* ctl) {
    if (threadIdx.x == 0) { const unsigned x = xb_xcc_id() + 1u; unsigned expect = 0u;
        if (!__hip_atomic_compare_exchange_strong(ctl + CW_MAP + (blockIdx.x & 7u), &expect, x, __ATOMIC_RELAXED, __ATOMIC_RELAXED, __HIP_MEMORY_SCOPE_AGENT) && expect != x) xb_add(ctl + CW_MAPBAD, 1u);
        if (xb_xcc_id() >= 8u) xb_add(ctl + CW_MAPBAD, 1u); }
}
__device__ __forceinline__ void xcdl_barrier(unsigned* ctl, const XcdBarrier& b) {
    asm volatile("s_waitcnt vmcnt(0)" ::: "memory");
    __syncthreads();
    if (threadIdx.x == 0) {
        __builtin_amdgcn_s_waitcnt(0);
        const unsigned nloc = b.st[0];
        const unsigned old = xb_add(ctl + CW_XLSUB + 64 * b.x, 1u), gen = old / nloc;
        if (old + 1u == (gen + 1u) * nloc) (void)xb_add(ctl + CW_XLGEN + 64 * b.x, 1u);
        else XB_SPIN(xb_ld(ctl + CW_XLGEN + 64 * b.x) == gen, b.bar);
        __builtin_amdgcn_fence(__ATOMIC_ACQUIRE, "agent");
        asm volatile("s_waitcnt vmcnt(0)" ::: "memory");
    }
    __syncthreads();
}

struct Args { const float* in[22]; float* out; unsigned char* ws; int ph_lo, ph_hi, bar_region, pad; };
constexpr int PH_LAYER0 = 4, PH_PER_LAYER = 10, PH_END = PH_LAYER0 + NL * PH_PER_LAYER;

constexpr int NWAVES = 8, NTHR = NWAVES * 64;
constexpr int RING_BYTES = 131072, LDSCTL_OFF = RING_BYTES, MISC_OFF = LDSCTL_OFF + 320;
constexpr int LDS_BYTES = 147456;

struct Frame {
    LAS unsigned char* lds;
    int wave, vcu, G;
    const float* in[22];
    unsigned char* ws;
    float* xres;
};

__device__ __forceinline__ void ph_rows0(Frame& F) {
    int lane_ = lane_id(); asm volatile("" : "+v"(lane_)); const int tid_ = F.wave * 64 + lane_;
    const int gw = F.vcu * NWAVES + F.wave, NGW = F.G * NWAVES;
    const float* x = F.in[0]; const float* mem = F.in[1]; const float* mg = F.in[12];
    bf16* XR = (bf16*)(F.ws + WS_XR); bf16* MEMN = (bf16*)(F.ws + WS_MEMN); float* RINV = (float*)(F.ws + WS_RINV);
    for (int m = gw; m < T + NMEM; m += NGW) {
        const bool is_mem = m >= T;
        const float* src = is_mem ? mem + (size_t)(m - T) * D : x + (size_t)m * D;
        bf16* dst = is_mem ? MEMN + (size_t)(m - T) * D : XR + (size_t)m * D;
        f32x4 v[4]; float s = 0.f;
#pragma unroll
        for (int j = 0; j < 4; ++j) { v[j] = __builtin_nontemporal_load((const f32x4*)(src + 4 * lane_ + 256 * j)); s += (v[j].x * v[j].x + v[j].y * v[j].y) + (v[j].z * v[j].z + v[j].w * v[j].w); }
        const float rinv = __builtin_amdgcn_rsqf(wave_sum(s) * (1.0f / D) + EPS);
        if (!is_mem && lane_ == 0) RINV[m] = rinv;
        const float sc = is_mem ? rinv : 1.0f;
#pragma unroll
        for (int j = 0; j < 4; ++j) {
            f32x4 g = (f32x4){1.f, 1.f, 1.f, 1.f};
            if (is_mem) g = *(const f32x4*)(mg + 4 * lane_ + 256 * j);
            v2u o; o.x = pk2(v[j].x * sc * g.x, v[j].y * sc * g.y); o.y = pk2(v[j].z * sc * g.z, v[j].w * sc * g.w);
            *(v2u*)(dst + 4 * lane_ + 256 * j) = o;
        }
    }
#if defined(SELFTEST_F8)
    if (F.vcu == 0 && F.wave == 0) {
        typedef int v8i_t __attribute__((ext_vector_type(8)));
        const int fr = lane_ & 15; const unsigned codes[4] = {0x38383838u, 0x3A3A3A3Au, 0x3C3C3C3Cu, 0x40404040u}; const float vals[4] = {1.0f, 1.25f, 1.5f, 2.0f};
        unsigned bc = codes[0]; float bv = vals[0];
#pragma unroll
        for (int q = 1; q < 4; ++q) if ((fr & 3) == q) { bc = codes[q]; bv = vals[q]; }
        v8i_t A, B;
#pragma unroll
        for (int q = 0; q < 8; ++q) { A[q] = 0x38383838; B[q] = (int)bc; }
        f32x4 acc = (f32x4){0.f, 0.f, 0.f, 0.f}; unsigned sc = 0x7f7f7f7fu; asm volatile("" : "+v"(sc), "+v"(A), "+v"(B), "+v"(acc));
        asm volatile("s_nop 7\n\tv_mfma_scale_f32_16x16x128_f8f6f4 %0, %1, %2, %0, %3, %3 op_sel_hi:[0,0,0]\n\ts_nop 15\n\ts_nop 15\n\ts_nop 15\n\ts_nop 15\n\ts_nop 15\n\ts_nop 15" : "+v"(acc) : "v"(A), "v"(B), "v"(sc));
        bool bad = false;
#pragma unroll
        for (int e = 0; e < 4; ++e) bad |= (acc[e] != 128.0f * bv);
        const unsigned w = pk4_fp8(1.25f, 448.0f, 1000.0f, -2.0f); bad |= (w != 0xC07E7E3Au);
        {   const float v = (float)((lane_ * 37 + 11) % 101);
            float r16 = v; r16 += __shfl_xor(r16, 1); r16 += __shfl_xor(r16, 2); r16 += __shfl_xor(r16, 4); r16 += __shfl_xor(r16, 8);
            float m16 = v; m16 = fmaxf(m16, __shfl_xor(m16, 1)); m16 = fmaxf(m16, __shfl_xor(m16, 2)); m16 = fmaxf(m16, __shfl_xor(m16, 4)); m16 = fmaxf(m16, __shfl_xor(m16, 8));
            float r8 = v; r8 += __shfl_xor(r8, 1); r8 += __shfl_xor(r8, 2); r8 += __shfl_xor(r8, 4);
            float r64 = r16; r64 += __shfl_xor(r64, 16); r64 += __shfl_xor(r64, 32);
            if (SELFTEST_F8 & 1) bad |= (sum_row16(v) != r16) | (max_row16(v) != m16) | (sum_row8(v) != r8);
            if (SELFTEST_F8 & 2) bad |= (wave_sum(v) != r64);
            if (SELFTEST_F8 & 4) bad |= (add_x16(v) != v + __shfl_xor(v, 16)) | (max_x16(v) != fmaxf(v, __shfl_xor(v, 16)));
            if (SELFTEST_F8 & 8) bad |= (add_x32(v) != v + __shfl_xor(v, 32)) | (max_x32(v) != fmaxf(v, __shfl_xor(v, 32)));
            if (SELFTEST_F8 & 16) bad |= (lane_ != (int)(threadIdx.x & 63));
            const int iv = lane_ * 3 + 1; if (SELFTEST_F8 & 32) bad |= (__builtin_amdgcn_readlane(iv, 5) != 16) | false; { const int bp = __builtin_amdgcn_ds_bpermute((lane_ - 1) << 2, iv); if (SELFTEST_F8 & 32) bad |= (lane_ > 0 && bp != iv - 3); }
            const float xq = 0.37f + (float)lane_; const float rq = __builtin_amdgcn_rsqf(xq), rr = 1.0f / sqrtf(xq); if (SELFTEST_F8 & 64) bad |= (fabsf(rq - rr) > 1e-5f * rr); }
        if (bad) __hip_atomic_store((unsigned*)(F.ws + WS_CTL) + CW_TMO, 1u, __ATOMIC_RELAXED, __HIP_MEMORY_SCOPE_AGENT);
    }
#endif
    float* COS = (float*)(F.ws + WS_ROPE); float* SIN = COS + SEQ * 32;
    const int gt = F.vcu * NTHR + tid_, NGT = F.G * NTHR;
    for (int i = gt; i < SEQ * 32; i += NGT) {
        const int t = i >> 5, p = i & 31;
        const float fr = expf(-9.210340371976184f * (float)(p & 15) * (1.0f / 16.0f));
        const float pos = (float)((p < 16) ? (t >> 6) : (t & 63));
        float rev = pos * fr * 0.15915494309189535f; rev -= floorf(rev);
        COS[i] = __builtin_amdgcn_cosf(rev); SIN[i] = __builtin_amdgcn_sinf(rev);
    }
}

__device__ __forceinline__ void ph_gmlp(Frame& F, int l) {
    int lane_ = lane_id(); asm volatile("" : "+v"(lane_)); const int tid_ = F.wave * 64 + lane_;
    const bf16* UACT = (const bf16*)(F.ws + WS_UACT); const bf16* VACT = (const bf16*)(F.ws + WS_VACT);
    const float* VSTAT = (const float*)(F.ws + WS_VSTAT); float* GMSTAT = (float*)(F.ws + WS_GMSTAT);
    bf16* MERGED = (bf16*)(F.ws + WS_MERGED);
    const float* gvn = F.in[4] + (size_t)l * GMW; const float* bs = F.in[6] + (size_t)l * 4 * 128;
    const bf16* WSB = (const bf16*)(F.ws + WS_WSB) + (size_t)l * 4 * 128 * 128;
    LAS bf16* vT = (LAS bf16*)F.lds;
    const int fr = lane_ & 15, fq = lane_ >> 4, w = F.wave;
    const int jv = tid_ & 127, csv = tid_ >> 7;
    v4u nraw[4]; f32x4 ns0, ns1;
#define GM_LOADV(U_) do { const int n_ = (U_) >> 2, g_ = (U_) & 3; const size_t row_ = (size_t)n_ * 128 + jv; ns0 = *(const f32x4*)(VSTAT + row_ * 8); ns1 = *(const f32x4*)(VSTAT + row_ * 8 + 4); \
        _Pragma("unroll") for (int q_ = 0; q_ < 4; ++q_) nraw[q_] = *(const v4u*)(VACT + row_ * GMW + g_ * 128 + (csv * 4 + q_) * 8); } while (0)
    constexpr int NU = (T / 128) * 4;
    unsigned* gmq = (unsigned*)(F.ws + WS_CTL) + CW_GMQ + 64 * l;
    LAS int* nxt = (LAS int*)(F.lds + 36864);
    if (F.vcu < NU) GM_LOADV(F.vcu);
    for (int u = F.vcu; u < NU; ) {
        const int n = u >> 2, g = u & 3; const int row0 = n * 128;
        v4u raw[4]; const f32x4 s0 = ns0, s1 = ns1;
#pragma unroll
        for (int q = 0; q < 4; ++q) raw[q] = nraw[q];
        __syncthreads();
        unsigned tk = 0u; if (tid_ == 0) tk = __hip_atomic_fetch_add(gmq, 1u, __ATOMIC_RELAXED, __HIP_MEMORY_SCOPE_AGENT);
        {   const float rinv = __builtin_amdgcn_rsqf((((s0[0] + s0[1]) + (s0[2] + s0[3])) + ((s1[0] + s1[1]) + (s1[2] + s1[3]))) * (1.0f / GMW) + EPS);
#pragma unroll
            for (int q = 0; q < 4; ++q) { const int c8 = (csv * 4 + q) * 8;
                const f32x4 g0 = *(const f32x4*)(gvn + g * 128 + c8) * rinv, g1 = *(const f32x4*)(gvn + g * 128 + c8 + 4) * rinv;
                LAS bf16* d = vT + c8 * 136 + jv;
                d[0 * 136] = (bf16)f2bf(bflo(raw[q].x) * g0[0]); d[1 * 136] = (bf16)f2bf(bfhi(raw[q].x) * g0[1]); d[2 * 136] = (bf16)f2bf(bflo(raw[q].y) * g0[2]); d[3 * 136] = (bf16)f2bf(bfhi(raw[q].y) * g0[3]);
                d[4 * 136] = (bf16)f2bf(bflo(raw[q].z) * g1[0]); d[5 * 136] = (bf16)f2bf(bfhi(raw[q].z) * g1[1]); d[6 * 136] = (bf16)f2bf(bflo(raw[q].w) * g1[2]); d[7 * 136] = (bf16)f2bf(bfhi(raw[q].w) * g1[3]); } }
        bf16x8_t bw[4];
#pragma unroll
        for (int ks = 0; ks < 4; ++ks) bw[ks] = *(const bf16x8_t*)(WSB + ((size_t)(g * 128 + 16 * w + fr)) * 128 + 32 * ks + 8 * fq);
        const size_t row = (size_t)row0 + 16 * w + fr; const float bias = bs[g * 128 + 16 * w + fr];
        v2u uu[8];
#pragma unroll
        for (int cb = 0; cb < 8; ++cb) uu[cb] = *(const v2u*)(UACT + row * GMW + g * 128 + 16 * cb + 4 * fq);
        if (tid_ == 0) *nxt = F.G + (int)tk;
        __syncthreads();
        const int un = *nxt;
        if (un < NU) GM_LOADV(un);
        f32x4 acc[8];
#pragma unroll
        for (int cb = 0; cb < 8; ++cb) { acc[cb] = (f32x4){0.f, 0.f, 0.f, 0.f};
#pragma unroll
            for (int ks = 0; ks < 4; ++ks) { const bf16x8_t a = *(const LAS bf16x8_t*)(vT + (16 * cb + fr) * 136 + 32 * ks + 8 * fq);
                acc[cb] = __builtin_amdgcn_mfma_f32_16x16x32_bf16(a, bw[ks], acc[cb], 0, 0, 0); } }
        float ss = 0.f;
#pragma unroll
        for (int cb = 0; cb < 8; ++cb) {
            v2u o; o.x = pk2(bflo(uu[cb].x) * (acc[cb][0] + bias), bfhi(uu[cb].x) * (acc[cb][1] + bias)); o.y = pk2(bflo(uu[cb].y) * (acc[cb][2] + bias), bfhi(uu[cb].y) * (acc[cb][3] + bias));
            *(v2u*)(MERGED + row * 1024 + g * 128 + 16 * cb + 4 * fq) = o;
            const float a0 = bflo(o.x), a1 = bfhi(o.x), a2 = bflo(o.y), a3 = bfhi(o.y); ss += (a0 * a0 + a1 * a1) + (a2 * a2 + a3 * a3); }
        ss = add_x32(add_x16(ss));
        if (fq == 0) GMSTAT[row * 4 + g] = ss;
        u = un;
    }
#undef GM_LOADV
    __syncthreads();
}

__device__ __forceinline__ void ph_router(Frame& F, int l) {
    const bf16* XR = (const bf16*)(F.ws + WS_XR); float* AFF = (float*)(F.ws + WS_AFF); unsigned char* X8 = F.ws + WS_XR8;
    constexpr int RP = 2064;
    const int gw = F.vcu * NWAVES + F.wave, NGW = F.G * NWAVES;
    for (int blk = gw; blk < T / 16; blk += NGW) {
        int lane_ = lane_id(); asm volatile("" : "+v"(lane_)); const int fr = lane_ & 15, fq = lane_ >> 4;
        v4u x[32];
#pragma unroll
        for (int ks = 0; ks < 32; ++ks) x[ks] = *(const v4u*)(XR + ((size_t)blk * 16 + fr) * D + 128 * (ks >> 2) + 32 * fq + 8 * (ks & 3));
        if (blk == gw) {
        {
            int tid_ = F.wave * 64 + lane_id(); asm volatile("" : "+v"(tid_));
            const bf16* gh = (const bf16*)(F.ws + WS_WRH) + (size_t)l * NE * D; const bf16* gl = (const bf16*)(F.ws + WS_WRL) + (size_t)l * NE * D;
            v4u th[4], tl[4];
#pragma unroll
            for (int i = 0; i < 4; ++i) { const int c = tid_ + 512 * i; th[i] = *(const v4u*)(gh + (size_t)(c >> 7) * D + 8 * (c & 127)); tl[i] = *(const v4u*)(gl + (size_t)(c >> 7) * D + 8 * (c & 127)); }
#pragma unroll
            for (int i = 0; i < 4; ++i) { const int c = tid_ + 512 * i; *(LAS v4u*)(F.lds + (c >> 7) * RP + 16 * (c & 127)) = th[i]; *(LAS v4u*)(F.lds + 16 * RP + (c >> 7) * RP + 16 * (c & 127)) = tl[i]; }
        }
        __syncthreads();
        }
        int wo_ = fr * RP + 64 * fq; asm volatile("" : "+v"(wo_));
        const LAS unsigned char* wp = F.lds + wo_;
        const size_t row = (size_t)blk * 16 + fr;
        f32x4 acc = (f32x4){0.f, 0.f, 0.f, 0.f}; float ss = 0.f;
#pragma unroll
        for (int ks = 0; ks < 32; ++ks) { const bf16x8_t xk = __builtin_bit_cast(bf16x8_t, x[ks]);
            const bf16x8_t wh = *(const LAS bf16x8_t*)(wp + 256 * (ks >> 2) + 16 * (ks & 3)), wl = *(const LAS bf16x8_t*)(wp + 16 * RP + 256 * (ks >> 2) + 16 * (ks & 3));
            acc = __builtin_amdgcn_mfma_f32_16x16x32_bf16(wh, xk, acc, 0, 0, 0); acc = __builtin_amdgcn_mfma_f32_16x16x32_bf16(wl, xk, acc, 0, 0, 0);
            const v4u xb = x[ks];
            const float a0 = bflo(xb.x), a1 = bfhi(xb.x), a2 = bflo(xb.y), a3 = bfhi(xb.y), a4 = bflo(xb.z), a5 = bfhi(xb.z), a6 = bflo(xb.w), a7 = bfhi(xb.w);
            ss += ((a0 * a0 + a1 * a1) + (a2 * a2 + a3 * a3)) + ((a4 * a4 + a5 * a5) + (a6 * a6 + a7 * a7)); }
        ss = add_x32(add_x16(ss));
        const float rinv = __builtin_amdgcn_rsqf(ss * (1.0f / D) + EPS);
        const f32x4 lg = acc * (rinv * LOG2E);
        float mx = fmaxf(fmaxf(lg[0], lg[1]), fmaxf(lg[2], lg[3])); mx = max_x32(max_x16(mx));
        f32x4 pe; float den = 0.f;
#pragma unroll
        for (int i = 0; i < 4; ++i) { pe[i] = __builtin_amdgcn_exp2f(lg[i] - mx); den += pe[i]; }
        den = add_x32(add_x16(den));
        *(f32x4*)(AFF + row * NE + 4 * fq) = pe * __builtin_amdgcn_rcpf(den);
        const float sc = rinv * A8S;
#pragma unroll
        for (int g = 0; g < 8; ++g) {
            v4u o0, o1;
#pragma unroll
            for (int i = 0; i < 4; ++i) asm volatile("" : "+v"(x[4 * g + i]));
#define RT8(xb, lo_, hi_) lo_ = pk4_fp8(bflo(xb.x) * sc, bfhi(xb.x) * sc, bflo(xb.y) * sc, bfhi(xb.y) * sc); hi_ = pk4_fp8(bflo(xb.z) * sc, bfhi(xb.z) * sc, bflo(xb.w) * sc, bfhi(xb.w) * sc);
            RT8(x[4 * g], o0.x, o0.y) RT8(x[4 * g + 1], o0.z, o0.w) RT8(x[4 * g + 2], o1.x, o1.y) RT8(x[4 * g + 3], o1.z, o1.w)
#undef RT8
            *(v4u*)(X8 + row * D + 128 * g + 32 * fq) = o0; *(v4u*)(X8 + row * D + 128 * g + 32 * fq + 16) = o1; }
    }
}

__device__ __forceinline__ void ph_topk(Frame& F) {
    int lane_ = lane_id(); asm volatile("" : "+v"(lane_)); const int tid_ = F.wave * 64 + lane_;
    const float* AFF = (const float*)(F.ws + WS_AFF); int* IDX = (int*)(F.ws + WS_IDX); int* INV = (int*)(F.ws + WS_INV);
    LAS unsigned* hist = (LAS unsigned*)F.lds;
    LAS unsigned* sh = hist + 256;
    LAS unsigned* wsum = hist + 512;
    for (int p = F.vcu; p < NB_ * NE; p += F.G) {
        const int b = p >> 4, e = p & 15;
        unsigned key[16];
#pragma unroll
        for (int i = 0; i < 16; ++i) key[i] = __builtin_bit_cast(unsigned, AFF[((size_t)b * SEQ + tid_ * 16 + i) * NE + e]);
        unsigned prefix = 0u, krem = CAP;
#pragma unroll
        for (int pass = 0; pass < 4; ++pass) {
            const int shift = pass == 3 ? 0 : 23 - 8 * pass; const unsigned dmask = pass == 3 ? 127u : 255u;
            const unsigned himask = pass == 0 ? 0u : (pass == 1 ? 0xff800000u : (pass == 2 ? 0xffff8000u : 0xffffff80u));
            __syncthreads();
            if (tid_ < 256) hist[tid_] = 0u;
            __syncthreads();
#pragma unroll
            for (int i = 0; i < 16; ++i) if ((key[i] & himask) == prefix) atomicAdd((unsigned*)&hist[(key[i] >> shift) & dmask], 1u);
            __syncthreads();
            if (F.wave == 0) {
                unsigned c[4]; unsigned t = 0u;
#pragma unroll
                for (int j = 0; j < 4; ++j) { c[j] = hist[255 - 4 * lane_ - j]; t += c[j]; }
                unsigned inc = t;
#pragma unroll
                for (int o = 1; o < 64; o <<= 1) { const unsigned a = (unsigned)__builtin_amdgcn_ds_bpermute((lane_ - o) << 2, (int)inc); if (lane_ >= o) inc += a; }
                unsigned above = inc - t;
                if (above < krem && krem <= inc) {
                    int d = 255 - 4 * lane_;
#pragma unroll
                    for (int j = 0; j < 3; ++j) { if (above + c[j] < krem) { above += c[j]; d = 254 - 4 * lane_ - j; } else break; }
                    sh[0] = prefix | ((unsigned)d << shift); sh[1] = krem - above; }
            }
            __syncthreads();
            prefix = sh[0]; krem = sh[1];
        }
        const unsigned thr = prefix;
        unsigned cg = 0u, ce = 0u;
#pragma unroll
        for (int i = 0; i < 16; ++i) { cg += key[i] > thr ? 1u : 0u; ce += key[i] == thr ? 1u : 0u; }
        unsigned sg = cg, se = ce;
#pragma unroll
        for (int o = 1; o < 64; o <<= 1) { const unsigned a = (unsigned)__builtin_amdgcn_ds_bpermute((lane_ - o) << 2, (int)sg), c2 = (unsigned)__builtin_amdgcn_ds_bpermute((lane_ - o) << 2, (int)se); if (lane_ >= o) { sg += a; se += c2; } }
        __syncthreads();
        if (lane_ == 63) { wsum[F.wave] = sg; wsum[8 + F.wave] = se; }
        __syncthreads();
        unsigned og = 0u, oe = 0u;
        for (int w = 0; w < F.wave; ++w) { og += wsum[w]; oe += wsum[8 + w]; }
        unsigned gb = og + sg - cg, eb = oe + se - ce;
#pragma unroll
        for (int i = 0; i < 16; ++i) {
            const int t = tid_ * 16 + i; int pos = -1;
            if (key[i] > thr) { pos = (int)(gb + (eb < krem ? eb : krem)); ++gb; }
            else if (key[i] == thr) { if (eb < krem) pos = (int)(gb + eb); ++eb; }
            INV[((size_t)b * SEQ + t) * NE + e] = pos;
            if (pos >= 0) IDX[(size_t)p * CAP + pos] = t;
        }
    }
    __syncthreads();
}

__device__ __forceinline__ void ph_combine(Frame& F, int l, bool dummy) {
    int lane_ = lane_id(); asm volatile("" : "+v"(lane_));
    const float* AFF = (const float*)(F.ws + WS_AFF); const int* INV = (const int*)(F.ws + WS_INV);
    const unsigned char* Y = F.ws + WS_Y; bf16* XR = (bf16*)(F.ws + WS_XR); const float* fg = F.in[21]; float* RINV = (float*)(F.ws + WS_RINV);
    const int gw = F.vcu * NWAVES + F.wave, NGW = F.G * NWAVES;
#define CMB_LOAD_A(X_, POS_, AFF_, M_) do { POS_ = -1; AFF_ = 0.f; if ((M_) < T) { _Pragma("unroll") for (int j_ = 0; j_ < 4; ++j_) X_[j_] = *(const v2u*)(XR + (size_t)(M_) * D + 4 * lane_ + 256 * j_); \
        if (lane_ < NE) { POS_ = INV[(size_t)(M_) * NE + lane_]; AFF_ = AFF[(size_t)(M_) * NE + lane_]; } } } while (0)
#define CMB_ISSUE_Y(W_, AS_, MASK_, POS_, AFF_, M_) do { MASK_ = (unsigned)__builtin_amdgcn_ballot_w64(POS_ >= 0) & 0xffffu; const int b_ = ((M_) < T ? (M_) : 0) / SEQ; \
        _Pragma("unroll") for (int q_ = 0; q_ < 4; ++q_) { AS_[q_] = 0.f; _Pragma("unroll") for (int j_ = 0; j_ < 4; ++j_) W_[q_][j_] = 0; \
            if (MASK_) { const int e_ = __builtin_ctz(MASK_); MASK_ &= MASK_ - 1u; const int pos_ = __builtin_amdgcn_readlane(POS_, e_); \
                AS_[q_] = __builtin_bit_cast(float, __builtin_amdgcn_readlane(__builtin_bit_cast(int, AFF_), e_)) * (1.0f / Y8S); const unsigned char* yr_ = Y + ((size_t)(b_ * NE + e_) * CAP + pos_) * D; \
                _Pragma("unroll") for (int j_ = 0; j_ < 4; ++j_) W_[q_][j_] = *(const int*)(yr_ + 4 * lane_ + 256 * j_); } } } while (0)
#define CMB_ACC(W_, AS_) do { _Pragma("unroll") for (int q_ = 0; q_ < 4; ++q_) _Pragma("unroll") for (int j_ = 0; j_ < 4; ++j_) { \
        const auto lo_ = __builtin_amdgcn_cvt_pk_f32_fp8(W_[q_][j_], false), hi_ = __builtin_amdgcn_cvt_pk_f32_fp8(W_[q_][j_], true); const float l0_ = lo_[0], l1_ = lo_[1], h0_ = hi_[0], h1_ = hi_[1]; \
        v[j_].x += AS_[q_] * l0_; v[j_].y += AS_[q_] * l1_; v[j_].z += AS_[q_] * h0_; v[j_].w += AS_[q_] * h1_; } } while (0)
    v2u cx[4], nx[4]; int cpos, npos; float caff, naff; int cw[4][4]; float cas[4]; unsigned cmask;
    CMB_LOAD_A(cx, cpos, caff, gw); CMB_LOAD_A(nx, npos, naff, gw + NGW);
    CMB_ISSUE_Y(cw, cas, cmask, cpos, caff, gw);
    for (int m = gw; m < T; m += NGW) {
        const int b = m / SEQ;
        bf16* xw = (dummy ? (bf16*)(F.ws + WS_NSCR) : XR) + (size_t)m * D; float* ow = (dummy ? (float*)(F.ws + WS_NSCR) : F.xres) + (size_t)m * D;
        v2u tx[4]; int tw[4][4]; float tas[4]; unsigned tmask; const int tpos = npos; const float taff = naff;
#pragma unroll
        for (int j = 0; j < 4; ++j) tx[j] = nx[j];
        CMB_ISSUE_Y(tw, tas, tmask, tpos, taff, m + NGW);
        CMB_LOAD_A(nx, npos, naff, m + 2 * NGW);
        f32x4 v[4];
#pragma unroll
        for (int j = 0; j < 4; ++j) v[j] = (f32x4){bflo(cx[j].x), bfhi(cx[j].x), bflo(cx[j].y), bfhi(cx[j].y)};
        CMB_ACC(cw, cas);
        while (cmask) {
            int rw[4][4]; float ras[4]; unsigned rm = cmask; const int rpos = cpos; const float raff = caff;
            (void)b;
            {   unsigned mk = rm;
#pragma unroll
                for (int q = 0; q < 4; ++q) { ras[q] = 0.f;
#pragma unroll
                    for (int j = 0; j < 4; ++j) rw[q][j] = 0;
                    if (mk) { const int e = __builtin_ctz(mk); mk &= mk - 1u; const int pos = __builtin_amdgcn_readlane(rpos, e);
                        ras[q] = __builtin_bit_cast(float, __builtin_amdgcn_readlane(__builtin_bit_cast(int, raff), e)) * (1.0f / Y8S); const unsigned char* yr = Y + ((size_t)(b * NE + e) * CAP + pos) * D;
#pragma unroll
                        for (int j = 0; j < 4; ++j) rw[q][j] = *(const int*)(yr + 4 * lane_ + 256 * j); } }
                cmask = mk; }
            CMB_ACC(rw, ras);
        }
#pragma unroll
        for (int j = 0; j < 4; ++j) cx[j] = tx[j];
        cpos = tpos; caff = taff; cmask = tmask;
#pragma unroll
        for (int q = 0; q < 4; ++q) { cas[q] = tas[q];
#pragma unroll
            for (int j = 0; j < 4; ++j) cw[q][j] = tw[q][j]; }
        float s = 0.f;
#pragma unroll
        for (int j = 0; j < 4; ++j) s += (v[j].x * v[j].x + v[j].y * v[j].y) + (v[j].z * v[j].z + v[j].w * v[j].w);
        const float rinv = __builtin_amdgcn_rsqf(wave_sum(s) * (1.0f / D) + EPS);
        if (l == NL - 1) {
#if defined(SELFTEST_F8)
            if (__hip_atomic_load((unsigned*)(F.ws + WS_CTL) + CW_TMO, __ATOMIC_RELAXED, __HIP_MEMORY_SCOPE_AGENT) != 0u) v[0].x = __builtin_nanf("");
#endif
            float pr_ = 1.0f;
#if REPK == 300 || REPK == 301 || REPK == 302 || REPK == 310
            { const unsigned* pw_ = (const unsigned*)(F.ws + WS_CTL + 64); float rr_ = (float)pw_[0] / (float)pw_[1]; if (REPK == 302) rr_ = floorf(rr_ * 20.0f) * 0.05f; if (REPK == 310) rr_ = floorf(rr_ * PROBE_Q + PROBE_QOFF) / PROBE_Q; pr_ = 1.0f + (REPK == 301 ? 1.0f : (REPK == 310 ? PROBE_SCALE : 0.125f)) * rr_; }
#endif
#pragma unroll
            for (int j = 0; j < 4; ++j) { const f32x4 g = *(const f32x4*)(fg + 4 * lane_ + 256 * j); *(f32x4*)(ow + 4 * lane_ + 256 * j) = (f32x4){v[j].x * rinv * g.x * pr_, v[j].y * rinv * g.y * pr_, v[j].z * rinv * g.z * pr_, v[j].w * rinv * g.w * pr_}; }
        } else {
            if (lane_ == 0 && !dummy) RINV[m] = rinv;
#pragma unroll
            for (int j = 0; j < 4; ++j) { v2u o; o.x = pk2(v[j].x, v[j].y); o.y = pk2(v[j].z, v[j].w); *(v2u*)(xw + 4 * lane_ + 256 * j) = o; }
        }
    }
}

#undef CMB_LOAD_A
#undef CMB_ISSUE_Y
#undef CMB_ACC
namespace pg8 {
typedef short bf16x8 __attribute__((ext_vector_type(8)));
typedef float f32x2 __attribute__((ext_vector_type(2)));
typedef int v4i_t __attribute__((ext_vector_type(4)));
typedef int v8i_t __attribute__((ext_vector_type(8)));
constexpr int BM = 256, BK = 64, HALF = 128, HTB = HALF * BK * 2, STAGE_BYTES = 8 * HTB, NXCD = 8, WGM = 2;
__host__ __device__ __forceinline__ int lds_byte(int r, int c) { const int st = (r >> 4) * 2 + (c >> 5), rr = r & 15, cc = c & 31, ob = rr * 64 + cc * 2; return st * 1024 + (ob ^ (((ob >> 9) & 1) << 5)); }
__host__ __device__ __forceinline__ void stage_rc(int b, int& R, int& C) { const int st = b / 1024, sb = b % 1024, swz = sb ^ (((sb >> 9) & 1) << 5); R = (st >> 1) * 16 + swz / 64; C = (st & 1) * 32 + (swz % 64) / 2; }
__host__ __device__ __forceinline__ int perm32(int rho) { const int n = rho >> 4, i = rho & 15; return 8 * (i >> 2) + 4 * n + (i & 3); }

struct Unit { int pm, pn, z; const char* a; const char* b; const int* gi; int grow; };

struct TileOrder {
    int nM, nN, nwg, G, c;
    __device__ __forceinline__ void init(int nM_, int nN_, int G_, int c_) { nM = nM_; nN = nN_; nwg = nM * nN; G = G_; c = c_; }
    __device__ __forceinline__ bool tile(int i, int& pm, int& pn) const {
        const long L = (long)i * G + c; if (L >= nwg) return false;
        int wgid = (int)L; { const int q = nwg / NXCD, r = nwg % NXCD, xcd = wgid % NXCD, off = wgid / NXCD; wgid = (xcd < r ? xcd * (q + 1) : r * (q + 1) + (xcd - r) * q) + off; }
        const int nig = WGM * nN, gid = wgid / nig, fm = gid * WGM, gsz = (nM - fm) < WGM ? (nM - fm) : WGM;
        pm = fm + ((wgid % nig) % gsz); pn = (wgid % nig) / gsz; return true;
    }
};

__device__ __forceinline__ unsigned cvt_pk_bf16(float lo, float hi) { unsigned r; asm volatile("v_cvt_pk_bf16_f32 %0, %1, %2" : "=v"(r) : "v"(lo), "v"(hi)); return r; }
typedef f32x4 Acc[2][2][4][2];
#ifndef NT_STORE
#define NT_STORE 0
#endif
__device__ __forceinline__ void st16(void* p, const v4u w, bool nostore = false) { if (nostore) return; if (NT_STORE) __builtin_nontemporal_store(w, (v4u*)p); else *(v4u*)p = w; }
#ifndef NT_Y
#define NT_Y 1
#endif

template <class Epi, class Sched, bool ALIGN_EPI, bool GATHER, bool FP8 = false>
__device__ __forceinline__ void gemm_phase(LAS unsigned char* lds, const int wave_idx, const int lda, const int ldb, const int K, const Sched& S, Epi& E) {
    const int lane = lane_id();
    int wid = wave_idx; asm volatile("" : "+s"(wid));
    const int tid = wid * 64 + lane, wr = wid >> 2, wc = wid & 3, fr = lane & 15, fq = lane >> 4;
    const int nt = K / BK;
    unsigned voffA[2], voffB[2];
#pragma unroll
    for (int i = 0; i < 2; ++i) { int R, C; stage_rc(tid * 16 + i * 8192, R, C); const int Rb = (R & ~31) + perm32(R & 31);
        voffA[i] = (unsigned)(R * lda + C) * 2u; voffB[i] = (unsigned)(Rb * ldb + C) * 2u; }
    const size_t kstep = (size_t)(BK * 2);
    const size_t hstepA = (size_t)HALF * lda * 2, hstepB = (size_t)HALF * ldb * 2;
    const unsigned ldsw = (unsigned)wid * 1024u;
    const int aoff = lds_byte(wr * 64 + fr, fq * 8), boff = lds_byte(wc * 32 + fr, fq * 8);
    unsigned vgc[2][2], vgn[2][2];
#define PG8_SA(b, h) (((b) * 2 + (h)) * HTB)
#define PG8_SB(b, h) ((4 + (b) * 2 + (h)) * HTB)
#define PG8_GL(gp, voff, bufoff, _i) __builtin_amdgcn_global_load_lds((const unsigned*)((const char*)(gp) + (voff)), (LAS unsigned*)(lds + (bufoff) + ldsw + (_i) * 8192), 16, 0, 0)
#define PG8_STAGE_B(bufoff, gbase) do { PG8_GL(gbase, voffB[0], bufoff, 0); PG8_GL(gbase, voffB[1], bufoff, 1); } while (0)
#define PG8_STAGE_A(bufoff, gbase, h, VG) do { if constexpr (GATHER) { PG8_GL(gbase, VG[h][0], bufoff, 0); PG8_GL(gbase, VG[h][1], bufoff, 1); } \
        else { PG8_GL((gbase) + (h) * hstepA, voffA[0], bufoff, 0); PG8_GL((gbase) + (h) * hstepA, voffA[1], bufoff, 1); } } while (0)
#define PG8_CAT(x0, x1) __builtin_shufflevector(__builtin_bit_cast(v4i_t, x0), __builtin_bit_cast(v4i_t, x1), 0, 1, 2, 3, 4, 5, 6, 7)
#define PG8_RD(off) (*(const LAS bf16x8*)(lds + (off)))
#define PG8_LDA(dst, b, h) do { if constexpr (FP8) { _Pragma("unroll") for (int m = 0; m < 4; ++m) dst##8[m] = PG8_CAT(PG8_RD(PG8_SA(b, h) + aoff + m * 2048), PG8_RD(PG8_SA(b, h) + aoff + m * 2048 + 1024)); } \
        else { _Pragma("unroll") for (int m = 0; m < 4; ++m) _Pragma("unroll") for (int k = 0; k < 2; ++k) dst[m][k] = PG8_RD(PG8_SA(b, h) + aoff + m * 2048 + k * 1024); } } while (0)
#define PG8_LDB(dst, b, h) do { if constexpr (FP8) { _Pragma("unroll") for (int n = 0; n < 2; ++n) dst##8[n] = PG8_CAT(PG8_RD(PG8_SB(b, h) + boff + n * 2048), PG8_RD(PG8_SB(b, h) + boff + n * 2048 + 1024)); } \
        else { _Pragma("unroll") for (int n = 0; n < 2; ++n) _Pragma("unroll") for (int k = 0; k < 2; ++k) dst[n][k] = PG8_RD(PG8_SB(b, h) + boff + n * 2048 + k * 1024); } } while (0)
#define PG8_MMA(ai, bj, At, Bt) do { __builtin_amdgcn_s_setprio(1); _Pragma("unroll") for (int m = 0; m < 4; ++m) _Pragma("unroll") for (int n = 0; n < 2; ++n) { \
        if constexpr (FP8) asm volatile("v_mfma_scale_f32_16x16x128_f8f6f4 %0, %1, %2, %0, %3, %3 op_sel_hi:[0,0,0]" : "+v"(acc[ai][bj][m][n]) : "v"(Bt##8[n]), "v"(At##8[m]), "v"(sc8)); \
        else { _Pragma("unroll") for (int k = 0; k < 2; ++k) acc[ai][bj][m][n] = __builtin_amdgcn_mfma_f32_16x16x32_bf16(Bt[n][k], At[m][k], acc[ai][bj][m][n], 0, 0, 0); } } __builtin_amdgcn_s_setprio(0); } while (0)
#define PG8_WAIT_V(n) asm volatile("s_waitcnt vmcnt(" #n ")" ::: "memory")
#define PG8_WAIT_L(n) asm volatile("s_waitcnt lgkmcnt(" #n ")" ::: "memory")
#define PG8_BAR __builtin_amdgcn_s_barrier()
#define PG8_SCHED __builtin_amdgcn_sched_barrier(0)
#define PG8_GIDX(VG, U) do { const int _t = wid * 64 + lane_id();   \
        _Pragma("unroll") for (int _i = 0; _i < 2; ++_i) { int _R, _C; stage_rc(_t * 16 + _i * 8192, _R, _C); _Pragma("unroll") for (int _h = 0; _h < 2; ++_h) \
        VG[_h][_i] = (unsigned)((U).grow + (U).gi[_h * HALF + _R]) * (unsigned)(lda * 2) + (unsigned)_C * 2u; } } while (0)
    Unit cur, nxt; int ui = 0;
    if (!S.next(0, cur)) return;
    Acc acc;
#pragma unroll
    for (int a = 0; a < 2; ++a)
#pragma unroll
        for (int b = 0; b < 2; ++b)
#pragma unroll
            for (int m = 0; m < 4; ++m)
#pragma unroll
                for (int n = 0; n < 2; ++n) acc[a][b][m][n] = (f32x4){0.f, 0.f, 0.f, 0.f};
    bf16x8 At[4][2], B0[2][2], B1[2][2];
    v8i_t At8[4], B08[2], B18[2];
    unsigned sc8 = 0x7f7f7f7fu; asm volatile("" : "+v"(sc8));
    const char* cA = cur.a; const char* cB = cur.b;
    if constexpr (GATHER) { PG8_GIDX(vgc, cur); } else { vgc[0][0] = vgc[0][1] = vgc[1][0] = vgc[1][1] = 0u; }
    E.prep(cur, wr, wc, fr, fq);
    PG8_STAGE_B(PG8_SB(0, 0), cB); PG8_STAGE_B(PG8_SB(0, 1), cB + hstepB); PG8_STAGE_A(PG8_SA(0, 0), cA, 0, vgc); PG8_STAGE_A(PG8_SA(0, 1), cA, 1, vgc);
    if (wr == 1) PG8_BAR;
    PG8_WAIT_V(2); PG8_BAR;
    PG8_STAGE_B(PG8_SB(1, 0), cB + kstep); PG8_STAGE_A(PG8_SA(1, 0), cA + kstep, 0, vgc); PG8_STAGE_B(PG8_SB(1, 1), cB + hstepB + kstep);
    PG8_WAIT_V(6); PG8_BAR;
    for (;;) {
        const bool has_next = S.next(ui + 1, nxt);
        const char* nA = has_next ? nxt.a : cA; const char* nB = has_next ? nxt.b : cB;
        if constexpr (GATHER) { if (has_next) { PG8_GIDX(vgn, nxt); } else {
#pragma unroll
            for (int h = 0; h < 2; ++h) { vgn[h][0] = vgc[h][0]; vgn[h][1] = vgc[h][1]; } } }
        else { vgn[0][0] = vgn[0][1] = vgn[1][0] = vgn[1][1] = 0u; }
        for (int t = 0; t < nt; t += 2) {
            const bool last = (t == nt - 2);
            const char* a1 = cA + (size_t)(t + 1) * kstep;
            const char* a2 = last ? nA : cA + (size_t)(t + 2) * kstep; const char* b2 = last ? nB : cB + (size_t)(t + 2) * kstep;
            const char* a3 = a2 + kstep; const char* b3 = b2 + kstep;
            if constexpr (Epi::MIDK) { if (t == (nt >> 1)) E.midk(acc); }
            PG8_LDB(B0, 0, 0); PG8_LDB(B1, 0, 1); PG8_SCHED; PG8_LDA(At, 0, 0); PG8_STAGE_A(PG8_SA(1, 1), a1, 1, vgc);
            if constexpr (GATHER) { if (last) {
#pragma unroll
                for (int h = 0; h < 2; ++h) { vgc[h][0] = vgn[h][0]; vgc[h][1] = vgn[h][1]; } } }
            PG8_WAIT_V(8); PG8_WAIT_L(0); PG8_BAR; PG8_MMA(0, 0, At, B0); PG8_MMA(0, 1, At, B1); PG8_BAR; PG8_SCHED;
            PG8_LDA(At, 0, 1); PG8_STAGE_B(PG8_SB(0, 0), b2); PG8_STAGE_B(PG8_SB(0, 1), b2 + hstepB); PG8_STAGE_A(PG8_SA(0, 0), a2, 0, vgc);
            PG8_WAIT_V(8); PG8_WAIT_L(0); PG8_BAR; PG8_MMA(1, 0, At, B0); PG8_MMA(1, 1, At, B1); PG8_BAR; PG8_SCHED;
            PG8_LDB(B0, 1, 0); PG8_LDB(B1, 1, 1); PG8_SCHED; PG8_LDA(At, 1, 0); PG8_STAGE_A(PG8_SA(0, 1), a2, 1, vgc);
            PG8_WAIT_V(8); PG8_WAIT_L(0); PG8_BAR; PG8_MMA(0, 0, At, B0); PG8_MMA(0, 1, At, B1); PG8_BAR; PG8_SCHED;
            PG8_LDA(At, 1, 1); PG8_STAGE_B(PG8_SB(1, 0), b3); PG8_STAGE_B(PG8_SB(1, 1), b3 + hstepB); PG8_STAGE_A(PG8_SA(1, 0), a3, 0, vgc);
            PG8_WAIT_V(8); PG8_WAIT_L(0); PG8_BAR; PG8_MMA(1, 0, At, B0); PG8_MMA(1, 1, At, B1); PG8_BAR; PG8_SCHED;
        }
        if constexpr (ALIGN_EPI) { if (wr == 0) PG8_BAR; }
        if constexpr (FP8) asm volatile("s_nop 15\n\ts_nop 15\n\ts_nop 15\n\ts_nop 15" ::: "memory");
        E(acc, cur, wr, wc, fr, fq);
        if (!has_next) break;
#pragma unroll
        for (int a = 0; a < 2; ++a)
#pragma unroll
            for (int b = 0; b < 2; ++b)
#pragma unroll
                for (int m = 0; m < 4; ++m)
#pragma unroll
                    for (int n = 0; n < 2; ++n) acc[a][b][m][n] = (f32x4){0.f, 0.f, 0.f, 0.f};
        cur = nxt; cA = nA; cB = nB; ++ui;
#pragma unroll
        for (int h = 0; h < 2; ++h) { vgc[h][0] = vgn[h][0]; vgc[h][1] = vgn[h][1]; }
        E.prep(cur, wr, wc, fr, fq);
        if constexpr (ALIGN_EPI) { if (wr == 1) PG8_BAR; }
    }
    PG8_WAIT_V(0);
    if constexpr (!ALIGN_EPI) { if (wr == 0) PG8_BAR; }
    PG8_BAR;
#undef PG8_SA
#undef PG8_SB
#undef PG8_GL
#undef PG8_STAGE_A
#undef PG8_STAGE_B
#undef PG8_LDA
#undef PG8_RD
#undef PG8_LDB
#undef PG8_MMA
#undef PG8_CAT
#undef PG8_WAIT_V
#undef PG8_WAIT_L
#undef PG8_SCHED
#undef PG8_GIDX
}

#define EPI_ROWS for (int ai = 0; ai < 2; ++ai) _Pragma("unroll") for (int m = 0; m < 4; ++m)
__device__ __forceinline__ v4u pack8(const f32x4 a, const f32x4 b) { v4u w; w.x = cvt_pk_bf16(a[0], a[1]); w.y = cvt_pk_bf16(a[2], a[3]); w.z = cvt_pk_bf16(b[0], b[1]); w.w = cvt_pk_bf16(b[2], b[3]); return w; }

__device__ __forceinline__ void st8x2(unsigned char* pa, unsigned char* pb, const v2u a, const v2u b, const int fq, const bool nt) {
    const auto r0 = __builtin_amdgcn_permlane16_swap(a.x, b.x, false, false); const auto r1 = __builtin_amdgcn_permlane16_swap(a.y, b.y, false, false);
    const unsigned x0 = r0[0], x1 = r0[1], y0 = r1[0], y1 = r1[1];
    const v4u w = (v4u){x0, y0, x1, y1};
    unsigned char* p = (fq & 1) ? pb - 8 : pa;
    if (nt) __builtin_nontemporal_store(w, (v4u*)p); else *(v4u*)p = w;
}
template <int mode, bool OUT8 = false>
struct EpiStore {
    static constexpr bool MIDK = false;
    bf16* O; int ldc; const float* cs; float scale; bool skip = false;
    __device__ __forceinline__ void prep(const Unit&, int, int, int, int) {}
    __device__ __forceinline__ void midk(Acc&) {}
    __device__ __forceinline__ void operator()(const Acc& acc, const Unit& u, int wr, int wc, int fr, int fq) const {
        asm volatile("" : "+v"(fr), "+v"(fq));
        if (skip) return;
        size_t base; const float* csp = cs;
        if constexpr (mode == 0) base = (size_t)u.pm * 256 * ldc + (size_t)u.pn * 256;
        else if constexpr (mode == 1) { const int lb = u.pm >> 2, h = u.pm & 3; base = (size_t)lb * D * D + (size_t)(h * 256) * D + u.pn * 256; csp = cs + (size_t)(lb >> 2) * D + u.pn * 256; }
        else if constexpr (mode == 2) { const int pml = u.pm & 3, lbh = u.pm >> 2, h = lbh & 3, lb = lbh >> 2; base = (size_t)lb * D * D + (size_t)(pml * 256) * D + h * 256; }
        else { const int l = u.pm >> 2, pml = u.pm & 3; base = (size_t)l * NMEM * 2 * D + (size_t)(pml * 256) * 2 * D + u.pn * 256; }
        const int cb = wc * 32 + 8 * fq;
        f32x4 c0[2], c1[2];
#pragma unroll
        for (int bj = 0; bj < 2; ++bj) { if (csp) { c0[bj] = *(const f32x4*)(csp + bj * HALF + cb) * scale; c1[bj] = *(const f32x4*)(csp + bj * HALF + cb + 4) * scale; } else { c0[bj] = (f32x4){scale, scale, scale, scale}; c1[bj] = c0[bj]; } }
#pragma unroll
        EPI_ROWS { bf16* rowp = O + base + (size_t)(ai * HALF + wr * 64 + m * 16 + fr) * ldc + cb;
            if constexpr (OUT8) { unsigned char* rp8 = (unsigned char*)O + base + (size_t)(ai * HALF + wr * 64 + m * 16 + fr) * ldc + cb;
#pragma unroll
                for (int bj = 0; bj < 2; ++bj) { const f32x4 a = acc[ai][bj][m][0] * c0[bj], b = acc[ai][bj][m][1] * c1[bj]; v2u o; o.x = pk4_fp8(a[0], a[1], a[2], a[3]); o.y = pk4_fp8(b[0], b[1], b[2], b[3]); *(v2u*)(rp8 + bj * HALF) = o; } }
            else
#pragma unroll
            for (int bj = 0; bj < 2; ++bj) { const v4u w_ = pack8(acc[ai][bj][m][0] * c0[bj], acc[ai][bj][m][1] * c1[bj]); if constexpr (mode == 0 && NT_Y) __builtin_nontemporal_store(w_, (v4u*)(rowp + bj * HALF)); else *(v4u*)(rowp + bj * HALF) = w_; } }
    }
};
struct EpiH {
    static constexpr bool MIDK = false;
    unsigned char* H;
    __device__ __forceinline__ void prep(const Unit&, int, int, int, int) {}
    __device__ __forceinline__ void midk(Acc&) {}
    __device__ __forceinline__ void operator()(const Acc& acc, const Unit& u, int wr, int wc, int fr, int fq) const {
        asm volatile("" : "+v"(fr), "+v"(fq));
        const int cb = u.pn * 128 + wc * 32 + 8 * fq; constexpr float us = 1.0f / (W8S * A8S);
#pragma unroll
        for (int ai = 0; ai < 2; ++ai)
#pragma unroll
            for (int m = 0; m < 4; m += 2) { const int rl = ai * HALF + wr * 64 + m * 16 + fr; unsigned char* rowp = H + (size_t)(u.pm * 256 + rl) * FF + cb;
                v2u o[2];
#pragma unroll
                for (int q = 0; q < 2; ++q) { const f32x4 h0 = silu_mul4(acc[ai][0][m + q][0], acc[ai][1][m + q][0], us, H8S), h1 = silu_mul4(acc[ai][0][m + q][1], acc[ai][1][m + q][1], us, H8S);
                    o[q].x = pk4_fp8(h0[0], h0[1], h0[2], h0[3]); o[q].y = pk4_fp8(h1[0], h1[1], h1[2], h1[3]); }
                st8x2(rowp, rowp + (size_t)16 * FF, o[0], o[1], fq, false); }
    }
};
struct EpiY8 {
    static constexpr bool MIDK = false;
    unsigned char* Y; float scale; bool skip = false, halfst = false;
    __device__ __forceinline__ void prep(const Unit&, int, int, int, int) {}
    __device__ __forceinline__ void midk(Acc&) {}
    __device__ __forceinline__ void operator()(const Acc& acc, const Unit& u, int wr, int wc, int fr, int fq) const {
        if (skip) return;
        asm volatile("" : "+v"(fr), "+v"(fq));
        const int cb = u.pn * 256 + wc * 32 + 8 * fq;
#pragma unroll
        for (int ai = 0; ai < 2; ++ai)
#pragma unroll
            for (int m = 0; m < 4; m += 2) { unsigned char* rp0 = Y + (size_t)(u.pm * 256 + ai * HALF + wr * 64 + m * 16 + fr) * D + cb; unsigned char* rp1 = rp0 + (size_t)16 * D;
#pragma unroll
                for (int bj = 0; bj < 2; ++bj) { v2u o0, o1;
                    { const f32x4 a = acc[ai][bj][m][0] * scale, b = acc[ai][bj][m][1] * scale; o0.x = pk4_fp8(a[0], a[1], a[2], a[3]); o0.y = pk4_fp8(b[0], b[1], b[2], b[3]); }
                    { const f32x4 a = acc[ai][bj][m + 1][0] * scale, b = acc[ai][bj][m + 1][1] * scale; o1.x = pk4_fp8(a[0], a[1], a[2], a[3]); o1.y = pk4_fp8(b[0], b[1], b[2], b[3]); }
                    st8x2(rp0 + bj * HALF, rp1 + bj * HALF, o0, o1, fq, false); } }
    }
};
template <bool MK, bool WRITE_XB>
struct EpiX {
    static constexpr bool MIDK = MK;
    bf16* xr; float* xstat; const float* gmstat; const float* atstat; LAS unsigned char* lds; unsigned char* xa8; float scale;
#if REPK == 2 || REPK == 4
    long wofs = 0;
#else
    static constexpr long wofs = 0;
#endif
    int wr_, wc_, fr_;
    __device__ __forceinline__ void prep(const Unit& u, int wr, int wc, int fr, int fq) {
        wr_ = wr; wc_ = wc; fr_ = fr;
        if constexpr (MK) {
            asm volatile("" : "+v"(fr), "+v"(fq));
            LAS f32x2* X = (LAS f32x2*)(lds + RING_BYTES + 1024) + (wr * 4 + wc) * 128;
#pragma unroll
            EPI_ROWS { const size_t row = (size_t)u.pm * 256 + ai * HALF + wr * 64 + m * 16 + fr;
                const f32x4 g = *(const f32x4*)(gmstat + row * 4), a0 = *(const f32x4*)(atstat + row * 8), a1 = *(const f32x4*)(atstat + row * 8 + 4);
                const float sg = (g[0] + g[1]) + (g[2] + g[3]), sa = ((a0[0] + a0[1]) + (a0[2] + a0[3])) + ((a1[0] + a1[1]) + (a1[2] + a1[3]));
                const float rgm = __builtin_amdgcn_rsqf(sg * (1.0f / 512.0f) + EPS), rat = __builtin_amdgcn_rsqf(sa * (1.0f / 512.0f) + EPS);
                if (fq == 0) X[(ai * 4 + m) * 16 + fr] = (f32x2){rgm / rat, rat}; }
            asm volatile("s_waitcnt lgkmcnt(0)" ::: "memory");
        }
    }
    __device__ __forceinline__ void midk(Acc& acc) {
        int fr = fr_; asm volatile("" : "+v"(fr));
        const LAS f32x2* X = (const LAS f32x2*)(lds + RING_BYTES + 1024) + (wr_ * 4 + wc_) * 128;
#pragma unroll
        EPI_ROWS { const float f = X[(ai * 4 + m) * 16 + fr].x;
#pragma unroll
            for (int bj = 0; bj < 2; ++bj) { acc[ai][bj][m][0] *= f; acc[ai][bj][m][1] *= f; } }
    }
    __device__ __forceinline__ void operator()(const Acc& acc, const Unit& u, int wr, int wc, int fr, int fq) const {
        asm volatile("" : "+v"(fr), "+v"(fq));
        const int cb = u.pn * 256 + wc * 32 + 8 * fq;
        v4u rb[2][4][2];
#define EPX_LOAD(AI) _Pragma("unroll") for (int mm = 0; mm < 4; ++mm) _Pragma("unroll") for (int bj = 0; bj < 2; ++bj) rb[AI][mm][bj] = *(const v4u*)(xr + ((size_t)u.pm * 256 + (AI) * HALF + wr * 64 + mm * 16 + fr) * D + cb + bj * HALF);
        if constexpr (!WRITE_XB) { EPX_LOAD(0) EPX_LOAD(1) }
#pragma unroll
        for (int ai = 0; ai < 2; ++ai) {
            if constexpr (WRITE_XB) { if (ai == 0) { EPX_LOAD(0) } else { EPX_LOAD(1) } }
#pragma unroll
            for (int m = 0; m < 4; m += 2) {
                v2u o8[2][2];
#pragma unroll
                for (int q = 0; q < 2; ++q) { const size_t row = (size_t)u.pm * 256 + ai * HALF + wr * 64 + (m + q) * 16 + fr; const size_t off = row * D + cb;
                    float f = scale; if constexpr (MK) f = ((const LAS f32x2*)(lds + RING_BYTES + 1024) + (wr * 4 + wc) * 128)[(ai * 4 + m + q) * 16 + fr].y; float ss = 0.f;
#pragma unroll
                    for (int bj = 0; bj < 2; ++bj) { const v4u b = rb[ai][m + q][bj];
                        const f32x4 x0 = (f32x4){bflo(b.x), bfhi(b.x), bflo(b.y), bfhi(b.y)} + acc[ai][bj][m + q][0] * f, x1 = (f32x4){bflo(b.z), bfhi(b.z), bflo(b.w), bfhi(b.w)} + acc[ai][bj][m + q][1] * f;
                        *(v4u*)(xr + wofs + off + bj * HALF) = pack8(x0, x1);
                        if constexpr (WRITE_XB) { o8[q][bj].x = pk4_fp8(x0[0] * A8S, x0[1] * A8S, x0[2] * A8S, x0[3] * A8S); o8[q][bj].y = pk4_fp8(x1[0] * A8S, x1[1] * A8S, x1[2] * A8S, x1[3] * A8S);
                            ss += ((x0[0] * x0[0] + x0[1] * x0[1]) + (x0[2] * x0[2] + x0[3] * x0[3])) + ((x1[0] * x1[0] + x1[1] * x1[1]) + (x1[2] * x1[2] + x1[3] * x1[3])); } }
                    if constexpr (WRITE_XB) { ss = add_x32(add_x16(ss)); if (fq == 0) xstat[row * 16 + u.pn * 4 + wc] = ss; } }
                if constexpr (WRITE_XB) { unsigned char* rp = xa8 + ((size_t)u.pm * 256 + ai * HALF + wr * 64 + m * 16 + fr) * D + cb;
#pragma unroll
                    for (int bj = 0; bj < 2; ++bj) st8x2(rp + bj * HALF, rp + (size_t)16 * D + bj * HALF, o8[0][bj], o8[1][bj], fq, false); }
                asm volatile("" ::: "memory"); } }
#undef EPX_LOAD
    }
};
constexpr int EXCH_OFF = RING_BYTES + 1024;
struct EpiS {
    static constexpr bool MIDK = false;
    const float* xstat; unsigned char* P; LAS unsigned char* lds;
    __device__ __forceinline__ void prep(const Unit& u, int wr, int wc, int fr, int fq) {
        asm volatile("" : "+v"(fr), "+v"(fq));
        LAS float* RV = (LAS float*)(lds + EXCH_OFF + 8192) + (wr * 4 + wc) * 128;
#pragma unroll
        EPI_ROWS { const size_t row = (size_t)u.pm * 256 + ai * HALF + wr * 64 + m * 16 + fr;
            const f32x4 s0 = *(const f32x4*)(xstat + row * 16), s1 = *(const f32x4*)(xstat + row * 16 + 4), s2 = *(const f32x4*)(xstat + row * 16 + 8), s3 = *(const f32x4*)(xstat + row * 16 + 12);
            const float ssq = (((s0[0] + s0[1]) + (s0[2] + s0[3])) + ((s1[0] + s1[1]) + (s1[2] + s1[3]))) + (((s2[0] + s2[1]) + (s2[2] + s2[3])) + ((s3[0] + s3[1]) + (s3[2] + s3[3])));
            if (fq == 0) RV[(ai * 4 + m) * 16 + fr] = __builtin_amdgcn_rsqf(ssq * (1.0f / D) + EPS) * (1.0f / (A8S * Q8S)); }
        asm volatile("s_waitcnt lgkmcnt(0)" ::: "memory");
    }
    __device__ __forceinline__ void midk(Acc&) {}
    __device__ __forceinline__ void operator()(Acc& acc, const Unit& u, int wr, int wc, int fr, int fq) const {
        asm volatile("" : "+v"(fr), "+v"(fq));
        LAS f32x2* X = (LAS f32x2*)(lds + EXCH_OFF);
        float mw[2][4];
#pragma unroll
        EPI_ROWS { const int rl = ai * HALF + wr * 64 + m * 16 + fr;
            const float rinv = ((const LAS float*)(lds + EXCH_OFF + 8192) + (wr * 4 + wc) * 128)[(ai * 4 + m) * 16 + fr];
            float mx = -3.0e38f;
#pragma unroll
            for (int bj = 0; bj < 2; ++bj)
#pragma unroll
                for (int n = 0; n < 2; ++n) { acc[ai][bj][m][n] *= rinv; const f32x4 v = acc[ai][bj][m][n]; mx = fmaxf(mx, fmaxf(fmaxf(v[0], v[1]), fmaxf(v[2], v[3]))); }
            mx = max_x32(max_x16(mx));
            float sm = 0.f;
#pragma unroll
            for (int bj = 0; bj < 2; ++bj)
#pragma unroll
                for (int n = 0; n < 2; ++n) { f32x4 v = acc[ai][bj][m][n];
#pragma unroll
                    for (int i = 0; i < 4; ++i) { v[i] = __builtin_amdgcn_exp2f(v[i] - mx); sm += v[i]; }
                    acc[ai][bj][m][n] = v; }
            sm = add_x32(add_x16(sm));
            mw[ai][m] = mx;
            if (fq == 0) X[rl * 4 + wc] = (f32x2){mx, sm};
            if (m & 1) asm volatile("" ::: "memory"); }
        asm volatile("s_waitcnt lgkmcnt(0)\n\ts_barrier" ::: "memory");
        const int cb = u.pn * 256 + wc * 32 + 8 * fq;
#pragma unroll
        for (int ai = 0; ai < 2; ++ai)
#pragma unroll
            for (int m = 0; m < 4; m += 2) { float f[2];
#pragma unroll
                for (int q = 0; q < 2; ++q) { const int rl = ai * HALF + wr * 64 + (m + q) * 16 + fr;
                    const f32x2 e0 = X[rl * 4 + 0], e1 = X[rl * 4 + 1], e2 = X[rl * 4 + 2], e3 = X[rl * 4 + 3];
                    const float M = fmaxf(fmaxf(e0.x, e1.x), fmaxf(e2.x, e3.x));
                    const float den = (e0.y * __builtin_amdgcn_exp2f(e0.x - M) + e1.y * __builtin_amdgcn_exp2f(e1.x - M)) + (e2.y * __builtin_amdgcn_exp2f(e2.x - M) + e3.y * __builtin_amdgcn_exp2f(e3.x - M));
                    f[q] = __builtin_amdgcn_exp2f(mw[ai][m + q] - M) * __builtin_amdgcn_rcpf(den) * P8S; }
                unsigned char* rp = P + ((size_t)u.pm * 256 + ai * HALF + wr * 64 + m * 16 + fr) * D + cb;
#pragma unroll
                for (int bj = 0; bj < 2; ++bj) { v2u o[2];
#pragma unroll
                    for (int q = 0; q < 2; ++q) { const f32x4 a = acc[ai][bj][m + q][0] * f[q], b = acc[ai][bj][m + q][1] * f[q]; o[q].x = pk4_fp8(a[0], a[1], a[2], a[3]); o[q].y = pk4_fp8(b[0], b[1], b[2], b[3]); }
                    st8x2(rp + bj * HALF, rp + (size_t)16 * D + bj * HALF, o[0], o[1], fq, false); } }
        asm volatile("s_waitcnt lgkmcnt(0)" ::: "memory");
    }
};
struct EpiIn {
    static constexpr bool MIDK = false;
    bf16 *uact, *vact, *q, *k, *v; float* vstat; const float *qg, *kg, *cosT, *sinT, *rinv; bool nostore = false, skip = false;
    __device__ __forceinline__ void prep(const Unit&, int, int, int, int) {}
    __device__ __forceinline__ void midk(Acc&) {}
    __device__ __forceinline__ void operator()(const Acc& acc, const Unit& u, int wr, int wc, int fr, int fq) const {
        asm volatile("" : "+v"(fr), "+v"(fq));
        if (skip) return;
        const int pn = u.pn;
        if (pn < 4) {
            bf16* O = pn < 2 ? uact : vact; const int cb = (pn & 1) * 256 + wc * 32 + 8 * fq;
#pragma unroll
            EPI_ROWS { const size_t row = (size_t)u.pm * 256 + ai * HALF + wr * 64 + m * 16 + fr; float ss = 0.f; const float ri = rinv[row];
#pragma unroll
                for (int bj = 0; bj < 2; ++bj) { const f32x4 g0 = gelu4(acc[ai][bj][m][0] * ri), g1 = gelu4(acc[ai][bj][m][1] * ri);
                    const v4u w = pack8(g0, g1); st16(O + row * GMW + cb + bj * HALF, w, nostore);
                    if (pn >= 2) { const float a0 = bflo(w.x), a1 = bfhi(w.x), a2 = bflo(w.y), a3 = bfhi(w.y), a4 = bflo(w.z), a5 = bfhi(w.z), a6 = bflo(w.w), a7 = bfhi(w.w);
                        ss += ((a0 * a0 + a1 * a1) + (a2 * a2 + a3 * a3)) + ((a4 * a4 + a5 * a5) + (a6 * a6 + a7 * a7)); } }
                if (pn >= 2) { ss = add_x32(add_x16(ss)); if (fq == 0) vstat[row * 8 + (pn - 2) * 4 + wc] = ss; } }
        } else if (pn == 6 && wc >= 2) {
#pragma unroll
            EPI_ROWS { const size_t row = (size_t)u.pm * 256 + ai * HALF + wr * 64 + m * 16 + fr; const float ri = rinv[row];
#pragma unroll
                for (int bj = 0; bj < 2; ++bj) st16(v + row * 128 + (wc - 2) * 64 + bj * 32 + 8 * fq, pack8(acc[ai][bj][m][0] * ri, acc[ai][bj][m][1] * ri), nostore); }
        } else {
            const bool isq = pn < 6; const float* g = isq ? qg : kg; const float sc = isq ? QSCALE : 1.0f;
            bf16* O = isq ? q + ((pn - 4) * 4 + wc) * 64 : k + wc * 64; const int ldo = isq ? 512 : 128;
            f32x4 gv[2][2];
#pragma unroll
            for (int bj = 0; bj < 2; ++bj) { gv[bj][0] = *(const f32x4*)(g + bj * 32 + 8 * fq) * sc; gv[bj][1] = *(const f32x4*)(g + bj * 32 + 8 * fq + 4) * sc; }
#pragma unroll
            EPI_ROWS { const size_t row = (size_t)u.pm * 256 + ai * HALF + wr * 64 + m * 16 + fr; const int t = (int)(row % SEQ); const float ri = this->rinv[row];
                float ss = 0.f;
#pragma unroll
                for (int bj = 0; bj < 2; ++bj)
#pragma unroll
                    for (int n = 0; n < 2; ++n) { const f32x4 x = acc[ai][bj][m][n]; ss += (x[0] * x[0] + x[1] * x[1]) + (x[2] * x[2] + x[3] * x[3]); }
                ss = add_x32(add_x16(ss));
                const float rinv = ri * __builtin_amdgcn_rsqf(ss * (ri * ri) * (1.0f / 64.0f) + EPS);
#pragma unroll
                for (int bj = 0; bj < 2; ++bj) { const f32x4 c = *(const f32x4*)(cosT + t * 32 + bj * 16 + 4 * fq), sn = *(const f32x4*)(sinT + t * 32 + bj * 16 + 4 * fq);
                    const f32x4 x0 = acc[ai][bj][m][0] * gv[bj][0] * rinv, x1 = acc[ai][bj][m][1] * gv[bj][1] * rinv; f32x4 o0, o1;
                    o0[0] = x0[0] * c[0] - x0[1] * sn[0]; o0[1] = x0[0] * sn[0] + x0[1] * c[0]; o0[2] = x0[2] * c[1] - x0[3] * sn[1]; o0[3] = x0[2] * sn[1] + x0[3] * c[1];
                    o1[0] = x1[0] * c[2] - x1[1] * sn[2]; o1[1] = x1[0] * sn[2] + x1[1] * c[2]; o1[2] = x1[2] * c[3] - x1[3] * sn[3]; o1[3] = x1[2] * sn[3] + x1[3] * c[3];
                    st16(O + row * ldo + bj * 32 + 8 * fq, pack8(o0, o1), nostore); }
                if (m & 1) asm volatile("" ::: "memory"); }
        }
    }
};
}


struct CvtJob { const float* W; const float* gain; bf16* WT; int K, N, dst_row0, k0, n0; bool f8; };
__device__ __forceinline__ CvtJob cvt_decode(const Frame& F, int it) {
    constexpr int I_IN = 16 * 56, I_SQ = 512, I_KV = 1024, I_HEAD = I_IN + I_SQ + I_KV + I_SQ, I_LAYER = I_HEAD + NE * 3 * I_SQ;
    CvtJob j; j.f8 = false; const int l = it / I_LAYER; int r = it % I_LAYER;
    if (r < I_IN) { const int kb = r / 56, nb = r % 56, n0 = nb * 32, pn = n0 >> 8; int dr = n0;
        if (pn >= 4) { const int sidx = n0 & 255, w = sidx >> 6, bj = (sidx >> 5) & 1; dr = pn * 256 + 128 * bj + 32 * w; }
        j.W = F.in[3] + (size_t)l * D * INW; j.gain = F.in[2] + (size_t)l * D; j.WT = (bf16*)(F.ws + WS_WIN) + (size_t)l * INW * D; j.K = D; j.N = INW; j.dst_row0 = dr; j.k0 = kb * 64; j.n0 = n0; return j; }
    r -= I_IN;
    if (r < I_SQ) { j.W = F.in[10] + (size_t)l * D * D; j.gain = F.in[9] + (size_t)l * D; j.WT = (bf16*)(F.ws + WS_WOUT) + (size_t)l * D * D; j.K = D; j.N = D; j.dst_row0 = (r % 32) * 32; j.k0 = (r / 32) * 64; j.n0 = (r % 32) * 32; return j; }
    r -= I_SQ;
    if (r < I_KV) { j.W = F.in[14] + (size_t)l * D * 2 * D; j.gain = nullptr; j.WT = (bf16*)(F.ws + WS_WKVT) + (size_t)l * 2 * D * D; j.K = D; j.N = 2 * D; j.dst_row0 = (r % 64) * 32; j.k0 = (r / 64) * 64; j.n0 = (r % 64) * 32; return j; }
    r -= I_KV;
    if (r < I_SQ) { j.W = F.in[15] + (size_t)l * D * D; j.gain = nullptr; j.WT = (bf16*)(F.ws + WS_WOT) + (size_t)l * D * D; j.K = D; j.N = D; j.dst_row0 = (r % 32) * 32; j.k0 = (r / 32) * 64; j.n0 = (r % 32) * 32; return j; }
    r -= I_SQ;
    const int e = r / (3 * I_SQ), rr = r % (3 * I_SQ), which = rr / I_SQ, sub = rr % I_SQ, kb = sub / 32, n0 = (sub % 32) * 32;
    const size_t mo = ((size_t)l * NE + e) * D * FF;
    j.K = D; j.N = FF; j.k0 = kb * 64; j.n0 = n0;
    j.f8 = true;
    if (which == 2) { j.W = F.in[20] + mo; j.gain = nullptr; j.WT = (bf16*)(F.ws + WS_WD + mo); j.dst_row0 = n0; }
    else { j.W = (which == 0 ? F.in[18] : F.in[19]) + mo; j.gain = F.in[16] + (size_t)l * D; j.WT = (bf16*)(F.ws + WS_WGU + 2 * mo); j.dst_row0 = 256 * (n0 >> 7) + 128 * which + (n0 & 127); }
    return j;
}
#define CVT_LOAD(J, R) do { const float* p_ = (J).W + (size_t)((J).k0 + (lane_ >> 5)) * (J).N + (J).n0 + (lane_ & 31); _Pragma("unroll") for (int i_ = 0; i_ < 32; ++i_) R[i_] = __builtin_nontemporal_load(p_ + (size_t)(2 * i_) * (J).N); } while (0)
#ifndef CVT_DEFER_E
#define CVT_DEFER_E 8
#endif
#ifndef CVT_DEFER_A
#define CVT_DEFER_A 3
#endif
constexpr int CVT_I_LAYER = 16 * 56 + 512 + 1024 + 512 + NE * 3 * 512, CVT_ND = CVT_DEFER_E * 3 * 512, CVT_NDA = CVT_DEFER_A * 3 * 512;
constexpr int CVT_N1 = CVT_I_LAYER - CVT_ND, CVT_N2 = CVT_I_LAYER - CVT_ND - CVT_NDA;
constexpr int CVT_NPRO = CVT_I_LAYER + (NL > 1 ? CVT_N1 : 0) + (NL > 2 ? (NL - 2) * CVT_N2 : 0);
__device__ __forceinline__ int cvt_map(int L, int part, int i) {
    if (L >= 1) return L * CVT_I_LAYER + (part ? CVT_N1 : CVT_N2) + i;
    if (i < CVT_I_LAYER) return i;
    int j = i - CVT_I_LAYER; if (j < CVT_N1) return CVT_I_LAYER + j;
    j -= CVT_N1; const int l = 2 + j / CVT_N2, r = j % CVT_N2; return l * CVT_I_LAYER + r;
}
__device__ __forceinline__ void cvt_items(Frame& F, const int L, const int part, const int gw, const int NGW) {
    int lane_ = lane_id(); asm volatile("" : "+v"(lane_));
    LAS float* scr = (LAS float*)(F.lds + F.wave * 16384);
    const int NITEMS = L >= 1 ? (part ? CVT_ND : CVT_NDA) : CVT_NPRO;
    if (gw < NITEMS) {
        int it = gw; CvtJob cur = cvt_decode(F, cvt_map(L, part, it)); float r[32]; CVT_LOAD(cur, r);
        for (;;) {
            const int nit = it + NGW; const bool hn = nit < NITEMS; CvtJob nx = cur; if (hn) nx = cvt_decode(F, cvt_map(L, part, nit));
#pragma unroll
            for (int i = 0; i < 32; ++i) scr[(2 * i + (lane_ >> 5)) * 33 + (lane_ & 31)] = r[i];
            if (hn) CVT_LOAD(nx, r);
            asm volatile("s_waitcnt lgkmcnt(0)" ::: "memory");
            const int c = lane_ & 7;
            f32x4 g0 = (f32x4){1.f, 1.f, 1.f, 1.f}, g1 = g0;
            if (cur.gain) { g0 = *(const f32x4*)(cur.gain + cur.k0 + 8 * c); g1 = *(const f32x4*)(cur.gain + cur.k0 + 8 * c + 4); }
#pragma unroll
            for (int j = 0; j < 4; ++j) { const int n = (lane_ >> 3) + 8 * j; const LAS float* sp = scr + (8 * c) * 33 + n;
                if (cur.f8) { v2u o; o.x = pk4_fp8(sp[0 * 33] * g0[0] * W8S, sp[1 * 33] * g0[1] * W8S, sp[2 * 33] * g0[2] * W8S, sp[3 * 33] * g0[3] * W8S); o.y = pk4_fp8(sp[4 * 33] * g1[0] * W8S, sp[5 * 33] * g1[1] * W8S, sp[6 * 33] * g1[2] * W8S, sp[7 * 33] * g1[3] * W8S);
                    *(v2u*)((unsigned char*)cur.WT + (size_t)(cur.dst_row0 + n) * cur.K + cur.k0 + 8 * c) = o; }
                else { v4u o; o.x = pk2(sp[0 * 33] * g0[0], sp[1 * 33] * g0[1]); o.y = pk2(sp[2 * 33] * g0[2], sp[3 * 33] * g0[3]); o.z = pk2(sp[4 * 33] * g1[0], sp[5 * 33] * g1[1]); o.w = pk2(sp[6 * 33] * g1[2], sp[7 * 33] * g1[3]);
                    *(v4u*)(cur.WT + (size_t)(cur.dst_row0 + n) * cur.K + cur.k0 + 8 * c) = o; } }
            asm volatile("s_waitcnt lgkmcnt(0)" ::: "memory");
            if (!hn) break; cur = nx; it = nit;
        }
    }
}
__device__ __forceinline__ void ph_convert(Frame& F) {
    int lane_ = lane_id(); asm volatile("" : "+v"(lane_)); const int tid_ = F.wave * 64 + lane_;
    cvt_items(F, -1, 0, F.vcu * NWAVES + F.wave, F.G * NWAVES);
    {   const float* wsrc = F.in[5]; bf16* WSBd = (bf16*)(F.ws + WS_WSB);
        for (int i = F.vcu * NTHR + tid_; i < NL * 4 * 128 * 128 / 8; i += F.G * NTHR) { const f32x4 a = *(const f32x4*)(wsrc + (size_t)i * 8), b = *(const f32x4*)(wsrc + (size_t)i * 8 + 4);
            v4u o; o.x = pk2(a.x, a.y); o.y = pk2(a.z, a.w); o.z = pk2(b.x, b.y); o.w = pk2(b.z, b.w); *(v4u*)(WSBd + (size_t)i * 8) = o; } }
    {   bf16* WRH = (bf16*)(F.ws + WS_WRH); bf16* WRL = (bf16*)(F.ws + WS_WRL);
        for (int i = F.vcu * NTHR + tid_; i < NL * NE * D; i += F.G * NTHR) { const int l = i / (NE * D), e = (i / D) % NE, c = i % D;
            const float w = F.in[17][((size_t)l * D + c) * NE + e] * F.in[16][(size_t)l * D + c]; const unsigned h = f2bf(w); WRH[i] = (bf16)h; WRL[i] = (bf16)f2bf(w - bf2f(h)); } }
    const int gt = F.vcu * NTHR + tid_, NGT = F.G * NTHR;
    const float* wq = F.in[13]; bf16* WQB = (bf16*)(F.ws + WS_WQB);
    for (int i = gt; i < NL * D * D / 8; i += NGT) { const f32x4 a = *(const f32x4*)(wq + (size_t)i * 8), b = *(const f32x4*)(wq + (size_t)i * 8 + 4);
        v4u o; o.x = pk2(a.x, a.y); o.y = pk2(a.z, a.w); o.z = pk2(b.x, b.y); o.w = pk2(b.z, b.w); *(v4u*)(WQB + (size_t)i * 8) = o; }
}

struct SchedDense {
    pg8::TileOrder o; const char* A; size_t a_tile; const char* B; size_t b_tile, b_batch; int bdiv, bmod;
    __device__ __forceinline__ bool next(int i, pg8::Unit& u) const { if (!o.tile(i, u.pm, u.pn)) return false;
        u.z = 0; u.gi = nullptr; u.grow = 0; u.a = A + (size_t)u.pm * a_tile; u.b = B + (size_t)((u.pm / bdiv) % bmod) * b_batch + (size_t)u.pn * b_tile; return true; }
};
struct SchedE1 {
    pg8::TileOrder o; const char* HBp; const int* IDX; const char* WGU;
    __device__ __forceinline__ bool next(int i, pg8::Unit& u) const { if (!o.tile(i, u.pm, u.pn)) return false;
        const int z = u.pm >> 2; u.z = z; u.gi = IDX + (size_t)u.pm * 256; u.grow = (z >> 4) * SEQ; u.a = HBp;
        u.b = WGU + (size_t)(z & 15) * (2 * FF * D) + (size_t)u.pn * (256 * D); return true; }
};
struct SchedKV { pg8::TileOrder o; const char* MEMN; const char* WKVT; int pm0 = 0;
    __device__ __forceinline__ bool next(int i, pg8::Unit& u) const { if (!o.tile(i, u.pm, u.pn)) return false; u.pm += pm0; u.z = 0; u.gi = nullptr; u.grow = 0;
        u.a = MEMN + (size_t)(u.pm & 3) * (256 * D * 2); u.b = WKVT + (size_t)(u.pm >> 2) * (2 * D * D * 2) + (size_t)u.pn * (256 * D * 2); return true; } };
struct SchedQK { pg8::TileOrder o; const char* KVM; const char* WQB; int pm0 = 0;
    __device__ __forceinline__ bool next(int i, pg8::Unit& u) const { if (!o.tile(i, u.pm, u.pn)) return false; u.pm += pm0; u.z = 0; u.gi = nullptr; u.grow = 0;
        const int h = u.pm & 3, lb = u.pm >> 2, b = lb & 3, l = lb >> 2;
        u.a = KVM + ((size_t)l * NMEM * 2 * D + (size_t)(b * 256) * 2 * D + h * 256) * 2; u.b = WQB + ((size_t)l * D * D + (size_t)u.pn * 256 * D + h * 256) * 2; return true; } };
struct SchedVO { pg8::TileOrder o; const char* KVM; const char* WOT; int pm0 = 0;
    __device__ __forceinline__ bool next(int i, pg8::Unit& u) const { if (!o.tile(i, u.pm, u.pn)) return false; u.pm += pm0; u.z = 0; u.gi = nullptr; u.grow = 0;
        const int pml = u.pm & 3, lbh = u.pm >> 2, h = lbh & 3, lb = lbh >> 2, b = lb & 3, l = lb >> 2;
        u.a = WOT + ((size_t)l * D * D + (size_t)pml * 256 * D + h * 256) * 2; u.b = KVM + ((size_t)l * NMEM * 2 * D + (size_t)(b * 256) * 2 * D + D + h * 256) * 2; return true; } };

namespace attn_body {
#if REPK == 300 || REPK == 301 || REPK == 302
#ifndef PROBE_WAVE
#define PROBE_WAVE 0
#endif
#define ATS_PROBE ((blockIdx.x == 0) ? (unsigned*)((char*)ATS - WS_ATSTAT + WS_CTL + 64) : (unsigned*)nullptr)
#endif
using bf16=__hip_bfloat16;
using bf16x8=__attribute__((ext_vector_type(8)))short;
using s16x4=__attribute__((ext_vector_type(4)))short;
using f32x16=__attribute__((ext_vector_type(16)))float;
using u32x4=__attribute__((ext_vector_type(4)))unsigned;
constexpr int SEQ=8192,D=64,QP=512,KP=128,OP=1024;
constexpr int NW=8,QBLK=32,QB=QBLK*NW,KVBLK=64,NQB=SEQ/QB;
constexpr int ATTN_UNIT_ROWS=QB;
__device__ __forceinline__ int crow(int r,int hi){return (r&3)+8*(r>>2)+4*hi;}
#define SBAR() __builtin_amdgcn_sched_barrier(0)
__device__ __forceinline__ void cmask(f32x16&p0,f32x16&p1,int jb,int qrel,int hi){
  const float NEG=-INFINITY; int kb=64*jb+4*hi;
  #pragma unroll
  for(int r=0;r<16;++r){int kv=kb+(r&3)+8*(r>>2); if(kv>qrel)p0[r]=NEG; if(kv+32>qrel)p1[r]=NEG;}
}

constexpr int NSLOT=3, SLOTB=8192;
constexpr int LDS_K=0, LDS_V=NSLOT*SLOTB, LDS_WS=2*NSLOT*SLOTB, LDS_OST=LDS_WS+NW*64*4, LDS_BYTES=LDS_OST+NW*4096;
constexpr float C2=0.125f*1.4426950408889634f;
__device__ __forceinline__ void glds16(const void*gsrc,unsigned lds_dst){unsigned keep;
  asm volatile("s_mov_b32 %0, m0\n\ts_mov_b32 m0, %2\n\ts_nop 0\n\tglobal_load_lds_dwordx4 %1, off\n\ts_mov_b32 m0, %0":"=&s"(keep):"v"(gsrc),"s"(lds_dst):"memory");}
__device__ __forceinline__ float max3f(float a,float b,float c){float r;asm("v_max3_f32 %0, %1, %2, %3":"=v"(r):"v"(a),"v"(b),"v"(c));return r;}
__device__ __forceinline__ float max2f(float a,float b){float r;asm("v_max_f32_e32 %0, %1, %2":"=v"(r):"v"(a),"v"(b));return r;}
__device__ __forceinline__ float fadd_s(float a,float b){float r;asm("v_add_f32_e32 %0, %1, %2":"=v"(r):"v"(a),"v"(b));return r;}
__device__ __forceinline__ float fsub_s(float a,float b){float r;asm("v_sub_f32_e32 %0, %1, %2":"=v"(r):"v"(a),"v"(b));return r;}
typedef float f32x2_t __attribute__((ext_vector_type(2))); typedef __bf16 bf16x2_t __attribute__((ext_vector_type(2)));
__device__ __forceinline__ unsigned cvtpk_s(float lo,float hi){f32x2_t v={lo,hi};bf16x2_t b=__builtin_convertvector(v,bf16x2_t);return __builtin_bit_cast(unsigned,b);}
#define WAIT_BAR(N) asm volatile("s_waitcnt vmcnt(" #N ") lgkmcnt(0)\n\ts_barrier":::"memory")

__device__ __forceinline__ void qkt(f32x16&p0,f32x16&p1,const char*Kslot,const bf16x8*qr,const f32x16&negm,int r32,int hi){
  const char*kb=Kslot+hi*1024+r32*16;
  #pragma unroll
  for(int d0=0;d0<4;++d0){
    const bf16x8 b0=*reinterpret_cast<const bf16x8*>(kb+d0*2048);
    const bf16x8 b1=*reinterpret_cast<const bf16x8*>(kb+d0*2048+512);
    if(d0==0){p0=__builtin_amdgcn_mfma_f32_32x32x16_bf16(b0,qr[0],negm,0,0,0);p1=__builtin_amdgcn_mfma_f32_32x32x16_bf16(b1,qr[0],negm,0,0,0);}
    else{p0=__builtin_amdgcn_mfma_f32_32x32x16_bf16(b0,qr[d0],p0,0,0,0);p1=__builtin_amdgcn_mfma_f32_32x32x16_bf16(b1,qr[d0],p1,0,0,0);}}
}
typedef __attribute__((address_space(3))) const char* lds_cptr;
typedef short v4i16_t __attribute__((ext_vector_type(4)));
__device__ __forceinline__ void kload8(bf16x8*kf,lds_cptr kp){
  kf[0]=*(const __attribute__((address_space(3))) bf16x8*)(kp);      kf[1]=*(const __attribute__((address_space(3))) bf16x8*)(kp+512);
  kf[2]=*(const __attribute__((address_space(3))) bf16x8*)(kp+2048); kf[3]=*(const __attribute__((address_space(3))) bf16x8*)(kp+2560);
  kf[4]=*(const __attribute__((address_space(3))) bf16x8*)(kp+4096); kf[5]=*(const __attribute__((address_space(3))) bf16x8*)(kp+4608);
  kf[6]=*(const __attribute__((address_space(3))) bf16x8*)(kp+6144); kf[7]=*(const __attribute__((address_space(3))) bf16x8*)(kp+6656);
}
__device__ __forceinline__ void kload2(bf16x8*kf,lds_cptr kp,int j){ kf[2*j]=*(const __attribute__((address_space(3))) bf16x8*)(kp+j*2048); kf[2*j+1]=*(const __attribute__((address_space(3))) bf16x8*)(kp+j*2048+512); }
__device__ __forceinline__ s16x4 vtr(lds_cptr p){ return __builtin_bit_cast(s16x4,__builtin_amdgcn_ds_read_tr16_b64_v4i16((__attribute__((address_space(3))) v4i16_t*)p)); }
__device__ __forceinline__ float rowmax(const f32x16&p0,const f32x16&p1){
  float a=max3f(p0[0],p0[1],p1[0]),b=max3f(p0[2],p0[3],p1[1]);a=max3f(a,p1[2],p1[3]);
  #pragma unroll
  for(int r=4;r<16;r+=4){a=max3f(a,p0[r],p0[r+1]);b=max3f(b,p0[r+2],p0[r+3]);a=max3f(a,p1[r],p1[r+1]);b=max3f(b,p1[r+2],p1[r+3]);}
  const float m=max2f(a,b);
  auto rr=__builtin_amdgcn_permlane32_swap(__float_as_uint(m),__float_as_uint(m),false,false);
  return max2f(__uint_as_float(rr[0]),__uint_as_float(rr[1]));
}
__device__ __forceinline__ void pv(f32x16*o,int vb,bf16x8 pa0,bf16x8 pa1,bf16x8 pa2,bf16x8 pa3){
  #pragma unroll
  for(int d0=0;d0<2;++d0){s16x4 lo[4],hi[4];
    #pragma unroll
    for(int ks=0;ks<4;++ks){
      asm volatile("ds_read_b64_tr_b16 %0,%1 offset:%c2":"=&v"(lo[ks]):"v"(vb),"i"(d0*4096+ks*1024):"memory");
      asm volatile("ds_read_b64_tr_b16 %0,%1 offset:%c2":"=&v"(hi[ks]):"v"(vb),"i"(d0*4096+ks*1024+512):"memory");}
    asm volatile("s_waitcnt lgkmcnt(0)":::"memory");SBAR();
    #define PK(k) (bf16x8){lo[k][0],lo[k][1],lo[k][2],lo[k][3],hi[k][0],hi[k][1],hi[k][2],hi[k][3]}
    o[d0]=__builtin_amdgcn_mfma_f32_32x32x16_bf16(pa0,PK(0),o[d0],0,0,0);
    o[d0]=__builtin_amdgcn_mfma_f32_32x32x16_bf16(pa1,PK(1),o[d0],0,0,0);
    o[d0]=__builtin_amdgcn_mfma_f32_32x32x16_bf16(pa2,PK(2),o[d0],0,0,0);
    o[d0]=__builtin_amdgcn_mfma_f32_32x32x16_bf16(pa3,PK(3),o[d0],0,0,0);
    #undef PK
  }
}

#ifndef ATTN_STORE16
#define ATTN_STORE16(p,v) (*(u32x4*)(p)=(v))
#endif
template<int THRL,bool STATIC_REF,bool LSUM> __device__ __forceinline__ void attn_unit(int b,int h,int qb,const bf16*Q,const bf16*__restrict__ K,const bf16*__restrict__ V,bf16*O,float*ATS,char*shm,int wave_idx,float refB){
  int lane; asm volatile("v_mbcnt_lo_u32_b32 %0, -1, 0\n\tv_mbcnt_hi_u32_b32 %0, -1, %0":"=v"(lane)); const int r32=lane&31,hi=lane>>5; const int wid=wave_idx; const int kvh=h>>2;
  const long rowbase=(long)b*SEQ; const int q0=qb*QB;
  const bf16*Qw=Q+(rowbase+q0+wid*QBLK)*QP+h*D;
  const bf16*Kh=K+rowbase*KP+kvh*D,*Vh=V+rowbase*KP+kvh*D;
  const unsigned lds0=(unsigned)(uintptr_t)shm;
  float*wsf=(float*)(shm+LDS_WS)+wid*64;
  const bf16*ksrc=Kh+(long)lane*KP+wid*8;
  const bf16*vsrc=Vh+(long)(16*(wid&3)+(lane>>2))*KP+(wid>>2)*32+(lane&3)*8;
  const unsigned kdst=lds0+LDS_K+wid*1024, vdst=lds0+LDS_V+wid*1024;
  #define DMA_K(t,slot) glds16(ksrc+(long)(t)*KVBLK*KP,(unsigned)__builtin_amdgcn_readfirstlane(kdst+(slot)))
  #define DMA_V(t,slot) glds16(vsrc+(long)(t)*KVBLK*KP,(unsigned)__builtin_amdgcn_readfirstlane(vdst+(slot)))
  const int vb0=(int)(lds0+LDS_V)+((lane>>4)&1)*32+(lane&3)*8+(4*hi+((lane&15)>>2))*64;
  const char*Kbase=shm+LDS_K; bf16x8 kf[8];
  const lds_cptr shm3=(lds_cptr)shm; const lds_cptr kp0=shm3+LDS_K+hi*1024+r32*16; const lds_cptr vp0=shm3+LDS_V+((lane>>4)&1)*32+(lane&3)*8+(4*hi+((lane&15)>>2))*64;
  const int NT=SEQ/KVBLK;
  DMA_K(0,0);DMA_V(0,0);DMA_K(1,SLOTB);
  bf16x8 qr[4];
  #pragma unroll
  for(int d0=0;d0<4;++d0)qr[d0]=*reinterpret_cast<const bf16x8*>(&Qw[(long)r32*QP+d0*16+hi*8]);
  float mhat=0.f,l_reg=0.f;f32x16 o[2];o[0]=f32x16{};o[1]=f32x16{};f32x16 negm=f32x16{};
  if constexpr(STATIC_REF){ _Pragma("unroll") for(int r=0;r<16;++r)negm[r]=-refB; }
  asm volatile("":"+v"(negm));
  f32x16 lblk=f32x16{}; unsigned one2_; asm volatile("v_mov_b32 %0, 0x3f803f80":"=v"(one2_)); const bf16x8 ones8=__builtin_bit_cast(bf16x8,(u32x4){one2_,one2_,one2_,one2_});
  const int qrel=wid*QBLK+r32;
  #define CMASK(P0,P1,t) do{}while(0)
  bool resc=false;
  #define START(P0,P1) do{ if constexpr(!STATIC_REF){ const float rm=rowmax(P0,P1); resc=false; \
    { const float dl=rm; mhat=fadd_s(mhat,dl); \
      _Pragma("unroll") for(int r=0;r<16;++r){P0[r]=fsub_s(P0[r],dl);P1[r]=fsub_s(P1[r],dl);} \
      _Pragma("unroll") for(int r=0;r<16;++r)negm[r]=-mhat; asm volatile("":"+v"(negm)); } } \
    _Pragma("unroll") for(int r=0;r<16;++r)P0[r]=__builtin_amdgcn_exp2f(P0[r]); }while(0)
  #define RESC() do{ if constexpr(!STATIC_REF) if(resc){ asm volatile("s_waitcnt lgkmcnt(0)":::"memory"); \
      _Pragma("unroll") for(int d_=0;d_<2;++d_) _Pragma("unroll") for(int r=0;r<16;++r)o[d_][r]*=wsf[crow(r,hi)]; } }while(0)
  f32x16 pA0,pA1,pB0,pB1;
  int sl_prev=0,sl_cur=0,sl_next=SLOTB;
  #define ROT() do{sl_prev=sl_cur;sl_cur=sl_next;sl_next=(sl_next==(NSLOT-1)*SLOTB)?0:sl_next+SLOTB;}while(0)
  DMA_K(2,2*SLOTB);
  WAIT_BAR(3);
  qkt(pA0,pA1,Kbase,qr,negm,r32,hi);asm volatile("s_nop 15\n\ts_nop 7":"+v"(pA0),"+v"(pA1));CMASK(pA0,pA1,0);
  START(pA0,pA1);
  _Pragma("unroll") for(int r=0;r<16;++r)pA1[r]=__builtin_amdgcn_exp2f(pA1[r]);
  WAIT_BAR(0);
  DMA_K(3,0);DMA_V(1,SLOTB);
  ROT();
  kload8(kf,kp0+sl_cur);
  WAIT_BAR(2);
  asm volatile("":"+v"(kf[0]),"+v"(kf[1]),"+v"(kf[2]),"+v"(kf[3]),"+v"(kf[4]),"+v"(kf[5]),"+v"(kf[6]),"+v"(kf[7]));
  s16x4 vlo[8],vhi[8]; u32x4 pw0,pw1,pw2,pw3;
  #define PKW(P,B) cvtpk_s(P[B],P[B+1])
  #define PAF(k) __builtin_bit_cast(bf16x8,pw##k)
  #define VFR(i) (bf16x8){vlo[i][0],vlo[i][1],vlo[i][2],vlo[i][3],vhi[i][0],vhi[i][1],vhi[i][2],vhi[i][3]}
  #define PIN(x) asm volatile("":"+v"(x))
  #define MX3(a,b,c) __builtin_fmaxf(__builtin_fmaxf((a),(b)),(c))
  #define GAPA(MF,A0,A1,A2,A3,W0,W1,PW) do{ MF; if constexpr(!LSUM){ sacc+=A0; sacc+=A1; sacc+=A2; sacc+=A3; PIN(sacc); } W0; W1; PIN(PW); SBAR(); }while(0)
  #define GAPA2(MF,A0,A1,W0,W1,PW) do{ MF; if constexpr(!LSUM){ sacc+=A0; sacc+=A1; PIN(sacc); } W0; W1; PIN(PW); SBAR(); }while(0)
  #define LSM(k) do{ if constexpr(LSUM){ lblk=__builtin_amdgcn_mfma_f32_32x32x16_bf16(PAF(k),ones8,lblk,0,0,0); SBAR(); } }while(0)
  #define EX(v) __builtin_amdgcn_exp2f(v)
  #define GAPB(MF,X,B) do{ MF; X[B]=EX(X[B]); X[B+1]=EX(X[B+1]); X[B+2]=EX(X[B+2]); X[B+3]=EX(X[B+3]); PIN(X); SBAR(); }while(0)
  #define VRD(i) do{ vlo[i]=vtr(vp_+(((i)>>2)*4096+((i)&3)*1024)); vhi[i]=vtr(vp_+(((i)>>2)*4096+((i)&3)*1024+512)); }while(0)
  #define KRD(G,j) do{ if(G){ kload2(kf,kp0+sl_next,j); SBAR(); } }while(0)
  #define PINKF() asm volatile("":"+v"(kf[0]),"+v"(kf[1]),"+v"(kf[2]),"+v"(kf[3]),"+v"(kf[4]),"+v"(kf[5]),"+v"(kf[6]),"+v"(kf[7]))
  #define STEP(C0,C1,P0,P1,t,GK,GV,GL) do{ SBAR(); \
    const lds_cptr vp_=vp0+sl_prev; \
    VRD(0); SBAR(); float sacc=0.f; if constexpr(!LSUM) sacc=(P0[0]+P0[1]); \
    GAPA(C0=__builtin_amdgcn_mfma_f32_32x32x16_bf16(kf[0],qr[0],negm,0,0,0), P0[2],P0[3],P0[4],P0[5],     pw0[0]=PKW(P0,0), pw0[1]=PKW(P0,2), pw0); \
    VRD(4); SBAR(); GAPA(C1=__builtin_amdgcn_mfma_f32_32x32x16_bf16(kf[1],qr[0],negm,0,0,0), P0[6],P0[7],P0[8],P0[9],     pw0[2]=PKW(P0,4), pw0[3]=PKW(P0,6), pw0); \
    VRD(1); SBAR(); GAPA(C0=__builtin_amdgcn_mfma_f32_32x32x16_bf16(kf[2],qr[1],C0,0,0,0),   P0[10],P0[11],P0[12],P0[13], pw1[0]=PKW(P0,8), pw1[1]=PKW(P0,10), pw1); \
    VRD(5); SBAR(); GAPA(C1=__builtin_amdgcn_mfma_f32_32x32x16_bf16(kf[3],qr[1],C1,0,0,0),   P0[14],P0[15],P1[0],P1[1],   pw1[2]=PKW(P0,12),pw1[3]=PKW(P0,14), pw1); \
    VRD(2); SBAR(); GAPA(C0=__builtin_amdgcn_mfma_f32_32x32x16_bf16(kf[4],qr[2],C0,0,0,0),   P1[2],P1[3],P1[4],P1[5],     pw2[0]=PKW(P1,0), pw2[1]=PKW(P1,2), pw2); \
    VRD(6); SBAR(); GAPA(C1=__builtin_amdgcn_mfma_f32_32x32x16_bf16(kf[5],qr[2],C1,0,0,0),   P1[6],P1[7],P1[8],P1[9],     pw2[2]=PKW(P1,4), pw2[3]=PKW(P1,6), pw2); \
    VRD(3); SBAR(); GAPA(C0=__builtin_amdgcn_mfma_f32_32x32x16_bf16(kf[6],qr[3],C0,0,0,0),   P1[10],P1[11],P1[12],P1[13], pw3[0]=PKW(P1,8), pw3[1]=PKW(P1,10), pw3); \
    VRD(7); SBAR(); GAPA2(C1=__builtin_amdgcn_mfma_f32_32x32x16_bf16(kf[7],qr[3],C1,0,0,0),  P1[14],P1[15],               pw3[2]=PKW(P1,12),pw3[3]=PKW(P1,14), pw3); \
    l_reg+=sacc; \
    if(GK){DMA_K((t)+3,sl_cur);} if(GV){DMA_V((t)+1,sl_next);} \
    CMASK(C0,C1,t); \
    if constexpr(!STATIC_REF){ float a=MX3(C0[0],C0[1],C1[0]),b=MX3(C0[2],C0[3],C1[1]); a=MX3(a,C1[2],C1[3]); \
      _Pragma("unroll") for(int r=4;r<16;r+=4){a=MX3(a,C0[r],C0[r+1]);b=MX3(b,C0[r+2],C0[r+3]);a=MX3(a,C1[r],C1[r+1]);b=MX3(b,C1[r+2],C1[r+3]);} \
      float rm=__builtin_fmaxf(a,b); { auto rr=__builtin_amdgcn_permlane32_swap(__float_as_uint(rm),__float_as_uint(rm),false,false); rm=__builtin_fmaxf(__uint_as_float(rr[0]),__uint_as_float(rr[1])); } \
      resc=false; \
      if(__builtin_expect(__any(rm>(float)THRL),0)){ const float dl=__builtin_fmaxf(rm,0.f); mhat+=dl; \
        _Pragma("unroll") for(int r=0;r<16;++r){C0[r]-=dl;C1[r]-=dl;} \
        _Pragma("unroll") for(int r=0;r<16;++r)negm[r]=-mhat; asm volatile("":"+v"(negm)); \
        const float f=__builtin_amdgcn_exp2f(-dl); l_reg*=f; if(hi==0)wsf[r32]=f; resc=true; } } \
    SBAR(); \
    GAPB(o[0]=__builtin_amdgcn_mfma_f32_32x32x16_bf16(PAF(0),VFR(0),o[0],0,0,0), C0,0); \
    GAPB(o[1]=__builtin_amdgcn_mfma_f32_32x32x16_bf16(PAF(0),VFR(4),o[1],0,0,0), C0,4); \
    LSM(0); KRD(GL,0); GAPB(o[0]=__builtin_amdgcn_mfma_f32_32x32x16_bf16(PAF(1),VFR(1),o[0],0,0,0), C0,8); \
    KRD(GL,1); GAPB(o[1]=__builtin_amdgcn_mfma_f32_32x32x16_bf16(PAF(1),VFR(5),o[1],0,0,0), C0,12); \
    LSM(1); KRD(GL,2); GAPB(o[0]=__builtin_amdgcn_mfma_f32_32x32x16_bf16(PAF(2),VFR(2),o[0],0,0,0), C1,0); \
    KRD(GL,3); GAPB(o[1]=__builtin_amdgcn_mfma_f32_32x32x16_bf16(PAF(2),VFR(6),o[1],0,0,0), C1,4); \
    LSM(2); GAPB(o[0]=__builtin_amdgcn_mfma_f32_32x32x16_bf16(PAF(3),VFR(3),o[0],0,0,0), C1,8); \
    GAPB(o[1]=__builtin_amdgcn_mfma_f32_32x32x16_bf16(PAF(3),VFR(7),o[1],0,0,0), C1,12); LSM(3); \
    }while(0)
  int t=1;
#if REPK == 302
  unsigned long long tc0_, tr0_; asm volatile("s_memtime %0\n\ts_memrealtime %1\n\ts_waitcnt lgkmcnt(0)":"=s"(tc0_),"=s"(tr0_)::"memory");
#endif
#if REPK == 300 || REPK == 301
  unsigned tw_acc=0u; unsigned long long tu0; asm volatile("s_memtime %0\n\ts_waitcnt lgkmcnt(0)":"=s"(tu0)::"memory");
  #if REPK == 300
  #define WAIT_BAR_T() do{ unsigned long long a_,b_; asm volatile("s_waitcnt vmcnt(2) lgkmcnt(0)\n\ts_memtime %0\n\ts_barrier\n\ts_memtime %1\n\ts_waitcnt lgkmcnt(0)":"=s"(a_),"=s"(b_)::"memory"); tw_acc+=(unsigned)(b_-a_); }while(0)
  #else
  #define WAIT_BAR_T() do{ unsigned long long a_,b_; asm volatile("s_memtime %0\n\ts_waitcnt vmcnt(2) lgkmcnt(0)\n\ts_memtime %1\n\ts_barrier\n\ts_waitcnt lgkmcnt(0)":"=s"(a_),"=s"(b_)::"memory"); tw_acc+=(unsigned)(b_-a_); }while(0)
  #endif
#else
  #define WAIT_BAR_T() WAIT_BAR(2)
#endif
  for(;t+5<NT;t+=2){
    STEP(pB0,pB1,pA0,pA1,t,true,true,true);     WAIT_BAR_T(); PINKF(); RESC(); ROT();
    STEP(pA0,pA1,pB0,pB1,t+1,true,true,true);   WAIT_BAR_T(); PINKF(); RESC(); ROT();
  }
#if REPK == 302
  { unsigned long long tc1_, tr1_; asm volatile("s_memtime %0\n\ts_memrealtime %1\n\ts_waitcnt lgkmcnt(0)":"=s"(tc1_),"=s"(tr1_)::"memory");
    if(ATS_PROBE&&wave_idx==0&&lane==0){ atomicAdd(ATS_PROBE,(unsigned)(tc1_-tc0_)); atomicAdd(ATS_PROBE+1,(unsigned)(tr1_-tr0_)*30u); } }
#endif
#if REPK == 300 || REPK == 301
  { unsigned long long tu1; asm volatile("s_memtime %0\n\ts_waitcnt lgkmcnt(0)":"=s"(tu1)::"memory");
    if(ATS_PROBE&&wave_idx==PROBE_WAVE&&lane==0){ atomicAdd(ATS_PROBE,tw_acc); atomicAdd(ATS_PROBE+1,(unsigned)(tu1-tu0)); } }
#endif
  #undef WAIT_BAR_T
  #define ENDW(tt) do{ if((tt)+3<NT){WAIT_BAR(2);} else if((tt)+2<NT){WAIT_BAR(1);} else {WAIT_BAR(0);} }while(0)
  for(;t+1<NT;t+=2){
    STEP(pB0,pB1,pA0,pA1,t,(t+3<NT),(t+1<NT),(t+1<NT));       ENDW(t);   RESC(); ROT();
    STEP(pA0,pA1,pB0,pB1,t+1,(t+4<NT),(t+2<NT),(t+2<NT));     ENDW(t+1); RESC(); ROT();
  }
  STEP(pB0,pB1,pA0,pA1,NT-1,false,false,false); RESC();
  { if constexpr(!LSUM){ float sacc=pB0[0]+pB0[1]; _Pragma("unroll") for(int r=2;r<16;++r)sacc+=pB0[r]; _Pragma("unroll") for(int r=0;r<16;++r)sacc+=pB1[r]; l_reg+=sacc; }
    pw0=(u32x4){PKW(pB0,0),PKW(pB0,2),PKW(pB0,4),PKW(pB0,6)};pw1=(u32x4){PKW(pB0,8),PKW(pB0,10),PKW(pB0,12),PKW(pB0,14)};pw2=(u32x4){PKW(pB1,0),PKW(pB1,2),PKW(pB1,4),PKW(pB1,6)};pw3=(u32x4){PKW(pB1,8),PKW(pB1,10),PKW(pB1,12),PKW(pB1,14)};
    SBAR(); pv(o,vb0+sl_cur,PAF(0),PAF(1),PAF(2),PAF(3)); LSM(0); LSM(1); LSM(2); LSM(3); }
  #undef PKW
  #undef PAF
  #undef VFR
  #undef PIN
  #undef MX3
  #undef GAPA
  #undef GAPA2
  #undef LSM
  #undef GAPB
  #undef EX
  #undef VRD
  #undef KRD
  #undef PINKF
  #undef STEP
  #undef ENDW
  float rli[16];
  if constexpr(LSUM){ asm volatile("s_nop 15\n\ts_nop 7":"+v"(lblk));
    #pragma unroll
    for(int r=0;r<16;++r)rli[r]=__builtin_amdgcn_rcpf(lblk[r]); }
  else{
  {auto rr=__builtin_amdgcn_permlane32_swap(__float_as_uint(l_reg),__float_as_uint(l_reg),false,false);l_reg=__uint_as_float(rr[0])+__uint_as_float(rr[1]);}
  if(hi==0)wsf[32+r32]=l_reg;asm volatile("s_waitcnt lgkmcnt(0)":::"memory");
  #pragma unroll
  for(int r=0;r<16;++r)rli[r]=__builtin_amdgcn_rcpf(wsf[32+crow(r,hi)]); }
  bf16*Ow=O+(rowbase+q0+wid*QBLK)*OP+512+h*D; float*ATw=ATS+(rowbase+q0+wid*QBLK)*8+h;
  { bf16*stg=(bf16*)(shm+LDS_OST)+wid*2048;
    #pragma unroll
    for(int r=0;r<16;++r){const int orow=crow(r,hi);
      #pragma unroll
      for(int d0=0;d0<2;++d0)stg[orow*64+d0*32+r32]=__float2bfloat16(o[d0][r]*rli[r]);}
    asm volatile("s_waitcnt lgkmcnt(0)":::"memory");
    #pragma unroll
    for(int i=0;i<4;++i){const int row=i*8+(lane>>3),ch=lane&7; const u32x4 v=*(const u32x4*)(stg+row*64+ch*8); ATTN_STORE16(Ow+(long)row*OP+ch*8,v);
      float ss=0.f;
      #pragma unroll
      for(int q=0;q<4;++q){const float lo=__uint_as_float(v[q]<<16),hh=__uint_as_float(v[q]&0xffff0000u);ss+=lo*lo+hh*hh;}
      ss=sum_row8(ss); if(ch==0)ATw[(long)row*8]=ss;} }
  asm volatile("s_waitcnt lgkmcnt(0)\n\ts_barrier":::"memory");
  #undef DMA_K
  #undef DMA_V
  #undef CMASK
  #undef START
  #undef RESC
  #undef ROT
}
constexpr int ATTN_LDS_BYTES=LDS_BYTES;
#undef SBAR
#undef WAIT_BAR
}

__global__ void __launch_bounds__(NTHR, 2) mega(Args args) {
    extern __shared__ __attribute__((aligned(16))) unsigned char lds[];
    Frame F;
    F.lds = (LAS unsigned char*)lds;
    F.wave = __builtin_amdgcn_readfirstlane(threadIdx.x >> 6);
    F.G = gridDim.x; { const int bx = blockIdx.x; F.vcu = (F.G % 8 == 0) ? (bx % 8) * (F.G / 8) + bx / 8 : bx; }
#pragma unroll
    for (int i = 0; i < 22; ++i) F.in[i] = args.in[i];
    F.ws = args.ws; F.xres = args.out;
    volatile LAS unsigned* MISC = (volatile LAS unsigned*)(F.lds + MISC_OFF);
    for (int u = threadIdx.x; u < (LDS_BYTES - LDSCTL_OFF) / 4; u += NTHR) ((LAS unsigned*)(F.lds + LDSCTL_OFF))[u] = 0u;
    __syncthreads();
    const int lo = args.ph_lo, hi = args.ph_hi;
    unsigned* barw = (unsigned*)(F.ws + WS_CTL) + CW_BAR + args.bar_region * XCD_BAR_WORDS;
    XcdBarrier bar; bar.bar = barw; bar.x = 0; bar.st = nullptr;
    if (hi - lo > 1) { bar = xcd_barrier_post(barw, MISC + 8); map_check_post((unsigned*)(F.ws + WS_CTL)); }
#ifndef ONLY_K
#define ONLY_K -1
#endif
#define EN(kind) (ONLY_K < 0 || ONLY_K == (kind))
#ifndef ALIGN_A
#define ALIGN_A true
#endif
#ifndef ATTN_LSUM
#define ATTN_LSUM false
#endif
#ifndef ALIGN_IN
#define ALIGN_IN true
#endif
#ifndef ALIGN_E1
#define ALIGN_E1 true
#endif
#define IN(k) (lo <= (k) && (k) < hi)

#define PROBE_TOP(k) for (int rep_ = 0; rep_ < (REPK == (k) ? 2 : 1); ++rep_) {
#define PROBE_END(k) if (REPK == (k) && rep_ == 0) xcd_barrier(bar); }
#if REPK == 310
#ifndef PROBE_SEAM
#define PROBE_SEAM -1
#endif
#define SEAM_SEL(k) (PROBE_SEAM < 0 || (PROBE_SEAM == 10 ? (k) < PH_LAYER0 : ((k) >= PH_LAYER0 && ((k) - PH_LAYER0) % PH_PER_LAYER == PROBE_SEAM)))
    if (threadIdx.x == 0) { MISC[12] = 0u; MISC[13] = (unsigned)__builtin_amdgcn_s_memrealtime(); }
#define SEAM(k) do { if (IN(k) && IN((k) + 1)) { unsigned t0_ = 0u; \
        if (threadIdx.x == 0) { t0_ = (unsigned)__builtin_amdgcn_s_memrealtime(); \
            if ((k) == PH_END - 2) { unsigned* pc_ = (unsigned*)(F.ws + WS_CTL + 64); atomicAdd(pc_, MISC[12]); if (blockIdx.x == 0) atomicAdd(pc_ + 1, (t0_ - MISC[13]) * gridDim.x); } } \
        xcd_barrier(bar); \
        if (threadIdx.x == 0 && SEAM_SEL(k)) MISC[12] += (unsigned)__builtin_amdgcn_s_memrealtime() - t0_; } } while (0)
#define SEAMG(k) SEAM(k)
#else
#define SEAM(k) do { if (IN(k) && IN((k) + 1)) { xcd_barrier(bar); if (REPK == 200) xcd_barrier(bar); } } while (0)
#ifndef GROUP_SEAMS
#define GROUP_SEAMS 1
#endif
#define GRP_OK() (GROUP_SEAMS && F.G == 256 && (hi - lo > 1) && MISC[15] == 1u)
#define SEAMG(k) do { if (IN(k) && IN((k) + 1)) { if (GRP_OK()) xcdl_barrier((unsigned*)(F.ws + WS_CTL), bar); else xcd_barrier(bar); } } while (0)
#endif
    const int cid0 = (int)blockIdx.x; const int cid = cid0;
    if (EN(100) && IN(0)) { asm volatile("; PHASE_MARK P0"); PROBE_TOP(100) ph_rows0(F); PROBE_END(100) }
    if (EN(101) && IN(1)) { asm volatile("; PHASE_MARK P1"); PROBE_TOP(101) ph_convert(F); PROBE_END(101) } SEAM(1);
    if (threadIdx.x == 0) MISC[15] = (xb_ld((unsigned*)(F.ws + WS_CTL) + CW_MAPBAD) == 0u) ? 1u : 2u;
    __syncthreads();

#define RUN_KV(GG, CC) do { SchedKV S_; S_.o.init(NL * 4, 8, (GG), (CC)); S_.MEMN = (const char*)(F.ws + WS_MEMN); S_.WKVT = (const char*)(F.ws + WS_WKVT); \
        pg8::EpiStore<3> E_{(bf16*)(F.ws + WS_KVM), 2 * D, nullptr, 1.0f}; pg8::gemm_phase<pg8::EpiStore<3>, SchedKV, true, false>(F.lds, F.wave, D, D, D, S_, E_); } while (0)
#define RUN_QK(LL, GG, CC) do { SchedQK S_; S_.o.init(16, 4, (GG), (CC)); S_.pm0 = (LL) * 16; S_.KVM = (const char*)(F.ws + WS_KVM); S_.WQB = (const char*)(F.ws + WS_WQB); \
        pg8::EpiStore<1, true> E_{(bf16*)(F.ws + WS_QKT), D, F.in[11], XQSCALE * Q8S}; int la_ = 2 * D, lb_ = D, kk_ = 256; asm volatile("" : "+s"(la_), "+s"(lb_), "+s"(kk_)); \
        pg8::gemm_phase<pg8::EpiStore<1, true>, SchedQK, true, false>(F.lds, F.wave, la_, lb_, kk_, S_, E_); } while (0)
#define RUN_VO(LL, GG, CC) do { SchedVO S_; S_.o.init(64, 1, (GG), (CC)); S_.pm0 = (LL) * 64; S_.KVM = (const char*)(F.ws + WS_KVM); S_.WOT = (const char*)(F.ws + WS_WOT); \
        pg8::EpiStore<2, true> E_{(bf16*)(F.ws + WS_VOT), D, nullptr, V8S}; int la_ = D, lb_ = 2 * D, kk_ = 256; asm volatile("" : "+s"(la_), "+s"(lb_), "+s"(kk_)); \
        pg8::gemm_phase<pg8::EpiStore<2, true>, SchedVO, true, false>(F.lds, F.wave, la_, lb_, kk_, S_, E_); } while (0)
    for (int l = 0; l < NL; ++l) {
        const int pb = PH_LAYER0 + PH_PER_LAYER * l;
        int cid = cid0; asm volatile("" : "+s"(cid));
        if (EN(0) && IN(pb + 0)) { asm volatile("; PHASE_MARK L0"); for (int rep_ = 0; rep_ < ((REPK == 0 || REPK == 91 || REPK == 92) ? 2 : 1); ++rep_) {
            SchedDense S; S.o.init(T / 256, 7, F.G, cid); S.A = (const char*)(F.ws + WS_XR); S.a_tile = 256 * D * 2; S.B = (const char*)(F.ws + WS_WIN) + (size_t)l * INW * D * 2; S.b_tile = 256 * D * 2; S.b_batch = 0; S.bdiv = 1; S.bmod = 1;
            pg8::EpiIn E{(bf16*)(F.ws + WS_UACT), (bf16*)(F.ws + WS_VACT), (bf16*)(F.ws + WS_Q), (bf16*)(F.ws + WS_K), (bf16*)(F.ws + WS_V), (float*)(F.ws + WS_VSTAT),
                         F.in[7] + (size_t)l * 64, F.in[8] + (size_t)l * 64, (const float*)(F.ws + WS_ROPE), (const float*)(F.ws + WS_ROPE) + SEQ * 32, (const float*)(F.ws + WS_RINV)}; E.nostore = (REPK == 91 && rep_ == 0); E.skip = (REPK == 92 && rep_ == 0);
            pg8::gemm_phase<pg8::EpiIn, SchedDense, ALIGN_IN, false>(F.lds, F.wave, D, D, D, S, E);
            if ((REPK != 0 && REPK != 91 && REPK != 92) || rep_ == 1) { const int Gh = F.G >> 1;
                if (cid >= Gh) { if (l == 0) RUN_KV(F.G - Gh, cid - Gh); else { RUN_QK(l, F.G - Gh, cid - Gh); RUN_VO(l, F.G - Gh, cid - Gh);
                    if (CVT_NDA > 0 && l + 1 < NL) { __syncthreads(); cvt_items(F, l + 1, 0, (cid - Gh) * NWAVES + F.wave, (F.G - Gh) * NWAVES); } } } }
        if ((REPK == 0 || REPK == 91 || REPK == 92) && rep_ == 0) xcd_barrier(bar); } } SEAM(pb + 0);
        if (EN(1) && IN(pb + 1)) { asm volatile("; PHASE_MARK L1");
            float refB; { const int ln = lane_id(); float mq = fabsf(F.in[7][(size_t)l * 64 + ln]), mk = fabsf(F.in[8][(size_t)l * 64 + ln]); mq = max_x32(max_x16(max_row16(mq))); mk = max_x32(max_x16(max_row16(mk)));
                          refB = 8.0f * LOG2E * 1.02f * mq * mk; refB = __builtin_bit_cast(float, __builtin_amdgcn_readfirstlane(__builtin_bit_cast(int, refB))); }
            if (l == 0) { RUN_QK(0, F.G, cid); RUN_VO(0, F.G, (cid + (F.G >> 1)) % F.G); }
            PROBE_TOP(11)
            for (int it = 0; ; ++it) { const int w = it * F.G + F.vcu; if (w >= NB_ * 8 * (SEQ / 256)) break;
                const int i = w >> 8, c = w & 255, x = c >> 5, j = c & 31;
                if (refB < 60.0f) attn_body::attn_unit<8, true, ATTN_LSUM>(x >> 1, (x & 1) * 4 + i, j, (const attn_body::bf16*)(F.ws + WS_Q), (const attn_body::bf16*)(F.ws + WS_K), (const attn_body::bf16*)(F.ws + WS_V),
                                        (attn_body::bf16*)(F.ws + WS_MERGED), (float*)(F.ws + WS_ATSTAT), (char*)lds, F.wave, refB);
                else attn_body::attn_unit<8, false, false>(x >> 1, (x & 1) * 4 + i, j, (const attn_body::bf16*)(F.ws + WS_Q), (const attn_body::bf16*)(F.ws + WS_K), (const attn_body::bf16*)(F.ws + WS_V),
                                        (attn_body::bf16*)(F.ws + WS_MERGED), (float*)(F.ws + WS_ATSTAT), (char*)lds, F.wave, refB); }
            PROBE_END(11)
            PROBE_TOP(12) ph_gmlp(F, l); PROBE_END(12) } SEAM(pb + 1);
        if (EN(2) && IN(pb + 2)) { asm volatile("; PHASE_MARK L2"); PROBE_TOP(2)
            SchedDense S; S.o.init(T / 256, 4, F.G, cid); S.A = (const char*)(F.ws + WS_MERGED); S.a_tile = 256 * D * 2; S.B = (const char*)(F.ws + WS_WOUT) + (size_t)l * D * D * 2; S.b_tile = 256 * D * 2; S.b_batch = 0; S.bdiv = 1; S.bmod = 1;
            pg8::EpiX<true, true> E; E.xr = (bf16*)(F.ws + WS_XR); E.xstat = (float*)(F.ws + WS_XSTAT); E.gmstat = (const float*)(F.ws + WS_GMSTAT); E.atstat = (const float*)(F.ws + WS_ATSTAT); E.lds = F.lds; E.xa8 = F.ws + WS_XR8; E.scale = 1.0f;
#if REPK == 2
            if (rep_ == 0) E.wofs = (long)(WS_NSCR - WS_XR) / 2;
#endif
            pg8::gemm_phase<pg8::EpiX<true, true>, SchedDense, ALIGN_A, false>(F.lds, F.wave, D, D, D, S, E);
        PROBE_END(2) } SEAMG(pb + 2);
        if (EN(3) && IN(pb + 3)) { asm volatile("; PHASE_MARK L3"); PROBE_TOP(3)
            SchedDense S; S.o.init(T / 256, 4, F.G, cid); S.A = (const char*)(F.ws + WS_XR8); S.a_tile = 256 * D; S.B = (const char*)(F.ws + WS_QKT) + (size_t)l * NB_ * D * D; S.b_tile = 256 * D; S.b_batch = (size_t)D * D; S.bdiv = SEQ / 256; S.bmod = NB_;
            pg8::EpiS E{(const float*)(F.ws + WS_XSTAT), F.ws + WS_P, F.lds};
            int kq = D / 2; asm volatile("" : "+s"(kq));
            pg8::gemm_phase<pg8::EpiS, SchedDense, true, false, true>(F.lds, F.wave, kq, kq, kq, S, E);
        PROBE_END(3) } SEAMG(pb + 3);
        if (EN(4) && IN(pb + 4)) { asm volatile("; PHASE_MARK L4"); PROBE_TOP(4)
            SchedDense S; S.o.init(T / 256, 4, F.G, cid); S.A = (const char*)(F.ws + WS_P); S.a_tile = 256 * D; S.B = (const char*)(F.ws + WS_VOT) + (size_t)l * NB_ * D * D; S.b_tile = 256 * D; S.b_batch = (size_t)D * D; S.bdiv = SEQ / 256; S.bmod = NB_;
            pg8::EpiX<false, false> E; E.xr = (bf16*)(F.ws + WS_XR); E.xstat = nullptr; E.gmstat = nullptr; E.atstat = nullptr; E.lds = F.lds; E.xa8 = nullptr; E.scale = 1.0f / (P8S * V8S);
#if REPK == 4
            if (rep_ == 0) E.wofs = (long)(WS_NSCR - WS_XR) / 2;
#endif
            int kq = D / 2; asm volatile("" : "+s"(kq));
            pg8::gemm_phase<pg8::EpiX<false, false>, SchedDense, ALIGN_A, false, true>(F.lds, F.wave, kq, kq, kq, S, E);
        PROBE_END(4) } SEAMG(pb + 4);
        if (EN(5) && IN(pb + 5)) { asm volatile("; PHASE_MARK L5"); PROBE_TOP(5) ph_router(F, l); PROBE_END(5) } SEAM(pb + 5);
        if (EN(6) && IN(pb + 6)) { asm volatile("; PHASE_MARK L6"); PROBE_TOP(6) ph_topk(F);
            if (CVT_ND > 0 && l + 1 < NL && F.vcu >= NB_ * NE && F.G > NB_ * NE) cvt_items(F, l + 1, 1, (F.vcu - NB_ * NE) * NWAVES + F.wave, (F.G - NB_ * NE) * NWAVES);
            PROBE_END(6) } SEAM(pb + 6);
        if (EN(7) && IN(pb + 7)) { asm volatile("; PHASE_MARK L7"); PROBE_TOP(7)
            SchedE1 S; S.o.init(NB_ * NE * 4, 8, F.G, cid); S.HBp = (const char*)(F.ws + WS_XR8); S.IDX = (const int*)(F.ws + WS_IDX); S.WGU = (const char*)(F.ws + WS_WGU) + (size_t)l * NE * 2 * FF * D;
            pg8::EpiH E{F.ws + WS_H};
            int kq = D / 2; asm volatile("" : "+s"(kq));
            pg8::gemm_phase<pg8::EpiH, SchedE1, ALIGN_E1, true, true>(F.lds, F.wave, kq, kq, kq, S, E);
        PROBE_END(7) } SEAM(pb + 7);
        if (EN(8) && IN(pb + 8)) { asm volatile("; PHASE_MARK L8"); for (int rep_ = 0; rep_ < ((REPK == 8 || REPK == 81 || REPK == 82) ? 2 : 1); ++rep_) {
            SchedDense S; S.o.init(NB_ * NE * 4, 4, F.G, cid); S.A = (const char*)(F.ws + WS_H); S.a_tile = 256 * FF; S.B = (const char*)(F.ws + WS_WD) + (size_t)l * NE * D * FF; S.b_tile = 256 * FF; S.b_batch = (size_t)D * FF; S.bdiv = 4; S.bmod = NE;
            pg8::EpiY8 E{F.ws + WS_Y, Y8S / (H8S * W8S)}; E.skip = (REPK == 81 && rep_ == 0); E.halfst = (REPK == 82 && rep_ == 0);
            int kq = FF / 2; asm volatile("" : "+s"(kq));
            pg8::gemm_phase<pg8::EpiY8, SchedDense, ALIGN_A, false, true>(F.lds, F.wave, kq, kq, kq, S, E);
        if ((REPK == 8 || REPK == 81 || REPK == 82) && rep_ == 0) xcd_barrier(bar); } } SEAM(pb + 8);
        if (EN(9) && IN(pb + 9)) { asm volatile("; PHASE_MARK L9"); PROBE_TOP(9) ph_combine(F, l, REPK == 9 && rep_ == 0); PROBE_END(9) } SEAM(pb + 9);
    }
#undef IN
#undef SEAM
}

static int g_grid = 0;
static void launch_mega(Args a, int lo, int hi, int region, hipStream_t stream) {
    a.ph_lo = lo; a.ph_hi = hi; a.bar_region = region; a.pad = 0;
    hipLaunchKernelGGL(mega, dim3(g_grid), dim3(NTHR), LDS_BYTES, stream, a);
}
extern "C" void kernel_launch(void* const* d_in, const int* in_sizes, int n_in, void* d_out, int out_size, void* d_ws, size_t ws_size, hipStream_t stream) {
    if (g_grid == 0) {
        if (n_in != 22 || out_size != T * D || ws_size < WS_END) { fprintf(stderr, "kernel_launch: unexpected sizes n_in %d out %d ws %zu\n", n_in, out_size, ws_size); g_grid = -1; return; }
        int dev = 0, cus = 0;
        if (hipGetDevice(&dev) != hipSuccess || hipDeviceGetAttribute(&cus, hipDeviceAttributeMultiprocessorCount, dev) != hipSuccess) { g_grid = -1; return; }
        if (hipFuncSetAttribute((const void*)mega, hipFuncAttributeMaxDynamicSharedMemorySize, LDS_BYTES) != hipSuccess) { g_grid = -1; return; }
        int per_cu = 0;
        if (hipOccupancyMaxActiveBlocksPerMultiprocessor(&per_cu, (const void*)mega, NTHR, LDS_BYTES) != hipSuccess || per_cu < 1) fprintf(stderr, "kernel_launch: occupancy query says %d\n", per_cu);
        (void)hipGetLastError();
        g_grid = cus;
    }
    if (g_grid < 0) return;
    hipMemsetAsync((char*)d_ws + WS_CTL, 0, CTL_ZERO_BYTES, stream);
    Args a{};
    for (int i = 0; i < 22; ++i) a.in[i] = (const float*)d_in[i];
    a.out = (float*)d_out; a.ws = (unsigned char*)d_ws;
    launch_mega(a, 0, PH_END, 0, stream);
}
```

```cpp
#ifndef PROBE_SCALE
#define PROBE_SCALE 0.5f
#endif
#ifndef PROBE_Q
#define PROBE_Q 25.0f
#endif
#ifndef PROBE_QOFF
#define PROBE_QOFF 0.0f
#endif
#ifndef ROUTER_HANDOFF
#define ROUTER_HANDOFF 1
#endif
#ifndef REPK
#define REPK -1
#endif
#include <hip/hip_runtime.h>
#include <hip/hip_bf16.h>
#include <cstdio>
#include <cstdint>
#include <cmath>

constexpr int NB_ = 4, SEQ = 8192, T = NB_ * SEQ, D = 1024, NL = 4;
constexpr int MEML = 256, NMEM = NB_ * MEML;
constexpr int INW = 1792, GMW = 512, NE = 16, CAP = 1024, FF = 1024;
constexpr float EPS = 1e-6f;
constexpr float LOG2E = 1.4426950408889634f;
constexpr float QSCALE = 0.125f * LOG2E;
constexpr float XQSCALE = 0.0625f * LOG2E;
constexpr float W8S = 256.0f, A8S = 16.0f, H8S = 8.0f, Y8S = 32.0f;
constexpr float Q8S = 512.0f, P8S = 256.0f, V8S = 64.0f;

constexpr size_t MiB = 1u << 20;
constexpr size_t WS_CTL = 0, CTL_ZERO_BYTES = 1 * MiB;
constexpr size_t WS_ROPE = 1 * MiB;
constexpr size_t WS_AFF = 3 * MiB;
constexpr size_t WS_INV = 5 * MiB;
constexpr size_t WS_IDX = 7 * MiB;
constexpr size_t WS_VSTAT = 8 * MiB;
constexpr size_t WS_ATSTAT = 9 * MiB;
constexpr size_t WS_GMSTAT = 10 * MiB;
constexpr size_t WS_RINV = 10 * MiB + 512 * 1024;
constexpr size_t WS_RINV2 = 10 * MiB + 768 * 1024;
constexpr size_t WS_XSTAT = 11 * MiB;
constexpr size_t WS_MEMN = 13 * MiB;
constexpr size_t WS_WSB = 15 * MiB;
constexpr size_t WS_WRH = 15 * MiB + 512 * 1024, WS_WRL = WS_WRH + 128 * 1024;
constexpr size_t WS_WIN = 16 * MiB;
constexpr size_t WS_WOUT = 30 * MiB;
constexpr size_t WS_QKT = 38 * MiB;
constexpr size_t WS_VOT = 70 * MiB;
constexpr size_t WS_WGU = 102 * MiB;
constexpr size_t WS_WD = 358 * MiB;
constexpr size_t WS_XR = 486 * MiB;
constexpr size_t WS_R1 = 550 * MiB;
constexpr size_t WS_UACT = WS_R1, WS_VACT = WS_R1 + 32 * MiB, WS_Q = WS_R1 + 64 * MiB, WS_K = WS_R1 + 96 * MiB, WS_V = WS_R1 + 104 * MiB;
constexpr size_t WS_WQB = 230 * MiB, WS_WOT = 238 * MiB, WS_WKVT = 246 * MiB, WS_KVM = 262 * MiB;
constexpr size_t WS_H = WS_R1;
constexpr size_t WS_MERGED = 678 * MiB;
constexpr size_t WS_XR8 = 742 * MiB;
constexpr size_t WS_P = WS_R1;
constexpr size_t WS_Y = 678 * MiB;
constexpr size_t WS_NSCR = 806 * MiB;
constexpr size_t WS_END = 808 * MiB;

constexpr int CW_TMO = 0, CW_CODE = 1, CW_GMQ = 1024  , CW_RTQ = 1536  , CW_CVQ = 2560  , CW_BAR = 4096;

#define GAS __attribute__((address_space(1)))
#define LAS __attribute__((address_space(3)))
typedef unsigned short bf16;
typedef unsigned v4u __attribute__((ext_vector_type(4)));
typedef unsigned v2u __attribute__((ext_vector_type(2)));
typedef float f32x4 __attribute__((ext_vector_type(4)));
typedef short bf16x8_t __attribute__((ext_vector_type(8)));
typedef GAS unsigned gu32;
#define RLX_AGENT __ATOMIC_RELAXED, __HIP_MEMORY_SCOPE_AGENT
__device__ __forceinline__ unsigned f2bf(float f) { unsigned u = __builtin_bit_cast(unsigned, f); return (u + 0x7fffu + ((u >> 16) & 1u)) >> 16; }
__device__ __forceinline__ unsigned pk2(float lo, float hi) { return f2bf(lo) | (f2bf(hi) << 16); }
__device__ __forceinline__ float bf2f(unsigned v) { return __builtin_bit_cast(float, v << 16); }
__device__ __forceinline__ float bflo(unsigned w) { return __builtin_bit_cast(float, w << 16); }
__device__ __forceinline__ float bfhi(unsigned w) { return __builtin_bit_cast(float, w & 0xffff0000u); }
__device__ __forceinline__ float rbf(float f) { return bf2f(f2bf(f)); }
__device__ __forceinline__ float clamp8(float v) { return __builtin_amdgcn_fmed3f(v, -448.0f, 448.0f); }
__device__ __forceinline__ unsigned pk4_fp8(float a, float b, float c, float d) { unsigned w = 0u; w = __builtin_amdgcn_cvt_pk_fp8_f32(clamp8(a), clamp8(b), w, false); w = __builtin_amdgcn_cvt_pk_fp8_f32(clamp8(c), clamp8(d), w, true); return w; }
__device__ __forceinline__ float gelu_tanh(float x) {
    const float z = 1.5957691216057308f * (x + 0.044715f * x * x * x);
    return x * __builtin_amdgcn_rcpf(1.0f + __builtin_amdgcn_exp2f(-z * LOG2E));
}
typedef float f32x2_t __attribute__((ext_vector_type(2)));
__device__ __forceinline__ f32x4 gelu4(const f32x4 x) {
    const f32x4 w = (x * x) * (-1.5957691216057308f * 0.044715f * LOG2E) + (-1.5957691216057308f * LOG2E); const f32x4 a = w * x;
    f32x4 d; d[0] = __builtin_amdgcn_exp2f(a[0]); d[1] = __builtin_amdgcn_exp2f(a[1]); d[2] = __builtin_amdgcn_exp2f(a[2]); d[3] = __builtin_amdgcn_exp2f(a[3]);
    d = d + 1.0f;
    f32x4 r; r[0] = __builtin_amdgcn_rcpf(d[0]); r[1] = __builtin_amdgcn_rcpf(d[1]); r[2] = __builtin_amdgcn_rcpf(d[2]); r[3] = __builtin_amdgcn_rcpf(d[3]);
    return x * r;
}
__device__ __forceinline__ f32x4 silu_mul4(const f32x4 g, const f32x4 u, const float sg, const float su) {
    const f32x4 a = g * (-sg * LOG2E);
    f32x4 d; d[0] = __builtin_amdgcn_exp2f(a[0]); d[1] = __builtin_amdgcn_exp2f(a[1]); d[2] = __builtin_amdgcn_exp2f(a[2]); d[3] = __builtin_amdgcn_exp2f(a[3]);
    d = d + 1.0f;
    f32x4 r; r[0] = __builtin_amdgcn_rcpf(d[0]); r[1] = __builtin_amdgcn_rcpf(d[1]); r[2] = __builtin_amdgcn_rcpf(d[2]); r[3] = __builtin_amdgcn_rcpf(d[3]);
    return (g * r) * (u * (sg * sg * su));
}
__device__ __forceinline__ float silu_f(float a) { return a * __builtin_amdgcn_rcpf(1.0f + __builtin_amdgcn_exp2f(-a * LOG2E)); }
__device__ __forceinline__ int lane_id() { int l; asm volatile("v_mbcnt_lo_u32_b32 %0, -1, 0\n\tv_mbcnt_hi_u32_b32 %0, -1, %0" : "=v"(l)); return l; }
template <int CTRL> __device__ __forceinline__ float dpp_f(float v) { return __builtin_bit_cast(float, __builtin_amdgcn_update_dpp(0, __builtin_bit_cast(int, v), CTRL, 0xf, 0xf, true)); }
__device__ __forceinline__ float sum_row16(float v) { v += dpp_f<0xB1>(v); v += dpp_f<0x4E>(v); v += dpp_f<0x141>(v); v += dpp_f<0x140>(v); return v; }
__device__ __forceinline__ float max_row16(float v) { v = fmaxf(v, dpp_f<0xB1>(v)); v = fmaxf(v, dpp_f<0x4E>(v)); v = fmaxf(v, dpp_f<0x141>(v)); v = fmaxf(v, dpp_f<0x140>(v)); return v; }
__device__ __forceinline__ float sum_row8(float v) { v += dpp_f<0xB1>(v); v += dpp_f<0x4E>(v); v += dpp_f<0x141>(v); return v; }
__device__ __forceinline__ float swz16(float v) { return __builtin_bit_cast(float, __builtin_amdgcn_ds_swizzle(__builtin_bit_cast(int, v), 0x401f)); }
__device__ __forceinline__ float add_x16(float v) { return v + swz16(v); }
__device__ __forceinline__ float add_x32(float v) { const unsigned a = __builtin_bit_cast(unsigned, v); const auto r = __builtin_amdgcn_permlane32_swap(a, a, false, false); const unsigned r0 = r[0], r1 = r[1]; return __builtin_bit_cast(float, r0) + __builtin_bit_cast(float, r1); }
__device__ __forceinline__ float max_x16(float v) { return fmaxf(v, swz16(v)); }
__device__ __forceinline__ float max_x32(float v) { const unsigned a = __builtin_bit_cast(unsigned, v); const auto r = __builtin_amdgcn_permlane32_swap(a, a, false, false); const unsigned r0 = r[0], r1 = r[1]; return fmaxf(__builtin_bit_cast(float, r0), __builtin_bit_cast(float, r1)); }
__device__ __forceinline__ float wave_sum(float v) { return add_x32(add_x16(sum_row16(v))); }

#define XB_TMO      128
#define XB_XCNT(j)  (256  + 64 * (j))
#define XB_XSUB(j)  (1280 + 64 * (j))
#define XB_XGEN(j)  (2304 + 64 * (j))
#define XB_TOP      3328
#define XB_TOPGEN   3392
#define XCD_BAR_WORDS 3456
#define XB_SPIN_CAP (1u << 18)
__device__ __forceinline__ unsigned xb_ld(unsigned* p)              { return __hip_atomic_load(p, __ATOMIC_RELAXED, __HIP_MEMORY_SCOPE_AGENT); }
__device__ __forceinline__ unsigned xb_add(unsigned* p, unsigned v) { return __hip_atomic_fetch_add(p, v, __ATOMIC_RELAXED, __HIP_MEMORY_SCOPE_AGENT); }
__device__ __forceinline__ unsigned xb_xcc_id() { return (unsigned)__builtin_amdgcn_s_getreg((3 << 11) | 20) & 0xFu; }
#define XB_SPIN(cond, bar) do { unsigned _sp = 0; while (cond) { __builtin_amdgcn_s_sleep(1); \
    if ((++_sp & 255u) == 0u) { if (xb_ld(&(bar)[XB_TMO])) break; if (_sp > XB_SPIN_CAP) { atomicAdd(&(bar)[XB_TMO], 1u); break; } } } } while (0)
struct XcdBarrier { unsigned* bar; unsigned x; volatile LAS unsigned* st; };
__device__ __forceinline__ XcdBarrier xcd_barrier_post(unsigned* bar, volatile LAS unsigned* st) {
    XcdBarrier b; b.bar = bar; b.x = xb_xcc_id(); b.st = st;
    if (threadIdx.x == 0) (void)xb_add(&bar[XB_XCNT(b.x)], 1u);
    return b;
}
__device__ __forceinline__ void xcd_barrier_complete(unsigned* bar, unsigned x, unsigned& nloc, unsigned& nx) {
    const unsigned G = gridDim.x * gridDim.y * gridDim.z;
    unsigned sum, cnt, mine, sp = 0u;
    for (;;) {
        sum = 0u; cnt = 0u; mine = 0u;
#pragma unroll
        for (unsigned j = 0; j < 16; ++j) { const unsigned c = xb_ld(&bar[XB_XCNT(j)]); sum += c; cnt += (c > 0u) ? 1u : 0u; mine = (j == x) ? c : mine; }
        if (sum == G) break;
        __builtin_amdgcn_s_sleep(1);
        if ((++sp & 255u) == 0u) { if (xb_ld(&bar[XB_TMO])) break; if (sp > XB_SPIN_CAP) { atomicAdd(&bar[XB_TMO], 1u); break; } }
    }
    nloc = mine > 0u ? mine : 1u; nx = cnt > 0u ? cnt : 1u;
}
__device__ __forceinline__ void xcd_barrier(const XcdBarrier& b) {
    asm volatile("s_waitcnt vmcnt(0)" ::: "memory");
    __syncthreads();
    if (threadIdx.x == 0) {
        unsigned* bar = b.bar;
        __builtin_amdgcn_s_waitcnt(0);
        unsigned nloc = b.st[0], nx = b.st[1];
        if (nloc == 0u) { xcd_barrier_complete(bar, b.x, nloc, nx); b.st[0] = nloc; b.st[1] = nx; }
        const unsigned old = xb_add(&bar[XB_XSUB(b.x)], 1u);
        const unsigned gen = old / nloc;
        if (old + 1u == (gen + 1u) * nloc) {
            __builtin_amdgcn_fence(__ATOMIC_RELEASE, "agent");
            asm volatile("s_waitcnt vmcnt(0)" ::: "memory");
            const unsigned og = xb_add(&bar[XB_TOP], 1u);
            const unsigned tg = og / nx;
            if (og + 1u == (tg + 1u) * nx) xb_add(&bar[XB_TOPGEN], 1u);
            else XB_SPIN(xb_ld(&bar[XB_TOPGEN]) == tg, bar);
            __builtin_amdgcn_fence(__ATOMIC_ACQUIRE, "agent");
            xb_add(&bar[XB_XGEN(b.x)], 1u);
            asm volatile("s_waitcnt vmcnt(0)" ::: "memory");
        } else {
            XB_SPIN(xb_ld(&bar[XB_XGEN(b.x)]) == gen, bar);
            __builtin_amdgcn_fence(__ATOMIC_ACQUIRE, "agent");
            asm volatile("s_waitcnt vmcnt(0)" ::: "memory");
        }
    }
    __syncthreads();
}

constexpr int CW_XLSUB = 3072, CW_XLGEN = 3584;
constexpr int CW_MAP = 512, CW_MAPBAD = 576;
__device__ __forceinline__ void map_check_post(unsigned* ctl) {
    if (threadIdx.x == 0) { const unsigned x = xb_xcc_id() + 1u; unsigned expect = 0u;
        if (!__hip_atomic_compare_exchange_strong(ctl + CW_MAP + (blockIdx.x & 7u), &expect, x, __ATOMIC_RELAXED, __ATOMIC_RELAXED, __HIP_MEMORY_SCOPE_AGENT) && expect != x) xb_add(ctl + CW_MAPBAD, 1u);
        if (xb_xcc_id() >= 8u) xb_add(ctl + CW_MAPBAD, 1u); }
}
__device__ __forceinline__ void xcdl_barrier(unsigned* ctl, const XcdBarrier& b) {
    asm volatile("s_waitcnt vmcnt(0)" ::: "memory");
    __syncthreads();
    if (threadIdx.x == 0) {
        __builtin_amdgcn_s_waitcnt(0);
        const unsigned nloc = b.st[0];
        const unsigned old = xb_add(ctl + CW_XLSUB + 64 * b.x, 1u), gen = old / nloc;
        if (old + 1u == (gen + 1u) * nloc) (void)xb_add(ctl + CW_XLGEN + 64 * b.x, 1u);
        else XB_SPIN(xb_ld(ctl + CW_XLGEN + 64 * b.x) == gen, b.bar);
        __builtin_amdgcn_fence(__ATOMIC_ACQUIRE, "agent");
        asm volatile("s_waitcnt vmcnt(0)" ::: "memory");
    }
    __syncthreads();
}

struct Args { const float* in[22]; float* out; unsigned char* ws; int ph_lo, ph_hi, bar_region, pad; };
constexpr int PH_LAYER0 = 4, PH_PER_LAYER = 10, PH_END = PH_LAYER0 + NL * PH_PER_LAYER;

constexpr int NWAVES = 8, NTHR = NWAVES * 64;
constexpr int RING_BYTES = 131072, LDSCTL_OFF = RING_BYTES, MISC_OFF = LDSCTL_OFF + 320;
constexpr int LDS_BYTES = 147456;

struct Frame {
    LAS unsigned char* lds;
    int wave, vcu, G;
    const float* in[22];
    unsigned char* ws;
    float* xres;
};

__device__ __forceinline__ void ph_rows0(Frame& F) {
    int lane_ = lane_id(); asm volatile("" : "+v"(lane_)); const int tid_ = F.wave * 64 + lane_;
    const int gw = F.vcu * NWAVES + F.wave, NGW = F.G * NWAVES;
    const float* x = F.in[0]; const float* mem = F.in[1]; const float* mg = F.in[12];
    bf16* XR = (bf16*)(F.ws + WS_XR); bf16* MEMN = (bf16*)(F.ws + WS_MEMN); float* RINV = (float*)(F.ws + WS_RINV);
#define R0_SRC(M_) (((M_) >= T) ? mem + (size_t)((M_) - T) * D : x + (size_t)(M_) * D)
#define R0_LOAD(V_, M_) do { if ((M_) < T + NMEM) { const float* s_ = R0_SRC(M_); _Pragma("unroll") for (int j_ = 0; j_ < 4; ++j_) V_[j_] = __builtin_nontemporal_load((const f32x4*)(s_ + 4 * lane_ + 256 * j_)); } } while (0)
    f32x4 n1[4], n2[4];
    R0_LOAD(n1, gw); R0_LOAD(n2, gw + NGW);
    for (int m = gw; m < T + NMEM; m += NGW) {
        const bool is_mem = m >= T;
        bf16* dst = is_mem ? MEMN + (size_t)(m - T) * D : XR + (size_t)m * D;
        f32x4 v[4]; float s = 0.f;
#pragma unroll
        for (int j = 0; j < 4; ++j) { v[j] = n1[j]; n1[j] = n2[j]; }
        R0_LOAD(n2, m + 2 * NGW);
#pragma unroll
        for (int j = 0; j < 4; ++j) s += (v[j].x * v[j].x + v[j].y * v[j].y) + (v[j].z * v[j].z + v[j].w * v[j].w);
        const float rinv = __builtin_amdgcn_rsqf(wave_sum(s) * (1.0f / D) + EPS);
        if (!is_mem && lane_ == 0) RINV[m] = rinv;
        const float sc = is_mem ? rinv : 1.0f;
#pragma unroll
        for (int j = 0; j < 4; ++j) {
            f32x4 g = (f32x4){1.f, 1.f, 1.f, 1.f};
            if (is_mem) g = *(const f32x4*)(mg + 4 * lane_ + 256 * j);
            v2u o; o.x = pk2(v[j].x * sc * g.x, v[j].y * sc * g.y); o.y = pk2(v[j].z * sc * g.z, v[j].w * sc * g.w);
            *(v2u*)(dst + 4 * lane_ + 256 * j) = o;
        }
    }
#undef R0_LOAD
#undef R0_SRC
#if defined(SELFTEST_F8)
    if (F.vcu == 0 && F.wave == 0) {
        typedef int v8i_t __attribute__((ext_vector_type(8)));
        const int fr = lane_ & 15; const unsigned codes[4] = {0x38383838u, 0x3A3A3A3Au, 0x3C3C3C3Cu, 0x40404040u}; const float vals[4] = {1.0f, 1.25f, 1.5f, 2.0f};
        unsigned bc = codes[0]; float bv = vals[0];
#pragma unroll
        for (int q = 1; q < 4; ++q) if ((fr & 3) == q) { bc = codes[q]; bv = vals[q]; }
        v8i_t A, B;
#pragma unroll
        for (int q = 0; q < 8; ++q) { A[q] = 0x38383838; B[q] = (int)bc; }
        f32x4 acc = (f32x4){0.f, 0.f, 0.f, 0.f}; unsigned sc = 0x7f7f7f7fu; asm volatile("" : "+v"(sc), "+v"(A), "+v"(B), "+v"(acc));
        asm volatile("s_nop 7\n\tv_mfma_scale_f32_16x16x128_f8f6f4 %0, %1, %2, %0, %3, %3 op_sel_hi:[0,0,0]\n\ts_nop 15\n\ts_nop 15\n\ts_nop 15\n\ts_nop 15\n\ts_nop 15\n\ts_nop 15" : "+v"(acc) : "v"(A), "v"(B), "v"(sc));
        bool bad = false;
#pragma unroll
        for (int e = 0; e < 4; ++e) bad |= (acc[e] != 128.0f * bv);
        const unsigned w = pk4_fp8(1.25f, 448.0f, 1000.0f, -2.0f); bad |= (w != 0xC07E7E3Au);
        {   const float v = (float)((lane_ * 37 + 11) % 101);
            float r16 = v; r16 += __shfl_xor(r16, 1); r16 += __shfl_xor(r16, 2); r16 += __shfl_xor(r16, 4); r16 += __shfl_xor(r16, 8);
            float m16 = v; m16 = fmaxf(m16, __shfl_xor(m16, 1)); m16 = fmaxf(m16, __shfl_xor(m16, 2)); m16 = fmaxf(m16, __shfl_xor(m16, 4)); m16 = fmaxf(m16, __shfl_xor(m16, 8));
            float r8 = v; r8 += __shfl_xor(r8, 1); r8 += __shfl_xor(r8, 2); r8 += __shfl_xor(r8, 4);
            float r64 = r16; r64 += __shfl_xor(r64, 16); r64 += __shfl_xor(r64, 32);
            if (SELFTEST_F8 & 1) bad |= (sum_row16(v) != r16) | (max_row16(v) != m16) | (sum_row8(v) != r8);
            if (SELFTEST_F8 & 2) bad |= (wave_sum(v) != r64);
            if (SELFTEST_F8 & 4) bad |= (add_x16(v) != v + __shfl_xor(v, 16)) | (max_x16(v) != fmaxf(v, __shfl_xor(v, 16)));
            if (SELFTEST_F8 & 8) bad |= (add_x32(v) != v + __shfl_xor(v, 32)) | (max_x32(v) != fmaxf(v, __shfl_xor(v, 32)));
            if (SELFTEST_F8 & 16) bad |= (lane_ != (int)(threadIdx.x & 63));
            const int iv = lane_ * 3 + 1; if (SELFTEST_F8 & 32) bad |= (__builtin_amdgcn_readlane(iv, 5) != 16) | false; { const int bp = __builtin_amdgcn_ds_bpermute((lane_ - 1) << 2, iv); if (SELFTEST_F8 & 32) bad |= (lane_ > 0 && bp != iv - 3); }
            const float xq = 0.37f + (float)lane_; const float rq = __builtin_amdgcn_rsqf(xq), rr = 1.0f / sqrtf(xq); if (SELFTEST_F8 & 64) bad |= (fabsf(rq - rr) > 1e-5f * rr); }
        if (bad) __hip_atomic_store((unsigned*)(F.ws + WS_CTL) + CW_TMO, 1u, __ATOMIC_RELAXED, __HIP_MEMORY_SCOPE_AGENT);
    }
#endif
    float* COS = (float*)(F.ws + WS_ROPE); float* SIN = COS + SEQ * 32;
    const int gt = F.vcu * NTHR + tid_, NGT = F.G * NTHR;
    for (int i = gt; i < SEQ * 32; i += NGT) {
        const int t = i >> 5, p = i & 31;
        const float fr = expf(-9.210340371976184f * (float)(p & 15) * (1.0f / 16.0f));
        const float pos = (float)((p < 16) ? (t >> 6) : (t & 63));
        float rev = pos * fr * 0.15915494309189535f; rev -= floorf(rev);
        COS[i] = __builtin_amdgcn_cosf(rev); SIN[i] = __builtin_amdgcn_sinf(rev);
    }
}

__device__ __forceinline__ void ph_gmlp(Frame& F, int l) {
    int lane_ = lane_id(); asm volatile("" : "+v"(lane_)); const int tid_ = F.wave * 64 + lane_;
    const bf16* UACT = (const bf16*)(F.ws + WS_UACT); const bf16* VACT = (const bf16*)(F.ws + WS_VACT);
    const float* VSTAT = (const float*)(F.ws + WS_VSTAT); float* GMSTAT = (float*)(F.ws + WS_GMSTAT);
    bf16* MERGED = (bf16*)(F.ws + WS_MERGED);
    const float* gvn = F.in[4] + (size_t)l * GMW; const float* bs = F.in[6] + (size_t)l * 4 * 128;
    const bf16* WSB = (const bf16*)(F.ws + WS_WSB) + (size_t)l * 4 * 128 * 128;
    LAS bf16* vT = (LAS bf16*)F.lds;
    const int fr = lane_ & 15, fq = lane_ >> 4, w = F.wave;
    const int jv = tid_ & 127, csv = tid_ >> 7;
    v4u nraw[4]; f32x4 ns0, ns1;
#define GM_LOADV(U_) do { const int n_ = (U_) >> 2, g_ = (U_) & 3; const size_t row_ = (size_t)n_ * 128 + jv; ns0 = *(const f32x4*)(VSTAT + row_ * 8); ns1 = *(const f32x4*)(VSTAT + row_ * 8 + 4); \
        _Pragma("unroll") for (int q_ = 0; q_ < 4; ++q_) nraw[q_] = *(const v4u*)(VACT + row_ * GMW + g_ * 128 + (csv * 4 + q_) * 8); } while (0)
    constexpr int NU = (T / 128) * 4;
    unsigned* gmq = (unsigned*)(F.ws + WS_CTL) + CW_GMQ + 64 * l;
    LAS int* nxt = (LAS int*)(F.lds + 36864);
    if (F.vcu < NU) GM_LOADV(F.vcu);
    for (int u = F.vcu; u < NU; ) {
        const int n = u >> 2, g = u & 3; const int row0 = n * 128;
        v4u raw[4]; const f32x4 s0 = ns0, s1 = ns1;
#pragma unroll
        for (int q = 0; q < 4; ++q) raw[q] = nraw[q];
        __syncthreads();
        unsigned tk = 0u; if (tid_ == 0) tk = __hip_atomic_fetch_add(gmq, 1u, __ATOMIC_RELAXED, __HIP_MEMORY_SCOPE_AGENT);
        {   const float rinv = __builtin_amdgcn_rsqf((((s0[0] + s0[1]) + (s0[2] + s0[3])) + ((s1[0] + s1[1]) + (s1[2] + s1[3]))) * (1.0f / GMW) + EPS);
#pragma unroll
            for (int q = 0; q < 4; ++q) { const int c8 = (csv * 4 + q) * 8;
                const f32x4 g0 = *(const f32x4*)(gvn + g * 128 + c8) * rinv, g1 = *(const f32x4*)(gvn + g * 128 + c8 + 4) * rinv;
                LAS bf16* d = vT + c8 * 136 + jv;
                d[0 * 136] = (bf16)f2bf(bflo(raw[q].x) * g0[0]); d[1 * 136] = (bf16)f2bf(bfhi(raw[q].x) * g0[1]); d[2 * 136] = (bf16)f2bf(bflo(raw[q].y) * g0[2]); d[3 * 136] = (bf16)f2bf(bfhi(raw[q].y) * g0[3]);
                d[4 * 136] = (bf16)f2bf(bflo(raw[q].z) * g1[0]); d[5 * 136] = (bf16)f2bf(bfhi(raw[q].z) * g1[1]); d[6 * 136] = (bf16)f2bf(bflo(raw[q].w) * g1[2]); d[7 * 136] = (bf16)f2bf(bfhi(raw[q].w) * g1[3]); } }
        bf16x8_t bw[4];
#pragma unroll
        for (int ks = 0; ks < 4; ++ks) bw[ks] = *(const bf16x8_t*)(WSB + ((size_t)(g * 128 + 16 * w + fr)) * 128 + 32 * ks + 8 * fq);
        const size_t row = (size_t)row0 + 16 * w + fr; const float bias = bs[g * 128 + 16 * w + fr];
        v2u uu[8];
#pragma unroll
        for (int cb = 0; cb < 8; ++cb) uu[cb] = *(const v2u*)(UACT + row * GMW + g * 128 + 16 * cb + 4 * fq);
        if (tid_ == 0) *nxt = F.G + (int)tk;
        __syncthreads();
        const int un = *nxt;
        if (un < NU) GM_LOADV(un);
        f32x4 acc[8];
#pragma unroll
        for (int cb = 0; cb < 8; ++cb) { acc[cb] = (f32x4){0.f, 0.f, 0.f, 0.f};
#pragma unroll
            for (int ks = 0; ks < 4; ++ks) { const bf16x8_t a = *(const LAS bf16x8_t*)(vT + (16 * cb + fr) * 136 + 32 * ks + 8 * fq);
                acc[cb] = __builtin_amdgcn_mfma_f32_16x16x32_bf16(a, bw[ks], acc[cb], 0, 0, 0); } }
        float ss = 0.f;
#pragma unroll
        for (int cb = 0; cb < 8; ++cb) {
            v2u o; o.x = pk2(bflo(uu[cb].x) * (acc[cb][0] + bias), bfhi(uu[cb].x) * (acc[cb][1] + bias)); o.y = pk2(bflo(uu[cb].y) * (acc[cb][2] + bias), bfhi(uu[cb].y) * (acc[cb][3] + bias));
            *(v2u*)(MERGED + row * 1024 + g * 128 + 16 * cb + 4 * fq) = o;
            const float a0 = bflo(o.x), a1 = bfhi(o.x), a2 = bflo(o.y), a3 = bfhi(o.y); ss += (a0 * a0 + a1 * a1) + (a2 * a2 + a3 * a3); }
        ss = add_x32(add_x16(ss));
        if (fq == 0) GMSTAT[row * 4 + g] = ss;
        u = un;
    }
#undef GM_LOADV
    __syncthreads();
}

__device__ __forceinline__ void ph_router(Frame& F, int l) {
    const bf16* XR = (const bf16*)(F.ws + WS_XR); float* AFF = (float*)(F.ws + WS_AFF); unsigned char* X8 = F.ws + WS_XR8;
    constexpr int RP = 2064;
    const int gw = F.vcu * NWAVES + F.wave, NGW = F.G * NWAVES;
    for (int blk = gw; blk < T / 16; blk += NGW) {
        int lane_ = lane_id(); asm volatile("" : "+v"(lane_)); const int fr = lane_ & 15, fq = lane_ >> 4;
        v4u x[32];
#pragma unroll
        for (int ks = 0; ks < 32; ++ks) x[ks] = *(const v4u*)(XR + ((size_t)blk * 16 + fr) * D + 128 * (ks >> 2) + 32 * fq + 8 * (ks & 3));
        if (blk == gw) {
        {
            int tid_ = F.wave * 64 + lane_id(); asm volatile("" : "+v"(tid_));
            const bf16* gh = (const bf16*)(F.ws + WS_WRH) + (size_t)l * NE * D; const bf16* gl = (const bf16*)(F.ws + WS_WRL) + (size_t)l * NE * D;
            v4u th[4], tl[4];
#pragma unroll
            for (int i = 0; i < 4; ++i) { const int c = tid_ + 512 * i; th[i] = *(const v4u*)(gh + (size_t)(c >> 7) * D + 8 * (c & 127)); tl[i] = *(const v4u*)(gl + (size_t)(c >> 7) * D + 8 * (c & 127)); }
#pragma unroll
            for (int i = 0; i < 4; ++i) { const int c = tid_ + 512 * i; *(LAS v4u*)(F.lds + (c >> 7) * RP + 16 * (c & 127)) = th[i]; *(LAS v4u*)(F.lds + 16 * RP + (c >> 7) * RP + 16 * (c & 127)) = tl[i]; }
        }
        __syncthreads();
        }
        int wo_ = fr * RP + 64 * fq; asm volatile("" : "+v"(wo_));
        const LAS unsigned char* wp = F.lds + wo_;
        const size_t row = (size_t)blk * 16 + fr;
        f32x4 acc = (f32x4){0.f, 0.f, 0.f, 0.f}; float ss = 0.f;
#pragma unroll
        for (int ks = 0; ks < 32; ++ks) { const bf16x8_t xk = __builtin_bit_cast(bf16x8_t, x[ks]);
            const bf16x8_t wh = *(const LAS bf16x8_t*)(wp + 256 * (ks >> 2) + 16 * (ks & 3)), wl = *(const LAS bf16x8_t*)(wp + 16 * RP + 256 * (ks >> 2) + 16 * (ks & 3));
            acc = __builtin_amdgcn_mfma_f32_16x16x32_bf16(wh, xk, acc, 0, 0, 0); acc = __builtin_amdgcn_mfma_f32_16x16x32_bf16(wl, xk, acc, 0, 0, 0);
            const v4u xb = x[ks];
            const float a0 = bflo(xb.x), a1 = bfhi(xb.x), a2 = bflo(xb.y), a3 = bfhi(xb.y), a4 = bflo(xb.z), a5 = bfhi(xb.z), a6 = bflo(xb.w), a7 = bfhi(xb.w);
            ss += ((a0 * a0 + a1 * a1) + (a2 * a2 + a3 * a3)) + ((a4 * a4 + a5 * a5) + (a6 * a6 + a7 * a7)); }
        ss = add_x32(add_x16(ss));
        const float rinv = __builtin_amdgcn_rsqf(ss * (1.0f / D) + EPS);
        const f32x4 lg = acc * (rinv * LOG2E);
        float mx = fmaxf(fmaxf(lg[0], lg[1]), fmaxf(lg[2], lg[3])); mx = max_x32(max_x16(mx));
        f32x4 pe; float den = 0.f;
#pragma unroll
        for (int i = 0; i < 4; ++i) { pe[i] = __builtin_amdgcn_exp2f(lg[i] - mx); den += pe[i]; }
        den = add_x32(add_x16(den));
        { const f32x4 av_ = pe * __builtin_amdgcn_rcpf(den);
          const __amdgpu_buffer_rsrc_t ar_ = __builtin_amdgcn_make_buffer_rsrc((void*)AFF, 0, T * NE * 4, 0x00020000);
          __builtin_amdgcn_raw_buffer_store_b128(__builtin_bit_cast(v4u, av_), ar_, (unsigned)((row * NE + 4 * fq) * 4), 0, 16); }
        const float sc = rinv * A8S;
#pragma unroll
        for (int g = 0; g < 8; ++g) {
            v4u o0, o1;
#pragma unroll
            for (int i = 0; i < 4; ++i) asm volatile("" : "+v"(x[4 * g + i]));
#define RT8(xb, lo_, hi_) lo_ = pk4_fp8(bflo(xb.x) * sc, bfhi(xb.x) * sc, bflo(xb.y) * sc, bfhi(xb.y) * sc); hi_ = pk4_fp8(bflo(xb.z) * sc, bfhi(xb.z) * sc, bflo(xb.w) * sc, bfhi(xb.w) * sc);
            RT8(x[4 * g], o0.x, o0.y) RT8(x[4 * g + 1], o0.z, o0.w) RT8(x[4 * g + 2], o1.x, o1.y) RT8(x[4 * g + 3], o1.z, o1.w)
#undef RT8
            *(v4u*)(X8 + row * D + 128 * g + 32 * fq) = o0; *(v4u*)(X8 + row * D + 128 * g + 32 * fq + 16) = o1; }
    }
}

__device__ __forceinline__ void ph_topk(Frame& F) {
    int lane_ = lane_id(); asm volatile("" : "+v"(lane_)); const int tid_ = F.wave * 64 + lane_;
    const float* AFF = (const float*)(F.ws + WS_AFF); int* IDX = (int*)(F.ws + WS_IDX); int* INV = (int*)(F.ws + WS_INV);
    LAS unsigned* hist = (LAS unsigned*)F.lds;
    LAS unsigned* sh = hist + 256;
    LAS unsigned* wsum = hist + 512;
    for (int p = F.vcu; p < NB_ * NE; p += F.G) {
        const int b = p >> 4, e = p & 15;
        unsigned key[16];
#pragma unroll
        for (int i = 0; i < 16; ++i) key[i] = __builtin_bit_cast(unsigned, AFF[((size_t)b * SEQ + tid_ * 16 + i) * NE + e]);
        unsigned prefix = 0u, krem = CAP;
#pragma unroll
        for (int pass = 0; pass < 4; ++pass) {
            const int shift = pass == 3 ? 0 : 23 - 8 * pass; const unsigned dmask = pass == 3 ? 127u : 255u;
            const unsigned himask = pass == 0 ? 0u : (pass == 1 ? 0xff800000u : (pass == 2 ? 0xffff8000u : 0xffffff80u));
            __syncthreads();
            if (tid_ < 256) hist[tid_] = 0u;
            __syncthreads();
#pragma unroll
            for (int i = 0; i < 16; ++i) if ((key[i] & himask) == prefix) atomicAdd((unsigned*)&hist[(key[i] >> shift) & dmask], 1u);
            __syncthreads();
            if (F.wave == 0) {
                unsigned c[4]; unsigned t = 0u;
#pragma unroll
                for (int j = 0; j < 4; ++j) { c[j] = hist[255 - 4 * lane_ - j]; t += c[j]; }
                unsigned inc = t;
#pragma unroll
                for (int o = 1; o < 64; o <<= 1) { const unsigned a = (unsigned)__builtin_amdgcn_ds_bpermute((lane_ - o) << 2, (int)inc); if (lane_ >= o) inc += a; }
                unsigned above = inc - t;
                if (above < krem && krem <= inc) {
                    int d = 255 - 4 * lane_;
#pragma unroll
                    for (int j = 0; j < 3; ++j) { if (above + c[j] < krem) { above += c[j]; d = 254 - 4 * lane_ - j; } else break; }
                    sh[0] = prefix | ((unsigned)d << shift); sh[1] = krem - above; }
            }
            __syncthreads();
            prefix = sh[0]; krem = sh[1];
        }
        const unsigned thr = prefix;
        unsigned cg = 0u, ce = 0u;
#pragma unroll
        for (int i = 0; i < 16; ++i) { cg += key[i] > thr ? 1u : 0u; ce += key[i] == thr ? 1u : 0u; }
        unsigned sg = cg, se = ce;
#pragma unroll
        for (int o = 1; o < 64; o <<= 1) { const unsigned a = (unsigned)__builtin_amdgcn_ds_bpermute((lane_ - o) << 2, (int)sg), c2 = (unsigned)__builtin_amdgcn_ds_bpermute((lane_ - o) << 2, (int)se); if (lane_ >= o) { sg += a; se += c2; } }
        __syncthreads();
        if (lane_ == 63) { wsum[F.wave] = sg; wsum[8 + F.wave] = se; }
        __syncthreads();
        unsigned og = 0u, oe = 0u;
        for (int w = 0; w < F.wave; ++w) { og += wsum[w]; oe += wsum[8 + w]; }
        unsigned gb = og + sg - cg, eb = oe + se - ce;
#pragma unroll
        for (int i = 0; i < 16; ++i) {
            const int t = tid_ * 16 + i; int pos = -1;
            if (key[i] > thr) { pos = (int)(gb + (eb < krem ? eb : krem)); ++gb; }
            else if (key[i] == thr) { if (eb < krem) pos = (int)(gb + eb); ++eb; }
            INV[((size_t)b * SEQ + t) * NE + e] = pos;
            if (pos >= 0) IDX[(size_t)p * CAP + pos] = t;
        }
    }
    __syncthreads();
}

__device__ __forceinline__ void ph_combine(Frame& F, int l, bool dummy) {
    int lane_ = lane_id(); asm volatile("" : "+v"(lane_));
    const float* AFF = (const float*)(F.ws + WS_AFF); const int* INV = (const int*)(F.ws + WS_INV);
    const unsigned char* Y = F.ws + WS_Y; bf16* XR = (bf16*)(F.ws + WS_XR); const float* fg = F.in[21]; float* RINV = (float*)(F.ws + WS_RINV);
    const int RPW = T / (F.G * NWAVES); const int m0 = (F.vcu * NWAVES + F.wave) * RPW, mEnd = m0 + RPW;
#define CMB_LOAD_A(X_, POS_, AFF_, M_) do { POS_ = -1; AFF_ = 0.f; if ((M_) < mEnd) { _Pragma("unroll") for (int j_ = 0; j_ < 4; ++j_) X_[j_] = *(const v2u*)(XR + (size_t)(M_) * D + 4 * lane_ + 256 * j_); \
        if (lane_ < NE) { POS_ = INV[(size_t)(M_) * NE + lane_]; AFF_ = AFF[(size_t)(M_) * NE + lane_]; } } } while (0)
#define CMB_ISSUE_Y(W_, AS_, MASK_, POS_, AFF_, M_) do { MASK_ = (unsigned)__builtin_amdgcn_ballot_w64(POS_ >= 0) & 0xffffu; const int b_ = ((M_) < mEnd ? (M_) : 0) / SEQ; \
        _Pragma("unroll") for (int q_ = 0; q_ < 4; ++q_) { AS_[q_] = 0.f; _Pragma("unroll") for (int j_ = 0; j_ < 4; ++j_) W_[q_][j_] = 0; \
            if (MASK_) { const int e_ = __builtin_ctz(MASK_); MASK_ &= MASK_ - 1u; const int pos_ = __builtin_amdgcn_readlane(POS_, e_); \
                AS_[q_] = __builtin_bit_cast(float, __builtin_amdgcn_readlane(__builtin_bit_cast(int, AFF_), e_)) * (1.0f / Y8S); const unsigned char* yr_ = Y + ((size_t)(e_ * NB_ + b_) * CAP + pos_) * D; \
                _Pragma("unroll") for (int j_ = 0; j_ < 4; ++j_) W_[q_][j_] = *(const int*)(yr_ + 4 * lane_ + 256 * j_); } } } while (0)
#define CMB_ACC(W_, AS_) do { _Pragma("unroll") for (int q_ = 0; q_ < 4; ++q_) _Pragma("unroll") for (int j_ = 0; j_ < 4; ++j_) { \
        const auto lo_ = __builtin_amdgcn_cvt_pk_f32_fp8(W_[q_][j_], false), hi_ = __builtin_amdgcn_cvt_pk_f32_fp8(W_[q_][j_], true); const float l0_ = lo_[0], l1_ = lo_[1], h0_ = hi_[0], h1_ = hi_[1]; \
        v[j_].x += AS_[q_] * l0_; v[j_].y += AS_[q_] * l1_; v[j_].z += AS_[q_] * h0_; v[j_].w += AS_[q_] * h1_; } } while (0)
    v2u cx[4], nx[4]; int cpos, npos; float caff, naff; int cw[4][4]; float cas[4]; unsigned cmask;
    CMB_LOAD_A(cx, cpos, caff, m0); CMB_LOAD_A(nx, npos, naff, m0 + 1);
    CMB_ISSUE_Y(cw, cas, cmask, cpos, caff, m0);
    for (int m = m0; m < mEnd; ++m) {
        const int b = m / SEQ;
        bf16* xw = (dummy ? (bf16*)(F.ws + WS_NSCR) : XR) + (size_t)m * D; float* ow = (dummy ? (float*)(F.ws + WS_NSCR) : F.xres) + (size_t)m * D;
        v2u tx[4]; int tw[4][4]; float tas[4]; unsigned tmask; const int tpos = npos; const float taff = naff;
#pragma unroll
        for (int j = 0; j < 4; ++j) tx[j] = nx[j];
        CMB_ISSUE_Y(tw, tas, tmask, tpos, taff, m + 1);
        CMB_LOAD_A(nx, npos, naff, m + 2);
        f32x4 v[4];
#pragma unroll
        for (int j = 0; j < 4; ++j) v[j] = (f32x4){bflo(cx[j].x), bfhi(cx[j].x), bflo(cx[j].y), bfhi(cx[j].y)};
        CMB_ACC(cw, cas);
        while (cmask) {
            int rw[4][4]; float ras[4]; unsigned rm = cmask; const int rpos = cpos; const float raff = caff;
            (void)b;
            {   unsigned mk = rm;
#pragma unroll
                for (int q = 0; q < 4; ++q) { ras[q] = 0.f;
#pragma unroll
                    for (int j = 0; j < 4; ++j) rw[q][j] = 0;
                    if (mk) { const int e = __builtin_ctz(mk); mk &= mk - 1u; const int pos = __builtin_amdgcn_readlane(rpos, e);
                        ras[q] = __builtin_bit_cast(float, __builtin_amdgcn_readlane(__builtin_bit_cast(int, raff), e)) * (1.0f / Y8S); const unsigned char* yr = Y + ((size_t)(e * NB_ + b) * CAP + pos) * D;
#pragma unroll
                        for (int j = 0; j < 4; ++j) rw[q][j] = *(const int*)(yr + 4 * lane_ + 256 * j); } }
                cmask = mk; }
            CMB_ACC(rw, ras);
        }
#pragma unroll
        for (int j = 0; j < 4; ++j) cx[j] = tx[j];
        cpos = tpos; caff = taff; cmask = tmask;
#pragma unroll
        for (int q = 0; q < 4; ++q) { cas[q] = tas[q];
#pragma unroll
            for (int j = 0; j < 4; ++j) cw[q][j] = tw[q][j]; }
        float s = 0.f;
#pragma unroll
        for (int j = 0; j < 4; ++j) s += (v[j].x * v[j].x + v[j].y * v[j].y) + (v[j].z * v[j].z + v[j].w * v[j].w);
        const float rinv = __builtin_amdgcn_rsqf(wave_sum(s) * (1.0f / D) + EPS);
        if (l == NL - 1) {
#if defined(SELFTEST_F8)
            if (__hip_atomic_load((unsigned*)(F.ws + WS_CTL) + CW_TMO, __ATOMIC_RELAXED, __HIP_MEMORY_SCOPE_AGENT) != 0u) v[0].x = __builtin_nanf("");
#endif
            float pr_ = 1.0f;
#if REPK == 300 || REPK == 301 || REPK == 302 || REPK == 310
            { const unsigned* pw_ = (const unsigned*)(F.ws + WS_CTL + 64); float rr_ = (float)pw_[0] / (float)pw_[1]; if (REPK == 302) rr_ = floorf(rr_ * 20.0f) * 0.05f; if (REPK == 310) rr_ = floorf(rr_ * PROBE_Q + PROBE_QOFF) / PROBE_Q; pr_ = 1.0f + (REPK == 301 ? 1.0f : (REPK == 310 ? PROBE_SCALE : 0.125f)) * rr_; }
#endif
#pragma unroll
            for (int j = 0; j < 4; ++j) { const f32x4 g = *(const f32x4*)(fg + 4 * lane_ + 256 * j); *(f32x4*)(ow + 4 * lane_ + 256 * j) = (f32x4){v[j].x * rinv * g.x * pr_, v[j].y * rinv * g.y * pr_, v[j].z * rinv * g.z * pr_, v[j].w * rinv * g.w * pr_}; }
        } else {
            if (lane_ == 0 && !dummy) RINV[m] = rinv;
#pragma unroll
            for (int j = 0; j < 4; ++j) { v2u o; o.x = pk2(v[j].x, v[j].y); o.y = pk2(v[j].z, v[j].w); *(v2u*)(xw + 4 * lane_ + 256 * j) = o; }
        }
    }
}

#undef CMB_LOAD_A
#undef CMB_ISSUE_Y
#undef CMB_ACC
namespace pg8 {
typedef short bf16x8 __attribute__((ext_vector_type(8)));
typedef float f32x2 __attribute__((ext_vector_type(2)));
typedef int v4i_t __attribute__((ext_vector_type(4)));
typedef int v8i_t __attribute__((ext_vector_type(8)));
constexpr int BM = 256, BK = 64, HALF = 128, HTB = HALF * BK * 2, STAGE_BYTES = 8 * HTB, NXCD = 8, WGM = 2;
__host__ __device__ __forceinline__ int lds_byte(int r, int c) { const int st = (r >> 4) * 2 + (c >> 5), rr = r & 15, cc = c & 31, ob = rr * 64 + cc * 2; return st * 1024 + (ob ^ (((ob >> 9) & 1) << 5)); }
__host__ __device__ __forceinline__ void stage_rc(int b, int& R, int& C) { const int st = b / 1024, sb = b % 1024, swz = sb ^ (((sb >> 9) & 1) << 5); R = (st >> 1) * 16 + swz / 64; C = (st & 1) * 32 + (swz % 64) / 2; }
__host__ __device__ __forceinline__ int perm32(int rho) { const int n = rho >> 4, i = rho & 15; return 8 * (i >> 2) + 4 * n + (i & 3); }

struct Unit { int pm, pn, z; const char* a; const char* b; const int* gi; int grow; };

struct TileOrder {
    int nM, nN, nwg, G, c;
    __device__ __forceinline__ void init(int nM_, int nN_, int G_, int c_) { nM = nM_; nN = nN_; nwg = nM * nN; G = G_; c = c_; }
    __device__ __forceinline__ bool tile(int i, int& pm, int& pn) const {
        const long L = (long)i * G + c; if (L >= nwg) return false;
        int wgid = (int)L; { const int q = nwg / NXCD, r = nwg % NXCD, xcd = wgid % NXCD, off = wgid / NXCD; wgid = (xcd < r ? xcd * (q + 1) : r * (q + 1) + (xcd - r) * q) + off; }
        const int nig = WGM * nN, gid = wgid / nig, fm = gid * WGM, gsz = (nM - fm) < WGM ? (nM - fm) : WGM;
        pm = fm + ((wgid % nig) % gsz); pn = (wgid % nig) / gsz; return true;
    }
};

__device__ __forceinline__ unsigned cvt_pk_bf16(float lo, float hi) { unsigned r; asm volatile("v_cvt_pk_bf16_f32 %0, %1, %2" : "=v"(r) : "v"(lo), "v"(hi)); return r; }
typedef f32x4 Acc[2][2][4][2];
#ifndef NT_STORE
#define NT_STORE 0
#endif
__device__ __forceinline__ void st16(void* p, const v4u w, bool nostore = false) { if (nostore) return; if (NT_STORE) __builtin_nontemporal_store(w, (v4u*)p); else *(v4u*)p = w; }
#ifndef NT_Y
#define NT_Y 1
#endif

template <class Epi, class Sched, bool ALIGN_EPI, bool GATHER, bool FP8 = false>
__device__ __forceinline__ void gemm_phase(LAS unsigned char* lds, const int wave_idx, const int lda, const int ldb, const int K, const Sched& S, Epi& E) {
    const int lane = lane_id();
    int wid = wave_idx; asm volatile("" : "+s"(wid));
    const int tid = wid * 64 + lane, wr = wid >> 2, wc = wid & 3, fr = lane & 15, fq = lane >> 4;
    const int nt = K / BK;
    unsigned voffA[2], voffB[2];
#pragma unroll
    for (int i = 0; i < 2; ++i) { int R, C; stage_rc(tid * 16 + i * 8192, R, C); const int Rb = (R & ~31) + perm32(R & 31);
        voffA[i] = (unsigned)(R * lda + C) * 2u; voffB[i] = (unsigned)(Rb * ldb + C) * 2u; }
    const size_t kstep = (size_t)(BK * 2);
    const size_t hstepA = (size_t)HALF * lda * 2, hstepB = (size_t)HALF * ldb * 2;
    const unsigned ldsw = (unsigned)wid * 1024u;
    const int aoff = lds_byte(wr * 64 + fr, fq * 8), boff = lds_byte(wc * 32 + fr, fq * 8);
    unsigned vgc[2][2], vgn[2][2];
#define PG8_SA(b, h) (((b) * 2 + (h)) * HTB)
#define PG8_SB(b, h) ((4 + (b) * 2 + (h)) * HTB)
#define PG8_GL(gp, voff, bufoff, _i) __builtin_amdgcn_global_load_lds((const unsigned*)((const char*)(gp) + (voff)), (LAS unsigned*)(lds + (bufoff) + ldsw + (_i) * 8192), 16, 0, 0)
#define PG8_STAGE_B(bufoff, gbase) do { PG8_GL(gbase, voffB[0], bufoff, 0); PG8_GL(gbase, voffB[1], bufoff, 1); } while (0)
#define PG8_STAGE_A(bufoff, gbase, h, VG) do { if constexpr (GATHER) { PG8_GL(gbase, VG[h][0], bufoff, 0); PG8_GL(gbase, VG[h][1], bufoff, 1); } \
        else { PG8_GL((gbase) + (h) * hstepA, voffA[0], bufoff, 0); PG8_GL((gbase) + (h) * hstepA, voffA[1], bufoff, 1); } } while (0)
#define PG8_CAT(x0, x1) __builtin_shufflevector(__builtin_bit_cast(v4i_t, x0), __builtin_bit_cast(v4i_t, x1), 0, 1, 2, 3, 4, 5, 6, 7)
#define PG8_RD(off) (*(const LAS bf16x8*)(lds + (off)))
#define PG8_LDA(dst, b, h) do { if constexpr (FP8) { _Pragma("unroll") for (int m = 0; m < 4; ++m) dst##8[m] = PG8_CAT(PG8_RD(PG8_SA(b, h) + aoff + m * 2048), PG8_RD(PG8_SA(b, h) + aoff + m * 2048 + 1024)); } \
        else { _Pragma("unroll") for (int m = 0; m < 4; ++m) _Pragma("unroll") for (int k = 0; k < 2; ++k) dst[m][k] = PG8_RD(PG8_SA(b, h) + aoff + m * 2048 + k * 1024); } } while (0)
#define PG8_LDB(dst, b, h) do { if constexpr (FP8) { _Pragma("unroll") for (int n = 0; n < 2; ++n) dst##8[n] = PG8_CAT(PG8_RD(PG8_SB(b, h) + boff + n * 2048), PG8_RD(PG8_SB(b, h) + boff + n * 2048 + 1024)); } \
        else { _Pragma("unroll") for (int n = 0; n < 2; ++n) _Pragma("unroll") for (int k = 0; k < 2; ++k) dst[n][k] = PG8_RD(PG8_SB(b, h) + boff + n * 2048 + k * 1024); } } while (0)
#define PG8_MMA(ai, bj, At, Bt) do { __builtin_amdgcn_s_setprio(1); _Pragma("unroll") for (int m = 0; m < 4; ++m) _Pragma("unroll") for (int n = 0; n < 2; ++n) { \
        if constexpr (FP8) asm volatile("v_mfma_scale_f32_16x16x128_f8f6f4 %0, %1, %2, %0, %3, %3 op_sel_hi:[0,0,0]" : "+v"(acc[ai][bj][m][n]) : "v"(Bt##8[n]), "v"(At##8[m]), "v"(sc8)); \
        else { _Pragma("unroll") for (int k = 0; k < 2; ++k) acc[ai][bj][m][n] = __builtin_amdgcn_mfma_f32_16x16x32_bf16(Bt[n][k], At[m][k], acc[ai][bj][m][n], 0, 0, 0); } } __builtin_amdgcn_s_setprio(0); } while (0)
#define PG8_WAIT_V(n) asm volatile("s_waitcnt vmcnt(" #n ")" ::: "memory")
#define PG8_WAIT_L(n) asm volatile("s_waitcnt lgkmcnt(" #n ")" ::: "memory")
#define PG8_BAR __builtin_amdgcn_s_barrier()
#define PG8_SCHED __builtin_amdgcn_sched_barrier(0)
#define PG8_GIDX(VG, U) do { const int _t = wid * 64 + lane_id();   \
        _Pragma("unroll") for (int _i = 0; _i < 2; ++_i) { int _R, _C; stage_rc(_t * 16 + _i * 8192, _R, _C); _Pragma("unroll") for (int _h = 0; _h < 2; ++_h) \
        VG[_h][_i] = (unsigned)((U).grow + (U).gi[_h * HALF + _R]) * (unsigned)(lda * 2) + (unsigned)_C * 2u; } } while (0)
    Unit cur, nxt; int ui = 0;
    if (!S.next(0, cur)) return;
    Acc acc;
#pragma unroll
    for (int a = 0; a < 2; ++a)
#pragma unroll
        for (int b = 0; b < 2; ++b)
#pragma unroll
            for (int m = 0; m < 4; ++m)
#pragma unroll
                for (int n = 0; n < 2; ++n) acc[a][b][m][n] = (f32x4){0.f, 0.f, 0.f, 0.f};
    bf16x8 At[4][2], B0[2][2], B1[2][2];
    v8i_t At8[4], B08[2], B18[2];
    unsigned sc8 = 0x7f7f7f7fu; asm volatile("" : "+v"(sc8));
    const char* cA = cur.a; const char* cB = cur.b;
    if constexpr (GATHER) { PG8_GIDX(vgc, cur); } else { vgc[0][0] = vgc[0][1] = vgc[1][0] = vgc[1][1] = 0u; }
    E.prep(cur, wr, wc, fr, fq);
    PG8_STAGE_B(PG8_SB(0, 0), cB); PG8_STAGE_B(PG8_SB(0, 1), cB + hstepB); PG8_STAGE_A(PG8_SA(0, 0), cA, 0, vgc); PG8_STAGE_A(PG8_SA(0, 1), cA, 1, vgc);
    if (wr == 1) PG8_BAR;
    PG8_WAIT_V(2); PG8_BAR;
    PG8_STAGE_B(PG8_SB(1, 0), cB + kstep); PG8_STAGE_A(PG8_SA(1, 0), cA + kstep, 0, vgc); PG8_STAGE_B(PG8_SB(1, 1), cB + hstepB + kstep);
    PG8_WAIT_V(6); PG8_BAR;
    for (;;) {
        const bool has_next = S.next(ui + 1, nxt);
        const char* nA = has_next ? nxt.a : cA; const char* nB = has_next ? nxt.b : cB;
        if constexpr (GATHER) { if (has_next) { PG8_GIDX(vgn, nxt); } else {
#pragma unroll
            for (int h = 0; h < 2; ++h) { vgn[h][0] = vgc[h][0]; vgn[h][1] = vgc[h][1]; } } }
        else { vgn[0][0] = vgn[0][1] = vgn[1][0] = vgn[1][1] = 0u; }
        for (int t = 0; t < nt; t += 2) {
            const bool last = (t == nt - 2);
            const char* a1 = cA + (size_t)(t + 1) * kstep;
            const char* a2 = last ? nA : cA + (size_t)(t + 2) * kstep; const char* b2 = last ? nB : cB + (size_t)(t + 2) * kstep;
            const char* a3 = a2 + kstep; const char* b3 = b2 + kstep;
            if constexpr (Epi::MIDK) { if (t == (nt >> 1)) E.midk(acc); }
            PG8_LDB(B0, 0, 0); PG8_LDB(B1, 0, 1); PG8_SCHED; PG8_LDA(At, 0, 0); PG8_STAGE_A(PG8_SA(1, 1), a1, 1, vgc);
            if constexpr (GATHER) { if (last) {
#pragma unroll
                for (int h = 0; h < 2; ++h) { vgc[h][0] = vgn[h][0]; vgc[h][1] = vgn[h][1]; } } }
            PG8_WAIT_V(8); PG8_WAIT_L(0); PG8_BAR; PG8_MMA(0, 0, At, B0); PG8_MMA(0, 1, At, B1); PG8_BAR; PG8_SCHED;
            PG8_LDA(At, 0, 1); PG8_STAGE_B(PG8_SB(0, 0), b2); PG8_STAGE_B(PG8_SB(0, 1), b2 + hstepB); PG8_STAGE_A(PG8_SA(0, 0), a2, 0, vgc);
            PG8_WAIT_V(8); PG8_WAIT_L(0); PG8_BAR; PG8_MMA(1, 0, At, B0); PG8_MMA(1, 1, At, B1); PG8_BAR; PG8_SCHED;
            PG8_LDB(B0, 1, 0); PG8_LDB(B1, 1, 1); PG8_SCHED; PG8_LDA(At, 1, 0); PG8_STAGE_A(PG8_SA(0, 1), a2, 1, vgc);
            PG8_WAIT_V(8); PG8_WAIT_L(0); PG8_BAR; PG8_MMA(0, 0, At, B0); PG8_MMA(0, 1, At, B1); PG8_BAR; PG8_SCHED;
            PG8_LDA(At, 1, 1); PG8_STAGE_B(PG8_SB(1, 0), b3); PG8_STAGE_B(PG8_SB(1, 1), b3 + hstepB); PG8_STAGE_A(PG8_SA(1, 0), a3, 0, vgc);
            PG8_WAIT_V(8); PG8_WAIT_L(0); PG8_BAR; PG8_MMA(1, 0, At, B0); PG8_MMA(1, 1, At, B1); PG8_BAR; PG8_SCHED;
        }
        if constexpr (ALIGN_EPI) { if (wr == 0) PG8_BAR; }
        if constexpr (FP8) asm volatile("s_nop 15\n\ts_nop 15\n\ts_nop 15\n\ts_nop 15" ::: "memory");
        E(acc, cur, wr, wc, fr, fq);
        if (!has_next) break;
#pragma unroll
        for (int a = 0; a < 2; ++a)
#pragma unroll
            for (int b = 0; b < 2; ++b)
#pragma unroll
                for (int m = 0; m < 4; ++m)
#pragma unroll
                    for (int n = 0; n < 2; ++n) acc[a][b][m][n] = (f32x4){0.f, 0.f, 0.f, 0.f};
        cur = nxt; cA = nA; cB = nB; ++ui;
#pragma unroll
        for (int h = 0; h < 2; ++h) { vgc[h][0] = vgn[h][0]; vgc[h][1] = vgn[h][1]; }
        E.prep(cur, wr, wc, fr, fq);
        if constexpr (ALIGN_EPI) { if (wr == 1) PG8_BAR; }
    }
    PG8_WAIT_V(0);
    if constexpr (!ALIGN_EPI) { if (wr == 0) PG8_BAR; }
    PG8_BAR;
#undef PG8_SA
#undef PG8_SB
#undef PG8_GL
#undef PG8_STAGE_A
#undef PG8_STAGE_B
#undef PG8_LDA
#undef PG8_RD
#undef PG8_LDB
#undef PG8_MMA
#undef PG8_CAT
#undef PG8_WAIT_V
#undef PG8_WAIT_L
#undef PG8_SCHED
#undef PG8_GIDX
}

#define EPI_ROWS for (int ai = 0; ai < 2; ++ai) _Pragma("unroll") for (int m = 0; m < 4; ++m)
__device__ __forceinline__ v4u pack8(const f32x4 a, const f32x4 b) { v4u w; w.x = cvt_pk_bf16(a[0], a[1]); w.y = cvt_pk_bf16(a[2], a[3]); w.z = cvt_pk_bf16(b[0], b[1]); w.w = cvt_pk_bf16(b[2], b[3]); return w; }

__device__ __forceinline__ void st8x2(unsigned char* pa, unsigned char* pb, const v2u a, const v2u b, const int fq, const bool nt) {
    const auto r0 = __builtin_amdgcn_permlane16_swap(a.x, b.x, false, false); const auto r1 = __builtin_amdgcn_permlane16_swap(a.y, b.y, false, false);
    const unsigned x0 = r0[0], x1 = r0[1], y0 = r1[0], y1 = r1[1];
    const v4u w = (v4u){x0, y0, x1, y1};
    unsigned char* p = (fq & 1) ? pb - 8 : pa;
    if (nt) __builtin_nontemporal_store(w, (v4u*)p); else *(v4u*)p = w;
}
template <int mode, bool OUT8 = false>
struct EpiStore {
    static constexpr bool MIDK = false;
    bf16* O; int ldc; const float* cs; float scale; bool skip = false;
    __device__ __forceinline__ void prep(const Unit&, int, int, int, int) {}
    __device__ __forceinline__ void midk(Acc&) {}
    __device__ __forceinline__ void operator()(const Acc& acc, const Unit& u, int wr, int wc, int fr, int fq) const {
        asm volatile("" : "+v"(fr), "+v"(fq));
        if (skip) return;
        size_t base; const float* csp = cs;
        if constexpr (mode == 0) base = (size_t)u.pm * 256 * ldc + (size_t)u.pn * 256;
        else if constexpr (mode == 1) { const int lb = u.pm >> 2, h = u.pm & 3; base = (size_t)lb * D * D + (size_t)(h * 256) * D + u.pn * 256; csp = cs + (size_t)(lb >> 2) * D + u.pn * 256; }
        else if constexpr (mode == 2) { const int pml = u.pm & 3, lbh = u.pm >> 2, h = lbh & 3, lb = lbh >> 2; base = (size_t)lb * D * D + (size_t)(pml * 256) * D + h * 256; }
        else { const int l = u.pm >> 2, pml = u.pm & 3; base = (size_t)l * NMEM * 2 * D + (size_t)(pml * 256) * 2 * D + u.pn * 256; }
        const int cb = wc * 32 + 8 * fq;
        f32x4 c0[2], c1[2];
#pragma unroll
        for (int bj = 0; bj < 2; ++bj) { if (csp) { c0[bj] = *(const f32x4*)(csp + bj * HALF + cb) * scale; c1[bj] = *(const f32x4*)(csp + bj * HALF + cb + 4) * scale; } else { c0[bj] = (f32x4){scale, scale, scale, scale}; c1[bj] = c0[bj]; } }
#pragma unroll
        EPI_ROWS { bf16* rowp = O + base + (size_t)(ai * HALF + wr * 64 + m * 16 + fr) * ldc + cb;
            if constexpr (OUT8) { unsigned char* rp8 = (unsigned char*)O + base + (size_t)(ai * HALF + wr * 64 + m * 16 + fr) * ldc + cb;
#pragma unroll
                for (int bj = 0; bj < 2; ++bj) { const f32x4 a = acc[ai][bj][m][0] * c0[bj], b = acc[ai][bj][m][1] * c1[bj]; v2u o; o.x = pk4_fp8(a[0], a[1], a[2], a[3]); o.y = pk4_fp8(b[0], b[1], b[2], b[3]); *(v2u*)(rp8 + bj * HALF) = o; } }
            else
#pragma unroll
            for (int bj = 0; bj < 2; ++bj) { const v4u w_ = pack8(acc[ai][bj][m][0] * c0[bj], acc[ai][bj][m][1] * c1[bj]); if constexpr (mode == 0 && NT_Y) __builtin_nontemporal_store(w_, (v4u*)(rowp + bj * HALF)); else *(v4u*)(rowp + bj * HALF) = w_; } }
    }
};
struct EpiH {
    static constexpr bool MIDK = false;
    unsigned char* H;
    __device__ __forceinline__ void prep(const Unit&, int, int, int, int) {}
    __device__ __forceinline__ void midk(Acc&) {}
    __device__ __forceinline__ void operator()(const Acc& acc, const Unit& u, int wr, int wc, int fr, int fq) const {
        asm volatile("" : "+v"(fr), "+v"(fq));
        const int cb = u.pn * 128 + wc * 32 + 8 * fq; constexpr float us = 1.0f / (W8S * A8S);
#pragma unroll
        for (int ai = 0; ai < 2; ++ai)
#pragma unroll
            for (int m = 0; m < 4; m += 2) { const int rl = ai * HALF + wr * 64 + m * 16 + fr; unsigned char* rowp = H + (size_t)(u.pm * 256 + rl) * FF + cb;
                v2u o[2];
#pragma unroll
                for (int q = 0; q < 2; ++q) { const f32x4 h0 = silu_mul4(acc[ai][0][m + q][0], acc[ai][1][m + q][0], us, H8S), h1 = silu_mul4(acc[ai][0][m + q][1], acc[ai][1][m + q][1], us, H8S);
                    o[q].x = pk4_fp8(h0[0], h0[1], h0[2], h0[3]); o[q].y = pk4_fp8(h1[0], h1[1], h1[2], h1[3]); }
                st8x2(rowp, rowp + (size_t)16 * FF, o[0], o[1], fq, false); }
    }
};
struct EpiY8 {
    static constexpr bool MIDK = false;
    unsigned char* Y; float scale; bool skip = false, halfst = false;
    __device__ __forceinline__ void prep(const Unit&, int, int, int, int) {}
    __device__ __forceinline__ void midk(Acc&) {}
    __device__ __forceinline__ void operator()(const Acc& acc, const Unit& u, int wr, int wc, int fr, int fq) const {
        if (skip) return;
        asm volatile("" : "+v"(fr), "+v"(fq));
        const int cb = u.pn * 256 + wc * 32 + 8 * fq;
#pragma unroll
        for (int ai = 0; ai < 2; ++ai)
#pragma unroll
            for (int m = 0; m < 4; m += 2) { unsigned char* rp0 = Y + (size_t)(u.pm * 256 + ai * HALF + wr * 64 + m * 16 + fr) * D + cb; unsigned char* rp1 = rp0 + (size_t)16 * D;
#pragma unroll
                for (int bj = 0; bj < 2; ++bj) { v2u o0, o1;
                    { const f32x4 a = acc[ai][bj][m][0] * scale, b = acc[ai][bj][m][1] * scale; o0.x = pk4_fp8(a[0], a[1], a[2], a[3]); o0.y = pk4_fp8(b[0], b[1], b[2], b[3]); }
                    { const f32x4 a = acc[ai][bj][m + 1][0] * scale, b = acc[ai][bj][m + 1][1] * scale; o1.x = pk4_fp8(a[0], a[1], a[2], a[3]); o1.y = pk4_fp8(b[0], b[1], b[2], b[3]); }
                    st8x2(rp0 + bj * HALF, rp1 + bj * HALF, o0, o1, fq, false); } }
    }
};
template <bool MK, bool WRITE_XB>
struct EpiX {
    static constexpr bool MIDK = MK;
    bf16* xr; float* xstat; const float* gmstat; const float* atstat; LAS unsigned char* lds; unsigned char* xa8; float scale;
#if REPK == 2 || REPK == 4
    long wofs = 0;
#else
    static constexpr long wofs = 0;
#endif
    int wr_, wc_, fr_;
    __device__ __forceinline__ void prep(const Unit& u, int wr, int wc, int fr, int fq) {
        wr_ = wr; wc_ = wc; fr_ = fr;
        if constexpr (MK) {
            asm volatile("" : "+v"(fr), "+v"(fq));
            LAS f32x2* X = (LAS f32x2*)(lds + RING_BYTES + 1024) + (wr * 4 + wc) * 128;
#pragma unroll
            EPI_ROWS { const size_t row = (size_t)u.pm * 256 + ai * HALF + wr * 64 + m * 16 + fr;
                const f32x4 g = *(const f32x4*)(gmstat + row * 4), a0 = *(const f32x4*)(atstat + row * 8), a1 = *(const f32x4*)(atstat + row * 8 + 4);
                const float sg = (g[0] + g[1]) + (g[2] + g[3]), sa = ((a0[0] + a0[1]) + (a0[2] + a0[3])) + ((a1[0] + a1[1]) + (a1[2] + a1[3]));
                const float rgm = __builtin_amdgcn_rsqf(sg * (1.0f / 512.0f) + EPS), rat = __builtin_amdgcn_rsqf(sa * (1.0f / 512.0f) + EPS);
                if (fq == 0) X[(ai * 4 + m) * 16 + fr] = (f32x2){rgm / rat, rat}; }
            asm volatile("s_waitcnt lgkmcnt(0)" ::: "memory");
        }
    }
    __device__ __forceinline__ void midk(Acc& acc) {
        int fr = fr_; asm volatile("" : "+v"(fr));
        const LAS f32x2* X = (const LAS f32x2*)(lds + RING_BYTES + 1024) + (wr_ * 4 + wc_) * 128;
#pragma unroll
        EPI_ROWS { const float f = X[(ai * 4 + m) * 16 + fr].x;
#pragma unroll
            for (int bj = 0; bj < 2; ++bj) { acc[ai][bj][m][0] *= f; acc[ai][bj][m][1] *= f; } }
    }
    __device__ __forceinline__ void operator()(const Acc& acc, const Unit& u, int wr, int wc, int fr, int fq) const {
        asm volatile("" : "+v"(fr), "+v"(fq));
        const int cb = u.pn * 256 + wc * 32 + 8 * fq;
        v4u rb[2][4][2];
#define EPX_LOAD(AI) _Pragma("unroll") for (int mm = 0; mm < 4; ++mm) _Pragma("unroll") for (int bj = 0; bj < 2; ++bj) rb[AI][mm][bj] = *(const v4u*)(xr + ((size_t)u.pm * 256 + (AI) * HALF + wr * 64 + mm * 16 + fr) * D + cb + bj * HALF);
        if constexpr (!WRITE_XB) { EPX_LOAD(0) EPX_LOAD(1) }
#pragma unroll
        for (int ai = 0; ai < 2; ++ai) {
            if constexpr (WRITE_XB) { if (ai == 0) { EPX_LOAD(0) } else { EPX_LOAD(1) } }
#pragma unroll
            for (int m = 0; m < 4; m += 2) {
                v2u o8[2][2];
#pragma unroll
                for (int q = 0; q < 2; ++q) { const size_t row = (size_t)u.pm * 256 + ai * HALF + wr * 64 + (m + q) * 16 + fr; const size_t off = row * D + cb;
                    float f = scale; if constexpr (MK) f = ((const LAS f32x2*)(lds + RING_BYTES + 1024) + (wr * 4 + wc) * 128)[(ai * 4 + m + q) * 16 + fr].y; float ss = 0.f;
#pragma unroll
                    for (int bj = 0; bj < 2; ++bj) { const v4u b = rb[ai][m + q][bj];
                        const f32x4 x0 = (f32x4){bflo(b.x), bfhi(b.x), bflo(b.y), bfhi(b.y)} + acc[ai][bj][m + q][0] * f, x1 = (f32x4){bflo(b.z), bfhi(b.z), bflo(b.w), bfhi(b.w)} + acc[ai][bj][m + q][1] * f;
                        *(v4u*)(xr + wofs + off + bj * HALF) = pack8(x0, x1);
                        if constexpr (WRITE_XB) { o8[q][bj].x = pk4_fp8(x0[0] * A8S, x0[1] * A8S, x0[2] * A8S, x0[3] * A8S); o8[q][bj].y = pk4_fp8(x1[0] * A8S, x1[1] * A8S, x1[2] * A8S, x1[3] * A8S);
                            ss += ((x0[0] * x0[0] + x0[1] * x0[1]) + (x0[2] * x0[2] + x0[3] * x0[3])) + ((x1[0] * x1[0] + x1[1] * x1[1]) + (x1[2] * x1[2] + x1[3] * x1[3])); } }
                    if constexpr (WRITE_XB) { ss = add_x32(add_x16(ss)); if (fq == 0) xstat[row * 16 + u.pn * 4 + wc] = ss; } }
                if constexpr (WRITE_XB) { unsigned char* rp = xa8 + ((size_t)u.pm * 256 + ai * HALF + wr * 64 + m * 16 + fr) * D + cb;
#pragma unroll
                    for (int bj = 0; bj < 2; ++bj) st8x2(rp + bj * HALF, rp + (size_t)16 * D + bj * HALF, o8[0][bj], o8[1][bj], fq, false); }
                asm volatile("" ::: "memory"); } }
#undef EPX_LOAD
    }
};
constexpr int EXCH_OFF = RING_BYTES + 1024;
struct EpiS {
    static constexpr bool MIDK = false;
    const float* xstat; unsigned char* P; LAS unsigned char* lds;
    __device__ __forceinline__ void prep(const Unit& u, int wr, int wc, int fr, int fq) {
        asm volatile("" : "+v"(fr), "+v"(fq));
        LAS float* RV = (LAS float*)(lds + EXCH_OFF + 8192) + (wr * 4 + wc) * 128;
#pragma unroll
        EPI_ROWS { const size_t row = (size_t)u.pm * 256 + ai * HALF + wr * 64 + m * 16 + fr;
            const f32x4 s0 = *(const f32x4*)(xstat + row * 16), s1 = *(const f32x4*)(xstat + row * 16 + 4), s2 = *(const f32x4*)(xstat + row * 16 + 8), s3 = *(const f32x4*)(xstat + row * 16 + 12);
            const float ssq = (((s0[0] + s0[1]) + (s0[2] + s0[3])) + ((s1[0] + s1[1]) + (s1[2] + s1[3]))) + (((s2[0] + s2[1]) + (s2[2] + s2[3])) + ((s3[0] + s3[1]) + (s3[2] + s3[3])));
            if (fq == 0) RV[(ai * 4 + m) * 16 + fr] = __builtin_amdgcn_rsqf(ssq * (1.0f / D) + EPS) * (1.0f / (A8S * Q8S)); }
        asm volatile("s_waitcnt lgkmcnt(0)" ::: "memory");
    }
    __device__ __forceinline__ void midk(Acc&) {}
    __device__ __forceinline__ void operator()(Acc& acc, const Unit& u, int wr, int wc, int fr, int fq) const {
        asm volatile("" : "+v"(fr), "+v"(fq));
        LAS f32x2* X = (LAS f32x2*)(lds + EXCH_OFF);
        float mw[2][4];
#pragma unroll
        EPI_ROWS { const int rl = ai * HALF + wr * 64 + m * 16 + fr;
            const float rinv = ((const LAS float*)(lds + EXCH_OFF + 8192) + (wr * 4 + wc) * 128)[(ai * 4 + m) * 16 + fr];
            float mx = -3.0e38f;
#pragma unroll
            for (int bj = 0; bj < 2; ++bj)
#pragma unroll
                for (int n = 0; n < 2; ++n) { acc[ai][bj][m][n] *= rinv; const f32x4 v = acc[ai][bj][m][n]; mx = fmaxf(mx, fmaxf(fmaxf(v[0], v[1]), fmaxf(v[2], v[3]))); }
            mx = max_x32(max_x16(mx));
            float sm = 0.f;
#pragma unroll
            for (int bj = 0; bj < 2; ++bj)
#pragma unroll
                for (int n = 0; n < 2; ++n) { f32x4 v = acc[ai][bj][m][n];
#pragma unroll
                    for (int i = 0; i < 4; ++i) { v[i] = __builtin_amdgcn_exp2f(v[i] - mx); sm += v[i]; }
                    acc[ai][bj][m][n] = v; }
            sm = add_x32(add_x16(sm));
            mw[ai][m] = mx;
            if (fq == 0) X[rl * 4 + wc] = (f32x2){mx, sm};
            if (m & 1) asm volatile("" ::: "memory"); }
        asm volatile("s_waitcnt lgkmcnt(0)\n\ts_barrier" ::: "memory");
        const int cb = u.pn * 256 + wc * 32 + 8 * fq;
#pragma unroll
        for (int ai = 0; ai < 2; ++ai)
#pragma unroll
            for (int m = 0; m < 4; m += 2) { float f[2];
#pragma unroll
                for (int q = 0; q < 2; ++q) { const int rl = ai * HALF + wr * 64 + (m + q) * 16 + fr;
                    const f32x2 e0 = X[rl * 4 + 0], e1 = X[rl * 4 + 1], e2 = X[rl * 4 + 2], e3 = X[rl * 4 + 3];
                    const float M = fmaxf(fmaxf(e0.x, e1.x), fmaxf(e2.x, e3.x));
                    const float den = (e0.y * __builtin_amdgcn_exp2f(e0.x - M) + e1.y * __builtin_amdgcn_exp2f(e1.x - M)) + (e2.y * __builtin_amdgcn_exp2f(e2.x - M) + e3.y * __builtin_amdgcn_exp2f(e3.x - M));
                    f[q] = __builtin_amdgcn_exp2f(mw[ai][m + q] - M) * __builtin_amdgcn_rcpf(den) * P8S; }
                unsigned char* rp = P + ((size_t)u.pm * 256 + ai * HALF + wr * 64 + m * 16 + fr) * D + cb;
#pragma unroll
                for (int bj = 0; bj < 2; ++bj) { v2u o[2];
#pragma unroll
                    for (int q = 0; q < 2; ++q) { const f32x4 a = acc[ai][bj][m + q][0] * f[q], b = acc[ai][bj][m + q][1] * f[q]; o[q].x = pk4_fp8(a[0], a[1], a[2], a[3]); o[q].y = pk4_fp8(b[0], b[1], b[2], b[3]); }
                    st8x2(rp + bj * HALF, rp + (size_t)16 * D + bj * HALF, o[0], o[1], fq, false); } }
        asm volatile("s_waitcnt lgkmcnt(0)" ::: "memory");
    }
};
struct EpiIn {
    static constexpr bool MIDK = false;
    bf16 *uact, *vact, *q, *k, *v; float* vstat; const float *qg, *kg, *cosT, *sinT, *rinv; bool nostore = false, skip = false;
    __device__ __forceinline__ void prep(const Unit&, int, int, int, int) {}
    __device__ __forceinline__ void midk(Acc&) {}
    __device__ __forceinline__ void operator()(const Acc& acc, const Unit& u, int wr, int wc, int fr, int fq) const {
        asm volatile("" : "+v"(fr), "+v"(fq));
        if (skip) return;
        const int pn = u.pn;
        if (pn < 4) {
            bf16* O = pn < 2 ? uact : vact; const int cb = (pn & 1) * 256 + wc * 32 + 8 * fq;
#pragma unroll
            EPI_ROWS { const size_t row = (size_t)u.pm * 256 + ai * HALF + wr * 64 + m * 16 + fr; float ss = 0.f; const float ri = rinv[row];
#pragma unroll
                for (int bj = 0; bj < 2; ++bj) { const f32x4 g0 = gelu4(acc[ai][bj][m][0] * ri), g1 = gelu4(acc[ai][bj][m][1] * ri);
                    const v4u w = pack8(g0, g1); st16(O + row * GMW + cb + bj * HALF, w, nostore);
                    if (pn >= 2) { const float a0 = bflo(w.x), a1 = bfhi(w.x), a2 = bflo(w.y), a3 = bfhi(w.y), a4 = bflo(w.z), a5 = bfhi(w.z), a6 = bflo(w.w), a7 = bfhi(w.w);
                        ss += ((a0 * a0 + a1 * a1) + (a2 * a2 + a3 * a3)) + ((a4 * a4 + a5 * a5) + (a6 * a6 + a7 * a7)); } }
                if (pn >= 2) { ss = add_x32(add_x16(ss)); if (fq == 0) vstat[row * 8 + (pn - 2) * 4 + wc] = ss; } }
        } else if (pn == 6 && wc >= 2) {
#pragma unroll
            EPI_ROWS { const size_t row = (size_t)u.pm * 256 + ai * HALF + wr * 64 + m * 16 + fr; const float ri = rinv[row];
#pragma unroll
                for (int bj = 0; bj < 2; ++bj) st16(v + row * 128 + (wc - 2) * 64 + bj * 32 + 8 * fq, pack8(acc[ai][bj][m][0] * ri, acc[ai][bj][m][1] * ri), nostore); }
        } else {
            const bool isq = pn < 6; const float* g = isq ? qg : kg; const float sc = isq ? QSCALE : 1.0f;
            bf16* O = isq ? q + ((pn - 4) * 4 + wc) * 64 : k + wc * 64; const int ldo = isq ? 512 : 128;
            f32x4 gv[2][2];
#pragma unroll
            for (int bj = 0; bj < 2; ++bj) { gv[bj][0] = *(const f32x4*)(g + bj * 32 + 8 * fq) * sc; gv[bj][1] = *(const f32x4*)(g + bj * 32 + 8 * fq + 4) * sc; }
#pragma unroll
            EPI_ROWS { const size_t row = (size_t)u.pm * 256 + ai * HALF + wr * 64 + m * 16 + fr; const int t = (int)(row % SEQ); const float ri = this->rinv[row];
                float ss = 0.f;
#pragma unroll
                for (int bj = 0; bj < 2; ++bj)
#pragma unroll
                    for (int n = 0; n < 2; ++n) { const f32x4 x = acc[ai][bj][m][n]; ss += (x[0] * x[0] + x[1] * x[1]) + (x[2] * x[2] + x[3] * x[3]); }
                ss = add_x32(add_x16(ss));
                const float rinv = ri * __builtin_amdgcn_rsqf(ss * (ri * ri) * (1.0f / 64.0f) + EPS);
#pragma unroll
                for (int bj = 0; bj < 2; ++bj) { const f32x4 c = *(const f32x4*)(cosT + t * 32 + bj * 16 + 4 * fq), sn = *(const f32x4*)(sinT + t * 32 + bj * 16 + 4 * fq);
                    const f32x4 x0 = acc[ai][bj][m][0] * gv[bj][0] * rinv, x1 = acc[ai][bj][m][1] * gv[bj][1] * rinv; f32x4 o0, o1;
                    o0[0] = x0[0] * c[0] - x0[1] * sn[0]; o0[1] = x0[0] * sn[0] + x0[1] * c[0]; o0[2] = x0[2] * c[1] - x0[3] * sn[1]; o0[3] = x0[2] * sn[1] + x0[3] * c[1];
                    o1[0] = x1[0] * c[2] - x1[1] * sn[2]; o1[1] = x1[0] * sn[2] + x1[1] * c[2]; o1[2] = x1[2] * c[3] - x1[3] * sn[3]; o1[3] = x1[2] * sn[3] + x1[3] * c[3];
                    st16(O + row * ldo + bj * 32 + 8 * fq, pack8(o0, o1), nostore); }
                if (m & 1) asm volatile("" ::: "memory"); }
        }
    }
};
}


struct CvtJob { const float* W; const float* gain; bf16* WT; int K, N, dst_row0, k0, n0; bool f8; };
__device__ __forceinline__ CvtJob cvt_decode(const Frame& F, int it) {
    constexpr int I_IN = 16 * 56, I_SQ = 512, I_KV = 1024, I_HEAD = I_IN + I_SQ + I_KV + I_SQ, I_LAYER = I_HEAD + NE * 3 * I_SQ;
    CvtJob j; j.f8 = false; const int l = it / I_LAYER; int r = it % I_LAYER;
    if (r < I_IN) { const int kb = r / 56, nb = r % 56, n0 = nb * 32, pn = n0 >> 8; int dr = n0;
        if (pn >= 4) { const int sidx = n0 & 255, w = sidx >> 6, bj = (sidx >> 5) & 1; dr = pn * 256 + 128 * bj + 32 * w; }
        j.W = F.in[3] + (size_t)l * D * INW; j.gain = F.in[2] + (size_t)l * D; j.WT = (bf16*)(F.ws + WS_WIN) + (size_t)l * INW * D; j.K = D; j.N = INW; j.dst_row0 = dr; j.k0 = kb * 64; j.n0 = n0; return j; }
    r -= I_IN;
    if (r < I_SQ) { j.W = F.in[10] + (size_t)l * D * D; j.gain = F.in[9] + (size_t)l * D; j.WT = (bf16*)(F.ws + WS_WOUT) + (size_t)l * D * D; j.K = D; j.N = D; j.dst_row0 = (r % 32) * 32; j.k0 = (r / 32) * 64; j.n0 = (r % 32) * 32; return j; }
    r -= I_SQ;
    if (r < I_KV) { j.W = F.in[14] + (size_t)l * D * 2 * D; j.gain = nullptr; j.WT = (bf16*)(F.ws + WS_WKVT) + (size_t)l * 2 * D * D; j.K = D; j.N = 2 * D; j.dst_row0 = (r % 64) * 32; j.k0 = (r / 64) * 64; j.n0 = (r % 64) * 32; return j; }
    r -= I_KV;
    if (r < I_SQ) { j.W = F.in[15] + (size_t)l * D * D; j.gain = nullptr; j.WT = (bf16*)(F.ws + WS_WOT) + (size_t)l * D * D; j.K = D; j.N = D; j.dst_row0 = (r % 32) * 32; j.k0 = (r / 32) * 64; j.n0 = (r % 32) * 32; return j; }
    r -= I_SQ;
    const int e = r / (3 * I_SQ), rr = r % (3 * I_SQ), which = rr / I_SQ, sub = rr % I_SQ, kb = sub / 32, n0 = (sub % 32) * 32;
    const size_t mo = ((size_t)l * NE + e) * D * FF;
    j.K = D; j.N = FF; j.k0 = kb * 64; j.n0 = n0;
    j.f8 = true;
    if (which == 2) { j.W = F.in[20] + mo; j.gain = nullptr; j.WT = (bf16*)(F.ws + WS_WD + mo); j.dst_row0 = n0; }
    else { j.W = (which == 0 ? F.in[18] : F.in[19]) + mo; j.gain = F.in[16] + (size_t)l * D; j.WT = (bf16*)(F.ws + WS_WGU + 2 * mo); j.dst_row0 = 256 * (n0 >> 7) + 128 * which + (n0 & 127); }
    return j;
}
#define CVT_LOAD(J, R) do { const float* p_ = (J).W + (size_t)((J).k0 + (lane_ >> 5)) * (J).N + (J).n0 + (lane_ & 31); _Pragma("unroll") for (int i_ = 0; i_ < 32; ++i_) R[i_] = __builtin_nontemporal_load(p_ + (size_t)(2 * i_) * (J).N); } while (0)
#ifndef CVT_DEFER_E
#define CVT_DEFER_E 8
#endif
#ifndef CVT_DEFER_A
#define CVT_DEFER_A 3
#endif
constexpr int CVT_I_LAYER = 16 * 56 + 512 + 1024 + 512 + NE * 3 * 512, CVT_ND = CVT_DEFER_E * 3 * 512, CVT_NDA = CVT_DEFER_A * 3 * 512;
constexpr int CVT_N1 = CVT_I_LAYER - CVT_ND, CVT_N2 = CVT_I_LAYER - CVT_ND - CVT_NDA;
constexpr int CVT_NPRO = CVT_I_LAYER + (NL > 1 ? CVT_N1 : 0) + (NL > 2 ? (NL - 2) * CVT_N2 : 0);
__device__ __forceinline__ int cvt_map(int L, int part, int i) {
    if (L >= 1) return L * CVT_I_LAYER + (part ? CVT_N1 : CVT_N2) + i;
    if (i < CVT_I_LAYER) return i;
    int j = i - CVT_I_LAYER; if (j < CVT_N1) return CVT_I_LAYER + j;
    j -= CVT_N1; const int l = 2 + j / CVT_N2, r = j % CVT_N2; return l * CVT_I_LAYER + r;
}
#define CVT_EMIT(cur) do { \
            const int c = lane_ & 7; \
            f32x4 g0 = (f32x4){1.f, 1.f, 1.f, 1.f}, g1 = g0; \
            if (cur.gain) { g0 = *(const f32x4*)(cur.gain + cur.k0 + 8 * c); g1 = *(const f32x4*)(cur.gain + cur.k0 + 8 * c + 4); } \
_Pragma("unroll") \
            for (int j = 0; j < 4; ++j) { const int n = (lane_ >> 3) + 8 * j; const LAS float* sp = scr + (8 * c) * 33 + n; \
                if (cur.f8) { v2u o; o.x = pk4_fp8(sp[0 * 33] * g0[0] * W8S, sp[1 * 33] * g0[1] * W8S, sp[2 * 33] * g0[2] * W8S, sp[3 * 33] * g0[3] * W8S); o.y = pk4_fp8(sp[4 * 33] * g1[0] * W8S, sp[5 * 33] * g1[1] * W8S, sp[6 * 33] * g1[2] * W8S, sp[7 * 33] * g1[3] * W8S); \
                    *(v2u*)((unsigned char*)cur.WT + (size_t)(cur.dst_row0 + n) * cur.K + cur.k0 + 8 * c) = o; } \
                else { v4u o; o.x = pk2(sp[0 * 33] * g0[0], sp[1 * 33] * g0[1]); o.y = pk2(sp[2 * 33] * g0[2], sp[3 * 33] * g0[3]); o.z = pk2(sp[4 * 33] * g1[0], sp[5 * 33] * g1[1]); o.w = pk2(sp[6 * 33] * g1[2], sp[7 * 33] * g1[3]); \
                    *(v4u*)(cur.WT + (size_t)(cur.dst_row0 + n) * cur.K + cur.k0 + 8 * c) = o; } } \
    } while (0)
__device__ __forceinline__ void cvt_pool(Frame& F, const int L, const int part, unsigned* ctr) {
    int lane_ = lane_id(); asm volatile("" : "+v"(lane_)); const int tid_ = F.wave * 64 + lane_;
    LAS float* scr = (LAS float*)(F.lds + F.wave * 16384);
    LAS int* slot = (LAS int*)(F.lds + RING_BYTES + 1024);
    const int NT = (part ? CVT_ND : CVT_NDA) / NWAVES;
    if (tid_ == 0) slot[0] = (int)__hip_atomic_fetch_add(ctr, 1u, __ATOMIC_RELAXED, __HIP_MEMORY_SCOPE_AGENT);
    __syncthreads();
    const int tk0 = slot[0];
    if (tk0 < NT) {
        CvtJob cur = cvt_decode(F, cvt_map(L, part, tk0 * NWAVES + F.wave)); float r[32]; CVT_LOAD(cur, r);
        for (int k = 1; ; ++k) {
            unsigned tn = 0u; if (tid_ == 0) tn = __hip_atomic_fetch_add(ctr, 1u, __ATOMIC_RELAXED, __HIP_MEMORY_SCOPE_AGENT);
#pragma unroll
            for (int i = 0; i < 32; ++i) scr[(2 * i + (lane_ >> 5)) * 33 + (lane_ & 31)] = r[i];
            if (tid_ == 0) slot[k & 1] = (int)tn;
            __syncthreads();
            const int tkn = slot[k & 1]; const bool hn = tkn < NT; CvtJob nx = cur; if (hn) { nx = cvt_decode(F, cvt_map(L, part, tkn * NWAVES + F.wave)); CVT_LOAD(nx, r); }
            asm volatile("s_waitcnt lgkmcnt(0)" ::: "memory");
            CVT_EMIT(cur);
            asm volatile("s_waitcnt lgkmcnt(0)" ::: "memory");
            if (!hn) break; cur = nx;
        }
    }
    __syncthreads();
}
__device__ __forceinline__ void cvt_items(Frame& F, const int L, const int part, const int gw, const int NGW) {
    int lane_ = lane_id(); asm volatile("" : "+v"(lane_));
    LAS float* scr = (LAS float*)(F.lds + F.wave * 16384);
    const int NITEMS = L >= 1 ? (part ? CVT_ND : CVT_NDA) : CVT_NPRO;
    if (gw < NITEMS) {
        int it = gw; CvtJob cur = cvt_decode(F, cvt_map(L, part, it)); float r[32]; CVT_LOAD(cur, r);
        for (;;) {
            const int nit = it + NGW; const bool hn = nit < NITEMS; CvtJob nx = cur; if (hn) nx = cvt_decode(F, cvt_map(L, part, nit));
#pragma unroll
            for (int i = 0; i < 32; ++i) scr[(2 * i + (lane_ >> 5)) * 33 + (lane_ & 31)] = r[i];
            if (hn) CVT_LOAD(nx, r);
            asm volatile("s_waitcnt lgkmcnt(0)" ::: "memory");
            const int c = lane_ & 7;
            f32x4 g0 = (f32x4){1.f, 1.f, 1.f, 1.f}, g1 = g0;
            if (cur.gain) { g0 = *(const f32x4*)(cur.gain + cur.k0 + 8 * c); g1 = *(const f32x4*)(cur.gain + cur.k0 + 8 * c + 4); }
#pragma unroll
            for (int j = 0; j < 4; ++j) { const int n = (lane_ >> 3) + 8 * j; const LAS float* sp = scr + (8 * c) * 33 + n;
                if (cur.f8) { v2u o; o.x = pk4_fp8(sp[0 * 33] * g0[0] * W8S, sp[1 * 33] * g0[1] * W8S, sp[2 * 33] * g0[2] * W8S, sp[3 * 33] * g0[3] * W8S); o.y = pk4_fp8(sp[4 * 33] * g1[0] * W8S, sp[5 * 33] * g1[1] * W8S, sp[6 * 33] * g1[2] * W8S, sp[7 * 33] * g1[3] * W8S);
                    *(v2u*)((unsigned char*)cur.WT + (size_t)(cur.dst_row0 + n) * cur.K + cur.k0 + 8 * c) = o; }
                else { v4u o; o.x = pk2(sp[0 * 33] * g0[0], sp[1 * 33] * g0[1]); o.y = pk2(sp[2 * 33] * g0[2], sp[3 * 33] * g0[3]); o.z = pk2(sp[4 * 33] * g1[0], sp[5 * 33] * g1[1]); o.w = pk2(sp[6 * 33] * g1[2], sp[7 * 33] * g1[3]);
                    *(v4u*)(cur.WT + (size_t)(cur.dst_row0 + n) * cur.K + cur.k0 + 8 * c) = o; } }
            asm volatile("s_waitcnt lgkmcnt(0)" ::: "memory");
            if (!hn) break; cur = nx; it = nit;
        }
    }
}
__device__ __forceinline__ void ph_convert(Frame& F) {
    int lane_ = lane_id(); asm volatile("" : "+v"(lane_)); const int tid_ = F.wave * 64 + lane_;
    cvt_items(F, -1, 0, F.vcu * NWAVES + F.wave, F.G * NWAVES);
    {   const float* wsrc = F.in[5]; bf16* WSBd = (bf16*)(F.ws + WS_WSB);
        for (int i = F.vcu * NTHR + tid_; i < NL * 4 * 128 * 128 / 8; i += F.G * NTHR) { const f32x4 a = *(const f32x4*)(wsrc + (size_t)i * 8), b = *(const f32x4*)(wsrc + (size_t)i * 8 + 4);
            v4u o; o.x = pk2(a.x, a.y); o.y = pk2(a.z, a.w); o.z = pk2(b.x, b.y); o.w = pk2(b.z, b.w); *(v4u*)(WSBd + (size_t)i * 8) = o; } }
    {   bf16* WRH = (bf16*)(F.ws + WS_WRH); bf16* WRL = (bf16*)(F.ws + WS_WRL);
        for (int i = F.vcu * NTHR + tid_; i < NL * NE * D; i += F.G * NTHR) { const int l = i / (NE * D), e = (i / D) % NE, c = i % D;
            const float w = F.in[17][((size_t)l * D + c) * NE + e] * F.in[16][(size_t)l * D + c]; const unsigned h = f2bf(w); WRH[i] = (bf16)h; WRL[i] = (bf16)f2bf(w - bf2f(h)); } }
    const int gt = F.vcu * NTHR + tid_, NGT = F.G * NTHR;
    const float* wq = F.in[13]; bf16* WQB = (bf16*)(F.ws + WS_WQB);
    for (int i = gt; i < NL * D * D / 8; i += NGT) { const f32x4 a = *(const f32x4*)(wq + (size_t)i * 8), b = *(const f32x4*)(wq + (size_t)i * 8 + 4);
        v4u o; o.x = pk2(a.x, a.y); o.y = pk2(a.z, a.w); o.z = pk2(b.x, b.y); o.w = pk2(b.z, b.w); *(v4u*)(WQB + (size_t)i * 8) = o; }
}

struct SchedDense {
    pg8::TileOrder o; const char* A; size_t a_tile; const char* B; size_t b_tile, b_batch; int bdiv, bmod;
    __device__ __forceinline__ bool next(int i, pg8::Unit& u) const { if (!o.tile(i, u.pm, u.pn)) return false;
        u.z = 0; u.gi = nullptr; u.grow = 0; u.a = A + (size_t)u.pm * a_tile; u.b = B + (size_t)((u.pm / bdiv) % bmod) * b_batch + (size_t)u.pn * b_tile; return true; }
};
struct SchedE1 {
    pg8::TileOrder o; const char* HBp; const int* IDX; const char* WGU;
    __device__ __forceinline__ bool next(int i, pg8::Unit& u) const { if (!o.tile(i, u.pm, u.pn)) return false;
        const int z = u.pm >> 2, q = u.pm & 3, e = z / NB_, b = z % NB_; u.z = z; u.gi = IDX + ((size_t)(b * NE + e) * 4 + q) * 256; u.grow = b * SEQ; u.a = HBp;
        u.b = WGU + (size_t)e * (2 * FF * D) + (size_t)u.pn * (256 * D); return true; }
};
struct SchedKV { pg8::TileOrder o; const char* MEMN; const char* WKVT; int pm0 = 0;
    __device__ __forceinline__ bool next(int i, pg8::Unit& u) const { if (!o.tile(i, u.pm, u.pn)) return false; u.pm += pm0; u.z = 0; u.gi = nullptr; u.grow = 0;
        u.a = MEMN + (size_t)(u.pm & 3) * (256 * D * 2); u.b = WKVT + (size_t)(u.pm >> 2) * (2 * D * D * 2) + (size_t)u.pn * (256 * D * 2); return true; } };
struct SchedQK { pg8::TileOrder o; const char* KVM; const char* WQB; int pm0 = 0;
    __device__ __forceinline__ bool next(int i, pg8::Unit& u) const { if (!o.tile(i, u.pm, u.pn)) return false; u.pm += pm0; u.z = 0; u.gi = nullptr; u.grow = 0;
        const int h = u.pm & 3, lb = u.pm >> 2, b = lb & 3, l = lb >> 2;
        u.a = KVM + ((size_t)l * NMEM * 2 * D + (size_t)(b * 256) * 2 * D + h * 256) * 2; u.b = WQB + ((size_t)l * D * D + (size_t)u.pn * 256 * D + h * 256) * 2; return true; } };
struct SchedVO { pg8::TileOrder o; const char* KVM; const char* WOT; int pm0 = 0;
    __device__ __forceinline__ bool next(int i, pg8::Unit& u) const { if (!o.tile(i, u.pm, u.pn)) return false; u.pm += pm0; u.z = 0; u.gi = nullptr; u.grow = 0;
        const int pml = u.pm & 3, lbh = u.pm >> 2, h = lbh & 3, lb = lbh >> 2, b = lb & 3, l = lb >> 2;
        u.a = WOT + ((size_t)l * D * D + (size_t)pml * 256 * D + h * 256) * 2; u.b = KVM + ((size_t)l * NMEM * 2 * D + (size_t)(b * 256) * 2 * D + D + h * 256) * 2; return true; } };

namespace attn_body {
#if REPK == 300 || REPK == 301 || REPK == 302
#ifndef PROBE_WAVE
#define PROBE_WAVE 0
#endif
#define ATS_PROBE ((blockIdx.x == 0) ? (unsigned*)((char*)ATS - WS_ATSTAT + WS_CTL + 64) : (unsigned*)nullptr)
#endif
using bf16=__hip_bfloat16;
using bf16x8=__attribute__((ext_vector_type(8)))short;
using s16x4=__attribute__((ext_vector_type(4)))short;
using f32x16=__attribute__((ext_vector_type(16)))float;
using u32x4=__attribute__((ext_vector_type(4)))unsigned;
constexpr int SEQ=8192,D=64,QP=512,KP=128,OP=1024;
constexpr int NW=8,QBLK=32,QB=QBLK*NW,KVBLK=64,NQB=SEQ/QB;
constexpr int ATTN_UNIT_ROWS=QB;
__device__ __forceinline__ int crow(int r,int hi){return (r&3)+8*(r>>2)+4*hi;}
#define SBAR() __builtin_amdgcn_sched_barrier(0)
__device__ __forceinline__ void cmask(f32x16&p0,f32x16&p1,int jb,int qrel,int hi){
  const float NEG=-INFINITY; int kb=64*jb+4*hi;
  #pragma unroll
  for(int r=0;r<16;++r){int kv=kb+(r&3)+8*(r>>2); if(kv>qrel)p0[r]=NEG; if(kv+32>qrel)p1[r]=NEG;}
}

constexpr int NSLOT=3, SLOTB=8192;
constexpr int LDS_K=0, LDS_V=NSLOT*SLOTB, LDS_WS=2*NSLOT*SLOTB, LDS_OST=LDS_WS+NW*64*4, LDS_BYTES=LDS_OST+NW*4096;
constexpr float C2=0.125f*1.4426950408889634f;
__device__ __forceinline__ void glds16(const void*gsrc,unsigned lds_dst){unsigned keep;
  asm volatile("s_mov_b32 %0, m0\n\ts_mov_b32 m0, %2\n\ts_nop 0\n\tglobal_load_lds_dwordx4 %1, off\n\ts_mov_b32 m0, %0":"=&s"(keep):"v"(gsrc),"s"(lds_dst):"memory");}
__device__ __forceinline__ float max3f(float a,float b,float c){float r;asm("v_max3_f32 %0, %1, %2, %3":"=v"(r):"v"(a),"v"(b),"v"(c));return r;}
__device__ __forceinline__ float max2f(float a,float b){float r;asm("v_max_f32_e32 %0, %1, %2":"=v"(r):"v"(a),"v"(b));return r;}
__device__ __forceinline__ float fadd_s(float a,float b){float r;asm("v_add_f32_e32 %0, %1, %2":"=v"(r):"v"(a),"v"(b));return r;}
__device__ __forceinline__ float fsub_s(float a,float b){float r;asm("v_sub_f32_e32 %0, %1, %2":"=v"(r):"v"(a),"v"(b));return r;}
typedef float f32x2_t __attribute__((ext_vector_type(2))); typedef __bf16 bf16x2_t __attribute__((ext_vector_type(2)));
__device__ __forceinline__ unsigned cvtpk_s(float lo,float hi){f32x2_t v={lo,hi};bf16x2_t b=__builtin_convertvector(v,bf16x2_t);return __builtin_bit_cast(unsigned,b);}
#define WAIT_BAR(N) asm volatile("s_waitcnt vmcnt(" #N ") lgkmcnt(0)\n\ts_barrier":::"memory")

__device__ __forceinline__ void qkt(f32x16&p0,f32x16&p1,const char*Kslot,const bf16x8*qr,const f32x16&negm,int r32,int hi){
  const char*kb=Kslot+hi*1024+r32*16;
  #pragma unroll
  for(int d0=0;d0<4;++d0){
    const bf16x8 b0=*reinterpret_cast<const bf16x8*>(kb+d0*2048);
    const bf16x8 b1=*reinterpret_cast<const bf16x8*>(kb+d0*2048+512);
    if(d0==0){p0=__builtin_amdgcn_mfma_f32_32x32x16_bf16(b0,qr[0],negm,0,0,0);p1=__builtin_amdgcn_mfma_f32_32x32x16_bf16(b1,qr[0],negm,0,0,0);}
    else{p0=__builtin_amdgcn_mfma_f32_32x32x16_bf16(b0,qr[d0],p0,0,0,0);p1=__builtin_amdgcn_mfma_f32_32x32x16_bf16(b1,qr[d0],p1,0,0,0);}}
}
typedef __attribute__((address_space(3))) const char* lds_cptr;
typedef short v4i16_t __attribute__((ext_vector_type(4)));
__device__ __forceinline__ void kload8(bf16x8*kf,lds_cptr kp){
  kf[0]=*(const __attribute__((address_space(3))) bf16x8*)(kp);      kf[1]=*(const __attribute__((address_space(3))) bf16x8*)(kp+512);
  kf[2]=*(const __attribute__((address_space(3))) bf16x8*)(kp+2048); kf[3]=*(const __attribute__((address_space(3))) bf16x8*)(kp+2560);
  kf[4]=*(const __attribute__((address_space(3))) bf16x8*)(kp+4096); kf[5]=*(const __attribute__((address_space(3))) bf16x8*)(kp+4608);
  kf[6]=*(const __attribute__((address_space(3))) bf16x8*)(kp+6144); kf[7]=*(const __attribute__((address_space(3))) bf16x8*)(kp+6656);
}
__device__ __forceinline__ void kload2(bf16x8*kf,lds_cptr kp,int j){ kf[2*j]=*(const __attribute__((address_space(3))) bf16x8*)(kp+j*2048); kf[2*j+1]=*(const __attribute__((address_space(3))) bf16x8*)(kp+j*2048+512); }
__device__ __forceinline__ s16x4 vtr(lds_cptr p){ return __builtin_bit_cast(s16x4,__builtin_amdgcn_ds_read_tr16_b64_v4i16((__attribute__((address_space(3))) v4i16_t*)p)); }
__device__ __forceinline__ float rowmax(const f32x16&p0,const f32x16&p1){
  float a=max3f(p0[0],p0[1],p1[0]),b=max3f(p0[2],p0[3],p1[1]);a=max3f(a,p1[2],p1[3]);
  #pragma unroll
  for(int r=4;r<16;r+=4){a=max3f(a,p0[r],p0[r+1]);b=max3f(b,p0[r+2],p0[r+3]);a=max3f(a,p1[r],p1[r+1]);b=max3f(b,p1[r+2],p1[r+3]);}
  const float m=max2f(a,b);
  auto rr=__builtin_amdgcn_permlane32_swap(__float_as_uint(m),__float_as_uint(m),false,false);
  return max2f(__uint_as_float(rr[0]),__uint_as_float(rr[1]));
}
__device__ __forceinline__ void pv(f32x16*o,int vb,bf16x8 pa0,bf16x8 pa1,bf16x8 pa2,bf16x8 pa3){
  #pragma unroll
  for(int d0=0;d0<2;++d0){s16x4 lo[4],hi[4];
    #pragma unroll
    for(int ks=0;ks<4;++ks){
      asm volatile("ds_read_b64_tr_b16 %0,%1 offset:%c2":"=&v"(lo[ks]):"v"(vb),"i"(d0*4096+ks*1024):"memory");
      asm volatile("ds_read_b64_tr_b16 %0,%1 offset:%c2":"=&v"(hi[ks]):"v"(vb),"i"(d0*4096+ks*1024+512):"memory");}
    asm volatile("s_waitcnt lgkmcnt(0)":::"memory");SBAR();
    #define PK(k) (bf16x8){lo[k][0],lo[k][1],lo[k][2],lo[k][3],hi[k][0],hi[k][1],hi[k][2],hi[k][3]}
    o[d0]=__builtin_amdgcn_mfma_f32_32x32x16_bf16(pa0,PK(0),o[d0],0,0,0);
    o[d0]=__builtin_amdgcn_mfma_f32_32x32x16_bf16(pa1,PK(1),o[d0],0,0,0);
    o[d0]=__builtin_amdgcn_mfma_f32_32x32x16_bf16(pa2,PK(2),o[d0],0,0,0);
    o[d0]=__builtin_amdgcn_mfma_f32_32x32x16_bf16(pa3,PK(3),o[d0],0,0,0);
    #undef PK
  }
}

#ifndef ATTN_STORE16
#define ATTN_STORE16(p,v) (*(u32x4*)(p)=(v))
#endif
template<int THRL,bool STATIC_REF,bool LSUM> __device__ __forceinline__ void attn_unit(int b,int h,int qb,const bf16*Q,const bf16*__restrict__ K,const bf16*__restrict__ V,bf16*O,float*ATS,char*shm,int wave_idx,float refB){
  int lane; asm volatile("v_mbcnt_lo_u32_b32 %0, -1, 0\n\tv_mbcnt_hi_u32_b32 %0, -1, %0":"=v"(lane)); const int r32=lane&31,hi=lane>>5; const int wid=wave_idx; const int kvh=h>>2;
  const long rowbase=(long)b*SEQ; const int q0=qb*QB;
  const bf16*Qw=Q+(rowbase+q0+wid*QBLK)*QP+h*D;
  const bf16*Kh=K+rowbase*KP+kvh*D,*Vh=V+rowbase*KP+kvh*D;
  const unsigned lds0=(unsigned)(uintptr_t)shm;
  float*wsf=(float*)(shm+LDS_WS)+wid*64;
  const bf16*ksrc=Kh+(long)lane*KP+wid*8;
  const bf16*vsrc=Vh+(long)(16*(wid&3)+(lane>>2))*KP+(wid>>2)*32+(lane&3)*8;
  const unsigned kdst=lds0+LDS_K+wid*1024, vdst=lds0+LDS_V+wid*1024;
  #define DMA_K(t,slot) glds16(ksrc+(long)(t)*KVBLK*KP,(unsigned)__builtin_amdgcn_readfirstlane(kdst+(slot)))
  #define DMA_V(t,slot) glds16(vsrc+(long)(t)*KVBLK*KP,(unsigned)__builtin_amdgcn_readfirstlane(vdst+(slot)))
  const int vb0=(int)(lds0+LDS_V)+((lane>>4)&1)*32+(lane&3)*8+(4*hi+((lane&15)>>2))*64;
  const char*Kbase=shm+LDS_K; bf16x8 kf[8];
  const lds_cptr shm3=(lds_cptr)shm; const lds_cptr kp0=shm3+LDS_K+hi*1024+r32*16; const lds_cptr vp0=shm3+LDS_V+((lane>>4)&1)*32+(lane&3)*8+(4*hi+((lane&15)>>2))*64;
  const int NT=SEQ/KVBLK;
  DMA_K(0,0);DMA_V(0,0);DMA_K(1,SLOTB);
  bf16x8 qr[4];
  #pragma unroll
  for(int d0=0;d0<4;++d0)qr[d0]=*reinterpret_cast<const bf16x8*>(&Qw[(long)r32*QP+d0*16+hi*8]);
  float mhat=0.f,l_reg=0.f;f32x16 o[2];o[0]=f32x16{};o[1]=f32x16{};f32x16 negm=f32x16{};
  if constexpr(STATIC_REF){ _Pragma("unroll") for(int r=0;r<16;++r)negm[r]=-refB; }
  asm volatile("":"+v"(negm));
  f32x16 lblk=f32x16{}; unsigned one2_; asm volatile("v_mov_b32 %0, 0x3f803f80":"=v"(one2_)); const bf16x8 ones8=__builtin_bit_cast(bf16x8,(u32x4){one2_,one2_,one2_,one2_});
  const int qrel=wid*QBLK+r32;
  #define CMASK(P0,P1,t) do{}while(0)
  bool resc=false;
  #define START(P0,P1) do{ if constexpr(!STATIC_REF){ const float rm=rowmax(P0,P1); resc=false; \
    { const float dl=rm; mhat=fadd_s(mhat,dl); \
      _Pragma("unroll") for(int r=0;r<16;++r){P0[r]=fsub_s(P0[r],dl);P1[r]=fsub_s(P1[r],dl);} \
      _Pragma("unroll") for(int r=0;r<16;++r)negm[r]=-mhat; asm volatile("":"+v"(negm)); } } \
    _Pragma("unroll") for(int r=0;r<16;++r)P0[r]=__builtin_amdgcn_exp2f(P0[r]); }while(0)
  #define RESC() do{ if constexpr(!STATIC_REF) if(resc){ asm volatile("s_waitcnt lgkmcnt(0)":::"memory"); \
      _Pragma("unroll") for(int d_=0;d_<2;++d_) _Pragma("unroll") for(int r=0;r<16;++r)o[d_][r]*=wsf[crow(r,hi)]; } }while(0)
  f32x16 pA0,pA1,pB0,pB1;
  int sl_prev=0,sl_cur=0,sl_next=SLOTB;
  #define ROT() do{sl_prev=sl_cur;sl_cur=sl_next;sl_next=(sl_next==(NSLOT-1)*SLOTB)?0:sl_next+SLOTB;}while(0)
  DMA_K(2,2*SLOTB);
  WAIT_BAR(3);
  qkt(pA0,pA1,Kbase,qr,negm,r32,hi);asm volatile("s_nop 15\n\ts_nop 7":"+v"(pA0),"+v"(pA1));CMASK(pA0,pA1,0);
  START(pA0,pA1);
  _Pragma("unroll") for(int r=0;r<16;++r)pA1[r]=__builtin_amdgcn_exp2f(pA1[r]);
  WAIT_BAR(0);
  DMA_K(3,0);DMA_V(1,SLOTB);
  ROT();
  kload8(kf,kp0+sl_cur);
  WAIT_BAR(2);
  asm volatile("":"+v"(kf[0]),"+v"(kf[1]),"+v"(kf[2]),"+v"(kf[3]),"+v"(kf[4]),"+v"(kf[5]),"+v"(kf[6]),"+v"(kf[7]));
  s16x4 vlo[8],vhi[8]; u32x4 pw0,pw1,pw2,pw3;
  #define PKW(P,B) cvtpk_s(P[B],P[B+1])
  #define PAF(k) __builtin_bit_cast(bf16x8,pw##k)
  #define VFR(i) (bf16x8){vlo[i][0],vlo[i][1],vlo[i][2],vlo[i][3],vhi[i][0],vhi[i][1],vhi[i][2],vhi[i][3]}
  #define PIN(x) asm volatile("":"+v"(x))
  #define MX3(a,b,c) __builtin_fmaxf(__builtin_fmaxf((a),(b)),(c))
  #define GAPA(MF,A0,A1,A2,A3,W0,W1,PW) do{ MF; if constexpr(!LSUM){ sacc+=A0; sacc+=A1; sacc+=A2; sacc+=A3; PIN(sacc); } W0; W1; PIN(PW); SBAR(); }while(0)
  #define GAPA2(MF,A0,A1,W0,W1,PW) do{ MF; if constexpr(!LSUM){ sacc+=A0; sacc+=A1; PIN(sacc); } W0; W1; PIN(PW); SBAR(); }while(0)
  #define LSM(k) do{ if constexpr(LSUM){ lblk=__builtin_amdgcn_mfma_f32_32x32x16_bf16(PAF(k),ones8,lblk,0,0,0); SBAR(); } }while(0)
  #define EX(v) __builtin_amdgcn_exp2f(v)
  #define GAPB(MF,X,B) do{ MF; X[B]=EX(X[B]); X[B+1]=EX(X[B+1]); X[B+2]=EX(X[B+2]); X[B+3]=EX(X[B+3]); PIN(X); SBAR(); }while(0)
  #define VRD(i) do{ vlo[i]=vtr(vp_+(((i)>>2)*4096+((i)&3)*1024)); vhi[i]=vtr(vp_+(((i)>>2)*4096+((i)&3)*1024+512)); }while(0)
  #define KRD(G,j) do{ if(G){ kload2(kf,kp0+sl_next,j); SBAR(); } }while(0)
  #define PINKF() asm volatile("":"+v"(kf[0]),"+v"(kf[1]),"+v"(kf[2]),"+v"(kf[3]),"+v"(kf[4]),"+v"(kf[5]),"+v"(kf[6]),"+v"(kf[7]))
  #define STEP(C0,C1,P0,P1,t,GK,GV,GL) do{ SBAR(); \
    const lds_cptr vp_=vp0+sl_prev; \
    VRD(0); SBAR(); float sacc=0.f; if constexpr(!LSUM) sacc=(P0[0]+P0[1]); \
    GAPA(C0=__builtin_amdgcn_mfma_f32_32x32x16_bf16(kf[0],qr[0],negm,0,0,0), P0[2],P0[3],P0[4],P0[5],     pw0[0]=PKW(P0,0), pw0[1]=PKW(P0,2), pw0); \
    VRD(4); SBAR(); GAPA(C1=__builtin_amdgcn_mfma_f32_32x32x16_bf16(kf[1],qr[0],negm,0,0,0), P0[6],P0[7],P0[8],P0[9],     pw0[2]=PKW(P0,4), pw0[3]=PKW(P0,6), pw0); \
    VRD(1); SBAR(); GAPA(C0=__builtin_amdgcn_mfma_f32_32x32x16_bf16(kf[2],qr[1],C0,0,0,0),   P0[10],P0[11],P0[12],P0[13], pw1[0]=PKW(P0,8), pw1[1]=PKW(P0,10), pw1); \
    VRD(5); SBAR(); GAPA(C1=__builtin_amdgcn_mfma_f32_32x32x16_bf16(kf[3],qr[1],C1,0,0,0),   P0[14],P0[15],P1[0],P1[1],   pw1[2]=PKW(P0,12),pw1[3]=PKW(P0,14), pw1); \
    VRD(2); SBAR(); GAPA(C0=__builtin_amdgcn_mfma_f32_32x32x16_bf16(kf[4],qr[2],C0,0,0,0),   P1[2],P1[3],P1[4],P1[5],     pw2[0]=PKW(P1,0), pw2[1]=PKW(P1,2), pw2); \
    VRD(6); SBAR(); GAPA(C1=__builtin_amdgcn_mfma_f32_32x32x16_bf16(kf[5],qr[2],C1,0,0,0),   P1[6],P1[7],P1[8],P1[9],     pw2[2]=PKW(P1,4), pw2[3]=PKW(P1,6), pw2); \
    VRD(3); SBAR(); GAPA(C0=__builtin_amdgcn_mfma_f32_32x32x16_bf16(kf[6],qr[3],C0,0,0,0),   P1[10],P1[11],P1[12],P1[13], pw3[0]=PKW(P1,8), pw3[1]=PKW(P1,10), pw3); \
    VRD(7); SBAR(); GAPA2(C1=__builtin_amdgcn_mfma_f32_32x32x16_bf16(kf[7],qr[3],C1,0,0,0),  P1[14],P1[15],               pw3[2]=PKW(P1,12),pw3[3]=PKW(P1,14), pw3); \
    l_reg+=sacc; \
    if(GK){DMA_K((t)+3,sl_cur);} if(GV){DMA_V((t)+1,sl_next);} \
    CMASK(C0,C1,t); \
    if constexpr(!STATIC_REF){ float a=MX3(C0[0],C0[1],C1[0]),b=MX3(C0[2],C0[3],C1[1]); a=MX3(a,C1[2],C1[3]); \
      _Pragma("unroll") for(int r=4;r<16;r+=4){a=MX3(a,C0[r],C0[r+1]);b=MX3(b,C0[r+2],C0[r+3]);a=MX3(a,C1[r],C1[r+1]);b=MX3(b,C1[r+2],C1[r+3]);} \
      float rm=__builtin_fmaxf(a,b); { auto rr=__builtin_amdgcn_permlane32_swap(__float_as_uint(rm),__float_as_uint(rm),false,false); rm=__builtin_fmaxf(__uint_as_float(rr[0]),__uint_as_float(rr[1])); } \
      resc=false; \
      if(__builtin_expect(__any(rm>(float)THRL),0)){ const float dl=__builtin_fmaxf(rm,0.f); mhat+=dl; \
        _Pragma("unroll") for(int r=0;r<16;++r){C0[r]-=dl;C1[r]-=dl;} \
        _Pragma("unroll") for(int r=0;r<16;++r)negm[r]=-mhat; asm volatile("":"+v"(negm)); \
        const float f=__builtin_amdgcn_exp2f(-dl); l_reg*=f; if(hi==0)wsf[r32]=f; resc=true; } } \
    SBAR(); \
    GAPB(o[0]=__builtin_amdgcn_mfma_f32_32x32x16_bf16(PAF(0),VFR(0),o[0],0,0,0), C0,0); \
    GAPB(o[1]=__builtin_amdgcn_mfma_f32_32x32x16_bf16(PAF(0),VFR(4),o[1],0,0,0), C0,4); \
    LSM(0); KRD(GL,0); GAPB(o[0]=__builtin_amdgcn_mfma_f32_32x32x16_bf16(PAF(1),VFR(1),o[0],0,0,0), C0,8); \
    KRD(GL,1); GAPB(o[1]=__builtin_amdgcn_mfma_f32_32x32x16_bf16(PAF(1),VFR(5),o[1],0,0,0), C0,12); \
    LSM(1); KRD(GL,2); GAPB(o[0]=__builtin_amdgcn_mfma_f32_32x32x16_bf16(PAF(2),VFR(2),o[0],0,0,0), C1,0); \
    KRD(GL,3); GAPB(o[1]=__builtin_amdgcn_mfma_f32_32x32x16_bf16(PAF(2),VFR(6),o[1],0,0,0), C1,4); \
    LSM(2); GAPB(o[0]=__builtin_amdgcn_mfma_f32_32x32x16_bf16(PAF(3),VFR(3),o[0],0,0,0), C1,8); \
    GAPB(o[1]=__builtin_amdgcn_mfma_f32_32x32x16_bf16(PAF(3),VFR(7),o[1],0,0,0), C1,12); LSM(3); \
    }while(0)
  int t=1;
#if REPK == 302
  unsigned long long tc0_, tr0_; asm volatile("s_memtime %0\n\ts_memrealtime %1\n\ts_waitcnt lgkmcnt(0)":"=s"(tc0_),"=s"(tr0_)::"memory");
#endif
#if REPK == 300 || REPK == 301
  unsigned tw_acc=0u; unsigned long long tu0; asm volatile("s_memtime %0\n\ts_waitcnt lgkmcnt(0)":"=s"(tu0)::"memory");
  #if REPK == 300
  #define WAIT_BAR_T() do{ unsigned long long a_,b_; asm volatile("s_waitcnt vmcnt(2) lgkmcnt(0)\n\ts_memtime %0\n\ts_barrier\n\ts_memtime %1\n\ts_waitcnt lgkmcnt(0)":"=s"(a_),"=s"(b_)::"memory"); tw_acc+=(unsigned)(b_-a_); }while(0)
  #else
  #define WAIT_BAR_T() do{ unsigned long long a_,b_; asm volatile("s_memtime %0\n\ts_waitcnt vmcnt(2) lgkmcnt(0)\n\ts_memtime %1\n\ts_barrier\n\ts_waitcnt lgkmcnt(0)":"=s"(a_),"=s"(b_)::"memory"); tw_acc+=(unsigned)(b_-a_); }while(0)
  #endif
#else
  #define WAIT_BAR_T() WAIT_BAR(2)
#endif
  for(;t+5<NT;t+=2){
    STEP(pB0,pB1,pA0,pA1,t,true,true,true);     WAIT_BAR_T(); PINKF(); RESC(); ROT();
    STEP(pA0,pA1,pB0,pB1,t+1,true,true,true);   WAIT_BAR_T(); PINKF(); RESC(); ROT();
  }
#if REPK == 302
  { unsigned long long tc1_, tr1_; asm volatile("s_memtime %0\n\ts_memrealtime %1\n\ts_waitcnt lgkmcnt(0)":"=s"(tc1_),"=s"(tr1_)::"memory");
    if(ATS_PROBE&&wave_idx==0&&lane==0){ atomicAdd(ATS_PROBE,(unsigned)(tc1_-tc0_)); atomicAdd(ATS_PROBE+1,(unsigned)(tr1_-tr0_)*30u); } }
#endif
#if REPK == 300 || REPK == 301
  { unsigned long long tu1; asm volatile("s_memtime %0\n\ts_waitcnt lgkmcnt(0)":"=s"(tu1)::"memory");
    if(ATS_PROBE&&wave_idx==PROBE_WAVE&&lane==0){ atomicAdd(ATS_PROBE,tw_acc); atomicAdd(ATS_PROBE+1,(unsigned)(tu1-tu0)); } }
#endif
  #undef WAIT_BAR_T
  #define ENDW(tt) do{ if((tt)+3<NT){WAIT_BAR(2);} else if((tt)+2<NT){WAIT_BAR(1);} else {WAIT_BAR(0);} }while(0)
  for(;t+1<NT;t+=2){
    STEP(pB0,pB1,pA0,pA1,t,(t+3<NT),(t+1<NT),(t+1<NT));       ENDW(t);   RESC(); ROT();
    STEP(pA0,pA1,pB0,pB1,t+1,(t+4<NT),(t+2<NT),(t+2<NT));     ENDW(t+1); RESC(); ROT();
  }
  STEP(pB0,pB1,pA0,pA1,NT-1,false,false,false); RESC();
  { if constexpr(!LSUM){ float sacc=pB0[0]+pB0[1]; _Pragma("unroll") for(int r=2;r<16;++r)sacc+=pB0[r]; _Pragma("unroll") for(int r=0;r<16;++r)sacc+=pB1[r]; l_reg+=sacc; }
    pw0=(u32x4){PKW(pB0,0),PKW(pB0,2),PKW(pB0,4),PKW(pB0,6)};pw1=(u32x4){PKW(pB0,8),PKW(pB0,10),PKW(pB0,12),PKW(pB0,14)};pw2=(u32x4){PKW(pB1,0),PKW(pB1,2),PKW(pB1,4),PKW(pB1,6)};pw3=(u32x4){PKW(pB1,8),PKW(pB1,10),PKW(pB1,12),PKW(pB1,14)};
    SBAR(); pv(o,vb0+sl_cur,PAF(0),PAF(1),PAF(2),PAF(3)); LSM(0); LSM(1); LSM(2); LSM(3); }
  #undef PKW
  #undef PAF
  #undef VFR
  #undef PIN
  #undef MX3
  #undef GAPA
  #undef GAPA2
  #undef LSM
  #undef GAPB
  #undef EX
  #undef VRD
  #undef KRD
  #undef PINKF
  #undef STEP
  #undef ENDW
  float rli[16];
  if constexpr(LSUM){ asm volatile("s_nop 15\n\ts_nop 7":"+v"(lblk));
    #pragma unroll
    for(int r=0;r<16;++r)rli[r]=__builtin_amdgcn_rcpf(lblk[r]); }
  else{
  {auto rr=__builtin_amdgcn_permlane32_swap(__float_as_uint(l_reg),__float_as_uint(l_reg),false,false);l_reg=__uint_as_float(rr[0])+__uint_as_float(rr[1]);}
  if(hi==0)wsf[32+r32]=l_reg;asm volatile("s_waitcnt lgkmcnt(0)":::"memory");
  #pragma unroll
  for(int r=0;r<16;++r)rli[r]=__builtin_amdgcn_rcpf(wsf[32+crow(r,hi)]); }
  bf16*Ow=O+(rowbase+q0+wid*QBLK)*OP+512+h*D; float*ATw=ATS+(rowbase+q0+wid*QBLK)*8+h;
  { bf16*stg=(bf16*)(shm+LDS_OST)+wid*2048;
    #pragma unroll
    for(int r=0;r<16;++r){const int orow=crow(r,hi);
      #pragma unroll
      for(int d0=0;d0<2;++d0)stg[orow*64+d0*32+r32]=__float2bfloat16(o[d0][r]*rli[r]);}
    asm volatile("s_waitcnt lgkmcnt(0)":::"memory");
    #pragma unroll
    for(int i=0;i<4;++i){const int row=i*8+(lane>>3),ch=lane&7; const u32x4 v=*(const u32x4*)(stg+row*64+ch*8); ATTN_STORE16(Ow+(long)row*OP+ch*8,v);
      float ss=0.f;
      #pragma unroll
      for(int q=0;q<4;++q){const float lo=__uint_as_float(v[q]<<16),hh=__uint_as_float(v[q]&0xffff0000u);ss+=lo*lo+hh*hh;}
      ss=sum_row8(ss); if(ch==0)ATw[(long)row*8]=ss;} }
  asm volatile("s_waitcnt lgkmcnt(0)\n\ts_barrier":::"memory");
  #undef DMA_K
  #undef DMA_V
  #undef CMASK
  #undef START
  #undef RESC
  #undef ROT
}
constexpr int ATTN_LDS_BYTES=LDS_BYTES;
#undef SBAR
#undef WAIT_BAR
}

__global__ void __launch_bounds__(NTHR, 2) mega(Args args) {
    extern __shared__ __attribute__((aligned(16))) unsigned char lds[];
    Frame F;
    F.lds = (LAS unsigned char*)lds;
    F.wave = __builtin_amdgcn_readfirstlane(threadIdx.x >> 6);
    F.G = gridDim.x; { const int bx = blockIdx.x; F.vcu = (F.G % 8 == 0) ? (bx % 8) * (F.G / 8) + bx / 8 : bx; }
#pragma unroll
    for (int i = 0; i < 22; ++i) F.in[i] = args.in[i];
    F.ws = args.ws; F.xres = args.out;
    volatile LAS unsigned* MISC = (volatile LAS unsigned*)(F.lds + MISC_OFF);
    for (int u = threadIdx.x; u < (LDS_BYTES - LDSCTL_OFF) / 4; u += NTHR) ((LAS unsigned*)(F.lds + LDSCTL_OFF))[u] = 0u;
    __syncthreads();
    const int lo = args.ph_lo, hi = args.ph_hi;
    unsigned* barw = (unsigned*)(F.ws + WS_CTL) + CW_BAR + args.bar_region * XCD_BAR_WORDS;
    XcdBarrier bar; bar.bar = barw; bar.x = 0; bar.st = nullptr;
    if (hi - lo > 1) { bar = xcd_barrier_post(barw, MISC + 8); map_check_post((unsigned*)(F.ws + WS_CTL)); }
#ifndef ONLY_K
#define ONLY_K -1
#endif
#define EN(kind) (ONLY_K < 0 || ONLY_K == (kind))
#ifndef ALIGN_A
#define ALIGN_A true
#endif
#ifndef ATTN_LSUM
#define ATTN_LSUM false
#endif
#ifndef ALIGN_IN
#define ALIGN_IN true
#endif
#ifndef ALIGN_E1
#define ALIGN_E1 true
#endif
#define IN(k) (lo <= (k) && (k) < hi)

#define PROBE_TOP(k) for (int rep_ = 0; rep_ < (REPK == (k) ? 2 : 1); ++rep_) {
#define PROBE_END(k) if (REPK == (k) && rep_ == 0) xcd_barrier(bar); }
#if REPK == 310
#ifndef PROBE_SEAM
#define PROBE_SEAM -1
#endif
#define SEAM_SEL(k) (PROBE_SEAM < 0 || (PROBE_SEAM == 10 ? (k) < PH_LAYER0 : ((k) >= PH_LAYER0 && ((k) - PH_LAYER0) % PH_PER_LAYER == PROBE_SEAM)))
    if (threadIdx.x == 0) { MISC[12] = 0u; MISC[13] = (unsigned)__builtin_amdgcn_s_memrealtime(); }
#define SEAM(k) do { if (IN(k) && IN((k) + 1)) { unsigned t0_ = 0u; \
        if (threadIdx.x == 0) { t0_ = (unsigned)__builtin_amdgcn_s_memrealtime(); \
            if ((k) == PH_END - 2) { unsigned* pc_ = (unsigned*)(F.ws + WS_CTL + 64); atomicAdd(pc_, MISC[12]); if (blockIdx.x == 0) atomicAdd(pc_ + 1, (t0_ - MISC[13]) * gridDim.x); } } \
        xcd_barrier(bar); \
        if (threadIdx.x == 0 && SEAM_SEL(k)) MISC[12] += (unsigned)__builtin_amdgcn_s_memrealtime() - t0_; } } while (0)
#define SEAMG(k) SEAM(k)
#else
#define SEAM(k) do { if (IN(k) && IN((k) + 1)) { xcd_barrier(bar); if (REPK == 200) xcd_barrier(bar); } } while (0)
#ifndef GROUP_SEAMS
#define GROUP_SEAMS 1
#endif
#define GRP_OK() (GROUP_SEAMS && F.G == 256 && (hi - lo > 1) && MISC[15] == 1u)
#define SEAMG(k) do { if (IN(k) && IN((k) + 1)) { if (GRP_OK()) xcdl_barrier((unsigned*)(F.ws + WS_CTL), bar); else xcd_barrier(bar); } } while (0)
#endif
    const int cid0 = (int)blockIdx.x; const int cid = cid0;
    if (EN(100) && IN(0)) { asm volatile("; PHASE_MARK P0"); PROBE_TOP(100) ph_rows0(F); PROBE_END(100) }
    if (EN(101) && IN(1)) { asm volatile("; PHASE_MARK P1"); PROBE_TOP(101) ph_convert(F); PROBE_END(101) } SEAM(1);
    if (threadIdx.x == 0) MISC[15] = (xb_ld((unsigned*)(F.ws + WS_CTL) + CW_MAPBAD) == 0u) ? 1u : 2u;
    __syncthreads();

#define RUN_KV(GG, CC) do { SchedKV S_; S_.o.init(NL * 4, 8, (GG), (CC)); S_.MEMN = (const char*)(F.ws + WS_MEMN); S_.WKVT = (const char*)(F.ws + WS_WKVT); \
        pg8::EpiStore<3> E_{(bf16*)(F.ws + WS_KVM), 2 * D, nullptr, 1.0f}; pg8::gemm_phase<pg8::EpiStore<3>, SchedKV, true, false>(F.lds, F.wave, D, D, D, S_, E_); } while (0)
#define RUN_QK(LL, GG, CC) do { SchedQK S_; S_.o.init(16, 4, (GG), (CC)); S_.pm0 = (LL) * 16; S_.KVM = (const char*)(F.ws + WS_KVM); S_.WQB = (const char*)(F.ws + WS_WQB); \
        pg8::EpiStore<1, true> E_{(bf16*)(F.ws + WS_QKT), D, F.in[11], XQSCALE * Q8S}; int la_ = 2 * D, lb_ = D, kk_ = 256; asm volatile("" : "+s"(la_), "+s"(lb_), "+s"(kk_)); \
        pg8::gemm_phase<pg8::EpiStore<1, true>, SchedQK, true, false>(F.lds, F.wave, la_, lb_, kk_, S_, E_); } while (0)
#define RUN_VO(LL, GG, CC) do { SchedVO S_; S_.o.init(64, 1, (GG), (CC)); S_.pm0 = (LL) * 64; S_.KVM = (const char*)(F.ws + WS_KVM); S_.WOT = (const char*)(F.ws + WS_WOT); \
        pg8::EpiStore<2, true> E_{(bf16*)(F.ws + WS_VOT), D, nullptr, V8S}; int la_ = D, lb_ = 2 * D, kk_ = 256; asm volatile("" : "+s"(la_), "+s"(lb_), "+s"(kk_)); \
        pg8::gemm_phase<pg8::EpiStore<2, true>, SchedVO, true, false>(F.lds, F.wave, la_, lb_, kk_, S_, E_); } while (0)
    for (int l = 0; l < NL; ++l) {
        const int pb = PH_LAYER0 + PH_PER_LAYER * l;
        int cid = cid0; asm volatile("" : "+s"(cid));
        if (EN(0) && IN(pb + 0)) { asm volatile("; PHASE_MARK L0"); for (int rep_ = 0; rep_ < ((REPK == 0 || REPK == 91 || REPK == 92) ? 2 : 1); ++rep_) {
            SchedDense S; S.o.init(T / 256, 7, F.G, cid); S.A = (const char*)(F.ws + WS_XR); S.a_tile = 256 * D * 2; S.B = (const char*)(F.ws + WS_WIN) + (size_t)l * INW * D * 2; S.b_tile = 256 * D * 2; S.b_batch = 0; S.bdiv = 1; S.bmod = 1;
            pg8::EpiIn E{(bf16*)(F.ws + WS_UACT), (bf16*)(F.ws + WS_VACT), (bf16*)(F.ws + WS_Q), (bf16*)(F.ws + WS_K), (bf16*)(F.ws + WS_V), (float*)(F.ws + WS_VSTAT),
                         F.in[7] + (size_t)l * 64, F.in[8] + (size_t)l * 64, (const float*)(F.ws + WS_ROPE), (const float*)(F.ws + WS_ROPE) + SEQ * 32, (const float*)(F.ws + WS_RINV)}; E.nostore = (REPK == 91 && rep_ == 0); E.skip = (REPK == 92 && rep_ == 0);
            pg8::gemm_phase<pg8::EpiIn, SchedDense, ALIGN_IN, false>(F.lds, F.wave, D, D, D, S, E);
            if ((REPK != 0 && REPK != 91 && REPK != 92) || rep_ == 1) { const int Gh = F.G >> 1;
                if (cid >= Gh) { if (l == 0) RUN_KV(F.G - Gh, cid - Gh); else { RUN_QK(l, F.G - Gh, cid - Gh); RUN_VO(l, F.G - Gh, cid - Gh);
                    if (CVT_NDA > 0 && l + 1 < NL) { __syncthreads(); cvt_items(F, l + 1, 0, (cid - Gh) * NWAVES + F.wave, (F.G - Gh) * NWAVES); } } } }
        if ((REPK == 0 || REPK == 91 || REPK == 92) && rep_ == 0) xcd_barrier(bar); } } SEAM(pb + 0);
        if (EN(1) && IN(pb + 1)) { asm volatile("; PHASE_MARK L1");
            float refB; { const int ln = lane_id(); float mq = fabsf(F.in[7][(size_t)l * 64 + ln]), mk = fabsf(F.in[8][(size_t)l * 64 + ln]); mq = max_x32(max_x16(max_row16(mq))); mk = max_x32(max_x16(max_row16(mk)));
                          refB = 8.0f * LOG2E * 1.02f * mq * mk; refB = __builtin_bit_cast(float, __builtin_amdgcn_readfirstlane(__builtin_bit_cast(int, refB))); }
            if (l == 0) { RUN_QK(0, F.G, cid); RUN_VO(0, F.G, (cid + (F.G >> 1)) % F.G); }
            PROBE_TOP(11)
            for (int it = 0; ; ++it) { const int w = it * F.G + F.vcu; if (w >= NB_ * 8 * (SEQ / 256)) break;
                const int i = w >> 8, c = w & 255, x = c >> 5, j = c & 31;
                if (refB < 60.0f) attn_body::attn_unit<8, true, ATTN_LSUM>(x >> 1, (x & 1) * 4 + i, j, (const attn_body::bf16*)(F.ws + WS_Q), (const attn_body::bf16*)(F.ws + WS_K), (const attn_body::bf16*)(F.ws + WS_V),
                                        (attn_body::bf16*)(F.ws + WS_MERGED), (float*)(F.ws + WS_ATSTAT), (char*)lds, F.wave, refB);
                else attn_body::attn_unit<8, false, false>(x >> 1, (x & 1) * 4 + i, j, (const attn_body::bf16*)(F.ws + WS_Q), (const attn_body::bf16*)(F.ws + WS_K), (const attn_body::bf16*)(F.ws + WS_V),
                                        (attn_body::bf16*)(F.ws + WS_MERGED), (float*)(F.ws + WS_ATSTAT), (char*)lds, F.wave, refB); }
            PROBE_END(11)
            PROBE_TOP(12) ph_gmlp(F, l); PROBE_END(12) } SEAM(pb + 1);
        if (EN(2) && IN(pb + 2)) { asm volatile("; PHASE_MARK L2"); PROBE_TOP(2)
            SchedDense S; S.o.init(T / 256, 4, F.G, cid); S.A = (const char*)(F.ws + WS_MERGED); S.a_tile = 256 * D * 2; S.B = (const char*)(F.ws + WS_WOUT) + (size_t)l * D * D * 2; S.b_tile = 256 * D * 2; S.b_batch = 0; S.bdiv = 1; S.bmod = 1;
            pg8::EpiX<true, true> E; E.xr = (bf16*)(F.ws + WS_XR); E.xstat = (float*)(F.ws + WS_XSTAT); E.gmstat = (const float*)(F.ws + WS_GMSTAT); E.atstat = (const float*)(F.ws + WS_ATSTAT); E.lds = F.lds; E.xa8 = F.ws + WS_XR8; E.scale = 1.0f;
#if REPK == 2
            if (rep_ == 0) E.wofs = (long)(WS_NSCR - WS_XR) / 2;
#endif
            pg8::gemm_phase<pg8::EpiX<true, true>, SchedDense, ALIGN_A, false>(F.lds, F.wave, D, D, D, S, E);
        PROBE_END(2) } SEAMG(pb + 2);
        if (EN(3) && IN(pb + 3)) { asm volatile("; PHASE_MARK L3"); PROBE_TOP(3)
            SchedDense S; S.o.init(T / 256, 4, F.G, cid); S.A = (const char*)(F.ws + WS_XR8); S.a_tile = 256 * D; S.B = (const char*)(F.ws + WS_QKT) + (size_t)l * NB_ * D * D; S.b_tile = 256 * D; S.b_batch = (size_t)D * D; S.bdiv = SEQ / 256; S.bmod = NB_;
            pg8::EpiS E{(const float*)(F.ws + WS_XSTAT), F.ws + WS_P, F.lds};
            int kq = D / 2; asm volatile("" : "+s"(kq));
            pg8::gemm_phase<pg8::EpiS, SchedDense, true, false, true>(F.lds, F.wave, kq, kq, kq, S, E);
        PROBE_END(3) } SEAMG(pb + 3);
        if (EN(4) && IN(pb + 4)) { asm volatile("; PHASE_MARK L4"); PROBE_TOP(4)
            SchedDense S; S.o.init(T / 256, 4, F.G, cid); S.A = (const char*)(F.ws + WS_P); S.a_tile = 256 * D; S.B = (const char*)(F.ws + WS_VOT) + (size_t)l * NB_ * D * D; S.b_tile = 256 * D; S.b_batch = (size_t)D * D; S.bdiv = SEQ / 256; S.bmod = NB_;
            pg8::EpiX<false, false> E; E.xr = (bf16*)(F.ws + WS_XR); E.xstat = nullptr; E.gmstat = nullptr; E.atstat = nullptr; E.lds = F.lds; E.xa8 = nullptr; E.scale = 1.0f / (P8S * V8S);
#if REPK == 4
            if (rep_ == 0) E.wofs = (long)(WS_NSCR - WS_XR) / 2;
#endif
            int kq = D / 2; asm volatile("" : "+s"(kq));
            pg8::gemm_phase<pg8::EpiX<false, false>, SchedDense, ALIGN_A, false, true>(F.lds, F.wave, kq, kq, kq, S, E);
        PROBE_END(4) } SEAMG(pb + 4);
        if (EN(5) && IN(pb + 5)) { asm volatile("; PHASE_MARK L5"); PROBE_TOP(5) ph_router(F, l); PROBE_END(5) }
        if (IN(pb + 5) && IN(pb + 6)) {
            if (ROUTER_HANDOFF && F.G == 256 && REPK != 310) {
                asm volatile("s_waitcnt vmcnt(0)" ::: "memory");
                __syncthreads();
                if (threadIdx.x == 0) { unsigned* rq = (unsigned*)(F.ws + WS_CTL) + CW_RTQ + 64 * (4 * l);
                    (void)xb_add(rq + 64 * (F.vcu >> 6), 1u);
                    if (F.vcu < NB_ * NE) { unsigned* mine = rq + 64 * (F.vcu >> 4); XB_SPIN(xb_ld(mine) < 64u, barw);
                        __builtin_amdgcn_fence(__ATOMIC_ACQUIRE, "agent"); asm volatile("s_waitcnt vmcnt(0)" ::: "memory"); } }
                __syncthreads();
            } else xcd_barrier(bar);
        }
        if (EN(6) && IN(pb + 6)) { asm volatile("; PHASE_MARK L6"); PROBE_TOP(6) ph_topk(F);
            if (CVT_ND > 0 && l + 1 < NL && F.G > NB_ * NE) cvt_pool(F, l + 1, 1, (unsigned*)(F.ws + WS_CTL) + CW_CVQ + 64 * l);
            PROBE_END(6) } SEAM(pb + 6);
        if (EN(7) && IN(pb + 7)) { asm volatile("; PHASE_MARK L7"); PROBE_TOP(7)
            SchedE1 S; S.o.init(NB_ * NE * 4, 8, F.G, cid); S.HBp = (const char*)(F.ws + WS_XR8); S.IDX = (const int*)(F.ws + WS_IDX); S.WGU = (const char*)(F.ws + WS_WGU) + (size_t)l * NE * 2 * FF * D;
            pg8::EpiH E{F.ws + WS_H};
            int kq = D / 2; asm volatile("" : "+s"(kq));
            pg8::gemm_phase<pg8::EpiH, SchedE1, ALIGN_E1, true, true>(F.lds, F.wave, kq, kq, kq, S, E);
        PROBE_END(7) } SEAMG(pb + 7);
        if (EN(8) && IN(pb + 8)) { asm volatile("; PHASE_MARK L8"); for (int rep_ = 0; rep_ < ((REPK == 8 || REPK == 81 || REPK == 82) ? 2 : 1); ++rep_) {
            SchedDense S; S.o.init(NB_ * NE * 4, 4, F.G, cid); S.A = (const char*)(F.ws + WS_H); S.a_tile = 256 * FF; S.B = (const char*)(F.ws + WS_WD) + (size_t)l * NE * D * FF; S.b_tile = 256 * FF; S.b_batch = (size_t)D * FF; S.bdiv = 4 * NB_; S.bmod = NE;
            pg8::EpiY8 E{F.ws + WS_Y, Y8S / (H8S * W8S)}; E.skip = (REPK == 81 && rep_ == 0); E.halfst = (REPK == 82 && rep_ == 0);
            int kq = FF / 2; asm volatile("" : "+s"(kq));
            pg8::gemm_phase<pg8::EpiY8, SchedDense, ALIGN_A, false, true>(F.lds, F.wave, kq, kq, kq, S, E);
        if ((REPK == 8 || REPK == 81 || REPK == 82) && rep_ == 0) xcd_barrier(bar); } } SEAM(pb + 8);
        if (EN(9) && IN(pb + 9)) { asm volatile("; PHASE_MARK L9"); PROBE_TOP(9) ph_combine(F, l, REPK == 9 && rep_ == 0); PROBE_END(9) } SEAMG(pb + 9);
    }
#undef IN
#undef SEAM
}

static int g_grid = 0;
static void launch_mega(Args a, int lo, int hi, int region, hipStream_t stream) {
    a.ph_lo = lo; a.ph_hi = hi; a.bar_region = region; a.pad = 0;
    hipLaunchKernelGGL(mega, dim3(g_grid), dim3(NTHR), LDS_BYTES, stream, a);
}
extern "C" void kernel_launch(void* const* d_in, const int* in_sizes, int n_in, void* d_out, int out_size, void* d_ws, size_t ws_size, hipStream_t stream) {
    if (g_grid == 0) {
        if (n_in != 22 || out_size != T * D || ws_size < WS_END) { fprintf(stderr, "kernel_launch: unexpected sizes n_in %d out %d ws %zu\n", n_in, out_size, ws_size); g_grid = -1; return; }
        int dev = 0, cus = 0;
        if (hipGetDevice(&dev) != hipSuccess || hipDeviceGetAttribute(&cus, hipDeviceAttributeMultiprocessorCount, dev) != hipSuccess) { g_grid = -1; return; }
        if (hipFuncSetAttribute((const void*)mega, hipFuncAttributeMaxDynamicSharedMemorySize, LDS_BYTES) != hipSuccess) { g_grid = -1; return; }
        int per_cu = 0;
        if (hipOccupancyMaxActiveBlocksPerMultiprocessor(&per_cu, (const void*)mega, NTHR, LDS_BYTES) != hipSuccess || per_cu < 1) fprintf(stderr, "kernel_launch: occupancy query says %d\n", per_cu);
        (void)hipGetLastError();
        g_grid = cus;
    }
    if (g_grid < 0) return;
    hipMemsetAsync((char*)d_ws + WS_CTL, 0, CTL_ZERO_BYTES, stream);
    Args a{};
    for (int i = 0; i < 22; ++i) a.in[i] = (const float*)d_in[i];
    a.out = (float*)d_out; a.ws = (unsigned char*)d_ws;
    launch_mega(a, 0, PH_END, 0, stream);
}
```
